# Optimizing an MI355X kernel written in HIP

```python
import math
import jax
import jax.numpy as jnp
from jax import lax
import numpy as np

D_MODEL = 1024
BATCH = 2
SEQ = 8192
DEPTH = 4

GRID_W = 64
CTX_LEN = 256
N_MOD = 9
N_NORMS = 6
D_FF = 2816
MACARON_W = 0.5
NORM_EPS = 1e-6
NEG_INF = -1e30

HY_CH = 256
HY_ORDER = 2
HY_EMB = 33
HY_FILT = 64
HY_SHORT = 3
HY_TARGET = 1e-2
HY_FAST = 0.3
HY_SLOW = 1.5

RW_HEADS = 6
RW_HD = 64
RW_W = RW_HEADS * RW_HD
RW_DECAY_LORA = 64
RW_AAA_LORA = 64
RW_GATE_LORA = 128
RW_GN_EPS = 64e-5
ROPE_BASE = 10000.0

NA_HEADS = 6
NA_HD = 64
NA_W = NA_HEADS * NA_HD
WIN_ROWS = 8
WIN_COLS = 16
COL_BLOCK = 16
COL_BAND = 32

MIX_W = HY_CH + RW_W + NA_W
HY_IN = (HY_ORDER + 1) * HY_CH
RW_IN = 3 * RW_W + 2 * RW_DECAY_LORA + 2 * RW_AAA_LORA + RW_GATE_LORA
NA_IN = 3 * NA_W
IN_W = HY_IN + RW_IN + NA_IN

kernel_name = 'hybrid_hyena_rwkv7_natten_dit_trunk'


def rmsnorm(x, g):
    xf = x.astype(jnp.float32)
    y = xf * lax.rsqrt(jnp.mean(xf * xf, axis=-1, keepdims=True) + NORM_EPS)
    return (y * g.astype(jnp.float32)).astype(x.dtype)


def modulate(x, shift, scale):
    return x * (1 + scale) + shift


def swiglu(u, w_gu, w_dn):
    gate, up = jnp.split(u @ w_gu, 2, axis=-1)
    return (jax.nn.silu(gate) * up) @ w_dn


def ffn_sublayer(h, shift, scale, gate, g_pre, g_post, w_gu, w_dn):
    u = modulate(rmsnorm(h, g_pre), shift, scale)
    return h + MACARON_W * gate * rmsnorm(swiglu(u, w_gu, w_dn), g_post)


def centred_depthwise_conv(x, w, b):
    k = w.shape[0]
    half = k // 2
    L = x.shape[1]
    xp = jnp.pad(x, ((0, 0), (half, half), (0, 0)))
    return sum(xp[:, j:j + L] * w[j] for j in range(k)) + b


def neighbour_tokens(x):
    xp = jnp.pad(x, ((0, 0), (1, 1), (0, 0)))
    return xp[:, :-2], xp[:, 2:]


def axial_rope_tables(L, hd):
    nf = hd // 4
    t = jnp.arange(L)
    row = (t // GRID_W).astype(jnp.float32)
    col = (t % GRID_W).astype(jnp.float32)
    inv = ROPE_BASE ** (-jnp.arange(nf, dtype=jnp.float32) / nf)
    ang_r = row[:, None] * inv
    ang_c = col[:, None] * inv
    ang = jnp.concatenate([ang_r, ang_r, ang_c, ang_c], axis=-1)
    return jnp.cos(ang), jnp.sin(ang)


def apply_rope(x, cos, sin):
    sh = x.shape
    L, hd = cos.shape
    xa = x.reshape(sh[:-1] + (2, 2, hd // 4))
    rot = jnp.stack([-xa[..., 1, :], xa[..., 0, :]], axis=-2).reshape(sh)
    bshape = (1, L) + (1,) * (x.ndim - 3) + (hd,)
    return (x * cos.reshape(bshape) + rot * sin.reshape(bshape)).astype(x.dtype)


def hyena_filters(L, w1, b1, w2, b2, w3, freq):
    f32 = jnp.float32
    t = jnp.linspace(0.0, 1.0, L, dtype=f32)[:, None]
    bands = (HY_EMB - 1) // 2
    ang = 2.0 * math.pi * jnp.arange(L, dtype=f32)[:, None] / L
    fr = jnp.linspace(1e-4, bands - 1, bands, dtype=f32)[None, :]
    z = jnp.concatenate([t, jnp.cos(fr * ang), -jnp.sin(fr * ang)], axis=-1)
    fq = freq.astype(f32)
    h = jnp.sin(fq * (z @ w1.astype(f32) + b1.astype(f32)))
    h = jnp.sin(fq * (h @ w2.astype(f32) + b2.astype(f32)))
    h = (h @ w3.astype(f32)).reshape(L, HY_ORDER, 2, HY_CH)
    deltas = jnp.abs(jnp.linspace(math.log(HY_TARGET) / HY_SLOW, math.log(HY_TARGET) / HY_FAST, HY_CH, dtype=f32))
    return h * jnp.exp(-t * deltas)[:, None, None, :]


def bidir_long_conv(u, h_fwd, h_bwd, bias):
    L = u.shape[1]
    n = 2 * L
    k = jnp.concatenate([h_fwd, jnp.zeros_like(h_fwd[:1]), h_bwd[:0:-1]], axis=0)
    uf = u.astype(jnp.float32)
    y = jnp.fft.irfft(jnp.fft.rfft(uf, n=n, axis=1) * jnp.fft.rfft(k, n=n, axis=0)[None], n=n, axis=1)[:, :L]
    return (y + uf * bias.astype(jnp.float32)).astype(u.dtype)


def hyena_mixer(p, conv_w, conv_b, filters, bias):
    v, *gates = jnp.split(centred_depthwise_conv(p, conv_w, conv_b), HY_ORDER + 1, axis=-1)
    z = v
    for o, gate in enumerate(gates):
        z = gate * bidir_long_conv(z, filters[:, o, 0], filters[:, o, 1], bias[o])
    return z


def l2_normalize(x):
    xf = x.astype(jnp.float32)
    n = jnp.sqrt(jnp.sum(xf * xf, axis=-1, keepdims=True))
    return (xf / jnp.maximum(n, 1e-12)).astype(x.dtype)


def rwkv_inputs(p, mu, w0, w2, a0, a2, g2, k_k, k_a, rope_cs):
    B, L, _ = p.shape
    prev, nxt = neighbour_tokens(p)
    xs = p + mu[0] * (prev - p) + mu[1] * (nxt - p)
    i1 = 3 * RW_W + 2 * RW_DECAY_LORA
    r, k, v, wd, ad, gd = jnp.split(xs, [RW_W, 2 * RW_W, 3 * RW_W, i1, i1 + 2 * RW_AAA_LORA], axis=-1)
    heads = lambda t: t.reshape(t.shape[:-1] + (RW_HEADS, RW_HD))
    g = jax.nn.sigmoid(gd) @ g2
    wd = jnp.tanh(wd.reshape(B, L, 2, RW_DECAY_LORA))
    logw = -jax.nn.softplus(-(w0 + jnp.einsum('bldr,drc->bldc', wd, w2))) - 0.5
    decay = jnp.exp(-jnp.exp(logw.astype(jnp.float32)))
    a = jax.nn.sigmoid(a0 + jnp.einsum('bldr,drc->bldc', ad.reshape(B, L, 2, RW_AAA_LORA), a2))
    kk = l2_normalize(heads(k * k_k))
    k_dir = heads(k[:, :, None] * (1 + (a - 1) * k_a))
    b = kk[:, :, None] * heads(a)
    r, v = heads(r), heads(v)
    r_s, kk_s, k_s, b_s = r, kk, k_dir, b
    if rope_cs is not None:
        r_s, kk_s, k_s, b_s = (apply_rope(t, rope_cs[0], rope_cs[1]) for t in (r, kk, k_dir, b))
    return (r_s, heads(decay), k_s, v, -kk_s, b_s), (r, k_dir, v, g)


def wkv7_scan(state0, scan_in, d, reverse, emit):
    r, decay, k, v, a, b = scan_in
    seq = tuple(jnp.moveaxis(t.astype(jnp.float32), 1, 0) for t in (r, decay[:, :, d], k[:, :, d], v, a, b[:, :, d]))

    def step(S, inp):
        r_t, w_t, k_t, v_t, a_t, b_t = inp
        sa = jnp.einsum('bhij,bhj->bhi', S, a_t)
        S = S * w_t[:, :, None, :] + sa[..., None] * b_t[:, :, None, :] + v_t[..., None] * k_t[:, :, None, :]
        return S, (jnp.einsum('bhij,bhj->bhi', S, r_t) if emit else None)

    S, ys = lax.scan(step, state0, seq, reverse=reverse)
    return S, (jnp.moveaxis(ys, 0, 1) if emit else None)


def rwkv_output(y_f, y_b, out_in, r_k, ln_w, ln_b):
    r, k_dir, v, g = out_in
    B, L = y_f.shape[:2]
    y = y_f + y_b
    mean = jnp.mean(y, axis=-1, keepdims=True)
    var = jnp.mean(jnp.square(y - mean), axis=-1, keepdims=True)
    y = ((y - mean) * lax.rsqrt(var + RW_GN_EPS)).reshape(B, L, RW_W) * ln_w + ln_b
    bonus = jnp.sum(r[:, :, None] * k_dir * r_k, axis=(2, 4))[..., None] * v
    return (y.astype(g.dtype) + bonus.reshape(B, L, RW_W)) * g


def natten_column_tables():
    ncb = GRID_W // COL_BLOCK
    qcols = np.arange(GRID_W).reshape(ncb, COL_BLOCK)
    win0 = np.clip(qcols - WIN_COLS // 2, 0, GRID_W - WIN_COLS)
    band0 = np.clip(np.arange(ncb) * COL_BLOCK - WIN_COLS // 2, 0, GRID_W - COL_BAND)
    band_cols = band0[:, None] + np.arange(COL_BAND)
    kc = band_cols[:, None, :]
    valid = (kc >= win0[..., None]) & (kc < win0[..., None] + WIN_COLS)
    col_off = np.clip(kc - qcols[..., None] + WIN_COLS - 1, 0, 2 * WIN_COLS - 2)
    return band_cols, valid, col_off


def natten_latent(q, k, v, k_ctx, v_ctx, rpb):
    B, L = q.shape[:2]
    rows = L // GRID_W
    kr = min(WIN_ROWS, rows)
    ncb = GRID_W // COL_BLOCK
    band_cols, valid, col_off = natten_column_tables()
    valid = jnp.asarray(valid)
    grid = lambda t: t.reshape(B, rows, GRID_W, NA_HEADS, NA_HD)
    qg, kg, vg = grid(q), grid(k), grid(v)
    scale = NA_HD ** -0.5
    n_loc = kr * COL_BAND

    def row_block(i):
        start = jnp.clip(i - WIN_ROWS // 2, 0, rows - kr)
        q_i = lax.dynamic_index_in_dim(qg, i, axis=1, keepdims=False).reshape(B, ncb, COL_BLOCK, NA_HEADS, NA_HD)
        k_i = jnp.take(lax.dynamic_slice_in_dim(kg, start, kr, axis=1), band_cols, axis=2)
        v_i = jnp.take(lax.dynamic_slice_in_dim(vg, start, kr, axis=1), band_cols, axis=2)
        row_off = start + jnp.arange(kr) - i + WIN_ROWS - 1
        bias = jnp.transpose(rpb[:, row_off][:, :, col_off], (0, 2, 3, 1, 4))
        s_loc = jnp.einsum('bnqhd,brnkhd->bhnqrk', q_i, k_i).astype(jnp.float32) * scale + bias.astype(jnp.float32)
        s_loc = jnp.where(valid[:, :, None, :], s_loc, NEG_INF)
        s_ctx = jnp.einsum('bnqhd,bchd->bhnqc', q_i, k_ctx).astype(jnp.float32) * scale
        s = jnp.concatenate([s_loc.reshape(B, NA_HEADS, ncb, COL_BLOCK, n_loc), s_ctx], axis=-1)
        p = jax.nn.softmax(s, axis=-1).astype(v.dtype)
        p_loc = p[..., :n_loc].reshape(B, NA_HEADS, ncb, COL_BLOCK, kr, COL_BAND)
        o = jnp.einsum('bhnqrk,brnkhd->bnqhd', p_loc, v_i) + jnp.einsum('bhnqc,bchd->bnqhd', p[..., n_loc:], v_ctx)
        return o.reshape(B, GRID_W, NA_W)

    out = lax.map(row_block, jnp.arange(rows))
    return jnp.moveaxis(out, 0, 1).reshape(B, L, NA_W)


def context_attention(q, k, v):
    B, Lc = q.shape[:2]
    s = jnp.einsum('bqhd,bkhd->bhqk', q, k).astype(jnp.float32) * NA_HD ** -0.5
    p = jax.nn.softmax(s, axis=-1).astype(v.dtype)
    return jnp.einsum('bhqk,bkhd->bqhd', p, v).reshape(B, Lc, NA_W)


def token_mixer(u_ctx, u_lat, rope_cs, w_in, w_out, hy, rw, na_rpb, ctx_out):
    split = lambda p: jnp.split(p, [HY_IN, HY_IN + RW_IN], axis=-1)
    hy_c, rw_c, na_c = split(u_ctx @ w_in)
    hy_l, rw_l, na_l = split(u_lat @ w_in)
    hy_conv_w, hy_conv_b, f_w1, f_b1, f_w2, f_b2, f_w3, f_freq, hy_bias = hy
    o_hy_l = hyena_mixer(hy_l, hy_conv_w, hy_conv_b, hyena_filters(u_lat.shape[1], f_w1, f_b1, f_w2, f_b2, f_w3, f_freq), hy_bias)
    mu, w0, w2, a0, a2, g2, k_k, k_a, r_k, ln_w, ln_b = rw
    scan_c, out_c = rwkv_inputs(rw_c, mu, w0, w2, a0, a2, g2, k_k, k_a, None)
    scan_l, out_l = rwkv_inputs(rw_l, mu, w0, w2, a0, a2, g2, k_k, k_a, rope_cs)
    s0 = jnp.zeros((u_lat.shape[0], RW_HEADS, RW_HD, RW_HD), jnp.float32)
    s_f, y_fc = wkv7_scan(s0, scan_c, 0, False, ctx_out)
    s_b, y_bc = wkv7_scan(s0, scan_c, 1, True, ctx_out)
    _, y_fl = wkv7_scan(s_f, scan_l, 0, False, True)
    _, y_bl = wkv7_scan(s_b, scan_l, 1, True, True)
    o_rw_l = rwkv_output(y_fl, y_bl, out_l, r_k, ln_w, ln_b)
    heads = lambda t: t.reshape(t.shape[:-1] + (NA_HEADS, NA_HD))
    q_c, k_c, v_c = (heads(t) for t in jnp.split(na_c, 3, axis=-1))
    q_l, k_l, v_l = (heads(t) for t in jnp.split(na_l, 3, axis=-1))
    o_na_l = natten_latent(q_l, k_l, v_l, k_c, v_c, na_rpb)
    o_lat = jnp.concatenate([o_hy_l.astype(u_lat.dtype), o_rw_l.astype(u_lat.dtype), o_na_l], axis=-1) @ w_out
    if not ctx_out:
        return o_lat, None
    o_hy_c = hyena_mixer(hy_c, hy_conv_w, hy_conv_b, hyena_filters(u_ctx.shape[1], f_w1, f_b1, f_w2, f_b2, f_w3, f_freq), hy_bias)
    o_rw_c = rwkv_output(y_fc, y_bc, out_c, r_k, ln_w, ln_b)
    o_na_c = context_attention(q_c, k_c, v_c)
    o_ctx = jnp.concatenate([o_hy_c.astype(u_ctx.dtype), o_rw_c.astype(u_ctx.dtype), o_na_c], axis=-1) @ w_out
    return o_lat, o_ctx


def setup_inputs(seed: int = 0) -> dict:
    key = jax.random.key(seed)
    ks = iter(jax.random.split(key, 40))
    f32 = jnp.float32
    D = D_MODEL

    def nrm(shape, s=1.0):
        return s * jax.random.normal(next(ks), shape, f32)

    return {
        'x': nrm((BATCH, SEQ, D)),
        'c': nrm((BATCH, D)),
        'ctx': nrm((BATCH, CTX_LEN, D)),
        'c_ctx': nrm((D,)),
        'mod_w': nrm((DEPTH, D, N_MOD * D), 0.5 * D ** -0.5),
        'mod_b': nrm((DEPTH, N_MOD * D), 0.01),
        'norm_g': 1.0 + nrm((DEPTH, N_NORMS, D), 0.05),
        'ffn1_wgu': nrm((DEPTH, D, 2 * D_FF), D ** -0.5),
        'ffn1_wdn': nrm((DEPTH, D_FF, D), D_FF ** -0.5),
        'ffn2_wgu': nrm((DEPTH, D, 2 * D_FF), D ** -0.5),
        'ffn2_wdn': nrm((DEPTH, D_FF, D), D_FF ** -0.5),
        'w_in': nrm((DEPTH, D, IN_W), D ** -0.5),
        'w_out': nrm((DEPTH, MIX_W, D), MIX_W ** -0.5),
        'hy_conv_w': nrm((DEPTH, HY_SHORT, HY_IN), 0.5),
        'hy_conv_b': nrm((DEPTH, HY_IN), 0.01),
        'hy_f_w1': nrm((DEPTH, HY_EMB, HY_FILT), HY_EMB ** -0.5),
        'hy_f_b1': nrm((DEPTH, HY_FILT), 0.1),
        'hy_f_w2': nrm((DEPTH, HY_FILT, HY_FILT), HY_FILT ** -0.5),
        'hy_f_b2': nrm((DEPTH, HY_FILT), 0.1),
        'hy_f_w3': nrm((DEPTH, HY_FILT, HY_ORDER * 2 * HY_CH), 0.01),
        'hy_freq': 1.0 + nrm((DEPTH, HY_FILT), 0.05),
        'hy_bias': nrm((DEPTH, HY_ORDER, HY_CH), 0.5),
        'rw_mu': jax.random.uniform(next(ks), (DEPTH, 2, RW_IN), f32, 0.0, 0.5),
        'rw_w0': -1.0 + nrm((DEPTH, 2, RW_W), 0.5),
        'rw_w2': nrm((DEPTH, 2, RW_DECAY_LORA, RW_W), 0.5 * RW_DECAY_LORA ** -0.5),
        'rw_a0': nrm((DEPTH, 2, RW_W), 0.1),
        'rw_a2': nrm((DEPTH, 2, RW_AAA_LORA, RW_W), 0.5 * RW_AAA_LORA ** -0.5),
        'rw_g2': nrm((DEPTH, RW_GATE_LORA, RW_W), RW_GATE_LORA ** -0.5),
        'rw_k_k': 0.85 + nrm((DEPTH, RW_W), 0.05),
        'rw_k_a': 1.0 + nrm((DEPTH, RW_W), 0.05),
        'rw_r_k': nrm((DEPTH, RW_HEADS, RW_HD), 0.1),
        'rw_ln_w': 1.0 + nrm((DEPTH, RW_W), 0.05),
        'rw_ln_b': nrm((DEPTH, RW_W), 0.01),
        'na_rpb': nrm((DEPTH, NA_HEADS, 2 * WIN_ROWS - 1, 2 * WIN_COLS - 1), 0.1),
    }


def reference(x, c, ctx, c_ctx, mod_w, mod_b, norm_g, ffn1_wgu, ffn1_wdn, ffn2_wgu, ffn2_wdn, w_in, w_out,
              hy_conv_w, hy_conv_b, hy_f_w1, hy_f_b1, hy_f_w2, hy_f_b2, hy_f_w3, hy_freq, hy_bias,
              rw_mu, rw_w0, rw_w2, rw_a0, rw_a2, rw_g2, rw_k_k, rw_k_a, rw_r_k, rw_ln_w, rw_ln_b, na_rpb):
    rope_cs = axial_rope_tables(x.shape[1], RW_HD)
    silu_c = jax.nn.silu(c)
    silu_cc = jax.nn.silu(c_ctx)
    h_lat, h_ctx = x, ctx
    for l in range(DEPTH):
        ctx_out = l < DEPTH - 1
        m_l = jnp.split((silu_c @ mod_w[l] + mod_b[l])[:, None, :], N_MOD, axis=-1)
        m_c = jnp.split(silu_cc @ mod_w[l] + mod_b[l], N_MOD, axis=-1)
        g = norm_g[l]
        h_lat = ffn_sublayer(h_lat, m_l[0], m_l[1], m_l[2], g[0], g[1], ffn1_wgu[l], ffn1_wdn[l])
        h_ctx = ffn_sublayer(h_ctx, m_c[0], m_c[1], m_c[2], g[0], g[1], ffn1_wgu[l], ffn1_wdn[l])
        u_lat = modulate(rmsnorm(h_lat, g[2]), m_l[3], m_l[4])
        u_ctx = modulate(rmsnorm(h_ctx, g[2]), m_c[3], m_c[4])
        hy = (hy_conv_w[l], hy_conv_b[l], hy_f_w1[l], hy_f_b1[l], hy_f_w2[l], hy_f_b2[l], hy_f_w3[l], hy_freq[l], hy_bias[l])
        rw = (rw_mu[l], rw_w0[l], rw_w2[l], rw_a0[l], rw_a2[l], rw_g2[l], rw_k_k[l], rw_k_a[l], rw_r_k[l], rw_ln_w[l], rw_ln_b[l])
        o_lat, o_ctx = token_mixer(u_ctx, u_lat, rope_cs, w_in[l], w_out[l], hy, rw, na_rpb[l], ctx_out)
        h_lat = h_lat + m_l[5] * rmsnorm(o_lat, g[3])
        h_lat = ffn_sublayer(h_lat, m_l[6], m_l[7], m_l[8], g[4], g[5], ffn2_wgu[l], ffn2_wdn[l])
        if ctx_out:
            h_ctx = h_ctx + m_c[5] * rmsnorm(o_ctx, g[3])
            h_ctx = ffn_sublayer(h_ctx, m_c[6], m_c[7], m_c[8], g[4], g[5], ffn2_wgu[l], ffn2_wdn[l])
    return h_lat
```

```cpp
#include <hip/hip_runtime.h>
#include <hip/hip_cooperative_groups.h>
#include <cstdio>
namespace cg = cooperative_groups;
__device__ __forceinline__ int otid() { int t = threadIdx.x; asm volatile("" : "+v"(t)); return t; }
namespace pg8 {
#define PG8_LAS __attribute__((address_space(3)))
typedef unsigned short bf16_t;
typedef short bf16x8 __attribute__((ext_vector_type(8)));
typedef float f32x4 __attribute__((ext_vector_type(4)));
typedef unsigned u32x4 __attribute__((ext_vector_type(4)));
constexpr int BM = 256, BK = 64, HALF = 128, HTB = HALF * BK * 2  , STAGE_BYTES = 8 * HTB, NXCD = 8, WGM = 8;

__host__ __device__ __forceinline__ int lds_byte(int r, int c) { const int st = (r >> 4) * 2 + (c >> 5), rr = r & 15, cc = c & 31, ob = rr * 64 + cc * 2; return st * 1024 + (ob ^ (((ob >> 9) & 1) << 5)); }
__host__ __device__ __forceinline__ void stage_rc(int b, int& R, int& C) { const int st = b / 1024, sb = b % 1024, swz = sb ^ (((sb >> 9) & 1) << 5); R = (st >> 1) * 16 + swz / 64; C = (st & 1) * 32 + (swz % 64) / 2; }
__host__ __device__ __forceinline__ int perm32(int rho) { const int n = rho >> 4, i = rho & 15; return 8 * (i >> 2) + 4 * n + (i & 3); }

struct Unit { int pm, pn; };
struct Gemm { const bf16_t* A; const bf16_t* Bt; int M, N, K; };
struct StaticOrder {
    int nM, nN, nwg, G, c;
    __host__ __device__ void init(int M, int N, int G_, int c_) { nM = M / BM; nN = N / BM; nwg = nM * nN; G = G_; c = c_; }
    __host__ __device__ bool next(int i, Unit& u) const {
        const long L = (long)i * G + c; if (L >= nwg) return false;
        int wgid = (int)L; { const int q = nwg / NXCD, r = nwg % NXCD, xcd = wgid % NXCD, off = wgid / NXCD; wgid = (xcd < r ? xcd * (q + 1) : r * (q + 1) + (xcd - r) * q) + off; }
        const int nig = WGM * nN, gid = wgid / nig, fm = gid * WGM, gsz = (nM - fm) < WGM ? (nM - fm) : WGM;
        u.pm = fm + ((wgid % nig) % gsz); u.pn = (wgid % nig) / gsz; return true;
    }
    __device__ __forceinline__ void a_ready(const Unit&) const {}
    __device__ __forceinline__ void done(const Unit&) const {}
};
__device__ __forceinline__ unsigned cvt_pk_bf16(float lo, float hi) { unsigned r; asm volatile("v_cvt_pk_bf16_f32 %0, %1, %2" : "=v"(r) : "v"(lo), "v"(hi)); return r; }
template <class Epi, class Sched>
__device__ __forceinline__ void gemm_phase(PG8_LAS unsigned char* lds, const Gemm g, const Sched& S, const Epi& E) {
    const int tid = otid(), wid = __builtin_amdgcn_readfirstlane(tid >> 6), lane = tid & 63, wr = wid >> 2, wc = wid & 3, fr = lane & 15, fq = lane >> 4;
    const int K = g.K, nt = K / BK;
#define PG8_STAMP() do {} while (0)
    unsigned voffA[2], voffB[2];
#pragma unroll
    for (int i = 0; i < 2; ++i) { int R, C; stage_rc(tid * 16 + i * 8192, R, C); const int Rb = Epi::PERM ? ((R & ~31) + perm32(R & 31)) : R;
        voffA[i] = (unsigned)(R * K + C) * 2u; voffB[i] = (unsigned)(Rb * K + C) * 2u; }
    const size_t kstep = (size_t)(BK * 2);
    const size_t hstep = (size_t)HALF * K * 2;
    const size_t tstep = 2 * hstep;
    const unsigned ldsw = (unsigned)wid * 1024u;
    const int aoff = lds_byte(wr * 64 + fr, fq * 8), boff = lds_byte(wc * 32 + fr, fq * 8);
#define PG8_SA(b, h) (((b) * 2 + (h)) * HTB)
#define PG8_SB(b, h) ((4 + (b) * 2 + (h)) * HTB)
#define PG8_STAGE(bufoff, gbase, voff) do { _Pragma("unroll") for (int _i = 0; _i < 2; ++_i) \
        __builtin_amdgcn_global_load_lds((const unsigned*)((const char*)(gbase) + (voff)[_i]), (PG8_LAS unsigned*)(lds + (bufoff) + ldsw + _i * 8192), 16, 0, 0); } while (0)
#define PG8_LDA(dst, b, h) do { _Pragma("unroll") for (int m = 0; m < 4; ++m) _Pragma("unroll") for (int k = 0; k < 2; ++k) dst[m][k] = *(const PG8_LAS bf16x8*)(lds + PG8_SA(b, h) + aoff + m * 2048 + k * 1024); } while (0)
#define PG8_LDB(dst, b, h) do { _Pragma("unroll") for (int n = 0; n < 2; ++n) _Pragma("unroll") for (int k = 0; k < 2; ++k) dst[n][k] = *(const PG8_LAS bf16x8*)(lds + PG8_SB(b, h) + boff + n * 2048 + k * 1024); } while (0)
#define PG8_MMA(ai, bj, At, Bt) do { __builtin_amdgcn_s_setprio(1); _Pragma("unroll") for (int m = 0; m < 4; ++m) _Pragma("unroll") for (int n = 0; n < 2; ++n) _Pragma("unroll") for (int k = 0; k < 2; ++k) \
        acc[ai][bj][m][n] = __builtin_amdgcn_mfma_f32_16x16x32_bf16(Bt[n][k], At[m][k], acc[ai][bj][m][n], 0, 0, 0); __builtin_amdgcn_s_setprio(0); } while (0)
#define PG8_WAIT_V(n) asm volatile("s_waitcnt vmcnt(" #n ")" ::: "memory")
#define PG8_WAIT_L(n) asm volatile("s_waitcnt lgkmcnt(" #n ")" ::: "memory")
#define PG8_BAR __builtin_amdgcn_s_barrier()
#define PG8_SCHED __builtin_amdgcn_sched_barrier(0)
    Unit cur, nxt; int ui = 0;
    if (!S.next(0, cur)) return;
    f32x4 acc[2][2][4][2];
#pragma unroll
    for (int a = 0; a < 2; ++a)
#pragma unroll
        for (int b = 0; b < 2; ++b)
#pragma unroll
            for (int m = 0; m < 4; ++m)
#pragma unroll
                for (int n = 0; n < 2; ++n) acc[a][b][m][n] = (f32x4){0.f, 0.f, 0.f, 0.f};
    bf16x8 At[4][2], B0[2][2], B1[2][2];
    const char* cA = (const char*)g.A + (size_t)cur.pm * tstep; const char* cB = (const char*)g.Bt + (size_t)cur.pn * tstep;
    S.a_ready(cur);
    PG8_STAGE(PG8_SB(0, 0), cB, voffB); PG8_STAGE(PG8_SA(0, 0), cA, voffA); PG8_STAGE(PG8_SB(0, 1), cB + hstep, voffB); PG8_STAGE(PG8_SA(0, 1), cA + hstep, voffA);
    if (wr == 1) PG8_BAR;
    PG8_WAIT_V(4); PG8_BAR;
    PG8_STAGE(PG8_SB(1, 0), cB + kstep, voffB); PG8_STAGE(PG8_SA(1, 0), cA + kstep, voffA); PG8_STAGE(PG8_SB(1, 1), cB + hstep + kstep, voffB);
    PG8_WAIT_V(6); PG8_BAR;
    PG8_STAMP();
    for (;;) {
        const bool has_next = S.next(ui + 1, nxt);
        const char* nA = has_next ? (const char*)g.A + (size_t)nxt.pm * tstep : cA; const char* nB = has_next ? (const char*)g.Bt + (size_t)nxt.pn * tstep : cB;
        for (int t = 0; t < nt; t += 2) {
            const bool last = (t == nt - 2);
            const char* a1 = cA + (size_t)(t + 1) * kstep;
            const char* a2 = last ? nA : cA + (size_t)(t + 2) * kstep; const char* b2 = last ? nB : cB + (size_t)(t + 2) * kstep;
            const char* a3 = a2 + kstep; const char* b3 = b2 + kstep;
            if (last && has_next) S.a_ready(nxt);
            PG8_LDB(B0, 0, 0); PG8_SCHED; PG8_LDA(At, 0, 0); PG8_STAGE(PG8_SA(1, 1), a1 + hstep, voffA);
            PG8_WAIT_L(8); PG8_BAR; PG8_WAIT_L(0); PG8_MMA(0, 0, At, B0); PG8_BAR; PG8_SCHED;
            PG8_LDB(B1, 0, 1); PG8_STAGE(PG8_SB(0, 0), b2, voffB);
            PG8_BAR; PG8_WAIT_L(0); PG8_MMA(0, 1, At, B1); PG8_BAR;
            PG8_LDA(At, 0, 1); PG8_STAGE(PG8_SA(0, 0), a2, voffA);
            PG8_BAR; PG8_WAIT_L(0); PG8_MMA(1, 0, At, B0); PG8_BAR; PG8_SCHED;
            PG8_STAGE(PG8_SB(0, 1), b2 + hstep, voffB);
            PG8_WAIT_V(6); PG8_BAR; PG8_MMA(1, 1, At, B1); PG8_BAR;
            PG8_LDB(B0, 1, 0); PG8_SCHED; PG8_LDA(At, 1, 0); PG8_STAGE(PG8_SA(0, 1), a2 + hstep, voffA);
            PG8_WAIT_L(8); PG8_BAR; PG8_WAIT_L(0); PG8_MMA(0, 0, At, B0); PG8_BAR; PG8_SCHED;
            PG8_LDB(B1, 1, 1); PG8_STAGE(PG8_SB(1, 0), b3, voffB);
            PG8_BAR; PG8_WAIT_L(0); PG8_MMA(0, 1, At, B1); PG8_BAR;
            PG8_LDA(At, 1, 1); PG8_STAGE(PG8_SA(1, 0), a3, voffA);
            PG8_BAR; PG8_WAIT_L(0); PG8_MMA(1, 0, At, B0); PG8_BAR; PG8_SCHED;
            PG8_STAGE(PG8_SB(1, 1), b3 + hstep, voffB);
            PG8_WAIT_V(6); PG8_BAR; PG8_MMA(1, 1, At, B1); PG8_BAR;
        }
        PG8_STAMP();
        if constexpr (!Epi::AFTER_DRAIN) { E(acc, cur, wr, wc, fr, fq); S.done(cur); }
        PG8_STAMP();
        if (!has_next) break;
#pragma unroll
        for (int a = 0; a < 2; ++a)
#pragma unroll
            for (int b = 0; b < 2; ++b)
#pragma unroll
                for (int m = 0; m < 4; ++m)
#pragma unroll
                    for (int n = 0; n < 2; ++n) acc[a][b][m][n] = (f32x4){0.f, 0.f, 0.f, 0.f};
        cur = nxt; cA = nA; cB = nB; ++ui;
    }
    PG8_WAIT_V(0);
    if (wr == 0) PG8_BAR;
    PG8_BAR;
    if constexpr (Epi::AFTER_DRAIN) { E.fused(acc, cur, wr, wc, fr, fq, lds, wid, lane); S.done(cur); }
    PG8_STAMP();
#undef PG8_STAMP
#undef PG8_SA
#undef PG8_SB
#undef PG8_STAGE
#undef PG8_LDA
#undef PG8_LDB
#undef PG8_MMA
#undef PG8_WAIT_V
#undef PG8_WAIT_L
#undef PG8_BAR
#undef PG8_SCHED
}
}

using pg8::bf16_t; using pg8::f32x4; using pg8::u32x4; using pg8::cvt_pk_bf16;
typedef unsigned u32x2 __attribute__((ext_vector_type(2)));
#define LAS __attribute__((address_space(3)))

constexpr int D = 1024, NB = 2, SEQ = 8192, DEPTH = 4, CTX = 256, DFF = 2816;
constexpr int TL = NB * SEQ, TC = NB * CTX, T = TL + TC;
constexpr int NMOD = 9 * D;
constexpr int HYC = 256, RWW = 384, NAW = 384, INW = 3456, INWP = 3584;
constexpr int HY_IN = 768, RW_IN = 1536, NA_IN = 1152;
constexpr int NFFT = 16384;
constexpr int NTHR = 512, NWAVE = 8;
constexpr int LDS_MAIN = 131072, LDS_EXTRA = 8192, LDS_BYTES = LDS_MAIN + LDS_EXTRA;
constexpr float NORM_EPS = 1e-6f;

constexpr size_t al256(size_t x) { return (x + 255) & ~(size_t)255; }
constexpr size_t WS_MODV = 0;
constexpr size_t WS_WGU1 = al256(WS_MODV + (size_t)DEPTH * 3 * NMOD * 4);
constexpr size_t WS_WDN1 = WS_WGU1 + (size_t)2 * DFF * D * 2;
constexpr size_t WS_WGU2 = WS_WDN1 + (size_t)D * DFF * 2;
constexpr size_t WS_WDN2 = WS_WGU2 + (size_t)2 * DFF * D * 2;
constexpr size_t WS_WIN = WS_WDN2 + (size_t)D * DFF * 2;
constexpr size_t WS_WOUT = WS_WIN + (size_t)INWP * D * 2;
constexpr size_t WS_WLORA = WS_WOUT + (size_t)D * D * 2;
constexpr size_t WS_H = WS_WLORA + (size_t)2048 * 384 * 2;
constexpr size_t WS_U = WS_H + (size_t)T * D * 4;
constexpr size_t WS_S = WS_U + (size_t)T * D * 2;
constexpr size_t WS_Y = WS_S;
constexpr size_t WS_ACT = WS_Y + (size_t)T * D * 4;
constexpr size_t WS_FFN_END = WS_ACT + (size_t)T * DFF * 2;
constexpr size_t WS_PHY = WS_S;
constexpr size_t WS_PRW = WS_PHY + (size_t)T * HY_IN * 2;
constexpr size_t WS_YDIR = WS_PRW;
constexpr size_t WS_PNA = WS_PRW + (size_t)T * RW_IN * 2;
constexpr size_t WS_ALORA = WS_PNA + (size_t)T * NA_IN * 2;
constexpr size_t WS_DECAY = WS_ALORA + (size_t)T * 384 * 2;
constexpr size_t WS_LORAO = WS_DECAY + (size_t)2 * T * 384 * 4;
constexpr size_t WS_RS = WS_LORAO + (size_t)T * 2048 * 2;
constexpr size_t WS_KKS = WS_RS + (size_t)T * 384 * 2;
constexpr size_t WS_VS = WS_KKS + (size_t)T * 384 * 2;
constexpr size_t WS_KS = WS_VS + (size_t)T * 384 * 2;
constexpr size_t WS_BS = WS_KS + (size_t)2 * T * 384 * 2;
constexpr size_t WS_BONUS = WS_BS + (size_t)2 * T * 384 * 2;
constexpr size_t WS_H2 = al256(WS_BONUS + (size_t)T * 6 * 4);
constexpr size_t WS_SPEC = WS_H2 + (size_t)(SEQ + CTX) * 64 * 4;
constexpr size_t WS_Z1 = WS_SPEC + (size_t)512 * NFFT * 8;
constexpr size_t WS_MIX_END = WS_Z1 + (size_t)HYC * NB * SEQ * 4;
constexpr size_t WS_END = WS_MIX_END > WS_FFN_END ? WS_MIX_END : WS_FFN_END;

struct Params { const float* in[34]; float* out; unsigned char* ws; };
enum { I_X = 0, I_C, I_CTX, I_CCTX, I_MODW, I_MODB, I_NORMG, I_F1GU, I_F1DN, I_F2GU, I_F2DN, I_WIN, I_WOUT, I_HCW, I_HCB, I_HW1, I_HB1, I_HW2, I_HB2, I_HW3, I_HFREQ, I_HBIAS,
       I_MU, I_W0, I_W2, I_A0, I_A2, I_G2, I_KK, I_KA, I_RK, I_LNW, I_LNB, I_RPB };

__device__ __forceinline__ float bf2f(bf16_t b) { return __uint_as_float(((unsigned)b) << 16); }
__device__ __forceinline__ bf16_t f2bf(float f) { unsigned u = __float_as_uint(f); u += 0x7FFFu + ((u >> 16) & 1u); return (bf16_t)(u >> 16); }
__device__ __forceinline__ float lo_bf(unsigned w) { return __uint_as_float(w << 16); }
__device__ __forceinline__ float hi_bf(unsigned w) { return __uint_as_float(w & 0xffff0000u); }
__device__ __forceinline__ float wsum(float v) {
#pragma unroll
    for (int o = 32; o > 0; o >>= 1) v += __shfl_xor(v, o);
    return v;
}
__device__ __forceinline__ float sigmoidf_(float x) { return __builtin_amdgcn_rcpf(1.0f + __expf(-x)); }
__device__ __forceinline__ void unpack8(const u32x4 w, float (&f)[8]) {
    f[0] = lo_bf(w.x); f[1] = hi_bf(w.x); f[2] = lo_bf(w.y); f[3] = hi_bf(w.y); f[4] = lo_bf(w.z); f[5] = hi_bf(w.z); f[6] = lo_bf(w.w); f[7] = hi_bf(w.w);
}
__device__ __forceinline__ void row_nbrs(int row, bool& hasp, bool& hasn) {
    if (row < TL) { const int t = row & (SEQ - 1); hasp = t > 0; hasn = t < SEQ - 1; }
    else { const int t = (row - TL) & (CTX - 1); hasp = t > 0; hasn = t < CTX - 1; }
}

__device__ void ph_modv(const Params& P, float* lds) {
    const int tid = otid();
    float* sv = lds;
    float* red = lds + 3072;
    for (int i = tid; i < 3072; i += NTHR) { const int s = i >> 10, k = i & 1023; const float c = s < 2 ? P.in[I_C][s * 1024 + k] : P.in[I_CCTX][k]; sv[i] = c / (1.0f + expf(-c)); }
    __syncthreads();
    float* modv = (float*)(P.ws + WS_MODV);
    const int kc = tid >> 6, cl = tid & 63;
    for (int item = blockIdx.x; item < DEPTH * 144; item += gridDim.x) {
        const int l = item / 144, cb = item % 144, col = cb * 64 + cl;
        const float* w = P.in[I_MODW] + ((size_t)l * 1024 + kc * 128) * NMOD + col;
        float a0 = 0.f, a1 = 0.f, a2 = 0.f;
#pragma unroll 8
        for (int k = 0; k < 128; ++k) { const float wv = w[(size_t)k * NMOD]; a0 += sv[kc * 128 + k] * wv; a1 += sv[1024 + kc * 128 + k] * wv; a2 += sv[2048 + kc * 128 + k] * wv; }
        red[(0 * 8 + kc) * 64 + cl] = a0; red[(1 * 8 + kc) * 64 + cl] = a1; red[(2 * 8 + kc) * 64 + cl] = a2;
        __syncthreads();
        if (tid < 192) { const int s = tid >> 6, c = tid & 63; float r = P.in[I_MODB][l * NMOD + cb * 64 + c];
#pragma unroll
            for (int q = 0; q < 8; ++q) r += red[(s * 8 + q) * 64 + c];
            modv[((size_t)l * 3 + s) * NMOD + cb * 64 + c] = r; }
        __syncthreads();
    }
}

__device__ __forceinline__ int rowmap_gu(int n) { const int up = n >= DFF ? 1 : 0; const int j = n - up * DFF; return (j >> 7) * 256 + up * 128 + (j & 127); }
__device__ void conv_tile(const float* __restrict__ src, int K, int N, bf16_t* __restrict__ dst, int tk, int tn, bool gu, float* tile) {
    const int tid = otid(); const int k0 = tk * 64, n0 = tn * 64;
#pragma unroll
    for (int rr = 0; rr < 2; ++rr) { const int kk = (tid >> 4) + rr * 32, n4 = (tid & 15) * 4; const float4 v = *(const float4*)(src + (size_t)(k0 + kk) * N + n0 + n4);
        tile[kk * 65 + n4 + 0] = v.x; tile[kk * 65 + n4 + 1] = v.y; tile[kk * 65 + n4 + 2] = v.z; tile[kk * 65 + n4 + 3] = v.w; }
    __syncthreads();
    { const int nn = tid >> 3, ks = (tid & 7) * 8; const int n = n0 + nn; const int row = gu ? rowmap_gu(n) : n;
      u32x4 w; w.x = cvt_pk_bf16(tile[(ks + 0) * 65 + nn], tile[(ks + 1) * 65 + nn]); w.y = cvt_pk_bf16(tile[(ks + 2) * 65 + nn], tile[(ks + 3) * 65 + nn]);
      w.z = cvt_pk_bf16(tile[(ks + 4) * 65 + nn], tile[(ks + 5) * 65 + nn]); w.w = cvt_pk_bf16(tile[(ks + 6) * 65 + nn], tile[(ks + 7) * 65 + nn]);
      *(u32x4*)(dst + (size_t)row * K + k0 + ks) = w; }
    __syncthreads();
}
__device__ void ph_prep(const Params& P, int l, float* lds) {
    const int tid = otid();
    unsigned char* ws = P.ws;
    constexpr int N0 = 16 * 88, N1 = 44 * 16, N4 = 16 * 54, N5 = 16 * 16;
    constexpr int C0 = N0, C1 = C0 + N1, C2 = C1 + N0, C3 = C2 + N1, C4 = C3 + N4, C5 = C4 + N5;
    for (int it = blockIdx.x; it < C5; it += gridDim.x) {
        if (it < C0) { conv_tile(P.in[I_F1GU] + (size_t)l * D * 2 * DFF, D, 2 * DFF, (bf16_t*)(ws + WS_WGU1), it / 88, it % 88, true, lds); }
        else if (it < C1) { const int j = it - C0; conv_tile(P.in[I_F1DN] + (size_t)l * DFF * D, DFF, D, (bf16_t*)(ws + WS_WDN1), j / 16, j % 16, false, lds); }
        else if (it < C2) { const int j = it - C1; conv_tile(P.in[I_F2GU] + (size_t)l * D * 2 * DFF, D, 2 * DFF, (bf16_t*)(ws + WS_WGU2), j / 88, j % 88, true, lds); }
        else if (it < C3) { const int j = it - C2; conv_tile(P.in[I_F2DN] + (size_t)l * DFF * D, DFF, D, (bf16_t*)(ws + WS_WDN2), j / 16, j % 16, false, lds); }
        else if (it < C4) { const int j = it - C3; conv_tile(P.in[I_WIN] + (size_t)l * D * INW, D, INW, (bf16_t*)(ws + WS_WIN), j / 54, j % 54, false, lds); }
        else { const int j = it - C4; conv_tile(P.in[I_WOUT] + (size_t)l * D * D, D, D, (bf16_t*)(ws + WS_WOUT), j / 16, j % 16, false, lds); }
    }
    const int gtid = blockIdx.x * NTHR + tid, gn = gridDim.x * NTHR;
    { unsigned* z = (unsigned*)(ws + WS_WIN + (size_t)INW * D * 2); for (int i = gtid; i < (INWP - INW) * D / 2; i += gn) z[i] = 0u; }
    { bf16_t* wl = (bf16_t*)(ws + WS_WLORA);
      const float* w2 = P.in[I_W2] + (size_t)l * 2 * 64 * RWW; const float* a2 = P.in[I_A2] + (size_t)l * 2 * 64 * RWW; const float* g2 = P.in[I_G2] + (size_t)l * 128 * RWW;
      for (int i = gtid; i < 2048 * 384; i += gn) { const int k = i / 2048, j = i % 2048; float v = 0.f;
          if (j < 1920) { const int grp = j / 384, c = j % 384;
              if (grp == 0) { if (k < 64) v = w2[(size_t)k * RWW + c]; }
              else if (grp == 1) { if (k >= 64 && k < 128) v = w2[(size_t)(64 + k - 64) * RWW + c]; }
              else if (grp == 2) { if (k >= 128 && k < 192) v = a2[(size_t)(k - 128) * RWW + c]; }
              else if (grp == 3) { if (k >= 192 && k < 256) v = a2[(size_t)(64 + k - 192) * RWW + c]; }
              else { if (k >= 256) v = g2[(size_t)(k - 256) * RWW + c]; } }
          wl[(size_t)j * 384 + k] = f2bf(v); } }
    { float* h2 = (float*)(ws + WS_H2);
      const float* w1 = P.in[I_HW1] + (size_t)l * 33 * 64; const float* b1 = P.in[I_HB1] + l * 64; const float* w2f = P.in[I_HW2] + (size_t)l * 64 * 64; const float* b2 = P.in[I_HB2] + l * 64;
      const float* fqv = P.in[I_HFREQ] + l * 64;
      const int lane = tid & 63, gw = blockIdx.x * NWAVE + (tid >> 6), nw = gridDim.x * NWAVE;
      const float fq = fqv[lane], bb1 = b1[lane], bb2 = b2[lane];
      for (int n = gw; n < SEQ + CTX; n += nw) {
          const int L = n < SEQ ? SEQ : CTX, pos = n < SEQ ? n : n - SEQ;
          const float tt = (float)pos / (float)(L - 1);
          const float ang = 6.283185307179586f * (float)pos / (float)L;
          float z = 0.f;
          if (lane == 0) z = tt;
          else if (lane <= 16) { const float fr = 1e-4f + (float)(lane - 1) * ((15.0f - 1e-4f) / 15.0f); z = cosf(fr * ang); }
          else if (lane <= 32) { const float fr = 1e-4f + (float)(lane - 17) * ((15.0f - 1e-4f) / 15.0f); z = -sinf(fr * ang); }
          float a = bb1;
#pragma unroll
          for (int e = 0; e < 33; ++e) a += __shfl(z, e) * w1[e * 64 + lane];
          const float h1 = sinf(fq * a);
          float c = bb2;
#pragma unroll
          for (int i = 0; i < 64; ++i) c += __shfl(h1, i) * w2f[i * 64 + lane];
          h2[(size_t)n * 64 + lane] = sinf(fq * c);
      } }
}

__device__ void ph_rowpass(const Params& P, int mode, int lpost, int gate_i, int gpost_i, float ps, int lpre, int gpre_i, int shift_i, int scale_i) {
    const int tid = otid(), lane = tid & 63, gw = blockIdx.x * NWAVE + (tid >> 6), nw = gridDim.x * NWAVE;
    const float* modv = (const float*)(P.ws + WS_MODV);
    float* H = (float*)(P.ws + WS_H); const float* Y = (const float*)(P.ws + WS_Y); bf16_t* U = (bf16_t*)(P.ws + WS_U);
    int cur_s = -1;
    float4 A[4], Bv[4], Cv[4];
#pragma unroll
    for (int j = 0; j < 4; ++j) { A[j] = make_float4(0.f, 0.f, 0.f, 0.f); Bv[j] = A[j]; Cv[j] = A[j]; }
    for (int row = gw; row < T; row += nw) {
        const int s = row < SEQ ? 0 : (row < TL ? 1 : 2);
        if (s != cur_s) { cur_s = s;
#pragma unroll
            for (int j = 0; j < 4; ++j) { const int e = lane * 4 + 256 * j;
                if (mode != 0) { const float4 g = *(const float4*)(modv + ((size_t)lpost * 3 + s) * NMOD + gate_i * D + e); const float4 gp = *(const float4*)(P.in[I_NORMG] + ((size_t)lpost * 6 + gpost_i) * D + e);
                    A[j] = make_float4(ps * g.x * gp.x, ps * g.y * gp.y, ps * g.z * gp.z, ps * g.w * gp.w); }
                if (mode != 2) { const float4 sc = *(const float4*)(modv + ((size_t)lpre * 3 + s) * NMOD + scale_i * D + e); const float4 gq = *(const float4*)(P.in[I_NORMG] + ((size_t)lpre * 6 + gpre_i) * D + e);
                    Bv[j] = make_float4(gq.x * (1.f + sc.x), gq.y * (1.f + sc.y), gq.z * (1.f + sc.z), gq.w * (1.f + sc.w));
                    Cv[j] = *(const float4*)(modv + ((size_t)lpre * 3 + s) * NMOD + shift_i * D + e); } } }
        float4 h[4];
        if (mode == 0) { const float* src = row < TL ? P.in[I_X] + (size_t)row * D : P.in[I_CTX] + (size_t)(row - TL) * D;
#pragma unroll
            for (int j = 0; j < 4; ++j) h[j] = *(const float4*)(src + lane * 4 + 256 * j);
        } else {
            float4 y[4]; float ss = 0.f;
#pragma unroll
            for (int j = 0; j < 4; ++j) { h[j] = *(const float4*)(H + (size_t)row * D + lane * 4 + 256 * j); y[j] = *(const float4*)(Y + (size_t)row * D + lane * 4 + 256 * j);
                ss += y[j].x * y[j].x + y[j].y * y[j].y + y[j].z * y[j].z + y[j].w * y[j].w; }
            ss = wsum(ss); const float r = rsqrtf(ss * (1.0f / D) + NORM_EPS);
#pragma unroll
            for (int j = 0; j < 4; ++j) { h[j].x += A[j].x * (y[j].x * r); h[j].y += A[j].y * (y[j].y * r); h[j].z += A[j].z * (y[j].z * r); h[j].w += A[j].w * (y[j].w * r); }
        }
        if (mode == 2) { if (row < TL) {
#pragma unroll
                for (int j = 0; j < 4; ++j) *(float4*)(P.out + (size_t)row * D + lane * 4 + 256 * j) = h[j]; }
            continue; }
        float s2 = 0.f;
#pragma unroll
        for (int j = 0; j < 4; ++j) { *(float4*)(H + (size_t)row * D + lane * 4 + 256 * j) = h[j]; s2 += h[j].x * h[j].x + h[j].y * h[j].y + h[j].z * h[j].z + h[j].w * h[j].w; }
        s2 = wsum(s2); const float r2 = rsqrtf(s2 * (1.0f / D) + NORM_EPS);
#pragma unroll
        for (int j = 0; j < 4; ++j) { u32x2 w; w.x = cvt_pk_bf16(h[j].x * r2 * Bv[j].x + Cv[j].x, h[j].y * r2 * Bv[j].y + Cv[j].y); w.y = cvt_pk_bf16(h[j].z * r2 * Bv[j].z + Cv[j].z, h[j].w * r2 * Bv[j].w + Cv[j].w);
            *(u32x2*)(U + (size_t)row * D + lane * 4 + 256 * j) = w; }
    }
}

struct EpiGU {
    static constexpr bool PERM = true, AFTER_DRAIN = false;
    bf16_t* O;
    __device__ __forceinline__ void operator()(const f32x4 (&acc)[2][2][4][2], const pg8::Unit& u, int wr, int wc, int fr, int fq) const {
        const int row0 = u.pm * 256 + wr * 64 + fr, col0 = u.pn * 128 + wc * 32 + 8 * fq;
#pragma unroll
        for (int ai = 0; ai < 2; ++ai)
#pragma unroll
            for (int m = 0; m < 4; ++m) { float o[8];
#pragma unroll
                for (int n = 0; n < 2; ++n)
#pragma unroll
                    for (int j = 0; j < 4; ++j) { const float g = acc[ai][0][m][n][j], up = acc[ai][1][m][n][j]; o[n * 4 + j] = g * __builtin_amdgcn_rcpf(1.0f + __expf(-g)) * up; }
                u32x4 w; w.x = cvt_pk_bf16(o[0], o[1]); w.y = cvt_pk_bf16(o[2], o[3]); w.z = cvt_pk_bf16(o[4], o[5]); w.w = cvt_pk_bf16(o[6], o[7]);
                *(u32x4*)(O + (size_t)(row0 + ai * 128 + m * 16) * DFF + col0) = w; }
    }
};
struct EpiF32 {
    static constexpr bool PERM = false, AFTER_DRAIN = false;
    float* C;
    __device__ __forceinline__ void operator()(const f32x4 (&acc)[2][2][4][2], const pg8::Unit& u, int wr, int wc, int fr, int fq) const {
        const int row0 = u.pm * 256 + wr * 64 + fr, col0 = u.pn * 256 + wc * 32 + 4 * fq;
#pragma unroll
        for (int ai = 0; ai < 2; ++ai)
#pragma unroll
            for (int m = 0; m < 4; ++m) { float* rowp = C + (size_t)(row0 + ai * 128 + m * 16) * D + col0;
#pragma unroll
                for (int bj = 0; bj < 2; ++bj)
#pragma unroll
                    for (int n = 0; n < 2; ++n) *(f32x4*)(rowp + bj * 128 + n * 16) = acc[ai][bj][m][n]; }
    }
};
struct EpiWin {
    static constexpr bool PERM = true, AFTER_DRAIN = false;
    bf16_t* PHY; bf16_t* PRW; bf16_t* PNA;
    __device__ __forceinline__ void operator()(const f32x4 (&acc)[2][2][4][2], const pg8::Unit& u, int wr, int wc, int fr, int fq) const {
        const int row0 = u.pm * 256 + wr * 64 + fr;
        bf16_t* base; int ld, cbase;
        if (u.pn < 3) { base = PHY; ld = HY_IN; cbase = u.pn * 256; }
        else if (u.pn < 9) { base = PRW; ld = RW_IN; cbase = u.pn * 256 - HY_IN; }
        else { base = PNA; ld = NA_IN; cbase = u.pn * 256 - HY_IN - RW_IN; }
        const int nbj = (u.pn == 13) ? 1 : 2;
#pragma unroll
        for (int ai = 0; ai < 2; ++ai)
#pragma unroll
            for (int m = 0; m < 4; ++m)
#pragma unroll
                for (int bj = 0; bj < 2; ++bj) { if (bj < nbj) { const f32x4 v0 = acc[ai][bj][m][0], v1 = acc[ai][bj][m][1];
                    u32x4 w; w.x = cvt_pk_bf16(v0[0], v0[1]); w.y = cvt_pk_bf16(v0[2], v0[3]); w.z = cvt_pk_bf16(v1[0], v1[1]); w.w = cvt_pk_bf16(v1[2], v1[3]);
                    *(u32x4*)(base + (size_t)(row0 + ai * 128 + m * 16) * ld + cbase + bj * 128 + wc * 32 + 8 * fq) = w; } }
    }
};
struct EpiLora {
    static constexpr bool PERM = true, AFTER_DRAIN = false;
    bf16_t* O;
    __device__ __forceinline__ void operator()(const f32x4 (&acc)[2][2][4][2], const pg8::Unit& u, int wr, int wc, int fr, int fq) const {
        const int row0 = u.pm * 256 + wr * 64 + fr, col0 = u.pn * 256 + wc * 32 + 8 * fq;
#pragma unroll
        for (int ai = 0; ai < 2; ++ai)
#pragma unroll
            for (int m = 0; m < 4; ++m) { bf16_t* rowp = O + (size_t)(row0 + ai * 128 + m * 16) * 2048 + col0;
#pragma unroll
                for (int bj = 0; bj < 2; ++bj) { const f32x4 v0 = acc[ai][bj][m][0], v1 = acc[ai][bj][m][1];
                    u32x4 w; w.x = cvt_pk_bf16(v0[0], v0[1]); w.y = cvt_pk_bf16(v0[2], v0[3]); w.z = cvt_pk_bf16(v1[0], v1[1]); w.w = cvt_pk_bf16(v1[2], v1[3]);
                    *(u32x4*)(rowp + bj * 128) = w; } }
    }
};
template <class Epi> __device__ __forceinline__ void run_gemm(LAS unsigned char* lds, const bf16_t* A, const bf16_t* Bt, int M, int N, int K, const Epi& E) {
    pg8::Gemm g{A, Bt, M, N, K}; pg8::StaticOrder S; S.init(M, N, (int)gridDim.x, (int)blockIdx.x);
    pg8::gemm_phase<Epi, pg8::StaticOrder>(lds, g, S, E);
    __syncthreads();
}

__device__ void ph_loraprep(const Params& P, int l) {
    const bf16_t* PRW = (const bf16_t*)(P.ws + WS_PRW); bf16_t* AL = (bf16_t*)(P.ws + WS_ALORA);
    const float* mu = P.in[I_MU] + (size_t)l * 2 * RW_IN;
    const int gtid = blockIdx.x * NTHR + otid(), gn = gridDim.x * NTHR;
    for (int it = gtid; it < T * 48; it += gn) {
        const int row = it / 48, j8 = it % 48, col = 1152 + j8 * 8;
        bool hp, hn; row_nbrs(row, hp, hn);
        float p[8], pp[8], pn[8];
        unpack8(*(const u32x4*)(PRW + (size_t)row * RW_IN + col), p);
        if (hp) unpack8(*(const u32x4*)(PRW + (size_t)(row - 1) * RW_IN + col), pp); else {
#pragma unroll
            for (int i = 0; i < 8; ++i) pp[i] = 0.f; }
        if (hn) unpack8(*(const u32x4*)(PRW + (size_t)(row + 1) * RW_IN + col), pn); else {
#pragma unroll
            for (int i = 0; i < 8; ++i) pn[i] = 0.f; }
        float o[8];
#pragma unroll
        for (int i = 0; i < 8; ++i) { const float xs = p[i] + mu[col + i] * (pp[i] - p[i]) + mu[RW_IN + col + i] * (pn[i] - p[i]);
            o[i] = j8 < 16 ? tanhf(xs) : (j8 < 32 ? xs : sigmoidf_(xs)); }
        u32x4 w; w.x = cvt_pk_bf16(o[0], o[1]); w.y = cvt_pk_bf16(o[2], o[3]); w.z = cvt_pk_bf16(o[4], o[5]); w.w = cvt_pk_bf16(o[6], o[7]);
        *(u32x4*)(AL + (size_t)row * 384 + j8 * 8) = w;
    }
}

__device__ void ph_rwkvprep(const Params& P, int l) {
    const int tid = otid(), lane = tid & 63, gw = blockIdx.x * NWAVE + (tid >> 6), nw = gridDim.x * NWAVE;
    const bf16_t* PRW = (const bf16_t*)(P.ws + WS_PRW); const bf16_t* LO = (const bf16_t*)(P.ws + WS_LORAO);
    bf16_t* RS = (bf16_t*)(P.ws + WS_RS); bf16_t* KKS = (bf16_t*)(P.ws + WS_KKS); bf16_t* VS = (bf16_t*)(P.ws + WS_VS); bf16_t* KS = (bf16_t*)(P.ws + WS_KS); bf16_t* BS = (bf16_t*)(P.ws + WS_BS);
    float* BON = (float*)(P.ws + WS_BONUS);
    const float* mu = P.in[I_MU] + (size_t)l * 2 * RW_IN;
    const int f = lane & 15; const float inv = __expf(-(float)f * (9.210340371976184f / 16.0f));
    for (int it = gw; it < T * 6; it += nw) {
        const int row = it / 6, h = it % 6, c = h * 64 + lane;
        bool hp, hn; row_nbrs(row, hp, hn);
        float x[3];
#pragma unroll
        for (int q = 0; q < 3; ++q) { const int col = q * 384 + c; const float p = bf2f(PRW[(size_t)row * RW_IN + col]);
            const float pp = hp ? bf2f(PRW[(size_t)(row - 1) * RW_IN + col]) : 0.f, pn = hn ? bf2f(PRW[(size_t)(row + 1) * RW_IN + col]) : 0.f;
            x[q] = p + mu[col] * (pp - p) + mu[RW_IN + col] * (pn - p); }
        const float r = x[0], k = x[1], v = x[2];
        const float kkr = k * P.in[I_KK][l * RWW + c];
        const float nrm = sqrtf(wsum(kkr * kkr));
        const float kk = kkr / fmaxf(nrm, 1e-12f);
        const float a0 = sigmoidf_(bf2f(LO[(size_t)row * 2048 + 768 + c]) + P.in[I_A0][(size_t)l * 2 * RWW + c]), a1 = sigmoidf_(bf2f(LO[(size_t)row * 2048 + 1152 + c]) + P.in[I_A0][(size_t)l * 2 * RWW + RWW + c]);
        { float* DEC = (float*)(P.ws + WS_DECAY);
          const float x0 = bf2f(LO[(size_t)row * 2048 + c]) + P.in[I_W0][(size_t)l * 2 * RWW + c], x1 = bf2f(LO[(size_t)row * 2048 + 384 + c]) + P.in[I_W0][(size_t)l * 2 * RWW + RWW + c];
          DEC[(size_t)row * 384 + c] = __expf(-0.6065306597f * sigmoidf_(x0)); DEC[((size_t)T + row) * 384 + c] = __expf(-0.6065306597f * sigmoidf_(x1)); }
        const float ka = P.in[I_KA][l * RWW + c];
        float kd0 = k * (1.f + (a0 - 1.f) * ka), kd1 = k * (1.f + (a1 - 1.f) * ka);
        float b0 = kk * a0, b1 = kk * a1;
        const float bon = wsum(r * (kd0 + kd1) * P.in[I_RK][l * RWW + c]);
        if (lane == 0) BON[(size_t)row * 6 + h] = bon;
        float rs = r, kks = kk;
        if (row < TL) {
            const int t = row & (SEQ - 1); const float pos = (lane < 32) ? (float)(t >> 6) : (float)(t & 63);
            float sn, cs; sincosf(pos * inv, &sn, &cs);
            const float sg = (lane & 16) ? 1.f : -1.f;
            const float r2 = __shfl_xor(rs, 16), k2 = __shfl_xor(kks, 16), d0 = __shfl_xor(kd0, 16), d1 = __shfl_xor(kd1, 16), e0 = __shfl_xor(b0, 16), e1 = __shfl_xor(b1, 16);
            rs = rs * cs + sg * r2 * sn; kks = kks * cs + sg * k2 * sn; kd0 = kd0 * cs + sg * d0 * sn; kd1 = kd1 * cs + sg * d1 * sn; b0 = b0 * cs + sg * e0 * sn; b1 = b1 * cs + sg * e1 * sn;
        }
        const size_t o = (size_t)row * 384 + c;
        RS[o] = f2bf(rs); KKS[o] = f2bf(-kks); VS[o] = f2bf(v);
        KS[o] = f2bf(kd0); KS[(size_t)T * 384 + o] = f2bf(kd1); BS[o] = f2bf(b0); BS[(size_t)T * 384 + o] = f2bf(b1);
    }
}

__device__ __forceinline__ int scan_row(int b, int d, int step) {
    if (step < CTX) { const int tc = d ? (CTX - 1 - step) : step; return TL + b * CTX + tc; }
    const int tl = d ? (SEQ - 1 - (step - CTX)) : (step - CTX); return b * SEQ + tl;
}
__device__ void scan_task_v1(const Params& P, int task, float* sv) {
    const int lane = otid() & 63;
    const int d = task & 1, h = (task >> 1) % 6, b = task / 12;
    const float* DEC = (const float*)(P.ws + WS_DECAY) + (size_t)d * T * 384; const bf16_t* KKS = (const bf16_t*)(P.ws + WS_KKS); const bf16_t* RS = (const bf16_t*)(P.ws + WS_RS);
    const bf16_t* VS = (const bf16_t*)(P.ws + WS_VS); const bf16_t* KS = (const bf16_t*)(P.ws + WS_KS) + (size_t)d * T * 384; const bf16_t* BS = (const bf16_t*)(P.ws + WS_BS) + (size_t)d * T * 384;
    float* YD = (float*)(P.ws + WS_YDIR) + (size_t)d * T * 384;
    float S[64];
#pragma unroll
    for (int j = 0; j < 64; ++j) S[j] = 0.f;
    size_t o = (size_t)scan_row(b, d, 0) * 384 + h * 64 + lane;
    float nw_ = DEC[o], na = bf2f(KKS[o]), nb = bf2f(BS[o]), nk = bf2f(KS[o]), nr = bf2f(RS[o]), nv = bf2f(VS[o]);
    for (int step = 0; step < CTX + SEQ; ++step) {
        const float v = nv; const size_t oc = o;
        asm volatile("s_waitcnt lgkmcnt(0)" ::: "memory");
        sv[lane] = nw_; sv[64 + lane] = na; sv[128 + lane] = nb; sv[192 + lane] = nk; sv[256 + lane] = nr;
        asm volatile("s_waitcnt lgkmcnt(0)" ::: "memory");
        if (step + 1 < CTX + SEQ) { o = (size_t)scan_row(b, d, step + 1) * 384 + h * 64 + lane;
            nw_ = DEC[o]; na = bf2f(KKS[o]); nb = bf2f(BS[o]); nk = bf2f(KS[o]); nr = bf2f(RS[o]); nv = bf2f(VS[o]); }
        float sa0 = 0.f, sa1 = 0.f, sa2 = 0.f, sa3 = 0.f;
#pragma unroll
        for (int j = 0; j < 64; j += 4) { const float4 a4 = *(const float4*)(sv + 64 + j);
            sa0 += S[j + 0] * a4.x; sa1 += S[j + 1] * a4.y; sa2 += S[j + 2] * a4.z; sa3 += S[j + 3] * a4.w; }
        const float sa = (sa0 + sa1) + (sa2 + sa3);
        float y0 = 0.f, y1 = 0.f, y2 = 0.f, y3 = 0.f;
#pragma unroll
        for (int j = 0; j < 64; j += 4) {
            const float4 w4 = *(const float4*)(sv + j), b4 = *(const float4*)(sv + 128 + j), k4 = *(const float4*)(sv + 192 + j), r4 = *(const float4*)(sv + 256 + j);
            S[j + 0] = S[j + 0] * w4.x + sa * b4.x + v * k4.x; y0 += S[j + 0] * r4.x;
            S[j + 1] = S[j + 1] * w4.y + sa * b4.y + v * k4.y; y1 += S[j + 1] * r4.y;
            S[j + 2] = S[j + 2] * w4.z + sa * b4.z + v * k4.z; y2 += S[j + 2] * r4.z;
            S[j + 3] = S[j + 3] * w4.w + sa * b4.w + v * k4.w; y3 += S[j + 3] * r4.w; }
        YD[oc] = (y0 + y1) + (y2 + y3);
    }
}

__device__ __forceinline__ void natt_key(const bf16_t* PNA, size_t krow, int hoff, const float (&q)[16], float bias, float& m, float& lsum, float (&o)[16]) {
    const bf16_t* kp = PNA + krow * NA_IN + 384 + hoff; const bf16_t* vp = PNA + krow * NA_IN + 768 + hoff;
    float s = 0.f;
#pragma unroll
    for (int j8 = 0; j8 < 2; ++j8) { float kf[8]; unpack8(*(const u32x4*)(kp + j8 * 8), kf);
#pragma unroll
        for (int i = 0; i < 8; ++i) s += q[j8 * 8 + i] * kf[i]; }
    s += __shfl_xor(s, 1); s += __shfl_xor(s, 2); s += bias;
    const float mn = fmaxf(m, s), corr = __expf(m - mn), p = __expf(s - mn);
    m = mn; lsum = lsum * corr + p;
#pragma unroll
    for (int j8 = 0; j8 < 2; ++j8) { float vf[8]; unpack8(*(const u32x4*)(vp + j8 * 8), vf);
#pragma unroll
        for (int i = 0; i < 8; ++i) o[j8 * 8 + i] = o[j8 * 8 + i] * corr + p * vf[i]; }
}
__device__ void natten_items_v1(const Params& P, int l, int wid0, int nworkers) {
    const bf16_t* PNA = (const bf16_t*)(P.ws + WS_PNA); bf16_t* MIX = (bf16_t*)(P.ws + WS_U);
    const float* rpb = P.in[I_RPB] + (size_t)l * 6 * 15 * 31;
    const int sub = wid0 & 3;
    for (int it = wid0 >> 2; it < T * 6; it += nworkers >> 2) {
        const int row = it % T, h = it / T, hoff = h * 64 + sub * 16;
        float q[16], o[16];
#pragma unroll
        for (int j8 = 0; j8 < 2; ++j8) { float qf[8]; unpack8(*(const u32x4*)(PNA + (size_t)row * NA_IN + hoff + j8 * 8), qf);
#pragma unroll
            for (int i = 0; i < 8; ++i) { q[j8 * 8 + i] = qf[i] * 0.125f; o[j8 * 8 + i] = 0.f; } }
        float m = -3.0e38f, lsum = 0.f;
        int b;
        if (row < TL) { b = row >> 13; const int t = row & (SEQ - 1), i = t >> 6, col = t & 63;
            const int start = min(max(i - 4, 0), 120), win0 = min(max(col - 8, 0), 48);
            for (int r = 0; r < 8; ++r) for (int kc = win0; kc < win0 + 16; ++kc) {
                const float bias = rpb[(h * 15 + (start + r - i + 7)) * 31 + (kc - col + 15)];
                natt_key(PNA, (size_t)b * SEQ + (start + r) * 64 + kc, hoff, q, bias, m, lsum, o); }
        } else b = (row - TL) >> 8;
        for (int c = 0; c < CTX; ++c) natt_key(PNA, (size_t)TL + b * CTX + c, hoff, q, 0.f, m, lsum, o);
        const float il = 1.0f / lsum;
#pragma unroll
        for (int j8 = 0; j8 < 2; ++j8) { u32x4 w; w.x = cvt_pk_bf16(o[j8 * 8 + 0] * il, o[j8 * 8 + 1] * il); w.y = cvt_pk_bf16(o[j8 * 8 + 2] * il, o[j8 * 8 + 3] * il);
            w.z = cvt_pk_bf16(o[j8 * 8 + 4] * il, o[j8 * 8 + 5] * il); w.w = cvt_pk_bf16(o[j8 * 8 + 6] * il, o[j8 * 8 + 7] * il);
            *(u32x4*)(MIX + (size_t)row * D + 640 + hoff + j8 * 8) = w; }
    }
}

__device__ void fft_fwd(float2* X) {
    for (int s = 13; s >= 0; --s) { const int half = 1 << s;
        for (int j = otid(); j < NFFT / 2; j += NTHR) { const int lo = j & (half - 1), i0 = ((j >> s) << (s + 1)) | lo, i1 = i0 + half;
            const float2 a = X[i0], b = X[i1]; const float fr = (float)lo / (float)(2 * half);
            const float cw = __builtin_amdgcn_cosf(fr), sw = __builtin_amdgcn_sinf(fr);
            const float dx = a.x - b.x, dy = a.y - b.y;
            X[i0] = make_float2(a.x + b.x, a.y + b.y); X[i1] = make_float2(dx * cw + dy * sw, dy * cw - dx * sw); }
        __syncthreads(); }
}
__device__ void fft_inv(float2* X) {
    for (int s = 0; s <= 13; ++s) { const int half = 1 << s;
        for (int j = otid(); j < NFFT / 2; j += NTHR) { const int lo = j & (half - 1), i0 = ((j >> s) << (s + 1)) | lo, i1 = i0 + half;
            const float2 a = X[i0], b = X[i1]; const float fr = (float)lo / (float)(2 * half);
            const float cw = __builtin_amdgcn_cosf(fr), sw = __builtin_amdgcn_sinf(fr);
            const float bx = b.x * cw - b.y * sw, by = b.x * sw + b.y * cw;
            X[i0] = make_float2(a.x + bx, a.y + by); X[i1] = make_float2(a.x - bx, a.y - by); }
        __syncthreads(); }
}
__device__ __forceinline__ float hy_delta(int c) { const float lo = -4.605170185988091f / 1.5f, hi = -4.605170185988091f / 0.3f; return fabsf(lo + (float)c * ((hi - lo) / 255.0f)); }
__device__ __forceinline__ float hy_short(const bf16_t* PHY, const float* cw, const float* cb, int row, int col) {
    bool hp, hn; row_nbrs(row, hp, hn);
    float v = cb[col] + cw[HY_IN + col] * bf2f(PHY[(size_t)row * HY_IN + col]);
    if (hp) v += cw[col] * bf2f(PHY[(size_t)(row - 1) * HY_IN + col]);
    if (hn) v += cw[2 * HY_IN + col] * bf2f(PHY[(size_t)(row + 1) * HY_IN + col]);
    return v;
}
__device__ void hy_spec_task(const Params& P, int l, int o, int c, float2* X, float* ex) {
    const int tid = otid();
    const float* h2 = (const float*)(P.ws + WS_H2); const float* w3 = P.in[I_HW3] + (size_t)l * 64 * 1024;
    if (tid < 128) { const int dir = tid >> 6, i = tid & 63; ex[tid] = w3[(size_t)i * 1024 + o * 512 + dir * 256 + c]; }
    __syncthreads();
    const float dl = hy_delta(c);
    for (int n = tid; n < SEQ; n += NTHR) { float af = 0.f, ab = 0.f;
#pragma unroll
        for (int i4 = 0; i4 < 16; ++i4) { const float4 hv = *(const float4*)(h2 + (size_t)n * 64 + i4 * 4);
            af += hv.x * ex[i4 * 4] + hv.y * ex[i4 * 4 + 1] + hv.z * ex[i4 * 4 + 2] + hv.w * ex[i4 * 4 + 3];
            ab += hv.x * ex[64 + i4 * 4] + hv.y * ex[64 + i4 * 4 + 1] + hv.z * ex[64 + i4 * 4 + 2] + hv.w * ex[64 + i4 * 4 + 3]; }
        const float dec = __expf(-((float)n / (float)(SEQ - 1)) * dl) * (1.0f / NFFT);
        X[n] = make_float2(af * dec, 0.f);
        if (n > 0) X[NFFT - n] = make_float2(ab * dec, 0.f); else X[SEQ] = make_float2(0.f, 0.f); }
    __syncthreads();
    fft_fwd(X);
    float2* spec = (float2*)(P.ws + WS_SPEC) + (size_t)(o * 256 + c) * NFFT;
    for (int i = tid; i < NFFT; i += NTHR) spec[i] = X[i];
    __syncthreads();
}
__device__ void hy_conv_core(const Params& P, int o, int c, float2* X) {
    fft_fwd(X);
    const float2* spec = (const float2*)(P.ws + WS_SPEC) + (size_t)(o * 256 + c) * NFFT;
    for (int i = otid(); i < NFFT; i += NTHR) { const float2 a = X[i], k = spec[i]; X[i] = make_float2(a.x * k.x - a.y * k.y, a.x * k.y + a.y * k.x); }
    __syncthreads();
    fft_inv(X);
}
__device__ void hy_task1(const Params& P, int l, int c, float2* X, float* ex) {
    const int tid = otid();
    const bf16_t* PHY = (const bf16_t*)(P.ws + WS_PHY); const float* cw = P.in[I_HCW] + (size_t)l * 3 * HY_IN; const float* cb = P.in[I_HCB] + (size_t)l * HY_IN;
    const float bias0 = P.in[I_HBIAS][(size_t)l * 2 * HYC + c], bias1 = P.in[I_HBIAS][(size_t)l * 2 * HYC + HYC + c];
    for (int n = tid; n < SEQ; n += NTHR) { X[n] = make_float2(hy_short(PHY, cw, cb, n, c), hy_short(PHY, cw, cb, SEQ + n, c)); X[SEQ + n] = make_float2(0.f, 0.f); }
    __syncthreads();
    hy_conv_core(P, 0, c, X);
    float* Z1 = (float*)(P.ws + WS_Z1) + (size_t)c * NB * SEQ;
    for (int n = tid; n < SEQ; n += NTHR) { const float2 y = X[n];
        const float v0 = hy_short(PHY, cw, cb, n, c), v1 = hy_short(PHY, cw, cb, SEQ + n, c), g0 = hy_short(PHY, cw, cb, n, HYC + c), g1 = hy_short(PHY, cw, cb, SEQ + n, HYC + c);
        Z1[n] = g0 * (y.x + bias0 * v0); Z1[SEQ + n] = g1 * (y.y + bias0 * v1); }
    __syncthreads();
    float* f = (float*)X;
    float* vv = f, *x1 = f + 512, *x2 = f + 1024, *hf = f + 1536  , *z1 = f + 2560;
    const float* h2c = (const float*)(P.ws + WS_H2) + (size_t)SEQ * 64; const float* w3 = P.in[I_HW3] + (size_t)l * 64 * 1024;
    { const int b = tid >> 8, t = tid & 255, row = TL + b * CTX + t;
      vv[tid] = hy_short(PHY, cw, cb, row, c); x1[tid] = hy_short(PHY, cw, cb, row, HYC + c); x2[tid] = hy_short(PHY, cw, cb, row, 2 * HYC + c);
      const float dl = hy_delta(c);
      for (int q = tid; q < 1024; q += NTHR) { const int od = q >> 8, n = q & 255; float a = 0.f;
          for (int i = 0; i < 64; ++i) a += h2c[n * 64 + i] * w3[(size_t)i * 1024 + od * 256 + c];
          hf[q] = a * __expf(-((float)n / (float)(CTX - 1)) * dl); } }
    __syncthreads();
    { const int b = tid >> 8, t = tid & 255; float y = bias0 * vv[tid];
      for (int s = 0; s <= t; ++s) y += hf[t - s] * vv[b * 256 + s];
      for (int s = t + 1; s < CTX; ++s) y += hf[256 + s - t] * vv[b * 256 + s];
      z1[tid] = x1[tid] * y; }
    __syncthreads();
    { const int b = tid >> 8, t = tid & 255; float y = bias1 * z1[tid];
      for (int s = 0; s <= t; ++s) y += hf[512 + t - s] * z1[b * 256 + s];
      for (int s = t + 1; s < CTX; ++s) y += hf[768 + s - t] * z1[b * 256 + s];
      bf16_t* MIX = (bf16_t*)(P.ws + WS_U); MIX[(size_t)(TL + b * CTX + t) * D + c] = f2bf(x2[tid] * y); }
    __syncthreads();
}
__device__ void hy_task2(const Params& P, int l, int c, float2* X) {
    const int tid = otid();
    const bf16_t* PHY = (const bf16_t*)(P.ws + WS_PHY); const float* cw = P.in[I_HCW] + (size_t)l * 3 * HY_IN; const float* cb = P.in[I_HCB] + (size_t)l * HY_IN;
    const float bias1 = P.in[I_HBIAS][(size_t)l * 2 * HYC + HYC + c];
    const float* Z1 = (const float*)(P.ws + WS_Z1) + (size_t)c * NB * SEQ;
    for (int n = tid; n < SEQ; n += NTHR) { X[n] = make_float2(Z1[n], Z1[SEQ + n]); X[SEQ + n] = make_float2(0.f, 0.f); }
    __syncthreads();
    hy_conv_core(P, 1, c, X);
    bf16_t* MIX = (bf16_t*)(P.ws + WS_U);
    for (int n = tid; n < SEQ; n += NTHR) { const float2 y = X[n];
        const float g0 = hy_short(PHY, cw, cb, n, 2 * HYC + c), g1 = hy_short(PHY, cw, cb, SEQ + n, 2 * HYC + c);
        MIX[(size_t)n * D + c] = f2bf(g0 * (y.x + bias1 * Z1[n])); MIX[(size_t)(SEQ + n) * D + c] = f2bf(g1 * (y.y + bias1 * Z1[SEQ + n])); }
    __syncthreads();
}

__device__ void ph_rwkvout(const Params& P, int l) {
    const int tid = otid(), lane = tid & 63, gw = blockIdx.x * NWAVE + (tid >> 6), nw = gridDim.x * NWAVE;
    const float* YD = (const float*)(P.ws + WS_YDIR); const bf16_t* VS = (const bf16_t*)(P.ws + WS_VS); const bf16_t* LO = (const bf16_t*)(P.ws + WS_LORAO); const float* BON = (const float*)(P.ws + WS_BONUS);
    bf16_t* MIX = (bf16_t*)(P.ws + WS_U);
    for (int it = gw; it < T * 6; it += nw) { const int row = it / 6, h = it % 6, c = h * 64 + lane; const size_t o = (size_t)row * 384 + c;
        const float y = YD[o] + YD[(size_t)T * 384 + o];
        const float mean = wsum(y) * (1.0f / 64.0f); const float dv = y - mean; const float var = wsum(dv * dv) * (1.0f / 64.0f);
        const float yn = dv * rsqrtf(var + 64e-5f) * P.in[I_LNW][l * RWW + c] + P.in[I_LNB][l * RWW + c];
        MIX[(size_t)row * D + 256 + c] = f2bf((yn + BON[(size_t)row * 6 + h] * bf2f(VS[o])) * bf2f(LO[(size_t)row * 2048 + 1536 + c])); }
}

typedef const __attribute__((address_space(4))) Params* KParamsPtr;
__device__ __forceinline__ const Params* fresh_params() { KParamsPtr q = (KParamsPtr)__builtin_amdgcn_kernarg_segment_ptr(); asm volatile("" : "+s"(q)); return (const Params*)q; }
__global__ void __launch_bounds__(NTHR, 2) fwd_megakernel(Params P_unused, int ph_lo, int ph_hi) {
    extern __shared__ __attribute__((aligned(16))) unsigned char smem[];
    cg::grid_group grid = cg::this_grid();
    LAS unsigned char* lds3 = (LAS unsigned char*)smem;
    float* ldsf = (float*)smem; float2* X = (float2*)smem; float* ex = (float*)(smem + LDS_MAIN);
    int ph = 0;
#define PHASE_BEGIN if (ph >= ph_lo && ph < ph_hi) { const Params& P = *fresh_params(); unsigned char* ws = P.ws; (void)ws;
#define PHASE_END   if (ph + 1 < ph_hi) grid.sync(); } ++ph;
    PHASE_BEGIN ph_modv(P, ldsf); PHASE_END
    for (int l = 0; l < DEPTH; ++l) {
        PHASE_BEGIN
            ph_prep(P, l, ldsf);
            if (l == 0) ph_rowpass(P, 0, 0, 0, 0, 0.f, 0, 0, 0, 1);
            else ph_rowpass(P, 1, l - 1, 8, 5, 0.5f, l, 0, 0, 1);
        PHASE_END
        PHASE_BEGIN { EpiGU E{(bf16_t*)(ws + WS_ACT)}; run_gemm(lds3, (const bf16_t*)(ws + WS_U), (const bf16_t*)(ws + WS_WGU1), T, 2 * DFF, D, E); } PHASE_END
        PHASE_BEGIN { EpiF32 E{(float*)(ws + WS_Y)}; run_gemm(lds3, (const bf16_t*)(ws + WS_ACT), (const bf16_t*)(ws + WS_WDN1), T, D, DFF, E); } PHASE_END
        PHASE_BEGIN ph_rowpass(P, 1, l, 2, 1, 0.5f, l, 2, 3, 4); PHASE_END
        PHASE_BEGIN { EpiWin E{(bf16_t*)(ws + WS_PHY), (bf16_t*)(ws + WS_PRW), (bf16_t*)(ws + WS_PNA)}; run_gemm(lds3, (const bf16_t*)(ws + WS_U), (const bf16_t*)(ws + WS_WIN), T, INWP, D, E); } PHASE_END
        PHASE_BEGIN
            ph_loraprep(P, l);
            for (int it = blockIdx.x; it < 512; it += gridDim.x) hy_spec_task(P, l, it >> 8, it & 255, X, ex);
        PHASE_END
        PHASE_BEGIN { EpiLora E{(bf16_t*)(ws + WS_LORAO)};
            run_gemm(lds3, (const bf16_t*)(ws + WS_ALORA), (const bf16_t*)(ws + WS_WLORA), T, 2048, 384, E); } PHASE_END
        PHASE_BEGIN
            ph_rwkvprep(P, l);
            for (int c = blockIdx.x; c < HYC; c += gridDim.x) hy_task1(P, l, c, X, ex);
        PHASE_END
        PHASE_BEGIN
            if (blockIdx.x < 24) { if (otid() < 64) scan_task_v1(P, blockIdx.x, ldsf); }
            else {
                for (int c = blockIdx.x - 24; c < HYC; c += gridDim.x - 24) hy_task2(P, l, c, X);
                natten_items_v1(P, l, (blockIdx.x - 24) * NTHR + otid(), (gridDim.x - 24) * NTHR);
            }
        PHASE_END
        PHASE_BEGIN ph_rwkvout(P, l); PHASE_END
        PHASE_BEGIN { EpiF32 E{(float*)(ws + WS_Y)}; run_gemm(lds3, (const bf16_t*)(ws + WS_U), (const bf16_t*)(ws + WS_WOUT), T, D, D, E); } PHASE_END
        PHASE_BEGIN ph_rowpass(P, 1, l, 5, 3, 1.0f, l, 4, 6, 7); PHASE_END
        PHASE_BEGIN { EpiGU E{(bf16_t*)(ws + WS_ACT)}; run_gemm(lds3, (const bf16_t*)(ws + WS_U), (const bf16_t*)(ws + WS_WGU2), T, 2 * DFF, D, E); } PHASE_END
        PHASE_BEGIN { EpiF32 E{(float*)(ws + WS_Y)}; run_gemm(lds3, (const bf16_t*)(ws + WS_ACT), (const bf16_t*)(ws + WS_WDN2), T, D, DFF, E); } PHASE_END
    }
    PHASE_BEGIN ph_rowpass(P, 2, DEPTH - 1, 8, 5, 0.5f, 0, 0, 0, 0); PHASE_END
#undef PHASE_BEGIN
#undef PHASE_END
}
constexpr int N_PHASES = 1 + DEPTH * 14 + 1;

extern "C" void kernel_launch(void* const* d_in, const int* in_sizes, int n_in, void* d_out, int out_size, void* d_ws, size_t ws_size, hipStream_t stream) {
    static int grid = 0;
    if (grid == 0) {
        if (n_in != 34 || ws_size < WS_END) { fprintf(stderr, "kernel_launch: need 34 inputs and %zu bytes of workspace; got %d, %zu\n", (size_t)WS_END, n_in, ws_size); grid = -1; return; }
        int dev = 0, cus = 0, per_cu = 0;
        hipGetDevice(&dev); hipDeviceGetAttribute(&cus, hipDeviceAttributeMultiprocessorCount, dev);
        if (hipFuncSetAttribute((const void*)fwd_megakernel, hipFuncAttributeMaxDynamicSharedMemorySize, LDS_BYTES) != hipSuccess) { fprintf(stderr, "kernel_launch: hipFuncSetAttribute failed\n"); grid = -1; return; }
        if (hipOccupancyMaxActiveBlocksPerMultiprocessor(&per_cu, (const void*)fwd_megakernel, NTHR, LDS_BYTES) != hipSuccess || per_cu < 1) { fprintf(stderr, "kernel_launch: occupancy query says %d\n", per_cu); per_cu = 1; }
        (void)hipGetLastError();
        grid = cus;
    }
    if (grid < 0) return;
    Params p{};
    for (int i = 0; i < 34; ++i) p.in[i] = (const float*)d_in[i];
    p.out = (float*)d_out; p.ws = (unsigned char*)d_ws;
#if MK_SPLIT
    for (int ph = 0; ph < N_PHASES; ++ph) { int lo = ph, hi = ph + 1; hipLaunchKernelGGL(fwd_megakernel, dim3(grid), dim3(NTHR), LDS_BYTES, stream, p, lo, hi); }
#else
    int lo = 0, hi = N_PHASES;
    void* args[] = {&p, &lo, &hi};
    hipError_t e = hipLaunchCooperativeKernel((const void*)fwd_megakernel, dim3(grid), dim3(NTHR), args, LDS_BYTES, stream);
    if (e != hipSuccess) fprintf(stderr, "cooperative launch failed: %s (grid %d)\n", hipGetErrorString(e), grid);
#endif
}
```

```cpp
#include <hip/hip_runtime.h>
#include <hip/hip_cooperative_groups.h>
#include <cstdio>
namespace cg = cooperative_groups;
__device__ __forceinline__ int otid() { int t = threadIdx.x; asm volatile("" : "+v"(t)); return t; }
namespace pg8 {
#define PG8_LAS __attribute__((address_space(3)))
typedef unsigned short bf16_t;
typedef short bf16x8 __attribute__((ext_vector_type(8)));
typedef float f32x4 __attribute__((ext_vector_type(4)));
typedef unsigned u32x4 __attribute__((ext_vector_type(4)));
constexpr int BM = 256, BK = 64, HALF = 128, HTB = HALF * BK * 2  , STAGE_BYTES = 8 * HTB, NXCD = 8, WGM = 8;

__host__ __device__ __forceinline__ int lds_byte(int r, int c) { const int st = (r >> 4) * 2 + (c >> 5), rr = r & 15, cc = c & 31, ob = rr * 64 + cc * 2; return st * 1024 + (ob ^ (((ob >> 9) & 1) << 5)); }
__host__ __device__ __forceinline__ void stage_rc(int b, int& R, int& C) { const int st = b / 1024, sb = b % 1024, swz = sb ^ (((sb >> 9) & 1) << 5); R = (st >> 1) * 16 + swz / 64; C = (st & 1) * 32 + (swz % 64) / 2; }
__host__ __device__ __forceinline__ int perm32(int rho) { const int n = rho >> 4, i = rho & 15; return 8 * (i >> 2) + 4 * n + (i & 3); }

struct Unit { int pm, pn; };
struct Gemm { const bf16_t* A; const bf16_t* Bt; int M, N, K; };
struct StaticOrder {
    int nM, nN, nwg, G, c;
    __host__ __device__ void init(int M, int N, int G_, int c_) { nM = M / BM; nN = N / BM; nwg = nM * nN; G = G_; c = c_; }
    __host__ __device__ bool next(int i, Unit& u) const {
        const long L = (long)i * G + c; if (L >= nwg) return false;
        int wgid = (int)L; { const int q = nwg / NXCD, r = nwg % NXCD, xcd = wgid % NXCD, off = wgid / NXCD; wgid = (xcd < r ? xcd * (q + 1) : r * (q + 1) + (xcd - r) * q) + off; }
        const int nig = WGM * nN, gid = wgid / nig, fm = gid * WGM, gsz = (nM - fm) < WGM ? (nM - fm) : WGM;
        u.pm = fm + ((wgid % nig) % gsz); u.pn = (wgid % nig) / gsz; return true;
    }
    __device__ __forceinline__ void a_ready(const Unit&) const {}
    __device__ __forceinline__ void done(const Unit&) const {}
};
__device__ __forceinline__ unsigned cvt_pk_bf16(float lo, float hi) { unsigned r; asm volatile("v_cvt_pk_bf16_f32 %0, %1, %2" : "=v"(r) : "v"(lo), "v"(hi)); return r; }
template <class Epi, class Sched>
__device__ __forceinline__ void gemm_phase(PG8_LAS unsigned char* lds, const Gemm g, const Sched& S, const Epi& E) {
    const int tid = otid(), wid = __builtin_amdgcn_readfirstlane(tid >> 6), lane = tid & 63, wr = wid >> 2, wc = wid & 3, fr = lane & 15, fq = lane >> 4;
    const int K = g.K, nt = K / BK;
#define PG8_STAMP() do {} while (0)
    unsigned voffA[2], voffB[2];
#pragma unroll
    for (int i = 0; i < 2; ++i) { int R, C; stage_rc(tid * 16 + i * 8192, R, C); const int Rb = Epi::PERM ? ((R & ~31) + perm32(R & 31)) : R;
        voffA[i] = (unsigned)(R * K + C) * 2u; voffB[i] = (unsigned)(Rb * K + C) * 2u; }
    const size_t kstep = (size_t)(BK * 2);
    const size_t hstep = (size_t)HALF * K * 2;
    const size_t tstep = 2 * hstep;
    const unsigned ldsw = (unsigned)wid * 1024u;
    const int aoff = lds_byte(wr * 64 + fr, fq * 8), boff = lds_byte(wc * 32 + fr, fq * 8);
#define PG8_SA(b, h) (((b) * 2 + (h)) * HTB)
#define PG8_SB(b, h) ((4 + (b) * 2 + (h)) * HTB)
#define PG8_STAGE(bufoff, gbase, voff) do { _Pragma("unroll") for (int _i = 0; _i < 2; ++_i) \
        __builtin_amdgcn_global_load_lds((const unsigned*)((const char*)(gbase) + (voff)[_i]), (PG8_LAS unsigned*)(lds + (bufoff) + ldsw + _i * 8192), 16, 0, 0); } while (0)
#define PG8_LDA(dst, b, h) do { _Pragma("unroll") for (int m = 0; m < 4; ++m) _Pragma("unroll") for (int k = 0; k < 2; ++k) dst[m][k] = *(const PG8_LAS bf16x8*)(lds + PG8_SA(b, h) + aoff + m * 2048 + k * 1024); } while (0)
#define PG8_LDB(dst, b, h) do { _Pragma("unroll") for (int n = 0; n < 2; ++n) _Pragma("unroll") for (int k = 0; k < 2; ++k) dst[n][k] = *(const PG8_LAS bf16x8*)(lds + PG8_SB(b, h) + boff + n * 2048 + k * 1024); } while (0)
#define PG8_MMA(ai, bj, At, Bt) do { __builtin_amdgcn_s_setprio(1); _Pragma("unroll") for (int m = 0; m < 4; ++m) _Pragma("unroll") for (int n = 0; n < 2; ++n) _Pragma("unroll") for (int k = 0; k < 2; ++k) \
        acc[ai][bj][m][n] = __builtin_amdgcn_mfma_f32_16x16x32_bf16(Bt[n][k], At[m][k], acc[ai][bj][m][n], 0, 0, 0); __builtin_amdgcn_s_setprio(0); } while (0)
#define PG8_WAIT_V(n) asm volatile("s_waitcnt vmcnt(" #n ")" ::: "memory")
#define PG8_WAIT_L(n) asm volatile("s_waitcnt lgkmcnt(" #n ")" ::: "memory")
#define PG8_BAR __builtin_amdgcn_s_barrier()
#define PG8_SCHED __builtin_amdgcn_sched_barrier(0)
    Unit cur, nxt; int ui = 0;
    if (!S.next(0, cur)) return;
    f32x4 acc[2][2][4][2];
#pragma unroll
    for (int a = 0; a < 2; ++a)
#pragma unroll
        for (int b = 0; b < 2; ++b)
#pragma unroll
            for (int m = 0; m < 4; ++m)
#pragma unroll
                for (int n = 0; n < 2; ++n) acc[a][b][m][n] = (f32x4){0.f, 0.f, 0.f, 0.f};
    bf16x8 At[4][2], B0[2][2], B1[2][2];
    const char* cA = (const char*)g.A + (size_t)cur.pm * tstep; const char* cB = (const char*)g.Bt + (size_t)cur.pn * tstep;
    S.a_ready(cur);
    PG8_STAGE(PG8_SB(0, 0), cB, voffB); PG8_STAGE(PG8_SA(0, 0), cA, voffA); PG8_STAGE(PG8_SB(0, 1), cB + hstep, voffB); PG8_STAGE(PG8_SA(0, 1), cA + hstep, voffA);
    if (wr == 1) PG8_BAR;
    PG8_WAIT_V(4); PG8_BAR;
    PG8_STAGE(PG8_SB(1, 0), cB + kstep, voffB); PG8_STAGE(PG8_SA(1, 0), cA + kstep, voffA); PG8_STAGE(PG8_SB(1, 1), cB + hstep + kstep, voffB);
    PG8_WAIT_V(6); PG8_BAR;
    PG8_STAMP();
    for (;;) {
        const bool has_next = S.next(ui + 1, nxt);
        const char* nA = has_next ? (const char*)g.A + (size_t)nxt.pm * tstep : cA; const char* nB = has_next ? (const char*)g.Bt + (size_t)nxt.pn * tstep : cB;
        for (int t = 0; t < nt; t += 2) {
            const bool last = (t == nt - 2);
            const char* a1 = cA + (size_t)(t + 1) * kstep;
            const char* a2 = last ? nA : cA + (size_t)(t + 2) * kstep; const char* b2 = last ? nB : cB + (size_t)(t + 2) * kstep;
            const char* a3 = a2 + kstep; const char* b3 = b2 + kstep;
            if (last && has_next) S.a_ready(nxt);
            PG8_LDB(B0, 0, 0); PG8_SCHED; PG8_LDA(At, 0, 0); PG8_STAGE(PG8_SA(1, 1), a1 + hstep, voffA);
            PG8_WAIT_L(8); PG8_BAR; PG8_WAIT_L(0); PG8_MMA(0, 0, At, B0); PG8_BAR; PG8_SCHED;
            PG8_LDB(B1, 0, 1); PG8_STAGE(PG8_SB(0, 0), b2, voffB);
            PG8_BAR; PG8_WAIT_L(0); PG8_MMA(0, 1, At, B1); PG8_BAR;
            PG8_LDA(At, 0, 1); PG8_STAGE(PG8_SA(0, 0), a2, voffA);
            PG8_BAR; PG8_WAIT_L(0); PG8_MMA(1, 0, At, B0); PG8_BAR; PG8_SCHED;
            PG8_STAGE(PG8_SB(0, 1), b2 + hstep, voffB);
            PG8_WAIT_V(6); PG8_BAR; PG8_MMA(1, 1, At, B1); PG8_BAR;
            PG8_LDB(B0, 1, 0); PG8_SCHED; PG8_LDA(At, 1, 0); PG8_STAGE(PG8_SA(0, 1), a2 + hstep, voffA);
            PG8_WAIT_L(8); PG8_BAR; PG8_WAIT_L(0); PG8_MMA(0, 0, At, B0); PG8_BAR; PG8_SCHED;
            PG8_LDB(B1, 1, 1); PG8_STAGE(PG8_SB(1, 0), b3, voffB);
            PG8_BAR; PG8_WAIT_L(0); PG8_MMA(0, 1, At, B1); PG8_BAR;
            PG8_LDA(At, 1, 1); PG8_STAGE(PG8_SA(1, 0), a3, voffA);
            PG8_BAR; PG8_WAIT_L(0); PG8_MMA(1, 0, At, B0); PG8_BAR; PG8_SCHED;
            PG8_STAGE(PG8_SB(1, 1), b3 + hstep, voffB);
            PG8_WAIT_V(6); PG8_BAR; PG8_MMA(1, 1, At, B1); PG8_BAR;
        }
        PG8_STAMP();
        if constexpr (!Epi::AFTER_DRAIN) { E(acc, cur, wr, wc, fr, fq); S.done(cur); }
        PG8_STAMP();
        if (!has_next) break;
#pragma unroll
        for (int a = 0; a < 2; ++a)
#pragma unroll
            for (int b = 0; b < 2; ++b)
#pragma unroll
                for (int m = 0; m < 4; ++m)
#pragma unroll
                    for (int n = 0; n < 2; ++n) acc[a][b][m][n] = (f32x4){0.f, 0.f, 0.f, 0.f};
        cur = nxt; cA = nA; cB = nB; ++ui;
    }
    PG8_WAIT_V(0);
    if (wr == 0) PG8_BAR;
    PG8_BAR;
    if constexpr (Epi::AFTER_DRAIN) { E.fused(acc, cur, wr, wc, fr, fq, lds, wid, lane); S.done(cur); }
    PG8_STAMP();
#undef PG8_STAMP
#undef PG8_SA
#undef PG8_SB
#undef PG8_STAGE
#undef PG8_LDA
#undef PG8_LDB
#undef PG8_MMA
#undef PG8_WAIT_V
#undef PG8_WAIT_L
#undef PG8_BAR
#undef PG8_SCHED
}
}

using pg8::bf16_t; using pg8::f32x4; using pg8::u32x4; using pg8::cvt_pk_bf16;
typedef unsigned u32x2 __attribute__((ext_vector_type(2)));
#define LAS __attribute__((address_space(3)))

constexpr int D = 1024, NB = 2, SEQ = 8192, DEPTH = 4, CTX = 256, DFF = 2816;
constexpr int TL = NB * SEQ, TC = NB * CTX, T = TL + TC;
constexpr int NMOD = 9 * D;
constexpr int HYC = 256, RWW = 384, NAW = 384, INW = 3456, INWP = 3584;
constexpr int HY_IN = 768, RW_IN = 1536, NA_IN = 1152;
constexpr int NFFT = 16384;
constexpr int NTHR = 512, NWAVE = 8;
constexpr int LDS_MAIN = 131072, LDS_EXTRA = 8192, LDS_BYTES = LDS_MAIN + LDS_EXTRA;
constexpr float NORM_EPS = 1e-6f;

constexpr size_t al256(size_t x) { return (x + 255) & ~(size_t)255; }
constexpr size_t WS_MODV = 0;
constexpr size_t WS_WGU1 = al256(WS_MODV + (size_t)DEPTH * 3 * NMOD * 4);
constexpr size_t WS_WDN1 = WS_WGU1 + (size_t)2 * DFF * D * 2;
constexpr size_t WS_WGU2 = WS_WDN1 + (size_t)D * DFF * 2;
constexpr size_t WS_WDN2 = WS_WGU2 + (size_t)2 * DFF * D * 2;
constexpr size_t WS_WIN = WS_WDN2 + (size_t)D * DFF * 2;
constexpr size_t WS_WOUT = WS_WIN + (size_t)INWP * D * 2;
constexpr size_t WS_WLORA = WS_WOUT + (size_t)D * D * 2;
constexpr size_t WS_H = WS_WLORA + (size_t)2048 * 384 * 2;
constexpr size_t WS_U = WS_H + (size_t)T * D * 4;
constexpr size_t WS_S = WS_U + (size_t)T * D * 2;
constexpr size_t WS_Y = WS_S;
constexpr size_t WS_ACT = WS_Y + (size_t)T * D * 4;
constexpr size_t WS_FFN_END = WS_ACT + (size_t)T * DFF * 2;
constexpr size_t WS_PHY = WS_S;
constexpr size_t WS_PRW = WS_PHY + (size_t)T * HY_IN * 2;
constexpr size_t WS_YDIR = WS_PRW;
constexpr size_t WS_PNA = WS_PRW + (size_t)T * RW_IN * 2;
constexpr size_t WS_ALORA = WS_PNA + (size_t)T * NA_IN * 2;
constexpr size_t WS_DECAY = WS_ALORA + (size_t)T * 384 * 2;
constexpr size_t WS_LORAO = WS_DECAY + (size_t)2 * T * 384 * 4;
constexpr size_t WS_E = WS_LORAO;
constexpr size_t WS_ZP = WS_E + (size_t)24 * SEQ * 64 * 2;
constexpr size_t WS_GATE = WS_LORAO + (size_t)T * 1536 * 2;
static_assert(WS_ZP + (size_t)24 * 33 * 2 * 4096 * 4 <= WS_GATE, "E + ZP must fit in the LORAO region");
constexpr size_t WS_RS = WS_GATE + (size_t)T * 384 * 2;
constexpr size_t WS_KKS = WS_RS + (size_t)T * 384 * 2;
constexpr size_t WS_VS = WS_KKS + (size_t)T * 384 * 2;
constexpr size_t WS_KS = WS_VS + (size_t)T * 384 * 2;
constexpr size_t WS_BS = WS_KS + (size_t)2 * T * 384 * 2;
constexpr size_t WS_BONUS = WS_BS + (size_t)2 * T * 384 * 2;
constexpr size_t WS_H2 = al256(WS_BONUS + (size_t)T * 6 * 4);
constexpr size_t WS_SPEC = WS_H2 + (size_t)(SEQ + CTX) * 64 * 4;
constexpr size_t WS_Z1 = WS_SPEC + (size_t)512 * NFFT * 8;
constexpr size_t WS_MIX_END = WS_Z1 + (size_t)HYC * NB * SEQ * 4;
constexpr size_t WS_END = WS_MIX_END > WS_FFN_END ? WS_MIX_END : WS_FFN_END;

struct Params { const float* in[34]; float* out; unsigned char* ws; };
enum { I_X = 0, I_C, I_CTX, I_CCTX, I_MODW, I_MODB, I_NORMG, I_F1GU, I_F1DN, I_F2GU, I_F2DN, I_WIN, I_WOUT, I_HCW, I_HCB, I_HW1, I_HB1, I_HW2, I_HB2, I_HW3, I_HFREQ, I_HBIAS,
       I_MU, I_W0, I_W2, I_A0, I_A2, I_G2, I_KK, I_KA, I_RK, I_LNW, I_LNB, I_RPB };

__device__ __forceinline__ float bf2f(bf16_t b) { return __uint_as_float(((unsigned)b) << 16); }
__device__ __forceinline__ bf16_t f2bf(float f) { unsigned u = __float_as_uint(f); u += 0x7FFFu + ((u >> 16) & 1u); return (bf16_t)(u >> 16); }
__device__ __forceinline__ float lo_bf(unsigned w) { return __uint_as_float(w << 16); }
__device__ __forceinline__ float hi_bf(unsigned w) { return __uint_as_float(w & 0xffff0000u); }
__device__ __forceinline__ float wsum(float v) {
#pragma unroll
    for (int o = 32; o > 0; o >>= 1) v += __shfl_xor(v, o);
    return v;
}
__device__ __forceinline__ float sigmoidf_(float x) { return __builtin_amdgcn_rcpf(1.0f + __expf(-x)); }
__device__ __forceinline__ void unpack8(const u32x4 w, float (&f)[8]) {
    f[0] = lo_bf(w.x); f[1] = hi_bf(w.x); f[2] = lo_bf(w.y); f[3] = hi_bf(w.y); f[4] = lo_bf(w.z); f[5] = hi_bf(w.z); f[6] = lo_bf(w.w); f[7] = hi_bf(w.w);
}
__device__ __forceinline__ void row_nbrs(int row, bool& hasp, bool& hasn) {
    if (row < TL) { const int t = row & (SEQ - 1); hasp = t > 0; hasn = t < SEQ - 1; }
    else { const int t = (row - TL) & (CTX - 1); hasp = t > 0; hasn = t < CTX - 1; }
}

__device__ void ph_modv(const Params& P, float* lds) {
    const int tid = otid();
    float* sv = lds;
    float* red = lds + 3072;
    for (int i = tid; i < 3072; i += NTHR) { const int s = i >> 10, k = i & 1023; const float c = s < 2 ? P.in[I_C][s * 1024 + k] : P.in[I_CCTX][k]; sv[i] = c / (1.0f + expf(-c)); }
    __syncthreads();
    float* modv = (float*)(P.ws + WS_MODV);
    const int kc = tid >> 6, cl = tid & 63;
    for (int item = blockIdx.x; item < DEPTH * 144; item += gridDim.x) {
        const int l = item / 144, cb = item % 144, col = cb * 64 + cl;
        const float* w = P.in[I_MODW] + ((size_t)l * 1024 + kc * 128) * NMOD + col;
        float a0 = 0.f, a1 = 0.f, a2 = 0.f;
#pragma unroll 8
        for (int k = 0; k < 128; ++k) { const float wv = w[(size_t)k * NMOD]; a0 += sv[kc * 128 + k] * wv; a1 += sv[1024 + kc * 128 + k] * wv; a2 += sv[2048 + kc * 128 + k] * wv; }
        red[(0 * 8 + kc) * 64 + cl] = a0; red[(1 * 8 + kc) * 64 + cl] = a1; red[(2 * 8 + kc) * 64 + cl] = a2;
        __syncthreads();
        if (tid < 192) { const int s = tid >> 6, c = tid & 63; float r = P.in[I_MODB][l * NMOD + cb * 64 + c];
#pragma unroll
            for (int q = 0; q < 8; ++q) r += red[(s * 8 + q) * 64 + c];
            modv[((size_t)l * 3 + s) * NMOD + cb * 64 + c] = r; }
        __syncthreads();
    }
}

__device__ __forceinline__ int rowmap_gu(int n) { const int up = n >= DFF ? 1 : 0; const int j = n - up * DFF; return (j >> 7) * 256 + up * 128 + (j & 127); }
__device__ void conv_tile(const float* __restrict__ src, int K, int N, bf16_t* __restrict__ dst, int tk, int tn, bool gu, float* tile) {
    const int tid = otid(); const int k0 = tk * 64, n0 = tn * 64;
#pragma unroll
    for (int rr = 0; rr < 2; ++rr) { const int kk = (tid >> 4) + rr * 32, n4 = (tid & 15) * 4; const float4 v = *(const float4*)(src + (size_t)(k0 + kk) * N + n0 + n4);
        tile[kk * 65 + n4 + 0] = v.x; tile[kk * 65 + n4 + 1] = v.y; tile[kk * 65 + n4 + 2] = v.z; tile[kk * 65 + n4 + 3] = v.w; }
    __syncthreads();
    { const int nn = tid >> 3, ks = (tid & 7) * 8; const int n = n0 + nn; const int row = gu ? rowmap_gu(n) : n;
      u32x4 w; w.x = cvt_pk_bf16(tile[(ks + 0) * 65 + nn], tile[(ks + 1) * 65 + nn]); w.y = cvt_pk_bf16(tile[(ks + 2) * 65 + nn], tile[(ks + 3) * 65 + nn]);
      w.z = cvt_pk_bf16(tile[(ks + 4) * 65 + nn], tile[(ks + 5) * 65 + nn]); w.w = cvt_pk_bf16(tile[(ks + 6) * 65 + nn], tile[(ks + 7) * 65 + nn]);
      *(u32x4*)(dst + (size_t)row * K + k0 + ks) = w; }
    __syncthreads();
}
__device__ void ph_prep(const Params& P, int l, float* lds) {
    const int tid = otid();
    unsigned char* ws = P.ws;
    constexpr int N0 = 16 * 88, N1 = 44 * 16, N4 = 16 * 54, N5 = 16 * 16;
    constexpr int C0 = N0, C1 = C0 + N1, C2 = C1 + N0, C3 = C2 + N1, C4 = C3 + N4, C5 = C4 + N5;
    for (int it = blockIdx.x; it < C5; it += gridDim.x) {
        if (it < C0) { conv_tile(P.in[I_F1GU] + (size_t)l * D * 2 * DFF, D, 2 * DFF, (bf16_t*)(ws + WS_WGU1), it / 88, it % 88, true, lds); }
        else if (it < C1) { const int j = it - C0; conv_tile(P.in[I_F1DN] + (size_t)l * DFF * D, DFF, D, (bf16_t*)(ws + WS_WDN1), j / 16, j % 16, false, lds); }
        else if (it < C2) { const int j = it - C1; conv_tile(P.in[I_F2GU] + (size_t)l * D * 2 * DFF, D, 2 * DFF, (bf16_t*)(ws + WS_WGU2), j / 88, j % 88, true, lds); }
        else if (it < C3) { const int j = it - C2; conv_tile(P.in[I_F2DN] + (size_t)l * DFF * D, DFF, D, (bf16_t*)(ws + WS_WDN2), j / 16, j % 16, false, lds); }
        else if (it < C4) { const int j = it - C3; conv_tile(P.in[I_WIN] + (size_t)l * D * INW, D, INW, (bf16_t*)(ws + WS_WIN), j / 54, j % 54, false, lds); }
        else { const int j = it - C4; conv_tile(P.in[I_WOUT] + (size_t)l * D * D, D, D, (bf16_t*)(ws + WS_WOUT), j / 16, j % 16, false, lds); }
    }
    const int gtid = blockIdx.x * NTHR + tid, gn = gridDim.x * NTHR;
    { unsigned* z = (unsigned*)(ws + WS_WIN + (size_t)INW * D * 2); for (int i = gtid; i < (INWP - INW) * D / 2; i += gn) z[i] = 0u; }
    { bf16_t* wl = (bf16_t*)(ws + WS_WLORA);
      const float* w2 = P.in[I_W2] + (size_t)l * 2 * 64 * RWW; const float* a2 = P.in[I_A2] + (size_t)l * 2 * 64 * RWW; const float* g2 = P.in[I_G2] + (size_t)l * 128 * RWW;
      for (int i = gtid; i < 2048 * 384; i += gn) { const int k = i / 2048, j = i % 2048; float v = 0.f;
          if (j < 1920) { const int grp = j / 384, c = j % 384;
              if (grp == 0) { if (k < 64) v = w2[(size_t)k * RWW + c]; }
              else if (grp == 1) { if (k >= 64 && k < 128) v = w2[(size_t)(64 + k - 64) * RWW + c]; }
              else if (grp == 2) { if (k >= 128 && k < 192) v = a2[(size_t)(k - 128) * RWW + c]; }
              else if (grp == 3) { if (k >= 192 && k < 256) v = a2[(size_t)(64 + k - 192) * RWW + c]; }
              else { if (k >= 256) v = g2[(size_t)(k - 256) * RWW + c]; } }
          wl[(size_t)j * 384 + k] = f2bf(v); } }
    { float* h2 = (float*)(ws + WS_H2);
      const float* w1 = P.in[I_HW1] + (size_t)l * 33 * 64; const float* b1 = P.in[I_HB1] + l * 64; const float* w2f = P.in[I_HW2] + (size_t)l * 64 * 64; const float* b2 = P.in[I_HB2] + l * 64;
      const float* fqv = P.in[I_HFREQ] + l * 64;
      const int lane = tid & 63, gw = blockIdx.x * NWAVE + (tid >> 6), nw = gridDim.x * NWAVE;
      const float fq = fqv[lane], bb1 = b1[lane], bb2 = b2[lane];
      for (int n = gw; n < SEQ + CTX; n += nw) {
          const int L = n < SEQ ? SEQ : CTX, pos = n < SEQ ? n : n - SEQ;
          const float tt = (float)pos / (float)(L - 1);
          const float ang = 6.283185307179586f * (float)pos / (float)L;
          float z = 0.f;
          if (lane == 0) z = tt;
          else if (lane <= 16) { const float fr = 1e-4f + (float)(lane - 1) * ((15.0f - 1e-4f) / 15.0f); z = cosf(fr * ang); }
          else if (lane <= 32) { const float fr = 1e-4f + (float)(lane - 17) * ((15.0f - 1e-4f) / 15.0f); z = -sinf(fr * ang); }
          float a = bb1;
#pragma unroll
          for (int e = 0; e < 33; ++e) a += __shfl(z, e) * w1[e * 64 + lane];
          const float h1 = sinf(fq * a);
          float c = bb2;
#pragma unroll
          for (int i = 0; i < 64; ++i) c += __shfl(h1, i) * w2f[i * 64 + lane];
          h2[(size_t)n * 64 + lane] = sinf(fq * c);
      } }
}

__device__ void ph_rowpass(const Params& P, int mode, int lpost, int gate_i, int gpost_i, float ps, int lpre, int gpre_i, int shift_i, int scale_i) {
    const int tid = otid(), lane = tid & 63, gw = blockIdx.x * NWAVE + (tid >> 6), nw = gridDim.x * NWAVE;
    const float* modv = (const float*)(P.ws + WS_MODV);
    float* H = (float*)(P.ws + WS_H); const float* Y = (const float*)(P.ws + WS_Y); bf16_t* U = (bf16_t*)(P.ws + WS_U);
    int cur_s = -1;
    float4 A[4], Bv[4], Cv[4];
#pragma unroll
    for (int j = 0; j < 4; ++j) { A[j] = make_float4(0.f, 0.f, 0.f, 0.f); Bv[j] = A[j]; Cv[j] = A[j]; }
    for (int row = gw; row < T; row += nw) {
        const int s = row < SEQ ? 0 : (row < TL ? 1 : 2);
        if (s != cur_s) { cur_s = s;
#pragma unroll
            for (int j = 0; j < 4; ++j) { const int e = lane * 4 + 256 * j;
                if (mode != 0) { const float4 g = *(const float4*)(modv + ((size_t)lpost * 3 + s) * NMOD + gate_i * D + e); const float4 gp = *(const float4*)(P.in[I_NORMG] + ((size_t)lpost * 6 + gpost_i) * D + e);
                    A[j] = make_float4(ps * g.x * gp.x, ps * g.y * gp.y, ps * g.z * gp.z, ps * g.w * gp.w); }
                if (mode != 2) { const float4 sc = *(const float4*)(modv + ((size_t)lpre * 3 + s) * NMOD + scale_i * D + e); const float4 gq = *(const float4*)(P.in[I_NORMG] + ((size_t)lpre * 6 + gpre_i) * D + e);
                    Bv[j] = make_float4(gq.x * (1.f + sc.x), gq.y * (1.f + sc.y), gq.z * (1.f + sc.z), gq.w * (1.f + sc.w));
                    Cv[j] = *(const float4*)(modv + ((size_t)lpre * 3 + s) * NMOD + shift_i * D + e); } } }
        float4 h[4];
        if (mode == 0) { const float* src = row < TL ? P.in[I_X] + (size_t)row * D : P.in[I_CTX] + (size_t)(row - TL) * D;
#pragma unroll
            for (int j = 0; j < 4; ++j) h[j] = *(const float4*)(src + lane * 4 + 256 * j);
        } else {
            float4 y[4]; float ss = 0.f;
#pragma unroll
            for (int j = 0; j < 4; ++j) { h[j] = *(const float4*)(H + (size_t)row * D + lane * 4 + 256 * j); y[j] = *(const float4*)(Y + (size_t)row * D + lane * 4 + 256 * j);
                ss += y[j].x * y[j].x + y[j].y * y[j].y + y[j].z * y[j].z + y[j].w * y[j].w; }
            ss = wsum(ss); const float r = rsqrtf(ss * (1.0f / D) + NORM_EPS);
#pragma unroll
            for (int j = 0; j < 4; ++j) { h[j].x += A[j].x * (y[j].x * r); h[j].y += A[j].y * (y[j].y * r); h[j].z += A[j].z * (y[j].z * r); h[j].w += A[j].w * (y[j].w * r); }
        }
        if (mode == 2) { if (row < TL) {
#pragma unroll
                for (int j = 0; j < 4; ++j) *(float4*)(P.out + (size_t)row * D + lane * 4 + 256 * j) = h[j]; }
            continue; }
        float s2 = 0.f;
#pragma unroll
        for (int j = 0; j < 4; ++j) { *(float4*)(H + (size_t)row * D + lane * 4 + 256 * j) = h[j]; s2 += h[j].x * h[j].x + h[j].y * h[j].y + h[j].z * h[j].z + h[j].w * h[j].w; }
        s2 = wsum(s2); const float r2 = rsqrtf(s2 * (1.0f / D) + NORM_EPS);
#pragma unroll
        for (int j = 0; j < 4; ++j) { u32x2 w; w.x = cvt_pk_bf16(h[j].x * r2 * Bv[j].x + Cv[j].x, h[j].y * r2 * Bv[j].y + Cv[j].y); w.y = cvt_pk_bf16(h[j].z * r2 * Bv[j].z + Cv[j].z, h[j].w * r2 * Bv[j].w + Cv[j].w);
            *(u32x2*)(U + (size_t)row * D + lane * 4 + 256 * j) = w; }
    }
}

struct EpiGU {
    static constexpr bool PERM = true, AFTER_DRAIN = false;
    bf16_t* O;
    __device__ __forceinline__ void operator()(const f32x4 (&acc)[2][2][4][2], const pg8::Unit& u, int wr, int wc, int fr, int fq) const {
        const int row0 = u.pm * 256 + wr * 64 + fr, col0 = u.pn * 128 + wc * 32 + 8 * fq;
#pragma unroll
        for (int ai = 0; ai < 2; ++ai)
#pragma unroll
            for (int m = 0; m < 4; ++m) { float o[8];
#pragma unroll
                for (int n = 0; n < 2; ++n)
#pragma unroll
                    for (int j = 0; j < 4; ++j) { const float g = acc[ai][0][m][n][j], up = acc[ai][1][m][n][j]; o[n * 4 + j] = g * __builtin_amdgcn_rcpf(1.0f + __expf(-g)) * up; }
                u32x4 w; w.x = cvt_pk_bf16(o[0], o[1]); w.y = cvt_pk_bf16(o[2], o[3]); w.z = cvt_pk_bf16(o[4], o[5]); w.w = cvt_pk_bf16(o[6], o[7]);
                *(u32x4*)(O + (size_t)(row0 + ai * 128 + m * 16) * DFF + col0) = w; }
    }
};
struct EpiF32 {
    static constexpr bool PERM = false, AFTER_DRAIN = false;
    float* C;
    __device__ __forceinline__ void operator()(const f32x4 (&acc)[2][2][4][2], const pg8::Unit& u, int wr, int wc, int fr, int fq) const {
        const int row0 = u.pm * 256 + wr * 64 + fr, col0 = u.pn * 256 + wc * 32 + 4 * fq;
#pragma unroll
        for (int ai = 0; ai < 2; ++ai)
#pragma unroll
            for (int m = 0; m < 4; ++m) { float* rowp = C + (size_t)(row0 + ai * 128 + m * 16) * D + col0;
#pragma unroll
                for (int bj = 0; bj < 2; ++bj)
#pragma unroll
                    for (int n = 0; n < 2; ++n) *(f32x4*)(rowp + bj * 128 + n * 16) = acc[ai][bj][m][n]; }
    }
};
struct EpiWin {
    static constexpr bool PERM = true, AFTER_DRAIN = false;
    bf16_t* PHY; bf16_t* PRW; bf16_t* PNA;
    __device__ __forceinline__ void operator()(const f32x4 (&acc)[2][2][4][2], const pg8::Unit& u, int wr, int wc, int fr, int fq) const {
        const int row0 = u.pm * 256 + wr * 64 + fr;
        bf16_t* base; int ld, cbase;
        if (u.pn < 3) { base = PHY; ld = HY_IN; cbase = u.pn * 256; }
        else if (u.pn < 9) { base = PRW; ld = RW_IN; cbase = u.pn * 256 - HY_IN; }
        else { base = PNA; ld = NA_IN; cbase = u.pn * 256 - HY_IN - RW_IN; }
        const int nbj = (u.pn == 13) ? 1 : 2;
#pragma unroll
        for (int ai = 0; ai < 2; ++ai)
#pragma unroll
            for (int m = 0; m < 4; ++m)
#pragma unroll
                for (int bj = 0; bj < 2; ++bj) { if (bj < nbj) { const f32x4 v0 = acc[ai][bj][m][0], v1 = acc[ai][bj][m][1];
                    u32x4 w; w.x = cvt_pk_bf16(v0[0], v0[1]); w.y = cvt_pk_bf16(v0[2], v0[3]); w.z = cvt_pk_bf16(v1[0], v1[1]); w.w = cvt_pk_bf16(v1[2], v1[3]);
                    *(u32x4*)(base + (size_t)(row0 + ai * 128 + m * 16) * ld + cbase + bj * 128 + wc * 32 + 8 * fq) = w; } }
    }
};
struct EpiLora {
    static constexpr bool PERM = true, AFTER_DRAIN = false;
    bf16_t* LO; bf16_t* GATE;
    __device__ __forceinline__ void operator()(const f32x4 (&acc)[2][2][4][2], const pg8::Unit& u, int wr, int wc, int fr, int fq) const {
        const int row0 = u.pm * 256 + wr * 64 + fr;
        bf16_t* base; int ld, cbase;
        if (u.pn < 6) { base = LO; ld = 1536; cbase = u.pn * 256; } else { base = GATE; ld = 384; cbase = u.pn * 256 - 1536; }
        const int nbj = (u.pn == 7) ? 1 : 2;
#pragma unroll
        for (int ai = 0; ai < 2; ++ai)
#pragma unroll
            for (int m = 0; m < 4; ++m)
#pragma unroll
                for (int bj = 0; bj < 2; ++bj) { if (bj < nbj) { const f32x4 v0 = acc[ai][bj][m][0], v1 = acc[ai][bj][m][1];
                    u32x4 w; w.x = cvt_pk_bf16(v0[0], v0[1]); w.y = cvt_pk_bf16(v0[2], v0[3]); w.z = cvt_pk_bf16(v1[0], v1[1]); w.w = cvt_pk_bf16(v1[2], v1[3]);
                    *(u32x4*)(base + (size_t)(row0 + ai * 128 + m * 16) * ld + cbase + bj * 128 + wc * 32 + 8 * fq) = w; } }
    }
};
template <class Epi> __device__ __forceinline__ void run_gemm(LAS unsigned char* lds, const bf16_t* A, const bf16_t* Bt, int M, int N, int K, const Epi& E) {
    asm volatile("" : "+s"(K));
    pg8::Gemm g{A, Bt, M, N, K}; pg8::StaticOrder S; S.init(M, N, (int)gridDim.x, (int)blockIdx.x);
    pg8::gemm_phase<Epi, pg8::StaticOrder>(lds, g, S, E);
    __syncthreads();
}

__device__ void ph_loraprep(const Params& P, int l) {
    const bf16_t* PRW = (const bf16_t*)(P.ws + WS_PRW); bf16_t* AL = (bf16_t*)(P.ws + WS_ALORA);
    const float* mu = P.in[I_MU] + (size_t)l * 2 * RW_IN;
    const int gtid = blockIdx.x * NTHR + otid(), gn = gridDim.x * NTHR;
    for (int it = gtid; it < T * 48; it += gn) {
        const int row = it / 48, j8 = it % 48, col = 1152 + j8 * 8;
        bool hp, hn; row_nbrs(row, hp, hn);
        float p[8], pp[8], pn[8];
        unpack8(*(const u32x4*)(PRW + (size_t)row * RW_IN + col), p);
        if (hp) unpack8(*(const u32x4*)(PRW + (size_t)(row - 1) * RW_IN + col), pp); else {
#pragma unroll
            for (int i = 0; i < 8; ++i) pp[i] = 0.f; }
        if (hn) unpack8(*(const u32x4*)(PRW + (size_t)(row + 1) * RW_IN + col), pn); else {
#pragma unroll
            for (int i = 0; i < 8; ++i) pn[i] = 0.f; }
        float o[8];
#pragma unroll
        for (int i = 0; i < 8; ++i) { const float xs = p[i] + mu[col + i] * (pp[i] - p[i]) + mu[RW_IN + col + i] * (pn[i] - p[i]);
            o[i] = j8 < 16 ? tanhf(xs) : (j8 < 32 ? xs : sigmoidf_(xs)); }
        u32x4 w; w.x = cvt_pk_bf16(o[0], o[1]); w.y = cvt_pk_bf16(o[2], o[3]); w.z = cvt_pk_bf16(o[4], o[5]); w.w = cvt_pk_bf16(o[6], o[7]);
        *(u32x4*)(AL + (size_t)row * 384 + j8 * 8) = w;
    }
}

__device__ void ph_rwkvprep(const Params& P, int l) {
    const int tid = otid(), lane = tid & 63, gw = blockIdx.x * NWAVE + (tid >> 6), nw = gridDim.x * NWAVE;
    const bf16_t* PRW = (const bf16_t*)(P.ws + WS_PRW); const bf16_t* LO = (const bf16_t*)(P.ws + WS_LORAO);
    bf16_t* RS = (bf16_t*)(P.ws + WS_RS); bf16_t* KKS = (bf16_t*)(P.ws + WS_KKS); bf16_t* VS = (bf16_t*)(P.ws + WS_VS); bf16_t* KS = (bf16_t*)(P.ws + WS_KS); bf16_t* BS = (bf16_t*)(P.ws + WS_BS);
    float* BON = (float*)(P.ws + WS_BONUS);
    const float* mu = P.in[I_MU] + (size_t)l * 2 * RW_IN;
    const int f = lane & 15; const float inv = __expf(-(float)f * (9.210340371976184f / 16.0f));
    for (int it = gw; it < T * 6; it += nw) {
        const int row = it / 6, h = it % 6, c = h * 64 + lane;
        bool hp, hn; row_nbrs(row, hp, hn);
        float x[3];
#pragma unroll
        for (int q = 0; q < 3; ++q) { const int col = q * 384 + c; const float p = bf2f(PRW[(size_t)row * RW_IN + col]);
            const float pp = hp ? bf2f(PRW[(size_t)(row - 1) * RW_IN + col]) : 0.f, pn = hn ? bf2f(PRW[(size_t)(row + 1) * RW_IN + col]) : 0.f;
            x[q] = p + mu[col] * (pp - p) + mu[RW_IN + col] * (pn - p); }
        const float r = x[0], k = x[1], v = x[2];
        const float kkr = k * P.in[I_KK][l * RWW + c];
        const float nrm = sqrtf(wsum(kkr * kkr));
        const float kk = kkr / fmaxf(nrm, 1e-12f);
        const float a0 = sigmoidf_(bf2f(LO[(size_t)row * 1536 + 768 + c]) + P.in[I_A0][(size_t)l * 2 * RWW + c]), a1 = sigmoidf_(bf2f(LO[(size_t)row * 1536 + 1152 + c]) + P.in[I_A0][(size_t)l * 2 * RWW + RWW + c]);
        { float* DEC = (float*)(P.ws + WS_DECAY);
          const float x0 = bf2f(LO[(size_t)row * 1536 + c]) + P.in[I_W0][(size_t)l * 2 * RWW + c], x1 = bf2f(LO[(size_t)row * 1536 + 384 + c]) + P.in[I_W0][(size_t)l * 2 * RWW + RWW + c];
          DEC[(size_t)row * 384 + c] = __expf(-0.6065306597f * sigmoidf_(x0)); DEC[((size_t)T + row) * 384 + c] = __expf(-0.6065306597f * sigmoidf_(x1)); }
        const float ka = P.in[I_KA][l * RWW + c];
        float kd0 = k * (1.f + (a0 - 1.f) * ka), kd1 = k * (1.f + (a1 - 1.f) * ka);
        float b0 = kk * a0, b1 = kk * a1;
        const float bon = wsum(r * (kd0 + kd1) * P.in[I_RK][l * RWW + c]);
        if (lane == 0) BON[(size_t)row * 6 + h] = bon;
        float rs = r, kks = kk;
        if (row < TL) {
            const int t = row & (SEQ - 1); const float pos = (lane < 32) ? (float)(t >> 6) : (float)(t & 63);
            float sn, cs; sincosf(pos * inv, &sn, &cs);
            const float sg = (lane & 16) ? 1.f : -1.f;
            const float r2 = __shfl_xor(rs, 16), k2 = __shfl_xor(kks, 16), d0 = __shfl_xor(kd0, 16), d1 = __shfl_xor(kd1, 16), e0 = __shfl_xor(b0, 16), e1 = __shfl_xor(b1, 16);
            rs = rs * cs + sg * r2 * sn; kks = kks * cs + sg * k2 * sn; kd0 = kd0 * cs + sg * d0 * sn; kd1 = kd1 * cs + sg * d1 * sn; b0 = b0 * cs + sg * e0 * sn; b1 = b1 * cs + sg * e1 * sn;
        }
        const size_t o = (size_t)row * 384 + c;
        RS[o] = f2bf(rs); KKS[o] = f2bf(-kks); VS[o] = f2bf(v);
        KS[o] = f2bf(kd0); KS[(size_t)T * 384 + o] = f2bf(kd1); BS[o] = f2bf(b0); BS[(size_t)T * 384 + o] = f2bf(b1);
    }
}

__device__ __forceinline__ int scan_row(int b, int d, int step) {
    if (step < CTX) { const int tc = d ? (CTX - 1 - step) : step; return TL + b * CTX + tc; }
    const int tl = d ? (SEQ - 1 - (step - CTX)) : (step - CTX); return b * SEQ + tl;
}
__device__ void scan_task_v1(const Params& P, int task, float* sv) {
    const int lane = otid() & 63;
    const int d = task & 1, h = (task >> 1) % 6, b = task / 12;
    const float* DEC = (const float*)(P.ws + WS_DECAY) + (size_t)d * T * 384; const bf16_t* KKS = (const bf16_t*)(P.ws + WS_KKS); const bf16_t* RS = (const bf16_t*)(P.ws + WS_RS);
    const bf16_t* VS = (const bf16_t*)(P.ws + WS_VS); const bf16_t* KS = (const bf16_t*)(P.ws + WS_KS) + (size_t)d * T * 384; const bf16_t* BS = (const bf16_t*)(P.ws + WS_BS) + (size_t)d * T * 384;
    float* YD = (float*)(P.ws + WS_YDIR) + (size_t)d * T * 384;
    float S[64];
#pragma unroll
    for (int j = 0; j < 64; ++j) S[j] = 0.f;
    size_t o = (size_t)scan_row(b, d, 0) * 384 + h * 64 + lane;
    float nw_ = DEC[o], na = bf2f(KKS[o]), nb = bf2f(BS[o]), nk = bf2f(KS[o]), nr = bf2f(RS[o]), nv = bf2f(VS[o]);
    for (int step = 0; step < CTX + SEQ; ++step) {
        const float v = nv; const size_t oc = o;
        asm volatile("s_waitcnt lgkmcnt(0)" ::: "memory");
        sv[lane] = nw_; sv[64 + lane] = na; sv[128 + lane] = nb; sv[192 + lane] = nk; sv[256 + lane] = nr;
        asm volatile("s_waitcnt lgkmcnt(0)" ::: "memory");
        if (step + 1 < CTX + SEQ) { o = (size_t)scan_row(b, d, step + 1) * 384 + h * 64 + lane;
            nw_ = DEC[o]; na = bf2f(KKS[o]); nb = bf2f(BS[o]); nk = bf2f(KS[o]); nr = bf2f(RS[o]); nv = bf2f(VS[o]); }
        float sa0 = 0.f, sa1 = 0.f, sa2 = 0.f, sa3 = 0.f;
#pragma unroll
        for (int j = 0; j < 64; j += 4) { const float4 a4 = *(const float4*)(sv + 64 + j);
            sa0 += S[j + 0] * a4.x; sa1 += S[j + 1] * a4.y; sa2 += S[j + 2] * a4.z; sa3 += S[j + 3] * a4.w; }
        const float sa = (sa0 + sa1) + (sa2 + sa3);
        float y0 = 0.f, y1 = 0.f, y2 = 0.f, y3 = 0.f;
#pragma unroll
        for (int j = 0; j < 64; j += 4) {
            const float4 w4 = *(const float4*)(sv + j), b4 = *(const float4*)(sv + 128 + j), k4 = *(const float4*)(sv + 192 + j), r4 = *(const float4*)(sv + 256 + j);
            S[j + 0] = S[j + 0] * w4.x + sa * b4.x + v * k4.x; y0 += S[j + 0] * r4.x;
            S[j + 1] = S[j + 1] * w4.y + sa * b4.y + v * k4.y; y1 += S[j + 1] * r4.y;
            S[j + 2] = S[j + 2] * w4.z + sa * b4.z + v * k4.z; y2 += S[j + 2] * r4.z;
            S[j + 3] = S[j + 3] * w4.w + sa * b4.w + v * k4.w; y3 += S[j + 3] * r4.w; }
        YD[oc] = (y0 + y1) + (y2 + y3);
    }
}

__device__ __forceinline__ void natt_key(const bf16_t* PNA, size_t krow, int hoff, const float (&q)[16], float bias, float& m, float& lsum, float (&o)[16]) {
    const bf16_t* kp = PNA + krow * NA_IN + 384 + hoff; const bf16_t* vp = PNA + krow * NA_IN + 768 + hoff;
    float s = 0.f;
#pragma unroll
    for (int j8 = 0; j8 < 2; ++j8) { float kf[8]; unpack8(*(const u32x4*)(kp + j8 * 8), kf);
#pragma unroll
        for (int i = 0; i < 8; ++i) s += q[j8 * 8 + i] * kf[i]; }
    s += __shfl_xor(s, 1); s += __shfl_xor(s, 2); s += bias;
    const float mn = fmaxf(m, s), corr = __expf(m - mn), p = __expf(s - mn);
    m = mn; lsum = lsum * corr + p;
#pragma unroll
    for (int j8 = 0; j8 < 2; ++j8) { float vf[8]; unpack8(*(const u32x4*)(vp + j8 * 8), vf);
#pragma unroll
        for (int i = 0; i < 8; ++i) o[j8 * 8 + i] = o[j8 * 8 + i] * corr + p * vf[i]; }
}
__device__ void natten_items_v1(const Params& P, int l, int wid0, int nworkers) {
    const bf16_t* PNA = (const bf16_t*)(P.ws + WS_PNA); bf16_t* MIX = (bf16_t*)(P.ws + WS_U);
    const float* rpb = P.in[I_RPB] + (size_t)l * 6 * 15 * 31;
    const int sub = wid0 & 3;
    for (int it = wid0 >> 2; it < T * 6; it += nworkers >> 2) {
        const int row = it % T, h = it / T, hoff = h * 64 + sub * 16;
        float q[16], o[16];
#pragma unroll
        for (int j8 = 0; j8 < 2; ++j8) { float qf[8]; unpack8(*(const u32x4*)(PNA + (size_t)row * NA_IN + hoff + j8 * 8), qf);
#pragma unroll
            for (int i = 0; i < 8; ++i) { q[j8 * 8 + i] = qf[i] * 0.125f; o[j8 * 8 + i] = 0.f; } }
        float m = -3.0e38f, lsum = 0.f;
        int b;
        if (row < TL) { b = row >> 13; const int t = row & (SEQ - 1), i = t >> 6, col = t & 63;
            const int start = min(max(i - 4, 0), 120), win0 = min(max(col - 8, 0), 48);
            for (int r = 0; r < 8; ++r) for (int kc = win0; kc < win0 + 16; ++kc) {
                const float bias = rpb[(h * 15 + (start + r - i + 7)) * 31 + (kc - col + 15)];
                natt_key(PNA, (size_t)b * SEQ + (start + r) * 64 + kc, hoff, q, bias, m, lsum, o); }
        } else b = (row - TL) >> 8;
        for (int c = 0; c < CTX; ++c) natt_key(PNA, (size_t)TL + b * CTX + c, hoff, q, 0.f, m, lsum, o);
        const float il = 1.0f / lsum;
#pragma unroll
        for (int j8 = 0; j8 < 2; ++j8) { u32x4 w; w.x = cvt_pk_bf16(o[j8 * 8 + 0] * il, o[j8 * 8 + 1] * il); w.y = cvt_pk_bf16(o[j8 * 8 + 2] * il, o[j8 * 8 + 3] * il);
            w.z = cvt_pk_bf16(o[j8 * 8 + 4] * il, o[j8 * 8 + 5] * il); w.w = cvt_pk_bf16(o[j8 * 8 + 6] * il, o[j8 * 8 + 7] * il);
            *(u32x4*)(MIX + (size_t)row * D + 640 + hoff + j8 * 8) = w; }
    }
}

__device__ void fft_fwd(float2* X) {
    for (int s = 13; s >= 0; --s) { const int half = 1 << s;
        for (int j = otid(); j < NFFT / 2; j += NTHR) { const int lo = j & (half - 1), i0 = ((j >> s) << (s + 1)) | lo, i1 = i0 + half;
            const float2 a = X[i0], b = X[i1]; const float fr = (float)lo / (float)(2 * half);
            const float cw = __builtin_amdgcn_cosf(fr), sw = __builtin_amdgcn_sinf(fr);
            const float dx = a.x - b.x, dy = a.y - b.y;
            X[i0] = make_float2(a.x + b.x, a.y + b.y); X[i1] = make_float2(dx * cw + dy * sw, dy * cw - dx * sw); }
        __syncthreads(); }
}
__device__ void fft_inv(float2* X) {
    for (int s = 0; s <= 13; ++s) { const int half = 1 << s;
        for (int j = otid(); j < NFFT / 2; j += NTHR) { const int lo = j & (half - 1), i0 = ((j >> s) << (s + 1)) | lo, i1 = i0 + half;
            const float2 a = X[i0], b = X[i1]; const float fr = (float)lo / (float)(2 * half);
            const float cw = __builtin_amdgcn_cosf(fr), sw = __builtin_amdgcn_sinf(fr);
            const float bx = b.x * cw - b.y * sw, by = b.x * sw + b.y * cw;
            X[i0] = make_float2(a.x + bx, a.y + by); X[i1] = make_float2(a.x - bx, a.y - by); }
        __syncthreads(); }
}
__device__ __forceinline__ float hy_delta(int c) { const float lo = -4.605170185988091f / 1.5f, hi = -4.605170185988091f / 0.3f; return fabsf(lo + (float)c * ((hi - lo) / 255.0f)); }
__device__ __forceinline__ float hy_short(const bf16_t* PHY, const float* cw, const float* cb, int row, int col) {
    bool hp, hn; row_nbrs(row, hp, hn);
    float v = cb[col] + cw[HY_IN + col] * bf2f(PHY[(size_t)row * HY_IN + col]);
    if (hp) v += cw[col] * bf2f(PHY[(size_t)(row - 1) * HY_IN + col]);
    if (hn) v += cw[2 * HY_IN + col] * bf2f(PHY[(size_t)(row + 1) * HY_IN + col]);
    return v;
}
__device__ void hy_spec_task(const Params& P, int l, int o, int c, float2* X, float* ex) {
    const int tid = otid();
    const float* h2 = (const float*)(P.ws + WS_H2); const float* w3 = P.in[I_HW3] + (size_t)l * 64 * 1024;
    if (tid < 128) { const int dir = tid >> 6, i = tid & 63; ex[tid] = w3[(size_t)i * 1024 + o * 512 + dir * 256 + c]; }
    __syncthreads();
    const float dl = hy_delta(c);
    for (int n = tid; n < SEQ; n += NTHR) { float af = 0.f, ab = 0.f;
#pragma unroll
        for (int i4 = 0; i4 < 16; ++i4) { const float4 hv = *(const float4*)(h2 + (size_t)n * 64 + i4 * 4);
            af += hv.x * ex[i4 * 4] + hv.y * ex[i4 * 4 + 1] + hv.z * ex[i4 * 4 + 2] + hv.w * ex[i4 * 4 + 3];
            ab += hv.x * ex[64 + i4 * 4] + hv.y * ex[64 + i4 * 4 + 1] + hv.z * ex[64 + i4 * 4 + 2] + hv.w * ex[64 + i4 * 4 + 3]; }
        const float dec = __expf(-((float)n / (float)(SEQ - 1)) * dl) * (1.0f / NFFT);
        X[n] = make_float2(af * dec, 0.f);
        if (n > 0) X[NFFT - n] = make_float2(ab * dec, 0.f); else X[SEQ] = make_float2(0.f, 0.f); }
    __syncthreads();
    fft_fwd(X);
    float2* spec = (float2*)(P.ws + WS_SPEC) + (size_t)(o * 256 + c) * NFFT;
    for (int i = tid; i < NFFT; i += NTHR) spec[i] = X[i];
    __syncthreads();
}
__device__ void hy_conv_core(const Params& P, int o, int c, float2* X) {
    fft_fwd(X);
    const float2* spec = (const float2*)(P.ws + WS_SPEC) + (size_t)(o * 256 + c) * NFFT;
    for (int i = otid(); i < NFFT; i += NTHR) { const float2 a = X[i], k = spec[i]; X[i] = make_float2(a.x * k.x - a.y * k.y, a.x * k.y + a.y * k.x); }
    __syncthreads();
    fft_inv(X);
}
__device__ void hy_task1(const Params& P, int l, int c, float2* X, float* ex) {
    const int tid = otid();
    const bf16_t* PHY = (const bf16_t*)(P.ws + WS_PHY); const float* cw = P.in[I_HCW] + (size_t)l * 3 * HY_IN; const float* cb = P.in[I_HCB] + (size_t)l * HY_IN;
    const float bias0 = P.in[I_HBIAS][(size_t)l * 2 * HYC + c], bias1 = P.in[I_HBIAS][(size_t)l * 2 * HYC + HYC + c];
    for (int n = tid; n < SEQ; n += NTHR) { X[n] = make_float2(hy_short(PHY, cw, cb, n, c), hy_short(PHY, cw, cb, SEQ + n, c)); X[SEQ + n] = make_float2(0.f, 0.f); }
    __syncthreads();
    hy_conv_core(P, 0, c, X);
    float* Z1 = (float*)(P.ws + WS_Z1) + (size_t)c * NB * SEQ;
    for (int n = tid; n < SEQ; n += NTHR) { const float2 y = X[n];
        const float v0 = hy_short(PHY, cw, cb, n, c), v1 = hy_short(PHY, cw, cb, SEQ + n, c), g0 = hy_short(PHY, cw, cb, n, HYC + c), g1 = hy_short(PHY, cw, cb, SEQ + n, HYC + c);
        Z1[n] = g0 * (y.x + bias0 * v0); Z1[SEQ + n] = g1 * (y.y + bias0 * v1); }
    __syncthreads();
    float* f = (float*)X;
    float* vv = f, *x1 = f + 512, *x2 = f + 1024, *hf = f + 1536  , *z1 = f + 2560;
    const float* h2c = (const float*)(P.ws + WS_H2) + (size_t)SEQ * 64; const float* w3 = P.in[I_HW3] + (size_t)l * 64 * 1024;
    { const int b = tid >> 8, t = tid & 255, row = TL + b * CTX + t;
      vv[tid] = hy_short(PHY, cw, cb, row, c); x1[tid] = hy_short(PHY, cw, cb, row, HYC + c); x2[tid] = hy_short(PHY, cw, cb, row, 2 * HYC + c);
      const float dl = hy_delta(c);
      for (int q = tid; q < 1024; q += NTHR) { const int od = q >> 8, n = q & 255; float a = 0.f;
          for (int i = 0; i < 64; ++i) a += h2c[n * 64 + i] * w3[(size_t)i * 1024 + od * 256 + c];
          hf[q] = a * __expf(-((float)n / (float)(CTX - 1)) * dl); } }
    __syncthreads();
    { const int b = tid >> 8, t = tid & 255; float y = bias0 * vv[tid];
      for (int s = 0; s <= t; ++s) y += hf[t - s] * vv[b * 256 + s];
      for (int s = t + 1; s < CTX; ++s) y += hf[256 + s - t] * vv[b * 256 + s];
      z1[tid] = x1[tid] * y; }
    __syncthreads();
    { const int b = tid >> 8, t = tid & 255; float y = bias1 * z1[tid];
      for (int s = 0; s <= t; ++s) y += hf[512 + t - s] * z1[b * 256 + s];
      for (int s = t + 1; s < CTX; ++s) y += hf[768 + s - t] * z1[b * 256 + s];
      bf16_t* MIX = (bf16_t*)(P.ws + WS_U); MIX[(size_t)(TL + b * CTX + t) * D + c] = f2bf(x2[tid] * y); }
    __syncthreads();
}
__device__ void hy_task2(const Params& P, int l, int c, float2* X) {
    const int tid = otid();
    const bf16_t* PHY = (const bf16_t*)(P.ws + WS_PHY); const float* cw = P.in[I_HCW] + (size_t)l * 3 * HY_IN; const float* cb = P.in[I_HCB] + (size_t)l * HY_IN;
    const float bias1 = P.in[I_HBIAS][(size_t)l * 2 * HYC + HYC + c];
    const float* Z1 = (const float*)(P.ws + WS_Z1) + (size_t)c * NB * SEQ;
    for (int n = tid; n < SEQ; n += NTHR) { X[n] = make_float2(Z1[n], Z1[SEQ + n]); X[SEQ + n] = make_float2(0.f, 0.f); }
    __syncthreads();
    hy_conv_core(P, 1, c, X);
    bf16_t* MIX = (bf16_t*)(P.ws + WS_U);
    for (int n = tid; n < SEQ; n += NTHR) { const float2 y = X[n];
        const float g0 = hy_short(PHY, cw, cb, n, 2 * HYC + c), g1 = hy_short(PHY, cw, cb, SEQ + n, 2 * HYC + c);
        MIX[(size_t)n * D + c] = f2bf(g0 * (y.x + bias1 * Z1[n])); MIX[(size_t)(SEQ + n) * D + c] = f2bf(g1 * (y.y + bias1 * Z1[SEQ + n])); }
    __syncthreads();
}

constexpr int SEGC = 256, NSEG = 33, SCH = 4;
typedef float f32x2v __attribute__((ext_vector_type(2)));
template <bool IDENT>
__device__ void scan_seg(const Params& P, int chain, int g, float* ring  ) {
    const int lane = otid() & 63;
    const int d = chain & 1, h = (chain >> 1) % 6, b = chain / 12;
    const float* DEC = (const float*)(P.ws + WS_DECAY) + (size_t)d * T * 384; const bf16_t* KKS = (const bf16_t*)(P.ws + WS_KKS); const bf16_t* RS = (const bf16_t*)(P.ws + WS_RS);
    const bf16_t* VS = (const bf16_t*)(P.ws + WS_VS); const bf16_t* KS = (const bf16_t*)(P.ws + WS_KS) + (size_t)d * T * 384; const bf16_t* BS = (const bf16_t*)(P.ws + WS_BS) + (size_t)d * T * 384;
    float* YD = (float*)(P.ws + WS_YDIR) + (size_t)d * T * 384;
    bf16_t* E = (bf16_t*)(P.ws + WS_E) + (size_t)chain * SEQ * 64;
    const int step0 = g == 0 ? 0 : CTX + (g - 1) * SEGC;
    f32x2v S0[32], S1[32];
#pragma unroll
    for (int j = 0; j < 32; ++j) { S0[j] = (f32x2v){0.f, 0.f}; S1[j] = (f32x2v){(2 * j == lane) ? 1.f : 0.f, (2 * j + 1 == lane) ? 1.f : 0.f}; }
    float pw[SCH], pa[SCH], pb[SCH], pk[SCH], pr[SCH], pv[SCH]; size_t po[SCH];
#pragma unroll
    for (int s = 0; s < SCH; ++s) { const size_t o = (size_t)scan_row(b, d, step0 + s) * 384 + h * 64 + lane; po[s] = o;
        pw[s] = DEC[o]; pa[s] = bf2f(KKS[o]); pb[s] = bf2f(BS[o]); pk[s] = bf2f(KS[o]); pr[s] = bf2f(RS[o]); pv[s] = bf2f(VS[o]); }
    for (int c = 0; c < SEGC / SCH; ++c) {
        float cv[SCH]; size_t co[SCH];
        asm volatile("s_waitcnt lgkmcnt(0)" ::: "memory");
#pragma unroll
        for (int s = 0; s < SCH; ++s) { float* sv = ring + s * 320; sv[lane] = pw[s]; sv[64 + lane] = pa[s]; sv[128 + lane] = pb[s]; sv[192 + lane] = pk[s]; sv[256 + lane] = pr[s]; cv[s] = pv[s]; co[s] = po[s]; }
        asm volatile("s_waitcnt lgkmcnt(0)" ::: "memory");
        if (c + 1 < SEGC / SCH) {
#pragma unroll
            for (int s = 0; s < SCH; ++s) { const size_t o = (size_t)scan_row(b, d, step0 + (c + 1) * SCH + s) * 384 + h * 64 + lane; po[s] = o;
                pw[s] = DEC[o]; pa[s] = bf2f(KKS[o]); pb[s] = bf2f(BS[o]); pk[s] = bf2f(KS[o]); pr[s] = bf2f(RS[o]); pv[s] = bf2f(VS[o]); } }
#pragma unroll
        for (int s = 0; s < SCH; ++s) { const float* sv = ring + s * 320;
            f32x2v sa2 = (f32x2v){0.f, 0.f}, sb2 = (f32x2v){0.f, 0.f}, sa3 = sa2, sb3 = sa2;
#pragma unroll
            for (int j = 0; j < 64; j += 4) { const float4 a4 = *(const float4*)(sv + 64 + j); const f32x2v alo = (f32x2v){a4.x, a4.y}, ahi = (f32x2v){a4.z, a4.w};
                sa2 += S0[j / 2] * alo; sa3 += S0[j / 2 + 1] * ahi;
                if (IDENT) { sb2 += S1[j / 2] * alo; sb3 += S1[j / 2 + 1] * ahi; } }
            const float sa = (sa2.x + sa2.y) + (sa3.x + sa3.y), sb = (sb2.x + sb2.y) + (sb3.x + sb3.y);
            const f32x2v saa = (f32x2v){sa, sa}, sbb = (f32x2v){sb, sb}, vv = (f32x2v){cv[s], cv[s]};
            f32x2v y2 = (f32x2v){0.f, 0.f}, y3 = y2, e2 = y2, e3 = y2;
#pragma unroll
            for (int j = 0; j < 64; j += 4) {
                const float4 w4 = *(const float4*)(sv + j), b4 = *(const float4*)(sv + 128 + j), k4 = *(const float4*)(sv + 192 + j), r4 = *(const float4*)(sv + 256 + j);
                const f32x2v wlo = (f32x2v){w4.x, w4.y}, whi = (f32x2v){w4.z, w4.w}, blo = (f32x2v){b4.x, b4.y}, bhi = (f32x2v){b4.z, b4.w};
                const f32x2v klo = (f32x2v){k4.x, k4.y}, khi = (f32x2v){k4.z, k4.w}, rlo = (f32x2v){r4.x, r4.y}, rhi = (f32x2v){r4.z, r4.w};
                S0[j / 2] = S0[j / 2] * wlo + saa * blo + vv * klo; y2 += S0[j / 2] * rlo;
                S0[j / 2 + 1] = S0[j / 2 + 1] * whi + saa * bhi + vv * khi; y3 += S0[j / 2 + 1] * rhi;
                if (IDENT) { S1[j / 2] = S1[j / 2] * wlo + sbb * blo; e2 += S1[j / 2] * rlo; S1[j / 2 + 1] = S1[j / 2 + 1] * whi + sbb * bhi; e3 += S1[j / 2 + 1] * rhi; } }
            YD[co[s]] = (y2.x + y2.y) + (y3.x + y3.y);
            if (IDENT) { const int tl = d ? (SEQ - 1 - (step0 - CTX + c * SCH + s)) : (step0 - CTX + c * SCH + s); E[(size_t)tl * 64 + lane] = f2bf((e2.x + e2.y) + (e3.x + e3.y)); }
        }
    }
    float* ZP = (float*)(P.ws + WS_ZP) + ((size_t)chain * NSEG + g) * 2 * 4096;
#pragma unroll
    for (int j = 0; j < 32; j += 2) { *(float4*)(ZP + lane * 64 + 2 * j) = make_float4(S0[j].x, S0[j].y, S0[j + 1].x, S0[j + 1].y);
        if (IDENT) *(float4*)(ZP + 4096 + lane * 64 + 2 * j) = make_float4(S1[j].x, S1[j].y, S1[j + 1].x, S1[j + 1].y); }
}
__device__ void scan_combine(const Params& P, int chain, float* lds) {
    const int tid = otid(); const int i = tid >> 3, j0 = (tid & 7) * 8;
    float* Sl = lds;
    float* Pl = lds + 64 * 65;
    float* ZPc = (float*)(P.ws + WS_ZP) + (size_t)chain * NSEG * 2 * 4096;
    float sn[8];
#pragma unroll
    for (int q = 0; q < 8; ++q) sn[q] = ZPc[i * 64 + j0 + q];
    for (int g = 1; g < NSEG - 1; ++g) {
        __syncthreads();
#pragma unroll
        for (int q = 0; q < 8; ++q) Sl[i * 65 + j0 + q] = sn[q];
        const float* Pg = ZPc + (size_t)g * 2 * 4096 + 4096;
#pragma unroll
        for (int q = 0; q < 8; ++q) Pl[tid * 8 + q] = Pg[tid * 8 + q];
        float* Zg = ZPc + (size_t)g * 2 * 4096;
#pragma unroll
        for (int q = 0; q < 8; ++q) sn[q] = Zg[i * 64 + j0 + q];
        __syncthreads();
        for (int m = 0; m < 64; ++m) { const float sv = Sl[i * 65 + m]; const float4 p0 = *(const float4*)(Pl + m * 64 + j0), p1 = *(const float4*)(Pl + m * 64 + j0 + 4);
            sn[0] += sv * p0.x; sn[1] += sv * p0.y; sn[2] += sv * p0.z; sn[3] += sv * p0.w; sn[4] += sv * p1.x; sn[5] += sv * p1.y; sn[6] += sv * p1.z; sn[7] += sv * p1.w; }
#pragma unroll
        for (int q = 0; q < 8; ++q) Zg[i * 64 + j0 + q] = sn[q];
    }
    __syncthreads();
}

__device__ __forceinline__ void rwkv_out_store(const Params& P, int l, int row, int h, int lane, float y) {
    const int c = h * 64 + lane; const size_t o = (size_t)row * 384 + c;
    const bf16_t* VS = (const bf16_t*)(P.ws + WS_VS); const bf16_t* GT = (const bf16_t*)(P.ws + WS_GATE); const float* BON = (const float*)(P.ws + WS_BONUS); bf16_t* MIX = (bf16_t*)(P.ws + WS_U);
    const float mean = wsum(y) * (1.0f / 64.0f); const float dv = y - mean; const float var = wsum(dv * dv) * (1.0f / 64.0f);
    const float yn = dv * rsqrtf(var + 64e-5f) * P.in[I_LNW][l * RWW + c] + P.in[I_LNB][l * RWW + c];
    MIX[(size_t)row * D + 256 + c] = f2bf((yn + BON[(size_t)row * 6 + h] * bf2f(VS[o])) * bf2f(GT[o]));
}
constexpr int OCH = 8;
__device__ void ph_rwkvout(const Params& P, int l, float* ldsf) {
    const int tid = otid(), lane = tid & 63, wv = tid >> 6, gw = blockIdx.x * NWAVE + wv, nw = gridDim.x * NWAVE;
    const float* YD = (const float*)(P.ws + WS_YDIR);
    float* est = ldsf + wv * (OCH * 128);
    for (int it = gw; it < NB * 6 * 32 * 4; it += nw) {
        const int sub = it & 3, q = (it >> 2) & 31, h = (it >> 7) % 6, b = it / (128 * 6);
        const int chf = b * 12 + h * 2, chb = chf + 1;
        const float* Sfp = (const float*)(P.ws + WS_ZP) + ((size_t)chf * NSEG + q) * 2 * 4096 + lane * 64;
        const float* Sbp = (const float*)(P.ws + WS_ZP) + ((size_t)chb * NSEG + (31 - q)) * 2 * 4096 + lane * 64;
        float Sf[64], Sb[64];
#pragma unroll
        for (int j = 0; j < 64; j += 4) { const float4 a = *(const float4*)(Sfp + j), c4 = *(const float4*)(Sbp + j);
            Sf[j] = a.x; Sf[j + 1] = a.y; Sf[j + 2] = a.z; Sf[j + 3] = a.w; Sb[j] = c4.x; Sb[j + 1] = c4.y; Sb[j + 2] = c4.z; Sb[j + 3] = c4.w; }
        const bf16_t* Ef = (const bf16_t*)(P.ws + WS_E) + (size_t)chf * SEQ * 64; const bf16_t* Eb = (const bf16_t*)(P.ws + WS_E) + (size_t)chb * SEQ * 64;
        const int t0 = q * 256 + sub * 64;
        for (int tg = 0; tg < 64; tg += OCH) {
            asm volatile("s_waitcnt lgkmcnt(0)" ::: "memory");
#pragma unroll
            for (int s = 0; s < OCH; ++s) { const int t = t0 + tg + s; est[s * 128 + lane] = bf2f(Ef[(size_t)t * 64 + lane]); est[s * 128 + 64 + lane] = bf2f(Eb[(size_t)t * 64 + lane]); }
            asm volatile("s_waitcnt lgkmcnt(0)" ::: "memory");
#pragma unroll 1
            for (int s = 0; s < OCH; ++s) { const int t = t0 + tg + s, row = b * SEQ + t; const size_t o = (size_t)row * 384 + h * 64 + lane;
                float c0 = 0.f, c1 = 0.f, c2 = 0.f, c3 = 0.f;
#pragma unroll
                for (int j = 0; j < 64; j += 4) { const float4 ef = *(const float4*)(est + s * 128 + j), eb = *(const float4*)(est + s * 128 + 64 + j);
                    c0 += Sf[j] * ef.x + Sb[j] * eb.x; c1 += Sf[j + 1] * ef.y + Sb[j + 1] * eb.y; c2 += Sf[j + 2] * ef.z + Sb[j + 2] * eb.z; c3 += Sf[j + 3] * ef.w + Sb[j + 3] * eb.w;
                    if ((j & 15) == 12) asm volatile("" ::: "memory"); }
                const float y = YD[o] + YD[(size_t)T * 384 + o] + ((c0 + c1) + (c2 + c3));
                rwkv_out_store(P, l, row, h, lane, y); }
        }
    }
    for (int it = gw; it < TC * 6; it += nw) { const int row = TL + it / 6, h = it % 6; const size_t o = (size_t)row * 384 + h * 64 + lane;
        rwkv_out_store(P, l, row, h, lane, YD[o] + YD[(size_t)T * 384 + o]); }
}

typedef const __attribute__((address_space(4))) Params* KParamsPtr;
__device__ __forceinline__ const Params* fresh_params() { KParamsPtr q = (KParamsPtr)__builtin_amdgcn_kernarg_segment_ptr(); asm volatile("" : "+s"(q)); return (const Params*)q; }
__global__ void __launch_bounds__(NTHR, 2) fwd_megakernel(Params P_unused, int ph_lo, int ph_hi) {
    extern __shared__ __attribute__((aligned(16))) unsigned char smem[];
    cg::grid_group grid = cg::this_grid();
    LAS unsigned char* lds3 = (LAS unsigned char*)smem;
    float* ldsf = (float*)smem; float2* X = (float2*)smem; float* ex = (float*)(smem + LDS_MAIN);
    int ph = 0;
#define PHASE_BEGIN if (ph >= ph_lo && ph < ph_hi) { const Params& P = *fresh_params(); unsigned char* ws = P.ws; (void)ws;
#define PHASE_END   if (ph + 1 < ph_hi) grid.sync(); } ++ph;
    PHASE_BEGIN ph_modv(P, ldsf); PHASE_END
    for (int l = 0; l < DEPTH; ++l) {
        PHASE_BEGIN
            ph_prep(P, l, ldsf);
            if (l == 0) ph_rowpass(P, 0, 0, 0, 0, 0.f, 0, 0, 0, 1);
            else ph_rowpass(P, 1, l - 1, 8, 5, 0.5f, l, 0, 0, 1);
        PHASE_END
        PHASE_BEGIN { EpiGU E{(bf16_t*)(ws + WS_ACT)}; run_gemm(lds3, (const bf16_t*)(ws + WS_U), (const bf16_t*)(ws + WS_WGU1), T, 2 * DFF, D, E); } PHASE_END
        PHASE_BEGIN { EpiF32 E{(float*)(ws + WS_Y)}; run_gemm(lds3, (const bf16_t*)(ws + WS_ACT), (const bf16_t*)(ws + WS_WDN1), T, D, DFF, E); } PHASE_END
        PHASE_BEGIN ph_rowpass(P, 1, l, 2, 1, 0.5f, l, 2, 3, 4); PHASE_END
        PHASE_BEGIN { EpiWin E{(bf16_t*)(ws + WS_PHY), (bf16_t*)(ws + WS_PRW), (bf16_t*)(ws + WS_PNA)}; run_gemm(lds3, (const bf16_t*)(ws + WS_U), (const bf16_t*)(ws + WS_WIN), T, INWP, D, E); } PHASE_END
        PHASE_BEGIN
            ph_loraprep(P, l);
            for (int it = blockIdx.x; it < 512; it += gridDim.x) hy_spec_task(P, l, it >> 8, it & 255, X, ex);
        PHASE_END
        PHASE_BEGIN { EpiLora E{(bf16_t*)(ws + WS_LORAO), (bf16_t*)(ws + WS_GATE)};
            run_gemm(lds3, (const bf16_t*)(ws + WS_ALORA), (const bf16_t*)(ws + WS_WLORA), T, 2048, 384, E); } PHASE_END
        PHASE_BEGIN
            ph_rwkvprep(P, l);
            for (int c = blockIdx.x; c < HYC; c += gridDim.x) hy_task1(P, l, c, X, ex);
        PHASE_END
        PHASE_BEGIN {
            const int wv = otid() >> 6;
            if (wv < 4) { const int k = wv * (int)gridDim.x + (int)blockIdx.x;
                if (k < 24 * NSEG) { const int chain = k / NSEG, g = k % NSEG; float* ring = ldsf + wv * (SCH * 320);
                    if (g == 0) scan_seg<false>(P, chain, g, ring); else scan_seg<true>(P, chain, g, ring); } }
            else natten_items_v1(P, l, (int)blockIdx.x * 256 + (otid() - 256), (int)gridDim.x * 256);
        } PHASE_END
        PHASE_BEGIN
            if (blockIdx.x < 24) scan_combine(P, blockIdx.x, ldsf);
            else for (int c = blockIdx.x - 24; c < HYC; c += gridDim.x - 24) hy_task2(P, l, c, X);
        PHASE_END
        PHASE_BEGIN ph_rwkvout(P, l, ldsf); PHASE_END
        PHASE_BEGIN { EpiF32 E{(float*)(ws + WS_Y)}; run_gemm(lds3, (const bf16_t*)(ws + WS_U), (const bf16_t*)(ws + WS_WOUT), T, D, D, E); } PHASE_END
        PHASE_BEGIN ph_rowpass(P, 1, l, 5, 3, 1.0f, l, 4, 6, 7); PHASE_END
        PHASE_BEGIN { EpiGU E{(bf16_t*)(ws + WS_ACT)}; run_gemm(lds3, (const bf16_t*)(ws + WS_U), (const bf16_t*)(ws + WS_WGU2), T, 2 * DFF, D, E); } PHASE_END
        PHASE_BEGIN { EpiF32 E{(float*)(ws + WS_Y)}; run_gemm(lds3, (const bf16_t*)(ws + WS_ACT), (const bf16_t*)(ws + WS_WDN2), T, D, DFF, E); } PHASE_END
    }
    PHASE_BEGIN ph_rowpass(P, 2, DEPTH - 1, 8, 5, 0.5f, 0, 0, 0, 0); PHASE_END
#undef PHASE_BEGIN
#undef PHASE_END
}
constexpr int N_PHASES = 1 + DEPTH * 15 + 1;

extern "C" void kernel_launch(void* const* d_in, const int* in_sizes, int n_in, void* d_out, int out_size, void* d_ws, size_t ws_size, hipStream_t stream) {
    static int grid = 0;
    if (grid == 0) {
        if (n_in != 34 || ws_size < WS_END) { fprintf(stderr, "kernel_launch: need 34 inputs and %zu bytes of workspace; got %d, %zu\n", (size_t)WS_END, n_in, ws_size); grid = -1; return; }
        int dev = 0, cus = 0, per_cu = 0;
        hipGetDevice(&dev); hipDeviceGetAttribute(&cus, hipDeviceAttributeMultiprocessorCount, dev);
        if (hipFuncSetAttribute((const void*)fwd_megakernel, hipFuncAttributeMaxDynamicSharedMemorySize, LDS_BYTES) != hipSuccess) { fprintf(stderr, "kernel_launch: hipFuncSetAttribute failed\n"); grid = -1; return; }
        if (hipOccupancyMaxActiveBlocksPerMultiprocessor(&per_cu, (const void*)fwd_megakernel, NTHR, LDS_BYTES) != hipSuccess || per_cu < 1) { fprintf(stderr, "kernel_launch: occupancy query says %d\n", per_cu); per_cu = 1; }
        (void)hipGetLastError();
        grid = cus;
    }
    if (grid < 0) return;
    Params p{};
    for (int i = 0; i < 34; ++i) p.in[i] = (const float*)d_in[i];
    p.out = (float*)d_out; p.ws = (unsigned char*)d_ws;
#if MK_SPLIT
    for (int ph = 0; ph < N_PHASES; ++ph) { int lo = ph, hi = ph + 1; hipLaunchKernelGGL(fwd_megakernel, dim3(grid), dim3(NTHR), LDS_BYTES, stream, p, lo, hi); }
#else
    int lo = 0, hi = N_PHASES;
    void* args[] = {&p, &lo, &hi};
    hipError_t e = hipLaunchCooperativeKernel((const void*)fwd_megakernel, dim3(grid), dim3(NTHR), args, LDS_BYTES, stream);
    if (e != hipSuccess) fprintf(stderr, "cooperative launch failed: %s (grid %d)\n", hipGetErrorString(e), grid);
#endif
}
```

```cpp
#include <hip/hip_runtime.h>
#include <hip/hip_cooperative_groups.h>
#include <cstdio>
namespace cg = cooperative_groups;
__device__ __forceinline__ int otid() { int t = threadIdx.x; asm volatile("" : "+v"(t)); return t; }
namespace pg8 {
#define PG8_LAS __attribute__((address_space(3)))
typedef unsigned short bf16_t;
typedef short bf16x8 __attribute__((ext_vector_type(8)));
typedef float f32x4 __attribute__((ext_vector_type(4)));
typedef unsigned u32x4 __attribute__((ext_vector_type(4)));
constexpr int BM = 256, BK = 64, HALF = 128, HTB = HALF * BK * 2  , STAGE_BYTES = 8 * HTB, NXCD = 8, WGM = 8;

__host__ __device__ __forceinline__ int lds_byte(int r, int c) { const int st = (r >> 4) * 2 + (c >> 5), rr = r & 15, cc = c & 31, ob = rr * 64 + cc * 2; return st * 1024 + (ob ^ (((ob >> 9) & 1) << 5)); }
__host__ __device__ __forceinline__ void stage_rc(int b, int& R, int& C) { const int st = b / 1024, sb = b % 1024, swz = sb ^ (((sb >> 9) & 1) << 5); R = (st >> 1) * 16 + swz / 64; C = (st & 1) * 32 + (swz % 64) / 2; }
__host__ __device__ __forceinline__ int perm32(int rho) { const int n = rho >> 4, i = rho & 15; return 8 * (i >> 2) + 4 * n + (i & 3); }

struct Unit { int pm, pn; };
struct Gemm { const bf16_t* A; const bf16_t* Bt; int M, N, K; };
struct StaticOrder {
    int nM, nN, nwg, G, c;
    __host__ __device__ void init(int M, int N, int G_, int c_) { nM = M / BM; nN = N / BM; nwg = nM * nN; G = G_; c = c_; }
    __host__ __device__ bool next(int i, Unit& u) const {
        const long L = (long)i * G + c; if (L >= nwg) return false;
        int wgid = (int)L; { const int q = nwg / NXCD, r = nwg % NXCD, xcd = wgid % NXCD, off = wgid / NXCD; wgid = (xcd < r ? xcd * (q + 1) : r * (q + 1) + (xcd - r) * q) + off; }
        const int nig = WGM * nN, gid = wgid / nig, fm = gid * WGM, gsz = (nM - fm) < WGM ? (nM - fm) : WGM;
        u.pm = fm + ((wgid % nig) % gsz); u.pn = (wgid % nig) / gsz; return true;
    }
    __device__ __forceinline__ void a_ready(const Unit&) const {}
    __device__ __forceinline__ void done(const Unit&) const {}
};
__device__ __forceinline__ unsigned cvt_pk_bf16(float lo, float hi) { unsigned r; asm volatile("v_cvt_pk_bf16_f32 %0, %1, %2" : "=v"(r) : "v"(lo), "v"(hi)); return r; }
template <class Epi, class Sched>
__device__ __forceinline__ void gemm_phase(PG8_LAS unsigned char* lds, const Gemm g, const Sched& S, const Epi& E) {
    const int tid = otid(), wid = __builtin_amdgcn_readfirstlane(tid >> 6), lane = tid & 63, wr = wid >> 2, wc = wid & 3, fr = lane & 15, fq = lane >> 4;
    const int K = g.K, nt = K / BK;
#define PG8_STAMP() do {} while (0)
    unsigned voffA[2], voffB[2];
#pragma unroll
    for (int i = 0; i < 2; ++i) { int R, C; stage_rc(tid * 16 + i * 8192, R, C); const int Rb = Epi::PERM ? ((R & ~31) + perm32(R & 31)) : R;
        voffA[i] = (unsigned)(R * K + C) * 2u; voffB[i] = (unsigned)(Rb * K + C) * 2u; }
    const size_t kstep = (size_t)(BK * 2);
    const size_t hstep = (size_t)HALF * K * 2;
    const size_t tstep = 2 * hstep;
    const unsigned ldsw = (unsigned)wid * 1024u;
    const int aoff = lds_byte(wr * 64 + fr, fq * 8), boff = lds_byte(wc * 32 + fr, fq * 8);
#define PG8_SA(b, h) (((b) * 2 + (h)) * HTB)
#define PG8_SB(b, h) ((4 + (b) * 2 + (h)) * HTB)
#define PG8_STAGE(bufoff, gbase, voff) do { _Pragma("unroll") for (int _i = 0; _i < 2; ++_i) \
        __builtin_amdgcn_global_load_lds((const unsigned*)((const char*)(gbase) + (voff)[_i]), (PG8_LAS unsigned*)(lds + (bufoff) + ldsw + _i * 8192), 16, 0, 0); } while (0)
#define PG8_LDA(dst, b, h) do { _Pragma("unroll") for (int m = 0; m < 4; ++m) _Pragma("unroll") for (int k = 0; k < 2; ++k) dst[m][k] = *(const PG8_LAS bf16x8*)(lds + PG8_SA(b, h) + aoff + m * 2048 + k * 1024); } while (0)
#define PG8_LDB(dst, b, h) do { _Pragma("unroll") for (int n = 0; n < 2; ++n) _Pragma("unroll") for (int k = 0; k < 2; ++k) dst[n][k] = *(const PG8_LAS bf16x8*)(lds + PG8_SB(b, h) + boff + n * 2048 + k * 1024); } while (0)
#define PG8_MMA(ai, bj, At, Bt) do { __builtin_amdgcn_s_setprio(1); _Pragma("unroll") for (int m = 0; m < 4; ++m) _Pragma("unroll") for (int n = 0; n < 2; ++n) _Pragma("unroll") for (int k = 0; k < 2; ++k) \
        acc[ai][bj][m][n] = __builtin_amdgcn_mfma_f32_16x16x32_bf16(Bt[n][k], At[m][k], acc[ai][bj][m][n], 0, 0, 0); __builtin_amdgcn_s_setprio(0); } while (0)
#define PG8_WAIT_V(n) asm volatile("s_waitcnt vmcnt(" #n ")" ::: "memory")
#define PG8_WAIT_L(n) asm volatile("s_waitcnt lgkmcnt(" #n ")" ::: "memory")
#define PG8_BAR __builtin_amdgcn_s_barrier()
#define PG8_SCHED __builtin_amdgcn_sched_barrier(0)
    Unit cur, nxt; int ui = 0;
    if (!S.next(0, cur)) return;
    f32x4 acc[2][2][4][2];
#pragma unroll
    for (int a = 0; a < 2; ++a)
#pragma unroll
        for (int b = 0; b < 2; ++b)
#pragma unroll
            for (int m = 0; m < 4; ++m)
#pragma unroll
                for (int n = 0; n < 2; ++n) acc[a][b][m][n] = (f32x4){0.f, 0.f, 0.f, 0.f};
    bf16x8 At[4][2], B0[2][2], B1[2][2];
    const char* cA = (const char*)g.A + (size_t)cur.pm * tstep; const char* cB = (const char*)g.Bt + (size_t)cur.pn * tstep;
    S.a_ready(cur);
    PG8_STAGE(PG8_SB(0, 0), cB, voffB); PG8_STAGE(PG8_SA(0, 0), cA, voffA); PG8_STAGE(PG8_SB(0, 1), cB + hstep, voffB); PG8_STAGE(PG8_SA(0, 1), cA + hstep, voffA);
    if (wr == 1) PG8_BAR;
    PG8_WAIT_V(4); PG8_BAR;
    PG8_STAGE(PG8_SB(1, 0), cB + kstep, voffB); PG8_STAGE(PG8_SA(1, 0), cA + kstep, voffA); PG8_STAGE(PG8_SB(1, 1), cB + hstep + kstep, voffB);
    PG8_WAIT_V(6); PG8_BAR;
    PG8_STAMP();
    for (;;) {
        const bool has_next = S.next(ui + 1, nxt);
        const char* nA = has_next ? (const char*)g.A + (size_t)nxt.pm * tstep : cA; const char* nB = has_next ? (const char*)g.Bt + (size_t)nxt.pn * tstep : cB;
        for (int t = 0; t < nt; t += 2) {
            const bool last = (t == nt - 2);
            const char* a1 = cA + (size_t)(t + 1) * kstep;
            const char* a2 = last ? nA : cA + (size_t)(t + 2) * kstep; const char* b2 = last ? nB : cB + (size_t)(t + 2) * kstep;
            const char* a3 = a2 + kstep; const char* b3 = b2 + kstep;
            if (last && has_next) S.a_ready(nxt);
            PG8_LDB(B0, 0, 0); PG8_SCHED; PG8_LDA(At, 0, 0); PG8_STAGE(PG8_SA(1, 1), a1 + hstep, voffA);
            PG8_WAIT_L(8); PG8_BAR; PG8_WAIT_L(0); PG8_MMA(0, 0, At, B0); PG8_BAR; PG8_SCHED;
            PG8_LDB(B1, 0, 1); PG8_STAGE(PG8_SB(0, 0), b2, voffB);
            PG8_BAR; PG8_WAIT_L(0); PG8_MMA(0, 1, At, B1); PG8_BAR;
            PG8_LDA(At, 0, 1); PG8_STAGE(PG8_SA(0, 0), a2, voffA);
            PG8_BAR; PG8_WAIT_L(0); PG8_MMA(1, 0, At, B0); PG8_BAR; PG8_SCHED;
            PG8_STAGE(PG8_SB(0, 1), b2 + hstep, voffB);
            PG8_WAIT_V(6); PG8_BAR; PG8_MMA(1, 1, At, B1); PG8_BAR;
            PG8_LDB(B0, 1, 0); PG8_SCHED; PG8_LDA(At, 1, 0); PG8_STAGE(PG8_SA(0, 1), a2 + hstep, voffA);
            PG8_WAIT_L(8); PG8_BAR; PG8_WAIT_L(0); PG8_MMA(0, 0, At, B0); PG8_BAR; PG8_SCHED;
            PG8_LDB(B1, 1, 1); PG8_STAGE(PG8_SB(1, 0), b3, voffB);
            PG8_BAR; PG8_WAIT_L(0); PG8_MMA(0, 1, At, B1); PG8_BAR;
            PG8_LDA(At, 1, 1); PG8_STAGE(PG8_SA(1, 0), a3, voffA);
            PG8_BAR; PG8_WAIT_L(0); PG8_MMA(1, 0, At, B0); PG8_BAR; PG8_SCHED;
            PG8_STAGE(PG8_SB(1, 1), b3 + hstep, voffB);
            PG8_WAIT_V(6); PG8_BAR; PG8_MMA(1, 1, At, B1); PG8_BAR;
        }
        PG8_STAMP();
        if constexpr (!Epi::AFTER_DRAIN) { E(acc, cur, wr, wc, fr, fq); S.done(cur); }
        PG8_STAMP();
        if (!has_next) break;
#pragma unroll
        for (int a = 0; a < 2; ++a)
#pragma unroll
            for (int b = 0; b < 2; ++b)
#pragma unroll
                for (int m = 0; m < 4; ++m)
#pragma unroll
                    for (int n = 0; n < 2; ++n) acc[a][b][m][n] = (f32x4){0.f, 0.f, 0.f, 0.f};
        cur = nxt; cA = nA; cB = nB; ++ui;
    }
    PG8_WAIT_V(0);
    if (wr == 0) PG8_BAR;
    PG8_BAR;
    if constexpr (Epi::AFTER_DRAIN) { E.fused(acc, cur, wr, wc, fr, fq, lds, wid, lane); S.done(cur); }
    PG8_STAMP();
#undef PG8_STAMP
#undef PG8_SA
#undef PG8_SB
#undef PG8_STAGE
#undef PG8_LDA
#undef PG8_LDB
#undef PG8_MMA
#undef PG8_WAIT_V
#undef PG8_WAIT_L
#undef PG8_BAR
#undef PG8_SCHED
}
}

using pg8::bf16_t; using pg8::f32x4; using pg8::u32x4; using pg8::cvt_pk_bf16;
typedef unsigned u32x2 __attribute__((ext_vector_type(2)));
#define LAS __attribute__((address_space(3)))

constexpr int D = 1024, NB = 2, SEQ = 8192, DEPTH = 4, CTX = 256, DFF = 2816;
constexpr int TL = NB * SEQ, TC = NB * CTX, T = TL + TC;
constexpr int NMOD = 9 * D;
constexpr int HYC = 256, RWW = 384, NAW = 384, INW = 3456, INWP = 3584;
constexpr int HY_IN = 768, RW_IN = 1536, NA_IN = 1152;
constexpr int NFFT = 16384;
constexpr int NTHR = 512, NWAVE = 8;
constexpr int LDS_MAIN = 131072, LDS_EXTRA = 8192, LDS_BYTES = LDS_MAIN + LDS_EXTRA;
constexpr float NORM_EPS = 1e-6f;

constexpr size_t al256(size_t x) { return (x + 255) & ~(size_t)255; }
constexpr size_t WS_MODV = 0;
constexpr size_t WS_WGU1 = al256(WS_MODV + (size_t)DEPTH * 3 * NMOD * 4);
constexpr size_t WS_WDN1 = WS_WGU1 + (size_t)2 * DFF * D * 2;
constexpr size_t WS_WGU2 = WS_WDN1 + (size_t)D * DFF * 2;
constexpr size_t WS_WDN2 = WS_WGU2 + (size_t)2 * DFF * D * 2;
constexpr size_t WS_WIN = WS_WDN2 + (size_t)D * DFF * 2;
constexpr size_t WS_WOUT = WS_WIN + (size_t)INWP * D * 2;
constexpr size_t WS_WLORA = WS_WOUT + (size_t)D * D * 2;
constexpr size_t WS_H = WS_WLORA + (size_t)2048 * 384 * 2;
constexpr size_t WS_U = WS_H + (size_t)T * D * 4;
constexpr size_t WS_S = WS_U + (size_t)T * D * 2;
constexpr size_t WS_Y = WS_S;
constexpr size_t WS_ACT = WS_Y + (size_t)T * D * 4;
constexpr size_t WS_FFN_END = WS_ACT + (size_t)T * DFF * 2;
constexpr size_t WS_PHY = WS_S;
constexpr size_t WS_PRW = WS_PHY + (size_t)T * HY_IN * 2;
constexpr size_t WS_YDIR = WS_PRW;
constexpr size_t WS_PNA = WS_PRW + (size_t)T * RW_IN * 2;
constexpr size_t WS_ALORA = WS_PNA + (size_t)T * NA_IN * 2;
constexpr size_t WS_DECAY = WS_ALORA + (size_t)T * 384 * 2;
constexpr size_t WS_LORAO = WS_DECAY + (size_t)2 * T * 384 * 4;
constexpr size_t WS_E = WS_LORAO;
constexpr size_t WS_ZP = WS_E + (size_t)24 * SEQ * 64 * 2;
constexpr size_t WS_GATE = WS_LORAO + (size_t)T * 1536 * 2;
static_assert(WS_ZP + (size_t)24 * 33 * 2 * 4096 * 4 <= WS_GATE, "E + ZP must fit in the LORAO region");
constexpr size_t WS_RS = WS_GATE + (size_t)T * 384 * 2;
constexpr size_t WS_KKS = WS_RS + (size_t)T * 384 * 2;
constexpr size_t WS_VS = WS_KKS + (size_t)T * 384 * 2;
constexpr size_t WS_KS = WS_VS + (size_t)T * 384 * 2;
constexpr size_t WS_BS = WS_KS + (size_t)2 * T * 384 * 2;
constexpr size_t WS_BONUS = WS_BS + (size_t)2 * T * 384 * 2;
constexpr size_t WS_H2 = al256(WS_BONUS + (size_t)T * 6 * 4);
constexpr size_t WS_SPEC = WS_H2 + (size_t)(SEQ + CTX) * 64 * 4;
constexpr size_t WS_Z1 = WS_SPEC + (size_t)512 * NFFT * 8;
constexpr size_t WS_VTL = WS_Z1 + (size_t)HYC * NB * SEQ * 4;
constexpr size_t WS_VTC = WS_VTL + (size_t)NB * 6 * 64 * SEQ * 2;
constexpr size_t WS_MIX_END = WS_VTC + (size_t)NB * 6 * 64 * CTX * 2;
constexpr size_t WS_END = WS_MIX_END > WS_FFN_END ? WS_MIX_END : WS_FFN_END;

struct Params { const float* in[34]; float* out; unsigned char* ws; };
enum { I_X = 0, I_C, I_CTX, I_CCTX, I_MODW, I_MODB, I_NORMG, I_F1GU, I_F1DN, I_F2GU, I_F2DN, I_WIN, I_WOUT, I_HCW, I_HCB, I_HW1, I_HB1, I_HW2, I_HB2, I_HW3, I_HFREQ, I_HBIAS,
       I_MU, I_W0, I_W2, I_A0, I_A2, I_G2, I_KK, I_KA, I_RK, I_LNW, I_LNB, I_RPB };

__device__ __forceinline__ float bf2f(bf16_t b) { return __uint_as_float(((unsigned)b) << 16); }
__device__ __forceinline__ bf16_t f2bf(float f) { unsigned u = __float_as_uint(f); u += 0x7FFFu + ((u >> 16) & 1u); return (bf16_t)(u >> 16); }
__device__ __forceinline__ float lo_bf(unsigned w) { return __uint_as_float(w << 16); }
__device__ __forceinline__ float hi_bf(unsigned w) { return __uint_as_float(w & 0xffff0000u); }
__device__ __forceinline__ float wsum(float v) {
#pragma unroll
    for (int o = 32; o > 0; o >>= 1) v += __shfl_xor(v, o);
    return v;
}
__device__ __forceinline__ float sigmoidf_(float x) { return __builtin_amdgcn_rcpf(1.0f + __expf(-x)); }
__device__ __forceinline__ void unpack8(const u32x4 w, float (&f)[8]) {
    f[0] = lo_bf(w.x); f[1] = hi_bf(w.x); f[2] = lo_bf(w.y); f[3] = hi_bf(w.y); f[4] = lo_bf(w.z); f[5] = hi_bf(w.z); f[6] = lo_bf(w.w); f[7] = hi_bf(w.w);
}
__device__ __forceinline__ void row_nbrs(int row, bool& hasp, bool& hasn) {
    if (row < TL) { const int t = row & (SEQ - 1); hasp = t > 0; hasn = t < SEQ - 1; }
    else { const int t = (row - TL) & (CTX - 1); hasp = t > 0; hasn = t < CTX - 1; }
}

__device__ void ph_modv(const Params& P, float* lds) {
    const int tid = otid();
    float* sv = lds;
    float* red = lds + 3072;
    for (int i = tid; i < 3072; i += NTHR) { const int s = i >> 10, k = i & 1023; const float c = s < 2 ? P.in[I_C][s * 1024 + k] : P.in[I_CCTX][k]; sv[i] = c / (1.0f + expf(-c)); }
    __syncthreads();
    float* modv = (float*)(P.ws + WS_MODV);
    const int kc = tid >> 6, cl = tid & 63;
    for (int item = blockIdx.x; item < DEPTH * 144; item += gridDim.x) {
        const int l = item / 144, cb = item % 144, col = cb * 64 + cl;
        const float* w = P.in[I_MODW] + ((size_t)l * 1024 + kc * 128) * NMOD + col;
        float a0 = 0.f, a1 = 0.f, a2 = 0.f;
#pragma unroll 8
        for (int k = 0; k < 128; ++k) { const float wv = w[(size_t)k * NMOD]; a0 += sv[kc * 128 + k] * wv; a1 += sv[1024 + kc * 128 + k] * wv; a2 += sv[2048 + kc * 128 + k] * wv; }
        red[(0 * 8 + kc) * 64 + cl] = a0; red[(1 * 8 + kc) * 64 + cl] = a1; red[(2 * 8 + kc) * 64 + cl] = a2;
        __syncthreads();
        if (tid < 192) { const int s = tid >> 6, c = tid & 63; float r = P.in[I_MODB][l * NMOD + cb * 64 + c];
#pragma unroll
            for (int q = 0; q < 8; ++q) r += red[(s * 8 + q) * 64 + c];
            modv[((size_t)l * 3 + s) * NMOD + cb * 64 + c] = r; }
        __syncthreads();
    }
}

__device__ __forceinline__ int rowmap_gu(int n) { const int up = n >= DFF ? 1 : 0; const int j = n - up * DFF; return (j >> 7) * 256 + up * 128 + (j & 127); }
__device__ void conv_tile(const float* __restrict__ src, int K, int N, bf16_t* __restrict__ dst, int tk, int tn, bool gu, float* tile) {
    const int tid = otid(); const int k0 = tk * 64, n0 = tn * 64;
#pragma unroll
    for (int rr = 0; rr < 2; ++rr) { const int kk = (tid >> 4) + rr * 32, n4 = (tid & 15) * 4; const float4 v = *(const float4*)(src + (size_t)(k0 + kk) * N + n0 + n4);
        tile[kk * 65 + n4 + 0] = v.x; tile[kk * 65 + n4 + 1] = v.y; tile[kk * 65 + n4 + 2] = v.z; tile[kk * 65 + n4 + 3] = v.w; }
    __syncthreads();
    { const int nn = tid >> 3, ks = (tid & 7) * 8; const int n = n0 + nn; const int row = gu ? rowmap_gu(n) : n;
      u32x4 w; w.x = cvt_pk_bf16(tile[(ks + 0) * 65 + nn], tile[(ks + 1) * 65 + nn]); w.y = cvt_pk_bf16(tile[(ks + 2) * 65 + nn], tile[(ks + 3) * 65 + nn]);
      w.z = cvt_pk_bf16(tile[(ks + 4) * 65 + nn], tile[(ks + 5) * 65 + nn]); w.w = cvt_pk_bf16(tile[(ks + 6) * 65 + nn], tile[(ks + 7) * 65 + nn]);
      *(u32x4*)(dst + (size_t)row * K + k0 + ks) = w; }
    __syncthreads();
}
__device__ void ph_prep(const Params& P, int l, float* lds) {
    const int tid = otid();
    unsigned char* ws = P.ws;
    constexpr int N0 = 16 * 88, N1 = 44 * 16, N4 = 16 * 54, N5 = 16 * 16;
    constexpr int C0 = N0, C1 = C0 + N1, C2 = C1 + N0, C3 = C2 + N1, C4 = C3 + N4, C5 = C4 + N5;
    for (int it = blockIdx.x; it < C5; it += gridDim.x) {
        if (it < C0) { conv_tile(P.in[I_F1GU] + (size_t)l * D * 2 * DFF, D, 2 * DFF, (bf16_t*)(ws + WS_WGU1), it / 88, it % 88, true, lds); }
        else if (it < C1) { const int j = it - C0; conv_tile(P.in[I_F1DN] + (size_t)l * DFF * D, DFF, D, (bf16_t*)(ws + WS_WDN1), j / 16, j % 16, false, lds); }
        else if (it < C2) { const int j = it - C1; conv_tile(P.in[I_F2GU] + (size_t)l * D * 2 * DFF, D, 2 * DFF, (bf16_t*)(ws + WS_WGU2), j / 88, j % 88, true, lds); }
        else if (it < C3) { const int j = it - C2; conv_tile(P.in[I_F2DN] + (size_t)l * DFF * D, DFF, D, (bf16_t*)(ws + WS_WDN2), j / 16, j % 16, false, lds); }
        else if (it < C4) { const int j = it - C3; conv_tile(P.in[I_WIN] + (size_t)l * D * INW, D, INW, (bf16_t*)(ws + WS_WIN), j / 54, j % 54, false, lds); }
        else { const int j = it - C4; conv_tile(P.in[I_WOUT] + (size_t)l * D * D, D, D, (bf16_t*)(ws + WS_WOUT), j / 16, j % 16, false, lds); }
    }
    const int gtid = blockIdx.x * NTHR + tid, gn = gridDim.x * NTHR;
    { unsigned* z = (unsigned*)(ws + WS_WIN + (size_t)INW * D * 2); for (int i = gtid; i < (INWP - INW) * D / 2; i += gn) z[i] = 0u; }
    { bf16_t* wl = (bf16_t*)(ws + WS_WLORA);
      const float* w2 = P.in[I_W2] + (size_t)l * 2 * 64 * RWW; const float* a2 = P.in[I_A2] + (size_t)l * 2 * 64 * RWW; const float* g2 = P.in[I_G2] + (size_t)l * 128 * RWW;
      for (int i = gtid; i < 2048 * 384; i += gn) { const int k = i / 2048, j = i % 2048; float v = 0.f;
          if (j < 1920) { const int grp = j / 384, c = j % 384;
              if (grp == 0) { if (k < 64) v = w2[(size_t)k * RWW + c]; }
              else if (grp == 1) { if (k >= 64 && k < 128) v = w2[(size_t)(64 + k - 64) * RWW + c]; }
              else if (grp == 2) { if (k >= 128 && k < 192) v = a2[(size_t)(k - 128) * RWW + c]; }
              else if (grp == 3) { if (k >= 192 && k < 256) v = a2[(size_t)(64 + k - 192) * RWW + c]; }
              else { if (k >= 256) v = g2[(size_t)(k - 256) * RWW + c]; } }
          wl[(size_t)j * 384 + k] = f2bf(v); } }
    { float* h2 = (float*)(ws + WS_H2);
      const float* w1 = P.in[I_HW1] + (size_t)l * 33 * 64; const float* b1 = P.in[I_HB1] + l * 64; const float* w2f = P.in[I_HW2] + (size_t)l * 64 * 64; const float* b2 = P.in[I_HB2] + l * 64;
      const float* fqv = P.in[I_HFREQ] + l * 64;
      const int lane = tid & 63, gw = blockIdx.x * NWAVE + (tid >> 6), nw = gridDim.x * NWAVE;
      const float fq = fqv[lane], bb1 = b1[lane], bb2 = b2[lane];
      for (int n = gw; n < SEQ + CTX; n += nw) {
          const int L = n < SEQ ? SEQ : CTX, pos = n < SEQ ? n : n - SEQ;
          const float tt = (float)pos / (float)(L - 1);
          const float ang = 6.283185307179586f * (float)pos / (float)L;
          float z = 0.f;
          if (lane == 0) z = tt;
          else if (lane <= 16) { const float fr = 1e-4f + (float)(lane - 1) * ((15.0f - 1e-4f) / 15.0f); z = cosf(fr * ang); }
          else if (lane <= 32) { const float fr = 1e-4f + (float)(lane - 17) * ((15.0f - 1e-4f) / 15.0f); z = -sinf(fr * ang); }
          float a = bb1;
#pragma unroll
          for (int e = 0; e < 33; ++e) a += __shfl(z, e) * w1[e * 64 + lane];
          const float h1 = sinf(fq * a);
          float c = bb2;
#pragma unroll
          for (int i = 0; i < 64; ++i) c += __shfl(h1, i) * w2f[i * 64 + lane];
          h2[(size_t)n * 64 + lane] = sinf(fq * c);
      } }
}

__device__ void ph_rowpass(const Params& P, int mode, int lpost, int gate_i, int gpost_i, float ps, int lpre, int gpre_i, int shift_i, int scale_i) {
    const int tid = otid(), lane = tid & 63, gw = blockIdx.x * NWAVE + (tid >> 6), nw = gridDim.x * NWAVE;
    const float* modv = (const float*)(P.ws + WS_MODV);
    float* H = (float*)(P.ws + WS_H); const float* Y = (const float*)(P.ws + WS_Y); bf16_t* U = (bf16_t*)(P.ws + WS_U);
    int cur_s = -1;
    float4 A[4], Bv[4], Cv[4];
#pragma unroll
    for (int j = 0; j < 4; ++j) { A[j] = make_float4(0.f, 0.f, 0.f, 0.f); Bv[j] = A[j]; Cv[j] = A[j]; }
    for (int row = gw; row < T; row += nw) {
        const int s = row < SEQ ? 0 : (row < TL ? 1 : 2);
        if (s != cur_s) { cur_s = s;
#pragma unroll
            for (int j = 0; j < 4; ++j) { const int e = lane * 4 + 256 * j;
                if (mode != 0) { const float4 g = *(const float4*)(modv + ((size_t)lpost * 3 + s) * NMOD + gate_i * D + e); const float4 gp = *(const float4*)(P.in[I_NORMG] + ((size_t)lpost * 6 + gpost_i) * D + e);
                    A[j] = make_float4(ps * g.x * gp.x, ps * g.y * gp.y, ps * g.z * gp.z, ps * g.w * gp.w); }
                if (mode != 2) { const float4 sc = *(const float4*)(modv + ((size_t)lpre * 3 + s) * NMOD + scale_i * D + e); const float4 gq = *(const float4*)(P.in[I_NORMG] + ((size_t)lpre * 6 + gpre_i) * D + e);
                    Bv[j] = make_float4(gq.x * (1.f + sc.x), gq.y * (1.f + sc.y), gq.z * (1.f + sc.z), gq.w * (1.f + sc.w));
                    Cv[j] = *(const float4*)(modv + ((size_t)lpre * 3 + s) * NMOD + shift_i * D + e); } } }
        float4 h[4];
        if (mode == 0) { const float* src = row < TL ? P.in[I_X] + (size_t)row * D : P.in[I_CTX] + (size_t)(row - TL) * D;
#pragma unroll
            for (int j = 0; j < 4; ++j) h[j] = *(const float4*)(src + lane * 4 + 256 * j);
        } else {
            float4 y[4]; float ss = 0.f;
#pragma unroll
            for (int j = 0; j < 4; ++j) { h[j] = *(const float4*)(H + (size_t)row * D + lane * 4 + 256 * j); y[j] = *(const float4*)(Y + (size_t)row * D + lane * 4 + 256 * j);
                ss += y[j].x * y[j].x + y[j].y * y[j].y + y[j].z * y[j].z + y[j].w * y[j].w; }
            ss = wsum(ss); const float r = rsqrtf(ss * (1.0f / D) + NORM_EPS);
#pragma unroll
            for (int j = 0; j < 4; ++j) { h[j].x += A[j].x * (y[j].x * r); h[j].y += A[j].y * (y[j].y * r); h[j].z += A[j].z * (y[j].z * r); h[j].w += A[j].w * (y[j].w * r); }
        }
        if (mode == 2) { if (row < TL) {
#pragma unroll
                for (int j = 0; j < 4; ++j) *(float4*)(P.out + (size_t)row * D + lane * 4 + 256 * j) = h[j]; }
            continue; }
        float s2 = 0.f;
#pragma unroll
        for (int j = 0; j < 4; ++j) { *(float4*)(H + (size_t)row * D + lane * 4 + 256 * j) = h[j]; s2 += h[j].x * h[j].x + h[j].y * h[j].y + h[j].z * h[j].z + h[j].w * h[j].w; }
        s2 = wsum(s2); const float r2 = rsqrtf(s2 * (1.0f / D) + NORM_EPS);
#pragma unroll
        for (int j = 0; j < 4; ++j) { u32x2 w; w.x = cvt_pk_bf16(h[j].x * r2 * Bv[j].x + Cv[j].x, h[j].y * r2 * Bv[j].y + Cv[j].y); w.y = cvt_pk_bf16(h[j].z * r2 * Bv[j].z + Cv[j].z, h[j].w * r2 * Bv[j].w + Cv[j].w);
            *(u32x2*)(U + (size_t)row * D + lane * 4 + 256 * j) = w; }
    }
}

struct EpiGU {
    static constexpr bool PERM = true, AFTER_DRAIN = false;
    bf16_t* O;
    __device__ __forceinline__ void operator()(const f32x4 (&acc)[2][2][4][2], const pg8::Unit& u, int wr, int wc, int fr, int fq) const {
        const int row0 = u.pm * 256 + wr * 64 + fr, col0 = u.pn * 128 + wc * 32 + 8 * fq;
#pragma unroll
        for (int ai = 0; ai < 2; ++ai)
#pragma unroll
            for (int m = 0; m < 4; ++m) { float o[8];
#pragma unroll
                for (int n = 0; n < 2; ++n)
#pragma unroll
                    for (int j = 0; j < 4; ++j) { const float g = acc[ai][0][m][n][j], up = acc[ai][1][m][n][j]; o[n * 4 + j] = g * __builtin_amdgcn_rcpf(1.0f + __expf(-g)) * up; }
                u32x4 w; w.x = cvt_pk_bf16(o[0], o[1]); w.y = cvt_pk_bf16(o[2], o[3]); w.z = cvt_pk_bf16(o[4], o[5]); w.w = cvt_pk_bf16(o[6], o[7]);
                *(u32x4*)(O + (size_t)(row0 + ai * 128 + m * 16) * DFF + col0) = w; }
    }
};
struct EpiF32 {
    static constexpr bool PERM = false, AFTER_DRAIN = false;
    float* C;
    __device__ __forceinline__ void operator()(const f32x4 (&acc)[2][2][4][2], const pg8::Unit& u, int wr, int wc, int fr, int fq) const {
        const int row0 = u.pm * 256 + wr * 64 + fr, col0 = u.pn * 256 + wc * 32 + 4 * fq;
#pragma unroll
        for (int ai = 0; ai < 2; ++ai)
#pragma unroll
            for (int m = 0; m < 4; ++m) { float* rowp = C + (size_t)(row0 + ai * 128 + m * 16) * D + col0;
#pragma unroll
                for (int bj = 0; bj < 2; ++bj)
#pragma unroll
                    for (int n = 0; n < 2; ++n) *(f32x4*)(rowp + bj * 128 + n * 16) = acc[ai][bj][m][n]; }
    }
};
struct EpiWin {
    static constexpr bool PERM = true, AFTER_DRAIN = false;
    bf16_t* PHY; bf16_t* PRW; bf16_t* PNA;
    __device__ __forceinline__ void operator()(const f32x4 (&acc)[2][2][4][2], const pg8::Unit& u, int wr, int wc, int fr, int fq) const {
        const int row0 = u.pm * 256 + wr * 64 + fr;
        bf16_t* base; int ld, cbase;
        if (u.pn < 3) { base = PHY; ld = HY_IN; cbase = u.pn * 256; }
        else if (u.pn < 9) { base = PRW; ld = RW_IN; cbase = u.pn * 256 - HY_IN; }
        else { base = PNA; ld = NA_IN; cbase = u.pn * 256 - HY_IN - RW_IN; }
        const int nbj = (u.pn == 13) ? 1 : 2;
#pragma unroll
        for (int ai = 0; ai < 2; ++ai)
#pragma unroll
            for (int m = 0; m < 4; ++m)
#pragma unroll
                for (int bj = 0; bj < 2; ++bj) { if (bj < nbj) { const f32x4 v0 = acc[ai][bj][m][0], v1 = acc[ai][bj][m][1];
                    u32x4 w; w.x = cvt_pk_bf16(v0[0], v0[1]); w.y = cvt_pk_bf16(v0[2], v0[3]); w.z = cvt_pk_bf16(v1[0], v1[1]); w.w = cvt_pk_bf16(v1[2], v1[3]);
                    *(u32x4*)(base + (size_t)(row0 + ai * 128 + m * 16) * ld + cbase + bj * 128 + wc * 32 + 8 * fq) = w; } }
    }
};
struct EpiLora {
    static constexpr bool PERM = true, AFTER_DRAIN = false;
    bf16_t* LO; bf16_t* GATE;
    __device__ __forceinline__ void operator()(const f32x4 (&acc)[2][2][4][2], const pg8::Unit& u, int wr, int wc, int fr, int fq) const {
        const int row0 = u.pm * 256 + wr * 64 + fr;
        bf16_t* base; int ld, cbase;
        if (u.pn < 6) { base = LO; ld = 1536; cbase = u.pn * 256; } else { base = GATE; ld = 384; cbase = u.pn * 256 - 1536; }
        const int nbj = (u.pn == 7) ? 1 : 2;
#pragma unroll
        for (int ai = 0; ai < 2; ++ai)
#pragma unroll
            for (int m = 0; m < 4; ++m)
#pragma unroll
                for (int bj = 0; bj < 2; ++bj) { if (bj < nbj) { const f32x4 v0 = acc[ai][bj][m][0], v1 = acc[ai][bj][m][1];
                    u32x4 w; w.x = cvt_pk_bf16(v0[0], v0[1]); w.y = cvt_pk_bf16(v0[2], v0[3]); w.z = cvt_pk_bf16(v1[0], v1[1]); w.w = cvt_pk_bf16(v1[2], v1[3]);
                    *(u32x4*)(base + (size_t)(row0 + ai * 128 + m * 16) * ld + cbase + bj * 128 + wc * 32 + 8 * fq) = w; } }
    }
};
template <class Epi> __device__ __forceinline__ void run_gemm(LAS unsigned char* lds, const bf16_t* A, const bf16_t* Bt, int M, int N, int K, const Epi& E) {
    asm volatile("" : "+s"(K));
    pg8::Gemm g{A, Bt, M, N, K}; pg8::StaticOrder S; S.init(M, N, (int)gridDim.x, (int)blockIdx.x);
    pg8::gemm_phase<Epi, pg8::StaticOrder>(lds, g, S, E);
    __syncthreads();
}

__device__ void ph_loraprep(const Params& P, int l) {
    const bf16_t* PRW = (const bf16_t*)(P.ws + WS_PRW); bf16_t* AL = (bf16_t*)(P.ws + WS_ALORA);
    const float* mu = P.in[I_MU] + (size_t)l * 2 * RW_IN;
    const int gtid = blockIdx.x * NTHR + otid(), gn = gridDim.x * NTHR;
    for (int it = gtid; it < T * 48; it += gn) {
        const int row = it / 48, j8 = it % 48, col = 1152 + j8 * 8;
        bool hp, hn; row_nbrs(row, hp, hn);
        float p[8], pp[8], pn[8];
        unpack8(*(const u32x4*)(PRW + (size_t)row * RW_IN + col), p);
        if (hp) unpack8(*(const u32x4*)(PRW + (size_t)(row - 1) * RW_IN + col), pp); else {
#pragma unroll
            for (int i = 0; i < 8; ++i) pp[i] = 0.f; }
        if (hn) unpack8(*(const u32x4*)(PRW + (size_t)(row + 1) * RW_IN + col), pn); else {
#pragma unroll
            for (int i = 0; i < 8; ++i) pn[i] = 0.f; }
        float o[8];
#pragma unroll
        for (int i = 0; i < 8; ++i) { const float xs = p[i] + mu[col + i] * (pp[i] - p[i]) + mu[RW_IN + col + i] * (pn[i] - p[i]);
            o[i] = j8 < 16 ? tanhf(xs) : (j8 < 32 ? xs : sigmoidf_(xs)); }
        u32x4 w; w.x = cvt_pk_bf16(o[0], o[1]); w.y = cvt_pk_bf16(o[2], o[3]); w.z = cvt_pk_bf16(o[4], o[5]); w.w = cvt_pk_bf16(o[6], o[7]);
        *(u32x4*)(AL + (size_t)row * 384 + j8 * 8) = w;
    }
}

__device__ void ph_rwkvprep(const Params& P, int l) {
    const int tid = otid(), lane = tid & 63, gw = blockIdx.x * NWAVE + (tid >> 6), nw = gridDim.x * NWAVE;
    const bf16_t* PRW = (const bf16_t*)(P.ws + WS_PRW); const bf16_t* LO = (const bf16_t*)(P.ws + WS_LORAO);
    bf16_t* RS = (bf16_t*)(P.ws + WS_RS); bf16_t* KKS = (bf16_t*)(P.ws + WS_KKS); bf16_t* VS = (bf16_t*)(P.ws + WS_VS); bf16_t* KS = (bf16_t*)(P.ws + WS_KS); bf16_t* BS = (bf16_t*)(P.ws + WS_BS);
    float* BON = (float*)(P.ws + WS_BONUS);
    const float* mu = P.in[I_MU] + (size_t)l * 2 * RW_IN;
    const int f = lane & 15; const float inv = __expf(-(float)f * (9.210340371976184f / 16.0f));
    for (int it = gw; it < T * 6; it += nw) {
        const int row = it / 6, h = it % 6, c = h * 64 + lane;
        bool hp, hn; row_nbrs(row, hp, hn);
        float x[3];
#pragma unroll
        for (int q = 0; q < 3; ++q) { const int col = q * 384 + c; const float p = bf2f(PRW[(size_t)row * RW_IN + col]);
            const float pp = hp ? bf2f(PRW[(size_t)(row - 1) * RW_IN + col]) : 0.f, pn = hn ? bf2f(PRW[(size_t)(row + 1) * RW_IN + col]) : 0.f;
            x[q] = p + mu[col] * (pp - p) + mu[RW_IN + col] * (pn - p); }
        const float r = x[0], k = x[1], v = x[2];
        const float kkr = k * P.in[I_KK][l * RWW + c];
        const float nrm = sqrtf(wsum(kkr * kkr));
        const float kk = kkr / fmaxf(nrm, 1e-12f);
        const float a0 = sigmoidf_(bf2f(LO[(size_t)row * 1536 + 768 + c]) + P.in[I_A0][(size_t)l * 2 * RWW + c]), a1 = sigmoidf_(bf2f(LO[(size_t)row * 1536 + 1152 + c]) + P.in[I_A0][(size_t)l * 2 * RWW + RWW + c]);
        { float* DEC = (float*)(P.ws + WS_DECAY);
          const float x0 = bf2f(LO[(size_t)row * 1536 + c]) + P.in[I_W0][(size_t)l * 2 * RWW + c], x1 = bf2f(LO[(size_t)row * 1536 + 384 + c]) + P.in[I_W0][(size_t)l * 2 * RWW + RWW + c];
          DEC[(size_t)row * 384 + c] = __expf(-0.6065306597f * sigmoidf_(x0)); DEC[((size_t)T + row) * 384 + c] = __expf(-0.6065306597f * sigmoidf_(x1)); }
        const float ka = P.in[I_KA][l * RWW + c];
        float kd0 = k * (1.f + (a0 - 1.f) * ka), kd1 = k * (1.f + (a1 - 1.f) * ka);
        float b0 = kk * a0, b1 = kk * a1;
        const float bon = wsum(r * (kd0 + kd1) * P.in[I_RK][l * RWW + c]);
        if (lane == 0) BON[(size_t)row * 6 + h] = bon;
        float rs = r, kks = kk;
        if (row < TL) {
            const int t = row & (SEQ - 1); const float pos = (lane < 32) ? (float)(t >> 6) : (float)(t & 63);
            float sn, cs; sincosf(pos * inv, &sn, &cs);
            const float sg = (lane & 16) ? 1.f : -1.f;
            const float r2 = __shfl_xor(rs, 16), k2 = __shfl_xor(kks, 16), d0 = __shfl_xor(kd0, 16), d1 = __shfl_xor(kd1, 16), e0 = __shfl_xor(b0, 16), e1 = __shfl_xor(b1, 16);
            rs = rs * cs + sg * r2 * sn; kks = kks * cs + sg * k2 * sn; kd0 = kd0 * cs + sg * d0 * sn; kd1 = kd1 * cs + sg * d1 * sn; b0 = b0 * cs + sg * e0 * sn; b1 = b1 * cs + sg * e1 * sn;
        }
        const size_t o = (size_t)row * 384 + c;
        RS[o] = f2bf(rs); KKS[o] = f2bf(-kks); VS[o] = f2bf(v);
        KS[o] = f2bf(kd0); KS[(size_t)T * 384 + o] = f2bf(kd1); BS[o] = f2bf(b0); BS[(size_t)T * 384 + o] = f2bf(b1);
    }
}

__device__ __forceinline__ int scan_row(int b, int d, int step) {
    if (step < CTX) { const int tc = d ? (CTX - 1 - step) : step; return TL + b * CTX + tc; }
    const int tl = d ? (SEQ - 1 - (step - CTX)) : (step - CTX); return b * SEQ + tl;
}
__device__ void scan_task_v1(const Params& P, int task, float* sv) {
    const int lane = otid() & 63;
    const int d = task & 1, h = (task >> 1) % 6, b = task / 12;
    const float* DEC = (const float*)(P.ws + WS_DECAY) + (size_t)d * T * 384; const bf16_t* KKS = (const bf16_t*)(P.ws + WS_KKS); const bf16_t* RS = (const bf16_t*)(P.ws + WS_RS);
    const bf16_t* VS = (const bf16_t*)(P.ws + WS_VS); const bf16_t* KS = (const bf16_t*)(P.ws + WS_KS) + (size_t)d * T * 384; const bf16_t* BS = (const bf16_t*)(P.ws + WS_BS) + (size_t)d * T * 384;
    float* YD = (float*)(P.ws + WS_YDIR) + (size_t)d * T * 384;
    float S[64];
#pragma unroll
    for (int j = 0; j < 64; ++j) S[j] = 0.f;
    size_t o = (size_t)scan_row(b, d, 0) * 384 + h * 64 + lane;
    float nw_ = DEC[o], na = bf2f(KKS[o]), nb = bf2f(BS[o]), nk = bf2f(KS[o]), nr = bf2f(RS[o]), nv = bf2f(VS[o]);
    for (int step = 0; step < CTX + SEQ; ++step) {
        const float v = nv; const size_t oc = o;
        asm volatile("s_waitcnt lgkmcnt(0)" ::: "memory");
        sv[lane] = nw_; sv[64 + lane] = na; sv[128 + lane] = nb; sv[192 + lane] = nk; sv[256 + lane] = nr;
        asm volatile("s_waitcnt lgkmcnt(0)" ::: "memory");
        if (step + 1 < CTX + SEQ) { o = (size_t)scan_row(b, d, step + 1) * 384 + h * 64 + lane;
            nw_ = DEC[o]; na = bf2f(KKS[o]); nb = bf2f(BS[o]); nk = bf2f(KS[o]); nr = bf2f(RS[o]); nv = bf2f(VS[o]); }
        float sa0 = 0.f, sa1 = 0.f, sa2 = 0.f, sa3 = 0.f;
#pragma unroll
        for (int j = 0; j < 64; j += 4) { const float4 a4 = *(const float4*)(sv + 64 + j);
            sa0 += S[j + 0] * a4.x; sa1 += S[j + 1] * a4.y; sa2 += S[j + 2] * a4.z; sa3 += S[j + 3] * a4.w; }
        const float sa = (sa0 + sa1) + (sa2 + sa3);
        float y0 = 0.f, y1 = 0.f, y2 = 0.f, y3 = 0.f;
#pragma unroll
        for (int j = 0; j < 64; j += 4) {
            const float4 w4 = *(const float4*)(sv + j), b4 = *(const float4*)(sv + 128 + j), k4 = *(const float4*)(sv + 192 + j), r4 = *(const float4*)(sv + 256 + j);
            S[j + 0] = S[j + 0] * w4.x + sa * b4.x + v * k4.x; y0 += S[j + 0] * r4.x;
            S[j + 1] = S[j + 1] * w4.y + sa * b4.y + v * k4.y; y1 += S[j + 1] * r4.y;
            S[j + 2] = S[j + 2] * w4.z + sa * b4.z + v * k4.z; y2 += S[j + 2] * r4.z;
            S[j + 3] = S[j + 3] * w4.w + sa * b4.w + v * k4.w; y3 += S[j + 3] * r4.w; }
        YD[oc] = (y0 + y1) + (y2 + y3);
    }
}

__device__ __forceinline__ void natt_key(const bf16_t* PNA, size_t krow, int hoff, const float (&q)[16], float bias, float& m, float& lsum, float (&o)[16]) {
    const bf16_t* kp = PNA + krow * NA_IN + 384 + hoff; const bf16_t* vp = PNA + krow * NA_IN + 768 + hoff;
    float s = 0.f;
#pragma unroll
    for (int j8 = 0; j8 < 2; ++j8) { float kf[8]; unpack8(*(const u32x4*)(kp + j8 * 8), kf);
#pragma unroll
        for (int i = 0; i < 8; ++i) s += q[j8 * 8 + i] * kf[i]; }
    s += __shfl_xor(s, 1); s += __shfl_xor(s, 2); s += bias;
    const float mn = fmaxf(m, s), corr = __expf(m - mn), p = __expf(s - mn);
    m = mn; lsum = lsum * corr + p;
#pragma unroll
    for (int j8 = 0; j8 < 2; ++j8) { float vf[8]; unpack8(*(const u32x4*)(vp + j8 * 8), vf);
#pragma unroll
        for (int i = 0; i < 8; ++i) o[j8 * 8 + i] = o[j8 * 8 + i] * corr + p * vf[i]; }
}
__device__ void natten_items_v1(const Params& P, int l, int wid0, int nworkers) {
    const bf16_t* PNA = (const bf16_t*)(P.ws + WS_PNA); bf16_t* MIX = (bf16_t*)(P.ws + WS_U);
    const float* rpb = P.in[I_RPB] + (size_t)l * 6 * 15 * 31;
    const int sub = wid0 & 3;
    for (int it = wid0 >> 2; it < T * 6; it += nworkers >> 2) {
        const int row = it % T, h = it / T, hoff = h * 64 + sub * 16;
        float q[16], o[16];
#pragma unroll
        for (int j8 = 0; j8 < 2; ++j8) { float qf[8]; unpack8(*(const u32x4*)(PNA + (size_t)row * NA_IN + hoff + j8 * 8), qf);
#pragma unroll
            for (int i = 0; i < 8; ++i) { q[j8 * 8 + i] = qf[i] * 0.125f; o[j8 * 8 + i] = 0.f; } }
        float m = -3.0e38f, lsum = 0.f;
        int b;
        if (row < TL) { b = row >> 13; const int t = row & (SEQ - 1), i = t >> 6, col = t & 63;
            const int start = min(max(i - 4, 0), 120), win0 = min(max(col - 8, 0), 48);
            for (int r = 0; r < 8; ++r) for (int kc = win0; kc < win0 + 16; ++kc) {
                const float bias = rpb[(h * 15 + (start + r - i + 7)) * 31 + (kc - col + 15)];
                natt_key(PNA, (size_t)b * SEQ + (start + r) * 64 + kc, hoff, q, bias, m, lsum, o); }
        } else b = (row - TL) >> 8;
        for (int c = 0; c < CTX; ++c) natt_key(PNA, (size_t)TL + b * CTX + c, hoff, q, 0.f, m, lsum, o);
        const float il = 1.0f / lsum;
#pragma unroll
        for (int j8 = 0; j8 < 2; ++j8) { u32x4 w; w.x = cvt_pk_bf16(o[j8 * 8 + 0] * il, o[j8 * 8 + 1] * il); w.y = cvt_pk_bf16(o[j8 * 8 + 2] * il, o[j8 * 8 + 3] * il);
            w.z = cvt_pk_bf16(o[j8 * 8 + 4] * il, o[j8 * 8 + 5] * il); w.w = cvt_pk_bf16(o[j8 * 8 + 6] * il, o[j8 * 8 + 7] * il);
            *(u32x4*)(MIX + (size_t)row * D + 640 + hoff + j8 * 8) = w; }
    }
}

__device__ void vt_tile(const Params& P, int tile, unsigned short* tl  ) {
    const int tid = otid();
    const bf16_t* PNA = (const bf16_t*)(P.ws + WS_PNA);
    int h, tok0; bf16_t* dst; int ldt;
    if (tile < NB * 128 * 6) { h = tile % 6; const int sb = tile / 6; const int b = sb >> 7, blk = sb & 127; tok0 = b * SEQ + blk * 64; dst = (bf16_t*)(P.ws + WS_VTL) + ((size_t)(b * 6 + h) * 64) * SEQ + blk * 64; ldt = SEQ; }
    else { const int tt = tile - NB * 128 * 6; h = tt % 6; const int sb = tt / 6; const int b = sb >> 2, blk = sb & 3; tok0 = TL + b * CTX + blk * 64; dst = (bf16_t*)(P.ws + WS_VTC) + ((size_t)(b * 6 + h) * 64) * CTX + blk * 64; ldt = CTX; }
    { const int tok = tid >> 3, seg = tid & 7; const u32x4 v = *(const u32x4*)(PNA + (size_t)(tok0 + tok) * NA_IN + 768 + h * 64 + seg * 8);
      unsigned* w = (unsigned*)(tl + tok * 72 + seg * 8); w[0] = v.x; w[1] = v.y; w[2] = v.z; w[3] = v.w; }
    __syncthreads();
    { const int hd = tid >> 3, ts = tid & 7; unsigned short e[8];
#pragma unroll
      for (int k = 0; k < 8; ++k) e[k] = tl[(ts * 8 + k) * 72 + hd];
      u32x4 w; w.x = (unsigned)e[0] | ((unsigned)e[1] << 16); w.y = (unsigned)e[2] | ((unsigned)e[3] << 16); w.z = (unsigned)e[4] | ((unsigned)e[5] << 16); w.w = (unsigned)e[6] | ((unsigned)e[7] << 16);
      *(u32x4*)(dst + (size_t)hd * ldt + ts * 8) = w; }
    __syncthreads();
}
constexpr int NAT_LAT_TASKS = NB * 128 * 4 * 6, NAT_CTX_TASKS = NB * 16 * 6, NAT_TASKS = NAT_LAT_TASKS + NAT_CTX_TASKS;
__device__ void natten_task(const Params& P, int l, int task) {
    using pg8::bf16x8;
    const int lane = otid() & 63, fr = lane & 15, fq = lane >> 4;
    const bf16_t* PNA = (const bf16_t*)(P.ws + WS_PNA); bf16_t* MIX = (bf16_t*)(P.ws + WS_U);
    const bool lat = task < NAT_LAT_TASKS;
    int b, h, i = 0, n = 0, qtok0;
    if (lat) { h = task % 6; const int r = task / 6; n = r & 3; i = (r >> 2) & 127; b = r >> 9; qtok0 = b * SEQ + i * 64 + 16 * n; }
    else { const int tt = task - NAT_LAT_TASKS; h = tt % 6; const int qb = (tt / 6) & 15; b = tt / 96; qtok0 = TL + b * CTX + 16 * qb; }
    const int start = min(max(i - 4, 0), 120), band0 = min(max(16 * n - 8, 0), 32);
    const int col = 16 * n + fr, win0 = min(max(col - 8, 0), 48);
    bf16x8 bq[2];
#pragma unroll
    for (int kh = 0; kh < 2; ++kh) bq[kh] = *(const bf16x8*)(PNA + (size_t)(qtok0 + fr) * NA_IN + h * 64 + kh * 32 + fq * 8);
    f32x4 sc[32];
    if (lat) {
#pragma unroll
        for (int t = 0; t < 16; ++t) { const int tok0 = b * SEQ + (start + (t >> 1)) * 64 + band0 + 16 * (t & 1);
            const bf16_t* kp = PNA + (size_t)(tok0 + fr) * NA_IN + 384 + h * 64 + fq * 8;
            const bf16x8 k0 = *(const bf16x8*)kp, k1 = *(const bf16x8*)(kp + 32);
            f32x4 a = (f32x4){0.f, 0.f, 0.f, 0.f};
            a = __builtin_amdgcn_mfma_f32_16x16x32_bf16(k0, bq[0], a, 0, 0, 0); a = __builtin_amdgcn_mfma_f32_16x16x32_bf16(k1, bq[1], a, 0, 0, 0);
            sc[t] = a; if ((t & 3) == 3) asm volatile("" ::: "memory"); }
    } else {
#pragma unroll
        for (int t = 0; t < 16; ++t) sc[t] = (f32x4){-3.0e38f, -3.0e38f, -3.0e38f, -3.0e38f};
    }
#pragma unroll
    for (int t = 16; t < 32; ++t) { const int tok0 = TL + b * CTX + 16 * (t - 16);
        const bf16_t* kp = PNA + (size_t)(tok0 + fr) * NA_IN + 384 + h * 64 + fq * 8;
        const bf16x8 k0 = *(const bf16x8*)kp, k1 = *(const bf16x8*)(kp + 32);
        f32x4 a = (f32x4){0.f, 0.f, 0.f, 0.f};
        a = __builtin_amdgcn_mfma_f32_16x16x32_bf16(k0, bq[0], a, 0, 0, 0); a = __builtin_amdgcn_mfma_f32_16x16x32_bf16(k1, bq[1], a, 0, 0, 0);
        sc[t] = a * 0.125f; if ((t & 3) == 3) asm volatile("" ::: "memory"); }
    if (lat) { const float* rpb = P.in[I_RPB] + ((size_t)l * 6 + h) * 15 * 31;
#pragma unroll
        for (int t = 0; t < 16; ++t) { const int ro = start + (t >> 1) - i + 7; const int kc0 = band0 + 16 * (t & 1) + fq * 4;
#pragma unroll
            for (int j = 0; j < 4; ++j) { const int kc = kc0 + j; const bool ok = kc >= win0 && kc < win0 + 16; const int co = min(max(kc - col + 15, 0), 30);
                const float bias = rpb[ro * 31 + co]; sc[t][j] = ok ? sc[t][j] * 0.125f + bias : -3.0e38f; } } }
    float mx = -3.0e38f;
#pragma unroll
    for (int t = 0; t < 32; ++t) mx = fmaxf(mx, fmaxf(fmaxf(sc[t][0], sc[t][1]), fmaxf(sc[t][2], sc[t][3])));
    mx = fmaxf(mx, __shfl_xor(mx, 16)); mx = fmaxf(mx, __shfl_xor(mx, 32));
    float sum = 0.f;
#pragma unroll
    for (int t = 0; t < 32; ++t) {
#pragma unroll
        for (int j = 0; j < 4; ++j) { const float p = __expf(sc[t][j] - mx); sc[t][j] = p; sum += p; } }
    sum += __shfl_xor(sum, 16); sum += __shfl_xor(sum, 32);
    const float inv = 1.0f / sum;
    f32x4 ot[4];
#pragma unroll
    for (int q = 0; q < 4; ++q) ot[q] = (f32x4){0.f, 0.f, 0.f, 0.f};
    const bf16_t* VTL = (const bf16_t*)(P.ws + WS_VTL) + ((size_t)(b * 6 + h) * 64) * SEQ; const bf16_t* VTC = (const bf16_t*)(P.ws + WS_VTC) + ((size_t)(b * 6 + h) * 64) * CTX;
    if (lat) {
#pragma unroll
        for (int m = 0; m < 8; ++m) { const int tk = (start + m) * 64 + band0 + fq * 4;
            u32x4 pw; pw.x = cvt_pk_bf16(sc[2 * m][0], sc[2 * m][1]); pw.y = cvt_pk_bf16(sc[2 * m][2], sc[2 * m][3]); pw.z = cvt_pk_bf16(sc[2 * m + 1][0], sc[2 * m + 1][1]); pw.w = cvt_pk_bf16(sc[2 * m + 1][2], sc[2 * m + 1][3]);
            const bf16x8 pb = __builtin_bit_cast(bf16x8, pw);
#pragma unroll
            for (int q = 0; q < 4; ++q) { const bf16_t* vp = VTL + (size_t)(q * 16 + fr) * SEQ + tk; const u32x2 v0 = *(const u32x2*)vp, v1 = *(const u32x2*)(vp + 16);
                u32x4 vw; vw.x = v0.x; vw.y = v0.y; vw.z = v1.x; vw.w = v1.y;
                ot[q] = __builtin_amdgcn_mfma_f32_16x16x32_bf16(__builtin_bit_cast(bf16x8, vw), pb, ot[q], 0, 0, 0); }
            if (m & 1) asm volatile("" ::: "memory"); }
    }
#pragma unroll
    for (int m = 0; m < 8; ++m) { const int tk = 32 * m + fq * 4;
        u32x4 pw; pw.x = cvt_pk_bf16(sc[16 + 2 * m][0], sc[16 + 2 * m][1]); pw.y = cvt_pk_bf16(sc[16 + 2 * m][2], sc[16 + 2 * m][3]); pw.z = cvt_pk_bf16(sc[17 + 2 * m][0], sc[17 + 2 * m][1]); pw.w = cvt_pk_bf16(sc[17 + 2 * m][2], sc[17 + 2 * m][3]);
        const bf16x8 pb = __builtin_bit_cast(bf16x8, pw);
#pragma unroll
        for (int q = 0; q < 4; ++q) { const bf16_t* vp = VTC + (size_t)(q * 16 + fr) * CTX + tk; const u32x2 v0 = *(const u32x2*)vp, v1 = *(const u32x2*)(vp + 16);
            u32x4 vw; vw.x = v0.x; vw.y = v0.y; vw.z = v1.x; vw.w = v1.y;
            ot[q] = __builtin_amdgcn_mfma_f32_16x16x32_bf16(__builtin_bit_cast(bf16x8, vw), pb, ot[q], 0, 0, 0); }
        if (m & 1) asm volatile("" ::: "memory"); }
#pragma unroll
    for (int q = 0; q < 4; ++q) { u32x2 w; w.x = cvt_pk_bf16(ot[q][0] * inv, ot[q][1] * inv); w.y = cvt_pk_bf16(ot[q][2] * inv, ot[q][3] * inv);
        *(u32x2*)(MIX + (size_t)(qtok0 + fr) * D + 640 + h * 64 + q * 16 + fq * 4) = w; }
}

__device__ void fft_fwd(float2* X) {
    for (int s = 13; s >= 0; --s) { const int half = 1 << s;
        for (int j = otid(); j < NFFT / 2; j += NTHR) { const int lo = j & (half - 1), i0 = ((j >> s) << (s + 1)) | lo, i1 = i0 + half;
            const float2 a = X[i0], b = X[i1]; const float fr = (float)lo / (float)(2 * half);
            const float cw = __builtin_amdgcn_cosf(fr), sw = __builtin_amdgcn_sinf(fr);
            const float dx = a.x - b.x, dy = a.y - b.y;
            X[i0] = make_float2(a.x + b.x, a.y + b.y); X[i1] = make_float2(dx * cw + dy * sw, dy * cw - dx * sw); }
        __syncthreads(); }
}
__device__ void fft_inv(float2* X) {
    for (int s = 0; s <= 13; ++s) { const int half = 1 << s;
        for (int j = otid(); j < NFFT / 2; j += NTHR) { const int lo = j & (half - 1), i0 = ((j >> s) << (s + 1)) | lo, i1 = i0 + half;
            const float2 a = X[i0], b = X[i1]; const float fr = (float)lo / (float)(2 * half);
            const float cw = __builtin_amdgcn_cosf(fr), sw = __builtin_amdgcn_sinf(fr);
            const float bx = b.x * cw - b.y * sw, by = b.x * sw + b.y * cw;
            X[i0] = make_float2(a.x + bx, a.y + by); X[i1] = make_float2(a.x - bx, a.y - by); }
        __syncthreads(); }
}
__device__ __forceinline__ float hy_delta(int c) { const float lo = -4.605170185988091f / 1.5f, hi = -4.605170185988091f / 0.3f; return fabsf(lo + (float)c * ((hi - lo) / 255.0f)); }
__device__ __forceinline__ float hy_short(const bf16_t* PHY, const float* cw, const float* cb, int row, int col) {
    bool hp, hn; row_nbrs(row, hp, hn);
    float v = cb[col] + cw[HY_IN + col] * bf2f(PHY[(size_t)row * HY_IN + col]);
    if (hp) v += cw[col] * bf2f(PHY[(size_t)(row - 1) * HY_IN + col]);
    if (hn) v += cw[2 * HY_IN + col] * bf2f(PHY[(size_t)(row + 1) * HY_IN + col]);
    return v;
}
__device__ void hy_spec_task(const Params& P, int l, int o, int c, float2* X, float* ex) {
    const int tid = otid();
    const float* h2 = (const float*)(P.ws + WS_H2); const float* w3 = P.in[I_HW3] + (size_t)l * 64 * 1024;
    if (tid < 128) { const int dir = tid >> 6, i = tid & 63; ex[tid] = w3[(size_t)i * 1024 + o * 512 + dir * 256 + c]; }
    __syncthreads();
    const float dl = hy_delta(c);
    for (int n = tid; n < SEQ; n += NTHR) { float af = 0.f, ab = 0.f;
#pragma unroll
        for (int i4 = 0; i4 < 16; ++i4) { const float4 hv = *(const float4*)(h2 + (size_t)n * 64 + i4 * 4);
            af += hv.x * ex[i4 * 4] + hv.y * ex[i4 * 4 + 1] + hv.z * ex[i4 * 4 + 2] + hv.w * ex[i4 * 4 + 3];
            ab += hv.x * ex[64 + i4 * 4] + hv.y * ex[64 + i4 * 4 + 1] + hv.z * ex[64 + i4 * 4 + 2] + hv.w * ex[64 + i4 * 4 + 3]; }
        const float dec = __expf(-((float)n / (float)(SEQ - 1)) * dl) * (1.0f / NFFT);
        X[n] = make_float2(af * dec, 0.f);
        if (n > 0) X[NFFT - n] = make_float2(ab * dec, 0.f); else X[SEQ] = make_float2(0.f, 0.f); }
    __syncthreads();
    fft_fwd(X);
    float2* spec = (float2*)(P.ws + WS_SPEC) + (size_t)(o * 256 + c) * NFFT;
    for (int i = tid; i < NFFT; i += NTHR) spec[i] = X[i];
    __syncthreads();
}
__device__ void hy_conv_core(const Params& P, int o, int c, float2* X) {
    fft_fwd(X);
    const float2* spec = (const float2*)(P.ws + WS_SPEC) + (size_t)(o * 256 + c) * NFFT;
    for (int i = otid(); i < NFFT; i += NTHR) { const float2 a = X[i], k = spec[i]; X[i] = make_float2(a.x * k.x - a.y * k.y, a.x * k.y + a.y * k.x); }
    __syncthreads();
    fft_inv(X);
}
__device__ void hy_task1(const Params& P, int l, int c, float2* X, float* ex) {
    const int tid = otid();
    const bf16_t* PHY = (const bf16_t*)(P.ws + WS_PHY); const float* cw = P.in[I_HCW] + (size_t)l * 3 * HY_IN; const float* cb = P.in[I_HCB] + (size_t)l * HY_IN;
    const float bias0 = P.in[I_HBIAS][(size_t)l * 2 * HYC + c], bias1 = P.in[I_HBIAS][(size_t)l * 2 * HYC + HYC + c];
    for (int n = tid; n < SEQ; n += NTHR) { X[n] = make_float2(hy_short(PHY, cw, cb, n, c), hy_short(PHY, cw, cb, SEQ + n, c)); X[SEQ + n] = make_float2(0.f, 0.f); }
    __syncthreads();
    hy_conv_core(P, 0, c, X);
    float* Z1 = (float*)(P.ws + WS_Z1) + (size_t)c * NB * SEQ;
    for (int n = tid; n < SEQ; n += NTHR) { const float2 y = X[n];
        const float v0 = hy_short(PHY, cw, cb, n, c), v1 = hy_short(PHY, cw, cb, SEQ + n, c), g0 = hy_short(PHY, cw, cb, n, HYC + c), g1 = hy_short(PHY, cw, cb, SEQ + n, HYC + c);
        Z1[n] = g0 * (y.x + bias0 * v0); Z1[SEQ + n] = g1 * (y.y + bias0 * v1); }
    __syncthreads();
    float* f = (float*)X;
    float* vv = f, *x1 = f + 512, *x2 = f + 1024, *hf = f + 1536  , *z1 = f + 2560;
    const float* h2c = (const float*)(P.ws + WS_H2) + (size_t)SEQ * 64; const float* w3 = P.in[I_HW3] + (size_t)l * 64 * 1024;
    { const int b = tid >> 8, t = tid & 255, row = TL + b * CTX + t;
      vv[tid] = hy_short(PHY, cw, cb, row, c); x1[tid] = hy_short(PHY, cw, cb, row, HYC + c); x2[tid] = hy_short(PHY, cw, cb, row, 2 * HYC + c);
      const float dl = hy_delta(c);
      for (int q = tid; q < 1024; q += NTHR) { const int od = q >> 8, n = q & 255; float a = 0.f;
          for (int i = 0; i < 64; ++i) a += h2c[n * 64 + i] * w3[(size_t)i * 1024 + od * 256 + c];
          hf[q] = a * __expf(-((float)n / (float)(CTX - 1)) * dl); } }
    __syncthreads();
    { const int b = tid >> 8, t = tid & 255; float y = bias0 * vv[tid];
      for (int s = 0; s <= t; ++s) y += hf[t - s] * vv[b * 256 + s];
      for (int s = t + 1; s < CTX; ++s) y += hf[256 + s - t] * vv[b * 256 + s];
      z1[tid] = x1[tid] * y; }
    __syncthreads();
    { const int b = tid >> 8, t = tid & 255; float y = bias1 * z1[tid];
      for (int s = 0; s <= t; ++s) y += hf[512 + t - s] * z1[b * 256 + s];
      for (int s = t + 1; s < CTX; ++s) y += hf[768 + s - t] * z1[b * 256 + s];
      bf16_t* MIX = (bf16_t*)(P.ws + WS_U); MIX[(size_t)(TL + b * CTX + t) * D + c] = f2bf(x2[tid] * y); }
    __syncthreads();
}
__device__ void hy_task2(const Params& P, int l, int c, float2* X) {
    const int tid = otid();
    const bf16_t* PHY = (const bf16_t*)(P.ws + WS_PHY); const float* cw = P.in[I_HCW] + (size_t)l * 3 * HY_IN; const float* cb = P.in[I_HCB] + (size_t)l * HY_IN;
    const float bias1 = P.in[I_HBIAS][(size_t)l * 2 * HYC + HYC + c];
    const float* Z1 = (const float*)(P.ws + WS_Z1) + (size_t)c * NB * SEQ;
    for (int n = tid; n < SEQ; n += NTHR) { X[n] = make_float2(Z1[n], Z1[SEQ + n]); X[SEQ + n] = make_float2(0.f, 0.f); }
    __syncthreads();
    hy_conv_core(P, 1, c, X);
    bf16_t* MIX = (bf16_t*)(P.ws + WS_U);
    for (int n = tid; n < SEQ; n += NTHR) { const float2 y = X[n];
        const float g0 = hy_short(PHY, cw, cb, n, 2 * HYC + c), g1 = hy_short(PHY, cw, cb, SEQ + n, 2 * HYC + c);
        MIX[(size_t)n * D + c] = f2bf(g0 * (y.x + bias1 * Z1[n])); MIX[(size_t)(SEQ + n) * D + c] = f2bf(g1 * (y.y + bias1 * Z1[SEQ + n])); }
    __syncthreads();
}

constexpr int SEGC = 256, NSEG = 33, SCH = 4;
typedef float f32x2v __attribute__((ext_vector_type(2)));
template <bool IDENT>
__device__ void scan_seg(const Params& P, int chain, int g, float* ring  ) {
    const int lane = otid() & 63;
    const int d = chain & 1, h = (chain >> 1) % 6, b = chain / 12;
    const float* DEC = (const float*)(P.ws + WS_DECAY) + (size_t)d * T * 384; const bf16_t* KKS = (const bf16_t*)(P.ws + WS_KKS); const bf16_t* RS = (const bf16_t*)(P.ws + WS_RS);
    const bf16_t* VS = (const bf16_t*)(P.ws + WS_VS); const bf16_t* KS = (const bf16_t*)(P.ws + WS_KS) + (size_t)d * T * 384; const bf16_t* BS = (const bf16_t*)(P.ws + WS_BS) + (size_t)d * T * 384;
    float* YD = (float*)(P.ws + WS_YDIR) + (size_t)d * T * 384;
    bf16_t* E = (bf16_t*)(P.ws + WS_E) + (size_t)chain * SEQ * 64;
    const int step0 = g == 0 ? 0 : CTX + (g - 1) * SEGC;
    f32x2v S0[32], S1[32];
#pragma unroll
    for (int j = 0; j < 32; ++j) { S0[j] = (f32x2v){0.f, 0.f}; S1[j] = (f32x2v){(2 * j == lane) ? 1.f : 0.f, (2 * j + 1 == lane) ? 1.f : 0.f}; }
    float pw[SCH], pa[SCH], pb[SCH], pk[SCH], pr[SCH], pv[SCH]; int po[SCH];
#pragma unroll
    for (int s = 0; s < SCH; ++s) { const int o = scan_row(b, d, step0 + s) * 384 + h * 64 + lane; po[s] = o;
        pw[s] = DEC[o]; pa[s] = bf2f(KKS[o]); pb[s] = bf2f(BS[o]); pk[s] = bf2f(KS[o]); pr[s] = bf2f(RS[o]); pv[s] = bf2f(VS[o]); }
    for (int c = 0; c < SEGC / SCH; ++c) {
        float cv[SCH]; int co[SCH];
        asm volatile("s_waitcnt lgkmcnt(0)" ::: "memory");
#pragma unroll
        for (int s = 0; s < SCH; ++s) { float* sv = ring + s * 320; sv[lane] = pw[s]; sv[64 + lane] = pa[s]; sv[128 + lane] = pb[s]; sv[192 + lane] = pk[s]; sv[256 + lane] = pr[s]; cv[s] = pv[s]; co[s] = po[s]; }
        asm volatile("s_waitcnt lgkmcnt(0)" ::: "memory");
        if (c + 1 < SEGC / SCH) {
#pragma unroll
            for (int s = 0; s < SCH; ++s) { const int o = scan_row(b, d, step0 + (c + 1) * SCH + s) * 384 + h * 64 + lane; po[s] = o;
                pw[s] = DEC[o]; pa[s] = bf2f(KKS[o]); pb[s] = bf2f(BS[o]); pk[s] = bf2f(KS[o]); pr[s] = bf2f(RS[o]); pv[s] = bf2f(VS[o]); } }
#pragma unroll
        for (int s = 0; s < SCH; ++s) { const float* sv = ring + s * 320;
            f32x2v sa2 = (f32x2v){0.f, 0.f}, sb2 = (f32x2v){0.f, 0.f}, sa3 = sa2, sb3 = sa2;
#pragma unroll
            for (int j = 0; j < 64; j += 4) { const float4 a4 = *(const float4*)(sv + 64 + j); const f32x2v alo = (f32x2v){a4.x, a4.y}, ahi = (f32x2v){a4.z, a4.w};
                sa2 += S0[j / 2] * alo; sa3 += S0[j / 2 + 1] * ahi;
                if (IDENT) { sb2 += S1[j / 2] * alo; sb3 += S1[j / 2 + 1] * ahi; } }
            const float sa = (sa2.x + sa2.y) + (sa3.x + sa3.y), sb = (sb2.x + sb2.y) + (sb3.x + sb3.y);
            const f32x2v saa = (f32x2v){sa, sa}, sbb = (f32x2v){sb, sb}, vv = (f32x2v){cv[s], cv[s]};
            f32x2v y2 = (f32x2v){0.f, 0.f}, y3 = y2, e2 = y2, e3 = y2;
#pragma unroll
            for (int j = 0; j < 64; j += 4) {
                const float4 w4 = *(const float4*)(sv + j), b4 = *(const float4*)(sv + 128 + j), k4 = *(const float4*)(sv + 192 + j), r4 = *(const float4*)(sv + 256 + j);
                const f32x2v wlo = (f32x2v){w4.x, w4.y}, whi = (f32x2v){w4.z, w4.w}, blo = (f32x2v){b4.x, b4.y}, bhi = (f32x2v){b4.z, b4.w};
                const f32x2v klo = (f32x2v){k4.x, k4.y}, khi = (f32x2v){k4.z, k4.w}, rlo = (f32x2v){r4.x, r4.y}, rhi = (f32x2v){r4.z, r4.w};
                S0[j / 2] = S0[j / 2] * wlo + saa * blo + vv * klo; y2 += S0[j / 2] * rlo;
                S0[j / 2 + 1] = S0[j / 2 + 1] * whi + saa * bhi + vv * khi; y3 += S0[j / 2 + 1] * rhi;
                if (IDENT) { S1[j / 2] = S1[j / 2] * wlo + sbb * blo; e2 += S1[j / 2] * rlo; S1[j / 2 + 1] = S1[j / 2 + 1] * whi + sbb * bhi; e3 += S1[j / 2 + 1] * rhi; } }
            YD[co[s]] = (y2.x + y2.y) + (y3.x + y3.y);
            if (IDENT) { const int tl = d ? (SEQ - 1 - (step0 - CTX + c * SCH + s)) : (step0 - CTX + c * SCH + s); E[(size_t)tl * 64 + lane] = f2bf((e2.x + e2.y) + (e3.x + e3.y)); }
        }
    }
    float* ZP = (float*)(P.ws + WS_ZP) + ((size_t)chain * NSEG + g) * 2 * 4096;
#pragma unroll
    for (int j = 0; j < 32; j += 2) { *(float4*)(ZP + lane * 64 + 2 * j) = make_float4(S0[j].x, S0[j].y, S0[j + 1].x, S0[j + 1].y);
        if (IDENT) *(float4*)(ZP + 4096 + lane * 64 + 2 * j) = make_float4(S1[j].x, S1[j].y, S1[j + 1].x, S1[j + 1].y); }
}
__device__ void scan_combine(const Params& P, int chain, float* lds) {
    const int tid = otid(); const int i = tid >> 3, j0 = (tid & 7) * 8;
    float* Sl = lds;
    float* Pl = lds + 64 * 65;
    float* ZPc = (float*)(P.ws + WS_ZP) + (size_t)chain * NSEG * 2 * 4096;
    float sn[8];
#pragma unroll
    for (int q = 0; q < 8; ++q) sn[q] = ZPc[i * 64 + j0 + q];
    for (int g = 1; g < NSEG - 1; ++g) {
        __syncthreads();
#pragma unroll
        for (int q = 0; q < 8; ++q) Sl[i * 65 + j0 + q] = sn[q];
        const float* Pg = ZPc + (size_t)g * 2 * 4096 + 4096;
#pragma unroll
        for (int q = 0; q < 8; ++q) Pl[tid * 8 + q] = Pg[tid * 8 + q];
        float* Zg = ZPc + (size_t)g * 2 * 4096;
#pragma unroll
        for (int q = 0; q < 8; ++q) sn[q] = Zg[i * 64 + j0 + q];
        __syncthreads();
        for (int m = 0; m < 64; ++m) { const float sv = Sl[i * 65 + m]; const float4 p0 = *(const float4*)(Pl + m * 64 + j0), p1 = *(const float4*)(Pl + m * 64 + j0 + 4);
            sn[0] += sv * p0.x; sn[1] += sv * p0.y; sn[2] += sv * p0.z; sn[3] += sv * p0.w; sn[4] += sv * p1.x; sn[5] += sv * p1.y; sn[6] += sv * p1.z; sn[7] += sv * p1.w; }
#pragma unroll
        for (int q = 0; q < 8; ++q) Zg[i * 64 + j0 + q] = sn[q];
    }
    __syncthreads();
}

__device__ __forceinline__ void rwkv_out_store(const Params& P, int l, int row, int h, int lane, float y) {
    const int c = h * 64 + lane; const size_t o = (size_t)row * 384 + c;
    const bf16_t* VS = (const bf16_t*)(P.ws + WS_VS); const bf16_t* GT = (const bf16_t*)(P.ws + WS_GATE); const float* BON = (const float*)(P.ws + WS_BONUS); bf16_t* MIX = (bf16_t*)(P.ws + WS_U);
    const float mean = wsum(y) * (1.0f / 64.0f); const float dv = y - mean; const float var = wsum(dv * dv) * (1.0f / 64.0f);
    const float yn = dv * rsqrtf(var + 64e-5f) * P.in[I_LNW][l * RWW + c] + P.in[I_LNB][l * RWW + c];
    MIX[(size_t)row * D + 256 + c] = f2bf((yn + BON[(size_t)row * 6 + h] * bf2f(VS[o])) * bf2f(GT[o]));
}
constexpr int OCH = 8;
__device__ void ph_rwkvout(const Params& P, int l, float* ldsf) {
    const int tid = otid(), lane = tid & 63, wv = tid >> 6, gw = blockIdx.x * NWAVE + wv, nw = gridDim.x * NWAVE;
    const float* YD = (const float*)(P.ws + WS_YDIR);
    float* est = ldsf + wv * (OCH * 128);
    for (int it = gw; it < NB * 6 * 32 * 4; it += nw) {
        const int sub = it & 3, q = (it >> 2) & 31, h = (it >> 7) % 6, b = it / (128 * 6);
        const int chf = b * 12 + h * 2, chb = chf + 1;
        const float* Sfp = (const float*)(P.ws + WS_ZP) + ((size_t)chf * NSEG + q) * 2 * 4096 + lane * 64;
        const float* Sbp = (const float*)(P.ws + WS_ZP) + ((size_t)chb * NSEG + (31 - q)) * 2 * 4096 + lane * 64;
        float Sf[64], Sb[64];
#pragma unroll
        for (int j = 0; j < 64; j += 4) { const float4 a = *(const float4*)(Sfp + j), c4 = *(const float4*)(Sbp + j);
            Sf[j] = a.x; Sf[j + 1] = a.y; Sf[j + 2] = a.z; Sf[j + 3] = a.w; Sb[j] = c4.x; Sb[j + 1] = c4.y; Sb[j + 2] = c4.z; Sb[j + 3] = c4.w; }
        const bf16_t* Ef = (const bf16_t*)(P.ws + WS_E) + (size_t)chf * SEQ * 64; const bf16_t* Eb = (const bf16_t*)(P.ws + WS_E) + (size_t)chb * SEQ * 64;
        const int t0 = q * 256 + sub * 64;
        for (int tg = 0; tg < 64; tg += OCH) {
            asm volatile("s_waitcnt lgkmcnt(0)" ::: "memory");
#pragma unroll
            for (int s = 0; s < OCH; ++s) { const int t = t0 + tg + s; est[s * 128 + lane] = bf2f(Ef[(size_t)t * 64 + lane]); est[s * 128 + 64 + lane] = bf2f(Eb[(size_t)t * 64 + lane]); }
            asm volatile("s_waitcnt lgkmcnt(0)" ::: "memory");
#pragma unroll 1
            for (int s = 0; s < OCH; ++s) { const int t = t0 + tg + s, row = b * SEQ + t; const size_t o = (size_t)row * 384 + h * 64 + lane;
                float c0 = 0.f, c1 = 0.f, c2 = 0.f, c3 = 0.f;
#pragma unroll
                for (int j = 0; j < 64; j += 4) { const float4 ef = *(const float4*)(est + s * 128 + j), eb = *(const float4*)(est + s * 128 + 64 + j);
                    c0 += Sf[j] * ef.x + Sb[j] * eb.x; c1 += Sf[j + 1] * ef.y + Sb[j + 1] * eb.y; c2 += Sf[j + 2] * ef.z + Sb[j + 2] * eb.z; c3 += Sf[j + 3] * ef.w + Sb[j + 3] * eb.w;
                    if ((j & 15) == 12) asm volatile("" ::: "memory"); }
                const float y = YD[o] + YD[(size_t)T * 384 + o] + ((c0 + c1) + (c2 + c3));
                rwkv_out_store(P, l, row, h, lane, y); }
        }
    }
    for (int it = gw; it < TC * 6; it += nw) { const int row = TL + it / 6, h = it % 6; const size_t o = (size_t)row * 384 + h * 64 + lane;
        rwkv_out_store(P, l, row, h, lane, YD[o] + YD[(size_t)T * 384 + o]); }
}

typedef const __attribute__((address_space(4))) Params* KParamsPtr;
__device__ __forceinline__ const Params* fresh_params() { KParamsPtr q = (KParamsPtr)__builtin_amdgcn_kernarg_segment_ptr(); asm volatile("" : "+s"(q)); return (const Params*)q; }
__global__ void __launch_bounds__(NTHR, 2) fwd_megakernel(Params P_unused, int ph_lo, int ph_hi) {
    extern __shared__ __attribute__((aligned(16))) unsigned char smem[];
    cg::grid_group grid = cg::this_grid();
    LAS unsigned char* lds3 = (LAS unsigned char*)smem;
    float* ldsf = (float*)smem; float2* X = (float2*)smem; float* ex = (float*)(smem + LDS_MAIN);
    int ph = 0;
#define PHASE_BEGIN if (ph >= ph_lo && ph < ph_hi) { const Params& P = *fresh_params(); unsigned char* ws = P.ws; (void)ws;
#define PHASE_END   if (ph + 1 < ph_hi) grid.sync(); } ++ph;
    PHASE_BEGIN ph_modv(P, ldsf); PHASE_END
    for (int l = 0; l < DEPTH; ++l) {
        PHASE_BEGIN
            ph_prep(P, l, ldsf);
            if (l == 0) ph_rowpass(P, 0, 0, 0, 0, 0.f, 0, 0, 0, 1);
            else ph_rowpass(P, 1, l - 1, 8, 5, 0.5f, l, 0, 0, 1);
        PHASE_END
        PHASE_BEGIN { EpiGU E{(bf16_t*)(ws + WS_ACT)}; run_gemm(lds3, (const bf16_t*)(ws + WS_U), (const bf16_t*)(ws + WS_WGU1), T, 2 * DFF, D, E); } PHASE_END
        PHASE_BEGIN { EpiF32 E{(float*)(ws + WS_Y)}; run_gemm(lds3, (const bf16_t*)(ws + WS_ACT), (const bf16_t*)(ws + WS_WDN1), T, D, DFF, E); } PHASE_END
        PHASE_BEGIN ph_rowpass(P, 1, l, 2, 1, 0.5f, l, 2, 3, 4); PHASE_END
        PHASE_BEGIN { EpiWin E{(bf16_t*)(ws + WS_PHY), (bf16_t*)(ws + WS_PRW), (bf16_t*)(ws + WS_PNA)}; run_gemm(lds3, (const bf16_t*)(ws + WS_U), (const bf16_t*)(ws + WS_WIN), T, INWP, D, E); } PHASE_END
        PHASE_BEGIN
            ph_loraprep(P, l);
            for (int it = blockIdx.x; it < NB * 128 * 6 + NB * 4 * 6; it += gridDim.x) vt_tile(P, it, (unsigned short*)smem);
            for (int it = blockIdx.x; it < 512; it += gridDim.x) hy_spec_task(P, l, it >> 8, it & 255, X, ex);
        PHASE_END
        PHASE_BEGIN { EpiLora E{(bf16_t*)(ws + WS_LORAO), (bf16_t*)(ws + WS_GATE)};
            run_gemm(lds3, (const bf16_t*)(ws + WS_ALORA), (const bf16_t*)(ws + WS_WLORA), T, 2048, 384, E); } PHASE_END
        PHASE_BEGIN
            ph_rwkvprep(P, l);
            for (int c = blockIdx.x; c < HYC; c += gridDim.x) hy_task1(P, l, c, X, ex);
        PHASE_END
        PHASE_BEGIN {
            const int wv = __builtin_amdgcn_readfirstlane(otid() >> 6);
            if (wv < 4) { const int k = wv * (int)gridDim.x + (int)blockIdx.x;
                if (k < 24 * NSEG) { const int chain = k / NSEG, g = k % NSEG; float* ring = ldsf + wv * (SCH * 320);
                    if (g == 0) scan_seg<false>(P, chain, g, ring); else scan_seg<true>(P, chain, g, ring); } }
            else for (int it = (wv - 4) * (int)gridDim.x + (int)blockIdx.x; it < NAT_TASKS; it += 4 * (int)gridDim.x) natten_task(P, l, it);
        } PHASE_END
        PHASE_BEGIN
            if (blockIdx.x < 24) scan_combine(P, blockIdx.x, ldsf);
            else for (int c = blockIdx.x - 24; c < HYC; c += gridDim.x - 24) hy_task2(P, l, c, X);
        PHASE_END
        PHASE_BEGIN ph_rwkvout(P, l, ldsf); PHASE_END
        PHASE_BEGIN { EpiF32 E{(float*)(ws + WS_Y)}; run_gemm(lds3, (const bf16_t*)(ws + WS_U), (const bf16_t*)(ws + WS_WOUT), T, D, D, E); } PHASE_END
        PHASE_BEGIN ph_rowpass(P, 1, l, 5, 3, 1.0f, l, 4, 6, 7); PHASE_END
        PHASE_BEGIN { EpiGU E{(bf16_t*)(ws + WS_ACT)}; run_gemm(lds3, (const bf16_t*)(ws + WS_U), (const bf16_t*)(ws + WS_WGU2), T, 2 * DFF, D, E); } PHASE_END
        PHASE_BEGIN { EpiF32 E{(float*)(ws + WS_Y)}; run_gemm(lds3, (const bf16_t*)(ws + WS_ACT), (const bf16_t*)(ws + WS_WDN2), T, D, DFF, E); } PHASE_END
    }
    PHASE_BEGIN ph_rowpass(P, 2, DEPTH - 1, 8, 5, 0.5f, 0, 0, 0, 0); PHASE_END
#undef PHASE_BEGIN
#undef PHASE_END
}
constexpr int N_PHASES = 1 + DEPTH * 15 + 1;

extern "C" void kernel_launch(void* const* d_in, const int* in_sizes, int n_in, void* d_out, int out_size, void* d_ws, size_t ws_size, hipStream_t stream) {
    static int grid = 0;
    if (grid == 0) {
        if (n_in != 34 || ws_size < WS_END) { fprintf(stderr, "kernel_launch: need 34 inputs and %zu bytes of workspace; got %d, %zu\n", (size_t)WS_END, n_in, ws_size); grid = -1; return; }
        int dev = 0, cus = 0, per_cu = 0;
        hipGetDevice(&dev); hipDeviceGetAttribute(&cus, hipDeviceAttributeMultiprocessorCount, dev);
        if (hipFuncSetAttribute((const void*)fwd_megakernel, hipFuncAttributeMaxDynamicSharedMemorySize, LDS_BYTES) != hipSuccess) { fprintf(stderr, "kernel_launch: hipFuncSetAttribute failed\n"); grid = -1; return; }
        if (hipOccupancyMaxActiveBlocksPerMultiprocessor(&per_cu, (const void*)fwd_megakernel, NTHR, LDS_BYTES) != hipSuccess || per_cu < 1) { fprintf(stderr, "kernel_launch: occupancy query says %d\n", per_cu); per_cu = 1; }
        (void)hipGetLastError();
        grid = cus;
    }
    if (grid < 0) return;
    Params p{};
    for (int i = 0; i < 34; ++i) p.in[i] = (const float*)d_in[i];
    p.out = (float*)d_out; p.ws = (unsigned char*)d_ws;
#if MK_SPLIT
    for (int ph = 0; ph < N_PHASES; ++ph) { int lo = ph, hi = ph + 1; hipLaunchKernelGGL(fwd_megakernel, dim3(grid), dim3(NTHR), LDS_BYTES, stream, p, lo, hi); }
#else
    int lo = 0, hi = N_PHASES;
    void* args[] = {&p, &lo, &hi};
    hipError_t e = hipLaunchCooperativeKernel((const void*)fwd_megakernel, dim3(grid), dim3(NTHR), args, LDS_BYTES, stream);
    if (e != hipSuccess) fprintf(stderr, "cooperative launch failed: %s (grid %d)\n", hipGetErrorString(e), grid);
#endif
}
```

```cpp
#include <hip/hip_runtime.h>
#include <hip/hip_cooperative_groups.h>
#include <cstdio>
namespace cg = cooperative_groups;
__device__ __forceinline__ int otid() { int t = threadIdx.x; asm volatile("" : "+v"(t)); return t; }
namespace pg8 {
#define PG8_LAS __attribute__((address_space(3)))
typedef unsigned short bf16_t;
typedef short bf16x8 __attribute__((ext_vector_type(8)));
typedef float f32x4 __attribute__((ext_vector_type(4)));
typedef unsigned u32x4 __attribute__((ext_vector_type(4)));
constexpr int BM = 256, BK = 64, HALF = 128, HTB = HALF * BK * 2  , STAGE_BYTES = 8 * HTB, NXCD = 8, WGM = 8;

__host__ __device__ __forceinline__ int lds_byte(int r, int c) { const int st = (r >> 4) * 2 + (c >> 5), rr = r & 15, cc = c & 31, ob = rr * 64 + cc * 2; return st * 1024 + (ob ^ (((ob >> 9) & 1) << 5)); }
__host__ __device__ __forceinline__ void stage_rc(int b, int& R, int& C) { const int st = b / 1024, sb = b % 1024, swz = sb ^ (((sb >> 9) & 1) << 5); R = (st >> 1) * 16 + swz / 64; C = (st & 1) * 32 + (swz % 64) / 2; }
__host__ __device__ __forceinline__ int perm32(int rho) { const int n = rho >> 4, i = rho & 15; return 8 * (i >> 2) + 4 * n + (i & 3); }

struct Unit { int pm, pn; };
struct Gemm { const bf16_t* A; const bf16_t* Bt; int M, N, K; };
struct StaticOrder {
    int nM, nN, nwg, G, c;
    __host__ __device__ void init(int M, int N, int G_, int c_) { nM = M / BM; nN = N / BM; nwg = nM * nN; G = G_; c = c_; }
    __host__ __device__ bool next(int i, Unit& u) const {
        const long L = (long)i * G + c; if (L >= nwg) return false;
        int wgid = (int)L; { const int q = nwg / NXCD, r = nwg % NXCD, xcd = wgid % NXCD, off = wgid / NXCD; wgid = (xcd < r ? xcd * (q + 1) : r * (q + 1) + (xcd - r) * q) + off; }
        const int nig = WGM * nN, gid = wgid / nig, fm = gid * WGM, gsz = (nM - fm) < WGM ? (nM - fm) : WGM;
        u.pm = fm + ((wgid % nig) % gsz); u.pn = (wgid % nig) / gsz; return true;
    }
    __device__ __forceinline__ void a_ready(const Unit&) const {}
    __device__ __forceinline__ void done(const Unit&) const {}
};
__device__ __forceinline__ unsigned cvt_pk_bf16(float lo, float hi) { unsigned r; asm volatile("v_cvt_pk_bf16_f32 %0, %1, %2" : "=v"(r) : "v"(lo), "v"(hi)); return r; }
template <class Epi, class Sched>
__device__ __forceinline__ void gemm_phase(PG8_LAS unsigned char* lds, const Gemm g, const Sched& S, const Epi& E) {
    const int tid = otid(), wid = __builtin_amdgcn_readfirstlane(tid >> 6), lane = tid & 63, wr = wid >> 2, wc = wid & 3, fr = lane & 15, fq = lane >> 4;
    const int K = g.K, nt = K / BK;
#define PG8_STAMP() do {} while (0)
    unsigned voffA[2], voffB[2];
#pragma unroll
    for (int i = 0; i < 2; ++i) { int R, C; stage_rc(tid * 16 + i * 8192, R, C); const int Rb = Epi::PERM ? ((R & ~31) + perm32(R & 31)) : R;
        voffA[i] = (unsigned)(R * K + C) * 2u; voffB[i] = (unsigned)(Rb * K + C) * 2u; }
    const size_t kstep = (size_t)(BK * 2);
    const size_t hstep = (size_t)HALF * K * 2;
    const size_t tstep = 2 * hstep;
    const unsigned ldsw = (unsigned)wid * 1024u;
    const int aoff = lds_byte(wr * 64 + fr, fq * 8), boff = lds_byte(wc * 32 + fr, fq * 8);
#define PG8_SA(b, h) (((b) * 2 + (h)) * HTB)
#define PG8_SB(b, h) ((4 + (b) * 2 + (h)) * HTB)
#define PG8_STAGE(bufoff, gbase, voff) do { _Pragma("unroll") for (int _i = 0; _i < 2; ++_i) \
        __builtin_amdgcn_global_load_lds((const unsigned*)((const char*)(gbase) + (voff)[_i]), (PG8_LAS unsigned*)(lds + (bufoff) + ldsw + _i * 8192), 16, 0, 0); } while (0)
#define PG8_LDA(dst, b, h) do { _Pragma("unroll") for (int m = 0; m < 4; ++m) _Pragma("unroll") for (int k = 0; k < 2; ++k) dst[m][k] = *(const PG8_LAS bf16x8*)(lds + PG8_SA(b, h) + aoff + m * 2048 + k * 1024); } while (0)
#define PG8_LDB(dst, b, h) do { _Pragma("unroll") for (int n = 0; n < 2; ++n) _Pragma("unroll") for (int k = 0; k < 2; ++k) dst[n][k] = *(const PG8_LAS bf16x8*)(lds + PG8_SB(b, h) + boff + n * 2048 + k * 1024); } while (0)
#define PG8_MMA(ai, bj, At, Bt) do { __builtin_amdgcn_s_setprio(1); _Pragma("unroll") for (int m = 0; m < 4; ++m) _Pragma("unroll") for (int n = 0; n < 2; ++n) _Pragma("unroll") for (int k = 0; k < 2; ++k) \
        acc[ai][bj][m][n] = __builtin_amdgcn_mfma_f32_16x16x32_bf16(Bt[n][k], At[m][k], acc[ai][bj][m][n], 0, 0, 0); __builtin_amdgcn_s_setprio(0); } while (0)
#define PG8_WAIT_V(n) asm volatile("s_waitcnt vmcnt(" #n ")" ::: "memory")
#define PG8_WAIT_L(n) asm volatile("s_waitcnt lgkmcnt(" #n ")" ::: "memory")
#define PG8_BAR __builtin_amdgcn_s_barrier()
#define PG8_SCHED __builtin_amdgcn_sched_barrier(0)
    Unit cur, nxt; int ui = 0;
    if (!S.next(0, cur)) return;
    f32x4 acc[2][2][4][2];
#pragma unroll
    for (int a = 0; a < 2; ++a)
#pragma unroll
        for (int b = 0; b < 2; ++b)
#pragma unroll
            for (int m = 0; m < 4; ++m)
#pragma unroll
                for (int n = 0; n < 2; ++n) acc[a][b][m][n] = (f32x4){0.f, 0.f, 0.f, 0.f};
    bf16x8 At[4][2], B0[2][2], B1[2][2];
    const char* cA = (const char*)g.A + (size_t)cur.pm * tstep; const char* cB = (const char*)g.Bt + (size_t)cur.pn * tstep;
    S.a_ready(cur);
    PG8_STAGE(PG8_SB(0, 0), cB, voffB); PG8_STAGE(PG8_SA(0, 0), cA, voffA); PG8_STAGE(PG8_SB(0, 1), cB + hstep, voffB); PG8_STAGE(PG8_SA(0, 1), cA + hstep, voffA);
    if (wr == 1) PG8_BAR;
    PG8_WAIT_V(4); PG8_BAR;
    PG8_STAGE(PG8_SB(1, 0), cB + kstep, voffB); PG8_STAGE(PG8_SA(1, 0), cA + kstep, voffA); PG8_STAGE(PG8_SB(1, 1), cB + hstep + kstep, voffB);
    PG8_WAIT_V(6); PG8_BAR;
    PG8_STAMP();
    for (;;) {
        const bool has_next = S.next(ui + 1, nxt);
        const char* nA = has_next ? (const char*)g.A + (size_t)nxt.pm * tstep : cA; const char* nB = has_next ? (const char*)g.Bt + (size_t)nxt.pn * tstep : cB;
        for (int t = 0; t < nt; t += 2) {
            const bool last = (t == nt - 2);
            const char* a1 = cA + (size_t)(t + 1) * kstep;
            const char* a2 = last ? nA : cA + (size_t)(t + 2) * kstep; const char* b2 = last ? nB : cB + (size_t)(t + 2) * kstep;
            const char* a3 = a2 + kstep; const char* b3 = b2 + kstep;
            if (last && has_next) S.a_ready(nxt);
            PG8_LDB(B0, 0, 0); PG8_SCHED; PG8_LDA(At, 0, 0); PG8_STAGE(PG8_SA(1, 1), a1 + hstep, voffA);
            PG8_WAIT_L(8); PG8_BAR; PG8_WAIT_L(0); PG8_MMA(0, 0, At, B0); PG8_BAR; PG8_SCHED;
            PG8_LDB(B1, 0, 1); PG8_STAGE(PG8_SB(0, 0), b2, voffB);
            PG8_BAR; PG8_WAIT_L(0); PG8_MMA(0, 1, At, B1); PG8_BAR;
            PG8_LDA(At, 0, 1); PG8_STAGE(PG8_SA(0, 0), a2, voffA);
            PG8_BAR; PG8_WAIT_L(0); PG8_MMA(1, 0, At, B0); PG8_BAR; PG8_SCHED;
            PG8_STAGE(PG8_SB(0, 1), b2 + hstep, voffB);
            PG8_WAIT_V(6); PG8_BAR; PG8_MMA(1, 1, At, B1); PG8_BAR;
            PG8_LDB(B0, 1, 0); PG8_SCHED; PG8_LDA(At, 1, 0); PG8_STAGE(PG8_SA(0, 1), a2 + hstep, voffA);
            PG8_WAIT_L(8); PG8_BAR; PG8_WAIT_L(0); PG8_MMA(0, 0, At, B0); PG8_BAR; PG8_SCHED;
            PG8_LDB(B1, 1, 1); PG8_STAGE(PG8_SB(1, 0), b3, voffB);
            PG8_BAR; PG8_WAIT_L(0); PG8_MMA(0, 1, At, B1); PG8_BAR;
            PG8_LDA(At, 1, 1); PG8_STAGE(PG8_SA(1, 0), a3, voffA);
            PG8_BAR; PG8_WAIT_L(0); PG8_MMA(1, 0, At, B0); PG8_BAR; PG8_SCHED;
            PG8_STAGE(PG8_SB(1, 1), b3 + hstep, voffB);
            PG8_WAIT_V(6); PG8_BAR; PG8_MMA(1, 1, At, B1); PG8_BAR;
        }
        PG8_STAMP();
        if constexpr (!Epi::AFTER_DRAIN) { E(acc, cur, wr, wc, fr, fq); S.done(cur); }
        PG8_STAMP();
        if (!has_next) break;
#pragma unroll
        for (int a = 0; a < 2; ++a)
#pragma unroll
            for (int b = 0; b < 2; ++b)
#pragma unroll
                for (int m = 0; m < 4; ++m)
#pragma unroll
                    for (int n = 0; n < 2; ++n) acc[a][b][m][n] = (f32x4){0.f, 0.f, 0.f, 0.f};
        cur = nxt; cA = nA; cB = nB; ++ui;
    }
    PG8_WAIT_V(0);
    if (wr == 0) PG8_BAR;
    PG8_BAR;
    if constexpr (Epi::AFTER_DRAIN) { E.fused(acc, cur, wr, wc, fr, fq, lds, wid, lane); S.done(cur); }
    PG8_STAMP();
#undef PG8_STAMP
#undef PG8_SA
#undef PG8_SB
#undef PG8_STAGE
#undef PG8_LDA
#undef PG8_LDB
#undef PG8_MMA
#undef PG8_WAIT_V
#undef PG8_WAIT_L
#undef PG8_BAR
#undef PG8_SCHED
}
}
#define LAS __attribute__((address_space(3)))
#define XB_TMO      128
#define XB_XCNT(j)  (256  + 64 * (j))
#define XB_XSUB(j)  (1280 + 64 * (j))
#define XB_XGEN(j)  (2304 + 64 * (j))
#define XB_TOP      3328
#define XB_TOPGEN   3392
#define XCD_BAR_WORDS 3456
#define XB_SPIN_CAP (1u << 18)

__device__ __forceinline__ unsigned xb_ld(unsigned* p)              { return __hip_atomic_load(p, __ATOMIC_RELAXED, __HIP_MEMORY_SCOPE_AGENT); }
__device__ __forceinline__ unsigned xb_add(unsigned* p, unsigned v) { return __hip_atomic_fetch_add(p, v, __ATOMIC_RELAXED, __HIP_MEMORY_SCOPE_AGENT); }
__device__ __forceinline__ unsigned xb_xcc_id() { return (unsigned)__builtin_amdgcn_s_getreg((3 << 11) | 20) & 0xFu; }
#define XB_SPIN(cond, bar) do { unsigned _sp = 0; while (cond) { __builtin_amdgcn_s_sleep(1); \
    if ((++_sp & 255u) == 0u) { if (xb_ld(&(bar)[XB_TMO])) break; if (_sp > XB_SPIN_CAP) { atomicAdd(&(bar)[XB_TMO], 1u); break; } } } } while (0)

struct XcdBarrier {
    unsigned* bar; unsigned x;
    volatile LAS unsigned* st;
};

__device__ __forceinline__ XcdBarrier xcd_barrier_post(unsigned* bar, volatile LAS unsigned* st) {
    XcdBarrier b; b.bar = bar; b.x = xb_xcc_id(); b.st = st;
    if (threadIdx.x == 0) (void)xb_add(&bar[XB_XCNT(b.x)], 1u);
    return b;
}
__device__ __forceinline__ void xcd_barrier_complete(unsigned* bar, unsigned x, unsigned& nloc, unsigned& nx) {
    const unsigned G = gridDim.x * gridDim.y * gridDim.z;
    unsigned sum, cnt, mine, sp = 0u;
    for (;;) {
        sum = 0u; cnt = 0u; mine = 0u;
#pragma unroll
        for (unsigned j = 0; j < 16; ++j) { const unsigned c = xb_ld(&bar[XB_XCNT(j)]); sum += c; cnt += (c > 0u) ? 1u : 0u; mine = (j == x) ? c : mine; }
        if (sum == G) break;
        __builtin_amdgcn_s_sleep(1);
        if ((++sp & 255u) == 0u) { if (xb_ld(&bar[XB_TMO])) break; if (sp > XB_SPIN_CAP) { atomicAdd(&bar[XB_TMO], 1u); break; } }
    }
    nloc = mine > 0u ? mine : 1u; nx = cnt > 0u ? cnt : 1u;
}

__device__ __forceinline__ void xcd_barrier(const XcdBarrier& b) {
    asm volatile("s_waitcnt vmcnt(0)" ::: "memory");
    __syncthreads();
    if (threadIdx.x == 0) {
        unsigned* bar = b.bar;
        __builtin_amdgcn_s_waitcnt(0);
        unsigned nloc = b.st[0], nx = b.st[1];
        if (nloc == 0u) { xcd_barrier_complete(bar, b.x, nloc, nx); b.st[0] = nloc; b.st[1] = nx; }
        const unsigned old = xb_add(&bar[XB_XSUB(b.x)], 1u);
        const unsigned gen = old / nloc;
        if (old + 1u == (gen + 1u) * nloc) {
            __builtin_amdgcn_fence(__ATOMIC_RELEASE, "agent");
            asm volatile("s_waitcnt vmcnt(0)" ::: "memory");
            const unsigned og = xb_add(&bar[XB_TOP], 1u);
            const unsigned tg = og / nx;
            if (og + 1u == (tg + 1u) * nx) xb_add(&bar[XB_TOPGEN], 1u);
            else XB_SPIN(xb_ld(&bar[XB_TOPGEN]) == tg, bar);
            __builtin_amdgcn_fence(__ATOMIC_ACQUIRE, "agent");
            xb_add(&bar[XB_XGEN(b.x)], 1u);
            asm volatile("s_waitcnt vmcnt(0)" ::: "memory");
        } else {
            XB_SPIN(xb_ld(&bar[XB_XGEN(b.x)]) == gen, bar);
            __builtin_amdgcn_fence(__ATOMIC_ACQUIRE, "agent");
            asm volatile("s_waitcnt vmcnt(0)" ::: "memory");
        }
    }
    __syncthreads();
}

using pg8::bf16_t; using pg8::f32x4; using pg8::u32x4; using pg8::cvt_pk_bf16;
typedef unsigned u32x2 __attribute__((ext_vector_type(2)));


constexpr int D = 1024, NB = 2, SEQ = 8192, DEPTH = 4, CTX = 256, DFF = 2816;
constexpr int TL = NB * SEQ, TC = NB * CTX, T = TL + TC;
constexpr int NMOD = 9 * D;
constexpr int HYC = 256, RWW = 384, NAW = 384, INW = 3456, INWP = 3584;
constexpr int HY_IN = 768, RW_IN = 1536, NA_IN = 1152;
constexpr int NFFT = 16384;
constexpr int NTHR = 512, NWAVE = 8;
constexpr int LDS_MAIN = 131072, LDS_EXTRA = 8192, LDS_BYTES = LDS_MAIN + LDS_EXTRA;
constexpr float NORM_EPS = 1e-6f;

constexpr size_t al256(size_t x) { return (x + 255) & ~(size_t)255; }
constexpr size_t WS_MODV = 0;
constexpr size_t WS_WGU1 = al256(WS_MODV + (size_t)DEPTH * 3 * NMOD * 4);
constexpr size_t WS_WDN1 = WS_WGU1 + (size_t)2 * DFF * D * 2;
constexpr size_t WS_WGU2 = WS_WDN1 + (size_t)D * DFF * 2;
constexpr size_t WS_WDN2 = WS_WGU2 + (size_t)2 * DFF * D * 2;
constexpr size_t WS_WIN = WS_WDN2 + (size_t)D * DFF * 2;
constexpr size_t WS_WOUT = WS_WIN + (size_t)INWP * D * 2;
constexpr size_t WS_WLORA = WS_WOUT + (size_t)D * D * 2;
constexpr size_t WS_H = WS_WLORA + (size_t)2048 * 384 * 2;
constexpr size_t WS_U = WS_H + (size_t)T * D * 4;
constexpr size_t WS_S = WS_U + (size_t)T * D * 2;
constexpr size_t WS_Y = WS_S;
constexpr size_t WS_ACT = WS_Y + (size_t)T * D * 4;
constexpr size_t WS_FFN_END = WS_ACT + (size_t)T * DFF * 2;
constexpr size_t WS_PHY = WS_S;
constexpr size_t WS_PRW = WS_PHY + (size_t)T * HY_IN * 2;
constexpr size_t WS_YDIR = WS_PRW;
constexpr size_t WS_PNA = WS_PRW + (size_t)T * RW_IN * 2;
constexpr size_t WS_ALORA = WS_PNA + (size_t)T * NA_IN * 2;
constexpr size_t WS_DECAY = WS_ALORA + (size_t)T * 384 * 2;
constexpr size_t WS_LORAO = WS_DECAY + (size_t)2 * T * 384 * 4;
constexpr size_t WS_E = WS_LORAO;
constexpr size_t WS_ZP = WS_E + (size_t)24 * SEQ * 64 * 2;
constexpr size_t WS_GATE = WS_LORAO + (size_t)T * 1536 * 2;
static_assert(WS_ZP + (size_t)24 * 33 * 2 * 4096 * 4 <= WS_GATE, "E + ZP must fit in the LORAO region");
constexpr size_t WS_RS = WS_GATE + (size_t)T * 384 * 2;
constexpr size_t WS_KKS = WS_RS + (size_t)T * 384 * 2;
constexpr size_t WS_VS = WS_KKS + (size_t)T * 384 * 2;
constexpr size_t WS_KS = WS_VS + (size_t)T * 384 * 2;
constexpr size_t WS_BS = WS_KS + (size_t)2 * T * 384 * 2;
constexpr size_t WS_BONUS = WS_BS + (size_t)2 * T * 384 * 2;
constexpr size_t WS_H2 = al256(WS_BONUS + (size_t)T * 6 * 4);
constexpr size_t WS_SPEC = WS_H2 + (size_t)(SEQ + CTX) * 64 * 4;
constexpr size_t WS_Z1 = WS_SPEC + (size_t)512 * NFFT * 8;
constexpr size_t WS_VTL = WS_Z1 + (size_t)HYC * NB * SEQ * 4;
constexpr size_t WS_VTC = WS_VTL + (size_t)NB * 6 * 64 * SEQ * 2;
constexpr size_t WS_MIX_END = WS_VTC + (size_t)NB * 6 * 64 * CTX * 2;
constexpr size_t WS_BAR = al256(WS_MIX_END > WS_FFN_END ? WS_MIX_END : WS_FFN_END);
constexpr size_t WS_END = WS_BAR + (size_t)XCD_BAR_WORDS * 4;

struct Params { const float* in[34]; float* out; unsigned char* ws; };
enum { I_X = 0, I_C, I_CTX, I_CCTX, I_MODW, I_MODB, I_NORMG, I_F1GU, I_F1DN, I_F2GU, I_F2DN, I_WIN, I_WOUT, I_HCW, I_HCB, I_HW1, I_HB1, I_HW2, I_HB2, I_HW3, I_HFREQ, I_HBIAS,
       I_MU, I_W0, I_W2, I_A0, I_A2, I_G2, I_KK, I_KA, I_RK, I_LNW, I_LNB, I_RPB };

__device__ __forceinline__ float bf2f(bf16_t b) { return __uint_as_float(((unsigned)b) << 16); }
__device__ __forceinline__ bf16_t f2bf(float f) { unsigned u = __float_as_uint(f); u += 0x7FFFu + ((u >> 16) & 1u); return (bf16_t)(u >> 16); }
__device__ __forceinline__ float lo_bf(unsigned w) { return __uint_as_float(w << 16); }
__device__ __forceinline__ float hi_bf(unsigned w) { return __uint_as_float(w & 0xffff0000u); }
__device__ __forceinline__ float wsum(float v) {
#pragma unroll
    for (int o = 32; o > 0; o >>= 1) v += __shfl_xor(v, o);
    return v;
}
__device__ __forceinline__ float sigmoidf_(float x) { return __builtin_amdgcn_rcpf(1.0f + __expf(-x)); }
__device__ __forceinline__ void unpack8(const u32x4 w, float (&f)[8]) {
    f[0] = lo_bf(w.x); f[1] = hi_bf(w.x); f[2] = lo_bf(w.y); f[3] = hi_bf(w.y); f[4] = lo_bf(w.z); f[5] = hi_bf(w.z); f[6] = lo_bf(w.w); f[7] = hi_bf(w.w);
}
__device__ __forceinline__ void row_nbrs(int row, bool& hasp, bool& hasn) {
    if (row < TL) { const int t = row & (SEQ - 1); hasp = t > 0; hasn = t < SEQ - 1; }
    else { const int t = (row - TL) & (CTX - 1); hasp = t > 0; hasn = t < CTX - 1; }
}

__device__ __forceinline__ void ph_modv(const Params& P, float* lds) {
    const int tid = otid();
    float* sv = lds;
    float* red = lds + 3072;
    for (int i = tid; i < 3072; i += NTHR) { const int s = i >> 10, k = i & 1023; const float c = s < 2 ? P.in[I_C][s * 1024 + k] : P.in[I_CCTX][k]; sv[i] = c / (1.0f + expf(-c)); }
    __syncthreads();
    float* modv = (float*)(P.ws + WS_MODV);
    const int kc = tid >> 6, cl = tid & 63;
    for (int item = blockIdx.x; item < DEPTH * 144; item += gridDim.x) {
        const int l = item / 144, cb = item % 144, col = cb * 64 + cl;
        const float* w = P.in[I_MODW] + ((size_t)l * 1024 + kc * 128) * NMOD + col;
        float a0 = 0.f, a1 = 0.f, a2 = 0.f;
#pragma unroll 8
        for (int k = 0; k < 128; ++k) { const float wv = w[(size_t)k * NMOD]; a0 += sv[kc * 128 + k] * wv; a1 += sv[1024 + kc * 128 + k] * wv; a2 += sv[2048 + kc * 128 + k] * wv; }
        red[(0 * 8 + kc) * 64 + cl] = a0; red[(1 * 8 + kc) * 64 + cl] = a1; red[(2 * 8 + kc) * 64 + cl] = a2;
        __syncthreads();
        if (tid < 192) { const int s = tid >> 6, c = tid & 63; float r = P.in[I_MODB][l * NMOD + cb * 64 + c];
#pragma unroll
            for (int q = 0; q < 8; ++q) r += red[(s * 8 + q) * 64 + c];
            modv[((size_t)l * 3 + s) * NMOD + cb * 64 + c] = r; }
        __syncthreads();
    }
}

__device__ __forceinline__ int rowmap_gu(int n) { const int up = n >= DFF ? 1 : 0; const int j = n - up * DFF; return (j >> 7) * 256 + up * 128 + (j & 127); }
__device__ __forceinline__ void conv_tile(const float* __restrict__ src, int K, int N, bf16_t* __restrict__ dst, int tk, int tn, bool gu, float* tile) {
    const int tid = otid(); const int k0 = tk * 64, n0 = tn * 64;
#pragma unroll
    for (int rr = 0; rr < 2; ++rr) { const int kk = (tid >> 4) + rr * 32, n4 = (tid & 15) * 4; const float4 v = *(const float4*)(src + (size_t)(k0 + kk) * N + n0 + n4);
        tile[kk * 65 + n4 + 0] = v.x; tile[kk * 65 + n4 + 1] = v.y; tile[kk * 65 + n4 + 2] = v.z; tile[kk * 65 + n4 + 3] = v.w; }
    __syncthreads();
    { const int nn = tid >> 3, ks = (tid & 7) * 8; const int n = n0 + nn; const int row = gu ? rowmap_gu(n) : n;
      u32x4 w; w.x = cvt_pk_bf16(tile[(ks + 0) * 65 + nn], tile[(ks + 1) * 65 + nn]); w.y = cvt_pk_bf16(tile[(ks + 2) * 65 + nn], tile[(ks + 3) * 65 + nn]);
      w.z = cvt_pk_bf16(tile[(ks + 4) * 65 + nn], tile[(ks + 5) * 65 + nn]); w.w = cvt_pk_bf16(tile[(ks + 6) * 65 + nn], tile[(ks + 7) * 65 + nn]);
      *(u32x4*)(dst + (size_t)row * K + k0 + ks) = w; }
    __syncthreads();
}
__device__ __forceinline__ void ph_prep(const Params& P, int l, float* lds) {
    const int tid = otid();
    unsigned char* ws = P.ws;
    constexpr int N0 = 16 * 88, N1 = 44 * 16, N4 = 16 * 54, N5 = 16 * 16;
    constexpr int C0 = N0, C1 = C0 + N1, C2 = C1 + N0, C3 = C2 + N1, C4 = C3 + N4, C5 = C4 + N5;
    for (int it = blockIdx.x; it < C5; it += gridDim.x) {
        if (it < C0) { conv_tile(P.in[I_F1GU] + (size_t)l * D * 2 * DFF, D, 2 * DFF, (bf16_t*)(ws + WS_WGU1), it / 88, it % 88, true, lds); }
        else if (it < C1) { const int j = it - C0; conv_tile(P.in[I_F1DN] + (size_t)l * DFF * D, DFF, D, (bf16_t*)(ws + WS_WDN1), j / 16, j % 16, false, lds); }
        else if (it < C2) { const int j = it - C1; conv_tile(P.in[I_F2GU] + (size_t)l * D * 2 * DFF, D, 2 * DFF, (bf16_t*)(ws + WS_WGU2), j / 88, j % 88, true, lds); }
        else if (it < C3) { const int j = it - C2; conv_tile(P.in[I_F2DN] + (size_t)l * DFF * D, DFF, D, (bf16_t*)(ws + WS_WDN2), j / 16, j % 16, false, lds); }
        else if (it < C4) { const int j = it - C3; conv_tile(P.in[I_WIN] + (size_t)l * D * INW, D, INW, (bf16_t*)(ws + WS_WIN), j / 54, j % 54, false, lds); }
        else { const int j = it - C4; conv_tile(P.in[I_WOUT] + (size_t)l * D * D, D, D, (bf16_t*)(ws + WS_WOUT), j / 16, j % 16, false, lds); }
    }
    const int gtid = blockIdx.x * NTHR + tid, gn = gridDim.x * NTHR;
    { unsigned* z = (unsigned*)(ws + WS_WIN + (size_t)INW * D * 2); for (int i = gtid; i < (INWP - INW) * D / 2; i += gn) z[i] = 0u; }
    { bf16_t* wl = (bf16_t*)(ws + WS_WLORA);
      const float* w2 = P.in[I_W2] + (size_t)l * 2 * 64 * RWW; const float* a2 = P.in[I_A2] + (size_t)l * 2 * 64 * RWW; const float* g2 = P.in[I_G2] + (size_t)l * 128 * RWW;
      for (int i = gtid; i < 2048 * 384; i += gn) { const int k = i / 2048, j = i % 2048; float v = 0.f;
          if (j < 1920) { const int grp = j / 384, c = j % 384;
              if (grp == 0) { if (k < 64) v = w2[(size_t)k * RWW + c]; }
              else if (grp == 1) { if (k >= 64 && k < 128) v = w2[(size_t)(64 + k - 64) * RWW + c]; }
              else if (grp == 2) { if (k >= 128 && k < 192) v = a2[(size_t)(k - 128) * RWW + c]; }
              else if (grp == 3) { if (k >= 192 && k < 256) v = a2[(size_t)(64 + k - 192) * RWW + c]; }
              else { if (k >= 256) v = g2[(size_t)(k - 256) * RWW + c]; } }
          wl[(size_t)j * 384 + k] = f2bf(v); } }
    { float* h2 = (float*)(ws + WS_H2);
      const float* w1 = P.in[I_HW1] + (size_t)l * 33 * 64; const float* b1 = P.in[I_HB1] + l * 64; const float* w2f = P.in[I_HW2] + (size_t)l * 64 * 64; const float* b2 = P.in[I_HB2] + l * 64;
      const float* fqv = P.in[I_HFREQ] + l * 64;
      const int lane = tid & 63, gw = blockIdx.x * NWAVE + (tid >> 6), nw = gridDim.x * NWAVE;
      const float fq = fqv[lane], bb1 = b1[lane], bb2 = b2[lane];
      for (int n = gw; n < SEQ + CTX; n += nw) {
          const int L = n < SEQ ? SEQ : CTX, pos = n < SEQ ? n : n - SEQ;
          const float tt = (float)pos / (float)(L - 1);
          const float ang = 6.283185307179586f * (float)pos / (float)L;
          float z = 0.f;
          if (lane == 0) z = tt;
          else if (lane <= 16) { const float fr = 1e-4f + (float)(lane - 1) * ((15.0f - 1e-4f) / 15.0f); z = cosf(fr * ang); }
          else if (lane <= 32) { const float fr = 1e-4f + (float)(lane - 17) * ((15.0f - 1e-4f) / 15.0f); z = -sinf(fr * ang); }
          float a = bb1;
#pragma unroll
          for (int e = 0; e < 33; ++e) a += __shfl(z, e) * w1[e * 64 + lane];
          const float h1 = sinf(fq * a);
          float c = bb2;
#pragma unroll
          for (int i = 0; i < 64; ++i) c += __shfl(h1, i) * w2f[i * 64 + lane];
          h2[(size_t)n * 64 + lane] = sinf(fq * c);
      } }
}

__device__ __forceinline__ void ph_rowpass(const Params& P, int mode, int lpost, int gate_i, int gpost_i, float ps, int lpre, int gpre_i, int shift_i, int scale_i) {
    const int tid = otid(), lane = tid & 63, gw = blockIdx.x * NWAVE + (tid >> 6), nw = gridDim.x * NWAVE;
    const float* modv = (const float*)(P.ws + WS_MODV);
    float* H = (float*)(P.ws + WS_H); const float* Y = (const float*)(P.ws + WS_Y); bf16_t* U = (bf16_t*)(P.ws + WS_U);
    int cur_s = -1;
    float4 A[4], Bv[4], Cv[4];
#pragma unroll
    for (int j = 0; j < 4; ++j) { A[j] = make_float4(0.f, 0.f, 0.f, 0.f); Bv[j] = A[j]; Cv[j] = A[j]; }
    for (int row = gw; row < T; row += nw) {
        const int s = row < SEQ ? 0 : (row < TL ? 1 : 2);
        if (s != cur_s) { cur_s = s;
#pragma unroll
            for (int j = 0; j < 4; ++j) { const int e = lane * 4 + 256 * j;
                if (mode != 0) { const float4 g = *(const float4*)(modv + ((size_t)lpost * 3 + s) * NMOD + gate_i * D + e); const float4 gp = *(const float4*)(P.in[I_NORMG] + ((size_t)lpost * 6 + gpost_i) * D + e);
                    A[j] = make_float4(ps * g.x * gp.x, ps * g.y * gp.y, ps * g.z * gp.z, ps * g.w * gp.w); }
                if (mode != 2) { const float4 sc = *(const float4*)(modv + ((size_t)lpre * 3 + s) * NMOD + scale_i * D + e); const float4 gq = *(const float4*)(P.in[I_NORMG] + ((size_t)lpre * 6 + gpre_i) * D + e);
                    Bv[j] = make_float4(gq.x * (1.f + sc.x), gq.y * (1.f + sc.y), gq.z * (1.f + sc.z), gq.w * (1.f + sc.w));
                    Cv[j] = *(const float4*)(modv + ((size_t)lpre * 3 + s) * NMOD + shift_i * D + e); } } }
        float4 h[4];
        if (mode == 0) { const float* src = row < TL ? P.in[I_X] + (size_t)row * D : P.in[I_CTX] + (size_t)(row - TL) * D;
#pragma unroll
            for (int j = 0; j < 4; ++j) h[j] = *(const float4*)(src + lane * 4 + 256 * j);
        } else {
            float4 y[4]; float ss = 0.f;
#pragma unroll
            for (int j = 0; j < 4; ++j) { h[j] = *(const float4*)(H + (size_t)row * D + lane * 4 + 256 * j); y[j] = *(const float4*)(Y + (size_t)row * D + lane * 4 + 256 * j);
                ss += y[j].x * y[j].x + y[j].y * y[j].y + y[j].z * y[j].z + y[j].w * y[j].w; }
            ss = wsum(ss); const float r = rsqrtf(ss * (1.0f / D) + NORM_EPS);
#pragma unroll
            for (int j = 0; j < 4; ++j) { h[j].x += A[j].x * (y[j].x * r); h[j].y += A[j].y * (y[j].y * r); h[j].z += A[j].z * (y[j].z * r); h[j].w += A[j].w * (y[j].w * r); }
        }
        if (mode == 2) { if (row < TL) {
#pragma unroll
                for (int j = 0; j < 4; ++j) *(float4*)(P.out + (size_t)row * D + lane * 4 + 256 * j) = h[j]; }
            continue; }
        float s2 = 0.f;
#pragma unroll
        for (int j = 0; j < 4; ++j) { *(float4*)(H + (size_t)row * D + lane * 4 + 256 * j) = h[j]; s2 += h[j].x * h[j].x + h[j].y * h[j].y + h[j].z * h[j].z + h[j].w * h[j].w; }
        s2 = wsum(s2); const float r2 = rsqrtf(s2 * (1.0f / D) + NORM_EPS);
#pragma unroll
        for (int j = 0; j < 4; ++j) { u32x2 w; w.x = cvt_pk_bf16(h[j].x * r2 * Bv[j].x + Cv[j].x, h[j].y * r2 * Bv[j].y + Cv[j].y); w.y = cvt_pk_bf16(h[j].z * r2 * Bv[j].z + Cv[j].z, h[j].w * r2 * Bv[j].w + Cv[j].w);
            *(u32x2*)(U + (size_t)row * D + lane * 4 + 256 * j) = w; }
    }
}

struct EpiGU {
    static constexpr bool PERM = true, AFTER_DRAIN = false;
    bf16_t* O;
    __device__ __forceinline__ void operator()(const f32x4 (&acc)[2][2][4][2], const pg8::Unit& u, int wr, int wc, int fr, int fq) const {
        const int row0 = u.pm * 256 + wr * 64 + fr, col0 = u.pn * 128 + wc * 32 + 8 * fq;
#pragma unroll
        for (int ai = 0; ai < 2; ++ai)
#pragma unroll
            for (int m = 0; m < 4; ++m) { float o[8];
#pragma unroll
                for (int n = 0; n < 2; ++n)
#pragma unroll
                    for (int j = 0; j < 4; ++j) { const float g = acc[ai][0][m][n][j], up = acc[ai][1][m][n][j]; o[n * 4 + j] = g * __builtin_amdgcn_rcpf(1.0f + __expf(-g)) * up; }
                u32x4 w; w.x = cvt_pk_bf16(o[0], o[1]); w.y = cvt_pk_bf16(o[2], o[3]); w.z = cvt_pk_bf16(o[4], o[5]); w.w = cvt_pk_bf16(o[6], o[7]);
                *(u32x4*)(O + (size_t)(row0 + ai * 128 + m * 16) * DFF + col0) = w; }
    }
};
struct EpiF32 {
    static constexpr bool PERM = false, AFTER_DRAIN = false;
    float* C;
    __device__ __forceinline__ void operator()(const f32x4 (&acc)[2][2][4][2], const pg8::Unit& u, int wr, int wc, int fr, int fq) const {
        const int row0 = u.pm * 256 + wr * 64 + fr, col0 = u.pn * 256 + wc * 32 + 4 * fq;
#pragma unroll
        for (int ai = 0; ai < 2; ++ai)
#pragma unroll
            for (int m = 0; m < 4; ++m) { float* rowp = C + (size_t)(row0 + ai * 128 + m * 16) * D + col0;
#pragma unroll
                for (int bj = 0; bj < 2; ++bj)
#pragma unroll
                    for (int n = 0; n < 2; ++n) *(f32x4*)(rowp + bj * 128 + n * 16) = acc[ai][bj][m][n]; }
    }
};
struct EpiWin {
    static constexpr bool PERM = true, AFTER_DRAIN = false;
    bf16_t* PHY; bf16_t* PRW; bf16_t* PNA;
    __device__ __forceinline__ void operator()(const f32x4 (&acc)[2][2][4][2], const pg8::Unit& u, int wr, int wc, int fr, int fq) const {
        const int row0 = u.pm * 256 + wr * 64 + fr;
        bf16_t* base; int ld, cbase;
        if (u.pn < 3) { base = PHY; ld = HY_IN; cbase = u.pn * 256; }
        else if (u.pn < 9) { base = PRW; ld = RW_IN; cbase = u.pn * 256 - HY_IN; }
        else { base = PNA; ld = NA_IN; cbase = u.pn * 256 - HY_IN - RW_IN; }
        const int nbj = (u.pn == 13) ? 1 : 2;
#pragma unroll
        for (int ai = 0; ai < 2; ++ai)
#pragma unroll
            for (int m = 0; m < 4; ++m)
#pragma unroll
                for (int bj = 0; bj < 2; ++bj) { if (bj < nbj) { const f32x4 v0 = acc[ai][bj][m][0], v1 = acc[ai][bj][m][1];
                    u32x4 w; w.x = cvt_pk_bf16(v0[0], v0[1]); w.y = cvt_pk_bf16(v0[2], v0[3]); w.z = cvt_pk_bf16(v1[0], v1[1]); w.w = cvt_pk_bf16(v1[2], v1[3]);
                    *(u32x4*)(base + (size_t)(row0 + ai * 128 + m * 16) * ld + cbase + bj * 128 + wc * 32 + 8 * fq) = w; } }
    }
};
struct EpiLora {
    static constexpr bool PERM = true, AFTER_DRAIN = false;
    bf16_t* LO; bf16_t* GATE;
    __device__ __forceinline__ void operator()(const f32x4 (&acc)[2][2][4][2], const pg8::Unit& u, int wr, int wc, int fr, int fq) const {
        const int row0 = u.pm * 256 + wr * 64 + fr;
        bf16_t* base; int ld, cbase;
        if (u.pn < 6) { base = LO; ld = 1536; cbase = u.pn * 256; } else { base = GATE; ld = 384; cbase = u.pn * 256 - 1536; }
        const int nbj = (u.pn == 7) ? 1 : 2;
#pragma unroll
        for (int ai = 0; ai < 2; ++ai)
#pragma unroll
            for (int m = 0; m < 4; ++m)
#pragma unroll
                for (int bj = 0; bj < 2; ++bj) { if (bj < nbj) { const f32x4 v0 = acc[ai][bj][m][0], v1 = acc[ai][bj][m][1];
                    u32x4 w; w.x = cvt_pk_bf16(v0[0], v0[1]); w.y = cvt_pk_bf16(v0[2], v0[3]); w.z = cvt_pk_bf16(v1[0], v1[1]); w.w = cvt_pk_bf16(v1[2], v1[3]);
                    *(u32x4*)(base + (size_t)(row0 + ai * 128 + m * 16) * ld + cbase + bj * 128 + wc * 32 + 8 * fq) = w; } }
    }
};
template <class Epi> __device__ __forceinline__ void run_gemm(LAS unsigned char* lds, const bf16_t* A, const bf16_t* Bt, int M, int N, int K, const Epi& E) {
    asm volatile("" : "+s"(K));
    pg8::Gemm g{A, Bt, M, N, K}; pg8::StaticOrder S; S.init(M, N, (int)gridDim.x, (int)blockIdx.x);
    pg8::gemm_phase<Epi, pg8::StaticOrder>(lds, g, S, E);
    __syncthreads();
}

__device__ __forceinline__ void ph_loraprep(const Params& P, int l) {
    const bf16_t* PRW = (const bf16_t*)(P.ws + WS_PRW); bf16_t* AL = (bf16_t*)(P.ws + WS_ALORA);
    const float* mu = P.in[I_MU] + (size_t)l * 2 * RW_IN;
    const int gtid = blockIdx.x * NTHR + otid(), gn = gridDim.x * NTHR;
    for (int it = gtid; it < T * 48; it += gn) {
        const int row = it / 48, j8 = it % 48, col = 1152 + j8 * 8;
        bool hp, hn; row_nbrs(row, hp, hn);
        float p[8], pp[8], pn[8];
        unpack8(*(const u32x4*)(PRW + (size_t)row * RW_IN + col), p);
        if (hp) unpack8(*(const u32x4*)(PRW + (size_t)(row - 1) * RW_IN + col), pp); else {
#pragma unroll
            for (int i = 0; i < 8; ++i) pp[i] = 0.f; }
        if (hn) unpack8(*(const u32x4*)(PRW + (size_t)(row + 1) * RW_IN + col), pn); else {
#pragma unroll
            for (int i = 0; i < 8; ++i) pn[i] = 0.f; }
        float o[8];
#pragma unroll
        for (int i = 0; i < 8; ++i) { const float xs = p[i] + mu[col + i] * (pp[i] - p[i]) + mu[RW_IN + col + i] * (pn[i] - p[i]);
            o[i] = j8 < 16 ? tanhf(xs) : (j8 < 32 ? xs : sigmoidf_(xs)); }
        u32x4 w; w.x = cvt_pk_bf16(o[0], o[1]); w.y = cvt_pk_bf16(o[2], o[3]); w.z = cvt_pk_bf16(o[4], o[5]); w.w = cvt_pk_bf16(o[6], o[7]);
        *(u32x4*)(AL + (size_t)row * 384 + j8 * 8) = w;
    }
}

__device__ __forceinline__ void ph_rwkvprep(const Params& P, int l) {
    const int tid = otid(), lane = tid & 63, gw = blockIdx.x * NWAVE + (tid >> 6), nw = gridDim.x * NWAVE;
    const bf16_t* PRW = (const bf16_t*)(P.ws + WS_PRW); const bf16_t* LO = (const bf16_t*)(P.ws + WS_LORAO);
    bf16_t* RS = (bf16_t*)(P.ws + WS_RS); bf16_t* KKS = (bf16_t*)(P.ws + WS_KKS); bf16_t* VS = (bf16_t*)(P.ws + WS_VS); bf16_t* KS = (bf16_t*)(P.ws + WS_KS); bf16_t* BS = (bf16_t*)(P.ws + WS_BS);
    float* BON = (float*)(P.ws + WS_BONUS);
    const float* mu = P.in[I_MU] + (size_t)l * 2 * RW_IN;
    const int f = lane & 15; const float inv = __expf(-(float)f * (9.210340371976184f / 16.0f));
    for (int it = gw; it < T * 6; it += nw) {
        const int row = it / 6, h = it % 6, c = h * 64 + lane;
        bool hp, hn; row_nbrs(row, hp, hn);
        float x[3];
#pragma unroll
        for (int q = 0; q < 3; ++q) { const int col = q * 384 + c; const float p = bf2f(PRW[(size_t)row * RW_IN + col]);
            const float pp = hp ? bf2f(PRW[(size_t)(row - 1) * RW_IN + col]) : 0.f, pn = hn ? bf2f(PRW[(size_t)(row + 1) * RW_IN + col]) : 0.f;
            x[q] = p + mu[col] * (pp - p) + mu[RW_IN + col] * (pn - p); }
        const float r = x[0], k = x[1], v = x[2];
        const float kkr = k * P.in[I_KK][l * RWW + c];
        const float nrm = sqrtf(wsum(kkr * kkr));
        const float kk = kkr / fmaxf(nrm, 1e-12f);
        const float a0 = sigmoidf_(bf2f(LO[(size_t)row * 1536 + 768 + c]) + P.in[I_A0][(size_t)l * 2 * RWW + c]), a1 = sigmoidf_(bf2f(LO[(size_t)row * 1536 + 1152 + c]) + P.in[I_A0][(size_t)l * 2 * RWW + RWW + c]);
        { float* DEC = (float*)(P.ws + WS_DECAY);
          const float x0 = bf2f(LO[(size_t)row * 1536 + c]) + P.in[I_W0][(size_t)l * 2 * RWW + c], x1 = bf2f(LO[(size_t)row * 1536 + 384 + c]) + P.in[I_W0][(size_t)l * 2 * RWW + RWW + c];
          DEC[(size_t)row * 384 + c] = __expf(-0.6065306597f * sigmoidf_(x0)); DEC[((size_t)T + row) * 384 + c] = __expf(-0.6065306597f * sigmoidf_(x1)); }
        const float ka = P.in[I_KA][l * RWW + c];
        float kd0 = k * (1.f + (a0 - 1.f) * ka), kd1 = k * (1.f + (a1 - 1.f) * ka);
        float b0 = kk * a0, b1 = kk * a1;
        const float bon = wsum(r * (kd0 + kd1) * P.in[I_RK][l * RWW + c]);
        if (lane == 0) BON[(size_t)row * 6 + h] = bon;
        float rs = r, kks = kk;
        if (row < TL) {
            const int t = row & (SEQ - 1); const float pos = (lane < 32) ? (float)(t >> 6) : (float)(t & 63);
            float sn, cs; sincosf(pos * inv, &sn, &cs);
            const float sg = (lane & 16) ? 1.f : -1.f;
            const float r2 = __shfl_xor(rs, 16), k2 = __shfl_xor(kks, 16), d0 = __shfl_xor(kd0, 16), d1 = __shfl_xor(kd1, 16), e0 = __shfl_xor(b0, 16), e1 = __shfl_xor(b1, 16);
            rs = rs * cs + sg * r2 * sn; kks = kks * cs + sg * k2 * sn; kd0 = kd0 * cs + sg * d0 * sn; kd1 = kd1 * cs + sg * d1 * sn; b0 = b0 * cs + sg * e0 * sn; b1 = b1 * cs + sg * e1 * sn;
        }
        const size_t o = (size_t)row * 384 + c;
        RS[o] = f2bf(rs); KKS[o] = f2bf(-kks); VS[o] = f2bf(v);
        KS[o] = f2bf(kd0); KS[(size_t)T * 384 + o] = f2bf(kd1); BS[o] = f2bf(b0); BS[(size_t)T * 384 + o] = f2bf(b1);
    }
}

__device__ __forceinline__ int scan_row(int b, int d, int step) {
    if (step < CTX) { const int tc = d ? (CTX - 1 - step) : step; return TL + b * CTX + tc; }
    const int tl = d ? (SEQ - 1 - (step - CTX)) : (step - CTX); return b * SEQ + tl;
}
__device__ __forceinline__ void scan_task_v1(const Params& P, int task, float* sv) {
    const int lane = otid() & 63;
    const int d = task & 1, h = (task >> 1) % 6, b = task / 12;
    const float* DEC = (const float*)(P.ws + WS_DECAY) + (size_t)d * T * 384; const bf16_t* KKS = (const bf16_t*)(P.ws + WS_KKS); const bf16_t* RS = (const bf16_t*)(P.ws + WS_RS);
    const bf16_t* VS = (const bf16_t*)(P.ws + WS_VS); const bf16_t* KS = (const bf16_t*)(P.ws + WS_KS) + (size_t)d * T * 384; const bf16_t* BS = (const bf16_t*)(P.ws + WS_BS) + (size_t)d * T * 384;
    float* YD = (float*)(P.ws + WS_YDIR) + (size_t)d * T * 384;
    float S[64];
#pragma unroll
    for (int j = 0; j < 64; ++j) S[j] = 0.f;
    size_t o = (size_t)scan_row(b, d, 0) * 384 + h * 64 + lane;
    float nw_ = DEC[o], na = bf2f(KKS[o]), nb = bf2f(BS[o]), nk = bf2f(KS[o]), nr = bf2f(RS[o]), nv = bf2f(VS[o]);
    for (int step = 0; step < CTX + SEQ; ++step) {
        const float v = nv; const size_t oc = o;
        asm volatile("s_waitcnt lgkmcnt(0)" ::: "memory");
        sv[lane] = nw_; sv[64 + lane] = na; sv[128 + lane] = nb; sv[192 + lane] = nk; sv[256 + lane] = nr;
        asm volatile("s_waitcnt lgkmcnt(0)" ::: "memory");
        if (step + 1 < CTX + SEQ) { o = (size_t)scan_row(b, d, step + 1) * 384 + h * 64 + lane;
            nw_ = DEC[o]; na = bf2f(KKS[o]); nb = bf2f(BS[o]); nk = bf2f(KS[o]); nr = bf2f(RS[o]); nv = bf2f(VS[o]); }
        float sa0 = 0.f, sa1 = 0.f, sa2 = 0.f, sa3 = 0.f;
#pragma unroll
        for (int j = 0; j < 64; j += 4) { const float4 a4 = *(const float4*)(sv + 64 + j);
            sa0 += S[j + 0] * a4.x; sa1 += S[j + 1] * a4.y; sa2 += S[j + 2] * a4.z; sa3 += S[j + 3] * a4.w; }
        const float sa = (sa0 + sa1) + (sa2 + sa3);
        float y0 = 0.f, y1 = 0.f, y2 = 0.f, y3 = 0.f;
#pragma unroll
        for (int j = 0; j < 64; j += 4) {
            const float4 w4 = *(const float4*)(sv + j), b4 = *(const float4*)(sv + 128 + j), k4 = *(const float4*)(sv + 192 + j), r4 = *(const float4*)(sv + 256 + j);
            S[j + 0] = S[j + 0] * w4.x + sa * b4.x + v * k4.x; y0 += S[j + 0] * r4.x;
            S[j + 1] = S[j + 1] * w4.y + sa * b4.y + v * k4.y; y1 += S[j + 1] * r4.y;
            S[j + 2] = S[j + 2] * w4.z + sa * b4.z + v * k4.z; y2 += S[j + 2] * r4.z;
            S[j + 3] = S[j + 3] * w4.w + sa * b4.w + v * k4.w; y3 += S[j + 3] * r4.w; }
        YD[oc] = (y0 + y1) + (y2 + y3);
    }
}

__device__ __forceinline__ void natt_key(const bf16_t* PNA, size_t krow, int hoff, const float (&q)[16], float bias, float& m, float& lsum, float (&o)[16]) {
    const bf16_t* kp = PNA + krow * NA_IN + 384 + hoff; const bf16_t* vp = PNA + krow * NA_IN + 768 + hoff;
    float s = 0.f;
#pragma unroll
    for (int j8 = 0; j8 < 2; ++j8) { float kf[8]; unpack8(*(const u32x4*)(kp + j8 * 8), kf);
#pragma unroll
        for (int i = 0; i < 8; ++i) s += q[j8 * 8 + i] * kf[i]; }
    s += __shfl_xor(s, 1); s += __shfl_xor(s, 2); s += bias;
    const float mn = fmaxf(m, s), corr = __expf(m - mn), p = __expf(s - mn);
    m = mn; lsum = lsum * corr + p;
#pragma unroll
    for (int j8 = 0; j8 < 2; ++j8) { float vf[8]; unpack8(*(const u32x4*)(vp + j8 * 8), vf);
#pragma unroll
        for (int i = 0; i < 8; ++i) o[j8 * 8 + i] = o[j8 * 8 + i] * corr + p * vf[i]; }
}
__device__ __forceinline__ void natten_items_v1(const Params& P, int l, int wid0, int nworkers) {
    const bf16_t* PNA = (const bf16_t*)(P.ws + WS_PNA); bf16_t* MIX = (bf16_t*)(P.ws + WS_U);
    const float* rpb = P.in[I_RPB] + (size_t)l * 6 * 15 * 31;
    const int sub = wid0 & 3;
    for (int it = wid0 >> 2; it < T * 6; it += nworkers >> 2) {
        const int row = it % T, h = it / T, hoff = h * 64 + sub * 16;
        float q[16], o[16];
#pragma unroll
        for (int j8 = 0; j8 < 2; ++j8) { float qf[8]; unpack8(*(const u32x4*)(PNA + (size_t)row * NA_IN + hoff + j8 * 8), qf);
#pragma unroll
            for (int i = 0; i < 8; ++i) { q[j8 * 8 + i] = qf[i] * 0.125f; o[j8 * 8 + i] = 0.f; } }
        float m = -3.0e38f, lsum = 0.f;
        int b;
        if (row < TL) { b = row >> 13; const int t = row & (SEQ - 1), i = t >> 6, col = t & 63;
            const int start = min(max(i - 4, 0), 120), win0 = min(max(col - 8, 0), 48);
            for (int r = 0; r < 8; ++r) for (int kc = win0; kc < win0 + 16; ++kc) {
                const float bias = rpb[(h * 15 + (start + r - i + 7)) * 31 + (kc - col + 15)];
                natt_key(PNA, (size_t)b * SEQ + (start + r) * 64 + kc, hoff, q, bias, m, lsum, o); }
        } else b = (row - TL) >> 8;
        for (int c = 0; c < CTX; ++c) natt_key(PNA, (size_t)TL + b * CTX + c, hoff, q, 0.f, m, lsum, o);
        const float il = 1.0f / lsum;
#pragma unroll
        for (int j8 = 0; j8 < 2; ++j8) { u32x4 w; w.x = cvt_pk_bf16(o[j8 * 8 + 0] * il, o[j8 * 8 + 1] * il); w.y = cvt_pk_bf16(o[j8 * 8 + 2] * il, o[j8 * 8 + 3] * il);
            w.z = cvt_pk_bf16(o[j8 * 8 + 4] * il, o[j8 * 8 + 5] * il); w.w = cvt_pk_bf16(o[j8 * 8 + 6] * il, o[j8 * 8 + 7] * il);
            *(u32x4*)(MIX + (size_t)row * D + 640 + hoff + j8 * 8) = w; }
    }
}

__device__ __forceinline__ void vt_tile(const Params& P, int tile, unsigned short* tl  ) {
    const int tid = otid();
    const bf16_t* PNA = (const bf16_t*)(P.ws + WS_PNA);
    int h, tok0; bf16_t* dst; int ldt;
    if (tile < NB * 128 * 6) { h = tile % 6; const int sb = tile / 6; const int b = sb >> 7, blk = sb & 127; tok0 = b * SEQ + blk * 64; dst = (bf16_t*)(P.ws + WS_VTL) + ((size_t)(b * 6 + h) * 64) * SEQ + blk * 64; ldt = SEQ; }
    else { const int tt = tile - NB * 128 * 6; h = tt % 6; const int sb = tt / 6; const int b = sb >> 2, blk = sb & 3; tok0 = TL + b * CTX + blk * 64; dst = (bf16_t*)(P.ws + WS_VTC) + ((size_t)(b * 6 + h) * 64) * CTX + blk * 64; ldt = CTX; }
    { const int tok = tid >> 3, seg = tid & 7; const u32x4 v = *(const u32x4*)(PNA + (size_t)(tok0 + tok) * NA_IN + 768 + h * 64 + seg * 8);
      unsigned* w = (unsigned*)(tl + tok * 72 + seg * 8); w[0] = v.x; w[1] = v.y; w[2] = v.z; w[3] = v.w; }
    __syncthreads();
    { const int hd = tid >> 3, ts = tid & 7; unsigned short e[8];
#pragma unroll
      for (int k = 0; k < 8; ++k) e[k] = tl[(ts * 8 + k) * 72 + hd];
      u32x4 w; w.x = (unsigned)e[0] | ((unsigned)e[1] << 16); w.y = (unsigned)e[2] | ((unsigned)e[3] << 16); w.z = (unsigned)e[4] | ((unsigned)e[5] << 16); w.w = (unsigned)e[6] | ((unsigned)e[7] << 16);
      *(u32x4*)(dst + (size_t)hd * ldt + ts * 8) = w; }
    __syncthreads();
}
constexpr int NAT_LAT_TASKS = NB * 128 * 4 * 6, NAT_CTX_TASKS = NB * 16 * 6, NAT_TASKS = NAT_LAT_TASKS + NAT_CTX_TASKS;
__device__ __forceinline__ void natten_task(const Params& P, int l, int task) {
    using pg8::bf16x8;
    const int lane = otid() & 63, fr = lane & 15, fq = lane >> 4;
    const bf16_t* PNA = (const bf16_t*)(P.ws + WS_PNA); bf16_t* MIX = (bf16_t*)(P.ws + WS_U);
    const bool lat = task < NAT_LAT_TASKS;
    int b, h, i = 0, n = 0, qtok0;
    if (lat) { h = task % 6; const int r = task / 6; n = r & 3; i = (r >> 2) & 127; b = r >> 9; qtok0 = b * SEQ + i * 64 + 16 * n; }
    else { const int tt = task - NAT_LAT_TASKS; h = tt % 6; const int qb = (tt / 6) & 15; b = tt / 96; qtok0 = TL + b * CTX + 16 * qb; }
    const int start = min(max(i - 4, 0), 120), band0 = min(max(16 * n - 8, 0), 32);
    const int col = 16 * n + fr, win0 = min(max(col - 8, 0), 48);
    bf16x8 bq[2];
#pragma unroll
    for (int kh = 0; kh < 2; ++kh) bq[kh] = *(const bf16x8*)(PNA + (size_t)(qtok0 + fr) * NA_IN + h * 64 + kh * 32 + fq * 8);
    f32x4 sc[32];
    if (lat) {
#pragma unroll
        for (int t = 0; t < 16; ++t) { const int tok0 = b * SEQ + (start + (t >> 1)) * 64 + band0 + 16 * (t & 1);
            const bf16_t* kp = PNA + (size_t)(tok0 + fr) * NA_IN + 384 + h * 64 + fq * 8;
            const bf16x8 k0 = *(const bf16x8*)kp, k1 = *(const bf16x8*)(kp + 32);
            f32x4 a = (f32x4){0.f, 0.f, 0.f, 0.f};
            a = __builtin_amdgcn_mfma_f32_16x16x32_bf16(k0, bq[0], a, 0, 0, 0); a = __builtin_amdgcn_mfma_f32_16x16x32_bf16(k1, bq[1], a, 0, 0, 0);
            sc[t] = a; if ((t & 3) == 3) asm volatile("" ::: "memory"); }
    } else {
#pragma unroll
        for (int t = 0; t < 16; ++t) sc[t] = (f32x4){-3.0e38f, -3.0e38f, -3.0e38f, -3.0e38f};
    }
#pragma unroll
    for (int t = 16; t < 32; ++t) { const int tok0 = TL + b * CTX + 16 * (t - 16);
        const bf16_t* kp = PNA + (size_t)(tok0 + fr) * NA_IN + 384 + h * 64 + fq * 8;
        const bf16x8 k0 = *(const bf16x8*)kp, k1 = *(const bf16x8*)(kp + 32);
        f32x4 a = (f32x4){0.f, 0.f, 0.f, 0.f};
        a = __builtin_amdgcn_mfma_f32_16x16x32_bf16(k0, bq[0], a, 0, 0, 0); a = __builtin_amdgcn_mfma_f32_16x16x32_bf16(k1, bq[1], a, 0, 0, 0);
        sc[t] = a * 0.125f; if ((t & 3) == 3) asm volatile("" ::: "memory"); }
    if (lat) { const float* rpb = P.in[I_RPB] + ((size_t)l * 6 + h) * 15 * 31;
#pragma unroll
        for (int t = 0; t < 16; ++t) { const int ro = start + (t >> 1) - i + 7; const int kc0 = band0 + 16 * (t & 1) + fq * 4;
#pragma unroll
            for (int j = 0; j < 4; ++j) { const int kc = kc0 + j; const bool ok = kc >= win0 && kc < win0 + 16; const int co = min(max(kc - col + 15, 0), 30);
                const float bias = rpb[ro * 31 + co]; sc[t][j] = ok ? sc[t][j] * 0.125f + bias : -3.0e38f; } } }
    float mx = -3.0e38f;
#pragma unroll
    for (int t = 0; t < 32; ++t) mx = fmaxf(mx, fmaxf(fmaxf(sc[t][0], sc[t][1]), fmaxf(sc[t][2], sc[t][3])));
    mx = fmaxf(mx, __shfl_xor(mx, 16)); mx = fmaxf(mx, __shfl_xor(mx, 32));
    float sum = 0.f;
#pragma unroll
    for (int t = 0; t < 32; ++t) {
#pragma unroll
        for (int j = 0; j < 4; ++j) { const float p = __expf(sc[t][j] - mx); sc[t][j] = p; sum += p; } }
    sum += __shfl_xor(sum, 16); sum += __shfl_xor(sum, 32);
    const float inv = 1.0f / sum;
    f32x4 ot[4];
#pragma unroll
    for (int q = 0; q < 4; ++q) ot[q] = (f32x4){0.f, 0.f, 0.f, 0.f};
    const bf16_t* VTL = (const bf16_t*)(P.ws + WS_VTL) + ((size_t)(b * 6 + h) * 64) * SEQ; const bf16_t* VTC = (const bf16_t*)(P.ws + WS_VTC) + ((size_t)(b * 6 + h) * 64) * CTX;
    if (lat) {
#pragma unroll
        for (int m = 0; m < 8; ++m) { const int tk = (start + m) * 64 + band0 + fq * 4;
            u32x4 pw; pw.x = cvt_pk_bf16(sc[2 * m][0], sc[2 * m][1]); pw.y = cvt_pk_bf16(sc[2 * m][2], sc[2 * m][3]); pw.z = cvt_pk_bf16(sc[2 * m + 1][0], sc[2 * m + 1][1]); pw.w = cvt_pk_bf16(sc[2 * m + 1][2], sc[2 * m + 1][3]);
            const bf16x8 pb = __builtin_bit_cast(bf16x8, pw);
#pragma unroll
            for (int q = 0; q < 4; ++q) { const bf16_t* vp = VTL + (size_t)(q * 16 + fr) * SEQ + tk; const u32x2 v0 = *(const u32x2*)vp, v1 = *(const u32x2*)(vp + 16);
                u32x4 vw; vw.x = v0.x; vw.y = v0.y; vw.z = v1.x; vw.w = v1.y;
                ot[q] = __builtin_amdgcn_mfma_f32_16x16x32_bf16(__builtin_bit_cast(bf16x8, vw), pb, ot[q], 0, 0, 0); }
            if (m & 1) asm volatile("" ::: "memory"); }
    }
#pragma unroll
    for (int m = 0; m < 8; ++m) { const int tk = 32 * m + fq * 4;
        u32x4 pw; pw.x = cvt_pk_bf16(sc[16 + 2 * m][0], sc[16 + 2 * m][1]); pw.y = cvt_pk_bf16(sc[16 + 2 * m][2], sc[16 + 2 * m][3]); pw.z = cvt_pk_bf16(sc[17 + 2 * m][0], sc[17 + 2 * m][1]); pw.w = cvt_pk_bf16(sc[17 + 2 * m][2], sc[17 + 2 * m][3]);
        const bf16x8 pb = __builtin_bit_cast(bf16x8, pw);
#pragma unroll
        for (int q = 0; q < 4; ++q) { const bf16_t* vp = VTC + (size_t)(q * 16 + fr) * CTX + tk; const u32x2 v0 = *(const u32x2*)vp, v1 = *(const u32x2*)(vp + 16);
            u32x4 vw; vw.x = v0.x; vw.y = v0.y; vw.z = v1.x; vw.w = v1.y;
            ot[q] = __builtin_amdgcn_mfma_f32_16x16x32_bf16(__builtin_bit_cast(bf16x8, vw), pb, ot[q], 0, 0, 0); }
        if (m & 1) asm volatile("" ::: "memory"); }
#pragma unroll
    for (int q = 0; q < 4; ++q) { u32x2 w; w.x = cvt_pk_bf16(ot[q][0] * inv, ot[q][1] * inv); w.y = cvt_pk_bf16(ot[q][2] * inv, ot[q][3] * inv);
        *(u32x2*)(MIX + (size_t)(qtok0 + fr) * D + 640 + h * 64 + q * 16 + fq * 4) = w; }
}

__device__ __forceinline__ void fft_fwd(float2* X) {
    for (int s = 13; s >= 0; --s) { const int half = 1 << s;
        for (int j = otid(); j < NFFT / 2; j += NTHR) { const int lo = j & (half - 1), i0 = ((j >> s) << (s + 1)) | lo, i1 = i0 + half;
            const float2 a = X[i0], b = X[i1]; const float fr = (float)lo / (float)(2 * half);
            const float cw = __builtin_amdgcn_cosf(fr), sw = __builtin_amdgcn_sinf(fr);
            const float dx = a.x - b.x, dy = a.y - b.y;
            X[i0] = make_float2(a.x + b.x, a.y + b.y); X[i1] = make_float2(dx * cw + dy * sw, dy * cw - dx * sw); }
        __syncthreads(); }
}
__device__ __forceinline__ void fft_inv(float2* X) {
    for (int s = 0; s <= 13; ++s) { const int half = 1 << s;
        for (int j = otid(); j < NFFT / 2; j += NTHR) { const int lo = j & (half - 1), i0 = ((j >> s) << (s + 1)) | lo, i1 = i0 + half;
            const float2 a = X[i0], b = X[i1]; const float fr = (float)lo / (float)(2 * half);
            const float cw = __builtin_amdgcn_cosf(fr), sw = __builtin_amdgcn_sinf(fr);
            const float bx = b.x * cw - b.y * sw, by = b.x * sw + b.y * cw;
            X[i0] = make_float2(a.x + bx, a.y + by); X[i1] = make_float2(a.x - bx, a.y - by); }
        __syncthreads(); }
}
__device__ __forceinline__ float hy_delta(int c) { const float lo = -4.605170185988091f / 1.5f, hi = -4.605170185988091f / 0.3f; return fabsf(lo + (float)c * ((hi - lo) / 255.0f)); }
__device__ __forceinline__ float hy_short(const bf16_t* PHY, const float* cw, const float* cb, int row, int col) {
    bool hp, hn; row_nbrs(row, hp, hn);
    float v = cb[col] + cw[HY_IN + col] * bf2f(PHY[(size_t)row * HY_IN + col]);
    if (hp) v += cw[col] * bf2f(PHY[(size_t)(row - 1) * HY_IN + col]);
    if (hn) v += cw[2 * HY_IN + col] * bf2f(PHY[(size_t)(row + 1) * HY_IN + col]);
    return v;
}
__device__ __forceinline__ void hy_spec_task(const Params& P, int l, int o, int c, float2* X, float* ex) {
    const int tid = otid();
    const float* h2 = (const float*)(P.ws + WS_H2); const float* w3 = P.in[I_HW3] + (size_t)l * 64 * 1024;
    if (tid < 128) { const int dir = tid >> 6, i = tid & 63; ex[tid] = w3[(size_t)i * 1024 + o * 512 + dir * 256 + c]; }
    __syncthreads();
    const float dl = hy_delta(c);
    for (int n = tid; n < SEQ; n += NTHR) { float af = 0.f, ab = 0.f;
#pragma unroll
        for (int i4 = 0; i4 < 16; ++i4) { const float4 hv = *(const float4*)(h2 + (size_t)n * 64 + i4 * 4);
            af += hv.x * ex[i4 * 4] + hv.y * ex[i4 * 4 + 1] + hv.z * ex[i4 * 4 + 2] + hv.w * ex[i4 * 4 + 3];
            ab += hv.x * ex[64 + i4 * 4] + hv.y * ex[64 + i4 * 4 + 1] + hv.z * ex[64 + i4 * 4 + 2] + hv.w * ex[64 + i4 * 4 + 3]; }
        const float dec = __expf(-((float)n / (float)(SEQ - 1)) * dl) * (1.0f / NFFT);
        X[n] = make_float2(af * dec, 0.f);
        if (n > 0) X[NFFT - n] = make_float2(ab * dec, 0.f); else X[SEQ] = make_float2(0.f, 0.f); }
    __syncthreads();
    fft_fwd(X);
    float2* spec = (float2*)(P.ws + WS_SPEC) + (size_t)(o * 256 + c) * NFFT;
    for (int i = tid; i < NFFT; i += NTHR) spec[i] = X[i];
    __syncthreads();
}
__device__ __forceinline__ void hy_conv_core(const Params& P, int o, int c, float2* X) {
    fft_fwd(X);
    const float2* spec = (const float2*)(P.ws + WS_SPEC) + (size_t)(o * 256 + c) * NFFT;
    for (int i = otid(); i < NFFT; i += NTHR) { const float2 a = X[i], k = spec[i]; X[i] = make_float2(a.x * k.x - a.y * k.y, a.x * k.y + a.y * k.x); }
    __syncthreads();
    fft_inv(X);
}
__device__ __forceinline__ void hy_task1(const Params& P, int l, int c, float2* X, float* ex) {
    const int tid = otid();
    const bf16_t* PHY = (const bf16_t*)(P.ws + WS_PHY); const float* cw = P.in[I_HCW] + (size_t)l * 3 * HY_IN; const float* cb = P.in[I_HCB] + (size_t)l * HY_IN;
    const float bias0 = P.in[I_HBIAS][(size_t)l * 2 * HYC + c], bias1 = P.in[I_HBIAS][(size_t)l * 2 * HYC + HYC + c];
    for (int n = tid; n < SEQ; n += NTHR) { X[n] = make_float2(hy_short(PHY, cw, cb, n, c), hy_short(PHY, cw, cb, SEQ + n, c)); X[SEQ + n] = make_float2(0.f, 0.f); }
    __syncthreads();
    hy_conv_core(P, 0, c, X);
    float* Z1 = (float*)(P.ws + WS_Z1) + (size_t)c * NB * SEQ;
    for (int n = tid; n < SEQ; n += NTHR) { const float2 y = X[n];
        const float v0 = hy_short(PHY, cw, cb, n, c), v1 = hy_short(PHY, cw, cb, SEQ + n, c), g0 = hy_short(PHY, cw, cb, n, HYC + c), g1 = hy_short(PHY, cw, cb, SEQ + n, HYC + c);
        Z1[n] = g0 * (y.x + bias0 * v0); Z1[SEQ + n] = g1 * (y.y + bias0 * v1); }
    __syncthreads();
    float* f = (float*)X;
    float* vv = f, *x1 = f + 512, *x2 = f + 1024, *hf = f + 1536  , *z1 = f + 2560;
    const float* h2c = (const float*)(P.ws + WS_H2) + (size_t)SEQ * 64; const float* w3 = P.in[I_HW3] + (size_t)l * 64 * 1024;
    { const int b = tid >> 8, t = tid & 255, row = TL + b * CTX + t;
      vv[tid] = hy_short(PHY, cw, cb, row, c); x1[tid] = hy_short(PHY, cw, cb, row, HYC + c); x2[tid] = hy_short(PHY, cw, cb, row, 2 * HYC + c);
      const float dl = hy_delta(c);
      for (int q = tid; q < 1024; q += NTHR) { const int od = q >> 8, n = q & 255; float a = 0.f;
          for (int i = 0; i < 64; ++i) a += h2c[n * 64 + i] * w3[(size_t)i * 1024 + od * 256 + c];
          hf[q] = a * __expf(-((float)n / (float)(CTX - 1)) * dl); } }
    __syncthreads();
    { const int b = tid >> 8, t = tid & 255; float y = bias0 * vv[tid];
      for (int s = 0; s <= t; ++s) y += hf[t - s] * vv[b * 256 + s];
      for (int s = t + 1; s < CTX; ++s) y += hf[256 + s - t] * vv[b * 256 + s];
      z1[tid] = x1[tid] * y; }
    __syncthreads();
    { const int b = tid >> 8, t = tid & 255; float y = bias1 * z1[tid];
      for (int s = 0; s <= t; ++s) y += hf[512 + t - s] * z1[b * 256 + s];
      for (int s = t + 1; s < CTX; ++s) y += hf[768 + s - t] * z1[b * 256 + s];
      bf16_t* MIX = (bf16_t*)(P.ws + WS_U); MIX[(size_t)(TL + b * CTX + t) * D + c] = f2bf(x2[tid] * y); }
    __syncthreads();
}
__device__ __forceinline__ void hy_task2(const Params& P, int l, int c, float2* X) {
    const int tid = otid();
    const bf16_t* PHY = (const bf16_t*)(P.ws + WS_PHY); const float* cw = P.in[I_HCW] + (size_t)l * 3 * HY_IN; const float* cb = P.in[I_HCB] + (size_t)l * HY_IN;
    const float bias1 = P.in[I_HBIAS][(size_t)l * 2 * HYC + HYC + c];
    const float* Z1 = (const float*)(P.ws + WS_Z1) + (size_t)c * NB * SEQ;
    for (int n = tid; n < SEQ; n += NTHR) { X[n] = make_float2(Z1[n], Z1[SEQ + n]); X[SEQ + n] = make_float2(0.f, 0.f); }
    __syncthreads();
    hy_conv_core(P, 1, c, X);
    bf16_t* MIX = (bf16_t*)(P.ws + WS_U);
    for (int n = tid; n < SEQ; n += NTHR) { const float2 y = X[n];
        const float g0 = hy_short(PHY, cw, cb, n, 2 * HYC + c), g1 = hy_short(PHY, cw, cb, SEQ + n, 2 * HYC + c);
        MIX[(size_t)n * D + c] = f2bf(g0 * (y.x + bias1 * Z1[n])); MIX[(size_t)(SEQ + n) * D + c] = f2bf(g1 * (y.y + bias1 * Z1[SEQ + n])); }
    __syncthreads();
}

constexpr int SEGC = 256, NSEG = 33, SCH = 4;
typedef float f32x2v __attribute__((ext_vector_type(2)));
template <bool IDENT>
__device__ __forceinline__ void scan_seg(const Params& P, int chain, int g, float* ring  ) {
    const int lane = otid() & 63;
    const int d = chain & 1, h = (chain >> 1) % 6, b = chain / 12;
    const float* DEC = (const float*)(P.ws + WS_DECAY) + (size_t)d * T * 384; const bf16_t* KKS = (const bf16_t*)(P.ws + WS_KKS); const bf16_t* RS = (const bf16_t*)(P.ws + WS_RS);
    const bf16_t* VS = (const bf16_t*)(P.ws + WS_VS); const bf16_t* KS = (const bf16_t*)(P.ws + WS_KS) + (size_t)d * T * 384; const bf16_t* BS = (const bf16_t*)(P.ws + WS_BS) + (size_t)d * T * 384;
    float* YD = (float*)(P.ws + WS_YDIR) + (size_t)d * T * 384;
    bf16_t* E = (bf16_t*)(P.ws + WS_E) + (size_t)chain * SEQ * 64;
    const int step0 = g == 0 ? 0 : CTX + (g - 1) * SEGC;
    f32x2v S0[32], S1[32];
#pragma unroll
    for (int j = 0; j < 32; ++j) { S0[j] = (f32x2v){0.f, 0.f}; S1[j] = (f32x2v){(2 * j == lane) ? 1.f : 0.f, (2 * j + 1 == lane) ? 1.f : 0.f}; }
    float pw[SCH], pa[SCH], pb[SCH], pk[SCH], pr[SCH], pv[SCH]; int po[SCH];
#pragma unroll
    for (int s = 0; s < SCH; ++s) { const int o = scan_row(b, d, step0 + s) * 384 + h * 64 + lane; po[s] = o;
        pw[s] = DEC[o]; pa[s] = bf2f(KKS[o]); pb[s] = bf2f(BS[o]); pk[s] = bf2f(KS[o]); pr[s] = bf2f(RS[o]); pv[s] = bf2f(VS[o]); }
    for (int c = 0; c < SEGC / SCH; ++c) {
        float cv[SCH]; int co[SCH];
        asm volatile("s_waitcnt lgkmcnt(0)" ::: "memory");
#pragma unroll
        for (int s = 0; s < SCH; ++s) { float* sv = ring + s * 320; sv[lane] = pw[s]; sv[64 + lane] = pa[s]; sv[128 + lane] = pb[s]; sv[192 + lane] = pk[s]; sv[256 + lane] = pr[s]; cv[s] = pv[s]; co[s] = po[s]; }
        asm volatile("s_waitcnt lgkmcnt(0)" ::: "memory");
        if (c + 1 < SEGC / SCH) {
#pragma unroll
            for (int s = 0; s < SCH; ++s) { const int o = scan_row(b, d, step0 + (c + 1) * SCH + s) * 384 + h * 64 + lane; po[s] = o;
                pw[s] = DEC[o]; pa[s] = bf2f(KKS[o]); pb[s] = bf2f(BS[o]); pk[s] = bf2f(KS[o]); pr[s] = bf2f(RS[o]); pv[s] = bf2f(VS[o]); } }
#pragma unroll
        for (int s = 0; s < SCH; ++s) { const float* sv = ring + s * 320;
            f32x2v sa2 = (f32x2v){0.f, 0.f}, sb2 = (f32x2v){0.f, 0.f}, sa3 = sa2, sb3 = sa2;
#pragma unroll
            for (int j = 0; j < 64; j += 4) { const float4 a4 = *(const float4*)(sv + 64 + j); const f32x2v alo = (f32x2v){a4.x, a4.y}, ahi = (f32x2v){a4.z, a4.w};
                sa2 += S0[j / 2] * alo; sa3 += S0[j / 2 + 1] * ahi;
                if (IDENT) { sb2 += S1[j / 2] * alo; sb3 += S1[j / 2 + 1] * ahi; } }
            const float sa = (sa2.x + sa2.y) + (sa3.x + sa3.y), sb = (sb2.x + sb2.y) + (sb3.x + sb3.y);
            const f32x2v saa = (f32x2v){sa, sa}, sbb = (f32x2v){sb, sb}, vv = (f32x2v){cv[s], cv[s]};
            f32x2v y2 = (f32x2v){0.f, 0.f}, y3 = y2, e2 = y2, e3 = y2;
#pragma unroll
            for (int j = 0; j < 64; j += 4) {
                const float4 w4 = *(const float4*)(sv + j), b4 = *(const float4*)(sv + 128 + j), k4 = *(const float4*)(sv + 192 + j), r4 = *(const float4*)(sv + 256 + j);
                const f32x2v wlo = (f32x2v){w4.x, w4.y}, whi = (f32x2v){w4.z, w4.w}, blo = (f32x2v){b4.x, b4.y}, bhi = (f32x2v){b4.z, b4.w};
                const f32x2v klo = (f32x2v){k4.x, k4.y}, khi = (f32x2v){k4.z, k4.w}, rlo = (f32x2v){r4.x, r4.y}, rhi = (f32x2v){r4.z, r4.w};
                S0[j / 2] = S0[j / 2] * wlo + saa * blo + vv * klo; y2 += S0[j / 2] * rlo;
                S0[j / 2 + 1] = S0[j / 2 + 1] * whi + saa * bhi + vv * khi; y3 += S0[j / 2 + 1] * rhi;
                if (IDENT) { S1[j / 2] = S1[j / 2] * wlo + sbb * blo; e2 += S1[j / 2] * rlo; S1[j / 2 + 1] = S1[j / 2 + 1] * whi + sbb * bhi; e3 += S1[j / 2 + 1] * rhi; } }
            YD[co[s]] = (y2.x + y2.y) + (y3.x + y3.y);
            if (IDENT) { const int tl = d ? (SEQ - 1 - (step0 - CTX + c * SCH + s)) : (step0 - CTX + c * SCH + s); E[(size_t)tl * 64 + lane] = f2bf((e2.x + e2.y) + (e3.x + e3.y)); }
        }
    }
    float* ZP = (float*)(P.ws + WS_ZP) + ((size_t)chain * NSEG + g) * 2 * 4096;
#pragma unroll
    for (int j = 0; j < 32; j += 2) { *(float4*)(ZP + lane * 64 + 2 * j) = make_float4(S0[j].x, S0[j].y, S0[j + 1].x, S0[j + 1].y);
        if (IDENT) *(float4*)(ZP + 4096 + lane * 64 + 2 * j) = make_float4(S1[j].x, S1[j].y, S1[j + 1].x, S1[j + 1].y); }
}
__device__ __forceinline__ void scan_combine(const Params& P, int chain, float* lds) {
    const int tid = otid(); const int i = tid >> 3, j0 = (tid & 7) * 8;
    float* Sl = lds;
    float* Pl = lds + 64 * 65;
    float* ZPc = (float*)(P.ws + WS_ZP) + (size_t)chain * NSEG * 2 * 4096;
    float sn[8];
#pragma unroll
    for (int q = 0; q < 8; ++q) sn[q] = ZPc[i * 64 + j0 + q];
    for (int g = 1; g < NSEG - 1; ++g) {
        __syncthreads();
#pragma unroll
        for (int q = 0; q < 8; ++q) Sl[i * 65 + j0 + q] = sn[q];
        const float* Pg = ZPc + (size_t)g * 2 * 4096 + 4096;
#pragma unroll
        for (int q = 0; q < 8; ++q) Pl[tid * 8 + q] = Pg[tid * 8 + q];
        float* Zg = ZPc + (size_t)g * 2 * 4096;
#pragma unroll
        for (int q = 0; q < 8; ++q) sn[q] = Zg[i * 64 + j0 + q];
        __syncthreads();
        for (int m = 0; m < 64; ++m) { const float sv = Sl[i * 65 + m]; const float4 p0 = *(const float4*)(Pl + m * 64 + j0), p1 = *(const float4*)(Pl + m * 64 + j0 + 4);
            sn[0] += sv * p0.x; sn[1] += sv * p0.y; sn[2] += sv * p0.z; sn[3] += sv * p0.w; sn[4] += sv * p1.x; sn[5] += sv * p1.y; sn[6] += sv * p1.z; sn[7] += sv * p1.w; }
#pragma unroll
        for (int q = 0; q < 8; ++q) Zg[i * 64 + j0 + q] = sn[q];
    }
    __syncthreads();
}

__device__ __forceinline__ void rwkv_out_store(const Params& P, int l, int row, int h, int lane, float y) {
    const int c = h * 64 + lane; const size_t o = (size_t)row * 384 + c;
    const bf16_t* VS = (const bf16_t*)(P.ws + WS_VS); const bf16_t* GT = (const bf16_t*)(P.ws + WS_GATE); const float* BON = (const float*)(P.ws + WS_BONUS); bf16_t* MIX = (bf16_t*)(P.ws + WS_U);
    const float mean = wsum(y) * (1.0f / 64.0f); const float dv = y - mean; const float var = wsum(dv * dv) * (1.0f / 64.0f);
    const float yn = dv * rsqrtf(var + 64e-5f) * P.in[I_LNW][l * RWW + c] + P.in[I_LNB][l * RWW + c];
    MIX[(size_t)row * D + 256 + c] = f2bf((yn + BON[(size_t)row * 6 + h] * bf2f(VS[o])) * bf2f(GT[o]));
}
constexpr int OCH = 8;
__device__ __forceinline__ void ph_rwkvout(const Params& P, int l, float* ldsf) {
    const int tid = otid(), lane = tid & 63, wv = tid >> 6, gw = blockIdx.x * NWAVE + wv, nw = gridDim.x * NWAVE;
    const float* YD = (const float*)(P.ws + WS_YDIR);
    float* est = ldsf + wv * (OCH * 128);
    for (int it = gw; it < NB * 6 * 32 * 4; it += nw) {
        const int sub = it & 3, q = (it >> 2) & 31, h = (it >> 7) % 6, b = it / (128 * 6);
        const int chf = b * 12 + h * 2, chb = chf + 1;
        const float* Sfp = (const float*)(P.ws + WS_ZP) + ((size_t)chf * NSEG + q) * 2 * 4096 + lane * 64;
        const float* Sbp = (const float*)(P.ws + WS_ZP) + ((size_t)chb * NSEG + (31 - q)) * 2 * 4096 + lane * 64;
        float Sf[64], Sb[64];
#pragma unroll
        for (int j = 0; j < 64; j += 4) { const float4 a = *(const float4*)(Sfp + j), c4 = *(const float4*)(Sbp + j);
            Sf[j] = a.x; Sf[j + 1] = a.y; Sf[j + 2] = a.z; Sf[j + 3] = a.w; Sb[j] = c4.x; Sb[j + 1] = c4.y; Sb[j + 2] = c4.z; Sb[j + 3] = c4.w; }
        const bf16_t* Ef = (const bf16_t*)(P.ws + WS_E) + (size_t)chf * SEQ * 64; const bf16_t* Eb = (const bf16_t*)(P.ws + WS_E) + (size_t)chb * SEQ * 64;
        const int t0 = q * 256 + sub * 64;
        for (int tg = 0; tg < 64; tg += OCH) {
            asm volatile("s_waitcnt lgkmcnt(0)" ::: "memory");
#pragma unroll
            for (int s = 0; s < OCH; ++s) { const int t = t0 + tg + s; est[s * 128 + lane] = bf2f(Ef[(size_t)t * 64 + lane]); est[s * 128 + 64 + lane] = bf2f(Eb[(size_t)t * 64 + lane]); }
            asm volatile("s_waitcnt lgkmcnt(0)" ::: "memory");
#pragma unroll 1
            for (int s = 0; s < OCH; ++s) { const int t = t0 + tg + s, row = b * SEQ + t; const size_t o = (size_t)row * 384 + h * 64 + lane;
                float c0 = 0.f, c1 = 0.f, c2 = 0.f, c3 = 0.f;
#pragma unroll
                for (int j = 0; j < 64; j += 4) { const float4 ef = *(const float4*)(est + s * 128 + j), eb = *(const float4*)(est + s * 128 + 64 + j);
                    c0 += Sf[j] * ef.x + Sb[j] * eb.x; c1 += Sf[j + 1] * ef.y + Sb[j + 1] * eb.y; c2 += Sf[j + 2] * ef.z + Sb[j + 2] * eb.z; c3 += Sf[j + 3] * ef.w + Sb[j + 3] * eb.w;
                    if ((j & 15) == 12) asm volatile("" ::: "memory"); }
                const float y = YD[o] + YD[(size_t)T * 384 + o] + ((c0 + c1) + (c2 + c3));
                rwkv_out_store(P, l, row, h, lane, y); }
        }
    }
    for (int it = gw; it < TC * 6; it += nw) { const int row = TL + it / 6, h = it % 6; const size_t o = (size_t)row * 384 + h * 64 + lane;
        rwkv_out_store(P, l, row, h, lane, YD[o] + YD[(size_t)T * 384 + o]); }
}

typedef const __attribute__((address_space(4))) Params* KParamsPtr;
__device__ __forceinline__ const Params* fresh_params() { KParamsPtr q = (KParamsPtr)__builtin_amdgcn_kernarg_segment_ptr(); asm volatile("" : "+s"(q)); return (const Params*)q; }
__global__ void __launch_bounds__(NTHR, 2) fwd_megakernel(Params P_unused, int ph_lo, int ph_hi) {
    extern __shared__ __attribute__((aligned(16))) unsigned char smem[];
    cg::grid_group grid = cg::this_grid();
    LAS unsigned char* lds3 = (LAS unsigned char*)smem;
    float* ldsf = (float*)smem; float2* X = (float2*)smem; float* ex = (float*)(smem + LDS_MAIN);
    { volatile LAS unsigned* st = (volatile LAS unsigned*)(lds3 + LDS_MAIN + 4096); if (threadIdx.x == 0) { st[0] = 0u; st[1] = 0u; } }
    __syncthreads();
    XcdBarrier xbar = xcd_barrier_post((unsigned*)(((const Params*)fresh_params())->ws + WS_BAR), (volatile LAS unsigned*)(lds3 + LDS_MAIN + 4096));
    int ph = 0;
#ifndef REP_GEMM
#define REP_GEMM 1
#endif
#ifndef REP_SCAN
#define REP_SCAN 1
#endif
#ifndef REP_HY
#define REP_HY 1
#endif
#define PHASE_BEGIN if (ph >= ph_lo && ph < ph_hi) { const Params& P = *fresh_params(); unsigned char* ws = P.ws; (void)ws;
#ifndef REP_SYNC
#define REP_SYNC 1
#endif
#define PHASE_END   if (ph + 1 < ph_hi) { for (int rs_ = 0; rs_ < REP_SYNC; ++rs_) { if (ph == 0) grid.sync(); else xcd_barrier(xbar); } } } ++ph;
    PHASE_BEGIN ph_modv(P, ldsf); PHASE_END
    for (int l = 0; l < DEPTH; ++l) {
        PHASE_BEGIN
            ph_prep(P, l, ldsf);
            if (l == 0) ph_rowpass(P, 0, 0, 0, 0, 0.f, 0, 0, 0, 1);
            else ph_rowpass(P, 1, l - 1, 8, 5, 0.5f, l, 0, 0, 1);
        PHASE_END
        PHASE_BEGIN { EpiGU E{(bf16_t*)(ws + WS_ACT)}; for (int rep_ = 0; rep_ < REP_GEMM; ++rep_) run_gemm(lds3, (const bf16_t*)(ws + WS_U), (const bf16_t*)(ws + WS_WGU1), T, 2 * DFF, D, E); } PHASE_END
        PHASE_BEGIN { EpiF32 E{(float*)(ws + WS_Y)}; for (int rep_ = 0; rep_ < REP_GEMM; ++rep_) run_gemm(lds3, (const bf16_t*)(ws + WS_ACT), (const bf16_t*)(ws + WS_WDN1), T, D, DFF, E); } PHASE_END
        PHASE_BEGIN ph_rowpass(P, 1, l, 2, 1, 0.5f, l, 2, 3, 4); PHASE_END
        PHASE_BEGIN { EpiWin E{(bf16_t*)(ws + WS_PHY), (bf16_t*)(ws + WS_PRW), (bf16_t*)(ws + WS_PNA)}; for (int rep_ = 0; rep_ < REP_GEMM; ++rep_) run_gemm(lds3, (const bf16_t*)(ws + WS_U), (const bf16_t*)(ws + WS_WIN), T, INWP, D, E); } PHASE_END
        PHASE_BEGIN
            ph_loraprep(P, l);
            for (int it = blockIdx.x; it < NB * 128 * 6 + NB * 4 * 6; it += gridDim.x) vt_tile(P, it, (unsigned short*)smem);
            for (int rep_ = 0; rep_ < REP_HY; ++rep_) for (int it = blockIdx.x; it < 512; it += gridDim.x) hy_spec_task(P, l, it >> 8, it & 255, X, ex);
        PHASE_END
        PHASE_BEGIN { EpiLora E{(bf16_t*)(ws + WS_LORAO), (bf16_t*)(ws + WS_GATE)};
            for (int rep_ = 0; rep_ < REP_GEMM; ++rep_) run_gemm(lds3, (const bf16_t*)(ws + WS_ALORA), (const bf16_t*)(ws + WS_WLORA), T, 2048, 384, E); } PHASE_END
        PHASE_BEGIN
            ph_rwkvprep(P, l);
            for (int rep_ = 0; rep_ < REP_HY; ++rep_) for (int c = blockIdx.x; c < HYC; c += gridDim.x) hy_task1(P, l, c, X, ex);
        PHASE_END
        PHASE_BEGIN {
            const int wv = __builtin_amdgcn_readfirstlane(otid() >> 6);
            if (wv < 4) { const int k = wv * (int)gridDim.x + (int)blockIdx.x;
                if (k < 24 * NSEG) { const int chain = k / NSEG, g = k % NSEG; float* ring = ldsf + wv * (SCH * 320);
                    for (int rep_ = 0; rep_ < REP_SCAN; ++rep_) { if (g == 0) scan_seg<false>(P, chain, g, ring); else scan_seg<true>(P, chain, g, ring); } } }
            else for (int it = (wv - 4) * (int)gridDim.x + (int)blockIdx.x; it < NAT_TASKS; it += 4 * (int)gridDim.x) natten_task(P, l, it);
        } PHASE_END
        PHASE_BEGIN
            if (blockIdx.x < 24) scan_combine(P, blockIdx.x, ldsf);
            else for (int rep_ = 0; rep_ < REP_HY; ++rep_) for (int c = blockIdx.x - 24; c < HYC; c += gridDim.x - 24) hy_task2(P, l, c, X);
        PHASE_END
        PHASE_BEGIN ph_rwkvout(P, l, ldsf); PHASE_END
        PHASE_BEGIN { EpiF32 E{(float*)(ws + WS_Y)}; for (int rep_ = 0; rep_ < REP_GEMM; ++rep_) run_gemm(lds3, (const bf16_t*)(ws + WS_U), (const bf16_t*)(ws + WS_WOUT), T, D, D, E); } PHASE_END
        PHASE_BEGIN ph_rowpass(P, 1, l, 5, 3, 1.0f, l, 4, 6, 7); PHASE_END
        PHASE_BEGIN { EpiGU E{(bf16_t*)(ws + WS_ACT)}; for (int rep_ = 0; rep_ < REP_GEMM; ++rep_) run_gemm(lds3, (const bf16_t*)(ws + WS_U), (const bf16_t*)(ws + WS_WGU2), T, 2 * DFF, D, E); } PHASE_END
        PHASE_BEGIN { EpiF32 E{(float*)(ws + WS_Y)}; for (int rep_ = 0; rep_ < REP_GEMM; ++rep_) run_gemm(lds3, (const bf16_t*)(ws + WS_ACT), (const bf16_t*)(ws + WS_WDN2), T, D, DFF, E); } PHASE_END
    }
    PHASE_BEGIN ph_rowpass(P, 2, DEPTH - 1, 8, 5, 0.5f, 0, 0, 0, 0); PHASE_END
#undef PHASE_BEGIN
#undef PHASE_END
}
constexpr int N_PHASES = 1 + DEPTH * 15 + 1;

extern "C" void kernel_launch(void* const* d_in, const int* in_sizes, int n_in, void* d_out, int out_size, void* d_ws, size_t ws_size, hipStream_t stream) {
    static int grid = 0;
    if (grid == 0) {
        if (n_in != 34 || ws_size < WS_END) { fprintf(stderr, "kernel_launch: need 34 inputs and %zu bytes of workspace; got %d, %zu\n", (size_t)WS_END, n_in, ws_size); grid = -1; return; }
        int dev = 0, cus = 0, per_cu = 0;
        hipGetDevice(&dev); hipDeviceGetAttribute(&cus, hipDeviceAttributeMultiprocessorCount, dev);
        if (hipFuncSetAttribute((const void*)fwd_megakernel, hipFuncAttributeMaxDynamicSharedMemorySize, LDS_BYTES) != hipSuccess) { fprintf(stderr, "kernel_launch: hipFuncSetAttribute failed\n"); grid = -1; return; }
        if (hipOccupancyMaxActiveBlocksPerMultiprocessor(&per_cu, (const void*)fwd_megakernel, NTHR, LDS_BYTES) != hipSuccess || per_cu < 1) { fprintf(stderr, "kernel_launch: occupancy query says %d\n", per_cu); per_cu = 1; }
        (void)hipGetLastError();
        grid = cus;
    }
    if (grid < 0) return;
    if (hipMemsetAsync((char*)d_ws + WS_BAR, 0, (size_t)XCD_BAR_WORDS * 4, stream) != hipSuccess) { fprintf(stderr, "kernel_launch: memset of the barrier words failed\n"); return; }
    Params p{};
    for (int i = 0; i < 34; ++i) p.in[i] = (const float*)d_in[i];
    p.out = (float*)d_out; p.ws = (unsigned char*)d_ws;
#if MK_SPLIT
    for (int ph = 0; ph < N_PHASES; ++ph) { int lo = ph, hi = ph + 1; hipLaunchKernelGGL(fwd_megakernel, dim3(grid), dim3(NTHR), LDS_BYTES, stream, p, lo, hi); }
#else
    int lo = 0, hi = N_PHASES;
    void* args[] = {&p, &lo, &hi};
    hipError_t e = hipLaunchCooperativeKernel((const void*)fwd_megakernel, dim3(grid), dim3(NTHR), args, LDS_BYTES, stream);
    if (e != hipSuccess) fprintf(stderr, "cooperative launch failed: %s (grid %d)\n", hipGetErrorString(e), grid);
#endif
}
```

```cpp
#include <hip/hip_runtime.h>
#include <hip/hip_cooperative_groups.h>
#include <cstdio>
namespace cg = cooperative_groups;
__device__ __forceinline__ int otid() { int t = threadIdx.x; asm volatile("" : "+v"(t)); return t; }
namespace pg8 {
#define PG8_LAS __attribute__((address_space(3)))
typedef unsigned short bf16_t;
typedef short bf16x8 __attribute__((ext_vector_type(8)));
typedef float f32x4 __attribute__((ext_vector_type(4)));
typedef unsigned u32x4 __attribute__((ext_vector_type(4)));
constexpr int BM = 256, BK = 64, HALF = 128, HTB = HALF * BK * 2  , STAGE_BYTES = 8 * HTB, NXCD = 8, WGM = 8;

__host__ __device__ __forceinline__ int lds_byte(int r, int c) { const int st = (r >> 4) * 2 + (c >> 5), rr = r & 15, cc = c & 31, ob = rr * 64 + cc * 2; return st * 1024 + (ob ^ (((ob >> 9) & 1) << 5)); }
__host__ __device__ __forceinline__ void stage_rc(int b, int& R, int& C) { const int st = b / 1024, sb = b % 1024, swz = sb ^ (((sb >> 9) & 1) << 5); R = (st >> 1) * 16 + swz / 64; C = (st & 1) * 32 + (swz % 64) / 2; }
__host__ __device__ __forceinline__ int perm32(int rho) { const int n = rho >> 4, i = rho & 15; return 8 * (i >> 2) + 4 * n + (i & 3); }

struct Unit { int pm, pn; };
struct Gemm { const bf16_t* A; const bf16_t* Bt; int M, N, K; };
struct StaticOrder {
    int nM, nN, nwg, G, c;
    __host__ __device__ void init(int M, int N, int G_, int c_) { nM = M / BM; nN = N / BM; nwg = nM * nN; G = G_; c = c_; }
    __host__ __device__ bool next(int i, Unit& u) const {
        const long L = (long)i * G + c; if (L >= nwg) return false;
        int wgid = (int)L; { const int q = nwg / NXCD, r = nwg % NXCD, xcd = wgid % NXCD, off = wgid / NXCD; wgid = (xcd < r ? xcd * (q + 1) : r * (q + 1) + (xcd - r) * q) + off; }
        const int nig = WGM * nN, gid = wgid / nig, fm = gid * WGM, gsz = (nM - fm) < WGM ? (nM - fm) : WGM;
        u.pm = fm + ((wgid % nig) % gsz); u.pn = (wgid % nig) / gsz; return true;
    }
    __device__ __forceinline__ void a_ready(const Unit&) const {}
    __device__ __forceinline__ void done(const Unit&) const {}
};
__device__ __forceinline__ unsigned cvt_pk_bf16(float lo, float hi) { unsigned r; asm volatile("v_cvt_pk_bf16_f32 %0, %1, %2" : "=v"(r) : "v"(lo), "v"(hi)); return r; }
template <class Epi, class Sched>
__device__ __forceinline__ void gemm_phase(PG8_LAS unsigned char* lds, const Gemm g, const Sched& S, const Epi& E) {
    const int tid = otid(), wid = __builtin_amdgcn_readfirstlane(tid >> 6), lane = tid & 63, wr = wid >> 2, wc = wid & 3, fr = lane & 15, fq = lane >> 4;
    const int K = g.K, nt = K / BK;
#define PG8_STAMP() do {} while (0)
    unsigned voffA[2], voffB[2];
#pragma unroll
    for (int i = 0; i < 2; ++i) { int R, C; stage_rc(tid * 16 + i * 8192, R, C); const int Rb = Epi::PERM ? ((R & ~31) + perm32(R & 31)) : R;
        voffA[i] = (unsigned)(R * K + C) * 2u; voffB[i] = (unsigned)(Rb * K + C) * 2u; }
    const size_t kstep = (size_t)(BK * 2);
    const size_t hstep = (size_t)HALF * K * 2;
    const size_t tstep = 2 * hstep;
    const unsigned ldsw = (unsigned)wid * 1024u;
    const int aoff = lds_byte(wr * 64 + fr, fq * 8), boff = lds_byte(wc * 32 + fr, fq * 8);
#define PG8_SA(b, h) (((b) * 2 + (h)) * HTB)
#define PG8_SB(b, h) ((4 + (b) * 2 + (h)) * HTB)
#define PG8_STAGE(bufoff, gbase, voff) do { _Pragma("unroll") for (int _i = 0; _i < 2; ++_i) \
        __builtin_amdgcn_global_load_lds((const unsigned*)((const char*)(gbase) + (voff)[_i]), (PG8_LAS unsigned*)(lds + (bufoff) + ldsw + _i * 8192), 16, 0, 0); } while (0)
#define PG8_LDA(dst, b, h) do { _Pragma("unroll") for (int m = 0; m < 4; ++m) _Pragma("unroll") for (int k = 0; k < 2; ++k) dst[m][k] = *(const PG8_LAS bf16x8*)(lds + PG8_SA(b, h) + aoff + m * 2048 + k * 1024); } while (0)
#define PG8_LDB(dst, b, h) do { _Pragma("unroll") for (int n = 0; n < 2; ++n) _Pragma("unroll") for (int k = 0; k < 2; ++k) dst[n][k] = *(const PG8_LAS bf16x8*)(lds + PG8_SB(b, h) + boff + n * 2048 + k * 1024); } while (0)
#define PG8_MMA(ai, bj, At, Bt) do { __builtin_amdgcn_s_setprio(1); _Pragma("unroll") for (int m = 0; m < 4; ++m) _Pragma("unroll") for (int n = 0; n < 2; ++n) _Pragma("unroll") for (int k = 0; k < 2; ++k) \
        acc[ai][bj][m][n] = __builtin_amdgcn_mfma_f32_16x16x32_bf16(Bt[n][k], At[m][k], acc[ai][bj][m][n], 0, 0, 0); __builtin_amdgcn_s_setprio(0); } while (0)
#define PG8_WAIT_V(n) asm volatile("s_waitcnt vmcnt(" #n ")" ::: "memory")
#define PG8_WAIT_L(n) asm volatile("s_waitcnt lgkmcnt(" #n ")" ::: "memory")
#define PG8_BAR __builtin_amdgcn_s_barrier()
#define PG8_SCHED __builtin_amdgcn_sched_barrier(0)
    Unit cur, nxt; int ui = 0;
    if (!S.next(0, cur)) return;
    f32x4 acc[2][2][4][2];
#pragma unroll
    for (int a = 0; a < 2; ++a)
#pragma unroll
        for (int b = 0; b < 2; ++b)
#pragma unroll
            for (int m = 0; m < 4; ++m)
#pragma unroll
                for (int n = 0; n < 2; ++n) acc[a][b][m][n] = (f32x4){0.f, 0.f, 0.f, 0.f};
    bf16x8 At[4][2], B0[2][2], B1[2][2];
    const char* cA = (const char*)g.A + (size_t)cur.pm * tstep; const char* cB = (const char*)g.Bt + (size_t)cur.pn * tstep;
    S.a_ready(cur);
    PG8_STAGE(PG8_SB(0, 0), cB, voffB); PG8_STAGE(PG8_SA(0, 0), cA, voffA); PG8_STAGE(PG8_SB(0, 1), cB + hstep, voffB); PG8_STAGE(PG8_SA(0, 1), cA + hstep, voffA);
    if (wr == 1) PG8_BAR;
    PG8_WAIT_V(4); PG8_BAR;
    PG8_STAGE(PG8_SB(1, 0), cB + kstep, voffB); PG8_STAGE(PG8_SA(1, 0), cA + kstep, voffA); PG8_STAGE(PG8_SB(1, 1), cB + hstep + kstep, voffB);
    PG8_WAIT_V(6); PG8_BAR;
    PG8_STAMP();
    for (;;) {
        const bool has_next = S.next(ui + 1, nxt);
        const char* nA = has_next ? (const char*)g.A + (size_t)nxt.pm * tstep : cA; const char* nB = has_next ? (const char*)g.Bt + (size_t)nxt.pn * tstep : cB;
        for (int t = 0; t < nt; t += 2) {
            const bool last = (t == nt - 2);
            const char* a1 = cA + (size_t)(t + 1) * kstep;
            const char* a2 = last ? nA : cA + (size_t)(t + 2) * kstep; const char* b2 = last ? nB : cB + (size_t)(t + 2) * kstep;
            const char* a3 = a2 + kstep; const char* b3 = b2 + kstep;
            if (last && has_next) S.a_ready(nxt);
            PG8_LDB(B0, 0, 0); PG8_SCHED; PG8_LDA(At, 0, 0); PG8_STAGE(PG8_SA(1, 1), a1 + hstep, voffA);
            PG8_WAIT_L(8); PG8_BAR; PG8_WAIT_L(0); PG8_MMA(0, 0, At, B0); PG8_BAR; PG8_SCHED;
            PG8_LDB(B1, 0, 1); PG8_STAGE(PG8_SB(0, 0), b2, voffB);
            PG8_BAR; PG8_WAIT_L(0); PG8_MMA(0, 1, At, B1); PG8_BAR;
            PG8_LDA(At, 0, 1); PG8_STAGE(PG8_SA(0, 0), a2, voffA);
            PG8_BAR; PG8_WAIT_L(0); PG8_MMA(1, 0, At, B0); PG8_BAR; PG8_SCHED;
            PG8_STAGE(PG8_SB(0, 1), b2 + hstep, voffB);
            PG8_WAIT_V(6); PG8_BAR; PG8_MMA(1, 1, At, B1); PG8_BAR;
            PG8_LDB(B0, 1, 0); PG8_SCHED; PG8_LDA(At, 1, 0); PG8_STAGE(PG8_SA(0, 1), a2 + hstep, voffA);
            PG8_WAIT_L(8); PG8_BAR; PG8_WAIT_L(0); PG8_MMA(0, 0, At, B0); PG8_BAR; PG8_SCHED;
            PG8_LDB(B1, 1, 1); PG8_STAGE(PG8_SB(1, 0), b3, voffB);
            PG8_BAR; PG8_WAIT_L(0); PG8_MMA(0, 1, At, B1); PG8_BAR;
            PG8_LDA(At, 1, 1); PG8_STAGE(PG8_SA(1, 0), a3, voffA);
            PG8_BAR; PG8_WAIT_L(0); PG8_MMA(1, 0, At, B0); PG8_BAR; PG8_SCHED;
            PG8_STAGE(PG8_SB(1, 1), b3 + hstep, voffB);
            PG8_WAIT_V(6); PG8_BAR; PG8_MMA(1, 1, At, B1); PG8_BAR;
        }
        PG8_STAMP();
        if constexpr (!Epi::AFTER_DRAIN) { E(acc, cur, wr, wc, fr, fq); S.done(cur); }
        PG8_STAMP();
        if (!has_next) break;
#pragma unroll
        for (int a = 0; a < 2; ++a)
#pragma unroll
            for (int b = 0; b < 2; ++b)
#pragma unroll
                for (int m = 0; m < 4; ++m)
#pragma unroll
                    for (int n = 0; n < 2; ++n) acc[a][b][m][n] = (f32x4){0.f, 0.f, 0.f, 0.f};
        cur = nxt; cA = nA; cB = nB; ++ui;
    }
    PG8_WAIT_V(0);
    if (wr == 0) PG8_BAR;
    PG8_BAR;
    if constexpr (Epi::AFTER_DRAIN) { E.fused(acc, cur, wr, wc, fr, fq, lds, wid, lane); S.done(cur); }
    PG8_STAMP();
#undef PG8_STAMP
#undef PG8_SA
#undef PG8_SB
#undef PG8_STAGE
#undef PG8_LDA
#undef PG8_LDB
#undef PG8_MMA
#undef PG8_WAIT_V
#undef PG8_WAIT_L
#undef PG8_BAR
#undef PG8_SCHED
}
}
#define LAS __attribute__((address_space(3)))
#define XB_TMO      128
#define XB_XCNT(j)  (256  + 64 * (j))
#define XB_XSUB(j)  (1280 + 64 * (j))
#define XB_XGEN(j)  (2304 + 64 * (j))
#define XB_TOP      3328
#define XB_TOPGEN   3392
#define XCD_BAR_WORDS 3456
#define XB_SPIN_CAP (1u << 18)

__device__ __forceinline__ unsigned xb_ld(unsigned* p)              { return __hip_atomic_load(p, __ATOMIC_RELAXED, __HIP_MEMORY_SCOPE_AGENT); }
__device__ __forceinline__ unsigned xb_add(unsigned* p, unsigned v) { return __hip_atomic_fetch_add(p, v, __ATOMIC_RELAXED, __HIP_MEMORY_SCOPE_AGENT); }
__device__ __forceinline__ unsigned xb_xcc_id() { return (unsigned)__builtin_amdgcn_s_getreg((3 << 11) | 20) & 0xFu; }
#define XB_SPIN(cond, bar) do { unsigned _sp = 0; while (cond) { __builtin_amdgcn_s_sleep(1); \
    if ((++_sp & 255u) == 0u) { if (xb_ld(&(bar)[XB_TMO])) break; if (_sp > XB_SPIN_CAP) { atomicAdd(&(bar)[XB_TMO], 1u); break; } } } } while (0)

struct XcdBarrier {
    unsigned* bar; unsigned x;
    volatile LAS unsigned* st;
};

__device__ __forceinline__ XcdBarrier xcd_barrier_post(unsigned* bar, volatile LAS unsigned* st) {
    XcdBarrier b; b.bar = bar; b.x = xb_xcc_id(); b.st = st;
    if (threadIdx.x == 0) (void)xb_add(&bar[XB_XCNT(b.x)], 1u);
    return b;
}
__device__ __forceinline__ void xcd_barrier_complete(unsigned* bar, unsigned x, unsigned& nloc, unsigned& nx) {
    const unsigned G = gridDim.x * gridDim.y * gridDim.z;
    unsigned sum, cnt, mine, sp = 0u;
    for (;;) {
        sum = 0u; cnt = 0u; mine = 0u;
#pragma unroll
        for (unsigned j = 0; j < 16; ++j) { const unsigned c = xb_ld(&bar[XB_XCNT(j)]); sum += c; cnt += (c > 0u) ? 1u : 0u; mine = (j == x) ? c : mine; }
        if (sum == G) break;
        __builtin_amdgcn_s_sleep(1);
        if ((++sp & 255u) == 0u) { if (xb_ld(&bar[XB_TMO])) break; if (sp > XB_SPIN_CAP) { atomicAdd(&bar[XB_TMO], 1u); break; } }
    }
    nloc = mine > 0u ? mine : 1u; nx = cnt > 0u ? cnt : 1u;
}

__device__ __forceinline__ void xcd_barrier(const XcdBarrier& b) {
    asm volatile("s_waitcnt vmcnt(0)" ::: "memory");
    __syncthreads();
    if (threadIdx.x == 0) {
        unsigned* bar = b.bar;
        __builtin_amdgcn_s_waitcnt(0);
        unsigned nloc = b.st[0], nx = b.st[1];
        if (nloc == 0u) { xcd_barrier_complete(bar, b.x, nloc, nx); b.st[0] = nloc; b.st[1] = nx; }
        const unsigned old = xb_add(&bar[XB_XSUB(b.x)], 1u);
        const unsigned gen = old / nloc;
        if (old + 1u == (gen + 1u) * nloc) {
            __builtin_amdgcn_fence(__ATOMIC_RELEASE, "agent");
            asm volatile("s_waitcnt vmcnt(0)" ::: "memory");
            const unsigned og = xb_add(&bar[XB_TOP], 1u);
            const unsigned tg = og / nx;
            if (og + 1u == (tg + 1u) * nx) xb_add(&bar[XB_TOPGEN], 1u);
            else XB_SPIN(xb_ld(&bar[XB_TOPGEN]) == tg, bar);
            __builtin_amdgcn_fence(__ATOMIC_ACQUIRE, "agent");
            xb_add(&bar[XB_XGEN(b.x)], 1u);
            asm volatile("s_waitcnt vmcnt(0)" ::: "memory");
        } else {
            XB_SPIN(xb_ld(&bar[XB_XGEN(b.x)]) == gen, bar);
            __builtin_amdgcn_fence(__ATOMIC_ACQUIRE, "agent");
            asm volatile("s_waitcnt vmcnt(0)" ::: "memory");
        }
    }
    __syncthreads();
}

using pg8::bf16_t; using pg8::f32x4; using pg8::u32x4; using pg8::cvt_pk_bf16;
typedef unsigned u32x2 __attribute__((ext_vector_type(2)));


constexpr int D = 1024, NB = 2, SEQ = 8192, DEPTH = 4, CTX = 256, DFF = 2816;
constexpr int TL = NB * SEQ, TC = NB * CTX, T = TL + TC;
constexpr int NMOD = 9 * D;
constexpr int HYC = 256, RWW = 384, NAW = 384, INW = 3456, INWP = 3584;
constexpr int HY_IN = 768, RW_IN = 1536, NA_IN = 1152;
constexpr int NFFT = 16384;
constexpr int NTHR = 512, NWAVE = 8;
constexpr int LDS_MAIN = 131072, LDS_EXTRA = 8192, LDS_BYTES = LDS_MAIN + LDS_EXTRA;
constexpr float NORM_EPS = 1e-6f;

constexpr size_t al256(size_t x) { return (x + 255) & ~(size_t)255; }
constexpr size_t WS_MODV = 0;
constexpr size_t WS_WGU1 = al256(WS_MODV + (size_t)DEPTH * 3 * NMOD * 4);
constexpr size_t WS_WDN1 = WS_WGU1 + (size_t)2 * DFF * D * 2;
constexpr size_t WS_WGU2 = WS_WDN1 + (size_t)D * DFF * 2;
constexpr size_t WS_WDN2 = WS_WGU2 + (size_t)2 * DFF * D * 2;
constexpr size_t WS_WIN = WS_WDN2 + (size_t)D * DFF * 2;
constexpr size_t WS_WOUT = WS_WIN + (size_t)INWP * D * 2;
constexpr size_t WS_WLORA = WS_WOUT + (size_t)D * D * 2;
constexpr size_t WS_H = WS_WLORA + (size_t)2048 * 384 * 2;
constexpr size_t WS_U = WS_H + (size_t)T * D * 4;
constexpr size_t WS_S = WS_U + (size_t)T * D * 2;
constexpr size_t WS_Y = WS_S;
constexpr size_t WS_ACT = WS_Y + (size_t)T * D * 4;
constexpr size_t WS_FFN_END = WS_ACT + (size_t)T * DFF * 2;
constexpr size_t WS_PHY = WS_S;
constexpr size_t WS_PRW = WS_PHY + (size_t)T * HY_IN * 2;
constexpr size_t WS_YDIR = WS_PRW;
constexpr size_t WS_PNA = WS_PRW + (size_t)T * RW_IN * 2;
constexpr size_t WS_ALORA = WS_PNA + (size_t)T * NA_IN * 2;
constexpr size_t WS_DECAY = WS_ALORA + (size_t)T * 384 * 2;
constexpr size_t WS_LORAO = WS_DECAY + (size_t)2 * T * 384 * 4;
constexpr size_t WS_E = WS_LORAO;
constexpr size_t WS_ZP = WS_E + (size_t)24 * SEQ * 64 * 2;
constexpr size_t WS_GATE = WS_LORAO + (size_t)T * 1536 * 2;
static_assert(WS_ZP + (size_t)24 * 33 * 2 * 4096 * 4 <= WS_GATE, "E + ZP must fit in the LORAO region");
constexpr size_t WS_RS = WS_GATE + (size_t)T * 384 * 2;
constexpr size_t WS_KKS = WS_RS + (size_t)T * 384 * 2;
constexpr size_t WS_VS = WS_KKS + (size_t)T * 384 * 2;
constexpr size_t WS_KS = WS_VS + (size_t)T * 384 * 2;
constexpr size_t WS_BS = WS_KS + (size_t)2 * T * 384 * 2;
constexpr size_t WS_BONUS = WS_BS + (size_t)2 * T * 384 * 2;
constexpr size_t WS_H2 = al256(WS_BONUS + (size_t)T * 6 * 4);
constexpr size_t WS_SPEC = WS_H2 + (size_t)(SEQ + CTX) * 64 * 4;
constexpr size_t WS_Z1 = WS_SPEC + (size_t)512 * NFFT * 8;
constexpr size_t WS_VTL = WS_Z1 + (size_t)HYC * NB * SEQ * 4;
constexpr size_t WS_VTC = WS_VTL + (size_t)NB * 6 * 64 * SEQ * 2;
constexpr size_t WS_MIX_END = WS_VTC + (size_t)NB * 6 * 64 * CTX * 2;
constexpr size_t WS_BAR = al256(WS_MIX_END > WS_FFN_END ? WS_MIX_END : WS_FFN_END);
constexpr size_t WS_END = WS_BAR + (size_t)XCD_BAR_WORDS * 4;

struct Params { const float* in[34]; float* out; unsigned char* ws; };
enum { I_X = 0, I_C, I_CTX, I_CCTX, I_MODW, I_MODB, I_NORMG, I_F1GU, I_F1DN, I_F2GU, I_F2DN, I_WIN, I_WOUT, I_HCW, I_HCB, I_HW1, I_HB1, I_HW2, I_HB2, I_HW3, I_HFREQ, I_HBIAS,
       I_MU, I_W0, I_W2, I_A0, I_A2, I_G2, I_KK, I_KA, I_RK, I_LNW, I_LNB, I_RPB };

__device__ __forceinline__ float bf2f(bf16_t b) { return __uint_as_float(((unsigned)b) << 16); }
__device__ __forceinline__ bf16_t f2bf(float f) { unsigned u = __float_as_uint(f); u += 0x7FFFu + ((u >> 16) & 1u); return (bf16_t)(u >> 16); }
__device__ __forceinline__ float lo_bf(unsigned w) { return __uint_as_float(w << 16); }
__device__ __forceinline__ float hi_bf(unsigned w) { return __uint_as_float(w & 0xffff0000u); }
__device__ __forceinline__ float wsum(float v) {
#pragma unroll
    for (int o = 32; o > 0; o >>= 1) v += __shfl_xor(v, o);
    return v;
}
__device__ __forceinline__ float sigmoidf_(float x) { return __builtin_amdgcn_rcpf(1.0f + __expf(-x)); }
__device__ __forceinline__ void unpack8(const u32x4 w, float (&f)[8]) {
    f[0] = lo_bf(w.x); f[1] = hi_bf(w.x); f[2] = lo_bf(w.y); f[3] = hi_bf(w.y); f[4] = lo_bf(w.z); f[5] = hi_bf(w.z); f[6] = lo_bf(w.w); f[7] = hi_bf(w.w);
}
__device__ __forceinline__ void row_nbrs(int row, bool& hasp, bool& hasn) {
    if (row < TL) { const int t = row & (SEQ - 1); hasp = t > 0; hasn = t < SEQ - 1; }
    else { const int t = (row - TL) & (CTX - 1); hasp = t > 0; hasn = t < CTX - 1; }
}

__device__ __forceinline__ void ph_modv(const Params& P, float* lds) {
    const int tid = otid();
    float* sv = lds;
    float* red = lds + 3072;
    for (int i = tid; i < 3072; i += NTHR) { const int s = i >> 10, k = i & 1023; const float c = s < 2 ? P.in[I_C][s * 1024 + k] : P.in[I_CCTX][k]; sv[i] = c / (1.0f + expf(-c)); }
    __syncthreads();
    float* modv = (float*)(P.ws + WS_MODV);
    const int kc = tid >> 6, cl = tid & 63;
    for (int item = blockIdx.x; item < DEPTH * 144; item += gridDim.x) {
        const int l = item / 144, cb = item % 144, col = cb * 64 + cl;
        const float* w = P.in[I_MODW] + ((size_t)l * 1024 + kc * 128) * NMOD + col;
        float a0 = 0.f, a1 = 0.f, a2 = 0.f;
#pragma unroll 8
        for (int k = 0; k < 128; ++k) { const float wv = w[(size_t)k * NMOD]; a0 += sv[kc * 128 + k] * wv; a1 += sv[1024 + kc * 128 + k] * wv; a2 += sv[2048 + kc * 128 + k] * wv; }
        red[(0 * 8 + kc) * 64 + cl] = a0; red[(1 * 8 + kc) * 64 + cl] = a1; red[(2 * 8 + kc) * 64 + cl] = a2;
        __syncthreads();
        if (tid < 192) { const int s = tid >> 6, c = tid & 63; float r = P.in[I_MODB][l * NMOD + cb * 64 + c];
#pragma unroll
            for (int q = 0; q < 8; ++q) r += red[(s * 8 + q) * 64 + c];
            modv[((size_t)l * 3 + s) * NMOD + cb * 64 + c] = r; }
        __syncthreads();
    }
}

__device__ __forceinline__ int rowmap_gu(int n) { const int up = n >= DFF ? 1 : 0; const int j = n - up * DFF; return (j >> 7) * 256 + up * 128 + (j & 127); }
__device__ __forceinline__ void conv_tile(const float* __restrict__ src, int K, int N, bf16_t* __restrict__ dst, int tk, int tn, bool gu, float* tile) {
    const int tid = otid(); const int k0 = tk * 64, n0 = tn * 64;
#pragma unroll
    for (int rr = 0; rr < 2; ++rr) { const int kk = (tid >> 4) + rr * 32, n4 = (tid & 15) * 4; const float4 v = *(const float4*)(src + (size_t)(k0 + kk) * N + n0 + n4);
        tile[kk * 65 + n4 + 0] = v.x; tile[kk * 65 + n4 + 1] = v.y; tile[kk * 65 + n4 + 2] = v.z; tile[kk * 65 + n4 + 3] = v.w; }
    __syncthreads();
    { const int nn = tid >> 3, ks = (tid & 7) * 8; const int n = n0 + nn; const int row = gu ? rowmap_gu(n) : n;
      u32x4 w; w.x = cvt_pk_bf16(tile[(ks + 0) * 65 + nn], tile[(ks + 1) * 65 + nn]); w.y = cvt_pk_bf16(tile[(ks + 2) * 65 + nn], tile[(ks + 3) * 65 + nn]);
      w.z = cvt_pk_bf16(tile[(ks + 4) * 65 + nn], tile[(ks + 5) * 65 + nn]); w.w = cvt_pk_bf16(tile[(ks + 6) * 65 + nn], tile[(ks + 7) * 65 + nn]);
      *(u32x4*)(dst + (size_t)row * K + k0 + ks) = w; }
    __syncthreads();
}
__device__ __forceinline__ void ph_prep(const Params& P, int l, float* lds) {
    const int tid = otid();
    unsigned char* ws = P.ws;
    constexpr int N0 = 16 * 88, N1 = 44 * 16, N4 = 16 * 54, N5 = 16 * 16;
    constexpr int C0 = N0, C1 = C0 + N1, C2 = C1 + N0, C3 = C2 + N1, C4 = C3 + N4, C5 = C4 + N5;
    for (int it = blockIdx.x; it < C5; it += gridDim.x) {
        if (it < C0) { conv_tile(P.in[I_F1GU] + (size_t)l * D * 2 * DFF, D, 2 * DFF, (bf16_t*)(ws + WS_WGU1), it / 88, it % 88, true, lds); }
        else if (it < C1) { const int j = it - C0; conv_tile(P.in[I_F1DN] + (size_t)l * DFF * D, DFF, D, (bf16_t*)(ws + WS_WDN1), j / 16, j % 16, false, lds); }
        else if (it < C2) { const int j = it - C1; conv_tile(P.in[I_F2GU] + (size_t)l * D * 2 * DFF, D, 2 * DFF, (bf16_t*)(ws + WS_WGU2), j / 88, j % 88, true, lds); }
        else if (it < C3) { const int j = it - C2; conv_tile(P.in[I_F2DN] + (size_t)l * DFF * D, DFF, D, (bf16_t*)(ws + WS_WDN2), j / 16, j % 16, false, lds); }
        else if (it < C4) { const int j = it - C3; conv_tile(P.in[I_WIN] + (size_t)l * D * INW, D, INW, (bf16_t*)(ws + WS_WIN), j / 54, j % 54, false, lds); }
        else { const int j = it - C4; conv_tile(P.in[I_WOUT] + (size_t)l * D * D, D, D, (bf16_t*)(ws + WS_WOUT), j / 16, j % 16, false, lds); }
    }
    const int gtid = blockIdx.x * NTHR + tid, gn = gridDim.x * NTHR;
    { unsigned* z = (unsigned*)(ws + WS_WIN + (size_t)INW * D * 2); for (int i = gtid; i < (INWP - INW) * D / 2; i += gn) z[i] = 0u; }
    { bf16_t* wl = (bf16_t*)(ws + WS_WLORA);
      const float* w2 = P.in[I_W2] + (size_t)l * 2 * 64 * RWW; const float* a2 = P.in[I_A2] + (size_t)l * 2 * 64 * RWW; const float* g2 = P.in[I_G2] + (size_t)l * 128 * RWW;
      for (int i = gtid; i < 2048 * 384; i += gn) { const int k = i / 2048, j = i % 2048; float v = 0.f;
          if (j < 1920) { const int grp = j / 384, c = j % 384;
              if (grp == 0) { if (k < 64) v = w2[(size_t)k * RWW + c]; }
              else if (grp == 1) { if (k >= 64 && k < 128) v = w2[(size_t)(64 + k - 64) * RWW + c]; }
              else if (grp == 2) { if (k >= 128 && k < 192) v = a2[(size_t)(k - 128) * RWW + c]; }
              else if (grp == 3) { if (k >= 192 && k < 256) v = a2[(size_t)(64 + k - 192) * RWW + c]; }
              else { if (k >= 256) v = g2[(size_t)(k - 256) * RWW + c]; } }
          wl[(size_t)j * 384 + k] = f2bf(v); } }
    { float* h2 = (float*)(ws + WS_H2);
      const float* w1 = P.in[I_HW1] + (size_t)l * 33 * 64; const float* b1 = P.in[I_HB1] + l * 64; const float* w2f = P.in[I_HW2] + (size_t)l * 64 * 64; const float* b2 = P.in[I_HB2] + l * 64;
      const float* fqv = P.in[I_HFREQ] + l * 64;
      const int lane = tid & 63, gw = blockIdx.x * NWAVE + (tid >> 6), nw = gridDim.x * NWAVE;
      const float fq = fqv[lane], bb1 = b1[lane], bb2 = b2[lane];
      for (int n = gw; n < SEQ + CTX; n += nw) {
          const int L = n < SEQ ? SEQ : CTX, pos = n < SEQ ? n : n - SEQ;
          const float tt = (float)pos / (float)(L - 1);
          const float ang = 6.283185307179586f * (float)pos / (float)L;
          float z = 0.f;
          if (lane == 0) z = tt;
          else if (lane <= 16) { const float fr = 1e-4f + (float)(lane - 1) * ((15.0f - 1e-4f) / 15.0f); z = cosf(fr * ang); }
          else if (lane <= 32) { const float fr = 1e-4f + (float)(lane - 17) * ((15.0f - 1e-4f) / 15.0f); z = -sinf(fr * ang); }
          float a = bb1;
#pragma unroll
          for (int e = 0; e < 33; ++e) a += __shfl(z, e) * w1[e * 64 + lane];
          const float h1 = sinf(fq * a);
          float c = bb2;
#pragma unroll
          for (int i = 0; i < 64; ++i) c += __shfl(h1, i) * w2f[i * 64 + lane];
          h2[(size_t)n * 64 + lane] = sinf(fq * c);
      } }
}

__device__ __forceinline__ void ph_rowpass(const Params& P, int mode, int lpost, int gate_i, int gpost_i, float ps, int lpre, int gpre_i, int shift_i, int scale_i) {
    const int tid = otid(), lane = tid & 63, gw = blockIdx.x * NWAVE + (tid >> 6), nw = gridDim.x * NWAVE;
    const float* modv = (const float*)(P.ws + WS_MODV);
    float* H = (float*)(P.ws + WS_H); const float* Y = (const float*)(P.ws + WS_Y); bf16_t* U = (bf16_t*)(P.ws + WS_U);
    int cur_s = -1;
    float4 A[4], Bv[4], Cv[4];
#pragma unroll
    for (int j = 0; j < 4; ++j) { A[j] = make_float4(0.f, 0.f, 0.f, 0.f); Bv[j] = A[j]; Cv[j] = A[j]; }
    for (int row = gw; row < T; row += nw) {
        const int s = row < SEQ ? 0 : (row < TL ? 1 : 2);
        if (s != cur_s) { cur_s = s;
#pragma unroll
            for (int j = 0; j < 4; ++j) { const int e = lane * 4 + 256 * j;
                if (mode != 0) { const float4 g = *(const float4*)(modv + ((size_t)lpost * 3 + s) * NMOD + gate_i * D + e); const float4 gp = *(const float4*)(P.in[I_NORMG] + ((size_t)lpost * 6 + gpost_i) * D + e);
                    A[j] = make_float4(ps * g.x * gp.x, ps * g.y * gp.y, ps * g.z * gp.z, ps * g.w * gp.w); }
                if (mode != 2) { const float4 sc = *(const float4*)(modv + ((size_t)lpre * 3 + s) * NMOD + scale_i * D + e); const float4 gq = *(const float4*)(P.in[I_NORMG] + ((size_t)lpre * 6 + gpre_i) * D + e);
                    Bv[j] = make_float4(gq.x * (1.f + sc.x), gq.y * (1.f + sc.y), gq.z * (1.f + sc.z), gq.w * (1.f + sc.w));
                    Cv[j] = *(const float4*)(modv + ((size_t)lpre * 3 + s) * NMOD + shift_i * D + e); } } }
        float4 h[4];
        if (mode == 0) { const float* src = row < TL ? P.in[I_X] + (size_t)row * D : P.in[I_CTX] + (size_t)(row - TL) * D;
#pragma unroll
            for (int j = 0; j < 4; ++j) h[j] = *(const float4*)(src + lane * 4 + 256 * j);
        } else {
            float4 y[4]; float ss = 0.f;
#pragma unroll
            for (int j = 0; j < 4; ++j) { h[j] = *(const float4*)(H + (size_t)row * D + lane * 4 + 256 * j); y[j] = *(const float4*)(Y + (size_t)row * D + lane * 4 + 256 * j);
                ss += y[j].x * y[j].x + y[j].y * y[j].y + y[j].z * y[j].z + y[j].w * y[j].w; }
            ss = wsum(ss); const float r = rsqrtf(ss * (1.0f / D) + NORM_EPS);
#pragma unroll
            for (int j = 0; j < 4; ++j) { h[j].x += A[j].x * (y[j].x * r); h[j].y += A[j].y * (y[j].y * r); h[j].z += A[j].z * (y[j].z * r); h[j].w += A[j].w * (y[j].w * r); }
        }
        if (mode == 2) { if (row < TL) {
#pragma unroll
                for (int j = 0; j < 4; ++j) *(float4*)(P.out + (size_t)row * D + lane * 4 + 256 * j) = h[j]; }
            continue; }
        float s2 = 0.f;
#pragma unroll
        for (int j = 0; j < 4; ++j) { *(float4*)(H + (size_t)row * D + lane * 4 + 256 * j) = h[j]; s2 += h[j].x * h[j].x + h[j].y * h[j].y + h[j].z * h[j].z + h[j].w * h[j].w; }
        s2 = wsum(s2); const float r2 = rsqrtf(s2 * (1.0f / D) + NORM_EPS);
#pragma unroll
        for (int j = 0; j < 4; ++j) { u32x2 w; w.x = cvt_pk_bf16(h[j].x * r2 * Bv[j].x + Cv[j].x, h[j].y * r2 * Bv[j].y + Cv[j].y); w.y = cvt_pk_bf16(h[j].z * r2 * Bv[j].z + Cv[j].z, h[j].w * r2 * Bv[j].w + Cv[j].w);
            *(u32x2*)(U + (size_t)row * D + lane * 4 + 256 * j) = w; }
    }
}

struct EpiGU {
    static constexpr bool PERM = true, AFTER_DRAIN = false;
    bf16_t* O;
    __device__ __forceinline__ void operator()(const f32x4 (&acc)[2][2][4][2], const pg8::Unit& u, int wr, int wc, int fr, int fq) const {
        const int row0 = u.pm * 256 + wr * 64 + fr, col0 = u.pn * 128 + wc * 32 + 8 * fq;
#pragma unroll
        for (int ai = 0; ai < 2; ++ai)
#pragma unroll
            for (int m = 0; m < 4; ++m) { float o[8];
#pragma unroll
                for (int n = 0; n < 2; ++n)
#pragma unroll
                    for (int j = 0; j < 4; ++j) { const float g = acc[ai][0][m][n][j], up = acc[ai][1][m][n][j]; o[n * 4 + j] = g * __builtin_amdgcn_rcpf(1.0f + __expf(-g)) * up; }
                u32x4 w; w.x = cvt_pk_bf16(o[0], o[1]); w.y = cvt_pk_bf16(o[2], o[3]); w.z = cvt_pk_bf16(o[4], o[5]); w.w = cvt_pk_bf16(o[6], o[7]);
                *(u32x4*)(O + (size_t)(row0 + ai * 128 + m * 16) * DFF + col0) = w; }
    }
};
struct EpiF32 {
    static constexpr bool PERM = false, AFTER_DRAIN = false;
    float* C;
    __device__ __forceinline__ void operator()(const f32x4 (&acc)[2][2][4][2], const pg8::Unit& u, int wr, int wc, int fr, int fq) const {
        const int row0 = u.pm * 256 + wr * 64 + fr, col0 = u.pn * 256 + wc * 32 + 4 * fq;
#pragma unroll
        for (int ai = 0; ai < 2; ++ai)
#pragma unroll
            for (int m = 0; m < 4; ++m) { float* rowp = C + (size_t)(row0 + ai * 128 + m * 16) * D + col0;
#pragma unroll
                for (int bj = 0; bj < 2; ++bj)
#pragma unroll
                    for (int n = 0; n < 2; ++n) *(f32x4*)(rowp + bj * 128 + n * 16) = acc[ai][bj][m][n]; }
    }
};
struct EpiWin {
    static constexpr bool PERM = true, AFTER_DRAIN = false;
    bf16_t* PHYT; bf16_t* PRW; bf16_t* PNA;
    __device__ __forceinline__ void operator()(const f32x4 (&acc)[2][2][4][2], const pg8::Unit& u, int wr, int wc, int fr, int fq) const {
        const int row0 = u.pm * 256 + wr * 64 + fr;
        if (u.pn < 3) {
#pragma unroll
            for (int bj = 0; bj < 2; ++bj) { bf16_t* cp = PHYT + (size_t)(u.pn * 256 + bj * 128 + wc * 32 + 8 * fq) * T + row0;
#pragma unroll
                for (int ai = 0; ai < 2; ++ai)
#pragma unroll
                    for (int m = 0; m < 4; ++m) { const f32x4 v0 = acc[ai][bj][m][0], v1 = acc[ai][bj][m][1]; bf16_t* rp = cp + ai * 128 + m * 16;
                        const unsigned w0 = cvt_pk_bf16(v0[0], v0[1]), w1 = cvt_pk_bf16(v0[2], v0[3]), w2 = cvt_pk_bf16(v1[0], v1[1]), w3 = cvt_pk_bf16(v1[2], v1[3]);
                        rp[0] = (bf16_t)w0; rp[(size_t)T] = (bf16_t)(w0 >> 16); rp[(size_t)2 * T] = (bf16_t)w1; rp[(size_t)3 * T] = (bf16_t)(w1 >> 16);
                        rp[(size_t)4 * T] = (bf16_t)w2; rp[(size_t)5 * T] = (bf16_t)(w2 >> 16); rp[(size_t)6 * T] = (bf16_t)w3; rp[(size_t)7 * T] = (bf16_t)(w3 >> 16); } }
            return; }
        bf16_t* base; int ld, cbase;
        if (u.pn < 9) { base = PRW; ld = RW_IN; cbase = u.pn * 256 - HY_IN; }
        else { base = PNA; ld = NA_IN; cbase = u.pn * 256 - HY_IN - RW_IN; }
        const int nbj = (u.pn == 13) ? 1 : 2;
#pragma unroll
        for (int ai = 0; ai < 2; ++ai)
#pragma unroll
            for (int m = 0; m < 4; ++m)
#pragma unroll
                for (int bj = 0; bj < 2; ++bj) { if (bj < nbj) { const f32x4 v0 = acc[ai][bj][m][0], v1 = acc[ai][bj][m][1];
                    u32x4 w; w.x = cvt_pk_bf16(v0[0], v0[1]); w.y = cvt_pk_bf16(v0[2], v0[3]); w.z = cvt_pk_bf16(v1[0], v1[1]); w.w = cvt_pk_bf16(v1[2], v1[3]);
                    *(u32x4*)(base + (size_t)(row0 + ai * 128 + m * 16) * ld + cbase + bj * 128 + wc * 32 + 8 * fq) = w; } }
    }
};
struct EpiLora {
    static constexpr bool PERM = true, AFTER_DRAIN = false;
    bf16_t* LO; bf16_t* GATE;
    __device__ __forceinline__ void operator()(const f32x4 (&acc)[2][2][4][2], const pg8::Unit& u, int wr, int wc, int fr, int fq) const {
        const int row0 = u.pm * 256 + wr * 64 + fr;
        bf16_t* base; int ld, cbase;
        if (u.pn < 6) { base = LO; ld = 1536; cbase = u.pn * 256; } else { base = GATE; ld = 384; cbase = u.pn * 256 - 1536; }
        const int nbj = (u.pn == 7) ? 1 : 2;
#pragma unroll
        for (int ai = 0; ai < 2; ++ai)
#pragma unroll
            for (int m = 0; m < 4; ++m)
#pragma unroll
                for (int bj = 0; bj < 2; ++bj) { if (bj < nbj) { const f32x4 v0 = acc[ai][bj][m][0], v1 = acc[ai][bj][m][1];
                    u32x4 w; w.x = cvt_pk_bf16(v0[0], v0[1]); w.y = cvt_pk_bf16(v0[2], v0[3]); w.z = cvt_pk_bf16(v1[0], v1[1]); w.w = cvt_pk_bf16(v1[2], v1[3]);
                    *(u32x4*)(base + (size_t)(row0 + ai * 128 + m * 16) * ld + cbase + bj * 128 + wc * 32 + 8 * fq) = w; } }
    }
};
template <class Epi> __device__ __forceinline__ void run_gemm(LAS unsigned char* lds, const bf16_t* A, const bf16_t* Bt, int M, int N, int K, const Epi& E) {
    asm volatile("" : "+s"(K));
    pg8::Gemm g{A, Bt, M, N, K}; pg8::StaticOrder S; S.init(M, N, (int)gridDim.x, (int)blockIdx.x);
    pg8::gemm_phase<Epi, pg8::StaticOrder>(lds, g, S, E);
    __syncthreads();
}

__device__ __forceinline__ void ph_loraprep(const Params& P, int l) {
    const bf16_t* PRW = (const bf16_t*)(P.ws + WS_PRW); bf16_t* AL = (bf16_t*)(P.ws + WS_ALORA);
    const float* mu = P.in[I_MU] + (size_t)l * 2 * RW_IN;
    const int gtid = blockIdx.x * NTHR + otid(), gn = gridDim.x * NTHR;
    for (int it = gtid; it < T * 48; it += gn) {
        const int row = it / 48, j8 = it % 48, col = 1152 + j8 * 8;
        bool hp, hn; row_nbrs(row, hp, hn);
        float p[8], pp[8], pn[8];
        unpack8(*(const u32x4*)(PRW + (size_t)row * RW_IN + col), p);
        if (hp) unpack8(*(const u32x4*)(PRW + (size_t)(row - 1) * RW_IN + col), pp); else {
#pragma unroll
            for (int i = 0; i < 8; ++i) pp[i] = 0.f; }
        if (hn) unpack8(*(const u32x4*)(PRW + (size_t)(row + 1) * RW_IN + col), pn); else {
#pragma unroll
            for (int i = 0; i < 8; ++i) pn[i] = 0.f; }
        float o[8];
#pragma unroll
        for (int i = 0; i < 8; ++i) { const float xs = p[i] + mu[col + i] * (pp[i] - p[i]) + mu[RW_IN + col + i] * (pn[i] - p[i]);
            o[i] = j8 < 16 ? tanhf(xs) : (j8 < 32 ? xs : sigmoidf_(xs)); }
        u32x4 w; w.x = cvt_pk_bf16(o[0], o[1]); w.y = cvt_pk_bf16(o[2], o[3]); w.z = cvt_pk_bf16(o[4], o[5]); w.w = cvt_pk_bf16(o[6], o[7]);
        *(u32x4*)(AL + (size_t)row * 384 + j8 * 8) = w;
    }
}

__device__ __forceinline__ void ph_rwkvprep(const Params& P, int l) {
    const int tid = otid(), lane = tid & 63, gw = blockIdx.x * NWAVE + (tid >> 6), nw = gridDim.x * NWAVE;
    const bf16_t* PRW = (const bf16_t*)(P.ws + WS_PRW); const bf16_t* LO = (const bf16_t*)(P.ws + WS_LORAO);
    bf16_t* RS = (bf16_t*)(P.ws + WS_RS); bf16_t* KKS = (bf16_t*)(P.ws + WS_KKS); bf16_t* VS = (bf16_t*)(P.ws + WS_VS); bf16_t* KS = (bf16_t*)(P.ws + WS_KS); bf16_t* BS = (bf16_t*)(P.ws + WS_BS);
    float* BON = (float*)(P.ws + WS_BONUS);
    const float* mu = P.in[I_MU] + (size_t)l * 2 * RW_IN;
    const int f = lane & 15; const float inv = __expf(-(float)f * (9.210340371976184f / 16.0f));
    for (int row = gw; row < T; row += nw) {
        bool hp, hn; row_nbrs(row, hp, hn);
#pragma unroll
      for (int h = 0; h < 6; ++h) { const int c = h * 64 + lane;
        float x[3];
#pragma unroll
        for (int q = 0; q < 3; ++q) { const int col = q * 384 + c; const float p = bf2f(PRW[(size_t)row * RW_IN + col]);
            const float pp = hp ? bf2f(PRW[(size_t)(row - 1) * RW_IN + col]) : 0.f, pn = hn ? bf2f(PRW[(size_t)(row + 1) * RW_IN + col]) : 0.f;
            x[q] = p + mu[col] * (pp - p) + mu[RW_IN + col] * (pn - p); }
        const float r = x[0], k = x[1], v = x[2];
        const float kkr = k * P.in[I_KK][l * RWW + c];
        const float nrm = sqrtf(wsum(kkr * kkr));
        const float kk = kkr / fmaxf(nrm, 1e-12f);
        const float a0 = sigmoidf_(bf2f(LO[(size_t)row * 1536 + 768 + c]) + P.in[I_A0][(size_t)l * 2 * RWW + c]), a1 = sigmoidf_(bf2f(LO[(size_t)row * 1536 + 1152 + c]) + P.in[I_A0][(size_t)l * 2 * RWW + RWW + c]);
        { float* DEC = (float*)(P.ws + WS_DECAY);
          const float x0 = bf2f(LO[(size_t)row * 1536 + c]) + P.in[I_W0][(size_t)l * 2 * RWW + c], x1 = bf2f(LO[(size_t)row * 1536 + 384 + c]) + P.in[I_W0][(size_t)l * 2 * RWW + RWW + c];
          DEC[(size_t)row * 384 + c] = __expf(-0.6065306597f * sigmoidf_(x0)); DEC[((size_t)T + row) * 384 + c] = __expf(-0.6065306597f * sigmoidf_(x1)); }
        const float ka = P.in[I_KA][l * RWW + c];
        float kd0 = k * (1.f + (a0 - 1.f) * ka), kd1 = k * (1.f + (a1 - 1.f) * ka);
        float b0 = kk * a0, b1 = kk * a1;
        const float bon = wsum(r * (kd0 + kd1) * P.in[I_RK][l * RWW + c]);
        if (lane == 0) BON[(size_t)row * 6 + h] = bon;
        float rs = r, kks = kk;
        if (row < TL) {
            const int t = row & (SEQ - 1); const float pos = (lane < 32) ? (float)(t >> 6) : (float)(t & 63);
            float sn, cs; sincosf(pos * inv, &sn, &cs);
            const float sg = (lane & 16) ? 1.f : -1.f;
            const float r2 = __shfl_xor(rs, 16), k2 = __shfl_xor(kks, 16), d0 = __shfl_xor(kd0, 16), d1 = __shfl_xor(kd1, 16), e0 = __shfl_xor(b0, 16), e1 = __shfl_xor(b1, 16);
            rs = rs * cs + sg * r2 * sn; kks = kks * cs + sg * k2 * sn; kd0 = kd0 * cs + sg * d0 * sn; kd1 = kd1 * cs + sg * d1 * sn; b0 = b0 * cs + sg * e0 * sn; b1 = b1 * cs + sg * e1 * sn;
        }
        const size_t o = (size_t)row * 384 + c;
        RS[o] = f2bf(rs); KKS[o] = f2bf(-kks); VS[o] = f2bf(v);
        KS[o] = f2bf(kd0); KS[(size_t)T * 384 + o] = f2bf(kd1); BS[o] = f2bf(b0); BS[(size_t)T * 384 + o] = f2bf(b1);
      }
    }
}

__device__ __forceinline__ int scan_row(int b, int d, int step) {
    if (step < CTX) { const int tc = d ? (CTX - 1 - step) : step; return TL + b * CTX + tc; }
    const int tl = d ? (SEQ - 1 - (step - CTX)) : (step - CTX); return b * SEQ + tl;
}
__device__ __forceinline__ void scan_task_v1(const Params& P, int task, float* sv) {
    const int lane = otid() & 63;
    const int d = task & 1, h = (task >> 1) % 6, b = task / 12;
    const float* DEC = (const float*)(P.ws + WS_DECAY) + (size_t)d * T * 384; const bf16_t* KKS = (const bf16_t*)(P.ws + WS_KKS); const bf16_t* RS = (const bf16_t*)(P.ws + WS_RS);
    const bf16_t* VS = (const bf16_t*)(P.ws + WS_VS); const bf16_t* KS = (const bf16_t*)(P.ws + WS_KS) + (size_t)d * T * 384; const bf16_t* BS = (const bf16_t*)(P.ws + WS_BS) + (size_t)d * T * 384;
    float* YD = (float*)(P.ws + WS_YDIR) + (size_t)d * T * 384;
    float S[64];
#pragma unroll
    for (int j = 0; j < 64; ++j) S[j] = 0.f;
    size_t o = (size_t)scan_row(b, d, 0) * 384 + h * 64 + lane;
    float nw_ = DEC[o], na = bf2f(KKS[o]), nb = bf2f(BS[o]), nk = bf2f(KS[o]), nr = bf2f(RS[o]), nv = bf2f(VS[o]);
    for (int step = 0; step < CTX + SEQ; ++step) {
        const float v = nv; const size_t oc = o;
        asm volatile("s_waitcnt lgkmcnt(0)" ::: "memory");
        sv[lane] = nw_; sv[64 + lane] = na; sv[128 + lane] = nb; sv[192 + lane] = nk; sv[256 + lane] = nr;
        asm volatile("s_waitcnt lgkmcnt(0)" ::: "memory");
        if (step + 1 < CTX + SEQ) { o = (size_t)scan_row(b, d, step + 1) * 384 + h * 64 + lane;
            nw_ = DEC[o]; na = bf2f(KKS[o]); nb = bf2f(BS[o]); nk = bf2f(KS[o]); nr = bf2f(RS[o]); nv = bf2f(VS[o]); }
        float sa0 = 0.f, sa1 = 0.f, sa2 = 0.f, sa3 = 0.f;
#pragma unroll
        for (int j = 0; j < 64; j += 4) { const float4 a4 = *(const float4*)(sv + 64 + j);
            sa0 += S[j + 0] * a4.x; sa1 += S[j + 1] * a4.y; sa2 += S[j + 2] * a4.z; sa3 += S[j + 3] * a4.w; }
        const float sa = (sa0 + sa1) + (sa2 + sa3);
        float y0 = 0.f, y1 = 0.f, y2 = 0.f, y3 = 0.f;
#pragma unroll
        for (int j = 0; j < 64; j += 4) {
            const float4 w4 = *(const float4*)(sv + j), b4 = *(const float4*)(sv + 128 + j), k4 = *(const float4*)(sv + 192 + j), r4 = *(const float4*)(sv + 256 + j);
            S[j + 0] = S[j + 0] * w4.x + sa * b4.x + v * k4.x; y0 += S[j + 0] * r4.x;
            S[j + 1] = S[j + 1] * w4.y + sa * b4.y + v * k4.y; y1 += S[j + 1] * r4.y;
            S[j + 2] = S[j + 2] * w4.z + sa * b4.z + v * k4.z; y2 += S[j + 2] * r4.z;
            S[j + 3] = S[j + 3] * w4.w + sa * b4.w + v * k4.w; y3 += S[j + 3] * r4.w; }
        YD[oc] = (y0 + y1) + (y2 + y3);
    }
}

__device__ __forceinline__ void natt_key(const bf16_t* PNA, size_t krow, int hoff, const float (&q)[16], float bias, float& m, float& lsum, float (&o)[16]) {
    const bf16_t* kp = PNA + krow * NA_IN + 384 + hoff; const bf16_t* vp = PNA + krow * NA_IN + 768 + hoff;
    float s = 0.f;
#pragma unroll
    for (int j8 = 0; j8 < 2; ++j8) { float kf[8]; unpack8(*(const u32x4*)(kp + j8 * 8), kf);
#pragma unroll
        for (int i = 0; i < 8; ++i) s += q[j8 * 8 + i] * kf[i]; }
    s += __shfl_xor(s, 1); s += __shfl_xor(s, 2); s += bias;
    const float mn = fmaxf(m, s), corr = __expf(m - mn), p = __expf(s - mn);
    m = mn; lsum = lsum * corr + p;
#pragma unroll
    for (int j8 = 0; j8 < 2; ++j8) { float vf[8]; unpack8(*(const u32x4*)(vp + j8 * 8), vf);
#pragma unroll
        for (int i = 0; i < 8; ++i) o[j8 * 8 + i] = o[j8 * 8 + i] * corr + p * vf[i]; }
}
__device__ __forceinline__ void natten_items_v1(const Params& P, int l, int wid0, int nworkers) {
    const bf16_t* PNA = (const bf16_t*)(P.ws + WS_PNA); bf16_t* MIX = (bf16_t*)(P.ws + WS_U);
    const float* rpb = P.in[I_RPB] + (size_t)l * 6 * 15 * 31;
    const int sub = wid0 & 3;
    for (int it = wid0 >> 2; it < T * 6; it += nworkers >> 2) {
        const int row = it % T, h = it / T, hoff = h * 64 + sub * 16;
        float q[16], o[16];
#pragma unroll
        for (int j8 = 0; j8 < 2; ++j8) { float qf[8]; unpack8(*(const u32x4*)(PNA + (size_t)row * NA_IN + hoff + j8 * 8), qf);
#pragma unroll
            for (int i = 0; i < 8; ++i) { q[j8 * 8 + i] = qf[i] * 0.125f; o[j8 * 8 + i] = 0.f; } }
        float m = -3.0e38f, lsum = 0.f;
        int b;
        if (row < TL) { b = row >> 13; const int t = row & (SEQ - 1), i = t >> 6, col = t & 63;
            const int start = min(max(i - 4, 0), 120), win0 = min(max(col - 8, 0), 48);
            for (int r = 0; r < 8; ++r) for (int kc = win0; kc < win0 + 16; ++kc) {
                const float bias = rpb[(h * 15 + (start + r - i + 7)) * 31 + (kc - col + 15)];
                natt_key(PNA, (size_t)b * SEQ + (start + r) * 64 + kc, hoff, q, bias, m, lsum, o); }
        } else b = (row - TL) >> 8;
        for (int c = 0; c < CTX; ++c) natt_key(PNA, (size_t)TL + b * CTX + c, hoff, q, 0.f, m, lsum, o);
        const float il = 1.0f / lsum;
#pragma unroll
        for (int j8 = 0; j8 < 2; ++j8) { u32x4 w; w.x = cvt_pk_bf16(o[j8 * 8 + 0] * il, o[j8 * 8 + 1] * il); w.y = cvt_pk_bf16(o[j8 * 8 + 2] * il, o[j8 * 8 + 3] * il);
            w.z = cvt_pk_bf16(o[j8 * 8 + 4] * il, o[j8 * 8 + 5] * il); w.w = cvt_pk_bf16(o[j8 * 8 + 6] * il, o[j8 * 8 + 7] * il);
            *(u32x4*)(MIX + (size_t)row * D + 640 + hoff + j8 * 8) = w; }
    }
}

__device__ __forceinline__ void vt_tile(const Params& P, int tile, unsigned short* tl  ) {
    const int tid = otid();
    const bf16_t* PNA = (const bf16_t*)(P.ws + WS_PNA);
    int h, tok0; bf16_t* dst; int ldt;
    if (tile < NB * 128 * 6) { h = tile % 6; const int sb = tile / 6; const int b = sb >> 7, blk = sb & 127; tok0 = b * SEQ + blk * 64; dst = (bf16_t*)(P.ws + WS_VTL) + ((size_t)(b * 6 + h) * 64) * SEQ + blk * 64; ldt = SEQ; }
    else { const int tt = tile - NB * 128 * 6; h = tt % 6; const int sb = tt / 6; const int b = sb >> 2, blk = sb & 3; tok0 = TL + b * CTX + blk * 64; dst = (bf16_t*)(P.ws + WS_VTC) + ((size_t)(b * 6 + h) * 64) * CTX + blk * 64; ldt = CTX; }
    { const int tok = tid >> 3, seg = tid & 7; const u32x4 v = *(const u32x4*)(PNA + (size_t)(tok0 + tok) * NA_IN + 768 + h * 64 + seg * 8);
      unsigned* w = (unsigned*)(tl + tok * 72 + seg * 8); w[0] = v.x; w[1] = v.y; w[2] = v.z; w[3] = v.w; }
    __syncthreads();
    { const int hd = tid >> 3, ts = tid & 7; unsigned short e[8];
#pragma unroll
      for (int k = 0; k < 8; ++k) e[k] = tl[(ts * 8 + k) * 72 + hd];
      u32x4 w; w.x = (unsigned)e[0] | ((unsigned)e[1] << 16); w.y = (unsigned)e[2] | ((unsigned)e[3] << 16); w.z = (unsigned)e[4] | ((unsigned)e[5] << 16); w.w = (unsigned)e[6] | ((unsigned)e[7] << 16);
      *(u32x4*)(dst + (size_t)hd * ldt + ts * 8) = w; }
    __syncthreads();
}
constexpr int NAT_LAT_TASKS = NB * 128 * 4 * 6, NAT_CTX_TASKS = NB * 16 * 6, NAT_TASKS = NAT_LAT_TASKS + NAT_CTX_TASKS;
__device__ __forceinline__ void natten_task(const Params& P, int l, int task) {
    using pg8::bf16x8;
    const int lane = otid() & 63, fr = lane & 15, fq = lane >> 4;
    const bf16_t* PNA = (const bf16_t*)(P.ws + WS_PNA); bf16_t* MIX = (bf16_t*)(P.ws + WS_U);
    const bool lat = task < NAT_LAT_TASKS;
    int b, h, i = 0, n = 0, qtok0;
    if (lat) { h = task % 6; const int r = task / 6; n = r & 3; i = (r >> 2) & 127; b = r >> 9; qtok0 = b * SEQ + i * 64 + 16 * n; }
    else { const int tt = task - NAT_LAT_TASKS; h = tt % 6; const int qb = (tt / 6) & 15; b = tt / 96; qtok0 = TL + b * CTX + 16 * qb; }
    const int start = min(max(i - 4, 0), 120), band0 = min(max(16 * n - 8, 0), 32);
    const int col = 16 * n + fr, win0 = min(max(col - 8, 0), 48);
    bf16x8 bq[2];
#pragma unroll
    for (int kh = 0; kh < 2; ++kh) bq[kh] = *(const bf16x8*)(PNA + (size_t)(qtok0 + fr) * NA_IN + h * 64 + kh * 32 + fq * 8);
    f32x4 sc[32];
    if (lat) {
#pragma unroll
        for (int t = 0; t < 16; ++t) { const int tok0 = b * SEQ + (start + (t >> 1)) * 64 + band0 + 16 * (t & 1);
            const bf16_t* kp = PNA + (size_t)(tok0 + fr) * NA_IN + 384 + h * 64 + fq * 8;
            const bf16x8 k0 = *(const bf16x8*)kp, k1 = *(const bf16x8*)(kp + 32);
            f32x4 a = (f32x4){0.f, 0.f, 0.f, 0.f};
            a = __builtin_amdgcn_mfma_f32_16x16x32_bf16(k0, bq[0], a, 0, 0, 0); a = __builtin_amdgcn_mfma_f32_16x16x32_bf16(k1, bq[1], a, 0, 0, 0);
            sc[t] = a; if ((t & 3) == 3) asm volatile("" ::: "memory"); }
    } else {
#pragma unroll
        for (int t = 0; t < 16; ++t) sc[t] = (f32x4){-3.0e38f, -3.0e38f, -3.0e38f, -3.0e38f};
    }
#pragma unroll
    for (int t = 16; t < 32; ++t) { const int tok0 = TL + b * CTX + 16 * (t - 16);
        const bf16_t* kp = PNA + (size_t)(tok0 + fr) * NA_IN + 384 + h * 64 + fq * 8;
        const bf16x8 k0 = *(const bf16x8*)kp, k1 = *(const bf16x8*)(kp + 32);
        f32x4 a = (f32x4){0.f, 0.f, 0.f, 0.f};
        a = __builtin_amdgcn_mfma_f32_16x16x32_bf16(k0, bq[0], a, 0, 0, 0); a = __builtin_amdgcn_mfma_f32_16x16x32_bf16(k1, bq[1], a, 0, 0, 0);
        sc[t] = a * 0.125f; if ((t & 3) == 3) asm volatile("" ::: "memory"); }
    if (lat) { const float* rpb = P.in[I_RPB] + ((size_t)l * 6 + h) * 15 * 31;
#pragma unroll
        for (int t = 0; t < 16; ++t) { const int ro = start + (t >> 1) - i + 7; const int kc0 = band0 + 16 * (t & 1) + fq * 4;
#pragma unroll
            for (int j = 0; j < 4; ++j) { const int kc = kc0 + j; const bool ok = kc >= win0 && kc < win0 + 16; const int co = min(max(kc - col + 15, 0), 30);
                const float bias = rpb[ro * 31 + co]; sc[t][j] = ok ? sc[t][j] * 0.125f + bias : -3.0e38f; } } }
    float mx = -3.0e38f;
#pragma unroll
    for (int t = 0; t < 32; ++t) mx = fmaxf(mx, fmaxf(fmaxf(sc[t][0], sc[t][1]), fmaxf(sc[t][2], sc[t][3])));
    mx = fmaxf(mx, __shfl_xor(mx, 16)); mx = fmaxf(mx, __shfl_xor(mx, 32));
    float sum = 0.f;
#pragma unroll
    for (int t = 0; t < 32; ++t) {
#pragma unroll
        for (int j = 0; j < 4; ++j) { const float p = __expf(sc[t][j] - mx); sc[t][j] = p; sum += p; } }
    sum += __shfl_xor(sum, 16); sum += __shfl_xor(sum, 32);
    const float inv = 1.0f / sum;
    f32x4 ot[4];
#pragma unroll
    for (int q = 0; q < 4; ++q) ot[q] = (f32x4){0.f, 0.f, 0.f, 0.f};
    const bf16_t* VTL = (const bf16_t*)(P.ws + WS_VTL) + ((size_t)(b * 6 + h) * 64) * SEQ; const bf16_t* VTC = (const bf16_t*)(P.ws + WS_VTC) + ((size_t)(b * 6 + h) * 64) * CTX;
    if (lat) {
#pragma unroll
        for (int m = 0; m < 8; ++m) { const int tk = (start + m) * 64 + band0 + fq * 4;
            u32x4 pw; pw.x = cvt_pk_bf16(sc[2 * m][0], sc[2 * m][1]); pw.y = cvt_pk_bf16(sc[2 * m][2], sc[2 * m][3]); pw.z = cvt_pk_bf16(sc[2 * m + 1][0], sc[2 * m + 1][1]); pw.w = cvt_pk_bf16(sc[2 * m + 1][2], sc[2 * m + 1][3]);
            const bf16x8 pb = __builtin_bit_cast(bf16x8, pw);
#pragma unroll
            for (int q = 0; q < 4; ++q) { const bf16_t* vp = VTL + (size_t)(q * 16 + fr) * SEQ + tk; const u32x2 v0 = *(const u32x2*)vp, v1 = *(const u32x2*)(vp + 16);
                u32x4 vw; vw.x = v0.x; vw.y = v0.y; vw.z = v1.x; vw.w = v1.y;
                ot[q] = __builtin_amdgcn_mfma_f32_16x16x32_bf16(__builtin_bit_cast(bf16x8, vw), pb, ot[q], 0, 0, 0); }
            if (m & 1) asm volatile("" ::: "memory"); }
    }
#pragma unroll
    for (int m = 0; m < 8; ++m) { const int tk = 32 * m + fq * 4;
        u32x4 pw; pw.x = cvt_pk_bf16(sc[16 + 2 * m][0], sc[16 + 2 * m][1]); pw.y = cvt_pk_bf16(sc[16 + 2 * m][2], sc[16 + 2 * m][3]); pw.z = cvt_pk_bf16(sc[17 + 2 * m][0], sc[17 + 2 * m][1]); pw.w = cvt_pk_bf16(sc[17 + 2 * m][2], sc[17 + 2 * m][3]);
        const bf16x8 pb = __builtin_bit_cast(bf16x8, pw);
#pragma unroll
        for (int q = 0; q < 4; ++q) { const bf16_t* vp = VTC + (size_t)(q * 16 + fr) * CTX + tk; const u32x2 v0 = *(const u32x2*)vp, v1 = *(const u32x2*)(vp + 16);
            u32x4 vw; vw.x = v0.x; vw.y = v0.y; vw.z = v1.x; vw.w = v1.y;
            ot[q] = __builtin_amdgcn_mfma_f32_16x16x32_bf16(__builtin_bit_cast(bf16x8, vw), pb, ot[q], 0, 0, 0); }
        if (m & 1) asm volatile("" ::: "memory"); }
#pragma unroll
    for (int q = 0; q < 4; ++q) { u32x2 w; w.x = cvt_pk_bf16(ot[q][0] * inv, ot[q][1] * inv); w.y = cvt_pk_bf16(ot[q][2] * inv, ot[q][3] * inv);
        *(u32x2*)(MIX + (size_t)(qtok0 + fr) * D + 640 + h * 64 + q * 16 + fq * 4) = w; }
}

__device__ __forceinline__ void fft_fwd(float2* X) {
#pragma unroll 1
    for (int lq = 12; lq >= 0; lq -= 2) { const int q = 1 << lq;
        for (int j = otid(); j < NFFT / 4; j += NTHR) { const int lo = j & (q - 1), base = ((j >> lq) << (lq + 2)) | lo;
            const float2 x0 = X[base], x1 = X[base + q], x2 = X[base + 2 * q], x3 = X[base + 3 * q];
            const float fr = (float)lo / (float)(4 * q); const float c = __builtin_amdgcn_cosf(fr), s = __builtin_amdgcn_sinf(fr), c2 = c * c - s * s, s2 = 2.f * c * s;
            const float a0x = x0.x + x2.x, a0y = x0.y + x2.y, dx = x0.x - x2.x, dy = x0.y - x2.y;
            const float a2x = dx * c + dy * s, a2y = dy * c - dx * s;
            const float a1x = x1.x + x3.x, a1y = x1.y + x3.y, ex = x1.x - x3.x, ey = x1.y - x3.y;
            const float mx = ex * c + ey * s, my = ey * c - ex * s;
            const float a3x = my, a3y = -mx;
            const float fx = a0x - a1x, fy = a0y - a1y, gx = a2x - a3x, gy = a2y - a3y;
            X[base] = make_float2(a0x + a1x, a0y + a1y); X[base + q] = make_float2(fx * c2 + fy * s2, fy * c2 - fx * s2);
            X[base + 2 * q] = make_float2(a2x + a3x, a2y + a3y); X[base + 3 * q] = make_float2(gx * c2 + gy * s2, gy * c2 - gx * s2); }
        __syncthreads(); }
}
__device__ __forceinline__ void fft_inv(float2* X) {
#pragma unroll 1
    for (int lq = 0; lq <= 12; lq += 2) { const int q = 1 << lq;
        for (int j = otid(); j < NFFT / 4; j += NTHR) { const int lo = j & (q - 1), base = ((j >> lq) << (lq + 2)) | lo;
            const float2 y0 = X[base], y1 = X[base + q], y2 = X[base + 2 * q], y3 = X[base + 3 * q];
            const float fr = (float)lo / (float)(4 * q); const float c = __builtin_amdgcn_cosf(fr), s = __builtin_amdgcn_sinf(fr), c2 = c * c - s * s, s2 = 2.f * c * s;
            const float tx = y1.x * c2 - y1.y * s2, ty = y1.x * s2 + y1.y * c2;
            const float a0x = y0.x + tx, a0y = y0.y + ty, a1x = y0.x - tx, a1y = y0.y - ty;
            const float ux = y3.x * c2 - y3.y * s2, uy = y3.x * s2 + y3.y * c2;
            const float a2x = y2.x + ux, a2y = y2.y + uy, a3x = y2.x - ux, a3y = y2.y - uy;
            const float vx = a2x * c - a2y * s, vy = a2x * s + a2y * c;
            const float mx = a3x * c - a3y * s, my = a3x * s + a3y * c;
            const float wx = -my, wy = mx;
            X[base] = make_float2(a0x + vx, a0y + vy); X[base + 2 * q] = make_float2(a0x - vx, a0y - vy);
            X[base + q] = make_float2(a1x + wx, a1y + wy); X[base + 3 * q] = make_float2(a1x - wx, a1y - wy); }
        __syncthreads(); }
}
__device__ __forceinline__ float hy_delta(int c) { const float lo = -4.605170185988091f / 1.5f, hi = -4.605170185988091f / 0.3f; return fabsf(lo + (float)c * ((hi - lo) / 255.0f)); }
__device__ __forceinline__ float hy_short(const bf16_t* PHYT, const float* cw, const float* cb, int row, int col) {
    bool hp, hn; row_nbrs(row, hp, hn);
    const bf16_t* p = PHYT + (size_t)col * T + row;
    float v = cb[col] + cw[HY_IN + col] * bf2f(p[0]);
    if (hp) v += cw[col] * bf2f(p[-1]);
    if (hn) v += cw[2 * HY_IN + col] * bf2f(p[1]);
    return v;
}
__device__ __forceinline__ void hy_spec_task(const Params& P, int l, int o, int c, float2* X, float* ex) {
    const int tid = otid();
    const float* h2 = (const float*)(P.ws + WS_H2); const float* w3 = P.in[I_HW3] + (size_t)l * 64 * 1024;
    if (tid < 128) { const int dir = tid >> 6, i = tid & 63; ex[tid] = w3[(size_t)i * 1024 + o * 512 + dir * 256 + c]; }
    __syncthreads();
    const float dl = hy_delta(c);
    for (int n = tid; n < SEQ; n += NTHR) { float af = 0.f, ab = 0.f;
#pragma unroll
        for (int i4 = 0; i4 < 16; ++i4) { const float4 hv = *(const float4*)(h2 + (size_t)n * 64 + i4 * 4);
            af += hv.x * ex[i4 * 4] + hv.y * ex[i4 * 4 + 1] + hv.z * ex[i4 * 4 + 2] + hv.w * ex[i4 * 4 + 3];
            ab += hv.x * ex[64 + i4 * 4] + hv.y * ex[64 + i4 * 4 + 1] + hv.z * ex[64 + i4 * 4 + 2] + hv.w * ex[64 + i4 * 4 + 3]; }
        const float dec = __expf(-((float)n / (float)(SEQ - 1)) * dl) * (1.0f / NFFT);
        X[n] = make_float2(af * dec, 0.f);
        if (n > 0) X[NFFT - n] = make_float2(ab * dec, 0.f); else X[SEQ] = make_float2(0.f, 0.f); }
    __syncthreads();
    fft_fwd(X);
    float2* spec = (float2*)(P.ws + WS_SPEC) + (size_t)(o * 256 + c) * NFFT;
    for (int i = tid; i < NFFT; i += NTHR) spec[i] = X[i];
    __syncthreads();
}
__device__ __forceinline__ void hy_conv_core(const Params& P, int o, int c, float2* X) {
    fft_fwd(X);
    const float2* spec = (const float2*)(P.ws + WS_SPEC) + (size_t)(o * 256 + c) * NFFT;
    for (int i = otid(); i < NFFT; i += NTHR) { const float2 a = X[i], k = spec[i]; X[i] = make_float2(a.x * k.x - a.y * k.y, a.x * k.y + a.y * k.x); }
    __syncthreads();
    fft_inv(X);
}
__device__ __forceinline__ void hy_task1(const Params& P, int l, int c, float2* X, float* ex) {
    const int tid = otid();
    const bf16_t* PHY = (const bf16_t*)(P.ws + WS_PHY); const float* cw = P.in[I_HCW] + (size_t)l * 3 * HY_IN; const float* cb = P.in[I_HCB] + (size_t)l * HY_IN;
    const float bias0 = P.in[I_HBIAS][(size_t)l * 2 * HYC + c], bias1 = P.in[I_HBIAS][(size_t)l * 2 * HYC + HYC + c];
    for (int n = tid; n < SEQ; n += NTHR) { X[n] = make_float2(hy_short(PHY, cw, cb, n, c), hy_short(PHY, cw, cb, SEQ + n, c)); X[SEQ + n] = make_float2(0.f, 0.f); }
    __syncthreads();
    hy_conv_core(P, 0, c, X);
    float* Z1 = (float*)(P.ws + WS_Z1) + (size_t)c * NB * SEQ;
    for (int n = tid; n < SEQ; n += NTHR) { const float2 y = X[n];
        const float v0 = hy_short(PHY, cw, cb, n, c), v1 = hy_short(PHY, cw, cb, SEQ + n, c), g0 = hy_short(PHY, cw, cb, n, HYC + c), g1 = hy_short(PHY, cw, cb, SEQ + n, HYC + c);
        Z1[n] = g0 * (y.x + bias0 * v0); Z1[SEQ + n] = g1 * (y.y + bias0 * v1); }
    __syncthreads();
    float* f = (float*)X;
    float* vv = f, *x1 = f + 512, *x2 = f + 1024, *hf = f + 1536  , *z1 = f + 2560;
    const float* h2c = (const float*)(P.ws + WS_H2) + (size_t)SEQ * 64; const float* w3 = P.in[I_HW3] + (size_t)l * 64 * 1024;
    { const int b = tid >> 8, t = tid & 255, row = TL + b * CTX + t;
      vv[tid] = hy_short(PHY, cw, cb, row, c); x1[tid] = hy_short(PHY, cw, cb, row, HYC + c); x2[tid] = hy_short(PHY, cw, cb, row, 2 * HYC + c);
      const float dl = hy_delta(c);
      for (int q = tid; q < 1024; q += NTHR) { const int od = q >> 8, n = q & 255; float a = 0.f;
          for (int i = 0; i < 64; ++i) a += h2c[n * 64 + i] * w3[(size_t)i * 1024 + od * 256 + c];
          hf[q] = a * __expf(-((float)n / (float)(CTX - 1)) * dl); } }
    __syncthreads();
    { const int b = tid >> 8, t = tid & 255; float y = bias0 * vv[tid];
      for (int s = 0; s <= t; ++s) y += hf[t - s] * vv[b * 256 + s];
      for (int s = t + 1; s < CTX; ++s) y += hf[256 + s - t] * vv[b * 256 + s];
      z1[tid] = x1[tid] * y; }
    __syncthreads();
    { const int b = tid >> 8, t = tid & 255; float y = bias1 * z1[tid];
      for (int s = 0; s <= t; ++s) y += hf[512 + t - s] * z1[b * 256 + s];
      for (int s = t + 1; s < CTX; ++s) y += hf[768 + s - t] * z1[b * 256 + s];
      bf16_t* MIX = (bf16_t*)(P.ws + WS_U); MIX[(size_t)(TL + b * CTX + t) * D + c] = f2bf(x2[tid] * y); }
    __syncthreads();
}
__device__ __forceinline__ void hy_task2(const Params& P, int l, int c, float2* X) {
    const int tid = otid();
    const bf16_t* PHY = (const bf16_t*)(P.ws + WS_PHY); const float* cw = P.in[I_HCW] + (size_t)l * 3 * HY_IN; const float* cb = P.in[I_HCB] + (size_t)l * HY_IN;
    const float bias1 = P.in[I_HBIAS][(size_t)l * 2 * HYC + HYC + c];
    const float* Z1 = (const float*)(P.ws + WS_Z1) + (size_t)c * NB * SEQ;
    for (int n = tid; n < SEQ; n += NTHR) { X[n] = make_float2(Z1[n], Z1[SEQ + n]); X[SEQ + n] = make_float2(0.f, 0.f); }
    __syncthreads();
    hy_conv_core(P, 1, c, X);
    bf16_t* MIX = (bf16_t*)(P.ws + WS_U);
    for (int n = tid; n < SEQ; n += NTHR) { const float2 y = X[n];
        const float g0 = hy_short(PHY, cw, cb, n, 2 * HYC + c), g1 = hy_short(PHY, cw, cb, SEQ + n, 2 * HYC + c);
        MIX[(size_t)n * D + c] = f2bf(g0 * (y.x + bias1 * Z1[n])); MIX[(size_t)(SEQ + n) * D + c] = f2bf(g1 * (y.y + bias1 * Z1[SEQ + n])); }
    __syncthreads();
}

constexpr int SEGC = 256, NSEG = 33, SCH = 4;
typedef float f32x2v __attribute__((ext_vector_type(2)));
template <bool IDENT>
__device__ __forceinline__ void scan_seg(const Params& P, int chain, int g, float* ring  ) {
    const int lane = otid() & 63;
    const int d = chain & 1, h = (chain >> 1) % 6, b = chain / 12;
    const float* DEC = (const float*)(P.ws + WS_DECAY) + (size_t)d * T * 384; const bf16_t* KKS = (const bf16_t*)(P.ws + WS_KKS); const bf16_t* RS = (const bf16_t*)(P.ws + WS_RS);
    const bf16_t* VS = (const bf16_t*)(P.ws + WS_VS); const bf16_t* KS = (const bf16_t*)(P.ws + WS_KS) + (size_t)d * T * 384; const bf16_t* BS = (const bf16_t*)(P.ws + WS_BS) + (size_t)d * T * 384;
    float* YD = (float*)(P.ws + WS_YDIR) + (size_t)d * T * 384;
    bf16_t* E = (bf16_t*)(P.ws + WS_E) + (size_t)chain * SEQ * 64;
    const int step0 = g == 0 ? 0 : CTX + (g - 1) * SEGC;
    f32x2v S0[32], S1[32];
#pragma unroll
    for (int j = 0; j < 32; ++j) { S0[j] = (f32x2v){0.f, 0.f}; S1[j] = (f32x2v){(2 * j == lane) ? 1.f : 0.f, (2 * j + 1 == lane) ? 1.f : 0.f}; }
    float pw[SCH], pa[SCH], pb[SCH], pk[SCH], pr[SCH], pv[SCH]; int po[SCH];
#pragma unroll
    for (int s = 0; s < SCH; ++s) { const int o = scan_row(b, d, step0 + s) * 384 + h * 64 + lane; po[s] = o;
        pw[s] = DEC[o]; pa[s] = bf2f(KKS[o]); pb[s] = bf2f(BS[o]); pk[s] = bf2f(KS[o]); pr[s] = bf2f(RS[o]); pv[s] = bf2f(VS[o]); }
    for (int c = 0; c < SEGC / SCH; ++c) {
        float cv[SCH]; int co[SCH];
        asm volatile("s_waitcnt lgkmcnt(0)" ::: "memory");
#pragma unroll
        for (int s = 0; s < SCH; ++s) { float* sv = ring + s * 320; sv[lane] = pw[s]; sv[64 + lane] = pa[s]; sv[128 + lane] = pb[s]; sv[192 + lane] = pk[s]; sv[256 + lane] = pr[s]; cv[s] = pv[s]; co[s] = po[s]; }
        asm volatile("s_waitcnt lgkmcnt(0)" ::: "memory");
        if (c + 1 < SEGC / SCH) {
#pragma unroll
            for (int s = 0; s < SCH; ++s) { const int o = scan_row(b, d, step0 + (c + 1) * SCH + s) * 384 + h * 64 + lane; po[s] = o;
                pw[s] = DEC[o]; pa[s] = bf2f(KKS[o]); pb[s] = bf2f(BS[o]); pk[s] = bf2f(KS[o]); pr[s] = bf2f(RS[o]); pv[s] = bf2f(VS[o]); } }
#pragma unroll
        for (int s = 0; s < SCH; ++s) { const float* sv = ring + s * 320;
            f32x2v sa2 = (f32x2v){0.f, 0.f}, sb2 = (f32x2v){0.f, 0.f}, sa3 = sa2, sb3 = sa2;
#pragma unroll
            for (int hb = 0; hb < 2; ++hb) { float4 A[8];
#pragma unroll
                for (int i = 0; i < 8; ++i) A[i] = *(const float4*)(sv + 64 + hb * 32 + 4 * i);
                __builtin_amdgcn_sched_barrier(0);
#pragma unroll
                for (int i = 0; i < 8; ++i) { const int jj = hb * 16 + 2 * i; const f32x2v alo = (f32x2v){A[i].x, A[i].y}, ahi = (f32x2v){A[i].z, A[i].w};
                    sa2 += S0[jj] * alo; sa3 += S0[jj + 1] * ahi;
                    if (IDENT) { sb2 += S1[jj] * alo; sb3 += S1[jj + 1] * ahi; } }
                __builtin_amdgcn_sched_barrier(0); }
            const float sa = (sa2.x + sa2.y) + (sa3.x + sa3.y), sb = (sb2.x + sb2.y) + (sb3.x + sb3.y);
            const f32x2v saa = (f32x2v){sa, sa}, sbb = (f32x2v){sb, sb}, vv = (f32x2v){cv[s], cv[s]};
            f32x2v y2 = (f32x2v){0.f, 0.f}, y3 = y2, e2 = y2, e3 = y2;
#pragma unroll
            for (int ch = 0; ch < 8; ++ch) { float4 W[2], Bq[2], K[2], R[2];
#pragma unroll
                for (int i = 0; i < 2; ++i) { const int j = ch * 8 + 4 * i; W[i] = *(const float4*)(sv + j); Bq[i] = *(const float4*)(sv + 128 + j); K[i] = *(const float4*)(sv + 192 + j); R[i] = *(const float4*)(sv + 256 + j); }
                __builtin_amdgcn_sched_barrier(0);
#pragma unroll
                for (int i = 0; i < 2; ++i) { const int jj = ch * 4 + 2 * i;
                    const f32x2v wlo = (f32x2v){W[i].x, W[i].y}, whi = (f32x2v){W[i].z, W[i].w}, blo = (f32x2v){Bq[i].x, Bq[i].y}, bhi = (f32x2v){Bq[i].z, Bq[i].w};
                    const f32x2v klo = (f32x2v){K[i].x, K[i].y}, khi = (f32x2v){K[i].z, K[i].w}, rlo = (f32x2v){R[i].x, R[i].y}, rhi = (f32x2v){R[i].z, R[i].w};
                    S0[jj] = S0[jj] * wlo + saa * blo + vv * klo; y2 += S0[jj] * rlo;
                    S0[jj + 1] = S0[jj + 1] * whi + saa * bhi + vv * khi; y3 += S0[jj + 1] * rhi;
                    if (IDENT) { S1[jj] = S1[jj] * wlo + sbb * blo; e2 += S1[jj] * rlo; S1[jj + 1] = S1[jj + 1] * whi + sbb * bhi; e3 += S1[jj + 1] * rhi; } }
                __builtin_amdgcn_sched_barrier(0); }
            YD[co[s]] = (y2.x + y2.y) + (y3.x + y3.y);
            if (IDENT) { const int tl = d ? (SEQ - 1 - (step0 - CTX + c * SCH + s)) : (step0 - CTX + c * SCH + s); E[(size_t)tl * 64 + lane] = f2bf((e2.x + e2.y) + (e3.x + e3.y)); }
        }
    }
    float* ZP = (float*)(P.ws + WS_ZP) + ((size_t)chain * NSEG + g) * 2 * 4096;
#pragma unroll
    for (int j = 0; j < 32; j += 2) { *(float4*)(ZP + lane * 64 + 2 * j) = make_float4(S0[j].x, S0[j].y, S0[j + 1].x, S0[j + 1].y);
        if (IDENT) *(float4*)(ZP + 4096 + lane * 64 + 2 * j) = make_float4(S1[j].x, S1[j].y, S1[j + 1].x, S1[j + 1].y); }
}
__device__ __forceinline__ void scan_combine(const Params& P, int chain, float* lds) {
    const int tid = otid(); const int i = tid >> 3, j0 = (tid & 7) * 8;
    float* Sl = lds;
    float* Pl = lds + 64 * 65;
    float* ZPc = (float*)(P.ws + WS_ZP) + (size_t)chain * NSEG * 2 * 4096;
    float sn[8];
#pragma unroll
    for (int q = 0; q < 8; ++q) sn[q] = ZPc[i * 64 + j0 + q];
    for (int g = 1; g < NSEG - 1; ++g) {
        __syncthreads();
#pragma unroll
        for (int q = 0; q < 8; ++q) Sl[i * 65 + j0 + q] = sn[q];
        const float* Pg = ZPc + (size_t)g * 2 * 4096 + 4096;
#pragma unroll
        for (int q = 0; q < 8; ++q) Pl[tid * 8 + q] = Pg[tid * 8 + q];
        float* Zg = ZPc + (size_t)g * 2 * 4096;
#pragma unroll
        for (int q = 0; q < 8; ++q) sn[q] = Zg[i * 64 + j0 + q];
        __syncthreads();
        for (int m = 0; m < 64; ++m) { const float sv = Sl[i * 65 + m]; const float4 p0 = *(const float4*)(Pl + m * 64 + j0), p1 = *(const float4*)(Pl + m * 64 + j0 + 4);
            sn[0] += sv * p0.x; sn[1] += sv * p0.y; sn[2] += sv * p0.z; sn[3] += sv * p0.w; sn[4] += sv * p1.x; sn[5] += sv * p1.y; sn[6] += sv * p1.z; sn[7] += sv * p1.w; }
#pragma unroll
        for (int q = 0; q < 8; ++q) Zg[i * 64 + j0 + q] = sn[q];
    }
    __syncthreads();
}

__device__ __forceinline__ void rwkv_out_fin(const Params& P, int row, int c, float y, float lnw, float lnb, float bon, float vs, float gt) {
    bf16_t* MIX = (bf16_t*)(P.ws + WS_U);
    const float mean = wsum(y) * (1.0f / 64.0f); const float dv = y - mean; const float var = wsum(dv * dv) * (1.0f / 64.0f);
    const float yn = dv * rsqrtf(var + 64e-5f) * lnw + lnb;
    MIX[(size_t)row * D + 256 + c] = f2bf((yn + bon * vs) * gt);
}
constexpr int OCH = 4;
__device__ __forceinline__ void ph_rwkvout(const Params& P, int l, float* ldsf) {
    const int tid = otid(), lane = tid & 63, wv = tid >> 6, gw = blockIdx.x * NWAVE + wv, nw = gridDim.x * NWAVE;
    const float* YD = (const float*)(P.ws + WS_YDIR); const bf16_t* VS = (const bf16_t*)(P.ws + WS_VS); const bf16_t* GT = (const bf16_t*)(P.ws + WS_GATE); const float* BON = (const float*)(P.ws + WS_BONUS);
    float* est = ldsf + wv * (OCH * 128);
    for (int it = gw; it < NB * 6 * 32 * 4; it += nw) {
        const int sub = it & 3, q = (it >> 2) & 31, h = (it >> 7) % 6, b = it / (128 * 6);
        const int chf = b * 12 + h * 2, chb = chf + 1, c = h * 64 + lane;
        const float lnw = P.in[I_LNW][l * RWW + c], lnb = P.in[I_LNB][l * RWW + c];
        const float* Sfp = (const float*)(P.ws + WS_ZP) + ((size_t)chf * NSEG + q) * 2 * 4096 + lane * 64;
        const float* Sbp = (const float*)(P.ws + WS_ZP) + ((size_t)chb * NSEG + (31 - q)) * 2 * 4096 + lane * 64;
        float Sf[64], Sb[64];
#pragma unroll
        for (int j = 0; j < 64; j += 4) { const float4 a = *(const float4*)(Sfp + j), c4 = *(const float4*)(Sbp + j);
            Sf[j] = a.x; Sf[j + 1] = a.y; Sf[j + 2] = a.z; Sf[j + 3] = a.w; Sb[j] = c4.x; Sb[j + 1] = c4.y; Sb[j + 2] = c4.z; Sb[j + 3] = c4.w; }
        const bf16_t* Ef = (const bf16_t*)(P.ws + WS_E) + (size_t)chf * SEQ * 64; const bf16_t* Eb = (const bf16_t*)(P.ws + WS_E) + (size_t)chb * SEQ * 64;
        const int t0 = q * 256 + sub * 64;
        float nyd[OCH], nbon[OCH], nvs[OCH], ngt[OCH], nef[OCH], neb[OCH];
#pragma unroll
        for (int s = 0; s < OCH; ++s) { const int t = t0 + s, row = b * SEQ + t; const size_t o = (size_t)row * 384 + c;
            nef[s] = bf2f(Ef[(size_t)t * 64 + lane]); neb[s] = bf2f(Eb[(size_t)t * 64 + lane]); nyd[s] = YD[o] + YD[(size_t)T * 384 + o]; nbon[s] = BON[(size_t)row * 6 + h]; nvs[s] = bf2f(VS[o]); ngt[s] = bf2f(GT[o]); }
        for (int tg = 0; tg < 64; tg += OCH) {
            float yd[OCH], bon[OCH], vs[OCH], gt[OCH];
            asm volatile("s_waitcnt lgkmcnt(0)" ::: "memory");
#pragma unroll
            for (int s = 0; s < OCH; ++s) { est[s * 128 + lane] = nef[s]; est[s * 128 + 64 + lane] = neb[s]; yd[s] = nyd[s]; bon[s] = nbon[s]; vs[s] = nvs[s]; gt[s] = ngt[s]; }
            asm volatile("s_waitcnt lgkmcnt(0)" ::: "memory");
            if (tg + OCH < 64) {
#pragma unroll
                for (int s = 0; s < OCH; ++s) { const int t = t0 + tg + OCH + s, row = b * SEQ + t; const size_t o = (size_t)row * 384 + c;
                    nef[s] = bf2f(Ef[(size_t)t * 64 + lane]); neb[s] = bf2f(Eb[(size_t)t * 64 + lane]); nyd[s] = YD[o] + YD[(size_t)T * 384 + o]; nbon[s] = BON[(size_t)row * 6 + h]; nvs[s] = bf2f(VS[o]); ngt[s] = bf2f(GT[o]); } }
#pragma unroll
            for (int s = 0; s < OCH; ++s) { const int row = b * SEQ + t0 + tg + s;
                float c0 = 0.f, c1 = 0.f, c2 = 0.f, c3 = 0.f;
#pragma unroll
                for (int j = 0; j < 64; j += 4) { const float4 ef = *(const float4*)(est + s * 128 + j), eb = *(const float4*)(est + s * 128 + 64 + j);
                    c0 += Sf[j] * ef.x + Sb[j] * eb.x; c1 += Sf[j + 1] * ef.y + Sb[j + 1] * eb.y; c2 += Sf[j + 2] * ef.z + Sb[j + 2] * eb.z; c3 += Sf[j + 3] * ef.w + Sb[j + 3] * eb.w;
                    if ((j & 15) == 12) asm volatile("" ::: "memory"); }
                rwkv_out_fin(P, row, c, yd[s] + ((c0 + c1) + (c2 + c3)), lnw, lnb, bon[s], vs[s], gt[s]); }
        }
    }
    for (int it = gw; it < TC * 6; it += nw) { const int row = TL + it / 6, h = it % 6, c = h * 64 + lane; const size_t o = (size_t)row * 384 + c;
        rwkv_out_fin(P, row, c, YD[o] + YD[(size_t)T * 384 + o], P.in[I_LNW][l * RWW + c], P.in[I_LNB][l * RWW + c], BON[(size_t)row * 6 + h], bf2f(VS[o]), bf2f(GT[o])); }
}

typedef const __attribute__((address_space(4))) Params* KParamsPtr;
__device__ __forceinline__ const Params* fresh_params() { KParamsPtr q = (KParamsPtr)__builtin_amdgcn_kernarg_segment_ptr(); asm volatile("" : "+s"(q)); return (const Params*)q; }
__global__ void __launch_bounds__(NTHR, 2) fwd_megakernel(Params P_unused, int ph_lo, int ph_hi) {
    extern __shared__ __attribute__((aligned(16))) unsigned char smem[];
    cg::grid_group grid = cg::this_grid();
    LAS unsigned char* lds3 = (LAS unsigned char*)smem;
    float* ldsf = (float*)smem; float2* X = (float2*)smem; float* ex = (float*)(smem + LDS_MAIN);
    { volatile LAS unsigned* st = (volatile LAS unsigned*)(lds3 + LDS_MAIN + 4096); if (threadIdx.x == 0) { st[0] = 0u; st[1] = 0u; } }
    __syncthreads();
    XcdBarrier xbar = xcd_barrier_post((unsigned*)(((const Params*)fresh_params())->ws + WS_BAR), (volatile LAS unsigned*)(lds3 + LDS_MAIN + 4096));
    int ph = 0;
#ifndef REP_GEMM
#define REP_GEMM 1
#endif
#ifndef REP_SCAN
#define REP_SCAN 1
#endif
#ifndef REP_MISC
#define REP_MISC 1
#endif
#ifndef REP_HY
#define REP_HY 1
#endif
#define PHASE_BEGIN if (ph >= ph_lo && ph < ph_hi) { const Params& P = *fresh_params(); unsigned char* ws = P.ws; (void)ws;
#ifndef REP_SYNC
#define REP_SYNC 1
#endif
#define PHASE_END   if (ph + 1 < ph_hi) { for (int rs_ = 0; rs_ < REP_SYNC; ++rs_) { if (ph == 0) grid.sync(); else xcd_barrier(xbar); } } } ++ph;
    PHASE_BEGIN ph_modv(P, ldsf); PHASE_END
    for (int l = 0; l < DEPTH; ++l) {
        PHASE_BEGIN
            for (int rep_ = 0; rep_ < REP_MISC; ++rep_) ph_prep(P, l, ldsf);
            if (l == 0) ph_rowpass(P, 0, 0, 0, 0, 0.f, 0, 0, 0, 1);
            else ph_rowpass(P, 1, l - 1, 8, 5, 0.5f, l, 0, 0, 1);
        PHASE_END
        PHASE_BEGIN { EpiGU E{(bf16_t*)(ws + WS_ACT)}; for (int rep_ = 0; rep_ < REP_GEMM; ++rep_) run_gemm(lds3, (const bf16_t*)(ws + WS_U), (const bf16_t*)(ws + WS_WGU1), T, 2 * DFF, D, E); } PHASE_END
        PHASE_BEGIN { EpiF32 E{(float*)(ws + WS_Y)}; for (int rep_ = 0; rep_ < REP_GEMM; ++rep_) run_gemm(lds3, (const bf16_t*)(ws + WS_ACT), (const bf16_t*)(ws + WS_WDN1), T, D, DFF, E); } PHASE_END
        PHASE_BEGIN ph_rowpass(P, 1, l, 2, 1, 0.5f, l, 2, 3, 4); PHASE_END
        PHASE_BEGIN { EpiWin E{(bf16_t*)(ws + WS_PHY), (bf16_t*)(ws + WS_PRW), (bf16_t*)(ws + WS_PNA)}; for (int rep_ = 0; rep_ < REP_GEMM; ++rep_) run_gemm(lds3, (const bf16_t*)(ws + WS_U), (const bf16_t*)(ws + WS_WIN), T, INWP, D, E); } PHASE_END
        PHASE_BEGIN
            for (int rep_ = 0; rep_ < REP_MISC; ++rep_) { ph_loraprep(P, l);
            for (int it = blockIdx.x; it < NB * 128 * 6 + NB * 4 * 6; it += gridDim.x) vt_tile(P, it, (unsigned short*)smem); }
            for (int rep_ = 0; rep_ < REP_HY; ++rep_) for (int it = blockIdx.x; it < 512; it += gridDim.x) hy_spec_task(P, l, it >> 8, it & 255, X, ex);
        PHASE_END
        PHASE_BEGIN { EpiLora E{(bf16_t*)(ws + WS_LORAO), (bf16_t*)(ws + WS_GATE)};
            for (int rep_ = 0; rep_ < REP_GEMM; ++rep_) run_gemm(lds3, (const bf16_t*)(ws + WS_ALORA), (const bf16_t*)(ws + WS_WLORA), T, 2048, 384, E); } PHASE_END
        PHASE_BEGIN
            for (int rep_ = 0; rep_ < REP_MISC; ++rep_) ph_rwkvprep(P, l);
            for (int rep_ = 0; rep_ < REP_HY; ++rep_) for (int c = blockIdx.x; c < HYC; c += gridDim.x) hy_task1(P, l, c, X, ex);
        PHASE_END
        PHASE_BEGIN {
            const int wv = __builtin_amdgcn_readfirstlane(otid() >> 6);
            if (wv < 4) { const int k = wv * (int)gridDim.x + (int)blockIdx.x;
                if (k < 24 * NSEG) { const int chain = k / NSEG, g = k % NSEG; float* ring = ldsf + wv * (SCH * 320);
                    for (int rep_ = 0; rep_ < REP_SCAN; ++rep_) { if (g == 0) scan_seg<false>(P, chain, g, ring); else scan_seg<true>(P, chain, g, ring); } } }
            else for (int it = (wv - 4) * (int)gridDim.x + (int)blockIdx.x; it < NAT_TASKS; it += 4 * (int)gridDim.x) natten_task(P, l, it);
        } PHASE_END
        PHASE_BEGIN
            if (blockIdx.x < 24) scan_combine(P, blockIdx.x, ldsf);
            else for (int rep_ = 0; rep_ < REP_HY; ++rep_) for (int c = blockIdx.x - 24; c < HYC; c += gridDim.x - 24) hy_task2(P, l, c, X);
        PHASE_END
        PHASE_BEGIN for (int rep_ = 0; rep_ < REP_MISC; ++rep_) ph_rwkvout(P, l, ldsf); PHASE_END
        PHASE_BEGIN { EpiF32 E{(float*)(ws + WS_Y)}; for (int rep_ = 0; rep_ < REP_GEMM; ++rep_) run_gemm(lds3, (const bf16_t*)(ws + WS_U), (const bf16_t*)(ws + WS_WOUT), T, D, D, E); } PHASE_END
        PHASE_BEGIN ph_rowpass(P, 1, l, 5, 3, 1.0f, l, 4, 6, 7); PHASE_END
        PHASE_BEGIN { EpiGU E{(bf16_t*)(ws + WS_ACT)}; for (int rep_ = 0; rep_ < REP_GEMM; ++rep_) run_gemm(lds3, (const bf16_t*)(ws + WS_U), (const bf16_t*)(ws + WS_WGU2), T, 2 * DFF, D, E); } PHASE_END
        PHASE_BEGIN { EpiF32 E{(float*)(ws + WS_Y)}; for (int rep_ = 0; rep_ < REP_GEMM; ++rep_) run_gemm(lds3, (const bf16_t*)(ws + WS_ACT), (const bf16_t*)(ws + WS_WDN2), T, D, DFF, E); } PHASE_END
    }
    PHASE_BEGIN ph_rowpass(P, 2, DEPTH - 1, 8, 5, 0.5f, 0, 0, 0, 0); PHASE_END
#undef PHASE_BEGIN
#undef PHASE_END
}
constexpr int N_PHASES = 1 + DEPTH * 15 + 1;

extern "C" void kernel_launch(void* const* d_in, const int* in_sizes, int n_in, void* d_out, int out_size, void* d_ws, size_t ws_size, hipStream_t stream) {
    static int grid = 0;
    if (grid == 0) {
        if (n_in != 34 || ws_size < WS_END) { fprintf(stderr, "kernel_launch: need 34 inputs and %zu bytes of workspace; got %d, %zu\n", (size_t)WS_END, n_in, ws_size); grid = -1; return; }
        int dev = 0, cus = 0, per_cu = 0;
        hipGetDevice(&dev); hipDeviceGetAttribute(&cus, hipDeviceAttributeMultiprocessorCount, dev);
        if (hipFuncSetAttribute((const void*)fwd_megakernel, hipFuncAttributeMaxDynamicSharedMemorySize, LDS_BYTES) != hipSuccess) { fprintf(stderr, "kernel_launch: hipFuncSetAttribute failed\n"); grid = -1; return; }
        if (hipOccupancyMaxActiveBlocksPerMultiprocessor(&per_cu, (const void*)fwd_megakernel, NTHR, LDS_BYTES) != hipSuccess || per_cu < 1) { fprintf(stderr, "kernel_launch: occupancy query says %d\n", per_cu); per_cu = 1; }
        (void)hipGetLastError();
        grid = cus;
    }
    if (grid < 0) return;
    if (hipMemsetAsync((char*)d_ws + WS_BAR, 0, (size_t)XCD_BAR_WORDS * 4, stream) != hipSuccess) { fprintf(stderr, "kernel_launch: memset of the barrier words failed\n"); return; }
    Params p{};
    for (int i = 0; i < 34; ++i) p.in[i] = (const float*)d_in[i];
    p.out = (float*)d_out; p.ws = (unsigned char*)d_ws;
#if MK_SPLIT
    for (int ph = 0; ph < N_PHASES; ++ph) { int lo = ph, hi = ph + 1; hipLaunchKernelGGL(fwd_megakernel, dim3(grid), dim3(NTHR), LDS_BYTES, stream, p, lo, hi); }
#else
    int lo = 0, hi = N_PHASES;
    void* args[] = {&p, &lo, &hi};
    hipError_t e = hipLaunchCooperativeKernel((const void*)fwd_megakernel, dim3(grid), dim3(NTHR), args, LDS_BYTES, stream);
    if (e != hipSuccess) fprintf(stderr, "cooperative launch failed: %s (grid %d)\n", hipGetErrorString(e), grid);
#endif
}
```

```cpp
#include <hip/hip_runtime.h>
#include <hip/hip_cooperative_groups.h>
#include <cstdio>
namespace cg = cooperative_groups;
__device__ __forceinline__ int otid() { int t = threadIdx.x; asm volatile("" : "+v"(t)); return t; }
namespace pg8 {
#define PG8_LAS __attribute__((address_space(3)))
typedef unsigned short bf16_t;
typedef short bf16x8 __attribute__((ext_vector_type(8)));
typedef float f32x4 __attribute__((ext_vector_type(4)));
typedef unsigned u32x4 __attribute__((ext_vector_type(4)));
constexpr int BM = 256, BK = 64, HALF = 128, HTB = HALF * BK * 2  , STAGE_BYTES = 8 * HTB, NXCD = 8, WGM = 8;

__host__ __device__ __forceinline__ int lds_byte(int r, int c) { const int st = (r >> 4) * 2 + (c >> 5), rr = r & 15, cc = c & 31, ob = rr * 64 + cc * 2; return st * 1024 + (ob ^ (((ob >> 9) & 1) << 5)); }
__host__ __device__ __forceinline__ void stage_rc(int b, int& R, int& C) { const int st = b / 1024, sb = b % 1024, swz = sb ^ (((sb >> 9) & 1) << 5); R = (st >> 1) * 16 + swz / 64; C = (st & 1) * 32 + (swz % 64) / 2; }
__host__ __device__ __forceinline__ int perm32(int rho) { const int n = rho >> 4, i = rho & 15; return 8 * (i >> 2) + 4 * n + (i & 3); }

struct Unit { int pm, pn; };
struct Gemm { const bf16_t* A; const bf16_t* Bt; int M, N, K; };
struct StaticOrder {
    int nM, nN, nwg, G, c;
    __host__ __device__ void init(int M, int N, int G_, int c_) { nM = M / BM; nN = N / BM; nwg = nM * nN; G = G_; c = c_; }
    __host__ __device__ bool next(int i, Unit& u) const {
        const long L = (long)i * G + c; if (L >= nwg) return false;
        int wgid = (int)L; { const int q = nwg / NXCD, r = nwg % NXCD, xcd = wgid % NXCD, off = wgid / NXCD; wgid = (xcd < r ? xcd * (q + 1) : r * (q + 1) + (xcd - r) * q) + off; }
        const int nig = WGM * nN, gid = wgid / nig, fm = gid * WGM, gsz = (nM - fm) < WGM ? (nM - fm) : WGM;
        u.pm = fm + ((wgid % nig) % gsz); u.pn = (wgid % nig) / gsz; return true;
    }
    __device__ __forceinline__ void a_ready(const Unit&) const {}
    __device__ __forceinline__ void done(const Unit&) const {}
};
__device__ __forceinline__ unsigned cvt_pk_bf16(float lo, float hi) { unsigned r; asm volatile("v_cvt_pk_bf16_f32 %0, %1, %2" : "=v"(r) : "v"(lo), "v"(hi)); return r; }
template <class Epi, class Sched>
__device__ __forceinline__ void gemm_phase(PG8_LAS unsigned char* lds, const Gemm g, const Sched& S, const Epi& E) {
    const int tid = otid(), wid = __builtin_amdgcn_readfirstlane(tid >> 6), lane = tid & 63, wr = wid >> 2, wc = wid & 3, fr = lane & 15, fq = lane >> 4;
    const int K = g.K, nt = K / BK;
#define PG8_STAMP() do {} while (0)
    unsigned voffA[2], voffB[2];
#pragma unroll
    for (int i = 0; i < 2; ++i) { int R, C; stage_rc(tid * 16 + i * 8192, R, C); const int Rb = Epi::PERM ? ((R & ~31) + perm32(R & 31)) : R;
        voffA[i] = (unsigned)(R * K + C) * 2u; voffB[i] = (unsigned)(Rb * K + C) * 2u; }
    const size_t kstep = (size_t)(BK * 2);
    const size_t hstep = (size_t)HALF * K * 2;
    const size_t tstep = 2 * hstep;
    const unsigned ldsw = (unsigned)wid * 1024u;
    const int aoff = lds_byte(wr * 64 + fr, fq * 8), boff = lds_byte(wc * 32 + fr, fq * 8);
#define PG8_SA(b, h) (((b) * 2 + (h)) * HTB)
#define PG8_SB(b, h) ((4 + (b) * 2 + (h)) * HTB)
#define PG8_STAGE(bufoff, gbase, voff) do { _Pragma("unroll") for (int _i = 0; _i < 2; ++_i) \
        __builtin_amdgcn_global_load_lds((const unsigned*)((const char*)(gbase) + (voff)[_i]), (PG8_LAS unsigned*)(lds + (bufoff) + ldsw + _i * 8192), 16, 0, 0); } while (0)
#define PG8_LDA(dst, b, h) do { _Pragma("unroll") for (int m = 0; m < 4; ++m) _Pragma("unroll") for (int k = 0; k < 2; ++k) dst[m][k] = *(const PG8_LAS bf16x8*)(lds + PG8_SA(b, h) + aoff + m * 2048 + k * 1024); } while (0)
#define PG8_LDB(dst, b, h) do { _Pragma("unroll") for (int n = 0; n < 2; ++n) _Pragma("unroll") for (int k = 0; k < 2; ++k) dst[n][k] = *(const PG8_LAS bf16x8*)(lds + PG8_SB(b, h) + boff + n * 2048 + k * 1024); } while (0)
#define PG8_MMA(ai, bj, At, Bt) do { __builtin_amdgcn_s_setprio(1); _Pragma("unroll") for (int m = 0; m < 4; ++m) _Pragma("unroll") for (int n = 0; n < 2; ++n) _Pragma("unroll") for (int k = 0; k < 2; ++k) \
        acc[ai][bj][m][n] = __builtin_amdgcn_mfma_f32_16x16x32_bf16(Bt[n][k], At[m][k], acc[ai][bj][m][n], 0, 0, 0); __builtin_amdgcn_s_setprio(0); } while (0)
#define PG8_WAIT_V(n) asm volatile("s_waitcnt vmcnt(" #n ")" ::: "memory")
#define PG8_WAIT_L(n) asm volatile("s_waitcnt lgkmcnt(" #n ")" ::: "memory")
#define PG8_BAR __builtin_amdgcn_s_barrier()
#define PG8_SCHED __builtin_amdgcn_sched_barrier(0)
    Unit cur, nxt; int ui = 0;
    if (!S.next(0, cur)) return;
    f32x4 acc[2][2][4][2];
#pragma unroll
    for (int a = 0; a < 2; ++a)
#pragma unroll
        for (int b = 0; b < 2; ++b)
#pragma unroll
            for (int m = 0; m < 4; ++m)
#pragma unroll
                for (int n = 0; n < 2; ++n) acc[a][b][m][n] = (f32x4){0.f, 0.f, 0.f, 0.f};
    bf16x8 At[4][2], B0[2][2], B1[2][2];
    const char* cA = (const char*)g.A + (size_t)cur.pm * tstep; const char* cB = (const char*)g.Bt + (size_t)cur.pn * tstep;
    S.a_ready(cur);
    PG8_STAGE(PG8_SB(0, 0), cB, voffB); PG8_STAGE(PG8_SA(0, 0), cA, voffA); PG8_STAGE(PG8_SB(0, 1), cB + hstep, voffB); PG8_STAGE(PG8_SA(0, 1), cA + hstep, voffA);
    if (wr == 1) PG8_BAR;
    PG8_WAIT_V(4); PG8_BAR;
    PG8_STAGE(PG8_SB(1, 0), cB + kstep, voffB); PG8_STAGE(PG8_SA(1, 0), cA + kstep, voffA); PG8_STAGE(PG8_SB(1, 1), cB + hstep + kstep, voffB);
    PG8_WAIT_V(6); PG8_BAR;
    PG8_STAMP();
    for (;;) {
        const bool has_next = S.next(ui + 1, nxt);
        const char* nA = has_next ? (const char*)g.A + (size_t)nxt.pm * tstep : cA; const char* nB = has_next ? (const char*)g.Bt + (size_t)nxt.pn * tstep : cB;
        for (int t = 0; t < nt; t += 2) {
            const bool last = (t == nt - 2);
            const char* a1 = cA + (size_t)(t + 1) * kstep;
            const char* a2 = last ? nA : cA + (size_t)(t + 2) * kstep; const char* b2 = last ? nB : cB + (size_t)(t + 2) * kstep;
            const char* a3 = a2 + kstep; const char* b3 = b2 + kstep;
            if (last && has_next) S.a_ready(nxt);
            PG8_LDB(B0, 0, 0); PG8_SCHED; PG8_LDA(At, 0, 0); PG8_STAGE(PG8_SA(1, 1), a1 + hstep, voffA);
            PG8_WAIT_L(8); PG8_BAR; PG8_WAIT_L(0); PG8_MMA(0, 0, At, B0); PG8_BAR; PG8_SCHED;
            PG8_LDB(B1, 0, 1); PG8_STAGE(PG8_SB(0, 0), b2, voffB);
            PG8_BAR; PG8_WAIT_L(0); PG8_MMA(0, 1, At, B1); PG8_BAR;
            PG8_LDA(At, 0, 1); PG8_STAGE(PG8_SA(0, 0), a2, voffA);
            PG8_BAR; PG8_WAIT_L(0); PG8_MMA(1, 0, At, B0); PG8_BAR; PG8_SCHED;
            PG8_STAGE(PG8_SB(0, 1), b2 + hstep, voffB);
            PG8_WAIT_V(6); PG8_BAR; PG8_MMA(1, 1, At, B1); PG8_BAR;
            PG8_LDB(B0, 1, 0); PG8_SCHED; PG8_LDA(At, 1, 0); PG8_STAGE(PG8_SA(0, 1), a2 + hstep, voffA);
            PG8_WAIT_L(8); PG8_BAR; PG8_WAIT_L(0); PG8_MMA(0, 0, At, B0); PG8_BAR; PG8_SCHED;
            PG8_LDB(B1, 1, 1); PG8_STAGE(PG8_SB(1, 0), b3, voffB);
            PG8_BAR; PG8_WAIT_L(0); PG8_MMA(0, 1, At, B1); PG8_BAR;
            PG8_LDA(At, 1, 1); PG8_STAGE(PG8_SA(1, 0), a3, voffA);
            PG8_BAR; PG8_WAIT_L(0); PG8_MMA(1, 0, At, B0); PG8_BAR; PG8_SCHED;
            PG8_STAGE(PG8_SB(1, 1), b3 + hstep, voffB);
            PG8_WAIT_V(6); PG8_BAR; PG8_MMA(1, 1, At, B1); PG8_BAR;
        }
        PG8_STAMP();
        if constexpr (!Epi::AFTER_DRAIN) { E(acc, cur, wr, wc, fr, fq); S.done(cur); }
        PG8_STAMP();
        if (!has_next) break;
#pragma unroll
        for (int a = 0; a < 2; ++a)
#pragma unroll
            for (int b = 0; b < 2; ++b)
#pragma unroll
                for (int m = 0; m < 4; ++m)
#pragma unroll
                    for (int n = 0; n < 2; ++n) acc[a][b][m][n] = (f32x4){0.f, 0.f, 0.f, 0.f};
        cur = nxt; cA = nA; cB = nB; ++ui;
    }
    PG8_WAIT_V(0);
    if (wr == 0) PG8_BAR;
    PG8_BAR;
    if constexpr (Epi::AFTER_DRAIN) { E.fused(acc, cur, wr, wc, fr, fq, lds, wid, lane); S.done(cur); }
    PG8_STAMP();
#undef PG8_STAMP
#undef PG8_SA
#undef PG8_SB
#undef PG8_STAGE
#undef PG8_LDA
#undef PG8_LDB
#undef PG8_MMA
#undef PG8_WAIT_V
#undef PG8_WAIT_L
#undef PG8_BAR
#undef PG8_SCHED
}
}
#define LAS __attribute__((address_space(3)))
#define XB_TMO      128
#define XB_XCNT(j)  (256  + 64 * (j))
#define XB_XSUB(j)  (1280 + 64 * (j))
#define XB_XGEN(j)  (2304 + 64 * (j))
#define XB_TOP      3328
#define XB_TOPGEN   3392
#define XCD_BAR_WORDS 3456
#define XB_SPIN_CAP (1u << 18)

__device__ __forceinline__ unsigned xb_ld(unsigned* p)              { return __hip_atomic_load(p, __ATOMIC_RELAXED, __HIP_MEMORY_SCOPE_AGENT); }
__device__ __forceinline__ unsigned xb_add(unsigned* p, unsigned v) { return __hip_atomic_fetch_add(p, v, __ATOMIC_RELAXED, __HIP_MEMORY_SCOPE_AGENT); }
__device__ __forceinline__ unsigned xb_xcc_id() { return (unsigned)__builtin_amdgcn_s_getreg((3 << 11) | 20) & 0xFu; }
#define XB_SPIN(cond, bar) do { unsigned _sp = 0; while (cond) { __builtin_amdgcn_s_sleep(1); \
    if ((++_sp & 255u) == 0u) { if (xb_ld(&(bar)[XB_TMO])) break; if (_sp > XB_SPIN_CAP) { atomicAdd(&(bar)[XB_TMO], 1u); break; } } } } while (0)

struct XcdBarrier {
    unsigned* bar; unsigned x;
    volatile LAS unsigned* st;
};

__device__ __forceinline__ XcdBarrier xcd_barrier_post(unsigned* bar, volatile LAS unsigned* st) {
    XcdBarrier b; b.bar = bar; b.x = xb_xcc_id(); b.st = st;
    if (threadIdx.x == 0) (void)xb_add(&bar[XB_XCNT(b.x)], 1u);
    return b;
}
__device__ __forceinline__ void xcd_barrier_complete(unsigned* bar, unsigned x, unsigned& nloc, unsigned& nx) {
    const unsigned G = gridDim.x * gridDim.y * gridDim.z;
    unsigned sum, cnt, mine, sp = 0u;
    for (;;) {
        sum = 0u; cnt = 0u; mine = 0u;
#pragma unroll
        for (unsigned j = 0; j < 16; ++j) { const unsigned c = xb_ld(&bar[XB_XCNT(j)]); sum += c; cnt += (c > 0u) ? 1u : 0u; mine = (j == x) ? c : mine; }
        if (sum == G) break;
        __builtin_amdgcn_s_sleep(1);
        if ((++sp & 255u) == 0u) { if (xb_ld(&bar[XB_TMO])) break; if (sp > XB_SPIN_CAP) { atomicAdd(&bar[XB_TMO], 1u); break; } }
    }
    nloc = mine > 0u ? mine : 1u; nx = cnt > 0u ? cnt : 1u;
}

__device__ __forceinline__ void xcd_barrier(const XcdBarrier& b) {
    asm volatile("s_waitcnt vmcnt(0)" ::: "memory");
    __syncthreads();
    if (threadIdx.x == 0) {
        unsigned* bar = b.bar;
        __builtin_amdgcn_s_waitcnt(0);
        unsigned nloc = b.st[0], nx = b.st[1];
        if (nloc == 0u) { xcd_barrier_complete(bar, b.x, nloc, nx); b.st[0] = nloc; b.st[1] = nx; }
        const unsigned old = xb_add(&bar[XB_XSUB(b.x)], 1u);
        const unsigned gen = old / nloc;
        if (old + 1u == (gen + 1u) * nloc) {
            __builtin_amdgcn_fence(__ATOMIC_RELEASE, "agent");
            asm volatile("s_waitcnt vmcnt(0)" ::: "memory");
            const unsigned og = xb_add(&bar[XB_TOP], 1u);
            const unsigned tg = og / nx;
            if (og + 1u == (tg + 1u) * nx) xb_add(&bar[XB_TOPGEN], 1u);
            else XB_SPIN(xb_ld(&bar[XB_TOPGEN]) == tg, bar);
            __builtin_amdgcn_fence(__ATOMIC_ACQUIRE, "agent");
            xb_add(&bar[XB_XGEN(b.x)], 1u);
            asm volatile("s_waitcnt vmcnt(0)" ::: "memory");
        } else {
            XB_SPIN(xb_ld(&bar[XB_XGEN(b.x)]) == gen, bar);
            __builtin_amdgcn_fence(__ATOMIC_ACQUIRE, "agent");
            asm volatile("s_waitcnt vmcnt(0)" ::: "memory");
        }
    }
    __syncthreads();
}

using pg8::bf16_t; using pg8::f32x4; using pg8::u32x4; using pg8::cvt_pk_bf16;
typedef unsigned u32x2 __attribute__((ext_vector_type(2)));


constexpr int D = 1024, NB = 2, SEQ = 8192, DEPTH = 4, CTX = 256, DFF = 2816;
constexpr int TL = NB * SEQ, TC = NB * CTX, T = TL + TC;
constexpr int NMOD = 9 * D;
constexpr int HYC = 256, RWW = 384, NAW = 384, INW = 3456, INWP = 3584;
constexpr int HY_IN = 768, RW_IN = 1536, NA_IN = 1152;
constexpr int NFFT = 16384;
constexpr int NTHR = 512, NWAVE = 8;
constexpr int LDS_MAIN = 131072, LDS_EXTRA = 8192, LDS_BYTES = LDS_MAIN + LDS_EXTRA;
constexpr float NORM_EPS = 1e-6f;

constexpr size_t al256(size_t x) { return (x + 255) & ~(size_t)255; }
constexpr size_t WS_MODV = 0;
constexpr size_t WS_WGU1 = al256(WS_MODV + (size_t)DEPTH * 3 * NMOD * 4);
constexpr size_t WS_WDN1 = WS_WGU1 + (size_t)2 * DFF * D * 2;
constexpr size_t WS_WGU2 = WS_WDN1 + (size_t)D * DFF * 2;
constexpr size_t WS_WDN2 = WS_WGU2 + (size_t)2 * DFF * D * 2;
constexpr size_t WS_WIN = WS_WDN2 + (size_t)D * DFF * 2;
constexpr size_t WS_WOUT = WS_WIN + (size_t)INWP * D * 2;
constexpr size_t WS_WLORA = WS_WOUT + (size_t)D * D * 2;
constexpr size_t WS_H = WS_WLORA + (size_t)2048 * 384 * 2;
constexpr size_t WS_U = WS_H + (size_t)T * D * 4;
constexpr size_t WS_S = WS_U + (size_t)T * D * 2;
constexpr size_t WS_Y = WS_S;
constexpr size_t WS_ACT = WS_Y + (size_t)T * D * 4;
constexpr size_t WS_FFN_END = WS_ACT + (size_t)T * DFF * 2;
constexpr size_t WS_PHY = WS_S;
constexpr size_t WS_PRW = WS_PHY + (size_t)T * HY_IN * 2;
constexpr size_t WS_YDIR = WS_PRW;
constexpr size_t WS_PNA = WS_PRW + (size_t)T * RW_IN * 2;
constexpr size_t WS_ALORA = WS_PNA + (size_t)T * NA_IN * 2;
constexpr size_t WS_DECAY = WS_ALORA + (size_t)T * 384 * 2;
constexpr size_t WS_LORAO = WS_DECAY + (size_t)2 * T * 384 * 4;
constexpr size_t WS_E = WS_LORAO;
constexpr size_t WS_ZP = WS_E + (size_t)24 * SEQ * 64 * 2;
constexpr size_t WS_GATE = WS_LORAO + (size_t)T * 1536 * 2;
static_assert(WS_ZP + (size_t)24 * 33 * 2 * 4096 * 4 <= WS_GATE, "E + ZP must fit in the LORAO region");
constexpr size_t WS_RS = WS_GATE + (size_t)T * 384 * 2;
constexpr size_t WS_KKS = WS_RS + (size_t)T * 384 * 2;
constexpr size_t WS_VS = WS_KKS + (size_t)T * 384 * 2;
constexpr size_t WS_KS = WS_VS + (size_t)T * 384 * 2;
constexpr size_t WS_BS = WS_KS + (size_t)2 * T * 384 * 2;
constexpr size_t WS_BONUS = WS_BS + (size_t)2 * T * 384 * 2;
constexpr size_t WS_FILT = al256(WS_BONUS + (size_t)T * 6 * 4);
constexpr size_t WS_FILTC = WS_FILT + (size_t)1024 * SEQ * 2;
constexpr size_t WS_SPEC = WS_FILTC + (size_t)1024 * CTX * 2;
constexpr size_t WS_Z1 = WS_SPEC + (size_t)512 * NFFT * 8;
constexpr size_t WS_VTL = WS_Z1 + (size_t)HYC * NB * SEQ * 4;
constexpr size_t WS_VTC = WS_VTL + (size_t)NB * 6 * 64 * SEQ * 2;
constexpr size_t WS_MIX_END = WS_VTC + (size_t)NB * 6 * 64 * CTX * 2;
constexpr size_t WS_BAR = al256(WS_MIX_END > WS_FFN_END ? WS_MIX_END : WS_FFN_END);
constexpr size_t WS_END = WS_BAR + (size_t)XCD_BAR_WORDS * 4;
static_assert(WS_END <= (size_t)4 * DEPTH * D * NMOD * 4, "workspace map exceeds 4x the largest input tensor");

struct Params { const float* in[34]; float* out; unsigned char* ws; };
enum { I_X = 0, I_C, I_CTX, I_CCTX, I_MODW, I_MODB, I_NORMG, I_F1GU, I_F1DN, I_F2GU, I_F2DN, I_WIN, I_WOUT, I_HCW, I_HCB, I_HW1, I_HB1, I_HW2, I_HB2, I_HW3, I_HFREQ, I_HBIAS,
       I_MU, I_W0, I_W2, I_A0, I_A2, I_G2, I_KK, I_KA, I_RK, I_LNW, I_LNB, I_RPB };

typedef LAS float* ldsfp;
__device__ __forceinline__ ldsfp vlds(const void* p) { ldsfp q = (ldsfp)p; asm volatile("" : "+v"(q)); return q; }
__device__ __forceinline__ float bf2f(bf16_t b) { return __uint_as_float(((unsigned)b) << 16); }
__device__ __forceinline__ bf16_t f2bf(float f) { unsigned u = __float_as_uint(f); u += 0x7FFFu + ((u >> 16) & 1u); return (bf16_t)(u >> 16); }
__device__ __forceinline__ float lo_bf(unsigned w) { return __uint_as_float(w << 16); }
__device__ __forceinline__ float hi_bf(unsigned w) { return __uint_as_float(w & 0xffff0000u); }
__device__ __forceinline__ float wsum(float v) {
#pragma unroll
    for (int o = 32; o > 0; o >>= 1) v += __shfl_xor(v, o);
    return v;
}
__device__ __forceinline__ float sigmoidf_(float x) { return __builtin_amdgcn_rcpf(1.0f + __expf(-x)); }
__device__ __forceinline__ void unpack8(const u32x4 w, float (&f)[8]) {
    f[0] = lo_bf(w.x); f[1] = hi_bf(w.x); f[2] = lo_bf(w.y); f[3] = hi_bf(w.y); f[4] = lo_bf(w.z); f[5] = hi_bf(w.z); f[6] = lo_bf(w.w); f[7] = hi_bf(w.w);
}
__device__ __forceinline__ void row_nbrs(int row, bool& hasp, bool& hasn) {
    if (row < TL) { const int t = row & (SEQ - 1); hasp = t > 0; hasn = t < SEQ - 1; }
    else { const int t = (row - TL) & (CTX - 1); hasp = t > 0; hasn = t < CTX - 1; }
}

__device__ __forceinline__ void ph_modv(const Params& P, float* lds) {
    const int tid = otid();
    float* sv = lds;
    float* red = lds + 3072;
    for (int i = tid; i < 3072; i += NTHR) { const int s = i >> 10, k = i & 1023; const float c = s < 2 ? P.in[I_C][s * 1024 + k] : P.in[I_CCTX][k]; sv[i] = c / (1.0f + expf(-c)); }
    __syncthreads();
    float* modv = (float*)(P.ws + WS_MODV);
    const int kc = tid >> 6, cl = tid & 63;
    for (int item = blockIdx.x; item < DEPTH * 144; item += gridDim.x) {
        const int l = item / 144, cb = item % 144, col = cb * 64 + cl;
        const float* w = P.in[I_MODW] + ((size_t)l * 1024 + kc * 128) * NMOD + col;
        float a0 = 0.f, a1 = 0.f, a2 = 0.f;
#pragma unroll 8
        for (int k = 0; k < 128; ++k) { const float wv = w[(size_t)k * NMOD]; a0 += sv[kc * 128 + k] * wv; a1 += sv[1024 + kc * 128 + k] * wv; a2 += sv[2048 + kc * 128 + k] * wv; }
        red[(0 * 8 + kc) * 64 + cl] = a0; red[(1 * 8 + kc) * 64 + cl] = a1; red[(2 * 8 + kc) * 64 + cl] = a2;
        __syncthreads();
        if (tid < 192) { const int s = tid >> 6, c = tid & 63; float r = P.in[I_MODB][l * NMOD + cb * 64 + c];
#pragma unroll
            for (int q = 0; q < 8; ++q) r += red[(s * 8 + q) * 64 + c];
            modv[((size_t)l * 3 + s) * NMOD + cb * 64 + c] = r; }
        __syncthreads();
    }
}

__device__ __forceinline__ float hy_delta(int c);
__device__ __forceinline__ int rowmap_gu(int n) { const int up = n >= DFF ? 1 : 0; const int j = n - up * DFF; return (j >> 7) * 256 + up * 128 + (j & 127); }
__device__ __forceinline__ void conv_tile(const float* __restrict__ src, int K, int N, bf16_t* __restrict__ dst, int tk, int tn, bool gu, float* tile) {
    const int tid = otid(); const int k0 = tk * 64, n0 = tn * 64;
#pragma unroll
    for (int rr = 0; rr < 2; ++rr) { const int kk = (tid >> 4) + rr * 32, n4 = (tid & 15) * 4; const float4 v = *(const float4*)(src + (size_t)(k0 + kk) * N + n0 + n4);
        tile[kk * 65 + n4 + 0] = v.x; tile[kk * 65 + n4 + 1] = v.y; tile[kk * 65 + n4 + 2] = v.z; tile[kk * 65 + n4 + 3] = v.w; }
    __syncthreads();
    { const int nn = tid >> 3, ks = (tid & 7) * 8; const int n = n0 + nn; const int row = gu ? rowmap_gu(n) : n;
      u32x4 w; w.x = cvt_pk_bf16(tile[(ks + 0) * 65 + nn], tile[(ks + 1) * 65 + nn]); w.y = cvt_pk_bf16(tile[(ks + 2) * 65 + nn], tile[(ks + 3) * 65 + nn]);
      w.z = cvt_pk_bf16(tile[(ks + 4) * 65 + nn], tile[(ks + 5) * 65 + nn]); w.w = cvt_pk_bf16(tile[(ks + 6) * 65 + nn], tile[(ks + 7) * 65 + nn]);
      *(u32x4*)(dst + (size_t)row * K + k0 + ks) = w; }
    __syncthreads();
}
__device__ __forceinline__ void ph_prep(const Params& P, int l, float* lds) {
    const int tid = otid();
    unsigned char* ws = P.ws;
    constexpr int N0 = 16 * 88, N1 = 44 * 16, N4 = 16 * 54, N5 = 16 * 16;
    constexpr int C0 = N0, C1 = C0 + N1, C2 = C1 + N0, C3 = C2 + N1, C4 = C3 + N4, C5 = C4 + N5;
    for (int it = blockIdx.x; it < C5; it += gridDim.x) {
        if (it < C0) { conv_tile(P.in[I_F1GU] + (size_t)l * D * 2 * DFF, D, 2 * DFF, (bf16_t*)(ws + WS_WGU1), it / 88, it % 88, true, lds); }
        else if (it < C1) { const int j = it - C0; conv_tile(P.in[I_F1DN] + (size_t)l * DFF * D, DFF, D, (bf16_t*)(ws + WS_WDN1), j / 16, j % 16, false, lds); }
        else if (it < C2) { const int j = it - C1; conv_tile(P.in[I_F2GU] + (size_t)l * D * 2 * DFF, D, 2 * DFF, (bf16_t*)(ws + WS_WGU2), j / 88, j % 88, true, lds); }
        else if (it < C3) { const int j = it - C2; conv_tile(P.in[I_F2DN] + (size_t)l * DFF * D, DFF, D, (bf16_t*)(ws + WS_WDN2), j / 16, j % 16, false, lds); }
        else if (it < C4) { const int j = it - C3; conv_tile(P.in[I_WIN] + (size_t)l * D * INW, D, INW, (bf16_t*)(ws + WS_WIN), j / 54, j % 54, false, lds); }
        else { const int j = it - C4; conv_tile(P.in[I_WOUT] + (size_t)l * D * D, D, D, (bf16_t*)(ws + WS_WOUT), j / 16, j % 16, false, lds); }
    }
    const int gtid = blockIdx.x * NTHR + tid, gn = gridDim.x * NTHR;
    { unsigned* z = (unsigned*)(ws + WS_WIN + (size_t)INW * D * 2); for (int i = gtid; i < (INWP - INW) * D / 2; i += gn) z[i] = 0u; }
    { bf16_t* wl = (bf16_t*)(ws + WS_WLORA);
      const float* w2 = P.in[I_W2] + (size_t)l * 2 * 64 * RWW; const float* a2 = P.in[I_A2] + (size_t)l * 2 * 64 * RWW; const float* g2 = P.in[I_G2] + (size_t)l * 128 * RWW;
      for (int i = gtid; i < 2048 * 384; i += gn) { const int k = i / 2048, j = i % 2048; float v = 0.f;
          if (j < 1920) { const int grp = j / 384, c = j % 384;
              if (grp == 0) { if (k < 64) v = w2[(size_t)k * RWW + c]; }
              else if (grp == 1) { if (k >= 64 && k < 128) v = w2[(size_t)(64 + k - 64) * RWW + c]; }
              else if (grp == 2) { if (k >= 128 && k < 192) v = a2[(size_t)(k - 128) * RWW + c]; }
              else if (grp == 3) { if (k >= 192 && k < 256) v = a2[(size_t)(64 + k - 192) * RWW + c]; }
              else { if (k >= 256) v = g2[(size_t)(k - 256) * RWW + c]; } }
          wl[(size_t)j * 384 + k] = f2bf(v); } }
    { const float* w1_ = P.in[I_HW1] + (size_t)l * 33 * 64; const float* b1 = P.in[I_HB1] + l * 64; const float* w2f_ = P.in[I_HW2] + (size_t)l * 64 * 64; const float* b2 = P.in[I_HB2] + l * 64;
      const float* fqv = P.in[I_HFREQ] + l * 64; const float* w3 = P.in[I_HW3] + (size_t)l * 64 * 1024;
      const int lane = tid & 63, wv = tid >> 6;
      const float fq = fqv[lane], bb1 = b1[lane], bb2 = b2[lane];
      const ldsfp hl = vlds(lds);
      for (int task = blockIdx.x; task < 264; task += gridDim.x) {
          const int L = task < 256 ? SEQ : CTX, n0 = task < 256 ? task * 32 : (task - 256) * 32;
          __syncthreads();
#pragma unroll 1
          for (int pp = 0; pp < 4; ++pp) { const int p = wv * 4 + pp, pos = n0 + p;
              const float* w1 = w1_; const float* w2f = w2f_; asm volatile("" : "+s"(w1), "+s"(w2f));
              const float tt = (float)pos / (float)(L - 1);
              const float ang = 6.283185307179586f * (float)pos / (float)L;
              float z = 0.f;
              if (lane == 0) z = tt;
              else if (lane <= 16) { const float fr = 1e-4f + (float)(lane - 1) * ((15.0f - 1e-4f) / 15.0f); z = cosf(fr * ang); }
              else if (lane <= 32) { const float fr = 1e-4f + (float)(lane - 17) * ((15.0f - 1e-4f) / 15.0f); z = -sinf(fr * ang); }
              float a = bb1;
#pragma unroll
              for (int e = 0; e < 33; ++e) a += __shfl(z, e) * w1[e * 64 + lane];
              const float h1 = sinf(fq * a);
              float c = bb2;
#pragma unroll
              for (int i = 0; i < 64; ++i) c += __shfl(h1, i) * w2f[i * 64 + lane];
              hl[lane * 32 + p] = sinf(fq * c); }
          __syncthreads();
          float acc0[32], acc1[32];
#pragma unroll
          for (int p = 0; p < 32; ++p) { acc0[p] = 0.f; acc1[p] = 0.f; }
#pragma unroll 2
          for (int i = 0; i < 64; ++i) { const float wa = w3[(size_t)i * 1024 + tid], wb = w3[(size_t)i * 1024 + 512 + tid];
#pragma unroll
              for (int p4 = 0; p4 < 8; ++p4) { const f32x4 hv = *(const LAS f32x4*)(hl + i * 32 + p4 * 4);
                  acc0[p4 * 4 + 0] += hv.x * wa; acc0[p4 * 4 + 1] += hv.y * wa; acc0[p4 * 4 + 2] += hv.z * wa; acc0[p4 * 4 + 3] += hv.w * wa;
                  acc1[p4 * 4 + 0] += hv.x * wb; acc1[p4 * 4 + 1] += hv.y * wb; acc1[p4 * 4 + 2] += hv.z * wb; acc1[p4 * 4 + 3] += hv.w * wb; } }
          const float dl = hy_delta(tid & 255), sc = task < 256 ? (1.0f / NFFT) : 1.0f, invL = 1.0f / (float)(L - 1);
          bf16_t* dst = task < 256 ? (bf16_t*)(ws + WS_FILT) + (size_t)tid * SEQ + n0 : (bf16_t*)(ws + WS_FILTC) + (size_t)tid * CTX + n0;
          const size_t cstep = task < 256 ? (size_t)512 * SEQ : (size_t)512 * CTX;
#pragma unroll
          for (int p8 = 0; p8 < 4; ++p8) { float d[8];
#pragma unroll
              for (int k = 0; k < 8; ++k) d[k] = __expf(-((float)(n0 + p8 * 8 + k) * invL) * dl) * sc;
              u32x4 w; w.x = cvt_pk_bf16(acc0[p8 * 8 + 0] * d[0], acc0[p8 * 8 + 1] * d[1]); w.y = cvt_pk_bf16(acc0[p8 * 8 + 2] * d[2], acc0[p8 * 8 + 3] * d[3]);
              w.z = cvt_pk_bf16(acc0[p8 * 8 + 4] * d[4], acc0[p8 * 8 + 5] * d[5]); w.w = cvt_pk_bf16(acc0[p8 * 8 + 6] * d[6], acc0[p8 * 8 + 7] * d[7]);
              *(u32x4*)(dst + p8 * 8) = w;
              w.x = cvt_pk_bf16(acc1[p8 * 8 + 0] * d[0], acc1[p8 * 8 + 1] * d[1]); w.y = cvt_pk_bf16(acc1[p8 * 8 + 2] * d[2], acc1[p8 * 8 + 3] * d[3]);
              w.z = cvt_pk_bf16(acc1[p8 * 8 + 4] * d[4], acc1[p8 * 8 + 5] * d[5]); w.w = cvt_pk_bf16(acc1[p8 * 8 + 6] * d[6], acc1[p8 * 8 + 7] * d[7]);
              *(u32x4*)(dst + cstep + p8 * 8) = w; }
      }
      __syncthreads(); }
}

__device__ __forceinline__ void ph_rowpass(const Params& P, int mode, int lpost, int gate_i, int gpost_i, float ps, int lpre, int gpre_i, int shift_i, int scale_i) {
    const int tid = otid(), lane = tid & 63, gw = blockIdx.x * NWAVE + (tid >> 6), nw = gridDim.x * NWAVE;
    const float* modv = (const float*)(P.ws + WS_MODV);
    float* H = (float*)(P.ws + WS_H); const float* Y = (const float*)(P.ws + WS_Y); bf16_t* U = (bf16_t*)(P.ws + WS_U);
    int cur_s = -1;
    float4 A[4], Bv[4], Cv[4];
#pragma unroll
    for (int j = 0; j < 4; ++j) { A[j] = make_float4(0.f, 0.f, 0.f, 0.f); Bv[j] = A[j]; Cv[j] = A[j]; }
    for (int row = gw; row < T; row += nw) {
        const int s = row < SEQ ? 0 : (row < TL ? 1 : 2);
        if (s != cur_s) { cur_s = s;
#pragma unroll
            for (int j = 0; j < 4; ++j) { const int e = lane * 4 + 256 * j;
                if (mode != 0) { const float4 g = *(const float4*)(modv + ((size_t)lpost * 3 + s) * NMOD + gate_i * D + e); const float4 gp = *(const float4*)(P.in[I_NORMG] + ((size_t)lpost * 6 + gpost_i) * D + e);
                    A[j] = make_float4(ps * g.x * gp.x, ps * g.y * gp.y, ps * g.z * gp.z, ps * g.w * gp.w); }
                if (mode != 2) { const float4 sc = *(const float4*)(modv + ((size_t)lpre * 3 + s) * NMOD + scale_i * D + e); const float4 gq = *(const float4*)(P.in[I_NORMG] + ((size_t)lpre * 6 + gpre_i) * D + e);
                    Bv[j] = make_float4(gq.x * (1.f + sc.x), gq.y * (1.f + sc.y), gq.z * (1.f + sc.z), gq.w * (1.f + sc.w));
                    Cv[j] = *(const float4*)(modv + ((size_t)lpre * 3 + s) * NMOD + shift_i * D + e); } } }
        float4 h[4];
        if (mode == 0) { const float* src = row < TL ? P.in[I_X] + (size_t)row * D : P.in[I_CTX] + (size_t)(row - TL) * D;
#pragma unroll
            for (int j = 0; j < 4; ++j) h[j] = *(const float4*)(src + lane * 4 + 256 * j);
        } else {
            float4 y[4]; float ss = 0.f;
#pragma unroll
            for (int j = 0; j < 4; ++j) { h[j] = *(const float4*)(H + (size_t)row * D + lane * 4 + 256 * j); y[j] = *(const float4*)(Y + (size_t)row * D + lane * 4 + 256 * j);
                ss += y[j].x * y[j].x + y[j].y * y[j].y + y[j].z * y[j].z + y[j].w * y[j].w; }
            ss = wsum(ss); const float r = rsqrtf(ss * (1.0f / D) + NORM_EPS);
#pragma unroll
            for (int j = 0; j < 4; ++j) { h[j].x += A[j].x * (y[j].x * r); h[j].y += A[j].y * (y[j].y * r); h[j].z += A[j].z * (y[j].z * r); h[j].w += A[j].w * (y[j].w * r); }
        }
        if (mode == 2) { if (row < TL) {
#pragma unroll
                for (int j = 0; j < 4; ++j) *(float4*)(P.out + (size_t)row * D + lane * 4 + 256 * j) = h[j]; }
            continue; }
        float s2 = 0.f;
#pragma unroll
        for (int j = 0; j < 4; ++j) { *(float4*)(H + (size_t)row * D + lane * 4 + 256 * j) = h[j]; s2 += h[j].x * h[j].x + h[j].y * h[j].y + h[j].z * h[j].z + h[j].w * h[j].w; }
        s2 = wsum(s2); const float r2 = rsqrtf(s2 * (1.0f / D) + NORM_EPS);
#pragma unroll
        for (int j = 0; j < 4; ++j) { u32x2 w; w.x = cvt_pk_bf16(h[j].x * r2 * Bv[j].x + Cv[j].x, h[j].y * r2 * Bv[j].y + Cv[j].y); w.y = cvt_pk_bf16(h[j].z * r2 * Bv[j].z + Cv[j].z, h[j].w * r2 * Bv[j].w + Cv[j].w);
            *(u32x2*)(U + (size_t)row * D + lane * 4 + 256 * j) = w; }
    }
}

struct EpiGU {
    static constexpr bool PERM = true, AFTER_DRAIN = false;
    bf16_t* O;
    __device__ __forceinline__ void operator()(const f32x4 (&acc)[2][2][4][2], const pg8::Unit& u, int wr, int wc, int fr, int fq) const {
        const int row0 = u.pm * 256 + wr * 64 + fr, col0 = u.pn * 128 + wc * 32 + 8 * fq;
#pragma unroll
        for (int ai = 0; ai < 2; ++ai)
#pragma unroll
            for (int m = 0; m < 4; ++m) { float o[8];
#pragma unroll
                for (int n = 0; n < 2; ++n)
#pragma unroll
                    for (int j = 0; j < 4; ++j) { const float g = acc[ai][0][m][n][j], up = acc[ai][1][m][n][j]; o[n * 4 + j] = g * __builtin_amdgcn_rcpf(1.0f + __expf(-g)) * up; }
                u32x4 w; w.x = cvt_pk_bf16(o[0], o[1]); w.y = cvt_pk_bf16(o[2], o[3]); w.z = cvt_pk_bf16(o[4], o[5]); w.w = cvt_pk_bf16(o[6], o[7]);
                *(u32x4*)(O + (size_t)(row0 + ai * 128 + m * 16) * DFF + col0) = w; }
    }
};
struct EpiF32 {
    static constexpr bool PERM = false, AFTER_DRAIN = false;
    float* C;
    __device__ __forceinline__ void operator()(const f32x4 (&acc)[2][2][4][2], const pg8::Unit& u, int wr, int wc, int fr, int fq) const {
        const int row0 = u.pm * 256 + wr * 64 + fr, col0 = u.pn * 256 + wc * 32 + 4 * fq;
#pragma unroll
        for (int ai = 0; ai < 2; ++ai)
#pragma unroll
            for (int m = 0; m < 4; ++m) { float* rowp = C + (size_t)(row0 + ai * 128 + m * 16) * D + col0;
#pragma unroll
                for (int bj = 0; bj < 2; ++bj)
#pragma unroll
                    for (int n = 0; n < 2; ++n) *(f32x4*)(rowp + bj * 128 + n * 16) = acc[ai][bj][m][n]; }
    }
};
struct EpiWin {
    static constexpr bool PERM = true, AFTER_DRAIN = false;
    bf16_t* PHYT; bf16_t* PRW; bf16_t* PNA;
    __device__ __forceinline__ void operator()(const f32x4 (&acc)[2][2][4][2], const pg8::Unit& u, int wr, int wc, int fr, int fq) const {
        const int row0 = u.pm * 256 + wr * 64 + fr;
        if (u.pn < 3) {
#pragma unroll
            for (int bj = 0; bj < 2; ++bj) { bf16_t* cp = PHYT + (size_t)(u.pn * 256 + bj * 128 + wc * 32 + 8 * fq) * T + row0;
#pragma unroll
                for (int ai = 0; ai < 2; ++ai)
#pragma unroll
                    for (int m = 0; m < 4; ++m) { const f32x4 v0 = acc[ai][bj][m][0], v1 = acc[ai][bj][m][1]; bf16_t* rp = cp + ai * 128 + m * 16;
                        const unsigned w0 = cvt_pk_bf16(v0[0], v0[1]), w1 = cvt_pk_bf16(v0[2], v0[3]), w2 = cvt_pk_bf16(v1[0], v1[1]), w3 = cvt_pk_bf16(v1[2], v1[3]);
                        rp[0] = (bf16_t)w0; rp[(size_t)T] = (bf16_t)(w0 >> 16); rp[(size_t)2 * T] = (bf16_t)w1; rp[(size_t)3 * T] = (bf16_t)(w1 >> 16);
                        rp[(size_t)4 * T] = (bf16_t)w2; rp[(size_t)5 * T] = (bf16_t)(w2 >> 16); rp[(size_t)6 * T] = (bf16_t)w3; rp[(size_t)7 * T] = (bf16_t)(w3 >> 16); } }
            return; }
        bf16_t* base; int ld, cbase;
        if (u.pn < 9) { base = PRW; ld = RW_IN; cbase = u.pn * 256 - HY_IN; }
        else { base = PNA; ld = NA_IN; cbase = u.pn * 256 - HY_IN - RW_IN; }
        const int nbj = (u.pn == 13) ? 1 : 2;
#pragma unroll
        for (int ai = 0; ai < 2; ++ai)
#pragma unroll
            for (int m = 0; m < 4; ++m)
#pragma unroll
                for (int bj = 0; bj < 2; ++bj) { if (bj < nbj) { const f32x4 v0 = acc[ai][bj][m][0], v1 = acc[ai][bj][m][1];
                    u32x4 w; w.x = cvt_pk_bf16(v0[0], v0[1]); w.y = cvt_pk_bf16(v0[2], v0[3]); w.z = cvt_pk_bf16(v1[0], v1[1]); w.w = cvt_pk_bf16(v1[2], v1[3]);
                    *(u32x4*)(base + (size_t)(row0 + ai * 128 + m * 16) * ld + cbase + bj * 128 + wc * 32 + 8 * fq) = w; } }
    }
};
struct EpiLora {
    static constexpr bool PERM = true, AFTER_DRAIN = false;
    bf16_t* LO; bf16_t* GATE;
    __device__ __forceinline__ void operator()(const f32x4 (&acc)[2][2][4][2], const pg8::Unit& u, int wr, int wc, int fr, int fq) const {
        const int row0 = u.pm * 256 + wr * 64 + fr;
        bf16_t* base; int ld, cbase;
        if (u.pn < 6) { base = LO; ld = 1536; cbase = u.pn * 256; } else { base = GATE; ld = 384; cbase = u.pn * 256 - 1536; }
        const int nbj = (u.pn == 7) ? 1 : 2;
#pragma unroll
        for (int ai = 0; ai < 2; ++ai)
#pragma unroll
            for (int m = 0; m < 4; ++m)
#pragma unroll
                for (int bj = 0; bj < 2; ++bj) { if (bj < nbj) { const f32x4 v0 = acc[ai][bj][m][0], v1 = acc[ai][bj][m][1];
                    u32x4 w; w.x = cvt_pk_bf16(v0[0], v0[1]); w.y = cvt_pk_bf16(v0[2], v0[3]); w.z = cvt_pk_bf16(v1[0], v1[1]); w.w = cvt_pk_bf16(v1[2], v1[3]);
                    *(u32x4*)(base + (size_t)(row0 + ai * 128 + m * 16) * ld + cbase + bj * 128 + wc * 32 + 8 * fq) = w; } }
    }
};
template <class Epi> __device__ __forceinline__ void run_gemm(LAS unsigned char* lds, const bf16_t* A, const bf16_t* Bt, int M, int N, int K, const Epi& E) {
    asm volatile("" : "+s"(K));
    pg8::Gemm g{A, Bt, M, N, K}; pg8::StaticOrder S; S.init(M, N, (int)gridDim.x, (int)blockIdx.x);
    pg8::gemm_phase<Epi, pg8::StaticOrder>(lds, g, S, E);
    __syncthreads();
}

__device__ __forceinline__ void ph_loraprep(const Params& P, int l) {
    const bf16_t* PRW = (const bf16_t*)(P.ws + WS_PRW); bf16_t* AL = (bf16_t*)(P.ws + WS_ALORA);
    const float* mu = P.in[I_MU] + (size_t)l * 2 * RW_IN;
    const int gtid = blockIdx.x * NTHR + otid(), gn = gridDim.x * NTHR;
    for (int it = gtid; it < T * 48; it += gn) {
        const int row = it / 48, j8 = it % 48, col = 1152 + j8 * 8;
        bool hp, hn; row_nbrs(row, hp, hn);
        float p[8], pp[8], pn[8];
        unpack8(*(const u32x4*)(PRW + (size_t)row * RW_IN + col), p);
        if (hp) unpack8(*(const u32x4*)(PRW + (size_t)(row - 1) * RW_IN + col), pp); else {
#pragma unroll
            for (int i = 0; i < 8; ++i) pp[i] = 0.f; }
        if (hn) unpack8(*(const u32x4*)(PRW + (size_t)(row + 1) * RW_IN + col), pn); else {
#pragma unroll
            for (int i = 0; i < 8; ++i) pn[i] = 0.f; }
        float o[8];
#pragma unroll
        for (int i = 0; i < 8; ++i) { const float xs = p[i] + mu[col + i] * (pp[i] - p[i]) + mu[RW_IN + col + i] * (pn[i] - p[i]);
            o[i] = j8 < 16 ? tanhf(xs) : (j8 < 32 ? xs : sigmoidf_(xs)); }
        u32x4 w; w.x = cvt_pk_bf16(o[0], o[1]); w.y = cvt_pk_bf16(o[2], o[3]); w.z = cvt_pk_bf16(o[4], o[5]); w.w = cvt_pk_bf16(o[6], o[7]);
        *(u32x4*)(AL + (size_t)row * 384 + j8 * 8) = w;
    }
}

__device__ __forceinline__ void ph_rwkvprep(const Params& P, int l) {
    const int tid = otid(), lane = tid & 63, gw = blockIdx.x * NWAVE + (tid >> 6), nw = gridDim.x * NWAVE;
    const bf16_t* PRW = (const bf16_t*)(P.ws + WS_PRW); const bf16_t* LO = (const bf16_t*)(P.ws + WS_LORAO);
    bf16_t* RS = (bf16_t*)(P.ws + WS_RS); bf16_t* KKS = (bf16_t*)(P.ws + WS_KKS); bf16_t* VS = (bf16_t*)(P.ws + WS_VS); bf16_t* KS = (bf16_t*)(P.ws + WS_KS); bf16_t* BS = (bf16_t*)(P.ws + WS_BS);
    float* BON = (float*)(P.ws + WS_BONUS);
    const float* mu = P.in[I_MU] + (size_t)l * 2 * RW_IN;
    const int f = lane & 15; const float inv = __expf(-(float)f * (9.210340371976184f / 16.0f));
    for (int row = gw; row < T; row += nw) {
        bool hp, hn; row_nbrs(row, hp, hn);
#pragma unroll
      for (int h = 0; h < 6; ++h) { const int c = h * 64 + lane;
        float x[3];
#pragma unroll
        for (int q = 0; q < 3; ++q) { const int col = q * 384 + c; const float p = bf2f(PRW[(size_t)row * RW_IN + col]);
            const float pp = hp ? bf2f(PRW[(size_t)(row - 1) * RW_IN + col]) : 0.f, pn = hn ? bf2f(PRW[(size_t)(row + 1) * RW_IN + col]) : 0.f;
            x[q] = p + mu[col] * (pp - p) + mu[RW_IN + col] * (pn - p); }
        const float r = x[0], k = x[1], v = x[2];
        const float kkr = k * P.in[I_KK][l * RWW + c];
        const float nrm = sqrtf(wsum(kkr * kkr));
        const float kk = kkr / fmaxf(nrm, 1e-12f);
        const float a0 = sigmoidf_(bf2f(LO[(size_t)row * 1536 + 768 + c]) + P.in[I_A0][(size_t)l * 2 * RWW + c]), a1 = sigmoidf_(bf2f(LO[(size_t)row * 1536 + 1152 + c]) + P.in[I_A0][(size_t)l * 2 * RWW + RWW + c]);
        { float* DEC = (float*)(P.ws + WS_DECAY);
          const float x0 = bf2f(LO[(size_t)row * 1536 + c]) + P.in[I_W0][(size_t)l * 2 * RWW + c], x1 = bf2f(LO[(size_t)row * 1536 + 384 + c]) + P.in[I_W0][(size_t)l * 2 * RWW + RWW + c];
          DEC[(size_t)row * 384 + c] = __expf(-0.6065306597f * sigmoidf_(x0)); DEC[((size_t)T + row) * 384 + c] = __expf(-0.6065306597f * sigmoidf_(x1)); }
        const float ka = P.in[I_KA][l * RWW + c];
        float kd0 = k * (1.f + (a0 - 1.f) * ka), kd1 = k * (1.f + (a1 - 1.f) * ka);
        float b0 = kk * a0, b1 = kk * a1;
        const float bon = wsum(r * (kd0 + kd1) * P.in[I_RK][l * RWW + c]);
        if (lane == 0) BON[(size_t)row * 6 + h] = bon;
        float rs = r, kks = kk;
        if (row < TL) {
            const int t = row & (SEQ - 1); const float pos = (lane < 32) ? (float)(t >> 6) : (float)(t & 63);
            float sn, cs; sincosf(pos * inv, &sn, &cs);
            const float sg = (lane & 16) ? 1.f : -1.f;
            const float r2 = __shfl_xor(rs, 16), k2 = __shfl_xor(kks, 16), d0 = __shfl_xor(kd0, 16), d1 = __shfl_xor(kd1, 16), e0 = __shfl_xor(b0, 16), e1 = __shfl_xor(b1, 16);
            rs = rs * cs + sg * r2 * sn; kks = kks * cs + sg * k2 * sn; kd0 = kd0 * cs + sg * d0 * sn; kd1 = kd1 * cs + sg * d1 * sn; b0 = b0 * cs + sg * e0 * sn; b1 = b1 * cs + sg * e1 * sn;
        }
        const size_t o = (size_t)row * 384 + c;
        RS[o] = f2bf(rs); KKS[o] = f2bf(-kks); VS[o] = f2bf(v);
        KS[o] = f2bf(kd0); KS[(size_t)T * 384 + o] = f2bf(kd1); BS[o] = f2bf(b0); BS[(size_t)T * 384 + o] = f2bf(b1);
      }
    }
}

__device__ __forceinline__ int scan_row(int b, int d, int step) {
    if (step < CTX) { const int tc = d ? (CTX - 1 - step) : step; return TL + b * CTX + tc; }
    const int tl = d ? (SEQ - 1 - (step - CTX)) : (step - CTX); return b * SEQ + tl;
}
__device__ __forceinline__ void scan_task_v1(const Params& P, int task, float* sv) {
    const int lane = otid() & 63;
    const int d = task & 1, h = (task >> 1) % 6, b = task / 12;
    const float* DEC = (const float*)(P.ws + WS_DECAY) + (size_t)d * T * 384; const bf16_t* KKS = (const bf16_t*)(P.ws + WS_KKS); const bf16_t* RS = (const bf16_t*)(P.ws + WS_RS);
    const bf16_t* VS = (const bf16_t*)(P.ws + WS_VS); const bf16_t* KS = (const bf16_t*)(P.ws + WS_KS) + (size_t)d * T * 384; const bf16_t* BS = (const bf16_t*)(P.ws + WS_BS) + (size_t)d * T * 384;
    float* YD = (float*)(P.ws + WS_YDIR) + (size_t)d * T * 384;
    float S[64];
#pragma unroll
    for (int j = 0; j < 64; ++j) S[j] = 0.f;
    size_t o = (size_t)scan_row(b, d, 0) * 384 + h * 64 + lane;
    float nw_ = DEC[o], na = bf2f(KKS[o]), nb = bf2f(BS[o]), nk = bf2f(KS[o]), nr = bf2f(RS[o]), nv = bf2f(VS[o]);
    for (int step = 0; step < CTX + SEQ; ++step) {
        const float v = nv; const size_t oc = o;
        asm volatile("s_waitcnt lgkmcnt(0)" ::: "memory");
        sv[lane] = nw_; sv[64 + lane] = na; sv[128 + lane] = nb; sv[192 + lane] = nk; sv[256 + lane] = nr;
        asm volatile("s_waitcnt lgkmcnt(0)" ::: "memory");
        if (step + 1 < CTX + SEQ) { o = (size_t)scan_row(b, d, step + 1) * 384 + h * 64 + lane;
            nw_ = DEC[o]; na = bf2f(KKS[o]); nb = bf2f(BS[o]); nk = bf2f(KS[o]); nr = bf2f(RS[o]); nv = bf2f(VS[o]); }
        float sa0 = 0.f, sa1 = 0.f, sa2 = 0.f, sa3 = 0.f;
#pragma unroll
        for (int j = 0; j < 64; j += 4) { const float4 a4 = *(const float4*)(sv + 64 + j);
            sa0 += S[j + 0] * a4.x; sa1 += S[j + 1] * a4.y; sa2 += S[j + 2] * a4.z; sa3 += S[j + 3] * a4.w; }
        const float sa = (sa0 + sa1) + (sa2 + sa3);
        float y0 = 0.f, y1 = 0.f, y2 = 0.f, y3 = 0.f;
#pragma unroll
        for (int j = 0; j < 64; j += 4) {
            const float4 w4 = *(const float4*)(sv + j), b4 = *(const float4*)(sv + 128 + j), k4 = *(const float4*)(sv + 192 + j), r4 = *(const float4*)(sv + 256 + j);
            S[j + 0] = S[j + 0] * w4.x + sa * b4.x + v * k4.x; y0 += S[j + 0] * r4.x;
            S[j + 1] = S[j + 1] * w4.y + sa * b4.y + v * k4.y; y1 += S[j + 1] * r4.y;
            S[j + 2] = S[j + 2] * w4.z + sa * b4.z + v * k4.z; y2 += S[j + 2] * r4.z;
            S[j + 3] = S[j + 3] * w4.w + sa * b4.w + v * k4.w; y3 += S[j + 3] * r4.w; }
        YD[oc] = (y0 + y1) + (y2 + y3);
    }
}

__device__ __forceinline__ void natt_key(const bf16_t* PNA, size_t krow, int hoff, const float (&q)[16], float bias, float& m, float& lsum, float (&o)[16]) {
    const bf16_t* kp = PNA + krow * NA_IN + 384 + hoff; const bf16_t* vp = PNA + krow * NA_IN + 768 + hoff;
    float s = 0.f;
#pragma unroll
    for (int j8 = 0; j8 < 2; ++j8) { float kf[8]; unpack8(*(const u32x4*)(kp + j8 * 8), kf);
#pragma unroll
        for (int i = 0; i < 8; ++i) s += q[j8 * 8 + i] * kf[i]; }
    s += __shfl_xor(s, 1); s += __shfl_xor(s, 2); s += bias;
    const float mn = fmaxf(m, s), corr = __expf(m - mn), p = __expf(s - mn);
    m = mn; lsum = lsum * corr + p;
#pragma unroll
    for (int j8 = 0; j8 < 2; ++j8) { float vf[8]; unpack8(*(const u32x4*)(vp + j8 * 8), vf);
#pragma unroll
        for (int i = 0; i < 8; ++i) o[j8 * 8 + i] = o[j8 * 8 + i] * corr + p * vf[i]; }
}
__device__ __forceinline__ void natten_items_v1(const Params& P, int l, int wid0, int nworkers) {
    const bf16_t* PNA = (const bf16_t*)(P.ws + WS_PNA); bf16_t* MIX = (bf16_t*)(P.ws + WS_U);
    const float* rpb = P.in[I_RPB] + (size_t)l * 6 * 15 * 31;
    const int sub = wid0 & 3;
    for (int it = wid0 >> 2; it < T * 6; it += nworkers >> 2) {
        const int row = it % T, h = it / T, hoff = h * 64 + sub * 16;
        float q[16], o[16];
#pragma unroll
        for (int j8 = 0; j8 < 2; ++j8) { float qf[8]; unpack8(*(const u32x4*)(PNA + (size_t)row * NA_IN + hoff + j8 * 8), qf);
#pragma unroll
            for (int i = 0; i < 8; ++i) { q[j8 * 8 + i] = qf[i] * 0.125f; o[j8 * 8 + i] = 0.f; } }
        float m = -3.0e38f, lsum = 0.f;
        int b;
        if (row < TL) { b = row >> 13; const int t = row & (SEQ - 1), i = t >> 6, col = t & 63;
            const int start = min(max(i - 4, 0), 120), win0 = min(max(col - 8, 0), 48);
            for (int r = 0; r < 8; ++r) for (int kc = win0; kc < win0 + 16; ++kc) {
                const float bias = rpb[(h * 15 + (start + r - i + 7)) * 31 + (kc - col + 15)];
                natt_key(PNA, (size_t)b * SEQ + (start + r) * 64 + kc, hoff, q, bias, m, lsum, o); }
        } else b = (row - TL) >> 8;
        for (int c = 0; c < CTX; ++c) natt_key(PNA, (size_t)TL + b * CTX + c, hoff, q, 0.f, m, lsum, o);
        const float il = 1.0f / lsum;
#pragma unroll
        for (int j8 = 0; j8 < 2; ++j8) { u32x4 w; w.x = cvt_pk_bf16(o[j8 * 8 + 0] * il, o[j8 * 8 + 1] * il); w.y = cvt_pk_bf16(o[j8 * 8 + 2] * il, o[j8 * 8 + 3] * il);
            w.z = cvt_pk_bf16(o[j8 * 8 + 4] * il, o[j8 * 8 + 5] * il); w.w = cvt_pk_bf16(o[j8 * 8 + 6] * il, o[j8 * 8 + 7] * il);
            *(u32x4*)(MIX + (size_t)row * D + 640 + hoff + j8 * 8) = w; }
    }
}

__device__ __forceinline__ void vt_tile(const Params& P, int tile, unsigned short* tl  ) {
    const int tid = otid();
    const bf16_t* PNA = (const bf16_t*)(P.ws + WS_PNA);
    int h, tok0; bf16_t* dst; int ldt;
    if (tile < NB * 128 * 6) { h = tile % 6; const int sb = tile / 6; const int b = sb >> 7, blk = sb & 127; tok0 = b * SEQ + blk * 64; dst = (bf16_t*)(P.ws + WS_VTL) + ((size_t)(b * 6 + h) * 64) * SEQ + blk * 64; ldt = SEQ; }
    else { const int tt = tile - NB * 128 * 6; h = tt % 6; const int sb = tt / 6; const int b = sb >> 2, blk = sb & 3; tok0 = TL + b * CTX + blk * 64; dst = (bf16_t*)(P.ws + WS_VTC) + ((size_t)(b * 6 + h) * 64) * CTX + blk * 64; ldt = CTX; }
    { const int tok = tid >> 3, seg = tid & 7; const u32x4 v = *(const u32x4*)(PNA + (size_t)(tok0 + tok) * NA_IN + 768 + h * 64 + seg * 8);
      unsigned* w = (unsigned*)(tl + tok * 72 + seg * 8); w[0] = v.x; w[1] = v.y; w[2] = v.z; w[3] = v.w; }
    __syncthreads();
    { const int hd = tid >> 3, ts = tid & 7; unsigned short e[8];
#pragma unroll
      for (int k = 0; k < 8; ++k) e[k] = tl[(ts * 8 + k) * 72 + hd];
      u32x4 w; w.x = (unsigned)e[0] | ((unsigned)e[1] << 16); w.y = (unsigned)e[2] | ((unsigned)e[3] << 16); w.z = (unsigned)e[4] | ((unsigned)e[5] << 16); w.w = (unsigned)e[6] | ((unsigned)e[7] << 16);
      *(u32x4*)(dst + (size_t)hd * ldt + ts * 8) = w; }
    __syncthreads();
}
constexpr int NAT_LAT_TASKS = NB * 128 * 4 * 6, NAT_CTX_TASKS = NB * 16 * 6, NAT_TASKS = NAT_LAT_TASKS + NAT_CTX_TASKS;
__device__ __forceinline__ void natten_task(const Params& P, int l, int task) {
    using pg8::bf16x8;
    const int lane = otid() & 63, fr = lane & 15, fq = lane >> 4;
    const bf16_t* PNA = (const bf16_t*)(P.ws + WS_PNA); bf16_t* MIX = (bf16_t*)(P.ws + WS_U);
    const bool lat = task < NAT_LAT_TASKS;
    int b, h, i = 0, n = 0, qtok0;
    if (lat) { h = task % 6; const int r = task / 6; n = r & 3; i = (r >> 2) & 127; b = r >> 9; qtok0 = b * SEQ + i * 64 + 16 * n; }
    else { const int tt = task - NAT_LAT_TASKS; h = tt % 6; const int qb = (tt / 6) & 15; b = tt / 96; qtok0 = TL + b * CTX + 16 * qb; }
    const int start = min(max(i - 4, 0), 120), band0 = min(max(16 * n - 8, 0), 32);
    const int col = 16 * n + fr, win0 = min(max(col - 8, 0), 48);
    bf16x8 bq[2];
#pragma unroll
    for (int kh = 0; kh < 2; ++kh) bq[kh] = *(const bf16x8*)(PNA + (size_t)(qtok0 + fr) * NA_IN + h * 64 + kh * 32 + fq * 8);
    f32x4 sc[32];
    if (lat) {
#pragma unroll
        for (int t = 0; t < 16; ++t) { const int tok0 = b * SEQ + (start + (t >> 1)) * 64 + band0 + 16 * (t & 1);
            const bf16_t* kp = PNA + (size_t)(tok0 + fr) * NA_IN + 384 + h * 64 + fq * 8;
            const bf16x8 k0 = *(const bf16x8*)kp, k1 = *(const bf16x8*)(kp + 32);
            f32x4 a = (f32x4){0.f, 0.f, 0.f, 0.f};
            a = __builtin_amdgcn_mfma_f32_16x16x32_bf16(k0, bq[0], a, 0, 0, 0); a = __builtin_amdgcn_mfma_f32_16x16x32_bf16(k1, bq[1], a, 0, 0, 0);
            sc[t] = a; if ((t & 3) == 3) asm volatile("" ::: "memory"); }
    } else {
#pragma unroll
        for (int t = 0; t < 16; ++t) sc[t] = (f32x4){-3.0e38f, -3.0e38f, -3.0e38f, -3.0e38f};
    }
#pragma unroll
    for (int t = 16; t < 32; ++t) { const int tok0 = TL + b * CTX + 16 * (t - 16);
        const bf16_t* kp = PNA + (size_t)(tok0 + fr) * NA_IN + 384 + h * 64 + fq * 8;
        const bf16x8 k0 = *(const bf16x8*)kp, k1 = *(const bf16x8*)(kp + 32);
        f32x4 a = (f32x4){0.f, 0.f, 0.f, 0.f};
        a = __builtin_amdgcn_mfma_f32_16x16x32_bf16(k0, bq[0], a, 0, 0, 0); a = __builtin_amdgcn_mfma_f32_16x16x32_bf16(k1, bq[1], a, 0, 0, 0);
        sc[t] = a * 0.125f; if ((t & 3) == 3) asm volatile("" ::: "memory"); }
    if (lat) { const float* rpb = P.in[I_RPB] + ((size_t)l * 6 + h) * 15 * 31;
#pragma unroll
        for (int t = 0; t < 16; ++t) { const int ro = start + (t >> 1) - i + 7; const int kc0 = band0 + 16 * (t & 1) + fq * 4;
#pragma unroll
            for (int j = 0; j < 4; ++j) { const int kc = kc0 + j; const bool ok = kc >= win0 && kc < win0 + 16; const int co = min(max(kc - col + 15, 0), 30);
                const float bias = rpb[ro * 31 + co]; sc[t][j] = ok ? sc[t][j] * 0.125f + bias : -3.0e38f; } } }
    float mx = -3.0e38f;
#pragma unroll
    for (int t = 0; t < 32; ++t) mx = fmaxf(mx, fmaxf(fmaxf(sc[t][0], sc[t][1]), fmaxf(sc[t][2], sc[t][3])));
    mx = fmaxf(mx, __shfl_xor(mx, 16)); mx = fmaxf(mx, __shfl_xor(mx, 32));
    float sum = 0.f;
#pragma unroll
    for (int t = 0; t < 32; ++t) {
#pragma unroll
        for (int j = 0; j < 4; ++j) { const float p = __expf(sc[t][j] - mx); sc[t][j] = p; sum += p; } }
    sum += __shfl_xor(sum, 16); sum += __shfl_xor(sum, 32);
    const float inv = 1.0f / sum;
    f32x4 ot[4];
#pragma unroll
    for (int q = 0; q < 4; ++q) ot[q] = (f32x4){0.f, 0.f, 0.f, 0.f};
    const bf16_t* VTL = (const bf16_t*)(P.ws + WS_VTL) + ((size_t)(b * 6 + h) * 64) * SEQ; const bf16_t* VTC = (const bf16_t*)(P.ws + WS_VTC) + ((size_t)(b * 6 + h) * 64) * CTX;
    if (lat) {
#pragma unroll
        for (int m = 0; m < 8; ++m) { const int tk = (start + m) * 64 + band0 + fq * 4;
            u32x4 pw; pw.x = cvt_pk_bf16(sc[2 * m][0], sc[2 * m][1]); pw.y = cvt_pk_bf16(sc[2 * m][2], sc[2 * m][3]); pw.z = cvt_pk_bf16(sc[2 * m + 1][0], sc[2 * m + 1][1]); pw.w = cvt_pk_bf16(sc[2 * m + 1][2], sc[2 * m + 1][3]);
            const bf16x8 pb = __builtin_bit_cast(bf16x8, pw);
#pragma unroll
            for (int q = 0; q < 4; ++q) { const bf16_t* vp = VTL + (size_t)(q * 16 + fr) * SEQ + tk; const u32x2 v0 = *(const u32x2*)vp, v1 = *(const u32x2*)(vp + 16);
                u32x4 vw; vw.x = v0.x; vw.y = v0.y; vw.z = v1.x; vw.w = v1.y;
                ot[q] = __builtin_amdgcn_mfma_f32_16x16x32_bf16(__builtin_bit_cast(bf16x8, vw), pb, ot[q], 0, 0, 0); }
            if (m & 1) asm volatile("" ::: "memory"); }
    }
#pragma unroll
    for (int m = 0; m < 8; ++m) { const int tk = 32 * m + fq * 4;
        u32x4 pw; pw.x = cvt_pk_bf16(sc[16 + 2 * m][0], sc[16 + 2 * m][1]); pw.y = cvt_pk_bf16(sc[16 + 2 * m][2], sc[16 + 2 * m][3]); pw.z = cvt_pk_bf16(sc[17 + 2 * m][0], sc[17 + 2 * m][1]); pw.w = cvt_pk_bf16(sc[17 + 2 * m][2], sc[17 + 2 * m][3]);
        const bf16x8 pb = __builtin_bit_cast(bf16x8, pw);
#pragma unroll
        for (int q = 0; q < 4; ++q) { const bf16_t* vp = VTC + (size_t)(q * 16 + fr) * CTX + tk; const u32x2 v0 = *(const u32x2*)vp, v1 = *(const u32x2*)(vp + 16);
            u32x4 vw; vw.x = v0.x; vw.y = v0.y; vw.z = v1.x; vw.w = v1.y;
            ot[q] = __builtin_amdgcn_mfma_f32_16x16x32_bf16(__builtin_bit_cast(bf16x8, vw), pb, ot[q], 0, 0, 0); }
        if (m & 1) asm volatile("" ::: "memory"); }
#pragma unroll
    for (int q = 0; q < 4; ++q) { u32x2 w; w.x = cvt_pk_bf16(ot[q][0] * inv, ot[q][1] * inv); w.y = cvt_pk_bf16(ot[q][2] * inv, ot[q][3] * inv);
        *(u32x2*)(MIX + (size_t)(qtok0 + fr) * D + 640 + h * 64 + q * 16 + fq * 4) = w; }
}

__device__ __forceinline__ void fft_fwd(float2* X) {
#pragma unroll 1
    for (int lq = 12; lq >= 0; lq -= 2) { const int q = 1 << lq;
        for (int j = otid(); j < NFFT / 4; j += NTHR) { const int lo = j & (q - 1), base = ((j >> lq) << (lq + 2)) | lo;
            const float2 x0 = X[base], x1 = X[base + q], x2 = X[base + 2 * q], x3 = X[base + 3 * q];
            const float fr = (float)lo / (float)(4 * q); const float c = __builtin_amdgcn_cosf(fr), s = __builtin_amdgcn_sinf(fr), c2 = c * c - s * s, s2 = 2.f * c * s;
            const float a0x = x0.x + x2.x, a0y = x0.y + x2.y, dx = x0.x - x2.x, dy = x0.y - x2.y;
            const float a2x = dx * c + dy * s, a2y = dy * c - dx * s;
            const float a1x = x1.x + x3.x, a1y = x1.y + x3.y, ex = x1.x - x3.x, ey = x1.y - x3.y;
            const float mx = ex * c + ey * s, my = ey * c - ex * s;
            const float a3x = my, a3y = -mx;
            const float fx = a0x - a1x, fy = a0y - a1y, gx = a2x - a3x, gy = a2y - a3y;
            X[base] = make_float2(a0x + a1x, a0y + a1y); X[base + q] = make_float2(fx * c2 + fy * s2, fy * c2 - fx * s2);
            X[base + 2 * q] = make_float2(a2x + a3x, a2y + a3y); X[base + 3 * q] = make_float2(gx * c2 + gy * s2, gy * c2 - gx * s2); }
        __syncthreads(); }
}
__device__ __forceinline__ void fft_inv(float2* X) {
#pragma unroll 1
    for (int lq = 0; lq <= 12; lq += 2) { const int q = 1 << lq;
        for (int j = otid(); j < NFFT / 4; j += NTHR) { const int lo = j & (q - 1), base = ((j >> lq) << (lq + 2)) | lo;
            const float2 y0 = X[base], y1 = X[base + q], y2 = X[base + 2 * q], y3 = X[base + 3 * q];
            const float fr = (float)lo / (float)(4 * q); const float c = __builtin_amdgcn_cosf(fr), s = __builtin_amdgcn_sinf(fr), c2 = c * c - s * s, s2 = 2.f * c * s;
            const float tx = y1.x * c2 - y1.y * s2, ty = y1.x * s2 + y1.y * c2;
            const float a0x = y0.x + tx, a0y = y0.y + ty, a1x = y0.x - tx, a1y = y0.y - ty;
            const float ux = y3.x * c2 - y3.y * s2, uy = y3.x * s2 + y3.y * c2;
            const float a2x = y2.x + ux, a2y = y2.y + uy, a3x = y2.x - ux, a3y = y2.y - uy;
            const float vx = a2x * c - a2y * s, vy = a2x * s + a2y * c;
            const float mx = a3x * c - a3y * s, my = a3x * s + a3y * c;
            const float wx = -my, wy = mx;
            X[base] = make_float2(a0x + vx, a0y + vy); X[base + 2 * q] = make_float2(a0x - vx, a0y - vy);
            X[base + q] = make_float2(a1x + wx, a1y + wy); X[base + 3 * q] = make_float2(a1x - wx, a1y - wy); }
        __syncthreads(); }
}
__device__ __forceinline__ float hy_delta(int c) { const float lo = -4.605170185988091f / 1.5f, hi = -4.605170185988091f / 0.3f; return fabsf(lo + (float)c * ((hi - lo) / 255.0f)); }
__device__ __forceinline__ float hy_short(const bf16_t* PHYT, const float* cw, const float* cb, int row, int col) {
    bool hp, hn; row_nbrs(row, hp, hn);
    const bf16_t* p = PHYT + (size_t)col * T + row;
    float v = cb[col] + cw[HY_IN + col] * bf2f(p[0]);
    if (hp) v += cw[col] * bf2f(p[-1]);
    if (hn) v += cw[2 * HY_IN + col] * bf2f(p[1]);
    return v;
}
__device__ __forceinline__ void hy_spec_task(const Params& P, int l, int o, int c, float2* X, float* ex_) {
    const int tid = otid();
    const bf16_t* ff = (const bf16_t*)(P.ws + WS_FILT) + (size_t)(o * 512 + c) * SEQ; const bf16_t* fb = ff + (size_t)256 * SEQ;
    for (int n = tid; n < SEQ; n += NTHR) {
        X[n] = make_float2(bf2f(ff[n]), 0.f);
        if (n > 0) X[NFFT - n] = make_float2(bf2f(fb[n]), 0.f); else X[SEQ] = make_float2(0.f, 0.f); }
    __syncthreads();
    fft_fwd(X);
    float2* spec = (float2*)(P.ws + WS_SPEC) + (size_t)(o * 256 + c) * NFFT;
    for (int i = tid; i < NFFT; i += NTHR) spec[i] = X[i];
    __syncthreads();
}
__device__ __forceinline__ void hy_conv_core(const Params& P, int o, int c, float2* X) {
    fft_fwd(X);
    const float2* spec = (const float2*)(P.ws + WS_SPEC) + (size_t)(o * 256 + c) * NFFT;
    for (int i = otid(); i < NFFT; i += NTHR) { const float2 a = X[i], k = spec[i]; X[i] = make_float2(a.x * k.x - a.y * k.y, a.x * k.y + a.y * k.x); }
    __syncthreads();
    fft_inv(X);
}
__device__ __forceinline__ void hy_task1(const Params& P, int l, int c, float2* X, float* ex) {
    const int tid = otid();
    const bf16_t* PHY = (const bf16_t*)(P.ws + WS_PHY); const float* cw = P.in[I_HCW] + (size_t)l * 3 * HY_IN; const float* cb = P.in[I_HCB] + (size_t)l * HY_IN;
    const float bias0 = P.in[I_HBIAS][(size_t)l * 2 * HYC + c], bias1 = P.in[I_HBIAS][(size_t)l * 2 * HYC + HYC + c];
    for (int n = tid; n < SEQ; n += NTHR) { X[n] = make_float2(hy_short(PHY, cw, cb, n, c), hy_short(PHY, cw, cb, SEQ + n, c)); X[SEQ + n] = make_float2(0.f, 0.f); }
    __syncthreads();
    hy_conv_core(P, 0, c, X);
    float* Z1 = (float*)(P.ws + WS_Z1) + (size_t)c * NB * SEQ;
    for (int n = tid; n < SEQ; n += NTHR) { const float2 y = X[n];
        const float v0 = hy_short(PHY, cw, cb, n, c), v1 = hy_short(PHY, cw, cb, SEQ + n, c), g0 = hy_short(PHY, cw, cb, n, HYC + c), g1 = hy_short(PHY, cw, cb, SEQ + n, HYC + c);
        Z1[n] = g0 * (y.x + bias0 * v0); Z1[SEQ + n] = g1 * (y.y + bias0 * v1); }
    __syncthreads();
    float* f = (float*)X;
    float* vv = f, *x1 = f + 512, *x2 = f + 1024, *hf = f + 1536  , *z1 = f + 2560;
    const bf16_t* fc = (const bf16_t*)(P.ws + WS_FILTC);
    { const int b = tid >> 8, t = tid & 255, row = TL + b * CTX + t;
      vv[tid] = hy_short(PHY, cw, cb, row, c); x1[tid] = hy_short(PHY, cw, cb, row, HYC + c); x2[tid] = hy_short(PHY, cw, cb, row, 2 * HYC + c);
      for (int q = tid; q < 1024; q += NTHR) { const int od = q >> 8, n = q & 255; hf[q] = bf2f(fc[(size_t)(od * 256 + c) * CTX + n]); } }
    __syncthreads();
    { const int b = tid >> 8, t = tid & 255; float y = bias0 * vv[tid];
      for (int s = 0; s <= t; ++s) y += hf[t - s] * vv[b * 256 + s];
      for (int s = t + 1; s < CTX; ++s) y += hf[256 + s - t] * vv[b * 256 + s];
      z1[tid] = x1[tid] * y; }
    __syncthreads();
    { const int b = tid >> 8, t = tid & 255; float y = bias1 * z1[tid];
      for (int s = 0; s <= t; ++s) y += hf[512 + t - s] * z1[b * 256 + s];
      for (int s = t + 1; s < CTX; ++s) y += hf[768 + s - t] * z1[b * 256 + s];
      bf16_t* MIX = (bf16_t*)(P.ws + WS_U); MIX[(size_t)(TL + b * CTX + t) * D + c] = f2bf(x2[tid] * y); }
    __syncthreads();
}
__device__ __forceinline__ void hy_task2(const Params& P, int l, int c, float2* X) {
    const int tid = otid();
    const bf16_t* PHY = (const bf16_t*)(P.ws + WS_PHY); const float* cw = P.in[I_HCW] + (size_t)l * 3 * HY_IN; const float* cb = P.in[I_HCB] + (size_t)l * HY_IN;
    const float bias1 = P.in[I_HBIAS][(size_t)l * 2 * HYC + HYC + c];
    const float* Z1 = (const float*)(P.ws + WS_Z1) + (size_t)c * NB * SEQ;
    for (int n = tid; n < SEQ; n += NTHR) { X[n] = make_float2(Z1[n], Z1[SEQ + n]); X[SEQ + n] = make_float2(0.f, 0.f); }
    __syncthreads();
    hy_conv_core(P, 1, c, X);
    bf16_t* MIX = (bf16_t*)(P.ws + WS_U);
    for (int n = tid; n < SEQ; n += NTHR) { const float2 y = X[n];
        const float g0 = hy_short(PHY, cw, cb, n, 2 * HYC + c), g1 = hy_short(PHY, cw, cb, SEQ + n, 2 * HYC + c);
        MIX[(size_t)n * D + c] = f2bf(g0 * (y.x + bias1 * Z1[n])); MIX[(size_t)(SEQ + n) * D + c] = f2bf(g1 * (y.y + bias1 * Z1[SEQ + n])); }
    __syncthreads();
}

constexpr int SEGC = 256, NSEG = 33, SCH = 4;
typedef float f32x2v __attribute__((ext_vector_type(2)));
template <bool IDENT>
__device__ __forceinline__ void scan_seg(const Params& P, int chain, int g, float* ring_  ) {
    const ldsfp ring = vlds(ring_);
    const int lane = otid() & 63;
    const int d = chain & 1, h = (chain >> 1) % 6, b = chain / 12;
    const float* DEC = (const float*)(P.ws + WS_DECAY) + (size_t)d * T * 384; const bf16_t* KKS = (const bf16_t*)(P.ws + WS_KKS); const bf16_t* RS = (const bf16_t*)(P.ws + WS_RS);
    const bf16_t* VS = (const bf16_t*)(P.ws + WS_VS); const bf16_t* KS = (const bf16_t*)(P.ws + WS_KS) + (size_t)d * T * 384; const bf16_t* BS = (const bf16_t*)(P.ws + WS_BS) + (size_t)d * T * 384;
    float* YD = (float*)(P.ws + WS_YDIR) + (size_t)d * T * 384;
    bf16_t* E = (bf16_t*)(P.ws + WS_E) + (size_t)chain * SEQ * 64;
    const int step0 = g == 0 ? 0 : CTX + (g - 1) * SEGC;
    f32x2v S0[32], S1[32];
#pragma unroll
    for (int j = 0; j < 32; ++j) { S0[j] = (f32x2v){0.f, 0.f}; S1[j] = (f32x2v){(2 * j == lane) ? 1.f : 0.f, (2 * j + 1 == lane) ? 1.f : 0.f}; }
    float pw[SCH], pa[SCH], pb[SCH], pk[SCH], pr[SCH], pv[SCH]; int po[SCH];
#pragma unroll
    for (int s = 0; s < SCH; ++s) { const int o = scan_row(b, d, step0 + s) * 384 + h * 64 + lane; po[s] = o;
        pw[s] = DEC[o]; pa[s] = bf2f(KKS[o]); pb[s] = bf2f(BS[o]); pk[s] = bf2f(KS[o]); pr[s] = bf2f(RS[o]); pv[s] = bf2f(VS[o]); }
    for (int c = 0; c < SEGC / SCH; ++c) {
        float cv[SCH]; int co[SCH];
        asm volatile("s_waitcnt lgkmcnt(0)" ::: "memory");
#pragma unroll
        for (int s = 0; s < SCH; ++s) { const ldsfp sv = ring + s * 320; sv[lane] = pw[s]; sv[64 + lane] = pa[s]; sv[128 + lane] = pb[s]; sv[192 + lane] = pk[s]; sv[256 + lane] = pr[s]; cv[s] = pv[s]; co[s] = po[s]; }
        asm volatile("s_waitcnt lgkmcnt(0)" ::: "memory");
        if (c + 1 < SEGC / SCH) {
#pragma unroll
            for (int s = 0; s < SCH; ++s) { const int o = scan_row(b, d, step0 + (c + 1) * SCH + s) * 384 + h * 64 + lane; po[s] = o;
                pw[s] = DEC[o]; pa[s] = bf2f(KKS[o]); pb[s] = bf2f(BS[o]); pk[s] = bf2f(KS[o]); pr[s] = bf2f(RS[o]); pv[s] = bf2f(VS[o]); } }
#pragma unroll
        for (int s = 0; s < SCH; ++s) { const ldsfp sv = ring + s * 320;
            f32x2v sa2 = (f32x2v){0.f, 0.f}, sb2 = (f32x2v){0.f, 0.f}, sa3 = sa2, sb3 = sa2;
#pragma unroll
            for (int hb = 0; hb < 2; ++hb) { f32x4 A[8];
#pragma unroll
                for (int i = 0; i < 8; ++i) A[i] = *(const LAS f32x4*)(sv + 64 + hb * 32 + 4 * i);
                __builtin_amdgcn_sched_barrier(0);
#pragma unroll
                for (int i = 0; i < 8; ++i) { const int jj = hb * 16 + 2 * i; const f32x2v alo = (f32x2v){A[i].x, A[i].y}, ahi = (f32x2v){A[i].z, A[i].w};
                    sa2 += S0[jj] * alo; sa3 += S0[jj + 1] * ahi;
                    if (IDENT) { sb2 += S1[jj] * alo; sb3 += S1[jj + 1] * ahi; } }
                __builtin_amdgcn_sched_barrier(0); }
            const float sa = (sa2.x + sa2.y) + (sa3.x + sa3.y), sb = (sb2.x + sb2.y) + (sb3.x + sb3.y);
            const f32x2v saa = (f32x2v){sa, sa}, sbb = (f32x2v){sb, sb}, vv = (f32x2v){cv[s], cv[s]};
            f32x2v y2 = (f32x2v){0.f, 0.f}, y3 = y2, e2 = y2, e3 = y2;
#pragma unroll
            for (int ch = 0; ch < 8; ++ch) { f32x4 W[2], Bq[2], K[2], R[2];
#pragma unroll
                for (int i = 0; i < 2; ++i) { const int j = ch * 8 + 4 * i; W[i] = *(const LAS f32x4*)(sv + j); Bq[i] = *(const LAS f32x4*)(sv + 128 + j); K[i] = *(const LAS f32x4*)(sv + 192 + j); R[i] = *(const LAS f32x4*)(sv + 256 + j); }
                __builtin_amdgcn_sched_barrier(0);
#pragma unroll
                for (int i = 0; i < 2; ++i) { const int jj = ch * 4 + 2 * i;
                    const f32x2v wlo = (f32x2v){W[i].x, W[i].y}, whi = (f32x2v){W[i].z, W[i].w}, blo = (f32x2v){Bq[i].x, Bq[i].y}, bhi = (f32x2v){Bq[i].z, Bq[i].w};
                    const f32x2v klo = (f32x2v){K[i].x, K[i].y}, khi = (f32x2v){K[i].z, K[i].w}, rlo = (f32x2v){R[i].x, R[i].y}, rhi = (f32x2v){R[i].z, R[i].w};
                    S0[jj] = S0[jj] * wlo + saa * blo + vv * klo; y2 += S0[jj] * rlo;
                    S0[jj + 1] = S0[jj + 1] * whi + saa * bhi + vv * khi; y3 += S0[jj + 1] * rhi;
                    if (IDENT) { S1[jj] = S1[jj] * wlo + sbb * blo; e2 += S1[jj] * rlo; S1[jj + 1] = S1[jj + 1] * whi + sbb * bhi; e3 += S1[jj + 1] * rhi; } }
                __builtin_amdgcn_sched_barrier(0); }
            YD[co[s]] = (y2.x + y2.y) + (y3.x + y3.y);
            if (IDENT) { const int tl = d ? (SEQ - 1 - (step0 - CTX + c * SCH + s)) : (step0 - CTX + c * SCH + s); E[(size_t)tl * 64 + lane] = f2bf((e2.x + e2.y) + (e3.x + e3.y)); }
        }
    }
    float* ZP = (float*)(P.ws + WS_ZP) + ((size_t)chain * NSEG + g) * 2 * 4096;
#pragma unroll
    for (int j = 0; j < 32; j += 2) { *(float4*)(ZP + lane * 64 + 2 * j) = make_float4(S0[j].x, S0[j].y, S0[j + 1].x, S0[j + 1].y);
        if (IDENT) *(float4*)(ZP + 4096 + lane * 64 + 2 * j) = make_float4(S1[j].x, S1[j].y, S1[j + 1].x, S1[j + 1].y); }
}
__device__ __forceinline__ void scan_combine(const Params& P, int chain, float* lds) {
    const int tid = otid(); const int i = tid >> 3, j0 = (tid & 7) * 8;
    float* Sl = lds;
    float* Pl = lds + 64 * 65;
    float* ZPc = (float*)(P.ws + WS_ZP) + (size_t)chain * NSEG * 2 * 4096;
    float sn[8];
#pragma unroll
    for (int q = 0; q < 8; ++q) sn[q] = ZPc[i * 64 + j0 + q];
    for (int g = 1; g < NSEG - 1; ++g) {
        __syncthreads();
#pragma unroll
        for (int q = 0; q < 8; ++q) Sl[i * 65 + j0 + q] = sn[q];
        const float* Pg = ZPc + (size_t)g * 2 * 4096 + 4096;
#pragma unroll
        for (int q = 0; q < 8; ++q) Pl[tid * 8 + q] = Pg[tid * 8 + q];
        float* Zg = ZPc + (size_t)g * 2 * 4096;
#pragma unroll
        for (int q = 0; q < 8; ++q) sn[q] = Zg[i * 64 + j0 + q];
        __syncthreads();
        for (int m = 0; m < 64; ++m) { const float sv = Sl[i * 65 + m]; const float4 p0 = *(const float4*)(Pl + m * 64 + j0), p1 = *(const float4*)(Pl + m * 64 + j0 + 4);
            sn[0] += sv * p0.x; sn[1] += sv * p0.y; sn[2] += sv * p0.z; sn[3] += sv * p0.w; sn[4] += sv * p1.x; sn[5] += sv * p1.y; sn[6] += sv * p1.z; sn[7] += sv * p1.w; }
#pragma unroll
        for (int q = 0; q < 8; ++q) Zg[i * 64 + j0 + q] = sn[q];
    }
    __syncthreads();
}

__device__ __forceinline__ void rwkv_out_fin(const Params& P, int row, int c, float y, float lnw, float lnb, float bon, float vs, float gt) {
    bf16_t* MIX = (bf16_t*)(P.ws + WS_U);
    const float mean = wsum(y) * (1.0f / 64.0f); const float dv = y - mean; const float var = wsum(dv * dv) * (1.0f / 64.0f);
    const float yn = dv * rsqrtf(var + 64e-5f) * lnw + lnb;
    MIX[(size_t)row * D + 256 + c] = f2bf((yn + bon * vs) * gt);
}
__device__ __forceinline__ void ph_rwkvout(const Params& P, int l, float* ldsf) {
    using pg8::bf16x8;
    const int tid = otid(), lane = tid & 63, fr = lane & 15, fq = lane >> 4, wv = tid >> 6, gw = blockIdx.x * NWAVE + wv, nw = gridDim.x * NWAVE;
    const float* YD = (const float*)(P.ws + WS_YDIR); const bf16_t* VS = (const bf16_t*)(P.ws + WS_VS); const bf16_t* GT = (const bf16_t*)(P.ws + WS_GATE); const float* BON = (const float*)(P.ws + WS_BONUS);
    bf16_t* MIX = (bf16_t*)(P.ws + WS_U);
    for (int it = gw; it < NB * 6 * 32 * 4; it += nw) {
        const int sub = it & 3, q = (it >> 2) & 31, h = (it >> 7) % 6, b = it / (128 * 6);
        const int t0 = q * 256 + sub * 64;
        f32x4 acc[4][4];
#pragma unroll
        for (int mt = 0; mt < 4; ++mt)
#pragma unroll
            for (int nt = 0; nt < 4; ++nt) acc[mt][nt] = (f32x4){0.f, 0.f, 0.f, 0.f};
#pragma unroll
        for (int dir = 0; dir < 2; ++dir) { const int ch = b * 12 + h * 2 + dir, slot = dir ? (31 - q) : q;
            const float* Sp = (const float*)(P.ws + WS_ZP) + ((size_t)ch * NSEG + slot) * 2 * 4096;
            const bf16_t* Ep = (const bf16_t*)(P.ws + WS_E) + ((size_t)ch * SEQ + t0) * 64;
#pragma unroll
            for (int ks = 0; ks < 2; ++ks) { bf16x8 bop[4];
#pragma unroll
                for (int nt = 0; nt < 4; ++nt) { const float* sp = Sp + (nt * 16 + fr) * 64 + ks * 32 + fq * 8; const float4 s0 = *(const float4*)sp, s1 = *(const float4*)(sp + 4);
                    u32x4 w; w.x = cvt_pk_bf16(s0.x, s0.y); w.y = cvt_pk_bf16(s0.z, s0.w); w.z = cvt_pk_bf16(s1.x, s1.y); w.w = cvt_pk_bf16(s1.z, s1.w); bop[nt] = __builtin_bit_cast(bf16x8, w); }
#pragma unroll
                for (int mt = 0; mt < 4; ++mt) { const bf16x8 a = *(const bf16x8*)(Ep + (size_t)(mt * 16 + fr) * 64 + ks * 32 + fq * 8);
#pragma unroll
                    for (int nt = 0; nt < 4; ++nt) acc[mt][nt] = __builtin_amdgcn_mfma_f32_16x16x32_bf16(a, bop[nt], acc[mt][nt], 0, 0, 0); } } }
        float lnw[4], lnb[4];
#pragma unroll
        for (int nt = 0; nt < 4; ++nt) { lnw[nt] = P.in[I_LNW][l * RWW + h * 64 + nt * 16 + fr]; lnb[nt] = P.in[I_LNB][l * RWW + h * 64 + nt * 16 + fr]; }
#pragma unroll
        for (int mt = 0; mt < 4; ++mt)
#pragma unroll
            for (int rg = 0; rg < 4; ++rg) { const int row = b * SEQ + t0 + mt * 16 + fq * 4 + rg; const size_t o = (size_t)row * 384 + h * 64 + fr;
                float y[4], vs[4], gt[4]; const float bon = BON[(size_t)row * 6 + h];
#pragma unroll
                for (int nt = 0; nt < 4; ++nt) { y[nt] = YD[o + nt * 16] + YD[(size_t)T * 384 + o + nt * 16] + acc[mt][nt][rg]; vs[nt] = bf2f(VS[o + nt * 16]); gt[nt] = bf2f(GT[o + nt * 16]); }
                float sm = (y[0] + y[1]) + (y[2] + y[3]);
                sm += __shfl_xor(sm, 1); sm += __shfl_xor(sm, 2); sm += __shfl_xor(sm, 4); sm += __shfl_xor(sm, 8);
                const float mean = sm * (1.0f / 64.0f);
                float vr = 0.f;
#pragma unroll
                for (int nt = 0; nt < 4; ++nt) { y[nt] -= mean; vr += y[nt] * y[nt]; }
                vr += __shfl_xor(vr, 1); vr += __shfl_xor(vr, 2); vr += __shfl_xor(vr, 4); vr += __shfl_xor(vr, 8);
                const float rstd = rsqrtf(vr * (1.0f / 64.0f) + 64e-5f);
#pragma unroll
                for (int nt = 0; nt < 4; ++nt) MIX[(size_t)row * D + 256 + h * 64 + nt * 16 + fr] = f2bf((y[nt] * rstd * lnw[nt] + lnb[nt] + bon * vs[nt]) * gt[nt]);
                if (rg & 1) asm volatile("" ::: "memory"); }
    }
    for (int it = gw; it < TC * 6; it += nw) { const int row = TL + it / 6, h = it % 6, c = h * 64 + lane; const size_t o = (size_t)row * 384 + c;
        rwkv_out_fin(P, row, c, YD[o] + YD[(size_t)T * 384 + o], P.in[I_LNW][l * RWW + c], P.in[I_LNB][l * RWW + c], BON[(size_t)row * 6 + h], bf2f(VS[o]), bf2f(GT[o])); }
}

typedef const __attribute__((address_space(4))) Params* KParamsPtr;
__device__ __forceinline__ const Params* fresh_params() { KParamsPtr q = (KParamsPtr)__builtin_amdgcn_kernarg_segment_ptr(); asm volatile("" : "+s"(q)); return (const Params*)q; }
__global__ void __launch_bounds__(NTHR, 2) fwd_megakernel(Params P_unused, int ph_lo, int ph_hi) {
    extern __shared__ __attribute__((aligned(16))) unsigned char smem[];
    cg::grid_group grid = cg::this_grid();
    LAS unsigned char* lds3 = (LAS unsigned char*)smem;
    float* ldsf = (float*)smem; float2* X = (float2*)smem; float* ex = (float*)(smem + LDS_MAIN);
    { volatile LAS unsigned* st = (volatile LAS unsigned*)(lds3 + LDS_MAIN + 4096); if (threadIdx.x == 0) { st[0] = 0u; st[1] = 0u; } }
    __syncthreads();
    XcdBarrier xbar = xcd_barrier_post((unsigned*)(((const Params*)fresh_params())->ws + WS_BAR), (volatile LAS unsigned*)(lds3 + LDS_MAIN + 4096));
    int ph = 0;
#ifndef REP_GEMM
#define REP_GEMM 1
#endif
#ifndef REP_SCAN
#define REP_SCAN 1
#endif
#ifndef REP_MISC
#define REP_MISC 1
#endif
#ifndef REP_HY
#define REP_HY 1
#endif
#define PHASE_BEGIN if (ph >= ph_lo && ph < ph_hi) { const Params& P = *fresh_params(); unsigned char* ws = P.ws; (void)ws;
#ifndef REP_SYNC
#define REP_SYNC 1
#endif
#define PHASE_END   if (ph + 1 < ph_hi) { for (int rs_ = 0; rs_ < REP_SYNC; ++rs_) { if (ph == 0) grid.sync(); else xcd_barrier(xbar); } } } ++ph;
    PHASE_BEGIN ph_modv(P, ldsf); PHASE_END
    for (int l = 0; l < DEPTH; ++l) {
        PHASE_BEGIN
            for (int rep_ = 0; rep_ < REP_MISC; ++rep_) ph_prep(P, l, ldsf);
            if (l == 0) ph_rowpass(P, 0, 0, 0, 0, 0.f, 0, 0, 0, 1);
            else ph_rowpass(P, 1, l - 1, 8, 5, 0.5f, l, 0, 0, 1);
        PHASE_END
        PHASE_BEGIN { EpiGU E{(bf16_t*)(ws + WS_ACT)}; for (int rep_ = 0; rep_ < REP_GEMM; ++rep_) run_gemm(lds3, (const bf16_t*)(ws + WS_U), (const bf16_t*)(ws + WS_WGU1), T, 2 * DFF, D, E); } PHASE_END
        PHASE_BEGIN { EpiF32 E{(float*)(ws + WS_Y)}; for (int rep_ = 0; rep_ < REP_GEMM; ++rep_) run_gemm(lds3, (const bf16_t*)(ws + WS_ACT), (const bf16_t*)(ws + WS_WDN1), T, D, DFF, E); } PHASE_END
        PHASE_BEGIN ph_rowpass(P, 1, l, 2, 1, 0.5f, l, 2, 3, 4); PHASE_END
        PHASE_BEGIN { EpiWin E{(bf16_t*)(ws + WS_PHY), (bf16_t*)(ws + WS_PRW), (bf16_t*)(ws + WS_PNA)}; for (int rep_ = 0; rep_ < REP_GEMM; ++rep_) run_gemm(lds3, (const bf16_t*)(ws + WS_U), (const bf16_t*)(ws + WS_WIN), T, INWP, D, E); } PHASE_END
        PHASE_BEGIN
            for (int rep_ = 0; rep_ < REP_MISC; ++rep_) { ph_loraprep(P, l);
            for (int it = blockIdx.x; it < NB * 128 * 6 + NB * 4 * 6; it += gridDim.x) vt_tile(P, it, (unsigned short*)smem); }
            for (int rep_ = 0; rep_ < REP_HY; ++rep_) for (int it = blockIdx.x; it < 512; it += gridDim.x) hy_spec_task(P, l, it >> 8, it & 255, X, ex);
        PHASE_END
        PHASE_BEGIN { EpiLora E{(bf16_t*)(ws + WS_LORAO), (bf16_t*)(ws + WS_GATE)};
            for (int rep_ = 0; rep_ < REP_GEMM; ++rep_) run_gemm(lds3, (const bf16_t*)(ws + WS_ALORA), (const bf16_t*)(ws + WS_WLORA), T, 2048, 384, E); } PHASE_END
        PHASE_BEGIN
            for (int rep_ = 0; rep_ < REP_MISC; ++rep_) ph_rwkvprep(P, l);
            for (int rep_ = 0; rep_ < REP_HY; ++rep_) for (int c = blockIdx.x; c < HYC; c += gridDim.x) hy_task1(P, l, c, X, ex);
        PHASE_END
        PHASE_BEGIN {
            const int wv = __builtin_amdgcn_readfirstlane(otid() >> 6);
            if (wv < 4) { const int k = wv * (int)gridDim.x + (int)blockIdx.x;
                if (k < 24 * NSEG) { const int chain = k / NSEG, g = k % NSEG; float* ring = ldsf + wv * (SCH * 320);
                    for (int rep_ = 0; rep_ < REP_SCAN; ++rep_) { if (g == 0) scan_seg<false>(P, chain, g, ring); else scan_seg<true>(P, chain, g, ring); } } }
            else for (int it = (wv - 4) * (int)gridDim.x + (int)blockIdx.x; it < NAT_TASKS; it += 4 * (int)gridDim.x) natten_task(P, l, it);
        } PHASE_END
        PHASE_BEGIN
            if (blockIdx.x < 24) scan_combine(P, blockIdx.x, ldsf);
            else for (int rep_ = 0; rep_ < REP_HY; ++rep_) for (int c = blockIdx.x - 24; c < HYC; c += gridDim.x - 24) hy_task2(P, l, c, X);
        PHASE_END
        PHASE_BEGIN for (int rep_ = 0; rep_ < REP_MISC; ++rep_) ph_rwkvout(P, l, ldsf); PHASE_END
        PHASE_BEGIN { EpiF32 E{(float*)(ws + WS_Y)}; for (int rep_ = 0; rep_ < REP_GEMM; ++rep_) run_gemm(lds3, (const bf16_t*)(ws + WS_U), (const bf16_t*)(ws + WS_WOUT), T, D, D, E); } PHASE_END
        PHASE_BEGIN ph_rowpass(P, 1, l, 5, 3, 1.0f, l, 4, 6, 7); PHASE_END
        PHASE_BEGIN { EpiGU E{(bf16_t*)(ws + WS_ACT)}; for (int rep_ = 0; rep_ < REP_GEMM; ++rep_) run_gemm(lds3, (const bf16_t*)(ws + WS_U), (const bf16_t*)(ws + WS_WGU2), T, 2 * DFF, D, E); } PHASE_END
        PHASE_BEGIN { EpiF32 E{(float*)(ws + WS_Y)}; for (int rep_ = 0; rep_ < REP_GEMM; ++rep_) run_gemm(lds3, (const bf16_t*)(ws + WS_ACT), (const bf16_t*)(ws + WS_WDN2), T, D, DFF, E); } PHASE_END
    }
    PHASE_BEGIN ph_rowpass(P, 2, DEPTH - 1, 8, 5, 0.5f, 0, 0, 0, 0); PHASE_END
#undef PHASE_BEGIN
#undef PHASE_END
}
constexpr int N_PHASES = 1 + DEPTH * 15 + 1;

extern "C" void kernel_launch(void* const* d_in, const int* in_sizes, int n_in, void* d_out, int out_size, void* d_ws, size_t ws_size, hipStream_t stream) {
    static int grid = 0;
    if (grid == 0) {
        if (n_in != 34 || ws_size < WS_END) { fprintf(stderr, "kernel_launch: need 34 inputs and %zu bytes of workspace; got %d, %zu\n", (size_t)WS_END, n_in, ws_size); grid = -1; return; }
        int dev = 0, cus = 0, per_cu = 0;
        hipGetDevice(&dev); hipDeviceGetAttribute(&cus, hipDeviceAttributeMultiprocessorCount, dev);
        if (hipFuncSetAttribute((const void*)fwd_megakernel, hipFuncAttributeMaxDynamicSharedMemorySize, LDS_BYTES) != hipSuccess) { fprintf(stderr, "kernel_launch: hipFuncSetAttribute failed\n"); grid = -1; return; }
        if (hipOccupancyMaxActiveBlocksPerMultiprocessor(&per_cu, (const void*)fwd_megakernel, NTHR, LDS_BYTES) != hipSuccess || per_cu < 1) { fprintf(stderr, "kernel_launch: occupancy query says %d\n", per_cu); per_cu = 1; }
        (void)hipGetLastError();
        grid = cus;
    }
    if (grid < 0) return;
    if (hipMemsetAsync((char*)d_ws + WS_BAR, 0, (size_t)XCD_BAR_WORDS * 4, stream) != hipSuccess) { fprintf(stderr, "kernel_launch: memset of the barrier words failed\n"); return; }
    Params p{};
    for (int i = 0; i < 34; ++i) p.in[i] = (const float*)d_in[i];
    p.out = (float*)d_out; p.ws = (unsigned char*)d_ws;
#if MK_SPLIT
    for (int ph = 0; ph < N_PHASES; ++ph) { int lo = ph, hi = ph + 1; hipLaunchKernelGGL(fwd_megakernel, dim3(grid), dim3(NTHR), LDS_BYTES, stream, p, lo, hi); }
#else
    int lo = 0, hi = N_PHASES;
    void* args[] = {&p, &lo, &hi};
    hipError_t e = hipLaunchCooperativeKernel((const void*)fwd_megakernel, dim3(grid), dim3(NTHR), args, LDS_BYTES, stream);
    if (e != hipSuccess) fprintf(stderr, "cooperative launch failed: %s (grid %d)\n", hipGetErrorString(e), grid);
#endif
}
```

```cpp
#include <hip/hip_runtime.h>
#include <hip/hip_cooperative_groups.h>
#include <cstdio>
namespace cg = cooperative_groups;
__device__ __forceinline__ int otid() { int t = threadIdx.x; asm volatile("" : "+v"(t)); return t; }
namespace pg8 {
#define PG8_LAS __attribute__((address_space(3)))
typedef unsigned short bf16_t;
typedef short bf16x8 __attribute__((ext_vector_type(8)));
typedef float f32x4 __attribute__((ext_vector_type(4)));
typedef unsigned u32x4 __attribute__((ext_vector_type(4)));
constexpr int BM = 256, BK = 64, HALF = 128, HTB = HALF * BK * 2  , STAGE_BYTES = 8 * HTB, NXCD = 8, WGM = 8;

__host__ __device__ __forceinline__ int lds_byte(int r, int c) { const int st = (r >> 4) * 2 + (c >> 5), rr = r & 15, cc = c & 31, ob = rr * 64 + cc * 2; return st * 1024 + (ob ^ (((ob >> 9) & 1) << 5)); }
__host__ __device__ __forceinline__ void stage_rc(int b, int& R, int& C) { const int st = b / 1024, sb = b % 1024, swz = sb ^ (((sb >> 9) & 1) << 5); R = (st >> 1) * 16 + swz / 64; C = (st & 1) * 32 + (swz % 64) / 2; }
__host__ __device__ __forceinline__ int perm32(int rho) { const int n = rho >> 4, i = rho & 15; return 8 * (i >> 2) + 4 * n + (i & 3); }

struct Unit { int pm, pn; };
struct Gemm { const bf16_t* A; const bf16_t* Bt; int M, N, K; };
struct StaticOrder {
    int nM, nN, nwg, G, c;
    __host__ __device__ void init(int M, int N, int G_, int c_) { nM = M / BM; nN = N / BM; nwg = nM * nN; G = G_; c = c_; }
    __host__ __device__ bool next(int i, Unit& u) const {
        const long L = (long)i * G + c; if (L >= nwg) return false;
        int wgid = (int)L; { const int q = nwg / NXCD, r = nwg % NXCD, xcd = wgid % NXCD, off = wgid / NXCD; wgid = (xcd < r ? xcd * (q + 1) : r * (q + 1) + (xcd - r) * q) + off; }
        const int nig = WGM * nN, gid = wgid / nig, fm = gid * WGM, gsz = (nM - fm) < WGM ? (nM - fm) : WGM;
        u.pm = fm + ((wgid % nig) % gsz); u.pn = (wgid % nig) / gsz; return true;
    }
    __device__ __forceinline__ void a_ready(const Unit&) const {}
    __device__ __forceinline__ void done(const Unit&) const {}
};
__device__ __forceinline__ unsigned cvt_pk_bf16(float lo, float hi) { unsigned r; asm volatile("v_cvt_pk_bf16_f32 %0, %1, %2" : "=v"(r) : "v"(lo), "v"(hi)); return r; }
template <class Epi, class Sched>
__device__ __forceinline__ void gemm_phase(PG8_LAS unsigned char* lds, const Gemm g, const Sched& S, const Epi& E) {
    const int tid = otid(), wid = __builtin_amdgcn_readfirstlane(tid >> 6), lane = tid & 63, wr = wid >> 2, wc = wid & 3, fr = lane & 15, fq = lane >> 4;
    const int K = g.K, nt = K / BK;
#define PG8_STAMP() do {} while (0)
    unsigned voffA[2], voffB[2];
#pragma unroll
    for (int i = 0; i < 2; ++i) { int R, C; stage_rc(tid * 16 + i * 8192, R, C); const int Rb = Epi::PERM ? ((R & ~31) + perm32(R & 31)) : R;
        voffA[i] = (unsigned)(R * K + C) * 2u; voffB[i] = (unsigned)(Rb * K + C) * 2u; }
    const size_t kstep = (size_t)(BK * 2);
    const size_t hstep = (size_t)HALF * K * 2;
    const size_t tstep = 2 * hstep;
    const unsigned ldsw = (unsigned)wid * 1024u;
    const int aoff = lds_byte(wr * 64 + fr, fq * 8), boff = lds_byte(wc * 32 + fr, fq * 8);
#define PG8_SA(b, h) (((b) * 2 + (h)) * HTB)
#define PG8_SB(b, h) ((4 + (b) * 2 + (h)) * HTB)
#define PG8_STAGE(bufoff, gbase, voff) do { _Pragma("unroll") for (int _i = 0; _i < 2; ++_i) \
        __builtin_amdgcn_global_load_lds((const unsigned*)((const char*)(gbase) + (voff)[_i]), (PG8_LAS unsigned*)(lds + (bufoff) + ldsw + _i * 8192), 16, 0, 0); } while (0)
#define PG8_LDA(dst, b, h) do { _Pragma("unroll") for (int m = 0; m < 4; ++m) _Pragma("unroll") for (int k = 0; k < 2; ++k) dst[m][k] = *(const PG8_LAS bf16x8*)(lds + PG8_SA(b, h) + aoff + m * 2048 + k * 1024); } while (0)
#define PG8_LDB(dst, b, h) do { _Pragma("unroll") for (int n = 0; n < 2; ++n) _Pragma("unroll") for (int k = 0; k < 2; ++k) dst[n][k] = *(const PG8_LAS bf16x8*)(lds + PG8_SB(b, h) + boff + n * 2048 + k * 1024); } while (0)
#define PG8_MMA(ai, bj, At, Bt) do { __builtin_amdgcn_s_setprio(1); _Pragma("unroll") for (int m = 0; m < 4; ++m) _Pragma("unroll") for (int n = 0; n < 2; ++n) _Pragma("unroll") for (int k = 0; k < 2; ++k) \
        acc[ai][bj][m][n] = __builtin_amdgcn_mfma_f32_16x16x32_bf16(Bt[n][k], At[m][k], acc[ai][bj][m][n], 0, 0, 0); __builtin_amdgcn_s_setprio(0); } while (0)
#define PG8_WAIT_V(n) asm volatile("s_waitcnt vmcnt(" #n ")" ::: "memory")
#define PG8_WAIT_L(n) asm volatile("s_waitcnt lgkmcnt(" #n ")" ::: "memory")
#define PG8_BAR __builtin_amdgcn_s_barrier()
#define PG8_SCHED __builtin_amdgcn_sched_barrier(0)
    Unit cur, nxt; int ui = 0;
    if (!S.next(0, cur)) return;
    f32x4 acc[2][2][4][2];
#pragma unroll
    for (int a = 0; a < 2; ++a)
#pragma unroll
        for (int b = 0; b < 2; ++b)
#pragma unroll
            for (int m = 0; m < 4; ++m)
#pragma unroll
                for (int n = 0; n < 2; ++n) acc[a][b][m][n] = (f32x4){0.f, 0.f, 0.f, 0.f};
    bf16x8 At[4][2], B0[2][2], B1[2][2];
    const char* cA = (const char*)g.A + (size_t)cur.pm * tstep; const char* cB = (const char*)g.Bt + (size_t)cur.pn * tstep;
    S.a_ready(cur);
    PG8_STAGE(PG8_SB(0, 0), cB, voffB); PG8_STAGE(PG8_SA(0, 0), cA, voffA); PG8_STAGE(PG8_SB(0, 1), cB + hstep, voffB); PG8_STAGE(PG8_SA(0, 1), cA + hstep, voffA);
    if (wr == 1) PG8_BAR;
    PG8_WAIT_V(4); PG8_BAR;
    PG8_STAGE(PG8_SB(1, 0), cB + kstep, voffB); PG8_STAGE(PG8_SA(1, 0), cA + kstep, voffA); PG8_STAGE(PG8_SB(1, 1), cB + hstep + kstep, voffB);
    PG8_WAIT_V(6); PG8_BAR;
    PG8_STAMP();
    for (;;) {
        const bool has_next = S.next(ui + 1, nxt);
        const char* nA = has_next ? (const char*)g.A + (size_t)nxt.pm * tstep : cA; const char* nB = has_next ? (const char*)g.Bt + (size_t)nxt.pn * tstep : cB;
        for (int t = 0; t < nt; t += 2) {
            const bool last = (t == nt - 2);
            const char* a1 = cA + (size_t)(t + 1) * kstep;
            const char* a2 = last ? nA : cA + (size_t)(t + 2) * kstep; const char* b2 = last ? nB : cB + (size_t)(t + 2) * kstep;
            const char* a3 = a2 + kstep; const char* b3 = b2 + kstep;
            if (last && has_next) S.a_ready(nxt);
            PG8_LDB(B0, 0, 0); PG8_SCHED; PG8_LDA(At, 0, 0); PG8_STAGE(PG8_SA(1, 1), a1 + hstep, voffA);
            PG8_WAIT_L(8); PG8_BAR; PG8_WAIT_L(0); PG8_MMA(0, 0, At, B0); PG8_BAR; PG8_SCHED;
            PG8_LDB(B1, 0, 1); PG8_STAGE(PG8_SB(0, 0), b2, voffB);
            PG8_BAR; PG8_WAIT_L(0); PG8_MMA(0, 1, At, B1); PG8_BAR;
            PG8_LDA(At, 0, 1); PG8_STAGE(PG8_SA(0, 0), a2, voffA);
            PG8_BAR; PG8_WAIT_L(0); PG8_MMA(1, 0, At, B0); PG8_BAR; PG8_SCHED;
            PG8_STAGE(PG8_SB(0, 1), b2 + hstep, voffB);
            PG8_WAIT_V(6); PG8_BAR; PG8_MMA(1, 1, At, B1); PG8_BAR;
            PG8_LDB(B0, 1, 0); PG8_SCHED; PG8_LDA(At, 1, 0); PG8_STAGE(PG8_SA(0, 1), a2 + hstep, voffA);
            PG8_WAIT_L(8); PG8_BAR; PG8_WAIT_L(0); PG8_MMA(0, 0, At, B0); PG8_BAR; PG8_SCHED;
            PG8_LDB(B1, 1, 1); PG8_STAGE(PG8_SB(1, 0), b3, voffB);
            PG8_BAR; PG8_WAIT_L(0); PG8_MMA(0, 1, At, B1); PG8_BAR;
            PG8_LDA(At, 1, 1); PG8_STAGE(PG8_SA(1, 0), a3, voffA);
            PG8_BAR; PG8_WAIT_L(0); PG8_MMA(1, 0, At, B0); PG8_BAR; PG8_SCHED;
            PG8_STAGE(PG8_SB(1, 1), b3 + hstep, voffB);
            PG8_WAIT_V(6); PG8_BAR; PG8_MMA(1, 1, At, B1); PG8_BAR;
        }
        PG8_STAMP();
        if constexpr (!Epi::AFTER_DRAIN) { E(acc, cur, wr, wc, fr, fq); S.done(cur); }
        PG8_STAMP();
        if (!has_next) break;
#pragma unroll
        for (int a = 0; a < 2; ++a)
#pragma unroll
            for (int b = 0; b < 2; ++b)
#pragma unroll
                for (int m = 0; m < 4; ++m)
#pragma unroll
                    for (int n = 0; n < 2; ++n) acc[a][b][m][n] = (f32x4){0.f, 0.f, 0.f, 0.f};
        cur = nxt; cA = nA; cB = nB; ++ui;
    }
    PG8_WAIT_V(0);
    if (wr == 0) PG8_BAR;
    PG8_BAR;
    if constexpr (Epi::AFTER_DRAIN) { E.fused(acc, cur, wr, wc, fr, fq, lds, wid, lane); S.done(cur); }
    PG8_STAMP();
#undef PG8_STAMP
#undef PG8_SA
#undef PG8_SB
#undef PG8_STAGE
#undef PG8_LDA
#undef PG8_LDB
#undef PG8_MMA
#undef PG8_WAIT_V
#undef PG8_WAIT_L
#undef PG8_BAR
#undef PG8_SCHED
}
}
#define LAS __attribute__((address_space(3)))
#define XB_TMO      128
#define XB_XCNT(j)  (256  + 64 * (j))
#define XB_XSUB(j)  (1280 + 64 * (j))
#define XB_XGEN(j)  (2304 + 64 * (j))
#define XB_TOP      3328
#define XB_TOPGEN   3392
#define XCD_BAR_WORDS 3456
#define XB_SPIN_CAP (1u << 18)

__device__ __forceinline__ unsigned xb_ld(unsigned* p)              { return __hip_atomic_load(p, __ATOMIC_RELAXED, __HIP_MEMORY_SCOPE_AGENT); }
__device__ __forceinline__ unsigned xb_add(unsigned* p, unsigned v) { return __hip_atomic_fetch_add(p, v, __ATOMIC_RELAXED, __HIP_MEMORY_SCOPE_AGENT); }
__device__ __forceinline__ unsigned xb_xcc_id() { return (unsigned)__builtin_amdgcn_s_getreg((3 << 11) | 20) & 0xFu; }
#define XB_SPIN(cond, bar) do { unsigned _sp = 0; while (cond) { __builtin_amdgcn_s_sleep(1); \
    if ((++_sp & 255u) == 0u) { if (xb_ld(&(bar)[XB_TMO])) break; if (_sp > XB_SPIN_CAP) { atomicAdd(&(bar)[XB_TMO], 1u); break; } } } } while (0)

struct XcdBarrier {
    unsigned* bar; unsigned x;
    volatile LAS unsigned* st;
};

__device__ __forceinline__ XcdBarrier xcd_barrier_post(unsigned* bar, volatile LAS unsigned* st) {
    XcdBarrier b; b.bar = bar; b.x = xb_xcc_id(); b.st = st;
    if (threadIdx.x == 0) (void)xb_add(&bar[XB_XCNT(b.x)], 1u);
    return b;
}
__device__ __forceinline__ void xcd_barrier_complete(unsigned* bar, unsigned x, unsigned& nloc, unsigned& nx) {
    const unsigned G = gridDim.x * gridDim.y * gridDim.z;
    unsigned sum, cnt, mine, sp = 0u;
    for (;;) {
        sum = 0u; cnt = 0u; mine = 0u;
#pragma unroll
        for (unsigned j = 0; j < 16; ++j) { const unsigned c = xb_ld(&bar[XB_XCNT(j)]); sum += c; cnt += (c > 0u) ? 1u : 0u; mine = (j == x) ? c : mine; }
        if (sum == G) break;
        __builtin_amdgcn_s_sleep(1);
        if ((++sp & 255u) == 0u) { if (xb_ld(&bar[XB_TMO])) break; if (sp > XB_SPIN_CAP) { atomicAdd(&bar[XB_TMO], 1u); break; } }
    }
    nloc = mine > 0u ? mine : 1u; nx = cnt > 0u ? cnt : 1u;
}

__device__ __forceinline__ void xcd_barrier(const XcdBarrier& b) {
    asm volatile("s_waitcnt vmcnt(0)" ::: "memory");
    __syncthreads();
    if (threadIdx.x == 0) {
        unsigned* bar = b.bar;
        __builtin_amdgcn_s_waitcnt(0);
        unsigned nloc = b.st[0], nx = b.st[1];
        if (nloc == 0u) { xcd_barrier_complete(bar, b.x, nloc, nx); b.st[0] = nloc; b.st[1] = nx; }
        const unsigned old = xb_add(&bar[XB_XSUB(b.x)], 1u);
        const unsigned gen = old / nloc;
        if (old + 1u == (gen + 1u) * nloc) {
            __builtin_amdgcn_fence(__ATOMIC_RELEASE, "agent");
            asm volatile("s_waitcnt vmcnt(0)" ::: "memory");
            const unsigned og = xb_add(&bar[XB_TOP], 1u);
            const unsigned tg = og / nx;
            if (og + 1u == (tg + 1u) * nx) xb_add(&bar[XB_TOPGEN], 1u);
            else XB_SPIN(xb_ld(&bar[XB_TOPGEN]) == tg, bar);
            __builtin_amdgcn_fence(__ATOMIC_ACQUIRE, "agent");
            xb_add(&bar[XB_XGEN(b.x)], 1u);
            asm volatile("s_waitcnt vmcnt(0)" ::: "memory");
        } else {
            XB_SPIN(xb_ld(&bar[XB_XGEN(b.x)]) == gen, bar);
            __builtin_amdgcn_fence(__ATOMIC_ACQUIRE, "agent");
            asm volatile("s_waitcnt vmcnt(0)" ::: "memory");
        }
    }
    __syncthreads();
}

using pg8::bf16_t; using pg8::f32x4; using pg8::u32x4; using pg8::cvt_pk_bf16;
typedef unsigned u32x2 __attribute__((ext_vector_type(2)));


constexpr int D = 1024, NB = 2, SEQ = 8192, DEPTH = 4, CTX = 256, DFF = 2816;
constexpr int TL = NB * SEQ, TC = NB * CTX, T = TL + TC;
constexpr int NMOD = 9 * D;
constexpr int HYC = 256, RWW = 384, NAW = 384, INW = 3456, INWP = 3584;
constexpr int HY_IN = 768, RW_IN = 1536, NA_IN = 1152;
constexpr int NFFT = 16384;
constexpr int NTHR = 512, NWAVE = 8;
constexpr int LDS_MAIN = 131072, LDS_EXTRA = 8192, LDS_BYTES = LDS_MAIN + LDS_EXTRA;
constexpr float NORM_EPS = 1e-6f;

constexpr size_t al256(size_t x) { return (x + 255) & ~(size_t)255; }
constexpr size_t WS_MODV = 0;
constexpr size_t WS_WGU1 = al256(WS_MODV + (size_t)DEPTH * 3 * NMOD * 4);
constexpr size_t WS_WDN1 = WS_WGU1 + (size_t)2 * DFF * D * 2;
constexpr size_t WS_WGU2 = WS_WDN1 + (size_t)D * DFF * 2;
constexpr size_t WS_WDN2 = WS_WGU2 + (size_t)2 * DFF * D * 2;
constexpr size_t WS_WIN = WS_WDN2 + (size_t)D * DFF * 2;
constexpr size_t WS_WOUT = WS_WIN + (size_t)INWP * D * 2;
constexpr size_t WS_WLORA = WS_WOUT + (size_t)D * D * 2;
constexpr size_t WS_H = WS_WLORA + (size_t)2048 * 384 * 2;
constexpr size_t WS_U = WS_H + (size_t)T * D * 4;
constexpr size_t WS_S = WS_U + (size_t)T * D * 2;
constexpr size_t WS_Y = WS_S;
constexpr size_t WS_ACT = WS_Y + (size_t)T * D * 4;
constexpr size_t WS_FFN_END = WS_ACT + (size_t)T * DFF * 2;
constexpr size_t WS_PHY = WS_S;
constexpr size_t WS_PRW = WS_PHY + (size_t)T * HY_IN * 2;
constexpr size_t WS_YDIR = WS_PRW;
constexpr size_t WS_PNA = WS_PRW + (size_t)T * RW_IN * 2;
constexpr size_t WS_ALORA = WS_PNA + (size_t)T * NA_IN * 2;
constexpr size_t WS_DECAY = WS_ALORA + (size_t)T * 384 * 2;
constexpr size_t WS_LORAO = WS_DECAY + (size_t)2 * T * 384 * 4;
constexpr size_t WS_E = WS_LORAO;
constexpr size_t WS_ZP = WS_E + (size_t)24 * SEQ * 64 * 2;
constexpr size_t WS_GATE = WS_LORAO + (size_t)T * 1536 * 2;
static_assert(WS_ZP + (size_t)24 * 33 * 2 * 4096 * 4 <= WS_GATE, "E + ZP must fit in the LORAO region");
constexpr size_t WS_RS = WS_GATE + (size_t)T * 384 * 2;
constexpr size_t WS_KKS = WS_RS + (size_t)T * 384 * 2;
constexpr size_t WS_VS = WS_KKS + (size_t)T * 384 * 2;
constexpr size_t WS_KS = WS_VS + (size_t)T * 384 * 2;
constexpr size_t WS_BS = WS_KS + (size_t)2 * T * 384 * 2;
constexpr size_t WS_BONUS = WS_BS + (size_t)2 * T * 384 * 2;
constexpr size_t WS_FILT = al256(WS_BONUS + (size_t)T * 6 * 4);
constexpr size_t WS_FILTC = WS_FILT + (size_t)1024 * SEQ * 2;
constexpr size_t WS_SPEC = WS_FILTC + (size_t)1024 * CTX * 2;
constexpr size_t WS_Z1 = WS_SPEC + (size_t)512 * NFFT * 8;
constexpr size_t WS_VTL = WS_Z1 + (size_t)HYC * NB * SEQ * 4;
constexpr size_t WS_VTC = WS_VTL + (size_t)NB * 6 * 64 * SEQ * 2;
constexpr size_t WS_MIX_END = WS_VTC + (size_t)NB * 6 * 64 * CTX * 2;
constexpr size_t WS_BAR = al256(WS_MIX_END > WS_FFN_END ? WS_MIX_END : WS_FFN_END);
constexpr size_t WS_END = WS_BAR + (size_t)XCD_BAR_WORDS * 4;
static_assert(WS_END <= (size_t)4 * DEPTH * D * NMOD * 4, "workspace map exceeds 4x the largest input tensor");

struct Params { const float* in[34]; float* out; unsigned char* ws; };
enum { I_X = 0, I_C, I_CTX, I_CCTX, I_MODW, I_MODB, I_NORMG, I_F1GU, I_F1DN, I_F2GU, I_F2DN, I_WIN, I_WOUT, I_HCW, I_HCB, I_HW1, I_HB1, I_HW2, I_HB2, I_HW3, I_HFREQ, I_HBIAS,
       I_MU, I_W0, I_W2, I_A0, I_A2, I_G2, I_KK, I_KA, I_RK, I_LNW, I_LNB, I_RPB };

typedef LAS float* ldsfp;
__device__ __forceinline__ ldsfp vlds(const void* p) { ldsfp q = (ldsfp)p; asm volatile("" : "+v"(q)); return q; }
__device__ __forceinline__ float bf2f(bf16_t b) { return __uint_as_float(((unsigned)b) << 16); }
__device__ __forceinline__ bf16_t f2bf(float f) { unsigned u = __float_as_uint(f); u += 0x7FFFu + ((u >> 16) & 1u); return (bf16_t)(u >> 16); }
__device__ __forceinline__ float lo_bf(unsigned w) { return __uint_as_float(w << 16); }
__device__ __forceinline__ float hi_bf(unsigned w) { return __uint_as_float(w & 0xffff0000u); }
__device__ __forceinline__ float wsum(float v) {
#pragma unroll
    for (int o = 32; o > 0; o >>= 1) v += __shfl_xor(v, o);
    return v;
}
__device__ __forceinline__ float sigmoidf_(float x) { return __builtin_amdgcn_rcpf(1.0f + __expf(-x)); }
__device__ __forceinline__ void unpack8(const u32x4 w, float (&f)[8]) {
    f[0] = lo_bf(w.x); f[1] = hi_bf(w.x); f[2] = lo_bf(w.y); f[3] = hi_bf(w.y); f[4] = lo_bf(w.z); f[5] = hi_bf(w.z); f[6] = lo_bf(w.w); f[7] = hi_bf(w.w);
}
__device__ __forceinline__ void row_nbrs(int row, bool& hasp, bool& hasn) {
    if (row < TL) { const int t = row & (SEQ - 1); hasp = t > 0; hasn = t < SEQ - 1; }
    else { const int t = (row - TL) & (CTX - 1); hasp = t > 0; hasn = t < CTX - 1; }
}

__device__ __forceinline__ void ph_modv(const Params& P, float* lds) {
    const int tid = otid();
    float* sv = lds;
    float* red = lds + 3072;
    for (int i = tid; i < 3072; i += NTHR) { const int s = i >> 10, k = i & 1023; const float c = s < 2 ? P.in[I_C][s * 1024 + k] : P.in[I_CCTX][k]; sv[i] = c / (1.0f + expf(-c)); }
    __syncthreads();
    float* modv = (float*)(P.ws + WS_MODV);
    const int kc = tid >> 6, cl = tid & 63;
    for (int item = blockIdx.x; item < DEPTH * 144; item += gridDim.x) {
        const int l = item / 144, cb = item % 144, col = cb * 64 + cl;
        const float* w = P.in[I_MODW] + ((size_t)l * 1024 + kc * 128) * NMOD + col;
        float a0 = 0.f, a1 = 0.f, a2 = 0.f;
#pragma unroll 8
        for (int k = 0; k < 128; ++k) { const float wv = w[(size_t)k * NMOD]; a0 += sv[kc * 128 + k] * wv; a1 += sv[1024 + kc * 128 + k] * wv; a2 += sv[2048 + kc * 128 + k] * wv; }
        red[(0 * 8 + kc) * 64 + cl] = a0; red[(1 * 8 + kc) * 64 + cl] = a1; red[(2 * 8 + kc) * 64 + cl] = a2;
        __syncthreads();
        if (tid < 192) { const int s = tid >> 6, c = tid & 63; float r = P.in[I_MODB][l * NMOD + cb * 64 + c];
#pragma unroll
            for (int q = 0; q < 8; ++q) r += red[(s * 8 + q) * 64 + c];
            modv[((size_t)l * 3 + s) * NMOD + cb * 64 + c] = r; }
        __syncthreads();
    }
}

__device__ __forceinline__ float hy_delta(int c);
__device__ __forceinline__ int rowmap_gu(int n) { const int up = n >= DFF ? 1 : 0; const int j = n - up * DFF; return (j >> 7) * 256 + up * 128 + (j & 127); }
__device__ __forceinline__ void conv_tile(const float* __restrict__ src, int K, int N, bf16_t* __restrict__ dst, int tk, int tn, bool gu, float* tile) {
    const int tid = otid(); const int k0 = tk * 64, n0 = tn * 64;
#pragma unroll
    for (int rr = 0; rr < 2; ++rr) { const int kk = (tid >> 4) + rr * 32, n4 = (tid & 15) * 4; const float4 v = *(const float4*)(src + (size_t)(k0 + kk) * N + n0 + n4);
        tile[kk * 65 + n4 + 0] = v.x; tile[kk * 65 + n4 + 1] = v.y; tile[kk * 65 + n4 + 2] = v.z; tile[kk * 65 + n4 + 3] = v.w; }
    __syncthreads();
    { const int nn = tid >> 3, ks = (tid & 7) * 8; const int n = n0 + nn; const int row = gu ? rowmap_gu(n) : n;
      u32x4 w; w.x = cvt_pk_bf16(tile[(ks + 0) * 65 + nn], tile[(ks + 1) * 65 + nn]); w.y = cvt_pk_bf16(tile[(ks + 2) * 65 + nn], tile[(ks + 3) * 65 + nn]);
      w.z = cvt_pk_bf16(tile[(ks + 4) * 65 + nn], tile[(ks + 5) * 65 + nn]); w.w = cvt_pk_bf16(tile[(ks + 6) * 65 + nn], tile[(ks + 7) * 65 + nn]);
      *(u32x4*)(dst + (size_t)row * K + k0 + ks) = w; }
    __syncthreads();
}
__device__ __forceinline__ void ph_prep(const Params& P, int l, float* lds) {
    const int tid = otid();
    unsigned char* ws = P.ws;
    constexpr int N0 = 16 * 88, N1 = 44 * 16, N4 = 16 * 54, N5 = 16 * 16;
    constexpr int C0 = N0, C1 = C0 + N1, C2 = C1 + N0, C3 = C2 + N1, C4 = C3 + N4, C5 = C4 + N5;
    for (int it = blockIdx.x; it < C5; it += gridDim.x) {
        if (it < C0) { conv_tile(P.in[I_F1GU] + (size_t)l * D * 2 * DFF, D, 2 * DFF, (bf16_t*)(ws + WS_WGU1), it / 88, it % 88, true, lds); }
        else if (it < C1) { const int j = it - C0; conv_tile(P.in[I_F1DN] + (size_t)l * DFF * D, DFF, D, (bf16_t*)(ws + WS_WDN1), j / 16, j % 16, false, lds); }
        else if (it < C2) { const int j = it - C1; conv_tile(P.in[I_F2GU] + (size_t)l * D * 2 * DFF, D, 2 * DFF, (bf16_t*)(ws + WS_WGU2), j / 88, j % 88, true, lds); }
        else if (it < C3) { const int j = it - C2; conv_tile(P.in[I_F2DN] + (size_t)l * DFF * D, DFF, D, (bf16_t*)(ws + WS_WDN2), j / 16, j % 16, false, lds); }
        else if (it < C4) { const int j = it - C3; conv_tile(P.in[I_WIN] + (size_t)l * D * INW, D, INW, (bf16_t*)(ws + WS_WIN), j / 54, j % 54, false, lds); }
        else { const int j = it - C4; conv_tile(P.in[I_WOUT] + (size_t)l * D * D, D, D, (bf16_t*)(ws + WS_WOUT), j / 16, j % 16, false, lds); }
    }
    const int gtid = blockIdx.x * NTHR + tid, gn = gridDim.x * NTHR;
    { unsigned* z = (unsigned*)(ws + WS_WIN + (size_t)INW * D * 2); for (int i = gtid; i < (INWP - INW) * D / 2; i += gn) z[i] = 0u; }
    { bf16_t* wl = (bf16_t*)(ws + WS_WLORA);
      const float* w2 = P.in[I_W2] + (size_t)l * 2 * 64 * RWW; const float* a2 = P.in[I_A2] + (size_t)l * 2 * 64 * RWW; const float* g2 = P.in[I_G2] + (size_t)l * 128 * RWW;
      for (int i = gtid; i < 2048 * 384; i += gn) { const int k = i / 2048, j = i % 2048; float v = 0.f;
          if (j < 1920) { const int grp = j / 384, c = j % 384;
              if (grp == 0) { if (k < 64) v = w2[(size_t)k * RWW + c]; }
              else if (grp == 1) { if (k >= 64 && k < 128) v = w2[(size_t)(64 + k - 64) * RWW + c]; }
              else if (grp == 2) { if (k >= 128 && k < 192) v = a2[(size_t)(k - 128) * RWW + c]; }
              else if (grp == 3) { if (k >= 192 && k < 256) v = a2[(size_t)(64 + k - 192) * RWW + c]; }
              else { if (k >= 256) v = g2[(size_t)(k - 256) * RWW + c]; } }
          wl[(size_t)j * 384 + k] = f2bf(v); } }
    { const float* w1_ = P.in[I_HW1] + (size_t)l * 33 * 64; const float* b1 = P.in[I_HB1] + l * 64; const float* w2f_ = P.in[I_HW2] + (size_t)l * 64 * 64; const float* b2 = P.in[I_HB2] + l * 64;
      const float* fqv = P.in[I_HFREQ] + l * 64; const float* w3 = P.in[I_HW3] + (size_t)l * 64 * 1024;
      const int lane = tid & 63, wv = tid >> 6;
      const float fq = fqv[lane], bb1 = b1[lane], bb2 = b2[lane];
      const ldsfp hl = vlds(lds);
      for (int task = blockIdx.x; task < 264; task += gridDim.x) {
          const int L = task < 256 ? SEQ : CTX, n0 = task < 256 ? task * 32 : (task - 256) * 32;
          __syncthreads();
#pragma unroll 1
          for (int pp = 0; pp < 4; ++pp) { const int p = wv * 4 + pp, pos = n0 + p;
              const float* w1 = w1_; const float* w2f = w2f_; asm volatile("" : "+s"(w1), "+s"(w2f));
              const float tt = (float)pos / (float)(L - 1);
              const float ang = 6.283185307179586f * (float)pos / (float)L;
              float z = 0.f;
              if (lane == 0) z = tt;
              else if (lane <= 16) { const float fr = 1e-4f + (float)(lane - 1) * ((15.0f - 1e-4f) / 15.0f); z = cosf(fr * ang); }
              else if (lane <= 32) { const float fr = 1e-4f + (float)(lane - 17) * ((15.0f - 1e-4f) / 15.0f); z = -sinf(fr * ang); }
              float a = bb1;
#pragma unroll
              for (int e = 0; e < 33; ++e) a += __shfl(z, e) * w1[e * 64 + lane];
              const float h1 = sinf(fq * a);
              float c = bb2;
#pragma unroll
              for (int i = 0; i < 64; ++i) c += __shfl(h1, i) * w2f[i * 64 + lane];
              hl[lane * 32 + p] = sinf(fq * c); }
          __syncthreads();
          float acc0[32], acc1[32];
#pragma unroll
          for (int p = 0; p < 32; ++p) { acc0[p] = 0.f; acc1[p] = 0.f; }
#pragma unroll 2
          for (int i = 0; i < 64; ++i) { const float wa = w3[(size_t)i * 1024 + tid], wb = w3[(size_t)i * 1024 + 512 + tid];
#pragma unroll
              for (int p4 = 0; p4 < 8; ++p4) { const f32x4 hv = *(const LAS f32x4*)(hl + i * 32 + p4 * 4);
                  acc0[p4 * 4 + 0] += hv.x * wa; acc0[p4 * 4 + 1] += hv.y * wa; acc0[p4 * 4 + 2] += hv.z * wa; acc0[p4 * 4 + 3] += hv.w * wa;
                  acc1[p4 * 4 + 0] += hv.x * wb; acc1[p4 * 4 + 1] += hv.y * wb; acc1[p4 * 4 + 2] += hv.z * wb; acc1[p4 * 4 + 3] += hv.w * wb; } }
          const float dl = hy_delta(tid & 255), sc = task < 256 ? (1.0f / NFFT) : 1.0f, invL = 1.0f / (float)(L - 1);
          bf16_t* dst = task < 256 ? (bf16_t*)(ws + WS_FILT) + (size_t)tid * SEQ + n0 : (bf16_t*)(ws + WS_FILTC) + (size_t)tid * CTX + n0;
          const size_t cstep = task < 256 ? (size_t)512 * SEQ : (size_t)512 * CTX;
#pragma unroll
          for (int p8 = 0; p8 < 4; ++p8) { float d[8];
#pragma unroll
              for (int k = 0; k < 8; ++k) d[k] = __expf(-((float)(n0 + p8 * 8 + k) * invL) * dl) * sc;
              u32x4 w; w.x = cvt_pk_bf16(acc0[p8 * 8 + 0] * d[0], acc0[p8 * 8 + 1] * d[1]); w.y = cvt_pk_bf16(acc0[p8 * 8 + 2] * d[2], acc0[p8 * 8 + 3] * d[3]);
              w.z = cvt_pk_bf16(acc0[p8 * 8 + 4] * d[4], acc0[p8 * 8 + 5] * d[5]); w.w = cvt_pk_bf16(acc0[p8 * 8 + 6] * d[6], acc0[p8 * 8 + 7] * d[7]);
              *(u32x4*)(dst + p8 * 8) = w;
              w.x = cvt_pk_bf16(acc1[p8 * 8 + 0] * d[0], acc1[p8 * 8 + 1] * d[1]); w.y = cvt_pk_bf16(acc1[p8 * 8 + 2] * d[2], acc1[p8 * 8 + 3] * d[3]);
              w.z = cvt_pk_bf16(acc1[p8 * 8 + 4] * d[4], acc1[p8 * 8 + 5] * d[5]); w.w = cvt_pk_bf16(acc1[p8 * 8 + 6] * d[6], acc1[p8 * 8 + 7] * d[7]);
              *(u32x4*)(dst + cstep + p8 * 8) = w; }
      }
      __syncthreads(); }
}

__device__ __forceinline__ void ph_rowpass(const Params& P, int mode, int lpost, int gate_i, int gpost_i, float ps, int lpre, int gpre_i, int shift_i, int scale_i) {
    const int tid = otid(), lane = tid & 63, gw = blockIdx.x * NWAVE + (tid >> 6), nw = gridDim.x * NWAVE;
    const float* modv = (const float*)(P.ws + WS_MODV);
    float* H = (float*)(P.ws + WS_H); const bf16_t* Y = (const bf16_t*)(P.ws + WS_Y); bf16_t* U = (bf16_t*)(P.ws + WS_U);
    int cur_s = -1;
    float4 A[4], Bv[4], Cv[4];
#pragma unroll
    for (int j = 0; j < 4; ++j) { A[j] = make_float4(0.f, 0.f, 0.f, 0.f); Bv[j] = A[j]; Cv[j] = A[j]; }
    for (int row = gw; row < T; row += nw) {
        const int s = row < SEQ ? 0 : (row < TL ? 1 : 2);
        if (s != cur_s) { cur_s = s;
#pragma unroll
            for (int j = 0; j < 4; ++j) { const int e = lane * 4 + 256 * j;
                if (mode != 0) { const float4 g = *(const float4*)(modv + ((size_t)lpost * 3 + s) * NMOD + gate_i * D + e); const float4 gp = *(const float4*)(P.in[I_NORMG] + ((size_t)lpost * 6 + gpost_i) * D + e);
                    A[j] = make_float4(ps * g.x * gp.x, ps * g.y * gp.y, ps * g.z * gp.z, ps * g.w * gp.w); }
                if (mode != 2) { const float4 sc = *(const float4*)(modv + ((size_t)lpre * 3 + s) * NMOD + scale_i * D + e); const float4 gq = *(const float4*)(P.in[I_NORMG] + ((size_t)lpre * 6 + gpre_i) * D + e);
                    Bv[j] = make_float4(gq.x * (1.f + sc.x), gq.y * (1.f + sc.y), gq.z * (1.f + sc.z), gq.w * (1.f + sc.w));
                    Cv[j] = *(const float4*)(modv + ((size_t)lpre * 3 + s) * NMOD + shift_i * D + e); } } }
        float4 h[4];
        if (mode == 0) { const float* src = row < TL ? P.in[I_X] + (size_t)row * D : P.in[I_CTX] + (size_t)(row - TL) * D;
#pragma unroll
            for (int j = 0; j < 4; ++j) h[j] = *(const float4*)(src + lane * 4 + 256 * j);
        } else {
            float4 y[4]; float ss = 0.f;
#pragma unroll
            for (int j = 0; j < 4; ++j) { h[j] = *(const float4*)(H + (size_t)row * D + lane * 4 + 256 * j); { const u32x2 yw = *(const u32x2*)(Y + (size_t)row * D + lane * 4 + 256 * j); y[j] = make_float4(lo_bf(yw.x), hi_bf(yw.x), lo_bf(yw.y), hi_bf(yw.y)); }
                ss += y[j].x * y[j].x + y[j].y * y[j].y + y[j].z * y[j].z + y[j].w * y[j].w; }
            ss = wsum(ss); const float r = rsqrtf(ss * (1.0f / D) + NORM_EPS);
#pragma unroll
            for (int j = 0; j < 4; ++j) { h[j].x += A[j].x * (y[j].x * r); h[j].y += A[j].y * (y[j].y * r); h[j].z += A[j].z * (y[j].z * r); h[j].w += A[j].w * (y[j].w * r); }
        }
        if (mode == 2) { if (row < TL) {
#pragma unroll
                for (int j = 0; j < 4; ++j) *(float4*)(P.out + (size_t)row * D + lane * 4 + 256 * j) = h[j]; }
            continue; }
        float s2 = 0.f;
#pragma unroll
        for (int j = 0; j < 4; ++j) { *(float4*)(H + (size_t)row * D + lane * 4 + 256 * j) = h[j]; s2 += h[j].x * h[j].x + h[j].y * h[j].y + h[j].z * h[j].z + h[j].w * h[j].w; }
        s2 = wsum(s2); const float r2 = rsqrtf(s2 * (1.0f / D) + NORM_EPS);
#pragma unroll
        for (int j = 0; j < 4; ++j) { u32x2 w; w.x = cvt_pk_bf16(h[j].x * r2 * Bv[j].x + Cv[j].x, h[j].y * r2 * Bv[j].y + Cv[j].y); w.y = cvt_pk_bf16(h[j].z * r2 * Bv[j].z + Cv[j].z, h[j].w * r2 * Bv[j].w + Cv[j].w);
            *(u32x2*)(U + (size_t)row * D + lane * 4 + 256 * j) = w; }
    }
}

struct EpiGU {
    static constexpr bool PERM = true, AFTER_DRAIN = false;
    bf16_t* O;
    __device__ __forceinline__ void operator()(const f32x4 (&acc)[2][2][4][2], const pg8::Unit& u, int wr, int wc, int fr, int fq) const {
        const int row0 = u.pm * 256 + wr * 64 + fr, col0 = u.pn * 128 + wc * 32 + 8 * fq;
#pragma unroll
        for (int ai = 0; ai < 2; ++ai)
#pragma unroll
            for (int m = 0; m < 4; ++m) { float o[8];
#pragma unroll
                for (int n = 0; n < 2; ++n)
#pragma unroll
                    for (int j = 0; j < 4; ++j) { const float g = acc[ai][0][m][n][j], up = acc[ai][1][m][n][j]; o[n * 4 + j] = g * __builtin_amdgcn_rcpf(1.0f + __expf(-g)) * up; }
                u32x4 w; w.x = cvt_pk_bf16(o[0], o[1]); w.y = cvt_pk_bf16(o[2], o[3]); w.z = cvt_pk_bf16(o[4], o[5]); w.w = cvt_pk_bf16(o[6], o[7]);
                *(u32x4*)(O + (size_t)(row0 + ai * 128 + m * 16) * DFF + col0) = w; }
    }
};
struct EpiF32 {
    static constexpr bool PERM = true, AFTER_DRAIN = false;
    bf16_t* C;
    __device__ __forceinline__ void operator()(const f32x4 (&acc)[2][2][4][2], const pg8::Unit& u, int wr, int wc, int fr, int fq) const {
        const int row0 = u.pm * 256 + wr * 64 + fr, col0 = u.pn * 256 + wc * 32 + 8 * fq;
#pragma unroll
        for (int ai = 0; ai < 2; ++ai)
#pragma unroll
            for (int m = 0; m < 4; ++m) { bf16_t* rowp = C + (size_t)(row0 + ai * 128 + m * 16) * D + col0;
#pragma unroll
                for (int bj = 0; bj < 2; ++bj) { const f32x4 v0 = acc[ai][bj][m][0], v1 = acc[ai][bj][m][1];
                    u32x4 w; w.x = cvt_pk_bf16(v0[0], v0[1]); w.y = cvt_pk_bf16(v0[2], v0[3]); w.z = cvt_pk_bf16(v1[0], v1[1]); w.w = cvt_pk_bf16(v1[2], v1[3]);
                    *(u32x4*)(rowp + bj * 128) = w; } }
    }
};
struct EpiWin {
    static constexpr bool PERM = true, AFTER_DRAIN = false;
    bf16_t* PHYT; bf16_t* PRW; bf16_t* PNA;
    __device__ __forceinline__ void operator()(const f32x4 (&acc)[2][2][4][2], const pg8::Unit& u, int wr, int wc, int fr, int fq) const {
        const int row0 = u.pm * 256 + wr * 64 + fr;
        if (u.pn < 3) {
#pragma unroll
            for (int bj = 0; bj < 2; ++bj) { bf16_t* cp = PHYT + (size_t)(u.pn * 256 + bj * 128 + wc * 32 + 8 * fq) * T + row0;
#pragma unroll
                for (int ai = 0; ai < 2; ++ai)
#pragma unroll
                    for (int m = 0; m < 4; ++m) { const f32x4 v0 = acc[ai][bj][m][0], v1 = acc[ai][bj][m][1]; bf16_t* rp = cp + ai * 128 + m * 16;
                        const unsigned w0 = cvt_pk_bf16(v0[0], v0[1]), w1 = cvt_pk_bf16(v0[2], v0[3]), w2 = cvt_pk_bf16(v1[0], v1[1]), w3 = cvt_pk_bf16(v1[2], v1[3]);
                        rp[0] = (bf16_t)w0; rp[(size_t)T] = (bf16_t)(w0 >> 16); rp[(size_t)2 * T] = (bf16_t)w1; rp[(size_t)3 * T] = (bf16_t)(w1 >> 16);
                        rp[(size_t)4 * T] = (bf16_t)w2; rp[(size_t)5 * T] = (bf16_t)(w2 >> 16); rp[(size_t)6 * T] = (bf16_t)w3; rp[(size_t)7 * T] = (bf16_t)(w3 >> 16); } }
            return; }
        bf16_t* base; int ld, cbase;
        if (u.pn < 9) { base = PRW; ld = RW_IN; cbase = u.pn * 256 - HY_IN; }
        else { base = PNA; ld = NA_IN; cbase = u.pn * 256 - HY_IN - RW_IN; }
        const int nbj = (u.pn == 13) ? 1 : 2;
#pragma unroll
        for (int ai = 0; ai < 2; ++ai)
#pragma unroll
            for (int m = 0; m < 4; ++m)
#pragma unroll
                for (int bj = 0; bj < 2; ++bj) { if (bj < nbj) { const f32x4 v0 = acc[ai][bj][m][0], v1 = acc[ai][bj][m][1];
                    u32x4 w; w.x = cvt_pk_bf16(v0[0], v0[1]); w.y = cvt_pk_bf16(v0[2], v0[3]); w.z = cvt_pk_bf16(v1[0], v1[1]); w.w = cvt_pk_bf16(v1[2], v1[3]);
                    *(u32x4*)(base + (size_t)(row0 + ai * 128 + m * 16) * ld + cbase + bj * 128 + wc * 32 + 8 * fq) = w; } }
    }
};
struct EpiLora {
    static constexpr bool PERM = true, AFTER_DRAIN = false;
    bf16_t* LO; bf16_t* GATE;
    __device__ __forceinline__ void operator()(const f32x4 (&acc)[2][2][4][2], const pg8::Unit& u, int wr, int wc, int fr, int fq) const {
        const int row0 = u.pm * 256 + wr * 64 + fr;
        bf16_t* base; int ld, cbase;
        if (u.pn < 6) { base = LO; ld = 1536; cbase = u.pn * 256; } else { base = GATE; ld = 384; cbase = u.pn * 256 - 1536; }
        const int nbj = (u.pn == 7) ? 1 : 2;
#pragma unroll
        for (int ai = 0; ai < 2; ++ai)
#pragma unroll
            for (int m = 0; m < 4; ++m)
#pragma unroll
                for (int bj = 0; bj < 2; ++bj) { if (bj < nbj) { const f32x4 v0 = acc[ai][bj][m][0], v1 = acc[ai][bj][m][1];
                    u32x4 w; w.x = cvt_pk_bf16(v0[0], v0[1]); w.y = cvt_pk_bf16(v0[2], v0[3]); w.z = cvt_pk_bf16(v1[0], v1[1]); w.w = cvt_pk_bf16(v1[2], v1[3]);
                    *(u32x4*)(base + (size_t)(row0 + ai * 128 + m * 16) * ld + cbase + bj * 128 + wc * 32 + 8 * fq) = w; } }
    }
};
template <class Epi> __device__ __forceinline__ void run_gemm(LAS unsigned char* lds, const bf16_t* A, const bf16_t* Bt, int M, int N, int K, const Epi& E) {
    asm volatile("" : "+s"(K));
    pg8::Gemm g{A, Bt, M, N, K}; pg8::StaticOrder S; S.init(M, N, (int)gridDim.x, (int)blockIdx.x);
    pg8::gemm_phase<Epi, pg8::StaticOrder>(lds, g, S, E);
    __syncthreads();
}

__device__ __forceinline__ void ph_loraprep(const Params& P, int l) {
    const bf16_t* PRW = (const bf16_t*)(P.ws + WS_PRW); bf16_t* AL = (bf16_t*)(P.ws + WS_ALORA);
    const float* mu = P.in[I_MU] + (size_t)l * 2 * RW_IN;
    const int gtid = blockIdx.x * NTHR + otid(), gn = gridDim.x * NTHR;
    for (int it = gtid; it < T * 48; it += gn) {
        const int row = it / 48, j8 = it % 48, col = 1152 + j8 * 8;
        bool hp, hn; row_nbrs(row, hp, hn);
        float p[8], pp[8], pn[8];
        unpack8(*(const u32x4*)(PRW + (size_t)row * RW_IN + col), p);
        if (hp) unpack8(*(const u32x4*)(PRW + (size_t)(row - 1) * RW_IN + col), pp); else {
#pragma unroll
            for (int i = 0; i < 8; ++i) pp[i] = 0.f; }
        if (hn) unpack8(*(const u32x4*)(PRW + (size_t)(row + 1) * RW_IN + col), pn); else {
#pragma unroll
            for (int i = 0; i < 8; ++i) pn[i] = 0.f; }
        float o[8];
#pragma unroll
        for (int i = 0; i < 8; ++i) { const float xs = p[i] + mu[col + i] * (pp[i] - p[i]) + mu[RW_IN + col + i] * (pn[i] - p[i]);
            o[i] = j8 < 16 ? tanhf(xs) : (j8 < 32 ? xs : sigmoidf_(xs)); }
        u32x4 w; w.x = cvt_pk_bf16(o[0], o[1]); w.y = cvt_pk_bf16(o[2], o[3]); w.z = cvt_pk_bf16(o[4], o[5]); w.w = cvt_pk_bf16(o[6], o[7]);
        *(u32x4*)(AL + (size_t)row * 384 + j8 * 8) = w;
    }
}

__device__ __forceinline__ void ph_rwkvprep(const Params& P, int l) {
    const int tid = otid(), lane = tid & 63, gw = blockIdx.x * NWAVE + (tid >> 6), nw = gridDim.x * NWAVE;
    const bf16_t* PRW = (const bf16_t*)(P.ws + WS_PRW); const bf16_t* LO = (const bf16_t*)(P.ws + WS_LORAO);
    bf16_t* RS = (bf16_t*)(P.ws + WS_RS); bf16_t* KKS = (bf16_t*)(P.ws + WS_KKS); bf16_t* VS = (bf16_t*)(P.ws + WS_VS); bf16_t* KS = (bf16_t*)(P.ws + WS_KS); bf16_t* BS = (bf16_t*)(P.ws + WS_BS);
    float* BON = (float*)(P.ws + WS_BONUS);
    const float* mu = P.in[I_MU] + (size_t)l * 2 * RW_IN;
    const int f = lane & 15; const float inv = __expf(-(float)f * (9.210340371976184f / 16.0f));
    for (int row = gw; row < T; row += nw) {
        bool hp, hn; row_nbrs(row, hp, hn);
#pragma unroll
      for (int h = 0; h < 6; ++h) { const int c = h * 64 + lane;
        float x[3];
#pragma unroll
        for (int q = 0; q < 3; ++q) { const int col = q * 384 + c; const float p = bf2f(PRW[(size_t)row * RW_IN + col]);
            const float pp = hp ? bf2f(PRW[(size_t)(row - 1) * RW_IN + col]) : 0.f, pn = hn ? bf2f(PRW[(size_t)(row + 1) * RW_IN + col]) : 0.f;
            x[q] = p + mu[col] * (pp - p) + mu[RW_IN + col] * (pn - p); }
        const float r = x[0], k = x[1], v = x[2];
        const float kkr = k * P.in[I_KK][l * RWW + c];
        const float nrm = sqrtf(wsum(kkr * kkr));
        const float kk = kkr / fmaxf(nrm, 1e-12f);
        const float a0 = sigmoidf_(bf2f(LO[(size_t)row * 1536 + 768 + c]) + P.in[I_A0][(size_t)l * 2 * RWW + c]), a1 = sigmoidf_(bf2f(LO[(size_t)row * 1536 + 1152 + c]) + P.in[I_A0][(size_t)l * 2 * RWW + RWW + c]);
        { float* DEC = (float*)(P.ws + WS_DECAY);
          const float x0 = bf2f(LO[(size_t)row * 1536 + c]) + P.in[I_W0][(size_t)l * 2 * RWW + c], x1 = bf2f(LO[(size_t)row * 1536 + 384 + c]) + P.in[I_W0][(size_t)l * 2 * RWW + RWW + c];
          DEC[(size_t)row * 384 + c] = __expf(-0.6065306597f * sigmoidf_(x0)); DEC[((size_t)T + row) * 384 + c] = __expf(-0.6065306597f * sigmoidf_(x1)); }
        const float ka = P.in[I_KA][l * RWW + c];
        float kd0 = k * (1.f + (a0 - 1.f) * ka), kd1 = k * (1.f + (a1 - 1.f) * ka);
        float b0 = kk * a0, b1 = kk * a1;
        const float bon = wsum(r * (kd0 + kd1) * P.in[I_RK][l * RWW + c]);
        if (lane == 0) BON[(size_t)row * 6 + h] = bon;
        float rs = r, kks = kk;
        if (row < TL) {
            const int t = row & (SEQ - 1); const float pos = (lane < 32) ? (float)(t >> 6) : (float)(t & 63);
            float sn, cs; sincosf(pos * inv, &sn, &cs);
            const float sg = (lane & 16) ? 1.f : -1.f;
            const float r2 = __shfl_xor(rs, 16), k2 = __shfl_xor(kks, 16), d0 = __shfl_xor(kd0, 16), d1 = __shfl_xor(kd1, 16), e0 = __shfl_xor(b0, 16), e1 = __shfl_xor(b1, 16);
            rs = rs * cs + sg * r2 * sn; kks = kks * cs + sg * k2 * sn; kd0 = kd0 * cs + sg * d0 * sn; kd1 = kd1 * cs + sg * d1 * sn; b0 = b0 * cs + sg * e0 * sn; b1 = b1 * cs + sg * e1 * sn;
        }
        const size_t o = (size_t)row * 384 + c;
        RS[o] = f2bf(rs); KKS[o] = f2bf(-kks); VS[o] = f2bf(v);
        KS[o] = f2bf(kd0); KS[(size_t)T * 384 + o] = f2bf(kd1); BS[o] = f2bf(b0); BS[(size_t)T * 384 + o] = f2bf(b1);
      }
    }
}

__device__ __forceinline__ int scan_row(int b, int d, int step) {
    if (step < CTX) { const int tc = d ? (CTX - 1 - step) : step; return TL + b * CTX + tc; }
    const int tl = d ? (SEQ - 1 - (step - CTX)) : (step - CTX); return b * SEQ + tl;
}
__device__ __forceinline__ void scan_task_v1(const Params& P, int task, float* sv) {
    const int lane = otid() & 63;
    const int d = task & 1, h = (task >> 1) % 6, b = task / 12;
    const float* DEC = (const float*)(P.ws + WS_DECAY) + (size_t)d * T * 384; const bf16_t* KKS = (const bf16_t*)(P.ws + WS_KKS); const bf16_t* RS = (const bf16_t*)(P.ws + WS_RS);
    const bf16_t* VS = (const bf16_t*)(P.ws + WS_VS); const bf16_t* KS = (const bf16_t*)(P.ws + WS_KS) + (size_t)d * T * 384; const bf16_t* BS = (const bf16_t*)(P.ws + WS_BS) + (size_t)d * T * 384;
    float* YD = (float*)(P.ws + WS_YDIR) + (size_t)d * T * 384;
    float S[64];
#pragma unroll
    for (int j = 0; j < 64; ++j) S[j] = 0.f;
    size_t o = (size_t)scan_row(b, d, 0) * 384 + h * 64 + lane;
    float nw_ = DEC[o], na = bf2f(KKS[o]), nb = bf2f(BS[o]), nk = bf2f(KS[o]), nr = bf2f(RS[o]), nv = bf2f(VS[o]);
    for (int step = 0; step < CTX + SEQ; ++step) {
        const float v = nv; const size_t oc = o;
        asm volatile("s_waitcnt lgkmcnt(0)" ::: "memory");
        sv[lane] = nw_; sv[64 + lane] = na; sv[128 + lane] = nb; sv[192 + lane] = nk; sv[256 + lane] = nr;
        asm volatile("s_waitcnt lgkmcnt(0)" ::: "memory");
        if (step + 1 < CTX + SEQ) { o = (size_t)scan_row(b, d, step + 1) * 384 + h * 64 + lane;
            nw_ = DEC[o]; na = bf2f(KKS[o]); nb = bf2f(BS[o]); nk = bf2f(KS[o]); nr = bf2f(RS[o]); nv = bf2f(VS[o]); }
        float sa0 = 0.f, sa1 = 0.f, sa2 = 0.f, sa3 = 0.f;
#pragma unroll
        for (int j = 0; j < 64; j += 4) { const float4 a4 = *(const float4*)(sv + 64 + j);
            sa0 += S[j + 0] * a4.x; sa1 += S[j + 1] * a4.y; sa2 += S[j + 2] * a4.z; sa3 += S[j + 3] * a4.w; }
        const float sa = (sa0 + sa1) + (sa2 + sa3);
        float y0 = 0.f, y1 = 0.f, y2 = 0.f, y3 = 0.f;
#pragma unroll
        for (int j = 0; j < 64; j += 4) {
            const float4 w4 = *(const float4*)(sv + j), b4 = *(const float4*)(sv + 128 + j), k4 = *(const float4*)(sv + 192 + j), r4 = *(const float4*)(sv + 256 + j);
            S[j + 0] = S[j + 0] * w4.x + sa * b4.x + v * k4.x; y0 += S[j + 0] * r4.x;
            S[j + 1] = S[j + 1] * w4.y + sa * b4.y + v * k4.y; y1 += S[j + 1] * r4.y;
            S[j + 2] = S[j + 2] * w4.z + sa * b4.z + v * k4.z; y2 += S[j + 2] * r4.z;
            S[j + 3] = S[j + 3] * w4.w + sa * b4.w + v * k4.w; y3 += S[j + 3] * r4.w; }
        YD[oc] = (y0 + y1) + (y2 + y3);
    }
}

__device__ __forceinline__ void natt_key(const bf16_t* PNA, size_t krow, int hoff, const float (&q)[16], float bias, float& m, float& lsum, float (&o)[16]) {
    const bf16_t* kp = PNA + krow * NA_IN + 384 + hoff; const bf16_t* vp = PNA + krow * NA_IN + 768 + hoff;
    float s = 0.f;
#pragma unroll
    for (int j8 = 0; j8 < 2; ++j8) { float kf[8]; unpack8(*(const u32x4*)(kp + j8 * 8), kf);
#pragma unroll
        for (int i = 0; i < 8; ++i) s += q[j8 * 8 + i] * kf[i]; }
    s += __shfl_xor(s, 1); s += __shfl_xor(s, 2); s += bias;
    const float mn = fmaxf(m, s), corr = __expf(m - mn), p = __expf(s - mn);
    m = mn; lsum = lsum * corr + p;
#pragma unroll
    for (int j8 = 0; j8 < 2; ++j8) { float vf[8]; unpack8(*(const u32x4*)(vp + j8 * 8), vf);
#pragma unroll
        for (int i = 0; i < 8; ++i) o[j8 * 8 + i] = o[j8 * 8 + i] * corr + p * vf[i]; }
}
__device__ __forceinline__ void natten_items_v1(const Params& P, int l, int wid0, int nworkers) {
    const bf16_t* PNA = (const bf16_t*)(P.ws + WS_PNA); bf16_t* MIX = (bf16_t*)(P.ws + WS_U);
    const float* rpb = P.in[I_RPB] + (size_t)l * 6 * 15 * 31;
    const int sub = wid0 & 3;
    for (int it = wid0 >> 2; it < T * 6; it += nworkers >> 2) {
        const int row = it % T, h = it / T, hoff = h * 64 + sub * 16;
        float q[16], o[16];
#pragma unroll
        for (int j8 = 0; j8 < 2; ++j8) { float qf[8]; unpack8(*(const u32x4*)(PNA + (size_t)row * NA_IN + hoff + j8 * 8), qf);
#pragma unroll
            for (int i = 0; i < 8; ++i) { q[j8 * 8 + i] = qf[i] * 0.125f; o[j8 * 8 + i] = 0.f; } }
        float m = -3.0e38f, lsum = 0.f;
        int b;
        if (row < TL) { b = row >> 13; const int t = row & (SEQ - 1), i = t >> 6, col = t & 63;
            const int start = min(max(i - 4, 0), 120), win0 = min(max(col - 8, 0), 48);
            for (int r = 0; r < 8; ++r) for (int kc = win0; kc < win0 + 16; ++kc) {
                const float bias = rpb[(h * 15 + (start + r - i + 7)) * 31 + (kc - col + 15)];
                natt_key(PNA, (size_t)b * SEQ + (start + r) * 64 + kc, hoff, q, bias, m, lsum, o); }
        } else b = (row - TL) >> 8;
        for (int c = 0; c < CTX; ++c) natt_key(PNA, (size_t)TL + b * CTX + c, hoff, q, 0.f, m, lsum, o);
        const float il = 1.0f / lsum;
#pragma unroll
        for (int j8 = 0; j8 < 2; ++j8) { u32x4 w; w.x = cvt_pk_bf16(o[j8 * 8 + 0] * il, o[j8 * 8 + 1] * il); w.y = cvt_pk_bf16(o[j8 * 8 + 2] * il, o[j8 * 8 + 3] * il);
            w.z = cvt_pk_bf16(o[j8 * 8 + 4] * il, o[j8 * 8 + 5] * il); w.w = cvt_pk_bf16(o[j8 * 8 + 6] * il, o[j8 * 8 + 7] * il);
            *(u32x4*)(MIX + (size_t)row * D + 640 + hoff + j8 * 8) = w; }
    }
}

__device__ __forceinline__ void vt_tile(const Params& P, int tile, unsigned short* tl  ) {
    const int tid = otid();
    const bf16_t* PNA = (const bf16_t*)(P.ws + WS_PNA);
    int h, tok0; bf16_t* dst; int ldt;
    if (tile < NB * 128 * 6) { h = tile % 6; const int sb = tile / 6; const int b = sb >> 7, blk = sb & 127; tok0 = b * SEQ + blk * 64; dst = (bf16_t*)(P.ws + WS_VTL) + ((size_t)(b * 6 + h) * 64) * SEQ + blk * 64; ldt = SEQ; }
    else { const int tt = tile - NB * 128 * 6; h = tt % 6; const int sb = tt / 6; const int b = sb >> 2, blk = sb & 3; tok0 = TL + b * CTX + blk * 64; dst = (bf16_t*)(P.ws + WS_VTC) + ((size_t)(b * 6 + h) * 64) * CTX + blk * 64; ldt = CTX; }
    { const int tok = tid >> 3, seg = tid & 7; const u32x4 v = *(const u32x4*)(PNA + (size_t)(tok0 + tok) * NA_IN + 768 + h * 64 + seg * 8);
      unsigned* w = (unsigned*)(tl + tok * 72 + seg * 8); w[0] = v.x; w[1] = v.y; w[2] = v.z; w[3] = v.w; }
    __syncthreads();
    { const int hd = tid >> 3, ts = tid & 7; unsigned short e[8];
#pragma unroll
      for (int k = 0; k < 8; ++k) e[k] = tl[(ts * 8 + k) * 72 + hd];
      u32x4 w; w.x = (unsigned)e[0] | ((unsigned)e[1] << 16); w.y = (unsigned)e[2] | ((unsigned)e[3] << 16); w.z = (unsigned)e[4] | ((unsigned)e[5] << 16); w.w = (unsigned)e[6] | ((unsigned)e[7] << 16);
      *(u32x4*)(dst + (size_t)hd * ldt + ts * 8) = w; }
    __syncthreads();
}
constexpr int NAT_LAT_TASKS = NB * 128 * 4 * 6, NAT_CTX_TASKS = NB * 16 * 6, NAT_TASKS = NAT_LAT_TASKS + NAT_CTX_TASKS;
__device__ __forceinline__ void natten_task(const Params& P, int l, int task) {
    using pg8::bf16x8;
    const int lane = otid() & 63, fr = lane & 15, fq = lane >> 4;
    const bf16_t* PNA = (const bf16_t*)(P.ws + WS_PNA); bf16_t* MIX = (bf16_t*)(P.ws + WS_U);
    const bool lat = task < NAT_LAT_TASKS;
    int b, h, i = 0, n = 0, qtok0;
    if (lat) { h = task % 6; const int r = task / 6; n = r & 3; i = (r >> 2) & 127; b = r >> 9; qtok0 = b * SEQ + i * 64 + 16 * n; }
    else { const int tt = task - NAT_LAT_TASKS; h = tt % 6; const int qb = (tt / 6) & 15; b = tt / 96; qtok0 = TL + b * CTX + 16 * qb; }
    const int start = min(max(i - 4, 0), 120), band0 = min(max(16 * n - 8, 0), 32);
    const int col = 16 * n + fr, win0 = min(max(col - 8, 0), 48);
    bf16x8 bq[2];
#pragma unroll
    for (int kh = 0; kh < 2; ++kh) bq[kh] = *(const bf16x8*)(PNA + (size_t)(qtok0 + fr) * NA_IN + h * 64 + kh * 32 + fq * 8);
    f32x4 sc[32];
    if (lat) {
#pragma unroll
        for (int t = 0; t < 16; ++t) { const int tok0 = b * SEQ + (start + (t >> 1)) * 64 + band0 + 16 * (t & 1);
            const bf16_t* kp = PNA + (size_t)(tok0 + fr) * NA_IN + 384 + h * 64 + fq * 8;
            const bf16x8 k0 = *(const bf16x8*)kp, k1 = *(const bf16x8*)(kp + 32);
            f32x4 a = (f32x4){0.f, 0.f, 0.f, 0.f};
            a = __builtin_amdgcn_mfma_f32_16x16x32_bf16(k0, bq[0], a, 0, 0, 0); a = __builtin_amdgcn_mfma_f32_16x16x32_bf16(k1, bq[1], a, 0, 0, 0);
            sc[t] = a; if ((t & 3) == 3) asm volatile("" ::: "memory"); }
    } else {
#pragma unroll
        for (int t = 0; t < 16; ++t) sc[t] = (f32x4){-3.0e38f, -3.0e38f, -3.0e38f, -3.0e38f};
    }
#pragma unroll
    for (int t = 16; t < 32; ++t) { const int tok0 = TL + b * CTX + 16 * (t - 16);
        const bf16_t* kp = PNA + (size_t)(tok0 + fr) * NA_IN + 384 + h * 64 + fq * 8;
        const bf16x8 k0 = *(const bf16x8*)kp, k1 = *(const bf16x8*)(kp + 32);
        f32x4 a = (f32x4){0.f, 0.f, 0.f, 0.f};
        a = __builtin_amdgcn_mfma_f32_16x16x32_bf16(k0, bq[0], a, 0, 0, 0); a = __builtin_amdgcn_mfma_f32_16x16x32_bf16(k1, bq[1], a, 0, 0, 0);
        sc[t] = a * 0.125f; if ((t & 3) == 3) asm volatile("" ::: "memory"); }
    if (lat) { const float* rpb = P.in[I_RPB] + ((size_t)l * 6 + h) * 15 * 31;
#pragma unroll
        for (int t = 0; t < 16; ++t) { const int ro = start + (t >> 1) - i + 7; const int kc0 = band0 + 16 * (t & 1) + fq * 4;
#pragma unroll
            for (int j = 0; j < 4; ++j) { const int kc = kc0 + j; const bool ok = kc >= win0 && kc < win0 + 16; const int co = min(max(kc - col + 15, 0), 30);
                const float bias = rpb[ro * 31 + co]; sc[t][j] = ok ? sc[t][j] * 0.125f + bias : -3.0e38f; } } }
    float mx = -3.0e38f;
#pragma unroll
    for (int t = 0; t < 32; ++t) mx = fmaxf(mx, fmaxf(fmaxf(sc[t][0], sc[t][1]), fmaxf(sc[t][2], sc[t][3])));
    mx = fmaxf(mx, __shfl_xor(mx, 16)); mx = fmaxf(mx, __shfl_xor(mx, 32));
    float sum = 0.f;
#pragma unroll
    for (int t = 0; t < 32; ++t) {
#pragma unroll
        for (int j = 0; j < 4; ++j) { const float p = __expf(sc[t][j] - mx); sc[t][j] = p; sum += p; } }
    sum += __shfl_xor(sum, 16); sum += __shfl_xor(sum, 32);
    const float inv = 1.0f / sum;
    f32x4 ot[4];
#pragma unroll
    for (int q = 0; q < 4; ++q) ot[q] = (f32x4){0.f, 0.f, 0.f, 0.f};
    const bf16_t* VTL = (const bf16_t*)(P.ws + WS_VTL) + ((size_t)(b * 6 + h) * 64) * SEQ; const bf16_t* VTC = (const bf16_t*)(P.ws + WS_VTC) + ((size_t)(b * 6 + h) * 64) * CTX;
    if (lat) {
#pragma unroll
        for (int m = 0; m < 8; ++m) { const int tk = (start + m) * 64 + band0 + fq * 4;
            u32x4 pw; pw.x = cvt_pk_bf16(sc[2 * m][0], sc[2 * m][1]); pw.y = cvt_pk_bf16(sc[2 * m][2], sc[2 * m][3]); pw.z = cvt_pk_bf16(sc[2 * m + 1][0], sc[2 * m + 1][1]); pw.w = cvt_pk_bf16(sc[2 * m + 1][2], sc[2 * m + 1][3]);
            const bf16x8 pb = __builtin_bit_cast(bf16x8, pw);
#pragma unroll
            for (int q = 0; q < 4; ++q) { const bf16_t* vp = VTL + (size_t)(q * 16 + fr) * SEQ + tk; const u32x2 v0 = *(const u32x2*)vp, v1 = *(const u32x2*)(vp + 16);
                u32x4 vw; vw.x = v0.x; vw.y = v0.y; vw.z = v1.x; vw.w = v1.y;
                ot[q] = __builtin_amdgcn_mfma_f32_16x16x32_bf16(__builtin_bit_cast(bf16x8, vw), pb, ot[q], 0, 0, 0); }
            if (m & 1) asm volatile("" ::: "memory"); }
    }
#pragma unroll
    for (int m = 0; m < 8; ++m) { const int tk = 32 * m + fq * 4;
        u32x4 pw; pw.x = cvt_pk_bf16(sc[16 + 2 * m][0], sc[16 + 2 * m][1]); pw.y = cvt_pk_bf16(sc[16 + 2 * m][2], sc[16 + 2 * m][3]); pw.z = cvt_pk_bf16(sc[17 + 2 * m][0], sc[17 + 2 * m][1]); pw.w = cvt_pk_bf16(sc[17 + 2 * m][2], sc[17 + 2 * m][3]);
        const bf16x8 pb = __builtin_bit_cast(bf16x8, pw);
#pragma unroll
        for (int q = 0; q < 4; ++q) { const bf16_t* vp = VTC + (size_t)(q * 16 + fr) * CTX + tk; const u32x2 v0 = *(const u32x2*)vp, v1 = *(const u32x2*)(vp + 16);
            u32x4 vw; vw.x = v0.x; vw.y = v0.y; vw.z = v1.x; vw.w = v1.y;
            ot[q] = __builtin_amdgcn_mfma_f32_16x16x32_bf16(__builtin_bit_cast(bf16x8, vw), pb, ot[q], 0, 0, 0); }
        if (m & 1) asm volatile("" ::: "memory"); }
#pragma unroll
    for (int q = 0; q < 4; ++q) { u32x2 w; w.x = cvt_pk_bf16(ot[q][0] * inv, ot[q][1] * inv); w.y = cvt_pk_bf16(ot[q][2] * inv, ot[q][3] * inv);
        *(u32x2*)(MIX + (size_t)(qtok0 + fr) * D + 640 + h * 64 + q * 16 + fq * 4) = w; }
}

__device__ __forceinline__ void fft_fwd(float2* X) {
#pragma unroll 1
    for (int lq = 12; lq >= 0; lq -= 2) { const int q = 1 << lq; const float rq = 1.0f / (float)(4 * q);
        for (int j = otid(); j < NFFT / 4; j += NTHR) { const int lo = j & (q - 1), base = ((j >> lq) << (lq + 2)) | lo;
            const float2 x0 = X[base], x1 = X[base + q], x2 = X[base + 2 * q], x3 = X[base + 3 * q];
            const float fr = (float)lo * rq; const float c = __builtin_amdgcn_cosf(fr), s = __builtin_amdgcn_sinf(fr), c2 = c * c - s * s, s2 = 2.f * c * s;
            const float a0x = x0.x + x2.x, a0y = x0.y + x2.y, dx = x0.x - x2.x, dy = x0.y - x2.y;
            const float a2x = dx * c + dy * s, a2y = dy * c - dx * s;
            const float a1x = x1.x + x3.x, a1y = x1.y + x3.y, ex = x1.x - x3.x, ey = x1.y - x3.y;
            const float mx = ex * c + ey * s, my = ey * c - ex * s;
            const float a3x = my, a3y = -mx;
            const float fx = a0x - a1x, fy = a0y - a1y, gx = a2x - a3x, gy = a2y - a3y;
            X[base] = make_float2(a0x + a1x, a0y + a1y); X[base + q] = make_float2(fx * c2 + fy * s2, fy * c2 - fx * s2);
            X[base + 2 * q] = make_float2(a2x + a3x, a2y + a3y); X[base + 3 * q] = make_float2(gx * c2 + gy * s2, gy * c2 - gx * s2); }
        __syncthreads(); }
}
__device__ __forceinline__ void fft_inv(float2* X) {
#pragma unroll 1
    for (int lq = 0; lq <= 12; lq += 2) { const int q = 1 << lq; const float rq = 1.0f / (float)(4 * q);
        for (int j = otid(); j < NFFT / 4; j += NTHR) { const int lo = j & (q - 1), base = ((j >> lq) << (lq + 2)) | lo;
            const float2 y0 = X[base], y1 = X[base + q], y2 = X[base + 2 * q], y3 = X[base + 3 * q];
            const float fr = (float)lo * rq; const float c = __builtin_amdgcn_cosf(fr), s = __builtin_amdgcn_sinf(fr), c2 = c * c - s * s, s2 = 2.f * c * s;
            const float tx = y1.x * c2 - y1.y * s2, ty = y1.x * s2 + y1.y * c2;
            const float a0x = y0.x + tx, a0y = y0.y + ty, a1x = y0.x - tx, a1y = y0.y - ty;
            const float ux = y3.x * c2 - y3.y * s2, uy = y3.x * s2 + y3.y * c2;
            const float a2x = y2.x + ux, a2y = y2.y + uy, a3x = y2.x - ux, a3y = y2.y - uy;
            const float vx = a2x * c - a2y * s, vy = a2x * s + a2y * c;
            const float mx = a3x * c - a3y * s, my = a3x * s + a3y * c;
            const float wx = -my, wy = mx;
            X[base] = make_float2(a0x + vx, a0y + vy); X[base + 2 * q] = make_float2(a0x - vx, a0y - vy);
            X[base + q] = make_float2(a1x + wx, a1y + wy); X[base + 3 * q] = make_float2(a1x - wx, a1y - wy); }
        __syncthreads(); }
}
__device__ __forceinline__ float hy_delta(int c) { const float lo = -4.605170185988091f / 1.5f, hi = -4.605170185988091f / 0.3f; return fabsf(lo + (float)c * ((hi - lo) / 255.0f)); }
__device__ __forceinline__ float hy_short(const bf16_t* PHYT, const float* cw, const float* cb, int row, int col) {
    bool hp, hn; row_nbrs(row, hp, hn);
    const bf16_t* p = PHYT + (size_t)col * T + row;
    float v = cb[col] + cw[HY_IN + col] * bf2f(p[0]);
    if (hp) v += cw[col] * bf2f(p[-1]);
    if (hn) v += cw[2 * HY_IN + col] * bf2f(p[1]);
    return v;
}
struct HyTap { float w0, w1, w2, b; };
__device__ __forceinline__ HyTap hy_tap(const float* cw, const float* cb, int col) { HyTap t; t.w0 = cw[col]; t.w1 = cw[HY_IN + col]; t.w2 = cw[2 * HY_IN + col]; t.b = cb[col]; return t; }
__device__ __forceinline__ float hy_lat(const bf16_t* colp, int b, int n, const HyTap t) {
    const bf16_t* p = colp + b * SEQ + n;
    const float xm = bf2f(p[n > 0 ? -1 : 0]), x0 = bf2f(p[0]), xp = bf2f(p[n < SEQ - 1 ? 1 : 0]);
    return t.b + t.w1 * x0 + (n > 0 ? t.w0 * xm : 0.f) + (n < SEQ - 1 ? t.w2 * xp : 0.f);
}
__device__ __forceinline__ void hy_spec_task(const Params& P, int l, int o, int c, float2* X, float* ex_) {
    const int tid = otid();
    const bf16_t* ff = (const bf16_t*)(P.ws + WS_FILT) + (size_t)(o * 512 + c) * SEQ; const bf16_t* fb = ff + (size_t)256 * SEQ;
    for (int n = tid; n < SEQ; n += NTHR) {
        X[n] = make_float2(bf2f(ff[n]), 0.f);
        if (n > 0) X[NFFT - n] = make_float2(bf2f(fb[n]), 0.f); else X[SEQ] = make_float2(0.f, 0.f); }
    __syncthreads();
    fft_fwd(X);
    float2* spec = (float2*)(P.ws + WS_SPEC) + (size_t)(o * 256 + c) * NFFT;
    for (int i = tid; i < NFFT; i += NTHR) spec[i] = X[i];
    __syncthreads();
}
__device__ __forceinline__ void hy_conv_core(const Params& P, int o, int c, float2* X) {
    fft_fwd(X);
    const float2* spec = (const float2*)(P.ws + WS_SPEC) + (size_t)(o * 256 + c) * NFFT;
    for (int i = otid(); i < NFFT; i += NTHR) { const float2 a = X[i], k = spec[i]; X[i] = make_float2(a.x * k.x - a.y * k.y, a.x * k.y + a.y * k.x); }
    __syncthreads();
    fft_inv(X);
}
__device__ __forceinline__ void hy_task1(const Params& P, int l, int c, float2* X, float* ex) {
    const int tid = otid();
    const bf16_t* PHY = (const bf16_t*)(P.ws + WS_PHY); const float* cw = P.in[I_HCW] + (size_t)l * 3 * HY_IN; const float* cb = P.in[I_HCB] + (size_t)l * HY_IN;
    const float bias0 = P.in[I_HBIAS][(size_t)l * 2 * HYC + c], bias1 = P.in[I_HBIAS][(size_t)l * 2 * HYC + HYC + c];
    const HyTap tv = hy_tap(cw, cb, c), tg1 = hy_tap(cw, cb, HYC + c); const bf16_t* colv = PHY + (size_t)c * T; const bf16_t* colg1 = PHY + (size_t)(HYC + c) * T;
#pragma unroll 4
    for (int n = tid; n < SEQ; n += NTHR) { X[n] = make_float2(hy_lat(colv, 0, n, tv), hy_lat(colv, 1, n, tv)); X[SEQ + n] = make_float2(0.f, 0.f); }
    __syncthreads();
    hy_conv_core(P, 0, c, X);
    float* Z1 = (float*)(P.ws + WS_Z1) + (size_t)c * NB * SEQ;
#pragma unroll 4
    for (int n = tid; n < SEQ; n += NTHR) { const float2 y = X[n];
        const float v0 = hy_lat(colv, 0, n, tv), v1 = hy_lat(colv, 1, n, tv), g0 = hy_lat(colg1, 0, n, tg1), g1 = hy_lat(colg1, 1, n, tg1);
        Z1[n] = g0 * (y.x + bias0 * v0); Z1[SEQ + n] = g1 * (y.y + bias0 * v1); }
    __syncthreads();
    float* f = (float*)X;
    float* vv = f, *x1 = f + 512, *x2 = f + 1024, *hf = f + 1536  , *z1 = f + 2560;
    const bf16_t* fc = (const bf16_t*)(P.ws + WS_FILTC);
    { const int b = tid >> 8, t = tid & 255, row = TL + b * CTX + t;
      vv[tid] = hy_short(PHY, cw, cb, row, c); x1[tid] = hy_short(PHY, cw, cb, row, HYC + c); x2[tid] = hy_short(PHY, cw, cb, row, 2 * HYC + c);
      for (int q = tid; q < 1024; q += NTHR) { const int od = q >> 8, n = q & 255; hf[q] = bf2f(fc[(size_t)(od * 256 + c) * CTX + n]); } }
    __syncthreads();
    { const int b = tid >> 8, t = tid & 255; float y = bias0 * vv[tid];
      for (int s = 0; s <= t; ++s) y += hf[t - s] * vv[b * 256 + s];
      for (int s = t + 1; s < CTX; ++s) y += hf[256 + s - t] * vv[b * 256 + s];
      z1[tid] = x1[tid] * y; }
    __syncthreads();
    { const int b = tid >> 8, t = tid & 255; float y = bias1 * z1[tid];
      for (int s = 0; s <= t; ++s) y += hf[512 + t - s] * z1[b * 256 + s];
      for (int s = t + 1; s < CTX; ++s) y += hf[768 + s - t] * z1[b * 256 + s];
      bf16_t* MIX = (bf16_t*)(P.ws + WS_U); MIX[(size_t)(TL + b * CTX + t) * D + c] = f2bf(x2[tid] * y); }
    __syncthreads();
}
__device__ __forceinline__ void hy_task2(const Params& P, int l, int c, float2* X) {
    const int tid = otid();
    const bf16_t* PHY = (const bf16_t*)(P.ws + WS_PHY); const float* cw = P.in[I_HCW] + (size_t)l * 3 * HY_IN; const float* cb = P.in[I_HCB] + (size_t)l * HY_IN;
    const float bias1 = P.in[I_HBIAS][(size_t)l * 2 * HYC + HYC + c];
    const float* Z1 = (const float*)(P.ws + WS_Z1) + (size_t)c * NB * SEQ;
    for (int n = tid; n < SEQ; n += NTHR) { X[n] = make_float2(Z1[n], Z1[SEQ + n]); X[SEQ + n] = make_float2(0.f, 0.f); }
    __syncthreads();
    hy_conv_core(P, 1, c, X);
    bf16_t* MIX = (bf16_t*)(P.ws + WS_U);
    const HyTap tg2 = hy_tap(cw, cb, 2 * HYC + c); const bf16_t* colg2 = PHY + (size_t)(2 * HYC + c) * T;
#pragma unroll 4
    for (int n = tid; n < SEQ; n += NTHR) { const float2 y = X[n];
        const float g0 = hy_lat(colg2, 0, n, tg2), g1 = hy_lat(colg2, 1, n, tg2);
        MIX[(size_t)n * D + c] = f2bf(g0 * (y.x + bias1 * Z1[n])); MIX[(size_t)(SEQ + n) * D + c] = f2bf(g1 * (y.y + bias1 * Z1[SEQ + n])); }
    __syncthreads();
}

constexpr int SEGC = 256, NSEG = 33, SCH = 4;
typedef float f32x2v __attribute__((ext_vector_type(2)));
template <bool IDENT>
__device__ __forceinline__ void scan_seg(const Params& P, int chain, int g, float* ring_  ) {
    const ldsfp ring = vlds(ring_);
    const int lane = otid() & 63;
    const int d = chain & 1, h = (chain >> 1) % 6, b = chain / 12;
    const float* DEC = (const float*)(P.ws + WS_DECAY) + (size_t)d * T * 384; const bf16_t* KKS = (const bf16_t*)(P.ws + WS_KKS); const bf16_t* RS = (const bf16_t*)(P.ws + WS_RS);
    const bf16_t* VS = (const bf16_t*)(P.ws + WS_VS); const bf16_t* KS = (const bf16_t*)(P.ws + WS_KS) + (size_t)d * T * 384; const bf16_t* BS = (const bf16_t*)(P.ws + WS_BS) + (size_t)d * T * 384;
    float* YD = (float*)(P.ws + WS_YDIR) + (size_t)d * T * 384;
    bf16_t* E = (bf16_t*)(P.ws + WS_E) + (size_t)chain * SEQ * 64;
    const int step0 = g == 0 ? 0 : CTX + (g - 1) * SEGC;
    f32x2v S0[32], S1[32];
#pragma unroll
    for (int j = 0; j < 32; ++j) { S0[j] = (f32x2v){0.f, 0.f}; S1[j] = (f32x2v){(2 * j == lane) ? 1.f : 0.f, (2 * j + 1 == lane) ? 1.f : 0.f}; }
    float pw[SCH], pa[SCH], pb[SCH], pk[SCH], pr[SCH], pv[SCH]; int po[SCH];
#pragma unroll
    for (int s = 0; s < SCH; ++s) { const int o = scan_row(b, d, step0 + s) * 384 + h * 64 + lane; po[s] = o;
        pw[s] = DEC[o]; pa[s] = bf2f(KKS[o]); pb[s] = bf2f(BS[o]); pk[s] = bf2f(KS[o]); pr[s] = bf2f(RS[o]); pv[s] = bf2f(VS[o]); }
    for (int c = 0; c < SEGC / SCH; ++c) {
        float cv[SCH]; int co[SCH];
        asm volatile("s_waitcnt lgkmcnt(0)" ::: "memory");
#pragma unroll
        for (int s = 0; s < SCH; ++s) { const ldsfp sv = ring + s * 320; sv[lane] = pw[s]; sv[64 + lane] = pa[s]; sv[128 + lane] = pb[s]; sv[192 + lane] = pk[s]; sv[256 + lane] = pr[s]; cv[s] = pv[s]; co[s] = po[s]; }
        asm volatile("s_waitcnt lgkmcnt(0)" ::: "memory");
        if (c + 1 < SEGC / SCH) {
#pragma unroll
            for (int s = 0; s < SCH; ++s) { const int o = scan_row(b, d, step0 + (c + 1) * SCH + s) * 384 + h * 64 + lane; po[s] = o;
                pw[s] = DEC[o]; pa[s] = bf2f(KKS[o]); pb[s] = bf2f(BS[o]); pk[s] = bf2f(KS[o]); pr[s] = bf2f(RS[o]); pv[s] = bf2f(VS[o]); } }
#pragma unroll
        for (int s = 0; s < SCH; ++s) { const ldsfp sv = ring + s * 320;
            f32x2v sa2 = (f32x2v){0.f, 0.f}, sb2 = (f32x2v){0.f, 0.f}, sa3 = sa2, sb3 = sa2;
#pragma unroll
            for (int hb = 0; hb < 2; ++hb) { f32x4 A[8];
#pragma unroll
                for (int i = 0; i < 8; ++i) A[i] = *(const LAS f32x4*)(sv + 64 + hb * 32 + 4 * i);
                __builtin_amdgcn_sched_barrier(0);
#pragma unroll
                for (int i = 0; i < 8; ++i) { const int jj = hb * 16 + 2 * i; const f32x2v alo = (f32x2v){A[i].x, A[i].y}, ahi = (f32x2v){A[i].z, A[i].w};
                    sa2 += S0[jj] * alo; sa3 += S0[jj + 1] * ahi;
                    if (IDENT) { sb2 += S1[jj] * alo; sb3 += S1[jj + 1] * ahi; } }
                __builtin_amdgcn_sched_barrier(0); }
            const float sa = (sa2.x + sa2.y) + (sa3.x + sa3.y), sb = (sb2.x + sb2.y) + (sb3.x + sb3.y);
            const f32x2v saa = (f32x2v){sa, sa}, sbb = (f32x2v){sb, sb}, vv = (f32x2v){cv[s], cv[s]};
            f32x2v y2 = (f32x2v){0.f, 0.f}, y3 = y2, e2 = y2, e3 = y2;
#pragma unroll
            for (int ch = 0; ch < 8; ++ch) { f32x4 W[2], Bq[2], K[2], R[2];
#pragma unroll
                for (int i = 0; i < 2; ++i) { const int j = ch * 8 + 4 * i; W[i] = *(const LAS f32x4*)(sv + j); Bq[i] = *(const LAS f32x4*)(sv + 128 + j); K[i] = *(const LAS f32x4*)(sv + 192 + j); R[i] = *(const LAS f32x4*)(sv + 256 + j); }
                __builtin_amdgcn_sched_barrier(0);
#pragma unroll
                for (int i = 0; i < 2; ++i) { const int jj = ch * 4 + 2 * i;
                    const f32x2v wlo = (f32x2v){W[i].x, W[i].y}, whi = (f32x2v){W[i].z, W[i].w}, blo = (f32x2v){Bq[i].x, Bq[i].y}, bhi = (f32x2v){Bq[i].z, Bq[i].w};
                    const f32x2v klo = (f32x2v){K[i].x, K[i].y}, khi = (f32x2v){K[i].z, K[i].w}, rlo = (f32x2v){R[i].x, R[i].y}, rhi = (f32x2v){R[i].z, R[i].w};
                    S0[jj] = S0[jj] * wlo + saa * blo + vv * klo; y2 += S0[jj] * rlo;
                    S0[jj + 1] = S0[jj + 1] * whi + saa * bhi + vv * khi; y3 += S0[jj + 1] * rhi;
                    if (IDENT) { S1[jj] = S1[jj] * wlo + sbb * blo; e2 += S1[jj] * rlo; S1[jj + 1] = S1[jj + 1] * whi + sbb * bhi; e3 += S1[jj + 1] * rhi; } }
                __builtin_amdgcn_sched_barrier(0); }
            YD[co[s]] = (y2.x + y2.y) + (y3.x + y3.y);
            if (IDENT) { const int tl = d ? (SEQ - 1 - (step0 - CTX + c * SCH + s)) : (step0 - CTX + c * SCH + s); E[(size_t)tl * 64 + lane] = f2bf((e2.x + e2.y) + (e3.x + e3.y)); }
        }
    }
    float* ZP = (float*)(P.ws + WS_ZP) + ((size_t)chain * NSEG + g) * 2 * 4096;
#pragma unroll
    for (int j = 0; j < 32; j += 2) { *(float4*)(ZP + lane * 64 + 2 * j) = make_float4(S0[j].x, S0[j].y, S0[j + 1].x, S0[j + 1].y);
        if (IDENT) *(float4*)(ZP + 4096 + lane * 64 + 2 * j) = make_float4(S1[j].x, S1[j].y, S1[j + 1].x, S1[j + 1].y); }
}
__device__ __forceinline__ void scan_combine(const Params& P, int chain, float* lds) {
    const int tid = otid(); const int i = tid >> 3, j0 = (tid & 7) * 8;
    float* Sl = lds;
    float* Pl = lds + 64 * 65;
    float* ZPc = (float*)(P.ws + WS_ZP) + (size_t)chain * NSEG * 2 * 4096;
    float sn[8];
#pragma unroll
    for (int q = 0; q < 8; ++q) sn[q] = ZPc[i * 64 + j0 + q];
    for (int g = 1; g < NSEG - 1; ++g) {
        __syncthreads();
#pragma unroll
        for (int q = 0; q < 8; ++q) Sl[i * 65 + j0 + q] = sn[q];
        const float* Pg = ZPc + (size_t)g * 2 * 4096 + 4096;
#pragma unroll
        for (int q = 0; q < 8; ++q) Pl[tid * 8 + q] = Pg[tid * 8 + q];
        float* Zg = ZPc + (size_t)g * 2 * 4096;
#pragma unroll
        for (int q = 0; q < 8; ++q) sn[q] = Zg[i * 64 + j0 + q];
        __syncthreads();
        for (int m = 0; m < 64; ++m) { const float sv = Sl[i * 65 + m]; const float4 p0 = *(const float4*)(Pl + m * 64 + j0), p1 = *(const float4*)(Pl + m * 64 + j0 + 4);
            sn[0] += sv * p0.x; sn[1] += sv * p0.y; sn[2] += sv * p0.z; sn[3] += sv * p0.w; sn[4] += sv * p1.x; sn[5] += sv * p1.y; sn[6] += sv * p1.z; sn[7] += sv * p1.w; }
#pragma unroll
        for (int q = 0; q < 8; ++q) Zg[i * 64 + j0 + q] = sn[q];
    }
    __syncthreads();
}

__device__ __forceinline__ void rwkv_out_fin(const Params& P, int row, int c, float y, float lnw, float lnb, float bon, float vs, float gt) {
    bf16_t* MIX = (bf16_t*)(P.ws + WS_U);
    const float mean = wsum(y) * (1.0f / 64.0f); const float dv = y - mean; const float var = wsum(dv * dv) * (1.0f / 64.0f);
    const float yn = dv * rsqrtf(var + 64e-5f) * lnw + lnb;
    MIX[(size_t)row * D + 256 + c] = f2bf((yn + bon * vs) * gt);
}
__device__ __forceinline__ void ph_rwkvout(const Params& P, int l, float* ldsf) {
    using pg8::bf16x8;
    const int tid = otid(), lane = tid & 63, fr = lane & 15, fq = lane >> 4, wv = tid >> 6, gw = blockIdx.x * NWAVE + wv, nw = gridDim.x * NWAVE;
    const float* YD = (const float*)(P.ws + WS_YDIR); const bf16_t* VS = (const bf16_t*)(P.ws + WS_VS); const bf16_t* GT = (const bf16_t*)(P.ws + WS_GATE); const float* BON = (const float*)(P.ws + WS_BONUS);
    bf16_t* MIX = (bf16_t*)(P.ws + WS_U);
    for (int it = gw; it < NB * 6 * 32 * 4; it += nw) {
        const int sub = it & 3, q = (it >> 2) & 31, h = (it >> 7) % 6, b = it / (128 * 6);
        const int t0 = q * 256 + sub * 64;
        f32x4 acc[4][4];
#pragma unroll
        for (int mt = 0; mt < 4; ++mt)
#pragma unroll
            for (int nt = 0; nt < 4; ++nt) acc[mt][nt] = (f32x4){0.f, 0.f, 0.f, 0.f};
#pragma unroll
        for (int dir = 0; dir < 2; ++dir) { const int ch = b * 12 + h * 2 + dir, slot = dir ? (31 - q) : q;
            const float* Sp = (const float*)(P.ws + WS_ZP) + ((size_t)ch * NSEG + slot) * 2 * 4096;
            const bf16_t* Ep = (const bf16_t*)(P.ws + WS_E) + ((size_t)ch * SEQ + t0) * 64;
#pragma unroll
            for (int ks = 0; ks < 2; ++ks) { bf16x8 bop[4];
#pragma unroll
                for (int nt = 0; nt < 4; ++nt) { const float* sp = Sp + (nt * 16 + fr) * 64 + ks * 32 + fq * 8; const float4 s0 = *(const float4*)sp, s1 = *(const float4*)(sp + 4);
                    u32x4 w; w.x = cvt_pk_bf16(s0.x, s0.y); w.y = cvt_pk_bf16(s0.z, s0.w); w.z = cvt_pk_bf16(s1.x, s1.y); w.w = cvt_pk_bf16(s1.z, s1.w); bop[nt] = __builtin_bit_cast(bf16x8, w); }
#pragma unroll
                for (int mt = 0; mt < 4; ++mt) { const bf16x8 a = *(const bf16x8*)(Ep + (size_t)(mt * 16 + fr) * 64 + ks * 32 + fq * 8);
#pragma unroll
                    for (int nt = 0; nt < 4; ++nt) acc[mt][nt] = __builtin_amdgcn_mfma_f32_16x16x32_bf16(a, bop[nt], acc[mt][nt], 0, 0, 0); } } }
        float lnw[4], lnb[4];
#pragma unroll
        for (int nt = 0; nt < 4; ++nt) { lnw[nt] = P.in[I_LNW][l * RWW + h * 64 + nt * 16 + fr]; lnb[nt] = P.in[I_LNB][l * RWW + h * 64 + nt * 16 + fr]; }
#pragma unroll
        for (int mt = 0; mt < 4; ++mt)
#pragma unroll
            for (int rg = 0; rg < 4; ++rg) { const int row = b * SEQ + t0 + mt * 16 + fq * 4 + rg; const size_t o = (size_t)row * 384 + h * 64 + fr;
                float y[4], vs[4], gt[4]; const float bon = BON[(size_t)row * 6 + h];
#pragma unroll
                for (int nt = 0; nt < 4; ++nt) { y[nt] = YD[o + nt * 16] + YD[(size_t)T * 384 + o + nt * 16] + acc[mt][nt][rg]; vs[nt] = bf2f(VS[o + nt * 16]); gt[nt] = bf2f(GT[o + nt * 16]); }
                float sm = (y[0] + y[1]) + (y[2] + y[3]);
                sm += __shfl_xor(sm, 1); sm += __shfl_xor(sm, 2); sm += __shfl_xor(sm, 4); sm += __shfl_xor(sm, 8);
                const float mean = sm * (1.0f / 64.0f);
                float vr = 0.f;
#pragma unroll
                for (int nt = 0; nt < 4; ++nt) { y[nt] -= mean; vr += y[nt] * y[nt]; }
                vr += __shfl_xor(vr, 1); vr += __shfl_xor(vr, 2); vr += __shfl_xor(vr, 4); vr += __shfl_xor(vr, 8);
                const float rstd = rsqrtf(vr * (1.0f / 64.0f) + 64e-5f);
#pragma unroll
                for (int nt = 0; nt < 4; ++nt) MIX[(size_t)row * D + 256 + h * 64 + nt * 16 + fr] = f2bf((y[nt] * rstd * lnw[nt] + lnb[nt] + bon * vs[nt]) * gt[nt]);
                if (rg & 1) asm volatile("" ::: "memory"); }
    }
    for (int it = gw; it < TC * 6; it += nw) { const int row = TL + it / 6, h = it % 6, c = h * 64 + lane; const size_t o = (size_t)row * 384 + c;
        rwkv_out_fin(P, row, c, YD[o] + YD[(size_t)T * 384 + o], P.in[I_LNW][l * RWW + c], P.in[I_LNB][l * RWW + c], BON[(size_t)row * 6 + h], bf2f(VS[o]), bf2f(GT[o])); }
}

typedef const __attribute__((address_space(4))) Params* KParamsPtr;
__device__ __forceinline__ const Params* fresh_params() { KParamsPtr q = (KParamsPtr)__builtin_amdgcn_kernarg_segment_ptr(); asm volatile("" : "+s"(q)); return (const Params*)q; }
__global__ void __launch_bounds__(NTHR, 2) fwd_megakernel(Params P_unused, int ph_lo, int ph_hi) {
    extern __shared__ __attribute__((aligned(16))) unsigned char smem[];
    cg::grid_group grid = cg::this_grid();
    LAS unsigned char* lds3 = (LAS unsigned char*)smem;
    float* ldsf = (float*)smem; float2* X = (float2*)smem; float* ex = (float*)(smem + LDS_MAIN);
    { volatile LAS unsigned* st = (volatile LAS unsigned*)(lds3 + LDS_MAIN + 4096); if (threadIdx.x == 0) { st[0] = 0u; st[1] = 0u; } }
    __syncthreads();
    XcdBarrier xbar = xcd_barrier_post((unsigned*)(((const Params*)fresh_params())->ws + WS_BAR), (volatile LAS unsigned*)(lds3 + LDS_MAIN + 4096));
    int ph = 0;
#ifndef REP_GEMM
#define REP_GEMM 1
#endif
#ifndef REP_SCAN
#define REP_SCAN 1
#endif
#ifndef REP_MISC
#define REP_MISC 1
#endif
#ifndef REP_HY
#define REP_HY 1
#endif
#define PHASE_BEGIN if (ph >= ph_lo && ph < ph_hi) { const Params& P = *fresh_params(); unsigned char* ws = P.ws; (void)ws;
#ifndef REP_SYNC
#define REP_SYNC 1
#endif
#define PHASE_END   if (ph + 1 < ph_hi) { for (int rs_ = 0; rs_ < REP_SYNC; ++rs_) { if (ph == 0) grid.sync(); else xcd_barrier(xbar); } } } ++ph;
    PHASE_BEGIN ph_modv(P, ldsf); PHASE_END
    for (int l = 0; l < DEPTH; ++l) {
        PHASE_BEGIN
            for (int rep_ = 0; rep_ < REP_MISC; ++rep_) ph_prep(P, l, ldsf);
            if (l == 0) ph_rowpass(P, 0, 0, 0, 0, 0.f, 0, 0, 0, 1);
            else ph_rowpass(P, 1, l - 1, 8, 5, 0.5f, l, 0, 0, 1);
        PHASE_END
        PHASE_BEGIN { EpiGU E{(bf16_t*)(ws + WS_ACT)}; for (int rep_ = 0; rep_ < REP_GEMM; ++rep_) run_gemm(lds3, (const bf16_t*)(ws + WS_U), (const bf16_t*)(ws + WS_WGU1), T, 2 * DFF, D, E); } PHASE_END
        PHASE_BEGIN { EpiF32 E{(bf16_t*)(ws + WS_Y)}; for (int rep_ = 0; rep_ < REP_GEMM; ++rep_) run_gemm(lds3, (const bf16_t*)(ws + WS_ACT), (const bf16_t*)(ws + WS_WDN1), T, D, DFF, E); } PHASE_END
        PHASE_BEGIN ph_rowpass(P, 1, l, 2, 1, 0.5f, l, 2, 3, 4); PHASE_END
        PHASE_BEGIN { EpiWin E{(bf16_t*)(ws + WS_PHY), (bf16_t*)(ws + WS_PRW), (bf16_t*)(ws + WS_PNA)}; for (int rep_ = 0; rep_ < REP_GEMM; ++rep_) run_gemm(lds3, (const bf16_t*)(ws + WS_U), (const bf16_t*)(ws + WS_WIN), T, INWP, D, E); } PHASE_END
        PHASE_BEGIN
            for (int rep_ = 0; rep_ < REP_MISC; ++rep_) { ph_loraprep(P, l);
            for (int it = blockIdx.x; it < NB * 128 * 6 + NB * 4 * 6; it += gridDim.x) vt_tile(P, it, (unsigned short*)smem); }
            for (int rep_ = 0; rep_ < REP_HY; ++rep_) for (int it = blockIdx.x; it < 512; it += gridDim.x) hy_spec_task(P, l, it >> 8, it & 255, X, ex);
        PHASE_END
        PHASE_BEGIN { EpiLora E{(bf16_t*)(ws + WS_LORAO), (bf16_t*)(ws + WS_GATE)};
            for (int rep_ = 0; rep_ < REP_GEMM; ++rep_) run_gemm(lds3, (const bf16_t*)(ws + WS_ALORA), (const bf16_t*)(ws + WS_WLORA), T, 2048, 384, E); } PHASE_END
        PHASE_BEGIN
            for (int rep_ = 0; rep_ < REP_MISC; ++rep_) ph_rwkvprep(P, l);
            for (int rep_ = 0; rep_ < REP_HY; ++rep_) for (int c = blockIdx.x; c < HYC; c += gridDim.x) hy_task1(P, l, c, X, ex);
        PHASE_END
        PHASE_BEGIN {
            const int wv = __builtin_amdgcn_readfirstlane(otid() >> 6);
            if (wv < 4) { const int k = wv * (int)gridDim.x + (int)blockIdx.x;
                if (k < 24 * NSEG) { const int chain = k / NSEG, g = k % NSEG; float* ring = ldsf + wv * (SCH * 320);
                    for (int rep_ = 0; rep_ < REP_SCAN; ++rep_) { if (g == 0) scan_seg<false>(P, chain, g, ring); else scan_seg<true>(P, chain, g, ring); } } }
            else for (int it = (wv - 4) * (int)gridDim.x + (int)blockIdx.x; it < NAT_TASKS; it += 4 * (int)gridDim.x) natten_task(P, l, it);
        } PHASE_END
        PHASE_BEGIN
            if (blockIdx.x < 24) scan_combine(P, blockIdx.x, ldsf);
            else for (int rep_ = 0; rep_ < REP_HY; ++rep_) for (int c = blockIdx.x - 24; c < HYC; c += gridDim.x - 24) hy_task2(P, l, c, X);
        PHASE_END
        PHASE_BEGIN for (int rep_ = 0; rep_ < REP_MISC; ++rep_) ph_rwkvout(P, l, ldsf); PHASE_END
        PHASE_BEGIN { EpiF32 E{(bf16_t*)(ws + WS_Y)}; for (int rep_ = 0; rep_ < REP_GEMM; ++rep_) run_gemm(lds3, (const bf16_t*)(ws + WS_U), (const bf16_t*)(ws + WS_WOUT), T, D, D, E); } PHASE_END
        PHASE_BEGIN ph_rowpass(P, 1, l, 5, 3, 1.0f, l, 4, 6, 7); PHASE_END
        PHASE_BEGIN { EpiGU E{(bf16_t*)(ws + WS_ACT)}; for (int rep_ = 0; rep_ < REP_GEMM; ++rep_) run_gemm(lds3, (const bf16_t*)(ws + WS_U), (const bf16_t*)(ws + WS_WGU2), T, 2 * DFF, D, E); } PHASE_END
        PHASE_BEGIN { EpiF32 E{(bf16_t*)(ws + WS_Y)}; for (int rep_ = 0; rep_ < REP_GEMM; ++rep_) run_gemm(lds3, (const bf16_t*)(ws + WS_ACT), (const bf16_t*)(ws + WS_WDN2), T, D, DFF, E); } PHASE_END
    }
    PHASE_BEGIN ph_rowpass(P, 2, DEPTH - 1, 8, 5, 0.5f, 0, 0, 0, 0); PHASE_END
#undef PHASE_BEGIN
#undef PHASE_END
}
constexpr int N_PHASES = 1 + DEPTH * 15 + 1;

extern "C" void kernel_launch(void* const* d_in, const int* in_sizes, int n_in, void* d_out, int out_size, void* d_ws, size_t ws_size, hipStream_t stream) {
    static int grid = 0;
    if (grid == 0) {
        if (n_in != 34 || ws_size < WS_END) { fprintf(stderr, "kernel_launch: need 34 inputs and %zu bytes of workspace; got %d, %zu\n", (size_t)WS_END, n_in, ws_size); grid = -1; return; }
        int dev = 0, cus = 0, per_cu = 0;
        hipGetDevice(&dev); hipDeviceGetAttribute(&cus, hipDeviceAttributeMultiprocessorCount, dev);
        if (hipFuncSetAttribute((const void*)fwd_megakernel, hipFuncAttributeMaxDynamicSharedMemorySize, LDS_BYTES) != hipSuccess) { fprintf(stderr, "kernel_launch: hipFuncSetAttribute failed\n"); grid = -1; return; }
        if (hipOccupancyMaxActiveBlocksPerMultiprocessor(&per_cu, (const void*)fwd_megakernel, NTHR, LDS_BYTES) != hipSuccess || per_cu < 1) { fprintf(stderr, "kernel_launch: occupancy query says %d\n", per_cu); per_cu = 1; }
        (void)hipGetLastError();
        grid = cus;
    }
    if (grid < 0) return;
    if (hipMemsetAsync((char*)d_ws + WS_BAR, 0, (size_t)XCD_BAR_WORDS * 4, stream) != hipSuccess) { fprintf(stderr, "kernel_launch: memset of the barrier words failed\n"); return; }
    Params p{};
    for (int i = 0; i < 34; ++i) p.in[i] = (const float*)d_in[i];
    p.out = (float*)d_out; p.ws = (unsigned char*)d_ws;
#if MK_SPLIT
    for (int ph = 0; ph < N_PHASES; ++ph) { int lo = ph, hi = ph + 1; hipLaunchKernelGGL(fwd_megakernel, dim3(grid), dim3(NTHR), LDS_BYTES, stream, p, lo, hi); }
#else
    int lo = 0, hi = N_PHASES;
    void* args[] = {&p, &lo, &hi};
    hipError_t e = hipLaunchCooperativeKernel((const void*)fwd_megakernel, dim3(grid), dim3(NTHR), args, LDS_BYTES, stream);
    if (e != hipSuccess) fprintf(stderr, "cooperative launch failed: %s (grid %d)\n", hipGetErrorString(e), grid);
#endif
}
```

```cpp
#include <hip/hip_runtime.h>
#include <hip/hip_cooperative_groups.h>
#include <cstdio>
namespace cg = cooperative_groups;
__device__ __forceinline__ int otid() { int t = threadIdx.x; asm volatile("" : "+v"(t)); return t; }
namespace pg8 {
#define PG8_LAS __attribute__((address_space(3)))
typedef unsigned short bf16_t;
typedef short bf16x8 __attribute__((ext_vector_type(8)));
typedef float f32x4 __attribute__((ext_vector_type(4)));
typedef unsigned u32x4 __attribute__((ext_vector_type(4)));
constexpr int BM = 256, BK = 64, HALF = 128, HTB = HALF * BK * 2  , STAGE_BYTES = 8 * HTB, NXCD = 8, WGM = 8;

__host__ __device__ __forceinline__ int lds_byte(int r, int c) { const int st = (r >> 4) * 2 + (c >> 5), rr = r & 15, cc = c & 31, ob = rr * 64 + cc * 2; return st * 1024 + (ob ^ (((ob >> 9) & 1) << 5)); }
__host__ __device__ __forceinline__ void stage_rc(int b, int& R, int& C) { const int st = b / 1024, sb = b % 1024, swz = sb ^ (((sb >> 9) & 1) << 5); R = (st >> 1) * 16 + swz / 64; C = (st & 1) * 32 + (swz % 64) / 2; }
__host__ __device__ __forceinline__ int perm32(int rho) { const int n = rho >> 4, i = rho & 15; return 8 * (i >> 2) + 4 * n + (i & 3); }

struct Unit { int pm, pn; };
struct Gemm { const bf16_t* A; const bf16_t* Bt; int M, N, K; };
struct StaticOrder {
    int nM, nN, nwg, G, c;
    __host__ __device__ void init(int M, int N, int G_, int c_) { nM = M / BM; nN = N / BM; nwg = nM * nN; G = G_; c = c_; }
    __host__ __device__ bool next(int i, Unit& u) const {
        const long L = (long)i * G + c; if (L >= nwg) return false;
        int wgid = (int)L; { const int q = nwg / NXCD, r = nwg % NXCD, xcd = wgid % NXCD, off = wgid / NXCD; wgid = (xcd < r ? xcd * (q + 1) : r * (q + 1) + (xcd - r) * q) + off; }
        const int nig = WGM * nN, gid = wgid / nig, fm = gid * WGM, gsz = (nM - fm) < WGM ? (nM - fm) : WGM;
        u.pm = fm + ((wgid % nig) % gsz); u.pn = (wgid % nig) / gsz; return true;
    }
    __device__ __forceinline__ void a_ready(const Unit&) const {}
    __device__ __forceinline__ void done(const Unit&) const {}
};
__device__ __forceinline__ unsigned cvt_pk_bf16(float lo, float hi) { unsigned r; asm volatile("v_cvt_pk_bf16_f32 %0, %1, %2" : "=v"(r) : "v"(lo), "v"(hi)); return r; }
template <class Epi, class Sched>
__device__ __forceinline__ void gemm_phase(PG8_LAS unsigned char* lds, const Gemm g, const Sched& S, const Epi& E) {
    const int tid = otid(), wid = __builtin_amdgcn_readfirstlane(tid >> 6), lane = tid & 63, wr = wid >> 2, wc = wid & 3, fr = lane & 15, fq = lane >> 4;
    const int K = g.K, nt = K / BK;
#define PG8_STAMP() do {} while (0)
    unsigned voffA[2], voffB[2];
#pragma unroll
    for (int i = 0; i < 2; ++i) { int R, C; stage_rc(tid * 16 + i * 8192, R, C); const int Rb = Epi::PERM ? ((R & ~31) + perm32(R & 31)) : R;
        voffA[i] = (unsigned)(R * K + C) * 2u; voffB[i] = (unsigned)(Rb * K + C) * 2u; }
    const size_t kstep = (size_t)(BK * 2);
    const size_t hstep = (size_t)HALF * K * 2;
    const size_t tstep = 2 * hstep;
    const unsigned ldsw = (unsigned)wid * 1024u;
    const int aoff = lds_byte(wr * 64 + fr, fq * 8), boff = lds_byte(wc * 32 + fr, fq * 8);
#define PG8_SA(b, h) (((b) * 2 + (h)) * HTB)
#define PG8_SB(b, h) ((4 + (b) * 2 + (h)) * HTB)
#define PG8_STAGE(bufoff, gbase, voff) do { _Pragma("unroll") for (int _i = 0; _i < 2; ++_i) \
        __builtin_amdgcn_global_load_lds((const unsigned*)((const char*)(gbase) + (voff)[_i]), (PG8_LAS unsigned*)(lds + (bufoff) + ldsw + _i * 8192), 16, 0, 0); } while (0)
#define PG8_LDA(dst, b, h) do { _Pragma("unroll") for (int m = 0; m < 4; ++m) _Pragma("unroll") for (int k = 0; k < 2; ++k) dst[m][k] = *(const PG8_LAS bf16x8*)(lds + PG8_SA(b, h) + aoff + m * 2048 + k * 1024); } while (0)
#define PG8_LDB(dst, b, h) do { _Pragma("unroll") for (int n = 0; n < 2; ++n) _Pragma("unroll") for (int k = 0; k < 2; ++k) dst[n][k] = *(const PG8_LAS bf16x8*)(lds + PG8_SB(b, h) + boff + n * 2048 + k * 1024); } while (0)
#define PG8_MMA(ai, bj, At, Bt) do { __builtin_amdgcn_s_setprio(1); _Pragma("unroll") for (int m = 0; m < 4; ++m) _Pragma("unroll") for (int n = 0; n < 2; ++n) _Pragma("unroll") for (int k = 0; k < 2; ++k) \
        acc[ai][bj][m][n] = __builtin_amdgcn_mfma_f32_16x16x32_bf16(Bt[n][k], At[m][k], acc[ai][bj][m][n], 0, 0, 0); __builtin_amdgcn_s_setprio(0); } while (0)
#define PG8_WAIT_V(n) asm volatile("s_waitcnt vmcnt(" #n ")" ::: "memory")
#define PG8_WAIT_L(n) asm volatile("s_waitcnt lgkmcnt(" #n ")" ::: "memory")
#define PG8_BAR __builtin_amdgcn_s_barrier()
#define PG8_SCHED __builtin_amdgcn_sched_barrier(0)
    Unit cur, nxt; int ui = 0;
    if (!S.next(0, cur)) return;
    f32x4 acc[2][2][4][2];
#pragma unroll
    for (int a = 0; a < 2; ++a)
#pragma unroll
        for (int b = 0; b < 2; ++b)
#pragma unroll
            for (int m = 0; m < 4; ++m)
#pragma unroll
                for (int n = 0; n < 2; ++n) acc[a][b][m][n] = (f32x4){0.f, 0.f, 0.f, 0.f};
    bf16x8 At[4][2], B0[2][2], B1[2][2];
    const char* cA = (const char*)g.A + (size_t)cur.pm * tstep; const char* cB = (const char*)g.Bt + (size_t)cur.pn * tstep;
    S.a_ready(cur);
    PG8_STAGE(PG8_SB(0, 0), cB, voffB); PG8_STAGE(PG8_SA(0, 0), cA, voffA); PG8_STAGE(PG8_SB(0, 1), cB + hstep, voffB); PG8_STAGE(PG8_SA(0, 1), cA + hstep, voffA);
    if (wr == 1) PG8_BAR;
    PG8_WAIT_V(4); PG8_BAR;
    PG8_STAGE(PG8_SB(1, 0), cB + kstep, voffB); PG8_STAGE(PG8_SA(1, 0), cA + kstep, voffA); PG8_STAGE(PG8_SB(1, 1), cB + hstep + kstep, voffB);
    PG8_WAIT_V(6); PG8_BAR;
    PG8_STAMP();
    for (;;) {
        const bool has_next = S.next(ui + 1, nxt);
        const char* nA = has_next ? (const char*)g.A + (size_t)nxt.pm * tstep : cA; const char* nB = has_next ? (const char*)g.Bt + (size_t)nxt.pn * tstep : cB;
        for (int t = 0; t < nt; t += 2) {
            const bool last = (t == nt - 2);
            const char* a1 = cA + (size_t)(t + 1) * kstep;
            const char* a2 = last ? nA : cA + (size_t)(t + 2) * kstep; const char* b2 = last ? nB : cB + (size_t)(t + 2) * kstep;
            const char* a3 = a2 + kstep; const char* b3 = b2 + kstep;
            if (last && has_next) S.a_ready(nxt);
            PG8_LDB(B0, 0, 0); PG8_SCHED; PG8_LDA(At, 0, 0); PG8_STAGE(PG8_SA(1, 1), a1 + hstep, voffA);
            PG8_WAIT_L(8); PG8_BAR; PG8_WAIT_L(0); PG8_MMA(0, 0, At, B0); PG8_BAR; PG8_SCHED;
            PG8_LDB(B1, 0, 1); PG8_STAGE(PG8_SB(0, 0), b2, voffB);
            PG8_BAR; PG8_WAIT_L(0); PG8_MMA(0, 1, At, B1); PG8_BAR;
            PG8_LDA(At, 0, 1); PG8_STAGE(PG8_SA(0, 0), a2, voffA);
            PG8_BAR; PG8_WAIT_L(0); PG8_MMA(1, 0, At, B0); PG8_BAR; PG8_SCHED;
            PG8_STAGE(PG8_SB(0, 1), b2 + hstep, voffB);
            PG8_WAIT_V(6); PG8_BAR; PG8_MMA(1, 1, At, B1); PG8_BAR;
            PG8_LDB(B0, 1, 0); PG8_SCHED; PG8_LDA(At, 1, 0); PG8_STAGE(PG8_SA(0, 1), a2 + hstep, voffA);
            PG8_WAIT_L(8); PG8_BAR; PG8_WAIT_L(0); PG8_MMA(0, 0, At, B0); PG8_BAR; PG8_SCHED;
            PG8_LDB(B1, 1, 1); PG8_STAGE(PG8_SB(1, 0), b3, voffB);
            PG8_BAR; PG8_WAIT_L(0); PG8_MMA(0, 1, At, B1); PG8_BAR;
            PG8_LDA(At, 1, 1); PG8_STAGE(PG8_SA(1, 0), a3, voffA);
            PG8_BAR; PG8_WAIT_L(0); PG8_MMA(1, 0, At, B0); PG8_BAR; PG8_SCHED;
            PG8_STAGE(PG8_SB(1, 1), b3 + hstep, voffB);
            PG8_WAIT_V(6); PG8_BAR; PG8_MMA(1, 1, At, B1); PG8_BAR;
        }
        PG8_STAMP();
        if constexpr (!Epi::AFTER_DRAIN) { E(acc, cur, wr, wc, fr, fq); S.done(cur); }
        PG8_STAMP();
        if (!has_next) break;
#pragma unroll
        for (int a = 0; a < 2; ++a)
#pragma unroll
            for (int b = 0; b < 2; ++b)
#pragma unroll
                for (int m = 0; m < 4; ++m)
#pragma unroll
                    for (int n = 0; n < 2; ++n) acc[a][b][m][n] = (f32x4){0.f, 0.f, 0.f, 0.f};
        cur = nxt; cA = nA; cB = nB; ++ui;
    }
    PG8_WAIT_V(0);
    if (wr == 0) PG8_BAR;
    PG8_BAR;
    if constexpr (Epi::AFTER_DRAIN) { E.fused(acc, cur, wr, wc, fr, fq, lds, wid, lane); S.done(cur); }
    PG8_STAMP();
#undef PG8_STAMP
#undef PG8_SA
#undef PG8_SB
#undef PG8_STAGE
#undef PG8_LDA
#undef PG8_LDB
#undef PG8_MMA
#undef PG8_WAIT_V
#undef PG8_WAIT_L
#undef PG8_BAR
#undef PG8_SCHED
}
}
#define LAS __attribute__((address_space(3)))
#define XB_TMO      128
#define XB_XCNT(j)  (256  + 64 * (j))
#define XB_XSUB(j)  (1280 + 64 * (j))
#define XB_XGEN(j)  (2304 + 64 * (j))
#define XB_TOP      3328
#define XB_TOPGEN   3392
#define XCD_BAR_WORDS 3456
#define XB_SPIN_CAP (1u << 18)

__device__ __forceinline__ unsigned xb_ld(unsigned* p)              { return __hip_atomic_load(p, __ATOMIC_RELAXED, __HIP_MEMORY_SCOPE_AGENT); }
__device__ __forceinline__ unsigned xb_add(unsigned* p, unsigned v) { return __hip_atomic_fetch_add(p, v, __ATOMIC_RELAXED, __HIP_MEMORY_SCOPE_AGENT); }
__device__ __forceinline__ unsigned xb_xcc_id() { return (unsigned)__builtin_amdgcn_s_getreg((3 << 11) | 20) & 0xFu; }
#define XB_SPIN(cond, bar) do { unsigned _sp = 0; while (cond) { __builtin_amdgcn_s_sleep(1); \
    if ((++_sp & 255u) == 0u) { if (xb_ld(&(bar)[XB_TMO])) break; if (_sp > XB_SPIN_CAP) { atomicAdd(&(bar)[XB_TMO], 1u); break; } } } } while (0)

struct XcdBarrier {
    unsigned* bar; unsigned x;
    volatile LAS unsigned* st;
};

__device__ __forceinline__ XcdBarrier xcd_barrier_post(unsigned* bar, volatile LAS unsigned* st) {
    XcdBarrier b; b.bar = bar; b.x = xb_xcc_id(); b.st = st;
    if (threadIdx.x == 0) (void)xb_add(&bar[XB_XCNT(b.x)], 1u);
    return b;
}
__device__ __forceinline__ void xcd_barrier_complete(unsigned* bar, unsigned x, unsigned& nloc, unsigned& nx) {
    const unsigned G = gridDim.x * gridDim.y * gridDim.z;
    unsigned sum, cnt, mine, sp = 0u;
    for (;;) {
        sum = 0u; cnt = 0u; mine = 0u;
#pragma unroll
        for (unsigned j = 0; j < 16; ++j) { const unsigned c = xb_ld(&bar[XB_XCNT(j)]); sum += c; cnt += (c > 0u) ? 1u : 0u; mine = (j == x) ? c : mine; }
        if (sum == G) break;
        __builtin_amdgcn_s_sleep(1);
        if ((++sp & 255u) == 0u) { if (xb_ld(&bar[XB_TMO])) break; if (sp > XB_SPIN_CAP) { atomicAdd(&bar[XB_TMO], 1u); break; } }
    }
    nloc = mine > 0u ? mine : 1u; nx = cnt > 0u ? cnt : 1u;
}

__device__ __forceinline__ void xcd_barrier(const XcdBarrier& b) {
    asm volatile("s_waitcnt vmcnt(0)" ::: "memory");
    __syncthreads();
    if (threadIdx.x == 0) {
        unsigned* bar = b.bar;
        __builtin_amdgcn_s_waitcnt(0);
        unsigned nloc = b.st[0], nx = b.st[1];
        if (nloc == 0u) { xcd_barrier_complete(bar, b.x, nloc, nx); b.st[0] = nloc; b.st[1] = nx; }
        const unsigned old = xb_add(&bar[XB_XSUB(b.x)], 1u);
        const unsigned gen = old / nloc;
        if (old + 1u == (gen + 1u) * nloc) {
            __builtin_amdgcn_fence(__ATOMIC_RELEASE, "agent");
            asm volatile("s_waitcnt vmcnt(0)" ::: "memory");
            const unsigned og = xb_add(&bar[XB_TOP], 1u);
            const unsigned tg = og / nx;
            if (og + 1u == (tg + 1u) * nx) xb_add(&bar[XB_TOPGEN], 1u);
            else XB_SPIN(xb_ld(&bar[XB_TOPGEN]) == tg, bar);
            __builtin_amdgcn_fence(__ATOMIC_ACQUIRE, "agent");
            xb_add(&bar[XB_XGEN(b.x)], 1u);
            asm volatile("s_waitcnt vmcnt(0)" ::: "memory");
        } else {
            XB_SPIN(xb_ld(&bar[XB_XGEN(b.x)]) == gen, bar);
            __builtin_amdgcn_fence(__ATOMIC_ACQUIRE, "agent");
            asm volatile("s_waitcnt vmcnt(0)" ::: "memory");
        }
    }
    __syncthreads();
}

using pg8::bf16_t; using pg8::f32x4; using pg8::u32x4; using pg8::cvt_pk_bf16;
typedef unsigned u32x2 __attribute__((ext_vector_type(2)));


constexpr int D = 1024, NB = 2, SEQ = 8192, DEPTH = 4, CTX = 256, DFF = 2816;
constexpr int TL = NB * SEQ, TC = NB * CTX, T = TL + TC;
constexpr int NMOD = 9 * D;
constexpr int HYC = 256, RWW = 384, NAW = 384, INW = 3456, INWP = 3584;
constexpr int HY_IN = 768, RW_IN = 1536, NA_IN = 1152;
constexpr int NFFT = 16384;
constexpr int NTHR = 512, NWAVE = 8;
constexpr int LDS_MAIN = 131072, LDS_EXTRA = 8192, LDS_BYTES = LDS_MAIN + LDS_EXTRA;
constexpr float NORM_EPS = 1e-6f;

constexpr size_t al256(size_t x) { return (x + 255) & ~(size_t)255; }
constexpr size_t WS_MODV = 0;
constexpr size_t WS_WGU1 = al256(WS_MODV + (size_t)DEPTH * 3 * NMOD * 4);
constexpr size_t WS_WDN1 = WS_WGU1 + (size_t)2 * DFF * D * 2;
constexpr size_t WS_WGU2 = WS_WDN1 + (size_t)D * DFF * 2;
constexpr size_t WS_WDN2 = WS_WGU2 + (size_t)2 * DFF * D * 2;
constexpr size_t WS_WIN = WS_WDN2 + (size_t)D * DFF * 2;
constexpr size_t WS_WOUT = WS_WIN + (size_t)INWP * D * 2;
constexpr size_t WS_WLORA = WS_WOUT + (size_t)D * D * 2;
constexpr size_t WS_H = WS_WLORA + (size_t)2048 * 384 * 2;
constexpr size_t WS_U = WS_H + (size_t)T * D * 4;
constexpr size_t WS_S = WS_U + (size_t)T * D * 2;
constexpr size_t WS_Y = WS_S;
constexpr size_t WS_ACT = WS_Y + (size_t)T * D * 4;
constexpr size_t WS_FFN_END = WS_ACT + (size_t)T * DFF * 2;
constexpr size_t WS_PHY = WS_S;
constexpr size_t WS_PRW = WS_PHY + (size_t)T * HY_IN * 2;
constexpr size_t WS_YDIR = WS_PRW;
constexpr size_t WS_PNA = WS_PRW + (size_t)T * RW_IN * 2;
constexpr size_t WS_ALORA = WS_PNA + (size_t)T * NA_IN * 2;
constexpr size_t WS_DECAY = WS_ALORA + (size_t)T * 384 * 2;
constexpr size_t WS_LORAO = WS_DECAY + (size_t)2 * T * 384 * 4;
constexpr size_t WS_E = WS_LORAO;
constexpr size_t WS_ZP = WS_E + (size_t)24 * SEQ * 64 * 2;
constexpr size_t WS_GATE = WS_LORAO + (size_t)T * 1536 * 2;
static_assert(WS_ZP + (size_t)24 * 33 * 2 * 4096 * 4 <= WS_GATE, "E + ZP must fit in the LORAO region");
constexpr size_t WS_RS = WS_GATE + (size_t)T * 384 * 2;
constexpr size_t WS_KKS = WS_RS + (size_t)T * 384 * 2;
constexpr size_t WS_VS = WS_KKS + (size_t)T * 384 * 2;
constexpr size_t WS_KS = WS_VS + (size_t)T * 384 * 2;
constexpr size_t WS_BS = WS_KS + (size_t)2 * T * 384 * 2;
constexpr size_t WS_BONUS = WS_BS + (size_t)2 * T * 384 * 2;
constexpr size_t WS_FILT = al256(WS_BONUS + (size_t)T * 6 * 4);
constexpr size_t WS_FILTC = WS_FILT + (size_t)1024 * SEQ * 2;
constexpr size_t WS_SPEC = WS_FILTC + (size_t)1024 * CTX * 2;
constexpr size_t WS_Z1 = WS_SPEC + (size_t)512 * NFFT * 8;
constexpr size_t WS_VTL = WS_Z1 + (size_t)HYC * NB * SEQ * 4;
constexpr size_t WS_VTC = WS_VTL + (size_t)NB * 6 * 64 * SEQ * 2;
constexpr size_t WS_MIX_END = WS_VTC + (size_t)NB * 6 * 64 * CTX * 2;
constexpr size_t WS_BAR = al256(WS_MIX_END > WS_FFN_END ? WS_MIX_END : WS_FFN_END);
constexpr size_t WS_ROPE = al256(WS_BAR + (size_t)XCD_BAR_WORDS * 4);
constexpr size_t WS_END = WS_ROPE + (size_t)128 * 16 * 8;
static_assert(WS_END <= (size_t)4 * DEPTH * D * NMOD * 4, "workspace map exceeds 4x the largest input tensor");

struct Params { const float* in[34]; float* out; unsigned char* ws; };
enum { I_X = 0, I_C, I_CTX, I_CCTX, I_MODW, I_MODB, I_NORMG, I_F1GU, I_F1DN, I_F2GU, I_F2DN, I_WIN, I_WOUT, I_HCW, I_HCB, I_HW1, I_HB1, I_HW2, I_HB2, I_HW3, I_HFREQ, I_HBIAS,
       I_MU, I_W0, I_W2, I_A0, I_A2, I_G2, I_KK, I_KA, I_RK, I_LNW, I_LNB, I_RPB };

typedef LAS float* ldsfp;
__device__ __forceinline__ ldsfp vlds(const void* p) { ldsfp q = (ldsfp)p; asm volatile("" : "+v"(q)); return q; }
__device__ __forceinline__ float bf2f(bf16_t b) { return __uint_as_float(((unsigned)b) << 16); }
__device__ __forceinline__ bf16_t f2bf(float f) { unsigned u = __float_as_uint(f); u += 0x7FFFu + ((u >> 16) & 1u); return (bf16_t)(u >> 16); }
__device__ __forceinline__ float lo_bf(unsigned w) { return __uint_as_float(w << 16); }
__device__ __forceinline__ float hi_bf(unsigned w) { return __uint_as_float(w & 0xffff0000u); }
__device__ __forceinline__ float wsum(float v) {
#pragma unroll
    for (int o = 32; o > 0; o >>= 1) v += __shfl_xor(v, o);
    return v;
}
__device__ __forceinline__ float sigmoidf_(float x) { return __builtin_amdgcn_rcpf(1.0f + __expf(-x)); }
__device__ __forceinline__ void unpack8(const u32x4 w, float (&f)[8]) {
    f[0] = lo_bf(w.x); f[1] = hi_bf(w.x); f[2] = lo_bf(w.y); f[3] = hi_bf(w.y); f[4] = lo_bf(w.z); f[5] = hi_bf(w.z); f[6] = lo_bf(w.w); f[7] = hi_bf(w.w);
}
__device__ __forceinline__ void row_nbrs(int row, bool& hasp, bool& hasn) {
    if (row < TL) { const int t = row & (SEQ - 1); hasp = t > 0; hasn = t < SEQ - 1; }
    else { const int t = (row - TL) & (CTX - 1); hasp = t > 0; hasn = t < CTX - 1; }
}

__device__ __forceinline__ void ph_modv(const Params& P, float* lds) {
    const int tid = otid();
    float* sv = lds;
    float* red = lds + 3072;
    for (int i = tid; i < 3072; i += NTHR) { const int s = i >> 10, k = i & 1023; const float c = s < 2 ? P.in[I_C][s * 1024 + k] : P.in[I_CCTX][k]; sv[i] = c / (1.0f + expf(-c)); }
    __syncthreads();
    if (blockIdx.x < 4) { const int e = blockIdx.x * NTHR + tid, pos = e >> 4, f = e & 15; float sn, cs; sincosf((float)pos * expf(-(float)f * (9.210340371976184f / 16.0f)), &sn, &cs); ((float2*)(P.ws + WS_ROPE))[e] = make_float2(cs, sn); }
    float* modv = (float*)(P.ws + WS_MODV);
    const int kc = tid >> 6, cl = tid & 63;
    for (int item = blockIdx.x; item < DEPTH * 144; item += gridDim.x) {
        const int l = item / 144, cb = item % 144, col = cb * 64 + cl;
        const float* w = P.in[I_MODW] + ((size_t)l * 1024 + kc * 128) * NMOD + col;
        float a0 = 0.f, a1 = 0.f, a2 = 0.f;
#pragma unroll 8
        for (int k = 0; k < 128; ++k) { const float wv = w[(size_t)k * NMOD]; a0 += sv[kc * 128 + k] * wv; a1 += sv[1024 + kc * 128 + k] * wv; a2 += sv[2048 + kc * 128 + k] * wv; }
        red[(0 * 8 + kc) * 64 + cl] = a0; red[(1 * 8 + kc) * 64 + cl] = a1; red[(2 * 8 + kc) * 64 + cl] = a2;
        __syncthreads();
        if (tid < 192) { const int s = tid >> 6, c = tid & 63; float r = P.in[I_MODB][l * NMOD + cb * 64 + c];
#pragma unroll
            for (int q = 0; q < 8; ++q) r += red[(s * 8 + q) * 64 + c];
            modv[((size_t)l * 3 + s) * NMOD + cb * 64 + c] = r; }
        __syncthreads();
    }
}

__device__ __forceinline__ float hy_delta(int c);
__device__ __forceinline__ int rowmap_gu(int n) { const int up = n >= DFF ? 1 : 0; const int j = n - up * DFF; return (j >> 7) * 256 + up * 128 + (j & 127); }
__device__ __forceinline__ void conv_tile(const float* __restrict__ src, int K, int N, bf16_t* __restrict__ dst, int tk, int tn, bool gu, float* tile) {
    const int tid = otid(); const int k0 = tk * 64, n0 = tn * 64;
#pragma unroll
    for (int rr = 0; rr < 2; ++rr) { const int kk = (tid >> 4) + rr * 32, n4 = (tid & 15) * 4; const float4 v = *(const float4*)(src + (size_t)(k0 + kk) * N + n0 + n4);
        tile[kk * 65 + n4 + 0] = v.x; tile[kk * 65 + n4 + 1] = v.y; tile[kk * 65 + n4 + 2] = v.z; tile[kk * 65 + n4 + 3] = v.w; }
    __syncthreads();
    { const int nn = tid >> 3, ks = (tid & 7) * 8; const int n = n0 + nn; const int row = gu ? rowmap_gu(n) : n;
      u32x4 w; w.x = cvt_pk_bf16(tile[(ks + 0) * 65 + nn], tile[(ks + 1) * 65 + nn]); w.y = cvt_pk_bf16(tile[(ks + 2) * 65 + nn], tile[(ks + 3) * 65 + nn]);
      w.z = cvt_pk_bf16(tile[(ks + 4) * 65 + nn], tile[(ks + 5) * 65 + nn]); w.w = cvt_pk_bf16(tile[(ks + 6) * 65 + nn], tile[(ks + 7) * 65 + nn]);
      *(u32x4*)(dst + (size_t)row * K + k0 + ks) = w; }
    __syncthreads();
}
__device__ __forceinline__ void ph_prep(const Params& P, int l, float* lds) {
    const int tid = otid();
    unsigned char* ws = P.ws;
    constexpr int N0 = 16 * 88, N1 = 44 * 16, N4 = 16 * 54, N5 = 16 * 16;
    constexpr int C0 = N0, C1 = C0 + N1, C2 = C1 + N0, C3 = C2 + N1, C4 = C3 + N4, C5 = C4 + N5;
    for (int it = blockIdx.x; it < C5; it += gridDim.x) {
        if (it < C0) { conv_tile(P.in[I_F1GU] + (size_t)l * D * 2 * DFF, D, 2 * DFF, (bf16_t*)(ws + WS_WGU1), it / 88, it % 88, true, lds); }
        else if (it < C1) { const int j = it - C0; conv_tile(P.in[I_F1DN] + (size_t)l * DFF * D, DFF, D, (bf16_t*)(ws + WS_WDN1), j / 16, j % 16, false, lds); }
        else if (it < C2) { const int j = it - C1; conv_tile(P.in[I_F2GU] + (size_t)l * D * 2 * DFF, D, 2 * DFF, (bf16_t*)(ws + WS_WGU2), j / 88, j % 88, true, lds); }
        else if (it < C3) { const int j = it - C2; conv_tile(P.in[I_F2DN] + (size_t)l * DFF * D, DFF, D, (bf16_t*)(ws + WS_WDN2), j / 16, j % 16, false, lds); }
        else if (it < C4) { const int j = it - C3; conv_tile(P.in[I_WIN] + (size_t)l * D * INW, D, INW, (bf16_t*)(ws + WS_WIN), j / 54, j % 54, false, lds); }
        else { const int j = it - C4; conv_tile(P.in[I_WOUT] + (size_t)l * D * D, D, D, (bf16_t*)(ws + WS_WOUT), j / 16, j % 16, false, lds); }
    }
    const int gtid = blockIdx.x * NTHR + tid, gn = gridDim.x * NTHR;
    { unsigned* z = (unsigned*)(ws + WS_WIN + (size_t)INW * D * 2); for (int i = gtid; i < (INWP - INW) * D / 2; i += gn) z[i] = 0u; }
    { bf16_t* wl = (bf16_t*)(ws + WS_WLORA);
      const float* w2 = P.in[I_W2] + (size_t)l * 2 * 64 * RWW; const float* a2 = P.in[I_A2] + (size_t)l * 2 * 64 * RWW; const float* g2 = P.in[I_G2] + (size_t)l * 128 * RWW;
      for (int i = gtid; i < 2048 * 384; i += gn) { const int k = i / 2048, j = i % 2048; float v = 0.f;
          if (j < 1920) { const int grp = j / 384, c = j % 384;
              if (grp == 0) { if (k < 64) v = w2[(size_t)k * RWW + c]; }
              else if (grp == 1) { if (k >= 64 && k < 128) v = w2[(size_t)(64 + k - 64) * RWW + c]; }
              else if (grp == 2) { if (k >= 128 && k < 192) v = a2[(size_t)(k - 128) * RWW + c]; }
              else if (grp == 3) { if (k >= 192 && k < 256) v = a2[(size_t)(64 + k - 192) * RWW + c]; }
              else { if (k >= 256) v = g2[(size_t)(k - 256) * RWW + c]; } }
          wl[(size_t)j * 384 + k] = f2bf(v); } }
    { const float* w1_ = P.in[I_HW1] + (size_t)l * 33 * 64; const float* b1 = P.in[I_HB1] + l * 64; const float* w2f_ = P.in[I_HW2] + (size_t)l * 64 * 64; const float* b2 = P.in[I_HB2] + l * 64;
      const float* fqv = P.in[I_HFREQ] + l * 64; const float* w3 = P.in[I_HW3] + (size_t)l * 64 * 1024;
      const int lane = tid & 63, wv = tid >> 6;
      const float fq = fqv[lane], bb1 = b1[lane], bb2 = b2[lane];
      const ldsfp hl = vlds(lds);
      for (int task = blockIdx.x; task < 264; task += gridDim.x) {
          const int L = task < 256 ? SEQ : CTX, n0 = task < 256 ? task * 32 : (task - 256) * 32;
          __syncthreads();
#pragma unroll 1
          for (int pp = 0; pp < 4; ++pp) { const int p = wv * 4 + pp, pos = n0 + p;
              const float* w1 = w1_; const float* w2f = w2f_; asm volatile("" : "+s"(w1), "+s"(w2f));
              const float tt = (float)pos / (float)(L - 1);
              const float ang = 6.283185307179586f * (float)pos / (float)L;
              float z = 0.f;
              if (lane == 0) z = tt;
              else if (lane <= 16) { const float fr = 1e-4f + (float)(lane - 1) * ((15.0f - 1e-4f) / 15.0f); z = cosf(fr * ang); }
              else if (lane <= 32) { const float fr = 1e-4f + (float)(lane - 17) * ((15.0f - 1e-4f) / 15.0f); z = -sinf(fr * ang); }
              float a = bb1;
#pragma unroll
              for (int e = 0; e < 33; ++e) a += __shfl(z, e) * w1[e * 64 + lane];
              const float h1 = sinf(fq * a);
              float c = bb2;
#pragma unroll
              for (int i = 0; i < 64; ++i) c += __shfl(h1, i) * w2f[i * 64 + lane];
              hl[lane * 32 + p] = sinf(fq * c); }
          __syncthreads();
          float acc0[32], acc1[32];
#pragma unroll
          for (int p = 0; p < 32; ++p) { acc0[p] = 0.f; acc1[p] = 0.f; }
#pragma unroll 2
          for (int i = 0; i < 64; ++i) { const float wa = w3[(size_t)i * 1024 + tid], wb = w3[(size_t)i * 1024 + 512 + tid];
#pragma unroll
              for (int p4 = 0; p4 < 8; ++p4) { const f32x4 hv = *(const LAS f32x4*)(hl + i * 32 + p4 * 4);
                  acc0[p4 * 4 + 0] += hv.x * wa; acc0[p4 * 4 + 1] += hv.y * wa; acc0[p4 * 4 + 2] += hv.z * wa; acc0[p4 * 4 + 3] += hv.w * wa;
                  acc1[p4 * 4 + 0] += hv.x * wb; acc1[p4 * 4 + 1] += hv.y * wb; acc1[p4 * 4 + 2] += hv.z * wb; acc1[p4 * 4 + 3] += hv.w * wb; } }
          const float dl = hy_delta(tid & 255), sc = task < 256 ? (1.0f / NFFT) : 1.0f, invL = 1.0f / (float)(L - 1);
          bf16_t* dst = task < 256 ? (bf16_t*)(ws + WS_FILT) + (size_t)tid * SEQ + n0 : (bf16_t*)(ws + WS_FILTC) + (size_t)tid * CTX + n0;
          const size_t cstep = task < 256 ? (size_t)512 * SEQ : (size_t)512 * CTX;
#pragma unroll
          for (int p8 = 0; p8 < 4; ++p8) { float d[8];
#pragma unroll
              for (int k = 0; k < 8; ++k) d[k] = __expf(-((float)(n0 + p8 * 8 + k) * invL) * dl) * sc;
              u32x4 w; w.x = cvt_pk_bf16(acc0[p8 * 8 + 0] * d[0], acc0[p8 * 8 + 1] * d[1]); w.y = cvt_pk_bf16(acc0[p8 * 8 + 2] * d[2], acc0[p8 * 8 + 3] * d[3]);
              w.z = cvt_pk_bf16(acc0[p8 * 8 + 4] * d[4], acc0[p8 * 8 + 5] * d[5]); w.w = cvt_pk_bf16(acc0[p8 * 8 + 6] * d[6], acc0[p8 * 8 + 7] * d[7]);
              *(u32x4*)(dst + p8 * 8) = w;
              w.x = cvt_pk_bf16(acc1[p8 * 8 + 0] * d[0], acc1[p8 * 8 + 1] * d[1]); w.y = cvt_pk_bf16(acc1[p8 * 8 + 2] * d[2], acc1[p8 * 8 + 3] * d[3]);
              w.z = cvt_pk_bf16(acc1[p8 * 8 + 4] * d[4], acc1[p8 * 8 + 5] * d[5]); w.w = cvt_pk_bf16(acc1[p8 * 8 + 6] * d[6], acc1[p8 * 8 + 7] * d[7]);
              *(u32x4*)(dst + cstep + p8 * 8) = w; }
      }
      __syncthreads(); }
}

__device__ __forceinline__ void ph_rowpass(const Params& P, int mode, int lpost, int gate_i, int gpost_i, float ps, int lpre, int gpre_i, int shift_i, int scale_i) {
    const int tid = otid(), lane = tid & 63, gw = blockIdx.x * NWAVE + (tid >> 6), nw = gridDim.x * NWAVE;
    const float* modv = (const float*)(P.ws + WS_MODV);
    float* H = (float*)(P.ws + WS_H); const bf16_t* Y = (const bf16_t*)(P.ws + WS_Y); bf16_t* U = (bf16_t*)(P.ws + WS_U);
    int cur_s = -1;
    float4 A[4], Bv[4], Cv[4];
#pragma unroll
    for (int j = 0; j < 4; ++j) { A[j] = make_float4(0.f, 0.f, 0.f, 0.f); Bv[j] = A[j]; Cv[j] = A[j]; }
    for (int row = gw; row < T; row += nw) {
        const int s = row < SEQ ? 0 : (row < TL ? 1 : 2);
        if (s != cur_s) { cur_s = s;
#pragma unroll
            for (int j = 0; j < 4; ++j) { const int e = lane * 4 + 256 * j;
                if (mode != 0) { const float4 g = *(const float4*)(modv + ((size_t)lpost * 3 + s) * NMOD + gate_i * D + e); const float4 gp = *(const float4*)(P.in[I_NORMG] + ((size_t)lpost * 6 + gpost_i) * D + e);
                    A[j] = make_float4(ps * g.x * gp.x, ps * g.y * gp.y, ps * g.z * gp.z, ps * g.w * gp.w); }
                if (mode != 2) { const float4 sc = *(const float4*)(modv + ((size_t)lpre * 3 + s) * NMOD + scale_i * D + e); const float4 gq = *(const float4*)(P.in[I_NORMG] + ((size_t)lpre * 6 + gpre_i) * D + e);
                    Bv[j] = make_float4(gq.x * (1.f + sc.x), gq.y * (1.f + sc.y), gq.z * (1.f + sc.z), gq.w * (1.f + sc.w));
                    Cv[j] = *(const float4*)(modv + ((size_t)lpre * 3 + s) * NMOD + shift_i * D + e); } } }
        float4 h[4];
        if (mode == 0) { const float* src = row < TL ? P.in[I_X] + (size_t)row * D : P.in[I_CTX] + (size_t)(row - TL) * D;
#pragma unroll
            for (int j = 0; j < 4; ++j) h[j] = *(const float4*)(src + lane * 4 + 256 * j);
        } else {
            float4 y[4]; float ss = 0.f;
#pragma unroll
            for (int j = 0; j < 4; ++j) { h[j] = *(const float4*)(H + (size_t)row * D + lane * 4 + 256 * j); { const u32x2 yw = *(const u32x2*)(Y + (size_t)row * D + lane * 4 + 256 * j); y[j] = make_float4(lo_bf(yw.x), hi_bf(yw.x), lo_bf(yw.y), hi_bf(yw.y)); }
                ss += y[j].x * y[j].x + y[j].y * y[j].y + y[j].z * y[j].z + y[j].w * y[j].w; }
            ss = wsum(ss); const float r = rsqrtf(ss * (1.0f / D) + NORM_EPS);
#pragma unroll
            for (int j = 0; j < 4; ++j) { h[j].x += A[j].x * (y[j].x * r); h[j].y += A[j].y * (y[j].y * r); h[j].z += A[j].z * (y[j].z * r); h[j].w += A[j].w * (y[j].w * r); }
        }
        if (mode == 2) { if (row < TL) {
#pragma unroll
                for (int j = 0; j < 4; ++j) *(float4*)(P.out + (size_t)row * D + lane * 4 + 256 * j) = h[j]; }
            continue; }
        float s2 = 0.f;
#pragma unroll
        for (int j = 0; j < 4; ++j) { *(float4*)(H + (size_t)row * D + lane * 4 + 256 * j) = h[j]; s2 += h[j].x * h[j].x + h[j].y * h[j].y + h[j].z * h[j].z + h[j].w * h[j].w; }
        s2 = wsum(s2); const float r2 = rsqrtf(s2 * (1.0f / D) + NORM_EPS);
#pragma unroll
        for (int j = 0; j < 4; ++j) { u32x2 w; w.x = cvt_pk_bf16(h[j].x * r2 * Bv[j].x + Cv[j].x, h[j].y * r2 * Bv[j].y + Cv[j].y); w.y = cvt_pk_bf16(h[j].z * r2 * Bv[j].z + Cv[j].z, h[j].w * r2 * Bv[j].w + Cv[j].w);
            *(u32x2*)(U + (size_t)row * D + lane * 4 + 256 * j) = w; }
    }
}

struct EpiGU {
    static constexpr bool PERM = true, AFTER_DRAIN = false;
    bf16_t* O;
    __device__ __forceinline__ void operator()(const f32x4 (&acc)[2][2][4][2], const pg8::Unit& u, int wr, int wc, int fr, int fq) const {
        const int row0 = u.pm * 256 + wr * 64 + fr, col0 = u.pn * 128 + wc * 32 + 8 * fq;
#pragma unroll
        for (int ai = 0; ai < 2; ++ai)
#pragma unroll
            for (int m = 0; m < 4; ++m) { float o[8];
#pragma unroll
                for (int n = 0; n < 2; ++n)
#pragma unroll
                    for (int j = 0; j < 4; ++j) { const float g = acc[ai][0][m][n][j], up = acc[ai][1][m][n][j]; o[n * 4 + j] = g * __builtin_amdgcn_rcpf(1.0f + __expf(-g)) * up; }
                u32x4 w; w.x = cvt_pk_bf16(o[0], o[1]); w.y = cvt_pk_bf16(o[2], o[3]); w.z = cvt_pk_bf16(o[4], o[5]); w.w = cvt_pk_bf16(o[6], o[7]);
                *(u32x4*)(O + (size_t)(row0 + ai * 128 + m * 16) * DFF + col0) = w; }
    }
};
struct EpiF32 {
    static constexpr bool PERM = true, AFTER_DRAIN = false;
    bf16_t* C;
    __device__ __forceinline__ void operator()(const f32x4 (&acc)[2][2][4][2], const pg8::Unit& u, int wr, int wc, int fr, int fq) const {
        const int row0 = u.pm * 256 + wr * 64 + fr, col0 = u.pn * 256 + wc * 32 + 8 * fq;
#pragma unroll
        for (int ai = 0; ai < 2; ++ai)
#pragma unroll
            for (int m = 0; m < 4; ++m) { bf16_t* rowp = C + (size_t)(row0 + ai * 128 + m * 16) * D + col0;
#pragma unroll
                for (int bj = 0; bj < 2; ++bj) { const f32x4 v0 = acc[ai][bj][m][0], v1 = acc[ai][bj][m][1];
                    u32x4 w; w.x = cvt_pk_bf16(v0[0], v0[1]); w.y = cvt_pk_bf16(v0[2], v0[3]); w.z = cvt_pk_bf16(v1[0], v1[1]); w.w = cvt_pk_bf16(v1[2], v1[3]);
                    *(u32x4*)(rowp + bj * 128) = w; } }
    }
};
struct EpiWin {
    static constexpr bool PERM = true, AFTER_DRAIN = false;
    bf16_t* PHYT; bf16_t* PRW; bf16_t* PNA;
    __device__ __forceinline__ void operator()(const f32x4 (&acc)[2][2][4][2], const pg8::Unit& u, int wr, int wc, int fr, int fq) const {
        const int row0 = u.pm * 256 + wr * 64 + fr;
        if (u.pn < 3) {
#pragma unroll
            for (int bj = 0; bj < 2; ++bj) { bf16_t* cp = PHYT + (size_t)(u.pn * 256 + bj * 128 + wc * 32 + 8 * fq) * T + row0;
#pragma unroll
                for (int ai = 0; ai < 2; ++ai)
#pragma unroll
                    for (int m = 0; m < 4; ++m) { const f32x4 v0 = acc[ai][bj][m][0], v1 = acc[ai][bj][m][1]; bf16_t* rp = cp + ai * 128 + m * 16;
                        const unsigned w0 = cvt_pk_bf16(v0[0], v0[1]), w1 = cvt_pk_bf16(v0[2], v0[3]), w2 = cvt_pk_bf16(v1[0], v1[1]), w3 = cvt_pk_bf16(v1[2], v1[3]);
                        rp[0] = (bf16_t)w0; rp[(size_t)T] = (bf16_t)(w0 >> 16); rp[(size_t)2 * T] = (bf16_t)w1; rp[(size_t)3 * T] = (bf16_t)(w1 >> 16);
                        rp[(size_t)4 * T] = (bf16_t)w2; rp[(size_t)5 * T] = (bf16_t)(w2 >> 16); rp[(size_t)6 * T] = (bf16_t)w3; rp[(size_t)7 * T] = (bf16_t)(w3 >> 16); } }
            return; }
        bf16_t* base; int ld, cbase;
        if (u.pn < 9) { base = PRW; ld = RW_IN; cbase = u.pn * 256 - HY_IN; }
        else { base = PNA; ld = NA_IN; cbase = u.pn * 256 - HY_IN - RW_IN; }
        const int nbj = (u.pn == 13) ? 1 : 2;
#pragma unroll
        for (int ai = 0; ai < 2; ++ai)
#pragma unroll
            for (int m = 0; m < 4; ++m)
#pragma unroll
                for (int bj = 0; bj < 2; ++bj) { if (bj < nbj) { const f32x4 v0 = acc[ai][bj][m][0], v1 = acc[ai][bj][m][1];
                    u32x4 w; w.x = cvt_pk_bf16(v0[0], v0[1]); w.y = cvt_pk_bf16(v0[2], v0[3]); w.z = cvt_pk_bf16(v1[0], v1[1]); w.w = cvt_pk_bf16(v1[2], v1[3]);
                    *(u32x4*)(base + (size_t)(row0 + ai * 128 + m * 16) * ld + cbase + bj * 128 + wc * 32 + 8 * fq) = w; } }
    }
};
struct EpiLora {
    static constexpr bool PERM = true, AFTER_DRAIN = false;
    bf16_t* LO; bf16_t* GATE;
    __device__ __forceinline__ void operator()(const f32x4 (&acc)[2][2][4][2], const pg8::Unit& u, int wr, int wc, int fr, int fq) const {
        const int row0 = u.pm * 256 + wr * 64 + fr;
        bf16_t* base; int ld, cbase;
        if (u.pn < 6) { base = LO; ld = 1536; cbase = u.pn * 256; } else { base = GATE; ld = 384; cbase = u.pn * 256 - 1536; }
        const int nbj = (u.pn == 7) ? 1 : 2;
#pragma unroll
        for (int ai = 0; ai < 2; ++ai)
#pragma unroll
            for (int m = 0; m < 4; ++m)
#pragma unroll
                for (int bj = 0; bj < 2; ++bj) { if (bj < nbj) { const f32x4 v0 = acc[ai][bj][m][0], v1 = acc[ai][bj][m][1];
                    u32x4 w; w.x = cvt_pk_bf16(v0[0], v0[1]); w.y = cvt_pk_bf16(v0[2], v0[3]); w.z = cvt_pk_bf16(v1[0], v1[1]); w.w = cvt_pk_bf16(v1[2], v1[3]);
                    *(u32x4*)(base + (size_t)(row0 + ai * 128 + m * 16) * ld + cbase + bj * 128 + wc * 32 + 8 * fq) = w; } }
    }
};
template <class Epi> __device__ __forceinline__ void run_gemm(LAS unsigned char* lds, const bf16_t* A, const bf16_t* Bt, int M, int N, int K, const Epi& E) {
    asm volatile("" : "+s"(K));
    pg8::Gemm g{A, Bt, M, N, K}; pg8::StaticOrder S; S.init(M, N, (int)gridDim.x, (int)blockIdx.x);
    pg8::gemm_phase<Epi, pg8::StaticOrder>(lds, g, S, E);
    __syncthreads();
}

__device__ __forceinline__ void ph_loraprep(const Params& P, int l) {
    const bf16_t* PRW = (const bf16_t*)(P.ws + WS_PRW); bf16_t* AL = (bf16_t*)(P.ws + WS_ALORA);
    const float* mu = P.in[I_MU] + (size_t)l * 2 * RW_IN;
    const int gtid = blockIdx.x * NTHR + otid(), gn = gridDim.x * NTHR;
    for (int it = gtid; it < T * 48; it += gn) {
        const int row = it / 48, j8 = it % 48, col = 1152 + j8 * 8;
        bool hp, hn; row_nbrs(row, hp, hn);
        float p[8], pp[8], pn[8];
        unpack8(*(const u32x4*)(PRW + (size_t)row * RW_IN + col), p);
        if (hp) unpack8(*(const u32x4*)(PRW + (size_t)(row - 1) * RW_IN + col), pp); else {
#pragma unroll
            for (int i = 0; i < 8; ++i) pp[i] = 0.f; }
        if (hn) unpack8(*(const u32x4*)(PRW + (size_t)(row + 1) * RW_IN + col), pn); else {
#pragma unroll
            for (int i = 0; i < 8; ++i) pn[i] = 0.f; }
        float o[8];
#pragma unroll
        for (int i = 0; i < 8; ++i) { const float xs = p[i] + mu[col + i] * (pp[i] - p[i]) + mu[RW_IN + col + i] * (pn[i] - p[i]);
            o[i] = j8 < 16 ? tanhf(xs) : (j8 < 32 ? xs : sigmoidf_(xs)); }
        u32x4 w; w.x = cvt_pk_bf16(o[0], o[1]); w.y = cvt_pk_bf16(o[2], o[3]); w.z = cvt_pk_bf16(o[4], o[5]); w.w = cvt_pk_bf16(o[6], o[7]);
        *(u32x4*)(AL + (size_t)row * 384 + j8 * 8) = w;
    }
}

__device__ __forceinline__ void ph_rwkvprep(const Params& P, int l) {
    const int tid = otid(), lane = tid & 63, gw = blockIdx.x * NWAVE + (tid >> 6), nw = gridDim.x * NWAVE;
    const int nrw = nw / 6, h = gw % 6, rw0 = gw / 6;
    if (rw0 >= nrw) return;
    const bf16_t* PRW = (const bf16_t*)(P.ws + WS_PRW); const bf16_t* LO = (const bf16_t*)(P.ws + WS_LORAO);
    bf16_t* RS = (bf16_t*)(P.ws + WS_RS); bf16_t* KKS = (bf16_t*)(P.ws + WS_KKS); bf16_t* VS = (bf16_t*)(P.ws + WS_VS); bf16_t* KS = (bf16_t*)(P.ws + WS_KS); bf16_t* BS = (bf16_t*)(P.ws + WS_BS);
    float* BON = (float*)(P.ws + WS_BONUS); float* DEC = (float*)(P.ws + WS_DECAY);
    const float2* RT = (const float2*)(P.ws + WS_ROPE);
    const float* mu = P.in[I_MU] + (size_t)l * 2 * RW_IN;
    const int c = h * 64 + lane, f = lane & 15;
    const float mp0 = mu[c], mn0 = mu[RW_IN + c], mp1 = mu[384 + c], mn1 = mu[RW_IN + 384 + c], mp2 = mu[768 + c], mn2 = mu[RW_IN + 768 + c];
    const float ckk = P.in[I_KK][l * RWW + c], cka = P.in[I_KA][l * RWW + c], crk = P.in[I_RK][l * RWW + c];
    const float ca0 = P.in[I_A0][(size_t)l * 2 * RWW + c], ca1 = P.in[I_A0][(size_t)l * 2 * RWW + RWW + c], cw0 = P.in[I_W0][(size_t)l * 2 * RWW + c], cw1 = P.in[I_W0][(size_t)l * 2 * RWW + RWW + c];
    const float sg = (lane & 16) ? 1.f : -1.f;
#pragma unroll 2
    for (int row = rw0; row < T; row += nrw) {
        bool hp, hn; row_nbrs(row, hp, hn);
        const bf16_t* pr = PRW + (size_t)row * RW_IN + c; const int om = hp ? -RW_IN : 0, op = hn ? RW_IN : 0; const float fm = hp ? 1.f : 0.f, fp = hn ? 1.f : 0.f;
        const float r0 = bf2f(pr[0]), k0 = bf2f(pr[384]), v0 = bf2f(pr[768]);
        const float r = r0 + mp0 * (fm * bf2f(pr[om]) - r0) + mn0 * (fp * bf2f(pr[op]) - r0);
        const float k = k0 + mp1 * (fm * bf2f(pr[384 + om]) - k0) + mn1 * (fp * bf2f(pr[384 + op]) - k0);
        const float v = v0 + mp2 * (fm * bf2f(pr[768 + om]) - v0) + mn2 * (fp * bf2f(pr[768 + op]) - v0);
        const bf16_t* lo = LO + (size_t)row * 1536 + c;
        const float a0 = sigmoidf_(bf2f(lo[768]) + ca0), a1 = sigmoidf_(bf2f(lo[1152]) + ca1);
        const float x0 = bf2f(lo[0]) + cw0, x1 = bf2f(lo[384]) + cw1;
        const float kkr = k * ckk;
        const float nrm = sqrtf(wsum(kkr * kkr));
        const float kk = kkr / fmaxf(nrm, 1e-12f);
        float kd0 = k * (1.f + (a0 - 1.f) * cka), kd1 = k * (1.f + (a1 - 1.f) * cka);
        float b0 = kk * a0, b1 = kk * a1;
        const float bon = wsum(r * (kd0 + kd1) * crk);
        float rs = r, kks = kk;
        if (row < TL) {
            const int t = row & (SEQ - 1); const int pos = (lane < 32) ? (t >> 6) : (t & 63);
            const float2 csn = RT[pos * 16 + f]; const float cs = csn.x, sn = csn.y;
            const float r2 = __shfl_xor(rs, 16), k2 = __shfl_xor(kks, 16), d0 = __shfl_xor(kd0, 16), d1 = __shfl_xor(kd1, 16), e0 = __shfl_xor(b0, 16), e1 = __shfl_xor(b1, 16);
            rs = rs * cs + sg * r2 * sn; kks = kks * cs + sg * k2 * sn; kd0 = kd0 * cs + sg * d0 * sn; kd1 = kd1 * cs + sg * d1 * sn; b0 = b0 * cs + sg * e0 * sn; b1 = b1 * cs + sg * e1 * sn;
        }
        const size_t o = (size_t)row * 384 + c;
        DEC[o] = __expf(-0.6065306597f * sigmoidf_(x0)); DEC[(size_t)T * 384 + o] = __expf(-0.6065306597f * sigmoidf_(x1));
        if (lane == 0) BON[(size_t)row * 6 + h] = bon;
        RS[o] = f2bf(rs); KKS[o] = f2bf(-kks); VS[o] = f2bf(v);
        KS[o] = f2bf(kd0); KS[(size_t)T * 384 + o] = f2bf(kd1); BS[o] = f2bf(b0); BS[(size_t)T * 384 + o] = f2bf(b1);
    }
}

__device__ __forceinline__ int scan_row(int b, int d, int step) {
    if (step < CTX) { const int tc = d ? (CTX - 1 - step) : step; return TL + b * CTX + tc; }
    const int tl = d ? (SEQ - 1 - (step - CTX)) : (step - CTX); return b * SEQ + tl;
}
__device__ __forceinline__ void scan_task_v1(const Params& P, int task, float* sv) {
    const int lane = otid() & 63;
    const int d = task & 1, h = (task >> 1) % 6, b = task / 12;
    const float* DEC = (const float*)(P.ws + WS_DECAY) + (size_t)d * T * 384; const bf16_t* KKS = (const bf16_t*)(P.ws + WS_KKS); const bf16_t* RS = (const bf16_t*)(P.ws + WS_RS);
    const bf16_t* VS = (const bf16_t*)(P.ws + WS_VS); const bf16_t* KS = (const bf16_t*)(P.ws + WS_KS) + (size_t)d * T * 384; const bf16_t* BS = (const bf16_t*)(P.ws + WS_BS) + (size_t)d * T * 384;
    float* YD = (float*)(P.ws + WS_YDIR) + (size_t)d * T * 384;
    float S[64];
#pragma unroll
    for (int j = 0; j < 64; ++j) S[j] = 0.f;
    size_t o = (size_t)scan_row(b, d, 0) * 384 + h * 64 + lane;
    float nw_ = DEC[o], na = bf2f(KKS[o]), nb = bf2f(BS[o]), nk = bf2f(KS[o]), nr = bf2f(RS[o]), nv = bf2f(VS[o]);
    for (int step = 0; step < CTX + SEQ; ++step) {
        const float v = nv; const size_t oc = o;
        asm volatile("s_waitcnt lgkmcnt(0)" ::: "memory");
        sv[lane] = nw_; sv[64 + lane] = na; sv[128 + lane] = nb; sv[192 + lane] = nk; sv[256 + lane] = nr;
        asm volatile("s_waitcnt lgkmcnt(0)" ::: "memory");
        if (step + 1 < CTX + SEQ) { o = (size_t)scan_row(b, d, step + 1) * 384 + h * 64 + lane;
            nw_ = DEC[o]; na = bf2f(KKS[o]); nb = bf2f(BS[o]); nk = bf2f(KS[o]); nr = bf2f(RS[o]); nv = bf2f(VS[o]); }
        float sa0 = 0.f, sa1 = 0.f, sa2 = 0.f, sa3 = 0.f;
#pragma unroll
        for (int j = 0; j < 64; j += 4) { const float4 a4 = *(const float4*)(sv + 64 + j);
            sa0 += S[j + 0] * a4.x; sa1 += S[j + 1] * a4.y; sa2 += S[j + 2] * a4.z; sa3 += S[j + 3] * a4.w; }
        const float sa = (sa0 + sa1) + (sa2 + sa3);
        float y0 = 0.f, y1 = 0.f, y2 = 0.f, y3 = 0.f;
#pragma unroll
        for (int j = 0; j < 64; j += 4) {
            const float4 w4 = *(const float4*)(sv + j), b4 = *(const float4*)(sv + 128 + j), k4 = *(const float4*)(sv + 192 + j), r4 = *(const float4*)(sv + 256 + j);
            S[j + 0] = S[j + 0] * w4.x + sa * b4.x + v * k4.x; y0 += S[j + 0] * r4.x;
            S[j + 1] = S[j + 1] * w4.y + sa * b4.y + v * k4.y; y1 += S[j + 1] * r4.y;
            S[j + 2] = S[j + 2] * w4.z + sa * b4.z + v * k4.z; y2 += S[j + 2] * r4.z;
            S[j + 3] = S[j + 3] * w4.w + sa * b4.w + v * k4.w; y3 += S[j + 3] * r4.w; }
        YD[oc] = (y0 + y1) + (y2 + y3);
    }
}

__device__ __forceinline__ void natt_key(const bf16_t* PNA, size_t krow, int hoff, const float (&q)[16], float bias, float& m, float& lsum, float (&o)[16]) {
    const bf16_t* kp = PNA + krow * NA_IN + 384 + hoff; const bf16_t* vp = PNA + krow * NA_IN + 768 + hoff;
    float s = 0.f;
#pragma unroll
    for (int j8 = 0; j8 < 2; ++j8) { float kf[8]; unpack8(*(const u32x4*)(kp + j8 * 8), kf);
#pragma unroll
        for (int i = 0; i < 8; ++i) s += q[j8 * 8 + i] * kf[i]; }
    s += __shfl_xor(s, 1); s += __shfl_xor(s, 2); s += bias;
    const float mn = fmaxf(m, s), corr = __expf(m - mn), p = __expf(s - mn);
    m = mn; lsum = lsum * corr + p;
#pragma unroll
    for (int j8 = 0; j8 < 2; ++j8) { float vf[8]; unpack8(*(const u32x4*)(vp + j8 * 8), vf);
#pragma unroll
        for (int i = 0; i < 8; ++i) o[j8 * 8 + i] = o[j8 * 8 + i] * corr + p * vf[i]; }
}
__device__ __forceinline__ void natten_items_v1(const Params& P, int l, int wid0, int nworkers) {
    const bf16_t* PNA = (const bf16_t*)(P.ws + WS_PNA); bf16_t* MIX = (bf16_t*)(P.ws + WS_U);
    const float* rpb = P.in[I_RPB] + (size_t)l * 6 * 15 * 31;
    const int sub = wid0 & 3;
    for (int it = wid0 >> 2; it < T * 6; it += nworkers >> 2) {
        const int row = it % T, h = it / T, hoff = h * 64 + sub * 16;
        float q[16], o[16];
#pragma unroll
        for (int j8 = 0; j8 < 2; ++j8) { float qf[8]; unpack8(*(const u32x4*)(PNA + (size_t)row * NA_IN + hoff + j8 * 8), qf);
#pragma unroll
            for (int i = 0; i < 8; ++i) { q[j8 * 8 + i] = qf[i] * 0.125f; o[j8 * 8 + i] = 0.f; } }
        float m = -3.0e38f, lsum = 0.f;
        int b;
        if (row < TL) { b = row >> 13; const int t = row & (SEQ - 1), i = t >> 6, col = t & 63;
            const int start = min(max(i - 4, 0), 120), win0 = min(max(col - 8, 0), 48);
            for (int r = 0; r < 8; ++r) for (int kc = win0; kc < win0 + 16; ++kc) {
                const float bias = rpb[(h * 15 + (start + r - i + 7)) * 31 + (kc - col + 15)];
                natt_key(PNA, (size_t)b * SEQ + (start + r) * 64 + kc, hoff, q, bias, m, lsum, o); }
        } else b = (row - TL) >> 8;
        for (int c = 0; c < CTX; ++c) natt_key(PNA, (size_t)TL + b * CTX + c, hoff, q, 0.f, m, lsum, o);
        const float il = 1.0f / lsum;
#pragma unroll
        for (int j8 = 0; j8 < 2; ++j8) { u32x4 w; w.x = cvt_pk_bf16(o[j8 * 8 + 0] * il, o[j8 * 8 + 1] * il); w.y = cvt_pk_bf16(o[j8 * 8 + 2] * il, o[j8 * 8 + 3] * il);
            w.z = cvt_pk_bf16(o[j8 * 8 + 4] * il, o[j8 * 8 + 5] * il); w.w = cvt_pk_bf16(o[j8 * 8 + 6] * il, o[j8 * 8 + 7] * il);
            *(u32x4*)(MIX + (size_t)row * D + 640 + hoff + j8 * 8) = w; }
    }
}

__device__ __forceinline__ void vt_tile(const Params& P, int tile, unsigned short* tl  ) {
    const int tid = otid();
    const bf16_t* PNA = (const bf16_t*)(P.ws + WS_PNA);
    int h, tok0; bf16_t* dst; int ldt;
    if (tile < NB * 128 * 6) { h = tile % 6; const int sb = tile / 6; const int b = sb >> 7, blk = sb & 127; tok0 = b * SEQ + blk * 64; dst = (bf16_t*)(P.ws + WS_VTL) + ((size_t)(b * 6 + h) * 64) * SEQ + blk * 64; ldt = SEQ; }
    else { const int tt = tile - NB * 128 * 6; h = tt % 6; const int sb = tt / 6; const int b = sb >> 2, blk = sb & 3; tok0 = TL + b * CTX + blk * 64; dst = (bf16_t*)(P.ws + WS_VTC) + ((size_t)(b * 6 + h) * 64) * CTX + blk * 64; ldt = CTX; }
    { const int tok = tid >> 3, seg = tid & 7; const u32x4 v = *(const u32x4*)(PNA + (size_t)(tok0 + tok) * NA_IN + 768 + h * 64 + seg * 8);
      unsigned* w = (unsigned*)(tl + tok * 72 + seg * 8); w[0] = v.x; w[1] = v.y; w[2] = v.z; w[3] = v.w; }
    __syncthreads();
    { const int hd = tid >> 3, ts = tid & 7; unsigned short e[8];
#pragma unroll
      for (int k = 0; k < 8; ++k) e[k] = tl[(ts * 8 + k) * 72 + hd];
      u32x4 w; w.x = (unsigned)e[0] | ((unsigned)e[1] << 16); w.y = (unsigned)e[2] | ((unsigned)e[3] << 16); w.z = (unsigned)e[4] | ((unsigned)e[5] << 16); w.w = (unsigned)e[6] | ((unsigned)e[7] << 16);
      *(u32x4*)(dst + (size_t)hd * ldt + ts * 8) = w; }
    __syncthreads();
}
constexpr int NAT_LAT_TASKS = NB * 128 * 4 * 6, NAT_CTX_TASKS = NB * 16 * 6, NAT_TASKS = NAT_LAT_TASKS + NAT_CTX_TASKS;
__device__ __forceinline__ void natten_task(const Params& P, int l, int task) {
    using pg8::bf16x8;
    const int lane = otid() & 63, fr = lane & 15, fq = lane >> 4;
    const bf16_t* PNA = (const bf16_t*)(P.ws + WS_PNA); bf16_t* MIX = (bf16_t*)(P.ws + WS_U);
    const bool lat = task < NAT_LAT_TASKS;
    int b, h, i = 0, n = 0, qtok0;
    if (lat) { h = task % 6; const int r = task / 6; n = r & 3; i = (r >> 2) & 127; b = r >> 9; qtok0 = b * SEQ + i * 64 + 16 * n; }
    else { const int tt = task - NAT_LAT_TASKS; h = tt % 6; const int qb = (tt / 6) & 15; b = tt / 96; qtok0 = TL + b * CTX + 16 * qb; }
    const int start = min(max(i - 4, 0), 120), band0 = min(max(16 * n - 8, 0), 32);
    const int col = 16 * n + fr, win0 = min(max(col - 8, 0), 48);
    bf16x8 bq[2];
#pragma unroll
    for (int kh = 0; kh < 2; ++kh) bq[kh] = *(const bf16x8*)(PNA + (size_t)(qtok0 + fr) * NA_IN + h * 64 + kh * 32 + fq * 8);
    f32x4 sc[32];
    if (lat) {
#pragma unroll
        for (int t = 0; t < 16; ++t) { const int tok0 = b * SEQ + (start + (t >> 1)) * 64 + band0 + 16 * (t & 1);
            const bf16_t* kp = PNA + (size_t)(tok0 + fr) * NA_IN + 384 + h * 64 + fq * 8;
            const bf16x8 k0 = *(const bf16x8*)kp, k1 = *(const bf16x8*)(kp + 32);
            f32x4 a = (f32x4){0.f, 0.f, 0.f, 0.f};
            a = __builtin_amdgcn_mfma_f32_16x16x32_bf16(k0, bq[0], a, 0, 0, 0); a = __builtin_amdgcn_mfma_f32_16x16x32_bf16(k1, bq[1], a, 0, 0, 0);
            sc[t] = a; if ((t & 3) == 3) asm volatile("" ::: "memory"); }
    } else {
#pragma unroll
        for (int t = 0; t < 16; ++t) sc[t] = (f32x4){-3.0e38f, -3.0e38f, -3.0e38f, -3.0e38f};
    }
#pragma unroll
    for (int t = 16; t < 32; ++t) { const int tok0 = TL + b * CTX + 16 * (t - 16);
        const bf16_t* kp = PNA + (size_t)(tok0 + fr) * NA_IN + 384 + h * 64 + fq * 8;
        const bf16x8 k0 = *(const bf16x8*)kp, k1 = *(const bf16x8*)(kp + 32);
        f32x4 a = (f32x4){0.f, 0.f, 0.f, 0.f};
        a = __builtin_amdgcn_mfma_f32_16x16x32_bf16(k0, bq[0], a, 0, 0, 0); a = __builtin_amdgcn_mfma_f32_16x16x32_bf16(k1, bq[1], a, 0, 0, 0);
        sc[t] = a * 0.125f; if ((t & 3) == 3) asm volatile("" ::: "memory"); }
    if (lat) { const float* rpb = P.in[I_RPB] + ((size_t)l * 6 + h) * 15 * 31;
#pragma unroll
        for (int t = 0; t < 16; ++t) { const int ro = start + (t >> 1) - i + 7; const int kc0 = band0 + 16 * (t & 1) + fq * 4;
#pragma unroll
            for (int j = 0; j < 4; ++j) { const int kc = kc0 + j; const bool ok = kc >= win0 && kc < win0 + 16; const int co = min(max(kc - col + 15, 0), 30);
                const float bias = rpb[ro * 31 + co]; sc[t][j] = ok ? sc[t][j] * 0.125f + bias : -3.0e38f; } } }
    float mx = -3.0e38f;
#pragma unroll
    for (int t = 0; t < 32; ++t) mx = fmaxf(mx, fmaxf(fmaxf(sc[t][0], sc[t][1]), fmaxf(sc[t][2], sc[t][3])));
    mx = fmaxf(mx, __shfl_xor(mx, 16)); mx = fmaxf(mx, __shfl_xor(mx, 32));
    float sum = 0.f;
#pragma unroll
    for (int t = 0; t < 32; ++t) {
#pragma unroll
        for (int j = 0; j < 4; ++j) { const float p = __expf(sc[t][j] - mx); sc[t][j] = p; sum += p; } }
    sum += __shfl_xor(sum, 16); sum += __shfl_xor(sum, 32);
    const float inv = 1.0f / sum;
    f32x4 ot[4];
#pragma unroll
    for (int q = 0; q < 4; ++q) ot[q] = (f32x4){0.f, 0.f, 0.f, 0.f};
    const bf16_t* VTL = (const bf16_t*)(P.ws + WS_VTL) + ((size_t)(b * 6 + h) * 64) * SEQ; const bf16_t* VTC = (const bf16_t*)(P.ws + WS_VTC) + ((size_t)(b * 6 + h) * 64) * CTX;
    if (lat) {
#pragma unroll
        for (int m = 0; m < 8; ++m) { const int tk = (start + m) * 64 + band0 + fq * 4;
            u32x4 pw; pw.x = cvt_pk_bf16(sc[2 * m][0], sc[2 * m][1]); pw.y = cvt_pk_bf16(sc[2 * m][2], sc[2 * m][3]); pw.z = cvt_pk_bf16(sc[2 * m + 1][0], sc[2 * m + 1][1]); pw.w = cvt_pk_bf16(sc[2 * m + 1][2], sc[2 * m + 1][3]);
            const bf16x8 pb = __builtin_bit_cast(bf16x8, pw);
#pragma unroll
            for (int q = 0; q < 4; ++q) { const bf16_t* vp = VTL + (size_t)(q * 16 + fr) * SEQ + tk; const u32x2 v0 = *(const u32x2*)vp, v1 = *(const u32x2*)(vp + 16);
                u32x4 vw; vw.x = v0.x; vw.y = v0.y; vw.z = v1.x; vw.w = v1.y;
                ot[q] = __builtin_amdgcn_mfma_f32_16x16x32_bf16(__builtin_bit_cast(bf16x8, vw), pb, ot[q], 0, 0, 0); }
            if (m & 1) asm volatile("" ::: "memory"); }
    }
#pragma unroll
    for (int m = 0; m < 8; ++m) { const int tk = 32 * m + fq * 4;
        u32x4 pw; pw.x = cvt_pk_bf16(sc[16 + 2 * m][0], sc[16 + 2 * m][1]); pw.y = cvt_pk_bf16(sc[16 + 2 * m][2], sc[16 + 2 * m][3]); pw.z = cvt_pk_bf16(sc[17 + 2 * m][0], sc[17 + 2 * m][1]); pw.w = cvt_pk_bf16(sc[17 + 2 * m][2], sc[17 + 2 * m][3]);
        const bf16x8 pb = __builtin_bit_cast(bf16x8, pw);
#pragma unroll
        for (int q = 0; q < 4; ++q) { const bf16_t* vp = VTC + (size_t)(q * 16 + fr) * CTX + tk; const u32x2 v0 = *(const u32x2*)vp, v1 = *(const u32x2*)(vp + 16);
            u32x4 vw; vw.x = v0.x; vw.y = v0.y; vw.z = v1.x; vw.w = v1.y;
            ot[q] = __builtin_amdgcn_mfma_f32_16x16x32_bf16(__builtin_bit_cast(bf16x8, vw), pb, ot[q], 0, 0, 0); }
        if (m & 1) asm volatile("" ::: "memory"); }
#pragma unroll
    for (int q = 0; q < 4; ++q) { u32x2 w; w.x = cvt_pk_bf16(ot[q][0] * inv, ot[q][1] * inv); w.y = cvt_pk_bf16(ot[q][2] * inv, ot[q][3] * inv);
        *(u32x2*)(MIX + (size_t)(qtok0 + fr) * D + 640 + h * 64 + q * 16 + fq * 4) = w; }
}

__device__ __forceinline__ void fft_fwd(float2* X) {
#pragma unroll 1
    for (int lq = 12; lq >= 0; lq -= 2) { const int q = 1 << lq; const float rq = 1.0f / (float)(4 * q);
        for (int j = otid(); j < NFFT / 4; j += NTHR) { const int lo = j & (q - 1), base = ((j >> lq) << (lq + 2)) | lo;
            const float2 x0 = X[base], x1 = X[base + q], x2 = X[base + 2 * q], x3 = X[base + 3 * q];
            const float fr = (float)lo * rq; const float c = __builtin_amdgcn_cosf(fr), s = __builtin_amdgcn_sinf(fr), c2 = c * c - s * s, s2 = 2.f * c * s;
            const float a0x = x0.x + x2.x, a0y = x0.y + x2.y, dx = x0.x - x2.x, dy = x0.y - x2.y;
            const float a2x = dx * c + dy * s, a2y = dy * c - dx * s;
            const float a1x = x1.x + x3.x, a1y = x1.y + x3.y, ex = x1.x - x3.x, ey = x1.y - x3.y;
            const float mx = ex * c + ey * s, my = ey * c - ex * s;
            const float a3x = my, a3y = -mx;
            const float fx = a0x - a1x, fy = a0y - a1y, gx = a2x - a3x, gy = a2y - a3y;
            X[base] = make_float2(a0x + a1x, a0y + a1y); X[base + q] = make_float2(fx * c2 + fy * s2, fy * c2 - fx * s2);
            X[base + 2 * q] = make_float2(a2x + a3x, a2y + a3y); X[base + 3 * q] = make_float2(gx * c2 + gy * s2, gy * c2 - gx * s2); }
        __syncthreads(); }
}
__device__ __forceinline__ void fft_inv(float2* X) {
#pragma unroll 1
    for (int lq = 0; lq <= 12; lq += 2) { const int q = 1 << lq; const float rq = 1.0f / (float)(4 * q);
        for (int j = otid(); j < NFFT / 4; j += NTHR) { const int lo = j & (q - 1), base = ((j >> lq) << (lq + 2)) | lo;
            const float2 y0 = X[base], y1 = X[base + q], y2 = X[base + 2 * q], y3 = X[base + 3 * q];
            const float fr = (float)lo * rq; const float c = __builtin_amdgcn_cosf(fr), s = __builtin_amdgcn_sinf(fr), c2 = c * c - s * s, s2 = 2.f * c * s;
            const float tx = y1.x * c2 - y1.y * s2, ty = y1.x * s2 + y1.y * c2;
            const float a0x = y0.x + tx, a0y = y0.y + ty, a1x = y0.x - tx, a1y = y0.y - ty;
            const float ux = y3.x * c2 - y3.y * s2, uy = y3.x * s2 + y3.y * c2;
            const float a2x = y2.x + ux, a2y = y2.y + uy, a3x = y2.x - ux, a3y = y2.y - uy;
            const float vx = a2x * c - a2y * s, vy = a2x * s + a2y * c;
            const float mx = a3x * c - a3y * s, my = a3x * s + a3y * c;
            const float wx = -my, wy = mx;
            X[base] = make_float2(a0x + vx, a0y + vy); X[base + 2 * q] = make_float2(a0x - vx, a0y - vy);
            X[base + q] = make_float2(a1x + wx, a1y + wy); X[base + 3 * q] = make_float2(a1x - wx, a1y - wy); }
        __syncthreads(); }
}
__device__ __forceinline__ float hy_delta(int c) { const float lo = -4.605170185988091f / 1.5f, hi = -4.605170185988091f / 0.3f; return fabsf(lo + (float)c * ((hi - lo) / 255.0f)); }
__device__ __forceinline__ float hy_short(const bf16_t* PHYT, const float* cw, const float* cb, int row, int col) {
    bool hp, hn; row_nbrs(row, hp, hn);
    const bf16_t* p = PHYT + (size_t)col * T + row;
    float v = cb[col] + cw[HY_IN + col] * bf2f(p[0]);
    if (hp) v += cw[col] * bf2f(p[-1]);
    if (hn) v += cw[2 * HY_IN + col] * bf2f(p[1]);
    return v;
}
struct HyTap { float w0, w1, w2, b; };
__device__ __forceinline__ HyTap hy_tap(const float* cw, const float* cb, int col) { HyTap t; t.w0 = cw[col]; t.w1 = cw[HY_IN + col]; t.w2 = cw[2 * HY_IN + col]; t.b = cb[col]; return t; }
__device__ __forceinline__ float hy_lat(const bf16_t* colp, int b, int n, const HyTap t) {
    const bf16_t* p = colp + b * SEQ + n;
    const float xm = bf2f(p[n > 0 ? -1 : 0]), x0 = bf2f(p[0]), xp = bf2f(p[n < SEQ - 1 ? 1 : 0]);
    return t.b + t.w1 * x0 + (n > 0 ? t.w0 * xm : 0.f) + (n < SEQ - 1 ? t.w2 * xp : 0.f);
}
__device__ __forceinline__ void hy_spec_task(const Params& P, int l, int o, int c, float2* X, float* ex_) {
    const int tid = otid();
    const bf16_t* ff = (const bf16_t*)(P.ws + WS_FILT) + (size_t)(o * 512 + c) * SEQ; const bf16_t* fb = ff + (size_t)256 * SEQ;
    for (int n = tid; n < SEQ; n += NTHR) {
        X[n] = make_float2(bf2f(ff[n]), 0.f);
        if (n > 0) X[NFFT - n] = make_float2(bf2f(fb[n]), 0.f); else X[SEQ] = make_float2(0.f, 0.f); }
    __syncthreads();
    fft_fwd(X);
    float2* spec = (float2*)(P.ws + WS_SPEC) + (size_t)(o * 256 + c) * NFFT;
    for (int i = tid; i < NFFT; i += NTHR) spec[i] = X[i];
    __syncthreads();
}
__device__ __forceinline__ void hy_conv_core(const Params& P, int o, int c, float2* X) {
    fft_fwd(X);
    const float2* spec = (const float2*)(P.ws + WS_SPEC) + (size_t)(o * 256 + c) * NFFT;
    for (int i = otid(); i < NFFT; i += NTHR) { const float2 a = X[i], k = spec[i]; X[i] = make_float2(a.x * k.x - a.y * k.y, a.x * k.y + a.y * k.x); }
    __syncthreads();
    fft_inv(X);
}
__device__ __forceinline__ void hy_task1(const Params& P, int l, int c, float2* X, float* ex) {
    const int tid = otid();
    const bf16_t* PHY = (const bf16_t*)(P.ws + WS_PHY); const float* cw = P.in[I_HCW] + (size_t)l * 3 * HY_IN; const float* cb = P.in[I_HCB] + (size_t)l * HY_IN;
    const float bias0 = P.in[I_HBIAS][(size_t)l * 2 * HYC + c], bias1 = P.in[I_HBIAS][(size_t)l * 2 * HYC + HYC + c];
    const HyTap tv = hy_tap(cw, cb, c), tg1 = hy_tap(cw, cb, HYC + c); const bf16_t* colv = PHY + (size_t)c * T; const bf16_t* colg1 = PHY + (size_t)(HYC + c) * T;
#pragma unroll 4
    for (int n = tid; n < SEQ; n += NTHR) { X[n] = make_float2(hy_lat(colv, 0, n, tv), hy_lat(colv, 1, n, tv)); X[SEQ + n] = make_float2(0.f, 0.f); }
    __syncthreads();
    hy_conv_core(P, 0, c, X);
    float* Z1 = (float*)(P.ws + WS_Z1) + (size_t)c * NB * SEQ;
#pragma unroll 4
    for (int n = tid; n < SEQ; n += NTHR) { const float2 y = X[n];
        const float v0 = hy_lat(colv, 0, n, tv), v1 = hy_lat(colv, 1, n, tv), g0 = hy_lat(colg1, 0, n, tg1), g1 = hy_lat(colg1, 1, n, tg1);
        Z1[n] = g0 * (y.x + bias0 * v0); Z1[SEQ + n] = g1 * (y.y + bias0 * v1); }
    __syncthreads();
    float* f = (float*)X;
    float* vv = f, *x1 = f + 512, *x2 = f + 1024, *hf = f + 1536  , *z1 = f + 2560;
    const bf16_t* fc = (const bf16_t*)(P.ws + WS_FILTC);
    { const int b = tid >> 8, t = tid & 255, row = TL + b * CTX + t;
      vv[tid] = hy_short(PHY, cw, cb, row, c); x1[tid] = hy_short(PHY, cw, cb, row, HYC + c); x2[tid] = hy_short(PHY, cw, cb, row, 2 * HYC + c);
      for (int q = tid; q < 1024; q += NTHR) { const int od = q >> 8, n = q & 255; hf[q] = bf2f(fc[(size_t)(od * 256 + c) * CTX + n]); } }
    __syncthreads();
    { const int b = tid >> 8, t = tid & 255; float y = bias0 * vv[tid];
      for (int s = 0; s <= t; ++s) y += hf[t - s] * vv[b * 256 + s];
      for (int s = t + 1; s < CTX; ++s) y += hf[256 + s - t] * vv[b * 256 + s];
      z1[tid] = x1[tid] * y; }
    __syncthreads();
    { const int b = tid >> 8, t = tid & 255; float y = bias1 * z1[tid];
      for (int s = 0; s <= t; ++s) y += hf[512 + t - s] * z1[b * 256 + s];
      for (int s = t + 1; s < CTX; ++s) y += hf[768 + s - t] * z1[b * 256 + s];
      bf16_t* MIX = (bf16_t*)(P.ws + WS_U); MIX[(size_t)(TL + b * CTX + t) * D + c] = f2bf(x2[tid] * y); }
    __syncthreads();
}
__device__ __forceinline__ void hy_task2(const Params& P, int l, int c, float2* X) {
    const int tid = otid();
    const bf16_t* PHY = (const bf16_t*)(P.ws + WS_PHY); const float* cw = P.in[I_HCW] + (size_t)l * 3 * HY_IN; const float* cb = P.in[I_HCB] + (size_t)l * HY_IN;
    const float bias1 = P.in[I_HBIAS][(size_t)l * 2 * HYC + HYC + c];
    const float* Z1 = (const float*)(P.ws + WS_Z1) + (size_t)c * NB * SEQ;
    for (int n = tid; n < SEQ; n += NTHR) { X[n] = make_float2(Z1[n], Z1[SEQ + n]); X[SEQ + n] = make_float2(0.f, 0.f); }
    __syncthreads();
    hy_conv_core(P, 1, c, X);
    bf16_t* MIX = (bf16_t*)(P.ws + WS_U);
    const HyTap tg2 = hy_tap(cw, cb, 2 * HYC + c); const bf16_t* colg2 = PHY + (size_t)(2 * HYC + c) * T;
#pragma unroll 4
    for (int n = tid; n < SEQ; n += NTHR) { const float2 y = X[n];
        const float g0 = hy_lat(colg2, 0, n, tg2), g1 = hy_lat(colg2, 1, n, tg2);
        MIX[(size_t)n * D + c] = f2bf(g0 * (y.x + bias1 * Z1[n])); MIX[(size_t)(SEQ + n) * D + c] = f2bf(g1 * (y.y + bias1 * Z1[SEQ + n])); }
    __syncthreads();
}

constexpr int SEGC = 256, NSEG = 33, SCH = 4;
typedef float f32x2v __attribute__((ext_vector_type(2)));
template <bool IDENT>
__device__ __forceinline__ void scan_seg(const Params& P, int chain, int g, float* ring_  ) {
    const ldsfp ring = vlds(ring_);
    const int lane = otid() & 63;
    const int d = chain & 1, h = (chain >> 1) % 6, b = chain / 12;
    const float* DEC = (const float*)(P.ws + WS_DECAY) + (size_t)d * T * 384; const bf16_t* KKS = (const bf16_t*)(P.ws + WS_KKS); const bf16_t* RS = (const bf16_t*)(P.ws + WS_RS);
    const bf16_t* VS = (const bf16_t*)(P.ws + WS_VS); const bf16_t* KS = (const bf16_t*)(P.ws + WS_KS) + (size_t)d * T * 384; const bf16_t* BS = (const bf16_t*)(P.ws + WS_BS) + (size_t)d * T * 384;
    float* YD = (float*)(P.ws + WS_YDIR) + (size_t)d * T * 384;
    bf16_t* E = (bf16_t*)(P.ws + WS_E) + (size_t)chain * SEQ * 64;
    const int step0 = g == 0 ? 0 : CTX + (g - 1) * SEGC;
    f32x2v S0[32], S1[32];
#pragma unroll
    for (int j = 0; j < 32; ++j) { S0[j] = (f32x2v){0.f, 0.f}; S1[j] = (f32x2v){(2 * j == lane) ? 1.f : 0.f, (2 * j + 1 == lane) ? 1.f : 0.f}; }
    float pw[SCH], pa[SCH], pb[SCH], pk[SCH], pr[SCH], pv[SCH]; int po[SCH];
#pragma unroll
    for (int s = 0; s < SCH; ++s) { const int o = scan_row(b, d, step0 + s) * 384 + h * 64 + lane; po[s] = o;
        pw[s] = DEC[o]; pa[s] = bf2f(KKS[o]); pb[s] = bf2f(BS[o]); pk[s] = bf2f(KS[o]); pr[s] = bf2f(RS[o]); pv[s] = bf2f(VS[o]); }
    for (int c = 0; c < SEGC / SCH; ++c) {
        float cv[SCH]; int co[SCH];
        asm volatile("s_waitcnt lgkmcnt(0)" ::: "memory");
#pragma unroll
        for (int s = 0; s < SCH; ++s) { const ldsfp sv = ring + s * 320; sv[lane] = pw[s]; sv[64 + lane] = pa[s]; sv[128 + lane] = pb[s]; sv[192 + lane] = pk[s]; sv[256 + lane] = pr[s]; cv[s] = pv[s]; co[s] = po[s]; }
        asm volatile("s_waitcnt lgkmcnt(0)" ::: "memory");
        if (c + 1 < SEGC / SCH) {
#pragma unroll
            for (int s = 0; s < SCH; ++s) { const int o = scan_row(b, d, step0 + (c + 1) * SCH + s) * 384 + h * 64 + lane; po[s] = o;
                pw[s] = DEC[o]; pa[s] = bf2f(KKS[o]); pb[s] = bf2f(BS[o]); pk[s] = bf2f(KS[o]); pr[s] = bf2f(RS[o]); pv[s] = bf2f(VS[o]); } }
#pragma unroll
        for (int s = 0; s < SCH; ++s) { const ldsfp sv = ring + s * 320;
            f32x2v sa2 = (f32x2v){0.f, 0.f}, sb2 = (f32x2v){0.f, 0.f}, sa3 = sa2, sb3 = sa2;
#pragma unroll
            for (int hb = 0; hb < 2; ++hb) { f32x4 A[8];
#pragma unroll
                for (int i = 0; i < 8; ++i) A[i] = *(const LAS f32x4*)(sv + 64 + hb * 32 + 4 * i);
                __builtin_amdgcn_sched_barrier(0);
#pragma unroll
                for (int i = 0; i < 8; ++i) { const int jj = hb * 16 + 2 * i; const f32x2v alo = (f32x2v){A[i].x, A[i].y}, ahi = (f32x2v){A[i].z, A[i].w};
                    sa2 += S0[jj] * alo; sa3 += S0[jj + 1] * ahi;
                    if (IDENT) { sb2 += S1[jj] * alo; sb3 += S1[jj + 1] * ahi; } }
                __builtin_amdgcn_sched_barrier(0); }
            const float sa = (sa2.x + sa2.y) + (sa3.x + sa3.y), sb = (sb2.x + sb2.y) + (sb3.x + sb3.y);
            const f32x2v saa = (f32x2v){sa, sa}, sbb = (f32x2v){sb, sb}, vv = (f32x2v){cv[s], cv[s]};
            f32x2v y2 = (f32x2v){0.f, 0.f}, y3 = y2, e2 = y2, e3 = y2;
#pragma unroll
            for (int ch = 0; ch < 8; ++ch) { f32x4 W[2], Bq[2], K[2], R[2];
#pragma unroll
                for (int i = 0; i < 2; ++i) { const int j = ch * 8 + 4 * i; W[i] = *(const LAS f32x4*)(sv + j); Bq[i] = *(const LAS f32x4*)(sv + 128 + j); K[i] = *(const LAS f32x4*)(sv + 192 + j); R[i] = *(const LAS f32x4*)(sv + 256 + j); }
                __builtin_amdgcn_sched_barrier(0);
#pragma unroll
                for (int i = 0; i < 2; ++i) { const int jj = ch * 4 + 2 * i;
                    const f32x2v wlo = (f32x2v){W[i].x, W[i].y}, whi = (f32x2v){W[i].z, W[i].w}, blo = (f32x2v){Bq[i].x, Bq[i].y}, bhi = (f32x2v){Bq[i].z, Bq[i].w};
                    const f32x2v klo = (f32x2v){K[i].x, K[i].y}, khi = (f32x2v){K[i].z, K[i].w}, rlo = (f32x2v){R[i].x, R[i].y}, rhi = (f32x2v){R[i].z, R[i].w};
                    S0[jj] = S0[jj] * wlo + saa * blo + vv * klo; y2 += S0[jj] * rlo;
                    S0[jj + 1] = S0[jj + 1] * whi + saa * bhi + vv * khi; y3 += S0[jj + 1] * rhi;
                    if (IDENT) { S1[jj] = S1[jj] * wlo + sbb * blo; e2 += S1[jj] * rlo; S1[jj + 1] = S1[jj + 1] * whi + sbb * bhi; e3 += S1[jj + 1] * rhi; } }
                __builtin_amdgcn_sched_barrier(0); }
            YD[co[s]] = (y2.x + y2.y) + (y3.x + y3.y);
            if (IDENT) { const int tl = d ? (SEQ - 1 - (step0 - CTX + c * SCH + s)) : (step0 - CTX + c * SCH + s); E[(size_t)tl * 64 + lane] = f2bf((e2.x + e2.y) + (e3.x + e3.y)); }
        }
    }
    float* ZP = (float*)(P.ws + WS_ZP) + ((size_t)chain * NSEG + g) * 2 * 4096;
#pragma unroll
    for (int j = 0; j < 32; j += 2) { *(float4*)(ZP + lane * 64 + 2 * j) = make_float4(S0[j].x, S0[j].y, S0[j + 1].x, S0[j + 1].y);
        if (IDENT) *(float4*)(ZP + 4096 + lane * 64 + 2 * j) = make_float4(S1[j].x, S1[j].y, S1[j + 1].x, S1[j + 1].y); }
}
__device__ __forceinline__ void scan_combine(const Params& P, int chain, float* lds) {
    const int tid = otid(); const int i = tid >> 3, j0 = (tid & 7) * 8;
    float* Sl = lds;
    float* Pl = lds + 64 * 65;
    float* ZPc = (float*)(P.ws + WS_ZP) + (size_t)chain * NSEG * 2 * 4096;
    float sn[8];
#pragma unroll
    for (int q = 0; q < 8; ++q) sn[q] = ZPc[i * 64 + j0 + q];
    for (int g = 1; g < NSEG - 1; ++g) {
        __syncthreads();
#pragma unroll
        for (int q = 0; q < 8; ++q) Sl[i * 65 + j0 + q] = sn[q];
        const float* Pg = ZPc + (size_t)g * 2 * 4096 + 4096;
#pragma unroll
        for (int q = 0; q < 8; ++q) Pl[tid * 8 + q] = Pg[tid * 8 + q];
        float* Zg = ZPc + (size_t)g * 2 * 4096;
#pragma unroll
        for (int q = 0; q < 8; ++q) sn[q] = Zg[i * 64 + j0 + q];
        __syncthreads();
        for (int m = 0; m < 64; ++m) { const float sv = Sl[i * 65 + m]; const float4 p0 = *(const float4*)(Pl + m * 64 + j0), p1 = *(const float4*)(Pl + m * 64 + j0 + 4);
            sn[0] += sv * p0.x; sn[1] += sv * p0.y; sn[2] += sv * p0.z; sn[3] += sv * p0.w; sn[4] += sv * p1.x; sn[5] += sv * p1.y; sn[6] += sv * p1.z; sn[7] += sv * p1.w; }
#pragma unroll
        for (int q = 0; q < 8; ++q) Zg[i * 64 + j0 + q] = sn[q];
    }
    __syncthreads();
}

__device__ __forceinline__ void rwkv_out_fin(const Params& P, int row, int c, float y, float lnw, float lnb, float bon, float vs, float gt) {
    bf16_t* MIX = (bf16_t*)(P.ws + WS_U);
    const float mean = wsum(y) * (1.0f / 64.0f); const float dv = y - mean; const float var = wsum(dv * dv) * (1.0f / 64.0f);
    const float yn = dv * rsqrtf(var + 64e-5f) * lnw + lnb;
    MIX[(size_t)row * D + 256 + c] = f2bf((yn + bon * vs) * gt);
}
__device__ __forceinline__ void ph_rwkvout(const Params& P, int l, float* ldsf) {
    using pg8::bf16x8;
    const int tid = otid(), lane = tid & 63, fr = lane & 15, fq = lane >> 4, wv = tid >> 6, gw = blockIdx.x * NWAVE + wv, nw = gridDim.x * NWAVE;
    const float* YD = (const float*)(P.ws + WS_YDIR); const bf16_t* VS = (const bf16_t*)(P.ws + WS_VS); const bf16_t* GT = (const bf16_t*)(P.ws + WS_GATE); const float* BON = (const float*)(P.ws + WS_BONUS);
    bf16_t* MIX = (bf16_t*)(P.ws + WS_U);
    for (int it = gw; it < NB * 6 * 32 * 4; it += nw) {
        const int sub = it & 3, q = (it >> 2) & 31, h = (it >> 7) % 6, b = it / (128 * 6);
        const int t0 = q * 256 + sub * 64;
        f32x4 acc[4][4];
#pragma unroll
        for (int mt = 0; mt < 4; ++mt)
#pragma unroll
            for (int nt = 0; nt < 4; ++nt) acc[mt][nt] = (f32x4){0.f, 0.f, 0.f, 0.f};
#pragma unroll
        for (int dir = 0; dir < 2; ++dir) { const int ch = b * 12 + h * 2 + dir, slot = dir ? (31 - q) : q;
            const float* Sp = (const float*)(P.ws + WS_ZP) + ((size_t)ch * NSEG + slot) * 2 * 4096;
            const bf16_t* Ep = (const bf16_t*)(P.ws + WS_E) + ((size_t)ch * SEQ + t0) * 64;
#pragma unroll
            for (int ks = 0; ks < 2; ++ks) { bf16x8 bop[4];
#pragma unroll
                for (int nt = 0; nt < 4; ++nt) { const float* sp = Sp + (nt * 16 + fr) * 64 + ks * 32 + fq * 8; const float4 s0 = *(const float4*)sp, s1 = *(const float4*)(sp + 4);
                    u32x4 w; w.x = cvt_pk_bf16(s0.x, s0.y); w.y = cvt_pk_bf16(s0.z, s0.w); w.z = cvt_pk_bf16(s1.x, s1.y); w.w = cvt_pk_bf16(s1.z, s1.w); bop[nt] = __builtin_bit_cast(bf16x8, w); }
#pragma unroll
                for (int mt = 0; mt < 4; ++mt) { const bf16x8 a = *(const bf16x8*)(Ep + (size_t)(mt * 16 + fr) * 64 + ks * 32 + fq * 8);
#pragma unroll
                    for (int nt = 0; nt < 4; ++nt) acc[mt][nt] = __builtin_amdgcn_mfma_f32_16x16x32_bf16(a, bop[nt], acc[mt][nt], 0, 0, 0); } } }
        float lnw[4], lnb[4];
#pragma unroll
        for (int nt = 0; nt < 4; ++nt) { lnw[nt] = P.in[I_LNW][l * RWW + h * 64 + nt * 16 + fr]; lnb[nt] = P.in[I_LNB][l * RWW + h * 64 + nt * 16 + fr]; }
#pragma unroll
        for (int mt = 0; mt < 4; ++mt)
#pragma unroll
            for (int rg = 0; rg < 4; ++rg) { const int row = b * SEQ + t0 + mt * 16 + fq * 4 + rg; const size_t o = (size_t)row * 384 + h * 64 + fr;
                float y[4], vs[4], gt[4]; const float bon = BON[(size_t)row * 6 + h];
#pragma unroll
                for (int nt = 0; nt < 4; ++nt) { y[nt] = YD[o + nt * 16] + YD[(size_t)T * 384 + o + nt * 16] + acc[mt][nt][rg]; vs[nt] = bf2f(VS[o + nt * 16]); gt[nt] = bf2f(GT[o + nt * 16]); }
                float sm = (y[0] + y[1]) + (y[2] + y[3]);
                sm += __shfl_xor(sm, 1); sm += __shfl_xor(sm, 2); sm += __shfl_xor(sm, 4); sm += __shfl_xor(sm, 8);
                const float mean = sm * (1.0f / 64.0f);
                float vr = 0.f;
#pragma unroll
                for (int nt = 0; nt < 4; ++nt) { y[nt] -= mean; vr += y[nt] * y[nt]; }
                vr += __shfl_xor(vr, 1); vr += __shfl_xor(vr, 2); vr += __shfl_xor(vr, 4); vr += __shfl_xor(vr, 8);
                const float rstd = rsqrtf(vr * (1.0f / 64.0f) + 64e-5f);
#pragma unroll
                for (int nt = 0; nt < 4; ++nt) MIX[(size_t)row * D + 256 + h * 64 + nt * 16 + fr] = f2bf((y[nt] * rstd * lnw[nt] + lnb[nt] + bon * vs[nt]) * gt[nt]);
                if (rg & 1) asm volatile("" ::: "memory"); }
    }
    for (int it = gw; it < TC * 6; it += nw) { const int row = TL + it / 6, h = it % 6, c = h * 64 + lane; const size_t o = (size_t)row * 384 + c;
        rwkv_out_fin(P, row, c, YD[o] + YD[(size_t)T * 384 + o], P.in[I_LNW][l * RWW + c], P.in[I_LNB][l * RWW + c], BON[(size_t)row * 6 + h], bf2f(VS[o]), bf2f(GT[o])); }
}

typedef const __attribute__((address_space(4))) Params* KParamsPtr;
__device__ __forceinline__ const Params* fresh_params() { KParamsPtr q = (KParamsPtr)__builtin_amdgcn_kernarg_segment_ptr(); asm volatile("" : "+s"(q)); return (const Params*)q; }
__global__ void __launch_bounds__(NTHR, 2) fwd_megakernel(Params P_unused, int ph_lo, int ph_hi) {
    extern __shared__ __attribute__((aligned(16))) unsigned char smem[];
    cg::grid_group grid = cg::this_grid();
    LAS unsigned char* lds3 = (LAS unsigned char*)smem;
    float* ldsf = (float*)smem; float2* X = (float2*)smem; float* ex = (float*)(smem + LDS_MAIN);
    { volatile LAS unsigned* st = (volatile LAS unsigned*)(lds3 + LDS_MAIN + 4096); if (threadIdx.x == 0) { st[0] = 0u; st[1] = 0u; } }
    __syncthreads();
    XcdBarrier xbar = xcd_barrier_post((unsigned*)(((const Params*)fresh_params())->ws + WS_BAR), (volatile LAS unsigned*)(lds3 + LDS_MAIN + 4096));
    int ph = 0;
#ifndef REP_GEMM
#define REP_GEMM 1
#endif
#ifndef REP_SCAN
#define REP_SCAN 1
#endif
#ifndef REP_MISC
#define REP_MISC 1
#endif
#ifndef REP_HY
#define REP_HY 1
#endif
#define PHASE_BEGIN if (ph >= ph_lo && ph < ph_hi) { const Params& P = *fresh_params(); unsigned char* ws = P.ws; (void)ws;
#ifndef REP_SYNC
#define REP_SYNC 1
#endif
#define PHASE_END   if (ph + 1 < ph_hi) { for (int rs_ = 0; rs_ < REP_SYNC; ++rs_) { if (ph == 0) grid.sync(); else xcd_barrier(xbar); } } } ++ph;
    PHASE_BEGIN ph_modv(P, ldsf); PHASE_END
    for (int l = 0; l < DEPTH; ++l) {
        PHASE_BEGIN
            for (int rep_ = 0; rep_ < REP_MISC; ++rep_) ph_prep(P, l, ldsf);
            if (l == 0) ph_rowpass(P, 0, 0, 0, 0, 0.f, 0, 0, 0, 1);
            else ph_rowpass(P, 1, l - 1, 8, 5, 0.5f, l, 0, 0, 1);
        PHASE_END
        PHASE_BEGIN { EpiGU E{(bf16_t*)(ws + WS_ACT)}; for (int rep_ = 0; rep_ < REP_GEMM; ++rep_) run_gemm(lds3, (const bf16_t*)(ws + WS_U), (const bf16_t*)(ws + WS_WGU1), T, 2 * DFF, D, E); } PHASE_END
        PHASE_BEGIN { EpiF32 E{(bf16_t*)(ws + WS_Y)}; for (int rep_ = 0; rep_ < REP_GEMM; ++rep_) run_gemm(lds3, (const bf16_t*)(ws + WS_ACT), (const bf16_t*)(ws + WS_WDN1), T, D, DFF, E); } PHASE_END
        PHASE_BEGIN ph_rowpass(P, 1, l, 2, 1, 0.5f, l, 2, 3, 4); PHASE_END
        PHASE_BEGIN { EpiWin E{(bf16_t*)(ws + WS_PHY), (bf16_t*)(ws + WS_PRW), (bf16_t*)(ws + WS_PNA)}; for (int rep_ = 0; rep_ < REP_GEMM; ++rep_) run_gemm(lds3, (const bf16_t*)(ws + WS_U), (const bf16_t*)(ws + WS_WIN), T, INWP, D, E); } PHASE_END
        PHASE_BEGIN
            for (int rep_ = 0; rep_ < REP_MISC; ++rep_) { ph_loraprep(P, l);
            for (int it = blockIdx.x; it < NB * 128 * 6 + NB * 4 * 6; it += gridDim.x) vt_tile(P, it, (unsigned short*)smem); }
            for (int rep_ = 0; rep_ < REP_HY; ++rep_) for (int it = blockIdx.x; it < 512; it += gridDim.x) hy_spec_task(P, l, it >> 8, it & 255, X, ex);
        PHASE_END
        PHASE_BEGIN { EpiLora E{(bf16_t*)(ws + WS_LORAO), (bf16_t*)(ws + WS_GATE)};
            for (int rep_ = 0; rep_ < REP_GEMM; ++rep_) run_gemm(lds3, (const bf16_t*)(ws + WS_ALORA), (const bf16_t*)(ws + WS_WLORA), T, 2048, 384, E); } PHASE_END
        PHASE_BEGIN
            for (int rep_ = 0; rep_ < REP_MISC; ++rep_) ph_rwkvprep(P, l);
            for (int rep_ = 0; rep_ < REP_HY; ++rep_) for (int c = blockIdx.x; c < HYC; c += gridDim.x) hy_task1(P, l, c, X, ex);
        PHASE_END
        PHASE_BEGIN {
            const int wv = __builtin_amdgcn_readfirstlane(otid() >> 6);
            if (wv < 4) { const int k = wv * (int)gridDim.x + (int)blockIdx.x;
                if (k < 24 * NSEG) { const int chain = k / NSEG, g = k % NSEG; float* ring = ldsf + wv * (SCH * 320);
                    for (int rep_ = 0; rep_ < REP_SCAN; ++rep_) { if (g == 0) scan_seg<false>(P, chain, g, ring); else scan_seg<true>(P, chain, g, ring); } } }
            else for (int it = (wv - 4) * (int)gridDim.x + (int)blockIdx.x; it < NAT_TASKS; it += 4 * (int)gridDim.x) natten_task(P, l, it);
        } PHASE_END
        PHASE_BEGIN
            if (blockIdx.x < 24) scan_combine(P, blockIdx.x, ldsf);
            else for (int rep_ = 0; rep_ < REP_HY; ++rep_) for (int c = blockIdx.x - 24; c < HYC; c += gridDim.x - 24) hy_task2(P, l, c, X);
        PHASE_END
        PHASE_BEGIN for (int rep_ = 0; rep_ < REP_MISC; ++rep_) ph_rwkvout(P, l, ldsf); PHASE_END
        PHASE_BEGIN { EpiF32 E{(bf16_t*)(ws + WS_Y)}; for (int rep_ = 0; rep_ < REP_GEMM; ++rep_) run_gemm(lds3, (const bf16_t*)(ws + WS_U), (const bf16_t*)(ws + WS_WOUT), T, D, D, E); } PHASE_END
        PHASE_BEGIN ph_rowpass(P, 1, l, 5, 3, 1.0f, l, 4, 6, 7); PHASE_END
        PHASE_BEGIN { EpiGU E{(bf16_t*)(ws + WS_ACT)}; for (int rep_ = 0; rep_ < REP_GEMM; ++rep_) run_gemm(lds3, (const bf16_t*)(ws + WS_U), (const bf16_t*)(ws + WS_WGU2), T, 2 * DFF, D, E); } PHASE_END
        PHASE_BEGIN { EpiF32 E{(bf16_t*)(ws + WS_Y)}; for (int rep_ = 0; rep_ < REP_GEMM; ++rep_) run_gemm(lds3, (const bf16_t*)(ws + WS_ACT), (const bf16_t*)(ws + WS_WDN2), T, D, DFF, E); } PHASE_END
    }
    PHASE_BEGIN ph_rowpass(P, 2, DEPTH - 1, 8, 5, 0.5f, 0, 0, 0, 0); PHASE_END
#undef PHASE_BEGIN
#undef PHASE_END
}
constexpr int N_PHASES = 1 + DEPTH * 15 + 1;

extern "C" void kernel_launch(void* const* d_in, const int* in_sizes, int n_in, void* d_out, int out_size, void* d_ws, size_t ws_size, hipStream_t stream) {
    static int grid = 0;
    if (grid == 0) {
        if (n_in != 34 || ws_size < WS_END) { fprintf(stderr, "kernel_launch: need 34 inputs and %zu bytes of workspace; got %d, %zu\n", (size_t)WS_END, n_in, ws_size); grid = -1; return; }
        int dev = 0, cus = 0, per_cu = 0;
        hipGetDevice(&dev); hipDeviceGetAttribute(&cus, hipDeviceAttributeMultiprocessorCount, dev);
        if (hipFuncSetAttribute((const void*)fwd_megakernel, hipFuncAttributeMaxDynamicSharedMemorySize, LDS_BYTES) != hipSuccess) { fprintf(stderr, "kernel_launch: hipFuncSetAttribute failed\n"); grid = -1; return; }
        if (hipOccupancyMaxActiveBlocksPerMultiprocessor(&per_cu, (const void*)fwd_megakernel, NTHR, LDS_BYTES) != hipSuccess || per_cu < 1) { fprintf(stderr, "kernel_launch: occupancy query says %d\n", per_cu); per_cu = 1; }
        (void)hipGetLastError();
        grid = cus;
    }
    if (grid < 0) return;
    if (hipMemsetAsync((char*)d_ws + WS_BAR, 0, (size_t)XCD_BAR_WORDS * 4, stream) != hipSuccess) { fprintf(stderr, "kernel_launch: memset of the barrier words failed\n"); return; }
    Params p{};
    for (int i = 0; i < 34; ++i) p.in[i] = (const float*)d_in[i];
    p.out = (float*)d_out; p.ws = (unsigned char*)d_ws;
#if MK_SPLIT
    for (int ph = 0; ph < N_PHASES; ++ph) { int lo = ph, hi = ph + 1; hipLaunchKernelGGL(fwd_megakernel, dim3(grid), dim3(NTHR), LDS_BYTES, stream, p, lo, hi); }
#else
    int lo = 0, hi = N_PHASES;
    void* args[] = {&p, &lo, &hi};
    hipError_t e = hipLaunchCooperativeKernel((const void*)fwd_megakernel, dim3(grid), dim3(NTHR), args, LDS_BYTES, stream);
    if (e != hipSuccess) fprintf(stderr, "cooperative launch failed: %s (grid %d)\n", hipGetErrorString(e), grid);
#endif
}
```

```cpp
#include <hip/hip_runtime.h>
#include <hip/hip_cooperative_groups.h>
#include <cstdio>
namespace cg = cooperative_groups;
__device__ __forceinline__ int otid() { int t = threadIdx.x; asm volatile("" : "+v"(t)); return t; }
namespace pg8 {
#define PG8_LAS __attribute__((address_space(3)))
typedef unsigned short bf16_t;
typedef short bf16x8 __attribute__((ext_vector_type(8)));
typedef float f32x4 __attribute__((ext_vector_type(4)));
typedef unsigned u32x4 __attribute__((ext_vector_type(4)));
constexpr int BM = 256, BK = 64, HALF = 128, HTB = HALF * BK * 2  , STAGE_BYTES = 8 * HTB, NXCD = 8, WGM = 8;

__host__ __device__ __forceinline__ int lds_byte(int r, int c) { const int st = (r >> 4) * 2 + (c >> 5), rr = r & 15, cc = c & 31, ob = rr * 64 + cc * 2; return st * 1024 + (ob ^ (((ob >> 9) & 1) << 5)); }
__host__ __device__ __forceinline__ void stage_rc(int b, int& R, int& C) { const int st = b / 1024, sb = b % 1024, swz = sb ^ (((sb >> 9) & 1) << 5); R = (st >> 1) * 16 + swz / 64; C = (st & 1) * 32 + (swz % 64) / 2; }
__host__ __device__ __forceinline__ int perm32(int rho) { const int n = rho >> 4, i = rho & 15; return 8 * (i >> 2) + 4 * n + (i & 3); }

struct Unit { int pm, pn, kt0, nkt; };
struct Gemm { const bf16_t* A; const bf16_t* Bt; int M, N, K; };
struct StaticOrder {
    int nM, nN, nwg, G, c;
    __host__ __device__ void init(int M, int N, int G_, int c_) { nM = M / BM; nN = N / BM; nwg = nM * nN; G = G_; c = c_; }
    __host__ __device__ bool next(int i, Unit& u) const {
        const long L = (long)i * G + c; if (L >= nwg) return false;
        int wgid = (int)L; { const int q = nwg / NXCD, r = nwg % NXCD, xcd = wgid % NXCD, off = wgid / NXCD; wgid = (xcd < r ? xcd * (q + 1) : r * (q + 1) + (xcd - r) * q) + off; }
        const int nig = WGM * nN, gid = wgid / nig, fm = gid * WGM, gsz = (nM - fm) < WGM ? (nM - fm) : WGM;
        u.pm = fm + ((wgid % nig) % gsz); u.pn = (wgid % nig) / gsz; u.kt0 = 0; u.nkt = 0; return true;
    }
    __device__ __forceinline__ void a_ready(const Unit&) const {}
    __device__ __forceinline__ void done(const Unit&) const {}
};
__device__ __forceinline__ unsigned cvt_pk_bf16(float lo, float hi) { unsigned r; asm volatile("v_cvt_pk_bf16_f32 %0, %1, %2" : "=v"(r) : "v"(lo), "v"(hi)); return r; }
template <class Epi, class Sched>
__device__ __forceinline__ void gemm_phase(PG8_LAS unsigned char* lds, const Gemm g, const Sched& S, const Epi& E) {
    const int tid = otid(), wid = __builtin_amdgcn_readfirstlane(tid >> 6), lane = tid & 63, wr = wid >> 2, wc = wid & 3, fr = lane & 15, fq = lane >> 4;
    const int K = g.K, nt = K / BK;
#define PG8_STAMP() do {} while (0)
    unsigned voffA[2], voffB[2];
#pragma unroll
    for (int i = 0; i < 2; ++i) { int R, C; stage_rc(tid * 16 + i * 8192, R, C); const int Rb = Epi::PERM ? ((R & ~31) + perm32(R & 31)) : R;
        voffA[i] = (unsigned)(R * K + C) * 2u; voffB[i] = (unsigned)(Rb * K + C) * 2u; }
    const size_t kstep = (size_t)(BK * 2);
    const size_t hstep = (size_t)HALF * K * 2;
    const size_t tstep = 2 * hstep;
    const unsigned ldsw = (unsigned)wid * 1024u;
    const int aoff = lds_byte(wr * 64 + fr, fq * 8), boff = lds_byte(wc * 32 + fr, fq * 8);
#define PG8_SA(b, h) (((b) * 2 + (h)) * HTB)
#define PG8_SB(b, h) ((4 + (b) * 2 + (h)) * HTB)
#define PG8_STAGE(bufoff, gbase, voff) do { _Pragma("unroll") for (int _i = 0; _i < 2; ++_i) \
        __builtin_amdgcn_global_load_lds((const unsigned*)((const char*)(gbase) + (voff)[_i]), (PG8_LAS unsigned*)(lds + (bufoff) + ldsw + _i * 8192), 16, 0, 0); } while (0)
#define PG8_LDA(dst, b, h) do { _Pragma("unroll") for (int m = 0; m < 4; ++m) _Pragma("unroll") for (int k = 0; k < 2; ++k) dst[m][k] = *(const PG8_LAS bf16x8*)(lds + PG8_SA(b, h) + aoff + m * 2048 + k * 1024); } while (0)
#define PG8_LDB(dst, b, h) do { _Pragma("unroll") for (int n = 0; n < 2; ++n) _Pragma("unroll") for (int k = 0; k < 2; ++k) dst[n][k] = *(const PG8_LAS bf16x8*)(lds + PG8_SB(b, h) + boff + n * 2048 + k * 1024); } while (0)
#define PG8_MMA(ai, bj, At, Bt) do { __builtin_amdgcn_s_setprio(1); _Pragma("unroll") for (int m = 0; m < 4; ++m) _Pragma("unroll") for (int n = 0; n < 2; ++n) _Pragma("unroll") for (int k = 0; k < 2; ++k) \
        acc[ai][bj][m][n] = __builtin_amdgcn_mfma_f32_16x16x32_bf16(Bt[n][k], At[m][k], acc[ai][bj][m][n], 0, 0, 0); __builtin_amdgcn_s_setprio(0); } while (0)
#define PG8_WAIT_V(n) asm volatile("s_waitcnt vmcnt(" #n ")" ::: "memory")
#define PG8_WAIT_L(n) asm volatile("s_waitcnt lgkmcnt(" #n ")" ::: "memory")
#define PG8_BAR __builtin_amdgcn_s_barrier()
#define PG8_SCHED __builtin_amdgcn_sched_barrier(0)
    Unit cur, nxt; int ui = 0;
    if (!S.next(0, cur)) return;
    f32x4 acc[2][2][4][2];
#pragma unroll
    for (int a = 0; a < 2; ++a)
#pragma unroll
        for (int b = 0; b < 2; ++b)
#pragma unroll
            for (int m = 0; m < 4; ++m)
#pragma unroll
                for (int n = 0; n < 2; ++n) acc[a][b][m][n] = (f32x4){0.f, 0.f, 0.f, 0.f};
    bf16x8 At[4][2], B0[2][2], B1[2][2];
    const char* cA = (const char*)g.A + (size_t)cur.pm * tstep + (size_t)cur.kt0 * kstep; const char* cB = (const char*)g.Bt + (size_t)cur.pn * tstep + (size_t)cur.kt0 * kstep;
    int ntc = cur.nkt > 0 ? cur.nkt : nt;
    S.a_ready(cur);
    PG8_STAGE(PG8_SB(0, 0), cB, voffB); PG8_STAGE(PG8_SA(0, 0), cA, voffA); PG8_STAGE(PG8_SB(0, 1), cB + hstep, voffB); PG8_STAGE(PG8_SA(0, 1), cA + hstep, voffA);
    if (wr == 1) PG8_BAR;
    PG8_WAIT_V(4); PG8_BAR;
    PG8_STAGE(PG8_SB(1, 0), cB + kstep, voffB); PG8_STAGE(PG8_SA(1, 0), cA + kstep, voffA); PG8_STAGE(PG8_SB(1, 1), cB + hstep + kstep, voffB);
    PG8_WAIT_V(6); PG8_BAR;
    PG8_STAMP();
    for (;;) {
        const bool has_next = S.next(ui + 1, nxt);
        const char* nA = has_next ? (const char*)g.A + (size_t)nxt.pm * tstep + (size_t)nxt.kt0 * kstep : cA; const char* nB = has_next ? (const char*)g.Bt + (size_t)nxt.pn * tstep + (size_t)nxt.kt0 * kstep : cB;
        for (int t = 0; t < ntc; t += 2) {
            const bool last = (t == ntc - 2);
            const char* a1 = cA + (size_t)(t + 1) * kstep;
            const char* a2 = last ? nA : cA + (size_t)(t + 2) * kstep; const char* b2 = last ? nB : cB + (size_t)(t + 2) * kstep;
            const char* a3 = a2 + kstep; const char* b3 = b2 + kstep;
            if (last && has_next) S.a_ready(nxt);
            PG8_LDB(B0, 0, 0); PG8_SCHED; PG8_LDA(At, 0, 0); PG8_STAGE(PG8_SA(1, 1), a1 + hstep, voffA);
            PG8_WAIT_L(8); PG8_BAR; PG8_WAIT_L(0); PG8_MMA(0, 0, At, B0); PG8_BAR; PG8_SCHED;
            PG8_LDB(B1, 0, 1); PG8_STAGE(PG8_SB(0, 0), b2, voffB);
            PG8_BAR; PG8_WAIT_L(0); PG8_MMA(0, 1, At, B1); PG8_BAR;
            PG8_LDA(At, 0, 1); PG8_STAGE(PG8_SA(0, 0), a2, voffA);
            PG8_BAR; PG8_WAIT_L(0); PG8_MMA(1, 0, At, B0); PG8_BAR; PG8_SCHED;
            PG8_STAGE(PG8_SB(0, 1), b2 + hstep, voffB);
            PG8_WAIT_V(6); PG8_BAR; PG8_MMA(1, 1, At, B1); PG8_BAR;
            PG8_LDB(B0, 1, 0); PG8_SCHED; PG8_LDA(At, 1, 0); PG8_STAGE(PG8_SA(0, 1), a2 + hstep, voffA);
            PG8_WAIT_L(8); PG8_BAR; PG8_WAIT_L(0); PG8_MMA(0, 0, At, B0); PG8_BAR; PG8_SCHED;
            PG8_LDB(B1, 1, 1); PG8_STAGE(PG8_SB(1, 0), b3, voffB);
            PG8_BAR; PG8_WAIT_L(0); PG8_MMA(0, 1, At, B1); PG8_BAR;
            PG8_LDA(At, 1, 1); PG8_STAGE(PG8_SA(1, 0), a3, voffA);
            PG8_BAR; PG8_WAIT_L(0); PG8_MMA(1, 0, At, B0); PG8_BAR; PG8_SCHED;
            PG8_STAGE(PG8_SB(1, 1), b3 + hstep, voffB);
            PG8_WAIT_V(6); PG8_BAR; PG8_MMA(1, 1, At, B1); PG8_BAR;
        }
        PG8_STAMP();
        if constexpr (!Epi::AFTER_DRAIN) { E(acc, cur, wr, wc, fr, fq); S.done(cur); }
        PG8_STAMP();
        if (!has_next) break;
#pragma unroll
        for (int a = 0; a < 2; ++a)
#pragma unroll
            for (int b = 0; b < 2; ++b)
#pragma unroll
                for (int m = 0; m < 4; ++m)
#pragma unroll
                    for (int n = 0; n < 2; ++n) acc[a][b][m][n] = (f32x4){0.f, 0.f, 0.f, 0.f};
        cur = nxt; cA = nA; cB = nB; ++ui; ntc = cur.nkt > 0 ? cur.nkt : nt;
    }
    PG8_WAIT_V(0);
    if (wr == 0) PG8_BAR;
    PG8_BAR;
    if constexpr (Epi::AFTER_DRAIN) { E.fused(acc, cur, wr, wc, fr, fq, lds, wid, lane); S.done(cur); }
    PG8_STAMP();
#undef PG8_STAMP
#undef PG8_SA
#undef PG8_SB
#undef PG8_STAGE
#undef PG8_LDA
#undef PG8_LDB
#undef PG8_MMA
#undef PG8_WAIT_V
#undef PG8_WAIT_L
#undef PG8_BAR
#undef PG8_SCHED
}
}
#define LAS __attribute__((address_space(3)))
#define XB_TMO      128
#define XB_XCNT(j)  (256  + 64 * (j))
#define XB_XSUB(j)  (1280 + 64 * (j))
#define XB_XGEN(j)  (2304 + 64 * (j))
#define XB_TOP      3328
#define XB_TOPGEN   3392
#define XCD_BAR_WORDS 3456
#define XB_SPIN_CAP (1u << 18)

__device__ __forceinline__ unsigned xb_ld(unsigned* p)              { return __hip_atomic_load(p, __ATOMIC_RELAXED, __HIP_MEMORY_SCOPE_AGENT); }
__device__ __forceinline__ unsigned xb_add(unsigned* p, unsigned v) { return __hip_atomic_fetch_add(p, v, __ATOMIC_RELAXED, __HIP_MEMORY_SCOPE_AGENT); }
__device__ __forceinline__ unsigned xb_xcc_id() { return (unsigned)__builtin_amdgcn_s_getreg((3 << 11) | 20) & 0xFu; }
#define XB_SPIN(cond, bar) do { unsigned _sp = 0; while (cond) { __builtin_amdgcn_s_sleep(1); \
    if ((++_sp & 255u) == 0u) { if (xb_ld(&(bar)[XB_TMO])) break; if (_sp > XB_SPIN_CAP) { atomicAdd(&(bar)[XB_TMO], 1u); break; } } } } while (0)

struct XcdBarrier {
    unsigned* bar; unsigned x;
    volatile LAS unsigned* st;
};

__device__ __forceinline__ XcdBarrier xcd_barrier_post(unsigned* bar, volatile LAS unsigned* st) {
    XcdBarrier b; b.bar = bar; b.x = xb_xcc_id(); b.st = st;
    if (threadIdx.x == 0) (void)xb_add(&bar[XB_XCNT(b.x)], 1u);
    return b;
}
__device__ __forceinline__ void xcd_barrier_complete(unsigned* bar, unsigned x, unsigned& nloc, unsigned& nx) {
    const unsigned G = gridDim.x * gridDim.y * gridDim.z;
    unsigned sum, cnt, mine, sp = 0u;
    for (;;) {
        sum = 0u; cnt = 0u; mine = 0u;
#pragma unroll
        for (unsigned j = 0; j < 16; ++j) { const unsigned c = xb_ld(&bar[XB_XCNT(j)]); sum += c; cnt += (c > 0u) ? 1u : 0u; mine = (j == x) ? c : mine; }
        if (sum == G) break;
        __builtin_amdgcn_s_sleep(1);
        if ((++sp & 255u) == 0u) { if (xb_ld(&bar[XB_TMO])) break; if (sp > XB_SPIN_CAP) { atomicAdd(&bar[XB_TMO], 1u); break; } }
    }
    nloc = mine > 0u ? mine : 1u; nx = cnt > 0u ? cnt : 1u;
}

__device__ __forceinline__ void xcd_barrier(const XcdBarrier& b) {
    asm volatile("s_waitcnt vmcnt(0)" ::: "memory");
    __syncthreads();
    if (threadIdx.x == 0) {
        unsigned* bar = b.bar;
        __builtin_amdgcn_s_waitcnt(0);
        unsigned nloc = b.st[0], nx = b.st[1];
        if (nloc == 0u) { xcd_barrier_complete(bar, b.x, nloc, nx); b.st[0] = nloc; b.st[1] = nx; }
        const unsigned old = xb_add(&bar[XB_XSUB(b.x)], 1u);
        const unsigned gen = old / nloc;
        if (old + 1u == (gen + 1u) * nloc) {
            __builtin_amdgcn_fence(__ATOMIC_RELEASE, "agent");
            asm volatile("s_waitcnt vmcnt(0)" ::: "memory");
            const unsigned og = xb_add(&bar[XB_TOP], 1u);
            const unsigned tg = og / nx;
            if (og + 1u == (tg + 1u) * nx) xb_add(&bar[XB_TOPGEN], 1u);
            else XB_SPIN(xb_ld(&bar[XB_TOPGEN]) == tg, bar);
            __builtin_amdgcn_fence(__ATOMIC_ACQUIRE, "agent");
            xb_add(&bar[XB_XGEN(b.x)], 1u);
            asm volatile("s_waitcnt vmcnt(0)" ::: "memory");
        } else {
            XB_SPIN(xb_ld(&bar[XB_XGEN(b.x)]) == gen, bar);
            __builtin_amdgcn_fence(__ATOMIC_ACQUIRE, "agent");
            asm volatile("s_waitcnt vmcnt(0)" ::: "memory");
        }
    }
    __syncthreads();
}

using pg8::bf16_t; using pg8::f32x4; using pg8::u32x4; using pg8::cvt_pk_bf16;
typedef unsigned u32x2 __attribute__((ext_vector_type(2)));


constexpr int D = 1024, NB = 2, SEQ = 8192, DEPTH = 4, CTX = 256, DFF = 2816;
constexpr int TL = NB * SEQ, TC = NB * CTX, T = TL + TC;
constexpr int NMOD = 9 * D;
constexpr int HYC = 256, RWW = 384, NAW = 384, INW = 3456, INWP = 3584;
constexpr int HY_IN = 768, RW_IN = 1536, NA_IN = 1152;
constexpr int NFFT = 16384;
constexpr int NTHR = 512, NWAVE = 8;
constexpr int LDS_MAIN = 131072, LDS_EXTRA = 8192, LDS_BYTES = LDS_MAIN + LDS_EXTRA;
constexpr float NORM_EPS = 1e-6f;

constexpr size_t al256(size_t x) { return (x + 255) & ~(size_t)255; }
constexpr size_t WS_MODV = 0;
constexpr size_t WS_WGU1 = al256(WS_MODV + (size_t)DEPTH * 3 * NMOD * 4);
constexpr size_t WS_WDN1 = WS_WGU1 + (size_t)2 * DFF * D * 2;
constexpr size_t WS_WGU2 = WS_WDN1 + (size_t)D * DFF * 2;
constexpr size_t WS_WDN2 = WS_WGU2 + (size_t)2 * DFF * D * 2;
constexpr size_t WS_WIN = WS_WDN2 + (size_t)D * DFF * 2;
constexpr size_t WS_WOUT = WS_WIN + (size_t)INWP * D * 2;
constexpr size_t WS_WLORA = WS_WOUT + (size_t)D * D * 2;
constexpr size_t WS_H = WS_WLORA + (size_t)2048 * 384 * 2;
constexpr size_t WS_U = WS_H + (size_t)T * D * 4;
constexpr size_t WS_S = WS_U + (size_t)T * D * 2;
constexpr size_t WS_Y = WS_S;
constexpr size_t WS_ACT = WS_Y + (size_t)T * D * 4;
constexpr size_t WS_FFN_END = WS_ACT + (size_t)T * DFF * 2;
constexpr size_t WS_PHY = WS_S;
constexpr size_t WS_PRW = WS_PHY + (size_t)T * HY_IN * 2;
constexpr size_t WS_YDIR = WS_PRW;
constexpr size_t WS_PNA = WS_PRW + (size_t)T * RW_IN * 2;
constexpr size_t WS_ALORA = WS_PNA + (size_t)T * NA_IN * 2;
constexpr size_t WS_DECAY = WS_ALORA + (size_t)T * 384 * 2;
constexpr size_t WS_LORAO = WS_DECAY + (size_t)2 * T * 384 * 4;
constexpr size_t WS_E = WS_LORAO;
constexpr size_t WS_ZP = WS_E + (size_t)24 * SEQ * 64 * 2;
constexpr size_t WS_GATE = WS_LORAO + (size_t)T * 1536 * 2;
static_assert(WS_ZP + (size_t)24 * 33 * 2 * 4096 * 4 <= WS_GATE, "E + ZP must fit in the LORAO region");
constexpr size_t WS_RS = WS_GATE + (size_t)T * 384 * 2;
constexpr size_t WS_KKS = WS_RS + (size_t)T * 384 * 2;
constexpr size_t WS_VS = WS_KKS + (size_t)T * 384 * 2;
constexpr size_t WS_KS = WS_VS + (size_t)T * 384 * 2;
constexpr size_t WS_BS = WS_KS + (size_t)2 * T * 384 * 2;
constexpr size_t WS_BONUS = WS_BS + (size_t)2 * T * 384 * 2;
constexpr size_t WS_FILT = al256(WS_BONUS + (size_t)T * 6 * 4);
constexpr size_t WS_FILTC = WS_FILT + (size_t)1024 * SEQ * 2;
constexpr size_t WS_SPEC = WS_FILTC + (size_t)1024 * CTX * 2;
constexpr size_t WS_Z1 = WS_SPEC + (size_t)512 * NFFT * 8;
constexpr size_t WS_VTL = WS_Z1 + (size_t)HYC * NB * SEQ * 4;
constexpr size_t WS_VTC = WS_VTL + (size_t)NB * 6 * 64 * SEQ * 2;
constexpr size_t WS_MIX_END = WS_VTC + (size_t)NB * 6 * 64 * CTX * 2;
constexpr size_t WS_BAR = al256(WS_MIX_END > WS_FFN_END ? WS_MIX_END : WS_FFN_END);
constexpr size_t WS_ROPE = al256(WS_BAR + (size_t)XCD_BAR_WORDS * 4);
constexpr size_t WS_YC = WS_FFN_END + (size_t)(8 << 20);
static_assert(WS_YC + (size_t)11 * TC * D * 4 <= WS_FILT, "YC partials must stay below the filter tables");
constexpr size_t WS_END = WS_ROPE + (size_t)128 * 16 * 8;
static_assert(WS_END <= (size_t)4 * DEPTH * D * NMOD * 4, "workspace map exceeds 4x the largest input tensor");

struct Params { const float* in[34]; float* out; unsigned char* ws; };
enum { I_X = 0, I_C, I_CTX, I_CCTX, I_MODW, I_MODB, I_NORMG, I_F1GU, I_F1DN, I_F2GU, I_F2DN, I_WIN, I_WOUT, I_HCW, I_HCB, I_HW1, I_HB1, I_HW2, I_HB2, I_HW3, I_HFREQ, I_HBIAS,
       I_MU, I_W0, I_W2, I_A0, I_A2, I_G2, I_KK, I_KA, I_RK, I_LNW, I_LNB, I_RPB };

typedef LAS float* ldsfp;
__device__ __forceinline__ ldsfp vlds(const void* p) { ldsfp q = (ldsfp)p; asm volatile("" : "+v"(q)); return q; }
__device__ __forceinline__ float bf2f(bf16_t b) { return __uint_as_float(((unsigned)b) << 16); }
__device__ __forceinline__ bf16_t f2bf(float f) { unsigned u = __float_as_uint(f); u += 0x7FFFu + ((u >> 16) & 1u); return (bf16_t)(u >> 16); }
__device__ __forceinline__ float lo_bf(unsigned w) { return __uint_as_float(w << 16); }
__device__ __forceinline__ float hi_bf(unsigned w) { return __uint_as_float(w & 0xffff0000u); }
__device__ __forceinline__ float wsum(float v) {
#pragma unroll
    for (int o = 32; o > 0; o >>= 1) v += __shfl_xor(v, o);
    return v;
}
__device__ __forceinline__ float sigmoidf_(float x) { return __builtin_amdgcn_rcpf(1.0f + __expf(-x)); }
__device__ __forceinline__ void unpack8(const u32x4 w, float (&f)[8]) {
    f[0] = lo_bf(w.x); f[1] = hi_bf(w.x); f[2] = lo_bf(w.y); f[3] = hi_bf(w.y); f[4] = lo_bf(w.z); f[5] = hi_bf(w.z); f[6] = lo_bf(w.w); f[7] = hi_bf(w.w);
}
__device__ __forceinline__ void row_nbrs(int row, bool& hasp, bool& hasn) {
    if (row < TL) { const int t = row & (SEQ - 1); hasp = t > 0; hasn = t < SEQ - 1; }
    else { const int t = (row - TL) & (CTX - 1); hasp = t > 0; hasn = t < CTX - 1; }
}

__device__ __forceinline__ void ph_modv(const Params& P, float* lds) {
    const int tid = otid();
    float* sv = lds;
    float* red = lds + 3072;
    for (int i = tid; i < 3072; i += NTHR) { const int s = i >> 10, k = i & 1023; const float c = s < 2 ? P.in[I_C][s * 1024 + k] : P.in[I_CCTX][k]; sv[i] = c / (1.0f + expf(-c)); }
    __syncthreads();
    if (blockIdx.x < 4) { const int e = blockIdx.x * NTHR + tid, pos = e >> 4, f = e & 15; float sn, cs; sincosf((float)pos * expf(-(float)f * (9.210340371976184f / 16.0f)), &sn, &cs); ((float2*)(P.ws + WS_ROPE))[e] = make_float2(cs, sn); }
    float* modv = (float*)(P.ws + WS_MODV);
    const int kc = tid >> 6, cl = tid & 63;
    for (int item = blockIdx.x; item < DEPTH * 144; item += gridDim.x) {
        const int l = item / 144, cb = item % 144, col = cb * 64 + cl;
        const float* w = P.in[I_MODW] + ((size_t)l * 1024 + kc * 128) * NMOD + col;
        float a0 = 0.f, a1 = 0.f, a2 = 0.f;
#pragma unroll 8
        for (int k = 0; k < 128; ++k) { const float wv = w[(size_t)k * NMOD]; a0 += sv[kc * 128 + k] * wv; a1 += sv[1024 + kc * 128 + k] * wv; a2 += sv[2048 + kc * 128 + k] * wv; }
        red[(0 * 8 + kc) * 64 + cl] = a0; red[(1 * 8 + kc) * 64 + cl] = a1; red[(2 * 8 + kc) * 64 + cl] = a2;
        __syncthreads();
        if (tid < 192) { const int s = tid >> 6, c = tid & 63; float r = P.in[I_MODB][l * NMOD + cb * 64 + c];
#pragma unroll
            for (int q = 0; q < 8; ++q) r += red[(s * 8 + q) * 64 + c];
            modv[((size_t)l * 3 + s) * NMOD + cb * 64 + c] = r; }
        __syncthreads();
    }
}

__device__ __forceinline__ float hy_delta(int c);
__device__ __forceinline__ int rowmap_gu(int n) { const int up = n >= DFF ? 1 : 0; const int j = n - up * DFF; return (j >> 7) * 256 + up * 128 + (j & 127); }
__device__ __forceinline__ void conv_tile(const float* __restrict__ src, int K, int N, bf16_t* __restrict__ dst, int tk, int tn, bool gu, float* tile) {
    const int tid = otid(); const int k0 = tk * 64, n0 = tn * 64;
#pragma unroll
    for (int rr = 0; rr < 2; ++rr) { const int kk = (tid >> 4) + rr * 32, n4 = (tid & 15) * 4; const float4 v = *(const float4*)(src + (size_t)(k0 + kk) * N + n0 + n4);
        tile[kk * 65 + n4 + 0] = v.x; tile[kk * 65 + n4 + 1] = v.y; tile[kk * 65 + n4 + 2] = v.z; tile[kk * 65 + n4 + 3] = v.w; }
    __syncthreads();
    { const int nn = tid >> 3, ks = (tid & 7) * 8; const int n = n0 + nn; const int row = gu ? rowmap_gu(n) : n;
      u32x4 w; w.x = cvt_pk_bf16(tile[(ks + 0) * 65 + nn], tile[(ks + 1) * 65 + nn]); w.y = cvt_pk_bf16(tile[(ks + 2) * 65 + nn], tile[(ks + 3) * 65 + nn]);
      w.z = cvt_pk_bf16(tile[(ks + 4) * 65 + nn], tile[(ks + 5) * 65 + nn]); w.w = cvt_pk_bf16(tile[(ks + 6) * 65 + nn], tile[(ks + 7) * 65 + nn]);
      *(u32x4*)(dst + (size_t)row * K + k0 + ks) = w; }
    __syncthreads();
}
__device__ __forceinline__ void ph_prep(const Params& P, int l, float* lds) {
    const int tid = otid();
    unsigned char* ws = P.ws;
    constexpr int N0 = 16 * 88, N1 = 44 * 16, N4 = 16 * 54, N5 = 16 * 16;
    constexpr int C0 = N0, C1 = C0 + N1, C2 = C1 + N0, C3 = C2 + N1, C4 = C3 + N4, C5 = C4 + N5;
    for (int it = blockIdx.x; it < C5; it += gridDim.x) {
        if (it < C0) { conv_tile(P.in[I_F1GU] + (size_t)l * D * 2 * DFF, D, 2 * DFF, (bf16_t*)(ws + WS_WGU1), it / 88, it % 88, true, lds); }
        else if (it < C1) { const int j = it - C0; conv_tile(P.in[I_F1DN] + (size_t)l * DFF * D, DFF, D, (bf16_t*)(ws + WS_WDN1), j / 16, j % 16, false, lds); }
        else if (it < C2) { const int j = it - C1; conv_tile(P.in[I_F2GU] + (size_t)l * D * 2 * DFF, D, 2 * DFF, (bf16_t*)(ws + WS_WGU2), j / 88, j % 88, true, lds); }
        else if (it < C3) { const int j = it - C2; conv_tile(P.in[I_F2DN] + (size_t)l * DFF * D, DFF, D, (bf16_t*)(ws + WS_WDN2), j / 16, j % 16, false, lds); }
        else if (it < C4) { const int j = it - C3; conv_tile(P.in[I_WIN] + (size_t)l * D * INW, D, INW, (bf16_t*)(ws + WS_WIN), j / 54, j % 54, false, lds); }
        else { const int j = it - C4; conv_tile(P.in[I_WOUT] + (size_t)l * D * D, D, D, (bf16_t*)(ws + WS_WOUT), j / 16, j % 16, false, lds); }
    }
    const int gtid = blockIdx.x * NTHR + tid, gn = gridDim.x * NTHR;
    { unsigned* z = (unsigned*)(ws + WS_WIN + (size_t)INW * D * 2); for (int i = gtid; i < (INWP - INW) * D / 2; i += gn) z[i] = 0u; }
    { bf16_t* wl = (bf16_t*)(ws + WS_WLORA);
      const float* w2 = P.in[I_W2] + (size_t)l * 2 * 64 * RWW; const float* a2 = P.in[I_A2] + (size_t)l * 2 * 64 * RWW; const float* g2 = P.in[I_G2] + (size_t)l * 128 * RWW;
      for (int i = gtid; i < 2048 * 384; i += gn) { const int k = i / 2048, j = i % 2048; float v = 0.f;
          if (j < 1920) { const int grp = j / 384, c = j % 384;
              if (grp == 0) { if (k < 64) v = w2[(size_t)k * RWW + c]; }
              else if (grp == 1) { if (k >= 64 && k < 128) v = w2[(size_t)(64 + k - 64) * RWW + c]; }
              else if (grp == 2) { if (k >= 128 && k < 192) v = a2[(size_t)(k - 128) * RWW + c]; }
              else if (grp == 3) { if (k >= 192 && k < 256) v = a2[(size_t)(64 + k - 192) * RWW + c]; }
              else { if (k >= 256) v = g2[(size_t)(k - 256) * RWW + c]; } }
          wl[(size_t)j * 384 + k] = f2bf(v); } }
    { const float* w1_ = P.in[I_HW1] + (size_t)l * 33 * 64; const float* b1 = P.in[I_HB1] + l * 64; const float* w2f_ = P.in[I_HW2] + (size_t)l * 64 * 64; const float* b2 = P.in[I_HB2] + l * 64;
      const float* fqv = P.in[I_HFREQ] + l * 64; const float* w3 = P.in[I_HW3] + (size_t)l * 64 * 1024;
      const int lane = tid & 63, wv = tid >> 6;
      const float fq = fqv[lane], bb1 = b1[lane], bb2 = b2[lane];
      const ldsfp hl = vlds(lds);
      for (int task = blockIdx.x; task < 264; task += gridDim.x) {
          const int L = task < 256 ? SEQ : CTX, n0 = task < 256 ? task * 32 : (task - 256) * 32;
          __syncthreads();
#pragma unroll 1
          for (int pp = 0; pp < 4; ++pp) { const int p = wv * 4 + pp, pos = n0 + p;
              const float* w1 = w1_; const float* w2f = w2f_; asm volatile("" : "+s"(w1), "+s"(w2f));
              const float tt = (float)pos / (float)(L - 1);
              const float ang = 6.283185307179586f * (float)pos / (float)L;
              float z = 0.f;
              if (lane == 0) z = tt;
              else if (lane <= 16) { const float fr = 1e-4f + (float)(lane - 1) * ((15.0f - 1e-4f) / 15.0f); z = cosf(fr * ang); }
              else if (lane <= 32) { const float fr = 1e-4f + (float)(lane - 17) * ((15.0f - 1e-4f) / 15.0f); z = -sinf(fr * ang); }
              float a = bb1;
#pragma unroll
              for (int e = 0; e < 33; ++e) a += __shfl(z, e) * w1[e * 64 + lane];
              const float h1 = sinf(fq * a);
              float c = bb2;
#pragma unroll
              for (int i = 0; i < 64; ++i) c += __shfl(h1, i) * w2f[i * 64 + lane];
              hl[lane * 32 + p] = sinf(fq * c); }
          __syncthreads();
          float acc0[32], acc1[32];
#pragma unroll
          for (int p = 0; p < 32; ++p) { acc0[p] = 0.f; acc1[p] = 0.f; }
#pragma unroll 2
          for (int i = 0; i < 64; ++i) { const float wa = w3[(size_t)i * 1024 + tid], wb = w3[(size_t)i * 1024 + 512 + tid];
#pragma unroll
              for (int p4 = 0; p4 < 8; ++p4) { const f32x4 hv = *(const LAS f32x4*)(hl + i * 32 + p4 * 4);
                  acc0[p4 * 4 + 0] += hv.x * wa; acc0[p4 * 4 + 1] += hv.y * wa; acc0[p4 * 4 + 2] += hv.z * wa; acc0[p4 * 4 + 3] += hv.w * wa;
                  acc1[p4 * 4 + 0] += hv.x * wb; acc1[p4 * 4 + 1] += hv.y * wb; acc1[p4 * 4 + 2] += hv.z * wb; acc1[p4 * 4 + 3] += hv.w * wb; } }
          const float dl = hy_delta(tid & 255), sc = task < 256 ? (1.0f / NFFT) : 1.0f, invL = 1.0f / (float)(L - 1);
          bf16_t* dst = task < 256 ? (bf16_t*)(ws + WS_FILT) + (size_t)tid * SEQ + n0 : (bf16_t*)(ws + WS_FILTC) + (size_t)tid * CTX + n0;
          const size_t cstep = task < 256 ? (size_t)512 * SEQ : (size_t)512 * CTX;
#pragma unroll
          for (int p8 = 0; p8 < 4; ++p8) { float d[8];
#pragma unroll
              for (int k = 0; k < 8; ++k) d[k] = __expf(-((float)(n0 + p8 * 8 + k) * invL) * dl) * sc;
              u32x4 w; w.x = cvt_pk_bf16(acc0[p8 * 8 + 0] * d[0], acc0[p8 * 8 + 1] * d[1]); w.y = cvt_pk_bf16(acc0[p8 * 8 + 2] * d[2], acc0[p8 * 8 + 3] * d[3]);
              w.z = cvt_pk_bf16(acc0[p8 * 8 + 4] * d[4], acc0[p8 * 8 + 5] * d[5]); w.w = cvt_pk_bf16(acc0[p8 * 8 + 6] * d[6], acc0[p8 * 8 + 7] * d[7]);
              *(u32x4*)(dst + p8 * 8) = w;
              w.x = cvt_pk_bf16(acc1[p8 * 8 + 0] * d[0], acc1[p8 * 8 + 1] * d[1]); w.y = cvt_pk_bf16(acc1[p8 * 8 + 2] * d[2], acc1[p8 * 8 + 3] * d[3]);
              w.z = cvt_pk_bf16(acc1[p8 * 8 + 4] * d[4], acc1[p8 * 8 + 5] * d[5]); w.w = cvt_pk_bf16(acc1[p8 * 8 + 6] * d[6], acc1[p8 * 8 + 7] * d[7]);
              *(u32x4*)(dst + cstep + p8 * 8) = w; }
      }
      __syncthreads(); }
}

__device__ __forceinline__ void ph_rowpass(const Params& P, int mode, int lpost, int gate_i, int gpost_i, float ps, int lpre, int gpre_i, int shift_i, int scale_i, int nsplit) {
    const int tid = otid(), lane = tid & 63, gw = blockIdx.x * NWAVE + (tid >> 6), nw = gridDim.x * NWAVE;
    const float* modv = (const float*)(P.ws + WS_MODV);
    float* H = (float*)(P.ws + WS_H); const bf16_t* Y = (const bf16_t*)(P.ws + WS_Y); bf16_t* U = (bf16_t*)(P.ws + WS_U);
    int cur_s = -1;
    float4 A[4], Bv[4], Cv[4];
#pragma unroll
    for (int j = 0; j < 4; ++j) { A[j] = make_float4(0.f, 0.f, 0.f, 0.f); Bv[j] = A[j]; Cv[j] = A[j]; }
    for (int row = gw; row < T; row += nw) {
        const int s = row < SEQ ? 0 : (row < TL ? 1 : 2);
        if (s != cur_s) { cur_s = s;
#pragma unroll
            for (int j = 0; j < 4; ++j) { const int e = lane * 4 + 256 * j;
                if (mode != 0) { const float4 g = *(const float4*)(modv + ((size_t)lpost * 3 + s) * NMOD + gate_i * D + e); const float4 gp = *(const float4*)(P.in[I_NORMG] + ((size_t)lpost * 6 + gpost_i) * D + e);
                    A[j] = make_float4(ps * g.x * gp.x, ps * g.y * gp.y, ps * g.z * gp.z, ps * g.w * gp.w); }
                if (mode != 2) { const float4 sc = *(const float4*)(modv + ((size_t)lpre * 3 + s) * NMOD + scale_i * D + e); const float4 gq = *(const float4*)(P.in[I_NORMG] + ((size_t)lpre * 6 + gpre_i) * D + e);
                    Bv[j] = make_float4(gq.x * (1.f + sc.x), gq.y * (1.f + sc.y), gq.z * (1.f + sc.z), gq.w * (1.f + sc.w));
                    Cv[j] = *(const float4*)(modv + ((size_t)lpre * 3 + s) * NMOD + shift_i * D + e); } } }
        float4 h[4];
        if (mode == 0) { const float* src = row < TL ? P.in[I_X] + (size_t)row * D : P.in[I_CTX] + (size_t)(row - TL) * D;
#pragma unroll
            for (int j = 0; j < 4; ++j) h[j] = *(const float4*)(src + lane * 4 + 256 * j);
        } else {
            float4 y[4]; float ss = 0.f;
#pragma unroll
            for (int j = 0; j < 4; ++j) { h[j] = *(const float4*)(H + (size_t)row * D + lane * 4 + 256 * j); if (row < TL) { const u32x2 yw = *(const u32x2*)(Y + (size_t)row * D + lane * 4 + 256 * j); y[j] = make_float4(lo_bf(yw.x), hi_bf(yw.x), lo_bf(yw.y), hi_bf(yw.y)); } else { const float* yp = (const float*)(P.ws + WS_YC) + (size_t)(row - TL) * D + lane * 4 + 256 * j; float4 a = *(const float4*)yp;
                    for (int q = 1; q < nsplit; ++q) { const float4 b4 = *(const float4*)(yp + (size_t)q * TC * D); a.x += b4.x; a.y += b4.y; a.z += b4.z; a.w += b4.w; } y[j] = a; }
                ss += y[j].x * y[j].x + y[j].y * y[j].y + y[j].z * y[j].z + y[j].w * y[j].w; }
            ss = wsum(ss); const float r = rsqrtf(ss * (1.0f / D) + NORM_EPS);
#pragma unroll
            for (int j = 0; j < 4; ++j) { h[j].x += A[j].x * (y[j].x * r); h[j].y += A[j].y * (y[j].y * r); h[j].z += A[j].z * (y[j].z * r); h[j].w += A[j].w * (y[j].w * r); }
        }
        if (mode == 2) { if (row < TL) {
#pragma unroll
                for (int j = 0; j < 4; ++j) *(float4*)(P.out + (size_t)row * D + lane * 4 + 256 * j) = h[j]; }
            continue; }
        float s2 = 0.f;
#pragma unroll
        for (int j = 0; j < 4; ++j) { *(float4*)(H + (size_t)row * D + lane * 4 + 256 * j) = h[j]; s2 += h[j].x * h[j].x + h[j].y * h[j].y + h[j].z * h[j].z + h[j].w * h[j].w; }
        s2 = wsum(s2); const float r2 = rsqrtf(s2 * (1.0f / D) + NORM_EPS);
#pragma unroll
        for (int j = 0; j < 4; ++j) { u32x2 w; w.x = cvt_pk_bf16(h[j].x * r2 * Bv[j].x + Cv[j].x, h[j].y * r2 * Bv[j].y + Cv[j].y); w.y = cvt_pk_bf16(h[j].z * r2 * Bv[j].z + Cv[j].z, h[j].w * r2 * Bv[j].w + Cv[j].w);
            *(u32x2*)(U + (size_t)row * D + lane * 4 + 256 * j) = w; }
    }
}

struct EpiGU {
    static constexpr bool PERM = true, AFTER_DRAIN = false;
    bf16_t* O;
    __device__ __forceinline__ void operator()(const f32x4 (&acc)[2][2][4][2], const pg8::Unit& u, int wr, int wc, int fr, int fq) const {
        const int row0 = u.pm * 256 + wr * 64 + fr, col0 = u.pn * 128 + wc * 32 + 8 * fq;
#pragma unroll
        for (int ai = 0; ai < 2; ++ai)
#pragma unroll
            for (int m = 0; m < 4; ++m) { float o[8];
#pragma unroll
                for (int n = 0; n < 2; ++n)
#pragma unroll
                    for (int j = 0; j < 4; ++j) { const float g = acc[ai][0][m][n][j], up = acc[ai][1][m][n][j]; o[n * 4 + j] = g * __builtin_amdgcn_rcpf(1.0f + __expf(-g)) * up; }
                u32x4 w; w.x = cvt_pk_bf16(o[0], o[1]); w.y = cvt_pk_bf16(o[2], o[3]); w.z = cvt_pk_bf16(o[4], o[5]); w.w = cvt_pk_bf16(o[6], o[7]);
                *(u32x4*)(O + (size_t)(row0 + ai * 128 + m * 16) * DFF + col0) = w; }
    }
};

struct TailOrder {
    int nsplit, kp, G, c;
    __device__ void init(int K, int KP, int G_, int c_) { kp = KP; nsplit = (K / 64) / KP; G = G_; c = c_; }
    __device__ bool next(int i, pg8::Unit& u) const {
        const long L = (long)i * G + c;
        if (L < 256) { int wgid = (int)L; { const int q = 256 / 8, xcd = wgid % 8, off = wgid / 8; wgid = xcd * q + off; }
            const int nig = 8 * 4, gid = wgid / nig, fm = gid * 8; u.pm = fm + ((wgid % nig) % 8); u.pn = (wgid % nig) / 8; u.kt0 = 0; u.nkt = 0; return true; }
        const int L2 = (int)(L - 256); if (L2 >= 8 * nsplit) return false;
        const int tile = L2 / nsplit, ks = L2 % nsplit; u.pm = 64 + (tile >> 2); u.pn = tile & 3; u.kt0 = ks * kp; u.nkt = kp; return true;
    }
    __device__ __forceinline__ void a_ready(const pg8::Unit&) const {}
    __device__ __forceinline__ void done(const pg8::Unit&) const {}
};
struct EpiF32 {
    static constexpr bool PERM = true, AFTER_DRAIN = false;
    bf16_t* C; float* YC;
    __device__ __forceinline__ void operator()(const f32x4 (&acc)[2][2][4][2], const pg8::Unit& u, int wr, int wc, int fr, int fq) const {
        const int row0 = u.pm * 256 + wr * 64 + fr, col0 = u.pn * 256 + wc * 32 + 8 * fq;
        if (u.pm < 64) {
#pragma unroll
            for (int ai = 0; ai < 2; ++ai)
#pragma unroll
                for (int m = 0; m < 4; ++m) { bf16_t* rowp = C + (size_t)(row0 + ai * 128 + m * 16) * D + col0;
#pragma unroll
                    for (int bj = 0; bj < 2; ++bj) { const f32x4 v0 = acc[ai][bj][m][0], v1 = acc[ai][bj][m][1];
                        u32x4 w; w.x = cvt_pk_bf16(v0[0], v0[1]); w.y = cvt_pk_bf16(v0[2], v0[3]); w.z = cvt_pk_bf16(v1[0], v1[1]); w.w = cvt_pk_bf16(v1[2], v1[3]);
                        *(u32x4*)(rowp + bj * 128) = w; } }
        } else { float* base = YC + (size_t)(u.kt0 >> 2) * TC * D;
#pragma unroll
            for (int ai = 0; ai < 2; ++ai)
#pragma unroll
                for (int m = 0; m < 4; ++m) { float* rowp = base + (size_t)(row0 - TL + ai * 128 + m * 16) * D + col0;
#pragma unroll
                    for (int bj = 0; bj < 2; ++bj)
#pragma unroll
                        for (int n = 0; n < 2; ++n) *(f32x4*)(rowp + bj * 128 + n * 4) = acc[ai][bj][m][n]; }
        }
    }
};
template <class Epi> __device__ __forceinline__ void run_gemm_tail(LAS unsigned char* lds, const bf16_t* A, const bf16_t* Bt, int K, const Epi& E) {
    asm volatile("" : "+s"(K));
    pg8::Gemm g{A, Bt, T, D, K}; TailOrder S; S.init(K, 4, (int)gridDim.x, (int)blockIdx.x);
    pg8::gemm_phase<Epi, TailOrder>(lds, g, S, E);
    __syncthreads();
}
__device__ __forceinline__ void zero_yc(const Params& P) { float4* z = (float4*)(P.ws + WS_YC); for (int i = blockIdx.x * NTHR + otid(); i < TC * D / 4; i += gridDim.x * NTHR) z[i] = make_float4(0.f, 0.f, 0.f, 0.f); }
struct EpiWin {
    static constexpr bool PERM = true, AFTER_DRAIN = false;
    bf16_t* PHYT; bf16_t* PRW; bf16_t* PNA;
    __device__ __forceinline__ void operator()(const f32x4 (&acc)[2][2][4][2], const pg8::Unit& u, int wr, int wc, int fr, int fq) const {
        const int row0 = u.pm * 256 + wr * 64 + fr;
        if (u.pn < 3) {
#pragma unroll
            for (int bj = 0; bj < 2; ++bj) { bf16_t* cp = PHYT + (size_t)(u.pn * 256 + bj * 128 + wc * 32 + 8 * fq) * T + row0;
#pragma unroll
                for (int ai = 0; ai < 2; ++ai)
#pragma unroll
                    for (int m = 0; m < 4; ++m) { const f32x4 v0 = acc[ai][bj][m][0], v1 = acc[ai][bj][m][1]; bf16_t* rp = cp + ai * 128 + m * 16;
                        const unsigned w0 = cvt_pk_bf16(v0[0], v0[1]), w1 = cvt_pk_bf16(v0[2], v0[3]), w2 = cvt_pk_bf16(v1[0], v1[1]), w3 = cvt_pk_bf16(v1[2], v1[3]);
                        rp[0] = (bf16_t)w0; rp[(size_t)T] = (bf16_t)(w0 >> 16); rp[(size_t)2 * T] = (bf16_t)w1; rp[(size_t)3 * T] = (bf16_t)(w1 >> 16);
                        rp[(size_t)4 * T] = (bf16_t)w2; rp[(size_t)5 * T] = (bf16_t)(w2 >> 16); rp[(size_t)6 * T] = (bf16_t)w3; rp[(size_t)7 * T] = (bf16_t)(w3 >> 16); } }
            return; }
        bf16_t* base; int ld, cbase;
        if (u.pn < 9) { base = PRW; ld = RW_IN; cbase = u.pn * 256 - HY_IN; }
        else { base = PNA; ld = NA_IN; cbase = u.pn * 256 - HY_IN - RW_IN; }
        const int nbj = (u.pn == 13) ? 1 : 2;
#pragma unroll
        for (int ai = 0; ai < 2; ++ai)
#pragma unroll
            for (int m = 0; m < 4; ++m)
#pragma unroll
                for (int bj = 0; bj < 2; ++bj) { if (bj < nbj) { const f32x4 v0 = acc[ai][bj][m][0], v1 = acc[ai][bj][m][1];
                    u32x4 w; w.x = cvt_pk_bf16(v0[0], v0[1]); w.y = cvt_pk_bf16(v0[2], v0[3]); w.z = cvt_pk_bf16(v1[0], v1[1]); w.w = cvt_pk_bf16(v1[2], v1[3]);
                    *(u32x4*)(base + (size_t)(row0 + ai * 128 + m * 16) * ld + cbase + bj * 128 + wc * 32 + 8 * fq) = w; } }
    }
};
struct EpiLora {
    static constexpr bool PERM = true, AFTER_DRAIN = false;
    bf16_t* LO; bf16_t* GATE;
    __device__ __forceinline__ void operator()(const f32x4 (&acc)[2][2][4][2], const pg8::Unit& u, int wr, int wc, int fr, int fq) const {
        const int row0 = u.pm * 256 + wr * 64 + fr;
        bf16_t* base; int ld, cbase;
        if (u.pn < 6) { base = LO; ld = 1536; cbase = u.pn * 256; } else { base = GATE; ld = 384; cbase = u.pn * 256 - 1536; }
        const int nbj = (u.pn == 7) ? 1 : 2;
#pragma unroll
        for (int ai = 0; ai < 2; ++ai)
#pragma unroll
            for (int m = 0; m < 4; ++m)
#pragma unroll
                for (int bj = 0; bj < 2; ++bj) { if (bj < nbj) { const f32x4 v0 = acc[ai][bj][m][0], v1 = acc[ai][bj][m][1];
                    u32x4 w; w.x = cvt_pk_bf16(v0[0], v0[1]); w.y = cvt_pk_bf16(v0[2], v0[3]); w.z = cvt_pk_bf16(v1[0], v1[1]); w.w = cvt_pk_bf16(v1[2], v1[3]);
                    *(u32x4*)(base + (size_t)(row0 + ai * 128 + m * 16) * ld + cbase + bj * 128 + wc * 32 + 8 * fq) = w; } }
    }
};
template <class Epi> __device__ __forceinline__ void run_gemm(LAS unsigned char* lds, const bf16_t* A, const bf16_t* Bt, int M, int N, int K, const Epi& E) {
    asm volatile("" : "+s"(K));
    pg8::Gemm g{A, Bt, M, N, K}; pg8::StaticOrder S; S.init(M, N, (int)gridDim.x, (int)blockIdx.x);
    pg8::gemm_phase<Epi, pg8::StaticOrder>(lds, g, S, E);
    __syncthreads();
}

__device__ __forceinline__ void ph_loraprep(const Params& P, int l) {
    const bf16_t* PRW = (const bf16_t*)(P.ws + WS_PRW); bf16_t* AL = (bf16_t*)(P.ws + WS_ALORA);
    const float* mu = P.in[I_MU] + (size_t)l * 2 * RW_IN;
    const int gtid = blockIdx.x * NTHR + otid(), gn = gridDim.x * NTHR;
    for (int it = gtid; it < T * 48; it += gn) {
        const int row = it / 48, j8 = it % 48, col = 1152 + j8 * 8;
        bool hp, hn; row_nbrs(row, hp, hn);
        float p[8], pp[8], pn[8];
        unpack8(*(const u32x4*)(PRW + (size_t)row * RW_IN + col), p);
        if (hp) unpack8(*(const u32x4*)(PRW + (size_t)(row - 1) * RW_IN + col), pp); else {
#pragma unroll
            for (int i = 0; i < 8; ++i) pp[i] = 0.f; }
        if (hn) unpack8(*(const u32x4*)(PRW + (size_t)(row + 1) * RW_IN + col), pn); else {
#pragma unroll
            for (int i = 0; i < 8; ++i) pn[i] = 0.f; }
        float o[8];
#pragma unroll
        for (int i = 0; i < 8; ++i) { const float xs = p[i] + mu[col + i] * (pp[i] - p[i]) + mu[RW_IN + col + i] * (pn[i] - p[i]);
            o[i] = j8 < 16 ? tanhf(xs) : (j8 < 32 ? xs : sigmoidf_(xs)); }
        u32x4 w; w.x = cvt_pk_bf16(o[0], o[1]); w.y = cvt_pk_bf16(o[2], o[3]); w.z = cvt_pk_bf16(o[4], o[5]); w.w = cvt_pk_bf16(o[6], o[7]);
        *(u32x4*)(AL + (size_t)row * 384 + j8 * 8) = w;
    }
}

__device__ __forceinline__ void ph_rwkvprep(const Params& P, int l) {
    const int tid = otid(), lane = tid & 63, gw = blockIdx.x * NWAVE + (tid >> 6), nw = gridDim.x * NWAVE;
    const int nrw = nw / 6, h = gw % 6, rw0 = gw / 6;
    if (rw0 >= nrw) return;
    const bf16_t* PRW = (const bf16_t*)(P.ws + WS_PRW); const bf16_t* LO = (const bf16_t*)(P.ws + WS_LORAO);
    bf16_t* RS = (bf16_t*)(P.ws + WS_RS); bf16_t* KKS = (bf16_t*)(P.ws + WS_KKS); bf16_t* VS = (bf16_t*)(P.ws + WS_VS); bf16_t* KS = (bf16_t*)(P.ws + WS_KS); bf16_t* BS = (bf16_t*)(P.ws + WS_BS);
    float* BON = (float*)(P.ws + WS_BONUS); float* DEC = (float*)(P.ws + WS_DECAY);
    const float2* RT = (const float2*)(P.ws + WS_ROPE);
    const float* mu = P.in[I_MU] + (size_t)l * 2 * RW_IN;
    const int c = h * 64 + lane, f = lane & 15;
    const float mp0 = mu[c], mn0 = mu[RW_IN + c], mp1 = mu[384 + c], mn1 = mu[RW_IN + 384 + c], mp2 = mu[768 + c], mn2 = mu[RW_IN + 768 + c];
    const float ckk = P.in[I_KK][l * RWW + c], cka = P.in[I_KA][l * RWW + c], crk = P.in[I_RK][l * RWW + c];
    const float ca0 = P.in[I_A0][(size_t)l * 2 * RWW + c], ca1 = P.in[I_A0][(size_t)l * 2 * RWW + RWW + c], cw0 = P.in[I_W0][(size_t)l * 2 * RWW + c], cw1 = P.in[I_W0][(size_t)l * 2 * RWW + RWW + c];
    const float sg = (lane & 16) ? 1.f : -1.f;
#pragma unroll 2
    for (int row = rw0; row < T; row += nrw) {
        bool hp, hn; row_nbrs(row, hp, hn);
        const bf16_t* pr = PRW + (size_t)row * RW_IN + c; const int om = hp ? -RW_IN : 0, op = hn ? RW_IN : 0; const float fm = hp ? 1.f : 0.f, fp = hn ? 1.f : 0.f;
        const float r0 = bf2f(pr[0]), k0 = bf2f(pr[384]), v0 = bf2f(pr[768]);
        const float r = r0 + mp0 * (fm * bf2f(pr[om]) - r0) + mn0 * (fp * bf2f(pr[op]) - r0);
        const float k = k0 + mp1 * (fm * bf2f(pr[384 + om]) - k0) + mn1 * (fp * bf2f(pr[384 + op]) - k0);
        const float v = v0 + mp2 * (fm * bf2f(pr[768 + om]) - v0) + mn2 * (fp * bf2f(pr[768 + op]) - v0);
        const bf16_t* lo = LO + (size_t)row * 1536 + c;
        const float a0 = sigmoidf_(bf2f(lo[768]) + ca0), a1 = sigmoidf_(bf2f(lo[1152]) + ca1);
        const float x0 = bf2f(lo[0]) + cw0, x1 = bf2f(lo[384]) + cw1;
        const float kkr = k * ckk;
        const float nrm = sqrtf(wsum(kkr * kkr));
        const float kk = kkr / fmaxf(nrm, 1e-12f);
        float kd0 = k * (1.f + (a0 - 1.f) * cka), kd1 = k * (1.f + (a1 - 1.f) * cka);
        float b0 = kk * a0, b1 = kk * a1;
        const float bon = wsum(r * (kd0 + kd1) * crk);
        float rs = r, kks = kk;
        if (row < TL) {
            const int t = row & (SEQ - 1); const int pos = (lane < 32) ? (t >> 6) : (t & 63);
            const float2 csn = RT[pos * 16 + f]; const float cs = csn.x, sn = csn.y;
            const float r2 = __shfl_xor(rs, 16), k2 = __shfl_xor(kks, 16), d0 = __shfl_xor(kd0, 16), d1 = __shfl_xor(kd1, 16), e0 = __shfl_xor(b0, 16), e1 = __shfl_xor(b1, 16);
            rs = rs * cs + sg * r2 * sn; kks = kks * cs + sg * k2 * sn; kd0 = kd0 * cs + sg * d0 * sn; kd1 = kd1 * cs + sg * d1 * sn; b0 = b0 * cs + sg * e0 * sn; b1 = b1 * cs + sg * e1 * sn;
        }
        const size_t o = (size_t)row * 384 + c;
        DEC[o] = __expf(-0.6065306597f * sigmoidf_(x0)); DEC[(size_t)T * 384 + o] = __expf(-0.6065306597f * sigmoidf_(x1));
        if (lane == 0) BON[(size_t)row * 6 + h] = bon;
        RS[o] = f2bf(rs); KKS[o] = f2bf(-kks); VS[o] = f2bf(v);
        KS[o] = f2bf(kd0); KS[(size_t)T * 384 + o] = f2bf(kd1); BS[o] = f2bf(b0); BS[(size_t)T * 384 + o] = f2bf(b1);
    }
}

__device__ __forceinline__ int scan_row(int b, int d, int step) {
    if (step < CTX) { const int tc = d ? (CTX - 1 - step) : step; return TL + b * CTX + tc; }
    const int tl = d ? (SEQ - 1 - (step - CTX)) : (step - CTX); return b * SEQ + tl;
}
__device__ __forceinline__ void scan_task_v1(const Params& P, int task, float* sv) {
    const int lane = otid() & 63;
    const int d = task & 1, h = (task >> 1) % 6, b = task / 12;
    const float* DEC = (const float*)(P.ws + WS_DECAY) + (size_t)d * T * 384; const bf16_t* KKS = (const bf16_t*)(P.ws + WS_KKS); const bf16_t* RS = (const bf16_t*)(P.ws + WS_RS);
    const bf16_t* VS = (const bf16_t*)(P.ws + WS_VS); const bf16_t* KS = (const bf16_t*)(P.ws + WS_KS) + (size_t)d * T * 384; const bf16_t* BS = (const bf16_t*)(P.ws + WS_BS) + (size_t)d * T * 384;
    float* YD = (float*)(P.ws + WS_YDIR) + (size_t)d * T * 384;
    float S[64];
#pragma unroll
    for (int j = 0; j < 64; ++j) S[j] = 0.f;
    size_t o = (size_t)scan_row(b, d, 0) * 384 + h * 64 + lane;
    float nw_ = DEC[o], na = bf2f(KKS[o]), nb = bf2f(BS[o]), nk = bf2f(KS[o]), nr = bf2f(RS[o]), nv = bf2f(VS[o]);
    for (int step = 0; step < CTX + SEQ; ++step) {
        const float v = nv; const size_t oc = o;
        asm volatile("s_waitcnt lgkmcnt(0)" ::: "memory");
        sv[lane] = nw_; sv[64 + lane] = na; sv[128 + lane] = nb; sv[192 + lane] = nk; sv[256 + lane] = nr;
        asm volatile("s_waitcnt lgkmcnt(0)" ::: "memory");
        if (step + 1 < CTX + SEQ) { o = (size_t)scan_row(b, d, step + 1) * 384 + h * 64 + lane;
            nw_ = DEC[o]; na = bf2f(KKS[o]); nb = bf2f(BS[o]); nk = bf2f(KS[o]); nr = bf2f(RS[o]); nv = bf2f(VS[o]); }
        float sa0 = 0.f, sa1 = 0.f, sa2 = 0.f, sa3 = 0.f;
#pragma unroll
        for (int j = 0; j < 64; j += 4) { const float4 a4 = *(const float4*)(sv + 64 + j);
            sa0 += S[j + 0] * a4.x; sa1 += S[j + 1] * a4.y; sa2 += S[j + 2] * a4.z; sa3 += S[j + 3] * a4.w; }
        const float sa = (sa0 + sa1) + (sa2 + sa3);
        float y0 = 0.f, y1 = 0.f, y2 = 0.f, y3 = 0.f;
#pragma unroll
        for (int j = 0; j < 64; j += 4) {
            const float4 w4 = *(const float4*)(sv + j), b4 = *(const float4*)(sv + 128 + j), k4 = *(const float4*)(sv + 192 + j), r4 = *(const float4*)(sv + 256 + j);
            S[j + 0] = S[j + 0] * w4.x + sa * b4.x + v * k4.x; y0 += S[j + 0] * r4.x;
            S[j + 1] = S[j + 1] * w4.y + sa * b4.y + v * k4.y; y1 += S[j + 1] * r4.y;
            S[j + 2] = S[j + 2] * w4.z + sa * b4.z + v * k4.z; y2 += S[j + 2] * r4.z;
            S[j + 3] = S[j + 3] * w4.w + sa * b4.w + v * k4.w; y3 += S[j + 3] * r4.w; }
        YD[oc] = (y0 + y1) + (y2 + y3);
    }
}

__device__ __forceinline__ void natt_key(const bf16_t* PNA, size_t krow, int hoff, const float (&q)[16], float bias, float& m, float& lsum, float (&o)[16]) {
    const bf16_t* kp = PNA + krow * NA_IN + 384 + hoff; const bf16_t* vp = PNA + krow * NA_IN + 768 + hoff;
    float s = 0.f;
#pragma unroll
    for (int j8 = 0; j8 < 2; ++j8) { float kf[8]; unpack8(*(const u32x4*)(kp + j8 * 8), kf);
#pragma unroll
        for (int i = 0; i < 8; ++i) s += q[j8 * 8 + i] * kf[i]; }
    s += __shfl_xor(s, 1); s += __shfl_xor(s, 2); s += bias;
    const float mn = fmaxf(m, s), corr = __expf(m - mn), p = __expf(s - mn);
    m = mn; lsum = lsum * corr + p;
#pragma unroll
    for (int j8 = 0; j8 < 2; ++j8) { float vf[8]; unpack8(*(const u32x4*)(vp + j8 * 8), vf);
#pragma unroll
        for (int i = 0; i < 8; ++i) o[j8 * 8 + i] = o[j8 * 8 + i] * corr + p * vf[i]; }
}
__device__ __forceinline__ void natten_items_v1(const Params& P, int l, int wid0, int nworkers) {
    const bf16_t* PNA = (const bf16_t*)(P.ws + WS_PNA); bf16_t* MIX = (bf16_t*)(P.ws + WS_U);
    const float* rpb = P.in[I_RPB] + (size_t)l * 6 * 15 * 31;
    const int sub = wid0 & 3;
    for (int it = wid0 >> 2; it < T * 6; it += nworkers >> 2) {
        const int row = it % T, h = it / T, hoff = h * 64 + sub * 16;
        float q[16], o[16];
#pragma unroll
        for (int j8 = 0; j8 < 2; ++j8) { float qf[8]; unpack8(*(const u32x4*)(PNA + (size_t)row * NA_IN + hoff + j8 * 8), qf);
#pragma unroll
            for (int i = 0; i < 8; ++i) { q[j8 * 8 + i] = qf[i] * 0.125f; o[j8 * 8 + i] = 0.f; } }
        float m = -3.0e38f, lsum = 0.f;
        int b;
        if (row < TL) { b = row >> 13; const int t = row & (SEQ - 1), i = t >> 6, col = t & 63;
            const int start = min(max(i - 4, 0), 120), win0 = min(max(col - 8, 0), 48);
            for (int r = 0; r < 8; ++r) for (int kc = win0; kc < win0 + 16; ++kc) {
                const float bias = rpb[(h * 15 + (start + r - i + 7)) * 31 + (kc - col + 15)];
                natt_key(PNA, (size_t)b * SEQ + (start + r) * 64 + kc, hoff, q, bias, m, lsum, o); }
        } else b = (row - TL) >> 8;
        for (int c = 0; c < CTX; ++c) natt_key(PNA, (size_t)TL + b * CTX + c, hoff, q, 0.f, m, lsum, o);
        const float il = 1.0f / lsum;
#pragma unroll
        for (int j8 = 0; j8 < 2; ++j8) { u32x4 w; w.x = cvt_pk_bf16(o[j8 * 8 + 0] * il, o[j8 * 8 + 1] * il); w.y = cvt_pk_bf16(o[j8 * 8 + 2] * il, o[j8 * 8 + 3] * il);
            w.z = cvt_pk_bf16(o[j8 * 8 + 4] * il, o[j8 * 8 + 5] * il); w.w = cvt_pk_bf16(o[j8 * 8 + 6] * il, o[j8 * 8 + 7] * il);
            *(u32x4*)(MIX + (size_t)row * D + 640 + hoff + j8 * 8) = w; }
    }
}

__device__ __forceinline__ void vt_tile(const Params& P, int tile, unsigned short* tl  ) {
    const int tid = otid();
    const bf16_t* PNA = (const bf16_t*)(P.ws + WS_PNA);
    int h, tok0; bf16_t* dst; int ldt;
    if (tile < NB * 128 * 6) { h = tile % 6; const int sb = tile / 6; const int b = sb >> 7, blk = sb & 127; tok0 = b * SEQ + blk * 64; dst = (bf16_t*)(P.ws + WS_VTL) + ((size_t)(b * 6 + h) * 64) * SEQ + blk * 64; ldt = SEQ; }
    else { const int tt = tile - NB * 128 * 6; h = tt % 6; const int sb = tt / 6; const int b = sb >> 2, blk = sb & 3; tok0 = TL + b * CTX + blk * 64; dst = (bf16_t*)(P.ws + WS_VTC) + ((size_t)(b * 6 + h) * 64) * CTX + blk * 64; ldt = CTX; }
    { const int tok = tid >> 3, seg = tid & 7; const u32x4 v = *(const u32x4*)(PNA + (size_t)(tok0 + tok) * NA_IN + 768 + h * 64 + seg * 8);
      unsigned* w = (unsigned*)(tl + tok * 72 + seg * 8); w[0] = v.x; w[1] = v.y; w[2] = v.z; w[3] = v.w; }
    __syncthreads();
    { const int hd = tid >> 3, ts = tid & 7; unsigned short e[8];
#pragma unroll
      for (int k = 0; k < 8; ++k) e[k] = tl[(ts * 8 + k) * 72 + hd];
      u32x4 w; w.x = (unsigned)e[0] | ((unsigned)e[1] << 16); w.y = (unsigned)e[2] | ((unsigned)e[3] << 16); w.z = (unsigned)e[4] | ((unsigned)e[5] << 16); w.w = (unsigned)e[6] | ((unsigned)e[7] << 16);
      *(u32x4*)(dst + (size_t)hd * ldt + ts * 8) = w; }
    __syncthreads();
}
constexpr int NAT_LAT_TASKS = NB * 128 * 4 * 6, NAT_CTX_TASKS = NB * 16 * 6, NAT_TASKS = NAT_LAT_TASKS + NAT_CTX_TASKS;
__device__ __forceinline__ void natten_task(const Params& P, int l, int task) {
    using pg8::bf16x8;
    const int lane = otid() & 63, fr = lane & 15, fq = lane >> 4;
    const bf16_t* PNA = (const bf16_t*)(P.ws + WS_PNA); bf16_t* MIX = (bf16_t*)(P.ws + WS_U);
    const bool lat = task < NAT_LAT_TASKS;
    int b, h, i = 0, n = 0, qtok0;
    if (lat) { h = task % 6; const int r = task / 6; n = r & 3; i = (r >> 2) & 127; b = r >> 9; qtok0 = b * SEQ + i * 64 + 16 * n; }
    else { const int tt = task - NAT_LAT_TASKS; h = tt % 6; const int qb = (tt / 6) & 15; b = tt / 96; qtok0 = TL + b * CTX + 16 * qb; }
    const int start = min(max(i - 4, 0), 120), band0 = min(max(16 * n - 8, 0), 32);
    const int col = 16 * n + fr, win0 = min(max(col - 8, 0), 48);
    bf16x8 bq[2];
#pragma unroll
    for (int kh = 0; kh < 2; ++kh) bq[kh] = *(const bf16x8*)(PNA + (size_t)(qtok0 + fr) * NA_IN + h * 64 + kh * 32 + fq * 8);
    f32x4 sc[32];
    if (lat) {
#pragma unroll
        for (int t = 0; t < 16; ++t) { const int tok0 = b * SEQ + (start + (t >> 1)) * 64 + band0 + 16 * (t & 1);
            const bf16_t* kp = PNA + (size_t)(tok0 + fr) * NA_IN + 384 + h * 64 + fq * 8;
            const bf16x8 k0 = *(const bf16x8*)kp, k1 = *(const bf16x8*)(kp + 32);
            f32x4 a = (f32x4){0.f, 0.f, 0.f, 0.f};
            a = __builtin_amdgcn_mfma_f32_16x16x32_bf16(k0, bq[0], a, 0, 0, 0); a = __builtin_amdgcn_mfma_f32_16x16x32_bf16(k1, bq[1], a, 0, 0, 0);
            sc[t] = a; if ((t & 3) == 3) asm volatile("" ::: "memory"); }
    } else {
#pragma unroll
        for (int t = 0; t < 16; ++t) sc[t] = (f32x4){-3.0e38f, -3.0e38f, -3.0e38f, -3.0e38f};
    }
#pragma unroll
    for (int t = 16; t < 32; ++t) { const int tok0 = TL + b * CTX + 16 * (t - 16);
        const bf16_t* kp = PNA + (size_t)(tok0 + fr) * NA_IN + 384 + h * 64 + fq * 8;
        const bf16x8 k0 = *(const bf16x8*)kp, k1 = *(const bf16x8*)(kp + 32);
        f32x4 a = (f32x4){0.f, 0.f, 0.f, 0.f};
        a = __builtin_amdgcn_mfma_f32_16x16x32_bf16(k0, bq[0], a, 0, 0, 0); a = __builtin_amdgcn_mfma_f32_16x16x32_bf16(k1, bq[1], a, 0, 0, 0);
        sc[t] = a * 0.125f; if ((t & 3) == 3) asm volatile("" ::: "memory"); }
    if (lat) { const float* rpb = P.in[I_RPB] + ((size_t)l * 6 + h) * 15 * 31;
#pragma unroll
        for (int t = 0; t < 16; ++t) { const int ro = start + (t >> 1) - i + 7; const int kc0 = band0 + 16 * (t & 1) + fq * 4;
#pragma unroll
            for (int j = 0; j < 4; ++j) { const int kc = kc0 + j; const bool ok = kc >= win0 && kc < win0 + 16; const int co = min(max(kc - col + 15, 0), 30);
                const float bias = rpb[ro * 31 + co]; sc[t][j] = ok ? sc[t][j] * 0.125f + bias : -3.0e38f; } } }
    float mx = -3.0e38f;
#pragma unroll
    for (int t = 0; t < 32; ++t) mx = fmaxf(mx, fmaxf(fmaxf(sc[t][0], sc[t][1]), fmaxf(sc[t][2], sc[t][3])));
    mx = fmaxf(mx, __shfl_xor(mx, 16)); mx = fmaxf(mx, __shfl_xor(mx, 32));
    float sum = 0.f;
#pragma unroll
    for (int t = 0; t < 32; ++t) {
#pragma unroll
        for (int j = 0; j < 4; ++j) { const float p = __expf(sc[t][j] - mx); sc[t][j] = p; sum += p; } }
    sum += __shfl_xor(sum, 16); sum += __shfl_xor(sum, 32);
    const float inv = 1.0f / sum;
    f32x4 ot[4];
#pragma unroll
    for (int q = 0; q < 4; ++q) ot[q] = (f32x4){0.f, 0.f, 0.f, 0.f};
    const bf16_t* VTL = (const bf16_t*)(P.ws + WS_VTL) + ((size_t)(b * 6 + h) * 64) * SEQ; const bf16_t* VTC = (const bf16_t*)(P.ws + WS_VTC) + ((size_t)(b * 6 + h) * 64) * CTX;
    if (lat) {
#pragma unroll
        for (int m = 0; m < 8; ++m) { const int tk = (start + m) * 64 + band0 + fq * 4;
            u32x4 pw; pw.x = cvt_pk_bf16(sc[2 * m][0], sc[2 * m][1]); pw.y = cvt_pk_bf16(sc[2 * m][2], sc[2 * m][3]); pw.z = cvt_pk_bf16(sc[2 * m + 1][0], sc[2 * m + 1][1]); pw.w = cvt_pk_bf16(sc[2 * m + 1][2], sc[2 * m + 1][3]);
            const bf16x8 pb = __builtin_bit_cast(bf16x8, pw);
#pragma unroll
            for (int q = 0; q < 4; ++q) { const bf16_t* vp = VTL + (size_t)(q * 16 + fr) * SEQ + tk; const u32x2 v0 = *(const u32x2*)vp, v1 = *(const u32x2*)(vp + 16);
                u32x4 vw; vw.x = v0.x; vw.y = v0.y; vw.z = v1.x; vw.w = v1.y;
                ot[q] = __builtin_amdgcn_mfma_f32_16x16x32_bf16(__builtin_bit_cast(bf16x8, vw), pb, ot[q], 0, 0, 0); }
            if (m & 1) asm volatile("" ::: "memory"); }
    }
#pragma unroll
    for (int m = 0; m < 8; ++m) { const int tk = 32 * m + fq * 4;
        u32x4 pw; pw.x = cvt_pk_bf16(sc[16 + 2 * m][0], sc[16 + 2 * m][1]); pw.y = cvt_pk_bf16(sc[16 + 2 * m][2], sc[16 + 2 * m][3]); pw.z = cvt_pk_bf16(sc[17 + 2 * m][0], sc[17 + 2 * m][1]); pw.w = cvt_pk_bf16(sc[17 + 2 * m][2], sc[17 + 2 * m][3]);
        const bf16x8 pb = __builtin_bit_cast(bf16x8, pw);
#pragma unroll
        for (int q = 0; q < 4; ++q) { const bf16_t* vp = VTC + (size_t)(q * 16 + fr) * CTX + tk; const u32x2 v0 = *(const u32x2*)vp, v1 = *(const u32x2*)(vp + 16);
            u32x4 vw; vw.x = v0.x; vw.y = v0.y; vw.z = v1.x; vw.w = v1.y;
            ot[q] = __builtin_amdgcn_mfma_f32_16x16x32_bf16(__builtin_bit_cast(bf16x8, vw), pb, ot[q], 0, 0, 0); }
        if (m & 1) asm volatile("" ::: "memory"); }
#pragma unroll
    for (int q = 0; q < 4; ++q) { u32x2 w; w.x = cvt_pk_bf16(ot[q][0] * inv, ot[q][1] * inv); w.y = cvt_pk_bf16(ot[q][2] * inv, ot[q][3] * inv);
        *(u32x2*)(MIX + (size_t)(qtok0 + fr) * D + 640 + h * 64 + q * 16 + fq * 4) = w; }
}

__device__ __forceinline__ void fft_fwd(float2* X) {
#pragma unroll 1
    for (int lq = 12; lq >= 0; lq -= 2) { const int q = 1 << lq; const float rq = 1.0f / (float)(4 * q);
        for (int j = otid(); j < NFFT / 4; j += NTHR) { const int lo = j & (q - 1), base = ((j >> lq) << (lq + 2)) | lo;
            const float2 x0 = X[base], x1 = X[base + q], x2 = X[base + 2 * q], x3 = X[base + 3 * q];
            const float fr = (float)lo * rq; const float c = __builtin_amdgcn_cosf(fr), s = __builtin_amdgcn_sinf(fr), c2 = c * c - s * s, s2 = 2.f * c * s;
            const float a0x = x0.x + x2.x, a0y = x0.y + x2.y, dx = x0.x - x2.x, dy = x0.y - x2.y;
            const float a2x = dx * c + dy * s, a2y = dy * c - dx * s;
            const float a1x = x1.x + x3.x, a1y = x1.y + x3.y, ex = x1.x - x3.x, ey = x1.y - x3.y;
            const float mx = ex * c + ey * s, my = ey * c - ex * s;
            const float a3x = my, a3y = -mx;
            const float fx = a0x - a1x, fy = a0y - a1y, gx = a2x - a3x, gy = a2y - a3y;
            X[base] = make_float2(a0x + a1x, a0y + a1y); X[base + q] = make_float2(fx * c2 + fy * s2, fy * c2 - fx * s2);
            X[base + 2 * q] = make_float2(a2x + a3x, a2y + a3y); X[base + 3 * q] = make_float2(gx * c2 + gy * s2, gy * c2 - gx * s2); }
        __syncthreads(); }
}
__device__ __forceinline__ void fft_inv(float2* X) {
#pragma unroll 1
    for (int lq = 0; lq <= 12; lq += 2) { const int q = 1 << lq; const float rq = 1.0f / (float)(4 * q);
        for (int j = otid(); j < NFFT / 4; j += NTHR) { const int lo = j & (q - 1), base = ((j >> lq) << (lq + 2)) | lo;
            const float2 y0 = X[base], y1 = X[base + q], y2 = X[base + 2 * q], y3 = X[base + 3 * q];
            const float fr = (float)lo * rq; const float c = __builtin_amdgcn_cosf(fr), s = __builtin_amdgcn_sinf(fr), c2 = c * c - s * s, s2 = 2.f * c * s;
            const float tx = y1.x * c2 - y1.y * s2, ty = y1.x * s2 + y1.y * c2;
            const float a0x = y0.x + tx, a0y = y0.y + ty, a1x = y0.x - tx, a1y = y0.y - ty;
            const float ux = y3.x * c2 - y3.y * s2, uy = y3.x * s2 + y3.y * c2;
            const float a2x = y2.x + ux, a2y = y2.y + uy, a3x = y2.x - ux, a3y = y2.y - uy;
            const float vx = a2x * c - a2y * s, vy = a2x * s + a2y * c;
            const float mx = a3x * c - a3y * s, my = a3x * s + a3y * c;
            const float wx = -my, wy = mx;
            X[base] = make_float2(a0x + vx, a0y + vy); X[base + 2 * q] = make_float2(a0x - vx, a0y - vy);
            X[base + q] = make_float2(a1x + wx, a1y + wy); X[base + 3 * q] = make_float2(a1x - wx, a1y - wy); }
        __syncthreads(); }
}
__device__ __forceinline__ float hy_delta(int c) { const float lo = -4.605170185988091f / 1.5f, hi = -4.605170185988091f / 0.3f; return fabsf(lo + (float)c * ((hi - lo) / 255.0f)); }
__device__ __forceinline__ float hy_short(const bf16_t* PHYT, const float* cw, const float* cb, int row, int col) {
    bool hp, hn; row_nbrs(row, hp, hn);
    const bf16_t* p = PHYT + (size_t)col * T + row;
    float v = cb[col] + cw[HY_IN + col] * bf2f(p[0]);
    if (hp) v += cw[col] * bf2f(p[-1]);
    if (hn) v += cw[2 * HY_IN + col] * bf2f(p[1]);
    return v;
}
struct HyTap { float w0, w1, w2, b; };
__device__ __forceinline__ HyTap hy_tap(const float* cw, const float* cb, int col) { HyTap t; t.w0 = cw[col]; t.w1 = cw[HY_IN + col]; t.w2 = cw[2 * HY_IN + col]; t.b = cb[col]; return t; }
__device__ __forceinline__ float hy_lat(const bf16_t* colp, int b, int n, const HyTap t) {
    const bf16_t* p = colp + b * SEQ + n;
    const float xm = bf2f(p[n > 0 ? -1 : 0]), x0 = bf2f(p[0]), xp = bf2f(p[n < SEQ - 1 ? 1 : 0]);
    return t.b + t.w1 * x0 + (n > 0 ? t.w0 * xm : 0.f) + (n < SEQ - 1 ? t.w2 * xp : 0.f);
}
__device__ __forceinline__ void hy_spec_task(const Params& P, int l, int o, int c, float2* X, float* ex_) {
    const int tid = otid();
    const bf16_t* ff = (const bf16_t*)(P.ws + WS_FILT) + (size_t)(o * 512 + c) * SEQ; const bf16_t* fb = ff + (size_t)256 * SEQ;
    for (int n = tid; n < SEQ; n += NTHR) {
        X[n] = make_float2(bf2f(ff[n]), 0.f);
        if (n > 0) X[NFFT - n] = make_float2(bf2f(fb[n]), 0.f); else X[SEQ] = make_float2(0.f, 0.f); }
    __syncthreads();
    fft_fwd(X);
    float2* spec = (float2*)(P.ws + WS_SPEC) + (size_t)(o * 256 + c) * NFFT;
    for (int i = tid; i < NFFT; i += NTHR) spec[i] = X[i];
    __syncthreads();
}
__device__ __forceinline__ void hy_conv_core(const Params& P, int o, int c, float2* X) {
    fft_fwd(X);
    const float2* spec = (const float2*)(P.ws + WS_SPEC) + (size_t)(o * 256 + c) * NFFT;
    for (int i = otid(); i < NFFT; i += NTHR) { const float2 a = X[i], k = spec[i]; X[i] = make_float2(a.x * k.x - a.y * k.y, a.x * k.y + a.y * k.x); }
    __syncthreads();
    fft_inv(X);
}
__device__ __forceinline__ void hy_task1(const Params& P, int l, int c, float2* X, float* ex) {
    const int tid = otid();
    const bf16_t* PHY = (const bf16_t*)(P.ws + WS_PHY); const float* cw = P.in[I_HCW] + (size_t)l * 3 * HY_IN; const float* cb = P.in[I_HCB] + (size_t)l * HY_IN;
    const float bias0 = P.in[I_HBIAS][(size_t)l * 2 * HYC + c], bias1 = P.in[I_HBIAS][(size_t)l * 2 * HYC + HYC + c];
    const HyTap tv = hy_tap(cw, cb, c), tg1 = hy_tap(cw, cb, HYC + c); const bf16_t* colv = PHY + (size_t)c * T; const bf16_t* colg1 = PHY + (size_t)(HYC + c) * T;
#pragma unroll 4
    for (int n = tid; n < SEQ; n += NTHR) { X[n] = make_float2(hy_lat(colv, 0, n, tv), hy_lat(colv, 1, n, tv)); X[SEQ + n] = make_float2(0.f, 0.f); }
    __syncthreads();
    hy_conv_core(P, 0, c, X);
    float* Z1 = (float*)(P.ws + WS_Z1) + (size_t)c * NB * SEQ;
#pragma unroll 4
    for (int n = tid; n < SEQ; n += NTHR) { const float2 y = X[n];
        const float v0 = hy_lat(colv, 0, n, tv), v1 = hy_lat(colv, 1, n, tv), g0 = hy_lat(colg1, 0, n, tg1), g1 = hy_lat(colg1, 1, n, tg1);
        Z1[n] = g0 * (y.x + bias0 * v0); Z1[SEQ + n] = g1 * (y.y + bias0 * v1); }
    __syncthreads();
    float* f = (float*)X;
    float* vv = f, *x1 = f + 512, *x2 = f + 1024, *hf = f + 1536  , *z1 = f + 2560;
    const bf16_t* fc = (const bf16_t*)(P.ws + WS_FILTC);
    { const int b = tid >> 8, t = tid & 255, row = TL + b * CTX + t;
      vv[tid] = hy_short(PHY, cw, cb, row, c); x1[tid] = hy_short(PHY, cw, cb, row, HYC + c); x2[tid] = hy_short(PHY, cw, cb, row, 2 * HYC + c);
      for (int q = tid; q < 1024; q += NTHR) { const int od = q >> 8, n = q & 255; hf[q] = bf2f(fc[(size_t)(od * 256 + c) * CTX + n]); } }
    __syncthreads();
    { const int b = tid >> 8, t = tid & 255; float y = bias0 * vv[tid];
      for (int s = 0; s <= t; ++s) y += hf[t - s] * vv[b * 256 + s];
      for (int s = t + 1; s < CTX; ++s) y += hf[256 + s - t] * vv[b * 256 + s];
      z1[tid] = x1[tid] * y; }
    __syncthreads();
    { const int b = tid >> 8, t = tid & 255; float y = bias1 * z1[tid];
      for (int s = 0; s <= t; ++s) y += hf[512 + t - s] * z1[b * 256 + s];
      for (int s = t + 1; s < CTX; ++s) y += hf[768 + s - t] * z1[b * 256 + s];
      bf16_t* MIX = (bf16_t*)(P.ws + WS_U); MIX[(size_t)(TL + b * CTX + t) * D + c] = f2bf(x2[tid] * y); }
    __syncthreads();
}
__device__ __forceinline__ void hy_task2(const Params& P, int l, int c, float2* X) {
    const int tid = otid();
    const bf16_t* PHY = (const bf16_t*)(P.ws + WS_PHY); const float* cw = P.in[I_HCW] + (size_t)l * 3 * HY_IN; const float* cb = P.in[I_HCB] + (size_t)l * HY_IN;
    const float bias1 = P.in[I_HBIAS][(size_t)l * 2 * HYC + HYC + c];
    const float* Z1 = (const float*)(P.ws + WS_Z1) + (size_t)c * NB * SEQ;
    for (int n = tid; n < SEQ; n += NTHR) { X[n] = make_float2(Z1[n], Z1[SEQ + n]); X[SEQ + n] = make_float2(0.f, 0.f); }
    __syncthreads();
    hy_conv_core(P, 1, c, X);
    bf16_t* MIX = (bf16_t*)(P.ws + WS_U);
    const HyTap tg2 = hy_tap(cw, cb, 2 * HYC + c); const bf16_t* colg2 = PHY + (size_t)(2 * HYC + c) * T;
#pragma unroll 4
    for (int n = tid; n < SEQ; n += NTHR) { const float2 y = X[n];
        const float g0 = hy_lat(colg2, 0, n, tg2), g1 = hy_lat(colg2, 1, n, tg2);
        MIX[(size_t)n * D + c] = f2bf(g0 * (y.x + bias1 * Z1[n])); MIX[(size_t)(SEQ + n) * D + c] = f2bf(g1 * (y.y + bias1 * Z1[SEQ + n])); }
    __syncthreads();
}

constexpr int SEGC = 256, NSEG = 33, SCH = 4;
typedef float f32x2v __attribute__((ext_vector_type(2)));
template <bool IDENT>
__device__ __forceinline__ void scan_seg(const Params& P, int chain, int g, float* ring_  ) {
    const ldsfp ring = vlds(ring_);
    const int lane = otid() & 63;
    const int d = chain & 1, h = (chain >> 1) % 6, b = chain / 12;
    const float* DEC = (const float*)(P.ws + WS_DECAY) + (size_t)d * T * 384; const bf16_t* KKS = (const bf16_t*)(P.ws + WS_KKS); const bf16_t* RS = (const bf16_t*)(P.ws + WS_RS);
    const bf16_t* VS = (const bf16_t*)(P.ws + WS_VS); const bf16_t* KS = (const bf16_t*)(P.ws + WS_KS) + (size_t)d * T * 384; const bf16_t* BS = (const bf16_t*)(P.ws + WS_BS) + (size_t)d * T * 384;
    float* YD = (float*)(P.ws + WS_YDIR) + (size_t)d * T * 384;
    bf16_t* E = (bf16_t*)(P.ws + WS_E) + (size_t)chain * SEQ * 64;
    const int step0 = g == 0 ? 0 : CTX + (g - 1) * SEGC;
    f32x2v S0[32], S1[32];
#pragma unroll
    for (int j = 0; j < 32; ++j) { S0[j] = (f32x2v){0.f, 0.f}; S1[j] = (f32x2v){(2 * j == lane) ? 1.f : 0.f, (2 * j + 1 == lane) ? 1.f : 0.f}; }
    float pw[SCH], pa[SCH], pb[SCH], pk[SCH], pr[SCH], pv[SCH]; int po[SCH];
#pragma unroll
    for (int s = 0; s < SCH; ++s) { const int o = scan_row(b, d, step0 + s) * 384 + h * 64 + lane; po[s] = o;
        pw[s] = DEC[o]; pa[s] = bf2f(KKS[o]); pb[s] = bf2f(BS[o]); pk[s] = bf2f(KS[o]); pr[s] = bf2f(RS[o]); pv[s] = bf2f(VS[o]); }
    for (int c = 0; c < SEGC / SCH; ++c) {
        float cv[SCH]; int co[SCH];
        asm volatile("s_waitcnt lgkmcnt(0)" ::: "memory");
#pragma unroll
        for (int s = 0; s < SCH; ++s) { const ldsfp sv = ring + s * 320; sv[lane] = pw[s]; sv[64 + lane] = pa[s]; sv[128 + lane] = pb[s]; sv[192 + lane] = pk[s]; sv[256 + lane] = pr[s]; cv[s] = pv[s]; co[s] = po[s]; }
        asm volatile("s_waitcnt lgkmcnt(0)" ::: "memory");
        if (c + 1 < SEGC / SCH) {
#pragma unroll
            for (int s = 0; s < SCH; ++s) { const int o = scan_row(b, d, step0 + (c + 1) * SCH + s) * 384 + h * 64 + lane; po[s] = o;
                pw[s] = DEC[o]; pa[s] = bf2f(KKS[o]); pb[s] = bf2f(BS[o]); pk[s] = bf2f(KS[o]); pr[s] = bf2f(RS[o]); pv[s] = bf2f(VS[o]); } }
#pragma unroll
        for (int s = 0; s < SCH; ++s) { const ldsfp sv = ring + s * 320;
            f32x2v sa2 = (f32x2v){0.f, 0.f}, sb2 = (f32x2v){0.f, 0.f}, sa3 = sa2, sb3 = sa2;
#pragma unroll
            for (int hb = 0; hb < 2; ++hb) { f32x4 A[8];
#pragma unroll
                for (int i = 0; i < 8; ++i) A[i] = *(const LAS f32x4*)(sv + 64 + hb * 32 + 4 * i);
                __builtin_amdgcn_sched_barrier(0);
#pragma unroll
                for (int i = 0; i < 8; ++i) { const int jj = hb * 16 + 2 * i; const f32x2v alo = (f32x2v){A[i].x, A[i].y}, ahi = (f32x2v){A[i].z, A[i].w};
                    sa2 += S0[jj] * alo; sa3 += S0[jj + 1] * ahi;
                    if (IDENT) { sb2 += S1[jj] * alo; sb3 += S1[jj + 1] * ahi; } }
                __builtin_amdgcn_sched_barrier(0); }
            const float sa = (sa2.x + sa2.y) + (sa3.x + sa3.y), sb = (sb2.x + sb2.y) + (sb3.x + sb3.y);
            const f32x2v saa = (f32x2v){sa, sa}, sbb = (f32x2v){sb, sb}, vv = (f32x2v){cv[s], cv[s]};
            f32x2v y2 = (f32x2v){0.f, 0.f}, y3 = y2, e2 = y2, e3 = y2;
#pragma unroll
            for (int ch = 0; ch < 8; ++ch) { f32x4 W[2], Bq[2], K[2], R[2];
#pragma unroll
                for (int i = 0; i < 2; ++i) { const int j = ch * 8 + 4 * i; W[i] = *(const LAS f32x4*)(sv + j); Bq[i] = *(const LAS f32x4*)(sv + 128 + j); K[i] = *(const LAS f32x4*)(sv + 192 + j); R[i] = *(const LAS f32x4*)(sv + 256 + j); }
                __builtin_amdgcn_sched_barrier(0);
#pragma unroll
                for (int i = 0; i < 2; ++i) { const int jj = ch * 4 + 2 * i;
                    const f32x2v wlo = (f32x2v){W[i].x, W[i].y}, whi = (f32x2v){W[i].z, W[i].w}, blo = (f32x2v){Bq[i].x, Bq[i].y}, bhi = (f32x2v){Bq[i].z, Bq[i].w};
                    const f32x2v klo = (f32x2v){K[i].x, K[i].y}, khi = (f32x2v){K[i].z, K[i].w}, rlo = (f32x2v){R[i].x, R[i].y}, rhi = (f32x2v){R[i].z, R[i].w};
                    S0[jj] = S0[jj] * wlo + saa * blo + vv * klo; y2 += S0[jj] * rlo;
                    S0[jj + 1] = S0[jj + 1] * whi + saa * bhi + vv * khi; y3 += S0[jj + 1] * rhi;
                    if (IDENT) { S1[jj] = S1[jj] * wlo + sbb * blo; e2 += S1[jj] * rlo; S1[jj + 1] = S1[jj + 1] * whi + sbb * bhi; e3 += S1[jj + 1] * rhi; } }
                __builtin_amdgcn_sched_barrier(0); }
            YD[co[s]] = (y2.x + y2.y) + (y3.x + y3.y);
            if (IDENT) { const int tl = d ? (SEQ - 1 - (step0 - CTX + c * SCH + s)) : (step0 - CTX + c * SCH + s); E[(size_t)tl * 64 + lane] = f2bf((e2.x + e2.y) + (e3.x + e3.y)); }
        }
    }
    float* ZP = (float*)(P.ws + WS_ZP) + ((size_t)chain * NSEG + g) * 2 * 4096;
#pragma unroll
    for (int j = 0; j < 32; j += 2) { *(float4*)(ZP + lane * 64 + 2 * j) = make_float4(S0[j].x, S0[j].y, S0[j + 1].x, S0[j + 1].y);
        if (IDENT) *(float4*)(ZP + 4096 + lane * 64 + 2 * j) = make_float4(S1[j].x, S1[j].y, S1[j + 1].x, S1[j + 1].y); }
}
__device__ __forceinline__ void scan_combine(const Params& P, int chain, float* lds) {
    const int tid = otid(); const int i = tid >> 3, j0 = (tid & 7) * 8;
    float* Sl = lds;
    float* Pl = lds + 64 * 65;
    float* ZPc = (float*)(P.ws + WS_ZP) + (size_t)chain * NSEG * 2 * 4096;
    float sn[8];
#pragma unroll
    for (int q = 0; q < 8; ++q) sn[q] = ZPc[i * 64 + j0 + q];
    for (int g = 1; g < NSEG - 1; ++g) {
        __syncthreads();
#pragma unroll
        for (int q = 0; q < 8; ++q) Sl[i * 65 + j0 + q] = sn[q];
        const float* Pg = ZPc + (size_t)g * 2 * 4096 + 4096;
#pragma unroll
        for (int q = 0; q < 8; ++q) Pl[tid * 8 + q] = Pg[tid * 8 + q];
        float* Zg = ZPc + (size_t)g * 2 * 4096;
#pragma unroll
        for (int q = 0; q < 8; ++q) sn[q] = Zg[i * 64 + j0 + q];
        __syncthreads();
        for (int m = 0; m < 64; ++m) { const float sv = Sl[i * 65 + m]; const float4 p0 = *(const float4*)(Pl + m * 64 + j0), p1 = *(const float4*)(Pl + m * 64 + j0 + 4);
            sn[0] += sv * p0.x; sn[1] += sv * p0.y; sn[2] += sv * p0.z; sn[3] += sv * p0.w; sn[4] += sv * p1.x; sn[5] += sv * p1.y; sn[6] += sv * p1.z; sn[7] += sv * p1.w; }
#pragma unroll
        for (int q = 0; q < 8; ++q) Zg[i * 64 + j0 + q] = sn[q];
    }
    __syncthreads();
}

__device__ __forceinline__ void rwkv_out_fin(const Params& P, int row, int c, float y, float lnw, float lnb, float bon, float vs, float gt) {
    bf16_t* MIX = (bf16_t*)(P.ws + WS_U);
    const float mean = wsum(y) * (1.0f / 64.0f); const float dv = y - mean; const float var = wsum(dv * dv) * (1.0f / 64.0f);
    const float yn = dv * rsqrtf(var + 64e-5f) * lnw + lnb;
    MIX[(size_t)row * D + 256 + c] = f2bf((yn + bon * vs) * gt);
}
__device__ __forceinline__ void ph_rwkvout(const Params& P, int l, float* ldsf) {
    using pg8::bf16x8;
    const int tid = otid(), lane = tid & 63, fr = lane & 15, fq = lane >> 4, wv = tid >> 6, gw = blockIdx.x * NWAVE + wv, nw = gridDim.x * NWAVE;
    const float* YD = (const float*)(P.ws + WS_YDIR); const bf16_t* VS = (const bf16_t*)(P.ws + WS_VS); const bf16_t* GT = (const bf16_t*)(P.ws + WS_GATE); const float* BON = (const float*)(P.ws + WS_BONUS);
    bf16_t* MIX = (bf16_t*)(P.ws + WS_U);
    for (int it = gw; it < NB * 6 * 32 * 4; it += nw) {
        const int sub = it & 3, q = (it >> 2) & 31, h = (it >> 7) % 6, b = it / (128 * 6);
        const int t0 = q * 256 + sub * 64;
        f32x4 acc[4][4];
#pragma unroll
        for (int mt = 0; mt < 4; ++mt)
#pragma unroll
            for (int nt = 0; nt < 4; ++nt) acc[mt][nt] = (f32x4){0.f, 0.f, 0.f, 0.f};
#pragma unroll
        for (int dir = 0; dir < 2; ++dir) { const int ch = b * 12 + h * 2 + dir, slot = dir ? (31 - q) : q;
            const float* Sp = (const float*)(P.ws + WS_ZP) + ((size_t)ch * NSEG + slot) * 2 * 4096;
            const bf16_t* Ep = (const bf16_t*)(P.ws + WS_E) + ((size_t)ch * SEQ + t0) * 64;
#pragma unroll
            for (int ks = 0; ks < 2; ++ks) { bf16x8 bop[4];
#pragma unroll
                for (int nt = 0; nt < 4; ++nt) { const float* sp = Sp + (nt * 16 + fr) * 64 + ks * 32 + fq * 8; const float4 s0 = *(const float4*)sp, s1 = *(const float4*)(sp + 4);
                    u32x4 w; w.x = cvt_pk_bf16(s0.x, s0.y); w.y = cvt_pk_bf16(s0.z, s0.w); w.z = cvt_pk_bf16(s1.x, s1.y); w.w = cvt_pk_bf16(s1.z, s1.w); bop[nt] = __builtin_bit_cast(bf16x8, w); }
#pragma unroll
                for (int mt = 0; mt < 4; ++mt) { const bf16x8 a = *(const bf16x8*)(Ep + (size_t)(mt * 16 + fr) * 64 + ks * 32 + fq * 8);
#pragma unroll
                    for (int nt = 0; nt < 4; ++nt) acc[mt][nt] = __builtin_amdgcn_mfma_f32_16x16x32_bf16(a, bop[nt], acc[mt][nt], 0, 0, 0); } } }
        float lnw[4], lnb[4];
#pragma unroll
        for (int nt = 0; nt < 4; ++nt) { lnw[nt] = P.in[I_LNW][l * RWW + h * 64 + nt * 16 + fr]; lnb[nt] = P.in[I_LNB][l * RWW + h * 64 + nt * 16 + fr]; }
#pragma unroll
        for (int mt = 0; mt < 4; ++mt)
#pragma unroll
            for (int rg = 0; rg < 4; ++rg) { const int row = b * SEQ + t0 + mt * 16 + fq * 4 + rg; const size_t o = (size_t)row * 384 + h * 64 + fr;
                float y[4], vs[4], gt[4]; const float bon = BON[(size_t)row * 6 + h];
#pragma unroll
                for (int nt = 0; nt < 4; ++nt) { y[nt] = YD[o + nt * 16] + YD[(size_t)T * 384 + o + nt * 16] + acc[mt][nt][rg]; vs[nt] = bf2f(VS[o + nt * 16]); gt[nt] = bf2f(GT[o + nt * 16]); }
                float sm = (y[0] + y[1]) + (y[2] + y[3]);
                sm += __shfl_xor(sm, 1); sm += __shfl_xor(sm, 2); sm += __shfl_xor(sm, 4); sm += __shfl_xor(sm, 8);
                const float mean = sm * (1.0f / 64.0f);
                float vr = 0.f;
#pragma unroll
                for (int nt = 0; nt < 4; ++nt) { y[nt] -= mean; vr += y[nt] * y[nt]; }
                vr += __shfl_xor(vr, 1); vr += __shfl_xor(vr, 2); vr += __shfl_xor(vr, 4); vr += __shfl_xor(vr, 8);
                const float rstd = rsqrtf(vr * (1.0f / 64.0f) + 64e-5f);
#pragma unroll
                for (int nt = 0; nt < 4; ++nt) MIX[(size_t)row * D + 256 + h * 64 + nt * 16 + fr] = f2bf((y[nt] * rstd * lnw[nt] + lnb[nt] + bon * vs[nt]) * gt[nt]);
                if (rg & 1) asm volatile("" ::: "memory"); }
    }
    for (int it = gw; it < TC * 6; it += nw) { const int row = TL + it / 6, h = it % 6, c = h * 64 + lane; const size_t o = (size_t)row * 384 + c;
        rwkv_out_fin(P, row, c, YD[o] + YD[(size_t)T * 384 + o], P.in[I_LNW][l * RWW + c], P.in[I_LNB][l * RWW + c], BON[(size_t)row * 6 + h], bf2f(VS[o]), bf2f(GT[o])); }
}

typedef const __attribute__((address_space(4))) Params* KParamsPtr;
__device__ __forceinline__ const Params* fresh_params() { KParamsPtr q = (KParamsPtr)__builtin_amdgcn_kernarg_segment_ptr(); asm volatile("" : "+s"(q)); return (const Params*)q; }
__global__ void __launch_bounds__(NTHR, 2) fwd_megakernel(Params P_unused, int ph_lo, int ph_hi) {
    extern __shared__ __attribute__((aligned(16))) unsigned char smem[];
    cg::grid_group grid = cg::this_grid();
    LAS unsigned char* lds3 = (LAS unsigned char*)smem;
    float* ldsf = (float*)smem; float2* X = (float2*)smem; float* ex = (float*)(smem + LDS_MAIN);
    { volatile LAS unsigned* st = (volatile LAS unsigned*)(lds3 + LDS_MAIN + 4096); if (threadIdx.x == 0) { st[0] = 0u; st[1] = 0u; } }
    __syncthreads();
    XcdBarrier xbar = xcd_barrier_post((unsigned*)(((const Params*)fresh_params())->ws + WS_BAR), (volatile LAS unsigned*)(lds3 + LDS_MAIN + 4096));
    int ph = 0;
#ifndef REP_GEMM
#define REP_GEMM 1
#endif
#ifndef REP_SCAN
#define REP_SCAN 1
#endif
#ifndef REP_MISC
#define REP_MISC 1
#endif
#ifndef REP_HY
#define REP_HY 1
#endif
#define PHASE_BEGIN if (ph >= ph_lo && ph < ph_hi) { const Params& P = *fresh_params(); unsigned char* ws = P.ws; (void)ws;
#ifndef REP_SYNC
#define REP_SYNC 1
#endif
#define PHASE_END   if (ph + 1 < ph_hi) { for (int rs_ = 0; rs_ < REP_SYNC; ++rs_) { if (ph == 0) grid.sync(); else xcd_barrier(xbar); } } } ++ph;
    PHASE_BEGIN ph_modv(P, ldsf); PHASE_END
    for (int l = 0; l < DEPTH; ++l) {
        PHASE_BEGIN
            for (int rep_ = 0; rep_ < REP_MISC; ++rep_) ph_prep(P, l, ldsf);
            if (l == 0) ph_rowpass(P, 0, 0, 0, 0, 0.f, 0, 0, 0, 1, 1);
            else ph_rowpass(P, 1, l - 1, 8, 5, 0.5f, l, 0, 0, 1, 11);
        PHASE_END
        PHASE_BEGIN { EpiGU E{(bf16_t*)(ws + WS_ACT)}; for (int rep_ = 0; rep_ < REP_GEMM; ++rep_) run_gemm(lds3, (const bf16_t*)(ws + WS_U), (const bf16_t*)(ws + WS_WGU1), T, 2 * DFF, D, E); } PHASE_END
        PHASE_BEGIN { EpiF32 E{(bf16_t*)(ws + WS_Y), (float*)(ws + WS_YC)}; run_gemm_tail(lds3, (const bf16_t*)(ws + WS_ACT), (const bf16_t*)(ws + WS_WDN1), DFF, E); } PHASE_END
        PHASE_BEGIN ph_rowpass(P, 1, l, 2, 1, 0.5f, l, 2, 3, 4, 11); PHASE_END
        PHASE_BEGIN { EpiWin E{(bf16_t*)(ws + WS_PHY), (bf16_t*)(ws + WS_PRW), (bf16_t*)(ws + WS_PNA)}; for (int rep_ = 0; rep_ < REP_GEMM; ++rep_) run_gemm(lds3, (const bf16_t*)(ws + WS_U), (const bf16_t*)(ws + WS_WIN), T, INWP, D, E); } PHASE_END
        PHASE_BEGIN
            for (int rep_ = 0; rep_ < REP_MISC; ++rep_) { ph_loraprep(P, l);
            for (int it = blockIdx.x; it < NB * 128 * 6 + NB * 4 * 6; it += gridDim.x) vt_tile(P, it, (unsigned short*)smem); }
            for (int rep_ = 0; rep_ < REP_HY; ++rep_) for (int it = blockIdx.x; it < 512; it += gridDim.x) hy_spec_task(P, l, it >> 8, it & 255, X, ex);
        PHASE_END
        PHASE_BEGIN { EpiLora E{(bf16_t*)(ws + WS_LORAO), (bf16_t*)(ws + WS_GATE)};
            for (int rep_ = 0; rep_ < REP_GEMM; ++rep_) run_gemm(lds3, (const bf16_t*)(ws + WS_ALORA), (const bf16_t*)(ws + WS_WLORA), T, 2048, 384, E); } PHASE_END
        PHASE_BEGIN
            for (int rep_ = 0; rep_ < REP_MISC; ++rep_) ph_rwkvprep(P, l);
            for (int rep_ = 0; rep_ < REP_HY; ++rep_) for (int c = blockIdx.x; c < HYC; c += gridDim.x) hy_task1(P, l, c, X, ex);
        PHASE_END
        PHASE_BEGIN {
            const int wv = __builtin_amdgcn_readfirstlane(otid() >> 6);
            if (wv < 4) { const int k = wv * (int)gridDim.x + (int)blockIdx.x;
                if (k < 24 * NSEG) { const int chain = k / NSEG, g = k % NSEG; float* ring = ldsf + wv * (SCH * 320);
                    for (int rep_ = 0; rep_ < REP_SCAN; ++rep_) { if (g == 0) scan_seg<false>(P, chain, g, ring); else scan_seg<true>(P, chain, g, ring); } } }
            else for (int it = (wv - 4) * (int)gridDim.x + (int)blockIdx.x; it < NAT_TASKS; it += 4 * (int)gridDim.x) natten_task(P, l, it);
        } PHASE_END
        PHASE_BEGIN
            if (blockIdx.x < 24) scan_combine(P, blockIdx.x, ldsf);
            else for (int rep_ = 0; rep_ < REP_HY; ++rep_) for (int c = blockIdx.x - 24; c < HYC; c += gridDim.x - 24) hy_task2(P, l, c, X);
        PHASE_END
        PHASE_BEGIN for (int rep_ = 0; rep_ < REP_MISC; ++rep_) ph_rwkvout(P, l, ldsf); PHASE_END
        PHASE_BEGIN { EpiF32 E{(bf16_t*)(ws + WS_Y), (float*)(ws + WS_YC)}; run_gemm_tail(lds3, (const bf16_t*)(ws + WS_U), (const bf16_t*)(ws + WS_WOUT), D, E); } PHASE_END
        PHASE_BEGIN ph_rowpass(P, 1, l, 5, 3, 1.0f, l, 4, 6, 7, 4); PHASE_END
        PHASE_BEGIN { EpiGU E{(bf16_t*)(ws + WS_ACT)}; for (int rep_ = 0; rep_ < REP_GEMM; ++rep_) run_gemm(lds3, (const bf16_t*)(ws + WS_U), (const bf16_t*)(ws + WS_WGU2), T, 2 * DFF, D, E); } PHASE_END
        PHASE_BEGIN { EpiF32 E{(bf16_t*)(ws + WS_Y), (float*)(ws + WS_YC)}; run_gemm_tail(lds3, (const bf16_t*)(ws + WS_ACT), (const bf16_t*)(ws + WS_WDN2), DFF, E); } PHASE_END
    }
    PHASE_BEGIN ph_rowpass(P, 2, DEPTH - 1, 8, 5, 0.5f, 0, 0, 0, 0, 11); PHASE_END
#undef PHASE_BEGIN
#undef PHASE_END
}
constexpr int N_PHASES = 1 + DEPTH * 15 + 1;

extern "C" void kernel_launch(void* const* d_in, const int* in_sizes, int n_in, void* d_out, int out_size, void* d_ws, size_t ws_size, hipStream_t stream) {
    static int grid = 0;
    if (grid == 0) {
        if (n_in != 34 || ws_size < WS_END) { fprintf(stderr, "kernel_launch: need 34 inputs and %zu bytes of workspace; got %d, %zu\n", (size_t)WS_END, n_in, ws_size); grid = -1; return; }
        int dev = 0, cus = 0, per_cu = 0;
        hipGetDevice(&dev); hipDeviceGetAttribute(&cus, hipDeviceAttributeMultiprocessorCount, dev);
        if (hipFuncSetAttribute((const void*)fwd_megakernel, hipFuncAttributeMaxDynamicSharedMemorySize, LDS_BYTES) != hipSuccess) { fprintf(stderr, "kernel_launch: hipFuncSetAttribute failed\n"); grid = -1; return; }
        if (hipOccupancyMaxActiveBlocksPerMultiprocessor(&per_cu, (const void*)fwd_megakernel, NTHR, LDS_BYTES) != hipSuccess || per_cu < 1) { fprintf(stderr, "kernel_launch: occupancy query says %d\n", per_cu); per_cu = 1; }
        (void)hipGetLastError();
        grid = cus;
    }
    if (grid < 0) return;
    if (hipMemsetAsync((char*)d_ws + WS_BAR, 0, (size_t)XCD_BAR_WORDS * 4, stream) != hipSuccess) { fprintf(stderr, "kernel_launch: memset of the barrier words failed\n"); return; }
    Params p{};
    for (int i = 0; i < 34; ++i) p.in[i] = (const float*)d_in[i];
    p.out = (float*)d_out; p.ws = (unsigned char*)d_ws;
#if MK_SPLIT
    for (int ph = 0; ph < N_PHASES; ++ph) { int lo = ph, hi = ph + 1; hipLaunchKernelGGL(fwd_megakernel, dim3(grid), dim3(NTHR), LDS_BYTES, stream, p, lo, hi); }
#else
    int lo = 0, hi = N_PHASES;
    void* args[] = {&p, &lo, &hi};
    hipError_t e = hipLaunchCooperativeKernel((const void*)fwd_megakernel, dim3(grid), dim3(NTHR), args, LDS_BYTES, stream);
    if (e != hipSuccess) fprintf(stderr, "cooperative launch failed: %s (grid %d)\n", hipGetErrorString(e), grid);
#endif
}
```

```cpp
#include <hip/hip_runtime.h>
#include <hip/hip_cooperative_groups.h>
#include <cstdio>
namespace cg = cooperative_groups;
__device__ __forceinline__ int otid() { int t = threadIdx.x; asm volatile("" : "+v"(t)); return t; }
namespace pg8 {
#define PG8_LAS __attribute__((address_space(3)))
typedef unsigned short bf16_t;
typedef short bf16x8 __attribute__((ext_vector_type(8)));
typedef float f32x4 __attribute__((ext_vector_type(4)));
typedef unsigned u32x4 __attribute__((ext_vector_type(4)));
constexpr int BM = 256, BK = 64, HALF = 128, HTB = HALF * BK * 2  , STAGE_BYTES = 8 * HTB, NXCD = 8, WGM = 8;

__host__ __device__ __forceinline__ int lds_byte(int r, int c) { const int st = (r >> 4) * 2 + (c >> 5), rr = r & 15, cc = c & 31, ob = rr * 64 + cc * 2; return st * 1024 + (ob ^ (((ob >> 9) & 1) << 5)); }
__host__ __device__ __forceinline__ void stage_rc(int b, int& R, int& C) { const int st = b / 1024, sb = b % 1024, swz = sb ^ (((sb >> 9) & 1) << 5); R = (st >> 1) * 16 + swz / 64; C = (st & 1) * 32 + (swz % 64) / 2; }
__host__ __device__ __forceinline__ int perm32(int rho) { const int n = rho >> 4, i = rho & 15; return 8 * (i >> 2) + 4 * n + (i & 3); }

struct Unit { int pm, pn, kt0, nkt; };
struct Gemm { const bf16_t* A; const bf16_t* Bt; int M, N, K; };
struct StaticOrder {
    int nM, nN, nwg, G, c;
    __host__ __device__ void init(int M, int N, int G_, int c_) { nM = M / BM; nN = N / BM; nwg = nM * nN; G = G_; c = c_; }
    __host__ __device__ bool next(int i, Unit& u) const {
        const long L = (long)i * G + c; if (L >= nwg) return false;
        int wgid = (int)L; { const int q = nwg / NXCD, r = nwg % NXCD, xcd = wgid % NXCD, off = wgid / NXCD; wgid = (xcd < r ? xcd * (q + 1) : r * (q + 1) + (xcd - r) * q) + off; }
        const int nig = WGM * nN, gid = wgid / nig, fm = gid * WGM, gsz = (nM - fm) < WGM ? (nM - fm) : WGM;
        u.pm = fm + ((wgid % nig) % gsz); u.pn = (wgid % nig) / gsz; u.kt0 = 0; u.nkt = 0; return true;
    }
    __device__ __forceinline__ void a_ready(const Unit&) const {}
    __device__ __forceinline__ void done(const Unit&) const {}
};
__device__ __forceinline__ unsigned cvt_pk_bf16(float lo, float hi) { unsigned r; asm volatile("v_cvt_pk_bf16_f32 %0, %1, %2" : "=v"(r) : "v"(lo), "v"(hi)); return r; }
template <class Epi, class Sched>
__device__ __forceinline__ void gemm_phase(PG8_LAS unsigned char* lds, const Gemm g, const Sched& S, const Epi& E) {
    const int tid = otid(), wid = __builtin_amdgcn_readfirstlane(tid >> 6), lane = tid & 63, wr = wid >> 2, wc = wid & 3, fr = lane & 15, fq = lane >> 4;
    const int K = g.K, nt = K / BK;
#define PG8_STAMP() do {} while (0)
    unsigned voffA[2], voffB[2];
#pragma unroll
    for (int i = 0; i < 2; ++i) { int R, C; stage_rc(tid * 16 + i * 8192, R, C); const int Rb = Epi::PERM ? ((R & ~31) + perm32(R & 31)) : R;
        voffA[i] = (unsigned)(R * K + C) * 2u; voffB[i] = (unsigned)(Rb * K + C) * 2u; }
    const size_t kstep = (size_t)(BK * 2);
    const size_t hstep = (size_t)HALF * K * 2;
    const size_t tstep = 2 * hstep;
    const unsigned ldsw = (unsigned)wid * 1024u;
    const int aoff = lds_byte(wr * 64 + fr, fq * 8), boff = lds_byte(wc * 32 + fr, fq * 8);
#define PG8_SA(b, h) (((b) * 2 + (h)) * HTB)
#define PG8_SB(b, h) ((4 + (b) * 2 + (h)) * HTB)
#define PG8_STAGE(bufoff, gbase, voff) do { _Pragma("unroll") for (int _i = 0; _i < 2; ++_i) \
        __builtin_amdgcn_global_load_lds((const unsigned*)((const char*)(gbase) + (voff)[_i]), (PG8_LAS unsigned*)(lds + (bufoff) + ldsw + _i * 8192), 16, 0, 0); } while (0)
#define PG8_LDA(dst, b, h) do { _Pragma("unroll") for (int m = 0; m < 4; ++m) _Pragma("unroll") for (int k = 0; k < 2; ++k) dst[m][k] = *(const PG8_LAS bf16x8*)(lds + PG8_SA(b, h) + aoff + m * 2048 + k * 1024); } while (0)
#define PG8_LDB(dst, b, h) do { _Pragma("unroll") for (int n = 0; n < 2; ++n) _Pragma("unroll") for (int k = 0; k < 2; ++k) dst[n][k] = *(const PG8_LAS bf16x8*)(lds + PG8_SB(b, h) + boff + n * 2048 + k * 1024); } while (0)
#define PG8_MMA(ai, bj, At, Bt) do { __builtin_amdgcn_s_setprio(1); _Pragma("unroll") for (int m = 0; m < 4; ++m) _Pragma("unroll") for (int n = 0; n < 2; ++n) _Pragma("unroll") for (int k = 0; k < 2; ++k) \
        acc[ai][bj][m][n] = __builtin_amdgcn_mfma_f32_16x16x32_bf16(Bt[n][k], At[m][k], acc[ai][bj][m][n], 0, 0, 0); __builtin_amdgcn_s_setprio(0); } while (0)
#define PG8_WAIT_V(n) asm volatile("s_waitcnt vmcnt(" #n ")" ::: "memory")
#define PG8_WAIT_L(n) asm volatile("s_waitcnt lgkmcnt(" #n ")" ::: "memory")
#define PG8_BAR __builtin_amdgcn_s_barrier()
#define PG8_SCHED __builtin_amdgcn_sched_barrier(0)
    Unit cur, nxt; int ui = 0;
    if (!S.next(0, cur)) return;
    f32x4 acc[2][2][4][2];
#pragma unroll
    for (int a = 0; a < 2; ++a)
#pragma unroll
        for (int b = 0; b < 2; ++b)
#pragma unroll
            for (int m = 0; m < 4; ++m)
#pragma unroll
                for (int n = 0; n < 2; ++n) acc[a][b][m][n] = (f32x4){0.f, 0.f, 0.f, 0.f};
    bf16x8 At[4][2], B0[2][2], B1[2][2];
    const char* cA = (const char*)g.A + (size_t)cur.pm * tstep + (size_t)cur.kt0 * kstep; const char* cB = (const char*)g.Bt + (size_t)cur.pn * tstep + (size_t)cur.kt0 * kstep;
    int ntc = cur.nkt > 0 ? cur.nkt : nt;
    S.a_ready(cur);
    PG8_STAGE(PG8_SB(0, 0), cB, voffB); PG8_STAGE(PG8_SA(0, 0), cA, voffA); PG8_STAGE(PG8_SB(0, 1), cB + hstep, voffB); PG8_STAGE(PG8_SA(0, 1), cA + hstep, voffA);
    if (wr == 1) PG8_BAR;
    PG8_WAIT_V(4); PG8_BAR;
    PG8_STAGE(PG8_SB(1, 0), cB + kstep, voffB); PG8_STAGE(PG8_SA(1, 0), cA + kstep, voffA); PG8_STAGE(PG8_SB(1, 1), cB + hstep + kstep, voffB);
    PG8_WAIT_V(6); PG8_BAR;
    PG8_STAMP();
    for (;;) {
        const bool has_next = S.next(ui + 1, nxt);
        const char* nA = has_next ? (const char*)g.A + (size_t)nxt.pm * tstep + (size_t)nxt.kt0 * kstep : cA; const char* nB = has_next ? (const char*)g.Bt + (size_t)nxt.pn * tstep + (size_t)nxt.kt0 * kstep : cB;
        for (int t = 0; t < ntc; t += 2) {
            const bool last = (t == ntc - 2);
            const char* a1 = cA + (size_t)(t + 1) * kstep;
            const char* a2 = last ? nA : cA + (size_t)(t + 2) * kstep; const char* b2 = last ? nB : cB + (size_t)(t + 2) * kstep;
            const char* a3 = a2 + kstep; const char* b3 = b2 + kstep;
            if (last && has_next) S.a_ready(nxt);
            PG8_LDB(B0, 0, 0); PG8_SCHED; PG8_LDA(At, 0, 0); PG8_STAGE(PG8_SA(1, 1), a1 + hstep, voffA);
            PG8_WAIT_L(8); PG8_BAR; PG8_WAIT_L(0); PG8_MMA(0, 0, At, B0); PG8_BAR; PG8_SCHED;
            PG8_LDB(B1, 0, 1); PG8_STAGE(PG8_SB(0, 0), b2, voffB);
            PG8_BAR; PG8_WAIT_L(0); PG8_MMA(0, 1, At, B1); PG8_BAR;
            PG8_LDA(At, 0, 1); PG8_STAGE(PG8_SA(0, 0), a2, voffA);
            PG8_BAR; PG8_WAIT_L(0); PG8_MMA(1, 0, At, B0); PG8_BAR; PG8_SCHED;
            PG8_STAGE(PG8_SB(0, 1), b2 + hstep, voffB);
            PG8_WAIT_V(6); PG8_BAR; PG8_MMA(1, 1, At, B1); PG8_BAR;
            PG8_LDB(B0, 1, 0); PG8_SCHED; PG8_LDA(At, 1, 0); PG8_STAGE(PG8_SA(0, 1), a2 + hstep, voffA);
            PG8_WAIT_L(8); PG8_BAR; PG8_WAIT_L(0); PG8_MMA(0, 0, At, B0); PG8_BAR; PG8_SCHED;
            PG8_LDB(B1, 1, 1); PG8_STAGE(PG8_SB(1, 0), b3, voffB);
            PG8_BAR; PG8_WAIT_L(0); PG8_MMA(0, 1, At, B1); PG8_BAR;
            PG8_LDA(At, 1, 1); PG8_STAGE(PG8_SA(1, 0), a3, voffA);
            PG8_BAR; PG8_WAIT_L(0); PG8_MMA(1, 0, At, B0); PG8_BAR; PG8_SCHED;
            PG8_STAGE(PG8_SB(1, 1), b3 + hstep, voffB);
            PG8_WAIT_V(6); PG8_BAR; PG8_MMA(1, 1, At, B1); PG8_BAR;
        }
        PG8_STAMP();
        if constexpr (!Epi::AFTER_DRAIN) { E(acc, cur, wr, wc, fr, fq); S.done(cur); }
        PG8_STAMP();
        if (!has_next) break;
#pragma unroll
        for (int a = 0; a < 2; ++a)
#pragma unroll
            for (int b = 0; b < 2; ++b)
#pragma unroll
                for (int m = 0; m < 4; ++m)
#pragma unroll
                    for (int n = 0; n < 2; ++n) acc[a][b][m][n] = (f32x4){0.f, 0.f, 0.f, 0.f};
        cur = nxt; cA = nA; cB = nB; ++ui; ntc = cur.nkt > 0 ? cur.nkt : nt;
    }
    PG8_WAIT_V(0);
    if (wr == 0) PG8_BAR;
    PG8_BAR;
    if constexpr (Epi::AFTER_DRAIN) { E.fused(acc, cur, wr, wc, fr, fq, lds, wid, lane); S.done(cur); }
    PG8_STAMP();
#undef PG8_STAMP
#undef PG8_SA
#undef PG8_SB
#undef PG8_STAGE
#undef PG8_LDA
#undef PG8_LDB
#undef PG8_MMA
#undef PG8_WAIT_V
#undef PG8_WAIT_L
#undef PG8_BAR
#undef PG8_SCHED
}
}
#define LAS __attribute__((address_space(3)))
#define XB_TMO      128
#define XB_XCNT(j)  (256  + 64 * (j))
#define XB_XSUB(j)  (1280 + 64 * (j))
#define XB_XGEN(j)  (2304 + 64 * (j))
#define XB_TOP      3328
#define XB_TOPGEN   3392
#define XCD_BAR_WORDS 3456
#define XB_SPIN_CAP (1u << 18)

__device__ __forceinline__ unsigned xb_ld(unsigned* p)              { return __hip_atomic_load(p, __ATOMIC_RELAXED, __HIP_MEMORY_SCOPE_AGENT); }
__device__ __forceinline__ unsigned xb_add(unsigned* p, unsigned v) { return __hip_atomic_fetch_add(p, v, __ATOMIC_RELAXED, __HIP_MEMORY_SCOPE_AGENT); }
__device__ __forceinline__ unsigned xb_xcc_id() { return (unsigned)__builtin_amdgcn_s_getreg((3 << 11) | 20) & 0xFu; }
#define XB_SPIN(cond, bar) do { unsigned _sp = 0; while (cond) { __builtin_amdgcn_s_sleep(1); \
    if ((++_sp & 255u) == 0u) { if (xb_ld(&(bar)[XB_TMO])) break; if (_sp > XB_SPIN_CAP) { atomicAdd(&(bar)[XB_TMO], 1u); break; } } } } while (0)

struct XcdBarrier {
    unsigned* bar; unsigned x;
    volatile LAS unsigned* st;
};

__device__ __forceinline__ XcdBarrier xcd_barrier_post(unsigned* bar, volatile LAS unsigned* st) {
    XcdBarrier b; b.bar = bar; b.x = xb_xcc_id(); b.st = st;
    if (threadIdx.x == 0) (void)xb_add(&bar[XB_XCNT(b.x)], 1u);
    return b;
}
__device__ __forceinline__ void xcd_barrier_complete(unsigned* bar, unsigned x, unsigned& nloc, unsigned& nx) {
    const unsigned G = gridDim.x * gridDim.y * gridDim.z;
    unsigned sum, cnt, mine, sp = 0u;
    for (;;) {
        sum = 0u; cnt = 0u; mine = 0u;
#pragma unroll
        for (unsigned j = 0; j < 16; ++j) { const unsigned c = xb_ld(&bar[XB_XCNT(j)]); sum += c; cnt += (c > 0u) ? 1u : 0u; mine = (j == x) ? c : mine; }
        if (sum == G) break;
        __builtin_amdgcn_s_sleep(1);
        if ((++sp & 255u) == 0u) { if (xb_ld(&bar[XB_TMO])) break; if (sp > XB_SPIN_CAP) { atomicAdd(&bar[XB_TMO], 1u); break; } }
    }
    nloc = mine > 0u ? mine : 1u; nx = cnt > 0u ? cnt : 1u;
}

__device__ __forceinline__ void xcd_barrier(const XcdBarrier& b) {
    asm volatile("s_waitcnt vmcnt(0)" ::: "memory");
    __syncthreads();
    if (threadIdx.x == 0) {
        unsigned* bar = b.bar;
        __builtin_amdgcn_s_waitcnt(0);
        unsigned nloc = b.st[0], nx = b.st[1];
        if (nloc == 0u) { xcd_barrier_complete(bar, b.x, nloc, nx); b.st[0] = nloc; b.st[1] = nx; }
        const unsigned old = xb_add(&bar[XB_XSUB(b.x)], 1u);
        const unsigned gen = old / nloc;
        if (old + 1u == (gen + 1u) * nloc) {
            __builtin_amdgcn_fence(__ATOMIC_RELEASE, "agent");
            asm volatile("s_waitcnt vmcnt(0)" ::: "memory");
            const unsigned og = xb_add(&bar[XB_TOP], 1u);
            const unsigned tg = og / nx;
            if (og + 1u == (tg + 1u) * nx) xb_add(&bar[XB_TOPGEN], 1u);
            else XB_SPIN(xb_ld(&bar[XB_TOPGEN]) == tg, bar);
            __builtin_amdgcn_fence(__ATOMIC_ACQUIRE, "agent");
            xb_add(&bar[XB_XGEN(b.x)], 1u);
            asm volatile("s_waitcnt vmcnt(0)" ::: "memory");
        } else {
            XB_SPIN(xb_ld(&bar[XB_XGEN(b.x)]) == gen, bar);
            __builtin_amdgcn_fence(__ATOMIC_ACQUIRE, "agent");
            asm volatile("s_waitcnt vmcnt(0)" ::: "memory");
        }
    }
    __syncthreads();
}

using pg8::bf16_t; using pg8::f32x4; using pg8::u32x4; using pg8::cvt_pk_bf16;
typedef unsigned u32x2 __attribute__((ext_vector_type(2)));


constexpr int D = 1024, NB = 2, SEQ = 8192, DEPTH = 4, CTX = 256, DFF = 2816;
constexpr int TL = NB * SEQ, TC = NB * CTX, T = TL + TC;
constexpr int NMOD = 9 * D;
constexpr int HYC = 256, RWW = 384, NAW = 384, INW = 3456, INWP = 3584;
constexpr int HY_IN = 768, RW_IN = 1536, NA_IN = 1152;
constexpr int NFFT = 16384;
constexpr int NTHR = 512, NWAVE = 8;
constexpr int LDS_MAIN = 131072, LDS_EXTRA = 8192, LDS_BYTES = LDS_MAIN + LDS_EXTRA;
constexpr float NORM_EPS = 1e-6f;

constexpr size_t al256(size_t x) { return (x + 255) & ~(size_t)255; }
constexpr size_t WS_MODV = 0;
constexpr size_t WS_WGU1 = al256(WS_MODV + (size_t)DEPTH * 3 * NMOD * 4);
constexpr size_t WS_WDN1 = WS_WGU1 + (size_t)2 * DFF * D * 2;
constexpr size_t WS_WGU2 = WS_WDN1 + (size_t)D * DFF * 2;
constexpr size_t WS_WDN2 = WS_WGU2 + (size_t)2 * DFF * D * 2;
constexpr size_t WS_WIN = WS_WDN2 + (size_t)D * DFF * 2;
constexpr size_t WS_WOUT = WS_WIN + (size_t)INWP * D * 2;
constexpr size_t WS_WLORA = WS_WOUT + (size_t)D * D * 2;
constexpr size_t WS_H = WS_WLORA + (size_t)2048 * 384 * 2;
constexpr size_t WS_U = WS_H + (size_t)T * D * 4;
constexpr size_t WS_S = WS_U + (size_t)T * D * 2;
constexpr size_t WS_Y = WS_S;
constexpr size_t WS_ACT = WS_Y + (size_t)T * D * 4;
constexpr size_t WS_FFN_END = WS_ACT + (size_t)T * DFF * 2;
constexpr size_t WS_PHY = WS_S;
constexpr size_t WS_PRW = WS_PHY + (size_t)T * HY_IN * 2;
constexpr size_t WS_YDIR = WS_PRW;
constexpr size_t WS_PNA = WS_PRW + (size_t)T * RW_IN * 2;
constexpr size_t WS_ALORA = WS_PNA + (size_t)T * NA_IN * 2;
constexpr size_t WS_DECAY = WS_ALORA + (size_t)T * 384 * 2;
constexpr size_t WS_LORAO = WS_DECAY + (size_t)2 * T * 384 * 4;
constexpr size_t WS_E = WS_LORAO;
constexpr size_t WS_ZP = WS_E + (size_t)24 * SEQ * 64 * 2;
constexpr size_t WS_GATE = WS_LORAO + (size_t)T * 1536 * 2;
static_assert(WS_ZP + (size_t)24 * 33 * 2 * 4096 * 4 <= WS_GATE, "E + ZP must fit in the LORAO region");
constexpr size_t WS_RS = WS_GATE + (size_t)T * 384 * 2;
constexpr size_t WS_KKS = WS_RS + (size_t)T * 384 * 2;
constexpr size_t WS_VS = WS_KKS + (size_t)T * 384 * 2;
constexpr size_t WS_KS = WS_VS + (size_t)T * 384 * 2;
constexpr size_t WS_BS = WS_KS + (size_t)2 * T * 384 * 2;
constexpr size_t WS_BONUS = WS_BS + (size_t)2 * T * 384 * 2;
constexpr size_t WS_FILT = al256(WS_BONUS + (size_t)T * 6 * 4);
constexpr size_t WS_FILTC = WS_FILT + (size_t)1024 * SEQ * 2;
constexpr size_t WS_SPEC = WS_FILTC + (size_t)1024 * CTX * 2;
constexpr size_t WS_Z1 = WS_SPEC + (size_t)512 * NFFT * 8;
constexpr size_t WS_VTL = WS_Z1 + (size_t)HYC * NB * SEQ * 4;
constexpr size_t WS_VTC = WS_VTL + (size_t)NB * 6 * 64 * SEQ * 2;
constexpr size_t WS_MIX_END = WS_VTC + (size_t)NB * 6 * 64 * CTX * 2;
constexpr size_t WS_BAR = al256(WS_MIX_END > WS_FFN_END ? WS_MIX_END : WS_FFN_END);
constexpr size_t WS_ROPE = al256(WS_BAR + (size_t)XCD_BAR_WORDS * 4);
constexpr size_t WS_YC = WS_FFN_END + (size_t)(8 << 20);
static_assert(WS_YC + (size_t)11 * TC * D * 4 <= WS_FILT, "YC partials must stay below the filter tables");
constexpr size_t WS_END = WS_ROPE + (size_t)128 * 16 * 8;
static_assert(WS_END <= (size_t)4 * DEPTH * D * NMOD * 4, "workspace map exceeds 4x the largest input tensor");

struct Params { const float* in[34]; float* out; unsigned char* ws; };
enum { I_X = 0, I_C, I_CTX, I_CCTX, I_MODW, I_MODB, I_NORMG, I_F1GU, I_F1DN, I_F2GU, I_F2DN, I_WIN, I_WOUT, I_HCW, I_HCB, I_HW1, I_HB1, I_HW2, I_HB2, I_HW3, I_HFREQ, I_HBIAS,
       I_MU, I_W0, I_W2, I_A0, I_A2, I_G2, I_KK, I_KA, I_RK, I_LNW, I_LNB, I_RPB };

typedef LAS float* ldsfp;
__device__ __forceinline__ ldsfp vlds(const void* p) { ldsfp q = (ldsfp)p; asm volatile("" : "+v"(q)); return q; }
__device__ __forceinline__ float bf2f(bf16_t b) { return __uint_as_float(((unsigned)b) << 16); }
__device__ __forceinline__ bf16_t f2bf(float f) { unsigned u = __float_as_uint(f); u += 0x7FFFu + ((u >> 16) & 1u); return (bf16_t)(u >> 16); }
__device__ __forceinline__ float lo_bf(unsigned w) { return __uint_as_float(w << 16); }
__device__ __forceinline__ float hi_bf(unsigned w) { return __uint_as_float(w & 0xffff0000u); }
__device__ __forceinline__ float wsum(float v) {
#pragma unroll
    for (int o = 32; o > 0; o >>= 1) v += __shfl_xor(v, o);
    return v;
}
__device__ __forceinline__ float sigmoidf_(float x) { return __builtin_amdgcn_rcpf(1.0f + __expf(-x)); }
__device__ __forceinline__ void unpack8(const u32x4 w, float (&f)[8]) {
    f[0] = lo_bf(w.x); f[1] = hi_bf(w.x); f[2] = lo_bf(w.y); f[3] = hi_bf(w.y); f[4] = lo_bf(w.z); f[5] = hi_bf(w.z); f[6] = lo_bf(w.w); f[7] = hi_bf(w.w);
}
__device__ __forceinline__ void row_nbrs(int row, bool& hasp, bool& hasn) {
    if (row < TL) { const int t = row & (SEQ - 1); hasp = t > 0; hasn = t < SEQ - 1; }
    else { const int t = (row - TL) & (CTX - 1); hasp = t > 0; hasn = t < CTX - 1; }
}

__device__ __forceinline__ void ph_modv(const Params& P, float* lds) {
    const int tid = otid();
    float* sv = lds;
    float* red = lds + 3072;
    for (int i = tid; i < 3072; i += NTHR) { const int s = i >> 10, k = i & 1023; const float c = s < 2 ? P.in[I_C][s * 1024 + k] : P.in[I_CCTX][k]; sv[i] = c / (1.0f + expf(-c)); }
    __syncthreads();
    if (blockIdx.x < 4) { const int e = blockIdx.x * NTHR + tid, pos = e >> 4, f = e & 15; float sn, cs; sincosf((float)pos * expf(-(float)f * (9.210340371976184f / 16.0f)), &sn, &cs); ((float2*)(P.ws + WS_ROPE))[e] = make_float2(cs, sn); }
    float* modv = (float*)(P.ws + WS_MODV);
    const int kc = tid >> 6, cl = tid & 63;
    for (int item = blockIdx.x; item < DEPTH * 144; item += gridDim.x) {
        const int l = item / 144, cb = item % 144, col = cb * 64 + cl;
        const float* w = P.in[I_MODW] + ((size_t)l * 1024 + kc * 128) * NMOD + col;
        float a0 = 0.f, a1 = 0.f, a2 = 0.f;
#pragma unroll 8
        for (int k = 0; k < 128; ++k) { const float wv = w[(size_t)k * NMOD]; a0 += sv[kc * 128 + k] * wv; a1 += sv[1024 + kc * 128 + k] * wv; a2 += sv[2048 + kc * 128 + k] * wv; }
        red[(0 * 8 + kc) * 64 + cl] = a0; red[(1 * 8 + kc) * 64 + cl] = a1; red[(2 * 8 + kc) * 64 + cl] = a2;
        __syncthreads();
        if (tid < 192) { const int s = tid >> 6, c = tid & 63; float r = P.in[I_MODB][l * NMOD + cb * 64 + c];
#pragma unroll
            for (int q = 0; q < 8; ++q) r += red[(s * 8 + q) * 64 + c];
            modv[((size_t)l * 3 + s) * NMOD + cb * 64 + c] = r; }
        __syncthreads();
    }
}

__device__ __forceinline__ float hy_delta(int c);
__device__ __forceinline__ int rowmap_gu(int n) { const int up = n >= DFF ? 1 : 0; const int j = n - up * DFF; return (j >> 7) * 256 + up * 128 + (j & 127); }
__device__ __forceinline__ void conv_tile(const float* __restrict__ src, int K, int N, bf16_t* __restrict__ dst, int tk, int tn, bool gu, float* tile) {
    const int tid = otid(); const int k0 = tk * 64, n0 = tn * 64;
#pragma unroll
    for (int rr = 0; rr < 2; ++rr) { const int kk = (tid >> 4) + rr * 32, n4 = (tid & 15) * 4; const float4 v = *(const float4*)(src + (size_t)(k0 + kk) * N + n0 + n4);
        tile[kk * 65 + n4 + 0] = v.x; tile[kk * 65 + n4 + 1] = v.y; tile[kk * 65 + n4 + 2] = v.z; tile[kk * 65 + n4 + 3] = v.w; }
    __syncthreads();
    { const int nn = tid >> 3, ks = (tid & 7) * 8; const int n = n0 + nn; const int row = gu ? rowmap_gu(n) : n;
      u32x4 w; w.x = cvt_pk_bf16(tile[(ks + 0) * 65 + nn], tile[(ks + 1) * 65 + nn]); w.y = cvt_pk_bf16(tile[(ks + 2) * 65 + nn], tile[(ks + 3) * 65 + nn]);
      w.z = cvt_pk_bf16(tile[(ks + 4) * 65 + nn], tile[(ks + 5) * 65 + nn]); w.w = cvt_pk_bf16(tile[(ks + 6) * 65 + nn], tile[(ks + 7) * 65 + nn]);
      *(u32x4*)(dst + (size_t)row * K + k0 + ks) = w; }
    __syncthreads();
}
__device__ __forceinline__ void ph_prep(const Params& P, int l, float* lds) {
    const int tid = otid();
    unsigned char* ws = P.ws;
    constexpr int N0 = 16 * 88, N1 = 44 * 16, N4 = 16 * 54, N5 = 16 * 16;
    constexpr int C0 = N0, C1 = C0 + N1, C2 = C1 + N0, C3 = C2 + N1, C4 = C3 + N4, C5 = C4 + N5;
    for (int it = blockIdx.x; it < C5; it += gridDim.x) {
        if (it < C0) { conv_tile(P.in[I_F1GU] + (size_t)l * D * 2 * DFF, D, 2 * DFF, (bf16_t*)(ws + WS_WGU1), it / 88, it % 88, true, lds); }
        else if (it < C1) { const int j = it - C0; conv_tile(P.in[I_F1DN] + (size_t)l * DFF * D, DFF, D, (bf16_t*)(ws + WS_WDN1), j / 16, j % 16, false, lds); }
        else if (it < C2) { const int j = it - C1; conv_tile(P.in[I_F2GU] + (size_t)l * D * 2 * DFF, D, 2 * DFF, (bf16_t*)(ws + WS_WGU2), j / 88, j % 88, true, lds); }
        else if (it < C3) { const int j = it - C2; conv_tile(P.in[I_F2DN] + (size_t)l * DFF * D, DFF, D, (bf16_t*)(ws + WS_WDN2), j / 16, j % 16, false, lds); }
        else if (it < C4) { const int j = it - C3; conv_tile(P.in[I_WIN] + (size_t)l * D * INW, D, INW, (bf16_t*)(ws + WS_WIN), j / 54, j % 54, false, lds); }
        else { const int j = it - C4; conv_tile(P.in[I_WOUT] + (size_t)l * D * D, D, D, (bf16_t*)(ws + WS_WOUT), j / 16, j % 16, false, lds); }
    }
    const int gtid = blockIdx.x * NTHR + tid, gn = gridDim.x * NTHR;
    { unsigned* z = (unsigned*)(ws + WS_WIN + (size_t)INW * D * 2); for (int i = gtid; i < (INWP - INW) * D / 2; i += gn) z[i] = 0u; }
    { bf16_t* wl = (bf16_t*)(ws + WS_WLORA);
      const float* w2 = P.in[I_W2] + (size_t)l * 2 * 64 * RWW; const float* a2 = P.in[I_A2] + (size_t)l * 2 * 64 * RWW; const float* g2 = P.in[I_G2] + (size_t)l * 128 * RWW;
      for (int i = gtid; i < 2048 * 384; i += gn) { const int k = i / 2048, j = i % 2048; float v = 0.f;
          if (j < 1920) { const int grp = j / 384, c = j % 384;
              if (grp == 0) { if (k < 64) v = w2[(size_t)k * RWW + c]; }
              else if (grp == 1) { if (k >= 64 && k < 128) v = w2[(size_t)(64 + k - 64) * RWW + c]; }
              else if (grp == 2) { if (k >= 128 && k < 192) v = a2[(size_t)(k - 128) * RWW + c]; }
              else if (grp == 3) { if (k >= 192 && k < 256) v = a2[(size_t)(64 + k - 192) * RWW + c]; }
              else { if (k >= 256) v = g2[(size_t)(k - 256) * RWW + c]; } }
          wl[(size_t)j * 384 + k] = f2bf(v); } }
    { const float* w1_ = P.in[I_HW1] + (size_t)l * 33 * 64; const float* b1 = P.in[I_HB1] + l * 64; const float* w2f_ = P.in[I_HW2] + (size_t)l * 64 * 64; const float* b2 = P.in[I_HB2] + l * 64;
      const float* fqv = P.in[I_HFREQ] + l * 64; const float* w3 = P.in[I_HW3] + (size_t)l * 64 * 1024;
      const int lane = tid & 63, wv = tid >> 6;
      const float fq = fqv[lane], bb1 = b1[lane], bb2 = b2[lane];
      const ldsfp hl = vlds(lds);
      for (int task = blockIdx.x; task < 264; task += gridDim.x) {
          const int L = task < 256 ? SEQ : CTX, n0 = task < 256 ? task * 32 : (task - 256) * 32;
          __syncthreads();
#pragma unroll 1
          for (int pp = 0; pp < 4; ++pp) { const int p = wv * 4 + pp, pos = n0 + p;
              const float* w1 = w1_; const float* w2f = w2f_; asm volatile("" : "+s"(w1), "+s"(w2f));
              const float tt = (float)pos / (float)(L - 1);
              const float ang = 6.283185307179586f * (float)pos / (float)L;
              float z = 0.f;
              if (lane == 0) z = tt;
              else if (lane <= 16) { const float fr = 1e-4f + (float)(lane - 1) * ((15.0f - 1e-4f) / 15.0f); z = cosf(fr * ang); }
              else if (lane <= 32) { const float fr = 1e-4f + (float)(lane - 17) * ((15.0f - 1e-4f) / 15.0f); z = -sinf(fr * ang); }
              float a = bb1;
#pragma unroll
              for (int e = 0; e < 33; ++e) a += __shfl(z, e) * w1[e * 64 + lane];
              const float h1 = sinf(fq * a);
              float c = bb2;
#pragma unroll
              for (int i = 0; i < 64; ++i) c += __shfl(h1, i) * w2f[i * 64 + lane];
              hl[lane * 32 + p] = sinf(fq * c); }
          __syncthreads();
          float acc0[32], acc1[32];
#pragma unroll
          for (int p = 0; p < 32; ++p) { acc0[p] = 0.f; acc1[p] = 0.f; }
#pragma unroll 2
          for (int i = 0; i < 64; ++i) { const float wa = w3[(size_t)i * 1024 + tid], wb = w3[(size_t)i * 1024 + 512 + tid];
#pragma unroll
              for (int p4 = 0; p4 < 8; ++p4) { const f32x4 hv = *(const LAS f32x4*)(hl + i * 32 + p4 * 4);
                  acc0[p4 * 4 + 0] += hv.x * wa; acc0[p4 * 4 + 1] += hv.y * wa; acc0[p4 * 4 + 2] += hv.z * wa; acc0[p4 * 4 + 3] += hv.w * wa;
                  acc1[p4 * 4 + 0] += hv.x * wb; acc1[p4 * 4 + 1] += hv.y * wb; acc1[p4 * 4 + 2] += hv.z * wb; acc1[p4 * 4 + 3] += hv.w * wb; } }
          const float dl = hy_delta(tid & 255), sc = task < 256 ? (1.0f / NFFT) : 1.0f, invL = 1.0f / (float)(L - 1);
          bf16_t* dst = task < 256 ? (bf16_t*)(ws + WS_FILT) + (size_t)tid * SEQ + n0 : (bf16_t*)(ws + WS_FILTC) + (size_t)tid * CTX + n0;
          const size_t cstep = task < 256 ? (size_t)512 * SEQ : (size_t)512 * CTX;
#pragma unroll
          for (int p8 = 0; p8 < 4; ++p8) { float d[8];
#pragma unroll
              for (int k = 0; k < 8; ++k) d[k] = __expf(-((float)(n0 + p8 * 8 + k) * invL) * dl) * sc;
              u32x4 w; w.x = cvt_pk_bf16(acc0[p8 * 8 + 0] * d[0], acc0[p8 * 8 + 1] * d[1]); w.y = cvt_pk_bf16(acc0[p8 * 8 + 2] * d[2], acc0[p8 * 8 + 3] * d[3]);
              w.z = cvt_pk_bf16(acc0[p8 * 8 + 4] * d[4], acc0[p8 * 8 + 5] * d[5]); w.w = cvt_pk_bf16(acc0[p8 * 8 + 6] * d[6], acc0[p8 * 8 + 7] * d[7]);
              *(u32x4*)(dst + p8 * 8) = w;
              w.x = cvt_pk_bf16(acc1[p8 * 8 + 0] * d[0], acc1[p8 * 8 + 1] * d[1]); w.y = cvt_pk_bf16(acc1[p8 * 8 + 2] * d[2], acc1[p8 * 8 + 3] * d[3]);
              w.z = cvt_pk_bf16(acc1[p8 * 8 + 4] * d[4], acc1[p8 * 8 + 5] * d[5]); w.w = cvt_pk_bf16(acc1[p8 * 8 + 6] * d[6], acc1[p8 * 8 + 7] * d[7]);
              *(u32x4*)(dst + cstep + p8 * 8) = w; }
      }
      __syncthreads(); }
}

__device__ __forceinline__ void ph_rowpass(const Params& P, int mode, int lpost, int gate_i, int gpost_i, float ps, int lpre, int gpre_i, int shift_i, int scale_i, int nsplit) {
    const int tid = otid(), lane = tid & 63, gw = blockIdx.x * NWAVE + (tid >> 6), nw = gridDim.x * NWAVE;
    const float* modv = (const float*)(P.ws + WS_MODV);
    float* H = (float*)(P.ws + WS_H); const bf16_t* Y = (const bf16_t*)(P.ws + WS_Y); bf16_t* U = (bf16_t*)(P.ws + WS_U);
    int cur_s = -1;
    float4 A[4], Bv[4], Cv[4];
#pragma unroll
    for (int j = 0; j < 4; ++j) { A[j] = make_float4(0.f, 0.f, 0.f, 0.f); Bv[j] = A[j]; Cv[j] = A[j]; }
    for (int row = gw; row < T; row += nw) {
        const int s = row < SEQ ? 0 : (row < TL ? 1 : 2);
        if (s != cur_s) { cur_s = s;
#pragma unroll
            for (int j = 0; j < 4; ++j) { const int e = lane * 4 + 256 * j;
                if (mode != 0) { const float4 g = *(const float4*)(modv + ((size_t)lpost * 3 + s) * NMOD + gate_i * D + e); const float4 gp = *(const float4*)(P.in[I_NORMG] + ((size_t)lpost * 6 + gpost_i) * D + e);
                    A[j] = make_float4(ps * g.x * gp.x, ps * g.y * gp.y, ps * g.z * gp.z, ps * g.w * gp.w); }
                if (mode != 2) { const float4 sc = *(const float4*)(modv + ((size_t)lpre * 3 + s) * NMOD + scale_i * D + e); const float4 gq = *(const float4*)(P.in[I_NORMG] + ((size_t)lpre * 6 + gpre_i) * D + e);
                    Bv[j] = make_float4(gq.x * (1.f + sc.x), gq.y * (1.f + sc.y), gq.z * (1.f + sc.z), gq.w * (1.f + sc.w));
                    Cv[j] = *(const float4*)(modv + ((size_t)lpre * 3 + s) * NMOD + shift_i * D + e); } } }
        float4 h[4];
        if (mode == 0) { const float* src = row < TL ? P.in[I_X] + (size_t)row * D : P.in[I_CTX] + (size_t)(row - TL) * D;
#pragma unroll
            for (int j = 0; j < 4; ++j) h[j] = *(const float4*)(src + lane * 4 + 256 * j);
        } else {
            float4 y[4]; float ss = 0.f;
#pragma unroll
            for (int j = 0; j < 4; ++j) { h[j] = *(const float4*)(H + (size_t)row * D + lane * 4 + 256 * j); if (row < TL) { const u32x2 yw = *(const u32x2*)(Y + (size_t)row * D + lane * 4 + 256 * j); y[j] = make_float4(lo_bf(yw.x), hi_bf(yw.x), lo_bf(yw.y), hi_bf(yw.y)); } else { const float* yp = (const float*)(P.ws + WS_YC) + (size_t)(row - TL) * D + lane * 4 + 256 * j; float4 a = *(const float4*)yp;
                    for (int q = 1; q < nsplit; ++q) { const float4 b4 = *(const float4*)(yp + (size_t)q * TC * D); a.x += b4.x; a.y += b4.y; a.z += b4.z; a.w += b4.w; } y[j] = a; }
                ss += y[j].x * y[j].x + y[j].y * y[j].y + y[j].z * y[j].z + y[j].w * y[j].w; }
            ss = wsum(ss); const float r = rsqrtf(ss * (1.0f / D) + NORM_EPS);
#pragma unroll
            for (int j = 0; j < 4; ++j) { h[j].x += A[j].x * (y[j].x * r); h[j].y += A[j].y * (y[j].y * r); h[j].z += A[j].z * (y[j].z * r); h[j].w += A[j].w * (y[j].w * r); }
        }
        if (mode == 2) { if (row < TL) {
#pragma unroll
                for (int j = 0; j < 4; ++j) *(float4*)(P.out + (size_t)row * D + lane * 4 + 256 * j) = h[j]; }
            continue; }
        float s2 = 0.f;
#pragma unroll
        for (int j = 0; j < 4; ++j) { *(float4*)(H + (size_t)row * D + lane * 4 + 256 * j) = h[j]; s2 += h[j].x * h[j].x + h[j].y * h[j].y + h[j].z * h[j].z + h[j].w * h[j].w; }
        s2 = wsum(s2); const float r2 = rsqrtf(s2 * (1.0f / D) + NORM_EPS);
#pragma unroll
        for (int j = 0; j < 4; ++j) { u32x2 w; w.x = cvt_pk_bf16(h[j].x * r2 * Bv[j].x + Cv[j].x, h[j].y * r2 * Bv[j].y + Cv[j].y); w.y = cvt_pk_bf16(h[j].z * r2 * Bv[j].z + Cv[j].z, h[j].w * r2 * Bv[j].w + Cv[j].w);
            *(u32x2*)(U + (size_t)row * D + lane * 4 + 256 * j) = w; }
    }
}

struct EpiGU {
    static constexpr bool PERM = true, AFTER_DRAIN = false;
    bf16_t* O;
    __device__ __forceinline__ void operator()(const f32x4 (&acc)[2][2][4][2], const pg8::Unit& u, int wr, int wc, int fr, int fq) const {
        const int row0 = u.pm * 256 + wr * 64 + fr, col0 = u.pn * 128 + wc * 32 + 8 * fq;
#pragma unroll
        for (int ai = 0; ai < 2; ++ai)
#pragma unroll
            for (int m = 0; m < 4; ++m) { float o[8];
#pragma unroll
                for (int n = 0; n < 2; ++n)
#pragma unroll
                    for (int j = 0; j < 4; ++j) { const float g = acc[ai][0][m][n][j], up = acc[ai][1][m][n][j]; o[n * 4 + j] = g * __builtin_amdgcn_rcpf(1.0f + __expf(-g)) * up; }
                u32x4 w; w.x = cvt_pk_bf16(o[0], o[1]); w.y = cvt_pk_bf16(o[2], o[3]); w.z = cvt_pk_bf16(o[4], o[5]); w.w = cvt_pk_bf16(o[6], o[7]);
                *(u32x4*)(O + (size_t)(row0 + ai * 128 + m * 16) * DFF + col0) = w; }
    }
};

struct TailOrder {
    int nsplit, kp, G, c;
    __device__ void init(int K, int KP, int G_, int c_) { kp = KP; nsplit = (K / 64) / KP; G = G_; c = c_; }
    __device__ bool next(int i, pg8::Unit& u) const {
        const long L = (long)i * G + c;
        if (L < 256) { int wgid = (int)L; { const int q = 256 / 8, xcd = wgid % 8, off = wgid / 8; wgid = xcd * q + off; }
            const int nig = 8 * 4, gid = wgid / nig, fm = gid * 8; u.pm = fm + ((wgid % nig) % 8); u.pn = (wgid % nig) / 8; u.kt0 = 0; u.nkt = 0; return true; }
        const int L2 = (int)(L - 256); if (L2 >= 8 * nsplit) return false;
        const int tile = L2 / nsplit, ks = L2 % nsplit; u.pm = 64 + (tile >> 2); u.pn = tile & 3; u.kt0 = ks * kp; u.nkt = kp; return true;
    }
    __device__ __forceinline__ void a_ready(const pg8::Unit&) const {}
    __device__ __forceinline__ void done(const pg8::Unit&) const {}
};
struct EpiF32 {
    static constexpr bool PERM = true, AFTER_DRAIN = false;
    bf16_t* C; float* YC;
    __device__ __forceinline__ void operator()(const f32x4 (&acc)[2][2][4][2], const pg8::Unit& u, int wr, int wc, int fr, int fq) const {
        const int row0 = u.pm * 256 + wr * 64 + fr, col0 = u.pn * 256 + wc * 32 + 8 * fq;
        if (u.pm < 64) {
#pragma unroll
            for (int ai = 0; ai < 2; ++ai)
#pragma unroll
                for (int m = 0; m < 4; ++m) { bf16_t* rowp = C + (size_t)(row0 + ai * 128 + m * 16) * D + col0;
#pragma unroll
                    for (int bj = 0; bj < 2; ++bj) { const f32x4 v0 = acc[ai][bj][m][0], v1 = acc[ai][bj][m][1];
                        u32x4 w; w.x = cvt_pk_bf16(v0[0], v0[1]); w.y = cvt_pk_bf16(v0[2], v0[3]); w.z = cvt_pk_bf16(v1[0], v1[1]); w.w = cvt_pk_bf16(v1[2], v1[3]);
                        *(u32x4*)(rowp + bj * 128) = w; } }
        } else { float* base = YC + (size_t)(u.kt0 >> 2) * TC * D;
#pragma unroll
            for (int ai = 0; ai < 2; ++ai)
#pragma unroll
                for (int m = 0; m < 4; ++m) { float* rowp = base + (size_t)(row0 - TL + ai * 128 + m * 16) * D + col0;
#pragma unroll
                    for (int bj = 0; bj < 2; ++bj)
#pragma unroll
                        for (int n = 0; n < 2; ++n) *(f32x4*)(rowp + bj * 128 + n * 4) = acc[ai][bj][m][n]; }
        }
    }
};
template <class Epi> __device__ __forceinline__ void run_gemm_tail(LAS unsigned char* lds, const bf16_t* A, const bf16_t* Bt, int K, const Epi& E) {
    asm volatile("" : "+s"(K));
    pg8::Gemm g{A, Bt, T, D, K}; TailOrder S; S.init(K, 4, (int)gridDim.x, (int)blockIdx.x);
    pg8::gemm_phase<Epi, TailOrder>(lds, g, S, E);
    __syncthreads();
}
__device__ __forceinline__ void zero_yc(const Params& P) { float4* z = (float4*)(P.ws + WS_YC); for (int i = blockIdx.x * NTHR + otid(); i < TC * D / 4; i += gridDim.x * NTHR) z[i] = make_float4(0.f, 0.f, 0.f, 0.f); }
struct EpiWin {
    static constexpr bool PERM = true, AFTER_DRAIN = false;
    bf16_t* PHYT; bf16_t* PRW; bf16_t* PNA;
    __device__ __forceinline__ void operator()(const f32x4 (&acc)[2][2][4][2], const pg8::Unit& u, int wr, int wc, int fr, int fq) const {
        const int row0 = u.pm * 256 + wr * 64 + fr;
        if (u.pn < 3) {
#pragma unroll
            for (int bj = 0; bj < 2; ++bj) { bf16_t* cp = PHYT + (size_t)(u.pn * 256 + bj * 128 + wc * 32 + 8 * fq) * T + row0;
#pragma unroll
                for (int ai = 0; ai < 2; ++ai)
#pragma unroll
                    for (int m = 0; m < 4; ++m) { const f32x4 v0 = acc[ai][bj][m][0], v1 = acc[ai][bj][m][1]; bf16_t* rp = cp + ai * 128 + m * 16;
                        const unsigned w0 = cvt_pk_bf16(v0[0], v0[1]), w1 = cvt_pk_bf16(v0[2], v0[3]), w2 = cvt_pk_bf16(v1[0], v1[1]), w3 = cvt_pk_bf16(v1[2], v1[3]);
                        rp[0] = (bf16_t)w0; rp[(size_t)T] = (bf16_t)(w0 >> 16); rp[(size_t)2 * T] = (bf16_t)w1; rp[(size_t)3 * T] = (bf16_t)(w1 >> 16);
                        rp[(size_t)4 * T] = (bf16_t)w2; rp[(size_t)5 * T] = (bf16_t)(w2 >> 16); rp[(size_t)6 * T] = (bf16_t)w3; rp[(size_t)7 * T] = (bf16_t)(w3 >> 16); } }
            return; }
        bf16_t* base; int ld, cbase;
        if (u.pn < 9) { base = PRW; ld = RW_IN; cbase = u.pn * 256 - HY_IN; }
        else { base = PNA; ld = NA_IN; cbase = u.pn * 256 - HY_IN - RW_IN; }
        const int nbj = (u.pn == 13) ? 1 : 2;
#pragma unroll
        for (int ai = 0; ai < 2; ++ai)
#pragma unroll
            for (int m = 0; m < 4; ++m)
#pragma unroll
                for (int bj = 0; bj < 2; ++bj) { if (bj < nbj) { const f32x4 v0 = acc[ai][bj][m][0], v1 = acc[ai][bj][m][1];
                    u32x4 w; w.x = cvt_pk_bf16(v0[0], v0[1]); w.y = cvt_pk_bf16(v0[2], v0[3]); w.z = cvt_pk_bf16(v1[0], v1[1]); w.w = cvt_pk_bf16(v1[2], v1[3]);
                    *(u32x4*)(base + (size_t)(row0 + ai * 128 + m * 16) * ld + cbase + bj * 128 + wc * 32 + 8 * fq) = w; } }
    }
};
struct EpiLora {
    static constexpr bool PERM = true, AFTER_DRAIN = false;
    bf16_t* LO; bf16_t* GATE;
    __device__ __forceinline__ void operator()(const f32x4 (&acc)[2][2][4][2], const pg8::Unit& u, int wr, int wc, int fr, int fq) const {
        const int row0 = u.pm * 256 + wr * 64 + fr;
        bf16_t* base; int ld, cbase;
        if (u.pn < 6) { base = LO; ld = 1536; cbase = u.pn * 256; } else { base = GATE; ld = 384; cbase = u.pn * 256 - 1536; }
        const int nbj = (u.pn == 7) ? 1 : 2;
#pragma unroll
        for (int ai = 0; ai < 2; ++ai)
#pragma unroll
            for (int m = 0; m < 4; ++m)
#pragma unroll
                for (int bj = 0; bj < 2; ++bj) { if (bj < nbj) { const f32x4 v0 = acc[ai][bj][m][0], v1 = acc[ai][bj][m][1];
                    u32x4 w; w.x = cvt_pk_bf16(v0[0], v0[1]); w.y = cvt_pk_bf16(v0[2], v0[3]); w.z = cvt_pk_bf16(v1[0], v1[1]); w.w = cvt_pk_bf16(v1[2], v1[3]);
                    *(u32x4*)(base + (size_t)(row0 + ai * 128 + m * 16) * ld + cbase + bj * 128 + wc * 32 + 8 * fq) = w; } }
    }
};
template <class Epi> __device__ __forceinline__ void run_gemm(LAS unsigned char* lds, const bf16_t* A, const bf16_t* Bt, int M, int N, int K, const Epi& E) {
    asm volatile("" : "+s"(K));
    pg8::Gemm g{A, Bt, M, N, K}; pg8::StaticOrder S; S.init(M, N, (int)gridDim.x, (int)blockIdx.x);
    pg8::gemm_phase<Epi, pg8::StaticOrder>(lds, g, S, E);
    __syncthreads();
}

__device__ __forceinline__ void ph_loraprep(const Params& P, int l) {
    const bf16_t* PRW = (const bf16_t*)(P.ws + WS_PRW); bf16_t* AL = (bf16_t*)(P.ws + WS_ALORA);
    const float* mu = P.in[I_MU] + (size_t)l * 2 * RW_IN;
    const int gtid = blockIdx.x * NTHR + otid(), gn = gridDim.x * NTHR;
    for (int it = gtid; it < T * 48; it += gn) {
        const int row = it / 48, j8 = it % 48, col = 1152 + j8 * 8;
        bool hp, hn; row_nbrs(row, hp, hn);
        float p[8], pp[8], pn[8];
        unpack8(*(const u32x4*)(PRW + (size_t)row * RW_IN + col), p);
        if (hp) unpack8(*(const u32x4*)(PRW + (size_t)(row - 1) * RW_IN + col), pp); else {
#pragma unroll
            for (int i = 0; i < 8; ++i) pp[i] = 0.f; }
        if (hn) unpack8(*(const u32x4*)(PRW + (size_t)(row + 1) * RW_IN + col), pn); else {
#pragma unroll
            for (int i = 0; i < 8; ++i) pn[i] = 0.f; }
        float o[8];
#pragma unroll
        for (int i = 0; i < 8; ++i) { const float xs = p[i] + mu[col + i] * (pp[i] - p[i]) + mu[RW_IN + col + i] * (pn[i] - p[i]);
            o[i] = j8 < 16 ? tanhf(xs) : (j8 < 32 ? xs : sigmoidf_(xs)); }
        u32x4 w; w.x = cvt_pk_bf16(o[0], o[1]); w.y = cvt_pk_bf16(o[2], o[3]); w.z = cvt_pk_bf16(o[4], o[5]); w.w = cvt_pk_bf16(o[6], o[7]);
        *(u32x4*)(AL + (size_t)row * 384 + j8 * 8) = w;
    }
}

__device__ __forceinline__ void ph_rwkvprep(const Params& P, int l) {
    const int tid = otid(), lane = tid & 63, gw = blockIdx.x * NWAVE + (tid >> 6), nw = gridDim.x * NWAVE;
    const int nrw = nw / 6, h = gw % 6, rw0 = gw / 6;
    if (rw0 >= nrw) return;
    const bf16_t* PRW = (const bf16_t*)(P.ws + WS_PRW); const bf16_t* LO = (const bf16_t*)(P.ws + WS_LORAO);
    bf16_t* RS = (bf16_t*)(P.ws + WS_RS); bf16_t* KKS = (bf16_t*)(P.ws + WS_KKS); bf16_t* VS = (bf16_t*)(P.ws + WS_VS); bf16_t* KS = (bf16_t*)(P.ws + WS_KS); bf16_t* BS = (bf16_t*)(P.ws + WS_BS);
    float* BON = (float*)(P.ws + WS_BONUS); float* DEC = (float*)(P.ws + WS_DECAY);
    const float2* RT = (const float2*)(P.ws + WS_ROPE);
    const float* mu = P.in[I_MU] + (size_t)l * 2 * RW_IN;
    const int c = h * 64 + lane, f = lane & 15;
    const float mp0 = mu[c], mn0 = mu[RW_IN + c], mp1 = mu[384 + c], mn1 = mu[RW_IN + 384 + c], mp2 = mu[768 + c], mn2 = mu[RW_IN + 768 + c];
    const float ckk = P.in[I_KK][l * RWW + c], cka = P.in[I_KA][l * RWW + c], crk = P.in[I_RK][l * RWW + c];
    const float ca0 = P.in[I_A0][(size_t)l * 2 * RWW + c], ca1 = P.in[I_A0][(size_t)l * 2 * RWW + RWW + c], cw0 = P.in[I_W0][(size_t)l * 2 * RWW + c], cw1 = P.in[I_W0][(size_t)l * 2 * RWW + RWW + c];
    const float sg = (lane & 16) ? 1.f : -1.f;
#pragma unroll 2
    for (int row = rw0; row < T; row += nrw) {
        bool hp, hn; row_nbrs(row, hp, hn);
        const bf16_t* pr = PRW + (size_t)row * RW_IN + c; const int om = hp ? -RW_IN : 0, op = hn ? RW_IN : 0; const float fm = hp ? 1.f : 0.f, fp = hn ? 1.f : 0.f;
        const float r0 = bf2f(pr[0]), k0 = bf2f(pr[384]), v0 = bf2f(pr[768]);
        const float r = r0 + mp0 * (fm * bf2f(pr[om]) - r0) + mn0 * (fp * bf2f(pr[op]) - r0);
        const float k = k0 + mp1 * (fm * bf2f(pr[384 + om]) - k0) + mn1 * (fp * bf2f(pr[384 + op]) - k0);
        const float v = v0 + mp2 * (fm * bf2f(pr[768 + om]) - v0) + mn2 * (fp * bf2f(pr[768 + op]) - v0);
        const bf16_t* lo = LO + (size_t)row * 1536 + c;
        const float a0 = sigmoidf_(bf2f(lo[768]) + ca0), a1 = sigmoidf_(bf2f(lo[1152]) + ca1);
        const float x0 = bf2f(lo[0]) + cw0, x1 = bf2f(lo[384]) + cw1;
        const float kkr = k * ckk;
        const float nrm = sqrtf(wsum(kkr * kkr));
        const float kk = kkr / fmaxf(nrm, 1e-12f);
        float kd0 = k * (1.f + (a0 - 1.f) * cka), kd1 = k * (1.f + (a1 - 1.f) * cka);
        float b0 = kk * a0, b1 = kk * a1;
        const float bon = wsum(r * (kd0 + kd1) * crk);
        float rs = r, kks = kk;
        if (row < TL) {
            const int t = row & (SEQ - 1); const int pos = (lane < 32) ? (t >> 6) : (t & 63);
            const float2 csn = RT[pos * 16 + f]; const float cs = csn.x, sn = csn.y;
            const float r2 = __shfl_xor(rs, 16), k2 = __shfl_xor(kks, 16), d0 = __shfl_xor(kd0, 16), d1 = __shfl_xor(kd1, 16), e0 = __shfl_xor(b0, 16), e1 = __shfl_xor(b1, 16);
            rs = rs * cs + sg * r2 * sn; kks = kks * cs + sg * k2 * sn; kd0 = kd0 * cs + sg * d0 * sn; kd1 = kd1 * cs + sg * d1 * sn; b0 = b0 * cs + sg * e0 * sn; b1 = b1 * cs + sg * e1 * sn;
        }
        const size_t o = (size_t)row * 384 + c;
        DEC[o] = __expf(-0.6065306597f * sigmoidf_(x0)); DEC[(size_t)T * 384 + o] = __expf(-0.6065306597f * sigmoidf_(x1));
        if (lane == 0) BON[(size_t)row * 6 + h] = bon;
        RS[o] = f2bf(rs); KKS[o] = f2bf(-kks); VS[o] = f2bf(v);
        KS[o] = f2bf(kd0); KS[(size_t)T * 384 + o] = f2bf(kd1); BS[o] = f2bf(b0); BS[(size_t)T * 384 + o] = f2bf(b1);
    }
}

__device__ __forceinline__ int scan_row(int b, int d, int step) {
    if (step < CTX) { const int tc = d ? (CTX - 1 - step) : step; return TL + b * CTX + tc; }
    const int tl = d ? (SEQ - 1 - (step - CTX)) : (step - CTX); return b * SEQ + tl;
}
__device__ __forceinline__ void scan_task_v1(const Params& P, int task, float* sv) {
    const int lane = otid() & 63;
    const int d = task & 1, h = (task >> 1) % 6, b = task / 12;
    const float* DEC = (const float*)(P.ws + WS_DECAY) + (size_t)d * T * 384; const bf16_t* KKS = (const bf16_t*)(P.ws + WS_KKS); const bf16_t* RS = (const bf16_t*)(P.ws + WS_RS);
    const bf16_t* VS = (const bf16_t*)(P.ws + WS_VS); const bf16_t* KS = (const bf16_t*)(P.ws + WS_KS) + (size_t)d * T * 384; const bf16_t* BS = (const bf16_t*)(P.ws + WS_BS) + (size_t)d * T * 384;
    float* YD = (float*)(P.ws + WS_YDIR) + (size_t)d * T * 384;
    float S[64];
#pragma unroll
    for (int j = 0; j < 64; ++j) S[j] = 0.f;
    size_t o = (size_t)scan_row(b, d, 0) * 384 + h * 64 + lane;
    float nw_ = DEC[o], na = bf2f(KKS[o]), nb = bf2f(BS[o]), nk = bf2f(KS[o]), nr = bf2f(RS[o]), nv = bf2f(VS[o]);
    for (int step = 0; step < CTX + SEQ; ++step) {
        const float v = nv; const size_t oc = o;
        asm volatile("s_waitcnt lgkmcnt(0)" ::: "memory");
        sv[lane] = nw_; sv[64 + lane] = na; sv[128 + lane] = nb; sv[192 + lane] = nk; sv[256 + lane] = nr;
        asm volatile("s_waitcnt lgkmcnt(0)" ::: "memory");
        if (step + 1 < CTX + SEQ) { o = (size_t)scan_row(b, d, step + 1) * 384 + h * 64 + lane;
            nw_ = DEC[o]; na = bf2f(KKS[o]); nb = bf2f(BS[o]); nk = bf2f(KS[o]); nr = bf2f(RS[o]); nv = bf2f(VS[o]); }
        float sa0 = 0.f, sa1 = 0.f, sa2 = 0.f, sa3 = 0.f;
#pragma unroll
        for (int j = 0; j < 64; j += 4) { const float4 a4 = *(const float4*)(sv + 64 + j);
            sa0 += S[j + 0] * a4.x; sa1 += S[j + 1] * a4.y; sa2 += S[j + 2] * a4.z; sa3 += S[j + 3] * a4.w; }
        const float sa = (sa0 + sa1) + (sa2 + sa3);
        float y0 = 0.f, y1 = 0.f, y2 = 0.f, y3 = 0.f;
#pragma unroll
        for (int j = 0; j < 64; j += 4) {
            const float4 w4 = *(const float4*)(sv + j), b4 = *(const float4*)(sv + 128 + j), k4 = *(const float4*)(sv + 192 + j), r4 = *(const float4*)(sv + 256 + j);
            S[j + 0] = S[j + 0] * w4.x + sa * b4.x + v * k4.x; y0 += S[j + 0] * r4.x;
            S[j + 1] = S[j + 1] * w4.y + sa * b4.y + v * k4.y; y1 += S[j + 1] * r4.y;
            S[j + 2] = S[j + 2] * w4.z + sa * b4.z + v * k4.z; y2 += S[j + 2] * r4.z;
            S[j + 3] = S[j + 3] * w4.w + sa * b4.w + v * k4.w; y3 += S[j + 3] * r4.w; }
        YD[oc] = (y0 + y1) + (y2 + y3);
    }
}

__device__ __forceinline__ void natt_key(const bf16_t* PNA, size_t krow, int hoff, const float (&q)[16], float bias, float& m, float& lsum, float (&o)[16]) {
    const bf16_t* kp = PNA + krow * NA_IN + 384 + hoff; const bf16_t* vp = PNA + krow * NA_IN + 768 + hoff;
    float s = 0.f;
#pragma unroll
    for (int j8 = 0; j8 < 2; ++j8) { float kf[8]; unpack8(*(const u32x4*)(kp + j8 * 8), kf);
#pragma unroll
        for (int i = 0; i < 8; ++i) s += q[j8 * 8 + i] * kf[i]; }
    s += __shfl_xor(s, 1); s += __shfl_xor(s, 2); s += bias;
    const float mn = fmaxf(m, s), corr = __expf(m - mn), p = __expf(s - mn);
    m = mn; lsum = lsum * corr + p;
#pragma unroll
    for (int j8 = 0; j8 < 2; ++j8) { float vf[8]; unpack8(*(const u32x4*)(vp + j8 * 8), vf);
#pragma unroll
        for (int i = 0; i < 8; ++i) o[j8 * 8 + i] = o[j8 * 8 + i] * corr + p * vf[i]; }
}
__device__ __forceinline__ void natten_items_v1(const Params& P, int l, int wid0, int nworkers) {
    const bf16_t* PNA = (const bf16_t*)(P.ws + WS_PNA); bf16_t* MIX = (bf16_t*)(P.ws + WS_U);
    const float* rpb = P.in[I_RPB] + (size_t)l * 6 * 15 * 31;
    const int sub = wid0 & 3;
    for (int it = wid0 >> 2; it < T * 6; it += nworkers >> 2) {
        const int row = it % T, h = it / T, hoff = h * 64 + sub * 16;
        float q[16], o[16];
#pragma unroll
        for (int j8 = 0; j8 < 2; ++j8) { float qf[8]; unpack8(*(const u32x4*)(PNA + (size_t)row * NA_IN + hoff + j8 * 8), qf);
#pragma unroll
            for (int i = 0; i < 8; ++i) { q[j8 * 8 + i] = qf[i] * 0.125f; o[j8 * 8 + i] = 0.f; } }
        float m = -3.0e38f, lsum = 0.f;
        int b;
        if (row < TL) { b = row >> 13; const int t = row & (SEQ - 1), i = t >> 6, col = t & 63;
            const int start = min(max(i - 4, 0), 120), win0 = min(max(col - 8, 0), 48);
            for (int r = 0; r < 8; ++r) for (int kc = win0; kc < win0 + 16; ++kc) {
                const float bias = rpb[(h * 15 + (start + r - i + 7)) * 31 + (kc - col + 15)];
                natt_key(PNA, (size_t)b * SEQ + (start + r) * 64 + kc, hoff, q, bias, m, lsum, o); }
        } else b = (row - TL) >> 8;
        for (int c = 0; c < CTX; ++c) natt_key(PNA, (size_t)TL + b * CTX + c, hoff, q, 0.f, m, lsum, o);
        const float il = 1.0f / lsum;
#pragma unroll
        for (int j8 = 0; j8 < 2; ++j8) { u32x4 w; w.x = cvt_pk_bf16(o[j8 * 8 + 0] * il, o[j8 * 8 + 1] * il); w.y = cvt_pk_bf16(o[j8 * 8 + 2] * il, o[j8 * 8 + 3] * il);
            w.z = cvt_pk_bf16(o[j8 * 8 + 4] * il, o[j8 * 8 + 5] * il); w.w = cvt_pk_bf16(o[j8 * 8 + 6] * il, o[j8 * 8 + 7] * il);
            *(u32x4*)(MIX + (size_t)row * D + 640 + hoff + j8 * 8) = w; }
    }
}

__device__ __forceinline__ void vt_tile(const Params& P, int tile, unsigned short* tl  ) {
    const int tid = otid();
    const bf16_t* PNA = (const bf16_t*)(P.ws + WS_PNA);
    int h, tok0; bf16_t* dst; int ldt;
    if (tile < NB * 128 * 6) { h = tile % 6; const int sb = tile / 6; const int b = sb >> 7, blk = sb & 127; tok0 = b * SEQ + blk * 64; dst = (bf16_t*)(P.ws + WS_VTL) + ((size_t)(b * 6 + h) * 64) * SEQ + blk * 64; ldt = SEQ; }
    else { const int tt = tile - NB * 128 * 6; h = tt % 6; const int sb = tt / 6; const int b = sb >> 2, blk = sb & 3; tok0 = TL + b * CTX + blk * 64; dst = (bf16_t*)(P.ws + WS_VTC) + ((size_t)(b * 6 + h) * 64) * CTX + blk * 64; ldt = CTX; }
    { const int tok = tid >> 3, seg = tid & 7; const u32x4 v = *(const u32x4*)(PNA + (size_t)(tok0 + tok) * NA_IN + 768 + h * 64 + seg * 8);
      unsigned* w = (unsigned*)(tl + tok * 72 + seg * 8); w[0] = v.x; w[1] = v.y; w[2] = v.z; w[3] = v.w; }
    __syncthreads();
    { const int hd = tid >> 3, ts = tid & 7; unsigned short e[8];
#pragma unroll
      for (int k = 0; k < 8; ++k) e[k] = tl[(ts * 8 + k) * 72 + hd];
      u32x4 w; w.x = (unsigned)e[0] | ((unsigned)e[1] << 16); w.y = (unsigned)e[2] | ((unsigned)e[3] << 16); w.z = (unsigned)e[4] | ((unsigned)e[5] << 16); w.w = (unsigned)e[6] | ((unsigned)e[7] << 16);
      *(u32x4*)(dst + (size_t)hd * ldt + ts * 8) = w; }
    __syncthreads();
}
constexpr int NAT_LAT_TASKS = NB * 128 * 4 * 6, NAT_CTX_TASKS = NB * 16 * 6, NAT_TASKS = NAT_LAT_TASKS + NAT_CTX_TASKS;
__device__ __forceinline__ void natten_task(const Params& P, int l, int task) {
    using pg8::bf16x8;
    const int lane = otid() & 63, fr = lane & 15, fq = lane >> 4;
    const bf16_t* PNA = (const bf16_t*)(P.ws + WS_PNA); bf16_t* MIX = (bf16_t*)(P.ws + WS_U);
    const bool lat = task < NAT_LAT_TASKS;
    int b, h, i = 0, n = 0, qtok0;
    if (lat) { h = task % 6; const int r = task / 6; n = r & 3; i = (r >> 2) & 127; b = r >> 9; qtok0 = b * SEQ + i * 64 + 16 * n; }
    else { const int tt = task - NAT_LAT_TASKS; h = tt % 6; const int qb = (tt / 6) & 15; b = tt / 96; qtok0 = TL + b * CTX + 16 * qb; }
    const int start = min(max(i - 4, 0), 120), band0 = min(max(16 * n - 8, 0), 32);
    const int col = 16 * n + fr, win0 = min(max(col - 8, 0), 48);
    bf16x8 bq[2];
#pragma unroll
    for (int kh = 0; kh < 2; ++kh) bq[kh] = *(const bf16x8*)(PNA + (size_t)(qtok0 + fr) * NA_IN + h * 64 + kh * 32 + fq * 8);
    f32x4 sc[32];
    if (lat) {
#pragma unroll
        for (int t = 0; t < 16; ++t) { const int tok0 = b * SEQ + (start + (t >> 1)) * 64 + band0 + 16 * (t & 1);
            const bf16_t* kp = PNA + (size_t)(tok0 + fr) * NA_IN + 384 + h * 64 + fq * 8;
            const bf16x8 k0 = *(const bf16x8*)kp, k1 = *(const bf16x8*)(kp + 32);
            f32x4 a = (f32x4){0.f, 0.f, 0.f, 0.f};
            a = __builtin_amdgcn_mfma_f32_16x16x32_bf16(k0, bq[0], a, 0, 0, 0); a = __builtin_amdgcn_mfma_f32_16x16x32_bf16(k1, bq[1], a, 0, 0, 0);
            sc[t] = a; if ((t & 3) == 3) asm volatile("" ::: "memory"); }
    } else {
#pragma unroll
        for (int t = 0; t < 16; ++t) sc[t] = (f32x4){-3.0e38f, -3.0e38f, -3.0e38f, -3.0e38f};
    }
#pragma unroll
    for (int t = 16; t < 32; ++t) { const int tok0 = TL + b * CTX + 16 * (t - 16);
        const bf16_t* kp = PNA + (size_t)(tok0 + fr) * NA_IN + 384 + h * 64 + fq * 8;
        const bf16x8 k0 = *(const bf16x8*)kp, k1 = *(const bf16x8*)(kp + 32);
        f32x4 a = (f32x4){0.f, 0.f, 0.f, 0.f};
        a = __builtin_amdgcn_mfma_f32_16x16x32_bf16(k0, bq[0], a, 0, 0, 0); a = __builtin_amdgcn_mfma_f32_16x16x32_bf16(k1, bq[1], a, 0, 0, 0);
        sc[t] = a * 0.125f; if ((t & 3) == 3) asm volatile("" ::: "memory"); }
    if (lat) { const float* rpb = P.in[I_RPB] + ((size_t)l * 6 + h) * 15 * 31;
#pragma unroll
        for (int t = 0; t < 16; ++t) { const int ro = start + (t >> 1) - i + 7; const int kc0 = band0 + 16 * (t & 1) + fq * 4;
#pragma unroll
            for (int j = 0; j < 4; ++j) { const int kc = kc0 + j; const bool ok = kc >= win0 && kc < win0 + 16; const int co = min(max(kc - col + 15, 0), 30);
                const float bias = rpb[ro * 31 + co]; sc[t][j] = ok ? sc[t][j] * 0.125f + bias : -3.0e38f; } } }
    float mx = -3.0e38f;
#pragma unroll
    for (int t = 0; t < 32; ++t) mx = fmaxf(mx, fmaxf(fmaxf(sc[t][0], sc[t][1]), fmaxf(sc[t][2], sc[t][3])));
    mx = fmaxf(mx, __shfl_xor(mx, 16)); mx = fmaxf(mx, __shfl_xor(mx, 32));
    float sum = 0.f;
#pragma unroll
    for (int t = 0; t < 32; ++t) {
#pragma unroll
        for (int j = 0; j < 4; ++j) { const float p = __expf(sc[t][j] - mx); sc[t][j] = p; sum += p; } }
    sum += __shfl_xor(sum, 16); sum += __shfl_xor(sum, 32);
    const float inv = 1.0f / sum;
    f32x4 ot[4];
#pragma unroll
    for (int q = 0; q < 4; ++q) ot[q] = (f32x4){0.f, 0.f, 0.f, 0.f};
    const bf16_t* VTL = (const bf16_t*)(P.ws + WS_VTL) + ((size_t)(b * 6 + h) * 64) * SEQ; const bf16_t* VTC = (const bf16_t*)(P.ws + WS_VTC) + ((size_t)(b * 6 + h) * 64) * CTX;
    if (lat) {
#pragma unroll
        for (int m = 0; m < 8; ++m) { const int tk = (start + m) * 64 + band0 + fq * 4;
            u32x4 pw; pw.x = cvt_pk_bf16(sc[2 * m][0], sc[2 * m][1]); pw.y = cvt_pk_bf16(sc[2 * m][2], sc[2 * m][3]); pw.z = cvt_pk_bf16(sc[2 * m + 1][0], sc[2 * m + 1][1]); pw.w = cvt_pk_bf16(sc[2 * m + 1][2], sc[2 * m + 1][3]);
            const bf16x8 pb = __builtin_bit_cast(bf16x8, pw);
#pragma unroll
            for (int q = 0; q < 4; ++q) { const bf16_t* vp = VTL + (size_t)(q * 16 + fr) * SEQ + tk; const u32x2 v0 = *(const u32x2*)vp, v1 = *(const u32x2*)(vp + 16);
                u32x4 vw; vw.x = v0.x; vw.y = v0.y; vw.z = v1.x; vw.w = v1.y;
                ot[q] = __builtin_amdgcn_mfma_f32_16x16x32_bf16(__builtin_bit_cast(bf16x8, vw), pb, ot[q], 0, 0, 0); }
            if (m & 1) asm volatile("" ::: "memory"); }
    }
#pragma unroll
    for (int m = 0; m < 8; ++m) { const int tk = 32 * m + fq * 4;
        u32x4 pw; pw.x = cvt_pk_bf16(sc[16 + 2 * m][0], sc[16 + 2 * m][1]); pw.y = cvt_pk_bf16(sc[16 + 2 * m][2], sc[16 + 2 * m][3]); pw.z = cvt_pk_bf16(sc[17 + 2 * m][0], sc[17 + 2 * m][1]); pw.w = cvt_pk_bf16(sc[17 + 2 * m][2], sc[17 + 2 * m][3]);
        const bf16x8 pb = __builtin_bit_cast(bf16x8, pw);
#pragma unroll
        for (int q = 0; q < 4; ++q) { const bf16_t* vp = VTC + (size_t)(q * 16 + fr) * CTX + tk; const u32x2 v0 = *(const u32x2*)vp, v1 = *(const u32x2*)(vp + 16);
            u32x4 vw; vw.x = v0.x; vw.y = v0.y; vw.z = v1.x; vw.w = v1.y;
            ot[q] = __builtin_amdgcn_mfma_f32_16x16x32_bf16(__builtin_bit_cast(bf16x8, vw), pb, ot[q], 0, 0, 0); }
        if (m & 1) asm volatile("" ::: "memory"); }
#pragma unroll
    for (int q = 0; q < 4; ++q) { u32x2 w; w.x = cvt_pk_bf16(ot[q][0] * inv, ot[q][1] * inv); w.y = cvt_pk_bf16(ot[q][2] * inv, ot[q][3] * inv);
        *(u32x2*)(MIX + (size_t)(qtok0 + fr) * D + 640 + h * 64 + q * 16 + fq * 4) = w; }
}

__device__ __forceinline__ void fft_fwd(float2* X) {
#pragma unroll 1
    for (int lq = 12; lq >= 0; lq -= 2) { const int q = 1 << lq; const float rq = 1.0f / (float)(4 * q);
        for (int j = otid(); j < NFFT / 4; j += NTHR) { const int lo = j & (q - 1), base = ((j >> lq) << (lq + 2)) | lo;
            const float2 x0 = X[base], x1 = X[base + q], x2 = X[base + 2 * q], x3 = X[base + 3 * q];
            const float fr = (float)lo * rq; const float c = __builtin_amdgcn_cosf(fr), s = __builtin_amdgcn_sinf(fr), c2 = c * c - s * s, s2 = 2.f * c * s;
            const float a0x = x0.x + x2.x, a0y = x0.y + x2.y, dx = x0.x - x2.x, dy = x0.y - x2.y;
            const float a2x = dx * c + dy * s, a2y = dy * c - dx * s;
            const float a1x = x1.x + x3.x, a1y = x1.y + x3.y, ex = x1.x - x3.x, ey = x1.y - x3.y;
            const float mx = ex * c + ey * s, my = ey * c - ex * s;
            const float a3x = my, a3y = -mx;
            const float fx = a0x - a1x, fy = a0y - a1y, gx = a2x - a3x, gy = a2y - a3y;
            X[base] = make_float2(a0x + a1x, a0y + a1y); X[base + q] = make_float2(fx * c2 + fy * s2, fy * c2 - fx * s2);
            X[base + 2 * q] = make_float2(a2x + a3x, a2y + a3y); X[base + 3 * q] = make_float2(gx * c2 + gy * s2, gy * c2 - gx * s2); }
        __syncthreads(); }
}
__device__ __forceinline__ void fft_inv(float2* X) {
#pragma unroll 1
    for (int lq = 0; lq <= 12; lq += 2) { const int q = 1 << lq; const float rq = 1.0f / (float)(4 * q);
        for (int j = otid(); j < NFFT / 4; j += NTHR) { const int lo = j & (q - 1), base = ((j >> lq) << (lq + 2)) | lo;
            const float2 y0 = X[base], y1 = X[base + q], y2 = X[base + 2 * q], y3 = X[base + 3 * q];
            const float fr = (float)lo * rq; const float c = __builtin_amdgcn_cosf(fr), s = __builtin_amdgcn_sinf(fr), c2 = c * c - s * s, s2 = 2.f * c * s;
            const float tx = y1.x * c2 - y1.y * s2, ty = y1.x * s2 + y1.y * c2;
            const float a0x = y0.x + tx, a0y = y0.y + ty, a1x = y0.x - tx, a1y = y0.y - ty;
            const float ux = y3.x * c2 - y3.y * s2, uy = y3.x * s2 + y3.y * c2;
            const float a2x = y2.x + ux, a2y = y2.y + uy, a3x = y2.x - ux, a3y = y2.y - uy;
            const float vx = a2x * c - a2y * s, vy = a2x * s + a2y * c;
            const float mx = a3x * c - a3y * s, my = a3x * s + a3y * c;
            const float wx = -my, wy = mx;
            X[base] = make_float2(a0x + vx, a0y + vy); X[base + 2 * q] = make_float2(a0x - vx, a0y - vy);
            X[base + q] = make_float2(a1x + wx, a1y + wy); X[base + 3 * q] = make_float2(a1x - wx, a1y - wy); }
        __syncthreads(); }
}
__device__ __forceinline__ float hy_delta(int c) { const float lo = -4.605170185988091f / 1.5f, hi = -4.605170185988091f / 0.3f; return fabsf(lo + (float)c * ((hi - lo) / 255.0f)); }
__device__ __forceinline__ float hy_short(const bf16_t* PHYT, const float* cw, const float* cb, int row, int col) {
    bool hp, hn; row_nbrs(row, hp, hn);
    const bf16_t* p = PHYT + (size_t)col * T + row;
    float v = cb[col] + cw[HY_IN + col] * bf2f(p[0]);
    if (hp) v += cw[col] * bf2f(p[-1]);
    if (hn) v += cw[2 * HY_IN + col] * bf2f(p[1]);
    return v;
}
struct HyTap { float w0, w1, w2, b; };
__device__ __forceinline__ HyTap hy_tap(const float* cw, const float* cb, int col) { HyTap t; t.w0 = cw[col]; t.w1 = cw[HY_IN + col]; t.w2 = cw[2 * HY_IN + col]; t.b = cb[col]; return t; }
__device__ __forceinline__ float hy_lat(const bf16_t* colp, int b, int n, const HyTap t) {
    const bf16_t* p = colp + b * SEQ + n;
    const float xm = bf2f(p[n > 0 ? -1 : 0]), x0 = bf2f(p[0]), xp = bf2f(p[n < SEQ - 1 ? 1 : 0]);
    return t.b + t.w1 * x0 + (n > 0 ? t.w0 * xm : 0.f) + (n < SEQ - 1 ? t.w2 * xp : 0.f);
}
__device__ __forceinline__ void hy_spec_task(const Params& P, int l, int o, int c, float2* X, float* ex_) {
    const int tid = otid();
    const bf16_t* ff = (const bf16_t*)(P.ws + WS_FILT) + (size_t)(o * 512 + c) * SEQ; const bf16_t* fb = ff + (size_t)256 * SEQ;
    for (int n = tid; n < SEQ; n += NTHR) {
        X[n] = make_float2(bf2f(ff[n]), 0.f);
        if (n > 0) X[NFFT - n] = make_float2(bf2f(fb[n]), 0.f); else X[SEQ] = make_float2(0.f, 0.f); }
    __syncthreads();
    fft_fwd(X);
    float2* spec = (float2*)(P.ws + WS_SPEC) + (size_t)(o * 256 + c) * NFFT;
    for (int i = tid; i < NFFT; i += NTHR) spec[i] = X[i];
    __syncthreads();
}
__device__ __forceinline__ void hy_conv_core(const Params& P, int o, int c, float2* X) {
    fft_fwd(X);
    const float2* spec = (const float2*)(P.ws + WS_SPEC) + (size_t)(o * 256 + c) * NFFT;
    for (int i = otid(); i < NFFT; i += NTHR) { const float2 a = X[i], k = spec[i]; X[i] = make_float2(a.x * k.x - a.y * k.y, a.x * k.y + a.y * k.x); }
    __syncthreads();
    fft_inv(X);
}
__device__ __forceinline__ void hy_task1(const Params& P, int l, int c, float2* X, float* ex) {
    const int tid = otid();
    const bf16_t* PHY = (const bf16_t*)(P.ws + WS_PHY); const float* cw = P.in[I_HCW] + (size_t)l * 3 * HY_IN; const float* cb = P.in[I_HCB] + (size_t)l * HY_IN;
    const float bias0 = P.in[I_HBIAS][(size_t)l * 2 * HYC + c], bias1 = P.in[I_HBIAS][(size_t)l * 2 * HYC + HYC + c];
    const HyTap tv = hy_tap(cw, cb, c), tg1 = hy_tap(cw, cb, HYC + c); const bf16_t* colv = PHY + (size_t)c * T; const bf16_t* colg1 = PHY + (size_t)(HYC + c) * T;
#pragma unroll 4
    for (int n = tid; n < SEQ; n += NTHR) { X[n] = make_float2(hy_lat(colv, 0, n, tv), hy_lat(colv, 1, n, tv)); X[SEQ + n] = make_float2(0.f, 0.f); }
    __syncthreads();
    hy_conv_core(P, 0, c, X);
    float* Z1 = (float*)(P.ws + WS_Z1) + (size_t)c * NB * SEQ;
#pragma unroll 4
    for (int n = tid; n < SEQ; n += NTHR) { const float2 y = X[n];
        const float v0 = hy_lat(colv, 0, n, tv), v1 = hy_lat(colv, 1, n, tv), g0 = hy_lat(colg1, 0, n, tg1), g1 = hy_lat(colg1, 1, n, tg1);
        Z1[n] = g0 * (y.x + bias0 * v0); Z1[SEQ + n] = g1 * (y.y + bias0 * v1); }
    __syncthreads();
    float* f = (float*)X;
    float* vv = f, *x1 = f + 512, *x2 = f + 1024, *hf = f + 1536  , *z1 = f + 2560;
    const bf16_t* fc = (const bf16_t*)(P.ws + WS_FILTC);
    { const int b = tid >> 8, t = tid & 255, row = TL + b * CTX + t;
      vv[tid] = hy_short(PHY, cw, cb, row, c); x1[tid] = hy_short(PHY, cw, cb, row, HYC + c); x2[tid] = hy_short(PHY, cw, cb, row, 2 * HYC + c);
      for (int q = tid; q < 1024; q += NTHR) { const int od = q >> 8, n = q & 255; hf[q] = bf2f(fc[(size_t)(od * 256 + c) * CTX + n]); } }
    __syncthreads();
    { const int b = tid >> 8, t = tid & 255; float y = bias0 * vv[tid];
      for (int s = 0; s <= t; ++s) y += hf[t - s] * vv[b * 256 + s];
      for (int s = t + 1; s < CTX; ++s) y += hf[256 + s - t] * vv[b * 256 + s];
      z1[tid] = x1[tid] * y; }
    __syncthreads();
    { const int b = tid >> 8, t = tid & 255; float y = bias1 * z1[tid];
      for (int s = 0; s <= t; ++s) y += hf[512 + t - s] * z1[b * 256 + s];
      for (int s = t + 1; s < CTX; ++s) y += hf[768 + s - t] * z1[b * 256 + s];
      bf16_t* MIX = (bf16_t*)(P.ws + WS_U); MIX[(size_t)(TL + b * CTX + t) * D + c] = f2bf(x2[tid] * y); }
    __syncthreads();
}
__device__ __forceinline__ void hy_task2(const Params& P, int l, int c, float2* X) {
    const int tid = otid();
    const bf16_t* PHY = (const bf16_t*)(P.ws + WS_PHY); const float* cw = P.in[I_HCW] + (size_t)l * 3 * HY_IN; const float* cb = P.in[I_HCB] + (size_t)l * HY_IN;
    const float bias1 = P.in[I_HBIAS][(size_t)l * 2 * HYC + HYC + c];
    const float* Z1 = (const float*)(P.ws + WS_Z1) + (size_t)c * NB * SEQ;
    for (int n = tid; n < SEQ; n += NTHR) { X[n] = make_float2(Z1[n], Z1[SEQ + n]); X[SEQ + n] = make_float2(0.f, 0.f); }
    __syncthreads();
    hy_conv_core(P, 1, c, X);
    bf16_t* MIX = (bf16_t*)(P.ws + WS_U);
    const HyTap tg2 = hy_tap(cw, cb, 2 * HYC + c); const bf16_t* colg2 = PHY + (size_t)(2 * HYC + c) * T;
#pragma unroll 4
    for (int n = tid; n < SEQ; n += NTHR) { const float2 y = X[n];
        const float g0 = hy_lat(colg2, 0, n, tg2), g1 = hy_lat(colg2, 1, n, tg2);
        MIX[(size_t)n * D + c] = f2bf(g0 * (y.x + bias1 * Z1[n])); MIX[(size_t)(SEQ + n) * D + c] = f2bf(g1 * (y.y + bias1 * Z1[SEQ + n])); }
    __syncthreads();
}

constexpr int SEGC = 256, NSEG = 33, SCH = 4;
typedef float f32x2v __attribute__((ext_vector_type(2)));
template <bool IDENT>
__device__ __forceinline__ void scan_seg(const Params& P, int chain, int g, float* ring_  ) {
    const ldsfp ring = vlds(ring_);
    const int lane = otid() & 63;
    const int d = chain & 1, h = (chain >> 1) % 6, b = chain / 12;
    const float* DEC = (const float*)(P.ws + WS_DECAY) + (size_t)d * T * 384; const bf16_t* KKS = (const bf16_t*)(P.ws + WS_KKS); const bf16_t* RS = (const bf16_t*)(P.ws + WS_RS);
    const bf16_t* VS = (const bf16_t*)(P.ws + WS_VS); const bf16_t* KS = (const bf16_t*)(P.ws + WS_KS) + (size_t)d * T * 384; const bf16_t* BS = (const bf16_t*)(P.ws + WS_BS) + (size_t)d * T * 384;
    float* YD = (float*)(P.ws + WS_YDIR) + (size_t)d * T * 384;
    bf16_t* E = (bf16_t*)(P.ws + WS_E) + (size_t)chain * SEQ * 64;
    const int step0 = g == 0 ? 0 : CTX + (g - 1) * SEGC;
    f32x2v S0[32], S1[32];
#pragma unroll
    for (int j = 0; j < 32; ++j) { S0[j] = (f32x2v){0.f, 0.f}; S1[j] = (f32x2v){(2 * j == lane) ? 1.f : 0.f, (2 * j + 1 == lane) ? 1.f : 0.f}; }
    float pw[SCH], pa[SCH], pb[SCH], pk[SCH], pr[SCH], pv[SCH]; int po[SCH];
#pragma unroll
    for (int s = 0; s < SCH; ++s) { const int o = scan_row(b, d, step0 + s) * 384 + h * 64 + lane; po[s] = o;
        pw[s] = DEC[o]; pa[s] = bf2f(KKS[o]); pb[s] = bf2f(BS[o]); pk[s] = bf2f(KS[o]); pr[s] = bf2f(RS[o]); pv[s] = bf2f(VS[o]); }
    for (int c = 0; c < SEGC / SCH; ++c) {
        float cv[SCH]; int co[SCH];
        asm volatile("s_waitcnt lgkmcnt(0)" ::: "memory");
#pragma unroll
        for (int s = 0; s < SCH; ++s) { const ldsfp sv = ring + s * 320; sv[lane] = pw[s]; sv[64 + lane] = pa[s]; sv[128 + lane] = pb[s]; sv[192 + lane] = pk[s]; sv[256 + lane] = pr[s]; cv[s] = pv[s]; co[s] = po[s]; }
        asm volatile("s_waitcnt lgkmcnt(0)" ::: "memory");
        if (c + 1 < SEGC / SCH) {
#pragma unroll
            for (int s = 0; s < SCH; ++s) { const int o = scan_row(b, d, step0 + (c + 1) * SCH + s) * 384 + h * 64 + lane; po[s] = o;
                pw[s] = DEC[o]; pa[s] = bf2f(KKS[o]); pb[s] = bf2f(BS[o]); pk[s] = bf2f(KS[o]); pr[s] = bf2f(RS[o]); pv[s] = bf2f(VS[o]); } }
#pragma unroll
        for (int s = 0; s < SCH; ++s) { const ldsfp sv = ring + s * 320;
            f32x2v sa2 = (f32x2v){0.f, 0.f}, sb2 = (f32x2v){0.f, 0.f}, sa3 = sa2, sb3 = sa2;
#pragma unroll
            for (int hb = 0; hb < 2; ++hb) { f32x4 A[8];
#pragma unroll
                for (int i = 0; i < 8; ++i) A[i] = *(const LAS f32x4*)(sv + 64 + hb * 32 + 4 * i);
                __builtin_amdgcn_sched_barrier(0);
#pragma unroll
                for (int i = 0; i < 8; ++i) { const int jj = hb * 16 + 2 * i; const f32x2v alo = (f32x2v){A[i].x, A[i].y}, ahi = (f32x2v){A[i].z, A[i].w};
                    sa2 += S0[jj] * alo; sa3 += S0[jj + 1] * ahi;
                    if (IDENT) { sb2 += S1[jj] * alo; sb3 += S1[jj + 1] * ahi; } }
                __builtin_amdgcn_sched_barrier(0); }
            const float sa = (sa2.x + sa2.y) + (sa3.x + sa3.y), sb = (sb2.x + sb2.y) + (sb3.x + sb3.y);
            const f32x2v saa = (f32x2v){sa, sa}, sbb = (f32x2v){sb, sb}, vv = (f32x2v){cv[s], cv[s]};
            f32x2v y2 = (f32x2v){0.f, 0.f}, y3 = y2, e2 = y2, e3 = y2;
#pragma unroll
            for (int ch = 0; ch < 8; ++ch) { f32x4 W[2], Bq[2], K[2], R[2];
#pragma unroll
                for (int i = 0; i < 2; ++i) { const int j = ch * 8 + 4 * i; W[i] = *(const LAS f32x4*)(sv + j); Bq[i] = *(const LAS f32x4*)(sv + 128 + j); K[i] = *(const LAS f32x4*)(sv + 192 + j); R[i] = *(const LAS f32x4*)(sv + 256 + j); }
                __builtin_amdgcn_sched_barrier(0);
#pragma unroll
                for (int i = 0; i < 2; ++i) { const int jj = ch * 4 + 2 * i;
                    const f32x2v wlo = (f32x2v){W[i].x, W[i].y}, whi = (f32x2v){W[i].z, W[i].w}, blo = (f32x2v){Bq[i].x, Bq[i].y}, bhi = (f32x2v){Bq[i].z, Bq[i].w};
                    const f32x2v klo = (f32x2v){K[i].x, K[i].y}, khi = (f32x2v){K[i].z, K[i].w}, rlo = (f32x2v){R[i].x, R[i].y}, rhi = (f32x2v){R[i].z, R[i].w};
                    S0[jj] = S0[jj] * wlo + saa * blo + vv * klo; y2 += S0[jj] * rlo;
                    S0[jj + 1] = S0[jj + 1] * whi + saa * bhi + vv * khi; y3 += S0[jj + 1] * rhi;
                    if (IDENT) { S1[jj] = S1[jj] * wlo + sbb * blo; e2 += S1[jj] * rlo; S1[jj + 1] = S1[jj + 1] * whi + sbb * bhi; e3 += S1[jj + 1] * rhi; } }
                __builtin_amdgcn_sched_barrier(0); }
            YD[co[s]] = (y2.x + y2.y) + (y3.x + y3.y);
            if (IDENT) { const int tl = d ? (SEQ - 1 - (step0 - CTX + c * SCH + s)) : (step0 - CTX + c * SCH + s); E[(size_t)tl * 64 + lane] = f2bf((e2.x + e2.y) + (e3.x + e3.y)); }
        }
    }
    float* ZP = (float*)(P.ws + WS_ZP) + ((size_t)chain * NSEG + g) * 2 * 4096;
#pragma unroll
    for (int j = 0; j < 32; j += 2) { *(float4*)(ZP + lane * 64 + 2 * j) = make_float4(S0[j].x, S0[j].y, S0[j + 1].x, S0[j + 1].y);
        if (IDENT) *(float4*)(ZP + 4096 + lane * 64 + 2 * j) = make_float4(S1[j].x, S1[j].y, S1[j + 1].x, S1[j + 1].y); }
}
__device__ __forceinline__ void scan_combine(const Params& P, int chain, float* lds) {
    const int tid = otid(); const int i = tid >> 3, j0 = (tid & 7) * 8;
    float* Sl = lds;
    float* Pl = lds + 64 * 65;
    float* ZPc = (float*)(P.ws + WS_ZP) + (size_t)chain * NSEG * 2 * 4096;
    float sn[8];
#pragma unroll
    for (int q = 0; q < 8; ++q) sn[q] = ZPc[i * 64 + j0 + q];
    for (int g = 1; g < NSEG - 1; ++g) {
        __syncthreads();
#pragma unroll
        for (int q = 0; q < 8; ++q) Sl[i * 65 + j0 + q] = sn[q];
        const float* Pg = ZPc + (size_t)g * 2 * 4096 + 4096;
#pragma unroll
        for (int q = 0; q < 8; ++q) Pl[tid * 8 + q] = Pg[tid * 8 + q];
        float* Zg = ZPc + (size_t)g * 2 * 4096;
#pragma unroll
        for (int q = 0; q < 8; ++q) sn[q] = Zg[i * 64 + j0 + q];
        __syncthreads();
        for (int m = 0; m < 64; ++m) { const float sv = Sl[i * 65 + m]; const float4 p0 = *(const float4*)(Pl + m * 64 + j0), p1 = *(const float4*)(Pl + m * 64 + j0 + 4);
            sn[0] += sv * p0.x; sn[1] += sv * p0.y; sn[2] += sv * p0.z; sn[3] += sv * p0.w; sn[4] += sv * p1.x; sn[5] += sv * p1.y; sn[6] += sv * p1.z; sn[7] += sv * p1.w; }
#pragma unroll
        for (int q = 0; q < 8; ++q) Zg[i * 64 + j0 + q] = sn[q];
    }
    __syncthreads();
}

__device__ __forceinline__ void rwkv_out_fin(const Params& P, int row, int c, float y, float lnw, float lnb, float bon, float vs, float gt) {
    bf16_t* MIX = (bf16_t*)(P.ws + WS_U);
    const float mean = wsum(y) * (1.0f / 64.0f); const float dv = y - mean; const float var = wsum(dv * dv) * (1.0f / 64.0f);
    const float yn = dv * rsqrtf(var + 64e-5f) * lnw + lnb;
    MIX[(size_t)row * D + 256 + c] = f2bf((yn + bon * vs) * gt);
}
__device__ __forceinline__ void ph_rwkvout(const Params& P, int l, float* ldsf) {
    using pg8::bf16x8;
    const int tid = otid(), lane = tid & 63, fr = lane & 15, fq = lane >> 4, wv = tid >> 6, gw = blockIdx.x * NWAVE + wv, nw = gridDim.x * NWAVE;
    const float* YD = (const float*)(P.ws + WS_YDIR); const bf16_t* VS = (const bf16_t*)(P.ws + WS_VS); const bf16_t* GT = (const bf16_t*)(P.ws + WS_GATE); const float* BON = (const float*)(P.ws + WS_BONUS);
    bf16_t* MIX = (bf16_t*)(P.ws + WS_U);
    for (int it = gw; it < NB * 6 * 32 * 4; it += nw) {
        const int sub = it & 3, q = (it >> 2) & 31, h = (it >> 7) % 6, b = it / (128 * 6);
        const int t0 = q * 256 + sub * 64;
        f32x4 acc[4][4];
#pragma unroll
        for (int mt = 0; mt < 4; ++mt)
#pragma unroll
            for (int nt = 0; nt < 4; ++nt) acc[mt][nt] = (f32x4){0.f, 0.f, 0.f, 0.f};
#pragma unroll
        for (int dir = 0; dir < 2; ++dir) { const int ch = b * 12 + h * 2 + dir, slot = dir ? (31 - q) : q;
            const float* Sp = (const float*)(P.ws + WS_ZP) + ((size_t)ch * NSEG + slot) * 2 * 4096;
            const bf16_t* Ep = (const bf16_t*)(P.ws + WS_E) + ((size_t)ch * SEQ + t0) * 64;
#pragma unroll
            for (int ks = 0; ks < 2; ++ks) { bf16x8 bop[4];
#pragma unroll
                for (int nt = 0; nt < 4; ++nt) { const float* sp = Sp + (nt * 16 + fr) * 64 + ks * 32 + fq * 8; const float4 s0 = *(const float4*)sp, s1 = *(const float4*)(sp + 4);
                    u32x4 w; w.x = cvt_pk_bf16(s0.x, s0.y); w.y = cvt_pk_bf16(s0.z, s0.w); w.z = cvt_pk_bf16(s1.x, s1.y); w.w = cvt_pk_bf16(s1.z, s1.w); bop[nt] = __builtin_bit_cast(bf16x8, w); }
#pragma unroll
                for (int mt = 0; mt < 4; ++mt) { const bf16x8 a = *(const bf16x8*)(Ep + (size_t)(mt * 16 + fr) * 64 + ks * 32 + fq * 8);
#pragma unroll
                    for (int nt = 0; nt < 4; ++nt) acc[mt][nt] = __builtin_amdgcn_mfma_f32_16x16x32_bf16(a, bop[nt], acc[mt][nt], 0, 0, 0); } } }
        float lnw[4], lnb[4];
#pragma unroll
        for (int nt = 0; nt < 4; ++nt) { lnw[nt] = P.in[I_LNW][l * RWW + h * 64 + nt * 16 + fr]; lnb[nt] = P.in[I_LNB][l * RWW + h * 64 + nt * 16 + fr]; }
#pragma unroll
        for (int mt = 0; mt < 4; ++mt)
#pragma unroll
            for (int rg = 0; rg < 4; ++rg) { const int row = b * SEQ + t0 + mt * 16 + fq * 4 + rg; const size_t o = (size_t)row * 384 + h * 64 + fr;
                float y[4], vs[4], gt[4]; const float bon = BON[(size_t)row * 6 + h];
#pragma unroll
                for (int nt = 0; nt < 4; ++nt) { y[nt] = YD[o + nt * 16] + YD[(size_t)T * 384 + o + nt * 16] + acc[mt][nt][rg]; vs[nt] = bf2f(VS[o + nt * 16]); gt[nt] = bf2f(GT[o + nt * 16]); }
                float sm = (y[0] + y[1]) + (y[2] + y[3]);
                sm += __shfl_xor(sm, 1); sm += __shfl_xor(sm, 2); sm += __shfl_xor(sm, 4); sm += __shfl_xor(sm, 8);
                const float mean = sm * (1.0f / 64.0f);
                float vr = 0.f;
#pragma unroll
                for (int nt = 0; nt < 4; ++nt) { y[nt] -= mean; vr += y[nt] * y[nt]; }
                vr += __shfl_xor(vr, 1); vr += __shfl_xor(vr, 2); vr += __shfl_xor(vr, 4); vr += __shfl_xor(vr, 8);
                const float rstd = rsqrtf(vr * (1.0f / 64.0f) + 64e-5f);
#pragma unroll
                for (int nt = 0; nt < 4; ++nt) MIX[(size_t)row * D + 256 + h * 64 + nt * 16 + fr] = f2bf((y[nt] * rstd * lnw[nt] + lnb[nt] + bon * vs[nt]) * gt[nt]);
                if (rg & 1) asm volatile("" ::: "memory"); }
    }
    for (int it = gw; it < TC * 6; it += nw) { const int row = TL + it / 6, h = it % 6, c = h * 64 + lane; const size_t o = (size_t)row * 384 + c;
        rwkv_out_fin(P, row, c, YD[o] + YD[(size_t)T * 384 + o], P.in[I_LNW][l * RWW + c], P.in[I_LNB][l * RWW + c], BON[(size_t)row * 6 + h], bf2f(VS[o]), bf2f(GT[o])); }
}

typedef const __attribute__((address_space(4))) Params* KParamsPtr;
__device__ __forceinline__ const Params* fresh_params() { KParamsPtr q = (KParamsPtr)__builtin_amdgcn_kernarg_segment_ptr(); asm volatile("" : "+s"(q)); return (const Params*)q; }
__global__ void __launch_bounds__(NTHR, 2) fwd_megakernel(Params P_unused, int ph_lo, int ph_hi) {
    extern __shared__ __attribute__((aligned(16))) unsigned char smem[];
    cg::grid_group grid = cg::this_grid();
    LAS unsigned char* lds3 = (LAS unsigned char*)smem;
    float* ldsf = (float*)smem; float2* X = (float2*)smem; float* ex = (float*)(smem + LDS_MAIN);
    { volatile LAS unsigned* st = (volatile LAS unsigned*)(lds3 + LDS_MAIN + 4096); if (threadIdx.x == 0) { st[0] = 0u; st[1] = 0u; } }
    __syncthreads();
    XcdBarrier xbar = xcd_barrier_post((unsigned*)(((const Params*)fresh_params())->ws + WS_BAR), (volatile LAS unsigned*)(lds3 + LDS_MAIN + 4096));
    int ph = 0;
#ifndef REP_GEMM
#define REP_GEMM 1
#endif
#ifndef REP_SCAN
#define REP_SCAN 1
#endif
#ifndef REP_MISC
#define REP_MISC 1
#endif
#ifndef REP_HY
#define REP_HY 1
#endif
#define PHASE_BEGIN if (ph >= ph_lo && ph < ph_hi) { const Params& P = *fresh_params(); unsigned char* ws = P.ws; (void)ws;
#ifndef REP_SYNC
#define REP_SYNC 1
#endif
#define PHASE_END   if (ph + 1 < ph_hi) { for (int rs_ = 0; rs_ < REP_SYNC; ++rs_) { if (ph == 0) grid.sync(); else xcd_barrier(xbar); } } } ++ph;
    PHASE_BEGIN ph_modv(P, ldsf); PHASE_END
    for (int l = 0; l < DEPTH; ++l) {
        PHASE_BEGIN
            for (int rep_ = 0; rep_ < REP_MISC; ++rep_) ph_prep(P, l, ldsf);
            if (l == 0) ph_rowpass(P, 0, 0, 0, 0, 0.f, 0, 0, 0, 1, 1);
            else ph_rowpass(P, 1, l - 1, 8, 5, 0.5f, l, 0, 0, 1, 11);
        PHASE_END
        PHASE_BEGIN { EpiGU E{(bf16_t*)(ws + WS_ACT)}; for (int rep_ = 0; rep_ < REP_GEMM; ++rep_) run_gemm(lds3, (const bf16_t*)(ws + WS_U), (const bf16_t*)(ws + WS_WGU1), T, 2 * DFF, D, E); } PHASE_END
        PHASE_BEGIN { EpiF32 E{(bf16_t*)(ws + WS_Y), (float*)(ws + WS_YC)}; run_gemm_tail(lds3, (const bf16_t*)(ws + WS_ACT), (const bf16_t*)(ws + WS_WDN1), DFF, E); } PHASE_END
        PHASE_BEGIN ph_rowpass(P, 1, l, 2, 1, 0.5f, l, 2, 3, 4, 11); PHASE_END
        PHASE_BEGIN { EpiWin E{(bf16_t*)(ws + WS_PHY), (bf16_t*)(ws + WS_PRW), (bf16_t*)(ws + WS_PNA)}; for (int rep_ = 0; rep_ < REP_GEMM; ++rep_) run_gemm(lds3, (const bf16_t*)(ws + WS_U), (const bf16_t*)(ws + WS_WIN), T, INWP, D, E); } PHASE_END
        PHASE_BEGIN
            for (int rep_ = 0; rep_ < REP_MISC; ++rep_) { ph_loraprep(P, l);
            for (int it = blockIdx.x; it < NB * 128 * 6 + NB * 4 * 6; it += gridDim.x) vt_tile(P, it, (unsigned short*)smem); }
            for (int rep_ = 0; rep_ < REP_HY; ++rep_) for (int it = blockIdx.x; it < 512; it += gridDim.x) hy_spec_task(P, l, it >> 8, it & 255, X, ex);
        PHASE_END
        PHASE_BEGIN { EpiLora E{(bf16_t*)(ws + WS_LORAO), (bf16_t*)(ws + WS_GATE)};
            for (int rep_ = 0; rep_ < REP_GEMM; ++rep_) run_gemm(lds3, (const bf16_t*)(ws + WS_ALORA), (const bf16_t*)(ws + WS_WLORA), T, 2048, 384, E); } PHASE_END
        PHASE_BEGIN
            for (int rep_ = 0; rep_ < REP_MISC; ++rep_) ph_rwkvprep(P, l);
            for (int rep_ = 0; rep_ < REP_HY; ++rep_) for (int c = blockIdx.x; c < HYC; c += gridDim.x) hy_task1(P, l, c, X, ex);
        PHASE_END
        PHASE_BEGIN {
            const int wv = __builtin_amdgcn_readfirstlane(otid() >> 6);
            if (wv < 4) { const int k = wv * (int)gridDim.x + (int)blockIdx.x;
                if (k < 24 * NSEG) { const int chain = k / NSEG, g = k % NSEG; float* ring = ldsf + wv * (SCH * 320);
                    __builtin_amdgcn_s_setprio(3);
                    for (int rep_ = 0; rep_ < REP_SCAN; ++rep_) { if (g == 0) scan_seg<false>(P, chain, g, ring); else scan_seg<true>(P, chain, g, ring); }
                    __builtin_amdgcn_s_setprio(0); } }
            else for (int it = (wv - 4) * (int)gridDim.x + (int)blockIdx.x; it < NAT_TASKS; it += 4 * (int)gridDim.x) natten_task(P, l, it);
        } PHASE_END
        PHASE_BEGIN
            if (blockIdx.x < 24) scan_combine(P, blockIdx.x, ldsf);
            else for (int rep_ = 0; rep_ < REP_HY; ++rep_) for (int c = blockIdx.x - 24; c < HYC; c += gridDim.x - 24) hy_task2(P, l, c, X);
        PHASE_END
        PHASE_BEGIN for (int rep_ = 0; rep_ < REP_MISC; ++rep_) ph_rwkvout(P, l, ldsf); PHASE_END
        PHASE_BEGIN { EpiF32 E{(bf16_t*)(ws + WS_Y), (float*)(ws + WS_YC)}; run_gemm_tail(lds3, (const bf16_t*)(ws + WS_U), (const bf16_t*)(ws + WS_WOUT), D, E); } PHASE_END
        PHASE_BEGIN ph_rowpass(P, 1, l, 5, 3, 1.0f, l, 4, 6, 7, 4); PHASE_END
        PHASE_BEGIN { EpiGU E{(bf16_t*)(ws + WS_ACT)}; for (int rep_ = 0; rep_ < REP_GEMM; ++rep_) run_gemm(lds3, (const bf16_t*)(ws + WS_U), (const bf16_t*)(ws + WS_WGU2), T, 2 * DFF, D, E); } PHASE_END
        PHASE_BEGIN { EpiF32 E{(bf16_t*)(ws + WS_Y), (float*)(ws + WS_YC)}; run_gemm_tail(lds3, (const bf16_t*)(ws + WS_ACT), (const bf16_t*)(ws + WS_WDN2), DFF, E); } PHASE_END
    }
    PHASE_BEGIN ph_rowpass(P, 2, DEPTH - 1, 8, 5, 0.5f, 0, 0, 0, 0, 11); PHASE_END
#undef PHASE_BEGIN
#undef PHASE_END
}
constexpr int N_PHASES = 1 + DEPTH * 15 + 1;

extern "C" void kernel_launch(void* const* d_in, const int* in_sizes, int n_in, void* d_out, int out_size, void* d_ws, size_t ws_size, hipStream_t stream) {
    static int grid = 0;
    if (grid == 0) {
        if (n_in != 34 || ws_size < WS_END) { fprintf(stderr, "kernel_launch: need 34 inputs and %zu bytes of workspace; got %d, %zu\n", (size_t)WS_END, n_in, ws_size); grid = -1; return; }
        int dev = 0, cus = 0, per_cu = 0;
        hipGetDevice(&dev); hipDeviceGetAttribute(&cus, hipDeviceAttributeMultiprocessorCount, dev);
        if (hipFuncSetAttribute((const void*)fwd_megakernel, hipFuncAttributeMaxDynamicSharedMemorySize, LDS_BYTES) != hipSuccess) { fprintf(stderr, "kernel_launch: hipFuncSetAttribute failed\n"); grid = -1; return; }
        if (hipOccupancyMaxActiveBlocksPerMultiprocessor(&per_cu, (const void*)fwd_megakernel, NTHR, LDS_BYTES) != hipSuccess || per_cu < 1) { fprintf(stderr, "kernel_launch: occupancy query says %d\n", per_cu); per_cu = 1; }
        (void)hipGetLastError();
        grid = cus;
    }
    if (grid < 0) return;
    if (hipMemsetAsync((char*)d_ws + WS_BAR, 0, (size_t)XCD_BAR_WORDS * 4, stream) != hipSuccess) { fprintf(stderr, "kernel_launch: memset of the barrier words failed\n"); return; }
    Params p{};
    for (int i = 0; i < 34; ++i) p.in[i] = (const float*)d_in[i];
    p.out = (float*)d_out; p.ws = (unsigned char*)d_ws;
#if MK_SPLIT
    for (int ph = 0; ph < N_PHASES; ++ph) { int lo = ph, hi = ph + 1; hipLaunchKernelGGL(fwd_megakernel, dim3(grid), dim3(NTHR), LDS_BYTES, stream, p, lo, hi); }
#else
    int lo = 0, hi = N_PHASES;
    void* args[] = {&p, &lo, &hi};
    hipError_t e = hipLaunchCooperativeKernel((const void*)fwd_megakernel, dim3(grid), dim3(NTHR), args, LDS_BYTES, stream);
    if (e != hipSuccess) fprintf(stderr, "cooperative launch failed: %s (grid %d)\n", hipGetErrorString(e), grid);
#endif
}
```

```cpp
#include <hip/hip_runtime.h>
#include <hip/hip_cooperative_groups.h>
#include <cstdio>
namespace cg = cooperative_groups;
__device__ __forceinline__ int otid() { int t = threadIdx.x; asm volatile("" : "+v"(t)); return t; }
namespace pg8 {
#define PG8_LAS __attribute__((address_space(3)))
typedef unsigned short bf16_t;
typedef short bf16x8 __attribute__((ext_vector_type(8)));
typedef float f32x4 __attribute__((ext_vector_type(4)));
typedef unsigned u32x4 __attribute__((ext_vector_type(4)));
constexpr int BM = 256, BK = 64, HALF = 128, HTB = HALF * BK * 2  , STAGE_BYTES = 8 * HTB, NXCD = 8, WGM = 8;

__host__ __device__ __forceinline__ int lds_byte(int r, int c) { const int st = (r >> 4) * 2 + (c >> 5), rr = r & 15, cc = c & 31, ob = rr * 64 + cc * 2; return st * 1024 + (ob ^ (((ob >> 9) & 1) << 5)); }
__host__ __device__ __forceinline__ void stage_rc(int b, int& R, int& C) { const int st = b / 1024, sb = b % 1024, swz = sb ^ (((sb >> 9) & 1) << 5); R = (st >> 1) * 16 + swz / 64; C = (st & 1) * 32 + (swz % 64) / 2; }
__host__ __device__ __forceinline__ int perm32(int rho) { const int n = rho >> 4, i = rho & 15; return 8 * (i >> 2) + 4 * n + (i & 3); }

struct Unit { int pm, pn, kt0, nkt; };
struct Gemm { const bf16_t* A; const bf16_t* Bt; int M, N, K; };
struct StaticOrder {
    int nM, nN, nwg, G, c;
    __host__ __device__ void init(int M, int N, int G_, int c_) { nM = M / BM; nN = N / BM; nwg = nM * nN; G = G_; c = c_; }
    __host__ __device__ bool next(int i, Unit& u) const {
        const long L = (long)i * G + c; if (L >= nwg) return false;
        int wgid = (int)L; { const int q = nwg / NXCD, r = nwg % NXCD, xcd = wgid % NXCD, off = wgid / NXCD; wgid = (xcd < r ? xcd * (q + 1) : r * (q + 1) + (xcd - r) * q) + off; }
        const int nig = WGM * nN, gid = wgid / nig, fm = gid * WGM, gsz = (nM - fm) < WGM ? (nM - fm) : WGM;
        u.pm = fm + ((wgid % nig) % gsz); u.pn = (wgid % nig) / gsz; u.kt0 = 0; u.nkt = 0; return true;
    }
    __device__ __forceinline__ void a_ready(const Unit&) const {}
    __device__ __forceinline__ void done(const Unit&) const {}
};
__device__ __forceinline__ unsigned cvt_pk_bf16(float lo, float hi) { unsigned r; asm volatile("v_cvt_pk_bf16_f32 %0, %1, %2" : "=v"(r) : "v"(lo), "v"(hi)); return r; }
template <class Epi, class Sched>
__device__ __forceinline__ void gemm_phase(PG8_LAS unsigned char* lds, const Gemm g, const Sched& S, const Epi& E) {
    const int tid = otid(), wid = __builtin_amdgcn_readfirstlane(tid >> 6), lane = tid & 63, wr = wid >> 2, wc = wid & 3, fr = lane & 15, fq = lane >> 4;
    const int K = g.K, nt = K / BK;
#define PG8_STAMP() do {} while (0)
    unsigned voffA[2], voffB[2];
#pragma unroll
    for (int i = 0; i < 2; ++i) { int R, C; stage_rc(tid * 16 + i * 8192, R, C); const int Rb = Epi::PERM ? ((R & ~31) + perm32(R & 31)) : R;
        voffA[i] = (unsigned)(R * K + C) * 2u; voffB[i] = (unsigned)(Rb * K + C) * 2u; }
    const size_t kstep = (size_t)(BK * 2);
    const size_t hstep = (size_t)HALF * K * 2;
    const size_t tstep = 2 * hstep;
    const unsigned ldsw = (unsigned)wid * 1024u;
    const int aoff = lds_byte(wr * 64 + fr, fq * 8), boff = lds_byte(wc * 32 + fr, fq * 8);
#define PG8_SA(b, h) (((b) * 2 + (h)) * HTB)
#define PG8_SB(b, h) ((4 + (b) * 2 + (h)) * HTB)
#define PG8_STAGE(bufoff, gbase, voff) do { _Pragma("unroll") for (int _i = 0; _i < 2; ++_i) \
        __builtin_amdgcn_global_load_lds((const unsigned*)((const char*)(gbase) + (voff)[_i]), (PG8_LAS unsigned*)(lds + (bufoff) + ldsw + _i * 8192), 16, 0, 0); } while (0)
#define PG8_LDA(dst, b, h) do { _Pragma("unroll") for (int m = 0; m < 4; ++m) _Pragma("unroll") for (int k = 0; k < 2; ++k) dst[m][k] = *(const PG8_LAS bf16x8*)(lds + PG8_SA(b, h) + aoff + m * 2048 + k * 1024); } while (0)
#define PG8_LDB(dst, b, h) do { _Pragma("unroll") for (int n = 0; n < 2; ++n) _Pragma("unroll") for (int k = 0; k < 2; ++k) dst[n][k] = *(const PG8_LAS bf16x8*)(lds + PG8_SB(b, h) + boff + n * 2048 + k * 1024); } while (0)
#define PG8_MMA(ai, bj, At, Bt) do { __builtin_amdgcn_s_setprio(1); _Pragma("unroll") for (int m = 0; m < 4; ++m) _Pragma("unroll") for (int n = 0; n < 2; ++n) _Pragma("unroll") for (int k = 0; k < 2; ++k) \
        acc[ai][bj][m][n] = __builtin_amdgcn_mfma_f32_16x16x32_bf16(Bt[n][k], At[m][k], acc[ai][bj][m][n], 0, 0, 0); __builtin_amdgcn_s_setprio(0); } while (0)
#define PG8_WAIT_V(n) asm volatile("s_waitcnt vmcnt(" #n ")" ::: "memory")
#define PG8_WAIT_L(n) asm volatile("s_waitcnt lgkmcnt(" #n ")" ::: "memory")
#define PG8_BAR __builtin_amdgcn_s_barrier()
#define PG8_SCHED __builtin_amdgcn_sched_barrier(0)
    Unit cur, nxt; int ui = 0;
    if (!S.next(0, cur)) return;
    f32x4 acc[2][2][4][2];
#pragma unroll
    for (int a = 0; a < 2; ++a)
#pragma unroll
        for (int b = 0; b < 2; ++b)
#pragma unroll
            for (int m = 0; m < 4; ++m)
#pragma unroll
                for (int n = 0; n < 2; ++n) acc[a][b][m][n] = (f32x4){0.f, 0.f, 0.f, 0.f};
    bf16x8 At[4][2], B0[2][2], B1[2][2];
    const char* cA = (const char*)g.A + (size_t)cur.pm * tstep + (size_t)cur.kt0 * kstep; const char* cB = (const char*)g.Bt + (size_t)cur.pn * tstep + (size_t)cur.kt0 * kstep;
    int ntc = cur.nkt > 0 ? cur.nkt : nt;
    S.a_ready(cur);
    PG8_STAGE(PG8_SB(0, 0), cB, voffB); PG8_STAGE(PG8_SA(0, 0), cA, voffA); PG8_STAGE(PG8_SB(0, 1), cB + hstep, voffB); PG8_STAGE(PG8_SA(0, 1), cA + hstep, voffA);
    if (wr == 1) PG8_BAR;
    PG8_WAIT_V(4); PG8_BAR;
    PG8_STAGE(PG8_SB(1, 0), cB + kstep, voffB); PG8_STAGE(PG8_SA(1, 0), cA + kstep, voffA); PG8_STAGE(PG8_SB(1, 1), cB + hstep + kstep, voffB);
    PG8_WAIT_V(6); PG8_BAR;
    PG8_STAMP();
    for (;;) {
        const bool has_next = S.next(ui + 1, nxt);
        const char* nA = has_next ? (const char*)g.A + (size_t)nxt.pm * tstep + (size_t)nxt.kt0 * kstep : cA; const char* nB = has_next ? (const char*)g.Bt + (size_t)nxt.pn * tstep + (size_t)nxt.kt0 * kstep : cB;
        for (int t = 0; t < ntc; t += 2) {
            const bool last = (t == ntc - 2);
            const char* a1 = cA + (size_t)(t + 1) * kstep;
            const char* a2 = last ? nA : cA + (size_t)(t + 2) * kstep; const char* b2 = last ? nB : cB + (size_t)(t + 2) * kstep;
            const char* a3 = a2 + kstep; const char* b3 = b2 + kstep;
            if (last && has_next) S.a_ready(nxt);
            PG8_LDB(B0, 0, 0); PG8_SCHED; PG8_LDA(At, 0, 0); PG8_STAGE(PG8_SA(1, 1), a1 + hstep, voffA);
            PG8_WAIT_L(8); PG8_BAR; PG8_WAIT_L(0); PG8_MMA(0, 0, At, B0); PG8_BAR; PG8_SCHED;
            PG8_LDB(B1, 0, 1); PG8_STAGE(PG8_SB(0, 0), b2, voffB);
            PG8_BAR; PG8_WAIT_L(0); PG8_MMA(0, 1, At, B1); PG8_BAR;
            PG8_LDA(At, 0, 1); PG8_STAGE(PG8_SA(0, 0), a2, voffA);
            PG8_BAR; PG8_WAIT_L(0); PG8_MMA(1, 0, At, B0); PG8_BAR; PG8_SCHED;
            PG8_STAGE(PG8_SB(0, 1), b2 + hstep, voffB);
            PG8_WAIT_V(6); PG8_BAR; PG8_MMA(1, 1, At, B1); PG8_BAR;
            PG8_LDB(B0, 1, 0); PG8_SCHED; PG8_LDA(At, 1, 0); PG8_STAGE(PG8_SA(0, 1), a2 + hstep, voffA);
            PG8_WAIT_L(8); PG8_BAR; PG8_WAIT_L(0); PG8_MMA(0, 0, At, B0); PG8_BAR; PG8_SCHED;
            PG8_LDB(B1, 1, 1); PG8_STAGE(PG8_SB(1, 0), b3, voffB);
            PG8_BAR; PG8_WAIT_L(0); PG8_MMA(0, 1, At, B1); PG8_BAR;
            PG8_LDA(At, 1, 1); PG8_STAGE(PG8_SA(1, 0), a3, voffA);
            PG8_BAR; PG8_WAIT_L(0); PG8_MMA(1, 0, At, B0); PG8_BAR; PG8_SCHED;
            PG8_STAGE(PG8_SB(1, 1), b3 + hstep, voffB);
            PG8_WAIT_V(6); PG8_BAR; PG8_MMA(1, 1, At, B1); PG8_BAR;
        }
        PG8_STAMP();
        if constexpr (!Epi::AFTER_DRAIN) { E(acc, cur, wr, wc, fr, fq); S.done(cur); }
        PG8_STAMP();
        if (!has_next) break;
#pragma unroll
        for (int a = 0; a < 2; ++a)
#pragma unroll
            for (int b = 0; b < 2; ++b)
#pragma unroll
                for (int m = 0; m < 4; ++m)
#pragma unroll
                    for (int n = 0; n < 2; ++n) acc[a][b][m][n] = (f32x4){0.f, 0.f, 0.f, 0.f};
        cur = nxt; cA = nA; cB = nB; ++ui; ntc = cur.nkt > 0 ? cur.nkt : nt;
    }
    PG8_WAIT_V(0);
    if (wr == 0) PG8_BAR;
    PG8_BAR;
    if constexpr (Epi::AFTER_DRAIN) { E.fused(acc, cur, wr, wc, fr, fq, lds, wid, lane); S.done(cur); }
    PG8_STAMP();
#undef PG8_STAMP
#undef PG8_SA
#undef PG8_SB
#undef PG8_STAGE
#undef PG8_LDA
#undef PG8_LDB
#undef PG8_MMA
#undef PG8_WAIT_V
#undef PG8_WAIT_L
#undef PG8_BAR
#undef PG8_SCHED
}
}
#define LAS __attribute__((address_space(3)))
#define XB_TMO      128
#define XB_XCNT(j)  (256  + 64 * (j))
#define XB_XSUB(j)  (1280 + 64 * (j))
#define XB_XGEN(j)  (2304 + 64 * (j))
#define XB_TOP      3328
#define XB_TOPGEN   3392
#define XCD_BAR_WORDS 3456
#define XB_SPIN_CAP (1u << 18)

__device__ __forceinline__ unsigned xb_ld(unsigned* p)              { return __hip_atomic_load(p, __ATOMIC_RELAXED, __HIP_MEMORY_SCOPE_AGENT); }
__device__ __forceinline__ unsigned xb_add(unsigned* p, unsigned v) { return __hip_atomic_fetch_add(p, v, __ATOMIC_RELAXED, __HIP_MEMORY_SCOPE_AGENT); }
__device__ __forceinline__ unsigned xb_xcc_id() { return (unsigned)__builtin_amdgcn_s_getreg((3 << 11) | 20) & 0xFu; }
#define XB_SPIN(cond, bar) do { unsigned _sp = 0; while (cond) { __builtin_amdgcn_s_sleep(1); \
    if ((++_sp & 255u) == 0u) { if (xb_ld(&(bar)[XB_TMO])) break; if (_sp > XB_SPIN_CAP) { atomicAdd(&(bar)[XB_TMO], 1u); break; } } } } while (0)

struct XcdBarrier {
    unsigned* bar; unsigned x;
    volatile LAS unsigned* st;
};

__device__ __forceinline__ XcdBarrier xcd_barrier_post(unsigned* bar, volatile LAS unsigned* st) {
    XcdBarrier b; b.bar = bar; b.x = xb_xcc_id(); b.st = st;
    if (threadIdx.x == 0) (void)xb_add(&bar[XB_XCNT(b.x)], 1u);
    return b;
}
__device__ __forceinline__ void xcd_barrier_complete(unsigned* bar, unsigned x, unsigned& nloc, unsigned& nx) {
    const unsigned G = gridDim.x * gridDim.y * gridDim.z;
    unsigned sum, cnt, mine, sp = 0u;
    for (;;) {
        sum = 0u; cnt = 0u; mine = 0u;
#pragma unroll
        for (unsigned j = 0; j < 16; ++j) { const unsigned c = xb_ld(&bar[XB_XCNT(j)]); sum += c; cnt += (c > 0u) ? 1u : 0u; mine = (j == x) ? c : mine; }
        if (sum == G) break;
        __builtin_amdgcn_s_sleep(1);
        if ((++sp & 255u) == 0u) { if (xb_ld(&bar[XB_TMO])) break; if (sp > XB_SPIN_CAP) { atomicAdd(&bar[XB_TMO], 1u); break; } }
    }
    nloc = mine > 0u ? mine : 1u; nx = cnt > 0u ? cnt : 1u;
}

__device__ __forceinline__ void xcd_barrier(const XcdBarrier& b) {
    asm volatile("s_waitcnt vmcnt(0)" ::: "memory");
    __syncthreads();
    if (threadIdx.x == 0) {
        unsigned* bar = b.bar;
        __builtin_amdgcn_s_waitcnt(0);
        unsigned nloc = b.st[0], nx = b.st[1];
        if (nloc == 0u) { xcd_barrier_complete(bar, b.x, nloc, nx); b.st[0] = nloc; b.st[1] = nx; }
        const unsigned old = xb_add(&bar[XB_XSUB(b.x)], 1u);
        const unsigned gen = old / nloc;
        if (old + 1u == (gen + 1u) * nloc) {
            __builtin_amdgcn_fence(__ATOMIC_RELEASE, "agent");
            asm volatile("s_waitcnt vmcnt(0)" ::: "memory");
            const unsigned og = xb_add(&bar[XB_TOP], 1u);
            const unsigned tg = og / nx;
            if (og + 1u == (tg + 1u) * nx) xb_add(&bar[XB_TOPGEN], 1u);
            else XB_SPIN(xb_ld(&bar[XB_TOPGEN]) == tg, bar);
            __builtin_amdgcn_fence(__ATOMIC_ACQUIRE, "agent");
            xb_add(&bar[XB_XGEN(b.x)], 1u);
            asm volatile("s_waitcnt vmcnt(0)" ::: "memory");
        } else {
            XB_SPIN(xb_ld(&bar[XB_XGEN(b.x)]) == gen, bar);
            __builtin_amdgcn_fence(__ATOMIC_ACQUIRE, "agent");
            asm volatile("s_waitcnt vmcnt(0)" ::: "memory");
        }
    }
    __syncthreads();
}

using pg8::bf16_t; using pg8::f32x4; using pg8::u32x4; using pg8::cvt_pk_bf16;
typedef unsigned u32x2 __attribute__((ext_vector_type(2)));


constexpr int D = 1024, NB = 2, SEQ = 8192, DEPTH = 4, CTX = 256, DFF = 2816;
constexpr int TL = NB * SEQ, TC = NB * CTX, T = TL + TC;
constexpr int NMOD = 9 * D;
constexpr int HYC = 256, RWW = 384, NAW = 384, INW = 3456, INWP = 3584;
constexpr int HY_IN = 768, RW_IN = 1536, NA_IN = 1152;
constexpr int NFFT = 16384;
constexpr int NTHR = 512, NWAVE = 8;
constexpr int LDS_MAIN = 131072, LDS_EXTRA = 8192, LDS_BYTES = LDS_MAIN + LDS_EXTRA;
constexpr float NORM_EPS = 1e-6f;

constexpr size_t al256(size_t x) { return (x + 255) & ~(size_t)255; }
constexpr size_t WS_MODV = 0;
constexpr size_t WS_WGU1 = al256(WS_MODV + (size_t)DEPTH * 3 * NMOD * 4);
constexpr size_t WS_WDN1 = WS_WGU1 + (size_t)2 * DFF * D * 2;
constexpr size_t WS_WGU2 = WS_WDN1 + (size_t)D * DFF * 2;
constexpr size_t WS_WDN2 = WS_WGU2 + (size_t)2 * DFF * D * 2;
constexpr size_t WS_WIN = WS_WDN2 + (size_t)D * DFF * 2;
constexpr size_t WS_WOUT = WS_WIN + (size_t)INWP * D * 2;
constexpr size_t WS_WLORA = WS_WOUT + (size_t)D * D * 2;
constexpr size_t WS_H = WS_WLORA + (size_t)2048 * 384 * 2;
constexpr size_t WS_U = WS_H + (size_t)T * D * 4;
constexpr size_t WS_S = WS_U + (size_t)T * D * 2;
constexpr size_t WS_Y = WS_S;
constexpr size_t WS_ACT = WS_Y + (size_t)T * D * 4;
constexpr size_t WS_FFN_END = WS_ACT + (size_t)T * DFF * 2;
constexpr size_t WS_PHY = WS_S;
constexpr size_t WS_PRW = WS_PHY + (size_t)T * HY_IN * 2;
constexpr size_t WS_YDIR = WS_PRW;
constexpr size_t WS_PNA = WS_PRW + (size_t)T * RW_IN * 2;
constexpr size_t WS_ALORA = WS_PNA + (size_t)T * NA_IN * 2;
constexpr size_t WS_DECAY = WS_ALORA + (size_t)T * 384 * 2;
constexpr size_t WS_LORAO = WS_DECAY + (size_t)2 * T * 384 * 4;
constexpr size_t WS_E = WS_LORAO;
constexpr size_t WS_ZP = WS_E + (size_t)24 * SEQ * 64 * 2;
constexpr size_t WS_GATE = WS_LORAO + (size_t)T * 1536 * 2;
static_assert(WS_ZP + (size_t)24 * 33 * 2 * 4096 * 4 <= WS_GATE, "E + ZP must fit in the LORAO region");
constexpr size_t WS_RS = WS_GATE + (size_t)T * 384 * 2;
constexpr size_t WS_KKS = WS_RS + (size_t)T * 384 * 2;
constexpr size_t WS_VS = WS_KKS + (size_t)T * 384 * 2;
constexpr size_t WS_KS = WS_VS + (size_t)T * 384 * 2;
constexpr size_t WS_BS = WS_KS + (size_t)2 * T * 384 * 2;
constexpr size_t WS_BONUS = WS_BS + (size_t)2 * T * 384 * 2;
constexpr size_t WS_FILT = al256(WS_BONUS + (size_t)T * 6 * 4);
constexpr size_t WS_FILTC = WS_FILT + (size_t)1024 * SEQ * 2;
constexpr size_t WS_SPEC = WS_FILTC + (size_t)1024 * CTX * 2;
constexpr size_t WS_Z1 = WS_SPEC + (size_t)512 * NFFT * 8;
constexpr size_t WS_VTL = WS_Z1 + (size_t)HYC * NB * SEQ * 4;
constexpr size_t WS_VTC = WS_VTL + (size_t)NB * 6 * 64 * SEQ * 2;
constexpr size_t WS_MIX_END = WS_VTC + (size_t)NB * 6 * 64 * CTX * 2;
constexpr size_t WS_BAR = al256(WS_MIX_END > WS_FFN_END ? WS_MIX_END : WS_FFN_END);
constexpr size_t WS_ROPE = al256(WS_BAR + (size_t)XCD_BAR_WORDS * 4);
constexpr size_t WS_YC = WS_FFN_END + (size_t)(8 << 20);
static_assert(WS_YC + (size_t)11 * TC * D * 4 <= WS_FILT, "YC partials must stay below the filter tables");
constexpr size_t WS_END = WS_ROPE + (size_t)128 * 16 * 8;
static_assert(WS_END <= (size_t)4 * DEPTH * D * NMOD * 4, "workspace map exceeds 4x the largest input tensor");

struct Params { const float* in[34]; float* out; unsigned char* ws; };
enum { I_X = 0, I_C, I_CTX, I_CCTX, I_MODW, I_MODB, I_NORMG, I_F1GU, I_F1DN, I_F2GU, I_F2DN, I_WIN, I_WOUT, I_HCW, I_HCB, I_HW1, I_HB1, I_HW2, I_HB2, I_HW3, I_HFREQ, I_HBIAS,
       I_MU, I_W0, I_W2, I_A0, I_A2, I_G2, I_KK, I_KA, I_RK, I_LNW, I_LNB, I_RPB };

typedef LAS float* ldsfp;
__device__ __forceinline__ ldsfp vlds(const void* p) { ldsfp q = (ldsfp)p; asm volatile("" : "+v"(q)); return q; }
__device__ __forceinline__ float bf2f(bf16_t b) { return __uint_as_float(((unsigned)b) << 16); }
__device__ __forceinline__ bf16_t f2bf(float f) { unsigned u = __float_as_uint(f); u += 0x7FFFu + ((u >> 16) & 1u); return (bf16_t)(u >> 16); }
__device__ __forceinline__ float lo_bf(unsigned w) { return __uint_as_float(w << 16); }
__device__ __forceinline__ float hi_bf(unsigned w) { return __uint_as_float(w & 0xffff0000u); }
__device__ __forceinline__ float wsum(float v) {
#pragma unroll
    for (int o = 32; o > 0; o >>= 1) v += __shfl_xor(v, o);
    return v;
}
__device__ __forceinline__ float sigmoidf_(float x) { return __builtin_amdgcn_rcpf(1.0f + __expf(-x)); }
__device__ __forceinline__ void unpack8(const u32x4 w, float (&f)[8]) {
    f[0] = lo_bf(w.x); f[1] = hi_bf(w.x); f[2] = lo_bf(w.y); f[3] = hi_bf(w.y); f[4] = lo_bf(w.z); f[5] = hi_bf(w.z); f[6] = lo_bf(w.w); f[7] = hi_bf(w.w);
}
__device__ __forceinline__ void row_nbrs(int row, bool& hasp, bool& hasn) {
    if (row < TL) { const int t = row & (SEQ - 1); hasp = t > 0; hasn = t < SEQ - 1; }
    else { const int t = (row - TL) & (CTX - 1); hasp = t > 0; hasn = t < CTX - 1; }
}

__device__ __forceinline__ void ph_modv(const Params& P, float* lds) {
    const int tid = otid();
    float* sv = lds;
    float* red = lds + 3072;
    for (int i = tid; i < 3072; i += NTHR) { const int s = i >> 10, k = i & 1023; const float c = s < 2 ? P.in[I_C][s * 1024 + k] : P.in[I_CCTX][k]; sv[i] = c / (1.0f + expf(-c)); }
    __syncthreads();
    if (blockIdx.x < 4) { const int e = blockIdx.x * NTHR + tid, pos = e >> 4, f = e & 15; float sn, cs; sincosf((float)pos * expf(-(float)f * (9.210340371976184f / 16.0f)), &sn, &cs); ((float2*)(P.ws + WS_ROPE))[e] = make_float2(cs, sn); }
    float* modv = (float*)(P.ws + WS_MODV);
    const int kc = tid >> 6, cl = tid & 63;
    for (int item = blockIdx.x; item < DEPTH * 144; item += gridDim.x) {
        const int l = item / 144, cb = item % 144, col = cb * 64 + cl;
        const float* w = P.in[I_MODW] + ((size_t)l * 1024 + kc * 128) * NMOD + col;
        float a0 = 0.f, a1 = 0.f, a2 = 0.f;
#pragma unroll 8
        for (int k = 0; k < 128; ++k) { const float wv = w[(size_t)k * NMOD]; a0 += sv[kc * 128 + k] * wv; a1 += sv[1024 + kc * 128 + k] * wv; a2 += sv[2048 + kc * 128 + k] * wv; }
        red[(0 * 8 + kc) * 64 + cl] = a0; red[(1 * 8 + kc) * 64 + cl] = a1; red[(2 * 8 + kc) * 64 + cl] = a2;
        __syncthreads();
        if (tid < 192) { const int s = tid >> 6, c = tid & 63; float r = P.in[I_MODB][l * NMOD + cb * 64 + c];
#pragma unroll
            for (int q = 0; q < 8; ++q) r += red[(s * 8 + q) * 64 + c];
            modv[((size_t)l * 3 + s) * NMOD + cb * 64 + c] = r; }
        __syncthreads();
    }
}

__device__ __forceinline__ float hy_delta(int c);
__device__ __forceinline__ int rowmap_gu(int n) { const int up = n >= DFF ? 1 : 0; const int j = n - up * DFF; return (j >> 7) * 256 + up * 128 + (j & 127); }
__device__ __forceinline__ void conv_tile(const float* __restrict__ src, int K, int N, bf16_t* __restrict__ dst, int tk, int tn, bool gu, float* tile) {
    const int tid = otid(); const int k0 = tk * 64, n0 = tn * 64;
#pragma unroll
    for (int rr = 0; rr < 2; ++rr) { const int kk = (tid >> 4) + rr * 32, n4 = (tid & 15) * 4; const float4 v = *(const float4*)(src + (size_t)(k0 + kk) * N + n0 + n4);
        tile[kk * 65 + n4 + 0] = v.x; tile[kk * 65 + n4 + 1] = v.y; tile[kk * 65 + n4 + 2] = v.z; tile[kk * 65 + n4 + 3] = v.w; }
    __syncthreads();
    { const int nn = tid >> 3, ks = (tid & 7) * 8; const int n = n0 + nn; const int row = gu ? rowmap_gu(n) : n;
      u32x4 w; w.x = cvt_pk_bf16(tile[(ks + 0) * 65 + nn], tile[(ks + 1) * 65 + nn]); w.y = cvt_pk_bf16(tile[(ks + 2) * 65 + nn], tile[(ks + 3) * 65 + nn]);
      w.z = cvt_pk_bf16(tile[(ks + 4) * 65 + nn], tile[(ks + 5) * 65 + nn]); w.w = cvt_pk_bf16(tile[(ks + 6) * 65 + nn], tile[(ks + 7) * 65 + nn]);
      *(u32x4*)(dst + (size_t)row * K + k0 + ks) = w; }
    __syncthreads();
}
__device__ __forceinline__ void ph_prep(const Params& P, int l, float* lds) {
    const int tid = otid();
    unsigned char* ws = P.ws;
    constexpr int N0 = 16 * 88, N1 = 44 * 16, N4 = 16 * 54, N5 = 16 * 16;
    constexpr int C0 = N0, C1 = C0 + N1, C2 = C1 + N0, C3 = C2 + N1, C4 = C3 + N4, C5 = C4 + N5;
    for (int it = blockIdx.x; it < C5; it += gridDim.x) {
        if (it < C0) { conv_tile(P.in[I_F1GU] + (size_t)l * D * 2 * DFF, D, 2 * DFF, (bf16_t*)(ws + WS_WGU1), it / 88, it % 88, true, lds); }
        else if (it < C1) { const int j = it - C0; conv_tile(P.in[I_F1DN] + (size_t)l * DFF * D, DFF, D, (bf16_t*)(ws + WS_WDN1), j / 16, j % 16, false, lds); }
        else if (it < C2) { const int j = it - C1; conv_tile(P.in[I_F2GU] + (size_t)l * D * 2 * DFF, D, 2 * DFF, (bf16_t*)(ws + WS_WGU2), j / 88, j % 88, true, lds); }
        else if (it < C3) { const int j = it - C2; conv_tile(P.in[I_F2DN] + (size_t)l * DFF * D, DFF, D, (bf16_t*)(ws + WS_WDN2), j / 16, j % 16, false, lds); }
        else if (it < C4) { const int j = it - C3; conv_tile(P.in[I_WIN] + (size_t)l * D * INW, D, INW, (bf16_t*)(ws + WS_WIN), j / 54, j % 54, false, lds); }
        else { const int j = it - C4; conv_tile(P.in[I_WOUT] + (size_t)l * D * D, D, D, (bf16_t*)(ws + WS_WOUT), j / 16, j % 16, false, lds); }
    }
    const int gtid = blockIdx.x * NTHR + tid, gn = gridDim.x * NTHR;
    { unsigned* z = (unsigned*)(ws + WS_WIN + (size_t)INW * D * 2); for (int i = gtid; i < (INWP - INW) * D / 2; i += gn) z[i] = 0u; }
    { bf16_t* wl = (bf16_t*)(ws + WS_WLORA);
      const float* w2 = P.in[I_W2] + (size_t)l * 2 * 64 * RWW; const float* a2 = P.in[I_A2] + (size_t)l * 2 * 64 * RWW; const float* g2 = P.in[I_G2] + (size_t)l * 128 * RWW;
      for (int i = gtid; i < 2048 * 384; i += gn) { const int k = i / 2048, j = i % 2048; float v = 0.f;
          if (j < 1920) { const int grp = j / 384, c = j % 384;
              if (grp == 0) { if (k < 64) v = w2[(size_t)k * RWW + c]; }
              else if (grp == 1) { if (k >= 64 && k < 128) v = w2[(size_t)(64 + k - 64) * RWW + c]; }
              else if (grp == 2) { if (k >= 128 && k < 192) v = a2[(size_t)(k - 128) * RWW + c]; }
              else if (grp == 3) { if (k >= 192 && k < 256) v = a2[(size_t)(64 + k - 192) * RWW + c]; }
              else { if (k >= 256) v = g2[(size_t)(k - 256) * RWW + c]; } }
          wl[(size_t)j * 384 + k] = f2bf(v); } }
    { const float* w1_ = P.in[I_HW1] + (size_t)l * 33 * 64; const float* b1 = P.in[I_HB1] + l * 64; const float* w2f_ = P.in[I_HW2] + (size_t)l * 64 * 64; const float* b2 = P.in[I_HB2] + l * 64;
      const float* fqv = P.in[I_HFREQ] + l * 64; const float* w3 = P.in[I_HW3] + (size_t)l * 64 * 1024;
      const int lane = tid & 63, wv = tid >> 6;
      const float fq = fqv[lane], bb1 = b1[lane], bb2 = b2[lane];
      const ldsfp hl = vlds(lds);
      for (int task = blockIdx.x; task < 264; task += gridDim.x) {
          const int L = task < 256 ? SEQ : CTX, n0 = task < 256 ? task * 32 : (task - 256) * 32;
          __syncthreads();
#pragma unroll 1
          for (int pp = 0; pp < 4; ++pp) { const int p = wv * 4 + pp, pos = n0 + p;
              const float* w1 = w1_; const float* w2f = w2f_; asm volatile("" : "+s"(w1), "+s"(w2f));
              const float tt = (float)pos / (float)(L - 1);
              const float ang = 6.283185307179586f * (float)pos / (float)L;
              float z = 0.f;
              if (lane == 0) z = tt;
              else if (lane <= 16) { const float fr = 1e-4f + (float)(lane - 1) * ((15.0f - 1e-4f) / 15.0f); z = cosf(fr * ang); }
              else if (lane <= 32) { const float fr = 1e-4f + (float)(lane - 17) * ((15.0f - 1e-4f) / 15.0f); z = -sinf(fr * ang); }
              float a = bb1;
#pragma unroll
              for (int e = 0; e < 33; ++e) a += __shfl(z, e) * w1[e * 64 + lane];
              const float h1 = sinf(fq * a);
              float c = bb2;
#pragma unroll
              for (int i = 0; i < 64; ++i) c += __shfl(h1, i) * w2f[i * 64 + lane];
              hl[lane * 32 + p] = sinf(fq * c); }
          __syncthreads();
          float acc0[32], acc1[32];
#pragma unroll
          for (int p = 0; p < 32; ++p) { acc0[p] = 0.f; acc1[p] = 0.f; }
#pragma unroll 2
          for (int i = 0; i < 64; ++i) { const float wa = w3[(size_t)i * 1024 + tid], wb = w3[(size_t)i * 1024 + 512 + tid];
#pragma unroll
              for (int p4 = 0; p4 < 8; ++p4) { const f32x4 hv = *(const LAS f32x4*)(hl + i * 32 + p4 * 4);
                  acc0[p4 * 4 + 0] += hv.x * wa; acc0[p4 * 4 + 1] += hv.y * wa; acc0[p4 * 4 + 2] += hv.z * wa; acc0[p4 * 4 + 3] += hv.w * wa;
                  acc1[p4 * 4 + 0] += hv.x * wb; acc1[p4 * 4 + 1] += hv.y * wb; acc1[p4 * 4 + 2] += hv.z * wb; acc1[p4 * 4 + 3] += hv.w * wb; } }
          const float dl = hy_delta(tid & 255), sc = task < 256 ? (1.0f / NFFT) : 1.0f, invL = 1.0f / (float)(L - 1);
          bf16_t* dst = task < 256 ? (bf16_t*)(ws + WS_FILT) + (size_t)tid * SEQ + n0 : (bf16_t*)(ws + WS_FILTC) + (size_t)tid * CTX + n0;
          const size_t cstep = task < 256 ? (size_t)512 * SEQ : (size_t)512 * CTX;
#pragma unroll
          for (int p8 = 0; p8 < 4; ++p8) { float d[8];
#pragma unroll
              for (int k = 0; k < 8; ++k) d[k] = __expf(-((float)(n0 + p8 * 8 + k) * invL) * dl) * sc;
              u32x4 w; w.x = cvt_pk_bf16(acc0[p8 * 8 + 0] * d[0], acc0[p8 * 8 + 1] * d[1]); w.y = cvt_pk_bf16(acc0[p8 * 8 + 2] * d[2], acc0[p8 * 8 + 3] * d[3]);
              w.z = cvt_pk_bf16(acc0[p8 * 8 + 4] * d[4], acc0[p8 * 8 + 5] * d[5]); w.w = cvt_pk_bf16(acc0[p8 * 8 + 6] * d[6], acc0[p8 * 8 + 7] * d[7]);
              *(u32x4*)(dst + p8 * 8) = w;
              w.x = cvt_pk_bf16(acc1[p8 * 8 + 0] * d[0], acc1[p8 * 8 + 1] * d[1]); w.y = cvt_pk_bf16(acc1[p8 * 8 + 2] * d[2], acc1[p8 * 8 + 3] * d[3]);
              w.z = cvt_pk_bf16(acc1[p8 * 8 + 4] * d[4], acc1[p8 * 8 + 5] * d[5]); w.w = cvt_pk_bf16(acc1[p8 * 8 + 6] * d[6], acc1[p8 * 8 + 7] * d[7]);
              *(u32x4*)(dst + cstep + p8 * 8) = w; }
      }
      __syncthreads(); }
}

__device__ __forceinline__ void ph_rowpass(const Params& P, int mode, int lpost, int gate_i, int gpost_i, float ps, int lpre, int gpre_i, int shift_i, int scale_i, int nsplit) {
    const int tid = otid(), lane = tid & 63, gw = blockIdx.x * NWAVE + (tid >> 6), nw = gridDim.x * NWAVE;
    const float* modv = (const float*)(P.ws + WS_MODV);
    float* H = (float*)(P.ws + WS_H); const bf16_t* Y = (const bf16_t*)(P.ws + WS_Y); bf16_t* U = (bf16_t*)(P.ws + WS_U);
    int cur_s = -1;
    float4 A[4], Bv[4], Cv[4];
#pragma unroll
    for (int j = 0; j < 4; ++j) { A[j] = make_float4(0.f, 0.f, 0.f, 0.f); Bv[j] = A[j]; Cv[j] = A[j]; }
    for (int row = gw; row < T; row += nw) {
        const int s = row < SEQ ? 0 : (row < TL ? 1 : 2);
        if (s != cur_s) { cur_s = s;
#pragma unroll
            for (int j = 0; j < 4; ++j) { const int e = lane * 4 + 256 * j;
                if (mode != 0) { const float4 g = *(const float4*)(modv + ((size_t)lpost * 3 + s) * NMOD + gate_i * D + e); const float4 gp = *(const float4*)(P.in[I_NORMG] + ((size_t)lpost * 6 + gpost_i) * D + e);
                    A[j] = make_float4(ps * g.x * gp.x, ps * g.y * gp.y, ps * g.z * gp.z, ps * g.w * gp.w); }
                if (mode != 2) { const float4 sc = *(const float4*)(modv + ((size_t)lpre * 3 + s) * NMOD + scale_i * D + e); const float4 gq = *(const float4*)(P.in[I_NORMG] + ((size_t)lpre * 6 + gpre_i) * D + e);
                    Bv[j] = make_float4(gq.x * (1.f + sc.x), gq.y * (1.f + sc.y), gq.z * (1.f + sc.z), gq.w * (1.f + sc.w));
                    Cv[j] = *(const float4*)(modv + ((size_t)lpre * 3 + s) * NMOD + shift_i * D + e); } } }
        float4 h[4];
        if (mode == 0) { const float* src = row < TL ? P.in[I_X] + (size_t)row * D : P.in[I_CTX] + (size_t)(row - TL) * D;
#pragma unroll
            for (int j = 0; j < 4; ++j) h[j] = *(const float4*)(src + lane * 4 + 256 * j);
        } else {
            float4 y[4]; float ss = 0.f;
#pragma unroll
            for (int j = 0; j < 4; ++j) { h[j] = *(const float4*)(H + (size_t)row * D + lane * 4 + 256 * j); if (row < TL) { const u32x2 yw = *(const u32x2*)(Y + (size_t)row * D + lane * 4 + 256 * j); y[j] = make_float4(lo_bf(yw.x), hi_bf(yw.x), lo_bf(yw.y), hi_bf(yw.y)); } else { const float* yp = (const float*)(P.ws + WS_YC) + (size_t)(row - TL) * D + lane * 4 + 256 * j; float4 a = *(const float4*)yp;
                    for (int q = 1; q < nsplit; ++q) { const float4 b4 = *(const float4*)(yp + (size_t)q * TC * D); a.x += b4.x; a.y += b4.y; a.z += b4.z; a.w += b4.w; } y[j] = a; }
                ss += y[j].x * y[j].x + y[j].y * y[j].y + y[j].z * y[j].z + y[j].w * y[j].w; }
            ss = wsum(ss); const float r = rsqrtf(ss * (1.0f / D) + NORM_EPS);
#pragma unroll
            for (int j = 0; j < 4; ++j) { h[j].x += A[j].x * (y[j].x * r); h[j].y += A[j].y * (y[j].y * r); h[j].z += A[j].z * (y[j].z * r); h[j].w += A[j].w * (y[j].w * r); }
        }
        if (mode == 2) { if (row < TL) {
#pragma unroll
                for (int j = 0; j < 4; ++j) *(float4*)(P.out + (size_t)row * D + lane * 4 + 256 * j) = h[j]; }
            continue; }
        float s2 = 0.f;
#pragma unroll
        for (int j = 0; j < 4; ++j) { *(float4*)(H + (size_t)row * D + lane * 4 + 256 * j) = h[j]; s2 += h[j].x * h[j].x + h[j].y * h[j].y + h[j].z * h[j].z + h[j].w * h[j].w; }
        s2 = wsum(s2); const float r2 = rsqrtf(s2 * (1.0f / D) + NORM_EPS);
#pragma unroll
        for (int j = 0; j < 4; ++j) { u32x2 w; w.x = cvt_pk_bf16(h[j].x * r2 * Bv[j].x + Cv[j].x, h[j].y * r2 * Bv[j].y + Cv[j].y); w.y = cvt_pk_bf16(h[j].z * r2 * Bv[j].z + Cv[j].z, h[j].w * r2 * Bv[j].w + Cv[j].w);
            *(u32x2*)(U + (size_t)row * D + lane * 4 + 256 * j) = w; }
    }
}

struct EpiGU {
    static constexpr bool PERM = true, AFTER_DRAIN = false;
    bf16_t* O;
    __device__ __forceinline__ void operator()(const f32x4 (&acc)[2][2][4][2], const pg8::Unit& u, int wr, int wc, int fr, int fq) const {
        const int row0 = u.pm * 256 + wr * 64 + fr, col0 = u.pn * 128 + wc * 32 + 8 * fq;
#pragma unroll
        for (int ai = 0; ai < 2; ++ai)
#pragma unroll
            for (int m = 0; m < 4; ++m) { float o[8];
#pragma unroll
                for (int n = 0; n < 2; ++n)
#pragma unroll
                    for (int j = 0; j < 4; ++j) { const float g = acc[ai][0][m][n][j], up = acc[ai][1][m][n][j]; o[n * 4 + j] = g * __builtin_amdgcn_rcpf(1.0f + __expf(-g)) * up; }
                u32x4 w; w.x = cvt_pk_bf16(o[0], o[1]); w.y = cvt_pk_bf16(o[2], o[3]); w.z = cvt_pk_bf16(o[4], o[5]); w.w = cvt_pk_bf16(o[6], o[7]);
                *(u32x4*)(O + (size_t)(row0 + ai * 128 + m * 16) * DFF + col0) = w; }
    }
};

struct TailOrder {
    int nsplit, kp, G, c;
    __device__ void init(int K, int KP, int G_, int c_) { kp = KP; nsplit = (K / 64) / KP; G = G_; c = c_; }
    __device__ bool next(int i, pg8::Unit& u) const {
        const long L = (long)i * G + c;
        if (L < 256) { int wgid = (int)L; { const int q = 256 / 8, xcd = wgid % 8, off = wgid / 8; wgid = xcd * q + off; }
            const int nig = 8 * 4, gid = wgid / nig, fm = gid * 8; u.pm = fm + ((wgid % nig) % 8); u.pn = (wgid % nig) / 8; u.kt0 = 0; u.nkt = 0; return true; }
        const int L2 = (int)(L - 256); if (L2 >= 8 * nsplit) return false;
        const int tile = L2 / nsplit, ks = L2 % nsplit; u.pm = 64 + (tile >> 2); u.pn = tile & 3; u.kt0 = ks * kp; u.nkt = kp; return true;
    }
    __device__ __forceinline__ void a_ready(const pg8::Unit&) const {}
    __device__ __forceinline__ void done(const pg8::Unit&) const {}
};
struct EpiF32 {
    static constexpr bool PERM = true, AFTER_DRAIN = false;
    bf16_t* C; float* YC;
    __device__ __forceinline__ void operator()(const f32x4 (&acc)[2][2][4][2], const pg8::Unit& u, int wr, int wc, int fr, int fq) const {
        const int row0 = u.pm * 256 + wr * 64 + fr, col0 = u.pn * 256 + wc * 32 + 8 * fq;
        if (u.pm < 64) {
#pragma unroll
            for (int ai = 0; ai < 2; ++ai)
#pragma unroll
                for (int m = 0; m < 4; ++m) { bf16_t* rowp = C + (size_t)(row0 + ai * 128 + m * 16) * D + col0;
#pragma unroll
                    for (int bj = 0; bj < 2; ++bj) { const f32x4 v0 = acc[ai][bj][m][0], v1 = acc[ai][bj][m][1];
                        u32x4 w; w.x = cvt_pk_bf16(v0[0], v0[1]); w.y = cvt_pk_bf16(v0[2], v0[3]); w.z = cvt_pk_bf16(v1[0], v1[1]); w.w = cvt_pk_bf16(v1[2], v1[3]);
                        *(u32x4*)(rowp + bj * 128) = w; } }
        } else { float* base = YC + (size_t)(u.kt0 >> 2) * TC * D;
#pragma unroll
            for (int ai = 0; ai < 2; ++ai)
#pragma unroll
                for (int m = 0; m < 4; ++m) { float* rowp = base + (size_t)(row0 - TL + ai * 128 + m * 16) * D + col0;
#pragma unroll
                    for (int bj = 0; bj < 2; ++bj)
#pragma unroll
                        for (int n = 0; n < 2; ++n) *(f32x4*)(rowp + bj * 128 + n * 4) = acc[ai][bj][m][n]; }
        }
    }
};
template <class Epi> __device__ __forceinline__ void run_gemm_tail(LAS unsigned char* lds, const bf16_t* A, const bf16_t* Bt, int K, const Epi& E) {
    asm volatile("" : "+s"(K));
    pg8::Gemm g{A, Bt, T, D, K}; TailOrder S; S.init(K, 4, (int)gridDim.x, (int)blockIdx.x);
    pg8::gemm_phase<Epi, TailOrder>(lds, g, S, E);
    __syncthreads();
}
__device__ __forceinline__ void zero_yc(const Params& P) { float4* z = (float4*)(P.ws + WS_YC); for (int i = blockIdx.x * NTHR + otid(); i < TC * D / 4; i += gridDim.x * NTHR) z[i] = make_float4(0.f, 0.f, 0.f, 0.f); }
struct EpiWin {
    static constexpr bool PERM = true, AFTER_DRAIN = false;
    bf16_t* PHYT; bf16_t* PRW; bf16_t* PNA;
    __device__ __forceinline__ void operator()(const f32x4 (&acc)[2][2][4][2], const pg8::Unit& u, int wr, int wc, int fr, int fq) const {
        const int row0 = u.pm * 256 + wr * 64 + fr;
        if (u.pn < 3) {
#pragma unroll
            for (int bj = 0; bj < 2; ++bj) { bf16_t* cp = PHYT + (size_t)(u.pn * 256 + bj * 128 + wc * 32 + 8 * fq) * T + row0;
#pragma unroll
                for (int ai = 0; ai < 2; ++ai)
#pragma unroll
                    for (int m = 0; m < 4; ++m) { const f32x4 v0 = acc[ai][bj][m][0], v1 = acc[ai][bj][m][1]; bf16_t* rp = cp + ai * 128 + m * 16;
                        const unsigned w0 = cvt_pk_bf16(v0[0], v0[1]), w1 = cvt_pk_bf16(v0[2], v0[3]), w2 = cvt_pk_bf16(v1[0], v1[1]), w3 = cvt_pk_bf16(v1[2], v1[3]);
                        rp[0] = (bf16_t)w0; rp[(size_t)T] = (bf16_t)(w0 >> 16); rp[(size_t)2 * T] = (bf16_t)w1; rp[(size_t)3 * T] = (bf16_t)(w1 >> 16);
                        rp[(size_t)4 * T] = (bf16_t)w2; rp[(size_t)5 * T] = (bf16_t)(w2 >> 16); rp[(size_t)6 * T] = (bf16_t)w3; rp[(size_t)7 * T] = (bf16_t)(w3 >> 16); } }
            return; }
        bf16_t* base; int ld, cbase;
        if (u.pn < 9) { base = PRW; ld = RW_IN; cbase = u.pn * 256 - HY_IN; }
        else { base = PNA; ld = NA_IN; cbase = u.pn * 256 - HY_IN - RW_IN; }
        const int nbj = (u.pn == 13) ? 1 : 2;
#pragma unroll
        for (int ai = 0; ai < 2; ++ai)
#pragma unroll
            for (int m = 0; m < 4; ++m)
#pragma unroll
                for (int bj = 0; bj < 2; ++bj) { if (bj < nbj) { const f32x4 v0 = acc[ai][bj][m][0], v1 = acc[ai][bj][m][1];
                    u32x4 w; w.x = cvt_pk_bf16(v0[0], v0[1]); w.y = cvt_pk_bf16(v0[2], v0[3]); w.z = cvt_pk_bf16(v1[0], v1[1]); w.w = cvt_pk_bf16(v1[2], v1[3]);
                    *(u32x4*)(base + (size_t)(row0 + ai * 128 + m * 16) * ld + cbase + bj * 128 + wc * 32 + 8 * fq) = w; } }
    }
};
struct EpiLora {
    static constexpr bool PERM = true, AFTER_DRAIN = false;
    bf16_t* LO; bf16_t* GATE;
    __device__ __forceinline__ void operator()(const f32x4 (&acc)[2][2][4][2], const pg8::Unit& u, int wr, int wc, int fr, int fq) const {
        const int row0 = u.pm * 256 + wr * 64 + fr;
        bf16_t* base; int ld, cbase;
        if (u.pn < 6) { base = LO; ld = 1536; cbase = u.pn * 256; } else { base = GATE; ld = 384; cbase = u.pn * 256 - 1536; }
        const int nbj = (u.pn == 7) ? 1 : 2;
#pragma unroll
        for (int ai = 0; ai < 2; ++ai)
#pragma unroll
            for (int m = 0; m < 4; ++m)
#pragma unroll
                for (int bj = 0; bj < 2; ++bj) { if (bj < nbj) { const f32x4 v0 = acc[ai][bj][m][0], v1 = acc[ai][bj][m][1];
                    u32x4 w; w.x = cvt_pk_bf16(v0[0], v0[1]); w.y = cvt_pk_bf16(v0[2], v0[3]); w.z = cvt_pk_bf16(v1[0], v1[1]); w.w = cvt_pk_bf16(v1[2], v1[3]);
                    *(u32x4*)(base + (size_t)(row0 + ai * 128 + m * 16) * ld + cbase + bj * 128 + wc * 32 + 8 * fq) = w; } }
    }
};
template <class Epi> __device__ __forceinline__ void run_gemm(LAS unsigned char* lds, const bf16_t* A, const bf16_t* Bt, int M, int N, int K, const Epi& E) {
    asm volatile("" : "+s"(K));
    pg8::Gemm g{A, Bt, M, N, K}; pg8::StaticOrder S; S.init(M, N, (int)gridDim.x, (int)blockIdx.x);
    pg8::gemm_phase<Epi, pg8::StaticOrder>(lds, g, S, E);
    __syncthreads();
}

__device__ __forceinline__ void ph_loraprep(const Params& P, int l) {
    const bf16_t* PRW = (const bf16_t*)(P.ws + WS_PRW); bf16_t* AL = (bf16_t*)(P.ws + WS_ALORA);
    const float* mu = P.in[I_MU] + (size_t)l * 2 * RW_IN;
    const int gtid = blockIdx.x * NTHR + otid(), gn = gridDim.x * NTHR;
    for (int it = gtid; it < T * 48; it += gn) {
        const int row = it / 48, j8 = it % 48, col = 1152 + j8 * 8;
        bool hp, hn; row_nbrs(row, hp, hn);
        float p[8], pp[8], pn[8];
        unpack8(*(const u32x4*)(PRW + (size_t)row * RW_IN + col), p);
        if (hp) unpack8(*(const u32x4*)(PRW + (size_t)(row - 1) * RW_IN + col), pp); else {
#pragma unroll
            for (int i = 0; i < 8; ++i) pp[i] = 0.f; }
        if (hn) unpack8(*(const u32x4*)(PRW + (size_t)(row + 1) * RW_IN + col), pn); else {
#pragma unroll
            for (int i = 0; i < 8; ++i) pn[i] = 0.f; }
        float o[8];
#pragma unroll
        for (int i = 0; i < 8; ++i) { const float xs = p[i] + mu[col + i] * (pp[i] - p[i]) + mu[RW_IN + col + i] * (pn[i] - p[i]);
            o[i] = j8 < 16 ? tanhf(xs) : (j8 < 32 ? xs : sigmoidf_(xs)); }
        u32x4 w; w.x = cvt_pk_bf16(o[0], o[1]); w.y = cvt_pk_bf16(o[2], o[3]); w.z = cvt_pk_bf16(o[4], o[5]); w.w = cvt_pk_bf16(o[6], o[7]);
        *(u32x4*)(AL + (size_t)row * 384 + j8 * 8) = w;
    }
}

__device__ __forceinline__ void ph_rwkvprep(const Params& P, int l) {
    const int tid = otid(), lane = tid & 63, gw = blockIdx.x * NWAVE + (tid >> 6), nw = gridDim.x * NWAVE;
    const int nrw = nw / 6, h = gw % 6, rw0 = gw / 6;
    if (rw0 >= nrw) return;
    const bf16_t* PRW = (const bf16_t*)(P.ws + WS_PRW); const bf16_t* LO = (const bf16_t*)(P.ws + WS_LORAO);
    bf16_t* RS = (bf16_t*)(P.ws + WS_RS); bf16_t* KKS = (bf16_t*)(P.ws + WS_KKS); bf16_t* VS = (bf16_t*)(P.ws + WS_VS); bf16_t* KS = (bf16_t*)(P.ws + WS_KS); bf16_t* BS = (bf16_t*)(P.ws + WS_BS);
    float* BON = (float*)(P.ws + WS_BONUS); float* DEC = (float*)(P.ws + WS_DECAY);
    const float2* RT = (const float2*)(P.ws + WS_ROPE);
    const float* mu = P.in[I_MU] + (size_t)l * 2 * RW_IN;
    const int c = h * 64 + lane, f = lane & 15;
    const float mp0 = mu[c], mn0 = mu[RW_IN + c], mp1 = mu[384 + c], mn1 = mu[RW_IN + 384 + c], mp2 = mu[768 + c], mn2 = mu[RW_IN + 768 + c];
    const float ckk = P.in[I_KK][l * RWW + c], cka = P.in[I_KA][l * RWW + c], crk = P.in[I_RK][l * RWW + c];
    const float ca0 = P.in[I_A0][(size_t)l * 2 * RWW + c], ca1 = P.in[I_A0][(size_t)l * 2 * RWW + RWW + c], cw0 = P.in[I_W0][(size_t)l * 2 * RWW + c], cw1 = P.in[I_W0][(size_t)l * 2 * RWW + RWW + c];
    const float sg = (lane & 16) ? 1.f : -1.f;
#pragma unroll 2
    for (int row = rw0; row < T; row += nrw) {
        bool hp, hn; row_nbrs(row, hp, hn);
        const bf16_t* pr = PRW + (size_t)row * RW_IN + c; const int om = hp ? -RW_IN : 0, op = hn ? RW_IN : 0; const float fm = hp ? 1.f : 0.f, fp = hn ? 1.f : 0.f;
        const float r0 = bf2f(pr[0]), k0 = bf2f(pr[384]), v0 = bf2f(pr[768]);
        const float r = r0 + mp0 * (fm * bf2f(pr[om]) - r0) + mn0 * (fp * bf2f(pr[op]) - r0);
        const float k = k0 + mp1 * (fm * bf2f(pr[384 + om]) - k0) + mn1 * (fp * bf2f(pr[384 + op]) - k0);
        const float v = v0 + mp2 * (fm * bf2f(pr[768 + om]) - v0) + mn2 * (fp * bf2f(pr[768 + op]) - v0);
        const bf16_t* lo = LO + (size_t)row * 1536 + c;
        const float a0 = sigmoidf_(bf2f(lo[768]) + ca0), a1 = sigmoidf_(bf2f(lo[1152]) + ca1);
        const float x0 = bf2f(lo[0]) + cw0, x1 = bf2f(lo[384]) + cw1;
        const float kkr = k * ckk;
        const float nrm = sqrtf(wsum(kkr * kkr));
        const float kk = kkr / fmaxf(nrm, 1e-12f);
        float kd0 = k * (1.f + (a0 - 1.f) * cka), kd1 = k * (1.f + (a1 - 1.f) * cka);
        float b0 = kk * a0, b1 = kk * a1;
        const float bon = wsum(r * (kd0 + kd1) * crk);
        float rs = r, kks = kk;
        if (row < TL) {
            const int t = row & (SEQ - 1); const int pos = (lane < 32) ? (t >> 6) : (t & 63);
            const float2 csn = RT[pos * 16 + f]; const float cs = csn.x, sn = csn.y;
            const float r2 = __shfl_xor(rs, 16), k2 = __shfl_xor(kks, 16), d0 = __shfl_xor(kd0, 16), d1 = __shfl_xor(kd1, 16), e0 = __shfl_xor(b0, 16), e1 = __shfl_xor(b1, 16);
            rs = rs * cs + sg * r2 * sn; kks = kks * cs + sg * k2 * sn; kd0 = kd0 * cs + sg * d0 * sn; kd1 = kd1 * cs + sg * d1 * sn; b0 = b0 * cs + sg * e0 * sn; b1 = b1 * cs + sg * e1 * sn;
        }
        const size_t o = (size_t)row * 384 + c;
        DEC[o] = __expf(-0.6065306597f * sigmoidf_(x0)); DEC[(size_t)T * 384 + o] = __expf(-0.6065306597f * sigmoidf_(x1));
        if (lane == 0) BON[(size_t)row * 6 + h] = bon;
        RS[o] = f2bf(rs); KKS[o] = f2bf(-kks); VS[o] = f2bf(v);
        KS[o] = f2bf(kd0); KS[(size_t)T * 384 + o] = f2bf(kd1); BS[o] = f2bf(b0); BS[(size_t)T * 384 + o] = f2bf(b1);
    }
}

__device__ __forceinline__ int scan_row(int b, int d, int step) {
    if (step < CTX) { const int tc = d ? (CTX - 1 - step) : step; return TL + b * CTX + tc; }
    const int tl = d ? (SEQ - 1 - (step - CTX)) : (step - CTX); return b * SEQ + tl;
}
__device__ __forceinline__ void scan_task_v1(const Params& P, int task, float* sv) {
    const int lane = otid() & 63;
    const int d = task & 1, h = (task >> 1) % 6, b = task / 12;
    const float* DEC = (const float*)(P.ws + WS_DECAY) + (size_t)d * T * 384; const bf16_t* KKS = (const bf16_t*)(P.ws + WS_KKS); const bf16_t* RS = (const bf16_t*)(P.ws + WS_RS);
    const bf16_t* VS = (const bf16_t*)(P.ws + WS_VS); const bf16_t* KS = (const bf16_t*)(P.ws + WS_KS) + (size_t)d * T * 384; const bf16_t* BS = (const bf16_t*)(P.ws + WS_BS) + (size_t)d * T * 384;
    float* YD = (float*)(P.ws + WS_YDIR) + (size_t)d * T * 384;
    float S[64];
#pragma unroll
    for (int j = 0; j < 64; ++j) S[j] = 0.f;
    size_t o = (size_t)scan_row(b, d, 0) * 384 + h * 64 + lane;
    float nw_ = DEC[o], na = bf2f(KKS[o]), nb = bf2f(BS[o]), nk = bf2f(KS[o]), nr = bf2f(RS[o]), nv = bf2f(VS[o]);
    for (int step = 0; step < CTX + SEQ; ++step) {
        const float v = nv; const size_t oc = o;
        asm volatile("s_waitcnt lgkmcnt(0)" ::: "memory");
        sv[lane] = nw_; sv[64 + lane] = na; sv[128 + lane] = nb; sv[192 + lane] = nk; sv[256 + lane] = nr;
        asm volatile("s_waitcnt lgkmcnt(0)" ::: "memory");
        if (step + 1 < CTX + SEQ) { o = (size_t)scan_row(b, d, step + 1) * 384 + h * 64 + lane;
            nw_ = DEC[o]; na = bf2f(KKS[o]); nb = bf2f(BS[o]); nk = bf2f(KS[o]); nr = bf2f(RS[o]); nv = bf2f(VS[o]); }
        float sa0 = 0.f, sa1 = 0.f, sa2 = 0.f, sa3 = 0.f;
#pragma unroll
        for (int j = 0; j < 64; j += 4) { const float4 a4 = *(const float4*)(sv + 64 + j);
            sa0 += S[j + 0] * a4.x; sa1 += S[j + 1] * a4.y; sa2 += S[j + 2] * a4.z; sa3 += S[j + 3] * a4.w; }
        const float sa = (sa0 + sa1) + (sa2 + sa3);
        float y0 = 0.f, y1 = 0.f, y2 = 0.f, y3 = 0.f;
#pragma unroll
        for (int j = 0; j < 64; j += 4) {
            const float4 w4 = *(const float4*)(sv + j), b4 = *(const float4*)(sv + 128 + j), k4 = *(const float4*)(sv + 192 + j), r4 = *(const float4*)(sv + 256 + j);
            S[j + 0] = S[j + 0] * w4.x + sa * b4.x + v * k4.x; y0 += S[j + 0] * r4.x;
            S[j + 1] = S[j + 1] * w4.y + sa * b4.y + v * k4.y; y1 += S[j + 1] * r4.y;
            S[j + 2] = S[j + 2] * w4.z + sa * b4.z + v * k4.z; y2 += S[j + 2] * r4.z;
            S[j + 3] = S[j + 3] * w4.w + sa * b4.w + v * k4.w; y3 += S[j + 3] * r4.w; }
        YD[oc] = (y0 + y1) + (y2 + y3);
    }
}

__device__ __forceinline__ void natt_key(const bf16_t* PNA, size_t krow, int hoff, const float (&q)[16], float bias, float& m, float& lsum, float (&o)[16]) {
    const bf16_t* kp = PNA + krow * NA_IN + 384 + hoff; const bf16_t* vp = PNA + krow * NA_IN + 768 + hoff;
    float s = 0.f;
#pragma unroll
    for (int j8 = 0; j8 < 2; ++j8) { float kf[8]; unpack8(*(const u32x4*)(kp + j8 * 8), kf);
#pragma unroll
        for (int i = 0; i < 8; ++i) s += q[j8 * 8 + i] * kf[i]; }
    s += __shfl_xor(s, 1); s += __shfl_xor(s, 2); s += bias;
    const float mn = fmaxf(m, s), corr = __expf(m - mn), p = __expf(s - mn);
    m = mn; lsum = lsum * corr + p;
#pragma unroll
    for (int j8 = 0; j8 < 2; ++j8) { float vf[8]; unpack8(*(const u32x4*)(vp + j8 * 8), vf);
#pragma unroll
        for (int i = 0; i < 8; ++i) o[j8 * 8 + i] = o[j8 * 8 + i] * corr + p * vf[i]; }
}
__device__ __forceinline__ void natten_items_v1(const Params& P, int l, int wid0, int nworkers) {
    const bf16_t* PNA = (const bf16_t*)(P.ws + WS_PNA); bf16_t* MIX = (bf16_t*)(P.ws + WS_U);
    const float* rpb = P.in[I_RPB] + (size_t)l * 6 * 15 * 31;
    const int sub = wid0 & 3;
    for (int it = wid0 >> 2; it < T * 6; it += nworkers >> 2) {
        const int row = it % T, h = it / T, hoff = h * 64 + sub * 16;
        float q[16], o[16];
#pragma unroll
        for (int j8 = 0; j8 < 2; ++j8) { float qf[8]; unpack8(*(const u32x4*)(PNA + (size_t)row * NA_IN + hoff + j8 * 8), qf);
#pragma unroll
            for (int i = 0; i < 8; ++i) { q[j8 * 8 + i] = qf[i] * 0.125f; o[j8 * 8 + i] = 0.f; } }
        float m = -3.0e38f, lsum = 0.f;
        int b;
        if (row < TL) { b = row >> 13; const int t = row & (SEQ - 1), i = t >> 6, col = t & 63;
            const int start = min(max(i - 4, 0), 120), win0 = min(max(col - 8, 0), 48);
            for (int r = 0; r < 8; ++r) for (int kc = win0; kc < win0 + 16; ++kc) {
                const float bias = rpb[(h * 15 + (start + r - i + 7)) * 31 + (kc - col + 15)];
                natt_key(PNA, (size_t)b * SEQ + (start + r) * 64 + kc, hoff, q, bias, m, lsum, o); }
        } else b = (row - TL) >> 8;
        for (int c = 0; c < CTX; ++c) natt_key(PNA, (size_t)TL + b * CTX + c, hoff, q, 0.f, m, lsum, o);
        const float il = 1.0f / lsum;
#pragma unroll
        for (int j8 = 0; j8 < 2; ++j8) { u32x4 w; w.x = cvt_pk_bf16(o[j8 * 8 + 0] * il, o[j8 * 8 + 1] * il); w.y = cvt_pk_bf16(o[j8 * 8 + 2] * il, o[j8 * 8 + 3] * il);
            w.z = cvt_pk_bf16(o[j8 * 8 + 4] * il, o[j8 * 8 + 5] * il); w.w = cvt_pk_bf16(o[j8 * 8 + 6] * il, o[j8 * 8 + 7] * il);
            *(u32x4*)(MIX + (size_t)row * D + 640 + hoff + j8 * 8) = w; }
    }
}

__device__ __forceinline__ void vt_tile(const Params& P, int tile, unsigned short* tl  ) {
    const int tid = otid();
    const bf16_t* PNA = (const bf16_t*)(P.ws + WS_PNA);
    int h, tok0; bf16_t* dst; int ldt;
    if (tile < NB * 128 * 6) { h = tile % 6; const int sb = tile / 6; const int b = sb >> 7, blk = sb & 127; tok0 = b * SEQ + blk * 64; dst = (bf16_t*)(P.ws + WS_VTL) + ((size_t)(b * 6 + h) * 64) * SEQ + blk * 64; ldt = SEQ; }
    else { const int tt = tile - NB * 128 * 6; h = tt % 6; const int sb = tt / 6; const int b = sb >> 2, blk = sb & 3; tok0 = TL + b * CTX + blk * 64; dst = (bf16_t*)(P.ws + WS_VTC) + ((size_t)(b * 6 + h) * 64) * CTX + blk * 64; ldt = CTX; }
    { const int tok = tid >> 3, seg = tid & 7; const u32x4 v = *(const u32x4*)(PNA + (size_t)(tok0 + tok) * NA_IN + 768 + h * 64 + seg * 8);
      unsigned* w = (unsigned*)(tl + tok * 72 + seg * 8); w[0] = v.x; w[1] = v.y; w[2] = v.z; w[3] = v.w; }
    __syncthreads();
    { const int hd = tid >> 3, ts = tid & 7; unsigned short e[8];
#pragma unroll
      for (int k = 0; k < 8; ++k) e[k] = tl[(ts * 8 + k) * 72 + hd];
      u32x4 w; w.x = (unsigned)e[0] | ((unsigned)e[1] << 16); w.y = (unsigned)e[2] | ((unsigned)e[3] << 16); w.z = (unsigned)e[4] | ((unsigned)e[5] << 16); w.w = (unsigned)e[6] | ((unsigned)e[7] << 16);
      *(u32x4*)(dst + (size_t)hd * ldt + ts * 8) = w; }
    __syncthreads();
}
constexpr int NAT_LAT_TASKS = NB * 128 * 4 * 6, NAT_CTX_TASKS = NB * 16 * 6, NAT_TASKS = NAT_LAT_TASKS + NAT_CTX_TASKS;
__device__ __forceinline__ void natten_task(const Params& P, int l, int task) {
    using pg8::bf16x8;
    const int lane = otid() & 63, fr = lane & 15, fq = lane >> 4;
    const bf16_t* PNA = (const bf16_t*)(P.ws + WS_PNA); bf16_t* MIX = (bf16_t*)(P.ws + WS_U);
    const bool lat = task < NAT_LAT_TASKS;
    int b, h, i = 0, n = 0, qtok0;
    if (lat) { h = task % 6; const int r = task / 6; n = r & 3; i = (r >> 2) & 127; b = r >> 9; qtok0 = b * SEQ + i * 64 + 16 * n; }
    else { const int tt = task - NAT_LAT_TASKS; h = tt % 6; const int qb = (tt / 6) & 15; b = tt / 96; qtok0 = TL + b * CTX + 16 * qb; }
    const int start = min(max(i - 4, 0), 120), band0 = min(max(16 * n - 8, 0), 32);
    const int col = 16 * n + fr, win0 = min(max(col - 8, 0), 48);
    bf16x8 bq[2];
#pragma unroll
    for (int kh = 0; kh < 2; ++kh) bq[kh] = *(const bf16x8*)(PNA + (size_t)(qtok0 + fr) * NA_IN + h * 64 + kh * 32 + fq * 8);
    f32x4 sc[32];
    if (lat) {
#pragma unroll
        for (int t = 0; t < 16; ++t) { const int tok0 = b * SEQ + (start + (t >> 1)) * 64 + band0 + 16 * (t & 1);
            const bf16_t* kp = PNA + (size_t)(tok0 + fr) * NA_IN + 384 + h * 64 + fq * 8;
            const bf16x8 k0 = *(const bf16x8*)kp, k1 = *(const bf16x8*)(kp + 32);
            f32x4 a = (f32x4){0.f, 0.f, 0.f, 0.f};
            a = __builtin_amdgcn_mfma_f32_16x16x32_bf16(k0, bq[0], a, 0, 0, 0); a = __builtin_amdgcn_mfma_f32_16x16x32_bf16(k1, bq[1], a, 0, 0, 0);
            sc[t] = a; if ((t & 3) == 3) asm volatile("" ::: "memory"); }
    } else {
#pragma unroll
        for (int t = 0; t < 16; ++t) sc[t] = (f32x4){-3.0e38f, -3.0e38f, -3.0e38f, -3.0e38f};
    }
#pragma unroll
    for (int t = 16; t < 32; ++t) { const int tok0 = TL + b * CTX + 16 * (t - 16);
        const bf16_t* kp = PNA + (size_t)(tok0 + fr) * NA_IN + 384 + h * 64 + fq * 8;
        const bf16x8 k0 = *(const bf16x8*)kp, k1 = *(const bf16x8*)(kp + 32);
        f32x4 a = (f32x4){0.f, 0.f, 0.f, 0.f};
        a = __builtin_amdgcn_mfma_f32_16x16x32_bf16(k0, bq[0], a, 0, 0, 0); a = __builtin_amdgcn_mfma_f32_16x16x32_bf16(k1, bq[1], a, 0, 0, 0);
        sc[t] = a * 0.125f; if ((t & 3) == 3) asm volatile("" ::: "memory"); }
    if (lat) { const float* rpb = P.in[I_RPB] + ((size_t)l * 6 + h) * 15 * 31;
#pragma unroll
        for (int t = 0; t < 16; ++t) { const int ro = start + (t >> 1) - i + 7; const int kc0 = band0 + 16 * (t & 1) + fq * 4;
#pragma unroll
            for (int j = 0; j < 4; ++j) { const int kc = kc0 + j; const bool ok = kc >= win0 && kc < win0 + 16; const int co = min(max(kc - col + 15, 0), 30);
                const float bias = rpb[ro * 31 + co]; sc[t][j] = ok ? sc[t][j] * 0.125f + bias : -3.0e38f; } } }
    float mx = -3.0e38f;
#pragma unroll
    for (int t = 0; t < 32; ++t) mx = fmaxf(mx, fmaxf(fmaxf(sc[t][0], sc[t][1]), fmaxf(sc[t][2], sc[t][3])));
    mx = fmaxf(mx, __shfl_xor(mx, 16)); mx = fmaxf(mx, __shfl_xor(mx, 32));
    float sum = 0.f;
#pragma unroll
    for (int t = 0; t < 32; ++t) {
#pragma unroll
        for (int j = 0; j < 4; ++j) { const float p = __expf(sc[t][j] - mx); sc[t][j] = p; sum += p; } }
    sum += __shfl_xor(sum, 16); sum += __shfl_xor(sum, 32);
    const float inv = 1.0f / sum;
    f32x4 ot[4];
#pragma unroll
    for (int q = 0; q < 4; ++q) ot[q] = (f32x4){0.f, 0.f, 0.f, 0.f};
    const bf16_t* VTL = (const bf16_t*)(P.ws + WS_VTL) + ((size_t)(b * 6 + h) * 64) * SEQ; const bf16_t* VTC = (const bf16_t*)(P.ws + WS_VTC) + ((size_t)(b * 6 + h) * 64) * CTX;
    if (lat) {
#pragma unroll
        for (int m = 0; m < 8; ++m) { const int tk = (start + m) * 64 + band0 + fq * 4;
            u32x4 pw; pw.x = cvt_pk_bf16(sc[2 * m][0], sc[2 * m][1]); pw.y = cvt_pk_bf16(sc[2 * m][2], sc[2 * m][3]); pw.z = cvt_pk_bf16(sc[2 * m + 1][0], sc[2 * m + 1][1]); pw.w = cvt_pk_bf16(sc[2 * m + 1][2], sc[2 * m + 1][3]);
            const bf16x8 pb = __builtin_bit_cast(bf16x8, pw);
#pragma unroll
            for (int q = 0; q < 4; ++q) { const bf16_t* vp = VTL + (size_t)(q * 16 + fr) * SEQ + tk; const u32x2 v0 = *(const u32x2*)vp, v1 = *(const u32x2*)(vp + 16);
                u32x4 vw; vw.x = v0.x; vw.y = v0.y; vw.z = v1.x; vw.w = v1.y;
                ot[q] = __builtin_amdgcn_mfma_f32_16x16x32_bf16(__builtin_bit_cast(bf16x8, vw), pb, ot[q], 0, 0, 0); }
            if (m & 1) asm volatile("" ::: "memory"); }
    }
#pragma unroll
    for (int m = 0; m < 8; ++m) { const int tk = 32 * m + fq * 4;
        u32x4 pw; pw.x = cvt_pk_bf16(sc[16 + 2 * m][0], sc[16 + 2 * m][1]); pw.y = cvt_pk_bf16(sc[16 + 2 * m][2], sc[16 + 2 * m][3]); pw.z = cvt_pk_bf16(sc[17 + 2 * m][0], sc[17 + 2 * m][1]); pw.w = cvt_pk_bf16(sc[17 + 2 * m][2], sc[17 + 2 * m][3]);
        const bf16x8 pb = __builtin_bit_cast(bf16x8, pw);
#pragma unroll
        for (int q = 0; q < 4; ++q) { const bf16_t* vp = VTC + (size_t)(q * 16 + fr) * CTX + tk; const u32x2 v0 = *(const u32x2*)vp, v1 = *(const u32x2*)(vp + 16);
            u32x4 vw; vw.x = v0.x; vw.y = v0.y; vw.z = v1.x; vw.w = v1.y;
            ot[q] = __builtin_amdgcn_mfma_f32_16x16x32_bf16(__builtin_bit_cast(bf16x8, vw), pb, ot[q], 0, 0, 0); }
        if (m & 1) asm volatile("" ::: "memory"); }
#pragma unroll
    for (int q = 0; q < 4; ++q) { u32x2 w; w.x = cvt_pk_bf16(ot[q][0] * inv, ot[q][1] * inv); w.y = cvt_pk_bf16(ot[q][2] * inv, ot[q][3] * inv);
        *(u32x2*)(MIX + (size_t)(qtok0 + fr) * D + 640 + h * 64 + q * 16 + fq * 4) = w; }
}

__device__ __forceinline__ void fft_fwd(float2* X) {
#pragma unroll 1
    for (int lq = 12; lq >= 0; lq -= 2) { const int q = 1 << lq; const float rq = 1.0f / (float)(4 * q);
        for (int j = otid(); j < NFFT / 4; j += NTHR) { const int lo = j & (q - 1), base = ((j >> lq) << (lq + 2)) | lo;
            const float2 x0 = X[base], x1 = X[base + q], x2 = X[base + 2 * q], x3 = X[base + 3 * q];
            const float fr = (float)lo * rq; const float c = __builtin_amdgcn_cosf(fr), s = __builtin_amdgcn_sinf(fr), c2 = c * c - s * s, s2 = 2.f * c * s;
            const float a0x = x0.x + x2.x, a0y = x0.y + x2.y, dx = x0.x - x2.x, dy = x0.y - x2.y;
            const float a2x = dx * c + dy * s, a2y = dy * c - dx * s;
            const float a1x = x1.x + x3.x, a1y = x1.y + x3.y, ex = x1.x - x3.x, ey = x1.y - x3.y;
            const float mx = ex * c + ey * s, my = ey * c - ex * s;
            const float a3x = my, a3y = -mx;
            const float fx = a0x - a1x, fy = a0y - a1y, gx = a2x - a3x, gy = a2y - a3y;
            X[base] = make_float2(a0x + a1x, a0y + a1y); X[base + q] = make_float2(fx * c2 + fy * s2, fy * c2 - fx * s2);
            X[base + 2 * q] = make_float2(a2x + a3x, a2y + a3y); X[base + 3 * q] = make_float2(gx * c2 + gy * s2, gy * c2 - gx * s2); }
        __syncthreads(); }
}
__device__ __forceinline__ void fft_inv(float2* X) {
#pragma unroll 1
    for (int lq = 0; lq <= 12; lq += 2) { const int q = 1 << lq; const float rq = 1.0f / (float)(4 * q);
        for (int j = otid(); j < NFFT / 4; j += NTHR) { const int lo = j & (q - 1), base = ((j >> lq) << (lq + 2)) | lo;
            const float2 y0 = X[base], y1 = X[base + q], y2 = X[base + 2 * q], y3 = X[base + 3 * q];
            const float fr = (float)lo * rq; const float c = __builtin_amdgcn_cosf(fr), s = __builtin_amdgcn_sinf(fr), c2 = c * c - s * s, s2 = 2.f * c * s;
            const float tx = y1.x * c2 - y1.y * s2, ty = y1.x * s2 + y1.y * c2;
            const float a0x = y0.x + tx, a0y = y0.y + ty, a1x = y0.x - tx, a1y = y0.y - ty;
            const float ux = y3.x * c2 - y3.y * s2, uy = y3.x * s2 + y3.y * c2;
            const float a2x = y2.x + ux, a2y = y2.y + uy, a3x = y2.x - ux, a3y = y2.y - uy;
            const float vx = a2x * c - a2y * s, vy = a2x * s + a2y * c;
            const float mx = a3x * c - a3y * s, my = a3x * s + a3y * c;
            const float wx = -my, wy = mx;
            X[base] = make_float2(a0x + vx, a0y + vy); X[base + 2 * q] = make_float2(a0x - vx, a0y - vy);
            X[base + q] = make_float2(a1x + wx, a1y + wy); X[base + 3 * q] = make_float2(a1x - wx, a1y - wy); }
        __syncthreads(); }
}
__device__ __forceinline__ float hy_delta(int c) { const float lo = -4.605170185988091f / 1.5f, hi = -4.605170185988091f / 0.3f; return fabsf(lo + (float)c * ((hi - lo) / 255.0f)); }
__device__ __forceinline__ float hy_short(const bf16_t* PHYT, const float* cw, const float* cb, int row, int col) {
    bool hp, hn; row_nbrs(row, hp, hn);
    const bf16_t* p = PHYT + (size_t)col * T + row;
    float v = cb[col] + cw[HY_IN + col] * bf2f(p[0]);
    if (hp) v += cw[col] * bf2f(p[-1]);
    if (hn) v += cw[2 * HY_IN + col] * bf2f(p[1]);
    return v;
}
struct HyTap { float w0, w1, w2, b; };
__device__ __forceinline__ HyTap hy_tap(const float* cw, const float* cb, int col) { HyTap t; t.w0 = cw[col]; t.w1 = cw[HY_IN + col]; t.w2 = cw[2 * HY_IN + col]; t.b = cb[col]; return t; }
__device__ __forceinline__ float hy_lat(const bf16_t* colp, int b, int n, const HyTap t) {
    const bf16_t* p = colp + b * SEQ + n;
    const float xm = bf2f(p[n > 0 ? -1 : 0]), x0 = bf2f(p[0]), xp = bf2f(p[n < SEQ - 1 ? 1 : 0]);
    return t.b + t.w1 * x0 + (n > 0 ? t.w0 * xm : 0.f) + (n < SEQ - 1 ? t.w2 * xp : 0.f);
}
__device__ __forceinline__ void hy_spec_task(const Params& P, int l, int o, int c, float2* X, float* ex_) {
    const int tid = otid();
    const bf16_t* ff = (const bf16_t*)(P.ws + WS_FILT) + (size_t)(o * 512 + c) * SEQ; const bf16_t* fb = ff + (size_t)256 * SEQ;
    for (int n = tid; n < SEQ; n += NTHR) {
        X[n] = make_float2(bf2f(ff[n]), 0.f);
        if (n > 0) X[NFFT - n] = make_float2(bf2f(fb[n]), 0.f); else X[SEQ] = make_float2(0.f, 0.f); }
    __syncthreads();
    fft_fwd(X);
    float2* spec = (float2*)(P.ws + WS_SPEC) + (size_t)(o * 256 + c) * NFFT;
    for (int i = tid; i < NFFT; i += NTHR) spec[i] = X[i];
    __syncthreads();
}
__device__ __forceinline__ void hy_conv_core(const Params& P, int o, int c, float2* X) {
    fft_fwd(X);
    const float2* spec = (const float2*)(P.ws + WS_SPEC) + (size_t)(o * 256 + c) * NFFT;
    for (int i = otid(); i < NFFT; i += NTHR) { const float2 a = X[i], k = spec[i]; X[i] = make_float2(a.x * k.x - a.y * k.y, a.x * k.y + a.y * k.x); }
    __syncthreads();
    fft_inv(X);
}
__device__ __forceinline__ void hy_task1(const Params& P, int l, int c, float2* X, float* ex) {
    const int tid = otid();
    const bf16_t* PHY = (const bf16_t*)(P.ws + WS_PHY); const float* cw = P.in[I_HCW] + (size_t)l * 3 * HY_IN; const float* cb = P.in[I_HCB] + (size_t)l * HY_IN;
    const float bias0 = P.in[I_HBIAS][(size_t)l * 2 * HYC + c], bias1 = P.in[I_HBIAS][(size_t)l * 2 * HYC + HYC + c];
    const HyTap tv = hy_tap(cw, cb, c), tg1 = hy_tap(cw, cb, HYC + c); const bf16_t* colv = PHY + (size_t)c * T; const bf16_t* colg1 = PHY + (size_t)(HYC + c) * T;
#pragma unroll 4
    for (int n = tid; n < SEQ; n += NTHR) { X[n] = make_float2(hy_lat(colv, 0, n, tv), hy_lat(colv, 1, n, tv)); X[SEQ + n] = make_float2(0.f, 0.f); }
    __syncthreads();
    hy_conv_core(P, 0, c, X);
    float* Z1 = (float*)(P.ws + WS_Z1) + (size_t)c * NB * SEQ;
#pragma unroll 4
    for (int n = tid; n < SEQ; n += NTHR) { const float2 y = X[n];
        const float v0 = hy_lat(colv, 0, n, tv), v1 = hy_lat(colv, 1, n, tv), g0 = hy_lat(colg1, 0, n, tg1), g1 = hy_lat(colg1, 1, n, tg1);
        Z1[n] = g0 * (y.x + bias0 * v0); Z1[SEQ + n] = g1 * (y.y + bias0 * v1); }
    __syncthreads();
    float* f = (float*)X;
    float* vv = f, *x1 = f + 512, *x2 = f + 1024, *hf = f + 1536  , *z1 = f + 2560;
    const bf16_t* fc = (const bf16_t*)(P.ws + WS_FILTC);
    { const int b = tid >> 8, t = tid & 255, row = TL + b * CTX + t;
      vv[tid] = hy_short(PHY, cw, cb, row, c); x1[tid] = hy_short(PHY, cw, cb, row, HYC + c); x2[tid] = hy_short(PHY, cw, cb, row, 2 * HYC + c);
      for (int q = tid; q < 1024; q += NTHR) { const int od = q >> 8, n = q & 255; hf[q] = bf2f(fc[(size_t)(od * 256 + c) * CTX + n]); } }
    __syncthreads();
    { const int b = tid >> 8, t = tid & 255; float y = bias0 * vv[tid];
      for (int s = 0; s <= t; ++s) y += hf[t - s] * vv[b * 256 + s];
      for (int s = t + 1; s < CTX; ++s) y += hf[256 + s - t] * vv[b * 256 + s];
      z1[tid] = x1[tid] * y; }
    __syncthreads();
    { const int b = tid >> 8, t = tid & 255; float y = bias1 * z1[tid];
      for (int s = 0; s <= t; ++s) y += hf[512 + t - s] * z1[b * 256 + s];
      for (int s = t + 1; s < CTX; ++s) y += hf[768 + s - t] * z1[b * 256 + s];
      bf16_t* MIX = (bf16_t*)(P.ws + WS_U); MIX[(size_t)(TL + b * CTX + t) * D + c] = f2bf(x2[tid] * y); }
    __syncthreads();
}
__device__ __forceinline__ void hy_task2(const Params& P, int l, int c, float2* X) {
    const int tid = otid();
    const bf16_t* PHY = (const bf16_t*)(P.ws + WS_PHY); const float* cw = P.in[I_HCW] + (size_t)l * 3 * HY_IN; const float* cb = P.in[I_HCB] + (size_t)l * HY_IN;
    const float bias1 = P.in[I_HBIAS][(size_t)l * 2 * HYC + HYC + c];
    const float* Z1 = (const float*)(P.ws + WS_Z1) + (size_t)c * NB * SEQ; float* Z1w = (float*)(P.ws + WS_Z1) + (size_t)c * NB * SEQ;
    for (int n = tid; n < SEQ; n += NTHR) { X[n] = make_float2(Z1[n], Z1[SEQ + n]); X[SEQ + n] = make_float2(0.f, 0.f); }
    __syncthreads();
    hy_conv_core(P, 1, c, X);
    bf16_t* MIX = (bf16_t*)(P.ws + WS_U);
    const HyTap tg2 = hy_tap(cw, cb, 2 * HYC + c); const bf16_t* colg2 = PHY + (size_t)(2 * HYC + c) * T;
#pragma unroll 4
    for (int n = tid; n < SEQ; n += NTHR) { const float2 y = X[n];
        const float g0 = hy_lat(colg2, 0, n, tg2), g1 = hy_lat(colg2, 1, n, tg2);
        Z1w[n] = g0 * (y.x + bias1 * Z1[n]); Z1w[SEQ + n] = g1 * (y.y + bias1 * Z1[SEQ + n]); }
    __syncthreads();
}

constexpr int SEGC = 256, NSEG = 33, SCH = 4;
typedef float f32x2v __attribute__((ext_vector_type(2)));
template <bool IDENT>
__device__ __forceinline__ void scan_seg(const Params& P, int chain, int g, float* ring_  ) {
    const ldsfp ring = vlds(ring_);
    const int lane = otid() & 63;
    const int d = chain & 1, h = (chain >> 1) % 6, b = chain / 12;
    const float* DEC = (const float*)(P.ws + WS_DECAY) + (size_t)d * T * 384; const bf16_t* KKS = (const bf16_t*)(P.ws + WS_KKS); const bf16_t* RS = (const bf16_t*)(P.ws + WS_RS);
    const bf16_t* VS = (const bf16_t*)(P.ws + WS_VS); const bf16_t* KS = (const bf16_t*)(P.ws + WS_KS) + (size_t)d * T * 384; const bf16_t* BS = (const bf16_t*)(P.ws + WS_BS) + (size_t)d * T * 384;
    float* YD = (float*)(P.ws + WS_YDIR) + (size_t)d * T * 384;
    bf16_t* E = (bf16_t*)(P.ws + WS_E) + (size_t)chain * SEQ * 64;
    const int step0 = g == 0 ? 0 : CTX + (g - 1) * SEGC;
    f32x2v S0[32], S1[32];
#pragma unroll
    for (int j = 0; j < 32; ++j) { S0[j] = (f32x2v){0.f, 0.f}; S1[j] = (f32x2v){(2 * j == lane) ? 1.f : 0.f, (2 * j + 1 == lane) ? 1.f : 0.f}; }
    float pw[SCH], pa[SCH], pb[SCH], pk[SCH], pr[SCH], pv[SCH]; int po[SCH];
#pragma unroll
    for (int s = 0; s < SCH; ++s) { const int o = scan_row(b, d, step0 + s) * 384 + h * 64 + lane; po[s] = o;
        pw[s] = DEC[o]; pa[s] = bf2f(KKS[o]); pb[s] = bf2f(BS[o]); pk[s] = bf2f(KS[o]); pr[s] = bf2f(RS[o]); pv[s] = bf2f(VS[o]); }
    for (int c = 0; c < SEGC / SCH; ++c) {
        float cv[SCH]; int co[SCH];
        asm volatile("s_waitcnt lgkmcnt(0)" ::: "memory");
#pragma unroll
        for (int s = 0; s < SCH; ++s) { const ldsfp sv = ring + s * 320; sv[lane] = pw[s]; sv[64 + lane] = pa[s]; sv[128 + lane] = pb[s]; sv[192 + lane] = pk[s]; sv[256 + lane] = pr[s]; cv[s] = pv[s]; co[s] = po[s]; }
        asm volatile("s_waitcnt lgkmcnt(0)" ::: "memory");
        if (c + 1 < SEGC / SCH) {
#pragma unroll
            for (int s = 0; s < SCH; ++s) { const int o = scan_row(b, d, step0 + (c + 1) * SCH + s) * 384 + h * 64 + lane; po[s] = o;
                pw[s] = DEC[o]; pa[s] = bf2f(KKS[o]); pb[s] = bf2f(BS[o]); pk[s] = bf2f(KS[o]); pr[s] = bf2f(RS[o]); pv[s] = bf2f(VS[o]); } }
#pragma unroll
        for (int s = 0; s < SCH; ++s) { const ldsfp sv = ring + s * 320;
            f32x2v sa2 = (f32x2v){0.f, 0.f}, sb2 = (f32x2v){0.f, 0.f}, sa3 = sa2, sb3 = sa2;
#pragma unroll
            for (int hb = 0; hb < 2; ++hb) { f32x4 A[8];
#pragma unroll
                for (int i = 0; i < 8; ++i) A[i] = *(const LAS f32x4*)(sv + 64 + hb * 32 + 4 * i);
                __builtin_amdgcn_sched_barrier(0);
#pragma unroll
                for (int i = 0; i < 8; ++i) { const int jj = hb * 16 + 2 * i; const f32x2v alo = (f32x2v){A[i].x, A[i].y}, ahi = (f32x2v){A[i].z, A[i].w};
                    sa2 += S0[jj] * alo; sa3 += S0[jj + 1] * ahi;
                    if (IDENT) { sb2 += S1[jj] * alo; sb3 += S1[jj + 1] * ahi; } }
                __builtin_amdgcn_sched_barrier(0); }
            const float sa = (sa2.x + sa2.y) + (sa3.x + sa3.y), sb = (sb2.x + sb2.y) + (sb3.x + sb3.y);
            const f32x2v saa = (f32x2v){sa, sa}, sbb = (f32x2v){sb, sb}, vv = (f32x2v){cv[s], cv[s]};
            f32x2v y2 = (f32x2v){0.f, 0.f}, y3 = y2, e2 = y2, e3 = y2;
#pragma unroll
            for (int ch = 0; ch < 8; ++ch) { f32x4 W[2], Bq[2], K[2], R[2];
#pragma unroll
                for (int i = 0; i < 2; ++i) { const int j = ch * 8 + 4 * i; W[i] = *(const LAS f32x4*)(sv + j); Bq[i] = *(const LAS f32x4*)(sv + 128 + j); K[i] = *(const LAS f32x4*)(sv + 192 + j); R[i] = *(const LAS f32x4*)(sv + 256 + j); }
                __builtin_amdgcn_sched_barrier(0);
#pragma unroll
                for (int i = 0; i < 2; ++i) { const int jj = ch * 4 + 2 * i;
                    const f32x2v wlo = (f32x2v){W[i].x, W[i].y}, whi = (f32x2v){W[i].z, W[i].w}, blo = (f32x2v){Bq[i].x, Bq[i].y}, bhi = (f32x2v){Bq[i].z, Bq[i].w};
                    const f32x2v klo = (f32x2v){K[i].x, K[i].y}, khi = (f32x2v){K[i].z, K[i].w}, rlo = (f32x2v){R[i].x, R[i].y}, rhi = (f32x2v){R[i].z, R[i].w};
                    S0[jj] = S0[jj] * wlo + saa * blo + vv * klo; y2 += S0[jj] * rlo;
                    S0[jj + 1] = S0[jj + 1] * whi + saa * bhi + vv * khi; y3 += S0[jj + 1] * rhi;
                    if (IDENT) { S1[jj] = S1[jj] * wlo + sbb * blo; e2 += S1[jj] * rlo; S1[jj + 1] = S1[jj + 1] * whi + sbb * bhi; e3 += S1[jj + 1] * rhi; } }
                __builtin_amdgcn_sched_barrier(0); }
            YD[co[s]] = (y2.x + y2.y) + (y3.x + y3.y);
            if (IDENT) { const int tl = d ? (SEQ - 1 - (step0 - CTX + c * SCH + s)) : (step0 - CTX + c * SCH + s); E[(size_t)tl * 64 + lane] = f2bf((e2.x + e2.y) + (e3.x + e3.y)); }
        }
    }
    float* ZP = (float*)(P.ws + WS_ZP) + ((size_t)chain * NSEG + g) * 2 * 4096;
#pragma unroll
    for (int j = 0; j < 32; j += 2) { *(float4*)(ZP + lane * 64 + 2 * j) = make_float4(S0[j].x, S0[j].y, S0[j + 1].x, S0[j + 1].y);
        if (IDENT) *(float4*)(ZP + 4096 + lane * 64 + 2 * j) = make_float4(S1[j].x, S1[j].y, S1[j + 1].x, S1[j + 1].y); }
}
__device__ __forceinline__ void scan_combine(const Params& P, int chain, float* lds) {
    const int tid = otid(); const int i = tid >> 3, j0 = (tid & 7) * 8;
    float* Sl = lds;
    float* Pl = lds + 64 * 65;
    float* ZPc = (float*)(P.ws + WS_ZP) + (size_t)chain * NSEG * 2 * 4096;
    float sn[8];
#pragma unroll
    for (int q = 0; q < 8; ++q) sn[q] = ZPc[i * 64 + j0 + q];
    for (int g = 1; g < NSEG - 1; ++g) {
        __syncthreads();
#pragma unroll
        for (int q = 0; q < 8; ++q) Sl[i * 65 + j0 + q] = sn[q];
        const float* Pg = ZPc + (size_t)g * 2 * 4096 + 4096;
#pragma unroll
        for (int q = 0; q < 8; ++q) Pl[tid * 8 + q] = Pg[tid * 8 + q];
        float* Zg = ZPc + (size_t)g * 2 * 4096;
#pragma unroll
        for (int q = 0; q < 8; ++q) sn[q] = Zg[i * 64 + j0 + q];
        __syncthreads();
        for (int m = 0; m < 64; ++m) { const float sv = Sl[i * 65 + m]; const float4 p0 = *(const float4*)(Pl + m * 64 + j0), p1 = *(const float4*)(Pl + m * 64 + j0 + 4);
            sn[0] += sv * p0.x; sn[1] += sv * p0.y; sn[2] += sv * p0.z; sn[3] += sv * p0.w; sn[4] += sv * p1.x; sn[5] += sv * p1.y; sn[6] += sv * p1.z; sn[7] += sv * p1.w; }
#pragma unroll
        for (int q = 0; q < 8; ++q) Zg[i * 64 + j0 + q] = sn[q];
    }
    __syncthreads();
}

__device__ __forceinline__ void rwkv_out_fin(const Params& P, int row, int c, float y, float lnw, float lnb, float bon, float vs, float gt) {
    bf16_t* MIX = (bf16_t*)(P.ws + WS_U);
    const float mean = wsum(y) * (1.0f / 64.0f); const float dv = y - mean; const float var = wsum(dv * dv) * (1.0f / 64.0f);
    const float yn = dv * rsqrtf(var + 64e-5f) * lnw + lnb;
    MIX[(size_t)row * D + 256 + c] = f2bf((yn + bon * vs) * gt);
}
__device__ __forceinline__ void ph_rwkvout(const Params& P, int l, float* ldsf) {
    using pg8::bf16x8;
    const int tid = otid(), lane = tid & 63, fr = lane & 15, fq = lane >> 4, wv = tid >> 6, gw = blockIdx.x * NWAVE + wv, nw = gridDim.x * NWAVE;
    const float* YD = (const float*)(P.ws + WS_YDIR); const bf16_t* VS = (const bf16_t*)(P.ws + WS_VS); const bf16_t* GT = (const bf16_t*)(P.ws + WS_GATE); const float* BON = (const float*)(P.ws + WS_BONUS);
    bf16_t* MIX = (bf16_t*)(P.ws + WS_U);
    for (int it = gw; it < NB * 6 * 32 * 4; it += nw) {
        const int sub = it & 3, q = (it >> 2) & 31, h = (it >> 7) % 6, b = it / (128 * 6);
        const int t0 = q * 256 + sub * 64;
        f32x4 acc[4][4];
#pragma unroll
        for (int mt = 0; mt < 4; ++mt)
#pragma unroll
            for (int nt = 0; nt < 4; ++nt) acc[mt][nt] = (f32x4){0.f, 0.f, 0.f, 0.f};
#pragma unroll
        for (int dir = 0; dir < 2; ++dir) { const int ch = b * 12 + h * 2 + dir, slot = dir ? (31 - q) : q;
            const float* Sp = (const float*)(P.ws + WS_ZP) + ((size_t)ch * NSEG + slot) * 2 * 4096;
            const bf16_t* Ep = (const bf16_t*)(P.ws + WS_E) + ((size_t)ch * SEQ + t0) * 64;
#pragma unroll
            for (int ks = 0; ks < 2; ++ks) { bf16x8 bop[4];
#pragma unroll
                for (int nt = 0; nt < 4; ++nt) { const float* sp = Sp + (nt * 16 + fr) * 64 + ks * 32 + fq * 8; const float4 s0 = *(const float4*)sp, s1 = *(const float4*)(sp + 4);
                    u32x4 w; w.x = cvt_pk_bf16(s0.x, s0.y); w.y = cvt_pk_bf16(s0.z, s0.w); w.z = cvt_pk_bf16(s1.x, s1.y); w.w = cvt_pk_bf16(s1.z, s1.w); bop[nt] = __builtin_bit_cast(bf16x8, w); }
#pragma unroll
                for (int mt = 0; mt < 4; ++mt) { const bf16x8 a = *(const bf16x8*)(Ep + (size_t)(mt * 16 + fr) * 64 + ks * 32 + fq * 8);
#pragma unroll
                    for (int nt = 0; nt < 4; ++nt) acc[mt][nt] = __builtin_amdgcn_mfma_f32_16x16x32_bf16(a, bop[nt], acc[mt][nt], 0, 0, 0); } } }
        float lnw[4], lnb[4];
#pragma unroll
        for (int nt = 0; nt < 4; ++nt) { lnw[nt] = P.in[I_LNW][l * RWW + h * 64 + nt * 16 + fr]; lnb[nt] = P.in[I_LNB][l * RWW + h * 64 + nt * 16 + fr]; }
#pragma unroll
        for (int mt = 0; mt < 4; ++mt)
#pragma unroll
            for (int rg = 0; rg < 4; ++rg) { const int row = b * SEQ + t0 + mt * 16 + fq * 4 + rg; const size_t o = (size_t)row * 384 + h * 64 + fr;
                float y[4], vs[4], gt[4]; const float bon = BON[(size_t)row * 6 + h];
#pragma unroll
                for (int nt = 0; nt < 4; ++nt) { y[nt] = YD[o + nt * 16] + YD[(size_t)T * 384 + o + nt * 16] + acc[mt][nt][rg]; vs[nt] = bf2f(VS[o + nt * 16]); gt[nt] = bf2f(GT[o + nt * 16]); }
                float sm = (y[0] + y[1]) + (y[2] + y[3]);
                sm += __shfl_xor(sm, 1); sm += __shfl_xor(sm, 2); sm += __shfl_xor(sm, 4); sm += __shfl_xor(sm, 8);
                const float mean = sm * (1.0f / 64.0f);
                float vr = 0.f;
#pragma unroll
                for (int nt = 0; nt < 4; ++nt) { y[nt] -= mean; vr += y[nt] * y[nt]; }
                vr += __shfl_xor(vr, 1); vr += __shfl_xor(vr, 2); vr += __shfl_xor(vr, 4); vr += __shfl_xor(vr, 8);
                const float rstd = rsqrtf(vr * (1.0f / 64.0f) + 64e-5f);
#pragma unroll
                for (int nt = 0; nt < 4; ++nt) MIX[(size_t)row * D + 256 + h * 64 + nt * 16 + fr] = f2bf((y[nt] * rstd * lnw[nt] + lnb[nt] + bon * vs[nt]) * gt[nt]);
                if (rg & 1) asm volatile("" ::: "memory"); }
    }
    for (int it = gw; it < TC * 6; it += nw) { const int row = TL + it / 6, h = it % 6, c = h * 64 + lane; const size_t o = (size_t)row * 384 + c;
        rwkv_out_fin(P, row, c, YD[o] + YD[(size_t)T * 384 + o], P.in[I_LNW][l * RWW + c], P.in[I_LNB][l * RWW + c], BON[(size_t)row * 6 + h], bf2f(VS[o]), bf2f(GT[o])); }
}

__device__ __forceinline__ void zt_tile(const Params& P, int tile, float* tl  ) {
    const int tid = otid(); const int c0 = (tile & 3) * 64, t0 = (tile >> 2) * 64;
    const float* Z = (const float*)(P.ws + WS_Z1); bf16_t* MIX = (bf16_t*)(P.ws + WS_U);
    { const int cc = tid >> 3, sg = (tid & 7) * 8; const float* src = Z + (size_t)(c0 + cc) * TL + t0 + sg; const float4 a = *(const float4*)src, b = *(const float4*)(src + 4);
      tl[cc * 65 + sg + 0] = a.x; tl[cc * 65 + sg + 1] = a.y; tl[cc * 65 + sg + 2] = a.z; tl[cc * 65 + sg + 3] = a.w; tl[cc * 65 + sg + 4] = b.x; tl[cc * 65 + sg + 5] = b.y; tl[cc * 65 + sg + 6] = b.z; tl[cc * 65 + sg + 7] = b.w; }
    __syncthreads();
    { const int tk = tid >> 3, cs = (tid & 7) * 8;
      u32x4 w; w.x = cvt_pk_bf16(tl[(cs + 0) * 65 + tk], tl[(cs + 1) * 65 + tk]); w.y = cvt_pk_bf16(tl[(cs + 2) * 65 + tk], tl[(cs + 3) * 65 + tk]);
      w.z = cvt_pk_bf16(tl[(cs + 4) * 65 + tk], tl[(cs + 5) * 65 + tk]); w.w = cvt_pk_bf16(tl[(cs + 6) * 65 + tk], tl[(cs + 7) * 65 + tk]);
      *(u32x4*)(MIX + (size_t)(t0 + tk) * D + c0 + cs) = w; }
    __syncthreads();
}
typedef const __attribute__((address_space(4))) Params* KParamsPtr;
__device__ __forceinline__ const Params* fresh_params() { KParamsPtr q = (KParamsPtr)__builtin_amdgcn_kernarg_segment_ptr(); asm volatile("" : "+s"(q)); return (const Params*)q; }
__global__ void __launch_bounds__(NTHR, 2) fwd_megakernel(Params P_unused, int ph_lo, int ph_hi) {
    extern __shared__ __attribute__((aligned(16))) unsigned char smem[];
    cg::grid_group grid = cg::this_grid();
    LAS unsigned char* lds3 = (LAS unsigned char*)smem;
    float* ldsf = (float*)smem; float2* X = (float2*)smem; float* ex = (float*)(smem + LDS_MAIN);
    { volatile LAS unsigned* st = (volatile LAS unsigned*)(lds3 + LDS_MAIN + 4096); if (threadIdx.x == 0) { st[0] = 0u; st[1] = 0u; } }
    __syncthreads();
    XcdBarrier xbar = xcd_barrier_post((unsigned*)(((const Params*)fresh_params())->ws + WS_BAR), (volatile LAS unsigned*)(lds3 + LDS_MAIN + 4096));
    int ph = 0;
#ifndef REP_GEMM
#define REP_GEMM 1
#endif
#ifndef REP_SCAN
#define REP_SCAN 1
#endif
#ifndef REP_MISC
#define REP_MISC 1
#endif
#ifndef REP_HY
#define REP_HY 1
#endif
#define PHASE_BEGIN if (ph >= ph_lo && ph < ph_hi) { const Params& P = *fresh_params(); unsigned char* ws = P.ws; (void)ws;
#ifndef REP_SYNC
#define REP_SYNC 1
#endif
#define PHASE_END   if (ph + 1 < ph_hi) { for (int rs_ = 0; rs_ < REP_SYNC; ++rs_) { if (ph == 0) grid.sync(); else xcd_barrier(xbar); } } } ++ph;
    PHASE_BEGIN ph_modv(P, ldsf); PHASE_END
    for (int l = 0; l < DEPTH; ++l) {
        PHASE_BEGIN
            for (int rep_ = 0; rep_ < REP_MISC; ++rep_) ph_prep(P, l, ldsf);
            if (l == 0) ph_rowpass(P, 0, 0, 0, 0, 0.f, 0, 0, 0, 1, 1);
            else ph_rowpass(P, 1, l - 1, 8, 5, 0.5f, l, 0, 0, 1, 11);
        PHASE_END
        PHASE_BEGIN { EpiGU E{(bf16_t*)(ws + WS_ACT)}; for (int rep_ = 0; rep_ < REP_GEMM; ++rep_) run_gemm(lds3, (const bf16_t*)(ws + WS_U), (const bf16_t*)(ws + WS_WGU1), T, 2 * DFF, D, E); } PHASE_END
        PHASE_BEGIN { EpiF32 E{(bf16_t*)(ws + WS_Y), (float*)(ws + WS_YC)}; run_gemm_tail(lds3, (const bf16_t*)(ws + WS_ACT), (const bf16_t*)(ws + WS_WDN1), DFF, E); } PHASE_END
        PHASE_BEGIN ph_rowpass(P, 1, l, 2, 1, 0.5f, l, 2, 3, 4, 11); PHASE_END
        PHASE_BEGIN { EpiWin E{(bf16_t*)(ws + WS_PHY), (bf16_t*)(ws + WS_PRW), (bf16_t*)(ws + WS_PNA)}; for (int rep_ = 0; rep_ < REP_GEMM; ++rep_) run_gemm(lds3, (const bf16_t*)(ws + WS_U), (const bf16_t*)(ws + WS_WIN), T, INWP, D, E); } PHASE_END
        PHASE_BEGIN
            for (int rep_ = 0; rep_ < REP_MISC; ++rep_) { ph_loraprep(P, l);
            for (int it = blockIdx.x; it < NB * 128 * 6 + NB * 4 * 6; it += gridDim.x) vt_tile(P, it, (unsigned short*)smem); }
            for (int rep_ = 0; rep_ < REP_HY; ++rep_) for (int it = blockIdx.x; it < 512; it += gridDim.x) hy_spec_task(P, l, it >> 8, it & 255, X, ex);
        PHASE_END
        PHASE_BEGIN { EpiLora E{(bf16_t*)(ws + WS_LORAO), (bf16_t*)(ws + WS_GATE)};
            for (int rep_ = 0; rep_ < REP_GEMM; ++rep_) run_gemm(lds3, (const bf16_t*)(ws + WS_ALORA), (const bf16_t*)(ws + WS_WLORA), T, 2048, 384, E); } PHASE_END
        PHASE_BEGIN
            for (int rep_ = 0; rep_ < REP_MISC; ++rep_) ph_rwkvprep(P, l);
            for (int rep_ = 0; rep_ < REP_HY; ++rep_) for (int c = blockIdx.x; c < HYC; c += gridDim.x) hy_task1(P, l, c, X, ex);
        PHASE_END
        PHASE_BEGIN {
            const int wv = __builtin_amdgcn_readfirstlane(otid() >> 6);
            if (wv < 4) { const int k = wv * (int)gridDim.x + (int)blockIdx.x;
                if (k < 24 * NSEG) { const int chain = k / NSEG, g = k % NSEG; float* ring = ldsf + wv * (SCH * 320);
                    __builtin_amdgcn_s_setprio(3);
                    for (int rep_ = 0; rep_ < REP_SCAN; ++rep_) { if (g == 0) scan_seg<false>(P, chain, g, ring); else scan_seg<true>(P, chain, g, ring); }
                    __builtin_amdgcn_s_setprio(0); } }
            else for (int it = (wv - 4) * (int)gridDim.x + (int)blockIdx.x; it < NAT_TASKS; it += 4 * (int)gridDim.x) natten_task(P, l, it);
        } PHASE_END
        PHASE_BEGIN
            if (blockIdx.x < 24) scan_combine(P, blockIdx.x, ldsf);
            else for (int rep_ = 0; rep_ < REP_HY; ++rep_) for (int c = blockIdx.x - 24; c < HYC; c += gridDim.x - 24) hy_task2(P, l, c, X);
        PHASE_END
        PHASE_BEGIN for (int rep_ = 0; rep_ < REP_MISC; ++rep_) ph_rwkvout(P, l, ldsf);
            __syncthreads();
            for (int it = blockIdx.x; it < 4 * (TL / 64); it += gridDim.x) zt_tile(P, it, ldsf);
        PHASE_END
        PHASE_BEGIN { EpiF32 E{(bf16_t*)(ws + WS_Y), (float*)(ws + WS_YC)}; run_gemm_tail(lds3, (const bf16_t*)(ws + WS_U), (const bf16_t*)(ws + WS_WOUT), D, E); } PHASE_END
        PHASE_BEGIN ph_rowpass(P, 1, l, 5, 3, 1.0f, l, 4, 6, 7, 4); PHASE_END
        PHASE_BEGIN { EpiGU E{(bf16_t*)(ws + WS_ACT)}; for (int rep_ = 0; rep_ < REP_GEMM; ++rep_) run_gemm(lds3, (const bf16_t*)(ws + WS_U), (const bf16_t*)(ws + WS_WGU2), T, 2 * DFF, D, E); } PHASE_END
        PHASE_BEGIN { EpiF32 E{(bf16_t*)(ws + WS_Y), (float*)(ws + WS_YC)}; run_gemm_tail(lds3, (const bf16_t*)(ws + WS_ACT), (const bf16_t*)(ws + WS_WDN2), DFF, E); } PHASE_END
    }
    PHASE_BEGIN ph_rowpass(P, 2, DEPTH - 1, 8, 5, 0.5f, 0, 0, 0, 0, 11); PHASE_END
#undef PHASE_BEGIN
#undef PHASE_END
}
constexpr int N_PHASES = 1 + DEPTH * 15 + 1;

extern "C" void kernel_launch(void* const* d_in, const int* in_sizes, int n_in, void* d_out, int out_size, void* d_ws, size_t ws_size, hipStream_t stream) {
    static int grid = 0;
    if (grid == 0) {
        if (n_in != 34 || ws_size < WS_END) { fprintf(stderr, "kernel_launch: need 34 inputs and %zu bytes of workspace; got %d, %zu\n", (size_t)WS_END, n_in, ws_size); grid = -1; return; }
        int dev = 0, cus = 0, per_cu = 0;
        hipGetDevice(&dev); hipDeviceGetAttribute(&cus, hipDeviceAttributeMultiprocessorCount, dev);
        if (hipFuncSetAttribute((const void*)fwd_megakernel, hipFuncAttributeMaxDynamicSharedMemorySize, LDS_BYTES) != hipSuccess) { fprintf(stderr, "kernel_launch: hipFuncSetAttribute failed\n"); grid = -1; return; }
        if (hipOccupancyMaxActiveBlocksPerMultiprocessor(&per_cu, (const void*)fwd_megakernel, NTHR, LDS_BYTES) != hipSuccess || per_cu < 1) { fprintf(stderr, "kernel_launch: occupancy query says %d\n", per_cu); per_cu = 1; }
        (void)hipGetLastError();
        grid = cus;
    }
    if (grid < 0) return;
    if (hipMemsetAsync((char*)d_ws + WS_BAR, 0, (size_t)XCD_BAR_WORDS * 4, stream) != hipSuccess) { fprintf(stderr, "kernel_launch: memset of the barrier words failed\n"); return; }
    Params p{};
    for (int i = 0; i < 34; ++i) p.in[i] = (const float*)d_in[i];
    p.out = (float*)d_out; p.ws = (unsigned char*)d_ws;
#if MK_SPLIT
    for (int ph = 0; ph < N_PHASES; ++ph) { int lo = ph, hi = ph + 1; hipLaunchKernelGGL(fwd_megakernel, dim3(grid), dim3(NTHR), LDS_BYTES, stream, p, lo, hi); }
#else
    int lo = 0, hi = N_PHASES;
    void* args[] = {&p, &lo, &hi};
    hipError_t e = hipLaunchCooperativeKernel((const void*)fwd_megakernel, dim3(grid), dim3(NTHR), args, LDS_BYTES, stream);
    if (e != hipSuccess) fprintf(stderr, "cooperative launch failed: %s (grid %d)\n", hipGetErrorString(e), grid);
#endif
}
```

```cpp
#include <hip/hip_runtime.h>
#include <hip/hip_cooperative_groups.h>
#include <cstdio>
namespace cg = cooperative_groups;
__device__ __forceinline__ int otid() { int t = threadIdx.x; asm volatile("" : "+v"(t)); return t; }
namespace pg8 {
#define PG8_LAS __attribute__((address_space(3)))
typedef unsigned short bf16_t;
typedef short bf16x8 __attribute__((ext_vector_type(8)));
typedef float f32x4 __attribute__((ext_vector_type(4)));
typedef unsigned u32x4 __attribute__((ext_vector_type(4)));
constexpr int BM = 256, BK = 64, HALF = 128, HTB = HALF * BK * 2  , STAGE_BYTES = 8 * HTB, NXCD = 8, WGM = 8;

__host__ __device__ __forceinline__ int lds_byte(int r, int c) { const int st = (r >> 4) * 2 + (c >> 5), rr = r & 15, cc = c & 31, ob = rr * 64 + cc * 2; return st * 1024 + (ob ^ (((ob >> 9) & 1) << 5)); }
__host__ __device__ __forceinline__ void stage_rc(int b, int& R, int& C) { const int st = b / 1024, sb = b % 1024, swz = sb ^ (((sb >> 9) & 1) << 5); R = (st >> 1) * 16 + swz / 64; C = (st & 1) * 32 + (swz % 64) / 2; }
__host__ __device__ __forceinline__ int perm32(int rho) { const int n = rho >> 4, i = rho & 15; return 8 * (i >> 2) + 4 * n + (i & 3); }

struct Unit { int pm, pn, kt0, nkt; };
struct Gemm { const bf16_t* A; const bf16_t* Bt; int M, N, K; };
struct StaticOrder {
    int nM, nN, nwg, G, c;
    __host__ __device__ void init(int M, int N, int G_, int c_) { nM = M / BM; nN = N / BM; nwg = nM * nN; G = G_; c = c_; }
    __host__ __device__ bool next(int i, Unit& u) const {
        const long L = (long)i * G + c; if (L >= nwg) return false;
        int wgid = (int)L; { const int q = nwg / NXCD, r = nwg % NXCD, xcd = wgid % NXCD, off = wgid / NXCD; wgid = (xcd < r ? xcd * (q + 1) : r * (q + 1) + (xcd - r) * q) + off; }
        const int nig = WGM * nN, gid = wgid / nig, fm = gid * WGM, gsz = (nM - fm) < WGM ? (nM - fm) : WGM;
        u.pm = fm + ((wgid % nig) % gsz); u.pn = (wgid % nig) / gsz; u.kt0 = 0; u.nkt = 0; return true;
    }
    __device__ __forceinline__ void a_ready(const Unit&) const {}
    __device__ __forceinline__ void done(const Unit&) const {}
};
__device__ __forceinline__ unsigned cvt_pk_bf16(float lo, float hi) { unsigned r; asm volatile("v_cvt_pk_bf16_f32 %0, %1, %2" : "=v"(r) : "v"(lo), "v"(hi)); return r; }
template <class Epi, class Sched>
__device__ __forceinline__ void gemm_phase(PG8_LAS unsigned char* lds, const Gemm g, const Sched& S, const Epi& E) {
    const int tid = otid(), wid = __builtin_amdgcn_readfirstlane(tid >> 6), lane = tid & 63, wr = wid >> 2, wc = wid & 3, fr = lane & 15, fq = lane >> 4;
    const int K = g.K, nt = K / BK;
#define PG8_STAMP() do {} while (0)
    unsigned voffA[2], voffB[2];
#pragma unroll
    for (int i = 0; i < 2; ++i) { int R, C; stage_rc(tid * 16 + i * 8192, R, C); const int Rb = Epi::PERM ? ((R & ~31) + perm32(R & 31)) : R;
        voffA[i] = (unsigned)(R * K + C) * 2u; voffB[i] = (unsigned)(Rb * K + C) * 2u; }
    const size_t kstep = (size_t)(BK * 2);
    const size_t hstep = (size_t)HALF * K * 2;
    const size_t tstep = 2 * hstep;
    const unsigned ldsw = (unsigned)wid * 1024u;
    const int aoff = lds_byte(wr * 64 + fr, fq * 8), boff = lds_byte(wc * 32 + fr, fq * 8);
#define PG8_SA(b, h) (((b) * 2 + (h)) * HTB)
#define PG8_SB(b, h) ((4 + (b) * 2 + (h)) * HTB)
#define PG8_STAGE(bufoff, gbase, voff) do { _Pragma("unroll") for (int _i = 0; _i < 2; ++_i) \
        __builtin_amdgcn_global_load_lds((const unsigned*)((const char*)(gbase) + (voff)[_i]), (PG8_LAS unsigned*)(lds + (bufoff) + ldsw + _i * 8192), 16, 0, 0); } while (0)
#define PG8_LDA(dst, b, h) do { _Pragma("unroll") for (int m = 0; m < 4; ++m) _Pragma("unroll") for (int k = 0; k < 2; ++k) dst[m][k] = *(const PG8_LAS bf16x8*)(lds + PG8_SA(b, h) + aoff + m * 2048 + k * 1024); } while (0)
#define PG8_LDB(dst, b, h) do { _Pragma("unroll") for (int n = 0; n < 2; ++n) _Pragma("unroll") for (int k = 0; k < 2; ++k) dst[n][k] = *(const PG8_LAS bf16x8*)(lds + PG8_SB(b, h) + boff + n * 2048 + k * 1024); } while (0)
#define PG8_MMA(ai, bj, At, Bt) do { __builtin_amdgcn_s_setprio(1); _Pragma("unroll") for (int m = 0; m < 4; ++m) _Pragma("unroll") for (int n = 0; n < 2; ++n) _Pragma("unroll") for (int k = 0; k < 2; ++k) \
        acc[ai][bj][m][n] = __builtin_amdgcn_mfma_f32_16x16x32_bf16(Bt[n][k], At[m][k], acc[ai][bj][m][n], 0, 0, 0); __builtin_amdgcn_s_setprio(0); } while (0)
#define PG8_WAIT_V(n) asm volatile("s_waitcnt vmcnt(" #n ")" ::: "memory")
#define PG8_WAIT_L(n) asm volatile("s_waitcnt lgkmcnt(" #n ")" ::: "memory")
#define PG8_BAR __builtin_amdgcn_s_barrier()
#define PG8_SCHED __builtin_amdgcn_sched_barrier(0)
    Unit cur, nxt; int ui = 0;
    if (!S.next(0, cur)) return;
    f32x4 acc[2][2][4][2];
#pragma unroll
    for (int a = 0; a < 2; ++a)
#pragma unroll
        for (int b = 0; b < 2; ++b)
#pragma unroll
            for (int m = 0; m < 4; ++m)
#pragma unroll
                for (int n = 0; n < 2; ++n) acc[a][b][m][n] = (f32x4){0.f, 0.f, 0.f, 0.f};
    bf16x8 At[4][2], B0[2][2], B1[2][2];
    const char* cA = (const char*)g.A + (size_t)cur.pm * tstep + (size_t)cur.kt0 * kstep; const char* cB = (const char*)g.Bt + (size_t)cur.pn * tstep + (size_t)cur.kt0 * kstep;
    int ntc = cur.nkt > 0 ? cur.nkt : nt;
    S.a_ready(cur);
    PG8_STAGE(PG8_SB(0, 0), cB, voffB); PG8_STAGE(PG8_SA(0, 0), cA, voffA); PG8_STAGE(PG8_SB(0, 1), cB + hstep, voffB); PG8_STAGE(PG8_SA(0, 1), cA + hstep, voffA);
    if (wr == 1) PG8_BAR;
    PG8_WAIT_V(4); PG8_BAR;
    PG8_STAGE(PG8_SB(1, 0), cB + kstep, voffB); PG8_STAGE(PG8_SA(1, 0), cA + kstep, voffA); PG8_STAGE(PG8_SB(1, 1), cB + hstep + kstep, voffB);
    PG8_WAIT_V(6); PG8_BAR;
    PG8_STAMP();
    for (;;) {
        const bool has_next = S.next(ui + 1, nxt);
        const char* nA = has_next ? (const char*)g.A + (size_t)nxt.pm * tstep + (size_t)nxt.kt0 * kstep : cA; const char* nB = has_next ? (const char*)g.Bt + (size_t)nxt.pn * tstep + (size_t)nxt.kt0 * kstep : cB;
        for (int t = 0; t < ntc; t += 2) {
            const bool last = (t == ntc - 2);
            const char* a1 = cA + (size_t)(t + 1) * kstep;
            const char* a2 = last ? nA : cA + (size_t)(t + 2) * kstep; const char* b2 = last ? nB : cB + (size_t)(t + 2) * kstep;
            const char* a3 = a2 + kstep; const char* b3 = b2 + kstep;
            if (last && has_next) S.a_ready(nxt);
            PG8_LDB(B0, 0, 0); PG8_SCHED; PG8_LDA(At, 0, 0); PG8_STAGE(PG8_SA(1, 1), a1 + hstep, voffA);
            PG8_WAIT_L(8); PG8_BAR; PG8_WAIT_L(0); PG8_MMA(0, 0, At, B0); PG8_BAR; PG8_SCHED;
            PG8_LDB(B1, 0, 1); PG8_STAGE(PG8_SB(0, 0), b2, voffB);
            PG8_BAR; PG8_WAIT_L(0); PG8_MMA(0, 1, At, B1); PG8_BAR;
            PG8_LDA(At, 0, 1); PG8_STAGE(PG8_SA(0, 0), a2, voffA);
            PG8_BAR; PG8_WAIT_L(0); PG8_MMA(1, 0, At, B0); PG8_BAR; PG8_SCHED;
            PG8_STAGE(PG8_SB(0, 1), b2 + hstep, voffB);
            PG8_WAIT_V(6); PG8_BAR; PG8_MMA(1, 1, At, B1); PG8_BAR;
            PG8_LDB(B0, 1, 0); PG8_SCHED; PG8_LDA(At, 1, 0); PG8_STAGE(PG8_SA(0, 1), a2 + hstep, voffA);
            PG8_WAIT_L(8); PG8_BAR; PG8_WAIT_L(0); PG8_MMA(0, 0, At, B0); PG8_BAR; PG8_SCHED;
            PG8_LDB(B1, 1, 1); PG8_STAGE(PG8_SB(1, 0), b3, voffB);
            PG8_BAR; PG8_WAIT_L(0); PG8_MMA(0, 1, At, B1); PG8_BAR;
            PG8_LDA(At, 1, 1); PG8_STAGE(PG8_SA(1, 0), a3, voffA);
            PG8_BAR; PG8_WAIT_L(0); PG8_MMA(1, 0, At, B0); PG8_BAR; PG8_SCHED;
            PG8_STAGE(PG8_SB(1, 1), b3 + hstep, voffB);
            PG8_WAIT_V(6); PG8_BAR; PG8_MMA(1, 1, At, B1); PG8_BAR;
        }
        PG8_STAMP();
        if constexpr (!Epi::AFTER_DRAIN) { E(acc, cur, wr, wc, fr, fq); S.done(cur); }
        PG8_STAMP();
        if (!has_next) break;
#pragma unroll
        for (int a = 0; a < 2; ++a)
#pragma unroll
            for (int b = 0; b < 2; ++b)
#pragma unroll
                for (int m = 0; m < 4; ++m)
#pragma unroll
                    for (int n = 0; n < 2; ++n) acc[a][b][m][n] = (f32x4){0.f, 0.f, 0.f, 0.f};
        cur = nxt; cA = nA; cB = nB; ++ui; ntc = cur.nkt > 0 ? cur.nkt : nt;
    }
    PG8_WAIT_V(0);
    if (wr == 0) PG8_BAR;
    PG8_BAR;
    if constexpr (Epi::AFTER_DRAIN) { E.fused(acc, cur, wr, wc, fr, fq, lds, wid, lane); S.done(cur); }
    PG8_STAMP();
#undef PG8_STAMP
#undef PG8_SA
#undef PG8_SB
#undef PG8_STAGE
#undef PG8_LDA
#undef PG8_LDB
#undef PG8_MMA
#undef PG8_WAIT_V
#undef PG8_WAIT_L
#undef PG8_BAR
#undef PG8_SCHED
}
}
#define LAS __attribute__((address_space(3)))
#define XB_TMO      128
#define XB_XCNT(j)  (256  + 64 * (j))
#define XB_XSUB(j)  (1280 + 64 * (j))
#define XB_XGEN(j)  (2304 + 64 * (j))
#define XB_TOP      3328
#define XB_TOPGEN   3392
#define XCD_BAR_WORDS 3456
#define XB_SPIN_CAP (1u << 18)

__device__ __forceinline__ unsigned xb_ld(unsigned* p)              { return __hip_atomic_load(p, __ATOMIC_RELAXED, __HIP_MEMORY_SCOPE_AGENT); }
__device__ __forceinline__ unsigned xb_add(unsigned* p, unsigned v) { return __hip_atomic_fetch_add(p, v, __ATOMIC_RELAXED, __HIP_MEMORY_SCOPE_AGENT); }
__device__ __forceinline__ unsigned xb_xcc_id() { return (unsigned)__builtin_amdgcn_s_getreg((3 << 11) | 20) & 0xFu; }
#define XB_SPIN(cond, bar) do { unsigned _sp = 0; while (cond) { __builtin_amdgcn_s_sleep(1); \
    if ((++_sp & 255u) == 0u) { if (xb_ld(&(bar)[XB_TMO])) break; if (_sp > XB_SPIN_CAP) { atomicAdd(&(bar)[XB_TMO], 1u); break; } } } } while (0)

struct XcdBarrier {
    unsigned* bar; unsigned x;
    volatile LAS unsigned* st;
};

__device__ __forceinline__ XcdBarrier xcd_barrier_post(unsigned* bar, volatile LAS unsigned* st) {
    XcdBarrier b; b.bar = bar; b.x = xb_xcc_id(); b.st = st;
    if (threadIdx.x == 0) (void)xb_add(&bar[XB_XCNT(b.x)], 1u);
    return b;
}
__device__ __forceinline__ void xcd_barrier_complete(unsigned* bar, unsigned x, unsigned& nloc, unsigned& nx) {
    const unsigned G = gridDim.x * gridDim.y * gridDim.z;
    unsigned sum, cnt, mine, sp = 0u;
    for (;;) {
        sum = 0u; cnt = 0u; mine = 0u;
#pragma unroll
        for (unsigned j = 0; j < 16; ++j) { const unsigned c = xb_ld(&bar[XB_XCNT(j)]); sum += c; cnt += (c > 0u) ? 1u : 0u; mine = (j == x) ? c : mine; }
        if (sum == G) break;
        __builtin_amdgcn_s_sleep(1);
        if ((++sp & 255u) == 0u) { if (xb_ld(&bar[XB_TMO])) break; if (sp > XB_SPIN_CAP) { atomicAdd(&bar[XB_TMO], 1u); break; } }
    }
    nloc = mine > 0u ? mine : 1u; nx = cnt > 0u ? cnt : 1u;
}

__device__ __forceinline__ void xcd_barrier(const XcdBarrier& b) {
    asm volatile("s_waitcnt vmcnt(0)" ::: "memory");
    __syncthreads();
    if (threadIdx.x == 0) {
        unsigned* bar = b.bar;
        __builtin_amdgcn_s_waitcnt(0);
        unsigned nloc = b.st[0], nx = b.st[1];
        if (nloc == 0u) { xcd_barrier_complete(bar, b.x, nloc, nx); b.st[0] = nloc; b.st[1] = nx; }
        const unsigned old = xb_add(&bar[XB_XSUB(b.x)], 1u);
        const unsigned gen = old / nloc;
        if (old + 1u == (gen + 1u) * nloc) {
            __builtin_amdgcn_fence(__ATOMIC_RELEASE, "agent");
            asm volatile("s_waitcnt vmcnt(0)" ::: "memory");
            const unsigned og = xb_add(&bar[XB_TOP], 1u);
            const unsigned tg = og / nx;
            if (og + 1u == (tg + 1u) * nx) xb_add(&bar[XB_TOPGEN], 1u);
            else XB_SPIN(xb_ld(&bar[XB_TOPGEN]) == tg, bar);
            __builtin_amdgcn_fence(__ATOMIC_ACQUIRE, "agent");
            xb_add(&bar[XB_XGEN(b.x)], 1u);
            asm volatile("s_waitcnt vmcnt(0)" ::: "memory");
        } else {
            XB_SPIN(xb_ld(&bar[XB_XGEN(b.x)]) == gen, bar);
            __builtin_amdgcn_fence(__ATOMIC_ACQUIRE, "agent");
            asm volatile("s_waitcnt vmcnt(0)" ::: "memory");
        }
    }
    __syncthreads();
}

using pg8::bf16_t; using pg8::f32x4; using pg8::u32x4; using pg8::cvt_pk_bf16;
typedef unsigned u32x2 __attribute__((ext_vector_type(2)));


constexpr int D = 1024, NB = 2, SEQ = 8192, DEPTH = 4, CTX = 256, DFF = 2816;
constexpr int TL = NB * SEQ, TC = NB * CTX, T = TL + TC;
constexpr int NMOD = 9 * D;
constexpr int HYC = 256, RWW = 384, NAW = 384, INW = 3456, INWP = 3584;
constexpr int HY_IN = 768, RW_IN = 1536, NA_IN = 1152;
constexpr int NFFT = 16384;
constexpr int NTHR = 512, NWAVE = 8;
constexpr int LDS_MAIN = 131072, LDS_EXTRA = 8192, LDS_BYTES = LDS_MAIN + LDS_EXTRA;
constexpr float NORM_EPS = 1e-6f;

constexpr size_t al256(size_t x) { return (x + 255) & ~(size_t)255; }
constexpr size_t WS_MODV = 0;
constexpr size_t WS_WGU1 = al256(WS_MODV + (size_t)DEPTH * 3 * NMOD * 4);
constexpr size_t WS_WDN1 = WS_WGU1 + (size_t)2 * DFF * D * 2;
constexpr size_t WS_WGU2 = WS_WDN1 + (size_t)D * DFF * 2;
constexpr size_t WS_WDN2 = WS_WGU2 + (size_t)2 * DFF * D * 2;
constexpr size_t WS_WIN = WS_WDN2 + (size_t)D * DFF * 2;
constexpr size_t WS_WOUT = WS_WIN + (size_t)INWP * D * 2;
constexpr size_t WS_WLORA = WS_WOUT + (size_t)D * D * 2;
constexpr size_t WS_H = WS_WLORA + (size_t)2048 * 384 * 2;
constexpr size_t WS_U = WS_H + (size_t)T * D * 4;
constexpr size_t WS_S = WS_U + (size_t)T * D * 2;
constexpr size_t WS_Y = WS_S;
constexpr size_t WS_ACT = WS_Y + (size_t)T * D * 4;
constexpr size_t WS_FFN_END = WS_ACT + (size_t)T * DFF * 2;
constexpr size_t WS_PHY = WS_S;
constexpr size_t WS_PRW = WS_PHY + (size_t)T * HY_IN * 2;
constexpr size_t WS_YDIR = WS_PRW;
constexpr size_t WS_PNA = WS_PRW + (size_t)T * RW_IN * 2;
constexpr size_t WS_ALORA = WS_PNA + (size_t)T * NA_IN * 2;
constexpr size_t WS_DECAY = WS_ALORA + (size_t)T * 384 * 2;
constexpr size_t WS_LORAO = WS_DECAY + (size_t)2 * T * 384 * 4;
constexpr size_t WS_E = WS_LORAO;
constexpr size_t WS_ZP = WS_E + (size_t)24 * SEQ * 64 * 2;
constexpr size_t WS_GATE = WS_LORAO + (size_t)T * 1536 * 2;
static_assert(WS_ZP + (size_t)24 * 33 * 2 * 4096 * 4 <= WS_GATE, "E + ZP must fit in the LORAO region");
constexpr size_t WS_RS = WS_GATE + (size_t)T * 384 * 2;
constexpr size_t WS_KKS = WS_RS + (size_t)T * 384 * 2;
constexpr size_t WS_VS = WS_KKS + (size_t)T * 384 * 2;
constexpr size_t WS_KS = WS_VS + (size_t)T * 384 * 2;
constexpr size_t WS_BS = WS_KS + (size_t)2 * T * 384 * 2;
constexpr size_t WS_BONUS = WS_BS + (size_t)2 * T * 384 * 2;
constexpr size_t WS_FILT = al256(WS_BONUS + (size_t)T * 6 * 4);
constexpr size_t WS_FILTC = WS_FILT + (size_t)1024 * SEQ * 2;
constexpr size_t WS_SPEC = WS_FILTC + (size_t)1024 * CTX * 2;
constexpr size_t WS_Z1 = WS_SPEC + (size_t)512 * NFFT * 8;
constexpr size_t WS_VTL = WS_Z1 + (size_t)HYC * NB * SEQ * 4;
constexpr size_t WS_VTC = WS_VTL + (size_t)NB * 6 * 64 * SEQ * 2;
constexpr size_t WS_MIX_END = WS_VTC + (size_t)NB * 6 * 64 * CTX * 2;
constexpr size_t WS_BAR = al256(WS_MIX_END > WS_FFN_END ? WS_MIX_END : WS_FFN_END);
constexpr size_t WS_ROPE = al256(WS_BAR + (size_t)XCD_BAR_WORDS * 4);
constexpr size_t WS_YC = WS_FFN_END + (size_t)(8 << 20);
static_assert(WS_YC + (size_t)11 * TC * D * 4 <= WS_FILT, "YC partials must stay below the filter tables");
constexpr size_t WS_END = WS_ROPE + (size_t)128 * 16 * 8;
static_assert(WS_END <= (size_t)4 * DEPTH * D * NMOD * 4, "workspace map exceeds 4x the largest input tensor");

struct Params { const float* in[34]; float* out; unsigned char* ws; };
enum { I_X = 0, I_C, I_CTX, I_CCTX, I_MODW, I_MODB, I_NORMG, I_F1GU, I_F1DN, I_F2GU, I_F2DN, I_WIN, I_WOUT, I_HCW, I_HCB, I_HW1, I_HB1, I_HW2, I_HB2, I_HW3, I_HFREQ, I_HBIAS,
       I_MU, I_W0, I_W2, I_A0, I_A2, I_G2, I_KK, I_KA, I_RK, I_LNW, I_LNB, I_RPB };

typedef LAS float* ldsfp;
__device__ __forceinline__ ldsfp vlds(const void* p) { ldsfp q = (ldsfp)p; asm volatile("" : "+v"(q)); return q; }
__device__ __forceinline__ float bf2f(bf16_t b) { return __uint_as_float(((unsigned)b) << 16); }
__device__ __forceinline__ bf16_t f2bf(float f) { unsigned u = __float_as_uint(f); u += 0x7FFFu + ((u >> 16) & 1u); return (bf16_t)(u >> 16); }
__device__ __forceinline__ float lo_bf(unsigned w) { return __uint_as_float(w << 16); }
__device__ __forceinline__ float hi_bf(unsigned w) { return __uint_as_float(w & 0xffff0000u); }
__device__ __forceinline__ float wsum(float v) {
#pragma unroll
    for (int o = 32; o > 0; o >>= 1) v += __shfl_xor(v, o);
    return v;
}
__device__ __forceinline__ float sigmoidf_(float x) { return __builtin_amdgcn_rcpf(1.0f + __expf(-x)); }
__device__ __forceinline__ void unpack8(const u32x4 w, float (&f)[8]) {
    f[0] = lo_bf(w.x); f[1] = hi_bf(w.x); f[2] = lo_bf(w.y); f[3] = hi_bf(w.y); f[4] = lo_bf(w.z); f[5] = hi_bf(w.z); f[6] = lo_bf(w.w); f[7] = hi_bf(w.w);
}
__device__ __forceinline__ void row_nbrs(int row, bool& hasp, bool& hasn) {
    if (row < TL) { const int t = row & (SEQ - 1); hasp = t > 0; hasn = t < SEQ - 1; }
    else { const int t = (row - TL) & (CTX - 1); hasp = t > 0; hasn = t < CTX - 1; }
}

__device__ __forceinline__ void ph_modv(const Params& P, float* lds) {
    const int tid = otid();
    float* sv = lds;
    float* red = lds + 3072;
    for (int i = tid; i < 3072; i += NTHR) { const int s = i >> 10, k = i & 1023; const float c = s < 2 ? P.in[I_C][s * 1024 + k] : P.in[I_CCTX][k]; sv[i] = c / (1.0f + expf(-c)); }
    __syncthreads();
    if (blockIdx.x < 4) { const int e = blockIdx.x * NTHR + tid, pos = e >> 4, f = e & 15; float sn, cs; sincosf((float)pos * expf(-(float)f * (9.210340371976184f / 16.0f)), &sn, &cs); ((float2*)(P.ws + WS_ROPE))[e] = make_float2(cs, sn); }
    float* modv = (float*)(P.ws + WS_MODV);
    const int kc = tid >> 6, cl = tid & 63;
    for (int item = blockIdx.x; item < DEPTH * 144; item += gridDim.x) {
        const int l = item / 144, cb = item % 144, col = cb * 64 + cl;
        const float* w = P.in[I_MODW] + ((size_t)l * 1024 + kc * 128) * NMOD + col;
        float a0 = 0.f, a1 = 0.f, a2 = 0.f;
#pragma unroll 8
        for (int k = 0; k < 128; ++k) { const float wv = w[(size_t)k * NMOD]; a0 += sv[kc * 128 + k] * wv; a1 += sv[1024 + kc * 128 + k] * wv; a2 += sv[2048 + kc * 128 + k] * wv; }
        red[(0 * 8 + kc) * 64 + cl] = a0; red[(1 * 8 + kc) * 64 + cl] = a1; red[(2 * 8 + kc) * 64 + cl] = a2;
        __syncthreads();
        if (tid < 192) { const int s = tid >> 6, c = tid & 63; float r = P.in[I_MODB][l * NMOD + cb * 64 + c];
#pragma unroll
            for (int q = 0; q < 8; ++q) r += red[(s * 8 + q) * 64 + c];
            modv[((size_t)l * 3 + s) * NMOD + cb * 64 + c] = r; }
        __syncthreads();
    }
}

__device__ __forceinline__ float hy_delta(int c);
__device__ __forceinline__ int rowmap_gu(int n) { const int up = n >= DFF ? 1 : 0; const int j = n - up * DFF; return (j >> 7) * 256 + up * 128 + (j & 127); }
__device__ __forceinline__ void conv_tile(const float* __restrict__ src, int K, int N, bf16_t* __restrict__ dst, int tk, int tn, bool gu, float* tile) {
    const int tid = otid(); const int k0 = tk * 64, n0 = tn * 64;
#pragma unroll
    for (int rr = 0; rr < 2; ++rr) { const int kk = (tid >> 4) + rr * 32, n4 = (tid & 15) * 4; const float4 v = *(const float4*)(src + (size_t)(k0 + kk) * N + n0 + n4);
        tile[kk * 65 + n4 + 0] = v.x; tile[kk * 65 + n4 + 1] = v.y; tile[kk * 65 + n4 + 2] = v.z; tile[kk * 65 + n4 + 3] = v.w; }
    __syncthreads();
    { const int nn = tid >> 3, ks = (tid & 7) * 8; const int n = n0 + nn; const int row = gu ? rowmap_gu(n) : n;
      u32x4 w; w.x = cvt_pk_bf16(tile[(ks + 0) * 65 + nn], tile[(ks + 1) * 65 + nn]); w.y = cvt_pk_bf16(tile[(ks + 2) * 65 + nn], tile[(ks + 3) * 65 + nn]);
      w.z = cvt_pk_bf16(tile[(ks + 4) * 65 + nn], tile[(ks + 5) * 65 + nn]); w.w = cvt_pk_bf16(tile[(ks + 6) * 65 + nn], tile[(ks + 7) * 65 + nn]);
      *(u32x4*)(dst + (size_t)row * K + k0 + ks) = w; }
    __syncthreads();
}
__device__ __forceinline__ void ph_prep(const Params& P, int l, float* lds) {
    const int tid = otid();
    unsigned char* ws = P.ws;
    constexpr int N0 = 16 * 88, N1 = 44 * 16, N4 = 16 * 54, N5 = 16 * 16;
    constexpr int C0 = N0, C1 = C0 + N1, C2 = C1 + N0, C3 = C2 + N1, C4 = C3 + N4, C5 = C4 + N5;
    for (int it = blockIdx.x; it < C5; it += gridDim.x) {
        if (it < C0) { conv_tile(P.in[I_F1GU] + (size_t)l * D * 2 * DFF, D, 2 * DFF, (bf16_t*)(ws + WS_WGU1), it / 88, it % 88, true, lds); }
        else if (it < C1) { const int j = it - C0; conv_tile(P.in[I_F1DN] + (size_t)l * DFF * D, DFF, D, (bf16_t*)(ws + WS_WDN1), j / 16, j % 16, false, lds); }
        else if (it < C2) { const int j = it - C1; conv_tile(P.in[I_F2GU] + (size_t)l * D * 2 * DFF, D, 2 * DFF, (bf16_t*)(ws + WS_WGU2), j / 88, j % 88, true, lds); }
        else if (it < C3) { const int j = it - C2; conv_tile(P.in[I_F2DN] + (size_t)l * DFF * D, DFF, D, (bf16_t*)(ws + WS_WDN2), j / 16, j % 16, false, lds); }
        else if (it < C4) { const int j = it - C3; conv_tile(P.in[I_WIN] + (size_t)l * D * INW, D, INW, (bf16_t*)(ws + WS_WIN), j / 54, j % 54, false, lds); }
        else { const int j = it - C4; conv_tile(P.in[I_WOUT] + (size_t)l * D * D, D, D, (bf16_t*)(ws + WS_WOUT), j / 16, j % 16, false, lds); }
    }
    const int gtid = blockIdx.x * NTHR + tid, gn = gridDim.x * NTHR;
    { unsigned* z = (unsigned*)(ws + WS_WIN + (size_t)INW * D * 2); for (int i = gtid; i < (INWP - INW) * D / 2; i += gn) z[i] = 0u; }
    { bf16_t* wl = (bf16_t*)(ws + WS_WLORA);
      const float* w2 = P.in[I_W2] + (size_t)l * 2 * 64 * RWW; const float* a2 = P.in[I_A2] + (size_t)l * 2 * 64 * RWW; const float* g2 = P.in[I_G2] + (size_t)l * 128 * RWW;
      for (int i = gtid; i < 2048 * 384; i += gn) { const int k = i / 2048, j = i % 2048; float v = 0.f;
          if (j < 1920) { const int grp = j / 384, c = j % 384;
              if (grp == 0) { if (k < 64) v = w2[(size_t)k * RWW + c]; }
              else if (grp == 1) { if (k >= 64 && k < 128) v = w2[(size_t)(64 + k - 64) * RWW + c]; }
              else if (grp == 2) { if (k >= 128 && k < 192) v = a2[(size_t)(k - 128) * RWW + c]; }
              else if (grp == 3) { if (k >= 192 && k < 256) v = a2[(size_t)(64 + k - 192) * RWW + c]; }
              else { if (k >= 256) v = g2[(size_t)(k - 256) * RWW + c]; } }
          wl[(size_t)j * 384 + k] = f2bf(v); } }
    { const float* w1_ = P.in[I_HW1] + (size_t)l * 33 * 64; const float* b1 = P.in[I_HB1] + l * 64; const float* w2f_ = P.in[I_HW2] + (size_t)l * 64 * 64; const float* b2 = P.in[I_HB2] + l * 64;
      const float* fqv = P.in[I_HFREQ] + l * 64; const float* w3 = P.in[I_HW3] + (size_t)l * 64 * 1024;
      const int lane = tid & 63, wv = tid >> 6;
      const float fq = fqv[lane], bb1 = b1[lane], bb2 = b2[lane];
      const ldsfp hl = vlds(lds);
      for (int task = blockIdx.x; task < 264; task += gridDim.x) {
          const int L = task < 256 ? SEQ : CTX, n0 = task < 256 ? task * 32 : (task - 256) * 32;
          __syncthreads();
#pragma unroll 1
          for (int pp = 0; pp < 4; ++pp) { const int p = wv * 4 + pp, pos = n0 + p;
              const float* w1 = w1_; const float* w2f = w2f_; asm volatile("" : "+s"(w1), "+s"(w2f));
              const float tt = (float)pos / (float)(L - 1);
              const float ang = 6.283185307179586f * (float)pos / (float)L;
              float z = 0.f;
              if (lane == 0) z = tt;
              else if (lane <= 16) { const float fr = 1e-4f + (float)(lane - 1) * ((15.0f - 1e-4f) / 15.0f); z = cosf(fr * ang); }
              else if (lane <= 32) { const float fr = 1e-4f + (float)(lane - 17) * ((15.0f - 1e-4f) / 15.0f); z = -sinf(fr * ang); }
              float a = bb1;
#pragma unroll
              for (int e = 0; e < 33; ++e) a += __shfl(z, e) * w1[e * 64 + lane];
              const float h1 = sinf(fq * a);
              float c = bb2;
#pragma unroll
              for (int i = 0; i < 64; ++i) c += __shfl(h1, i) * w2f[i * 64 + lane];
              hl[lane * 32 + p] = sinf(fq * c); }
          __syncthreads();
          float acc0[32], acc1[32];
#pragma unroll
          for (int p = 0; p < 32; ++p) { acc0[p] = 0.f; acc1[p] = 0.f; }
#pragma unroll 2
          for (int i = 0; i < 64; ++i) { const float wa = w3[(size_t)i * 1024 + tid], wb = w3[(size_t)i * 1024 + 512 + tid];
#pragma unroll
              for (int p4 = 0; p4 < 8; ++p4) { const f32x4 hv = *(const LAS f32x4*)(hl + i * 32 + p4 * 4);
                  acc0[p4 * 4 + 0] += hv.x * wa; acc0[p4 * 4 + 1] += hv.y * wa; acc0[p4 * 4 + 2] += hv.z * wa; acc0[p4 * 4 + 3] += hv.w * wa;
                  acc1[p4 * 4 + 0] += hv.x * wb; acc1[p4 * 4 + 1] += hv.y * wb; acc1[p4 * 4 + 2] += hv.z * wb; acc1[p4 * 4 + 3] += hv.w * wb; } }
          const float dl = hy_delta(tid & 255), sc = task < 256 ? (1.0f / NFFT) : 1.0f, invL = 1.0f / (float)(L - 1);
          bf16_t* dst = task < 256 ? (bf16_t*)(ws + WS_FILT) + (size_t)tid * SEQ + n0 : (bf16_t*)(ws + WS_FILTC) + (size_t)tid * CTX + n0;
          const size_t cstep = task < 256 ? (size_t)512 * SEQ : (size_t)512 * CTX;
#pragma unroll
          for (int p8 = 0; p8 < 4; ++p8) { float d[8];
#pragma unroll
              for (int k = 0; k < 8; ++k) d[k] = __expf(-((float)(n0 + p8 * 8 + k) * invL) * dl) * sc;
              u32x4 w; w.x = cvt_pk_bf16(acc0[p8 * 8 + 0] * d[0], acc0[p8 * 8 + 1] * d[1]); w.y = cvt_pk_bf16(acc0[p8 * 8 + 2] * d[2], acc0[p8 * 8 + 3] * d[3]);
              w.z = cvt_pk_bf16(acc0[p8 * 8 + 4] * d[4], acc0[p8 * 8 + 5] * d[5]); w.w = cvt_pk_bf16(acc0[p8 * 8 + 6] * d[6], acc0[p8 * 8 + 7] * d[7]);
              *(u32x4*)(dst + p8 * 8) = w;
              w.x = cvt_pk_bf16(acc1[p8 * 8 + 0] * d[0], acc1[p8 * 8 + 1] * d[1]); w.y = cvt_pk_bf16(acc1[p8 * 8 + 2] * d[2], acc1[p8 * 8 + 3] * d[3]);
              w.z = cvt_pk_bf16(acc1[p8 * 8 + 4] * d[4], acc1[p8 * 8 + 5] * d[5]); w.w = cvt_pk_bf16(acc1[p8 * 8 + 6] * d[6], acc1[p8 * 8 + 7] * d[7]);
              *(u32x4*)(dst + cstep + p8 * 8) = w; }
      }
      __syncthreads(); }
}

__device__ __forceinline__ void ph_rowpass(const Params& P, int mode, int lpost, int gate_i, int gpost_i, float ps, int lpre, int gpre_i, int shift_i, int scale_i, int nsplit) {
    const int tid = otid(), lane = tid & 63, gw = blockIdx.x * NWAVE + (tid >> 6), nw = gridDim.x * NWAVE;
    const float* modv = (const float*)(P.ws + WS_MODV);
    float* H = (float*)(P.ws + WS_H); const bf16_t* Y = (const bf16_t*)(P.ws + WS_Y); bf16_t* U = (bf16_t*)(P.ws + WS_U);
    int cur_s = -1;
    float4 A[4], Bv[4], Cv[4];
#pragma unroll
    for (int j = 0; j < 4; ++j) { A[j] = make_float4(0.f, 0.f, 0.f, 0.f); Bv[j] = A[j]; Cv[j] = A[j]; }
    for (int row = gw; row < T; row += nw) {
        const int s = row < SEQ ? 0 : (row < TL ? 1 : 2);
        if (s != cur_s) { cur_s = s;
#pragma unroll
            for (int j = 0; j < 4; ++j) { const int e = lane * 4 + 256 * j;
                if (mode != 0) { const float4 g = *(const float4*)(modv + ((size_t)lpost * 3 + s) * NMOD + gate_i * D + e); const float4 gp = *(const float4*)(P.in[I_NORMG] + ((size_t)lpost * 6 + gpost_i) * D + e);
                    A[j] = make_float4(ps * g.x * gp.x, ps * g.y * gp.y, ps * g.z * gp.z, ps * g.w * gp.w); }
                if (mode != 2) { const float4 sc = *(const float4*)(modv + ((size_t)lpre * 3 + s) * NMOD + scale_i * D + e); const float4 gq = *(const float4*)(P.in[I_NORMG] + ((size_t)lpre * 6 + gpre_i) * D + e);
                    Bv[j] = make_float4(gq.x * (1.f + sc.x), gq.y * (1.f + sc.y), gq.z * (1.f + sc.z), gq.w * (1.f + sc.w));
                    Cv[j] = *(const float4*)(modv + ((size_t)lpre * 3 + s) * NMOD + shift_i * D + e); } } }
        float4 h[4];
        if (mode == 0) { const float* src = row < TL ? P.in[I_X] + (size_t)row * D : P.in[I_CTX] + (size_t)(row - TL) * D;
#pragma unroll
            for (int j = 0; j < 4; ++j) h[j] = *(const float4*)(src + lane * 4 + 256 * j);
        } else {
            float4 y[4]; float ss = 0.f;
#pragma unroll
            for (int j = 0; j < 4; ++j) { h[j] = *(const float4*)(H + (size_t)row * D + lane * 4 + 256 * j); if (row < TL) { const u32x2 yw = *(const u32x2*)(Y + (size_t)row * D + lane * 4 + 256 * j); y[j] = make_float4(lo_bf(yw.x), hi_bf(yw.x), lo_bf(yw.y), hi_bf(yw.y)); } else { const float* yp = (const float*)(P.ws + WS_YC) + (size_t)(row - TL) * D + lane * 4 + 256 * j; float4 a = *(const float4*)yp;
                    for (int q = 1; q < nsplit; ++q) { const float4 b4 = *(const float4*)(yp + (size_t)q * TC * D); a.x += b4.x; a.y += b4.y; a.z += b4.z; a.w += b4.w; } y[j] = a; }
                ss += y[j].x * y[j].x + y[j].y * y[j].y + y[j].z * y[j].z + y[j].w * y[j].w; }
            ss = wsum(ss); const float r = rsqrtf(ss * (1.0f / D) + NORM_EPS);
#pragma unroll
            for (int j = 0; j < 4; ++j) { h[j].x += A[j].x * (y[j].x * r); h[j].y += A[j].y * (y[j].y * r); h[j].z += A[j].z * (y[j].z * r); h[j].w += A[j].w * (y[j].w * r); }
        }
        if (mode == 2) { if (row < TL) {
#pragma unroll
                for (int j = 0; j < 4; ++j) *(float4*)(P.out + (size_t)row * D + lane * 4 + 256 * j) = h[j]; }
            continue; }
        float s2 = 0.f;
#pragma unroll
        for (int j = 0; j < 4; ++j) { *(float4*)(H + (size_t)row * D + lane * 4 + 256 * j) = h[j]; s2 += h[j].x * h[j].x + h[j].y * h[j].y + h[j].z * h[j].z + h[j].w * h[j].w; }
        s2 = wsum(s2); const float r2 = rsqrtf(s2 * (1.0f / D) + NORM_EPS);
#pragma unroll
        for (int j = 0; j < 4; ++j) { u32x2 w; w.x = cvt_pk_bf16(h[j].x * r2 * Bv[j].x + Cv[j].x, h[j].y * r2 * Bv[j].y + Cv[j].y); w.y = cvt_pk_bf16(h[j].z * r2 * Bv[j].z + Cv[j].z, h[j].w * r2 * Bv[j].w + Cv[j].w);
            *(u32x2*)(U + (size_t)row * D + lane * 4 + 256 * j) = w; }
    }
}

struct EpiGU {
    static constexpr bool PERM = true, AFTER_DRAIN = false;
    bf16_t* O;
    __device__ __forceinline__ void operator()(const f32x4 (&acc)[2][2][4][2], const pg8::Unit& u, int wr, int wc, int fr, int fq) const {
        const int row0 = u.pm * 256 + wr * 64 + fr, col0 = u.pn * 128 + wc * 32 + 8 * fq;
#pragma unroll
        for (int ai = 0; ai < 2; ++ai)
#pragma unroll
            for (int m = 0; m < 4; ++m) { float o[8];
#pragma unroll
                for (int n = 0; n < 2; ++n)
#pragma unroll
                    for (int j = 0; j < 4; ++j) { const float g = acc[ai][0][m][n][j], up = acc[ai][1][m][n][j]; o[n * 4 + j] = g * __builtin_amdgcn_rcpf(1.0f + __expf(-g)) * up; }
                u32x4 w; w.x = cvt_pk_bf16(o[0], o[1]); w.y = cvt_pk_bf16(o[2], o[3]); w.z = cvt_pk_bf16(o[4], o[5]); w.w = cvt_pk_bf16(o[6], o[7]);
                *(u32x4*)(O + (size_t)(row0 + ai * 128 + m * 16) * DFF + col0) = w; }
    }
};

struct TailOrder {
    int nsplit, kp, G, c;
    __device__ void init(int K, int KP, int G_, int c_) { kp = KP; nsplit = (K / 64) / KP; G = G_; c = c_; }
    __device__ bool next(int i, pg8::Unit& u) const {
        const long L = (long)i * G + c;
        if (L < 256) { int wgid = (int)L; { const int q = 256 / 8, xcd = wgid % 8, off = wgid / 8; wgid = xcd * q + off; }
            const int nig = 8 * 4, gid = wgid / nig, fm = gid * 8; u.pm = fm + ((wgid % nig) % 8); u.pn = (wgid % nig) / 8; u.kt0 = 0; u.nkt = 0; return true; }
        const int L2 = (int)(L - 256); if (L2 >= 8 * nsplit) return false;
        const int tile = L2 / nsplit, ks = L2 % nsplit; u.pm = 64 + (tile >> 2); u.pn = tile & 3; u.kt0 = ks * kp; u.nkt = kp; return true;
    }
    __device__ __forceinline__ void a_ready(const pg8::Unit&) const {}
    __device__ __forceinline__ void done(const pg8::Unit&) const {}
};
struct EpiF32 {
    static constexpr bool PERM = true, AFTER_DRAIN = false;
    bf16_t* C; float* YC;
    __device__ __forceinline__ void operator()(const f32x4 (&acc)[2][2][4][2], const pg8::Unit& u, int wr, int wc, int fr, int fq) const {
        const int row0 = u.pm * 256 + wr * 64 + fr, col0 = u.pn * 256 + wc * 32 + 8 * fq;
        if (u.pm < 64) {
#pragma unroll
            for (int ai = 0; ai < 2; ++ai)
#pragma unroll
                for (int m = 0; m < 4; ++m) { bf16_t* rowp = C + (size_t)(row0 + ai * 128 + m * 16) * D + col0;
#pragma unroll
                    for (int bj = 0; bj < 2; ++bj) { const f32x4 v0 = acc[ai][bj][m][0], v1 = acc[ai][bj][m][1];
                        u32x4 w; w.x = cvt_pk_bf16(v0[0], v0[1]); w.y = cvt_pk_bf16(v0[2], v0[3]); w.z = cvt_pk_bf16(v1[0], v1[1]); w.w = cvt_pk_bf16(v1[2], v1[3]);
                        *(u32x4*)(rowp + bj * 128) = w; } }
        } else { float* base = YC + (size_t)(u.kt0 >> 2) * TC * D;
#pragma unroll
            for (int ai = 0; ai < 2; ++ai)
#pragma unroll
                for (int m = 0; m < 4; ++m) { float* rowp = base + (size_t)(row0 - TL + ai * 128 + m * 16) * D + col0;
#pragma unroll
                    for (int bj = 0; bj < 2; ++bj)
#pragma unroll
                        for (int n = 0; n < 2; ++n) *(f32x4*)(rowp + bj * 128 + n * 4) = acc[ai][bj][m][n]; }
        }
    }
};
template <class Epi> __device__ __forceinline__ void run_gemm_tail(LAS unsigned char* lds, const bf16_t* A, const bf16_t* Bt, int K, const Epi& E) {
    asm volatile("" : "+s"(K));
    pg8::Gemm g{A, Bt, T, D, K}; TailOrder S; S.init(K, 4, (int)gridDim.x, (int)blockIdx.x);
    pg8::gemm_phase<Epi, TailOrder>(lds, g, S, E);
    __syncthreads();
}
__device__ __forceinline__ void zero_yc(const Params& P) { float4* z = (float4*)(P.ws + WS_YC); for (int i = blockIdx.x * NTHR + otid(); i < TC * D / 4; i += gridDim.x * NTHR) z[i] = make_float4(0.f, 0.f, 0.f, 0.f); }
struct EpiWin {
    static constexpr bool PERM = true, AFTER_DRAIN = false;
    bf16_t* PHYT; bf16_t* PRW; bf16_t* PNA;
    __device__ __forceinline__ void operator()(const f32x4 (&acc)[2][2][4][2], const pg8::Unit& u, int wr, int wc, int fr, int fq) const {
        const int row0 = u.pm * 256 + wr * 64 + fr;
        if (u.pn < 3) {
#pragma unroll
            for (int bj = 0; bj < 2; ++bj) { bf16_t* cp = PHYT + (size_t)(u.pn * 256 + bj * 128 + wc * 32 + 8 * fq) * T + row0;
#pragma unroll
                for (int ai = 0; ai < 2; ++ai)
#pragma unroll
                    for (int m = 0; m < 4; ++m) { const f32x4 v0 = acc[ai][bj][m][0], v1 = acc[ai][bj][m][1]; bf16_t* rp = cp + ai * 128 + m * 16;
                        const unsigned w0 = cvt_pk_bf16(v0[0], v0[1]), w1 = cvt_pk_bf16(v0[2], v0[3]), w2 = cvt_pk_bf16(v1[0], v1[1]), w3 = cvt_pk_bf16(v1[2], v1[3]);
                        rp[0] = (bf16_t)w0; rp[(size_t)T] = (bf16_t)(w0 >> 16); rp[(size_t)2 * T] = (bf16_t)w1; rp[(size_t)3 * T] = (bf16_t)(w1 >> 16);
                        rp[(size_t)4 * T] = (bf16_t)w2; rp[(size_t)5 * T] = (bf16_t)(w2 >> 16); rp[(size_t)6 * T] = (bf16_t)w3; rp[(size_t)7 * T] = (bf16_t)(w3 >> 16); } }
            return; }
        bf16_t* base; int ld, cbase;
        if (u.pn < 9) { base = PRW; ld = RW_IN; cbase = u.pn * 256 - HY_IN; }
        else { base = PNA; ld = NA_IN; cbase = u.pn * 256 - HY_IN - RW_IN; }
        const int nbj = (u.pn == 13) ? 1 : 2;
#pragma unroll
        for (int ai = 0; ai < 2; ++ai)
#pragma unroll
            for (int m = 0; m < 4; ++m)
#pragma unroll
                for (int bj = 0; bj < 2; ++bj) { if (bj < nbj) { const f32x4 v0 = acc[ai][bj][m][0], v1 = acc[ai][bj][m][1];
                    u32x4 w; w.x = cvt_pk_bf16(v0[0], v0[1]); w.y = cvt_pk_bf16(v0[2], v0[3]); w.z = cvt_pk_bf16(v1[0], v1[1]); w.w = cvt_pk_bf16(v1[2], v1[3]);
                    *(u32x4*)(base + (size_t)(row0 + ai * 128 + m * 16) * ld + cbase + bj * 128 + wc * 32 + 8 * fq) = w; } }
    }
};
struct EpiLora {
    static constexpr bool PERM = true, AFTER_DRAIN = false;
    bf16_t* LO; bf16_t* GATE;
    __device__ __forceinline__ void operator()(const f32x4 (&acc)[2][2][4][2], const pg8::Unit& u, int wr, int wc, int fr, int fq) const {
        const int row0 = u.pm * 256 + wr * 64 + fr;
        bf16_t* base; int ld, cbase;
        if (u.pn < 6) { base = LO; ld = 1536; cbase = u.pn * 256; } else { base = GATE; ld = 384; cbase = u.pn * 256 - 1536; }
        const int nbj = (u.pn == 7) ? 1 : 2;
#pragma unroll
        for (int ai = 0; ai < 2; ++ai)
#pragma unroll
            for (int m = 0; m < 4; ++m)
#pragma unroll
                for (int bj = 0; bj < 2; ++bj) { if (bj < nbj) { const f32x4 v0 = acc[ai][bj][m][0], v1 = acc[ai][bj][m][1];
                    u32x4 w; w.x = cvt_pk_bf16(v0[0], v0[1]); w.y = cvt_pk_bf16(v0[2], v0[3]); w.z = cvt_pk_bf16(v1[0], v1[1]); w.w = cvt_pk_bf16(v1[2], v1[3]);
                    *(u32x4*)(base + (size_t)(row0 + ai * 128 + m * 16) * ld + cbase + bj * 128 + wc * 32 + 8 * fq) = w; } }
    }
};
template <class Epi> __device__ __forceinline__ void run_gemm(LAS unsigned char* lds, const bf16_t* A, const bf16_t* Bt, int M, int N, int K, const Epi& E) {
    asm volatile("" : "+s"(K));
    pg8::Gemm g{A, Bt, M, N, K}; pg8::StaticOrder S; S.init(M, N, (int)gridDim.x, (int)blockIdx.x);
    pg8::gemm_phase<Epi, pg8::StaticOrder>(lds, g, S, E);
    __syncthreads();
}

__device__ __forceinline__ void ph_loraprep(const Params& P, int l) {
    const bf16_t* PRW = (const bf16_t*)(P.ws + WS_PRW); bf16_t* AL = (bf16_t*)(P.ws + WS_ALORA);
    const float* mu = P.in[I_MU] + (size_t)l * 2 * RW_IN;
    const int gtid = blockIdx.x * NTHR + otid(), gn = gridDim.x * NTHR;
    for (int it = gtid; it < T * 48; it += gn) {
        const int row = it / 48, j8 = it % 48, col = 1152 + j8 * 8;
        bool hp, hn; row_nbrs(row, hp, hn);
        float p[8], pp[8], pn[8];
        unpack8(*(const u32x4*)(PRW + (size_t)row * RW_IN + col), p);
        if (hp) unpack8(*(const u32x4*)(PRW + (size_t)(row - 1) * RW_IN + col), pp); else {
#pragma unroll
            for (int i = 0; i < 8; ++i) pp[i] = 0.f; }
        if (hn) unpack8(*(const u32x4*)(PRW + (size_t)(row + 1) * RW_IN + col), pn); else {
#pragma unroll
            for (int i = 0; i < 8; ++i) pn[i] = 0.f; }
        float o[8];
#pragma unroll
        for (int i = 0; i < 8; ++i) { const float xs = p[i] + mu[col + i] * (pp[i] - p[i]) + mu[RW_IN + col + i] * (pn[i] - p[i]);
            o[i] = j8 < 16 ? tanhf(xs) : (j8 < 32 ? xs : sigmoidf_(xs)); }
        u32x4 w; w.x = cvt_pk_bf16(o[0], o[1]); w.y = cvt_pk_bf16(o[2], o[3]); w.z = cvt_pk_bf16(o[4], o[5]); w.w = cvt_pk_bf16(o[6], o[7]);
        *(u32x4*)(AL + (size_t)row * 384 + j8 * 8) = w;
    }
}

__device__ __forceinline__ void ph_rwkvprep(const Params& P, int l) {
    const int tid = otid(), lane = tid & 63, gw = blockIdx.x * NWAVE + (tid >> 6), nw = gridDim.x * NWAVE;
    const int nrw = nw / 6, h = gw % 6, rw0 = gw / 6;
    if (rw0 >= nrw) return;
    const bf16_t* PRW = (const bf16_t*)(P.ws + WS_PRW); const bf16_t* LO = (const bf16_t*)(P.ws + WS_LORAO);
    bf16_t* RS = (bf16_t*)(P.ws + WS_RS); bf16_t* KKS = (bf16_t*)(P.ws + WS_KKS); bf16_t* VS = (bf16_t*)(P.ws + WS_VS); bf16_t* KS = (bf16_t*)(P.ws + WS_KS); bf16_t* BS = (bf16_t*)(P.ws + WS_BS);
    float* BON = (float*)(P.ws + WS_BONUS); float* DEC = (float*)(P.ws + WS_DECAY);
    const float2* RT = (const float2*)(P.ws + WS_ROPE);
    const float* mu = P.in[I_MU] + (size_t)l * 2 * RW_IN;
    const int c = h * 64 + lane, f = lane & 15;
    const float mp0 = mu[c], mn0 = mu[RW_IN + c], mp1 = mu[384 + c], mn1 = mu[RW_IN + 384 + c], mp2 = mu[768 + c], mn2 = mu[RW_IN + 768 + c];
    const float ckk = P.in[I_KK][l * RWW + c], cka = P.in[I_KA][l * RWW + c], crk = P.in[I_RK][l * RWW + c];
    const float ca0 = P.in[I_A0][(size_t)l * 2 * RWW + c], ca1 = P.in[I_A0][(size_t)l * 2 * RWW + RWW + c], cw0 = P.in[I_W0][(size_t)l * 2 * RWW + c], cw1 = P.in[I_W0][(size_t)l * 2 * RWW + RWW + c];
    const float sg = (lane & 16) ? 1.f : -1.f;
#pragma unroll 2
    for (int row = rw0; row < T; row += nrw) {
        bool hp, hn; row_nbrs(row, hp, hn);
        const bf16_t* pr = PRW + (size_t)row * RW_IN + c; const int om = hp ? -RW_IN : 0, op = hn ? RW_IN : 0; const float fm = hp ? 1.f : 0.f, fp = hn ? 1.f : 0.f;
        const float r0 = bf2f(pr[0]), k0 = bf2f(pr[384]), v0 = bf2f(pr[768]);
        const float r = r0 + mp0 * (fm * bf2f(pr[om]) - r0) + mn0 * (fp * bf2f(pr[op]) - r0);
        const float k = k0 + mp1 * (fm * bf2f(pr[384 + om]) - k0) + mn1 * (fp * bf2f(pr[384 + op]) - k0);
        const float v = v0 + mp2 * (fm * bf2f(pr[768 + om]) - v0) + mn2 * (fp * bf2f(pr[768 + op]) - v0);
        const bf16_t* lo = LO + (size_t)row * 1536 + c;
        const float a0 = sigmoidf_(bf2f(lo[768]) + ca0), a1 = sigmoidf_(bf2f(lo[1152]) + ca1);
        const float x0 = bf2f(lo[0]) + cw0, x1 = bf2f(lo[384]) + cw1;
        const float kkr = k * ckk;
        const float nrm = sqrtf(wsum(kkr * kkr));
        const float kk = kkr / fmaxf(nrm, 1e-12f);
        float kd0 = k * (1.f + (a0 - 1.f) * cka), kd1 = k * (1.f + (a1 - 1.f) * cka);
        float b0 = kk * a0, b1 = kk * a1;
        const float bon = wsum(r * (kd0 + kd1) * crk);
        float rs = r, kks = kk;
        if (row < TL) {
            const int t = row & (SEQ - 1); const int pos = (lane < 32) ? (t >> 6) : (t & 63);
            const float2 csn = RT[pos * 16 + f]; const float cs = csn.x, sn = csn.y;
            const float r2 = __shfl_xor(rs, 16), k2 = __shfl_xor(kks, 16), d0 = __shfl_xor(kd0, 16), d1 = __shfl_xor(kd1, 16), e0 = __shfl_xor(b0, 16), e1 = __shfl_xor(b1, 16);
            rs = rs * cs + sg * r2 * sn; kks = kks * cs + sg * k2 * sn; kd0 = kd0 * cs + sg * d0 * sn; kd1 = kd1 * cs + sg * d1 * sn; b0 = b0 * cs + sg * e0 * sn; b1 = b1 * cs + sg * e1 * sn;
        }
        const size_t o = (size_t)row * 384 + c;
        DEC[o] = __expf(-0.6065306597f * sigmoidf_(x0)); DEC[(size_t)T * 384 + o] = __expf(-0.6065306597f * sigmoidf_(x1));
        if (lane == 0) BON[(size_t)row * 6 + h] = bon;
        RS[o] = f2bf(rs); KKS[o] = f2bf(-kks); VS[o] = f2bf(v);
        KS[o] = f2bf(kd0); KS[(size_t)T * 384 + o] = f2bf(kd1); BS[o] = f2bf(b0); BS[(size_t)T * 384 + o] = f2bf(b1);
    }
}

__device__ __forceinline__ int scan_row(int b, int d, int step) {
    if (step < CTX) { const int tc = d ? (CTX - 1 - step) : step; return TL + b * CTX + tc; }
    const int tl = d ? (SEQ - 1 - (step - CTX)) : (step - CTX); return b * SEQ + tl;
}
__device__ __forceinline__ void scan_task_v1(const Params& P, int task, float* sv) {
    const int lane = otid() & 63;
    const int d = task & 1, h = (task >> 1) % 6, b = task / 12;
    const float* DEC = (const float*)(P.ws + WS_DECAY) + (size_t)d * T * 384; const bf16_t* KKS = (const bf16_t*)(P.ws + WS_KKS); const bf16_t* RS = (const bf16_t*)(P.ws + WS_RS);
    const bf16_t* VS = (const bf16_t*)(P.ws + WS_VS); const bf16_t* KS = (const bf16_t*)(P.ws + WS_KS) + (size_t)d * T * 384; const bf16_t* BS = (const bf16_t*)(P.ws + WS_BS) + (size_t)d * T * 384;
    float* YD = (float*)(P.ws + WS_YDIR) + (size_t)d * T * 384;
    float S[64];
#pragma unroll
    for (int j = 0; j < 64; ++j) S[j] = 0.f;
    size_t o = (size_t)scan_row(b, d, 0) * 384 + h * 64 + lane;
    float nw_ = DEC[o], na = bf2f(KKS[o]), nb = bf2f(BS[o]), nk = bf2f(KS[o]), nr = bf2f(RS[o]), nv = bf2f(VS[o]);
    for (int step = 0; step < CTX + SEQ; ++step) {
        const float v = nv; const size_t oc = o;
        asm volatile("s_waitcnt lgkmcnt(0)" ::: "memory");
        sv[lane] = nw_; sv[64 + lane] = na; sv[128 + lane] = nb; sv[192 + lane] = nk; sv[256 + lane] = nr;
        asm volatile("s_waitcnt lgkmcnt(0)" ::: "memory");
        if (step + 1 < CTX + SEQ) { o = (size_t)scan_row(b, d, step + 1) * 384 + h * 64 + lane;
            nw_ = DEC[o]; na = bf2f(KKS[o]); nb = bf2f(BS[o]); nk = bf2f(KS[o]); nr = bf2f(RS[o]); nv = bf2f(VS[o]); }
        float sa0 = 0.f, sa1 = 0.f, sa2 = 0.f, sa3 = 0.f;
#pragma unroll
        for (int j = 0; j < 64; j += 4) { const float4 a4 = *(const float4*)(sv + 64 + j);
            sa0 += S[j + 0] * a4.x; sa1 += S[j + 1] * a4.y; sa2 += S[j + 2] * a4.z; sa3 += S[j + 3] * a4.w; }
        const float sa = (sa0 + sa1) + (sa2 + sa3);
        float y0 = 0.f, y1 = 0.f, y2 = 0.f, y3 = 0.f;
#pragma unroll
        for (int j = 0; j < 64; j += 4) {
            const float4 w4 = *(const float4*)(sv + j), b4 = *(const float4*)(sv + 128 + j), k4 = *(const float4*)(sv + 192 + j), r4 = *(const float4*)(sv + 256 + j);
            S[j + 0] = S[j + 0] * w4.x + sa * b4.x + v * k4.x; y0 += S[j + 0] * r4.x;
            S[j + 1] = S[j + 1] * w4.y + sa * b4.y + v * k4.y; y1 += S[j + 1] * r4.y;
            S[j + 2] = S[j + 2] * w4.z + sa * b4.z + v * k4.z; y2 += S[j + 2] * r4.z;
            S[j + 3] = S[j + 3] * w4.w + sa * b4.w + v * k4.w; y3 += S[j + 3] * r4.w; }
        YD[oc] = (y0 + y1) + (y2 + y3);
    }
}

__device__ __forceinline__ void natt_key(const bf16_t* PNA, size_t krow, int hoff, const float (&q)[16], float bias, float& m, float& lsum, float (&o)[16]) {
    const bf16_t* kp = PNA + krow * NA_IN + 384 + hoff; const bf16_t* vp = PNA + krow * NA_IN + 768 + hoff;
    float s = 0.f;
#pragma unroll
    for (int j8 = 0; j8 < 2; ++j8) { float kf[8]; unpack8(*(const u32x4*)(kp + j8 * 8), kf);
#pragma unroll
        for (int i = 0; i < 8; ++i) s += q[j8 * 8 + i] * kf[i]; }
    s += __shfl_xor(s, 1); s += __shfl_xor(s, 2); s += bias;
    const float mn = fmaxf(m, s), corr = __expf(m - mn), p = __expf(s - mn);
    m = mn; lsum = lsum * corr + p;
#pragma unroll
    for (int j8 = 0; j8 < 2; ++j8) { float vf[8]; unpack8(*(const u32x4*)(vp + j8 * 8), vf);
#pragma unroll
        for (int i = 0; i < 8; ++i) o[j8 * 8 + i] = o[j8 * 8 + i] * corr + p * vf[i]; }
}
__device__ __forceinline__ void natten_items_v1(const Params& P, int l, int wid0, int nworkers) {
    const bf16_t* PNA = (const bf16_t*)(P.ws + WS_PNA); bf16_t* MIX = (bf16_t*)(P.ws + WS_U);
    const float* rpb = P.in[I_RPB] + (size_t)l * 6 * 15 * 31;
    const int sub = wid0 & 3;
    for (int it = wid0 >> 2; it < T * 6; it += nworkers >> 2) {
        const int row = it % T, h = it / T, hoff = h * 64 + sub * 16;
        float q[16], o[16];
#pragma unroll
        for (int j8 = 0; j8 < 2; ++j8) { float qf[8]; unpack8(*(const u32x4*)(PNA + (size_t)row * NA_IN + hoff + j8 * 8), qf);
#pragma unroll
            for (int i = 0; i < 8; ++i) { q[j8 * 8 + i] = qf[i] * 0.125f; o[j8 * 8 + i] = 0.f; } }
        float m = -3.0e38f, lsum = 0.f;
        int b;
        if (row < TL) { b = row >> 13; const int t = row & (SEQ - 1), i = t >> 6, col = t & 63;
            const int start = min(max(i - 4, 0), 120), win0 = min(max(col - 8, 0), 48);
            for (int r = 0; r < 8; ++r) for (int kc = win0; kc < win0 + 16; ++kc) {
                const float bias = rpb[(h * 15 + (start + r - i + 7)) * 31 + (kc - col + 15)];
                natt_key(PNA, (size_t)b * SEQ + (start + r) * 64 + kc, hoff, q, bias, m, lsum, o); }
        } else b = (row - TL) >> 8;
        for (int c = 0; c < CTX; ++c) natt_key(PNA, (size_t)TL + b * CTX + c, hoff, q, 0.f, m, lsum, o);
        const float il = 1.0f / lsum;
#pragma unroll
        for (int j8 = 0; j8 < 2; ++j8) { u32x4 w; w.x = cvt_pk_bf16(o[j8 * 8 + 0] * il, o[j8 * 8 + 1] * il); w.y = cvt_pk_bf16(o[j8 * 8 + 2] * il, o[j8 * 8 + 3] * il);
            w.z = cvt_pk_bf16(o[j8 * 8 + 4] * il, o[j8 * 8 + 5] * il); w.w = cvt_pk_bf16(o[j8 * 8 + 6] * il, o[j8 * 8 + 7] * il);
            *(u32x4*)(MIX + (size_t)row * D + 640 + hoff + j8 * 8) = w; }
    }
}

__device__ __forceinline__ void vt_tile(const Params& P, int tile, unsigned short* tl  ) {
    const int tid = otid();
    const bf16_t* PNA = (const bf16_t*)(P.ws + WS_PNA);
    int h, tok0; bf16_t* dst; int ldt;
    if (tile < NB * 128 * 6) { h = tile % 6; const int sb = tile / 6; const int b = sb >> 7, blk = sb & 127; tok0 = b * SEQ + blk * 64; dst = (bf16_t*)(P.ws + WS_VTL) + ((size_t)(b * 6 + h) * 64) * SEQ + blk * 64; ldt = SEQ; }
    else { const int tt = tile - NB * 128 * 6; h = tt % 6; const int sb = tt / 6; const int b = sb >> 2, blk = sb & 3; tok0 = TL + b * CTX + blk * 64; dst = (bf16_t*)(P.ws + WS_VTC) + ((size_t)(b * 6 + h) * 64) * CTX + blk * 64; ldt = CTX; }
    { const int tok = tid >> 3, seg = tid & 7; const u32x4 v = *(const u32x4*)(PNA + (size_t)(tok0 + tok) * NA_IN + 768 + h * 64 + seg * 8);
      unsigned* w = (unsigned*)(tl + tok * 72 + seg * 8); w[0] = v.x; w[1] = v.y; w[2] = v.z; w[3] = v.w; }
    __syncthreads();
    { const int hd = tid >> 3, ts = tid & 7; unsigned short e[8];
#pragma unroll
      for (int k = 0; k < 8; ++k) e[k] = tl[(ts * 8 + k) * 72 + hd];
      u32x4 w; w.x = (unsigned)e[0] | ((unsigned)e[1] << 16); w.y = (unsigned)e[2] | ((unsigned)e[3] << 16); w.z = (unsigned)e[4] | ((unsigned)e[5] << 16); w.w = (unsigned)e[6] | ((unsigned)e[7] << 16);
      *(u32x4*)(dst + (size_t)hd * ldt + ts * 8) = w; }
    __syncthreads();
}
constexpr int NAT_LAT_TASKS = NB * 128 * 4 * 6, NAT_CTX_TASKS = NB * 16 * 6, NAT_TASKS = NAT_LAT_TASKS + NAT_CTX_TASKS;
__device__ __forceinline__ void natten_task(const Params& P, int l, int task) {
    using pg8::bf16x8;
    const int lane = otid() & 63, fr = lane & 15, fq = lane >> 4;
    const bf16_t* PNA = (const bf16_t*)(P.ws + WS_PNA); bf16_t* MIX = (bf16_t*)(P.ws + WS_U);
    const bool lat = task < NAT_LAT_TASKS;
    int b, h, i = 0, n = 0, qtok0;
    if (lat) { h = task % 6; const int r = task / 6; n = r & 3; i = (r >> 2) & 127; b = r >> 9; qtok0 = b * SEQ + i * 64 + 16 * n; }
    else { const int tt = task - NAT_LAT_TASKS; h = tt % 6; const int qb = (tt / 6) & 15; b = tt / 96; qtok0 = TL + b * CTX + 16 * qb; }
    const int start = min(max(i - 4, 0), 120), band0 = min(max(16 * n - 8, 0), 32);
    const int col = 16 * n + fr, win0 = min(max(col - 8, 0), 48);
    bf16x8 bq[2];
#pragma unroll
    for (int kh = 0; kh < 2; ++kh) bq[kh] = *(const bf16x8*)(PNA + (size_t)(qtok0 + fr) * NA_IN + h * 64 + kh * 32 + fq * 8);
    f32x4 sc[32];
    if (lat) {
#pragma unroll
        for (int t = 0; t < 16; ++t) { const int tok0 = b * SEQ + (start + (t >> 1)) * 64 + band0 + 16 * (t & 1);
            const bf16_t* kp = PNA + (size_t)(tok0 + fr) * NA_IN + 384 + h * 64 + fq * 8;
            const bf16x8 k0 = *(const bf16x8*)kp, k1 = *(const bf16x8*)(kp + 32);
            f32x4 a = (f32x4){0.f, 0.f, 0.f, 0.f};
            a = __builtin_amdgcn_mfma_f32_16x16x32_bf16(k0, bq[0], a, 0, 0, 0); a = __builtin_amdgcn_mfma_f32_16x16x32_bf16(k1, bq[1], a, 0, 0, 0);
            sc[t] = a; if ((t & 3) == 3) asm volatile("" ::: "memory"); }
    } else {
#pragma unroll
        for (int t = 0; t < 16; ++t) sc[t] = (f32x4){-3.0e38f, -3.0e38f, -3.0e38f, -3.0e38f};
    }
#pragma unroll
    for (int t = 16; t < 32; ++t) { const int tok0 = TL + b * CTX + 16 * (t - 16);
        const bf16_t* kp = PNA + (size_t)(tok0 + fr) * NA_IN + 384 + h * 64 + fq * 8;
        const bf16x8 k0 = *(const bf16x8*)kp, k1 = *(const bf16x8*)(kp + 32);
        f32x4 a = (f32x4){0.f, 0.f, 0.f, 0.f};
        a = __builtin_amdgcn_mfma_f32_16x16x32_bf16(k0, bq[0], a, 0, 0, 0); a = __builtin_amdgcn_mfma_f32_16x16x32_bf16(k1, bq[1], a, 0, 0, 0);
        sc[t] = a * 0.125f; if ((t & 3) == 3) asm volatile("" ::: "memory"); }
    if (lat) { const float* rpb = P.in[I_RPB] + ((size_t)l * 6 + h) * 15 * 31;
#pragma unroll
        for (int t = 0; t < 16; ++t) { const int ro = start + (t >> 1) - i + 7; const int kc0 = band0 + 16 * (t & 1) + fq * 4;
#pragma unroll
            for (int j = 0; j < 4; ++j) { const int kc = kc0 + j; const bool ok = kc >= win0 && kc < win0 + 16; const int co = min(max(kc - col + 15, 0), 30);
                const float bias = rpb[ro * 31 + co]; sc[t][j] = ok ? sc[t][j] * 0.125f + bias : -3.0e38f; } } }
    float mx = -3.0e38f;
#pragma unroll
    for (int t = 0; t < 32; ++t) mx = fmaxf(mx, fmaxf(fmaxf(sc[t][0], sc[t][1]), fmaxf(sc[t][2], sc[t][3])));
    mx = fmaxf(mx, __shfl_xor(mx, 16)); mx = fmaxf(mx, __shfl_xor(mx, 32));
    float sum = 0.f;
#pragma unroll
    for (int t = 0; t < 32; ++t) {
#pragma unroll
        for (int j = 0; j < 4; ++j) { const float p = __expf(sc[t][j] - mx); sc[t][j] = p; sum += p; } }
    sum += __shfl_xor(sum, 16); sum += __shfl_xor(sum, 32);
    const float inv = 1.0f / sum;
    f32x4 ot[4];
#pragma unroll
    for (int q = 0; q < 4; ++q) ot[q] = (f32x4){0.f, 0.f, 0.f, 0.f};
    const bf16_t* VTL = (const bf16_t*)(P.ws + WS_VTL) + ((size_t)(b * 6 + h) * 64) * SEQ; const bf16_t* VTC = (const bf16_t*)(P.ws + WS_VTC) + ((size_t)(b * 6 + h) * 64) * CTX;
    if (lat) {
#pragma unroll
        for (int m = 0; m < 8; ++m) { const int tk = (start + m) * 64 + band0 + fq * 4;
            u32x4 pw; pw.x = cvt_pk_bf16(sc[2 * m][0], sc[2 * m][1]); pw.y = cvt_pk_bf16(sc[2 * m][2], sc[2 * m][3]); pw.z = cvt_pk_bf16(sc[2 * m + 1][0], sc[2 * m + 1][1]); pw.w = cvt_pk_bf16(sc[2 * m + 1][2], sc[2 * m + 1][3]);
            const bf16x8 pb = __builtin_bit_cast(bf16x8, pw);
#pragma unroll
            for (int q = 0; q < 4; ++q) { const bf16_t* vp = VTL + (size_t)(q * 16 + fr) * SEQ + tk; const u32x2 v0 = *(const u32x2*)vp, v1 = *(const u32x2*)(vp + 16);
                u32x4 vw; vw.x = v0.x; vw.y = v0.y; vw.z = v1.x; vw.w = v1.y;
                ot[q] = __builtin_amdgcn_mfma_f32_16x16x32_bf16(__builtin_bit_cast(bf16x8, vw), pb, ot[q], 0, 0, 0); }
            if (m & 1) asm volatile("" ::: "memory"); }
    }
#pragma unroll
    for (int m = 0; m < 8; ++m) { const int tk = 32 * m + fq * 4;
        u32x4 pw; pw.x = cvt_pk_bf16(sc[16 + 2 * m][0], sc[16 + 2 * m][1]); pw.y = cvt_pk_bf16(sc[16 + 2 * m][2], sc[16 + 2 * m][3]); pw.z = cvt_pk_bf16(sc[17 + 2 * m][0], sc[17 + 2 * m][1]); pw.w = cvt_pk_bf16(sc[17 + 2 * m][2], sc[17 + 2 * m][3]);
        const bf16x8 pb = __builtin_bit_cast(bf16x8, pw);
#pragma unroll
        for (int q = 0; q < 4; ++q) { const bf16_t* vp = VTC + (size_t)(q * 16 + fr) * CTX + tk; const u32x2 v0 = *(const u32x2*)vp, v1 = *(const u32x2*)(vp + 16);
            u32x4 vw; vw.x = v0.x; vw.y = v0.y; vw.z = v1.x; vw.w = v1.y;
            ot[q] = __builtin_amdgcn_mfma_f32_16x16x32_bf16(__builtin_bit_cast(bf16x8, vw), pb, ot[q], 0, 0, 0); }
        if (m & 1) asm volatile("" ::: "memory"); }
#pragma unroll
    for (int q = 0; q < 4; ++q) { u32x2 w; w.x = cvt_pk_bf16(ot[q][0] * inv, ot[q][1] * inv); w.y = cvt_pk_bf16(ot[q][2] * inv, ot[q][3] * inv);
        *(u32x2*)(MIX + (size_t)(qtok0 + fr) * D + 640 + h * 64 + q * 16 + fq * 4) = w; }
}

__device__ __forceinline__ void fft_fwd(float2* X) {
#pragma unroll 1
    for (int lq = 12; lq >= 0; lq -= 2) { const int q = 1 << lq; const float rq = 1.0f / (float)(4 * q);
        for (int j = otid(); j < NFFT / 4; j += NTHR) { const int lo = j & (q - 1), base = ((j >> lq) << (lq + 2)) | lo;
            const float2 x0 = X[base], x1 = X[base + q], x2 = X[base + 2 * q], x3 = X[base + 3 * q];
            const float fr = (float)lo * rq; const float c = __builtin_amdgcn_cosf(fr), s = __builtin_amdgcn_sinf(fr), c2 = c * c - s * s, s2 = 2.f * c * s;
            const float a0x = x0.x + x2.x, a0y = x0.y + x2.y, dx = x0.x - x2.x, dy = x0.y - x2.y;
            const float a2x = dx * c + dy * s, a2y = dy * c - dx * s;
            const float a1x = x1.x + x3.x, a1y = x1.y + x3.y, ex = x1.x - x3.x, ey = x1.y - x3.y;
            const float mx = ex * c + ey * s, my = ey * c - ex * s;
            const float a3x = my, a3y = -mx;
            const float fx = a0x - a1x, fy = a0y - a1y, gx = a2x - a3x, gy = a2y - a3y;
            X[base] = make_float2(a0x + a1x, a0y + a1y); X[base + q] = make_float2(fx * c2 + fy * s2, fy * c2 - fx * s2);
            X[base + 2 * q] = make_float2(a2x + a3x, a2y + a3y); X[base + 3 * q] = make_float2(gx * c2 + gy * s2, gy * c2 - gx * s2); }
        __syncthreads(); }
}
__device__ __forceinline__ void fft_inv(float2* X) {
#pragma unroll 1
    for (int lq = 0; lq <= 12; lq += 2) { const int q = 1 << lq; const float rq = 1.0f / (float)(4 * q);
        for (int j = otid(); j < NFFT / 4; j += NTHR) { const int lo = j & (q - 1), base = ((j >> lq) << (lq + 2)) | lo;
            const float2 y0 = X[base], y1 = X[base + q], y2 = X[base + 2 * q], y3 = X[base + 3 * q];
            const float fr = (float)lo * rq; const float c = __builtin_amdgcn_cosf(fr), s = __builtin_amdgcn_sinf(fr), c2 = c * c - s * s, s2 = 2.f * c * s;
            const float tx = y1.x * c2 - y1.y * s2, ty = y1.x * s2 + y1.y * c2;
            const float a0x = y0.x + tx, a0y = y0.y + ty, a1x = y0.x - tx, a1y = y0.y - ty;
            const float ux = y3.x * c2 - y3.y * s2, uy = y3.x * s2 + y3.y * c2;
            const float a2x = y2.x + ux, a2y = y2.y + uy, a3x = y2.x - ux, a3y = y2.y - uy;
            const float vx = a2x * c - a2y * s, vy = a2x * s + a2y * c;
            const float mx = a3x * c - a3y * s, my = a3x * s + a3y * c;
            const float wx = -my, wy = mx;
            X[base] = make_float2(a0x + vx, a0y + vy); X[base + 2 * q] = make_float2(a0x - vx, a0y - vy);
            X[base + q] = make_float2(a1x + wx, a1y + wy); X[base + 3 * q] = make_float2(a1x - wx, a1y - wy); }
        __syncthreads(); }
}
__device__ __forceinline__ float hy_delta(int c) { const float lo = -4.605170185988091f / 1.5f, hi = -4.605170185988091f / 0.3f; return fabsf(lo + (float)c * ((hi - lo) / 255.0f)); }
__device__ __forceinline__ float hy_short(const bf16_t* PHYT, const float* cw, const float* cb, int row, int col) {
    bool hp, hn; row_nbrs(row, hp, hn);
    const bf16_t* p = PHYT + (size_t)col * T + row;
    float v = cb[col] + cw[HY_IN + col] * bf2f(p[0]);
    if (hp) v += cw[col] * bf2f(p[-1]);
    if (hn) v += cw[2 * HY_IN + col] * bf2f(p[1]);
    return v;
}
struct HyTap { float w0, w1, w2, b; };
__device__ __forceinline__ HyTap hy_tap(const float* cw, const float* cb, int col) { HyTap t; t.w0 = cw[col]; t.w1 = cw[HY_IN + col]; t.w2 = cw[2 * HY_IN + col]; t.b = cb[col]; return t; }
__device__ __forceinline__ float hy_lat(const bf16_t* colp, int b, int n, const HyTap t) {
    const bf16_t* p = colp + b * SEQ + n;
    const float xm = bf2f(p[n > 0 ? -1 : 0]), x0 = bf2f(p[0]), xp = bf2f(p[n < SEQ - 1 ? 1 : 0]);
    return t.b + t.w1 * x0 + (n > 0 ? t.w0 * xm : 0.f) + (n < SEQ - 1 ? t.w2 * xp : 0.f);
}
__device__ __forceinline__ void hy_spec_task(const Params& P, int l, int c, float2* X) {
    const int tid = otid();
    const bf16_t* f0 = (const bf16_t*)(P.ws + WS_FILT) + (size_t)c * SEQ; const bf16_t* b0 = f0 + (size_t)256 * SEQ; const bf16_t* f1 = f0 + (size_t)512 * SEQ; const bf16_t* b1 = f0 + (size_t)768 * SEQ;
    for (int n = tid; n < SEQ; n += NTHR) {
        X[n] = make_float2(bf2f(f0[n]), bf2f(f1[n]));
        if (n > 0) X[NFFT - n] = make_float2(bf2f(b0[n]), bf2f(b1[n])); else X[SEQ] = make_float2(0.f, 0.f); }
    __syncthreads();
    fft_fwd(X);
    float2* spec = (float2*)(P.ws + WS_SPEC) + (size_t)c * NFFT;
    for (int i = tid; i < NFFT; i += NTHR) spec[i] = X[i];
    __syncthreads();
}
__device__ __forceinline__ void hy_conv_core(const Params& P, int o, int c, float2* X) {
    fft_fwd(X);
    const float2* spec = (const float2*)(P.ws + WS_SPEC) + (size_t)c * NFFT;
    for (int i = otid(); i < NFFT; i += NTHR) {
        const unsigned f = __brev((unsigned)i) >> 18;
        const unsigned ip = __brev(((unsigned)NFFT - f) & (unsigned)(NFFT - 1)) >> 18;
        const float2 a = X[i], w = spec[i], w2 = spec[ip];
        const float kx = o == 0 ? 0.5f * (w.x + w2.x) : 0.5f * (w.y + w2.y), ky = o == 0 ? 0.5f * (w.y - w2.y) : -0.5f * (w.x - w2.x);
        X[i] = make_float2(a.x * kx - a.y * ky, a.x * ky + a.y * kx); }
    __syncthreads();
    fft_inv(X);
}
__device__ __forceinline__ void hy_task1(const Params& P, int l, int c, float2* X, float* ex) {
    const int tid = otid();
    const bf16_t* PHY = (const bf16_t*)(P.ws + WS_PHY); const float* cw = P.in[I_HCW] + (size_t)l * 3 * HY_IN; const float* cb = P.in[I_HCB] + (size_t)l * HY_IN;
    const float bias0 = P.in[I_HBIAS][(size_t)l * 2 * HYC + c], bias1 = P.in[I_HBIAS][(size_t)l * 2 * HYC + HYC + c];
    const HyTap tv = hy_tap(cw, cb, c), tg1 = hy_tap(cw, cb, HYC + c); const bf16_t* colv = PHY + (size_t)c * T; const bf16_t* colg1 = PHY + (size_t)(HYC + c) * T;
#pragma unroll 4
    for (int n = tid; n < SEQ; n += NTHR) { X[n] = make_float2(hy_lat(colv, 0, n, tv), hy_lat(colv, 1, n, tv)); X[SEQ + n] = make_float2(0.f, 0.f); }
    __syncthreads();
    hy_conv_core(P, 0, c, X);
    float* Z1 = (float*)(P.ws + WS_Z1) + (size_t)c * NB * SEQ;
#pragma unroll 4
    for (int n = tid; n < SEQ; n += NTHR) { const float2 y = X[n];
        const float v0 = hy_lat(colv, 0, n, tv), v1 = hy_lat(colv, 1, n, tv), g0 = hy_lat(colg1, 0, n, tg1), g1 = hy_lat(colg1, 1, n, tg1);
        Z1[n] = g0 * (y.x + bias0 * v0); Z1[SEQ + n] = g1 * (y.y + bias0 * v1); }
    __syncthreads();
    float* f = (float*)X;
    float* vv = f, *x1 = f + 512, *x2 = f + 1024, *hf = f + 1536  , *z1 = f + 2560;
    const bf16_t* fc = (const bf16_t*)(P.ws + WS_FILTC);
    { const int b = tid >> 8, t = tid & 255, row = TL + b * CTX + t;
      vv[tid] = hy_short(PHY, cw, cb, row, c); x1[tid] = hy_short(PHY, cw, cb, row, HYC + c); x2[tid] = hy_short(PHY, cw, cb, row, 2 * HYC + c);
      for (int q = tid; q < 1024; q += NTHR) { const int od = q >> 8, n = q & 255; hf[q] = bf2f(fc[(size_t)(od * 256 + c) * CTX + n]); } }
    __syncthreads();
    { const int b = tid >> 8, t = tid & 255; float y = bias0 * vv[tid];
      for (int s = 0; s <= t; ++s) y += hf[t - s] * vv[b * 256 + s];
      for (int s = t + 1; s < CTX; ++s) y += hf[256 + s - t] * vv[b * 256 + s];
      z1[tid] = x1[tid] * y; }
    __syncthreads();
    { const int b = tid >> 8, t = tid & 255; float y = bias1 * z1[tid];
      for (int s = 0; s <= t; ++s) y += hf[512 + t - s] * z1[b * 256 + s];
      for (int s = t + 1; s < CTX; ++s) y += hf[768 + s - t] * z1[b * 256 + s];
      bf16_t* MIX = (bf16_t*)(P.ws + WS_U); MIX[(size_t)(TL + b * CTX + t) * D + c] = f2bf(x2[tid] * y); }
    __syncthreads();
}
__device__ __forceinline__ void hy_task2(const Params& P, int l, int c, float2* X) {
    const int tid = otid();
    const bf16_t* PHY = (const bf16_t*)(P.ws + WS_PHY); const float* cw = P.in[I_HCW] + (size_t)l * 3 * HY_IN; const float* cb = P.in[I_HCB] + (size_t)l * HY_IN;
    const float bias1 = P.in[I_HBIAS][(size_t)l * 2 * HYC + HYC + c];
    const float* Z1 = (const float*)(P.ws + WS_Z1) + (size_t)c * NB * SEQ; float* Z1w = (float*)(P.ws + WS_Z1) + (size_t)c * NB * SEQ;
    for (int n = tid; n < SEQ; n += NTHR) { X[n] = make_float2(Z1[n], Z1[SEQ + n]); X[SEQ + n] = make_float2(0.f, 0.f); }
    __syncthreads();
    hy_conv_core(P, 1, c, X);
    bf16_t* MIX = (bf16_t*)(P.ws + WS_U);
    const HyTap tg2 = hy_tap(cw, cb, 2 * HYC + c); const bf16_t* colg2 = PHY + (size_t)(2 * HYC + c) * T;
#pragma unroll 4
    for (int n = tid; n < SEQ; n += NTHR) { const float2 y = X[n];
        const float g0 = hy_lat(colg2, 0, n, tg2), g1 = hy_lat(colg2, 1, n, tg2);
        Z1w[n] = g0 * (y.x + bias1 * Z1[n]); Z1w[SEQ + n] = g1 * (y.y + bias1 * Z1[SEQ + n]); }
    __syncthreads();
}

constexpr int SEGC = 256, NSEG = 33, SCH = 4;
typedef float f32x2v __attribute__((ext_vector_type(2)));
template <bool IDENT>
__device__ __forceinline__ void scan_seg(const Params& P, int chain, int g, float* ring_  ) {
    const ldsfp ring = vlds(ring_);
    const int lane = otid() & 63;
    const int d = chain & 1, h = (chain >> 1) % 6, b = chain / 12;
    const float* DEC = (const float*)(P.ws + WS_DECAY) + (size_t)d * T * 384; const bf16_t* KKS = (const bf16_t*)(P.ws + WS_KKS); const bf16_t* RS = (const bf16_t*)(P.ws + WS_RS);
    const bf16_t* VS = (const bf16_t*)(P.ws + WS_VS); const bf16_t* KS = (const bf16_t*)(P.ws + WS_KS) + (size_t)d * T * 384; const bf16_t* BS = (const bf16_t*)(P.ws + WS_BS) + (size_t)d * T * 384;
    float* YD = (float*)(P.ws + WS_YDIR) + (size_t)d * T * 384;
    bf16_t* E = (bf16_t*)(P.ws + WS_E) + (size_t)chain * SEQ * 64;
    const int step0 = g == 0 ? 0 : CTX + (g - 1) * SEGC;
    f32x2v S0[32], S1[32];
#pragma unroll
    for (int j = 0; j < 32; ++j) { S0[j] = (f32x2v){0.f, 0.f}; S1[j] = (f32x2v){(2 * j == lane) ? 1.f : 0.f, (2 * j + 1 == lane) ? 1.f : 0.f}; }
    float pw[SCH], pa[SCH], pb[SCH], pk[SCH], pr[SCH], pv[SCH]; int po[SCH];
#pragma unroll
    for (int s = 0; s < SCH; ++s) { const int o = scan_row(b, d, step0 + s) * 384 + h * 64 + lane; po[s] = o;
        pw[s] = DEC[o]; pa[s] = bf2f(KKS[o]); pb[s] = bf2f(BS[o]); pk[s] = bf2f(KS[o]); pr[s] = bf2f(RS[o]); pv[s] = bf2f(VS[o]); }
    for (int c = 0; c < SEGC / SCH; ++c) {
        float cv[SCH]; int co[SCH];
        asm volatile("s_waitcnt lgkmcnt(0)" ::: "memory");
#pragma unroll
        for (int s = 0; s < SCH; ++s) { const ldsfp sv = ring + s * 320; sv[lane] = pw[s]; sv[64 + lane] = pa[s]; sv[128 + lane] = pb[s]; sv[192 + lane] = pk[s]; sv[256 + lane] = pr[s]; cv[s] = pv[s]; co[s] = po[s]; }
        asm volatile("s_waitcnt lgkmcnt(0)" ::: "memory");
        if (c + 1 < SEGC / SCH) {
#pragma unroll
            for (int s = 0; s < SCH; ++s) { const int o = scan_row(b, d, step0 + (c + 1) * SCH + s) * 384 + h * 64 + lane; po[s] = o;
                pw[s] = DEC[o]; pa[s] = bf2f(KKS[o]); pb[s] = bf2f(BS[o]); pk[s] = bf2f(KS[o]); pr[s] = bf2f(RS[o]); pv[s] = bf2f(VS[o]); } }
#pragma unroll
        for (int s = 0; s < SCH; ++s) { const ldsfp sv = ring + s * 320;
            f32x2v sa2 = (f32x2v){0.f, 0.f}, sb2 = (f32x2v){0.f, 0.f}, sa3 = sa2, sb3 = sa2;
#pragma unroll
            for (int hb = 0; hb < 2; ++hb) { f32x4 A[8];
#pragma unroll
                for (int i = 0; i < 8; ++i) A[i] = *(const LAS f32x4*)(sv + 64 + hb * 32 + 4 * i);
                __builtin_amdgcn_sched_barrier(0);
#pragma unroll
                for (int i = 0; i < 8; ++i) { const int jj = hb * 16 + 2 * i; const f32x2v alo = (f32x2v){A[i].x, A[i].y}, ahi = (f32x2v){A[i].z, A[i].w};
                    sa2 += S0[jj] * alo; sa3 += S0[jj + 1] * ahi;
                    if (IDENT) { sb2 += S1[jj] * alo; sb3 += S1[jj + 1] * ahi; } }
                __builtin_amdgcn_sched_barrier(0); }
            const float sa = (sa2.x + sa2.y) + (sa3.x + sa3.y), sb = (sb2.x + sb2.y) + (sb3.x + sb3.y);
            const f32x2v saa = (f32x2v){sa, sa}, sbb = (f32x2v){sb, sb}, vv = (f32x2v){cv[s], cv[s]};
            f32x2v y2 = (f32x2v){0.f, 0.f}, y3 = y2, e2 = y2, e3 = y2;
#pragma unroll
            for (int ch = 0; ch < 8; ++ch) { f32x4 W[2], Bq[2], K[2], R[2];
#pragma unroll
                for (int i = 0; i < 2; ++i) { const int j = ch * 8 + 4 * i; W[i] = *(const LAS f32x4*)(sv + j); Bq[i] = *(const LAS f32x4*)(sv + 128 + j); K[i] = *(const LAS f32x4*)(sv + 192 + j); R[i] = *(const LAS f32x4*)(sv + 256 + j); }
                __builtin_amdgcn_sched_barrier(0);
#pragma unroll
                for (int i = 0; i < 2; ++i) { const int jj = ch * 4 + 2 * i;
                    const f32x2v wlo = (f32x2v){W[i].x, W[i].y}, whi = (f32x2v){W[i].z, W[i].w}, blo = (f32x2v){Bq[i].x, Bq[i].y}, bhi = (f32x2v){Bq[i].z, Bq[i].w};
                    const f32x2v klo = (f32x2v){K[i].x, K[i].y}, khi = (f32x2v){K[i].z, K[i].w}, rlo = (f32x2v){R[i].x, R[i].y}, rhi = (f32x2v){R[i].z, R[i].w};
                    S0[jj] = S0[jj] * wlo + saa * blo + vv * klo; y2 += S0[jj] * rlo;
                    S0[jj + 1] = S0[jj + 1] * whi + saa * bhi + vv * khi; y3 += S0[jj + 1] * rhi;
                    if (IDENT) { S1[jj] = S1[jj] * wlo + sbb * blo; e2 += S1[jj] * rlo; S1[jj + 1] = S1[jj + 1] * whi + sbb * bhi; e3 += S1[jj + 1] * rhi; } }
                __builtin_amdgcn_sched_barrier(0); }
            YD[co[s]] = (y2.x + y2.y) + (y3.x + y3.y);
            if (IDENT) { const int tl = d ? (SEQ - 1 - (step0 - CTX + c * SCH + s)) : (step0 - CTX + c * SCH + s); E[(size_t)tl * 64 + lane] = f2bf((e2.x + e2.y) + (e3.x + e3.y)); }
        }
    }
    float* ZP = (float*)(P.ws + WS_ZP) + ((size_t)chain * NSEG + g) * 2 * 4096;
#pragma unroll
    for (int j = 0; j < 32; j += 2) { *(float4*)(ZP + lane * 64 + 2 * j) = make_float4(S0[j].x, S0[j].y, S0[j + 1].x, S0[j + 1].y);
        if (IDENT) *(float4*)(ZP + 4096 + lane * 64 + 2 * j) = make_float4(S1[j].x, S1[j].y, S1[j + 1].x, S1[j + 1].y); }
}
__device__ __forceinline__ void scan_combine(const Params& P, int chain, float* lds) {
    const int tid = otid(); const int i = tid >> 3, j0 = (tid & 7) * 8;
    float* Sl = lds;
    float* Pl = lds + 64 * 65;
    float* ZPc = (float*)(P.ws + WS_ZP) + (size_t)chain * NSEG * 2 * 4096;
    float sn[8];
#pragma unroll
    for (int q = 0; q < 8; ++q) sn[q] = ZPc[i * 64 + j0 + q];
    for (int g = 1; g < NSEG - 1; ++g) {
        __syncthreads();
#pragma unroll
        for (int q = 0; q < 8; ++q) Sl[i * 65 + j0 + q] = sn[q];
        const float* Pg = ZPc + (size_t)g * 2 * 4096 + 4096;
#pragma unroll
        for (int q = 0; q < 8; ++q) Pl[tid * 8 + q] = Pg[tid * 8 + q];
        float* Zg = ZPc + (size_t)g * 2 * 4096;
#pragma unroll
        for (int q = 0; q < 8; ++q) sn[q] = Zg[i * 64 + j0 + q];
        __syncthreads();
        for (int m = 0; m < 64; ++m) { const float sv = Sl[i * 65 + m]; const float4 p0 = *(const float4*)(Pl + m * 64 + j0), p1 = *(const float4*)(Pl + m * 64 + j0 + 4);
            sn[0] += sv * p0.x; sn[1] += sv * p0.y; sn[2] += sv * p0.z; sn[3] += sv * p0.w; sn[4] += sv * p1.x; sn[5] += sv * p1.y; sn[6] += sv * p1.z; sn[7] += sv * p1.w; }
#pragma unroll
        for (int q = 0; q < 8; ++q) Zg[i * 64 + j0 + q] = sn[q];
    }
    __syncthreads();
}

__device__ __forceinline__ void rwkv_out_fin(const Params& P, int row, int c, float y, float lnw, float lnb, float bon, float vs, float gt) {
    bf16_t* MIX = (bf16_t*)(P.ws + WS_U);
    const float mean = wsum(y) * (1.0f / 64.0f); const float dv = y - mean; const float var = wsum(dv * dv) * (1.0f / 64.0f);
    const float yn = dv * rsqrtf(var + 64e-5f) * lnw + lnb;
    MIX[(size_t)row * D + 256 + c] = f2bf((yn + bon * vs) * gt);
}
__device__ __forceinline__ void ph_rwkvout(const Params& P, int l, float* ldsf) {
    using pg8::bf16x8;
    const int tid = otid(), lane = tid & 63, fr = lane & 15, fq = lane >> 4, wv = tid >> 6, gw = blockIdx.x * NWAVE + wv, nw = gridDim.x * NWAVE;
    const float* YD = (const float*)(P.ws + WS_YDIR); const bf16_t* VS = (const bf16_t*)(P.ws + WS_VS); const bf16_t* GT = (const bf16_t*)(P.ws + WS_GATE); const float* BON = (const float*)(P.ws + WS_BONUS);
    bf16_t* MIX = (bf16_t*)(P.ws + WS_U);
    for (int it = gw; it < NB * 6 * 32 * 4; it += nw) {
        const int sub = it & 3, q = (it >> 2) & 31, h = (it >> 7) % 6, b = it / (128 * 6);
        const int t0 = q * 256 + sub * 64;
        f32x4 acc[4][4];
#pragma unroll
        for (int mt = 0; mt < 4; ++mt)
#pragma unroll
            for (int nt = 0; nt < 4; ++nt) acc[mt][nt] = (f32x4){0.f, 0.f, 0.f, 0.f};
#pragma unroll
        for (int dir = 0; dir < 2; ++dir) { const int ch = b * 12 + h * 2 + dir, slot = dir ? (31 - q) : q;
            const float* Sp = (const float*)(P.ws + WS_ZP) + ((size_t)ch * NSEG + slot) * 2 * 4096;
            const bf16_t* Ep = (const bf16_t*)(P.ws + WS_E) + ((size_t)ch * SEQ + t0) * 64;
#pragma unroll
            for (int ks = 0; ks < 2; ++ks) { bf16x8 bop[4];
#pragma unroll
                for (int nt = 0; nt < 4; ++nt) { const float* sp = Sp + (nt * 16 + fr) * 64 + ks * 32 + fq * 8; const float4 s0 = *(const float4*)sp, s1 = *(const float4*)(sp + 4);
                    u32x4 w; w.x = cvt_pk_bf16(s0.x, s0.y); w.y = cvt_pk_bf16(s0.z, s0.w); w.z = cvt_pk_bf16(s1.x, s1.y); w.w = cvt_pk_bf16(s1.z, s1.w); bop[nt] = __builtin_bit_cast(bf16x8, w); }
#pragma unroll
                for (int mt = 0; mt < 4; ++mt) { const bf16x8 a = *(const bf16x8*)(Ep + (size_t)(mt * 16 + fr) * 64 + ks * 32 + fq * 8);
#pragma unroll
                    for (int nt = 0; nt < 4; ++nt) acc[mt][nt] = __builtin_amdgcn_mfma_f32_16x16x32_bf16(a, bop[nt], acc[mt][nt], 0, 0, 0); } } }
        float lnw[4], lnb[4];
#pragma unroll
        for (int nt = 0; nt < 4; ++nt) { lnw[nt] = P.in[I_LNW][l * RWW + h * 64 + nt * 16 + fr]; lnb[nt] = P.in[I_LNB][l * RWW + h * 64 + nt * 16 + fr]; }
#pragma unroll
        for (int mt = 0; mt < 4; ++mt)
#pragma unroll
            for (int rg = 0; rg < 4; ++rg) { const int row = b * SEQ + t0 + mt * 16 + fq * 4 + rg; const size_t o = (size_t)row * 384 + h * 64 + fr;
                float y[4], vs[4], gt[4]; const float bon = BON[(size_t)row * 6 + h];
#pragma unroll
                for (int nt = 0; nt < 4; ++nt) { y[nt] = YD[o + nt * 16] + YD[(size_t)T * 384 + o + nt * 16] + acc[mt][nt][rg]; vs[nt] = bf2f(VS[o + nt * 16]); gt[nt] = bf2f(GT[o + nt * 16]); }
                float sm = (y[0] + y[1]) + (y[2] + y[3]);
                sm += __shfl_xor(sm, 1); sm += __shfl_xor(sm, 2); sm += __shfl_xor(sm, 4); sm += __shfl_xor(sm, 8);
                const float mean = sm * (1.0f / 64.0f);
                float vr = 0.f;
#pragma unroll
                for (int nt = 0; nt < 4; ++nt) { y[nt] -= mean; vr += y[nt] * y[nt]; }
                vr += __shfl_xor(vr, 1); vr += __shfl_xor(vr, 2); vr += __shfl_xor(vr, 4); vr += __shfl_xor(vr, 8);
                const float rstd = rsqrtf(vr * (1.0f / 64.0f) + 64e-5f);
#pragma unroll
                for (int nt = 0; nt < 4; ++nt) MIX[(size_t)row * D + 256 + h * 64 + nt * 16 + fr] = f2bf((y[nt] * rstd * lnw[nt] + lnb[nt] + bon * vs[nt]) * gt[nt]);
                if (rg & 1) asm volatile("" ::: "memory"); }
    }
    for (int it = gw; it < TC * 6; it += nw) { const int row = TL + it / 6, h = it % 6, c = h * 64 + lane; const size_t o = (size_t)row * 384 + c;
        rwkv_out_fin(P, row, c, YD[o] + YD[(size_t)T * 384 + o], P.in[I_LNW][l * RWW + c], P.in[I_LNB][l * RWW + c], BON[(size_t)row * 6 + h], bf2f(VS[o]), bf2f(GT[o])); }
}

__device__ __forceinline__ void zt_tile(const Params& P, int tile, float* tl  ) {
    const int tid = otid(); const int c0 = (tile & 3) * 64, t0 = (tile >> 2) * 64;
    const float* Z = (const float*)(P.ws + WS_Z1); bf16_t* MIX = (bf16_t*)(P.ws + WS_U);
    { const int cc = tid >> 3, sg = (tid & 7) * 8; const float* src = Z + (size_t)(c0 + cc) * TL + t0 + sg; const float4 a = *(const float4*)src, b = *(const float4*)(src + 4);
      tl[cc * 65 + sg + 0] = a.x; tl[cc * 65 + sg + 1] = a.y; tl[cc * 65 + sg + 2] = a.z; tl[cc * 65 + sg + 3] = a.w; tl[cc * 65 + sg + 4] = b.x; tl[cc * 65 + sg + 5] = b.y; tl[cc * 65 + sg + 6] = b.z; tl[cc * 65 + sg + 7] = b.w; }
    __syncthreads();
    { const int tk = tid >> 3, cs = (tid & 7) * 8;
      u32x4 w; w.x = cvt_pk_bf16(tl[(cs + 0) * 65 + tk], tl[(cs + 1) * 65 + tk]); w.y = cvt_pk_bf16(tl[(cs + 2) * 65 + tk], tl[(cs + 3) * 65 + tk]);
      w.z = cvt_pk_bf16(tl[(cs + 4) * 65 + tk], tl[(cs + 5) * 65 + tk]); w.w = cvt_pk_bf16(tl[(cs + 6) * 65 + tk], tl[(cs + 7) * 65 + tk]);
      *(u32x4*)(MIX + (size_t)(t0 + tk) * D + c0 + cs) = w; }
    __syncthreads();
}
typedef const __attribute__((address_space(4))) Params* KParamsPtr;
__device__ __forceinline__ const Params* fresh_params() { KParamsPtr q = (KParamsPtr)__builtin_amdgcn_kernarg_segment_ptr(); asm volatile("" : "+s"(q)); return (const Params*)q; }
__global__ void __launch_bounds__(NTHR, 2) fwd_megakernel(Params P_unused, int ph_lo, int ph_hi) {
    extern __shared__ __attribute__((aligned(16))) unsigned char smem[];
    cg::grid_group grid = cg::this_grid();
    LAS unsigned char* lds3 = (LAS unsigned char*)smem;
    float* ldsf = (float*)smem; float2* X = (float2*)smem; float* ex = (float*)(smem + LDS_MAIN);
    { volatile LAS unsigned* st = (volatile LAS unsigned*)(lds3 + LDS_MAIN + 4096); if (threadIdx.x == 0) { st[0] = 0u; st[1] = 0u; } }
    __syncthreads();
    XcdBarrier xbar = xcd_barrier_post((unsigned*)(((const Params*)fresh_params())->ws + WS_BAR), (volatile LAS unsigned*)(lds3 + LDS_MAIN + 4096));
    int ph = 0;
#ifndef REP_GEMM
#define REP_GEMM 1
#endif
#ifndef REP_SCAN
#define REP_SCAN 1
#endif
#ifndef REP_MISC
#define REP_MISC 1
#endif
#ifndef REP_HY
#define REP_HY 1
#endif
#define PHASE_BEGIN if (ph >= ph_lo && ph < ph_hi) { const Params& P = *fresh_params(); unsigned char* ws = P.ws; (void)ws;
#ifndef REP_SYNC
#define REP_SYNC 1
#endif
#define PHASE_END   if (ph + 1 < ph_hi) { for (int rs_ = 0; rs_ < REP_SYNC; ++rs_) { if (ph == 0) grid.sync(); else xcd_barrier(xbar); } } } ++ph;
    PHASE_BEGIN ph_modv(P, ldsf); PHASE_END
    for (int l = 0; l < DEPTH; ++l) {
        PHASE_BEGIN
            for (int rep_ = 0; rep_ < REP_MISC; ++rep_) ph_prep(P, l, ldsf);
            if (l == 0) ph_rowpass(P, 0, 0, 0, 0, 0.f, 0, 0, 0, 1, 1);
            else ph_rowpass(P, 1, l - 1, 8, 5, 0.5f, l, 0, 0, 1, 11);
        PHASE_END
        PHASE_BEGIN { EpiGU E{(bf16_t*)(ws + WS_ACT)}; for (int rep_ = 0; rep_ < REP_GEMM; ++rep_) run_gemm(lds3, (const bf16_t*)(ws + WS_U), (const bf16_t*)(ws + WS_WGU1), T, 2 * DFF, D, E); } PHASE_END
        PHASE_BEGIN { EpiF32 E{(bf16_t*)(ws + WS_Y), (float*)(ws + WS_YC)}; run_gemm_tail(lds3, (const bf16_t*)(ws + WS_ACT), (const bf16_t*)(ws + WS_WDN1), DFF, E); } PHASE_END
        PHASE_BEGIN ph_rowpass(P, 1, l, 2, 1, 0.5f, l, 2, 3, 4, 11); PHASE_END
        PHASE_BEGIN { EpiWin E{(bf16_t*)(ws + WS_PHY), (bf16_t*)(ws + WS_PRW), (bf16_t*)(ws + WS_PNA)}; for (int rep_ = 0; rep_ < REP_GEMM; ++rep_) run_gemm(lds3, (const bf16_t*)(ws + WS_U), (const bf16_t*)(ws + WS_WIN), T, INWP, D, E); } PHASE_END
        PHASE_BEGIN
            for (int rep_ = 0; rep_ < REP_MISC; ++rep_) { ph_loraprep(P, l);
            for (int it = blockIdx.x; it < NB * 128 * 6 + NB * 4 * 6; it += gridDim.x) vt_tile(P, it, (unsigned short*)smem); }
            for (int rep_ = 0; rep_ < REP_HY; ++rep_) for (int it = blockIdx.x; it < 256; it += gridDim.x) hy_spec_task(P, l, it, X);
        PHASE_END
        PHASE_BEGIN { EpiLora E{(bf16_t*)(ws + WS_LORAO), (bf16_t*)(ws + WS_GATE)};
            for (int rep_ = 0; rep_ < REP_GEMM; ++rep_) run_gemm(lds3, (const bf16_t*)(ws + WS_ALORA), (const bf16_t*)(ws + WS_WLORA), T, 2048, 384, E); } PHASE_END
        PHASE_BEGIN
            for (int rep_ = 0; rep_ < REP_MISC; ++rep_) ph_rwkvprep(P, l);
            for (int rep_ = 0; rep_ < REP_HY; ++rep_) for (int c = blockIdx.x; c < HYC; c += gridDim.x) hy_task1(P, l, c, X, ex);
        PHASE_END
        PHASE_BEGIN {
            const int wv = __builtin_amdgcn_readfirstlane(otid() >> 6);
            if (wv < 4) { const int k = wv * (int)gridDim.x + (int)blockIdx.x;
                if (k < 24 * NSEG) { const int chain = k / NSEG, g = k % NSEG; float* ring = ldsf + wv * (SCH * 320);
                    __builtin_amdgcn_s_setprio(3);
                    for (int rep_ = 0; rep_ < REP_SCAN; ++rep_) { if (g == 0) scan_seg<false>(P, chain, g, ring); else scan_seg<true>(P, chain, g, ring); }
                    __builtin_amdgcn_s_setprio(0); } }
            else for (int it = (wv - 4) * (int)gridDim.x + (int)blockIdx.x; it < NAT_TASKS; it += 4 * (int)gridDim.x) natten_task(P, l, it);
        } PHASE_END
        PHASE_BEGIN
            if (blockIdx.x < 24) scan_combine(P, blockIdx.x, ldsf);
            else for (int rep_ = 0; rep_ < REP_HY; ++rep_) for (int c = blockIdx.x - 24; c < HYC; c += gridDim.x - 24) hy_task2(P, l, c, X);
        PHASE_END
        PHASE_BEGIN for (int rep_ = 0; rep_ < REP_MISC; ++rep_) ph_rwkvout(P, l, ldsf);
            __syncthreads();
            for (int it = blockIdx.x; it < 4 * (TL / 64); it += gridDim.x) zt_tile(P, it, ldsf);
        PHASE_END
        PHASE_BEGIN { EpiF32 E{(bf16_t*)(ws + WS_Y), (float*)(ws + WS_YC)}; run_gemm_tail(lds3, (const bf16_t*)(ws + WS_U), (const bf16_t*)(ws + WS_WOUT), D, E); } PHASE_END
        PHASE_BEGIN ph_rowpass(P, 1, l, 5, 3, 1.0f, l, 4, 6, 7, 4); PHASE_END
        PHASE_BEGIN { EpiGU E{(bf16_t*)(ws + WS_ACT)}; for (int rep_ = 0; rep_ < REP_GEMM; ++rep_) run_gemm(lds3, (const bf16_t*)(ws + WS_U), (const bf16_t*)(ws + WS_WGU2), T, 2 * DFF, D, E); } PHASE_END
        PHASE_BEGIN { EpiF32 E{(bf16_t*)(ws + WS_Y), (float*)(ws + WS_YC)}; run_gemm_tail(lds3, (const bf16_t*)(ws + WS_ACT), (const bf16_t*)(ws + WS_WDN2), DFF, E); } PHASE_END
    }
    PHASE_BEGIN ph_rowpass(P, 2, DEPTH - 1, 8, 5, 0.5f, 0, 0, 0, 0, 11); PHASE_END
#undef PHASE_BEGIN
#undef PHASE_END
}
constexpr int N_PHASES = 1 + DEPTH * 15 + 1;

extern "C" void kernel_launch(void* const* d_in, const int* in_sizes, int n_in, void* d_out, int out_size, void* d_ws, size_t ws_size, hipStream_t stream) {
    static int grid = 0;
    if (grid == 0) {
        if (n_in != 34 || ws_size < WS_END) { fprintf(stderr, "kernel_launch: need 34 inputs and %zu bytes of workspace; got %d, %zu\n", (size_t)WS_END, n_in, ws_size); grid = -1; return; }
        int dev = 0, cus = 0, per_cu = 0;
        hipGetDevice(&dev); hipDeviceGetAttribute(&cus, hipDeviceAttributeMultiprocessorCount, dev);
        if (hipFuncSetAttribute((const void*)fwd_megakernel, hipFuncAttributeMaxDynamicSharedMemorySize, LDS_BYTES) != hipSuccess) { fprintf(stderr, "kernel_launch: hipFuncSetAttribute failed\n"); grid = -1; return; }
        if (hipOccupancyMaxActiveBlocksPerMultiprocessor(&per_cu, (const void*)fwd_megakernel, NTHR, LDS_BYTES) != hipSuccess || per_cu < 1) { fprintf(stderr, "kernel_launch: occupancy query says %d\n", per_cu); per_cu = 1; }
        (void)hipGetLastError();
        grid = cus;
    }
    if (grid < 0) return;
    if (hipMemsetAsync((char*)d_ws + WS_BAR, 0, (size_t)XCD_BAR_WORDS * 4, stream) != hipSuccess) { fprintf(stderr, "kernel_launch: memset of the barrier words failed\n"); return; }
    Params p{};
    for (int i = 0; i < 34; ++i) p.in[i] = (const float*)d_in[i];
    p.out = (float*)d_out; p.ws = (unsigned char*)d_ws;
#if MK_SPLIT
    for (int ph = 0; ph < N_PHASES; ++ph) { int lo = ph, hi = ph + 1; hipLaunchKernelGGL(fwd_megakernel, dim3(grid), dim3(NTHR), LDS_BYTES, stream, p, lo, hi); }
#else
    int lo = 0, hi = N_PHASES;
    void* args[] = {&p, &lo, &hi};
    hipError_t e = hipLaunchCooperativeKernel((const void*)fwd_megakernel, dim3(grid), dim3(NTHR), args, LDS_BYTES, stream);
    if (e != hipSuccess) fprintf(stderr, "cooperative launch failed: %s (grid %d)\n", hipGetErrorString(e), grid);
#endif
}
```

```cpp
#include <hip/hip_runtime.h>
#include <hip/hip_cooperative_groups.h>
#include <cstdio>
namespace cg = cooperative_groups;
__device__ __forceinline__ int otid() { int t = threadIdx.x; asm volatile("" : "+v"(t)); return t; }
namespace pg8 {
#define PG8_LAS __attribute__((address_space(3)))
typedef unsigned short bf16_t;
typedef short bf16x8 __attribute__((ext_vector_type(8)));
typedef float f32x4 __attribute__((ext_vector_type(4)));
typedef unsigned u32x4 __attribute__((ext_vector_type(4)));
constexpr int BM = 256, BK = 64, HALF = 128, HTB = HALF * BK * 2  , STAGE_BYTES = 8 * HTB, NXCD = 8, WGM = 8;

__host__ __device__ __forceinline__ int lds_byte(int r, int c) { const int st = (r >> 4) * 2 + (c >> 5), rr = r & 15, cc = c & 31, ob = rr * 64 + cc * 2; return st * 1024 + (ob ^ (((ob >> 9) & 1) << 5)); }
__host__ __device__ __forceinline__ void stage_rc(int b, int& R, int& C) { const int st = b / 1024, sb = b % 1024, swz = sb ^ (((sb >> 9) & 1) << 5); R = (st >> 1) * 16 + swz / 64; C = (st & 1) * 32 + (swz % 64) / 2; }
__host__ __device__ __forceinline__ int perm32(int rho) { const int n = rho >> 4, i = rho & 15; return 8 * (i >> 2) + 4 * n + (i & 3); }

struct Unit { int pm, pn, kt0, nkt; };
struct Gemm { const bf16_t* A; const bf16_t* Bt; int M, N, K; };
struct StaticOrder {
    int nM, nN, nwg, G, c;
    __host__ __device__ void init(int M, int N, int G_, int c_) { nM = M / BM; nN = N / BM; nwg = nM * nN; G = G_; c = c_; }
    __host__ __device__ bool next(int i, Unit& u) const {
        const long L = (long)i * G + c; if (L >= nwg) return false;
        int wgid = (int)L; { const int q = nwg / NXCD, r = nwg % NXCD, xcd = wgid % NXCD, off = wgid / NXCD; wgid = (xcd < r ? xcd * (q + 1) : r * (q + 1) + (xcd - r) * q) + off; }
        const int nig = WGM * nN, gid = wgid / nig, fm = gid * WGM, gsz = (nM - fm) < WGM ? (nM - fm) : WGM;
        u.pm = fm + ((wgid % nig) % gsz); u.pn = (wgid % nig) / gsz; u.kt0 = 0; u.nkt = 0; return true;
    }
    __device__ __forceinline__ void a_ready(const Unit&) const {}
    __device__ __forceinline__ void done(const Unit&) const {}
};
__device__ __forceinline__ unsigned cvt_pk_bf16(float lo, float hi) { unsigned r; asm volatile("v_cvt_pk_bf16_f32 %0, %1, %2" : "=v"(r) : "v"(lo), "v"(hi)); return r; }
template <class Epi, class Sched>
__device__ __forceinline__ void gemm_phase(PG8_LAS unsigned char* lds, const Gemm g, const Sched& S, const Epi& E) {
    const int tid = otid(), wid = __builtin_amdgcn_readfirstlane(tid >> 6), lane = tid & 63, wr = wid >> 2, wc = wid & 3, fr = lane & 15, fq = lane >> 4;
    const int K = g.K, nt = K / BK;
#define PG8_STAMP() do {} while (0)
    unsigned voffA[2], voffB[2];
#pragma unroll
    for (int i = 0; i < 2; ++i) { int R, C; stage_rc(tid * 16 + i * 8192, R, C); const int Rb = Epi::PERM ? ((R & ~31) + perm32(R & 31)) : R;
        voffA[i] = (unsigned)(R * K + C) * 2u; voffB[i] = (unsigned)(Rb * K + C) * 2u; }
    const size_t kstep = (size_t)(BK * 2);
    const size_t hstep = (size_t)HALF * K * 2;
    const size_t tstep = 2 * hstep;
    const unsigned ldsw = (unsigned)wid * 1024u;
    const int aoff = lds_byte(wr * 64 + fr, fq * 8), boff = lds_byte(wc * 32 + fr, fq * 8);
#define PG8_SA(b, h) (((b) * 2 + (h)) * HTB)
#define PG8_SB(b, h) ((4 + (b) * 2 + (h)) * HTB)
#define PG8_STAGE(bufoff, gbase, voff) do { _Pragma("unroll") for (int _i = 0; _i < 2; ++_i) \
        __builtin_amdgcn_global_load_lds((const unsigned*)((const char*)(gbase) + (voff)[_i]), (PG8_LAS unsigned*)(lds + (bufoff) + ldsw + _i * 8192), 16, 0, 0); } while (0)
#define PG8_LDA(dst, b, h) do { _Pragma("unroll") for (int m = 0; m < 4; ++m) _Pragma("unroll") for (int k = 0; k < 2; ++k) dst[m][k] = *(const PG8_LAS bf16x8*)(lds + PG8_SA(b, h) + aoff + m * 2048 + k * 1024); } while (0)
#define PG8_LDB(dst, b, h) do { _Pragma("unroll") for (int n = 0; n < 2; ++n) _Pragma("unroll") for (int k = 0; k < 2; ++k) dst[n][k] = *(const PG8_LAS bf16x8*)(lds + PG8_SB(b, h) + boff + n * 2048 + k * 1024); } while (0)
#define PG8_MMA(ai, bj, At, Bt) do { __builtin_amdgcn_s_setprio(1); _Pragma("unroll") for (int m = 0; m < 4; ++m) _Pragma("unroll") for (int n = 0; n < 2; ++n) _Pragma("unroll") for (int k = 0; k < 2; ++k) \
        acc[ai][bj][m][n] = __builtin_amdgcn_mfma_f32_16x16x32_bf16(Bt[n][k], At[m][k], acc[ai][bj][m][n], 0, 0, 0); __builtin_amdgcn_s_setprio(0); } while (0)
#define PG8_WAIT_V(n) asm volatile("s_waitcnt vmcnt(" #n ")" ::: "memory")
#define PG8_WAIT_L(n) asm volatile("s_waitcnt lgkmcnt(" #n ")" ::: "memory")
#define PG8_BAR __builtin_amdgcn_s_barrier()
#define PG8_SCHED __builtin_amdgcn_sched_barrier(0)
    Unit cur, nxt; int ui = 0;
    if (!S.next(0, cur)) return;
    f32x4 acc[2][2][4][2];
#pragma unroll
    for (int a = 0; a < 2; ++a)
#pragma unroll
        for (int b = 0; b < 2; ++b)
#pragma unroll
            for (int m = 0; m < 4; ++m)
#pragma unroll
                for (int n = 0; n < 2; ++n) acc[a][b][m][n] = (f32x4){0.f, 0.f, 0.f, 0.f};
    bf16x8 At[4][2], B0[2][2], B1[2][2];
    const char* cA = (const char*)g.A + (size_t)cur.pm * tstep + (size_t)cur.kt0 * kstep; const char* cB = (const char*)g.Bt + (size_t)cur.pn * tstep + (size_t)cur.kt0 * kstep;
    int ntc = cur.nkt > 0 ? cur.nkt : nt;
    S.a_ready(cur);
    PG8_STAGE(PG8_SB(0, 0), cB, voffB); PG8_STAGE(PG8_SA(0, 0), cA, voffA); PG8_STAGE(PG8_SB(0, 1), cB + hstep, voffB); PG8_STAGE(PG8_SA(0, 1), cA + hstep, voffA);
    if (wr == 1) PG8_BAR;
    PG8_WAIT_V(4); PG8_BAR;
    PG8_STAGE(PG8_SB(1, 0), cB + kstep, voffB); PG8_STAGE(PG8_SA(1, 0), cA + kstep, voffA); PG8_STAGE(PG8_SB(1, 1), cB + hstep + kstep, voffB);
    PG8_WAIT_V(6); PG8_BAR;
    PG8_STAMP();
    for (;;) {
        const bool has_next = S.next(ui + 1, nxt);
        const char* nA = has_next ? (const char*)g.A + (size_t)nxt.pm * tstep + (size_t)nxt.kt0 * kstep : cA; const char* nB = has_next ? (const char*)g.Bt + (size_t)nxt.pn * tstep + (size_t)nxt.kt0 * kstep : cB;
        for (int t = 0; t < ntc; t += 2) {
            const bool last = (t == ntc - 2);
            const char* a1 = cA + (size_t)(t + 1) * kstep;
            const char* a2 = last ? nA : cA + (size_t)(t + 2) * kstep; const char* b2 = last ? nB : cB + (size_t)(t + 2) * kstep;
            const char* a3 = a2 + kstep; const char* b3 = b2 + kstep;
            if (last && has_next) S.a_ready(nxt);
            PG8_LDB(B0, 0, 0); PG8_SCHED; PG8_LDA(At, 0, 0); PG8_STAGE(PG8_SA(1, 1), a1 + hstep, voffA);
            PG8_WAIT_L(8); PG8_BAR; PG8_WAIT_L(0); PG8_MMA(0, 0, At, B0); PG8_BAR; PG8_SCHED;
            PG8_LDB(B1, 0, 1); PG8_STAGE(PG8_SB(0, 0), b2, voffB);
            PG8_BAR; PG8_WAIT_L(0); PG8_MMA(0, 1, At, B1); PG8_BAR;
            PG8_LDA(At, 0, 1); PG8_STAGE(PG8_SA(0, 0), a2, voffA);
            PG8_BAR; PG8_WAIT_L(0); PG8_MMA(1, 0, At, B0); PG8_BAR; PG8_SCHED;
            PG8_STAGE(PG8_SB(0, 1), b2 + hstep, voffB);
            PG8_WAIT_V(6); PG8_BAR; PG8_MMA(1, 1, At, B1); PG8_BAR;
            PG8_LDB(B0, 1, 0); PG8_SCHED; PG8_LDA(At, 1, 0); PG8_STAGE(PG8_SA(0, 1), a2 + hstep, voffA);
            PG8_WAIT_L(8); PG8_BAR; PG8_WAIT_L(0); PG8_MMA(0, 0, At, B0); PG8_BAR; PG8_SCHED;
            PG8_LDB(B1, 1, 1); PG8_STAGE(PG8_SB(1, 0), b3, voffB);
            PG8_BAR; PG8_WAIT_L(0); PG8_MMA(0, 1, At, B1); PG8_BAR;
            PG8_LDA(At, 1, 1); PG8_STAGE(PG8_SA(1, 0), a3, voffA);
            PG8_BAR; PG8_WAIT_L(0); PG8_MMA(1, 0, At, B0); PG8_BAR; PG8_SCHED;
            PG8_STAGE(PG8_SB(1, 1), b3 + hstep, voffB);
            PG8_WAIT_V(6); PG8_BAR; PG8_MMA(1, 1, At, B1); PG8_BAR;
        }
        PG8_STAMP();
        if constexpr (!Epi::AFTER_DRAIN) { E(acc, cur, wr, wc, fr, fq); S.done(cur); }
        PG8_STAMP();
        if (!has_next) break;
#pragma unroll
        for (int a = 0; a < 2; ++a)
#pragma unroll
            for (int b = 0; b < 2; ++b)
#pragma unroll
                for (int m = 0; m < 4; ++m)
#pragma unroll
                    for (int n = 0; n < 2; ++n) acc[a][b][m][n] = (f32x4){0.f, 0.f, 0.f, 0.f};
        cur = nxt; cA = nA; cB = nB; ++ui; ntc = cur.nkt > 0 ? cur.nkt : nt;
    }
    PG8_WAIT_V(0);
    if (wr == 0) PG8_BAR;
    PG8_BAR;
    if constexpr (Epi::AFTER_DRAIN) { E.fused(acc, cur, wr, wc, fr, fq, lds, wid, lane); S.done(cur); }
    PG8_STAMP();
#undef PG8_STAMP
#undef PG8_SA
#undef PG8_SB
#undef PG8_STAGE
#undef PG8_LDA
#undef PG8_LDB
#undef PG8_MMA
#undef PG8_WAIT_V
#undef PG8_WAIT_L
#undef PG8_BAR
#undef PG8_SCHED
}
}
#define LAS __attribute__((address_space(3)))
#define XB_TMO      128
#define XB_XCNT(j)  (256  + 64 * (j))
#define XB_XSUB(j)  (1280 + 64 * (j))
#define XB_XGEN(j)  (2304 + 64 * (j))
#define XB_TOP      3328
#define XB_TOPGEN   3392
#define XCD_BAR_WORDS 3456
#define XB_SPIN_CAP (1u << 18)

__device__ __forceinline__ unsigned xb_ld(unsigned* p)              { return __hip_atomic_load(p, __ATOMIC_RELAXED, __HIP_MEMORY_SCOPE_AGENT); }
__device__ __forceinline__ unsigned xb_add(unsigned* p, unsigned v) { return __hip_atomic_fetch_add(p, v, __ATOMIC_RELAXED, __HIP_MEMORY_SCOPE_AGENT); }
__device__ __forceinline__ unsigned xb_xcc_id() { return (unsigned)__builtin_amdgcn_s_getreg((3 << 11) | 20) & 0xFu; }
#define XB_SPIN(cond, bar) do { unsigned _sp = 0; while (cond) { __builtin_amdgcn_s_sleep(1); \
    if ((++_sp & 255u) == 0u) { if (xb_ld(&(bar)[XB_TMO])) break; if (_sp > XB_SPIN_CAP) { atomicAdd(&(bar)[XB_TMO], 1u); break; } } } } while (0)

struct XcdBarrier {
    unsigned* bar; unsigned x;
    volatile LAS unsigned* st;
};

__device__ __forceinline__ XcdBarrier xcd_barrier_post(unsigned* bar, volatile LAS unsigned* st) {
    XcdBarrier b; b.bar = bar; b.x = xb_xcc_id(); b.st = st;
    if (threadIdx.x == 0) (void)xb_add(&bar[XB_XCNT(b.x)], 1u);
    return b;
}
__device__ __forceinline__ void xcd_barrier_complete(unsigned* bar, unsigned x, unsigned& nloc, unsigned& nx) {
    const unsigned G = gridDim.x * gridDim.y * gridDim.z;
    unsigned sum, cnt, mine, sp = 0u;
    for (;;) {
        sum = 0u; cnt = 0u; mine = 0u;
#pragma unroll
        for (unsigned j = 0; j < 16; ++j) { const unsigned c = xb_ld(&bar[XB_XCNT(j)]); sum += c; cnt += (c > 0u) ? 1u : 0u; mine = (j == x) ? c : mine; }
        if (sum == G) break;
        __builtin_amdgcn_s_sleep(1);
        if ((++sp & 255u) == 0u) { if (xb_ld(&bar[XB_TMO])) break; if (sp > XB_SPIN_CAP) { atomicAdd(&bar[XB_TMO], 1u); break; } }
    }
    nloc = mine > 0u ? mine : 1u; nx = cnt > 0u ? cnt : 1u;
}

__device__ __forceinline__ void xcd_barrier(const XcdBarrier& b) {
    asm volatile("s_waitcnt vmcnt(0)" ::: "memory");
    __syncthreads();
    if (threadIdx.x == 0) {
        unsigned* bar = b.bar;
        __builtin_amdgcn_s_waitcnt(0);
        unsigned nloc = b.st[0], nx = b.st[1];
        if (nloc == 0u) { xcd_barrier_complete(bar, b.x, nloc, nx); b.st[0] = nloc; b.st[1] = nx; }
        const unsigned old = xb_add(&bar[XB_XSUB(b.x)], 1u);
        const unsigned gen = old / nloc;
        if (old + 1u == (gen + 1u) * nloc) {
            __builtin_amdgcn_fence(__ATOMIC_RELEASE, "agent");
            asm volatile("s_waitcnt vmcnt(0)" ::: "memory");
            const unsigned og = xb_add(&bar[XB_TOP], 1u);
            const unsigned tg = og / nx;
            if (og + 1u == (tg + 1u) * nx) xb_add(&bar[XB_TOPGEN], 1u);
            else XB_SPIN(xb_ld(&bar[XB_TOPGEN]) == tg, bar);
            __builtin_amdgcn_fence(__ATOMIC_ACQUIRE, "agent");
            xb_add(&bar[XB_XGEN(b.x)], 1u);
            asm volatile("s_waitcnt vmcnt(0)" ::: "memory");
        } else {
            XB_SPIN(xb_ld(&bar[XB_XGEN(b.x)]) == gen, bar);
            __builtin_amdgcn_fence(__ATOMIC_ACQUIRE, "agent");
            asm volatile("s_waitcnt vmcnt(0)" ::: "memory");
        }
    }
    __syncthreads();
}

using pg8::bf16_t; using pg8::f32x4; using pg8::u32x4; using pg8::cvt_pk_bf16;
typedef unsigned u32x2 __attribute__((ext_vector_type(2)));


constexpr int D = 1024, NB = 2, SEQ = 8192, DEPTH = 4, CTX = 256, DFF = 2816;
constexpr int TL = NB * SEQ, TC = NB * CTX, T = TL + TC;
constexpr int NMOD = 9 * D;
constexpr int HYC = 256, RWW = 384, NAW = 384, INW = 3456, INWP = 3584;
constexpr int HY_IN = 768, RW_IN = 1536, NA_IN = 1152;
constexpr int NFFT = 16384;
constexpr int NTHR = 512, NWAVE = 8;
constexpr int LDS_MAIN = 131072, LDS_EXTRA = 8192, LDS_BYTES = LDS_MAIN + LDS_EXTRA;
constexpr float NORM_EPS = 1e-6f;

constexpr size_t al256(size_t x) { return (x + 255) & ~(size_t)255; }
constexpr size_t WS_MODV = 0;
constexpr size_t WS_WGU1 = al256(WS_MODV + (size_t)DEPTH * 3 * NMOD * 4);
constexpr size_t WS_WDN1 = WS_WGU1 + (size_t)2 * DFF * D * 2;
constexpr size_t WS_WGU2 = WS_WDN1 + (size_t)D * DFF * 2;
constexpr size_t WS_WDN2 = WS_WGU2 + (size_t)2 * DFF * D * 2;
constexpr size_t WS_WIN = WS_WDN2 + (size_t)D * DFF * 2;
constexpr size_t WS_WOUT = WS_WIN + (size_t)INWP * D * 2;
constexpr size_t WS_WLORA = WS_WOUT + (size_t)D * D * 2;
constexpr size_t WS_H = WS_WLORA + (size_t)2048 * 384 * 2;
constexpr size_t WS_U = WS_H + (size_t)T * D * 4;
constexpr size_t WS_S = WS_U + (size_t)T * D * 2;
constexpr size_t WS_Y = WS_S;
constexpr size_t WS_ACT = WS_Y + (size_t)T * D * 4;
constexpr size_t WS_FFN_END = WS_ACT + (size_t)T * DFF * 2;
constexpr size_t WS_PHY = WS_S;
constexpr size_t WS_PRW = WS_PHY + (size_t)T * HY_IN * 2;
constexpr size_t WS_YDIR = WS_PRW;
constexpr size_t WS_PNA = WS_PRW + (size_t)T * RW_IN * 2;
constexpr size_t WS_ALORA = WS_PNA + (size_t)T * NA_IN * 2;
constexpr size_t WS_DECAY = WS_ALORA + (size_t)T * 384 * 2;
constexpr size_t WS_LORAO = WS_DECAY + (size_t)2 * T * 384 * 4;
constexpr size_t WS_E = WS_LORAO;
constexpr size_t WS_ZP = WS_E + (size_t)24 * SEQ * 64 * 2;
constexpr size_t WS_GATE = WS_LORAO + (size_t)T * 1536 * 2;
static_assert(WS_ZP + (size_t)24 * 33 * 2 * 4096 * 4 <= WS_GATE, "E + ZP must fit in the LORAO region");
constexpr size_t WS_RS = WS_GATE + (size_t)T * 384 * 2;
constexpr size_t WS_KKS = WS_RS + (size_t)T * 384 * 2;
constexpr size_t WS_VS = WS_KKS + (size_t)T * 384 * 2;
constexpr size_t WS_KS = WS_VS + (size_t)T * 384 * 2;
constexpr size_t WS_BS = WS_KS + (size_t)2 * T * 384 * 2;
constexpr size_t WS_BONUS = WS_BS + (size_t)2 * T * 384 * 2;
constexpr size_t WS_FILT = al256(WS_BONUS + (size_t)T * 6 * 4);
constexpr size_t WS_FILTC = WS_FILT + (size_t)1024 * SEQ * 2;
constexpr size_t WS_SPEC = WS_FILTC + (size_t)1024 * CTX * 2;
constexpr size_t WS_Z1 = WS_SPEC + (size_t)512 * NFFT * 8;
constexpr size_t WS_VTL = WS_Z1 + (size_t)HYC * NB * SEQ * 4;
constexpr size_t WS_VTC = WS_VTL + (size_t)NB * 6 * 64 * SEQ * 2;
constexpr size_t WS_MIX_END = WS_VTC + (size_t)NB * 6 * 64 * CTX * 2;
constexpr size_t WS_BAR = al256(WS_MIX_END > WS_FFN_END ? WS_MIX_END : WS_FFN_END);
constexpr size_t WS_ROPE = al256(WS_BAR + (size_t)XCD_BAR_WORDS * 4);
constexpr size_t WS_YC = WS_FFN_END + (size_t)(8 << 20);
static_assert(WS_YC + (size_t)11 * TC * D * 4 <= WS_FILT, "YC partials must stay below the filter tables");
constexpr size_t WS_END = WS_ROPE + (size_t)128 * 16 * 8;
static_assert(WS_END <= (size_t)4 * DEPTH * D * NMOD * 4, "workspace map exceeds 4x the largest input tensor");

struct Params { const float* in[34]; float* out; unsigned char* ws; };
enum { I_X = 0, I_C, I_CTX, I_CCTX, I_MODW, I_MODB, I_NORMG, I_F1GU, I_F1DN, I_F2GU, I_F2DN, I_WIN, I_WOUT, I_HCW, I_HCB, I_HW1, I_HB1, I_HW2, I_HB2, I_HW3, I_HFREQ, I_HBIAS,
       I_MU, I_W0, I_W2, I_A0, I_A2, I_G2, I_KK, I_KA, I_RK, I_LNW, I_LNB, I_RPB };

typedef LAS float* ldsfp;
__device__ __forceinline__ ldsfp vlds(const void* p) { ldsfp q = (ldsfp)p; asm volatile("" : "+v"(q)); return q; }
__device__ __forceinline__ float bf2f(bf16_t b) { return __uint_as_float(((unsigned)b) << 16); }
__device__ __forceinline__ bf16_t f2bf(float f) { unsigned u = __float_as_uint(f); u += 0x7FFFu + ((u >> 16) & 1u); return (bf16_t)(u >> 16); }
__device__ __forceinline__ float lo_bf(unsigned w) { return __uint_as_float(w << 16); }
__device__ __forceinline__ float hi_bf(unsigned w) { return __uint_as_float(w & 0xffff0000u); }
__device__ __forceinline__ float wsum(float v) {
#pragma unroll
    for (int o = 32; o > 0; o >>= 1) v += __shfl_xor(v, o);
    return v;
}
__device__ __forceinline__ float sigmoidf_(float x) { return __builtin_amdgcn_rcpf(1.0f + __expf(-x)); }
__device__ __forceinline__ void unpack8(const u32x4 w, float (&f)[8]) {
    f[0] = lo_bf(w.x); f[1] = hi_bf(w.x); f[2] = lo_bf(w.y); f[3] = hi_bf(w.y); f[4] = lo_bf(w.z); f[5] = hi_bf(w.z); f[6] = lo_bf(w.w); f[7] = hi_bf(w.w);
}
__device__ __forceinline__ void row_nbrs(int row, bool& hasp, bool& hasn) {
    if (row < TL) { const int t = row & (SEQ - 1); hasp = t > 0; hasn = t < SEQ - 1; }
    else { const int t = (row - TL) & (CTX - 1); hasp = t > 0; hasn = t < CTX - 1; }
}

__device__ __forceinline__ void ph_modv(const Params& P, float* lds) {
    const int tid = otid();
    float* sv = lds;
    float* red = lds + 3072;
    for (int i = tid; i < 3072; i += NTHR) { const int s = i >> 10, k = i & 1023; const float c = s < 2 ? P.in[I_C][s * 1024 + k] : P.in[I_CCTX][k]; sv[i] = c / (1.0f + expf(-c)); }
    __syncthreads();
    if (blockIdx.x < 4) { const int e = blockIdx.x * NTHR + tid, pos = e >> 4, f = e & 15; float sn, cs; sincosf((float)pos * expf(-(float)f * (9.210340371976184f / 16.0f)), &sn, &cs); ((float2*)(P.ws + WS_ROPE))[e] = make_float2(cs, sn); }
    float* modv = (float*)(P.ws + WS_MODV);
    const int kc = tid >> 6, cl = tid & 63;
    for (int item = blockIdx.x; item < DEPTH * 144; item += gridDim.x) {
        const int l = item / 144, cb = item % 144, col = cb * 64 + cl;
        const float* w = P.in[I_MODW] + ((size_t)l * 1024 + kc * 128) * NMOD + col;
        float a0 = 0.f, a1 = 0.f, a2 = 0.f;
#pragma unroll 8
        for (int k = 0; k < 128; ++k) { const float wv = w[(size_t)k * NMOD]; a0 += sv[kc * 128 + k] * wv; a1 += sv[1024 + kc * 128 + k] * wv; a2 += sv[2048 + kc * 128 + k] * wv; }
        red[(0 * 8 + kc) * 64 + cl] = a0; red[(1 * 8 + kc) * 64 + cl] = a1; red[(2 * 8 + kc) * 64 + cl] = a2;
        __syncthreads();
        if (tid < 192) { const int s = tid >> 6, c = tid & 63; float r = P.in[I_MODB][l * NMOD + cb * 64 + c];
#pragma unroll
            for (int q = 0; q < 8; ++q) r += red[(s * 8 + q) * 64 + c];
            modv[((size_t)l * 3 + s) * NMOD + cb * 64 + c] = r; }
        __syncthreads();
    }
}

__device__ __forceinline__ float hy_delta(int c);
__device__ __forceinline__ int rowmap_gu(int n) { const int up = n >= DFF ? 1 : 0; const int j = n - up * DFF; return (j >> 7) * 256 + up * 128 + (j & 127); }
__device__ __forceinline__ void conv_tile(const float* __restrict__ src, int K, int N, bf16_t* __restrict__ dst, int tk, int tn, bool gu, float* tile) {
    const int tid = otid(); const int k0 = tk * 64, n0 = tn * 64;
#pragma unroll
    for (int rr = 0; rr < 2; ++rr) { const int kk = (tid >> 4) + rr * 32, n4 = (tid & 15) * 4; const float4 v = *(const float4*)(src + (size_t)(k0 + kk) * N + n0 + n4);
        tile[kk * 65 + n4 + 0] = v.x; tile[kk * 65 + n4 + 1] = v.y; tile[kk * 65 + n4 + 2] = v.z; tile[kk * 65 + n4 + 3] = v.w; }
    __syncthreads();
    { const int nn = tid >> 3, ks = (tid & 7) * 8; const int n = n0 + nn; const int row = gu ? rowmap_gu(n) : n;
      u32x4 w; w.x = cvt_pk_bf16(tile[(ks + 0) * 65 + nn], tile[(ks + 1) * 65 + nn]); w.y = cvt_pk_bf16(tile[(ks + 2) * 65 + nn], tile[(ks + 3) * 65 + nn]);
      w.z = cvt_pk_bf16(tile[(ks + 4) * 65 + nn], tile[(ks + 5) * 65 + nn]); w.w = cvt_pk_bf16(tile[(ks + 6) * 65 + nn], tile[(ks + 7) * 65 + nn]);
      *(u32x4*)(dst + (size_t)row * K + k0 + ks) = w; }
    __syncthreads();
}
__device__ __forceinline__ void ph_prep(const Params& P, int l, float* lds) {
    const int tid = otid();
    unsigned char* ws = P.ws;
    constexpr int N0 = 16 * 88, N1 = 44 * 16, N4 = 16 * 54, N5 = 16 * 16;
    constexpr int C0 = N0, C1 = C0 + N1, C2 = C1 + N0, C3 = C2 + N1, C4 = C3 + N4, C5 = C4 + N5;
    for (int it = blockIdx.x; it < C5; it += gridDim.x) {
        if (it < C0) { conv_tile(P.in[I_F1GU] + (size_t)l * D * 2 * DFF, D, 2 * DFF, (bf16_t*)(ws + WS_WGU1), it / 88, it % 88, true, lds); }
        else if (it < C1) { const int j = it - C0; conv_tile(P.in[I_F1DN] + (size_t)l * DFF * D, DFF, D, (bf16_t*)(ws + WS_WDN1), j / 16, j % 16, false, lds); }
        else if (it < C2) { const int j = it - C1; conv_tile(P.in[I_F2GU] + (size_t)l * D * 2 * DFF, D, 2 * DFF, (bf16_t*)(ws + WS_WGU2), j / 88, j % 88, true, lds); }
        else if (it < C3) { const int j = it - C2; conv_tile(P.in[I_F2DN] + (size_t)l * DFF * D, DFF, D, (bf16_t*)(ws + WS_WDN2), j / 16, j % 16, false, lds); }
        else if (it < C4) { const int j = it - C3; conv_tile(P.in[I_WIN] + (size_t)l * D * INW, D, INW, (bf16_t*)(ws + WS_WIN), j / 54, j % 54, false, lds); }
        else { const int j = it - C4; conv_tile(P.in[I_WOUT] + (size_t)l * D * D, D, D, (bf16_t*)(ws + WS_WOUT), j / 16, j % 16, false, lds); }
    }
    const int gtid = blockIdx.x * NTHR + tid, gn = gridDim.x * NTHR;
    { unsigned* z = (unsigned*)(ws + WS_WIN + (size_t)INW * D * 2); for (int i = gtid; i < (INWP - INW) * D / 2; i += gn) z[i] = 0u; }
    { bf16_t* wl = (bf16_t*)(ws + WS_WLORA);
      const float* w2 = P.in[I_W2] + (size_t)l * 2 * 64 * RWW; const float* a2 = P.in[I_A2] + (size_t)l * 2 * 64 * RWW; const float* g2 = P.in[I_G2] + (size_t)l * 128 * RWW;
      for (int i = gtid; i < 2048 * 384; i += gn) { const int k = i / 2048, j = i % 2048; float v = 0.f;
          if (j < 1920) { const int grp = j / 384, c = j % 384;
              if (grp == 0) { if (k < 64) v = w2[(size_t)k * RWW + c]; }
              else if (grp == 1) { if (k >= 64 && k < 128) v = w2[(size_t)(64 + k - 64) * RWW + c]; }
              else if (grp == 2) { if (k >= 128 && k < 192) v = a2[(size_t)(k - 128) * RWW + c]; }
              else if (grp == 3) { if (k >= 192 && k < 256) v = a2[(size_t)(64 + k - 192) * RWW + c]; }
              else { if (k >= 256) v = g2[(size_t)(k - 256) * RWW + c]; } }
          wl[(size_t)j * 384 + k] = f2bf(v); } }
    { const float* w1_ = P.in[I_HW1] + (size_t)l * 33 * 64; const float* b1 = P.in[I_HB1] + l * 64; const float* w2f_ = P.in[I_HW2] + (size_t)l * 64 * 64; const float* b2 = P.in[I_HB2] + l * 64;
      const float* fqv = P.in[I_HFREQ] + l * 64; const float* w3 = P.in[I_HW3] + (size_t)l * 64 * 1024;
      const int lane = tid & 63, wv = tid >> 6;
      const float fq = fqv[lane], bb1 = b1[lane], bb2 = b2[lane];
      const ldsfp hl = vlds(lds);
      for (int task = blockIdx.x; task < 264; task += gridDim.x) {
          const int L = task < 256 ? SEQ : CTX, n0 = task < 256 ? task * 32 : (task - 256) * 32;
          __syncthreads();
#pragma unroll 1
          for (int pp = 0; pp < 4; ++pp) { const int p = wv * 4 + pp, pos = n0 + p;
              const float* w1 = w1_; const float* w2f = w2f_; asm volatile("" : "+s"(w1), "+s"(w2f));
              const float tt = (float)pos / (float)(L - 1);
              const float ang = 6.283185307179586f * (float)pos / (float)L;
              float z = 0.f;
              if (lane == 0) z = tt;
              else if (lane <= 16) { const float fr = 1e-4f + (float)(lane - 1) * ((15.0f - 1e-4f) / 15.0f); z = cosf(fr * ang); }
              else if (lane <= 32) { const float fr = 1e-4f + (float)(lane - 17) * ((15.0f - 1e-4f) / 15.0f); z = -sinf(fr * ang); }
              float a = bb1;
#pragma unroll
              for (int e = 0; e < 33; ++e) a += __shfl(z, e) * w1[e * 64 + lane];
              const float h1 = sinf(fq * a);
              float c = bb2;
#pragma unroll
              for (int i = 0; i < 64; ++i) c += __shfl(h1, i) * w2f[i * 64 + lane];
              hl[lane * 32 + p] = sinf(fq * c); }
          __syncthreads();
          float acc0[32], acc1[32];
#pragma unroll
          for (int p = 0; p < 32; ++p) { acc0[p] = 0.f; acc1[p] = 0.f; }
#pragma unroll 2
          for (int i = 0; i < 64; ++i) { const float wa = w3[(size_t)i * 1024 + tid], wb = w3[(size_t)i * 1024 + 512 + tid];
#pragma unroll
              for (int p4 = 0; p4 < 8; ++p4) { const f32x4 hv = *(const LAS f32x4*)(hl + i * 32 + p4 * 4);
                  acc0[p4 * 4 + 0] += hv.x * wa; acc0[p4 * 4 + 1] += hv.y * wa; acc0[p4 * 4 + 2] += hv.z * wa; acc0[p4 * 4 + 3] += hv.w * wa;
                  acc1[p4 * 4 + 0] += hv.x * wb; acc1[p4 * 4 + 1] += hv.y * wb; acc1[p4 * 4 + 2] += hv.z * wb; acc1[p4 * 4 + 3] += hv.w * wb; } }
          const float dl = hy_delta(tid & 255), sc = task < 256 ? (1.0f / NFFT) : 1.0f, invL = 1.0f / (float)(L - 1);
          bf16_t* dst = task < 256 ? (bf16_t*)(ws + WS_FILT) + (size_t)tid * SEQ + n0 : (bf16_t*)(ws + WS_FILTC) + (size_t)tid * CTX + n0;
          const size_t cstep = task < 256 ? (size_t)512 * SEQ : (size_t)512 * CTX;
#pragma unroll
          for (int p8 = 0; p8 < 4; ++p8) { float d[8];
#pragma unroll
              for (int k = 0; k < 8; ++k) d[k] = __expf(-((float)(n0 + p8 * 8 + k) * invL) * dl) * sc;
              u32x4 w; w.x = cvt_pk_bf16(acc0[p8 * 8 + 0] * d[0], acc0[p8 * 8 + 1] * d[1]); w.y = cvt_pk_bf16(acc0[p8 * 8 + 2] * d[2], acc0[p8 * 8 + 3] * d[3]);
              w.z = cvt_pk_bf16(acc0[p8 * 8 + 4] * d[4], acc0[p8 * 8 + 5] * d[5]); w.w = cvt_pk_bf16(acc0[p8 * 8 + 6] * d[6], acc0[p8 * 8 + 7] * d[7]);
              *(u32x4*)(dst + p8 * 8) = w;
              w.x = cvt_pk_bf16(acc1[p8 * 8 + 0] * d[0], acc1[p8 * 8 + 1] * d[1]); w.y = cvt_pk_bf16(acc1[p8 * 8 + 2] * d[2], acc1[p8 * 8 + 3] * d[3]);
              w.z = cvt_pk_bf16(acc1[p8 * 8 + 4] * d[4], acc1[p8 * 8 + 5] * d[5]); w.w = cvt_pk_bf16(acc1[p8 * 8 + 6] * d[6], acc1[p8 * 8 + 7] * d[7]);
              *(u32x4*)(dst + cstep + p8 * 8) = w; }
      }
      __syncthreads(); }
}

__device__ __forceinline__ void ph_rowpass(const Params& P, int mode, int lpost, int gate_i, int gpost_i, float ps, int lpre, int gpre_i, int shift_i, int scale_i, int nsplit) {
    const int tid = otid(), lane = tid & 63, gw = blockIdx.x * NWAVE + (tid >> 6), nw = gridDim.x * NWAVE;
    const float* modv = (const float*)(P.ws + WS_MODV);
    float* H = (float*)(P.ws + WS_H); const bf16_t* Y = (const bf16_t*)(P.ws + WS_Y); bf16_t* U = (bf16_t*)(P.ws + WS_U);
    int cur_s = -1;
    float4 A[4], Bv[4], Cv[4];
#pragma unroll
    for (int j = 0; j < 4; ++j) { A[j] = make_float4(0.f, 0.f, 0.f, 0.f); Bv[j] = A[j]; Cv[j] = A[j]; }
    for (int row = gw; row < T; row += nw) {
        const int s = row < SEQ ? 0 : (row < TL ? 1 : 2);
        if (s != cur_s) { cur_s = s;
#pragma unroll
            for (int j = 0; j < 4; ++j) { const int e = lane * 4 + 256 * j;
                if (mode != 0) { const float4 g = *(const float4*)(modv + ((size_t)lpost * 3 + s) * NMOD + gate_i * D + e); const float4 gp = *(const float4*)(P.in[I_NORMG] + ((size_t)lpost * 6 + gpost_i) * D + e);
                    A[j] = make_float4(ps * g.x * gp.x, ps * g.y * gp.y, ps * g.z * gp.z, ps * g.w * gp.w); }
                if (mode != 2) { const float4 sc = *(const float4*)(modv + ((size_t)lpre * 3 + s) * NMOD + scale_i * D + e); const float4 gq = *(const float4*)(P.in[I_NORMG] + ((size_t)lpre * 6 + gpre_i) * D + e);
                    Bv[j] = make_float4(gq.x * (1.f + sc.x), gq.y * (1.f + sc.y), gq.z * (1.f + sc.z), gq.w * (1.f + sc.w));
                    Cv[j] = *(const float4*)(modv + ((size_t)lpre * 3 + s) * NMOD + shift_i * D + e); } } }
        float4 h[4];
        if (mode == 0) { const float* src = row < TL ? P.in[I_X] + (size_t)row * D : P.in[I_CTX] + (size_t)(row - TL) * D;
#pragma unroll
            for (int j = 0; j < 4; ++j) h[j] = *(const float4*)(src + lane * 4 + 256 * j);
        } else {
            float4 y[4]; float ss = 0.f;
#pragma unroll
            for (int j = 0; j < 4; ++j) { h[j] = *(const float4*)(H + (size_t)row * D + lane * 4 + 256 * j); if (row < TL) { const u32x2 yw = *(const u32x2*)(Y + (size_t)row * D + lane * 4 + 256 * j); y[j] = make_float4(lo_bf(yw.x), hi_bf(yw.x), lo_bf(yw.y), hi_bf(yw.y)); } else { const float* yp = (const float*)(P.ws + WS_YC) + (size_t)(row - TL) * D + lane * 4 + 256 * j; float4 a = *(const float4*)yp;
                    for (int q = 1; q < nsplit; ++q) { const float4 b4 = *(const float4*)(yp + (size_t)q * TC * D); a.x += b4.x; a.y += b4.y; a.z += b4.z; a.w += b4.w; } y[j] = a; }
                ss += y[j].x * y[j].x + y[j].y * y[j].y + y[j].z * y[j].z + y[j].w * y[j].w; }
            ss = wsum(ss); const float r = rsqrtf(ss * (1.0f / D) + NORM_EPS);
#pragma unroll
            for (int j = 0; j < 4; ++j) { h[j].x += A[j].x * (y[j].x * r); h[j].y += A[j].y * (y[j].y * r); h[j].z += A[j].z * (y[j].z * r); h[j].w += A[j].w * (y[j].w * r); }
        }
        if (mode == 2) { if (row < TL) {
#pragma unroll
                for (int j = 0; j < 4; ++j) *(float4*)(P.out + (size_t)row * D + lane * 4 + 256 * j) = h[j]; }
            continue; }
        float s2 = 0.f;
#pragma unroll
        for (int j = 0; j < 4; ++j) { *(float4*)(H + (size_t)row * D + lane * 4 + 256 * j) = h[j]; s2 += h[j].x * h[j].x + h[j].y * h[j].y + h[j].z * h[j].z + h[j].w * h[j].w; }
        s2 = wsum(s2); const float r2 = rsqrtf(s2 * (1.0f / D) + NORM_EPS);
#pragma unroll
        for (int j = 0; j < 4; ++j) { u32x2 w; w.x = cvt_pk_bf16(h[j].x * r2 * Bv[j].x + Cv[j].x, h[j].y * r2 * Bv[j].y + Cv[j].y); w.y = cvt_pk_bf16(h[j].z * r2 * Bv[j].z + Cv[j].z, h[j].w * r2 * Bv[j].w + Cv[j].w);
            *(u32x2*)(U + (size_t)row * D + lane * 4 + 256 * j) = w; }
    }
}

struct EpiGU {
    static constexpr bool PERM = true, AFTER_DRAIN = false;
    bf16_t* O;
    __device__ __forceinline__ void operator()(const f32x4 (&acc)[2][2][4][2], const pg8::Unit& u, int wr, int wc, int fr, int fq) const {
        const int row0 = u.pm * 256 + wr * 64 + fr, col0 = u.pn * 128 + wc * 32 + 8 * fq;
#pragma unroll
        for (int ai = 0; ai < 2; ++ai)
#pragma unroll
            for (int m = 0; m < 4; ++m) { float o[8];
#pragma unroll
                for (int n = 0; n < 2; ++n)
#pragma unroll
                    for (int j = 0; j < 4; ++j) { const float g = acc[ai][0][m][n][j], up = acc[ai][1][m][n][j]; o[n * 4 + j] = g * __builtin_amdgcn_rcpf(1.0f + __expf(-g)) * up; }
                u32x4 w; w.x = cvt_pk_bf16(o[0], o[1]); w.y = cvt_pk_bf16(o[2], o[3]); w.z = cvt_pk_bf16(o[4], o[5]); w.w = cvt_pk_bf16(o[6], o[7]);
                *(u32x4*)(O + (size_t)(row0 + ai * 128 + m * 16) * DFF + col0) = w; }
    }
};

struct TailOrder {
    int nsplit, kp, G, c;
    __device__ void init(int K, int KP, int G_, int c_) { kp = KP; nsplit = (K / 64) / KP; G = G_; c = c_; }
    __device__ bool next(int i, pg8::Unit& u) const {
        const long L = (long)i * G + c;
        if (L < 256) { int wgid = (int)L; { const int q = 256 / 8, xcd = wgid % 8, off = wgid / 8; wgid = xcd * q + off; }
            const int nig = 8 * 4, gid = wgid / nig, fm = gid * 8; u.pm = fm + ((wgid % nig) % 8); u.pn = (wgid % nig) / 8; u.kt0 = 0; u.nkt = 0; return true; }
        const int L2 = (int)(L - 256); if (L2 >= 8 * nsplit) return false;
        const int tile = L2 / nsplit, ks = L2 % nsplit; u.pm = 64 + (tile >> 2); u.pn = tile & 3; u.kt0 = ks * kp; u.nkt = kp; return true;
    }
    __device__ __forceinline__ void a_ready(const pg8::Unit&) const {}
    __device__ __forceinline__ void done(const pg8::Unit&) const {}
};
struct EpiF32 {
    static constexpr bool PERM = true, AFTER_DRAIN = false;
    bf16_t* C; float* YC;
    __device__ __forceinline__ void operator()(const f32x4 (&acc)[2][2][4][2], const pg8::Unit& u, int wr, int wc, int fr, int fq) const {
        const int row0 = u.pm * 256 + wr * 64 + fr, col0 = u.pn * 256 + wc * 32 + 8 * fq;
        if (u.pm < 64) {
#pragma unroll
            for (int ai = 0; ai < 2; ++ai)
#pragma unroll
                for (int m = 0; m < 4; ++m) { bf16_t* rowp = C + (size_t)(row0 + ai * 128 + m * 16) * D + col0;
#pragma unroll
                    for (int bj = 0; bj < 2; ++bj) { const f32x4 v0 = acc[ai][bj][m][0], v1 = acc[ai][bj][m][1];
                        u32x4 w; w.x = cvt_pk_bf16(v0[0], v0[1]); w.y = cvt_pk_bf16(v0[2], v0[3]); w.z = cvt_pk_bf16(v1[0], v1[1]); w.w = cvt_pk_bf16(v1[2], v1[3]);
                        *(u32x4*)(rowp + bj * 128) = w; } }
        } else { float* base = YC + (size_t)(u.kt0 >> 2) * TC * D;
#pragma unroll
            for (int ai = 0; ai < 2; ++ai)
#pragma unroll
                for (int m = 0; m < 4; ++m) { float* rowp = base + (size_t)(row0 - TL + ai * 128 + m * 16) * D + col0;
#pragma unroll
                    for (int bj = 0; bj < 2; ++bj)
#pragma unroll
                        for (int n = 0; n < 2; ++n) *(f32x4*)(rowp + bj * 128 + n * 4) = acc[ai][bj][m][n]; }
        }
    }
};
template <class Epi> __device__ __forceinline__ void run_gemm_tail(LAS unsigned char* lds, const bf16_t* A, const bf16_t* Bt, int K, const Epi& E) {
    asm volatile("" : "+s"(K));
    pg8::Gemm g{A, Bt, T, D, K}; TailOrder S; S.init(K, 4, (int)gridDim.x, (int)blockIdx.x);
    pg8::gemm_phase<Epi, TailOrder>(lds, g, S, E);
    __syncthreads();
}
__device__ __forceinline__ void zero_yc(const Params& P) { float4* z = (float4*)(P.ws + WS_YC); for (int i = blockIdx.x * NTHR + otid(); i < TC * D / 4; i += gridDim.x * NTHR) z[i] = make_float4(0.f, 0.f, 0.f, 0.f); }
struct EpiWin {
    static constexpr bool PERM = true, AFTER_DRAIN = false;
    bf16_t* PHYT; bf16_t* PRW; bf16_t* PNA;
    __device__ __forceinline__ void operator()(const f32x4 (&acc)[2][2][4][2], const pg8::Unit& u, int wr, int wc, int fr, int fq) const {
        const int row0 = u.pm * 256 + wr * 64 + fr;
        if (u.pn < 3) {
#pragma unroll
            for (int bj = 0; bj < 2; ++bj) { bf16_t* cp = PHYT + (size_t)(u.pn * 256 + bj * 128 + wc * 32 + 8 * fq) * T + row0;
#pragma unroll
                for (int ai = 0; ai < 2; ++ai)
#pragma unroll
                    for (int m = 0; m < 4; ++m) { const f32x4 v0 = acc[ai][bj][m][0], v1 = acc[ai][bj][m][1]; bf16_t* rp = cp + ai * 128 + m * 16;
                        const unsigned w0 = cvt_pk_bf16(v0[0], v0[1]), w1 = cvt_pk_bf16(v0[2], v0[3]), w2 = cvt_pk_bf16(v1[0], v1[1]), w3 = cvt_pk_bf16(v1[2], v1[3]);
                        rp[0] = (bf16_t)w0; rp[(size_t)T] = (bf16_t)(w0 >> 16); rp[(size_t)2 * T] = (bf16_t)w1; rp[(size_t)3 * T] = (bf16_t)(w1 >> 16);
                        rp[(size_t)4 * T] = (bf16_t)w2; rp[(size_t)5 * T] = (bf16_t)(w2 >> 16); rp[(size_t)6 * T] = (bf16_t)w3; rp[(size_t)7 * T] = (bf16_t)(w3 >> 16); } }
            return; }
        bf16_t* base; int ld, cbase;
        if (u.pn < 9) { base = PRW; ld = RW_IN; cbase = u.pn * 256 - HY_IN; }
        else { base = PNA; ld = NA_IN; cbase = u.pn * 256 - HY_IN - RW_IN; }
        const int nbj = (u.pn == 13) ? 1 : 2;
#pragma unroll
        for (int ai = 0; ai < 2; ++ai)
#pragma unroll
            for (int m = 0; m < 4; ++m)
#pragma unroll
                for (int bj = 0; bj < 2; ++bj) { if (bj < nbj) { const f32x4 v0 = acc[ai][bj][m][0], v1 = acc[ai][bj][m][1];
                    u32x4 w; w.x = cvt_pk_bf16(v0[0], v0[1]); w.y = cvt_pk_bf16(v0[2], v0[3]); w.z = cvt_pk_bf16(v1[0], v1[1]); w.w = cvt_pk_bf16(v1[2], v1[3]);
                    *(u32x4*)(base + (size_t)(row0 + ai * 128 + m * 16) * ld + cbase + bj * 128 + wc * 32 + 8 * fq) = w; } }
    }
};
struct EpiLora {
    static constexpr bool PERM = true, AFTER_DRAIN = false;
    bf16_t* LO; bf16_t* GATE;
    __device__ __forceinline__ void operator()(const f32x4 (&acc)[2][2][4][2], const pg8::Unit& u, int wr, int wc, int fr, int fq) const {
        const int row0 = u.pm * 256 + wr * 64 + fr;
        bf16_t* base; int ld, cbase;
        if (u.pn < 6) { base = LO; ld = 1536; cbase = u.pn * 256; } else { base = GATE; ld = 384; cbase = u.pn * 256 - 1536; }
        const int nbj = (u.pn == 7) ? 1 : 2;
#pragma unroll
        for (int ai = 0; ai < 2; ++ai)
#pragma unroll
            for (int m = 0; m < 4; ++m)
#pragma unroll
                for (int bj = 0; bj < 2; ++bj) { if (bj < nbj) { const f32x4 v0 = acc[ai][bj][m][0], v1 = acc[ai][bj][m][1];
                    u32x4 w; w.x = cvt_pk_bf16(v0[0], v0[1]); w.y = cvt_pk_bf16(v0[2], v0[3]); w.z = cvt_pk_bf16(v1[0], v1[1]); w.w = cvt_pk_bf16(v1[2], v1[3]);
                    *(u32x4*)(base + (size_t)(row0 + ai * 128 + m * 16) * ld + cbase + bj * 128 + wc * 32 + 8 * fq) = w; } }
    }
};
template <class Epi> __device__ __forceinline__ void run_gemm(LAS unsigned char* lds, const bf16_t* A, const bf16_t* Bt, int M, int N, int K, const Epi& E) {
    asm volatile("" : "+s"(K));
    pg8::Gemm g{A, Bt, M, N, K}; pg8::StaticOrder S; S.init(M, N, (int)gridDim.x, (int)blockIdx.x);
    pg8::gemm_phase<Epi, pg8::StaticOrder>(lds, g, S, E);
    __syncthreads();
}

__device__ __forceinline__ void ph_loraprep(const Params& P, int l) {
    const bf16_t* PRW = (const bf16_t*)(P.ws + WS_PRW); bf16_t* AL = (bf16_t*)(P.ws + WS_ALORA);
    const float* mu = P.in[I_MU] + (size_t)l * 2 * RW_IN;
    const int gtid = blockIdx.x * NTHR + otid(), gn = gridDim.x * NTHR;
    for (int it = gtid; it < T * 48; it += gn) {
        const int row = it / 48, j8 = it % 48, col = 1152 + j8 * 8;
        bool hp, hn; row_nbrs(row, hp, hn);
        float p[8], pp[8], pn[8];
        unpack8(*(const u32x4*)(PRW + (size_t)row * RW_IN + col), p);
        if (hp) unpack8(*(const u32x4*)(PRW + (size_t)(row - 1) * RW_IN + col), pp); else {
#pragma unroll
            for (int i = 0; i < 8; ++i) pp[i] = 0.f; }
        if (hn) unpack8(*(const u32x4*)(PRW + (size_t)(row + 1) * RW_IN + col), pn); else {
#pragma unroll
            for (int i = 0; i < 8; ++i) pn[i] = 0.f; }
        float o[8];
#pragma unroll
        for (int i = 0; i < 8; ++i) { const float xs = p[i] + mu[col + i] * (pp[i] - p[i]) + mu[RW_IN + col + i] * (pn[i] - p[i]);
            o[i] = j8 < 16 ? tanhf(xs) : (j8 < 32 ? xs : sigmoidf_(xs)); }
        u32x4 w; w.x = cvt_pk_bf16(o[0], o[1]); w.y = cvt_pk_bf16(o[2], o[3]); w.z = cvt_pk_bf16(o[4], o[5]); w.w = cvt_pk_bf16(o[6], o[7]);
        *(u32x4*)(AL + (size_t)row * 384 + j8 * 8) = w;
    }
}

__device__ __forceinline__ void ph_rwkvprep(const Params& P, int l) {
    const int tid = otid(), lane = tid & 63, gw = blockIdx.x * NWAVE + (tid >> 6), nw = gridDim.x * NWAVE;
    const int nrw = nw / 6, h = gw % 6, rw0 = gw / 6;
    if (rw0 >= nrw) return;
    const bf16_t* PRW = (const bf16_t*)(P.ws + WS_PRW); const bf16_t* LO = (const bf16_t*)(P.ws + WS_LORAO);
    bf16_t* RS = (bf16_t*)(P.ws + WS_RS); bf16_t* KKS = (bf16_t*)(P.ws + WS_KKS); bf16_t* VS = (bf16_t*)(P.ws + WS_VS); bf16_t* KS = (bf16_t*)(P.ws + WS_KS); bf16_t* BS = (bf16_t*)(P.ws + WS_BS);
    float* BON = (float*)(P.ws + WS_BONUS); float* DEC = (float*)(P.ws + WS_DECAY);
    const float2* RT = (const float2*)(P.ws + WS_ROPE);
    const float* mu = P.in[I_MU] + (size_t)l * 2 * RW_IN;
    const int c = h * 64 + lane, f = lane & 15;
    const float mp0 = mu[c], mn0 = mu[RW_IN + c], mp1 = mu[384 + c], mn1 = mu[RW_IN + 384 + c], mp2 = mu[768 + c], mn2 = mu[RW_IN + 768 + c];
    const float ckk = P.in[I_KK][l * RWW + c], cka = P.in[I_KA][l * RWW + c], crk = P.in[I_RK][l * RWW + c];
    const float ca0 = P.in[I_A0][(size_t)l * 2 * RWW + c], ca1 = P.in[I_A0][(size_t)l * 2 * RWW + RWW + c], cw0 = P.in[I_W0][(size_t)l * 2 * RWW + c], cw1 = P.in[I_W0][(size_t)l * 2 * RWW + RWW + c];
    const float sg = (lane & 16) ? 1.f : -1.f;
#pragma unroll 2
    for (int row = rw0; row < T; row += nrw) {
        bool hp, hn; row_nbrs(row, hp, hn);
        const bf16_t* pr = PRW + (size_t)row * RW_IN + c; const int om = hp ? -RW_IN : 0, op = hn ? RW_IN : 0; const float fm = hp ? 1.f : 0.f, fp = hn ? 1.f : 0.f;
        const float r0 = bf2f(pr[0]), k0 = bf2f(pr[384]), v0 = bf2f(pr[768]);
        const float r = r0 + mp0 * (fm * bf2f(pr[om]) - r0) + mn0 * (fp * bf2f(pr[op]) - r0);
        const float k = k0 + mp1 * (fm * bf2f(pr[384 + om]) - k0) + mn1 * (fp * bf2f(pr[384 + op]) - k0);
        const float v = v0 + mp2 * (fm * bf2f(pr[768 + om]) - v0) + mn2 * (fp * bf2f(pr[768 + op]) - v0);
        const bf16_t* lo = LO + (size_t)row * 1536 + c;
        const float a0 = sigmoidf_(bf2f(lo[768]) + ca0), a1 = sigmoidf_(bf2f(lo[1152]) + ca1);
        const float x0 = bf2f(lo[0]) + cw0, x1 = bf2f(lo[384]) + cw1;
        const float kkr = k * ckk;
        const float nrm = sqrtf(wsum(kkr * kkr));
        const float kk = kkr / fmaxf(nrm, 1e-12f);
        float kd0 = k * (1.f + (a0 - 1.f) * cka), kd1 = k * (1.f + (a1 - 1.f) * cka);
        float b0 = kk * a0, b1 = kk * a1;
        const float bon = wsum(r * (kd0 + kd1) * crk);
        float rs = r, kks = kk;
        if (row < TL) {
            const int t = row & (SEQ - 1); const int pos = (lane < 32) ? (t >> 6) : (t & 63);
            const float2 csn = RT[pos * 16 + f]; const float cs = csn.x, sn = csn.y;
            const float r2 = __shfl_xor(rs, 16), k2 = __shfl_xor(kks, 16), d0 = __shfl_xor(kd0, 16), d1 = __shfl_xor(kd1, 16), e0 = __shfl_xor(b0, 16), e1 = __shfl_xor(b1, 16);
            rs = rs * cs + sg * r2 * sn; kks = kks * cs + sg * k2 * sn; kd0 = kd0 * cs + sg * d0 * sn; kd1 = kd1 * cs + sg * d1 * sn; b0 = b0 * cs + sg * e0 * sn; b1 = b1 * cs + sg * e1 * sn;
        }
        const size_t o = (size_t)row * 384 + c;
        DEC[o] = __expf(-0.6065306597f * sigmoidf_(x0)); DEC[(size_t)T * 384 + o] = __expf(-0.6065306597f * sigmoidf_(x1));
        if (lane == 0) BON[(size_t)row * 6 + h] = bon;
        RS[o] = f2bf(rs); KKS[o] = f2bf(-kks); VS[o] = f2bf(v);
        KS[o] = f2bf(kd0); KS[(size_t)T * 384 + o] = f2bf(kd1); BS[o] = f2bf(b0); BS[(size_t)T * 384 + o] = f2bf(b1);
    }
}

__device__ __forceinline__ int scan_row(int b, int d, int step) {
    if (step < CTX) { const int tc = d ? (CTX - 1 - step) : step; return TL + b * CTX + tc; }
    const int tl = d ? (SEQ - 1 - (step - CTX)) : (step - CTX); return b * SEQ + tl;
}
__device__ __forceinline__ void scan_task_v1(const Params& P, int task, float* sv) {
    const int lane = otid() & 63;
    const int d = task & 1, h = (task >> 1) % 6, b = task / 12;
    const float* DEC = (const float*)(P.ws + WS_DECAY) + (size_t)d * T * 384; const bf16_t* KKS = (const bf16_t*)(P.ws + WS_KKS); const bf16_t* RS = (const bf16_t*)(P.ws + WS_RS);
    const bf16_t* VS = (const bf16_t*)(P.ws + WS_VS); const bf16_t* KS = (const bf16_t*)(P.ws + WS_KS) + (size_t)d * T * 384; const bf16_t* BS = (const bf16_t*)(P.ws + WS_BS) + (size_t)d * T * 384;
    float* YD = (float*)(P.ws + WS_YDIR) + (size_t)d * T * 384;
    float S[64];
#pragma unroll
    for (int j = 0; j < 64; ++j) S[j] = 0.f;
    size_t o = (size_t)scan_row(b, d, 0) * 384 + h * 64 + lane;
    float nw_ = DEC[o], na = bf2f(KKS[o]), nb = bf2f(BS[o]), nk = bf2f(KS[o]), nr = bf2f(RS[o]), nv = bf2f(VS[o]);
    for (int step = 0; step < CTX + SEQ; ++step) {
        const float v = nv; const size_t oc = o;
        asm volatile("s_waitcnt lgkmcnt(0)" ::: "memory");
        sv[lane] = nw_; sv[64 + lane] = na; sv[128 + lane] = nb; sv[192 + lane] = nk; sv[256 + lane] = nr;
        asm volatile("s_waitcnt lgkmcnt(0)" ::: "memory");
        if (step + 1 < CTX + SEQ) { o = (size_t)scan_row(b, d, step + 1) * 384 + h * 64 + lane;
            nw_ = DEC[o]; na = bf2f(KKS[o]); nb = bf2f(BS[o]); nk = bf2f(KS[o]); nr = bf2f(RS[o]); nv = bf2f(VS[o]); }
        float sa0 = 0.f, sa1 = 0.f, sa2 = 0.f, sa3 = 0.f;
#pragma unroll
        for (int j = 0; j < 64; j += 4) { const float4 a4 = *(const float4*)(sv + 64 + j);
            sa0 += S[j + 0] * a4.x; sa1 += S[j + 1] * a4.y; sa2 += S[j + 2] * a4.z; sa3 += S[j + 3] * a4.w; }
        const float sa = (sa0 + sa1) + (sa2 + sa3);
        float y0 = 0.f, y1 = 0.f, y2 = 0.f, y3 = 0.f;
#pragma unroll
        for (int j = 0; j < 64; j += 4) {
            const float4 w4 = *(const float4*)(sv + j), b4 = *(const float4*)(sv + 128 + j), k4 = *(const float4*)(sv + 192 + j), r4 = *(const float4*)(sv + 256 + j);
            S[j + 0] = S[j + 0] * w4.x + sa * b4.x + v * k4.x; y0 += S[j + 0] * r4.x;
            S[j + 1] = S[j + 1] * w4.y + sa * b4.y + v * k4.y; y1 += S[j + 1] * r4.y;
            S[j + 2] = S[j + 2] * w4.z + sa * b4.z + v * k4.z; y2 += S[j + 2] * r4.z;
            S[j + 3] = S[j + 3] * w4.w + sa * b4.w + v * k4.w; y3 += S[j + 3] * r4.w; }
        YD[oc] = (y0 + y1) + (y2 + y3);
    }
}

__device__ __forceinline__ void natt_key(const bf16_t* PNA, size_t krow, int hoff, const float (&q)[16], float bias, float& m, float& lsum, float (&o)[16]) {
    const bf16_t* kp = PNA + krow * NA_IN + 384 + hoff; const bf16_t* vp = PNA + krow * NA_IN + 768 + hoff;
    float s = 0.f;
#pragma unroll
    for (int j8 = 0; j8 < 2; ++j8) { float kf[8]; unpack8(*(const u32x4*)(kp + j8 * 8), kf);
#pragma unroll
        for (int i = 0; i < 8; ++i) s += q[j8 * 8 + i] * kf[i]; }
    s += __shfl_xor(s, 1); s += __shfl_xor(s, 2); s += bias;
    const float mn = fmaxf(m, s), corr = __expf(m - mn), p = __expf(s - mn);
    m = mn; lsum = lsum * corr + p;
#pragma unroll
    for (int j8 = 0; j8 < 2; ++j8) { float vf[8]; unpack8(*(const u32x4*)(vp + j8 * 8), vf);
#pragma unroll
        for (int i = 0; i < 8; ++i) o[j8 * 8 + i] = o[j8 * 8 + i] * corr + p * vf[i]; }
}
__device__ __forceinline__ void natten_items_v1(const Params& P, int l, int wid0, int nworkers) {
    const bf16_t* PNA = (const bf16_t*)(P.ws + WS_PNA); bf16_t* MIX = (bf16_t*)(P.ws + WS_U);
    const float* rpb = P.in[I_RPB] + (size_t)l * 6 * 15 * 31;
    const int sub = wid0 & 3;
    for (int it = wid0 >> 2; it < T * 6; it += nworkers >> 2) {
        const int row = it % T, h = it / T, hoff = h * 64 + sub * 16;
        float q[16], o[16];
#pragma unroll
        for (int j8 = 0; j8 < 2; ++j8) { float qf[8]; unpack8(*(const u32x4*)(PNA + (size_t)row * NA_IN + hoff + j8 * 8), qf);
#pragma unroll
            for (int i = 0; i < 8; ++i) { q[j8 * 8 + i] = qf[i] * 0.125f; o[j8 * 8 + i] = 0.f; } }
        float m = -3.0e38f, lsum = 0.f;
        int b;
        if (row < TL) { b = row >> 13; const int t = row & (SEQ - 1), i = t >> 6, col = t & 63;
            const int start = min(max(i - 4, 0), 120), win0 = min(max(col - 8, 0), 48);
            for (int r = 0; r < 8; ++r) for (int kc = win0; kc < win0 + 16; ++kc) {
                const float bias = rpb[(h * 15 + (start + r - i + 7)) * 31 + (kc - col + 15)];
                natt_key(PNA, (size_t)b * SEQ + (start + r) * 64 + kc, hoff, q, bias, m, lsum, o); }
        } else b = (row - TL) >> 8;
        for (int c = 0; c < CTX; ++c) natt_key(PNA, (size_t)TL + b * CTX + c, hoff, q, 0.f, m, lsum, o);
        const float il = 1.0f / lsum;
#pragma unroll
        for (int j8 = 0; j8 < 2; ++j8) { u32x4 w; w.x = cvt_pk_bf16(o[j8 * 8 + 0] * il, o[j8 * 8 + 1] * il); w.y = cvt_pk_bf16(o[j8 * 8 + 2] * il, o[j8 * 8 + 3] * il);
            w.z = cvt_pk_bf16(o[j8 * 8 + 4] * il, o[j8 * 8 + 5] * il); w.w = cvt_pk_bf16(o[j8 * 8 + 6] * il, o[j8 * 8 + 7] * il);
            *(u32x4*)(MIX + (size_t)row * D + 640 + hoff + j8 * 8) = w; }
    }
}

__device__ __forceinline__ void vt_tile(const Params& P, int tile, unsigned short* tl  ) {
    const int tid = otid();
    const bf16_t* PNA = (const bf16_t*)(P.ws + WS_PNA);
    int h, tok0; bf16_t* dst; int ldt;
    if (tile < NB * 128 * 6) { h = tile % 6; const int sb = tile / 6; const int b = sb >> 7, blk = sb & 127; tok0 = b * SEQ + blk * 64; dst = (bf16_t*)(P.ws + WS_VTL) + ((size_t)(b * 6 + h) * 64) * SEQ + blk * 64; ldt = SEQ; }
    else { const int tt = tile - NB * 128 * 6; h = tt % 6; const int sb = tt / 6; const int b = sb >> 2, blk = sb & 3; tok0 = TL + b * CTX + blk * 64; dst = (bf16_t*)(P.ws + WS_VTC) + ((size_t)(b * 6 + h) * 64) * CTX + blk * 64; ldt = CTX; }
    { const int tok = tid >> 3, seg = tid & 7; const u32x4 v = *(const u32x4*)(PNA + (size_t)(tok0 + tok) * NA_IN + 768 + h * 64 + seg * 8);
      unsigned* w = (unsigned*)(tl + tok * 72 + seg * 8); w[0] = v.x; w[1] = v.y; w[2] = v.z; w[3] = v.w; }
    __syncthreads();
    { const int hd = tid >> 3, ts = tid & 7; unsigned short e[8];
#pragma unroll
      for (int k = 0; k < 8; ++k) e[k] = tl[(ts * 8 + k) * 72 + hd];
      u32x4 w; w.x = (unsigned)e[0] | ((unsigned)e[1] << 16); w.y = (unsigned)e[2] | ((unsigned)e[3] << 16); w.z = (unsigned)e[4] | ((unsigned)e[5] << 16); w.w = (unsigned)e[6] | ((unsigned)e[7] << 16);
      *(u32x4*)(dst + (size_t)hd * ldt + ts * 8) = w; }
    __syncthreads();
}
constexpr int NAT_LAT_TASKS = NB * 128 * 4 * 6, NAT_CTX_TASKS = NB * 16 * 6, NAT_TASKS = NAT_LAT_TASKS + NAT_CTX_TASKS;
__device__ __forceinline__ void natten_task(const Params& P, int l, int task) {
    using pg8::bf16x8;
    const int lane = otid() & 63, fr = lane & 15, fq = lane >> 4;
    const bf16_t* PNA = (const bf16_t*)(P.ws + WS_PNA); bf16_t* MIX = (bf16_t*)(P.ws + WS_U);
    const bool lat = task < NAT_LAT_TASKS;
    int b, h, i = 0, n = 0, qtok0;
    if (lat) { h = task % 6; const int r = task / 6; n = r & 3; i = (r >> 2) & 127; b = r >> 9; qtok0 = b * SEQ + i * 64 + 16 * n; }
    else { const int tt = task - NAT_LAT_TASKS; h = tt % 6; const int qb = (tt / 6) & 15; b = tt / 96; qtok0 = TL + b * CTX + 16 * qb; }
    const int start = min(max(i - 4, 0), 120), band0 = min(max(16 * n - 8, 0), 32);
    const int col = 16 * n + fr, win0 = min(max(col - 8, 0), 48);
    bf16x8 bq[2];
#pragma unroll
    for (int kh = 0; kh < 2; ++kh) bq[kh] = *(const bf16x8*)(PNA + (size_t)(qtok0 + fr) * NA_IN + h * 64 + kh * 32 + fq * 8);
    f32x4 sc[32];
    if (lat) {
#pragma unroll
        for (int t = 0; t < 16; ++t) { const int tok0 = b * SEQ + (start + (t >> 1)) * 64 + band0 + 16 * (t & 1);
            const bf16_t* kp = PNA + (size_t)(tok0 + fr) * NA_IN + 384 + h * 64 + fq * 8;
            const bf16x8 k0 = *(const bf16x8*)kp, k1 = *(const bf16x8*)(kp + 32);
            f32x4 a = (f32x4){0.f, 0.f, 0.f, 0.f};
            a = __builtin_amdgcn_mfma_f32_16x16x32_bf16(k0, bq[0], a, 0, 0, 0); a = __builtin_amdgcn_mfma_f32_16x16x32_bf16(k1, bq[1], a, 0, 0, 0);
            sc[t] = a; if ((t & 3) == 3) asm volatile("" ::: "memory"); }
    } else {
#pragma unroll
        for (int t = 0; t < 16; ++t) sc[t] = (f32x4){-3.0e38f, -3.0e38f, -3.0e38f, -3.0e38f};
    }
#pragma unroll
    for (int t = 16; t < 32; ++t) { const int tok0 = TL + b * CTX + 16 * (t - 16);
        const bf16_t* kp = PNA + (size_t)(tok0 + fr) * NA_IN + 384 + h * 64 + fq * 8;
        const bf16x8 k0 = *(const bf16x8*)kp, k1 = *(const bf16x8*)(kp + 32);
        f32x4 a = (f32x4){0.f, 0.f, 0.f, 0.f};
        a = __builtin_amdgcn_mfma_f32_16x16x32_bf16(k0, bq[0], a, 0, 0, 0); a = __builtin_amdgcn_mfma_f32_16x16x32_bf16(k1, bq[1], a, 0, 0, 0);
        sc[t] = a * 0.125f; if ((t & 3) == 3) asm volatile("" ::: "memory"); }
    if (lat) { const float* rpb = P.in[I_RPB] + ((size_t)l * 6 + h) * 15 * 31;
#pragma unroll
        for (int t = 0; t < 16; ++t) { const int ro = start + (t >> 1) - i + 7; const int kc0 = band0 + 16 * (t & 1) + fq * 4;
#pragma unroll
            for (int j = 0; j < 4; ++j) { const int kc = kc0 + j; const bool ok = kc >= win0 && kc < win0 + 16; const int co = min(max(kc - col + 15, 0), 30);
                const float bias = rpb[ro * 31 + co]; sc[t][j] = ok ? sc[t][j] * 0.125f + bias : -3.0e38f; } } }
    float mx = -3.0e38f;
#pragma unroll
    for (int t = 0; t < 32; ++t) mx = fmaxf(mx, fmaxf(fmaxf(sc[t][0], sc[t][1]), fmaxf(sc[t][2], sc[t][3])));
    mx = fmaxf(mx, __shfl_xor(mx, 16)); mx = fmaxf(mx, __shfl_xor(mx, 32));
    float sum = 0.f;
#pragma unroll
    for (int t = 0; t < 32; ++t) {
#pragma unroll
        for (int j = 0; j < 4; ++j) { const float p = __expf(sc[t][j] - mx); sc[t][j] = p; sum += p; } }
    sum += __shfl_xor(sum, 16); sum += __shfl_xor(sum, 32);
    const float inv = 1.0f / sum;
    f32x4 ot[4];
#pragma unroll
    for (int q = 0; q < 4; ++q) ot[q] = (f32x4){0.f, 0.f, 0.f, 0.f};
    const bf16_t* VTL = (const bf16_t*)(P.ws + WS_VTL) + ((size_t)(b * 6 + h) * 64) * SEQ; const bf16_t* VTC = (const bf16_t*)(P.ws + WS_VTC) + ((size_t)(b * 6 + h) * 64) * CTX;
    if (lat) {
#pragma unroll
        for (int m = 0; m < 8; ++m) { const int tk = (start + m) * 64 + band0 + fq * 4;
            u32x4 pw; pw.x = cvt_pk_bf16(sc[2 * m][0], sc[2 * m][1]); pw.y = cvt_pk_bf16(sc[2 * m][2], sc[2 * m][3]); pw.z = cvt_pk_bf16(sc[2 * m + 1][0], sc[2 * m + 1][1]); pw.w = cvt_pk_bf16(sc[2 * m + 1][2], sc[2 * m + 1][3]);
            const bf16x8 pb = __builtin_bit_cast(bf16x8, pw);
#pragma unroll
            for (int q = 0; q < 4; ++q) { const bf16_t* vp = VTL + (size_t)(q * 16 + fr) * SEQ + tk; const u32x2 v0 = *(const u32x2*)vp, v1 = *(const u32x2*)(vp + 16);
                u32x4 vw; vw.x = v0.x; vw.y = v0.y; vw.z = v1.x; vw.w = v1.y;
                ot[q] = __builtin_amdgcn_mfma_f32_16x16x32_bf16(__builtin_bit_cast(bf16x8, vw), pb, ot[q], 0, 0, 0); }
            if (m & 1) asm volatile("" ::: "memory"); }
    }
#pragma unroll
    for (int m = 0; m < 8; ++m) { const int tk = 32 * m + fq * 4;
        u32x4 pw; pw.x = cvt_pk_bf16(sc[16 + 2 * m][0], sc[16 + 2 * m][1]); pw.y = cvt_pk_bf16(sc[16 + 2 * m][2], sc[16 + 2 * m][3]); pw.z = cvt_pk_bf16(sc[17 + 2 * m][0], sc[17 + 2 * m][1]); pw.w = cvt_pk_bf16(sc[17 + 2 * m][2], sc[17 + 2 * m][3]);
        const bf16x8 pb = __builtin_bit_cast(bf16x8, pw);
#pragma unroll
        for (int q = 0; q < 4; ++q) { const bf16_t* vp = VTC + (size_t)(q * 16 + fr) * CTX + tk; const u32x2 v0 = *(const u32x2*)vp, v1 = *(const u32x2*)(vp + 16);
            u32x4 vw; vw.x = v0.x; vw.y = v0.y; vw.z = v1.x; vw.w = v1.y;
            ot[q] = __builtin_amdgcn_mfma_f32_16x16x32_bf16(__builtin_bit_cast(bf16x8, vw), pb, ot[q], 0, 0, 0); }
        if (m & 1) asm volatile("" ::: "memory"); }
#pragma unroll
    for (int q = 0; q < 4; ++q) { u32x2 w; w.x = cvt_pk_bf16(ot[q][0] * inv, ot[q][1] * inv); w.y = cvt_pk_bf16(ot[q][2] * inv, ot[q][3] * inv);
        *(u32x2*)(MIX + (size_t)(qtok0 + fr) * D + 640 + h * 64 + q * 16 + fq * 4) = w; }
}

__device__ __forceinline__ void fft_fwd(float2* X) {
#pragma unroll 1
    for (int lq = 12; lq >= 0; lq -= 2) { const int q = 1 << lq; const float rq = 1.0f / (float)(4 * q);
        for (int j = otid(); j < NFFT / 4; j += NTHR) { const int lo = j & (q - 1), base = ((j >> lq) << (lq + 2)) | lo;
            const float2 x0 = X[base], x1 = X[base + q], x2 = X[base + 2 * q], x3 = X[base + 3 * q];
            const float fr = (float)lo * rq; const float c = __builtin_amdgcn_cosf(fr), s = __builtin_amdgcn_sinf(fr), c2 = c * c - s * s, s2 = 2.f * c * s;
            const float a0x = x0.x + x2.x, a0y = x0.y + x2.y, dx = x0.x - x2.x, dy = x0.y - x2.y;
            const float a2x = dx * c + dy * s, a2y = dy * c - dx * s;
            const float a1x = x1.x + x3.x, a1y = x1.y + x3.y, ex = x1.x - x3.x, ey = x1.y - x3.y;
            const float mx = ex * c + ey * s, my = ey * c - ex * s;
            const float a3x = my, a3y = -mx;
            const float fx = a0x - a1x, fy = a0y - a1y, gx = a2x - a3x, gy = a2y - a3y;
            X[base] = make_float2(a0x + a1x, a0y + a1y); X[base + q] = make_float2(fx * c2 + fy * s2, fy * c2 - fx * s2);
            X[base + 2 * q] = make_float2(a2x + a3x, a2y + a3y); X[base + 3 * q] = make_float2(gx * c2 + gy * s2, gy * c2 - gx * s2); }
        __syncthreads(); }
}
__device__ __forceinline__ void fft_inv(float2* X) {
#pragma unroll 1
    for (int lq = 0; lq <= 12; lq += 2) { const int q = 1 << lq; const float rq = 1.0f / (float)(4 * q);
        for (int j = otid(); j < NFFT / 4; j += NTHR) { const int lo = j & (q - 1), base = ((j >> lq) << (lq + 2)) | lo;
            const float2 y0 = X[base], y1 = X[base + q], y2 = X[base + 2 * q], y3 = X[base + 3 * q];
            const float fr = (float)lo * rq; const float c = __builtin_amdgcn_cosf(fr), s = __builtin_amdgcn_sinf(fr), c2 = c * c - s * s, s2 = 2.f * c * s;
            const float tx = y1.x * c2 - y1.y * s2, ty = y1.x * s2 + y1.y * c2;
            const float a0x = y0.x + tx, a0y = y0.y + ty, a1x = y0.x - tx, a1y = y0.y - ty;
            const float ux = y3.x * c2 - y3.y * s2, uy = y3.x * s2 + y3.y * c2;
            const float a2x = y2.x + ux, a2y = y2.y + uy, a3x = y2.x - ux, a3y = y2.y - uy;
            const float vx = a2x * c - a2y * s, vy = a2x * s + a2y * c;
            const float mx = a3x * c - a3y * s, my = a3x * s + a3y * c;
            const float wx = -my, wy = mx;
            X[base] = make_float2(a0x + vx, a0y + vy); X[base + 2 * q] = make_float2(a0x - vx, a0y - vy);
            X[base + q] = make_float2(a1x + wx, a1y + wy); X[base + 3 * q] = make_float2(a1x - wx, a1y - wy); }
        __syncthreads(); }
}
__device__ __forceinline__ float hy_delta(int c) { const float lo = -4.605170185988091f / 1.5f, hi = -4.605170185988091f / 0.3f; return fabsf(lo + (float)c * ((hi - lo) / 255.0f)); }
__device__ __forceinline__ float hy_short(const bf16_t* PHYT, const float* cw, const float* cb, int row, int col) {
    bool hp, hn; row_nbrs(row, hp, hn);
    const bf16_t* p = PHYT + (size_t)col * T + row;
    float v = cb[col] + cw[HY_IN + col] * bf2f(p[0]);
    if (hp) v += cw[col] * bf2f(p[-1]);
    if (hn) v += cw[2 * HY_IN + col] * bf2f(p[1]);
    return v;
}
struct HyTap { float w0, w1, w2, b; };
__device__ __forceinline__ HyTap hy_tap(const float* cw, const float* cb, int col) { HyTap t; t.w0 = cw[col]; t.w1 = cw[HY_IN + col]; t.w2 = cw[2 * HY_IN + col]; t.b = cb[col]; return t; }
__device__ __forceinline__ float hy_lat(const bf16_t* colp, int b, int n, const HyTap t) {
    const bf16_t* p = colp + b * SEQ + n;
    const float xm = bf2f(p[n > 0 ? -1 : 0]), x0 = bf2f(p[0]), xp = bf2f(p[n < SEQ - 1 ? 1 : 0]);
    return t.b + t.w1 * x0 + (n > 0 ? t.w0 * xm : 0.f) + (n < SEQ - 1 ? t.w2 * xp : 0.f);
}
__device__ __forceinline__ void hy_spec_task(const Params& P, int l, int c, float2* X) {
    const int tid = otid();
    const bf16_t* f0 = (const bf16_t*)(P.ws + WS_FILT) + (size_t)c * SEQ; const bf16_t* b0 = f0 + (size_t)256 * SEQ; const bf16_t* f1 = f0 + (size_t)512 * SEQ; const bf16_t* b1 = f0 + (size_t)768 * SEQ;
    for (int n = tid; n < SEQ; n += NTHR) {
        X[n] = make_float2(bf2f(f0[n]), bf2f(f1[n]));
        if (n > 0) X[NFFT - n] = make_float2(bf2f(b0[n]), bf2f(b1[n])); else X[SEQ] = make_float2(0.f, 0.f); }
    __syncthreads();
    fft_fwd(X);
    float2* spec = (float2*)(P.ws + WS_SPEC) + (size_t)c * NFFT;
    for (int i = tid; i < NFFT; i += NTHR) spec[i] = X[i];
    __syncthreads();
}
__device__ __forceinline__ void hy_conv_core(const Params& P, int o, int c, float2* X) {
    fft_fwd(X);
    const float2* spec = (const float2*)(P.ws + WS_SPEC) + (size_t)c * NFFT;
    for (int i = otid(); i < NFFT; i += NTHR) {
        const unsigned f = __brev((unsigned)i) >> 18;
        const unsigned ip = __brev(((unsigned)NFFT - f) & (unsigned)(NFFT - 1)) >> 18;
        const float2 a = X[i], w = spec[i], w2 = spec[ip];
        const float kx = o == 0 ? 0.5f * (w.x + w2.x) : 0.5f * (w.y + w2.y), ky = o == 0 ? 0.5f * (w.y - w2.y) : -0.5f * (w.x - w2.x);
        X[i] = make_float2(a.x * kx - a.y * ky, a.x * ky + a.y * kx); }
    __syncthreads();
    fft_inv(X);
}
__device__ __forceinline__ void hy_task1(const Params& P, int l, int c, float2* X, float* ex) {
    const int tid = otid();
    const bf16_t* PHY = (const bf16_t*)(P.ws + WS_PHY); const float* cw = P.in[I_HCW] + (size_t)l * 3 * HY_IN; const float* cb = P.in[I_HCB] + (size_t)l * HY_IN;
    const float bias0 = P.in[I_HBIAS][(size_t)l * 2 * HYC + c], bias1 = P.in[I_HBIAS][(size_t)l * 2 * HYC + HYC + c];
    const HyTap tv = hy_tap(cw, cb, c), tg1 = hy_tap(cw, cb, HYC + c); const bf16_t* colv = PHY + (size_t)c * T; const bf16_t* colg1 = PHY + (size_t)(HYC + c) * T;
#pragma unroll 4
    for (int n = tid; n < SEQ; n += NTHR) { X[n] = make_float2(hy_lat(colv, 0, n, tv), hy_lat(colv, 1, n, tv)); X[SEQ + n] = make_float2(0.f, 0.f); }
    __syncthreads();
    hy_conv_core(P, 0, c, X);
    float* Z1 = (float*)(P.ws + WS_Z1) + (size_t)c * NB * SEQ;
#pragma unroll 4
    for (int n = tid; n < SEQ; n += NTHR) { const float2 y = X[n];
        const float v0 = hy_lat(colv, 0, n, tv), v1 = hy_lat(colv, 1, n, tv), g0 = hy_lat(colg1, 0, n, tg1), g1 = hy_lat(colg1, 1, n, tg1);
        Z1[n] = g0 * (y.x + bias0 * v0); Z1[SEQ + n] = g1 * (y.y + bias0 * v1); }
    __syncthreads();
    float* f = (float*)X;
    float* vv = f, *x1 = f + 512, *x2 = f + 1024, *hf = f + 1536  , *z1 = f + 2560;
    const bf16_t* fc = (const bf16_t*)(P.ws + WS_FILTC);
    { const int b = tid >> 8, t = tid & 255, row = TL + b * CTX + t;
      vv[tid] = hy_short(PHY, cw, cb, row, c); x1[tid] = hy_short(PHY, cw, cb, row, HYC + c); x2[tid] = hy_short(PHY, cw, cb, row, 2 * HYC + c);
      for (int q = tid; q < 1024; q += NTHR) { const int od = q >> 8, n = q & 255; hf[q] = bf2f(fc[(size_t)(od * 256 + c) * CTX + n]); } }
    __syncthreads();
    { const int b = tid >> 8, t = tid & 255; float y = bias0 * vv[tid];
      for (int s = 0; s <= t; ++s) y += hf[t - s] * vv[b * 256 + s];
      for (int s = t + 1; s < CTX; ++s) y += hf[256 + s - t] * vv[b * 256 + s];
      z1[tid] = x1[tid] * y; }
    __syncthreads();
    { const int b = tid >> 8, t = tid & 255; float y = bias1 * z1[tid];
      for (int s = 0; s <= t; ++s) y += hf[512 + t - s] * z1[b * 256 + s];
      for (int s = t + 1; s < CTX; ++s) y += hf[768 + s - t] * z1[b * 256 + s];
      bf16_t* MIX = (bf16_t*)(P.ws + WS_U); MIX[(size_t)(TL + b * CTX + t) * D + c] = f2bf(x2[tid] * y); }
    __syncthreads();
}
__device__ __forceinline__ void hy_task2(const Params& P, int l, int c, float2* X) {
    const int tid = otid();
    const bf16_t* PHY = (const bf16_t*)(P.ws + WS_PHY); const float* cw = P.in[I_HCW] + (size_t)l * 3 * HY_IN; const float* cb = P.in[I_HCB] + (size_t)l * HY_IN;
    const float bias1 = P.in[I_HBIAS][(size_t)l * 2 * HYC + HYC + c];
    const float* Z1 = (const float*)(P.ws + WS_Z1) + (size_t)c * NB * SEQ; float* Z1w = (float*)(P.ws + WS_Z1) + (size_t)c * NB * SEQ;
    for (int n = tid; n < SEQ; n += NTHR) { X[n] = make_float2(Z1[n], Z1[SEQ + n]); X[SEQ + n] = make_float2(0.f, 0.f); }
    __syncthreads();
    hy_conv_core(P, 1, c, X);
    bf16_t* MIX = (bf16_t*)(P.ws + WS_U);
    const HyTap tg2 = hy_tap(cw, cb, 2 * HYC + c); const bf16_t* colg2 = PHY + (size_t)(2 * HYC + c) * T;
#pragma unroll 4
    for (int n = tid; n < SEQ; n += NTHR) { const float2 y = X[n];
        const float g0 = hy_lat(colg2, 0, n, tg2), g1 = hy_lat(colg2, 1, n, tg2);
        Z1w[n] = g0 * (y.x + bias1 * Z1[n]); Z1w[SEQ + n] = g1 * (y.y + bias1 * Z1[SEQ + n]); }
    __syncthreads();
}

constexpr int SEGC = 256, NSEG = 33, SCH = 4;
typedef float f32x2v __attribute__((ext_vector_type(2)));
template <bool IDENT>
__device__ __forceinline__ void scan_seg(const Params& P, int chain, int g, float* ring_  ) {
    const ldsfp ring = vlds(ring_);
    const int lane = otid() & 63;
    const int d = chain & 1, h = (chain >> 1) % 6, b = chain / 12;
    const float* DEC = (const float*)(P.ws + WS_DECAY) + (size_t)d * T * 384; const bf16_t* KKS = (const bf16_t*)(P.ws + WS_KKS); const bf16_t* RS = (const bf16_t*)(P.ws + WS_RS);
    const bf16_t* VS = (const bf16_t*)(P.ws + WS_VS); const bf16_t* KS = (const bf16_t*)(P.ws + WS_KS) + (size_t)d * T * 384; const bf16_t* BS = (const bf16_t*)(P.ws + WS_BS) + (size_t)d * T * 384;
    float* YD = (float*)(P.ws + WS_YDIR) + (size_t)d * T * 384;
    bf16_t* E = (bf16_t*)(P.ws + WS_E) + (size_t)chain * SEQ * 64;
    const int step0 = g == 0 ? 0 : CTX + (g - 1) * SEGC;
    f32x2v S0[32], S1[32];
#pragma unroll
    for (int j = 0; j < 32; ++j) { S0[j] = (f32x2v){0.f, 0.f}; S1[j] = (f32x2v){(2 * j == lane) ? 1.f : 0.f, (2 * j + 1 == lane) ? 1.f : 0.f}; }
    float pw[SCH], pa[SCH], pb[SCH], pk[SCH], pr[SCH], pv[SCH]; int po[SCH];
#pragma unroll
    for (int s = 0; s < SCH; ++s) { const int o = scan_row(b, d, step0 + s) * 384 + h * 64 + lane; po[s] = o;
        pw[s] = DEC[o]; pa[s] = bf2f(KKS[o]); pb[s] = bf2f(BS[o]); pk[s] = bf2f(KS[o]); pr[s] = bf2f(RS[o]); pv[s] = bf2f(VS[o]); }
    for (int c = 0; c < SEGC / SCH; ++c) {
        float cv[SCH]; int co[SCH];
        asm volatile("s_waitcnt lgkmcnt(0)" ::: "memory");
#pragma unroll
        for (int s = 0; s < SCH; ++s) { const ldsfp sv = ring + s * 320; sv[lane] = pw[s]; sv[64 + lane] = pa[s]; sv[128 + lane] = pb[s]; sv[192 + lane] = pk[s]; sv[256 + lane] = pr[s]; cv[s] = pv[s]; co[s] = po[s]; }
        asm volatile("s_waitcnt lgkmcnt(0)" ::: "memory");
        if (c + 1 < SEGC / SCH) {
#pragma unroll
            for (int s = 0; s < SCH; ++s) { const int o = scan_row(b, d, step0 + (c + 1) * SCH + s) * 384 + h * 64 + lane; po[s] = o;
                pw[s] = DEC[o]; pa[s] = bf2f(KKS[o]); pb[s] = bf2f(BS[o]); pk[s] = bf2f(KS[o]); pr[s] = bf2f(RS[o]); pv[s] = bf2f(VS[o]); } }
#pragma unroll
        for (int s = 0; s < SCH; ++s) { const ldsfp sv = ring + s * 320;
            f32x2v sa2 = (f32x2v){0.f, 0.f}, sb2 = (f32x2v){0.f, 0.f}, sa3 = sa2, sb3 = sa2;
#pragma unroll
            for (int hb = 0; hb < 2; ++hb) { f32x4 A[8];
#pragma unroll
                for (int i = 0; i < 8; ++i) A[i] = *(const LAS f32x4*)(sv + 64 + hb * 32 + 4 * i);
                __builtin_amdgcn_sched_barrier(0);
#pragma unroll
                for (int i = 0; i < 8; ++i) { const int jj = hb * 16 + 2 * i; const f32x2v alo = (f32x2v){A[i].x, A[i].y}, ahi = (f32x2v){A[i].z, A[i].w};
                    sa2 += S0[jj] * alo; sa3 += S0[jj + 1] * ahi;
                    if (IDENT) { sb2 += S1[jj] * alo; sb3 += S1[jj + 1] * ahi; } }
                __builtin_amdgcn_sched_barrier(0); }
            const float sa = (sa2.x + sa2.y) + (sa3.x + sa3.y), sb = (sb2.x + sb2.y) + (sb3.x + sb3.y);
            const f32x2v saa = (f32x2v){sa, sa}, sbb = (f32x2v){sb, sb}, vv = (f32x2v){cv[s], cv[s]};
            f32x2v y2 = (f32x2v){0.f, 0.f}, y3 = y2, e2 = y2, e3 = y2;
#pragma unroll
            for (int ch = 0; ch < 8; ++ch) { f32x4 W[2], Bq[2], K[2], R[2];
#pragma unroll
                for (int i = 0; i < 2; ++i) { const int j = ch * 8 + 4 * i; W[i] = *(const LAS f32x4*)(sv + j); Bq[i] = *(const LAS f32x4*)(sv + 128 + j); K[i] = *(const LAS f32x4*)(sv + 192 + j); R[i] = *(const LAS f32x4*)(sv + 256 + j); }
                __builtin_amdgcn_sched_barrier(0);
#pragma unroll
                for (int i = 0; i < 2; ++i) { const int jj = ch * 4 + 2 * i;
                    const f32x2v wlo = (f32x2v){W[i].x, W[i].y}, whi = (f32x2v){W[i].z, W[i].w}, blo = (f32x2v){Bq[i].x, Bq[i].y}, bhi = (f32x2v){Bq[i].z, Bq[i].w};
                    const f32x2v klo = (f32x2v){K[i].x, K[i].y}, khi = (f32x2v){K[i].z, K[i].w}, rlo = (f32x2v){R[i].x, R[i].y}, rhi = (f32x2v){R[i].z, R[i].w};
                    S0[jj] = S0[jj] * wlo + saa * blo + vv * klo; y2 += S0[jj] * rlo;
                    S0[jj + 1] = S0[jj + 1] * whi + saa * bhi + vv * khi; y3 += S0[jj + 1] * rhi;
                    if (IDENT) { S1[jj] = S1[jj] * wlo + sbb * blo; e2 += S1[jj] * rlo; S1[jj + 1] = S1[jj + 1] * whi + sbb * bhi; e3 += S1[jj + 1] * rhi; } }
                __builtin_amdgcn_sched_barrier(0); }
            YD[co[s]] = (y2.x + y2.y) + (y3.x + y3.y);
            if (IDENT) { const int tl = d ? (SEQ - 1 - (step0 - CTX + c * SCH + s)) : (step0 - CTX + c * SCH + s); E[(size_t)tl * 64 + lane] = f2bf((e2.x + e2.y) + (e3.x + e3.y)); }
        }
    }
    float* ZP = (float*)(P.ws + WS_ZP) + ((size_t)chain * NSEG + g) * 2 * 4096;
#pragma unroll
    for (int j = 0; j < 32; j += 2) { *(float4*)(ZP + lane * 64 + 2 * j) = make_float4(S0[j].x, S0[j].y, S0[j + 1].x, S0[j + 1].y);
        if (IDENT) *(float4*)(ZP + 4096 + lane * 64 + 2 * j) = make_float4(S1[j].x, S1[j].y, S1[j + 1].x, S1[j + 1].y); }
}
typedef float f32x16 __attribute__((ext_vector_type(16)));
__device__ __forceinline__ void scan_combine(const Params& P, int chain, float* lds) {
    const int tid = otid(), lane = tid & 63, wv = tid >> 6, li = lane & 31, lh = lane >> 5;
    const ldsfp Sl = vlds(lds);
    const ldsfp Pl = Sl + 64 * 65;
    float* ZPc = (float*)(P.ws + WS_ZP) + (size_t)chain * NSEG * 2 * 4096;
    const int ti = (wv >> 1) & 1, tj = wv & 1;
    float pn[8];
#pragma unroll
    for (int q = 0; q < 8; ++q) { pn[q] = ZPc[(size_t)2 * 4096 + 4096 + tid * 8 + q]; Sl[(tid >> 3) * 65 + (tid & 7) * 8 + q] = ZPc[tid * 8 + q]; }
    f32x16 acc, zn;
#pragma unroll
    for (int r = 0; r < 16; ++r) { zn[r] = 0.f; acc[r] = 0.f; }
    if (wv < 4) {
#pragma unroll
        for (int r = 0; r < 16; ++r) zn[r] = ZPc[(size_t)2 * 4096 + (32 * ti + (r & 3) + 8 * (r >> 2) + 4 * lh) * 64 + 32 * tj + li]; }
    for (int g = 1; g < NSEG - 1; ++g) {
        __syncthreads();
        if (g > 1 && wv < 4) {
#pragma unroll
            for (int r = 0; r < 16; ++r) Sl[(32 * ti + (r & 3) + 8 * (r >> 2) + 4 * lh) * 65 + 32 * tj + li] = acc[r]; }
#pragma unroll
        for (int q = 0; q < 8; ++q) Pl[tid * 8 + q] = pn[q];
        acc = zn;
        if (g + 1 < NSEG - 1) { const float* nx = ZPc + (size_t)(g + 1) * 2 * 4096;
#pragma unroll
            for (int q = 0; q < 8; ++q) pn[q] = nx[4096 + tid * 8 + q];
            if (wv < 4) {
#pragma unroll
                for (int r = 0; r < 16; ++r) zn[r] = nx[(32 * ti + (r & 3) + 8 * (r >> 2) + 4 * lh) * 64 + 32 * tj + li]; } }
        __syncthreads();
        if (wv < 4) {
#pragma unroll 8
            for (int k0 = 0; k0 < 64; k0 += 2) { const float av = Sl[(32 * ti + li) * 65 + k0 + lh], bv = Pl[(k0 + lh) * 64 + 32 * tj + li];
                acc = __builtin_amdgcn_mfma_f32_32x32x2f32(av, bv, acc, 0, 0, 0); }
            float* Zg = ZPc + (size_t)g * 2 * 4096;
#pragma unroll
            for (int r = 0; r < 16; ++r) Zg[(32 * ti + (r & 3) + 8 * (r >> 2) + 4 * lh) * 64 + 32 * tj + li] = acc[r]; }
    }
    __syncthreads();
}

__device__ __forceinline__ void rwkv_out_fin(const Params& P, int row, int c, float y, float lnw, float lnb, float bon, float vs, float gt) {
    bf16_t* MIX = (bf16_t*)(P.ws + WS_U);
    const float mean = wsum(y) * (1.0f / 64.0f); const float dv = y - mean; const float var = wsum(dv * dv) * (1.0f / 64.0f);
    const float yn = dv * rsqrtf(var + 64e-5f) * lnw + lnb;
    MIX[(size_t)row * D + 256 + c] = f2bf((yn + bon * vs) * gt);
}
__device__ __forceinline__ void ph_rwkvout(const Params& P, int l, float* ldsf) {
    using pg8::bf16x8;
    const int tid = otid(), lane = tid & 63, fr = lane & 15, fq = lane >> 4, wv = tid >> 6, gw = blockIdx.x * NWAVE + wv, nw = gridDim.x * NWAVE;
    const float* YD = (const float*)(P.ws + WS_YDIR); const bf16_t* VS = (const bf16_t*)(P.ws + WS_VS); const bf16_t* GT = (const bf16_t*)(P.ws + WS_GATE); const float* BON = (const float*)(P.ws + WS_BONUS);
    bf16_t* MIX = (bf16_t*)(P.ws + WS_U);
    for (int it = gw; it < NB * 6 * 32 * 4; it += nw) {
        const int sub = it & 3, q = (it >> 2) & 31, h = (it >> 7) % 6, b = it / (128 * 6);
        const int t0 = q * 256 + sub * 64;
        f32x4 acc[4][4];
#pragma unroll
        for (int mt = 0; mt < 4; ++mt)
#pragma unroll
            for (int nt = 0; nt < 4; ++nt) acc[mt][nt] = (f32x4){0.f, 0.f, 0.f, 0.f};
#pragma unroll
        for (int dir = 0; dir < 2; ++dir) { const int ch = b * 12 + h * 2 + dir, slot = dir ? (31 - q) : q;
            const float* Sp = (const float*)(P.ws + WS_ZP) + ((size_t)ch * NSEG + slot) * 2 * 4096;
            const bf16_t* Ep = (const bf16_t*)(P.ws + WS_E) + ((size_t)ch * SEQ + t0) * 64;
#pragma unroll
            for (int ks = 0; ks < 2; ++ks) { bf16x8 bop[4];
#pragma unroll
                for (int nt = 0; nt < 4; ++nt) { const float* sp = Sp + (nt * 16 + fr) * 64 + ks * 32 + fq * 8; const float4 s0 = *(const float4*)sp, s1 = *(const float4*)(sp + 4);
                    u32x4 w; w.x = cvt_pk_bf16(s0.x, s0.y); w.y = cvt_pk_bf16(s0.z, s0.w); w.z = cvt_pk_bf16(s1.x, s1.y); w.w = cvt_pk_bf16(s1.z, s1.w); bop[nt] = __builtin_bit_cast(bf16x8, w); }
#pragma unroll
                for (int mt = 0; mt < 4; ++mt) { const bf16x8 a = *(const bf16x8*)(Ep + (size_t)(mt * 16 + fr) * 64 + ks * 32 + fq * 8);
#pragma unroll
                    for (int nt = 0; nt < 4; ++nt) acc[mt][nt] = __builtin_amdgcn_mfma_f32_16x16x32_bf16(a, bop[nt], acc[mt][nt], 0, 0, 0); } } }
        float lnw[4], lnb[4];
#pragma unroll
        for (int nt = 0; nt < 4; ++nt) { lnw[nt] = P.in[I_LNW][l * RWW + h * 64 + nt * 16 + fr]; lnb[nt] = P.in[I_LNB][l * RWW + h * 64 + nt * 16 + fr]; }
#pragma unroll
        for (int mt = 0; mt < 4; ++mt)
#pragma unroll
            for (int rg = 0; rg < 4; ++rg) { const int row = b * SEQ + t0 + mt * 16 + fq * 4 + rg; const size_t o = (size_t)row * 384 + h * 64 + fr;
                float y[4], vs[4], gt[4]; const float bon = BON[(size_t)row * 6 + h];
#pragma unroll
                for (int nt = 0; nt < 4; ++nt) { y[nt] = YD[o + nt * 16] + YD[(size_t)T * 384 + o + nt * 16] + acc[mt][nt][rg]; vs[nt] = bf2f(VS[o + nt * 16]); gt[nt] = bf2f(GT[o + nt * 16]); }
                float sm = (y[0] + y[1]) + (y[2] + y[3]);
                sm += __shfl_xor(sm, 1); sm += __shfl_xor(sm, 2); sm += __shfl_xor(sm, 4); sm += __shfl_xor(sm, 8);
                const float mean = sm * (1.0f / 64.0f);
                float vr = 0.f;
#pragma unroll
                for (int nt = 0; nt < 4; ++nt) { y[nt] -= mean; vr += y[nt] * y[nt]; }
                vr += __shfl_xor(vr, 1); vr += __shfl_xor(vr, 2); vr += __shfl_xor(vr, 4); vr += __shfl_xor(vr, 8);
                const float rstd = rsqrtf(vr * (1.0f / 64.0f) + 64e-5f);
#pragma unroll
                for (int nt = 0; nt < 4; ++nt) MIX[(size_t)row * D + 256 + h * 64 + nt * 16 + fr] = f2bf((y[nt] * rstd * lnw[nt] + lnb[nt] + bon * vs[nt]) * gt[nt]);
                if (rg & 1) asm volatile("" ::: "memory"); }
    }
    for (int it = gw; it < TC * 6; it += nw) { const int row = TL + it / 6, h = it % 6, c = h * 64 + lane; const size_t o = (size_t)row * 384 + c;
        rwkv_out_fin(P, row, c, YD[o] + YD[(size_t)T * 384 + o], P.in[I_LNW][l * RWW + c], P.in[I_LNB][l * RWW + c], BON[(size_t)row * 6 + h], bf2f(VS[o]), bf2f(GT[o])); }
}

__device__ __forceinline__ void zt_tile(const Params& P, int tile, float* tl  ) {
    const int tid = otid(); const int c0 = (tile & 3) * 64, t0 = (tile >> 2) * 64;
    const float* Z = (const float*)(P.ws + WS_Z1); bf16_t* MIX = (bf16_t*)(P.ws + WS_U);
    { const int cc = tid >> 3, sg = (tid & 7) * 8; const float* src = Z + (size_t)(c0 + cc) * TL + t0 + sg; const float4 a = *(const float4*)src, b = *(const float4*)(src + 4);
      tl[cc * 65 + sg + 0] = a.x; tl[cc * 65 + sg + 1] = a.y; tl[cc * 65 + sg + 2] = a.z; tl[cc * 65 + sg + 3] = a.w; tl[cc * 65 + sg + 4] = b.x; tl[cc * 65 + sg + 5] = b.y; tl[cc * 65 + sg + 6] = b.z; tl[cc * 65 + sg + 7] = b.w; }
    __syncthreads();
    { const int tk = tid >> 3, cs = (tid & 7) * 8;
      u32x4 w; w.x = cvt_pk_bf16(tl[(cs + 0) * 65 + tk], tl[(cs + 1) * 65 + tk]); w.y = cvt_pk_bf16(tl[(cs + 2) * 65 + tk], tl[(cs + 3) * 65 + tk]);
      w.z = cvt_pk_bf16(tl[(cs + 4) * 65 + tk], tl[(cs + 5) * 65 + tk]); w.w = cvt_pk_bf16(tl[(cs + 6) * 65 + tk], tl[(cs + 7) * 65 + tk]);
      *(u32x4*)(MIX + (size_t)(t0 + tk) * D + c0 + cs) = w; }
    __syncthreads();
}
typedef const __attribute__((address_space(4))) Params* KParamsPtr;
__device__ __forceinline__ const Params* fresh_params() { KParamsPtr q = (KParamsPtr)__builtin_amdgcn_kernarg_segment_ptr(); asm volatile("" : "+s"(q)); return (const Params*)q; }
__global__ void __launch_bounds__(NTHR, 2) fwd_megakernel(Params P_unused, int ph_lo, int ph_hi) {
    extern __shared__ __attribute__((aligned(16))) unsigned char smem[];
    cg::grid_group grid = cg::this_grid();
    LAS unsigned char* lds3 = (LAS unsigned char*)smem;
    float* ldsf = (float*)smem; float2* X = (float2*)smem; float* ex = (float*)(smem + LDS_MAIN);
    { volatile LAS unsigned* st = (volatile LAS unsigned*)(lds3 + LDS_MAIN + 4096); if (threadIdx.x == 0) { st[0] = 0u; st[1] = 0u; } }
    __syncthreads();
    XcdBarrier xbar = xcd_barrier_post((unsigned*)(((const Params*)fresh_params())->ws + WS_BAR), (volatile LAS unsigned*)(lds3 + LDS_MAIN + 4096));
    int ph = 0;
#ifndef REP_GEMM
#define REP_GEMM 1
#endif
#ifndef REP_SCAN
#define REP_SCAN 1
#endif
#ifndef REP_MISC
#define REP_MISC 1
#endif
#ifndef REP_HY
#define REP_HY 1
#endif
#define PHASE_BEGIN if (ph >= ph_lo && ph < ph_hi) { const Params& P = *fresh_params(); unsigned char* ws = P.ws; (void)ws;
#ifndef REP_SYNC
#define REP_SYNC 1
#endif
#define PHASE_END   if (ph + 1 < ph_hi) { for (int rs_ = 0; rs_ < REP_SYNC; ++rs_) { if (ph == 0) grid.sync(); else xcd_barrier(xbar); } } } ++ph;
    PHASE_BEGIN ph_modv(P, ldsf); PHASE_END
    for (int l = 0; l < DEPTH; ++l) {
        PHASE_BEGIN
            for (int rep_ = 0; rep_ < REP_MISC; ++rep_) ph_prep(P, l, ldsf);
            if (l == 0) ph_rowpass(P, 0, 0, 0, 0, 0.f, 0, 0, 0, 1, 1);
            else ph_rowpass(P, 1, l - 1, 8, 5, 0.5f, l, 0, 0, 1, 11);
        PHASE_END
        PHASE_BEGIN { EpiGU E{(bf16_t*)(ws + WS_ACT)}; for (int rep_ = 0; rep_ < REP_GEMM; ++rep_) run_gemm(lds3, (const bf16_t*)(ws + WS_U), (const bf16_t*)(ws + WS_WGU1), T, 2 * DFF, D, E); } PHASE_END
        PHASE_BEGIN { EpiF32 E{(bf16_t*)(ws + WS_Y), (float*)(ws + WS_YC)}; run_gemm_tail(lds3, (const bf16_t*)(ws + WS_ACT), (const bf16_t*)(ws + WS_WDN1), DFF, E); } PHASE_END
        PHASE_BEGIN ph_rowpass(P, 1, l, 2, 1, 0.5f, l, 2, 3, 4, 11); PHASE_END
        PHASE_BEGIN { EpiWin E{(bf16_t*)(ws + WS_PHY), (bf16_t*)(ws + WS_PRW), (bf16_t*)(ws + WS_PNA)}; for (int rep_ = 0; rep_ < REP_GEMM; ++rep_) run_gemm(lds3, (const bf16_t*)(ws + WS_U), (const bf16_t*)(ws + WS_WIN), T, INWP, D, E); } PHASE_END
        PHASE_BEGIN
            for (int rep_ = 0; rep_ < REP_MISC; ++rep_) { ph_loraprep(P, l);
            for (int it = blockIdx.x; it < NB * 128 * 6 + NB * 4 * 6; it += gridDim.x) vt_tile(P, it, (unsigned short*)smem); }
            for (int rep_ = 0; rep_ < REP_HY; ++rep_) for (int it = blockIdx.x; it < 256; it += gridDim.x) hy_spec_task(P, l, it, X);
        PHASE_END
        PHASE_BEGIN { EpiLora E{(bf16_t*)(ws + WS_LORAO), (bf16_t*)(ws + WS_GATE)};
            for (int rep_ = 0; rep_ < REP_GEMM; ++rep_) run_gemm(lds3, (const bf16_t*)(ws + WS_ALORA), (const bf16_t*)(ws + WS_WLORA), T, 2048, 384, E); } PHASE_END
        PHASE_BEGIN
            for (int rep_ = 0; rep_ < REP_MISC; ++rep_) ph_rwkvprep(P, l);
            for (int rep_ = 0; rep_ < REP_HY; ++rep_) for (int c = blockIdx.x; c < HYC; c += gridDim.x) hy_task1(P, l, c, X, ex);
        PHASE_END
        PHASE_BEGIN {
            const int wv = __builtin_amdgcn_readfirstlane(otid() >> 6);
            if (wv < 4) { const int k = wv * (int)gridDim.x + (int)blockIdx.x;
                if (k < 24 * NSEG) { const int chain = k / NSEG, g = k % NSEG; float* ring = ldsf + wv * (SCH * 320);
                    __builtin_amdgcn_s_setprio(3);
                    for (int rep_ = 0; rep_ < REP_SCAN; ++rep_) { if (g == 0) scan_seg<false>(P, chain, g, ring); else scan_seg<true>(P, chain, g, ring); }
                    __builtin_amdgcn_s_setprio(0); } }
            else for (int it = (wv - 4) * (int)gridDim.x + (int)blockIdx.x; it < NAT_TASKS; it += 4 * (int)gridDim.x) natten_task(P, l, it);
        } PHASE_END
        PHASE_BEGIN
            for (int rep_ = 0; rep_ < REP_HY; ++rep_) for (int c = blockIdx.x; c < HYC; c += gridDim.x) hy_task2(P, l, c, X);
            if (blockIdx.x >= gridDim.x - 24) scan_combine(P, (int)(gridDim.x - 1 - blockIdx.x), ldsf);
        PHASE_END
        PHASE_BEGIN for (int rep_ = 0; rep_ < REP_MISC; ++rep_) ph_rwkvout(P, l, ldsf);
            __syncthreads();
            for (int it = blockIdx.x; it < 4 * (TL / 64); it += gridDim.x) zt_tile(P, it, ldsf);
        PHASE_END
        PHASE_BEGIN { EpiF32 E{(bf16_t*)(ws + WS_Y), (float*)(ws + WS_YC)}; run_gemm_tail(lds3, (const bf16_t*)(ws + WS_U), (const bf16_t*)(ws + WS_WOUT), D, E); } PHASE_END
        PHASE_BEGIN ph_rowpass(P, 1, l, 5, 3, 1.0f, l, 4, 6, 7, 4); PHASE_END
        PHASE_BEGIN { EpiGU E{(bf16_t*)(ws + WS_ACT)}; for (int rep_ = 0; rep_ < REP_GEMM; ++rep_) run_gemm(lds3, (const bf16_t*)(ws + WS_U), (const bf16_t*)(ws + WS_WGU2), T, 2 * DFF, D, E); } PHASE_END
        PHASE_BEGIN { EpiF32 E{(bf16_t*)(ws + WS_Y), (float*)(ws + WS_YC)}; run_gemm_tail(lds3, (const bf16_t*)(ws + WS_ACT), (const bf16_t*)(ws + WS_WDN2), DFF, E); } PHASE_END
    }
    PHASE_BEGIN ph_rowpass(P, 2, DEPTH - 1, 8, 5, 0.5f, 0, 0, 0, 0, 11); PHASE_END
#undef PHASE_BEGIN
#undef PHASE_END
}
constexpr int N_PHASES = 1 + DEPTH * 15 + 1;

extern "C" void kernel_launch(void* const* d_in, const int* in_sizes, int n_in, void* d_out, int out_size, void* d_ws, size_t ws_size, hipStream_t stream) {
    static int grid = 0;
    if (grid == 0) {
        if (n_in != 34 || ws_size < WS_END) { fprintf(stderr, "kernel_launch: need 34 inputs and %zu bytes of workspace; got %d, %zu\n", (size_t)WS_END, n_in, ws_size); grid = -1; return; }
        int dev = 0, cus = 0, per_cu = 0;
        hipGetDevice(&dev); hipDeviceGetAttribute(&cus, hipDeviceAttributeMultiprocessorCount, dev);
        if (hipFuncSetAttribute((const void*)fwd_megakernel, hipFuncAttributeMaxDynamicSharedMemorySize, LDS_BYTES) != hipSuccess) { fprintf(stderr, "kernel_launch: hipFuncSetAttribute failed\n"); grid = -1; return; }
        if (hipOccupancyMaxActiveBlocksPerMultiprocessor(&per_cu, (const void*)fwd_megakernel, NTHR, LDS_BYTES) != hipSuccess || per_cu < 1) { fprintf(stderr, "kernel_launch: occupancy query says %d\n", per_cu); per_cu = 1; }
        (void)hipGetLastError();
        grid = cus;
    }
    if (grid < 0) return;
    if (hipMemsetAsync((char*)d_ws + WS_BAR, 0, (size_t)XCD_BAR_WORDS * 4, stream) != hipSuccess) { fprintf(stderr, "kernel_launch: memset of the barrier words failed\n"); return; }
    Params p{};
    for (int i = 0; i < 34; ++i) p.in[i] = (const float*)d_in[i];
    p.out = (float*)d_out; p.ws = (unsigned char*)d_ws;
#if MK_SPLIT
    for (int ph = 0; ph < N_PHASES; ++ph) { int lo = ph, hi = ph + 1; hipLaunchKernelGGL(fwd_megakernel, dim3(grid), dim3(NTHR), LDS_BYTES, stream, p, lo, hi); }
#else
    int lo = 0, hi = N_PHASES;
    void* args[] = {&p, &lo, &hi};
    hipError_t e = hipLaunchCooperativeKernel((const void*)fwd_megakernel, dim3(grid), dim3(NTHR), args, LDS_BYTES, stream);
    if (e != hipSuccess) fprintf(stderr, "cooperative launch failed: %s (grid %d)\n", hipGetErrorString(e), grid);
#endif
}
```

```cpp
#include <hip/hip_runtime.h>
#include <hip/hip_cooperative_groups.h>
#include <cstdio>
namespace cg = cooperative_groups;
__device__ __forceinline__ int otid() { int t = threadIdx.x; asm volatile("" : "+v"(t)); return t; }
namespace pg8 {
#define PG8_LAS __attribute__((address_space(3)))
typedef unsigned short bf16_t;
typedef short bf16x8 __attribute__((ext_vector_type(8)));
typedef float f32x4 __attribute__((ext_vector_type(4)));
typedef unsigned u32x4 __attribute__((ext_vector_type(4)));
constexpr int BM = 256, BK = 64, HALF = 128, HTB = HALF * BK * 2  , STAGE_BYTES = 8 * HTB, NXCD = 8, WGM = 8;

__host__ __device__ __forceinline__ int lds_byte(int r, int c) { const int st = (r >> 4) * 2 + (c >> 5), rr = r & 15, cc = c & 31, ob = rr * 64 + cc * 2; return st * 1024 + (ob ^ (((ob >> 9) & 1) << 5)); }
__host__ __device__ __forceinline__ void stage_rc(int b, int& R, int& C) { const int st = b / 1024, sb = b % 1024, swz = sb ^ (((sb >> 9) & 1) << 5); R = (st >> 1) * 16 + swz / 64; C = (st & 1) * 32 + (swz % 64) / 2; }
__host__ __device__ __forceinline__ int perm32(int rho) { const int n = rho >> 4, i = rho & 15; return 8 * (i >> 2) + 4 * n + (i & 3); }

struct Unit { int pm, pn, kt0, nkt; };
struct Gemm { const bf16_t* A; const bf16_t* Bt; int M, N, K; };
struct StaticOrder {
    int nM, nN, nwg, G, c;
    __host__ __device__ void init(int M, int N, int G_, int c_) { nM = M / BM; nN = N / BM; nwg = nM * nN; G = G_; c = c_; }
    __host__ __device__ bool next(int i, Unit& u) const {
        const long L = (long)i * G + c; if (L >= nwg) return false;
        int wgid = (int)L; { const int q = nwg / NXCD, r = nwg % NXCD, xcd = wgid % NXCD, off = wgid / NXCD; wgid = (xcd < r ? xcd * (q + 1) : r * (q + 1) + (xcd - r) * q) + off; }
        const int nig = WGM * nN, gid = wgid / nig, fm = gid * WGM, gsz = (nM - fm) < WGM ? (nM - fm) : WGM;
        u.pm = fm + ((wgid % nig) % gsz); u.pn = (wgid % nig) / gsz; u.kt0 = 0; u.nkt = 0; return true;
    }
    __device__ __forceinline__ void a_ready(const Unit&) const {}
    __device__ __forceinline__ void done(const Unit&) const {}
};
__device__ __forceinline__ unsigned cvt_pk_bf16(float lo, float hi) { unsigned r; asm volatile("v_cvt_pk_bf16_f32 %0, %1, %2" : "=v"(r) : "v"(lo), "v"(hi)); return r; }
template <class Epi, class Sched>
__device__ __forceinline__ void gemm_phase(PG8_LAS unsigned char* lds, const Gemm g, const Sched& S, const Epi& E) {
    const int tid = otid(), wid = __builtin_amdgcn_readfirstlane(tid >> 6), lane = tid & 63, wr = wid >> 2, wc = wid & 3, fr = lane & 15, fq = lane >> 4;
    const int K = g.K, nt = K / BK;
#define PG8_STAMP() do {} while (0)
    unsigned voffA[2], voffB[2];
#pragma unroll
    for (int i = 0; i < 2; ++i) { int R, C; stage_rc(tid * 16 + i * 8192, R, C); const int Rb = Epi::PERM ? ((R & ~31) + perm32(R & 31)) : R;
        voffA[i] = (unsigned)(R * K + C) * 2u; voffB[i] = (unsigned)(Rb * K + C) * 2u; }
    const size_t kstep = (size_t)(BK * 2);
    const size_t hstep = (size_t)HALF * K * 2;
    const size_t tstep = 2 * hstep;
    const unsigned ldsw = (unsigned)wid * 1024u;
    const int aoff = lds_byte(wr * 64 + fr, fq * 8), boff = lds_byte(wc * 32 + fr, fq * 8);
#define PG8_SA(b, h) (((b) * 2 + (h)) * HTB)
#define PG8_SB(b, h) ((4 + (b) * 2 + (h)) * HTB)
#define PG8_STAGE(bufoff, gbase, voff) do { _Pragma("unroll") for (int _i = 0; _i < 2; ++_i) \
        __builtin_amdgcn_global_load_lds((const unsigned*)((const char*)(gbase) + (voff)[_i]), (PG8_LAS unsigned*)(lds + (bufoff) + ldsw + _i * 8192), 16, 0, 0); } while (0)
#define PG8_LDA(dst, b, h) do { _Pragma("unroll") for (int m = 0; m < 4; ++m) _Pragma("unroll") for (int k = 0; k < 2; ++k) dst[m][k] = *(const PG8_LAS bf16x8*)(lds + PG8_SA(b, h) + aoff + m * 2048 + k * 1024); } while (0)
#define PG8_LDB(dst, b, h) do { _Pragma("unroll") for (int n = 0; n < 2; ++n) _Pragma("unroll") for (int k = 0; k < 2; ++k) dst[n][k] = *(const PG8_LAS bf16x8*)(lds + PG8_SB(b, h) + boff + n * 2048 + k * 1024); } while (0)
#define PG8_MMA(ai, bj, At, Bt) do { __builtin_amdgcn_s_setprio(1); _Pragma("unroll") for (int m = 0; m < 4; ++m) _Pragma("unroll") for (int n = 0; n < 2; ++n) _Pragma("unroll") for (int k = 0; k < 2; ++k) \
        acc[ai][bj][m][n] = __builtin_amdgcn_mfma_f32_16x16x32_bf16(Bt[n][k], At[m][k], acc[ai][bj][m][n], 0, 0, 0); __builtin_amdgcn_s_setprio(0); } while (0)
#define PG8_WAIT_V(n) asm volatile("s_waitcnt vmcnt(" #n ")" ::: "memory")
#define PG8_WAIT_L(n) asm volatile("s_waitcnt lgkmcnt(" #n ")" ::: "memory")
#define PG8_BAR __builtin_amdgcn_s_barrier()
#define PG8_SCHED __builtin_amdgcn_sched_barrier(0)
    Unit cur, nxt; int ui = 0;
    if (!S.next(0, cur)) return;
    f32x4 acc[2][2][4][2];
#pragma unroll
    for (int a = 0; a < 2; ++a)
#pragma unroll
        for (int b = 0; b < 2; ++b)
#pragma unroll
            for (int m = 0; m < 4; ++m)
#pragma unroll
                for (int n = 0; n < 2; ++n) acc[a][b][m][n] = (f32x4){0.f, 0.f, 0.f, 0.f};
    bf16x8 At[4][2], B0[2][2], B1[2][2];
    const char* cA = (const char*)g.A + (size_t)cur.pm * tstep + (size_t)cur.kt0 * kstep; const char* cB = (const char*)g.Bt + (size_t)cur.pn * tstep + (size_t)cur.kt0 * kstep;
    int ntc = cur.nkt > 0 ? cur.nkt : nt;
    S.a_ready(cur);
    PG8_STAGE(PG8_SB(0, 0), cB, voffB); PG8_STAGE(PG8_SA(0, 0), cA, voffA); PG8_STAGE(PG8_SB(0, 1), cB + hstep, voffB); PG8_STAGE(PG8_SA(0, 1), cA + hstep, voffA);
    if (wr == 1) PG8_BAR;
    PG8_WAIT_V(4); PG8_BAR;
    PG8_STAGE(PG8_SB(1, 0), cB + kstep, voffB); PG8_STAGE(PG8_SA(1, 0), cA + kstep, voffA); PG8_STAGE(PG8_SB(1, 1), cB + hstep + kstep, voffB);
    PG8_WAIT_V(6); PG8_BAR;
    PG8_STAMP();
    for (;;) {
        const bool has_next = S.next(ui + 1, nxt);
        const char* nA = has_next ? (const char*)g.A + (size_t)nxt.pm * tstep + (size_t)nxt.kt0 * kstep : cA; const char* nB = has_next ? (const char*)g.Bt + (size_t)nxt.pn * tstep + (size_t)nxt.kt0 * kstep : cB;
        for (int t = 0; t < ntc; t += 2) {
            const bool last = (t == ntc - 2);
            const char* a1 = cA + (size_t)(t + 1) * kstep;
            const char* a2 = last ? nA : cA + (size_t)(t + 2) * kstep; const char* b2 = last ? nB : cB + (size_t)(t + 2) * kstep;
            const char* a3 = a2 + kstep; const char* b3 = b2 + kstep;
            if (last && has_next) S.a_ready(nxt);
            PG8_LDB(B0, 0, 0); PG8_SCHED; PG8_LDA(At, 0, 0); PG8_STAGE(PG8_SA(1, 1), a1 + hstep, voffA);
            PG8_WAIT_L(8); PG8_BAR; PG8_WAIT_L(0); PG8_MMA(0, 0, At, B0); PG8_BAR; PG8_SCHED;
            PG8_LDB(B1, 0, 1); PG8_STAGE(PG8_SB(0, 0), b2, voffB);
            PG8_BAR; PG8_WAIT_L(0); PG8_MMA(0, 1, At, B1); PG8_BAR;
            PG8_LDA(At, 0, 1); PG8_STAGE(PG8_SA(0, 0), a2, voffA);
            PG8_BAR; PG8_WAIT_L(0); PG8_MMA(1, 0, At, B0); PG8_BAR; PG8_SCHED;
            PG8_STAGE(PG8_SB(0, 1), b2 + hstep, voffB);
            PG8_WAIT_V(6); PG8_BAR; PG8_MMA(1, 1, At, B1); PG8_BAR;
            PG8_LDB(B0, 1, 0); PG8_SCHED; PG8_LDA(At, 1, 0); PG8_STAGE(PG8_SA(0, 1), a2 + hstep, voffA);
            PG8_WAIT_L(8); PG8_BAR; PG8_WAIT_L(0); PG8_MMA(0, 0, At, B0); PG8_BAR; PG8_SCHED;
            PG8_LDB(B1, 1, 1); PG8_STAGE(PG8_SB(1, 0), b3, voffB);
            PG8_BAR; PG8_WAIT_L(0); PG8_MMA(0, 1, At, B1); PG8_BAR;
            PG8_LDA(At, 1, 1); PG8_STAGE(PG8_SA(1, 0), a3, voffA);
            PG8_BAR; PG8_WAIT_L(0); PG8_MMA(1, 0, At, B0); PG8_BAR; PG8_SCHED;
            PG8_STAGE(PG8_SB(1, 1), b3 + hstep, voffB);
            PG8_WAIT_V(6); PG8_BAR; PG8_MMA(1, 1, At, B1); PG8_BAR;
        }
        PG8_STAMP();
        if constexpr (!Epi::AFTER_DRAIN) { E(acc, cur, wr, wc, fr, fq); S.done(cur); }
        PG8_STAMP();
        if (!has_next) break;
#pragma unroll
        for (int a = 0; a < 2; ++a)
#pragma unroll
            for (int b = 0; b < 2; ++b)
#pragma unroll
                for (int m = 0; m < 4; ++m)
#pragma unroll
                    for (int n = 0; n < 2; ++n) acc[a][b][m][n] = (f32x4){0.f, 0.f, 0.f, 0.f};
        cur = nxt; cA = nA; cB = nB; ++ui; ntc = cur.nkt > 0 ? cur.nkt : nt;
    }
    PG8_WAIT_V(0);
    if (wr == 0) PG8_BAR;
    PG8_BAR;
    if constexpr (Epi::AFTER_DRAIN) { E.fused(acc, cur, wr, wc, fr, fq, lds, wid, lane); S.done(cur); }
    PG8_STAMP();
#undef PG8_STAMP
#undef PG8_SA
#undef PG8_SB
#undef PG8_STAGE
#undef PG8_LDA
#undef PG8_LDB
#undef PG8_MMA
#undef PG8_WAIT_V
#undef PG8_WAIT_L
#undef PG8_BAR
#undef PG8_SCHED
}
}
#define LAS __attribute__((address_space(3)))
#define XB_TMO      128
#define XB_XCNT(j)  (256  + 64 * (j))
#define XB_XSUB(j)  (1280 + 64 * (j))
#define XB_XGEN(j)  (2304 + 64 * (j))
#define XB_TOP      3328
#define XB_TOPGEN   3392
#define XCD_BAR_WORDS 3456
#define XB_SPIN_CAP (1u << 18)

__device__ __forceinline__ unsigned xb_ld(unsigned* p)              { return __hip_atomic_load(p, __ATOMIC_RELAXED, __HIP_MEMORY_SCOPE_AGENT); }
__device__ __forceinline__ unsigned xb_add(unsigned* p, unsigned v) { return __hip_atomic_fetch_add(p, v, __ATOMIC_RELAXED, __HIP_MEMORY_SCOPE_AGENT); }
__device__ __forceinline__ unsigned xb_xcc_id() { return (unsigned)__builtin_amdgcn_s_getreg((3 << 11) | 20) & 0xFu; }
#define XB_SPIN(cond, bar) do { unsigned _sp = 0; while (cond) { __builtin_amdgcn_s_sleep(1); \
    if ((++_sp & 255u) == 0u) { if (xb_ld(&(bar)[XB_TMO])) break; if (_sp > XB_SPIN_CAP) { atomicAdd(&(bar)[XB_TMO], 1u); break; } } } } while (0)

struct XcdBarrier {
    unsigned* bar; unsigned x;
    volatile LAS unsigned* st;
};

__device__ __forceinline__ XcdBarrier xcd_barrier_post(unsigned* bar, volatile LAS unsigned* st) {
    XcdBarrier b; b.bar = bar; b.x = xb_xcc_id(); b.st = st;
    if (threadIdx.x == 0) (void)xb_add(&bar[XB_XCNT(b.x)], 1u);
    return b;
}
__device__ __forceinline__ void xcd_barrier_complete(unsigned* bar, unsigned x, unsigned& nloc, unsigned& nx) {
    const unsigned G = gridDim.x * gridDim.y * gridDim.z;
    unsigned sum, cnt, mine, sp = 0u;
    for (;;) {
        sum = 0u; cnt = 0u; mine = 0u;
#pragma unroll
        for (unsigned j = 0; j < 16; ++j) { const unsigned c = xb_ld(&bar[XB_XCNT(j)]); sum += c; cnt += (c > 0u) ? 1u : 0u; mine = (j == x) ? c : mine; }
        if (sum == G) break;
        __builtin_amdgcn_s_sleep(1);
        if ((++sp & 255u) == 0u) { if (xb_ld(&bar[XB_TMO])) break; if (sp > XB_SPIN_CAP) { atomicAdd(&bar[XB_TMO], 1u); break; } }
    }
    nloc = mine > 0u ? mine : 1u; nx = cnt > 0u ? cnt : 1u;
}

__device__ __forceinline__ void xcd_barrier(const XcdBarrier& b) {
    asm volatile("s_waitcnt vmcnt(0)" ::: "memory");
    __syncthreads();
    if (threadIdx.x == 0) {
        unsigned* bar = b.bar;
        __builtin_amdgcn_s_waitcnt(0);
        unsigned nloc = b.st[0], nx = b.st[1];
        if (nloc == 0u) { xcd_barrier_complete(bar, b.x, nloc, nx); b.st[0] = nloc; b.st[1] = nx; }
        const unsigned old = xb_add(&bar[XB_XSUB(b.x)], 1u);
        const unsigned gen = old / nloc;
        if (old + 1u == (gen + 1u) * nloc) {
            __builtin_amdgcn_fence(__ATOMIC_RELEASE, "agent");
            asm volatile("s_waitcnt vmcnt(0)" ::: "memory");
            const unsigned og = xb_add(&bar[XB_TOP], 1u);
            const unsigned tg = og / nx;
            if (og + 1u == (tg + 1u) * nx) xb_add(&bar[XB_TOPGEN], 1u);
            else XB_SPIN(xb_ld(&bar[XB_TOPGEN]) == tg, bar);
            __builtin_amdgcn_fence(__ATOMIC_ACQUIRE, "agent");
            xb_add(&bar[XB_XGEN(b.x)], 1u);
            asm volatile("s_waitcnt vmcnt(0)" ::: "memory");
        } else {
            XB_SPIN(xb_ld(&bar[XB_XGEN(b.x)]) == gen, bar);
            __builtin_amdgcn_fence(__ATOMIC_ACQUIRE, "agent");
            asm volatile("s_waitcnt vmcnt(0)" ::: "memory");
        }
    }
    __syncthreads();
}

using pg8::bf16_t; using pg8::f32x4; using pg8::u32x4; using pg8::cvt_pk_bf16;
typedef unsigned u32x2 __attribute__((ext_vector_type(2)));


constexpr int D = 1024, NB = 2, SEQ = 8192, DEPTH = 4, CTX = 256, DFF = 2816;
constexpr int TL = NB * SEQ, TC = NB * CTX, T = TL + TC;
constexpr int NMOD = 9 * D;
constexpr int HYC = 256, RWW = 384, NAW = 384, INW = 3456, INWP = 3584;
constexpr int HY_IN = 768, RW_IN = 1536, NA_IN = 1152;
constexpr int NFFT = 16384;
constexpr int NTHR = 512, NWAVE = 8;
constexpr int LDS_MAIN = 131072, LDS_EXTRA = 8192, LDS_BYTES = LDS_MAIN + LDS_EXTRA;
constexpr float NORM_EPS = 1e-6f;

constexpr size_t al256(size_t x) { return (x + 255) & ~(size_t)255; }
constexpr size_t WS_MODV = 0;
constexpr size_t WS_WGU1 = al256(WS_MODV + (size_t)DEPTH * 3 * NMOD * 4);
constexpr size_t WS_WDN1 = WS_WGU1 + (size_t)2 * DFF * D * 2;
constexpr size_t WS_WGU2 = WS_WDN1 + (size_t)D * DFF * 2;
constexpr size_t WS_WDN2 = WS_WGU2 + (size_t)2 * DFF * D * 2;
constexpr size_t WS_WIN = WS_WDN2 + (size_t)D * DFF * 2;
constexpr size_t WS_WOUT = WS_WIN + (size_t)INWP * D * 2;
constexpr size_t WS_WLORA = WS_WOUT + (size_t)D * D * 2;
constexpr size_t WS_H = WS_WLORA + (size_t)2048 * 384 * 2;
constexpr size_t WS_U = WS_H + (size_t)T * D * 4;
constexpr size_t WS_S = WS_U + (size_t)T * D * 2;
constexpr size_t WS_Y = WS_S;
constexpr size_t WS_ACT = WS_Y + (size_t)T * D * 4;
constexpr size_t WS_FFN_END = WS_ACT + (size_t)T * DFF * 2;
constexpr size_t WS_PHY = WS_S;
constexpr size_t WS_PRW = WS_PHY + (size_t)T * HY_IN * 2;
constexpr size_t WS_YDIR = WS_PRW;
constexpr size_t WS_PNA = WS_PRW + (size_t)T * RW_IN * 2;
constexpr size_t WS_ALORA = WS_PNA + (size_t)T * NA_IN * 2;
constexpr size_t WS_DECAY = WS_ALORA + (size_t)T * 384 * 2;
constexpr size_t WS_LORAO = WS_DECAY + (size_t)2 * T * 384 * 4;
constexpr size_t WS_E = WS_LORAO;
constexpr size_t WS_ZP = WS_E + (size_t)24 * SEQ * 64 * 2;
constexpr size_t WS_GATE = WS_LORAO + (size_t)T * 1536 * 2;
static_assert(WS_ZP + (size_t)24 * 33 * 2 * 4096 * 4 <= WS_GATE, "E + ZP must fit in the LORAO region");
constexpr size_t WS_RS = WS_GATE + (size_t)T * 384 * 2;
constexpr size_t WS_KKS = WS_RS + (size_t)T * 384 * 2;
constexpr size_t WS_VS = WS_KKS + (size_t)T * 384 * 2;
constexpr size_t WS_KS = WS_VS + (size_t)T * 384 * 2;
constexpr size_t WS_BS = WS_KS + (size_t)2 * T * 384 * 2;
constexpr size_t WS_BONUS = WS_BS + (size_t)2 * T * 384 * 2;
constexpr size_t WS_FILT = al256(WS_BONUS + (size_t)T * 6 * 4);
constexpr size_t WS_FILTC = WS_FILT + (size_t)1024 * SEQ * 2;
constexpr size_t WS_SPEC = WS_FILTC + (size_t)1024 * CTX * 2;
constexpr size_t WS_Z1 = WS_SPEC + (size_t)512 * NFFT * 8;
constexpr size_t WS_VTL = WS_Z1 + (size_t)HYC * NB * SEQ * 4;
constexpr size_t WS_VTC = WS_VTL + (size_t)NB * 6 * 64 * SEQ * 2;
constexpr size_t WS_MIX_END = WS_VTC + (size_t)NB * 6 * 64 * CTX * 2;
constexpr size_t WS_BAR = al256(WS_MIX_END > WS_FFN_END ? WS_MIX_END : WS_FFN_END);
constexpr size_t WS_ROPE = al256(WS_BAR + (size_t)XCD_BAR_WORDS * 4);
constexpr size_t WS_YC = WS_FFN_END + (size_t)(8 << 20);
static_assert(WS_YC + (size_t)11 * TC * D * 4 <= WS_FILT, "YC partials must stay below the filter tables");
constexpr size_t WS_END = WS_ROPE + (size_t)128 * 16 * 8;
static_assert(WS_END <= (size_t)4 * DEPTH * D * NMOD * 4, "workspace map exceeds 4x the largest input tensor");

struct Params { const float* in[34]; float* out; unsigned char* ws; };
enum { I_X = 0, I_C, I_CTX, I_CCTX, I_MODW, I_MODB, I_NORMG, I_F1GU, I_F1DN, I_F2GU, I_F2DN, I_WIN, I_WOUT, I_HCW, I_HCB, I_HW1, I_HB1, I_HW2, I_HB2, I_HW3, I_HFREQ, I_HBIAS,
       I_MU, I_W0, I_W2, I_A0, I_A2, I_G2, I_KK, I_KA, I_RK, I_LNW, I_LNB, I_RPB };

typedef LAS float* ldsfp;
__device__ __forceinline__ ldsfp vlds(const void* p) { ldsfp q = (ldsfp)p; asm volatile("" : "+v"(q)); return q; }
__device__ __forceinline__ float bf2f(bf16_t b) { return __uint_as_float(((unsigned)b) << 16); }
__device__ __forceinline__ bf16_t f2bf(float f) { unsigned u = __float_as_uint(f); u += 0x7FFFu + ((u >> 16) & 1u); return (bf16_t)(u >> 16); }
__device__ __forceinline__ float lo_bf(unsigned w) { return __uint_as_float(w << 16); }
__device__ __forceinline__ float hi_bf(unsigned w) { return __uint_as_float(w & 0xffff0000u); }
__device__ __forceinline__ float wsum(float v) {
#pragma unroll
    for (int o = 32; o > 0; o >>= 1) v += __shfl_xor(v, o);
    return v;
}
__device__ __forceinline__ float sigmoidf_(float x) { return __builtin_amdgcn_rcpf(1.0f + __expf(-x)); }
__device__ __forceinline__ void unpack8(const u32x4 w, float (&f)[8]) {
    f[0] = lo_bf(w.x); f[1] = hi_bf(w.x); f[2] = lo_bf(w.y); f[3] = hi_bf(w.y); f[4] = lo_bf(w.z); f[5] = hi_bf(w.z); f[6] = lo_bf(w.w); f[7] = hi_bf(w.w);
}
__device__ __forceinline__ void row_nbrs(int row, bool& hasp, bool& hasn) {
    if (row < TL) { const int t = row & (SEQ - 1); hasp = t > 0; hasn = t < SEQ - 1; }
    else { const int t = (row - TL) & (CTX - 1); hasp = t > 0; hasn = t < CTX - 1; }
}

__device__ __forceinline__ void ph_modv(const Params& P, float* lds) {
    const int tid = otid();
    float* sv = lds;
    float* red = lds + 3072;
    for (int i = tid; i < 3072; i += NTHR) { const int s = i >> 10, k = i & 1023; const float c = s < 2 ? P.in[I_C][s * 1024 + k] : P.in[I_CCTX][k]; sv[i] = c / (1.0f + expf(-c)); }
    __syncthreads();
    if (blockIdx.x < 4) { const int e = blockIdx.x * NTHR + tid, pos = e >> 4, f = e & 15; float sn, cs; sincosf((float)pos * expf(-(float)f * (9.210340371976184f / 16.0f)), &sn, &cs); ((float2*)(P.ws + WS_ROPE))[e] = make_float2(cs, sn); }
    float* modv = (float*)(P.ws + WS_MODV);
    const int kc = tid >> 6, cl = tid & 63;
    for (int item = blockIdx.x; item < DEPTH * 144; item += gridDim.x) {
        const int l = item / 144, cb = item % 144, col = cb * 64 + cl;
        const float* w = P.in[I_MODW] + ((size_t)l * 1024 + kc * 128) * NMOD + col;
        float a0 = 0.f, a1 = 0.f, a2 = 0.f;
#pragma unroll 8
        for (int k = 0; k < 128; ++k) { const float wv = w[(size_t)k * NMOD]; a0 += sv[kc * 128 + k] * wv; a1 += sv[1024 + kc * 128 + k] * wv; a2 += sv[2048 + kc * 128 + k] * wv; }
        red[(0 * 8 + kc) * 64 + cl] = a0; red[(1 * 8 + kc) * 64 + cl] = a1; red[(2 * 8 + kc) * 64 + cl] = a2;
        __syncthreads();
        if (tid < 192) { const int s = tid >> 6, c = tid & 63; float r = P.in[I_MODB][l * NMOD + cb * 64 + c];
#pragma unroll
            for (int q = 0; q < 8; ++q) r += red[(s * 8 + q) * 64 + c];
            modv[((size_t)l * 3 + s) * NMOD + cb * 64 + c] = r; }
        __syncthreads();
    }
}

__device__ __forceinline__ float hy_delta(int c);
__device__ __forceinline__ int rowmap_gu(int n) { const int up = n >= DFF ? 1 : 0; const int j = n - up * DFF; return (j >> 7) * 256 + up * 128 + (j & 127); }
__device__ __forceinline__ void conv_tile(const float* __restrict__ src, int K, int N, bf16_t* __restrict__ dst, int tk, int tn, bool gu, float* tile) {
    const int tid = otid(); const int k0 = tk * 64, n0 = tn * 64;
#pragma unroll
    for (int rr = 0; rr < 2; ++rr) { const int kk = (tid >> 4) + rr * 32, n4 = (tid & 15) * 4; const float4 v = *(const float4*)(src + (size_t)(k0 + kk) * N + n0 + n4);
        tile[kk * 65 + n4 + 0] = v.x; tile[kk * 65 + n4 + 1] = v.y; tile[kk * 65 + n4 + 2] = v.z; tile[kk * 65 + n4 + 3] = v.w; }
    __syncthreads();
    { const int nn = tid >> 3, ks = (tid & 7) * 8; const int n = n0 + nn; const int row = gu ? rowmap_gu(n) : n;
      u32x4 w; w.x = cvt_pk_bf16(tile[(ks + 0) * 65 + nn], tile[(ks + 1) * 65 + nn]); w.y = cvt_pk_bf16(tile[(ks + 2) * 65 + nn], tile[(ks + 3) * 65 + nn]);
      w.z = cvt_pk_bf16(tile[(ks + 4) * 65 + nn], tile[(ks + 5) * 65 + nn]); w.w = cvt_pk_bf16(tile[(ks + 6) * 65 + nn], tile[(ks + 7) * 65 + nn]);
      *(u32x4*)(dst + (size_t)row * K + k0 + ks) = w; }
    __syncthreads();
}
__device__ __forceinline__ void ph_prep(const Params& P, int l, float* lds) {
    const int tid = otid();
    unsigned char* ws = P.ws;
    constexpr int N0 = 16 * 88, N1 = 44 * 16, N4 = 16 * 54, N5 = 16 * 16;
    constexpr int C0 = N0, C1 = C0 + N1, C2 = C1 + N0, C3 = C2 + N1, C4 = C3 + N4, C5 = C4 + N5;
    for (int it = blockIdx.x; it < C5; it += gridDim.x) {
        if (it < C0) { conv_tile(P.in[I_F1GU] + (size_t)l * D * 2 * DFF, D, 2 * DFF, (bf16_t*)(ws + WS_WGU1), it / 88, it % 88, true, lds); }
        else if (it < C1) { const int j = it - C0; conv_tile(P.in[I_F1DN] + (size_t)l * DFF * D, DFF, D, (bf16_t*)(ws + WS_WDN1), j / 16, j % 16, false, lds); }
        else if (it < C2) { const int j = it - C1; conv_tile(P.in[I_F2GU] + (size_t)l * D * 2 * DFF, D, 2 * DFF, (bf16_t*)(ws + WS_WGU2), j / 88, j % 88, true, lds); }
        else if (it < C3) { const int j = it - C2; conv_tile(P.in[I_F2DN] + (size_t)l * DFF * D, DFF, D, (bf16_t*)(ws + WS_WDN2), j / 16, j % 16, false, lds); }
        else if (it < C4) { const int j = it - C3; conv_tile(P.in[I_WIN] + (size_t)l * D * INW, D, INW, (bf16_t*)(ws + WS_WIN), j / 54, j % 54, false, lds); }
        else { const int j = it - C4; conv_tile(P.in[I_WOUT] + (size_t)l * D * D, D, D, (bf16_t*)(ws + WS_WOUT), j / 16, j % 16, false, lds); }
    }
    const int gtid = blockIdx.x * NTHR + tid, gn = gridDim.x * NTHR;
    { unsigned* z = (unsigned*)(ws + WS_WIN + (size_t)INW * D * 2); for (int i = gtid; i < (INWP - INW) * D / 2; i += gn) z[i] = 0u; }
    { bf16_t* wl = (bf16_t*)(ws + WS_WLORA);
      const float* w2 = P.in[I_W2] + (size_t)l * 2 * 64 * RWW; const float* a2 = P.in[I_A2] + (size_t)l * 2 * 64 * RWW; const float* g2 = P.in[I_G2] + (size_t)l * 128 * RWW;
      for (int i = gtid; i < 2048 * 384; i += gn) { const int k = i / 2048, j = i % 2048; float v = 0.f;
          if (j < 1920) { const int grp = j / 384, c = j % 384;
              if (grp == 0) { if (k < 64) v = w2[(size_t)k * RWW + c]; }
              else if (grp == 1) { if (k >= 64 && k < 128) v = w2[(size_t)(64 + k - 64) * RWW + c]; }
              else if (grp == 2) { if (k >= 128 && k < 192) v = a2[(size_t)(k - 128) * RWW + c]; }
              else if (grp == 3) { if (k >= 192 && k < 256) v = a2[(size_t)(64 + k - 192) * RWW + c]; }
              else { if (k >= 256) v = g2[(size_t)(k - 256) * RWW + c]; } }
          wl[(size_t)j * 384 + k] = f2bf(v); } }
    { const float* w1_ = P.in[I_HW1] + (size_t)l * 33 * 64; const float* b1 = P.in[I_HB1] + l * 64; const float* w2f_ = P.in[I_HW2] + (size_t)l * 64 * 64; const float* b2 = P.in[I_HB2] + l * 64;
      const float* fqv = P.in[I_HFREQ] + l * 64; const float* w3 = P.in[I_HW3] + (size_t)l * 64 * 1024;
      const int lane = tid & 63, wv = tid >> 6;
      const float fq = fqv[lane], bb1 = b1[lane], bb2 = b2[lane];
      const ldsfp hl = vlds(lds);
      for (int task = blockIdx.x; task < 256; task += gridDim.x) {
          const int n0 = task * 32;
          __syncthreads();
#pragma unroll 1
          for (int p = wv; p < 33; p += NWAVE) { const int L = p < 32 ? SEQ : CTX, pos = p < 32 ? n0 + p : task;
              const float* w1 = w1_; const float* w2f = w2f_; asm volatile("" : "+s"(w1), "+s"(w2f));
              const float tt = (float)pos / (float)(L - 1);
              const float ang = 6.283185307179586f * (float)pos / (float)L;
              float z = 0.f;
              if (lane == 0) z = tt;
              else if (lane <= 16) { const float fr = 1e-4f + (float)(lane - 1) * ((15.0f - 1e-4f) / 15.0f); z = cosf(fr * ang); }
              else if (lane <= 32) { const float fr = 1e-4f + (float)(lane - 17) * ((15.0f - 1e-4f) / 15.0f); z = -sinf(fr * ang); }
              float a = bb1;
#pragma unroll
              for (int e = 0; e < 33; ++e) a += __shfl(z, e) * w1[e * 64 + lane];
              const float h1 = sinf(fq * a);
              float c = bb2;
#pragma unroll
              for (int i = 0; i < 64; ++i) c += __shfl(h1, i) * w2f[i * 64 + lane];
              hl[lane * 36 + p] = sinf(fq * c); }
          __syncthreads();
          float acc0[33], acc1[33];
#pragma unroll
          for (int p = 0; p < 33; ++p) { acc0[p] = 0.f; acc1[p] = 0.f; }
#pragma unroll 2
          for (int i = 0; i < 64; ++i) { const float wa = w3[(size_t)i * 1024 + tid], wb = w3[(size_t)i * 1024 + 512 + tid];
#pragma unroll
              for (int p4 = 0; p4 < 8; ++p4) { const f32x4 hv = *(const LAS f32x4*)(hl + i * 36 + p4 * 4);
                  acc0[p4 * 4 + 0] += hv.x * wa; acc0[p4 * 4 + 1] += hv.y * wa; acc0[p4 * 4 + 2] += hv.z * wa; acc0[p4 * 4 + 3] += hv.w * wa;
                  acc1[p4 * 4 + 0] += hv.x * wb; acc1[p4 * 4 + 1] += hv.y * wb; acc1[p4 * 4 + 2] += hv.z * wb; acc1[p4 * 4 + 3] += hv.w * wb; }
              const float hc = hl[i * 36 + 32]; acc0[32] += hc * wa; acc1[32] += hc * wb; }
          const float dl = hy_delta(tid & 255), sc = 1.0f / NFFT, invL = 1.0f / (float)(SEQ - 1);
          bf16_t* dst = (bf16_t*)(ws + WS_FILT) + (size_t)tid * SEQ + n0;
          const size_t cstep = (size_t)512 * SEQ;
#pragma unroll
          for (int p8 = 0; p8 < 4; ++p8) { float d[8];
#pragma unroll
              for (int k = 0; k < 8; ++k) d[k] = __expf(-((float)(n0 + p8 * 8 + k) * invL) * dl) * sc;
              u32x4 w; w.x = cvt_pk_bf16(acc0[p8 * 8 + 0] * d[0], acc0[p8 * 8 + 1] * d[1]); w.y = cvt_pk_bf16(acc0[p8 * 8 + 2] * d[2], acc0[p8 * 8 + 3] * d[3]);
              w.z = cvt_pk_bf16(acc0[p8 * 8 + 4] * d[4], acc0[p8 * 8 + 5] * d[5]); w.w = cvt_pk_bf16(acc0[p8 * 8 + 6] * d[6], acc0[p8 * 8 + 7] * d[7]);
              *(u32x4*)(dst + p8 * 8) = w;
              w.x = cvt_pk_bf16(acc1[p8 * 8 + 0] * d[0], acc1[p8 * 8 + 1] * d[1]); w.y = cvt_pk_bf16(acc1[p8 * 8 + 2] * d[2], acc1[p8 * 8 + 3] * d[3]);
              w.z = cvt_pk_bf16(acc1[p8 * 8 + 4] * d[4], acc1[p8 * 8 + 5] * d[5]); w.w = cvt_pk_bf16(acc1[p8 * 8 + 6] * d[6], acc1[p8 * 8 + 7] * d[7]);
              *(u32x4*)(dst + cstep + p8 * 8) = w; }
          { const float dc = __expf(-((float)task * (1.0f / (float)(CTX - 1))) * dl); bf16_t* fc = (bf16_t*)(ws + WS_FILTC) + (size_t)tid * CTX + task;
            fc[0] = f2bf(acc0[32] * dc); fc[(size_t)512 * CTX] = f2bf(acc1[32] * dc); }
      }
      __syncthreads(); }
}

__device__ __forceinline__ void ph_rowpass(const Params& P, int mode, int lpost, int gate_i, int gpost_i, float ps, int lpre, int gpre_i, int shift_i, int scale_i, int nsplit) {
    const int tid = otid(), lane = tid & 63, gw = blockIdx.x * NWAVE + (tid >> 6), nw = gridDim.x * NWAVE;
    const float* modv = (const float*)(P.ws + WS_MODV);
    float* H = (float*)(P.ws + WS_H); const bf16_t* Y = (const bf16_t*)(P.ws + WS_Y); bf16_t* U = (bf16_t*)(P.ws + WS_U);
    int cur_s = -1;
    float4 A[4], Bv[4], Cv[4];
#pragma unroll
    for (int j = 0; j < 4; ++j) { A[j] = make_float4(0.f, 0.f, 0.f, 0.f); Bv[j] = A[j]; Cv[j] = A[j]; }
    for (int row = gw; row < T; row += nw) {
        const int s = row < SEQ ? 0 : (row < TL ? 1 : 2);
        if (s != cur_s) { cur_s = s;
#pragma unroll
            for (int j = 0; j < 4; ++j) { const int e = lane * 4 + 256 * j;
                if (mode != 0) { const float4 g = *(const float4*)(modv + ((size_t)lpost * 3 + s) * NMOD + gate_i * D + e); const float4 gp = *(const float4*)(P.in[I_NORMG] + ((size_t)lpost * 6 + gpost_i) * D + e);
                    A[j] = make_float4(ps * g.x * gp.x, ps * g.y * gp.y, ps * g.z * gp.z, ps * g.w * gp.w); }
                if (mode != 2) { const float4 sc = *(const float4*)(modv + ((size_t)lpre * 3 + s) * NMOD + scale_i * D + e); const float4 gq = *(const float4*)(P.in[I_NORMG] + ((size_t)lpre * 6 + gpre_i) * D + e);
                    Bv[j] = make_float4(gq.x * (1.f + sc.x), gq.y * (1.f + sc.y), gq.z * (1.f + sc.z), gq.w * (1.f + sc.w));
                    Cv[j] = *(const float4*)(modv + ((size_t)lpre * 3 + s) * NMOD + shift_i * D + e); } } }
        float4 h[4];
        if (mode == 0) { const float* src = row < TL ? P.in[I_X] + (size_t)row * D : P.in[I_CTX] + (size_t)(row - TL) * D;
#pragma unroll
            for (int j = 0; j < 4; ++j) h[j] = *(const float4*)(src + lane * 4 + 256 * j);
        } else {
            float4 y[4]; float ss = 0.f;
#pragma unroll
            for (int j = 0; j < 4; ++j) { h[j] = *(const float4*)(H + (size_t)row * D + lane * 4 + 256 * j); if (row < TL) { const u32x2 yw = *(const u32x2*)(Y + (size_t)row * D + lane * 4 + 256 * j); y[j] = make_float4(lo_bf(yw.x), hi_bf(yw.x), lo_bf(yw.y), hi_bf(yw.y)); } else { const float* yp = (const float*)(P.ws + WS_YC) + (size_t)(row - TL) * D + lane * 4 + 256 * j; float4 a = *(const float4*)yp;
                    for (int q = 1; q < nsplit; ++q) { const float4 b4 = *(const float4*)(yp + (size_t)q * TC * D); a.x += b4.x; a.y += b4.y; a.z += b4.z; a.w += b4.w; } y[j] = a; }
                ss += y[j].x * y[j].x + y[j].y * y[j].y + y[j].z * y[j].z + y[j].w * y[j].w; }
            ss = wsum(ss); const float r = rsqrtf(ss * (1.0f / D) + NORM_EPS);
#pragma unroll
            for (int j = 0; j < 4; ++j) { h[j].x += A[j].x * (y[j].x * r); h[j].y += A[j].y * (y[j].y * r); h[j].z += A[j].z * (y[j].z * r); h[j].w += A[j].w * (y[j].w * r); }
        }
        if (mode == 2) { if (row < TL) {
#pragma unroll
                for (int j = 0; j < 4; ++j) *(float4*)(P.out + (size_t)row * D + lane * 4 + 256 * j) = h[j]; }
            continue; }
        float s2 = 0.f;
#pragma unroll
        for (int j = 0; j < 4; ++j) { *(float4*)(H + (size_t)row * D + lane * 4 + 256 * j) = h[j]; s2 += h[j].x * h[j].x + h[j].y * h[j].y + h[j].z * h[j].z + h[j].w * h[j].w; }
        s2 = wsum(s2); const float r2 = rsqrtf(s2 * (1.0f / D) + NORM_EPS);
#pragma unroll
        for (int j = 0; j < 4; ++j) { u32x2 w; w.x = cvt_pk_bf16(h[j].x * r2 * Bv[j].x + Cv[j].x, h[j].y * r2 * Bv[j].y + Cv[j].y); w.y = cvt_pk_bf16(h[j].z * r2 * Bv[j].z + Cv[j].z, h[j].w * r2 * Bv[j].w + Cv[j].w);
            *(u32x2*)(U + (size_t)row * D + lane * 4 + 256 * j) = w; }
    }
}

struct EpiGU {
    static constexpr bool PERM = true, AFTER_DRAIN = false;
    bf16_t* O;
    __device__ __forceinline__ void operator()(const f32x4 (&acc)[2][2][4][2], const pg8::Unit& u, int wr, int wc, int fr, int fq) const {
        const int row0 = u.pm * 256 + wr * 64 + fr, col0 = u.pn * 128 + wc * 32 + 8 * fq;
#pragma unroll
        for (int ai = 0; ai < 2; ++ai)
#pragma unroll
            for (int m = 0; m < 4; ++m) { float o[8];
#pragma unroll
                for (int n = 0; n < 2; ++n)
#pragma unroll
                    for (int j = 0; j < 4; ++j) { const float g = acc[ai][0][m][n][j], up = acc[ai][1][m][n][j]; o[n * 4 + j] = g * __builtin_amdgcn_rcpf(1.0f + __expf(-g)) * up; }
                u32x4 w; w.x = cvt_pk_bf16(o[0], o[1]); w.y = cvt_pk_bf16(o[2], o[3]); w.z = cvt_pk_bf16(o[4], o[5]); w.w = cvt_pk_bf16(o[6], o[7]);
                *(u32x4*)(O + (size_t)(row0 + ai * 128 + m * 16) * DFF + col0) = w; }
    }
};

struct TailOrder {
    int nsplit, kp, G, c;
    __device__ void init(int K, int KP, int G_, int c_) { kp = KP; nsplit = (K / 64) / KP; G = G_; c = c_; }
    __device__ bool next(int i, pg8::Unit& u) const {
        const long L = (long)i * G + c;
        if (L < 256) { int wgid = (int)L; { const int q = 256 / 8, xcd = wgid % 8, off = wgid / 8; wgid = xcd * q + off; }
            const int nig = 8 * 4, gid = wgid / nig, fm = gid * 8; u.pm = fm + ((wgid % nig) % 8); u.pn = (wgid % nig) / 8; u.kt0 = 0; u.nkt = 0; return true; }
        const int L2 = (int)(L - 256); if (L2 >= 8 * nsplit) return false;
        const int tile = L2 / nsplit, ks = L2 % nsplit; u.pm = 64 + (tile >> 2); u.pn = tile & 3; u.kt0 = ks * kp; u.nkt = kp; return true;
    }
    __device__ __forceinline__ void a_ready(const pg8::Unit&) const {}
    __device__ __forceinline__ void done(const pg8::Unit&) const {}
};
struct EpiF32 {
    static constexpr bool PERM = true, AFTER_DRAIN = false;
    bf16_t* C; float* YC;
    __device__ __forceinline__ void operator()(const f32x4 (&acc)[2][2][4][2], const pg8::Unit& u, int wr, int wc, int fr, int fq) const {
        const int row0 = u.pm * 256 + wr * 64 + fr, col0 = u.pn * 256 + wc * 32 + 8 * fq;
        if (u.pm < 64) {
#pragma unroll
            for (int ai = 0; ai < 2; ++ai)
#pragma unroll
                for (int m = 0; m < 4; ++m) { bf16_t* rowp = C + (size_t)(row0 + ai * 128 + m * 16) * D + col0;
#pragma unroll
                    for (int bj = 0; bj < 2; ++bj) { const f32x4 v0 = acc[ai][bj][m][0], v1 = acc[ai][bj][m][1];
                        u32x4 w; w.x = cvt_pk_bf16(v0[0], v0[1]); w.y = cvt_pk_bf16(v0[2], v0[3]); w.z = cvt_pk_bf16(v1[0], v1[1]); w.w = cvt_pk_bf16(v1[2], v1[3]);
                        *(u32x4*)(rowp + bj * 128) = w; } }
        } else { float* base = YC + (size_t)(u.kt0 >> 2) * TC * D;
#pragma unroll
            for (int ai = 0; ai < 2; ++ai)
#pragma unroll
                for (int m = 0; m < 4; ++m) { float* rowp = base + (size_t)(row0 - TL + ai * 128 + m * 16) * D + col0;
#pragma unroll
                    for (int bj = 0; bj < 2; ++bj)
#pragma unroll
                        for (int n = 0; n < 2; ++n) *(f32x4*)(rowp + bj * 128 + n * 4) = acc[ai][bj][m][n]; }
        }
    }
};
template <class Epi> __device__ __forceinline__ void run_gemm_tail(LAS unsigned char* lds, const bf16_t* A, const bf16_t* Bt, int K, const Epi& E) {
    asm volatile("" : "+s"(K));
    pg8::Gemm g{A, Bt, T, D, K}; TailOrder S; S.init(K, 4, (int)gridDim.x, (int)blockIdx.x);
    pg8::gemm_phase<Epi, TailOrder>(lds, g, S, E);
    __syncthreads();
}
__device__ __forceinline__ void zero_yc(const Params& P) { float4* z = (float4*)(P.ws + WS_YC); for (int i = blockIdx.x * NTHR + otid(); i < TC * D / 4; i += gridDim.x * NTHR) z[i] = make_float4(0.f, 0.f, 0.f, 0.f); }
struct EpiWin {
    static constexpr bool PERM = true, AFTER_DRAIN = false;
    bf16_t* PHYT; bf16_t* PRW; bf16_t* PNA;
    __device__ __forceinline__ void operator()(const f32x4 (&acc)[2][2][4][2], const pg8::Unit& u, int wr, int wc, int fr, int fq) const {
        const int row0 = u.pm * 256 + wr * 64 + fr;
        if (u.pn < 3) {
#pragma unroll
            for (int bj = 0; bj < 2; ++bj) { bf16_t* cp = PHYT + (size_t)(u.pn * 256 + bj * 128 + wc * 32 + 8 * fq) * T + row0;
#pragma unroll
                for (int ai = 0; ai < 2; ++ai)
#pragma unroll
                    for (int m = 0; m < 4; ++m) { const f32x4 v0 = acc[ai][bj][m][0], v1 = acc[ai][bj][m][1]; bf16_t* rp = cp + ai * 128 + m * 16;
                        const unsigned w0 = cvt_pk_bf16(v0[0], v0[1]), w1 = cvt_pk_bf16(v0[2], v0[3]), w2 = cvt_pk_bf16(v1[0], v1[1]), w3 = cvt_pk_bf16(v1[2], v1[3]);
                        rp[0] = (bf16_t)w0; rp[(size_t)T] = (bf16_t)(w0 >> 16); rp[(size_t)2 * T] = (bf16_t)w1; rp[(size_t)3 * T] = (bf16_t)(w1 >> 16);
                        rp[(size_t)4 * T] = (bf16_t)w2; rp[(size_t)5 * T] = (bf16_t)(w2 >> 16); rp[(size_t)6 * T] = (bf16_t)w3; rp[(size_t)7 * T] = (bf16_t)(w3 >> 16); } }
            return; }
        bf16_t* base; int ld, cbase;
        if (u.pn < 9) { base = PRW; ld = RW_IN; cbase = u.pn * 256 - HY_IN; }
        else { base = PNA; ld = NA_IN; cbase = u.pn * 256 - HY_IN - RW_IN; }
        const int nbj = (u.pn == 13) ? 1 : 2;
#pragma unroll
        for (int ai = 0; ai < 2; ++ai)
#pragma unroll
            for (int m = 0; m < 4; ++m)
#pragma unroll
                for (int bj = 0; bj < 2; ++bj) { if (bj < nbj) { const f32x4 v0 = acc[ai][bj][m][0], v1 = acc[ai][bj][m][1];
                    u32x4 w; w.x = cvt_pk_bf16(v0[0], v0[1]); w.y = cvt_pk_bf16(v0[2], v0[3]); w.z = cvt_pk_bf16(v1[0], v1[1]); w.w = cvt_pk_bf16(v1[2], v1[3]);
                    *(u32x4*)(base + (size_t)(row0 + ai * 128 + m * 16) * ld + cbase + bj * 128 + wc * 32 + 8 * fq) = w; } }
    }
};
struct EpiLora {
    static constexpr bool PERM = true, AFTER_DRAIN = false;
    bf16_t* LO; bf16_t* GATE;
    __device__ __forceinline__ void operator()(const f32x4 (&acc)[2][2][4][2], const pg8::Unit& u, int wr, int wc, int fr, int fq) const {
        const int row0 = u.pm * 256 + wr * 64 + fr;
        bf16_t* base; int ld, cbase;
        if (u.pn < 6) { base = LO; ld = 1536; cbase = u.pn * 256; } else { base = GATE; ld = 384; cbase = u.pn * 256 - 1536; }
        const int nbj = (u.pn == 7) ? 1 : 2;
#pragma unroll
        for (int ai = 0; ai < 2; ++ai)
#pragma unroll
            for (int m = 0; m < 4; ++m)
#pragma unroll
                for (int bj = 0; bj < 2; ++bj) { if (bj < nbj) { const f32x4 v0 = acc[ai][bj][m][0], v1 = acc[ai][bj][m][1];
                    u32x4 w; w.x = cvt_pk_bf16(v0[0], v0[1]); w.y = cvt_pk_bf16(v0[2], v0[3]); w.z = cvt_pk_bf16(v1[0], v1[1]); w.w = cvt_pk_bf16(v1[2], v1[3]);
                    *(u32x4*)(base + (size_t)(row0 + ai * 128 + m * 16) * ld + cbase + bj * 128 + wc * 32 + 8 * fq) = w; } }
    }
};
template <class Epi> __device__ __forceinline__ void run_gemm(LAS unsigned char* lds, const bf16_t* A, const bf16_t* Bt, int M, int N, int K, const Epi& E) {
    asm volatile("" : "+s"(K));
    pg8::Gemm g{A, Bt, M, N, K}; pg8::StaticOrder S; S.init(M, N, (int)gridDim.x, (int)blockIdx.x);
    pg8::gemm_phase<Epi, pg8::StaticOrder>(lds, g, S, E);
    __syncthreads();
}

__device__ __forceinline__ void ph_loraprep(const Params& P, int l) {
    const bf16_t* PRW = (const bf16_t*)(P.ws + WS_PRW); bf16_t* AL = (bf16_t*)(P.ws + WS_ALORA);
    const float* mu = P.in[I_MU] + (size_t)l * 2 * RW_IN;
    const int gtid = blockIdx.x * NTHR + otid(), gn = gridDim.x * NTHR;
    for (int it = gtid; it < T * 48; it += gn) {
        const int row = it / 48, j8 = it % 48, col = 1152 + j8 * 8;
        bool hp, hn; row_nbrs(row, hp, hn);
        float p[8], pp[8], pn[8];
        unpack8(*(const u32x4*)(PRW + (size_t)row * RW_IN + col), p);
        if (hp) unpack8(*(const u32x4*)(PRW + (size_t)(row - 1) * RW_IN + col), pp); else {
#pragma unroll
            for (int i = 0; i < 8; ++i) pp[i] = 0.f; }
        if (hn) unpack8(*(const u32x4*)(PRW + (size_t)(row + 1) * RW_IN + col), pn); else {
#pragma unroll
            for (int i = 0; i < 8; ++i) pn[i] = 0.f; }
        float o[8];
#pragma unroll
        for (int i = 0; i < 8; ++i) { const float xs = p[i] + mu[col + i] * (pp[i] - p[i]) + mu[RW_IN + col + i] * (pn[i] - p[i]);
            o[i] = j8 < 16 ? tanhf(xs) : (j8 < 32 ? xs : sigmoidf_(xs)); }
        u32x4 w; w.x = cvt_pk_bf16(o[0], o[1]); w.y = cvt_pk_bf16(o[2], o[3]); w.z = cvt_pk_bf16(o[4], o[5]); w.w = cvt_pk_bf16(o[6], o[7]);
        *(u32x4*)(AL + (size_t)row * 384 + j8 * 8) = w;
    }
}

__device__ __forceinline__ void ph_rwkvprep(const Params& P, int l) {
    const int tid = otid(), lane = tid & 63, gw = blockIdx.x * NWAVE + (tid >> 6), nw = gridDim.x * NWAVE;
    const int nrw = nw / 6, h = gw % 6, rw0 = gw / 6;
    if (rw0 >= nrw) return;
    const bf16_t* PRW = (const bf16_t*)(P.ws + WS_PRW); const bf16_t* LO = (const bf16_t*)(P.ws + WS_LORAO);
    bf16_t* RS = (bf16_t*)(P.ws + WS_RS); bf16_t* KKS = (bf16_t*)(P.ws + WS_KKS); bf16_t* VS = (bf16_t*)(P.ws + WS_VS); bf16_t* KS = (bf16_t*)(P.ws + WS_KS); bf16_t* BS = (bf16_t*)(P.ws + WS_BS);
    float* BON = (float*)(P.ws + WS_BONUS); float* DEC = (float*)(P.ws + WS_DECAY);
    const float2* RT = (const float2*)(P.ws + WS_ROPE);
    const float* mu = P.in[I_MU] + (size_t)l * 2 * RW_IN;
    const int c = h * 64 + lane, f = lane & 15;
    const float mp0 = mu[c], mn0 = mu[RW_IN + c], mp1 = mu[384 + c], mn1 = mu[RW_IN + 384 + c], mp2 = mu[768 + c], mn2 = mu[RW_IN + 768 + c];
    const float ckk = P.in[I_KK][l * RWW + c], cka = P.in[I_KA][l * RWW + c], crk = P.in[I_RK][l * RWW + c];
    const float ca0 = P.in[I_A0][(size_t)l * 2 * RWW + c], ca1 = P.in[I_A0][(size_t)l * 2 * RWW + RWW + c], cw0 = P.in[I_W0][(size_t)l * 2 * RWW + c], cw1 = P.in[I_W0][(size_t)l * 2 * RWW + RWW + c];
    const float sg = (lane & 16) ? 1.f : -1.f;
#pragma unroll 2
    for (int row = rw0; row < T; row += nrw) {
        bool hp, hn; row_nbrs(row, hp, hn);
        const bf16_t* pr = PRW + (size_t)row * RW_IN + c; const int om = hp ? -RW_IN : 0, op = hn ? RW_IN : 0; const float fm = hp ? 1.f : 0.f, fp = hn ? 1.f : 0.f;
        const float r0 = bf2f(pr[0]), k0 = bf2f(pr[384]), v0 = bf2f(pr[768]);
        const float r = r0 + mp0 * (fm * bf2f(pr[om]) - r0) + mn0 * (fp * bf2f(pr[op]) - r0);
        const float k = k0 + mp1 * (fm * bf2f(pr[384 + om]) - k0) + mn1 * (fp * bf2f(pr[384 + op]) - k0);
        const float v = v0 + mp2 * (fm * bf2f(pr[768 + om]) - v0) + mn2 * (fp * bf2f(pr[768 + op]) - v0);
        const bf16_t* lo = LO + (size_t)row * 1536 + c;
        const float a0 = sigmoidf_(bf2f(lo[768]) + ca0), a1 = sigmoidf_(bf2f(lo[1152]) + ca1);
        const float x0 = bf2f(lo[0]) + cw0, x1 = bf2f(lo[384]) + cw1;
        const float kkr = k * ckk;
        const float nrm = sqrtf(wsum(kkr * kkr));
        const float kk = kkr / fmaxf(nrm, 1e-12f);
        float kd0 = k * (1.f + (a0 - 1.f) * cka), kd1 = k * (1.f + (a1 - 1.f) * cka);
        float b0 = kk * a0, b1 = kk * a1;
        const float bon = wsum(r * (kd0 + kd1) * crk);
        float rs = r, kks = kk;
        if (row < TL) {
            const int t = row & (SEQ - 1); const int pos = (lane < 32) ? (t >> 6) : (t & 63);
            const float2 csn = RT[pos * 16 + f]; const float cs = csn.x, sn = csn.y;
            const float r2 = __shfl_xor(rs, 16), k2 = __shfl_xor(kks, 16), d0 = __shfl_xor(kd0, 16), d1 = __shfl_xor(kd1, 16), e0 = __shfl_xor(b0, 16), e1 = __shfl_xor(b1, 16);
            rs = rs * cs + sg * r2 * sn; kks = kks * cs + sg * k2 * sn; kd0 = kd0 * cs + sg * d0 * sn; kd1 = kd1 * cs + sg * d1 * sn; b0 = b0 * cs + sg * e0 * sn; b1 = b1 * cs + sg * e1 * sn;
        }
        const size_t o = (size_t)row * 384 + c;
        DEC[o] = __expf(-0.6065306597f * sigmoidf_(x0)); DEC[(size_t)T * 384 + o] = __expf(-0.6065306597f * sigmoidf_(x1));
        if (lane == 0) BON[(size_t)row * 6 + h] = bon;
        RS[o] = f2bf(rs); KKS[o] = f2bf(-kks); VS[o] = f2bf(v);
        KS[o] = f2bf(kd0); KS[(size_t)T * 384 + o] = f2bf(kd1); BS[o] = f2bf(b0); BS[(size_t)T * 384 + o] = f2bf(b1);
    }
}

__device__ __forceinline__ int scan_row(int b, int d, int step) {
    if (step < CTX) { const int tc = d ? (CTX - 1 - step) : step; return TL + b * CTX + tc; }
    const int tl = d ? (SEQ - 1 - (step - CTX)) : (step - CTX); return b * SEQ + tl;
}
__device__ __forceinline__ void scan_task_v1(const Params& P, int task, float* sv) {
    const int lane = otid() & 63;
    const int d = task & 1, h = (task >> 1) % 6, b = task / 12;
    const float* DEC = (const float*)(P.ws + WS_DECAY) + (size_t)d * T * 384; const bf16_t* KKS = (const bf16_t*)(P.ws + WS_KKS); const bf16_t* RS = (const bf16_t*)(P.ws + WS_RS);
    const bf16_t* VS = (const bf16_t*)(P.ws + WS_VS); const bf16_t* KS = (const bf16_t*)(P.ws + WS_KS) + (size_t)d * T * 384; const bf16_t* BS = (const bf16_t*)(P.ws + WS_BS) + (size_t)d * T * 384;
    float* YD = (float*)(P.ws + WS_YDIR) + (size_t)d * T * 384;
    float S[64];
#pragma unroll
    for (int j = 0; j < 64; ++j) S[j] = 0.f;
    size_t o = (size_t)scan_row(b, d, 0) * 384 + h * 64 + lane;
    float nw_ = DEC[o], na = bf2f(KKS[o]), nb = bf2f(BS[o]), nk = bf2f(KS[o]), nr = bf2f(RS[o]), nv = bf2f(VS[o]);
    for (int step = 0; step < CTX + SEQ; ++step) {
        const float v = nv; const size_t oc = o;
        asm volatile("s_waitcnt lgkmcnt(0)" ::: "memory");
        sv[lane] = nw_; sv[64 + lane] = na; sv[128 + lane] = nb; sv[192 + lane] = nk; sv[256 + lane] = nr;
        asm volatile("s_waitcnt lgkmcnt(0)" ::: "memory");
        if (step + 1 < CTX + SEQ) { o = (size_t)scan_row(b, d, step + 1) * 384 + h * 64 + lane;
            nw_ = DEC[o]; na = bf2f(KKS[o]); nb = bf2f(BS[o]); nk = bf2f(KS[o]); nr = bf2f(RS[o]); nv = bf2f(VS[o]); }
        float sa0 = 0.f, sa1 = 0.f, sa2 = 0.f, sa3 = 0.f;
#pragma unroll
        for (int j = 0; j < 64; j += 4) { const float4 a4 = *(const float4*)(sv + 64 + j);
            sa0 += S[j + 0] * a4.x; sa1 += S[j + 1] * a4.y; sa2 += S[j + 2] * a4.z; sa3 += S[j + 3] * a4.w; }
        const float sa = (sa0 + sa1) + (sa2 + sa3);
        float y0 = 0.f, y1 = 0.f, y2 = 0.f, y3 = 0.f;
#pragma unroll
        for (int j = 0; j < 64; j += 4) {
            const float4 w4 = *(const float4*)(sv + j), b4 = *(const float4*)(sv + 128 + j), k4 = *(const float4*)(sv + 192 + j), r4 = *(const float4*)(sv + 256 + j);
            S[j + 0] = S[j + 0] * w4.x + sa * b4.x + v * k4.x; y0 += S[j + 0] * r4.x;
            S[j + 1] = S[j + 1] * w4.y + sa * b4.y + v * k4.y; y1 += S[j + 1] * r4.y;
            S[j + 2] = S[j + 2] * w4.z + sa * b4.z + v * k4.z; y2 += S[j + 2] * r4.z;
            S[j + 3] = S[j + 3] * w4.w + sa * b4.w + v * k4.w; y3 += S[j + 3] * r4.w; }
        YD[oc] = (y0 + y1) + (y2 + y3);
    }
}

__device__ __forceinline__ void natt_key(const bf16_t* PNA, size_t krow, int hoff, const float (&q)[16], float bias, float& m, float& lsum, float (&o)[16]) {
    const bf16_t* kp = PNA + krow * NA_IN + 384 + hoff; const bf16_t* vp = PNA + krow * NA_IN + 768 + hoff;
    float s = 0.f;
#pragma unroll
    for (int j8 = 0; j8 < 2; ++j8) { float kf[8]; unpack8(*(const u32x4*)(kp + j8 * 8), kf);
#pragma unroll
        for (int i = 0; i < 8; ++i) s += q[j8 * 8 + i] * kf[i]; }
    s += __shfl_xor(s, 1); s += __shfl_xor(s, 2); s += bias;
    const float mn = fmaxf(m, s), corr = __expf(m - mn), p = __expf(s - mn);
    m = mn; lsum = lsum * corr + p;
#pragma unroll
    for (int j8 = 0; j8 < 2; ++j8) { float vf[8]; unpack8(*(const u32x4*)(vp + j8 * 8), vf);
#pragma unroll
        for (int i = 0; i < 8; ++i) o[j8 * 8 + i] = o[j8 * 8 + i] * corr + p * vf[i]; }
}
__device__ __forceinline__ void natten_items_v1(const Params& P, int l, int wid0, int nworkers) {
    const bf16_t* PNA = (const bf16_t*)(P.ws + WS_PNA); bf16_t* MIX = (bf16_t*)(P.ws + WS_U);
    const float* rpb = P.in[I_RPB] + (size_t)l * 6 * 15 * 31;
    const int sub = wid0 & 3;
    for (int it = wid0 >> 2; it < T * 6; it += nworkers >> 2) {
        const int row = it % T, h = it / T, hoff = h * 64 + sub * 16;
        float q[16], o[16];
#pragma unroll
        for (int j8 = 0; j8 < 2; ++j8) { float qf[8]; unpack8(*(const u32x4*)(PNA + (size_t)row * NA_IN + hoff + j8 * 8), qf);
#pragma unroll
            for (int i = 0; i < 8; ++i) { q[j8 * 8 + i] = qf[i] * 0.125f; o[j8 * 8 + i] = 0.f; } }
        float m = -3.0e38f, lsum = 0.f;
        int b;
        if (row < TL) { b = row >> 13; const int t = row & (SEQ - 1), i = t >> 6, col = t & 63;
            const int start = min(max(i - 4, 0), 120), win0 = min(max(col - 8, 0), 48);
            for (int r = 0; r < 8; ++r) for (int kc = win0; kc < win0 + 16; ++kc) {
                const float bias = rpb[(h * 15 + (start + r - i + 7)) * 31 + (kc - col + 15)];
                natt_key(PNA, (size_t)b * SEQ + (start + r) * 64 + kc, hoff, q, bias, m, lsum, o); }
        } else b = (row - TL) >> 8;
        for (int c = 0; c < CTX; ++c) natt_key(PNA, (size_t)TL + b * CTX + c, hoff, q, 0.f, m, lsum, o);
        const float il = 1.0f / lsum;
#pragma unroll
        for (int j8 = 0; j8 < 2; ++j8) { u32x4 w; w.x = cvt_pk_bf16(o[j8 * 8 + 0] * il, o[j8 * 8 + 1] * il); w.y = cvt_pk_bf16(o[j8 * 8 + 2] * il, o[j8 * 8 + 3] * il);
            w.z = cvt_pk_bf16(o[j8 * 8 + 4] * il, o[j8 * 8 + 5] * il); w.w = cvt_pk_bf16(o[j8 * 8 + 6] * il, o[j8 * 8 + 7] * il);
            *(u32x4*)(MIX + (size_t)row * D + 640 + hoff + j8 * 8) = w; }
    }
}

__device__ __forceinline__ void vt_tile(const Params& P, int tile, unsigned short* tl  ) {
    const int tid = otid();
    const bf16_t* PNA = (const bf16_t*)(P.ws + WS_PNA);
    int h, tok0; bf16_t* dst; int ldt;
    if (tile < NB * 128 * 6) { h = tile % 6; const int sb = tile / 6; const int b = sb >> 7, blk = sb & 127; tok0 = b * SEQ + blk * 64; dst = (bf16_t*)(P.ws + WS_VTL) + ((size_t)(b * 6 + h) * 64) * SEQ + blk * 64; ldt = SEQ; }
    else { const int tt = tile - NB * 128 * 6; h = tt % 6; const int sb = tt / 6; const int b = sb >> 2, blk = sb & 3; tok0 = TL + b * CTX + blk * 64; dst = (bf16_t*)(P.ws + WS_VTC) + ((size_t)(b * 6 + h) * 64) * CTX + blk * 64; ldt = CTX; }
    { const int tok = tid >> 3, seg = tid & 7; const u32x4 v = *(const u32x4*)(PNA + (size_t)(tok0 + tok) * NA_IN + 768 + h * 64 + seg * 8);
      unsigned* w = (unsigned*)(tl + tok * 72 + seg * 8); w[0] = v.x; w[1] = v.y; w[2] = v.z; w[3] = v.w; }
    __syncthreads();
    { const int hd = tid >> 3, ts = tid & 7; unsigned short e[8];
#pragma unroll
      for (int k = 0; k < 8; ++k) e[k] = tl[(ts * 8 + k) * 72 + hd];
      u32x4 w; w.x = (unsigned)e[0] | ((unsigned)e[1] << 16); w.y = (unsigned)e[2] | ((unsigned)e[3] << 16); w.z = (unsigned)e[4] | ((unsigned)e[5] << 16); w.w = (unsigned)e[6] | ((unsigned)e[7] << 16);
      *(u32x4*)(dst + (size_t)hd * ldt + ts * 8) = w; }
    __syncthreads();
}
constexpr int NAT_LAT_TASKS = NB * 128 * 4 * 6, NAT_CTX_TASKS = NB * 16 * 6, NAT_TASKS = NAT_LAT_TASKS + NAT_CTX_TASKS;
__device__ __forceinline__ void natten_task(const Params& P, int l, int task) {
    using pg8::bf16x8;
    const int lane = otid() & 63, fr = lane & 15, fq = lane >> 4;
    const bf16_t* PNA = (const bf16_t*)(P.ws + WS_PNA); bf16_t* MIX = (bf16_t*)(P.ws + WS_U);
    const bool lat = task < NAT_LAT_TASKS;
    int b, h, i = 0, n = 0, qtok0;
    if (lat) { h = task % 6; const int r = task / 6; n = r & 3; i = (r >> 2) & 127; b = r >> 9; qtok0 = b * SEQ + i * 64 + 16 * n; }
    else { const int tt = task - NAT_LAT_TASKS; h = tt % 6; const int qb = (tt / 6) & 15; b = tt / 96; qtok0 = TL + b * CTX + 16 * qb; }
    const int start = min(max(i - 4, 0), 120), band0 = min(max(16 * n - 8, 0), 32);
    const int col = 16 * n + fr, win0 = min(max(col - 8, 0), 48);
    bf16x8 bq[2];
#pragma unroll
    for (int kh = 0; kh < 2; ++kh) bq[kh] = *(const bf16x8*)(PNA + (size_t)(qtok0 + fr) * NA_IN + h * 64 + kh * 32 + fq * 8);
    f32x4 sc[32];
    if (lat) {
#pragma unroll
        for (int t = 0; t < 16; ++t) { const int tok0 = b * SEQ + (start + (t >> 1)) * 64 + band0 + 16 * (t & 1);
            const bf16_t* kp = PNA + (size_t)(tok0 + fr) * NA_IN + 384 + h * 64 + fq * 8;
            const bf16x8 k0 = *(const bf16x8*)kp, k1 = *(const bf16x8*)(kp + 32);
            f32x4 a = (f32x4){0.f, 0.f, 0.f, 0.f};
            a = __builtin_amdgcn_mfma_f32_16x16x32_bf16(k0, bq[0], a, 0, 0, 0); a = __builtin_amdgcn_mfma_f32_16x16x32_bf16(k1, bq[1], a, 0, 0, 0);
            sc[t] = a; if ((t & 3) == 3) asm volatile("" ::: "memory"); }
    } else {
#pragma unroll
        for (int t = 0; t < 16; ++t) sc[t] = (f32x4){-3.0e38f, -3.0e38f, -3.0e38f, -3.0e38f};
    }
#pragma unroll
    for (int t = 16; t < 32; ++t) { const int tok0 = TL + b * CTX + 16 * (t - 16);
        const bf16_t* kp = PNA + (size_t)(tok0 + fr) * NA_IN + 384 + h * 64 + fq * 8;
        const bf16x8 k0 = *(const bf16x8*)kp, k1 = *(const bf16x8*)(kp + 32);
        f32x4 a = (f32x4){0.f, 0.f, 0.f, 0.f};
        a = __builtin_amdgcn_mfma_f32_16x16x32_bf16(k0, bq[0], a, 0, 0, 0); a = __builtin_amdgcn_mfma_f32_16x16x32_bf16(k1, bq[1], a, 0, 0, 0);
        sc[t] = a * 0.125f; if ((t & 3) == 3) asm volatile("" ::: "memory"); }
    if (lat) { const float* rpb = P.in[I_RPB] + ((size_t)l * 6 + h) * 15 * 31;
#pragma unroll
        for (int t = 0; t < 16; ++t) { const int ro = start + (t >> 1) - i + 7; const int kc0 = band0 + 16 * (t & 1) + fq * 4;
#pragma unroll
            for (int j = 0; j < 4; ++j) { const int kc = kc0 + j; const bool ok = kc >= win0 && kc < win0 + 16; const int co = min(max(kc - col + 15, 0), 30);
                const float bias = rpb[ro * 31 + co]; sc[t][j] = ok ? sc[t][j] * 0.125f + bias : -3.0e38f; } } }
    float mx = -3.0e38f;
#pragma unroll
    for (int t = 0; t < 32; ++t) mx = fmaxf(mx, fmaxf(fmaxf(sc[t][0], sc[t][1]), fmaxf(sc[t][2], sc[t][3])));
    mx = fmaxf(mx, __shfl_xor(mx, 16)); mx = fmaxf(mx, __shfl_xor(mx, 32));
    float sum = 0.f;
#pragma unroll
    for (int t = 0; t < 32; ++t) {
#pragma unroll
        for (int j = 0; j < 4; ++j) { const float p = __expf(sc[t][j] - mx); sc[t][j] = p; sum += p; } }
    sum += __shfl_xor(sum, 16); sum += __shfl_xor(sum, 32);
    const float inv = 1.0f / sum;
    f32x4 ot[4];
#pragma unroll
    for (int q = 0; q < 4; ++q) ot[q] = (f32x4){0.f, 0.f, 0.f, 0.f};
    const bf16_t* VTL = (const bf16_t*)(P.ws + WS_VTL) + ((size_t)(b * 6 + h) * 64) * SEQ; const bf16_t* VTC = (const bf16_t*)(P.ws + WS_VTC) + ((size_t)(b * 6 + h) * 64) * CTX;
    if (lat) {
#pragma unroll
        for (int m = 0; m < 8; ++m) { const int tk = (start + m) * 64 + band0 + fq * 4;
            u32x4 pw; pw.x = cvt_pk_bf16(sc[2 * m][0], sc[2 * m][1]); pw.y = cvt_pk_bf16(sc[2 * m][2], sc[2 * m][3]); pw.z = cvt_pk_bf16(sc[2 * m + 1][0], sc[2 * m + 1][1]); pw.w = cvt_pk_bf16(sc[2 * m + 1][2], sc[2 * m + 1][3]);
            const bf16x8 pb = __builtin_bit_cast(bf16x8, pw);
#pragma unroll
            for (int q = 0; q < 4; ++q) { const bf16_t* vp = VTL + (size_t)(q * 16 + fr) * SEQ + tk; const u32x2 v0 = *(const u32x2*)vp, v1 = *(const u32x2*)(vp + 16);
                u32x4 vw; vw.x = v0.x; vw.y = v0.y; vw.z = v1.x; vw.w = v1.y;
                ot[q] = __builtin_amdgcn_mfma_f32_16x16x32_bf16(__builtin_bit_cast(bf16x8, vw), pb, ot[q], 0, 0, 0); }
            if (m & 1) asm volatile("" ::: "memory"); }
    }
#pragma unroll
    for (int m = 0; m < 8; ++m) { const int tk = 32 * m + fq * 4;
        u32x4 pw; pw.x = cvt_pk_bf16(sc[16 + 2 * m][0], sc[16 + 2 * m][1]); pw.y = cvt_pk_bf16(sc[16 + 2 * m][2], sc[16 + 2 * m][3]); pw.z = cvt_pk_bf16(sc[17 + 2 * m][0], sc[17 + 2 * m][1]); pw.w = cvt_pk_bf16(sc[17 + 2 * m][2], sc[17 + 2 * m][3]);
        const bf16x8 pb = __builtin_bit_cast(bf16x8, pw);
#pragma unroll
        for (int q = 0; q < 4; ++q) { const bf16_t* vp = VTC + (size_t)(q * 16 + fr) * CTX + tk; const u32x2 v0 = *(const u32x2*)vp, v1 = *(const u32x2*)(vp + 16);
            u32x4 vw; vw.x = v0.x; vw.y = v0.y; vw.z = v1.x; vw.w = v1.y;
            ot[q] = __builtin_amdgcn_mfma_f32_16x16x32_bf16(__builtin_bit_cast(bf16x8, vw), pb, ot[q], 0, 0, 0); }
        if (m & 1) asm volatile("" ::: "memory"); }
#pragma unroll
    for (int q = 0; q < 4; ++q) { u32x2 w; w.x = cvt_pk_bf16(ot[q][0] * inv, ot[q][1] * inv); w.y = cvt_pk_bf16(ot[q][2] * inv, ot[q][3] * inv);
        *(u32x2*)(MIX + (size_t)(qtok0 + fr) * D + 640 + h * 64 + q * 16 + fq * 4) = w; }
}

__device__ __forceinline__ void fft_fwd(float2* X) {
#pragma unroll 1
    for (int lq = 12; lq >= 0; lq -= 2) { const int q = 1 << lq; const float rq = 1.0f / (float)(4 * q);
        for (int j = otid(); j < NFFT / 4; j += NTHR) { const int lo = j & (q - 1), base = ((j >> lq) << (lq + 2)) | lo;
            const float2 x0 = X[base], x1 = X[base + q], x2 = X[base + 2 * q], x3 = X[base + 3 * q];
            const float fr = (float)lo * rq; const float c = __builtin_amdgcn_cosf(fr), s = __builtin_amdgcn_sinf(fr), c2 = c * c - s * s, s2 = 2.f * c * s;
            const float a0x = x0.x + x2.x, a0y = x0.y + x2.y, dx = x0.x - x2.x, dy = x0.y - x2.y;
            const float a2x = dx * c + dy * s, a2y = dy * c - dx * s;
            const float a1x = x1.x + x3.x, a1y = x1.y + x3.y, ex = x1.x - x3.x, ey = x1.y - x3.y;
            const float mx = ex * c + ey * s, my = ey * c - ex * s;
            const float a3x = my, a3y = -mx;
            const float fx = a0x - a1x, fy = a0y - a1y, gx = a2x - a3x, gy = a2y - a3y;
            X[base] = make_float2(a0x + a1x, a0y + a1y); X[base + q] = make_float2(fx * c2 + fy * s2, fy * c2 - fx * s2);
            X[base + 2 * q] = make_float2(a2x + a3x, a2y + a3y); X[base + 3 * q] = make_float2(gx * c2 + gy * s2, gy * c2 - gx * s2); }
        __syncthreads(); }
}
__device__ __forceinline__ void fft_inv(float2* X) {
#pragma unroll 1
    for (int lq = 0; lq <= 12; lq += 2) { const int q = 1 << lq; const float rq = 1.0f / (float)(4 * q);
        for (int j = otid(); j < NFFT / 4; j += NTHR) { const int lo = j & (q - 1), base = ((j >> lq) << (lq + 2)) | lo;
            const float2 y0 = X[base], y1 = X[base + q], y2 = X[base + 2 * q], y3 = X[base + 3 * q];
            const float fr = (float)lo * rq; const float c = __builtin_amdgcn_cosf(fr), s = __builtin_amdgcn_sinf(fr), c2 = c * c - s * s, s2 = 2.f * c * s;
            const float tx = y1.x * c2 - y1.y * s2, ty = y1.x * s2 + y1.y * c2;
            const float a0x = y0.x + tx, a0y = y0.y + ty, a1x = y0.x - tx, a1y = y0.y - ty;
            const float ux = y3.x * c2 - y3.y * s2, uy = y3.x * s2 + y3.y * c2;
            const float a2x = y2.x + ux, a2y = y2.y + uy, a3x = y2.x - ux, a3y = y2.y - uy;
            const float vx = a2x * c - a2y * s, vy = a2x * s + a2y * c;
            const float mx = a3x * c - a3y * s, my = a3x * s + a3y * c;
            const float wx = -my, wy = mx;
            X[base] = make_float2(a0x + vx, a0y + vy); X[base + 2 * q] = make_float2(a0x - vx, a0y - vy);
            X[base + q] = make_float2(a1x + wx, a1y + wy); X[base + 3 * q] = make_float2(a1x - wx, a1y - wy); }
        __syncthreads(); }
}
__device__ __forceinline__ float hy_delta(int c) { const float lo = -4.605170185988091f / 1.5f, hi = -4.605170185988091f / 0.3f; return fabsf(lo + (float)c * ((hi - lo) / 255.0f)); }
__device__ __forceinline__ float hy_short(const bf16_t* PHYT, const float* cw, const float* cb, int row, int col) {
    bool hp, hn; row_nbrs(row, hp, hn);
    const bf16_t* p = PHYT + (size_t)col * T + row;
    float v = cb[col] + cw[HY_IN + col] * bf2f(p[0]);
    if (hp) v += cw[col] * bf2f(p[-1]);
    if (hn) v += cw[2 * HY_IN + col] * bf2f(p[1]);
    return v;
}
struct HyTap { float w0, w1, w2, b; };
__device__ __forceinline__ HyTap hy_tap(const float* cw, const float* cb, int col) { HyTap t; t.w0 = cw[col]; t.w1 = cw[HY_IN + col]; t.w2 = cw[2 * HY_IN + col]; t.b = cb[col]; return t; }
__device__ __forceinline__ float hy_lat(const bf16_t* colp, int b, int n, const HyTap t) {
    const bf16_t* p = colp + b * SEQ + n;
    const float xm = bf2f(p[n > 0 ? -1 : 0]), x0 = bf2f(p[0]), xp = bf2f(p[n < SEQ - 1 ? 1 : 0]);
    return t.b + t.w1 * x0 + (n > 0 ? t.w0 * xm : 0.f) + (n < SEQ - 1 ? t.w2 * xp : 0.f);
}
__device__ __forceinline__ void hy_spec_task(const Params& P, int l, int c, float2* X) {
    const int tid = otid();
    const bf16_t* f0 = (const bf16_t*)(P.ws + WS_FILT) + (size_t)c * SEQ; const bf16_t* b0 = f0 + (size_t)256 * SEQ; const bf16_t* f1 = f0 + (size_t)512 * SEQ; const bf16_t* b1 = f0 + (size_t)768 * SEQ;
    for (int n = tid; n < SEQ; n += NTHR) {
        X[n] = make_float2(bf2f(f0[n]), bf2f(f1[n]));
        if (n > 0) X[NFFT - n] = make_float2(bf2f(b0[n]), bf2f(b1[n])); else X[SEQ] = make_float2(0.f, 0.f); }
    __syncthreads();
    fft_fwd(X);
    float2* spec = (float2*)(P.ws + WS_SPEC) + (size_t)c * NFFT;
    for (int i = tid; i < NFFT; i += NTHR) spec[i] = X[i];
    __syncthreads();
}
__device__ __forceinline__ void hy_conv_core(const Params& P, int o, int c, float2* X) {
    fft_fwd(X);
    const float2* spec = (const float2*)(P.ws + WS_SPEC) + (size_t)c * NFFT;
    for (int i = otid(); i < NFFT; i += NTHR) {
        const unsigned f = __brev((unsigned)i) >> 18;
        const unsigned ip = __brev(((unsigned)NFFT - f) & (unsigned)(NFFT - 1)) >> 18;
        const float2 a = X[i], w = spec[i], w2 = spec[ip];
        const float kx = o == 0 ? 0.5f * (w.x + w2.x) : 0.5f * (w.y + w2.y), ky = o == 0 ? 0.5f * (w.y - w2.y) : -0.5f * (w.x - w2.x);
        X[i] = make_float2(a.x * kx - a.y * ky, a.x * ky + a.y * kx); }
    __syncthreads();
    fft_inv(X);
}
__device__ __forceinline__ void hy_task1(const Params& P, int l, int c, float2* X, float* ex) {
    const int tid = otid();
    const bf16_t* PHY = (const bf16_t*)(P.ws + WS_PHY); const float* cw = P.in[I_HCW] + (size_t)l * 3 * HY_IN; const float* cb = P.in[I_HCB] + (size_t)l * HY_IN;
    const float bias0 = P.in[I_HBIAS][(size_t)l * 2 * HYC + c], bias1 = P.in[I_HBIAS][(size_t)l * 2 * HYC + HYC + c];
    const HyTap tv = hy_tap(cw, cb, c), tg1 = hy_tap(cw, cb, HYC + c); const bf16_t* colv = PHY + (size_t)c * T; const bf16_t* colg1 = PHY + (size_t)(HYC + c) * T;
#pragma unroll 4
    for (int n = tid; n < SEQ; n += NTHR) { X[n] = make_float2(hy_lat(colv, 0, n, tv), hy_lat(colv, 1, n, tv)); X[SEQ + n] = make_float2(0.f, 0.f); }
    __syncthreads();
    hy_conv_core(P, 0, c, X);
    float* Z1 = (float*)(P.ws + WS_Z1) + (size_t)c * NB * SEQ;
#pragma unroll 4
    for (int n = tid; n < SEQ; n += NTHR) { const float2 y = X[n];
        const float v0 = hy_lat(colv, 0, n, tv), v1 = hy_lat(colv, 1, n, tv), g0 = hy_lat(colg1, 0, n, tg1), g1 = hy_lat(colg1, 1, n, tg1);
        Z1[n] = g0 * (y.x + bias0 * v0); Z1[SEQ + n] = g1 * (y.y + bias0 * v1); }
    __syncthreads();
    float* f = (float*)X;
    float* vv = f, *x1 = f + 512, *x2 = f + 1024, *hf = f + 1536  , *z1 = f + 2560;
    const bf16_t* fc = (const bf16_t*)(P.ws + WS_FILTC);
    { const int b = tid >> 8, t = tid & 255, row = TL + b * CTX + t;
      vv[tid] = hy_short(PHY, cw, cb, row, c); x1[tid] = hy_short(PHY, cw, cb, row, HYC + c); x2[tid] = hy_short(PHY, cw, cb, row, 2 * HYC + c);
      for (int q = tid; q < 1024; q += NTHR) { const int od = q >> 8, n = q & 255; hf[q] = bf2f(fc[(size_t)(od * 256 + c) * CTX + n]); } }
    __syncthreads();
    { const int b = tid >> 8, t = tid & 255; float y = bias0 * vv[tid];
      for (int s = 0; s <= t; ++s) y += hf[t - s] * vv[b * 256 + s];
      for (int s = t + 1; s < CTX; ++s) y += hf[256 + s - t] * vv[b * 256 + s];
      z1[tid] = x1[tid] * y; }
    __syncthreads();
    { const int b = tid >> 8, t = tid & 255; float y = bias1 * z1[tid];
      for (int s = 0; s <= t; ++s) y += hf[512 + t - s] * z1[b * 256 + s];
      for (int s = t + 1; s < CTX; ++s) y += hf[768 + s - t] * z1[b * 256 + s];
      bf16_t* MIX = (bf16_t*)(P.ws + WS_U); MIX[(size_t)(TL + b * CTX + t) * D + c] = f2bf(x2[tid] * y); }
    __syncthreads();
}
__device__ __forceinline__ void hy_task2(const Params& P, int l, int c, float2* X) {
    const int tid = otid();
    const bf16_t* PHY = (const bf16_t*)(P.ws + WS_PHY); const float* cw = P.in[I_HCW] + (size_t)l * 3 * HY_IN; const float* cb = P.in[I_HCB] + (size_t)l * HY_IN;
    const float bias1 = P.in[I_HBIAS][(size_t)l * 2 * HYC + HYC + c];
    const float* Z1 = (const float*)(P.ws + WS_Z1) + (size_t)c * NB * SEQ; float* Z1w = (float*)(P.ws + WS_Z1) + (size_t)c * NB * SEQ;
    for (int n = tid; n < SEQ; n += NTHR) { X[n] = make_float2(Z1[n], Z1[SEQ + n]); X[SEQ + n] = make_float2(0.f, 0.f); }
    __syncthreads();
    hy_conv_core(P, 1, c, X);
    bf16_t* MIX = (bf16_t*)(P.ws + WS_U);
    const HyTap tg2 = hy_tap(cw, cb, 2 * HYC + c); const bf16_t* colg2 = PHY + (size_t)(2 * HYC + c) * T;
#pragma unroll 4
    for (int n = tid; n < SEQ; n += NTHR) { const float2 y = X[n];
        const float g0 = hy_lat(colg2, 0, n, tg2), g1 = hy_lat(colg2, 1, n, tg2);
        Z1w[n] = g0 * (y.x + bias1 * Z1[n]); Z1w[SEQ + n] = g1 * (y.y + bias1 * Z1[SEQ + n]); }
    __syncthreads();
}

constexpr int SEGC = 256, NSEG = 33, SCH = 4;
typedef float f32x2v __attribute__((ext_vector_type(2)));
template <bool IDENT>
__device__ __forceinline__ void scan_seg(const Params& P, int chain, int g, float* ring_  ) {
    const ldsfp ring = vlds(ring_);
    const int lane = otid() & 63;
    const int d = chain & 1, h = (chain >> 1) % 6, b = chain / 12;
    const float* DEC = (const float*)(P.ws + WS_DECAY) + (size_t)d * T * 384; const bf16_t* KKS = (const bf16_t*)(P.ws + WS_KKS); const bf16_t* RS = (const bf16_t*)(P.ws + WS_RS);
    const bf16_t* VS = (const bf16_t*)(P.ws + WS_VS); const bf16_t* KS = (const bf16_t*)(P.ws + WS_KS) + (size_t)d * T * 384; const bf16_t* BS = (const bf16_t*)(P.ws + WS_BS) + (size_t)d * T * 384;
    float* YD = (float*)(P.ws + WS_YDIR) + (size_t)d * T * 384;
    bf16_t* E = (bf16_t*)(P.ws + WS_E) + (size_t)chain * SEQ * 64;
    const int step0 = g == 0 ? 0 : CTX + (g - 1) * SEGC;
    f32x2v S0[32], S1[32];
#pragma unroll
    for (int j = 0; j < 32; ++j) { S0[j] = (f32x2v){0.f, 0.f}; S1[j] = (f32x2v){(2 * j == lane) ? 1.f : 0.f, (2 * j + 1 == lane) ? 1.f : 0.f}; }
    float pw[SCH], pa[SCH], pb[SCH], pk[SCH], pr[SCH], pv[SCH]; int po[SCH];
#pragma unroll
    for (int s = 0; s < SCH; ++s) { const int o = scan_row(b, d, step0 + s) * 384 + h * 64 + lane; po[s] = o;
        pw[s] = DEC[o]; pa[s] = bf2f(KKS[o]); pb[s] = bf2f(BS[o]); pk[s] = bf2f(KS[o]); pr[s] = bf2f(RS[o]); pv[s] = bf2f(VS[o]); }
    for (int c = 0; c < SEGC / SCH; ++c) {
        float cv[SCH]; int co[SCH];
        asm volatile("s_waitcnt lgkmcnt(0)" ::: "memory");
#pragma unroll
        for (int s = 0; s < SCH; ++s) { const ldsfp sv = ring + s * 320; sv[lane] = pw[s]; sv[64 + lane] = pa[s]; sv[128 + lane] = pb[s]; sv[192 + lane] = pk[s]; sv[256 + lane] = pr[s]; cv[s] = pv[s]; co[s] = po[s]; }
        asm volatile("s_waitcnt lgkmcnt(0)" ::: "memory");
        if (c + 1 < SEGC / SCH) {
#pragma unroll
            for (int s = 0; s < SCH; ++s) { const int o = scan_row(b, d, step0 + (c + 1) * SCH + s) * 384 + h * 64 + lane; po[s] = o;
                pw[s] = DEC[o]; pa[s] = bf2f(KKS[o]); pb[s] = bf2f(BS[o]); pk[s] = bf2f(KS[o]); pr[s] = bf2f(RS[o]); pv[s] = bf2f(VS[o]); } }
#pragma unroll
        for (int s = 0; s < SCH; ++s) { const ldsfp sv = ring + s * 320;
            f32x2v sa2 = (f32x2v){0.f, 0.f}, sb2 = (f32x2v){0.f, 0.f}, sa3 = sa2, sb3 = sa2;
#pragma unroll
            for (int hb = 0; hb < 2; ++hb) { f32x4 A[8];
#pragma unroll
                for (int i = 0; i < 8; ++i) A[i] = *(const LAS f32x4*)(sv + 64 + hb * 32 + 4 * i);
                __builtin_amdgcn_sched_barrier(0);
#pragma unroll
                for (int i = 0; i < 8; ++i) { const int jj = hb * 16 + 2 * i; const f32x2v alo = (f32x2v){A[i].x, A[i].y}, ahi = (f32x2v){A[i].z, A[i].w};
                    sa2 += S0[jj] * alo; sa3 += S0[jj + 1] * ahi;
                    if (IDENT) { sb2 += S1[jj] * alo; sb3 += S1[jj + 1] * ahi; } }
                __builtin_amdgcn_sched_barrier(0); }
            const float sa = (sa2.x + sa2.y) + (sa3.x + sa3.y), sb = (sb2.x + sb2.y) + (sb3.x + sb3.y);
            const f32x2v saa = (f32x2v){sa, sa}, sbb = (f32x2v){sb, sb}, vv = (f32x2v){cv[s], cv[s]};
            f32x2v y2 = (f32x2v){0.f, 0.f}, y3 = y2, e2 = y2, e3 = y2;
#pragma unroll
            for (int ch = 0; ch < 8; ++ch) { f32x4 W[2], Bq[2], K[2], R[2];
#pragma unroll
                for (int i = 0; i < 2; ++i) { const int j = ch * 8 + 4 * i; W[i] = *(const LAS f32x4*)(sv + j); Bq[i] = *(const LAS f32x4*)(sv + 128 + j); K[i] = *(const LAS f32x4*)(sv + 192 + j); R[i] = *(const LAS f32x4*)(sv + 256 + j); }
                __builtin_amdgcn_sched_barrier(0);
#pragma unroll
                for (int i = 0; i < 2; ++i) { const int jj = ch * 4 + 2 * i;
                    const f32x2v wlo = (f32x2v){W[i].x, W[i].y}, whi = (f32x2v){W[i].z, W[i].w}, blo = (f32x2v){Bq[i].x, Bq[i].y}, bhi = (f32x2v){Bq[i].z, Bq[i].w};
                    const f32x2v klo = (f32x2v){K[i].x, K[i].y}, khi = (f32x2v){K[i].z, K[i].w}, rlo = (f32x2v){R[i].x, R[i].y}, rhi = (f32x2v){R[i].z, R[i].w};
                    S0[jj] = S0[jj] * wlo + saa * blo + vv * klo; y2 += S0[jj] * rlo;
                    S0[jj + 1] = S0[jj + 1] * whi + saa * bhi + vv * khi; y3 += S0[jj + 1] * rhi;
                    if (IDENT) { S1[jj] = S1[jj] * wlo + sbb * blo; e2 += S1[jj] * rlo; S1[jj + 1] = S1[jj + 1] * whi + sbb * bhi; e3 += S1[jj + 1] * rhi; } }
                __builtin_amdgcn_sched_barrier(0); }
            YD[co[s]] = (y2.x + y2.y) + (y3.x + y3.y);
            if (IDENT) { const int tl = d ? (SEQ - 1 - (step0 - CTX + c * SCH + s)) : (step0 - CTX + c * SCH + s); E[(size_t)tl * 64 + lane] = f2bf((e2.x + e2.y) + (e3.x + e3.y)); }
        }
    }
    float* ZP = (float*)(P.ws + WS_ZP) + ((size_t)chain * NSEG + g) * 2 * 4096;
#pragma unroll
    for (int j = 0; j < 32; j += 2) { *(float4*)(ZP + lane * 64 + 2 * j) = make_float4(S0[j].x, S0[j].y, S0[j + 1].x, S0[j + 1].y);
        if (IDENT) *(float4*)(ZP + 4096 + lane * 64 + 2 * j) = make_float4(S1[j].x, S1[j].y, S1[j + 1].x, S1[j + 1].y); }
}
typedef float f32x16 __attribute__((ext_vector_type(16)));
__device__ __forceinline__ void scan_combine(const Params& P, int chain, float* lds) {
    const int tid = otid(), lane = tid & 63, wv = tid >> 6, li = lane & 31, lh = lane >> 5;
    const ldsfp Sl = vlds(lds);
    const ldsfp Pl = Sl + 64 * 65;
    float* ZPc = (float*)(P.ws + WS_ZP) + (size_t)chain * NSEG * 2 * 4096;
    const int ti = (wv >> 1) & 1, tj = wv & 1;
    float pn[8];
#pragma unroll
    for (int q = 0; q < 8; ++q) { pn[q] = ZPc[(size_t)2 * 4096 + 4096 + tid * 8 + q]; Sl[(tid >> 3) * 65 + (tid & 7) * 8 + q] = ZPc[tid * 8 + q]; }
    f32x16 acc, zn;
#pragma unroll
    for (int r = 0; r < 16; ++r) { zn[r] = 0.f; acc[r] = 0.f; }
    if (wv < 4) {
#pragma unroll
        for (int r = 0; r < 16; ++r) zn[r] = ZPc[(size_t)2 * 4096 + (32 * ti + (r & 3) + 8 * (r >> 2) + 4 * lh) * 64 + 32 * tj + li]; }
    for (int g = 1; g < NSEG - 1; ++g) {
        __syncthreads();
        if (g > 1 && wv < 4) {
#pragma unroll
            for (int r = 0; r < 16; ++r) Sl[(32 * ti + (r & 3) + 8 * (r >> 2) + 4 * lh) * 65 + 32 * tj + li] = acc[r]; }
#pragma unroll
        for (int q = 0; q < 8; ++q) Pl[tid * 8 + q] = pn[q];
        acc = zn;
        if (g + 1 < NSEG - 1) { const float* nx = ZPc + (size_t)(g + 1) * 2 * 4096;
#pragma unroll
            for (int q = 0; q < 8; ++q) pn[q] = nx[4096 + tid * 8 + q];
            if (wv < 4) {
#pragma unroll
                for (int r = 0; r < 16; ++r) zn[r] = nx[(32 * ti + (r & 3) + 8 * (r >> 2) + 4 * lh) * 64 + 32 * tj + li]; } }
        __syncthreads();
        if (wv < 4) {
#pragma unroll 8
            for (int k0 = 0; k0 < 64; k0 += 2) { const float av = Sl[(32 * ti + li) * 65 + k0 + lh], bv = Pl[(k0 + lh) * 64 + 32 * tj + li];
                acc = __builtin_amdgcn_mfma_f32_32x32x2f32(av, bv, acc, 0, 0, 0); }
            float* Zg = ZPc + (size_t)g * 2 * 4096;
#pragma unroll
            for (int r = 0; r < 16; ++r) Zg[(32 * ti + (r & 3) + 8 * (r >> 2) + 4 * lh) * 64 + 32 * tj + li] = acc[r]; }
    }
    __syncthreads();
}

__device__ __forceinline__ void rwkv_out_fin(const Params& P, int row, int c, float y, float lnw, float lnb, float bon, float vs, float gt) {
    bf16_t* MIX = (bf16_t*)(P.ws + WS_U);
    const float mean = wsum(y) * (1.0f / 64.0f); const float dv = y - mean; const float var = wsum(dv * dv) * (1.0f / 64.0f);
    const float yn = dv * rsqrtf(var + 64e-5f) * lnw + lnb;
    MIX[(size_t)row * D + 256 + c] = f2bf((yn + bon * vs) * gt);
}
__device__ __forceinline__ void ph_rwkvout(const Params& P, int l, float* ldsf) {
    using pg8::bf16x8;
    const int tid = otid(), lane = tid & 63, fr = lane & 15, fq = lane >> 4, wv = tid >> 6, gw = blockIdx.x * NWAVE + wv, nw = gridDim.x * NWAVE;
    const float* YD = (const float*)(P.ws + WS_YDIR); const bf16_t* VS = (const bf16_t*)(P.ws + WS_VS); const bf16_t* GT = (const bf16_t*)(P.ws + WS_GATE); const float* BON = (const float*)(P.ws + WS_BONUS);
    bf16_t* MIX = (bf16_t*)(P.ws + WS_U);
    for (int it = gw; it < NB * 6 * 32 * 4; it += nw) {
        const int sub = it & 3, q = (it >> 2) & 31, h = (it >> 7) % 6, b = it / (128 * 6);
        const int t0 = q * 256 + sub * 64;
        f32x4 acc[4][4];
#pragma unroll
        for (int mt = 0; mt < 4; ++mt)
#pragma unroll
            for (int nt = 0; nt < 4; ++nt) acc[mt][nt] = (f32x4){0.f, 0.f, 0.f, 0.f};
#pragma unroll
        for (int dir = 0; dir < 2; ++dir) { const int ch = b * 12 + h * 2 + dir, slot = dir ? (31 - q) : q;
            const float* Sp = (const float*)(P.ws + WS_ZP) + ((size_t)ch * NSEG + slot) * 2 * 4096;
            const bf16_t* Ep = (const bf16_t*)(P.ws + WS_E) + ((size_t)ch * SEQ + t0) * 64;
#pragma unroll
            for (int ks = 0; ks < 2; ++ks) { bf16x8 bop[4];
#pragma unroll
                for (int nt = 0; nt < 4; ++nt) { const float* sp = Sp + (nt * 16 + fr) * 64 + ks * 32 + fq * 8; const float4 s0 = *(const float4*)sp, s1 = *(const float4*)(sp + 4);
                    u32x4 w; w.x = cvt_pk_bf16(s0.x, s0.y); w.y = cvt_pk_bf16(s0.z, s0.w); w.z = cvt_pk_bf16(s1.x, s1.y); w.w = cvt_pk_bf16(s1.z, s1.w); bop[nt] = __builtin_bit_cast(bf16x8, w); }
#pragma unroll
                for (int mt = 0; mt < 4; ++mt) { const bf16x8 a = *(const bf16x8*)(Ep + (size_t)(mt * 16 + fr) * 64 + ks * 32 + fq * 8);
#pragma unroll
                    for (int nt = 0; nt < 4; ++nt) acc[mt][nt] = __builtin_amdgcn_mfma_f32_16x16x32_bf16(a, bop[nt], acc[mt][nt], 0, 0, 0); } } }
        float lnw[4], lnb[4];
#pragma unroll
        for (int nt = 0; nt < 4; ++nt) { lnw[nt] = P.in[I_LNW][l * RWW + h * 64 + nt * 16 + fr]; lnb[nt] = P.in[I_LNB][l * RWW + h * 64 + nt * 16 + fr]; }
#pragma unroll
        for (int mt = 0; mt < 4; ++mt)
#pragma unroll
            for (int rg = 0; rg < 4; ++rg) { const int row = b * SEQ + t0 + mt * 16 + fq * 4 + rg; const size_t o = (size_t)row * 384 + h * 64 + fr;
                float y[4], vs[4], gt[4]; const float bon = BON[(size_t)row * 6 + h];
#pragma unroll
                for (int nt = 0; nt < 4; ++nt) { y[nt] = YD[o + nt * 16] + YD[(size_t)T * 384 + o + nt * 16] + acc[mt][nt][rg]; vs[nt] = bf2f(VS[o + nt * 16]); gt[nt] = bf2f(GT[o + nt * 16]); }
                float sm = (y[0] + y[1]) + (y[2] + y[3]);
                sm += __shfl_xor(sm, 1); sm += __shfl_xor(sm, 2); sm += __shfl_xor(sm, 4); sm += __shfl_xor(sm, 8);
                const float mean = sm * (1.0f / 64.0f);
                float vr = 0.f;
#pragma unroll
                for (int nt = 0; nt < 4; ++nt) { y[nt] -= mean; vr += y[nt] * y[nt]; }
                vr += __shfl_xor(vr, 1); vr += __shfl_xor(vr, 2); vr += __shfl_xor(vr, 4); vr += __shfl_xor(vr, 8);
                const float rstd = rsqrtf(vr * (1.0f / 64.0f) + 64e-5f);
#pragma unroll
                for (int nt = 0; nt < 4; ++nt) MIX[(size_t)row * D + 256 + h * 64 + nt * 16 + fr] = f2bf((y[nt] * rstd * lnw[nt] + lnb[nt] + bon * vs[nt]) * gt[nt]);
                if (rg & 1) asm volatile("" ::: "memory"); }
    }
    for (int it = gw; it < TC * 6; it += nw) { const int row = TL + it / 6, h = it % 6, c = h * 64 + lane; const size_t o = (size_t)row * 384 + c;
        rwkv_out_fin(P, row, c, YD[o] + YD[(size_t)T * 384 + o], P.in[I_LNW][l * RWW + c], P.in[I_LNB][l * RWW + c], BON[(size_t)row * 6 + h], bf2f(VS[o]), bf2f(GT[o])); }
}

__device__ __forceinline__ void zt_tile(const Params& P, int tile, float* tl  ) {
    const int tid = otid(); const int c0 = (tile & 3) * 64, t0 = (tile >> 2) * 64;
    const float* Z = (const float*)(P.ws + WS_Z1); bf16_t* MIX = (bf16_t*)(P.ws + WS_U);
    { const int cc = tid >> 3, sg = (tid & 7) * 8; const float* src = Z + (size_t)(c0 + cc) * TL + t0 + sg; const float4 a = *(const float4*)src, b = *(const float4*)(src + 4);
      tl[cc * 65 + sg + 0] = a.x; tl[cc * 65 + sg + 1] = a.y; tl[cc * 65 + sg + 2] = a.z; tl[cc * 65 + sg + 3] = a.w; tl[cc * 65 + sg + 4] = b.x; tl[cc * 65 + sg + 5] = b.y; tl[cc * 65 + sg + 6] = b.z; tl[cc * 65 + sg + 7] = b.w; }
    __syncthreads();
    { const int tk = tid >> 3, cs = (tid & 7) * 8;
      u32x4 w; w.x = cvt_pk_bf16(tl[(cs + 0) * 65 + tk], tl[(cs + 1) * 65 + tk]); w.y = cvt_pk_bf16(tl[(cs + 2) * 65 + tk], tl[(cs + 3) * 65 + tk]);
      w.z = cvt_pk_bf16(tl[(cs + 4) * 65 + tk], tl[(cs + 5) * 65 + tk]); w.w = cvt_pk_bf16(tl[(cs + 6) * 65 + tk], tl[(cs + 7) * 65 + tk]);
      *(u32x4*)(MIX + (size_t)(t0 + tk) * D + c0 + cs) = w; }
    __syncthreads();
}
typedef const __attribute__((address_space(4))) Params* KParamsPtr;
__device__ __forceinline__ const Params* fresh_params() { KParamsPtr q = (KParamsPtr)__builtin_amdgcn_kernarg_segment_ptr(); asm volatile("" : "+s"(q)); return (const Params*)q; }
__global__ void __launch_bounds__(NTHR, 2) fwd_megakernel(Params P_unused, int ph_lo, int ph_hi) {
    extern __shared__ __attribute__((aligned(16))) unsigned char smem[];
    cg::grid_group grid = cg::this_grid();
    LAS unsigned char* lds3 = (LAS unsigned char*)smem;
    float* ldsf = (float*)smem; float2* X = (float2*)smem; float* ex = (float*)(smem + LDS_MAIN);
    { volatile LAS unsigned* st = (volatile LAS unsigned*)(lds3 + LDS_MAIN + 4096); if (threadIdx.x == 0) { st[0] = 0u; st[1] = 0u; } }
    __syncthreads();
    XcdBarrier xbar = xcd_barrier_post((unsigned*)(((const Params*)fresh_params())->ws + WS_BAR), (volatile LAS unsigned*)(lds3 + LDS_MAIN + 4096));
    int ph = 0;
#ifndef REP_GEMM
#define REP_GEMM 1
#endif
#ifndef REP_SCAN
#define REP_SCAN 1
#endif
#ifndef REP_MISC
#define REP_MISC 1
#endif
#ifndef REP_HY
#define REP_HY 1
#endif
#define PHASE_BEGIN if (ph >= ph_lo && ph < ph_hi) { const Params& P = *fresh_params(); unsigned char* ws = P.ws; (void)ws;
#ifndef REP_SYNC
#define REP_SYNC 1
#endif
#define PHASE_END   if (ph + 1 < ph_hi) { for (int rs_ = 0; rs_ < REP_SYNC; ++rs_) { if (ph == 0) grid.sync(); else xcd_barrier(xbar); } } } ++ph;
    PHASE_BEGIN ph_modv(P, ldsf); PHASE_END
    for (int l = 0; l < DEPTH; ++l) {
        PHASE_BEGIN
            for (int rep_ = 0; rep_ < REP_MISC; ++rep_) ph_prep(P, l, ldsf);
            if (l == 0) ph_rowpass(P, 0, 0, 0, 0, 0.f, 0, 0, 0, 1, 1);
            else ph_rowpass(P, 1, l - 1, 8, 5, 0.5f, l, 0, 0, 1, 11);
        PHASE_END
        PHASE_BEGIN { EpiGU E{(bf16_t*)(ws + WS_ACT)}; for (int rep_ = 0; rep_ < REP_GEMM; ++rep_) run_gemm(lds3, (const bf16_t*)(ws + WS_U), (const bf16_t*)(ws + WS_WGU1), T, 2 * DFF, D, E); } PHASE_END
        PHASE_BEGIN { EpiF32 E{(bf16_t*)(ws + WS_Y), (float*)(ws + WS_YC)}; run_gemm_tail(lds3, (const bf16_t*)(ws + WS_ACT), (const bf16_t*)(ws + WS_WDN1), DFF, E); } PHASE_END
        PHASE_BEGIN ph_rowpass(P, 1, l, 2, 1, 0.5f, l, 2, 3, 4, 11); PHASE_END
        PHASE_BEGIN { EpiWin E{(bf16_t*)(ws + WS_PHY), (bf16_t*)(ws + WS_PRW), (bf16_t*)(ws + WS_PNA)}; for (int rep_ = 0; rep_ < REP_GEMM; ++rep_) run_gemm(lds3, (const bf16_t*)(ws + WS_U), (const bf16_t*)(ws + WS_WIN), T, INWP, D, E); } PHASE_END
        PHASE_BEGIN
            for (int rep_ = 0; rep_ < REP_MISC; ++rep_) { ph_loraprep(P, l);
            for (int it = blockIdx.x; it < NB * 128 * 6 + NB * 4 * 6; it += gridDim.x) vt_tile(P, it, (unsigned short*)smem); }
            for (int rep_ = 0; rep_ < REP_HY; ++rep_) for (int it = blockIdx.x; it < 256; it += gridDim.x) hy_spec_task(P, l, it, X);
        PHASE_END
        PHASE_BEGIN { EpiLora E{(bf16_t*)(ws + WS_LORAO), (bf16_t*)(ws + WS_GATE)};
            for (int rep_ = 0; rep_ < REP_GEMM; ++rep_) run_gemm(lds3, (const bf16_t*)(ws + WS_ALORA), (const bf16_t*)(ws + WS_WLORA), T, 2048, 384, E); } PHASE_END
        PHASE_BEGIN
            for (int rep_ = 0; rep_ < REP_MISC; ++rep_) ph_rwkvprep(P, l);
            for (int rep_ = 0; rep_ < REP_HY; ++rep_) for (int c = blockIdx.x; c < HYC; c += gridDim.x) hy_task1(P, l, c, X, ex);
        PHASE_END
        PHASE_BEGIN {
            const int wv = __builtin_amdgcn_readfirstlane(otid() >> 6);
            if (wv < 4) { const int k = wv * (int)gridDim.x + (int)blockIdx.x;
                if (k < 24 * NSEG) { const int chain = k / NSEG, g = k % NSEG; float* ring = ldsf + wv * (SCH * 320);
                    __builtin_amdgcn_s_setprio(3);
                    for (int rep_ = 0; rep_ < REP_SCAN; ++rep_) { if (g == 0) scan_seg<false>(P, chain, g, ring); else scan_seg<true>(P, chain, g, ring); }
                    __builtin_amdgcn_s_setprio(0); } }
            else for (int it = (wv - 4) * (int)gridDim.x + (int)blockIdx.x; it < NAT_TASKS; it += 4 * (int)gridDim.x) natten_task(P, l, it);
        } PHASE_END
        PHASE_BEGIN
            for (int rep_ = 0; rep_ < REP_HY; ++rep_) for (int c = blockIdx.x; c < HYC; c += gridDim.x) hy_task2(P, l, c, X);
            if (blockIdx.x >= gridDim.x - 24) scan_combine(P, (int)(gridDim.x - 1 - blockIdx.x), ldsf);
        PHASE_END
        PHASE_BEGIN for (int rep_ = 0; rep_ < REP_MISC; ++rep_) ph_rwkvout(P, l, ldsf);
            __syncthreads();
            for (int it = blockIdx.x; it < 4 * (TL / 64); it += gridDim.x) zt_tile(P, it, ldsf);
        PHASE_END
        PHASE_BEGIN { EpiF32 E{(bf16_t*)(ws + WS_Y), (float*)(ws + WS_YC)}; run_gemm_tail(lds3, (const bf16_t*)(ws + WS_U), (const bf16_t*)(ws + WS_WOUT), D, E); } PHASE_END
        PHASE_BEGIN ph_rowpass(P, 1, l, 5, 3, 1.0f, l, 4, 6, 7, 4); PHASE_END
        PHASE_BEGIN { EpiGU E{(bf16_t*)(ws + WS_ACT)}; for (int rep_ = 0; rep_ < REP_GEMM; ++rep_) run_gemm(lds3, (const bf16_t*)(ws + WS_U), (const bf16_t*)(ws + WS_WGU2), T, 2 * DFF, D, E); } PHASE_END
        PHASE_BEGIN { EpiF32 E{(bf16_t*)(ws + WS_Y), (float*)(ws + WS_YC)}; run_gemm_tail(lds3, (const bf16_t*)(ws + WS_ACT), (const bf16_t*)(ws + WS_WDN2), DFF, E); } PHASE_END
    }
    PHASE_BEGIN ph_rowpass(P, 2, DEPTH - 1, 8, 5, 0.5f, 0, 0, 0, 0, 11); PHASE_END
#undef PHASE_BEGIN
#undef PHASE_END
}
constexpr int N_PHASES = 1 + DEPTH * 15 + 1;

extern "C" void kernel_launch(void* const* d_in, const int* in_sizes, int n_in, void* d_out, int out_size, void* d_ws, size_t ws_size, hipStream_t stream) {
    static int grid = 0;
    if (grid == 0) {
        if (n_in != 34 || ws_size < WS_END) { fprintf(stderr, "kernel_launch: need 34 inputs and %zu bytes of workspace; got %d, %zu\n", (size_t)WS_END, n_in, ws_size); grid = -1; return; }
        int dev = 0, cus = 0, per_cu = 0;
        hipGetDevice(&dev); hipDeviceGetAttribute(&cus, hipDeviceAttributeMultiprocessorCount, dev);
        if (hipFuncSetAttribute((const void*)fwd_megakernel, hipFuncAttributeMaxDynamicSharedMemorySize, LDS_BYTES) != hipSuccess) { fprintf(stderr, "kernel_launch: hipFuncSetAttribute failed\n"); grid = -1; return; }
        if (hipOccupancyMaxActiveBlocksPerMultiprocessor(&per_cu, (const void*)fwd_megakernel, NTHR, LDS_BYTES) != hipSuccess || per_cu < 1) { fprintf(stderr, "kernel_launch: occupancy query says %d\n", per_cu); per_cu = 1; }
        (void)hipGetLastError();
        grid = cus;
    }
    if (grid < 0) return;
    if (hipMemsetAsync((char*)d_ws + WS_BAR, 0, (size_t)XCD_BAR_WORDS * 4, stream) != hipSuccess) { fprintf(stderr, "kernel_launch: memset of the barrier words failed\n"); return; }
    Params p{};
    for (int i = 0; i < 34; ++i) p.in[i] = (const float*)d_in[i];
    p.out = (float*)d_out; p.ws = (unsigned char*)d_ws;
#if MK_SPLIT
    for (int ph = 0; ph < N_PHASES; ++ph) { int lo = ph, hi = ph + 1; hipLaunchKernelGGL(fwd_megakernel, dim3(grid), dim3(NTHR), LDS_BYTES, stream, p, lo, hi); }
#else
    int lo = 0, hi = N_PHASES;
    void* args[] = {&p, &lo, &hi};
    hipError_t e = hipLaunchCooperativeKernel((const void*)fwd_megakernel, dim3(grid), dim3(NTHR), args, LDS_BYTES, stream);
    if (e != hipSuccess) fprintf(stderr, "cooperative launch failed: %s (grid %d)\n", hipGetErrorString(e), grid);
#endif
}
```

```cpp
#include <hip/hip_runtime.h>
#include <hip/hip_cooperative_groups.h>
#include <cstdio>
namespace cg = cooperative_groups;
__device__ __forceinline__ int otid() { int t = threadIdx.x; asm volatile("" : "+v"(t)); return t; }
namespace pg8 {
#define PG8_LAS __attribute__((address_space(3)))
typedef unsigned short bf16_t;
typedef short bf16x8 __attribute__((ext_vector_type(8)));
typedef float f32x4 __attribute__((ext_vector_type(4)));
typedef unsigned u32x4 __attribute__((ext_vector_type(4)));
constexpr int BM = 256, BK = 64, HALF = 128, HTB = HALF * BK * 2  , STAGE_BYTES = 8 * HTB, NXCD = 8, WGM = 8;

__host__ __device__ __forceinline__ int lds_byte(int r, int c) { const int st = (r >> 4) * 2 + (c >> 5), rr = r & 15, cc = c & 31, ob = rr * 64 + cc * 2; return st * 1024 + (ob ^ (((ob >> 9) & 1) << 5)); }
__host__ __device__ __forceinline__ void stage_rc(int b, int& R, int& C) { const int st = b / 1024, sb = b % 1024, swz = sb ^ (((sb >> 9) & 1) << 5); R = (st >> 1) * 16 + swz / 64; C = (st & 1) * 32 + (swz % 64) / 2; }
__host__ __device__ __forceinline__ int perm32(int rho) { const int n = rho >> 4, i = rho & 15; return 8 * (i >> 2) + 4 * n + (i & 3); }

struct Unit { int pm, pn, kt0, nkt; };
struct Gemm { const bf16_t* A; const bf16_t* Bt; int M, N, K; };
struct StaticOrder {
    int nM, nN, nwg, G, c;
    __host__ __device__ void init(int M, int N, int G_, int c_) { nM = M / BM; nN = N / BM; nwg = nM * nN; G = G_; c = c_; }
    __host__ __device__ bool next(int i, Unit& u) const {
        const long L = (long)i * G + c; if (L >= nwg) return false;
        int wgid = (int)L; { const int q = nwg / NXCD, r = nwg % NXCD, xcd = wgid % NXCD, off = wgid / NXCD; wgid = (xcd < r ? xcd * (q + 1) : r * (q + 1) + (xcd - r) * q) + off; }
        const int nig = WGM * nN, gid = wgid / nig, fm = gid * WGM, gsz = (nM - fm) < WGM ? (nM - fm) : WGM;
        u.pm = fm + ((wgid % nig) % gsz); u.pn = (wgid % nig) / gsz; u.kt0 = 0; u.nkt = 0; return true;
    }
    __device__ __forceinline__ void a_ready(const Unit&) const {}
    __device__ __forceinline__ void done(const Unit&) const {}
};
__device__ __forceinline__ unsigned cvt_pk_bf16(float lo, float hi) { unsigned r; asm volatile("v_cvt_pk_bf16_f32 %0, %1, %2" : "=v"(r) : "v"(lo), "v"(hi)); return r; }
template <class Epi, class Sched>
__device__ __forceinline__ void gemm_phase(PG8_LAS unsigned char* lds, const Gemm g, const Sched& S, const Epi& E) {
    const int tid = otid(), wid = __builtin_amdgcn_readfirstlane(tid >> 6), lane = tid & 63, wr = wid >> 2, wc = wid & 3, fr = lane & 15, fq = lane >> 4;
    const int K = g.K, nt = K / BK;
#define PG8_STAMP() do {} while (0)
    unsigned voffA[2], voffB[2];
#pragma unroll
    for (int i = 0; i < 2; ++i) { int R, C; stage_rc(tid * 16 + i * 8192, R, C); const int Rb = Epi::PERM ? ((R & ~31) + perm32(R & 31)) : R;
        voffA[i] = (unsigned)(R * K + C) * 2u; voffB[i] = (unsigned)(Rb * K + C) * 2u; }
    const size_t kstep = (size_t)(BK * 2);
    const size_t hstep = (size_t)HALF * K * 2;
    const size_t tstep = 2 * hstep;
    const unsigned ldsw = (unsigned)wid * 1024u;
    const int aoff = lds_byte(wr * 64 + fr, fq * 8), boff = lds_byte(wc * 32 + fr, fq * 8);
#define PG8_SA(b, h) (((b) * 2 + (h)) * HTB)
#define PG8_SB(b, h) ((4 + (b) * 2 + (h)) * HTB)
#define PG8_STAGE(bufoff, gbase, voff) do { _Pragma("unroll") for (int _i = 0; _i < 2; ++_i) \
        __builtin_amdgcn_global_load_lds((const unsigned*)((const char*)(gbase) + (voff)[_i]), (PG8_LAS unsigned*)(lds + (bufoff) + ldsw + _i * 8192), 16, 0, 0); } while (0)
#define PG8_LDA(dst, b, h) do { _Pragma("unroll") for (int m = 0; m < 4; ++m) _Pragma("unroll") for (int k = 0; k < 2; ++k) dst[m][k] = *(const PG8_LAS bf16x8*)(lds + PG8_SA(b, h) + aoff + m * 2048 + k * 1024); } while (0)
#define PG8_LDB(dst, b, h) do { _Pragma("unroll") for (int n = 0; n < 2; ++n) _Pragma("unroll") for (int k = 0; k < 2; ++k) dst[n][k] = *(const PG8_LAS bf16x8*)(lds + PG8_SB(b, h) + boff + n * 2048 + k * 1024); } while (0)
#define PG8_MMA(ai, bj, At, Bt) do { __builtin_amdgcn_s_setprio(1); _Pragma("unroll") for (int m = 0; m < 4; ++m) _Pragma("unroll") for (int n = 0; n < 2; ++n) _Pragma("unroll") for (int k = 0; k < 2; ++k) \
        acc[ai][bj][m][n] = __builtin_amdgcn_mfma_f32_16x16x32_bf16(Bt[n][k], At[m][k], acc[ai][bj][m][n], 0, 0, 0); __builtin_amdgcn_s_setprio(0); } while (0)
#define PG8_WAIT_V(n) asm volatile("s_waitcnt vmcnt(" #n ")" ::: "memory")
#define PG8_WAIT_L(n) asm volatile("s_waitcnt lgkmcnt(" #n ")" ::: "memory")
#define PG8_BAR __builtin_amdgcn_s_barrier()
#define PG8_SCHED __builtin_amdgcn_sched_barrier(0)
    Unit cur, nxt; int ui = 0;
    if (!S.next(0, cur)) return;
    f32x4 acc[2][2][4][2];
#pragma unroll
    for (int a = 0; a < 2; ++a)
#pragma unroll
        for (int b = 0; b < 2; ++b)
#pragma unroll
            for (int m = 0; m < 4; ++m)
#pragma unroll
                for (int n = 0; n < 2; ++n) acc[a][b][m][n] = (f32x4){0.f, 0.f, 0.f, 0.f};
    bf16x8 At[4][2], B0[2][2], B1[2][2];
    const char* cA = (const char*)g.A + (size_t)cur.pm * tstep + (size_t)cur.kt0 * kstep; const char* cB = (const char*)g.Bt + (size_t)cur.pn * tstep + (size_t)cur.kt0 * kstep;
    int ntc = cur.nkt > 0 ? cur.nkt : nt;
    S.a_ready(cur);
    PG8_STAGE(PG8_SB(0, 0), cB, voffB); PG8_STAGE(PG8_SA(0, 0), cA, voffA); PG8_STAGE(PG8_SB(0, 1), cB + hstep, voffB); PG8_STAGE(PG8_SA(0, 1), cA + hstep, voffA);
    if (wr == 1) PG8_BAR;
    PG8_WAIT_V(4); PG8_BAR;
    PG8_STAGE(PG8_SB(1, 0), cB + kstep, voffB); PG8_STAGE(PG8_SA(1, 0), cA + kstep, voffA); PG8_STAGE(PG8_SB(1, 1), cB + hstep + kstep, voffB);
    PG8_WAIT_V(6); PG8_BAR;
    PG8_STAMP();
    for (;;) {
        const bool has_next = S.next(ui + 1, nxt);
        const char* nA = has_next ? (const char*)g.A + (size_t)nxt.pm * tstep + (size_t)nxt.kt0 * kstep : cA; const char* nB = has_next ? (const char*)g.Bt + (size_t)nxt.pn * tstep + (size_t)nxt.kt0 * kstep : cB;
        for (int t = 0; t < ntc; t += 2) {
            const bool last = (t == ntc - 2);
            const char* a1 = cA + (size_t)(t + 1) * kstep;
            const char* a2 = last ? nA : cA + (size_t)(t + 2) * kstep; const char* b2 = last ? nB : cB + (size_t)(t + 2) * kstep;
            const char* a3 = a2 + kstep; const char* b3 = b2 + kstep;
            if (last && has_next) S.a_ready(nxt);
            PG8_LDB(B0, 0, 0); PG8_SCHED; PG8_LDA(At, 0, 0); PG8_STAGE(PG8_SA(1, 1), a1 + hstep, voffA);
            PG8_WAIT_L(8); PG8_BAR; PG8_WAIT_L(0); PG8_MMA(0, 0, At, B0); PG8_BAR; PG8_SCHED;
            PG8_LDB(B1, 0, 1); PG8_STAGE(PG8_SB(0, 0), b2, voffB);
            PG8_BAR; PG8_WAIT_L(0); PG8_MMA(0, 1, At, B1); PG8_BAR;
            PG8_LDA(At, 0, 1); PG8_STAGE(PG8_SA(0, 0), a2, voffA);
            PG8_BAR; PG8_WAIT_L(0); PG8_MMA(1, 0, At, B0); PG8_BAR; PG8_SCHED;
            PG8_STAGE(PG8_SB(0, 1), b2 + hstep, voffB);
            PG8_WAIT_V(6); PG8_BAR; PG8_MMA(1, 1, At, B1); PG8_BAR;
            PG8_LDB(B0, 1, 0); PG8_SCHED; PG8_LDA(At, 1, 0); PG8_STAGE(PG8_SA(0, 1), a2 + hstep, voffA);
            PG8_WAIT_L(8); PG8_BAR; PG8_WAIT_L(0); PG8_MMA(0, 0, At, B0); PG8_BAR; PG8_SCHED;
            PG8_LDB(B1, 1, 1); PG8_STAGE(PG8_SB(1, 0), b3, voffB);
            PG8_BAR; PG8_WAIT_L(0); PG8_MMA(0, 1, At, B1); PG8_BAR;
            PG8_LDA(At, 1, 1); PG8_STAGE(PG8_SA(1, 0), a3, voffA);
            PG8_BAR; PG8_WAIT_L(0); PG8_MMA(1, 0, At, B0); PG8_BAR; PG8_SCHED;
            PG8_STAGE(PG8_SB(1, 1), b3 + hstep, voffB);
            PG8_WAIT_V(6); PG8_BAR; PG8_MMA(1, 1, At, B1); PG8_BAR;
        }
        PG8_STAMP();
        if constexpr (!Epi::AFTER_DRAIN) { E(acc, cur, wr, wc, fr, fq); S.done(cur); }
        PG8_STAMP();
        if (!has_next) break;
#pragma unroll
        for (int a = 0; a < 2; ++a)
#pragma unroll
            for (int b = 0; b < 2; ++b)
#pragma unroll
                for (int m = 0; m < 4; ++m)
#pragma unroll
                    for (int n = 0; n < 2; ++n) acc[a][b][m][n] = (f32x4){0.f, 0.f, 0.f, 0.f};
        cur = nxt; cA = nA; cB = nB; ++ui; ntc = cur.nkt > 0 ? cur.nkt : nt;
    }
    PG8_WAIT_V(0);
    if (wr == 0) PG8_BAR;
    PG8_BAR;
    if constexpr (Epi::AFTER_DRAIN) { E.fused(acc, cur, wr, wc, fr, fq, lds, wid, lane); S.done(cur); }
    PG8_STAMP();
#undef PG8_STAMP
#undef PG8_SA
#undef PG8_SB
#undef PG8_STAGE
#undef PG8_LDA
#undef PG8_LDB
#undef PG8_MMA
#undef PG8_WAIT_V
#undef PG8_WAIT_L
#undef PG8_BAR
#undef PG8_SCHED
}
}
#define LAS __attribute__((address_space(3)))
#define XB_TMO      128
#define XB_XCNT(j)  (256  + 64 * (j))
#define XB_XSUB(j)  (1280 + 64 * (j))
#define XB_XGEN(j)  (2304 + 64 * (j))
#define XB_TOP      3328
#define XB_TOPGEN   3392
#define XCD_BAR_WORDS 3456
#define XB_SPIN_CAP (1u << 18)

__device__ __forceinline__ unsigned xb_ld(unsigned* p)              { return __hip_atomic_load(p, __ATOMIC_RELAXED, __HIP_MEMORY_SCOPE_AGENT); }
__device__ __forceinline__ unsigned xb_add(unsigned* p, unsigned v) { return __hip_atomic_fetch_add(p, v, __ATOMIC_RELAXED, __HIP_MEMORY_SCOPE_AGENT); }
__device__ __forceinline__ unsigned xb_xcc_id() { return (unsigned)__builtin_amdgcn_s_getreg((3 << 11) | 20) & 0xFu; }
#define XB_SPIN(cond, bar) do { unsigned _sp = 0; while (cond) { __builtin_amdgcn_s_sleep(1); \
    if ((++_sp & 255u) == 0u) { if (xb_ld(&(bar)[XB_TMO])) break; if (_sp > XB_SPIN_CAP) { atomicAdd(&(bar)[XB_TMO], 1u); break; } } } } while (0)

struct XcdBarrier {
    unsigned* bar; unsigned x;
    volatile LAS unsigned* st;
};

__device__ __forceinline__ XcdBarrier xcd_barrier_post(unsigned* bar, volatile LAS unsigned* st) {
    XcdBarrier b; b.bar = bar; b.x = xb_xcc_id(); b.st = st;
    if (threadIdx.x == 0) (void)xb_add(&bar[XB_XCNT(b.x)], 1u);
    return b;
}
__device__ __forceinline__ void xcd_barrier_complete(unsigned* bar, unsigned x, unsigned& nloc, unsigned& nx) {
    const unsigned G = gridDim.x * gridDim.y * gridDim.z;
    unsigned sum, cnt, mine, sp = 0u;
    for (;;) {
        sum = 0u; cnt = 0u; mine = 0u;
#pragma unroll
        for (unsigned j = 0; j < 16; ++j) { const unsigned c = xb_ld(&bar[XB_XCNT(j)]); sum += c; cnt += (c > 0u) ? 1u : 0u; mine = (j == x) ? c : mine; }
        if (sum == G) break;
        __builtin_amdgcn_s_sleep(1);
        if ((++sp & 255u) == 0u) { if (xb_ld(&bar[XB_TMO])) break; if (sp > XB_SPIN_CAP) { atomicAdd(&bar[XB_TMO], 1u); break; } }
    }
    nloc = mine > 0u ? mine : 1u; nx = cnt > 0u ? cnt : 1u;
}

__device__ __forceinline__ void xcd_barrier(const XcdBarrier& b) {
    asm volatile("s_waitcnt vmcnt(0)" ::: "memory");
    __syncthreads();
    if (threadIdx.x == 0) {
        unsigned* bar = b.bar;
        __builtin_amdgcn_s_waitcnt(0);
        unsigned nloc = b.st[0], nx = b.st[1];
        if (nloc == 0u) { xcd_barrier_complete(bar, b.x, nloc, nx); b.st[0] = nloc; b.st[1] = nx; }
        const unsigned old = xb_add(&bar[XB_XSUB(b.x)], 1u);
        const unsigned gen = old / nloc;
        if (old + 1u == (gen + 1u) * nloc) {
            __builtin_amdgcn_fence(__ATOMIC_RELEASE, "agent");
            asm volatile("s_waitcnt vmcnt(0)" ::: "memory");
            const unsigned og = xb_add(&bar[XB_TOP], 1u);
            const unsigned tg = og / nx;
            if (og + 1u == (tg + 1u) * nx) xb_add(&bar[XB_TOPGEN], 1u);
            else XB_SPIN(xb_ld(&bar[XB_TOPGEN]) == tg, bar);
            __builtin_amdgcn_fence(__ATOMIC_ACQUIRE, "agent");
            xb_add(&bar[XB_XGEN(b.x)], 1u);
            asm volatile("s_waitcnt vmcnt(0)" ::: "memory");
        } else {
            XB_SPIN(xb_ld(&bar[XB_XGEN(b.x)]) == gen, bar);
            __builtin_amdgcn_fence(__ATOMIC_ACQUIRE, "agent");
            asm volatile("s_waitcnt vmcnt(0)" ::: "memory");
        }
    }
    __syncthreads();
}

using pg8::bf16_t; using pg8::f32x4; using pg8::u32x4; using pg8::cvt_pk_bf16;
typedef unsigned u32x2 __attribute__((ext_vector_type(2)));


constexpr int D = 1024, NB = 2, SEQ = 8192, DEPTH = 4, CTX = 256, DFF = 2816;
constexpr int TL = NB * SEQ, TC = NB * CTX, T = TL + TC;
constexpr int NMOD = 9 * D;
constexpr int HYC = 256, RWW = 384, NAW = 384, INW = 3456, INWP = 3584;
constexpr int HY_IN = 768, RW_IN = 1536, NA_IN = 1152;
constexpr int NFFT = 16384;
constexpr int NTHR = 512, NWAVE = 8;
constexpr int LDS_MAIN = 131072, LDS_EXTRA = 8192, LDS_BYTES = LDS_MAIN + LDS_EXTRA;
constexpr float NORM_EPS = 1e-6f;

constexpr size_t al256(size_t x) { return (x + 255) & ~(size_t)255; }
constexpr size_t WS_MODV = 0;
constexpr size_t WS_WGU1 = al256(WS_MODV + (size_t)DEPTH * 3 * NMOD * 4);
constexpr size_t WS_WDN1 = WS_WGU1 + (size_t)2 * DFF * D * 2;
constexpr size_t WS_WGU2 = WS_WDN1 + (size_t)D * DFF * 2;
constexpr size_t WS_WDN2 = WS_WGU2 + (size_t)2 * DFF * D * 2;
constexpr size_t WS_WIN = WS_WDN2 + (size_t)D * DFF * 2;
constexpr size_t WS_WOUT = WS_WIN + (size_t)INWP * D * 2;
constexpr size_t WS_WLORA = WS_WOUT + (size_t)D * D * 2;
constexpr size_t WS_H = WS_WLORA + (size_t)2048 * 384 * 2;
constexpr size_t WS_U = WS_H + (size_t)T * D * 4;
constexpr size_t WS_S = WS_U + (size_t)T * D * 2;
constexpr size_t WS_Y = WS_S;
constexpr size_t WS_ACT = WS_Y + (size_t)T * D * 4;
constexpr size_t WS_FFN_END = WS_ACT + (size_t)T * DFF * 2;
constexpr size_t WS_PHY = WS_S;
constexpr size_t WS_PRW = WS_PHY + (size_t)T * HY_IN * 2;
constexpr size_t WS_YDIR = WS_PRW;
constexpr size_t WS_PNA = WS_PRW + (size_t)T * RW_IN * 2;
constexpr size_t WS_ALORA = WS_PNA + (size_t)T * NA_IN * 2;
constexpr size_t WS_DECAY = WS_ALORA + (size_t)T * 384 * 2;
constexpr size_t WS_LORAO = WS_DECAY + (size_t)2 * T * 384 * 4;
constexpr size_t WS_E = WS_LORAO;
constexpr size_t WS_ZP = WS_E + (size_t)24 * SEQ * 64 * 2;
constexpr size_t WS_GATE = WS_LORAO + (size_t)T * 1536 * 2;
static_assert(WS_ZP + (size_t)24 * 33 * 2 * 4096 * 4 <= WS_GATE, "E + ZP must fit in the LORAO region");
constexpr size_t WS_RS = WS_GATE + (size_t)T * 384 * 2;
constexpr size_t WS_KKS = WS_RS + (size_t)T * 384 * 2;
constexpr size_t WS_VS = WS_KKS + (size_t)T * 384 * 2;
constexpr size_t WS_KS = WS_VS + (size_t)T * 384 * 2;
constexpr size_t WS_BS = WS_KS + (size_t)2 * T * 384 * 2;
constexpr size_t WS_BONUS = WS_BS + (size_t)2 * T * 384 * 2;
constexpr size_t WS_FILT = al256(WS_BONUS + (size_t)T * 6 * 4);
constexpr size_t WS_FILTC = WS_FILT + (size_t)1024 * SEQ * 2;
constexpr size_t WS_SPEC = WS_FILTC + (size_t)1024 * CTX * 2;
constexpr size_t WS_Z1 = WS_SPEC + (size_t)512 * NFFT * 8;
constexpr size_t WS_VTL = WS_Z1 + (size_t)HYC * NB * SEQ * 4;
constexpr size_t WS_VTC = WS_VTL + (size_t)NB * 6 * 64 * SEQ * 2;
constexpr size_t WS_MIX_END = WS_VTC + (size_t)NB * 6 * 64 * CTX * 2;
constexpr size_t WS_BAR = al256(WS_MIX_END > WS_FFN_END ? WS_MIX_END : WS_FFN_END);
constexpr size_t WS_ROPE = al256(WS_BAR + (size_t)XCD_BAR_WORDS * 4);
constexpr size_t WS_YC = WS_FFN_END + (size_t)(8 << 20);
static_assert(WS_YC + (size_t)11 * TC * D * 4 <= WS_FILT, "YC partials must stay below the filter tables");
constexpr size_t WS_END = WS_ROPE + (size_t)128 * 16 * 8;
static_assert(WS_END <= (size_t)4 * DEPTH * D * NMOD * 4, "workspace map exceeds 4x the largest input tensor");

struct Params { const float* in[34]; float* out; unsigned char* ws; };
enum { I_X = 0, I_C, I_CTX, I_CCTX, I_MODW, I_MODB, I_NORMG, I_F1GU, I_F1DN, I_F2GU, I_F2DN, I_WIN, I_WOUT, I_HCW, I_HCB, I_HW1, I_HB1, I_HW2, I_HB2, I_HW3, I_HFREQ, I_HBIAS,
       I_MU, I_W0, I_W2, I_A0, I_A2, I_G2, I_KK, I_KA, I_RK, I_LNW, I_LNB, I_RPB };

typedef LAS float* ldsfp;
__device__ __forceinline__ ldsfp vlds(const void* p) { ldsfp q = (ldsfp)p; asm volatile("" : "+v"(q)); return q; }
__device__ __forceinline__ float bf2f(bf16_t b) { return __uint_as_float(((unsigned)b) << 16); }
__device__ __forceinline__ bf16_t f2bf(float f) { unsigned u = __float_as_uint(f); u += 0x7FFFu + ((u >> 16) & 1u); return (bf16_t)(u >> 16); }
__device__ __forceinline__ float lo_bf(unsigned w) { return __uint_as_float(w << 16); }
__device__ __forceinline__ float hi_bf(unsigned w) { return __uint_as_float(w & 0xffff0000u); }
__device__ __forceinline__ float wsum(float v) {
#pragma unroll
    for (int o = 32; o > 0; o >>= 1) v += __shfl_xor(v, o);
    return v;
}
__device__ __forceinline__ float sigmoidf_(float x) { return __builtin_amdgcn_rcpf(1.0f + __expf(-x)); }
__device__ __forceinline__ void unpack8(const u32x4 w, float (&f)[8]) {
    f[0] = lo_bf(w.x); f[1] = hi_bf(w.x); f[2] = lo_bf(w.y); f[3] = hi_bf(w.y); f[4] = lo_bf(w.z); f[5] = hi_bf(w.z); f[6] = lo_bf(w.w); f[7] = hi_bf(w.w);
}
__device__ __forceinline__ void row_nbrs(int row, bool& hasp, bool& hasn) {
    if (row < TL) { const int t = row & (SEQ - 1); hasp = t > 0; hasn = t < SEQ - 1; }
    else { const int t = (row - TL) & (CTX - 1); hasp = t > 0; hasn = t < CTX - 1; }
}

__device__ __forceinline__ void ph_modv(const Params& P, float* lds) {
    const int tid = otid();
    float* sv = lds;
    float* red = lds + 3072;
    for (int i = tid; i < 3072; i += NTHR) { const int s = i >> 10, k = i & 1023; const float c = s < 2 ? P.in[I_C][s * 1024 + k] : P.in[I_CCTX][k]; sv[i] = c / (1.0f + expf(-c)); }
    __syncthreads();
    if (blockIdx.x < 4) { const int e = blockIdx.x * NTHR + tid, pos = e >> 4, f = e & 15; float sn, cs; sincosf((float)pos * expf(-(float)f * (9.210340371976184f / 16.0f)), &sn, &cs); ((float2*)(P.ws + WS_ROPE))[e] = make_float2(cs, sn); }
    float* modv = (float*)(P.ws + WS_MODV);
    const int kc = tid >> 6, cl = tid & 63;
    for (int item = blockIdx.x; item < DEPTH * 144; item += gridDim.x) {
        const int l = item / 144, cb = item % 144, col = cb * 64 + cl;
        const float* w = P.in[I_MODW] + ((size_t)l * 1024 + kc * 128) * NMOD + col;
        float a0 = 0.f, a1 = 0.f, a2 = 0.f;
#pragma unroll 8
        for (int k = 0; k < 128; ++k) { const float wv = w[(size_t)k * NMOD]; a0 += sv[kc * 128 + k] * wv; a1 += sv[1024 + kc * 128 + k] * wv; a2 += sv[2048 + kc * 128 + k] * wv; }
        red[(0 * 8 + kc) * 64 + cl] = a0; red[(1 * 8 + kc) * 64 + cl] = a1; red[(2 * 8 + kc) * 64 + cl] = a2;
        __syncthreads();
        if (tid < 192) { const int s = tid >> 6, c = tid & 63; float r = P.in[I_MODB][l * NMOD + cb * 64 + c];
#pragma unroll
            for (int q = 0; q < 8; ++q) r += red[(s * 8 + q) * 64 + c];
            modv[((size_t)l * 3 + s) * NMOD + cb * 64 + c] = r; }
        __syncthreads();
    }
}

__device__ __forceinline__ float hy_delta(int c);
__device__ __forceinline__ int rowmap_gu(int n) { const int up = n >= DFF ? 1 : 0; const int j = n - up * DFF; return (j >> 7) * 256 + up * 128 + (j & 127); }
__device__ __forceinline__ void conv_tile(const float* __restrict__ src, int K, int N, bf16_t* __restrict__ dst, int tk, int tn, bool gu, float* tile) {
    const int tid = otid(); const int k0 = tk * 64, n0 = tn * 64;
#pragma unroll
    for (int rr = 0; rr < 2; ++rr) { const int kk = (tid >> 4) + rr * 32, n4 = (tid & 15) * 4; const float4 v = *(const float4*)(src + (size_t)(k0 + kk) * N + n0 + n4);
        tile[kk * 65 + n4 + 0] = v.x; tile[kk * 65 + n4 + 1] = v.y; tile[kk * 65 + n4 + 2] = v.z; tile[kk * 65 + n4 + 3] = v.w; }
    __syncthreads();
    { const int nn = tid >> 3, ks = (tid & 7) * 8; const int n = n0 + nn; const int row = gu ? rowmap_gu(n) : n;
      u32x4 w; w.x = cvt_pk_bf16(tile[(ks + 0) * 65 + nn], tile[(ks + 1) * 65 + nn]); w.y = cvt_pk_bf16(tile[(ks + 2) * 65 + nn], tile[(ks + 3) * 65 + nn]);
      w.z = cvt_pk_bf16(tile[(ks + 4) * 65 + nn], tile[(ks + 5) * 65 + nn]); w.w = cvt_pk_bf16(tile[(ks + 6) * 65 + nn], tile[(ks + 7) * 65 + nn]);
      *(u32x4*)(dst + (size_t)row * K + k0 + ks) = w; }
    __syncthreads();
}
__device__ __forceinline__ void ph_prep(const Params& P, int l, float* lds) {
    const int tid = otid();
    unsigned char* ws = P.ws;
    constexpr int N0 = 16 * 88, N1 = 44 * 16, N4 = 16 * 54, N5 = 16 * 16;
    constexpr int C0 = N0, C1 = C0 + N1, C2 = C1 + N0, C3 = C2 + N1, C4 = C3 + N4, C5 = C4 + N5;
    for (int it = blockIdx.x; it < C5; it += gridDim.x) {
        if (it < C0) { conv_tile(P.in[I_F1GU] + (size_t)l * D * 2 * DFF, D, 2 * DFF, (bf16_t*)(ws + WS_WGU1), it / 88, it % 88, true, lds); }
        else if (it < C1) { const int j = it - C0; conv_tile(P.in[I_F1DN] + (size_t)l * DFF * D, DFF, D, (bf16_t*)(ws + WS_WDN1), j / 16, j % 16, false, lds); }
        else if (it < C2) { const int j = it - C1; conv_tile(P.in[I_F2GU] + (size_t)l * D * 2 * DFF, D, 2 * DFF, (bf16_t*)(ws + WS_WGU2), j / 88, j % 88, true, lds); }
        else if (it < C3) { const int j = it - C2; conv_tile(P.in[I_F2DN] + (size_t)l * DFF * D, DFF, D, (bf16_t*)(ws + WS_WDN2), j / 16, j % 16, false, lds); }
        else if (it < C4) { const int j = it - C3; conv_tile(P.in[I_WIN] + (size_t)l * D * INW, D, INW, (bf16_t*)(ws + WS_WIN), j / 54, j % 54, false, lds); }
        else { const int j = it - C4; conv_tile(P.in[I_WOUT] + (size_t)l * D * D, D, D, (bf16_t*)(ws + WS_WOUT), j / 16, j % 16, false, lds); }
    }
    const int gtid = blockIdx.x * NTHR + tid, gn = gridDim.x * NTHR;
    { unsigned* z = (unsigned*)(ws + WS_WIN + (size_t)INW * D * 2); for (int i = gtid; i < (INWP - INW) * D / 2; i += gn) z[i] = 0u; }
    { bf16_t* wl = (bf16_t*)(ws + WS_WLORA);
      const float* w2 = P.in[I_W2] + (size_t)l * 2 * 64 * RWW; const float* a2 = P.in[I_A2] + (size_t)l * 2 * 64 * RWW; const float* g2 = P.in[I_G2] + (size_t)l * 128 * RWW;
      for (int i = gtid; i < 2048 * 48; i += gn) { const int kb = (i / 2048) * 8, j = i % 2048; float v[8];
#pragma unroll
          for (int q = 0; q < 8; ++q) v[q] = 0.f;
          if (j < 1920) { const int grp = j / 384, c = j % 384;
              const bool act = grp < 4 ? (kb >> 6) == grp : kb >= 256;
              if (act) { const float* src = (grp < 2 ? w2 + (size_t)kb * RWW : (grp < 4 ? a2 + (size_t)(kb - 128) * RWW : g2 + (size_t)(kb - 256) * RWW)) + c;
#pragma unroll
                  for (int q = 0; q < 8; ++q) v[q] = src[(size_t)q * RWW]; } }
          u32x4 w; w.x = cvt_pk_bf16(v[0], v[1]); w.y = cvt_pk_bf16(v[2], v[3]); w.z = cvt_pk_bf16(v[4], v[5]); w.w = cvt_pk_bf16(v[6], v[7]);
          *(u32x4*)(wl + (size_t)j * 384 + kb) = w; } }
    { const float* w1_ = P.in[I_HW1] + (size_t)l * 33 * 64; const float* b1 = P.in[I_HB1] + l * 64; const float* w2f_ = P.in[I_HW2] + (size_t)l * 64 * 64; const float* b2 = P.in[I_HB2] + l * 64;
      const float* fqv = P.in[I_HFREQ] + l * 64; const float* w3 = P.in[I_HW3] + (size_t)l * 64 * 1024;
      const int lane = tid & 63, wv = tid >> 6;
      const float fq = fqv[lane], bb1 = b1[lane], bb2 = b2[lane];
      const ldsfp hl = vlds(lds);
      for (int task = blockIdx.x; task < 256; task += gridDim.x) {
          const int n0 = task * 32;
          __syncthreads();
#pragma unroll 1
          for (int p = wv; p < 33; p += NWAVE) { const int L = p < 32 ? SEQ : CTX, pos = p < 32 ? n0 + p : task;
              const float* w1 = w1_; const float* w2f = w2f_; asm volatile("" : "+s"(w1), "+s"(w2f));
              const float tt = (float)pos / (float)(L - 1);
              const float ang = 6.283185307179586f * (float)pos / (float)L;
              float z = 0.f;
              if (lane == 0) z = tt;
              else if (lane <= 16) { const float fr = 1e-4f + (float)(lane - 1) * ((15.0f - 1e-4f) / 15.0f); z = cosf(fr * ang); }
              else if (lane <= 32) { const float fr = 1e-4f + (float)(lane - 17) * ((15.0f - 1e-4f) / 15.0f); z = -sinf(fr * ang); }
              float a = bb1;
#pragma unroll
              for (int e = 0; e < 33; ++e) a += __shfl(z, e) * w1[e * 64 + lane];
              const float h1 = sinf(fq * a);
              float c = bb2;
#pragma unroll
              for (int i = 0; i < 64; ++i) c += __shfl(h1, i) * w2f[i * 64 + lane];
              hl[lane * 36 + p] = sinf(fq * c); }
          __syncthreads();
          float acc0[33], acc1[33];
#pragma unroll
          for (int p = 0; p < 33; ++p) { acc0[p] = 0.f; acc1[p] = 0.f; }
#pragma unroll 2
          for (int i = 0; i < 64; ++i) { const float wa = w3[(size_t)i * 1024 + tid], wb = w3[(size_t)i * 1024 + 512 + tid];
#pragma unroll
              for (int p4 = 0; p4 < 8; ++p4) { const f32x4 hv = *(const LAS f32x4*)(hl + i * 36 + p4 * 4);
                  acc0[p4 * 4 + 0] += hv.x * wa; acc0[p4 * 4 + 1] += hv.y * wa; acc0[p4 * 4 + 2] += hv.z * wa; acc0[p4 * 4 + 3] += hv.w * wa;
                  acc1[p4 * 4 + 0] += hv.x * wb; acc1[p4 * 4 + 1] += hv.y * wb; acc1[p4 * 4 + 2] += hv.z * wb; acc1[p4 * 4 + 3] += hv.w * wb; }
              const float hc = hl[i * 36 + 32]; acc0[32] += hc * wa; acc1[32] += hc * wb; }
          const float dl = hy_delta(tid & 255), sc = 1.0f / NFFT, invL = 1.0f / (float)(SEQ - 1);
          bf16_t* dst = (bf16_t*)(ws + WS_FILT) + (size_t)tid * SEQ + n0;
          const size_t cstep = (size_t)512 * SEQ;
#pragma unroll
          for (int p8 = 0; p8 < 4; ++p8) { float d[8];
#pragma unroll
              for (int k = 0; k < 8; ++k) d[k] = __expf(-((float)(n0 + p8 * 8 + k) * invL) * dl) * sc;
              u32x4 w; w.x = cvt_pk_bf16(acc0[p8 * 8 + 0] * d[0], acc0[p8 * 8 + 1] * d[1]); w.y = cvt_pk_bf16(acc0[p8 * 8 + 2] * d[2], acc0[p8 * 8 + 3] * d[3]);
              w.z = cvt_pk_bf16(acc0[p8 * 8 + 4] * d[4], acc0[p8 * 8 + 5] * d[5]); w.w = cvt_pk_bf16(acc0[p8 * 8 + 6] * d[6], acc0[p8 * 8 + 7] * d[7]);
              *(u32x4*)(dst + p8 * 8) = w;
              w.x = cvt_pk_bf16(acc1[p8 * 8 + 0] * d[0], acc1[p8 * 8 + 1] * d[1]); w.y = cvt_pk_bf16(acc1[p8 * 8 + 2] * d[2], acc1[p8 * 8 + 3] * d[3]);
              w.z = cvt_pk_bf16(acc1[p8 * 8 + 4] * d[4], acc1[p8 * 8 + 5] * d[5]); w.w = cvt_pk_bf16(acc1[p8 * 8 + 6] * d[6], acc1[p8 * 8 + 7] * d[7]);
              *(u32x4*)(dst + cstep + p8 * 8) = w; }
          { const float dc = __expf(-((float)task * (1.0f / (float)(CTX - 1))) * dl); bf16_t* fc = (bf16_t*)(ws + WS_FILTC) + (size_t)tid * CTX + task;
            fc[0] = f2bf(acc0[32] * dc); fc[(size_t)512 * CTX] = f2bf(acc1[32] * dc); }
      }
      __syncthreads(); }
}

__device__ __forceinline__ void ph_rowpass(const Params& P, int mode, int lpost, int gate_i, int gpost_i, float ps, int lpre, int gpre_i, int shift_i, int scale_i, int nsplit) {
    const int tid = otid(), lane = tid & 63, gw = blockIdx.x * NWAVE + (tid >> 6), nw = gridDim.x * NWAVE;
    const float* modv = (const float*)(P.ws + WS_MODV);
    float* H = (float*)(P.ws + WS_H); const bf16_t* Y = (const bf16_t*)(P.ws + WS_Y); bf16_t* U = (bf16_t*)(P.ws + WS_U);
    int cur_s = -1;
    float4 A[4], Bv[4], Cv[4];
#pragma unroll
    for (int j = 0; j < 4; ++j) { A[j] = make_float4(0.f, 0.f, 0.f, 0.f); Bv[j] = A[j]; Cv[j] = A[j]; }
    for (int row = gw; row < T; row += nw) {
        const int s = row < SEQ ? 0 : (row < TL ? 1 : 2);
        if (s != cur_s) { cur_s = s;
#pragma unroll
            for (int j = 0; j < 4; ++j) { const int e = lane * 4 + 256 * j;
                if (mode != 0) { const float4 g = *(const float4*)(modv + ((size_t)lpost * 3 + s) * NMOD + gate_i * D + e); const float4 gp = *(const float4*)(P.in[I_NORMG] + ((size_t)lpost * 6 + gpost_i) * D + e);
                    A[j] = make_float4(ps * g.x * gp.x, ps * g.y * gp.y, ps * g.z * gp.z, ps * g.w * gp.w); }
                if (mode != 2) { const float4 sc = *(const float4*)(modv + ((size_t)lpre * 3 + s) * NMOD + scale_i * D + e); const float4 gq = *(const float4*)(P.in[I_NORMG] + ((size_t)lpre * 6 + gpre_i) * D + e);
                    Bv[j] = make_float4(gq.x * (1.f + sc.x), gq.y * (1.f + sc.y), gq.z * (1.f + sc.z), gq.w * (1.f + sc.w));
                    Cv[j] = *(const float4*)(modv + ((size_t)lpre * 3 + s) * NMOD + shift_i * D + e); } } }
        float4 h[4];
        if (mode == 0) { const float* src = row < TL ? P.in[I_X] + (size_t)row * D : P.in[I_CTX] + (size_t)(row - TL) * D;
#pragma unroll
            for (int j = 0; j < 4; ++j) h[j] = *(const float4*)(src + lane * 4 + 256 * j);
        } else {
            float4 y[4]; float ss = 0.f;
#pragma unroll
            for (int j = 0; j < 4; ++j) { h[j] = *(const float4*)(H + (size_t)row * D + lane * 4 + 256 * j); if (row < TL) { const u32x2 yw = *(const u32x2*)(Y + (size_t)row * D + lane * 4 + 256 * j); y[j] = make_float4(lo_bf(yw.x), hi_bf(yw.x), lo_bf(yw.y), hi_bf(yw.y)); } else { const float* yp = (const float*)(P.ws + WS_YC) + (size_t)(row - TL) * D + lane * 4 + 256 * j; float4 a = *(const float4*)yp;
                    for (int q = 1; q < nsplit; ++q) { const float4 b4 = *(const float4*)(yp + (size_t)q * TC * D); a.x += b4.x; a.y += b4.y; a.z += b4.z; a.w += b4.w; } y[j] = a; }
                ss += y[j].x * y[j].x + y[j].y * y[j].y + y[j].z * y[j].z + y[j].w * y[j].w; }
            ss = wsum(ss); const float r = rsqrtf(ss * (1.0f / D) + NORM_EPS);
#pragma unroll
            for (int j = 0; j < 4; ++j) { h[j].x += A[j].x * (y[j].x * r); h[j].y += A[j].y * (y[j].y * r); h[j].z += A[j].z * (y[j].z * r); h[j].w += A[j].w * (y[j].w * r); }
        }
        if (mode == 2) { if (row < TL) {
#pragma unroll
                for (int j = 0; j < 4; ++j) *(float4*)(P.out + (size_t)row * D + lane * 4 + 256 * j) = h[j]; }
            continue; }
        float s2 = 0.f;
#pragma unroll
        for (int j = 0; j < 4; ++j) { *(float4*)(H + (size_t)row * D + lane * 4 + 256 * j) = h[j]; s2 += h[j].x * h[j].x + h[j].y * h[j].y + h[j].z * h[j].z + h[j].w * h[j].w; }
        s2 = wsum(s2); const float r2 = rsqrtf(s2 * (1.0f / D) + NORM_EPS);
#pragma unroll
        for (int j = 0; j < 4; ++j) { u32x2 w; w.x = cvt_pk_bf16(h[j].x * r2 * Bv[j].x + Cv[j].x, h[j].y * r2 * Bv[j].y + Cv[j].y); w.y = cvt_pk_bf16(h[j].z * r2 * Bv[j].z + Cv[j].z, h[j].w * r2 * Bv[j].w + Cv[j].w);
            *(u32x2*)(U + (size_t)row * D + lane * 4 + 256 * j) = w; }
    }
}

struct EpiGU {
    static constexpr bool PERM = true, AFTER_DRAIN = false;
    bf16_t* O;
    __device__ __forceinline__ void operator()(const f32x4 (&acc)[2][2][4][2], const pg8::Unit& u, int wr, int wc, int fr, int fq) const {
        const int row0 = u.pm * 256 + wr * 64 + fr, col0 = u.pn * 128 + wc * 32 + 8 * fq;
#pragma unroll
        for (int ai = 0; ai < 2; ++ai)
#pragma unroll
            for (int m = 0; m < 4; ++m) { float o[8];
#pragma unroll
                for (int n = 0; n < 2; ++n)
#pragma unroll
                    for (int j = 0; j < 4; ++j) { const float g = acc[ai][0][m][n][j], up = acc[ai][1][m][n][j]; o[n * 4 + j] = g * __builtin_amdgcn_rcpf(1.0f + __expf(-g)) * up; }
                u32x4 w; w.x = cvt_pk_bf16(o[0], o[1]); w.y = cvt_pk_bf16(o[2], o[3]); w.z = cvt_pk_bf16(o[4], o[5]); w.w = cvt_pk_bf16(o[6], o[7]);
                *(u32x4*)(O + (size_t)(row0 + ai * 128 + m * 16) * DFF + col0) = w; }
    }
};

struct TailOrder {
    int nsplit, kp, G, c;
    __device__ void init(int K, int KP, int G_, int c_) { kp = KP; nsplit = (K / 64) / KP; G = G_; c = c_; }
    __device__ bool next(int i, pg8::Unit& u) const {
        const long L = (long)i * G + c;
        if (L < 256) { int wgid = (int)L; { const int q = 256 / 8, xcd = wgid % 8, off = wgid / 8; wgid = xcd * q + off; }
            const int nig = 8 * 4, gid = wgid / nig, fm = gid * 8; u.pm = fm + ((wgid % nig) % 8); u.pn = (wgid % nig) / 8; u.kt0 = 0; u.nkt = 0; return true; }
        const int L2 = (int)(L - 256); if (L2 >= 8 * nsplit) return false;
        const int tile = L2 / nsplit, ks = L2 % nsplit; u.pm = 64 + (tile >> 2); u.pn = tile & 3; u.kt0 = ks * kp; u.nkt = kp; return true;
    }
    __device__ __forceinline__ void a_ready(const pg8::Unit&) const {}
    __device__ __forceinline__ void done(const pg8::Unit&) const {}
};
struct EpiF32 {
    static constexpr bool PERM = true, AFTER_DRAIN = false;
    bf16_t* C; float* YC;
    __device__ __forceinline__ void operator()(const f32x4 (&acc)[2][2][4][2], const pg8::Unit& u, int wr, int wc, int fr, int fq) const {
        const int row0 = u.pm * 256 + wr * 64 + fr, col0 = u.pn * 256 + wc * 32 + 8 * fq;
        if (u.pm < 64) {
#pragma unroll
            for (int ai = 0; ai < 2; ++ai)
#pragma unroll
                for (int m = 0; m < 4; ++m) { bf16_t* rowp = C + (size_t)(row0 + ai * 128 + m * 16) * D + col0;
#pragma unroll
                    for (int bj = 0; bj < 2; ++bj) { const f32x4 v0 = acc[ai][bj][m][0], v1 = acc[ai][bj][m][1];
                        u32x4 w; w.x = cvt_pk_bf16(v0[0], v0[1]); w.y = cvt_pk_bf16(v0[2], v0[3]); w.z = cvt_pk_bf16(v1[0], v1[1]); w.w = cvt_pk_bf16(v1[2], v1[3]);
                        *(u32x4*)(rowp + bj * 128) = w; } }
        } else { float* base = YC + (size_t)(u.kt0 >> 2) * TC * D;
#pragma unroll
            for (int ai = 0; ai < 2; ++ai)
#pragma unroll
                for (int m = 0; m < 4; ++m) { float* rowp = base + (size_t)(row0 - TL + ai * 128 + m * 16) * D + col0;
#pragma unroll
                    for (int bj = 0; bj < 2; ++bj)
#pragma unroll
                        for (int n = 0; n < 2; ++n) *(f32x4*)(rowp + bj * 128 + n * 4) = acc[ai][bj][m][n]; }
        }
    }
};
template <class Epi> __device__ __forceinline__ void run_gemm_tail(LAS unsigned char* lds, const bf16_t* A, const bf16_t* Bt, int K, const Epi& E) {
    asm volatile("" : "+s"(K));
    pg8::Gemm g{A, Bt, T, D, K}; TailOrder S; S.init(K, 4, (int)gridDim.x, (int)blockIdx.x);
    pg8::gemm_phase<Epi, TailOrder>(lds, g, S, E);
    __syncthreads();
}
__device__ __forceinline__ void zero_yc(const Params& P) { float4* z = (float4*)(P.ws + WS_YC); for (int i = blockIdx.x * NTHR + otid(); i < TC * D / 4; i += gridDim.x * NTHR) z[i] = make_float4(0.f, 0.f, 0.f, 0.f); }
struct EpiWin {
    static constexpr bool PERM = true, AFTER_DRAIN = false;
    bf16_t* PHYT; bf16_t* PRW; bf16_t* PNA;
    __device__ __forceinline__ void operator()(const f32x4 (&acc)[2][2][4][2], const pg8::Unit& u, int wr, int wc, int fr, int fq) const {
        const int row0 = u.pm * 256 + wr * 64 + fr;
        if (u.pn < 3) {
#pragma unroll
            for (int bj = 0; bj < 2; ++bj) { bf16_t* cp = PHYT + (size_t)(u.pn * 256 + bj * 128 + wc * 32 + 8 * fq) * T + row0;
#pragma unroll
                for (int ai = 0; ai < 2; ++ai)
#pragma unroll
                    for (int m = 0; m < 4; ++m) { const f32x4 v0 = acc[ai][bj][m][0], v1 = acc[ai][bj][m][1]; bf16_t* rp = cp + ai * 128 + m * 16;
                        const unsigned w0 = cvt_pk_bf16(v0[0], v0[1]), w1 = cvt_pk_bf16(v0[2], v0[3]), w2 = cvt_pk_bf16(v1[0], v1[1]), w3 = cvt_pk_bf16(v1[2], v1[3]);
                        rp[0] = (bf16_t)w0; rp[(size_t)T] = (bf16_t)(w0 >> 16); rp[(size_t)2 * T] = (bf16_t)w1; rp[(size_t)3 * T] = (bf16_t)(w1 >> 16);
                        rp[(size_t)4 * T] = (bf16_t)w2; rp[(size_t)5 * T] = (bf16_t)(w2 >> 16); rp[(size_t)6 * T] = (bf16_t)w3; rp[(size_t)7 * T] = (bf16_t)(w3 >> 16); } }
            return; }
        bf16_t* base; int ld, cbase;
        if (u.pn < 9) { base = PRW; ld = RW_IN; cbase = u.pn * 256 - HY_IN; }
        else { base = PNA; ld = NA_IN; cbase = u.pn * 256 - HY_IN - RW_IN; }
        const int nbj = (u.pn == 13) ? 1 : 2;
#pragma unroll
        for (int ai = 0; ai < 2; ++ai)
#pragma unroll
            for (int m = 0; m < 4; ++m)
#pragma unroll
                for (int bj = 0; bj < 2; ++bj) { if (bj < nbj) { const f32x4 v0 = acc[ai][bj][m][0], v1 = acc[ai][bj][m][1];
                    u32x4 w; w.x = cvt_pk_bf16(v0[0], v0[1]); w.y = cvt_pk_bf16(v0[2], v0[3]); w.z = cvt_pk_bf16(v1[0], v1[1]); w.w = cvt_pk_bf16(v1[2], v1[3]);
                    *(u32x4*)(base + (size_t)(row0 + ai * 128 + m * 16) * ld + cbase + bj * 128 + wc * 32 + 8 * fq) = w; } }
    }
};
struct EpiLora {
    static constexpr bool PERM = true, AFTER_DRAIN = false;
    bf16_t* LO; bf16_t* GATE;
    __device__ __forceinline__ void operator()(const f32x4 (&acc)[2][2][4][2], const pg8::Unit& u, int wr, int wc, int fr, int fq) const {
        const int row0 = u.pm * 256 + wr * 64 + fr;
        bf16_t* base; int ld, cbase;
        if (u.pn < 6) { base = LO; ld = 1536; cbase = u.pn * 256; } else { base = GATE; ld = 384; cbase = u.pn * 256 - 1536; }
        const int nbj = (u.pn == 7) ? 1 : 2;
#pragma unroll
        for (int ai = 0; ai < 2; ++ai)
#pragma unroll
            for (int m = 0; m < 4; ++m)
#pragma unroll
                for (int bj = 0; bj < 2; ++bj) { if (bj < nbj) { const f32x4 v0 = acc[ai][bj][m][0], v1 = acc[ai][bj][m][1];
                    u32x4 w; w.x = cvt_pk_bf16(v0[0], v0[1]); w.y = cvt_pk_bf16(v0[2], v0[3]); w.z = cvt_pk_bf16(v1[0], v1[1]); w.w = cvt_pk_bf16(v1[2], v1[3]);
                    *(u32x4*)(base + (size_t)(row0 + ai * 128 + m * 16) * ld + cbase + bj * 128 + wc * 32 + 8 * fq) = w; } }
    }
};
template <class Epi> __device__ __forceinline__ void run_gemm(LAS unsigned char* lds, const bf16_t* A, const bf16_t* Bt, int M, int N, int K, const Epi& E) {
    asm volatile("" : "+s"(K));
    pg8::Gemm g{A, Bt, M, N, K}; pg8::StaticOrder S; S.init(M, N, (int)gridDim.x, (int)blockIdx.x);
    pg8::gemm_phase<Epi, pg8::StaticOrder>(lds, g, S, E);
    __syncthreads();
}

__device__ __forceinline__ void ph_loraprep(const Params& P, int l) {
    const bf16_t* PRW = (const bf16_t*)(P.ws + WS_PRW); bf16_t* AL = (bf16_t*)(P.ws + WS_ALORA);
    const float* mu = P.in[I_MU] + (size_t)l * 2 * RW_IN;
    const int gtid = blockIdx.x * NTHR + otid(), gn = gridDim.x * NTHR;
    for (int it = gtid; it < T * 48; it += gn) {
        const int row = it / 48, j8 = it % 48, col = 1152 + j8 * 8;
        bool hp, hn; row_nbrs(row, hp, hn);
        float p[8], pp[8], pn[8];
        unpack8(*(const u32x4*)(PRW + (size_t)row * RW_IN + col), p);
        if (hp) unpack8(*(const u32x4*)(PRW + (size_t)(row - 1) * RW_IN + col), pp); else {
#pragma unroll
            for (int i = 0; i < 8; ++i) pp[i] = 0.f; }
        if (hn) unpack8(*(const u32x4*)(PRW + (size_t)(row + 1) * RW_IN + col), pn); else {
#pragma unroll
            for (int i = 0; i < 8; ++i) pn[i] = 0.f; }
        float o[8];
#pragma unroll
        for (int i = 0; i < 8; ++i) { const float xs = p[i] + mu[col + i] * (pp[i] - p[i]) + mu[RW_IN + col + i] * (pn[i] - p[i]);
            o[i] = j8 < 16 ? tanhf(xs) : (j8 < 32 ? xs : sigmoidf_(xs)); }
        u32x4 w; w.x = cvt_pk_bf16(o[0], o[1]); w.y = cvt_pk_bf16(o[2], o[3]); w.z = cvt_pk_bf16(o[4], o[5]); w.w = cvt_pk_bf16(o[6], o[7]);
        *(u32x4*)(AL + (size_t)row * 384 + j8 * 8) = w;
    }
}

__device__ __forceinline__ void ph_rwkvprep(const Params& P, int l) {
    const int tid = otid(), lane = tid & 63, gw = blockIdx.x * NWAVE + (tid >> 6), nw = gridDim.x * NWAVE;
    const int nrw = nw / 6, h = gw % 6, rw0 = gw / 6;
    if (rw0 >= nrw) return;
    const bf16_t* PRW = (const bf16_t*)(P.ws + WS_PRW); const bf16_t* LO = (const bf16_t*)(P.ws + WS_LORAO);
    bf16_t* RS = (bf16_t*)(P.ws + WS_RS); bf16_t* KKS = (bf16_t*)(P.ws + WS_KKS); bf16_t* VS = (bf16_t*)(P.ws + WS_VS); bf16_t* KS = (bf16_t*)(P.ws + WS_KS); bf16_t* BS = (bf16_t*)(P.ws + WS_BS);
    float* BON = (float*)(P.ws + WS_BONUS); float* DEC = (float*)(P.ws + WS_DECAY);
    const float2* RT = (const float2*)(P.ws + WS_ROPE);
    const float* mu = P.in[I_MU] + (size_t)l * 2 * RW_IN;
    const int c = h * 64 + lane, f = lane & 15;
    const float mp0 = mu[c], mn0 = mu[RW_IN + c], mp1 = mu[384 + c], mn1 = mu[RW_IN + 384 + c], mp2 = mu[768 + c], mn2 = mu[RW_IN + 768 + c];
    const float ckk = P.in[I_KK][l * RWW + c], cka = P.in[I_KA][l * RWW + c], crk = P.in[I_RK][l * RWW + c];
    const float ca0 = P.in[I_A0][(size_t)l * 2 * RWW + c], ca1 = P.in[I_A0][(size_t)l * 2 * RWW + RWW + c], cw0 = P.in[I_W0][(size_t)l * 2 * RWW + c], cw1 = P.in[I_W0][(size_t)l * 2 * RWW + RWW + c];
    const float sg = (lane & 16) ? 1.f : -1.f;
#pragma unroll 2
    for (int row = rw0; row < T; row += nrw) {
        bool hp, hn; row_nbrs(row, hp, hn);
        const bf16_t* pr = PRW + (size_t)row * RW_IN + c; const int om = hp ? -RW_IN : 0, op = hn ? RW_IN : 0; const float fm = hp ? 1.f : 0.f, fp = hn ? 1.f : 0.f;
        const float r0 = bf2f(pr[0]), k0 = bf2f(pr[384]), v0 = bf2f(pr[768]);
        const float r = r0 + mp0 * (fm * bf2f(pr[om]) - r0) + mn0 * (fp * bf2f(pr[op]) - r0);
        const float k = k0 + mp1 * (fm * bf2f(pr[384 + om]) - k0) + mn1 * (fp * bf2f(pr[384 + op]) - k0);
        const float v = v0 + mp2 * (fm * bf2f(pr[768 + om]) - v0) + mn2 * (fp * bf2f(pr[768 + op]) - v0);
        const bf16_t* lo = LO + (size_t)row * 1536 + c;
        const float a0 = sigmoidf_(bf2f(lo[768]) + ca0), a1 = sigmoidf_(bf2f(lo[1152]) + ca1);
        const float x0 = bf2f(lo[0]) + cw0, x1 = bf2f(lo[384]) + cw1;
        const float kkr = k * ckk;
        const float nrm = sqrtf(wsum(kkr * kkr));
        const float kk = kkr / fmaxf(nrm, 1e-12f);
        float kd0 = k * (1.f + (a0 - 1.f) * cka), kd1 = k * (1.f + (a1 - 1.f) * cka);
        float b0 = kk * a0, b1 = kk * a1;
        const float bon = wsum(r * (kd0 + kd1) * crk);
        float rs = r, kks = kk;
        if (row < TL) {
            const int t = row & (SEQ - 1); const int pos = (lane < 32) ? (t >> 6) : (t & 63);
            const float2 csn = RT[pos * 16 + f]; const float cs = csn.x, sn = csn.y;
            const float r2 = __shfl_xor(rs, 16), k2 = __shfl_xor(kks, 16), d0 = __shfl_xor(kd0, 16), d1 = __shfl_xor(kd1, 16), e0 = __shfl_xor(b0, 16), e1 = __shfl_xor(b1, 16);
            rs = rs * cs + sg * r2 * sn; kks = kks * cs + sg * k2 * sn; kd0 = kd0 * cs + sg * d0 * sn; kd1 = kd1 * cs + sg * d1 * sn; b0 = b0 * cs + sg * e0 * sn; b1 = b1 * cs + sg * e1 * sn;
        }
        const size_t o = (size_t)row * 384 + c;
        DEC[o] = __expf(-0.6065306597f * sigmoidf_(x0)); DEC[(size_t)T * 384 + o] = __expf(-0.6065306597f * sigmoidf_(x1));
        if (lane == 0) BON[(size_t)row * 6 + h] = bon;
        RS[o] = f2bf(rs); KKS[o] = f2bf(-kks); VS[o] = f2bf(v);
        KS[o] = f2bf(kd0); KS[(size_t)T * 384 + o] = f2bf(kd1); BS[o] = f2bf(b0); BS[(size_t)T * 384 + o] = f2bf(b1);
    }
}

__device__ __forceinline__ int scan_row(int b, int d, int step) {
    if (step < CTX) { const int tc = d ? (CTX - 1 - step) : step; return TL + b * CTX + tc; }
    const int tl = d ? (SEQ - 1 - (step - CTX)) : (step - CTX); return b * SEQ + tl;
}
__device__ __forceinline__ void scan_task_v1(const Params& P, int task, float* sv) {
    const int lane = otid() & 63;
    const int d = task & 1, h = (task >> 1) % 6, b = task / 12;
    const float* DEC = (const float*)(P.ws + WS_DECAY) + (size_t)d * T * 384; const bf16_t* KKS = (const bf16_t*)(P.ws + WS_KKS); const bf16_t* RS = (const bf16_t*)(P.ws + WS_RS);
    const bf16_t* VS = (const bf16_t*)(P.ws + WS_VS); const bf16_t* KS = (const bf16_t*)(P.ws + WS_KS) + (size_t)d * T * 384; const bf16_t* BS = (const bf16_t*)(P.ws + WS_BS) + (size_t)d * T * 384;
    float* YD = (float*)(P.ws + WS_YDIR) + (size_t)d * T * 384;
    float S[64];
#pragma unroll
    for (int j = 0; j < 64; ++j) S[j] = 0.f;
    size_t o = (size_t)scan_row(b, d, 0) * 384 + h * 64 + lane;
    float nw_ = DEC[o], na = bf2f(KKS[o]), nb = bf2f(BS[o]), nk = bf2f(KS[o]), nr = bf2f(RS[o]), nv = bf2f(VS[o]);
    for (int step = 0; step < CTX + SEQ; ++step) {
        const float v = nv; const size_t oc = o;
        asm volatile("s_waitcnt lgkmcnt(0)" ::: "memory");
        sv[lane] = nw_; sv[64 + lane] = na; sv[128 + lane] = nb; sv[192 + lane] = nk; sv[256 + lane] = nr;
        asm volatile("s_waitcnt lgkmcnt(0)" ::: "memory");
        if (step + 1 < CTX + SEQ) { o = (size_t)scan_row(b, d, step + 1) * 384 + h * 64 + lane;
            nw_ = DEC[o]; na = bf2f(KKS[o]); nb = bf2f(BS[o]); nk = bf2f(KS[o]); nr = bf2f(RS[o]); nv = bf2f(VS[o]); }
        float sa0 = 0.f, sa1 = 0.f, sa2 = 0.f, sa3 = 0.f;
#pragma unroll
        for (int j = 0; j < 64; j += 4) { const float4 a4 = *(const float4*)(sv + 64 + j);
            sa0 += S[j + 0] * a4.x; sa1 += S[j + 1] * a4.y; sa2 += S[j + 2] * a4.z; sa3 += S[j + 3] * a4.w; }
        const float sa = (sa0 + sa1) + (sa2 + sa3);
        float y0 = 0.f, y1 = 0.f, y2 = 0.f, y3 = 0.f;
#pragma unroll
        for (int j = 0; j < 64; j += 4) {
            const float4 w4 = *(const float4*)(sv + j), b4 = *(const float4*)(sv + 128 + j), k4 = *(const float4*)(sv + 192 + j), r4 = *(const float4*)(sv + 256 + j);
            S[j + 0] = S[j + 0] * w4.x + sa * b4.x + v * k4.x; y0 += S[j + 0] * r4.x;
            S[j + 1] = S[j + 1] * w4.y + sa * b4.y + v * k4.y; y1 += S[j + 1] * r4.y;
            S[j + 2] = S[j + 2] * w4.z + sa * b4.z + v * k4.z; y2 += S[j + 2] * r4.z;
            S[j + 3] = S[j + 3] * w4.w + sa * b4.w + v * k4.w; y3 += S[j + 3] * r4.w; }
        YD[oc] = (y0 + y1) + (y2 + y3);
    }
}

__device__ __forceinline__ void natt_key(const bf16_t* PNA, size_t krow, int hoff, const float (&q)[16], float bias, float& m, float& lsum, float (&o)[16]) {
    const bf16_t* kp = PNA + krow * NA_IN + 384 + hoff; const bf16_t* vp = PNA + krow * NA_IN + 768 + hoff;
    float s = 0.f;
#pragma unroll
    for (int j8 = 0; j8 < 2; ++j8) { float kf[8]; unpack8(*(const u32x4*)(kp + j8 * 8), kf);
#pragma unroll
        for (int i = 0; i < 8; ++i) s += q[j8 * 8 + i] * kf[i]; }
    s += __shfl_xor(s, 1); s += __shfl_xor(s, 2); s += bias;
    const float mn = fmaxf(m, s), corr = __expf(m - mn), p = __expf(s - mn);
    m = mn; lsum = lsum * corr + p;
#pragma unroll
    for (int j8 = 0; j8 < 2; ++j8) { float vf[8]; unpack8(*(const u32x4*)(vp + j8 * 8), vf);
#pragma unroll
        for (int i = 0; i < 8; ++i) o[j8 * 8 + i] = o[j8 * 8 + i] * corr + p * vf[i]; }
}
__device__ __forceinline__ void natten_items_v1(const Params& P, int l, int wid0, int nworkers) {
    const bf16_t* PNA = (const bf16_t*)(P.ws + WS_PNA); bf16_t* MIX = (bf16_t*)(P.ws + WS_U);
    const float* rpb = P.in[I_RPB] + (size_t)l * 6 * 15 * 31;
    const int sub = wid0 & 3;
    for (int it = wid0 >> 2; it < T * 6; it += nworkers >> 2) {
        const int row = it % T, h = it / T, hoff = h * 64 + sub * 16;
        float q[16], o[16];
#pragma unroll
        for (int j8 = 0; j8 < 2; ++j8) { float qf[8]; unpack8(*(const u32x4*)(PNA + (size_t)row * NA_IN + hoff + j8 * 8), qf);
#pragma unroll
            for (int i = 0; i < 8; ++i) { q[j8 * 8 + i] = qf[i] * 0.125f; o[j8 * 8 + i] = 0.f; } }
        float m = -3.0e38f, lsum = 0.f;
        int b;
        if (row < TL) { b = row >> 13; const int t = row & (SEQ - 1), i = t >> 6, col = t & 63;
            const int start = min(max(i - 4, 0), 120), win0 = min(max(col - 8, 0), 48);
            for (int r = 0; r < 8; ++r) for (int kc = win0; kc < win0 + 16; ++kc) {
                const float bias = rpb[(h * 15 + (start + r - i + 7)) * 31 + (kc - col + 15)];
                natt_key(PNA, (size_t)b * SEQ + (start + r) * 64 + kc, hoff, q, bias, m, lsum, o); }
        } else b = (row - TL) >> 8;
        for (int c = 0; c < CTX; ++c) natt_key(PNA, (size_t)TL + b * CTX + c, hoff, q, 0.f, m, lsum, o);
        const float il = 1.0f / lsum;
#pragma unroll
        for (int j8 = 0; j8 < 2; ++j8) { u32x4 w; w.x = cvt_pk_bf16(o[j8 * 8 + 0] * il, o[j8 * 8 + 1] * il); w.y = cvt_pk_bf16(o[j8 * 8 + 2] * il, o[j8 * 8 + 3] * il);
            w.z = cvt_pk_bf16(o[j8 * 8 + 4] * il, o[j8 * 8 + 5] * il); w.w = cvt_pk_bf16(o[j8 * 8 + 6] * il, o[j8 * 8 + 7] * il);
            *(u32x4*)(MIX + (size_t)row * D + 640 + hoff + j8 * 8) = w; }
    }
}

__device__ __forceinline__ void vt_tile(const Params& P, int tile, unsigned short* tl  ) {
    const int tid = otid();
    const bf16_t* PNA = (const bf16_t*)(P.ws + WS_PNA);
    int h, tok0; bf16_t* dst; int ldt;
    if (tile < NB * 128 * 6) { h = tile % 6; const int sb = tile / 6; const int b = sb >> 7, blk = sb & 127; tok0 = b * SEQ + blk * 64; dst = (bf16_t*)(P.ws + WS_VTL) + ((size_t)(b * 6 + h) * 64) * SEQ + blk * 64; ldt = SEQ; }
    else { const int tt = tile - NB * 128 * 6; h = tt % 6; const int sb = tt / 6; const int b = sb >> 2, blk = sb & 3; tok0 = TL + b * CTX + blk * 64; dst = (bf16_t*)(P.ws + WS_VTC) + ((size_t)(b * 6 + h) * 64) * CTX + blk * 64; ldt = CTX; }
    { const int tok = tid >> 3, seg = tid & 7; const u32x4 v = *(const u32x4*)(PNA + (size_t)(tok0 + tok) * NA_IN + 768 + h * 64 + seg * 8);
      unsigned* w = (unsigned*)(tl + tok * 72 + seg * 8); w[0] = v.x; w[1] = v.y; w[2] = v.z; w[3] = v.w; }
    __syncthreads();
    { const int hd = tid >> 3, ts = tid & 7; unsigned short e[8];
#pragma unroll
      for (int k = 0; k < 8; ++k) e[k] = tl[(ts * 8 + k) * 72 + hd];
      u32x4 w; w.x = (unsigned)e[0] | ((unsigned)e[1] << 16); w.y = (unsigned)e[2] | ((unsigned)e[3] << 16); w.z = (unsigned)e[4] | ((unsigned)e[5] << 16); w.w = (unsigned)e[6] | ((unsigned)e[7] << 16);
      *(u32x4*)(dst + (size_t)hd * ldt + ts * 8) = w; }
    __syncthreads();
}
constexpr int NAT_LAT_TASKS = NB * 128 * 4 * 6, NAT_CTX_TASKS = NB * 16 * 6, NAT_TASKS = NAT_LAT_TASKS + NAT_CTX_TASKS;
__device__ __forceinline__ void natten_task(const Params& P, int l, int task) {
    using pg8::bf16x8;
    const int lane = otid() & 63, fr = lane & 15, fq = lane >> 4;
    const bf16_t* PNA = (const bf16_t*)(P.ws + WS_PNA); bf16_t* MIX = (bf16_t*)(P.ws + WS_U);
    const bool lat = task < NAT_LAT_TASKS;
    int b, h, i = 0, n = 0, qtok0;
    if (lat) { h = task % 6; const int r = task / 6; n = r & 3; i = (r >> 2) & 127; b = r >> 9; qtok0 = b * SEQ + i * 64 + 16 * n; }
    else { const int tt = task - NAT_LAT_TASKS; h = tt % 6; const int qb = (tt / 6) & 15; b = tt / 96; qtok0 = TL + b * CTX + 16 * qb; }
    const int start = min(max(i - 4, 0), 120), band0 = min(max(16 * n - 8, 0), 32);
    const int col = 16 * n + fr, win0 = min(max(col - 8, 0), 48);
    bf16x8 bq[2];
#pragma unroll
    for (int kh = 0; kh < 2; ++kh) bq[kh] = *(const bf16x8*)(PNA + (size_t)(qtok0 + fr) * NA_IN + h * 64 + kh * 32 + fq * 8);
    f32x4 sc[32];
    if (lat) {
#pragma unroll
        for (int t = 0; t < 16; ++t) { const int tok0 = b * SEQ + (start + (t >> 1)) * 64 + band0 + 16 * (t & 1);
            const bf16_t* kp = PNA + (size_t)(tok0 + fr) * NA_IN + 384 + h * 64 + fq * 8;
            const bf16x8 k0 = *(const bf16x8*)kp, k1 = *(const bf16x8*)(kp + 32);
            f32x4 a = (f32x4){0.f, 0.f, 0.f, 0.f};
            a = __builtin_amdgcn_mfma_f32_16x16x32_bf16(k0, bq[0], a, 0, 0, 0); a = __builtin_amdgcn_mfma_f32_16x16x32_bf16(k1, bq[1], a, 0, 0, 0);
            sc[t] = a; if ((t & 3) == 3) asm volatile("" ::: "memory"); }
    } else {
#pragma unroll
        for (int t = 0; t < 16; ++t) sc[t] = (f32x4){-3.0e38f, -3.0e38f, -3.0e38f, -3.0e38f};
    }
#pragma unroll
    for (int t = 16; t < 32; ++t) { const int tok0 = TL + b * CTX + 16 * (t - 16);
        const bf16_t* kp = PNA + (size_t)(tok0 + fr) * NA_IN + 384 + h * 64 + fq * 8;
        const bf16x8 k0 = *(const bf16x8*)kp, k1 = *(const bf16x8*)(kp + 32);
        f32x4 a = (f32x4){0.f, 0.f, 0.f, 0.f};
        a = __builtin_amdgcn_mfma_f32_16x16x32_bf16(k0, bq[0], a, 0, 0, 0); a = __builtin_amdgcn_mfma_f32_16x16x32_bf16(k1, bq[1], a, 0, 0, 0);
        sc[t] = a * 0.125f; if ((t & 3) == 3) asm volatile("" ::: "memory"); }
    if (lat) { const float* rpb = P.in[I_RPB] + ((size_t)l * 6 + h) * 15 * 31;
#pragma unroll
        for (int t = 0; t < 16; ++t) { const int ro = start + (t >> 1) - i + 7; const int kc0 = band0 + 16 * (t & 1) + fq * 4;
#pragma unroll
            for (int j = 0; j < 4; ++j) { const int kc = kc0 + j; const bool ok = kc >= win0 && kc < win0 + 16; const int co = min(max(kc - col + 15, 0), 30);
                const float bias = rpb[ro * 31 + co]; sc[t][j] = ok ? sc[t][j] * 0.125f + bias : -3.0e38f; } } }
    float mx = -3.0e38f;
#pragma unroll
    for (int t = 0; t < 32; ++t) mx = fmaxf(mx, fmaxf(fmaxf(sc[t][0], sc[t][1]), fmaxf(sc[t][2], sc[t][3])));
    mx = fmaxf(mx, __shfl_xor(mx, 16)); mx = fmaxf(mx, __shfl_xor(mx, 32));
    float sum = 0.f;
#pragma unroll
    for (int t = 0; t < 32; ++t) {
#pragma unroll
        for (int j = 0; j < 4; ++j) { const float p = __expf(sc[t][j] - mx); sc[t][j] = p; sum += p; } }
    sum += __shfl_xor(sum, 16); sum += __shfl_xor(sum, 32);
    const float inv = 1.0f / sum;
    f32x4 ot[4];
#pragma unroll
    for (int q = 0; q < 4; ++q) ot[q] = (f32x4){0.f, 0.f, 0.f, 0.f};
    const bf16_t* VTL = (const bf16_t*)(P.ws + WS_VTL) + ((size_t)(b * 6 + h) * 64) * SEQ; const bf16_t* VTC = (const bf16_t*)(P.ws + WS_VTC) + ((size_t)(b * 6 + h) * 64) * CTX;
    if (lat) {
#pragma unroll
        for (int m = 0; m < 8; ++m) { const int tk = (start + m) * 64 + band0 + fq * 4;
            u32x4 pw; pw.x = cvt_pk_bf16(sc[2 * m][0], sc[2 * m][1]); pw.y = cvt_pk_bf16(sc[2 * m][2], sc[2 * m][3]); pw.z = cvt_pk_bf16(sc[2 * m + 1][0], sc[2 * m + 1][1]); pw.w = cvt_pk_bf16(sc[2 * m + 1][2], sc[2 * m + 1][3]);
            const bf16x8 pb = __builtin_bit_cast(bf16x8, pw);
#pragma unroll
            for (int q = 0; q < 4; ++q) { const bf16_t* vp = VTL + (size_t)(q * 16 + fr) * SEQ + tk; const u32x2 v0 = *(const u32x2*)vp, v1 = *(const u32x2*)(vp + 16);
                u32x4 vw; vw.x = v0.x; vw.y = v0.y; vw.z = v1.x; vw.w = v1.y;
                ot[q] = __builtin_amdgcn_mfma_f32_16x16x32_bf16(__builtin_bit_cast(bf16x8, vw), pb, ot[q], 0, 0, 0); }
            if (m & 1) asm volatile("" ::: "memory"); }
    }
#pragma unroll
    for (int m = 0; m < 8; ++m) { const int tk = 32 * m + fq * 4;
        u32x4 pw; pw.x = cvt_pk_bf16(sc[16 + 2 * m][0], sc[16 + 2 * m][1]); pw.y = cvt_pk_bf16(sc[16 + 2 * m][2], sc[16 + 2 * m][3]); pw.z = cvt_pk_bf16(sc[17 + 2 * m][0], sc[17 + 2 * m][1]); pw.w = cvt_pk_bf16(sc[17 + 2 * m][2], sc[17 + 2 * m][3]);
        const bf16x8 pb = __builtin_bit_cast(bf16x8, pw);
#pragma unroll
        for (int q = 0; q < 4; ++q) { const bf16_t* vp = VTC + (size_t)(q * 16 + fr) * CTX + tk; const u32x2 v0 = *(const u32x2*)vp, v1 = *(const u32x2*)(vp + 16);
            u32x4 vw; vw.x = v0.x; vw.y = v0.y; vw.z = v1.x; vw.w = v1.y;
            ot[q] = __builtin_amdgcn_mfma_f32_16x16x32_bf16(__builtin_bit_cast(bf16x8, vw), pb, ot[q], 0, 0, 0); }
        if (m & 1) asm volatile("" ::: "memory"); }
#pragma unroll
    for (int q = 0; q < 4; ++q) { u32x2 w; w.x = cvt_pk_bf16(ot[q][0] * inv, ot[q][1] * inv); w.y = cvt_pk_bf16(ot[q][2] * inv, ot[q][3] * inv);
        *(u32x2*)(MIX + (size_t)(qtok0 + fr) * D + 640 + h * 64 + q * 16 + fq * 4) = w; }
}

__device__ __forceinline__ void fft_fwd(float2* X) {
#pragma unroll 1
    for (int lq = 12; lq >= 0; lq -= 2) { const int q = 1 << lq; const float rq = 1.0f / (float)(4 * q);
        for (int j = otid(); j < NFFT / 4; j += NTHR) { const int lo = j & (q - 1), base = ((j >> lq) << (lq + 2)) | lo;
            const float2 x0 = X[base], x1 = X[base + q], x2 = X[base + 2 * q], x3 = X[base + 3 * q];
            const float fr = (float)lo * rq; const float c = __builtin_amdgcn_cosf(fr), s = __builtin_amdgcn_sinf(fr), c2 = c * c - s * s, s2 = 2.f * c * s;
            const float a0x = x0.x + x2.x, a0y = x0.y + x2.y, dx = x0.x - x2.x, dy = x0.y - x2.y;
            const float a2x = dx * c + dy * s, a2y = dy * c - dx * s;
            const float a1x = x1.x + x3.x, a1y = x1.y + x3.y, ex = x1.x - x3.x, ey = x1.y - x3.y;
            const float mx = ex * c + ey * s, my = ey * c - ex * s;
            const float a3x = my, a3y = -mx;
            const float fx = a0x - a1x, fy = a0y - a1y, gx = a2x - a3x, gy = a2y - a3y;
            X[base] = make_float2(a0x + a1x, a0y + a1y); X[base + q] = make_float2(fx * c2 + fy * s2, fy * c2 - fx * s2);
            X[base + 2 * q] = make_float2(a2x + a3x, a2y + a3y); X[base + 3 * q] = make_float2(gx * c2 + gy * s2, gy * c2 - gx * s2); }
        __syncthreads(); }
}
__device__ __forceinline__ void fft_inv(float2* X) {
#pragma unroll 1
    for (int lq = 0; lq <= 12; lq += 2) { const int q = 1 << lq; const float rq = 1.0f / (float)(4 * q);
        for (int j = otid(); j < NFFT / 4; j += NTHR) { const int lo = j & (q - 1), base = ((j >> lq) << (lq + 2)) | lo;
            const float2 y0 = X[base], y1 = X[base + q], y2 = X[base + 2 * q], y3 = X[base + 3 * q];
            const float fr = (float)lo * rq; const float c = __builtin_amdgcn_cosf(fr), s = __builtin_amdgcn_sinf(fr), c2 = c * c - s * s, s2 = 2.f * c * s;
            const float tx = y1.x * c2 - y1.y * s2, ty = y1.x * s2 + y1.y * c2;
            const float a0x = y0.x + tx, a0y = y0.y + ty, a1x = y0.x - tx, a1y = y0.y - ty;
            const float ux = y3.x * c2 - y3.y * s2, uy = y3.x * s2 + y3.y * c2;
            const float a2x = y2.x + ux, a2y = y2.y + uy, a3x = y2.x - ux, a3y = y2.y - uy;
            const float vx = a2x * c - a2y * s, vy = a2x * s + a2y * c;
            const float mx = a3x * c - a3y * s, my = a3x * s + a3y * c;
            const float wx = -my, wy = mx;
            X[base] = make_float2(a0x + vx, a0y + vy); X[base + 2 * q] = make_float2(a0x - vx, a0y - vy);
            X[base + q] = make_float2(a1x + wx, a1y + wy); X[base + 3 * q] = make_float2(a1x - wx, a1y - wy); }
        __syncthreads(); }
}
__device__ __forceinline__ float hy_delta(int c) { const float lo = -4.605170185988091f / 1.5f, hi = -4.605170185988091f / 0.3f; return fabsf(lo + (float)c * ((hi - lo) / 255.0f)); }
__device__ __forceinline__ float hy_short(const bf16_t* PHYT, const float* cw, const float* cb, int row, int col) {
    bool hp, hn; row_nbrs(row, hp, hn);
    const bf16_t* p = PHYT + (size_t)col * T + row;
    float v = cb[col] + cw[HY_IN + col] * bf2f(p[0]);
    if (hp) v += cw[col] * bf2f(p[-1]);
    if (hn) v += cw[2 * HY_IN + col] * bf2f(p[1]);
    return v;
}
struct HyTap { float w0, w1, w2, b; };
__device__ __forceinline__ HyTap hy_tap(const float* cw, const float* cb, int col) { HyTap t; t.w0 = cw[col]; t.w1 = cw[HY_IN + col]; t.w2 = cw[2 * HY_IN + col]; t.b = cb[col]; return t; }
__device__ __forceinline__ float hy_lat(const bf16_t* colp, int b, int n, const HyTap t) {
    const bf16_t* p = colp + b * SEQ + n;
    const float xm = bf2f(p[n > 0 ? -1 : 0]), x0 = bf2f(p[0]), xp = bf2f(p[n < SEQ - 1 ? 1 : 0]);
    return t.b + t.w1 * x0 + (n > 0 ? t.w0 * xm : 0.f) + (n < SEQ - 1 ? t.w2 * xp : 0.f);
}
__device__ __forceinline__ void hy_spec_task(const Params& P, int l, int c, float2* X) {
    const int tid = otid();
    const bf16_t* f0 = (const bf16_t*)(P.ws + WS_FILT) + (size_t)c * SEQ; const bf16_t* b0 = f0 + (size_t)256 * SEQ; const bf16_t* f1 = f0 + (size_t)512 * SEQ; const bf16_t* b1 = f0 + (size_t)768 * SEQ;
    for (int n = tid; n < SEQ; n += NTHR) {
        X[n] = make_float2(bf2f(f0[n]), bf2f(f1[n]));
        if (n > 0) X[NFFT - n] = make_float2(bf2f(b0[n]), bf2f(b1[n])); else X[SEQ] = make_float2(0.f, 0.f); }
    __syncthreads();
    fft_fwd(X);
    float2* spec = (float2*)(P.ws + WS_SPEC) + (size_t)c * NFFT;
    for (int i = tid; i < NFFT; i += NTHR) spec[i] = X[i];
    __syncthreads();
}
__device__ __forceinline__ void hy_conv_core(const Params& P, int o, int c, float2* X) {
    fft_fwd(X);
    const float2* spec = (const float2*)(P.ws + WS_SPEC) + (size_t)c * NFFT;
    for (int i = otid(); i < NFFT; i += NTHR) {
        const unsigned f = __brev((unsigned)i) >> 18;
        const unsigned ip = __brev(((unsigned)NFFT - f) & (unsigned)(NFFT - 1)) >> 18;
        const float2 a = X[i], w = spec[i], w2 = spec[ip];
        const float kx = o == 0 ? 0.5f * (w.x + w2.x) : 0.5f * (w.y + w2.y), ky = o == 0 ? 0.5f * (w.y - w2.y) : -0.5f * (w.x - w2.x);
        X[i] = make_float2(a.x * kx - a.y * ky, a.x * ky + a.y * kx); }
    __syncthreads();
    fft_inv(X);
}
__device__ __forceinline__ void hy_task1(const Params& P, int l, int c, float2* X, float* ex) {
    const int tid = otid();
    const bf16_t* PHY = (const bf16_t*)(P.ws + WS_PHY); const float* cw = P.in[I_HCW] + (size_t)l * 3 * HY_IN; const float* cb = P.in[I_HCB] + (size_t)l * HY_IN;
    const float bias0 = P.in[I_HBIAS][(size_t)l * 2 * HYC + c], bias1 = P.in[I_HBIAS][(size_t)l * 2 * HYC + HYC + c];
    const HyTap tv = hy_tap(cw, cb, c), tg1 = hy_tap(cw, cb, HYC + c); const bf16_t* colv = PHY + (size_t)c * T; const bf16_t* colg1 = PHY + (size_t)(HYC + c) * T;
#pragma unroll 4
    for (int n = tid; n < SEQ; n += NTHR) { X[n] = make_float2(hy_lat(colv, 0, n, tv), hy_lat(colv, 1, n, tv)); X[SEQ + n] = make_float2(0.f, 0.f); }
    __syncthreads();
    hy_conv_core(P, 0, c, X);
    float* Z1 = (float*)(P.ws + WS_Z1) + (size_t)c * NB * SEQ;
#pragma unroll 4
    for (int n = tid; n < SEQ; n += NTHR) { const float2 y = X[n];
        const float v0 = hy_lat(colv, 0, n, tv), v1 = hy_lat(colv, 1, n, tv), g0 = hy_lat(colg1, 0, n, tg1), g1 = hy_lat(colg1, 1, n, tg1);
        Z1[n] = g0 * (y.x + bias0 * v0); Z1[SEQ + n] = g1 * (y.y + bias0 * v1); }
    __syncthreads();
    float* f = (float*)X;
    float* vv = f, *x1 = f + 512, *x2 = f + 1024, *hf = f + 1536  , *z1 = f + 2560;
    const bf16_t* fc = (const bf16_t*)(P.ws + WS_FILTC);
    { const int b = tid >> 8, t = tid & 255, row = TL + b * CTX + t;
      vv[tid] = hy_short(PHY, cw, cb, row, c); x1[tid] = hy_short(PHY, cw, cb, row, HYC + c); x2[tid] = hy_short(PHY, cw, cb, row, 2 * HYC + c);
      for (int q = tid; q < 1024; q += NTHR) { const int od = q >> 8, n = q & 255; hf[q] = bf2f(fc[(size_t)(od * 256 + c) * CTX + n]); } }
    __syncthreads();
    { const int b = tid >> 8, t = tid & 255; float y = bias0 * vv[tid];
      for (int s = 0; s <= t; ++s) y += hf[t - s] * vv[b * 256 + s];
      for (int s = t + 1; s < CTX; ++s) y += hf[256 + s - t] * vv[b * 256 + s];
      z1[tid] = x1[tid] * y; }
    __syncthreads();
    { const int b = tid >> 8, t = tid & 255; float y = bias1 * z1[tid];
      for (int s = 0; s <= t; ++s) y += hf[512 + t - s] * z1[b * 256 + s];
      for (int s = t + 1; s < CTX; ++s) y += hf[768 + s - t] * z1[b * 256 + s];
      bf16_t* MIX = (bf16_t*)(P.ws + WS_U); MIX[(size_t)(TL + b * CTX + t) * D + c] = f2bf(x2[tid] * y); }
    __syncthreads();
}
__device__ __forceinline__ void hy_task2(const Params& P, int l, int c, float2* X) {
    const int tid = otid();
    const bf16_t* PHY = (const bf16_t*)(P.ws + WS_PHY); const float* cw = P.in[I_HCW] + (size_t)l * 3 * HY_IN; const float* cb = P.in[I_HCB] + (size_t)l * HY_IN;
    const float bias1 = P.in[I_HBIAS][(size_t)l * 2 * HYC + HYC + c];
    const float* Z1 = (const float*)(P.ws + WS_Z1) + (size_t)c * NB * SEQ; float* Z1w = (float*)(P.ws + WS_Z1) + (size_t)c * NB * SEQ;
    for (int n = tid; n < SEQ; n += NTHR) { X[n] = make_float2(Z1[n], Z1[SEQ + n]); X[SEQ + n] = make_float2(0.f, 0.f); }
    __syncthreads();
    hy_conv_core(P, 1, c, X);
    bf16_t* MIX = (bf16_t*)(P.ws + WS_U);
    const HyTap tg2 = hy_tap(cw, cb, 2 * HYC + c); const bf16_t* colg2 = PHY + (size_t)(2 * HYC + c) * T;
#pragma unroll 4
    for (int n = tid; n < SEQ; n += NTHR) { const float2 y = X[n];
        const float g0 = hy_lat(colg2, 0, n, tg2), g1 = hy_lat(colg2, 1, n, tg2);
        Z1w[n] = g0 * (y.x + bias1 * Z1[n]); Z1w[SEQ + n] = g1 * (y.y + bias1 * Z1[SEQ + n]); }
    __syncthreads();
}

constexpr int SEGC = 256, NSEG = 33, SCH = 4;
typedef float f32x2v __attribute__((ext_vector_type(2)));
template <bool IDENT>
__device__ __forceinline__ void scan_seg(const Params& P, int chain, int g, float* ring_  ) {
    const ldsfp ring = vlds(ring_);
    const int lane = otid() & 63;
    const int d = chain & 1, h = (chain >> 1) % 6, b = chain / 12;
    const float* DEC = (const float*)(P.ws + WS_DECAY) + (size_t)d * T * 384; const bf16_t* KKS = (const bf16_t*)(P.ws + WS_KKS); const bf16_t* RS = (const bf16_t*)(P.ws + WS_RS);
    const bf16_t* VS = (const bf16_t*)(P.ws + WS_VS); const bf16_t* KS = (const bf16_t*)(P.ws + WS_KS) + (size_t)d * T * 384; const bf16_t* BS = (const bf16_t*)(P.ws + WS_BS) + (size_t)d * T * 384;
    float* YD = (float*)(P.ws + WS_YDIR) + (size_t)d * T * 384;
    bf16_t* E = (bf16_t*)(P.ws + WS_E) + (size_t)chain * SEQ * 64;
    const int step0 = g == 0 ? 0 : CTX + (g - 1) * SEGC;
    f32x2v S0[32], S1[32];
#pragma unroll
    for (int j = 0; j < 32; ++j) { S0[j] = (f32x2v){0.f, 0.f}; S1[j] = (f32x2v){(2 * j == lane) ? 1.f : 0.f, (2 * j + 1 == lane) ? 1.f : 0.f}; }
    float pw[SCH], pa[SCH], pb[SCH], pk[SCH], pr[SCH], pv[SCH]; int po[SCH];
#pragma unroll
    for (int s = 0; s < SCH; ++s) { const int o = scan_row(b, d, step0 + s) * 384 + h * 64 + lane; po[s] = o;
        pw[s] = DEC[o]; pa[s] = bf2f(KKS[o]); pb[s] = bf2f(BS[o]); pk[s] = bf2f(KS[o]); pr[s] = bf2f(RS[o]); pv[s] = bf2f(VS[o]); }
    for (int c = 0; c < SEGC / SCH; ++c) {
        float cv[SCH]; int co[SCH];
        asm volatile("s_waitcnt lgkmcnt(0)" ::: "memory");
#pragma unroll
        for (int s = 0; s < SCH; ++s) { const ldsfp sv = ring + s * 320; sv[lane] = pw[s]; sv[64 + lane] = pa[s]; sv[128 + lane] = pb[s]; sv[192 + lane] = pk[s]; sv[256 + lane] = pr[s]; cv[s] = pv[s]; co[s] = po[s]; }
        asm volatile("s_waitcnt lgkmcnt(0)" ::: "memory");
        if (c + 1 < SEGC / SCH) {
#pragma unroll
            for (int s = 0; s < SCH; ++s) { const int o = scan_row(b, d, step0 + (c + 1) * SCH + s) * 384 + h * 64 + lane; po[s] = o;
                pw[s] = DEC[o]; pa[s] = bf2f(KKS[o]); pb[s] = bf2f(BS[o]); pk[s] = bf2f(KS[o]); pr[s] = bf2f(RS[o]); pv[s] = bf2f(VS[o]); } }
#pragma unroll
        for (int s = 0; s < SCH; ++s) { const ldsfp sv = ring + s * 320;
            f32x2v sa2 = (f32x2v){0.f, 0.f}, sb2 = (f32x2v){0.f, 0.f}, sa3 = sa2, sb3 = sa2;
#pragma unroll
            for (int hb = 0; hb < 2; ++hb) { f32x4 A[8];
#pragma unroll
                for (int i = 0; i < 8; ++i) A[i] = *(const LAS f32x4*)(sv + 64 + hb * 32 + 4 * i);
                __builtin_amdgcn_sched_barrier(0);
#pragma unroll
                for (int i = 0; i < 8; ++i) { const int jj = hb * 16 + 2 * i; const f32x2v alo = (f32x2v){A[i].x, A[i].y}, ahi = (f32x2v){A[i].z, A[i].w};
                    sa2 += S0[jj] * alo; sa3 += S0[jj + 1] * ahi;
                    if (IDENT) { sb2 += S1[jj] * alo; sb3 += S1[jj + 1] * ahi; } }
                __builtin_amdgcn_sched_barrier(0); }
            const float sa = (sa2.x + sa2.y) + (sa3.x + sa3.y), sb = (sb2.x + sb2.y) + (sb3.x + sb3.y);
            const f32x2v saa = (f32x2v){sa, sa}, sbb = (f32x2v){sb, sb}, vv = (f32x2v){cv[s], cv[s]};
            f32x2v y2 = (f32x2v){0.f, 0.f}, y3 = y2, e2 = y2, e3 = y2;
#pragma unroll
            for (int ch = 0; ch < 8; ++ch) { f32x4 W[2], Bq[2], K[2], R[2];
#pragma unroll
                for (int i = 0; i < 2; ++i) { const int j = ch * 8 + 4 * i; W[i] = *(const LAS f32x4*)(sv + j); Bq[i] = *(const LAS f32x4*)(sv + 128 + j); K[i] = *(const LAS f32x4*)(sv + 192 + j); R[i] = *(const LAS f32x4*)(sv + 256 + j); }
                __builtin_amdgcn_sched_barrier(0);
#pragma unroll
                for (int i = 0; i < 2; ++i) { const int jj = ch * 4 + 2 * i;
                    const f32x2v wlo = (f32x2v){W[i].x, W[i].y}, whi = (f32x2v){W[i].z, W[i].w}, blo = (f32x2v){Bq[i].x, Bq[i].y}, bhi = (f32x2v){Bq[i].z, Bq[i].w};
                    const f32x2v klo = (f32x2v){K[i].x, K[i].y}, khi = (f32x2v){K[i].z, K[i].w}, rlo = (f32x2v){R[i].x, R[i].y}, rhi = (f32x2v){R[i].z, R[i].w};
                    S0[jj] = S0[jj] * wlo + saa * blo + vv * klo; y2 += S0[jj] * rlo;
                    S0[jj + 1] = S0[jj + 1] * whi + saa * bhi + vv * khi; y3 += S0[jj + 1] * rhi;
                    if (IDENT) { S1[jj] = S1[jj] * wlo + sbb * blo; e2 += S1[jj] * rlo; S1[jj + 1] = S1[jj + 1] * whi + sbb * bhi; e3 += S1[jj + 1] * rhi; } }
                __builtin_amdgcn_sched_barrier(0); }
            YD[co[s]] = (y2.x + y2.y) + (y3.x + y3.y);
            if (IDENT) { const int tl = d ? (SEQ - 1 - (step0 - CTX + c * SCH + s)) : (step0 - CTX + c * SCH + s); E[(size_t)tl * 64 + lane] = f2bf((e2.x + e2.y) + (e3.x + e3.y)); }
        }
    }
    float* ZP = (float*)(P.ws + WS_ZP) + ((size_t)chain * NSEG + g) * 2 * 4096;
#pragma unroll
    for (int j = 0; j < 32; j += 2) { *(float4*)(ZP + lane * 64 + 2 * j) = make_float4(S0[j].x, S0[j].y, S0[j + 1].x, S0[j + 1].y);
        if (IDENT) *(float4*)(ZP + 4096 + lane * 64 + 2 * j) = make_float4(S1[j].x, S1[j].y, S1[j + 1].x, S1[j + 1].y); }
}
typedef float f32x16 __attribute__((ext_vector_type(16)));
__device__ __forceinline__ void scan_combine(const Params& P, int chain, float* lds) {
    const int tid = otid(), lane = tid & 63, wv = tid >> 6, li = lane & 31, lh = lane >> 5;
    const ldsfp Sl = vlds(lds);
    const ldsfp Pl = Sl + 64 * 65;
    float* ZPc = (float*)(P.ws + WS_ZP) + (size_t)chain * NSEG * 2 * 4096;
    const int ti = (wv >> 1) & 1, tj = wv & 1;
    float pn[8];
#pragma unroll
    for (int q = 0; q < 8; ++q) { pn[q] = ZPc[(size_t)2 * 4096 + 4096 + tid * 8 + q]; Sl[(tid >> 3) * 65 + (tid & 7) * 8 + q] = ZPc[tid * 8 + q]; }
    f32x16 acc, zn;
#pragma unroll
    for (int r = 0; r < 16; ++r) { zn[r] = 0.f; acc[r] = 0.f; }
    if (wv < 4) {
#pragma unroll
        for (int r = 0; r < 16; ++r) zn[r] = ZPc[(size_t)2 * 4096 + (32 * ti + (r & 3) + 8 * (r >> 2) + 4 * lh) * 64 + 32 * tj + li]; }
    for (int g = 1; g < NSEG - 1; ++g) {
        __syncthreads();
        if (g > 1 && wv < 4) {
#pragma unroll
            for (int r = 0; r < 16; ++r) Sl[(32 * ti + (r & 3) + 8 * (r >> 2) + 4 * lh) * 65 + 32 * tj + li] = acc[r]; }
#pragma unroll
        for (int q = 0; q < 8; ++q) Pl[tid * 8 + q] = pn[q];
        acc = zn;
        if (g + 1 < NSEG - 1) { const float* nx = ZPc + (size_t)(g + 1) * 2 * 4096;
#pragma unroll
            for (int q = 0; q < 8; ++q) pn[q] = nx[4096 + tid * 8 + q];
            if (wv < 4) {
#pragma unroll
                for (int r = 0; r < 16; ++r) zn[r] = nx[(32 * ti + (r & 3) + 8 * (r >> 2) + 4 * lh) * 64 + 32 * tj + li]; } }
        __syncthreads();
        if (wv < 4) {
#pragma unroll 8
            for (int k0 = 0; k0 < 64; k0 += 2) { const float av = Sl[(32 * ti + li) * 65 + k0 + lh], bv = Pl[(k0 + lh) * 64 + 32 * tj + li];
                acc = __builtin_amdgcn_mfma_f32_32x32x2f32(av, bv, acc, 0, 0, 0); }
            float* Zg = ZPc + (size_t)g * 2 * 4096;
#pragma unroll
            for (int r = 0; r < 16; ++r) Zg[(32 * ti + (r & 3) + 8 * (r >> 2) + 4 * lh) * 64 + 32 * tj + li] = acc[r]; }
    }
    __syncthreads();
}

__device__ __forceinline__ void rwkv_out_fin(const Params& P, int row, int c, float y, float lnw, float lnb, float bon, float vs, float gt) {
    bf16_t* MIX = (bf16_t*)(P.ws + WS_U);
    const float mean = wsum(y) * (1.0f / 64.0f); const float dv = y - mean; const float var = wsum(dv * dv) * (1.0f / 64.0f);
    const float yn = dv * rsqrtf(var + 64e-5f) * lnw + lnb;
    MIX[(size_t)row * D + 256 + c] = f2bf((yn + bon * vs) * gt);
}
__device__ __forceinline__ void ph_rwkvout(const Params& P, int l, float* ldsf) {
    using pg8::bf16x8;
    const int tid = otid(), lane = tid & 63, fr = lane & 15, fq = lane >> 4, wv = tid >> 6, gw = blockIdx.x * NWAVE + wv, nw = gridDim.x * NWAVE;
    const float* YD = (const float*)(P.ws + WS_YDIR); const bf16_t* VS = (const bf16_t*)(P.ws + WS_VS); const bf16_t* GT = (const bf16_t*)(P.ws + WS_GATE); const float* BON = (const float*)(P.ws + WS_BONUS);
    bf16_t* MIX = (bf16_t*)(P.ws + WS_U);
    for (int it = gw; it < NB * 6 * 32 * 4; it += nw) {
        const int sub = it & 3, q = (it >> 2) & 31, h = (it >> 7) % 6, b = it / (128 * 6);
        const int t0 = q * 256 + sub * 64;
        f32x4 acc[4][4];
#pragma unroll
        for (int mt = 0; mt < 4; ++mt)
#pragma unroll
            for (int nt = 0; nt < 4; ++nt) acc[mt][nt] = (f32x4){0.f, 0.f, 0.f, 0.f};
#pragma unroll
        for (int dir = 0; dir < 2; ++dir) { const int ch = b * 12 + h * 2 + dir, slot = dir ? (31 - q) : q;
            const float* Sp = (const float*)(P.ws + WS_ZP) + ((size_t)ch * NSEG + slot) * 2 * 4096;
            const bf16_t* Ep = (const bf16_t*)(P.ws + WS_E) + ((size_t)ch * SEQ + t0) * 64;
#pragma unroll
            for (int ks = 0; ks < 2; ++ks) { bf16x8 bop[4];
#pragma unroll
                for (int nt = 0; nt < 4; ++nt) { const float* sp = Sp + (nt * 16 + fr) * 64 + ks * 32 + fq * 8; const float4 s0 = *(const float4*)sp, s1 = *(const float4*)(sp + 4);
                    u32x4 w; w.x = cvt_pk_bf16(s0.x, s0.y); w.y = cvt_pk_bf16(s0.z, s0.w); w.z = cvt_pk_bf16(s1.x, s1.y); w.w = cvt_pk_bf16(s1.z, s1.w); bop[nt] = __builtin_bit_cast(bf16x8, w); }
#pragma unroll
                for (int mt = 0; mt < 4; ++mt) { const bf16x8 a = *(const bf16x8*)(Ep + (size_t)(mt * 16 + fr) * 64 + ks * 32 + fq * 8);
#pragma unroll
                    for (int nt = 0; nt < 4; ++nt) acc[mt][nt] = __builtin_amdgcn_mfma_f32_16x16x32_bf16(a, bop[nt], acc[mt][nt], 0, 0, 0); } } }
        float lnw[4], lnb[4];
#pragma unroll
        for (int nt = 0; nt < 4; ++nt) { lnw[nt] = P.in[I_LNW][l * RWW + h * 64 + nt * 16 + fr]; lnb[nt] = P.in[I_LNB][l * RWW + h * 64 + nt * 16 + fr]; }
#pragma unroll
        for (int mt = 0; mt < 4; ++mt)
#pragma unroll
            for (int rg = 0; rg < 4; ++rg) { const int row = b * SEQ + t0 + mt * 16 + fq * 4 + rg; const size_t o = (size_t)row * 384 + h * 64 + fr;
                float y[4], vs[4], gt[4]; const float bon = BON[(size_t)row * 6 + h];
#pragma unroll
                for (int nt = 0; nt < 4; ++nt) { y[nt] = YD[o + nt * 16] + YD[(size_t)T * 384 + o + nt * 16] + acc[mt][nt][rg]; vs[nt] = bf2f(VS[o + nt * 16]); gt[nt] = bf2f(GT[o + nt * 16]); }
                float sm = (y[0] + y[1]) + (y[2] + y[3]);
                sm += __shfl_xor(sm, 1); sm += __shfl_xor(sm, 2); sm += __shfl_xor(sm, 4); sm += __shfl_xor(sm, 8);
                const float mean = sm * (1.0f / 64.0f);
                float vr = 0.f;
#pragma unroll
                for (int nt = 0; nt < 4; ++nt) { y[nt] -= mean; vr += y[nt] * y[nt]; }
                vr += __shfl_xor(vr, 1); vr += __shfl_xor(vr, 2); vr += __shfl_xor(vr, 4); vr += __shfl_xor(vr, 8);
                const float rstd = rsqrtf(vr * (1.0f / 64.0f) + 64e-5f);
#pragma unroll
                for (int nt = 0; nt < 4; ++nt) MIX[(size_t)row * D + 256 + h * 64 + nt * 16 + fr] = f2bf((y[nt] * rstd * lnw[nt] + lnb[nt] + bon * vs[nt]) * gt[nt]);
                if (rg & 1) asm volatile("" ::: "memory"); }
    }
    for (int it = gw; it < TC * 6; it += nw) { const int row = TL + it / 6, h = it % 6, c = h * 64 + lane; const size_t o = (size_t)row * 384 + c;
        rwkv_out_fin(P, row, c, YD[o] + YD[(size_t)T * 384 + o], P.in[I_LNW][l * RWW + c], P.in[I_LNB][l * RWW + c], BON[(size_t)row * 6 + h], bf2f(VS[o]), bf2f(GT[o])); }
}

__device__ __forceinline__ void zt_tile(const Params& P, int tile, float* tl  ) {
    const int tid = otid(); const int c0 = (tile & 3) * 64, t0 = (tile >> 2) * 64;
    const float* Z = (const float*)(P.ws + WS_Z1); bf16_t* MIX = (bf16_t*)(P.ws + WS_U);
    { const int cc = tid >> 3, sg = (tid & 7) * 8; const float* src = Z + (size_t)(c0 + cc) * TL + t0 + sg; const float4 a = *(const float4*)src, b = *(const float4*)(src + 4);
      tl[cc * 65 + sg + 0] = a.x; tl[cc * 65 + sg + 1] = a.y; tl[cc * 65 + sg + 2] = a.z; tl[cc * 65 + sg + 3] = a.w; tl[cc * 65 + sg + 4] = b.x; tl[cc * 65 + sg + 5] = b.y; tl[cc * 65 + sg + 6] = b.z; tl[cc * 65 + sg + 7] = b.w; }
    __syncthreads();
    { const int tk = tid >> 3, cs = (tid & 7) * 8;
      u32x4 w; w.x = cvt_pk_bf16(tl[(cs + 0) * 65 + tk], tl[(cs + 1) * 65 + tk]); w.y = cvt_pk_bf16(tl[(cs + 2) * 65 + tk], tl[(cs + 3) * 65 + tk]);
      w.z = cvt_pk_bf16(tl[(cs + 4) * 65 + tk], tl[(cs + 5) * 65 + tk]); w.w = cvt_pk_bf16(tl[(cs + 6) * 65 + tk], tl[(cs + 7) * 65 + tk]);
      *(u32x4*)(MIX + (size_t)(t0 + tk) * D + c0 + cs) = w; }
    __syncthreads();
}
typedef const __attribute__((address_space(4))) Params* KParamsPtr;
__device__ __forceinline__ const Params* fresh_params() { KParamsPtr q = (KParamsPtr)__builtin_amdgcn_kernarg_segment_ptr(); asm volatile("" : "+s"(q)); return (const Params*)q; }
__global__ void __launch_bounds__(NTHR, 2) fwd_megakernel(Params P_unused, int ph_lo, int ph_hi) {
    extern __shared__ __attribute__((aligned(16))) unsigned char smem[];
    cg::grid_group grid = cg::this_grid();
    LAS unsigned char* lds3 = (LAS unsigned char*)smem;
    float* ldsf = (float*)smem; float2* X = (float2*)smem; float* ex = (float*)(smem + LDS_MAIN);
    { volatile LAS unsigned* st = (volatile LAS unsigned*)(lds3 + LDS_MAIN + 4096); if (threadIdx.x == 0) { st[0] = 0u; st[1] = 0u; } }
    __syncthreads();
    XcdBarrier xbar = xcd_barrier_post((unsigned*)(((const Params*)fresh_params())->ws + WS_BAR), (volatile LAS unsigned*)(lds3 + LDS_MAIN + 4096));
    int ph = 0;
#ifndef REP_GEMM
#define REP_GEMM 1
#endif
#ifndef REP_SCAN
#define REP_SCAN 1
#endif
#ifndef REP_MISC
#define REP_MISC 1
#endif
#ifndef REP_HY
#define REP_HY 1
#endif
#define PHASE_BEGIN if (ph >= ph_lo && ph < ph_hi) { const Params& P = *fresh_params(); unsigned char* ws = P.ws; (void)ws;
#ifndef REP_SYNC
#define REP_SYNC 1
#endif
#define PHASE_END   if (ph + 1 < ph_hi) { for (int rs_ = 0; rs_ < REP_SYNC; ++rs_) { if (ph == 0) grid.sync(); else xcd_barrier(xbar); } } } ++ph;
    PHASE_BEGIN ph_modv(P, ldsf); PHASE_END
    for (int l = 0; l < DEPTH; ++l) {
        PHASE_BEGIN
            for (int rep_ = 0; rep_ < REP_MISC; ++rep_) ph_prep(P, l, ldsf);
            if (l == 0) ph_rowpass(P, 0, 0, 0, 0, 0.f, 0, 0, 0, 1, 1);
            else ph_rowpass(P, 1, l - 1, 8, 5, 0.5f, l, 0, 0, 1, 11);
        PHASE_END
        PHASE_BEGIN { EpiGU E{(bf16_t*)(ws + WS_ACT)}; for (int rep_ = 0; rep_ < REP_GEMM; ++rep_) run_gemm(lds3, (const bf16_t*)(ws + WS_U), (const bf16_t*)(ws + WS_WGU1), T, 2 * DFF, D, E); } PHASE_END
        PHASE_BEGIN { EpiF32 E{(bf16_t*)(ws + WS_Y), (float*)(ws + WS_YC)}; run_gemm_tail(lds3, (const bf16_t*)(ws + WS_ACT), (const bf16_t*)(ws + WS_WDN1), DFF, E); } PHASE_END
        PHASE_BEGIN ph_rowpass(P, 1, l, 2, 1, 0.5f, l, 2, 3, 4, 11); PHASE_END
        PHASE_BEGIN { EpiWin E{(bf16_t*)(ws + WS_PHY), (bf16_t*)(ws + WS_PRW), (bf16_t*)(ws + WS_PNA)}; for (int rep_ = 0; rep_ < REP_GEMM; ++rep_) run_gemm(lds3, (const bf16_t*)(ws + WS_U), (const bf16_t*)(ws + WS_WIN), T, INWP, D, E); } PHASE_END
        PHASE_BEGIN
            for (int rep_ = 0; rep_ < REP_MISC; ++rep_) { ph_loraprep(P, l);
            for (int it = blockIdx.x; it < NB * 128 * 6 + NB * 4 * 6; it += gridDim.x) vt_tile(P, it, (unsigned short*)smem); }
            for (int rep_ = 0; rep_ < REP_HY; ++rep_) for (int it = blockIdx.x; it < 256; it += gridDim.x) hy_spec_task(P, l, it, X);
        PHASE_END
        PHASE_BEGIN { EpiLora E{(bf16_t*)(ws + WS_LORAO), (bf16_t*)(ws + WS_GATE)};
            for (int rep_ = 0; rep_ < REP_GEMM; ++rep_) run_gemm(lds3, (const bf16_t*)(ws + WS_ALORA), (const bf16_t*)(ws + WS_WLORA), T, 2048, 384, E); } PHASE_END
        PHASE_BEGIN
            for (int rep_ = 0; rep_ < REP_MISC; ++rep_) ph_rwkvprep(P, l);
            for (int rep_ = 0; rep_ < REP_HY; ++rep_) for (int c = blockIdx.x; c < HYC; c += gridDim.x) hy_task1(P, l, c, X, ex);
        PHASE_END
        PHASE_BEGIN {
            const int wv = __builtin_amdgcn_readfirstlane(otid() >> 6);
            if (wv < 4) { const int k = wv * (int)gridDim.x + (int)blockIdx.x;
                if (k < 24 * NSEG) { const int chain = k / NSEG, g = k % NSEG; float* ring = ldsf + wv * (SCH * 320);
                    __builtin_amdgcn_s_setprio(3);
                    for (int rep_ = 0; rep_ < REP_SCAN; ++rep_) { if (g == 0) scan_seg<false>(P, chain, g, ring); else scan_seg<true>(P, chain, g, ring); }
                    __builtin_amdgcn_s_setprio(0); } }
            else for (int it = (wv - 4) * (int)gridDim.x + (int)blockIdx.x; it < NAT_TASKS; it += 4 * (int)gridDim.x) natten_task(P, l, it);
        } PHASE_END
        PHASE_BEGIN
            for (int rep_ = 0; rep_ < REP_HY; ++rep_) for (int c = blockIdx.x; c < HYC; c += gridDim.x) hy_task2(P, l, c, X);
            if (blockIdx.x >= gridDim.x - 24) scan_combine(P, (int)(gridDim.x - 1 - blockIdx.x), ldsf);
        PHASE_END
        PHASE_BEGIN for (int rep_ = 0; rep_ < REP_MISC; ++rep_) ph_rwkvout(P, l, ldsf);
            __syncthreads();
            for (int it = blockIdx.x; it < 4 * (TL / 64); it += gridDim.x) zt_tile(P, it, ldsf);
        PHASE_END
        PHASE_BEGIN { EpiF32 E{(bf16_t*)(ws + WS_Y), (float*)(ws + WS_YC)}; run_gemm_tail(lds3, (const bf16_t*)(ws + WS_U), (const bf16_t*)(ws + WS_WOUT), D, E); } PHASE_END
        PHASE_BEGIN ph_rowpass(P, 1, l, 5, 3, 1.0f, l, 4, 6, 7, 4); PHASE_END
        PHASE_BEGIN { EpiGU E{(bf16_t*)(ws + WS_ACT)}; for (int rep_ = 0; rep_ < REP_GEMM; ++rep_) run_gemm(lds3, (const bf16_t*)(ws + WS_U), (const bf16_t*)(ws + WS_WGU2), T, 2 * DFF, D, E); } PHASE_END
        PHASE_BEGIN { EpiF32 E{(bf16_t*)(ws + WS_Y), (float*)(ws + WS_YC)}; run_gemm_tail(lds3, (const bf16_t*)(ws + WS_ACT), (const bf16_t*)(ws + WS_WDN2), DFF, E); } PHASE_END
    }
    PHASE_BEGIN ph_rowpass(P, 2, DEPTH - 1, 8, 5, 0.5f, 0, 0, 0, 0, 11); PHASE_END
#undef PHASE_BEGIN
#undef PHASE_END
}
constexpr int N_PHASES = 1 + DEPTH * 15 + 1;

extern "C" void kernel_launch(void* const* d_in, const int* in_sizes, int n_in, void* d_out, int out_size, void* d_ws, size_t ws_size, hipStream_t stream) {
    static int grid = 0;
    if (grid == 0) {
        if (n_in != 34 || ws_size < WS_END) { fprintf(stderr, "kernel_launch: need 34 inputs and %zu bytes of workspace; got %d, %zu\n", (size_t)WS_END, n_in, ws_size); grid = -1; return; }
        int dev = 0, cus = 0, per_cu = 0;
        hipGetDevice(&dev); hipDeviceGetAttribute(&cus, hipDeviceAttributeMultiprocessorCount, dev);
        if (hipFuncSetAttribute((const void*)fwd_megakernel, hipFuncAttributeMaxDynamicSharedMemorySize, LDS_BYTES) != hipSuccess) { fprintf(stderr, "kernel_launch: hipFuncSetAttribute failed\n"); grid = -1; return; }
        if (hipOccupancyMaxActiveBlocksPerMultiprocessor(&per_cu, (const void*)fwd_megakernel, NTHR, LDS_BYTES) != hipSuccess || per_cu < 1) { fprintf(stderr, "kernel_launch: occupancy query says %d\n", per_cu); per_cu = 1; }
        (void)hipGetLastError();
        grid = cus;
    }
    if (grid < 0) return;
    if (hipMemsetAsync((char*)d_ws + WS_BAR, 0, (size_t)XCD_BAR_WORDS * 4, stream) != hipSuccess) { fprintf(stderr, "kernel_launch: memset of the barrier words failed\n"); return; }
    Params p{};
    for (int i = 0; i < 34; ++i) p.in[i] = (const float*)d_in[i];
    p.out = (float*)d_out; p.ws = (unsigned char*)d_ws;
#if MK_SPLIT
    for (int ph = 0; ph < N_PHASES; ++ph) { int lo = ph, hi = ph + 1; hipLaunchKernelGGL(fwd_megakernel, dim3(grid), dim3(NTHR), LDS_BYTES, stream, p, lo, hi); }
#else
    int lo = 0, hi = N_PHASES;
    void* args[] = {&p, &lo, &hi};
    hipError_t e = hipLaunchCooperativeKernel((const void*)fwd_megakernel, dim3(grid), dim3(NTHR), args, LDS_BYTES, stream);
    if (e != hipSuccess) fprintf(stderr, "cooperative launch failed: %s (grid %d)\n", hipGetErrorString(e), grid);
#endif
}
```

```cpp
#include <hip/hip_runtime.h>
#include <hip/hip_cooperative_groups.h>
#include <cstdio>
namespace cg = cooperative_groups;
__device__ __forceinline__ int otid() { int t = threadIdx.x; asm volatile("" : "+v"(t)); return t; }
namespace pg8 {
#define PG8_LAS __attribute__((address_space(3)))
typedef unsigned short bf16_t;
typedef short bf16x8 __attribute__((ext_vector_type(8)));
typedef float f32x4 __attribute__((ext_vector_type(4)));
typedef unsigned u32x4 __attribute__((ext_vector_type(4)));
constexpr int BM = 256, BK = 64, HALF = 128, HTB = HALF * BK * 2  , STAGE_BYTES = 8 * HTB, NXCD = 8, WGM = 8;

__host__ __device__ __forceinline__ int lds_byte(int r, int c) { const int st = (r >> 4) * 2 + (c >> 5), rr = r & 15, cc = c & 31, ob = rr * 64 + cc * 2; return st * 1024 + (ob ^ (((ob >> 9) & 1) << 5)); }
__host__ __device__ __forceinline__ void stage_rc(int b, int& R, int& C) { const int st = b / 1024, sb = b % 1024, swz = sb ^ (((sb >> 9) & 1) << 5); R = (st >> 1) * 16 + swz / 64; C = (st & 1) * 32 + (swz % 64) / 2; }
__host__ __device__ __forceinline__ int perm32(int rho) { const int n = rho >> 4, i = rho & 15; return 8 * (i >> 2) + 4 * n + (i & 3); }

struct Unit { int pm, pn, kt0, nkt; };
struct Gemm { const bf16_t* A; const bf16_t* Bt; int M, N, K; };
struct StaticOrder {
    int nM, nN, nwg, G, c;
    __host__ __device__ void init(int M, int N, int G_, int c_) { nM = M / BM; nN = N / BM; nwg = nM * nN; G = G_; c = c_; }
    __host__ __device__ bool next(int i, Unit& u) const {
        const long L = (long)i * G + c; if (L >= nwg) return false;
        int wgid = (int)L; { const int q = nwg / NXCD, r = nwg % NXCD, xcd = wgid % NXCD, off = wgid / NXCD; wgid = (xcd < r ? xcd * (q + 1) : r * (q + 1) + (xcd - r) * q) + off; }
        const int nig = WGM * nN, gid = wgid / nig, fm = gid * WGM, gsz = (nM - fm) < WGM ? (nM - fm) : WGM;
        u.pm = fm + ((wgid % nig) % gsz); u.pn = (wgid % nig) / gsz; u.kt0 = 0; u.nkt = 0; return true;
    }
    __device__ __forceinline__ void a_ready(const Unit&) const {}
    __device__ __forceinline__ void done(const Unit&) const {}
};
__device__ __forceinline__ unsigned cvt_pk_bf16(float lo, float hi) { unsigned r; asm volatile("v_cvt_pk_bf16_f32 %0, %1, %2" : "=v"(r) : "v"(lo), "v"(hi)); return r; }
template <class Epi, class Sched>
__device__ __forceinline__ void gemm_phase(PG8_LAS unsigned char* lds, const Gemm g, const Sched& S, const Epi& E) {
    const int tid = otid(), wid = __builtin_amdgcn_readfirstlane(tid >> 6), lane = tid & 63, wr = wid >> 2, wc = wid & 3, fr = lane & 15, fq = lane >> 4;
    const int K = g.K, nt = K / BK;
#define PG8_STAMP() do {} while (0)
    unsigned voffA[2], voffB[2];
#pragma unroll
    for (int i = 0; i < 2; ++i) { int R, C; stage_rc(tid * 16 + i * 8192, R, C); const int Rb = Epi::PERM ? ((R & ~31) + perm32(R & 31)) : R;
        voffA[i] = (unsigned)(R * K + C) * 2u; voffB[i] = (unsigned)(Rb * K + C) * 2u; }
    const size_t kstep = (size_t)(BK * 2);
    const size_t hstep = (size_t)HALF * K * 2;
    const size_t tstep = 2 * hstep;
    const unsigned ldsw = (unsigned)wid * 1024u;
    const int aoff = lds_byte(wr * 64 + fr, fq * 8), boff = lds_byte(wc * 32 + fr, fq * 8);
#define PG8_SA(b, h) (((b) * 2 + (h)) * HTB)
#define PG8_SB(b, h) ((4 + (b) * 2 + (h)) * HTB)
#define PG8_STAGE(bufoff, gbase, voff) do { _Pragma("unroll") for (int _i = 0; _i < 2; ++_i) \
        __builtin_amdgcn_global_load_lds((const unsigned*)((const char*)(gbase) + (voff)[_i]), (PG8_LAS unsigned*)(lds + (bufoff) + ldsw + _i * 8192), 16, 0, 0); } while (0)
#define PG8_LDA(dst, b, h) do { _Pragma("unroll") for (int m = 0; m < 4; ++m) _Pragma("unroll") for (int k = 0; k < 2; ++k) dst[m][k] = *(const PG8_LAS bf16x8*)(lds + PG8_SA(b, h) + aoff + m * 2048 + k * 1024); } while (0)
#define PG8_LDB(dst, b, h) do { _Pragma("unroll") for (int n = 0; n < 2; ++n) _Pragma("unroll") for (int k = 0; k < 2; ++k) dst[n][k] = *(const PG8_LAS bf16x8*)(lds + PG8_SB(b, h) + boff + n * 2048 + k * 1024); } while (0)
#define PG8_MMA(ai, bj, At, Bt) do { __builtin_amdgcn_s_setprio(1); _Pragma("unroll") for (int m = 0; m < 4; ++m) _Pragma("unroll") for (int n = 0; n < 2; ++n) _Pragma("unroll") for (int k = 0; k < 2; ++k) \
        acc[ai][bj][m][n] = __builtin_amdgcn_mfma_f32_16x16x32_bf16(Bt[n][k], At[m][k], acc[ai][bj][m][n], 0, 0, 0); __builtin_amdgcn_s_setprio(0); } while (0)
#define PG8_WAIT_V(n) asm volatile("s_waitcnt vmcnt(" #n ")" ::: "memory")
#define PG8_WAIT_L(n) asm volatile("s_waitcnt lgkmcnt(" #n ")" ::: "memory")
#define PG8_BAR __builtin_amdgcn_s_barrier()
#define PG8_SCHED __builtin_amdgcn_sched_barrier(0)
    Unit cur, nxt; int ui = 0;
    if (!S.next(0, cur)) return;
    f32x4 acc[2][2][4][2];
#pragma unroll
    for (int a = 0; a < 2; ++a)
#pragma unroll
        for (int b = 0; b < 2; ++b)
#pragma unroll
            for (int m = 0; m < 4; ++m)
#pragma unroll
                for (int n = 0; n < 2; ++n) acc[a][b][m][n] = (f32x4){0.f, 0.f, 0.f, 0.f};
    bf16x8 At[4][2], B0[2][2], B1[2][2];
    const char* cA = (const char*)g.A + (size_t)cur.pm * tstep + (size_t)cur.kt0 * kstep; const char* cB = (const char*)g.Bt + (size_t)cur.pn * tstep + (size_t)cur.kt0 * kstep;
    int ntc = cur.nkt > 0 ? cur.nkt : nt;
    S.a_ready(cur);
    PG8_STAGE(PG8_SB(0, 0), cB, voffB); PG8_STAGE(PG8_SA(0, 0), cA, voffA); PG8_STAGE(PG8_SB(0, 1), cB + hstep, voffB); PG8_STAGE(PG8_SA(0, 1), cA + hstep, voffA);
    if (wr == 1) PG8_BAR;
    PG8_WAIT_V(4); PG8_BAR;
    PG8_STAGE(PG8_SB(1, 0), cB + kstep, voffB); PG8_STAGE(PG8_SA(1, 0), cA + kstep, voffA); PG8_STAGE(PG8_SB(1, 1), cB + hstep + kstep, voffB);
    PG8_WAIT_V(6); PG8_BAR;
    PG8_STAMP();
    for (;;) {
        const bool has_next = S.next(ui + 1, nxt);
        const char* nA = has_next ? (const char*)g.A + (size_t)nxt.pm * tstep + (size_t)nxt.kt0 * kstep : cA; const char* nB = has_next ? (const char*)g.Bt + (size_t)nxt.pn * tstep + (size_t)nxt.kt0 * kstep : cB;
        for (int t = 0; t < ntc; t += 2) {
            const bool last = (t == ntc - 2);
            const char* a1 = cA + (size_t)(t + 1) * kstep;
            const char* a2 = last ? nA : cA + (size_t)(t + 2) * kstep; const char* b2 = last ? nB : cB + (size_t)(t + 2) * kstep;
            const char* a3 = a2 + kstep; const char* b3 = b2 + kstep;
            if (last && has_next) S.a_ready(nxt);
            PG8_LDB(B0, 0, 0); PG8_SCHED; PG8_LDA(At, 0, 0); PG8_STAGE(PG8_SA(1, 1), a1 + hstep, voffA);
            PG8_WAIT_L(8); PG8_BAR; PG8_WAIT_L(0); PG8_MMA(0, 0, At, B0); PG8_BAR; PG8_SCHED;
            PG8_LDB(B1, 0, 1); PG8_STAGE(PG8_SB(0, 0), b2, voffB);
            PG8_BAR; PG8_WAIT_L(0); PG8_MMA(0, 1, At, B1); PG8_BAR;
            PG8_LDA(At, 0, 1); PG8_STAGE(PG8_SA(0, 0), a2, voffA);
            PG8_BAR; PG8_WAIT_L(0); PG8_MMA(1, 0, At, B0); PG8_BAR; PG8_SCHED;
            PG8_STAGE(PG8_SB(0, 1), b2 + hstep, voffB);
            PG8_WAIT_V(6); PG8_BAR; PG8_MMA(1, 1, At, B1); PG8_BAR;
            PG8_LDB(B0, 1, 0); PG8_SCHED; PG8_LDA(At, 1, 0); PG8_STAGE(PG8_SA(0, 1), a2 + hstep, voffA);
            PG8_WAIT_L(8); PG8_BAR; PG8_WAIT_L(0); PG8_MMA(0, 0, At, B0); PG8_BAR; PG8_SCHED;
            PG8_LDB(B1, 1, 1); PG8_STAGE(PG8_SB(1, 0), b3, voffB);
            PG8_BAR; PG8_WAIT_L(0); PG8_MMA(0, 1, At, B1); PG8_BAR;
            PG8_LDA(At, 1, 1); PG8_STAGE(PG8_SA(1, 0), a3, voffA);
            PG8_BAR; PG8_WAIT_L(0); PG8_MMA(1, 0, At, B0); PG8_BAR; PG8_SCHED;
            PG8_STAGE(PG8_SB(1, 1), b3 + hstep, voffB);
            PG8_WAIT_V(6); PG8_BAR; PG8_MMA(1, 1, At, B1); PG8_BAR;
        }
        PG8_STAMP();
        if constexpr (!Epi::AFTER_DRAIN) { E(acc, cur, wr, wc, fr, fq); S.done(cur); }
        PG8_STAMP();
        if (!has_next) break;
#pragma unroll
        for (int a = 0; a < 2; ++a)
#pragma unroll
            for (int b = 0; b < 2; ++b)
#pragma unroll
                for (int m = 0; m < 4; ++m)
#pragma unroll
                    for (int n = 0; n < 2; ++n) acc[a][b][m][n] = (f32x4){0.f, 0.f, 0.f, 0.f};
        cur = nxt; cA = nA; cB = nB; ++ui; ntc = cur.nkt > 0 ? cur.nkt : nt;
    }
    PG8_WAIT_V(0);
    if (wr == 0) PG8_BAR;
    PG8_BAR;
    if constexpr (Epi::AFTER_DRAIN) { E.fused(acc, cur, wr, wc, fr, fq, lds, wid, lane); S.done(cur); }
    PG8_STAMP();
#undef PG8_STAMP
#undef PG8_SA
#undef PG8_SB
#undef PG8_STAGE
#undef PG8_LDA
#undef PG8_LDB
#undef PG8_MMA
#undef PG8_WAIT_V
#undef PG8_WAIT_L
#undef PG8_BAR
#undef PG8_SCHED
}
}
#define LAS __attribute__((address_space(3)))
#define XB_TMO      128
#define XB_XCNT(j)  (256  + 64 * (j))
#define XB_XSUB(j)  (1280 + 64 * (j))
#define XB_XGEN(j)  (2304 + 64 * (j))
#define XB_TOP      3328
#define XB_TOPGEN   3392
#define XCD_BAR_WORDS 3456
#define XB_SPIN_CAP (1u << 18)

__device__ __forceinline__ unsigned xb_ld(unsigned* p)              { return __hip_atomic_load(p, __ATOMIC_RELAXED, __HIP_MEMORY_SCOPE_AGENT); }
__device__ __forceinline__ unsigned xb_add(unsigned* p, unsigned v) { return __hip_atomic_fetch_add(p, v, __ATOMIC_RELAXED, __HIP_MEMORY_SCOPE_AGENT); }
__device__ __forceinline__ unsigned xb_xcc_id() { return (unsigned)__builtin_amdgcn_s_getreg((3 << 11) | 20) & 0xFu; }
#define XB_SPIN(cond, bar) do { unsigned _sp = 0; while (cond) { __builtin_amdgcn_s_sleep(1); \
    if ((++_sp & 255u) == 0u) { if (xb_ld(&(bar)[XB_TMO])) break; if (_sp > XB_SPIN_CAP) { atomicAdd(&(bar)[XB_TMO], 1u); break; } } } } while (0)

struct XcdBarrier {
    unsigned* bar; unsigned x;
    volatile LAS unsigned* st;
};

__device__ __forceinline__ XcdBarrier xcd_barrier_post(unsigned* bar, volatile LAS unsigned* st) {
    XcdBarrier b; b.bar = bar; b.x = xb_xcc_id(); b.st = st;
    if (threadIdx.x == 0) (void)xb_add(&bar[XB_XCNT(b.x)], 1u);
    return b;
}
__device__ __forceinline__ void xcd_barrier_complete(unsigned* bar, unsigned x, unsigned& nloc, unsigned& nx) {
    const unsigned G = gridDim.x * gridDim.y * gridDim.z;
    unsigned sum, cnt, mine, sp = 0u;
    for (;;) {
        sum = 0u; cnt = 0u; mine = 0u;
#pragma unroll
        for (unsigned j = 0; j < 16; ++j) { const unsigned c = xb_ld(&bar[XB_XCNT(j)]); sum += c; cnt += (c > 0u) ? 1u : 0u; mine = (j == x) ? c : mine; }
        if (sum == G) break;
        __builtin_amdgcn_s_sleep(1);
        if ((++sp & 255u) == 0u) { if (xb_ld(&bar[XB_TMO])) break; if (sp > XB_SPIN_CAP) { atomicAdd(&bar[XB_TMO], 1u); break; } }
    }
    nloc = mine > 0u ? mine : 1u; nx = cnt > 0u ? cnt : 1u;
}

__device__ __forceinline__ void xcd_barrier(const XcdBarrier& b) {
    asm volatile("s_waitcnt vmcnt(0)" ::: "memory");
    __syncthreads();
    if (threadIdx.x == 0) {
        unsigned* bar = b.bar;
        __builtin_amdgcn_s_waitcnt(0);
        unsigned nloc = b.st[0], nx = b.st[1];
        if (nloc == 0u) { xcd_barrier_complete(bar, b.x, nloc, nx); b.st[0] = nloc; b.st[1] = nx; }
        const unsigned old = xb_add(&bar[XB_XSUB(b.x)], 1u);
        const unsigned gen = old / nloc;
        if (old + 1u == (gen + 1u) * nloc) {
            __builtin_amdgcn_fence(__ATOMIC_RELEASE, "agent");
            asm volatile("s_waitcnt vmcnt(0)" ::: "memory");
            const unsigned og = xb_add(&bar[XB_TOP], 1u);
            const unsigned tg = og / nx;
            if (og + 1u == (tg + 1u) * nx) xb_add(&bar[XB_TOPGEN], 1u);
            else XB_SPIN(xb_ld(&bar[XB_TOPGEN]) == tg, bar);
            __builtin_amdgcn_fence(__ATOMIC_ACQUIRE, "agent");
            xb_add(&bar[XB_XGEN(b.x)], 1u);
            asm volatile("s_waitcnt vmcnt(0)" ::: "memory");
        } else {
            XB_SPIN(xb_ld(&bar[XB_XGEN(b.x)]) == gen, bar);
            __builtin_amdgcn_fence(__ATOMIC_ACQUIRE, "agent");
            asm volatile("s_waitcnt vmcnt(0)" ::: "memory");
        }
    }
    __syncthreads();
}

using pg8::bf16_t; using pg8::f32x4; using pg8::u32x4; using pg8::cvt_pk_bf16;
typedef unsigned u32x2 __attribute__((ext_vector_type(2)));


constexpr int D = 1024, NB = 2, SEQ = 8192, DEPTH = 4, CTX = 256, DFF = 2816;
constexpr int TL = NB * SEQ, TC = NB * CTX, T = TL + TC;
constexpr int NMOD = 9 * D;
constexpr int HYC = 256, RWW = 384, NAW = 384, INW = 3456, INWP = 3584;
constexpr int HY_IN = 768, RW_IN = 1536, NA_IN = 1152;
constexpr int NFFT = 16384;
constexpr int NTHR = 512, NWAVE = 8;
constexpr int LDS_MAIN = 131072, LDS_EXTRA = 8192, LDS_BYTES = LDS_MAIN + LDS_EXTRA;
constexpr float NORM_EPS = 1e-6f;

constexpr size_t al256(size_t x) { return (x + 255) & ~(size_t)255; }
constexpr size_t WS_MODV = 0;
constexpr size_t WS_WGU1 = al256(WS_MODV + (size_t)DEPTH * 3 * NMOD * 4);
constexpr size_t WS_WDN1 = WS_WGU1 + (size_t)2 * DFF * D * 2;
constexpr size_t WS_WGU2 = WS_WDN1 + (size_t)D * DFF * 2;
constexpr size_t WS_WDN2 = WS_WGU2 + (size_t)2 * DFF * D * 2;
constexpr size_t WS_WIN = WS_WDN2 + (size_t)D * DFF * 2;
constexpr size_t WS_WOUT = WS_WIN + (size_t)INWP * D * 2;
constexpr size_t WS_WLORA = WS_WOUT + (size_t)D * D * 2;
constexpr size_t WS_H = WS_WLORA + (size_t)2048 * 384 * 2;
constexpr size_t WS_U = WS_H + (size_t)T * D * 4;
constexpr size_t WS_S = WS_U + (size_t)T * D * 2;
constexpr size_t WS_Y = WS_S;
constexpr size_t WS_ACT = WS_Y + (size_t)T * D * 4;
constexpr size_t WS_FFN_END = WS_ACT + (size_t)T * DFF * 2;
constexpr size_t WS_PHY = WS_S;
constexpr size_t WS_PRW = WS_PHY + (size_t)T * HY_IN * 2;
constexpr size_t WS_YDIR = WS_PRW;
constexpr size_t WS_PNA = WS_PRW + (size_t)T * RW_IN * 2;
constexpr size_t WS_ALORA = WS_PNA + (size_t)T * NA_IN * 2;
constexpr size_t WS_DECAY = WS_ALORA + (size_t)T * 384 * 2;
constexpr size_t WS_LORAO = WS_DECAY + (size_t)2 * T * 384 * 4;
constexpr size_t WS_E = WS_LORAO;
constexpr size_t WS_ZP = WS_E + (size_t)24 * SEQ * 64 * 2;
constexpr size_t WS_GATE = WS_LORAO + (size_t)T * 1536 * 2;
static_assert(WS_ZP + (size_t)24 * 33 * 2 * 4096 * 4 <= WS_GATE, "E + ZP must fit in the LORAO region");
constexpr size_t WS_RS = WS_GATE + (size_t)T * 384 * 2;
constexpr size_t WS_KKS = WS_RS + (size_t)T * 384 * 2;
constexpr size_t WS_VS = WS_KKS + (size_t)T * 384 * 2;
constexpr size_t WS_KS = WS_VS + (size_t)T * 384 * 2;
constexpr size_t WS_BS = WS_KS + (size_t)2 * T * 384 * 2;
constexpr size_t WS_BONUS = WS_BS + (size_t)2 * T * 384 * 2;
constexpr size_t WS_FILT = al256(WS_BONUS + (size_t)T * 6 * 4);
constexpr size_t WS_FILTC = WS_FILT + (size_t)1024 * SEQ * 2;
constexpr size_t WS_SPEC = WS_FILTC + (size_t)1024 * CTX * 2;
constexpr size_t WS_Z1 = WS_SPEC + (size_t)512 * NFFT * 8;
constexpr size_t WS_VTL = WS_Z1 + (size_t)HYC * NB * SEQ * 4;
constexpr size_t WS_VTC = WS_VTL + (size_t)NB * 6 * 64 * SEQ * 2;
constexpr size_t WS_MIX_END = WS_VTC + (size_t)NB * 6 * 64 * CTX * 2;
constexpr size_t WS_BAR = al256(WS_MIX_END > WS_FFN_END ? WS_MIX_END : WS_FFN_END);
constexpr size_t WS_ROPE = al256(WS_BAR + (size_t)XCD_BAR_WORDS * 4);
constexpr size_t WS_YC = WS_FFN_END + (size_t)(8 << 20);
static_assert(WS_YC + (size_t)11 * TC * D * 4 <= WS_FILT, "YC partials must stay below the filter tables");
constexpr size_t WS_END = WS_ROPE + (size_t)128 * 16 * 8;
static_assert(WS_END <= (size_t)4 * DEPTH * D * NMOD * 4, "workspace map exceeds 4x the largest input tensor");

struct Params { const float* in[34]; float* out; unsigned char* ws; };
enum { I_X = 0, I_C, I_CTX, I_CCTX, I_MODW, I_MODB, I_NORMG, I_F1GU, I_F1DN, I_F2GU, I_F2DN, I_WIN, I_WOUT, I_HCW, I_HCB, I_HW1, I_HB1, I_HW2, I_HB2, I_HW3, I_HFREQ, I_HBIAS,
       I_MU, I_W0, I_W2, I_A0, I_A2, I_G2, I_KK, I_KA, I_RK, I_LNW, I_LNB, I_RPB };

typedef LAS float* ldsfp;
__device__ __forceinline__ ldsfp vlds(const void* p) { ldsfp q = (ldsfp)p; asm volatile("" : "+v"(q)); return q; }
__device__ __forceinline__ float bf2f(bf16_t b) { return __uint_as_float(((unsigned)b) << 16); }
__device__ __forceinline__ bf16_t f2bf(float f) { unsigned u = __float_as_uint(f); u += 0x7FFFu + ((u >> 16) & 1u); return (bf16_t)(u >> 16); }
__device__ __forceinline__ float lo_bf(unsigned w) { return __uint_as_float(w << 16); }
__device__ __forceinline__ float hi_bf(unsigned w) { return __uint_as_float(w & 0xffff0000u); }
__device__ __forceinline__ float wsum(float v) {
#pragma unroll
    for (int o = 32; o > 0; o >>= 1) v += __shfl_xor(v, o);
    return v;
}
__device__ __forceinline__ float sigmoidf_(float x) { return __builtin_amdgcn_rcpf(1.0f + __expf(-x)); }
__device__ __forceinline__ void unpack8(const u32x4 w, float (&f)[8]) {
    f[0] = lo_bf(w.x); f[1] = hi_bf(w.x); f[2] = lo_bf(w.y); f[3] = hi_bf(w.y); f[4] = lo_bf(w.z); f[5] = hi_bf(w.z); f[6] = lo_bf(w.w); f[7] = hi_bf(w.w);
}
__device__ __forceinline__ void row_nbrs(int row, bool& hasp, bool& hasn) {
    if (row < TL) { const int t = row & (SEQ - 1); hasp = t > 0; hasn = t < SEQ - 1; }
    else { const int t = (row - TL) & (CTX - 1); hasp = t > 0; hasn = t < CTX - 1; }
}

__device__ __forceinline__ void ph_modv(const Params& P, float* lds) {
    const int tid = otid();
    float* sv = lds;
    float* red = lds + 3072;
    for (int i = tid; i < 3072; i += NTHR) { const int s = i >> 10, k = i & 1023; const float c = s < 2 ? P.in[I_C][s * 1024 + k] : P.in[I_CCTX][k]; sv[i] = c / (1.0f + expf(-c)); }
    __syncthreads();
    if (blockIdx.x < 4) { const int e = blockIdx.x * NTHR + tid, pos = e >> 4, f = e & 15; float sn, cs; sincosf((float)pos * expf(-(float)f * (9.210340371976184f / 16.0f)), &sn, &cs); ((float2*)(P.ws + WS_ROPE))[e] = make_float2(cs, sn); }
    float* modv = (float*)(P.ws + WS_MODV);
    const int kc = tid >> 6, cl = tid & 63;
    for (int item = blockIdx.x; item < DEPTH * 144; item += gridDim.x) {
        const int l = item / 144, cb = item % 144, col = cb * 64 + cl;
        const float* w = P.in[I_MODW] + ((size_t)l * 1024 + kc * 128) * NMOD + col;
        float a0 = 0.f, a1 = 0.f, a2 = 0.f;
#pragma unroll 8
        for (int k = 0; k < 128; ++k) { const float wv = w[(size_t)k * NMOD]; a0 += sv[kc * 128 + k] * wv; a1 += sv[1024 + kc * 128 + k] * wv; a2 += sv[2048 + kc * 128 + k] * wv; }
        red[(0 * 8 + kc) * 64 + cl] = a0; red[(1 * 8 + kc) * 64 + cl] = a1; red[(2 * 8 + kc) * 64 + cl] = a2;
        __syncthreads();
        if (tid < 192) { const int s = tid >> 6, c = tid & 63; float r = P.in[I_MODB][l * NMOD + cb * 64 + c];
#pragma unroll
            for (int q = 0; q < 8; ++q) r += red[(s * 8 + q) * 64 + c];
            modv[((size_t)l * 3 + s) * NMOD + cb * 64 + c] = r; }
        __syncthreads();
    }
}

__device__ __forceinline__ float hy_delta(int c);
__device__ __forceinline__ int rowmap_gu(int n) { const int up = n >= DFF ? 1 : 0; const int j = n - up * DFF; return (j >> 7) * 256 + up * 128 + (j & 127); }
__device__ __forceinline__ void conv_tile(const float* __restrict__ src, int K, int N, bf16_t* __restrict__ dst, int tk, int tn, bool gu, float* tile) {
    const int tid = otid(); const int k0 = tk * 64, n0 = tn * 64;
#pragma unroll
    for (int rr = 0; rr < 2; ++rr) { const int kk = (tid >> 4) + rr * 32, n4 = (tid & 15) * 4; const float4 v = *(const float4*)(src + (size_t)(k0 + kk) * N + n0 + n4);
        tile[kk * 65 + n4 + 0] = v.x; tile[kk * 65 + n4 + 1] = v.y; tile[kk * 65 + n4 + 2] = v.z; tile[kk * 65 + n4 + 3] = v.w; }
    __syncthreads();
    { const int nn = tid >> 3, ks = (tid & 7) * 8; const int n = n0 + nn; const int row = gu ? rowmap_gu(n) : n;
      u32x4 w; w.x = cvt_pk_bf16(tile[(ks + 0) * 65 + nn], tile[(ks + 1) * 65 + nn]); w.y = cvt_pk_bf16(tile[(ks + 2) * 65 + nn], tile[(ks + 3) * 65 + nn]);
      w.z = cvt_pk_bf16(tile[(ks + 4) * 65 + nn], tile[(ks + 5) * 65 + nn]); w.w = cvt_pk_bf16(tile[(ks + 6) * 65 + nn], tile[(ks + 7) * 65 + nn]);
      *(u32x4*)(dst + (size_t)row * K + k0 + ks) = w; }
    __syncthreads();
}
__device__ __forceinline__ void ph_prep(const Params& P, int l, float* lds) {
    const int tid = otid();
    unsigned char* ws = P.ws;
    constexpr int N0 = 16 * 88, N1 = 44 * 16, N4 = 16 * 54, N5 = 16 * 16;
    constexpr int C0 = N0, C1 = C0 + N1, C2 = C1 + N0, C3 = C2 + N1, C4 = C3 + N4, C5 = C4 + N5;
    for (int it = blockIdx.x; it < C5; it += gridDim.x) {
        if (it < C0) { conv_tile(P.in[I_F1GU] + (size_t)l * D * 2 * DFF, D, 2 * DFF, (bf16_t*)(ws + WS_WGU1), it / 88, it % 88, true, lds); }
        else if (it < C1) { const int j = it - C0; conv_tile(P.in[I_F1DN] + (size_t)l * DFF * D, DFF, D, (bf16_t*)(ws + WS_WDN1), j / 16, j % 16, false, lds); }
        else if (it < C2) { const int j = it - C1; conv_tile(P.in[I_F2GU] + (size_t)l * D * 2 * DFF, D, 2 * DFF, (bf16_t*)(ws + WS_WGU2), j / 88, j % 88, true, lds); }
        else if (it < C3) { const int j = it - C2; conv_tile(P.in[I_F2DN] + (size_t)l * DFF * D, DFF, D, (bf16_t*)(ws + WS_WDN2), j / 16, j % 16, false, lds); }
        else if (it < C4) { const int j = it - C3; conv_tile(P.in[I_WIN] + (size_t)l * D * INW, D, INW, (bf16_t*)(ws + WS_WIN), j / 54, j % 54, false, lds); }
        else { const int j = it - C4; conv_tile(P.in[I_WOUT] + (size_t)l * D * D, D, D, (bf16_t*)(ws + WS_WOUT), j / 16, j % 16, false, lds); }
    }
    const int gtid = blockIdx.x * NTHR + tid, gn = gridDim.x * NTHR;
    { unsigned* z = (unsigned*)(ws + WS_WIN + (size_t)INW * D * 2); for (int i = gtid; i < (INWP - INW) * D / 2; i += gn) z[i] = 0u; }
    { bf16_t* wl = (bf16_t*)(ws + WS_WLORA);
      const float* w2 = P.in[I_W2] + (size_t)l * 2 * 64 * RWW; const float* a2 = P.in[I_A2] + (size_t)l * 2 * 64 * RWW; const float* g2 = P.in[I_G2] + (size_t)l * 128 * RWW;
      for (int i = gtid; i < 2048 * 48; i += gn) { const int kb = (i / 2048) * 8, j = i % 2048; float v[8];
#pragma unroll
          for (int q = 0; q < 8; ++q) v[q] = 0.f;
          if (j < 1920) { const int grp = j / 384, c = j % 384;
              const bool act = grp < 4 ? (kb >> 6) == grp : kb >= 256;
              if (act) { const float* src = (grp < 2 ? w2 + (size_t)kb * RWW : (grp < 4 ? a2 + (size_t)(kb - 128) * RWW : g2 + (size_t)(kb - 256) * RWW)) + c;
#pragma unroll
                  for (int q = 0; q < 8; ++q) v[q] = src[(size_t)q * RWW]; } }
          u32x4 w; w.x = cvt_pk_bf16(v[0], v[1]); w.y = cvt_pk_bf16(v[2], v[3]); w.z = cvt_pk_bf16(v[4], v[5]); w.w = cvt_pk_bf16(v[6], v[7]);
          *(u32x4*)(wl + (size_t)j * 384 + kb) = w; } }
    { const float* w1_ = P.in[I_HW1] + (size_t)l * 33 * 64; const float* b1 = P.in[I_HB1] + l * 64; const float* w2f_ = P.in[I_HW2] + (size_t)l * 64 * 64; const float* b2 = P.in[I_HB2] + l * 64;
      const float* fqv = P.in[I_HFREQ] + l * 64; const float* w3 = P.in[I_HW3] + (size_t)l * 64 * 1024;
      const int lane = tid & 63, wv = tid >> 6;
      const float fq = fqv[lane], bb1 = b1[lane], bb2 = b2[lane];
      const ldsfp hl = vlds(lds);
      for (int task = blockIdx.x; task < 256; task += gridDim.x) {
          const int n0 = task * 32;
          __syncthreads();
#pragma unroll 1
          for (int p = wv; p < 33; p += NWAVE) { const int L = p < 32 ? SEQ : CTX, pos = p < 32 ? n0 + p : task;
              const float* w1 = w1_; const float* w2f = w2f_; asm volatile("" : "+s"(w1), "+s"(w2f));
              const float tt = (float)pos / (float)(L - 1);
              const float ang = 6.283185307179586f * (float)pos / (float)L;
              float z = 0.f;
              if (lane == 0) z = tt;
              else if (lane <= 16) { const float fr = 1e-4f + (float)(lane - 1) * ((15.0f - 1e-4f) / 15.0f); z = cosf(fr * ang); }
              else if (lane <= 32) { const float fr = 1e-4f + (float)(lane - 17) * ((15.0f - 1e-4f) / 15.0f); z = -sinf(fr * ang); }
              float a = bb1;
#pragma unroll
              for (int e = 0; e < 33; ++e) a += __shfl(z, e) * w1[e * 64 + lane];
              const float h1 = sinf(fq * a);
              float c = bb2;
#pragma unroll
              for (int i = 0; i < 64; ++i) c += __shfl(h1, i) * w2f[i * 64 + lane];
              hl[lane * 36 + p] = sinf(fq * c); }
          __syncthreads();
          float acc0[33], acc1[33];
#pragma unroll
          for (int p = 0; p < 33; ++p) { acc0[p] = 0.f; acc1[p] = 0.f; }
#pragma unroll 2
          for (int i = 0; i < 64; ++i) { const float wa = w3[(size_t)i * 1024 + tid], wb = w3[(size_t)i * 1024 + 512 + tid];
#pragma unroll
              for (int p4 = 0; p4 < 8; ++p4) { const f32x4 hv = *(const LAS f32x4*)(hl + i * 36 + p4 * 4);
                  acc0[p4 * 4 + 0] += hv.x * wa; acc0[p4 * 4 + 1] += hv.y * wa; acc0[p4 * 4 + 2] += hv.z * wa; acc0[p4 * 4 + 3] += hv.w * wa;
                  acc1[p4 * 4 + 0] += hv.x * wb; acc1[p4 * 4 + 1] += hv.y * wb; acc1[p4 * 4 + 2] += hv.z * wb; acc1[p4 * 4 + 3] += hv.w * wb; }
              const float hc = hl[i * 36 + 32]; acc0[32] += hc * wa; acc1[32] += hc * wb; }
          const float dl = hy_delta(tid & 255), sc = 1.0f / NFFT, invL = 1.0f / (float)(SEQ - 1);
          bf16_t* dst = (bf16_t*)(ws + WS_FILT) + (size_t)tid * SEQ + n0;
          const size_t cstep = (size_t)512 * SEQ;
#pragma unroll
          for (int p8 = 0; p8 < 4; ++p8) { float d[8];
#pragma unroll
              for (int k = 0; k < 8; ++k) d[k] = __expf(-((float)(n0 + p8 * 8 + k) * invL) * dl) * sc;
              u32x4 w; w.x = cvt_pk_bf16(acc0[p8 * 8 + 0] * d[0], acc0[p8 * 8 + 1] * d[1]); w.y = cvt_pk_bf16(acc0[p8 * 8 + 2] * d[2], acc0[p8 * 8 + 3] * d[3]);
              w.z = cvt_pk_bf16(acc0[p8 * 8 + 4] * d[4], acc0[p8 * 8 + 5] * d[5]); w.w = cvt_pk_bf16(acc0[p8 * 8 + 6] * d[6], acc0[p8 * 8 + 7] * d[7]);
              *(u32x4*)(dst + p8 * 8) = w;
              w.x = cvt_pk_bf16(acc1[p8 * 8 + 0] * d[0], acc1[p8 * 8 + 1] * d[1]); w.y = cvt_pk_bf16(acc1[p8 * 8 + 2] * d[2], acc1[p8 * 8 + 3] * d[3]);
              w.z = cvt_pk_bf16(acc1[p8 * 8 + 4] * d[4], acc1[p8 * 8 + 5] * d[5]); w.w = cvt_pk_bf16(acc1[p8 * 8 + 6] * d[6], acc1[p8 * 8 + 7] * d[7]);
              *(u32x4*)(dst + cstep + p8 * 8) = w; }
          { const float dc = __expf(-((float)task * (1.0f / (float)(CTX - 1))) * dl); bf16_t* fc = (bf16_t*)(ws + WS_FILTC) + (size_t)tid * CTX + task;
            fc[0] = f2bf(acc0[32] * dc); fc[(size_t)512 * CTX] = f2bf(acc1[32] * dc); }
      }
      __syncthreads(); }
}

__device__ __forceinline__ void ph_rowpass(const Params& P, int mode, int lpost, int gate_i, int gpost_i, float ps, int lpre, int gpre_i, int shift_i, int scale_i, int nsplit) {
    const int tid = otid(), lane = tid & 63, gw = blockIdx.x * NWAVE + (tid >> 6), nw = gridDim.x * NWAVE;
    const float* modv = (const float*)(P.ws + WS_MODV);
    float* H = (float*)(P.ws + WS_H); const bf16_t* Y = (const bf16_t*)(P.ws + WS_Y); bf16_t* U = (bf16_t*)(P.ws + WS_U);
    int cur_s = -1;
    float4 A[4], Bv[4], Cv[4];
#pragma unroll
    for (int j = 0; j < 4; ++j) { A[j] = make_float4(0.f, 0.f, 0.f, 0.f); Bv[j] = A[j]; Cv[j] = A[j]; }
    for (int row = gw; row < T; row += nw) {
        const int s = row < SEQ ? 0 : (row < TL ? 1 : 2);
        if (s != cur_s) { cur_s = s;
#pragma unroll
            for (int j = 0; j < 4; ++j) { const int e = lane * 4 + 256 * j;
                if (mode != 0) { const float4 g = *(const float4*)(modv + ((size_t)lpost * 3 + s) * NMOD + gate_i * D + e); const float4 gp = *(const float4*)(P.in[I_NORMG] + ((size_t)lpost * 6 + gpost_i) * D + e);
                    A[j] = make_float4(ps * g.x * gp.x, ps * g.y * gp.y, ps * g.z * gp.z, ps * g.w * gp.w); }
                if (mode != 2) { const float4 sc = *(const float4*)(modv + ((size_t)lpre * 3 + s) * NMOD + scale_i * D + e); const float4 gq = *(const float4*)(P.in[I_NORMG] + ((size_t)lpre * 6 + gpre_i) * D + e);
                    Bv[j] = make_float4(gq.x * (1.f + sc.x), gq.y * (1.f + sc.y), gq.z * (1.f + sc.z), gq.w * (1.f + sc.w));
                    Cv[j] = *(const float4*)(modv + ((size_t)lpre * 3 + s) * NMOD + shift_i * D + e); } } }
        float4 h[4];
        if (mode == 0) { const float* src = row < TL ? P.in[I_X] + (size_t)row * D : P.in[I_CTX] + (size_t)(row - TL) * D;
#pragma unroll
            for (int j = 0; j < 4; ++j) h[j] = *(const float4*)(src + lane * 4 + 256 * j);
        } else {
            float4 y[4]; float ss = 0.f;
#pragma unroll
            for (int j = 0; j < 4; ++j) { h[j] = *(const float4*)(H + (size_t)row * D + lane * 4 + 256 * j); if (row < TL) { const u32x2 yw = *(const u32x2*)(Y + (size_t)row * D + lane * 4 + 256 * j); y[j] = make_float4(lo_bf(yw.x), hi_bf(yw.x), lo_bf(yw.y), hi_bf(yw.y)); } else { const float* yp = (const float*)(P.ws + WS_YC) + (size_t)(row - TL) * D + lane * 4 + 256 * j; float4 a = *(const float4*)yp;
                    for (int q = 1; q < nsplit; ++q) { const float4 b4 = *(const float4*)(yp + (size_t)q * TC * D); a.x += b4.x; a.y += b4.y; a.z += b4.z; a.w += b4.w; } y[j] = a; }
                ss += y[j].x * y[j].x + y[j].y * y[j].y + y[j].z * y[j].z + y[j].w * y[j].w; }
            ss = wsum(ss); const float r = rsqrtf(ss * (1.0f / D) + NORM_EPS);
#pragma unroll
            for (int j = 0; j < 4; ++j) { h[j].x += A[j].x * (y[j].x * r); h[j].y += A[j].y * (y[j].y * r); h[j].z += A[j].z * (y[j].z * r); h[j].w += A[j].w * (y[j].w * r); }
        }
        if (mode == 2) { if (row < TL) {
#pragma unroll
                for (int j = 0; j < 4; ++j) *(float4*)(P.out + (size_t)row * D + lane * 4 + 256 * j) = h[j]; }
            continue; }
        float s2 = 0.f;
#pragma unroll
        for (int j = 0; j < 4; ++j) { *(float4*)(H + (size_t)row * D + lane * 4 + 256 * j) = h[j]; s2 += h[j].x * h[j].x + h[j].y * h[j].y + h[j].z * h[j].z + h[j].w * h[j].w; }
        s2 = wsum(s2); const float r2 = rsqrtf(s2 * (1.0f / D) + NORM_EPS);
#pragma unroll
        for (int j = 0; j < 4; ++j) { u32x2 w; w.x = cvt_pk_bf16(h[j].x * r2 * Bv[j].x + Cv[j].x, h[j].y * r2 * Bv[j].y + Cv[j].y); w.y = cvt_pk_bf16(h[j].z * r2 * Bv[j].z + Cv[j].z, h[j].w * r2 * Bv[j].w + Cv[j].w);
            *(u32x2*)(U + (size_t)row * D + lane * 4 + 256 * j) = w; }
    }
}

struct EpiGU {
    static constexpr bool PERM = true, AFTER_DRAIN = false;
    bf16_t* O;
    __device__ __forceinline__ void operator()(const f32x4 (&acc)[2][2][4][2], const pg8::Unit& u, int wr, int wc, int fr, int fq) const {
        const int row0 = u.pm * 256 + wr * 64 + fr, col0 = u.pn * 128 + wc * 32 + 8 * fq;
#pragma unroll
        for (int ai = 0; ai < 2; ++ai)
#pragma unroll
            for (int m = 0; m < 4; ++m) { float o[8];
#pragma unroll
                for (int n = 0; n < 2; ++n)
#pragma unroll
                    for (int j = 0; j < 4; ++j) { const float g = acc[ai][0][m][n][j], up = acc[ai][1][m][n][j]; o[n * 4 + j] = g * __builtin_amdgcn_rcpf(1.0f + __expf(-g)) * up; }
                u32x4 w; w.x = cvt_pk_bf16(o[0], o[1]); w.y = cvt_pk_bf16(o[2], o[3]); w.z = cvt_pk_bf16(o[4], o[5]); w.w = cvt_pk_bf16(o[6], o[7]);
                *(u32x4*)(O + (size_t)(row0 + ai * 128 + m * 16) * DFF + col0) = w; }
    }
};

struct TailOrder {
    int nsplit, kp, G, c;
    __device__ void init(int K, int KP, int G_, int c_) { kp = KP; nsplit = (K / 64) / KP; G = G_; c = c_; }
    __device__ bool next(int i, pg8::Unit& u) const {
        const long L = (long)i * G + c;
        if (L < 256) { int wgid = (int)L; { const int q = 256 / 8, xcd = wgid % 8, off = wgid / 8; wgid = xcd * q + off; }
            const int nig = 8 * 4, gid = wgid / nig, fm = gid * 8; u.pm = fm + ((wgid % nig) % 8); u.pn = (wgid % nig) / 8; u.kt0 = 0; u.nkt = 0; return true; }
        const int L2 = (int)(L - 256); if (L2 >= 8 * nsplit) return false;
        const int tile = L2 / nsplit, ks = L2 % nsplit; u.pm = 64 + (tile >> 2); u.pn = tile & 3; u.kt0 = ks * kp; u.nkt = kp; return true;
    }
    __device__ __forceinline__ void a_ready(const pg8::Unit&) const {}
    __device__ __forceinline__ void done(const pg8::Unit&) const {}
};
struct EpiF32 {
    static constexpr bool PERM = true, AFTER_DRAIN = false;
    bf16_t* C; float* YC;
    __device__ __forceinline__ void operator()(const f32x4 (&acc)[2][2][4][2], const pg8::Unit& u, int wr, int wc, int fr, int fq) const {
        const int row0 = u.pm * 256 + wr * 64 + fr, col0 = u.pn * 256 + wc * 32 + 8 * fq;
        if (u.pm < 64) {
#pragma unroll
            for (int ai = 0; ai < 2; ++ai)
#pragma unroll
                for (int m = 0; m < 4; ++m) { bf16_t* rowp = C + (size_t)(row0 + ai * 128 + m * 16) * D + col0;
#pragma unroll
                    for (int bj = 0; bj < 2; ++bj) { const f32x4 v0 = acc[ai][bj][m][0], v1 = acc[ai][bj][m][1];
                        u32x4 w; w.x = cvt_pk_bf16(v0[0], v0[1]); w.y = cvt_pk_bf16(v0[2], v0[3]); w.z = cvt_pk_bf16(v1[0], v1[1]); w.w = cvt_pk_bf16(v1[2], v1[3]);
                        *(u32x4*)(rowp + bj * 128) = w; } }
        } else { float* base = YC + (size_t)(u.kt0 >> 2) * TC * D;
#pragma unroll
            for (int ai = 0; ai < 2; ++ai)
#pragma unroll
                for (int m = 0; m < 4; ++m) { float* rowp = base + (size_t)(row0 - TL + ai * 128 + m * 16) * D + col0;
#pragma unroll
                    for (int bj = 0; bj < 2; ++bj)
#pragma unroll
                        for (int n = 0; n < 2; ++n) *(f32x4*)(rowp + bj * 128 + n * 4) = acc[ai][bj][m][n]; }
        }
    }
};
template <class Epi> __device__ __forceinline__ void run_gemm_tail(LAS unsigned char* lds, const bf16_t* A, const bf16_t* Bt, int K, const Epi& E) {
    asm volatile("" : "+s"(K));
    pg8::Gemm g{A, Bt, T, D, K}; TailOrder S; S.init(K, 4, (int)gridDim.x, (int)blockIdx.x);
    pg8::gemm_phase<Epi, TailOrder>(lds, g, S, E);
    __syncthreads();
}
__device__ __forceinline__ void zero_yc(const Params& P) { float4* z = (float4*)(P.ws + WS_YC); for (int i = blockIdx.x * NTHR + otid(); i < TC * D / 4; i += gridDim.x * NTHR) z[i] = make_float4(0.f, 0.f, 0.f, 0.f); }
struct EpiWin {
    static constexpr bool PERM = true, AFTER_DRAIN = false;
    bf16_t* PHYT; bf16_t* PRW; bf16_t* PNA;
    __device__ __forceinline__ void operator()(const f32x4 (&acc)[2][2][4][2], const pg8::Unit& u, int wr, int wc, int fr, int fq) const {
        const int row0 = u.pm * 256 + wr * 64 + fr;
        if (u.pn < 3) {
#pragma unroll
            for (int bj = 0; bj < 2; ++bj) { bf16_t* cp = PHYT + (size_t)(u.pn * 256 + bj * 128 + wc * 32 + 8 * fq) * T + row0;
#pragma unroll
                for (int ai = 0; ai < 2; ++ai)
#pragma unroll
                    for (int m = 0; m < 4; ++m) { const f32x4 v0 = acc[ai][bj][m][0], v1 = acc[ai][bj][m][1]; bf16_t* rp = cp + ai * 128 + m * 16;
                        const unsigned w0 = cvt_pk_bf16(v0[0], v0[1]), w1 = cvt_pk_bf16(v0[2], v0[3]), w2 = cvt_pk_bf16(v1[0], v1[1]), w3 = cvt_pk_bf16(v1[2], v1[3]);
                        rp[0] = (bf16_t)w0; rp[(size_t)T] = (bf16_t)(w0 >> 16); rp[(size_t)2 * T] = (bf16_t)w1; rp[(size_t)3 * T] = (bf16_t)(w1 >> 16);
                        rp[(size_t)4 * T] = (bf16_t)w2; rp[(size_t)5 * T] = (bf16_t)(w2 >> 16); rp[(size_t)6 * T] = (bf16_t)w3; rp[(size_t)7 * T] = (bf16_t)(w3 >> 16); } }
            return; }
        bf16_t* base; int ld, cbase;
        if (u.pn < 9) { base = PRW; ld = RW_IN; cbase = u.pn * 256 - HY_IN; }
        else { base = PNA; ld = NA_IN; cbase = u.pn * 256 - HY_IN - RW_IN; }
        const int nbj = (u.pn == 13) ? 1 : 2;
#pragma unroll
        for (int ai = 0; ai < 2; ++ai)
#pragma unroll
            for (int m = 0; m < 4; ++m)
#pragma unroll
                for (int bj = 0; bj < 2; ++bj) { if (bj < nbj) { const f32x4 v0 = acc[ai][bj][m][0], v1 = acc[ai][bj][m][1];
                    u32x4 w; w.x = cvt_pk_bf16(v0[0], v0[1]); w.y = cvt_pk_bf16(v0[2], v0[3]); w.z = cvt_pk_bf16(v1[0], v1[1]); w.w = cvt_pk_bf16(v1[2], v1[3]);
                    *(u32x4*)(base + (size_t)(row0 + ai * 128 + m * 16) * ld + cbase + bj * 128 + wc * 32 + 8 * fq) = w; } }
    }
};
struct EpiLora {
    static constexpr bool PERM = true, AFTER_DRAIN = false;
    bf16_t* LO; bf16_t* GATE;
    __device__ __forceinline__ void operator()(const f32x4 (&acc)[2][2][4][2], const pg8::Unit& u, int wr, int wc, int fr, int fq) const {
        const int row0 = u.pm * 256 + wr * 64 + fr;
        bf16_t* base; int ld, cbase;
        if (u.pn < 6) { base = LO; ld = 1536; cbase = u.pn * 256; } else { base = GATE; ld = 384; cbase = u.pn * 256 - 1536; }
        const int nbj = (u.pn == 7) ? 1 : 2;
#pragma unroll
        for (int ai = 0; ai < 2; ++ai)
#pragma unroll
            for (int m = 0; m < 4; ++m)
#pragma unroll
                for (int bj = 0; bj < 2; ++bj) { if (bj < nbj) { const f32x4 v0 = acc[ai][bj][m][0], v1 = acc[ai][bj][m][1];
                    u32x4 w; w.x = cvt_pk_bf16(v0[0], v0[1]); w.y = cvt_pk_bf16(v0[2], v0[3]); w.z = cvt_pk_bf16(v1[0], v1[1]); w.w = cvt_pk_bf16(v1[2], v1[3]);
                    *(u32x4*)(base + (size_t)(row0 + ai * 128 + m * 16) * ld + cbase + bj * 128 + wc * 32 + 8 * fq) = w; } }
    }
};
template <class Epi> __device__ __forceinline__ void run_gemm(LAS unsigned char* lds, const bf16_t* A, const bf16_t* Bt, int M, int N, int K, const Epi& E) {
    asm volatile("" : "+s"(K));
    pg8::Gemm g{A, Bt, M, N, K}; pg8::StaticOrder S; S.init(M, N, (int)gridDim.x, (int)blockIdx.x);
    pg8::gemm_phase<Epi, pg8::StaticOrder>(lds, g, S, E);
    __syncthreads();
}

__device__ __forceinline__ void ph_loraprep(const Params& P, int l) {
    const bf16_t* PRW = (const bf16_t*)(P.ws + WS_PRW); bf16_t* AL = (bf16_t*)(P.ws + WS_ALORA);
    const float* mu = P.in[I_MU] + (size_t)l * 2 * RW_IN;
    const int gtid = blockIdx.x * NTHR + otid(), gn = gridDim.x * NTHR;
    for (int it = gtid; it < T * 48; it += gn) {
        const int row = it / 48, j8 = it % 48, col = 1152 + j8 * 8;
        bool hp, hn; row_nbrs(row, hp, hn);
        float p[8], pp[8], pn[8];
        unpack8(*(const u32x4*)(PRW + (size_t)row * RW_IN + col), p);
        if (hp) unpack8(*(const u32x4*)(PRW + (size_t)(row - 1) * RW_IN + col), pp); else {
#pragma unroll
            for (int i = 0; i < 8; ++i) pp[i] = 0.f; }
        if (hn) unpack8(*(const u32x4*)(PRW + (size_t)(row + 1) * RW_IN + col), pn); else {
#pragma unroll
            for (int i = 0; i < 8; ++i) pn[i] = 0.f; }
        float o[8];
#pragma unroll
        for (int i = 0; i < 8; ++i) { const float xs = p[i] + mu[col + i] * (pp[i] - p[i]) + mu[RW_IN + col + i] * (pn[i] - p[i]);
            o[i] = j8 < 16 ? tanhf(xs) : (j8 < 32 ? xs : sigmoidf_(xs)); }
        u32x4 w; w.x = cvt_pk_bf16(o[0], o[1]); w.y = cvt_pk_bf16(o[2], o[3]); w.z = cvt_pk_bf16(o[4], o[5]); w.w = cvt_pk_bf16(o[6], o[7]);
        *(u32x4*)(AL + (size_t)row * 384 + j8 * 8) = w;
    }
}

__device__ __forceinline__ void ph_rwkvprep(const Params& P, int l) {
    const int tid = otid(), lane = tid & 63, gw = blockIdx.x * NWAVE + (tid >> 6), nw = gridDim.x * NWAVE;
    const int nrw = nw / 6, h = gw % 6, rw0 = gw / 6;
    if (rw0 >= nrw) return;
    const int q = lane & 31, half = lane >> 5, c = h * 64 + 2 * q;
    const bf16_t* PRW = (const bf16_t*)(P.ws + WS_PRW); const bf16_t* LO = (const bf16_t*)(P.ws + WS_LORAO);
    bf16_t* RS = (bf16_t*)(P.ws + WS_RS); bf16_t* KKS = (bf16_t*)(P.ws + WS_KKS); bf16_t* VS = (bf16_t*)(P.ws + WS_VS); bf16_t* KS = (bf16_t*)(P.ws + WS_KS); bf16_t* BS = (bf16_t*)(P.ws + WS_BS);
    float* BON = (float*)(P.ws + WS_BONUS); float* DEC = (float*)(P.ws + WS_DECAY);
    const float* RT = (const float*)(P.ws + WS_ROPE);
    const float* mu = P.in[I_MU] + (size_t)l * 2 * RW_IN;
    float mp[3][2], mn[3][2], ckk[2], cka[2], crk[2], ca0[2], ca1[2], cw0[2], cw1[2];
#pragma unroll
    for (int e = 0; e < 2; ++e) {
#pragma unroll
        for (int t3 = 0; t3 < 3; ++t3) { mp[t3][e] = mu[t3 * 384 + c + e]; mn[t3][e] = mu[RW_IN + t3 * 384 + c + e]; }
        ckk[e] = P.in[I_KK][l * RWW + c + e]; cka[e] = P.in[I_KA][l * RWW + c + e]; crk[e] = P.in[I_RK][l * RWW + c + e];
        ca0[e] = P.in[I_A0][(size_t)l * 2 * RWW + c + e]; ca1[e] = P.in[I_A0][(size_t)l * 2 * RWW + RWW + c + e]; cw0[e] = P.in[I_W0][(size_t)l * 2 * RWW + c + e]; cw1[e] = P.in[I_W0][(size_t)l * 2 * RWW + RWW + c + e]; }
    const float sg = (q & 8) ? 1.f : -1.f;
    const int f0 = (2 * q) & 15;
#define LD2(ptr, lo_, hi_) do { const unsigned w_ = *(const unsigned*)(ptr); lo_ = lo_bf(w_); hi_ = hi_bf(w_); } while (0)
#define SUM32(x) do { x += __shfl_xor(x, 1); x += __shfl_xor(x, 2); x += __shfl_xor(x, 4); x += __shfl_xor(x, 8); x += __shfl_xor(x, 16); } while (0)
#pragma unroll 2
    for (int pi = rw0; pi < T / 2; pi += nrw) { const int row = 2 * pi + half;
        bool hp, hn; row_nbrs(row, hp, hn);
        const bf16_t* pr = PRW + (size_t)row * RW_IN + c; const int om = hp ? -RW_IN : 0, op = hn ? RW_IN : 0; const float fm = hp ? 1.f : 0.f, fp = hn ? 1.f : 0.f;
        float x[3][2];
#pragma unroll
        for (int t3 = 0; t3 < 3; ++t3) { float c0, c1, m0, m1, p0, p1; LD2(pr + t3 * 384, c0, c1); LD2(pr + t3 * 384 + om, m0, m1); LD2(pr + t3 * 384 + op, p0, p1);
            x[t3][0] = c0 + mp[t3][0] * (fm * m0 - c0) + mn[t3][0] * (fp * p0 - c0); x[t3][1] = c1 + mp[t3][1] * (fm * m1 - c1) + mn[t3][1] * (fp * p1 - c1); }
        const bf16_t* lo = LO + (size_t)row * 1536 + c;
        float la0[2], la1[2], lw0[2], lw1[2]; LD2(lo + 768, la0[0], la0[1]); LD2(lo + 1152, la1[0], la1[1]); LD2(lo, lw0[0], lw0[1]); LD2(lo + 384, lw1[0], lw1[1]);
        float a0[2], a1[2], kkr[2];
#pragma unroll
        for (int e = 0; e < 2; ++e) { a0[e] = sigmoidf_(la0[e] + ca0[e]); a1[e] = sigmoidf_(la1[e] + ca1[e]); kkr[e] = x[1][e] * ckk[e]; }
        float n2 = kkr[0] * kkr[0] + kkr[1] * kkr[1]; SUM32(n2);
        const float rn = 1.0f / fmaxf(sqrtf(n2), 1e-12f);
        float rs[2], kks[2], kd0[2], kd1[2], b0[2], b1[2]; float bon = 0.f;
#pragma unroll
        for (int e = 0; e < 2; ++e) { const float k = x[1][e]; kks[e] = kkr[e] * rn; rs[e] = x[0][e];
            kd0[e] = k * (1.f + (a0[e] - 1.f) * cka[e]); kd1[e] = k * (1.f + (a1[e] - 1.f) * cka[e]); b0[e] = kks[e] * a0[e]; b1[e] = kks[e] * a1[e];
            bon += rs[e] * (kd0[e] + kd1[e]) * crk[e]; }
        SUM32(bon);
        if (row < TL) {
            const int t = row & (SEQ - 1); const int pos = (q < 16) ? (t >> 6) : (t & 63);
            const float4 cs4 = *(const float4*)(RT + (size_t)(pos * 16 + f0) * 2);
            const float cs[2] = {cs4.x, cs4.z}, sn[2] = {cs4.y, cs4.w};
#pragma unroll
            for (int e = 0; e < 2; ++e) {
                const float r2 = __shfl_xor(rs[e], 8), k2 = __shfl_xor(kks[e], 8), d0 = __shfl_xor(kd0[e], 8), d1 = __shfl_xor(kd1[e], 8), e0 = __shfl_xor(b0[e], 8), e1 = __shfl_xor(b1[e], 8);
                rs[e] = rs[e] * cs[e] + sg * r2 * sn[e]; kks[e] = kks[e] * cs[e] + sg * k2 * sn[e]; kd0[e] = kd0[e] * cs[e] + sg * d0 * sn[e]; kd1[e] = kd1[e] * cs[e] + sg * d1 * sn[e];
                b0[e] = b0[e] * cs[e] + sg * e0 * sn[e]; b1[e] = b1[e] * cs[e] + sg * e1 * sn[e]; }
        }
        const size_t o = (size_t)row * 384 + c;
        *(float2*)(DEC + o) = make_float2(__expf(-0.6065306597f * sigmoidf_(lw0[0] + cw0[0])), __expf(-0.6065306597f * sigmoidf_(lw0[1] + cw0[1])));
        *(float2*)(DEC + (size_t)T * 384 + o) = make_float2(__expf(-0.6065306597f * sigmoidf_(lw1[0] + cw1[0])), __expf(-0.6065306597f * sigmoidf_(lw1[1] + cw1[1])));
        if (q == 0) BON[(size_t)row * 6 + h] = bon;
        *(unsigned*)(RS + o) = cvt_pk_bf16(rs[0], rs[1]); *(unsigned*)(KKS + o) = cvt_pk_bf16(-kks[0], -kks[1]); *(unsigned*)(VS + o) = cvt_pk_bf16(x[2][0], x[2][1]);
        *(unsigned*)(KS + o) = cvt_pk_bf16(kd0[0], kd0[1]); *(unsigned*)(KS + (size_t)T * 384 + o) = cvt_pk_bf16(kd1[0], kd1[1]);
        *(unsigned*)(BS + o) = cvt_pk_bf16(b0[0], b0[1]); *(unsigned*)(BS + (size_t)T * 384 + o) = cvt_pk_bf16(b1[0], b1[1]);
    }
#undef LD2
#undef SUM32
}

__device__ __forceinline__ int scan_row(int b, int d, int step) {
    if (step < CTX) { const int tc = d ? (CTX - 1 - step) : step; return TL + b * CTX + tc; }
    const int tl = d ? (SEQ - 1 - (step - CTX)) : (step - CTX); return b * SEQ + tl;
}
__device__ __forceinline__ void scan_task_v1(const Params& P, int task, float* sv) {
    const int lane = otid() & 63;
    const int d = task & 1, h = (task >> 1) % 6, b = task / 12;
    const float* DEC = (const float*)(P.ws + WS_DECAY) + (size_t)d * T * 384; const bf16_t* KKS = (const bf16_t*)(P.ws + WS_KKS); const bf16_t* RS = (const bf16_t*)(P.ws + WS_RS);
    const bf16_t* VS = (const bf16_t*)(P.ws + WS_VS); const bf16_t* KS = (const bf16_t*)(P.ws + WS_KS) + (size_t)d * T * 384; const bf16_t* BS = (const bf16_t*)(P.ws + WS_BS) + (size_t)d * T * 384;
    float* YD = (float*)(P.ws + WS_YDIR) + (size_t)d * T * 384;
    float S[64];
#pragma unroll
    for (int j = 0; j < 64; ++j) S[j] = 0.f;
    size_t o = (size_t)scan_row(b, d, 0) * 384 + h * 64 + lane;
    float nw_ = DEC[o], na = bf2f(KKS[o]), nb = bf2f(BS[o]), nk = bf2f(KS[o]), nr = bf2f(RS[o]), nv = bf2f(VS[o]);
    for (int step = 0; step < CTX + SEQ; ++step) {
        const float v = nv; const size_t oc = o;
        asm volatile("s_waitcnt lgkmcnt(0)" ::: "memory");
        sv[lane] = nw_; sv[64 + lane] = na; sv[128 + lane] = nb; sv[192 + lane] = nk; sv[256 + lane] = nr;
        asm volatile("s_waitcnt lgkmcnt(0)" ::: "memory");
        if (step + 1 < CTX + SEQ) { o = (size_t)scan_row(b, d, step + 1) * 384 + h * 64 + lane;
            nw_ = DEC[o]; na = bf2f(KKS[o]); nb = bf2f(BS[o]); nk = bf2f(KS[o]); nr = bf2f(RS[o]); nv = bf2f(VS[o]); }
        float sa0 = 0.f, sa1 = 0.f, sa2 = 0.f, sa3 = 0.f;
#pragma unroll
        for (int j = 0; j < 64; j += 4) { const float4 a4 = *(const float4*)(sv + 64 + j);
            sa0 += S[j + 0] * a4.x; sa1 += S[j + 1] * a4.y; sa2 += S[j + 2] * a4.z; sa3 += S[j + 3] * a4.w; }
        const float sa = (sa0 + sa1) + (sa2 + sa3);
        float y0 = 0.f, y1 = 0.f, y2 = 0.f, y3 = 0.f;
#pragma unroll
        for (int j = 0; j < 64; j += 4) {
            const float4 w4 = *(const float4*)(sv + j), b4 = *(const float4*)(sv + 128 + j), k4 = *(const float4*)(sv + 192 + j), r4 = *(const float4*)(sv + 256 + j);
            S[j + 0] = S[j + 0] * w4.x + sa * b4.x + v * k4.x; y0 += S[j + 0] * r4.x;
            S[j + 1] = S[j + 1] * w4.y + sa * b4.y + v * k4.y; y1 += S[j + 1] * r4.y;
            S[j + 2] = S[j + 2] * w4.z + sa * b4.z + v * k4.z; y2 += S[j + 2] * r4.z;
            S[j + 3] = S[j + 3] * w4.w + sa * b4.w + v * k4.w; y3 += S[j + 3] * r4.w; }
        YD[oc] = (y0 + y1) + (y2 + y3);
    }
}

__device__ __forceinline__ void natt_key(const bf16_t* PNA, size_t krow, int hoff, const float (&q)[16], float bias, float& m, float& lsum, float (&o)[16]) {
    const bf16_t* kp = PNA + krow * NA_IN + 384 + hoff; const bf16_t* vp = PNA + krow * NA_IN + 768 + hoff;
    float s = 0.f;
#pragma unroll
    for (int j8 = 0; j8 < 2; ++j8) { float kf[8]; unpack8(*(const u32x4*)(kp + j8 * 8), kf);
#pragma unroll
        for (int i = 0; i < 8; ++i) s += q[j8 * 8 + i] * kf[i]; }
    s += __shfl_xor(s, 1); s += __shfl_xor(s, 2); s += bias;
    const float mn = fmaxf(m, s), corr = __expf(m - mn), p = __expf(s - mn);
    m = mn; lsum = lsum * corr + p;
#pragma unroll
    for (int j8 = 0; j8 < 2; ++j8) { float vf[8]; unpack8(*(const u32x4*)(vp + j8 * 8), vf);
#pragma unroll
        for (int i = 0; i < 8; ++i) o[j8 * 8 + i] = o[j8 * 8 + i] * corr + p * vf[i]; }
}
__device__ __forceinline__ void natten_items_v1(const Params& P, int l, int wid0, int nworkers) {
    const bf16_t* PNA = (const bf16_t*)(P.ws + WS_PNA); bf16_t* MIX = (bf16_t*)(P.ws + WS_U);
    const float* rpb = P.in[I_RPB] + (size_t)l * 6 * 15 * 31;
    const int sub = wid0 & 3;
    for (int it = wid0 >> 2; it < T * 6; it += nworkers >> 2) {
        const int row = it % T, h = it / T, hoff = h * 64 + sub * 16;
        float q[16], o[16];
#pragma unroll
        for (int j8 = 0; j8 < 2; ++j8) { float qf[8]; unpack8(*(const u32x4*)(PNA + (size_t)row * NA_IN + hoff + j8 * 8), qf);
#pragma unroll
            for (int i = 0; i < 8; ++i) { q[j8 * 8 + i] = qf[i] * 0.125f; o[j8 * 8 + i] = 0.f; } }
        float m = -3.0e38f, lsum = 0.f;
        int b;
        if (row < TL) { b = row >> 13; const int t = row & (SEQ - 1), i = t >> 6, col = t & 63;
            const int start = min(max(i - 4, 0), 120), win0 = min(max(col - 8, 0), 48);
            for (int r = 0; r < 8; ++r) for (int kc = win0; kc < win0 + 16; ++kc) {
                const float bias = rpb[(h * 15 + (start + r - i + 7)) * 31 + (kc - col + 15)];
                natt_key(PNA, (size_t)b * SEQ + (start + r) * 64 + kc, hoff, q, bias, m, lsum, o); }
        } else b = (row - TL) >> 8;
        for (int c = 0; c < CTX; ++c) natt_key(PNA, (size_t)TL + b * CTX + c, hoff, q, 0.f, m, lsum, o);
        const float il = 1.0f / lsum;
#pragma unroll
        for (int j8 = 0; j8 < 2; ++j8) { u32x4 w; w.x = cvt_pk_bf16(o[j8 * 8 + 0] * il, o[j8 * 8 + 1] * il); w.y = cvt_pk_bf16(o[j8 * 8 + 2] * il, o[j8 * 8 + 3] * il);
            w.z = cvt_pk_bf16(o[j8 * 8 + 4] * il, o[j8 * 8 + 5] * il); w.w = cvt_pk_bf16(o[j8 * 8 + 6] * il, o[j8 * 8 + 7] * il);
            *(u32x4*)(MIX + (size_t)row * D + 640 + hoff + j8 * 8) = w; }
    }
}

__device__ __forceinline__ void vt_tile(const Params& P, int tile, unsigned short* tl  ) {
    const int tid = otid();
    const bf16_t* PNA = (const bf16_t*)(P.ws + WS_PNA);
    int h, tok0; bf16_t* dst; int ldt;
    if (tile < NB * 128 * 6) { h = tile % 6; const int sb = tile / 6; const int b = sb >> 7, blk = sb & 127; tok0 = b * SEQ + blk * 64; dst = (bf16_t*)(P.ws + WS_VTL) + ((size_t)(b * 6 + h) * 64) * SEQ + blk * 64; ldt = SEQ; }
    else { const int tt = tile - NB * 128 * 6; h = tt % 6; const int sb = tt / 6; const int b = sb >> 2, blk = sb & 3; tok0 = TL + b * CTX + blk * 64; dst = (bf16_t*)(P.ws + WS_VTC) + ((size_t)(b * 6 + h) * 64) * CTX + blk * 64; ldt = CTX; }
    { const int tok = tid >> 3, seg = tid & 7; const u32x4 v = *(const u32x4*)(PNA + (size_t)(tok0 + tok) * NA_IN + 768 + h * 64 + seg * 8);
      unsigned* w = (unsigned*)(tl + tok * 72 + seg * 8); w[0] = v.x; w[1] = v.y; w[2] = v.z; w[3] = v.w; }
    __syncthreads();
    { const int hd = tid >> 3, ts = tid & 7; unsigned short e[8];
#pragma unroll
      for (int k = 0; k < 8; ++k) e[k] = tl[(ts * 8 + k) * 72 + hd];
      u32x4 w; w.x = (unsigned)e[0] | ((unsigned)e[1] << 16); w.y = (unsigned)e[2] | ((unsigned)e[3] << 16); w.z = (unsigned)e[4] | ((unsigned)e[5] << 16); w.w = (unsigned)e[6] | ((unsigned)e[7] << 16);
      *(u32x4*)(dst + (size_t)hd * ldt + ts * 8) = w; }
    __syncthreads();
}
constexpr int NAT_LAT_TASKS = NB * 128 * 4 * 6, NAT_CTX_TASKS = NB * 16 * 6, NAT_TASKS = NAT_LAT_TASKS + NAT_CTX_TASKS;
__device__ __forceinline__ void natten_task(const Params& P, int l, int task) {
    using pg8::bf16x8;
    const int lane = otid() & 63, fr = lane & 15, fq = lane >> 4;
    const bf16_t* PNA = (const bf16_t*)(P.ws + WS_PNA); bf16_t* MIX = (bf16_t*)(P.ws + WS_U);
    const bool lat = task < NAT_LAT_TASKS;
    int b, h, i = 0, n = 0, qtok0;
    if (lat) { h = task % 6; const int r = task / 6; n = r & 3; i = (r >> 2) & 127; b = r >> 9; qtok0 = b * SEQ + i * 64 + 16 * n; }
    else { const int tt = task - NAT_LAT_TASKS; h = tt % 6; const int qb = (tt / 6) & 15; b = tt / 96; qtok0 = TL + b * CTX + 16 * qb; }
    const int start = min(max(i - 4, 0), 120), band0 = min(max(16 * n - 8, 0), 32);
    const int col = 16 * n + fr, win0 = min(max(col - 8, 0), 48);
    bf16x8 bq[2];
#pragma unroll
    for (int kh = 0; kh < 2; ++kh) bq[kh] = *(const bf16x8*)(PNA + (size_t)(qtok0 + fr) * NA_IN + h * 64 + kh * 32 + fq * 8);
    f32x4 sc[32];
    if (lat) {
#pragma unroll
        for (int t = 0; t < 16; ++t) { const int tok0 = b * SEQ + (start + (t >> 1)) * 64 + band0 + 16 * (t & 1);
            const bf16_t* kp = PNA + (size_t)(tok0 + fr) * NA_IN + 384 + h * 64 + fq * 8;
            const bf16x8 k0 = *(const bf16x8*)kp, k1 = *(const bf16x8*)(kp + 32);
            f32x4 a = (f32x4){0.f, 0.f, 0.f, 0.f};
            a = __builtin_amdgcn_mfma_f32_16x16x32_bf16(k0, bq[0], a, 0, 0, 0); a = __builtin_amdgcn_mfma_f32_16x16x32_bf16(k1, bq[1], a, 0, 0, 0);
            sc[t] = a; if ((t & 3) == 3) asm volatile("" ::: "memory"); }
    } else {
#pragma unroll
        for (int t = 0; t < 16; ++t) sc[t] = (f32x4){-3.0e38f, -3.0e38f, -3.0e38f, -3.0e38f};
    }
#pragma unroll
    for (int t = 16; t < 32; ++t) { const int tok0 = TL + b * CTX + 16 * (t - 16);
        const bf16_t* kp = PNA + (size_t)(tok0 + fr) * NA_IN + 384 + h * 64 + fq * 8;
        const bf16x8 k0 = *(const bf16x8*)kp, k1 = *(const bf16x8*)(kp + 32);
        f32x4 a = (f32x4){0.f, 0.f, 0.f, 0.f};
        a = __builtin_amdgcn_mfma_f32_16x16x32_bf16(k0, bq[0], a, 0, 0, 0); a = __builtin_amdgcn_mfma_f32_16x16x32_bf16(k1, bq[1], a, 0, 0, 0);
        sc[t] = a * 0.125f; if ((t & 3) == 3) asm volatile("" ::: "memory"); }
    if (lat) { const float* rpb = P.in[I_RPB] + ((size_t)l * 6 + h) * 15 * 31;
#pragma unroll
        for (int t = 0; t < 16; ++t) { const int ro = start + (t >> 1) - i + 7; const int kc0 = band0 + 16 * (t & 1) + fq * 4;
#pragma unroll
            for (int j = 0; j < 4; ++j) { const int kc = kc0 + j; const bool ok = kc >= win0 && kc < win0 + 16; const int co = min(max(kc - col + 15, 0), 30);
                const float bias = rpb[ro * 31 + co]; sc[t][j] = ok ? sc[t][j] * 0.125f + bias : -3.0e38f; } } }
    float mx = -3.0e38f;
#pragma unroll
    for (int t = 0; t < 32; ++t) mx = fmaxf(mx, fmaxf(fmaxf(sc[t][0], sc[t][1]), fmaxf(sc[t][2], sc[t][3])));
    mx = fmaxf(mx, __shfl_xor(mx, 16)); mx = fmaxf(mx, __shfl_xor(mx, 32));
    float sum = 0.f;
#pragma unroll
    for (int t = 0; t < 32; ++t) {
#pragma unroll
        for (int j = 0; j < 4; ++j) { const float p = __expf(sc[t][j] - mx); sc[t][j] = p; sum += p; } }
    sum += __shfl_xor(sum, 16); sum += __shfl_xor(sum, 32);
    const float inv = 1.0f / sum;
    f32x4 ot[4];
#pragma unroll
    for (int q = 0; q < 4; ++q) ot[q] = (f32x4){0.f, 0.f, 0.f, 0.f};
    const bf16_t* VTL = (const bf16_t*)(P.ws + WS_VTL) + ((size_t)(b * 6 + h) * 64) * SEQ; const bf16_t* VTC = (const bf16_t*)(P.ws + WS_VTC) + ((size_t)(b * 6 + h) * 64) * CTX;
    if (lat) {
#pragma unroll
        for (int m = 0; m < 8; ++m) { const int tk = (start + m) * 64 + band0 + fq * 4;
            u32x4 pw; pw.x = cvt_pk_bf16(sc[2 * m][0], sc[2 * m][1]); pw.y = cvt_pk_bf16(sc[2 * m][2], sc[2 * m][3]); pw.z = cvt_pk_bf16(sc[2 * m + 1][0], sc[2 * m + 1][1]); pw.w = cvt_pk_bf16(sc[2 * m + 1][2], sc[2 * m + 1][3]);
            const bf16x8 pb = __builtin_bit_cast(bf16x8, pw);
#pragma unroll
            for (int q = 0; q < 4; ++q) { const bf16_t* vp = VTL + (size_t)(q * 16 + fr) * SEQ + tk; const u32x2 v0 = *(const u32x2*)vp, v1 = *(const u32x2*)(vp + 16);
                u32x4 vw; vw.x = v0.x; vw.y = v0.y; vw.z = v1.x; vw.w = v1.y;
                ot[q] = __builtin_amdgcn_mfma_f32_16x16x32_bf16(__builtin_bit_cast(bf16x8, vw), pb, ot[q], 0, 0, 0); }
            if (m & 1) asm volatile("" ::: "memory"); }
    }
#pragma unroll
    for (int m = 0; m < 8; ++m) { const int tk = 32 * m + fq * 4;
        u32x4 pw; pw.x = cvt_pk_bf16(sc[16 + 2 * m][0], sc[16 + 2 * m][1]); pw.y = cvt_pk_bf16(sc[16 + 2 * m][2], sc[16 + 2 * m][3]); pw.z = cvt_pk_bf16(sc[17 + 2 * m][0], sc[17 + 2 * m][1]); pw.w = cvt_pk_bf16(sc[17 + 2 * m][2], sc[17 + 2 * m][3]);
        const bf16x8 pb = __builtin_bit_cast(bf16x8, pw);
#pragma unroll
        for (int q = 0; q < 4; ++q) { const bf16_t* vp = VTC + (size_t)(q * 16 + fr) * CTX + tk; const u32x2 v0 = *(const u32x2*)vp, v1 = *(const u32x2*)(vp + 16);
            u32x4 vw; vw.x = v0.x; vw.y = v0.y; vw.z = v1.x; vw.w = v1.y;
            ot[q] = __builtin_amdgcn_mfma_f32_16x16x32_bf16(__builtin_bit_cast(bf16x8, vw), pb, ot[q], 0, 0, 0); }
        if (m & 1) asm volatile("" ::: "memory"); }
#pragma unroll
    for (int q = 0; q < 4; ++q) { u32x2 w; w.x = cvt_pk_bf16(ot[q][0] * inv, ot[q][1] * inv); w.y = cvt_pk_bf16(ot[q][2] * inv, ot[q][3] * inv);
        *(u32x2*)(MIX + (size_t)(qtok0 + fr) * D + 640 + h * 64 + q * 16 + fq * 4) = w; }
}

__device__ __forceinline__ void fft_fwd(float2* X) {
#pragma unroll 1
    for (int lq = 12; lq >= 0; lq -= 2) { const int q = 1 << lq; const float rq = 1.0f / (float)(4 * q);
        for (int j = otid(); j < NFFT / 4; j += NTHR) { const int lo = j & (q - 1), base = ((j >> lq) << (lq + 2)) | lo;
            const float2 x0 = X[base], x1 = X[base + q], x2 = X[base + 2 * q], x3 = X[base + 3 * q];
            const float fr = (float)lo * rq; const float c = __builtin_amdgcn_cosf(fr), s = __builtin_amdgcn_sinf(fr), c2 = c * c - s * s, s2 = 2.f * c * s;
            const float a0x = x0.x + x2.x, a0y = x0.y + x2.y, dx = x0.x - x2.x, dy = x0.y - x2.y;
            const float a2x = dx * c + dy * s, a2y = dy * c - dx * s;
            const float a1x = x1.x + x3.x, a1y = x1.y + x3.y, ex = x1.x - x3.x, ey = x1.y - x3.y;
            const float mx = ex * c + ey * s, my = ey * c - ex * s;
            const float a3x = my, a3y = -mx;
            const float fx = a0x - a1x, fy = a0y - a1y, gx = a2x - a3x, gy = a2y - a3y;
            X[base] = make_float2(a0x + a1x, a0y + a1y); X[base + q] = make_float2(fx * c2 + fy * s2, fy * c2 - fx * s2);
            X[base + 2 * q] = make_float2(a2x + a3x, a2y + a3y); X[base + 3 * q] = make_float2(gx * c2 + gy * s2, gy * c2 - gx * s2); }
        __syncthreads(); }
}
__device__ __forceinline__ void fft_inv(float2* X) {
#pragma unroll 1
    for (int lq = 0; lq <= 12; lq += 2) { const int q = 1 << lq; const float rq = 1.0f / (float)(4 * q);
        for (int j = otid(); j < NFFT / 4; j += NTHR) { const int lo = j & (q - 1), base = ((j >> lq) << (lq + 2)) | lo;
            const float2 y0 = X[base], y1 = X[base + q], y2 = X[base + 2 * q], y3 = X[base + 3 * q];
            const float fr = (float)lo * rq; const float c = __builtin_amdgcn_cosf(fr), s = __builtin_amdgcn_sinf(fr), c2 = c * c - s * s, s2 = 2.f * c * s;
            const float tx = y1.x * c2 - y1.y * s2, ty = y1.x * s2 + y1.y * c2;
            const float a0x = y0.x + tx, a0y = y0.y + ty, a1x = y0.x - tx, a1y = y0.y - ty;
            const float ux = y3.x * c2 - y3.y * s2, uy = y3.x * s2 + y3.y * c2;
            const float a2x = y2.x + ux, a2y = y2.y + uy, a3x = y2.x - ux, a3y = y2.y - uy;
            const float vx = a2x * c - a2y * s, vy = a2x * s + a2y * c;
            const float mx = a3x * c - a3y * s, my = a3x * s + a3y * c;
            const float wx = -my, wy = mx;
            X[base] = make_float2(a0x + vx, a0y + vy); X[base + 2 * q] = make_float2(a0x - vx, a0y - vy);
            X[base + q] = make_float2(a1x + wx, a1y + wy); X[base + 3 * q] = make_float2(a1x - wx, a1y - wy); }
        __syncthreads(); }
}
__device__ __forceinline__ float hy_delta(int c) { const float lo = -4.605170185988091f / 1.5f, hi = -4.605170185988091f / 0.3f; return fabsf(lo + (float)c * ((hi - lo) / 255.0f)); }
__device__ __forceinline__ float hy_short(const bf16_t* PHYT, const float* cw, const float* cb, int row, int col) {
    bool hp, hn; row_nbrs(row, hp, hn);
    const bf16_t* p = PHYT + (size_t)col * T + row;
    float v = cb[col] + cw[HY_IN + col] * bf2f(p[0]);
    if (hp) v += cw[col] * bf2f(p[-1]);
    if (hn) v += cw[2 * HY_IN + col] * bf2f(p[1]);
    return v;
}
struct HyTap { float w0, w1, w2, b; };
__device__ __forceinline__ HyTap hy_tap(const float* cw, const float* cb, int col) { HyTap t; t.w0 = cw[col]; t.w1 = cw[HY_IN + col]; t.w2 = cw[2 * HY_IN + col]; t.b = cb[col]; return t; }
__device__ __forceinline__ float hy_lat(const bf16_t* colp, int b, int n, const HyTap t) {
    const bf16_t* p = colp + b * SEQ + n;
    const float xm = bf2f(p[n > 0 ? -1 : 0]), x0 = bf2f(p[0]), xp = bf2f(p[n < SEQ - 1 ? 1 : 0]);
    return t.b + t.w1 * x0 + (n > 0 ? t.w0 * xm : 0.f) + (n < SEQ - 1 ? t.w2 * xp : 0.f);
}
__device__ __forceinline__ void hy_spec_task(const Params& P, int l, int c, float2* X) {
    const int tid = otid();
    const bf16_t* f0 = (const bf16_t*)(P.ws + WS_FILT) + (size_t)c * SEQ; const bf16_t* b0 = f0 + (size_t)256 * SEQ; const bf16_t* f1 = f0 + (size_t)512 * SEQ; const bf16_t* b1 = f0 + (size_t)768 * SEQ;
    for (int n = tid; n < SEQ; n += NTHR) {
        X[n] = make_float2(bf2f(f0[n]), bf2f(f1[n]));
        if (n > 0) X[NFFT - n] = make_float2(bf2f(b0[n]), bf2f(b1[n])); else X[SEQ] = make_float2(0.f, 0.f); }
    __syncthreads();
    fft_fwd(X);
    float2* spec = (float2*)(P.ws + WS_SPEC) + (size_t)c * NFFT;
    for (int i = tid; i < NFFT; i += NTHR) spec[i] = X[i];
    __syncthreads();
}
__device__ __forceinline__ void hy_conv_core(const Params& P, int o, int c, float2* X) {
    fft_fwd(X);
    const float2* spec = (const float2*)(P.ws + WS_SPEC) + (size_t)c * NFFT;
    for (int i = otid(); i < NFFT; i += NTHR) {
        const unsigned f = __brev((unsigned)i) >> 18;
        const unsigned ip = __brev(((unsigned)NFFT - f) & (unsigned)(NFFT - 1)) >> 18;
        const float2 a = X[i], w = spec[i], w2 = spec[ip];
        const float kx = o == 0 ? 0.5f * (w.x + w2.x) : 0.5f * (w.y + w2.y), ky = o == 0 ? 0.5f * (w.y - w2.y) : -0.5f * (w.x - w2.x);
        X[i] = make_float2(a.x * kx - a.y * ky, a.x * ky + a.y * kx); }
    __syncthreads();
    fft_inv(X);
}
__device__ __forceinline__ void hy_task1(const Params& P, int l, int c, float2* X, float* ex) {
    const int tid = otid();
    const bf16_t* PHY = (const bf16_t*)(P.ws + WS_PHY); const float* cw = P.in[I_HCW] + (size_t)l * 3 * HY_IN; const float* cb = P.in[I_HCB] + (size_t)l * HY_IN;
    const float bias0 = P.in[I_HBIAS][(size_t)l * 2 * HYC + c], bias1 = P.in[I_HBIAS][(size_t)l * 2 * HYC + HYC + c];
    const HyTap tv = hy_tap(cw, cb, c), tg1 = hy_tap(cw, cb, HYC + c); const bf16_t* colv = PHY + (size_t)c * T; const bf16_t* colg1 = PHY + (size_t)(HYC + c) * T;
#pragma unroll 4
    for (int n = tid; n < SEQ; n += NTHR) { X[n] = make_float2(hy_lat(colv, 0, n, tv), hy_lat(colv, 1, n, tv)); X[SEQ + n] = make_float2(0.f, 0.f); }
    __syncthreads();
    hy_conv_core(P, 0, c, X);
    float* Z1 = (float*)(P.ws + WS_Z1) + (size_t)c * NB * SEQ;
#pragma unroll 4
    for (int n = tid; n < SEQ; n += NTHR) { const float2 y = X[n];
        const float v0 = hy_lat(colv, 0, n, tv), v1 = hy_lat(colv, 1, n, tv), g0 = hy_lat(colg1, 0, n, tg1), g1 = hy_lat(colg1, 1, n, tg1);
        Z1[n] = g0 * (y.x + bias0 * v0); Z1[SEQ + n] = g1 * (y.y + bias0 * v1); }
    __syncthreads();
    float* f = (float*)X;
    float* vv = f, *x1 = f + 512, *x2 = f + 1024, *hf = f + 1536  , *z1 = f + 2560;
    const bf16_t* fc = (const bf16_t*)(P.ws + WS_FILTC);
    { const int b = tid >> 8, t = tid & 255, row = TL + b * CTX + t;
      vv[tid] = hy_short(PHY, cw, cb, row, c); x1[tid] = hy_short(PHY, cw, cb, row, HYC + c); x2[tid] = hy_short(PHY, cw, cb, row, 2 * HYC + c);
      for (int q = tid; q < 1024; q += NTHR) { const int od = q >> 8, n = q & 255; hf[q] = bf2f(fc[(size_t)(od * 256 + c) * CTX + n]); } }
    __syncthreads();
    { const int b = tid >> 8, t = tid & 255; float y = bias0 * vv[tid];
      for (int s = 0; s <= t; ++s) y += hf[t - s] * vv[b * 256 + s];
      for (int s = t + 1; s < CTX; ++s) y += hf[256 + s - t] * vv[b * 256 + s];
      z1[tid] = x1[tid] * y; }
    __syncthreads();
    { const int b = tid >> 8, t = tid & 255; float y = bias1 * z1[tid];
      for (int s = 0; s <= t; ++s) y += hf[512 + t - s] * z1[b * 256 + s];
      for (int s = t + 1; s < CTX; ++s) y += hf[768 + s - t] * z1[b * 256 + s];
      bf16_t* MIX = (bf16_t*)(P.ws + WS_U); MIX[(size_t)(TL + b * CTX + t) * D + c] = f2bf(x2[tid] * y); }
    __syncthreads();
}
__device__ __forceinline__ void hy_task2(const Params& P, int l, int c, float2* X) {
    const int tid = otid();
    const bf16_t* PHY = (const bf16_t*)(P.ws + WS_PHY); const float* cw = P.in[I_HCW] + (size_t)l * 3 * HY_IN; const float* cb = P.in[I_HCB] + (size_t)l * HY_IN;
    const float bias1 = P.in[I_HBIAS][(size_t)l * 2 * HYC + HYC + c];
    const float* Z1 = (const float*)(P.ws + WS_Z1) + (size_t)c * NB * SEQ; float* Z1w = (float*)(P.ws + WS_Z1) + (size_t)c * NB * SEQ;
    for (int n = tid; n < SEQ; n += NTHR) { X[n] = make_float2(Z1[n], Z1[SEQ + n]); X[SEQ + n] = make_float2(0.f, 0.f); }
    __syncthreads();
    hy_conv_core(P, 1, c, X);
    bf16_t* MIX = (bf16_t*)(P.ws + WS_U);
    const HyTap tg2 = hy_tap(cw, cb, 2 * HYC + c); const bf16_t* colg2 = PHY + (size_t)(2 * HYC + c) * T;
#pragma unroll 4
    for (int n = tid; n < SEQ; n += NTHR) { const float2 y = X[n];
        const float g0 = hy_lat(colg2, 0, n, tg2), g1 = hy_lat(colg2, 1, n, tg2);
        Z1w[n] = g0 * (y.x + bias1 * Z1[n]); Z1w[SEQ + n] = g1 * (y.y + bias1 * Z1[SEQ + n]); }
    __syncthreads();
}

constexpr int SEGC = 256, NSEG = 33, SCH = 4;
typedef float f32x2v __attribute__((ext_vector_type(2)));
template <bool IDENT>
__device__ __forceinline__ void scan_seg(const Params& P, int chain, int g, float* ring_  ) {
    const ldsfp ring = vlds(ring_);
    const int lane = otid() & 63;
    const int d = chain & 1, h = (chain >> 1) % 6, b = chain / 12;
    const float* DEC = (const float*)(P.ws + WS_DECAY) + (size_t)d * T * 384; const bf16_t* KKS = (const bf16_t*)(P.ws + WS_KKS); const bf16_t* RS = (const bf16_t*)(P.ws + WS_RS);
    const bf16_t* VS = (const bf16_t*)(P.ws + WS_VS); const bf16_t* KS = (const bf16_t*)(P.ws + WS_KS) + (size_t)d * T * 384; const bf16_t* BS = (const bf16_t*)(P.ws + WS_BS) + (size_t)d * T * 384;
    float* YD = (float*)(P.ws + WS_YDIR) + (size_t)d * T * 384;
    bf16_t* E = (bf16_t*)(P.ws + WS_E) + (size_t)chain * SEQ * 64;
    const int step0 = g == 0 ? 0 : CTX + (g - 1) * SEGC;
    f32x2v S0[32], S1[32];
#pragma unroll
    for (int j = 0; j < 32; ++j) { S0[j] = (f32x2v){0.f, 0.f}; S1[j] = (f32x2v){(2 * j == lane) ? 1.f : 0.f, (2 * j + 1 == lane) ? 1.f : 0.f}; }
    float pw[SCH], pa[SCH], pb[SCH], pk[SCH], pr[SCH], pv[SCH]; int po[SCH];
#pragma unroll
    for (int s = 0; s < SCH; ++s) { const int o = scan_row(b, d, step0 + s) * 384 + h * 64 + lane; po[s] = o;
        pw[s] = DEC[o]; pa[s] = bf2f(KKS[o]); pb[s] = bf2f(BS[o]); pk[s] = bf2f(KS[o]); pr[s] = bf2f(RS[o]); pv[s] = bf2f(VS[o]); }
    for (int c = 0; c < SEGC / SCH; ++c) {
        float cv[SCH]; int co[SCH];
        asm volatile("s_waitcnt lgkmcnt(0)" ::: "memory");
#pragma unroll
        for (int s = 0; s < SCH; ++s) { const ldsfp sv = ring + s * 320; sv[lane] = pw[s]; sv[64 + lane] = pa[s]; sv[128 + lane] = pb[s]; sv[192 + lane] = pk[s]; sv[256 + lane] = pr[s]; cv[s] = pv[s]; co[s] = po[s]; }
        asm volatile("s_waitcnt lgkmcnt(0)" ::: "memory");
        if (c + 1 < SEGC / SCH) {
#pragma unroll
            for (int s = 0; s < SCH; ++s) { const int o = scan_row(b, d, step0 + (c + 1) * SCH + s) * 384 + h * 64 + lane; po[s] = o;
                pw[s] = DEC[o]; pa[s] = bf2f(KKS[o]); pb[s] = bf2f(BS[o]); pk[s] = bf2f(KS[o]); pr[s] = bf2f(RS[o]); pv[s] = bf2f(VS[o]); } }
#pragma unroll
        for (int s = 0; s < SCH; ++s) { const ldsfp sv = ring + s * 320;
            f32x2v sa2 = (f32x2v){0.f, 0.f}, sb2 = (f32x2v){0.f, 0.f}, sa3 = sa2, sb3 = sa2;
#pragma unroll
            for (int hb = 0; hb < 2; ++hb) { f32x4 A[8];
#pragma unroll
                for (int i = 0; i < 8; ++i) A[i] = *(const LAS f32x4*)(sv + 64 + hb * 32 + 4 * i);
                __builtin_amdgcn_sched_barrier(0);
#pragma unroll
                for (int i = 0; i < 8; ++i) { const int jj = hb * 16 + 2 * i; const f32x2v alo = (f32x2v){A[i].x, A[i].y}, ahi = (f32x2v){A[i].z, A[i].w};
                    sa2 += S0[jj] * alo; sa3 += S0[jj + 1] * ahi;
                    if (IDENT) { sb2 += S1[jj] * alo; sb3 += S1[jj + 1] * ahi; } }
                __builtin_amdgcn_sched_barrier(0); }
            const float sa = (sa2.x + sa2.y) + (sa3.x + sa3.y), sb = (sb2.x + sb2.y) + (sb3.x + sb3.y);
            const f32x2v saa = (f32x2v){sa, sa}, sbb = (f32x2v){sb, sb}, vv = (f32x2v){cv[s], cv[s]};
            f32x2v y2 = (f32x2v){0.f, 0.f}, y3 = y2, e2 = y2, e3 = y2;
#pragma unroll
            for (int ch = 0; ch < 8; ++ch) { f32x4 W[2], Bq[2], K[2], R[2];
#pragma unroll
                for (int i = 0; i < 2; ++i) { const int j = ch * 8 + 4 * i; W[i] = *(const LAS f32x4*)(sv + j); Bq[i] = *(const LAS f32x4*)(sv + 128 + j); K[i] = *(const LAS f32x4*)(sv + 192 + j); R[i] = *(const LAS f32x4*)(sv + 256 + j); }
                __builtin_amdgcn_sched_barrier(0);
#pragma unroll
                for (int i = 0; i < 2; ++i) { const int jj = ch * 4 + 2 * i;
                    const f32x2v wlo = (f32x2v){W[i].x, W[i].y}, whi = (f32x2v){W[i].z, W[i].w}, blo = (f32x2v){Bq[i].x, Bq[i].y}, bhi = (f32x2v){Bq[i].z, Bq[i].w};
                    const f32x2v klo = (f32x2v){K[i].x, K[i].y}, khi = (f32x2v){K[i].z, K[i].w}, rlo = (f32x2v){R[i].x, R[i].y}, rhi = (f32x2v){R[i].z, R[i].w};
                    S0[jj] = S0[jj] * wlo + saa * blo + vv * klo; y2 += S0[jj] * rlo;
                    S0[jj + 1] = S0[jj + 1] * whi + saa * bhi + vv * khi; y3 += S0[jj + 1] * rhi;
                    if (IDENT) { S1[jj] = S1[jj] * wlo + sbb * blo; e2 += S1[jj] * rlo; S1[jj + 1] = S1[jj + 1] * whi + sbb * bhi; e3 += S1[jj + 1] * rhi; } }
                __builtin_amdgcn_sched_barrier(0); }
            YD[co[s]] = (y2.x + y2.y) + (y3.x + y3.y);
            if (IDENT) { const int tl = d ? (SEQ - 1 - (step0 - CTX + c * SCH + s)) : (step0 - CTX + c * SCH + s); E[(size_t)tl * 64 + lane] = f2bf((e2.x + e2.y) + (e3.x + e3.y)); }
        }
    }
    float* ZP = (float*)(P.ws + WS_ZP) + ((size_t)chain * NSEG + g) * 2 * 4096;
#pragma unroll
    for (int j = 0; j < 32; j += 2) { *(float4*)(ZP + lane * 64 + 2 * j) = make_float4(S0[j].x, S0[j].y, S0[j + 1].x, S0[j + 1].y);
        if (IDENT) *(float4*)(ZP + 4096 + lane * 64 + 2 * j) = make_float4(S1[j].x, S1[j].y, S1[j + 1].x, S1[j + 1].y); }
}
typedef float f32x16 __attribute__((ext_vector_type(16)));
__device__ __forceinline__ void scan_combine(const Params& P, int chain, float* lds) {
    const int tid = otid(), lane = tid & 63, wv = tid >> 6, li = lane & 31, lh = lane >> 5;
    const ldsfp Sl = vlds(lds);
    const ldsfp Pl = Sl + 64 * 65;
    float* ZPc = (float*)(P.ws + WS_ZP) + (size_t)chain * NSEG * 2 * 4096;
    const int ti = (wv >> 1) & 1, tj = wv & 1;
    float pn[8];
#pragma unroll
    for (int q = 0; q < 8; ++q) { pn[q] = ZPc[(size_t)2 * 4096 + 4096 + tid * 8 + q]; Sl[(tid >> 3) * 65 + (tid & 7) * 8 + q] = ZPc[tid * 8 + q]; }
    f32x16 acc, zn;
#pragma unroll
    for (int r = 0; r < 16; ++r) { zn[r] = 0.f; acc[r] = 0.f; }
    if (wv < 4) {
#pragma unroll
        for (int r = 0; r < 16; ++r) zn[r] = ZPc[(size_t)2 * 4096 + (32 * ti + (r & 3) + 8 * (r >> 2) + 4 * lh) * 64 + 32 * tj + li]; }
    for (int g = 1; g < NSEG - 1; ++g) {
        __syncthreads();
        if (g > 1 && wv < 4) {
#pragma unroll
            for (int r = 0; r < 16; ++r) Sl[(32 * ti + (r & 3) + 8 * (r >> 2) + 4 * lh) * 65 + 32 * tj + li] = acc[r]; }
#pragma unroll
        for (int q = 0; q < 8; ++q) Pl[tid * 8 + q] = pn[q];
        acc = zn;
        if (g + 1 < NSEG - 1) { const float* nx = ZPc + (size_t)(g + 1) * 2 * 4096;
#pragma unroll
            for (int q = 0; q < 8; ++q) pn[q] = nx[4096 + tid * 8 + q];
            if (wv < 4) {
#pragma unroll
                for (int r = 0; r < 16; ++r) zn[r] = nx[(32 * ti + (r & 3) + 8 * (r >> 2) + 4 * lh) * 64 + 32 * tj + li]; } }
        __syncthreads();
        if (wv < 4) {
#pragma unroll 8
            for (int k0 = 0; k0 < 64; k0 += 2) { const float av = Sl[(32 * ti + li) * 65 + k0 + lh], bv = Pl[(k0 + lh) * 64 + 32 * tj + li];
                acc = __builtin_amdgcn_mfma_f32_32x32x2f32(av, bv, acc, 0, 0, 0); }
            float* Zg = ZPc + (size_t)g * 2 * 4096;
#pragma unroll
            for (int r = 0; r < 16; ++r) Zg[(32 * ti + (r & 3) + 8 * (r >> 2) + 4 * lh) * 64 + 32 * tj + li] = acc[r]; }
    }
    __syncthreads();
}

__device__ __forceinline__ void rwkv_out_fin(const Params& P, int row, int c, float y, float lnw, float lnb, float bon, float vs, float gt) {
    bf16_t* MIX = (bf16_t*)(P.ws + WS_U);
    const float mean = wsum(y) * (1.0f / 64.0f); const float dv = y - mean; const float var = wsum(dv * dv) * (1.0f / 64.0f);
    const float yn = dv * rsqrtf(var + 64e-5f) * lnw + lnb;
    MIX[(size_t)row * D + 256 + c] = f2bf((yn + bon * vs) * gt);
}
__device__ __forceinline__ void ph_rwkvout(const Params& P, int l, float* ldsf) {
    using pg8::bf16x8;
    const int tid = otid(), lane = tid & 63, fr = lane & 15, fq = lane >> 4, wv = tid >> 6, gw = blockIdx.x * NWAVE + wv, nw = gridDim.x * NWAVE;
    const float* YD = (const float*)(P.ws + WS_YDIR); const bf16_t* VS = (const bf16_t*)(P.ws + WS_VS); const bf16_t* GT = (const bf16_t*)(P.ws + WS_GATE); const float* BON = (const float*)(P.ws + WS_BONUS);
    bf16_t* MIX = (bf16_t*)(P.ws + WS_U);
    for (int it = gw; it < NB * 6 * 32 * 4; it += nw) {
        const int sub = it & 3, q = (it >> 2) & 31, h = (it >> 7) % 6, b = it / (128 * 6);
        const int t0 = q * 256 + sub * 64;
        f32x4 acc[4][4];
#pragma unroll
        for (int mt = 0; mt < 4; ++mt)
#pragma unroll
            for (int nt = 0; nt < 4; ++nt) acc[mt][nt] = (f32x4){0.f, 0.f, 0.f, 0.f};
#pragma unroll
        for (int dir = 0; dir < 2; ++dir) { const int ch = b * 12 + h * 2 + dir, slot = dir ? (31 - q) : q;
            const float* Sp = (const float*)(P.ws + WS_ZP) + ((size_t)ch * NSEG + slot) * 2 * 4096;
            const bf16_t* Ep = (const bf16_t*)(P.ws + WS_E) + ((size_t)ch * SEQ + t0) * 64;
#pragma unroll
            for (int ks = 0; ks < 2; ++ks) { bf16x8 bop[4];
#pragma unroll
                for (int nt = 0; nt < 4; ++nt) { const float* sp = Sp + (nt * 16 + fr) * 64 + ks * 32 + fq * 8; const float4 s0 = *(const float4*)sp, s1 = *(const float4*)(sp + 4);
                    u32x4 w; w.x = cvt_pk_bf16(s0.x, s0.y); w.y = cvt_pk_bf16(s0.z, s0.w); w.z = cvt_pk_bf16(s1.x, s1.y); w.w = cvt_pk_bf16(s1.z, s1.w); bop[nt] = __builtin_bit_cast(bf16x8, w); }
#pragma unroll
                for (int mt = 0; mt < 4; ++mt) { const bf16x8 a = *(const bf16x8*)(Ep + (size_t)(mt * 16 + fr) * 64 + ks * 32 + fq * 8);
#pragma unroll
                    for (int nt = 0; nt < 4; ++nt) acc[mt][nt] = __builtin_amdgcn_mfma_f32_16x16x32_bf16(a, bop[nt], acc[mt][nt], 0, 0, 0); } } }
        float lnw[4], lnb[4];
#pragma unroll
        for (int nt = 0; nt < 4; ++nt) { lnw[nt] = P.in[I_LNW][l * RWW + h * 64 + nt * 16 + fr]; lnb[nt] = P.in[I_LNB][l * RWW + h * 64 + nt * 16 + fr]; }
#pragma unroll
        for (int mt = 0; mt < 4; ++mt)
#pragma unroll
            for (int rg = 0; rg < 4; ++rg) { const int row = b * SEQ + t0 + mt * 16 + fq * 4 + rg; const size_t o = (size_t)row * 384 + h * 64 + fr;
                float y[4], vs[4], gt[4]; const float bon = BON[(size_t)row * 6 + h];
#pragma unroll
                for (int nt = 0; nt < 4; ++nt) { y[nt] = YD[o + nt * 16] + YD[(size_t)T * 384 + o + nt * 16] + acc[mt][nt][rg]; vs[nt] = bf2f(VS[o + nt * 16]); gt[nt] = bf2f(GT[o + nt * 16]); }
                float sm = (y[0] + y[1]) + (y[2] + y[3]);
                sm += __shfl_xor(sm, 1); sm += __shfl_xor(sm, 2); sm += __shfl_xor(sm, 4); sm += __shfl_xor(sm, 8);
                const float mean = sm * (1.0f / 64.0f);
                float vr = 0.f;
#pragma unroll
                for (int nt = 0; nt < 4; ++nt) { y[nt] -= mean; vr += y[nt] * y[nt]; }
                vr += __shfl_xor(vr, 1); vr += __shfl_xor(vr, 2); vr += __shfl_xor(vr, 4); vr += __shfl_xor(vr, 8);
                const float rstd = rsqrtf(vr * (1.0f / 64.0f) + 64e-5f);
#pragma unroll
                for (int nt = 0; nt < 4; ++nt) MIX[(size_t)row * D + 256 + h * 64 + nt * 16 + fr] = f2bf((y[nt] * rstd * lnw[nt] + lnb[nt] + bon * vs[nt]) * gt[nt]);
                if (rg & 1) asm volatile("" ::: "memory"); }
    }
    for (int it = gw; it < TC * 6; it += nw) { const int row = TL + it / 6, h = it % 6, c = h * 64 + lane; const size_t o = (size_t)row * 384 + c;
        rwkv_out_fin(P, row, c, YD[o] + YD[(size_t)T * 384 + o], P.in[I_LNW][l * RWW + c], P.in[I_LNB][l * RWW + c], BON[(size_t)row * 6 + h], bf2f(VS[o]), bf2f(GT[o])); }
}

__device__ __forceinline__ void zt_tile(const Params& P, int tile, float* tl  ) {
    const int tid = otid(); const int c0 = (tile & 3) * 64, t0 = (tile >> 2) * 64;
    const float* Z = (const float*)(P.ws + WS_Z1); bf16_t* MIX = (bf16_t*)(P.ws + WS_U);
    { const int cc = tid >> 3, sg = (tid & 7) * 8; const float* src = Z + (size_t)(c0 + cc) * TL + t0 + sg; const float4 a = *(const float4*)src, b = *(const float4*)(src + 4);
      tl[cc * 65 + sg + 0] = a.x; tl[cc * 65 + sg + 1] = a.y; tl[cc * 65 + sg + 2] = a.z; tl[cc * 65 + sg + 3] = a.w; tl[cc * 65 + sg + 4] = b.x; tl[cc * 65 + sg + 5] = b.y; tl[cc * 65 + sg + 6] = b.z; tl[cc * 65 + sg + 7] = b.w; }
    __syncthreads();
    { const int tk = tid >> 3, cs = (tid & 7) * 8;
      u32x4 w; w.x = cvt_pk_bf16(tl[(cs + 0) * 65 + tk], tl[(cs + 1) * 65 + tk]); w.y = cvt_pk_bf16(tl[(cs + 2) * 65 + tk], tl[(cs + 3) * 65 + tk]);
      w.z = cvt_pk_bf16(tl[(cs + 4) * 65 + tk], tl[(cs + 5) * 65 + tk]); w.w = cvt_pk_bf16(tl[(cs + 6) * 65 + tk], tl[(cs + 7) * 65 + tk]);
      *(u32x4*)(MIX + (size_t)(t0 + tk) * D + c0 + cs) = w; }
    __syncthreads();
}
typedef const __attribute__((address_space(4))) Params* KParamsPtr;
__device__ __forceinline__ const Params* fresh_params() { KParamsPtr q = (KParamsPtr)__builtin_amdgcn_kernarg_segment_ptr(); asm volatile("" : "+s"(q)); return (const Params*)q; }
__global__ void __launch_bounds__(NTHR, 2) fwd_megakernel(Params P_unused, int ph_lo, int ph_hi) {
    extern __shared__ __attribute__((aligned(16))) unsigned char smem[];
    cg::grid_group grid = cg::this_grid();
    LAS unsigned char* lds3 = (LAS unsigned char*)smem;
    float* ldsf = (float*)smem; float2* X = (float2*)smem; float* ex = (float*)(smem + LDS_MAIN);
    { volatile LAS unsigned* st = (volatile LAS unsigned*)(lds3 + LDS_MAIN + 4096); if (threadIdx.x == 0) { st[0] = 0u; st[1] = 0u; } }
    __syncthreads();
    XcdBarrier xbar = xcd_barrier_post((unsigned*)(((const Params*)fresh_params())->ws + WS_BAR), (volatile LAS unsigned*)(lds3 + LDS_MAIN + 4096));
    int ph = 0;
#ifndef REP_GEMM
#define REP_GEMM 1
#endif
#ifndef REP_SCAN
#define REP_SCAN 1
#endif
#ifndef REP_MISC
#define REP_MISC 1
#endif
#ifndef REP_HY
#define REP_HY 1
#endif
#define PHASE_BEGIN if (ph >= ph_lo && ph < ph_hi) { const Params& P = *fresh_params(); unsigned char* ws = P.ws; (void)ws;
#ifndef REP_SYNC
#define REP_SYNC 1
#endif
#define PHASE_END   if (ph + 1 < ph_hi) { for (int rs_ = 0; rs_ < REP_SYNC; ++rs_) { if (ph == 0) grid.sync(); else xcd_barrier(xbar); } } } ++ph;
    PHASE_BEGIN ph_modv(P, ldsf); PHASE_END
    for (int l = 0; l < DEPTH; ++l) {
        PHASE_BEGIN
            for (int rep_ = 0; rep_ < REP_MISC; ++rep_) ph_prep(P, l, ldsf);
            if (l == 0) ph_rowpass(P, 0, 0, 0, 0, 0.f, 0, 0, 0, 1, 1);
            else ph_rowpass(P, 1, l - 1, 8, 5, 0.5f, l, 0, 0, 1, 11);
        PHASE_END
        PHASE_BEGIN { EpiGU E{(bf16_t*)(ws + WS_ACT)}; for (int rep_ = 0; rep_ < REP_GEMM; ++rep_) run_gemm(lds3, (const bf16_t*)(ws + WS_U), (const bf16_t*)(ws + WS_WGU1), T, 2 * DFF, D, E); } PHASE_END
        PHASE_BEGIN { EpiF32 E{(bf16_t*)(ws + WS_Y), (float*)(ws + WS_YC)}; run_gemm_tail(lds3, (const bf16_t*)(ws + WS_ACT), (const bf16_t*)(ws + WS_WDN1), DFF, E); } PHASE_END
        PHASE_BEGIN ph_rowpass(P, 1, l, 2, 1, 0.5f, l, 2, 3, 4, 11); PHASE_END
        PHASE_BEGIN { EpiWin E{(bf16_t*)(ws + WS_PHY), (bf16_t*)(ws + WS_PRW), (bf16_t*)(ws + WS_PNA)}; for (int rep_ = 0; rep_ < REP_GEMM; ++rep_) run_gemm(lds3, (const bf16_t*)(ws + WS_U), (const bf16_t*)(ws + WS_WIN), T, INWP, D, E); } PHASE_END
        PHASE_BEGIN
            for (int rep_ = 0; rep_ < REP_MISC; ++rep_) { ph_loraprep(P, l);
            for (int it = blockIdx.x; it < NB * 128 * 6 + NB * 4 * 6; it += gridDim.x) vt_tile(P, it, (unsigned short*)smem); }
            for (int rep_ = 0; rep_ < REP_HY; ++rep_) for (int it = blockIdx.x; it < 256; it += gridDim.x) hy_spec_task(P, l, it, X);
        PHASE_END
        PHASE_BEGIN { EpiLora E{(bf16_t*)(ws + WS_LORAO), (bf16_t*)(ws + WS_GATE)};
            for (int rep_ = 0; rep_ < REP_GEMM; ++rep_) run_gemm(lds3, (const bf16_t*)(ws + WS_ALORA), (const bf16_t*)(ws + WS_WLORA), T, 2048, 384, E); } PHASE_END
        PHASE_BEGIN
            for (int rep_ = 0; rep_ < REP_MISC; ++rep_) ph_rwkvprep(P, l);
            for (int rep_ = 0; rep_ < REP_HY; ++rep_) for (int c = blockIdx.x; c < HYC; c += gridDim.x) hy_task1(P, l, c, X, ex);
        PHASE_END
        PHASE_BEGIN {
            const int wv = __builtin_amdgcn_readfirstlane(otid() >> 6);
            if (wv < 4) { const int k = wv * (int)gridDim.x + (int)blockIdx.x;
                if (k < 24 * NSEG) { const int chain = k / NSEG, g = k % NSEG; float* ring = ldsf + wv * (SCH * 320);
                    __builtin_amdgcn_s_setprio(3);
                    for (int rep_ = 0; rep_ < REP_SCAN; ++rep_) { if (g == 0) scan_seg<false>(P, chain, g, ring); else scan_seg<true>(P, chain, g, ring); }
                    __builtin_amdgcn_s_setprio(0); } }
            else for (int it = (wv - 4) * (int)gridDim.x + (int)blockIdx.x; it < NAT_TASKS; it += 4 * (int)gridDim.x) natten_task(P, l, it);
        } PHASE_END
        PHASE_BEGIN
            for (int rep_ = 0; rep_ < REP_HY; ++rep_) for (int c = blockIdx.x; c < HYC; c += gridDim.x) hy_task2(P, l, c, X);
            if (blockIdx.x >= gridDim.x - 24) scan_combine(P, (int)(gridDim.x - 1 - blockIdx.x), ldsf);
        PHASE_END
        PHASE_BEGIN for (int rep_ = 0; rep_ < REP_MISC; ++rep_) ph_rwkvout(P, l, ldsf);
            __syncthreads();
            for (int it = blockIdx.x; it < 4 * (TL / 64); it += gridDim.x) zt_tile(P, it, ldsf);
        PHASE_END
        PHASE_BEGIN { EpiF32 E{(bf16_t*)(ws + WS_Y), (float*)(ws + WS_YC)}; run_gemm_tail(lds3, (const bf16_t*)(ws + WS_U), (const bf16_t*)(ws + WS_WOUT), D, E); } PHASE_END
        PHASE_BEGIN ph_rowpass(P, 1, l, 5, 3, 1.0f, l, 4, 6, 7, 4); PHASE_END
        PHASE_BEGIN { EpiGU E{(bf16_t*)(ws + WS_ACT)}; for (int rep_ = 0; rep_ < REP_GEMM; ++rep_) run_gemm(lds3, (const bf16_t*)(ws + WS_U), (const bf16_t*)(ws + WS_WGU2), T, 2 * DFF, D, E); } PHASE_END
        PHASE_BEGIN { EpiF32 E{(bf16_t*)(ws + WS_Y), (float*)(ws + WS_YC)}; run_gemm_tail(lds3, (const bf16_t*)(ws + WS_ACT), (const bf16_t*)(ws + WS_WDN2), DFF, E); } PHASE_END
    }
    PHASE_BEGIN ph_rowpass(P, 2, DEPTH - 1, 8, 5, 0.5f, 0, 0, 0, 0, 11); PHASE_END
#undef PHASE_BEGIN
#undef PHASE_END
}
constexpr int N_PHASES = 1 + DEPTH * 15 + 1;

extern "C" void kernel_launch(void* const* d_in, const int* in_sizes, int n_in, void* d_out, int out_size, void* d_ws, size_t ws_size, hipStream_t stream) {
    static int grid = 0;
    if (grid == 0) {
        if (n_in != 34 || ws_size < WS_END) { fprintf(stderr, "kernel_launch: need 34 inputs and %zu bytes of workspace; got %d, %zu\n", (size_t)WS_END, n_in, ws_size); grid = -1; return; }
        int dev = 0, cus = 0, per_cu = 0;
        hipGetDevice(&dev); hipDeviceGetAttribute(&cus, hipDeviceAttributeMultiprocessorCount, dev);
        if (hipFuncSetAttribute((const void*)fwd_megakernel, hipFuncAttributeMaxDynamicSharedMemorySize, LDS_BYTES) != hipSuccess) { fprintf(stderr, "kernel_launch: hipFuncSetAttribute failed\n"); grid = -1; return; }
        if (hipOccupancyMaxActiveBlocksPerMultiprocessor(&per_cu, (const void*)fwd_megakernel, NTHR, LDS_BYTES) != hipSuccess || per_cu < 1) { fprintf(stderr, "kernel_launch: occupancy query says %d\n", per_cu); per_cu = 1; }
        (void)hipGetLastError();
        grid = cus;
    }
    if (grid < 0) return;
    if (hipMemsetAsync((char*)d_ws + WS_BAR, 0, (size_t)XCD_BAR_WORDS * 4, stream) != hipSuccess) { fprintf(stderr, "kernel_launch: memset of the barrier words failed\n"); return; }
    Params p{};
    for (int i = 0; i < 34; ++i) p.in[i] = (const float*)d_in[i];
    p.out = (float*)d_out; p.ws = (unsigned char*)d_ws;
#if MK_SPLIT
    for (int ph = 0; ph < N_PHASES; ++ph) { int lo = ph, hi = ph + 1; hipLaunchKernelGGL(fwd_megakernel, dim3(grid), dim3(NTHR), LDS_BYTES, stream, p, lo, hi); }
#else
    int lo = 0, hi = N_PHASES;
    void* args[] = {&p, &lo, &hi};
    hipError_t e = hipLaunchCooperativeKernel((const void*)fwd_megakernel, dim3(grid), dim3(NTHR), args, LDS_BYTES, stream);
    if (e != hipSuccess) fprintf(stderr, "cooperative launch failed: %s (grid %d)\n", hipGetErrorString(e), grid);
#endif
}
```

```cpp
#include <hip/hip_runtime.h>
#include <hip/hip_cooperative_groups.h>
#include <cstdio>
namespace cg = cooperative_groups;
__device__ __forceinline__ int otid() { int t = threadIdx.x; asm volatile("" : "+v"(t)); return t; }
namespace pg8 {
#define PG8_LAS __attribute__((address_space(3)))
typedef unsigned short bf16_t;
typedef short bf16x8 __attribute__((ext_vector_type(8)));
typedef float f32x4 __attribute__((ext_vector_type(4)));
typedef unsigned u32x4 __attribute__((ext_vector_type(4)));
constexpr int BM = 256, BK = 64, HALF = 128, HTB = HALF * BK * 2  , STAGE_BYTES = 8 * HTB, NXCD = 8, WGM = 8;

__host__ __device__ __forceinline__ int lds_byte(int r, int c) { const int st = (r >> 4) * 2 + (c >> 5), rr = r & 15, cc = c & 31, ob = rr * 64 + cc * 2; return st * 1024 + (ob ^ (((ob >> 9) & 1) << 5)); }
__host__ __device__ __forceinline__ void stage_rc(int b, int& R, int& C) { const int st = b / 1024, sb = b % 1024, swz = sb ^ (((sb >> 9) & 1) << 5); R = (st >> 1) * 16 + swz / 64; C = (st & 1) * 32 + (swz % 64) / 2; }
__host__ __device__ __forceinline__ int perm32(int rho) { const int n = rho >> 4, i = rho & 15; return 8 * (i >> 2) + 4 * n + (i & 3); }

struct Unit { int pm, pn, kt0, nkt; };
struct Gemm { const bf16_t* A; const bf16_t* Bt; int M, N, K; };
struct StaticOrder {
    int nM, nN, nwg, G, c;
    __host__ __device__ void init(int M, int N, int G_, int c_) { nM = M / BM; nN = N / BM; nwg = nM * nN; G = G_; c = c_; }
    __host__ __device__ bool next(int i, Unit& u) const {
        const long L = (long)i * G + c; if (L >= nwg) return false;
        int wgid = (int)L; { const int q = nwg / NXCD, r = nwg % NXCD, xcd = wgid % NXCD, off = wgid / NXCD; wgid = (xcd < r ? xcd * (q + 1) : r * (q + 1) + (xcd - r) * q) + off; }
        const int nig = WGM * nN, gid = wgid / nig, fm = gid * WGM, gsz = (nM - fm) < WGM ? (nM - fm) : WGM;
        u.pm = fm + ((wgid % nig) % gsz); u.pn = (wgid % nig) / gsz; u.kt0 = 0; u.nkt = 0; return true;
    }
    __device__ __forceinline__ void a_ready(const Unit&) const {}
    __device__ __forceinline__ void done(const Unit&) const {}
};
__device__ __forceinline__ unsigned cvt_pk_bf16(float lo, float hi) { unsigned r; asm volatile("v_cvt_pk_bf16_f32 %0, %1, %2" : "=v"(r) : "v"(lo), "v"(hi)); return r; }
template <class Epi, class Sched>
__device__ __forceinline__ void gemm_phase(PG8_LAS unsigned char* lds, const Gemm g, const Sched& S, const Epi& E) {
    const int tid = otid(), wid = __builtin_amdgcn_readfirstlane(tid >> 6), lane = tid & 63, wr = wid >> 2, wc = wid & 3, fr = lane & 15, fq = lane >> 4;
    const int K = g.K, nt = K / BK;
#define PG8_STAMP() do {} while (0)
    unsigned voffA[2], voffB[2];
#pragma unroll
    for (int i = 0; i < 2; ++i) { int R, C; stage_rc(tid * 16 + i * 8192, R, C); const int Rb = Epi::PERM ? ((R & ~31) + perm32(R & 31)) : R;
        voffA[i] = (unsigned)(R * K + C) * 2u; voffB[i] = (unsigned)(Rb * K + C) * 2u; }
    const size_t kstep = (size_t)(BK * 2);
    const size_t hstep = (size_t)HALF * K * 2;
    const size_t tstep = 2 * hstep;
    const unsigned ldsw = (unsigned)wid * 1024u;
    const int aoff = lds_byte(wr * 64 + fr, fq * 8), boff = lds_byte(wc * 32 + fr, fq * 8);
#define PG8_SA(b, h) (((b) * 2 + (h)) * HTB)
#define PG8_SB(b, h) ((4 + (b) * 2 + (h)) * HTB)
#define PG8_STAGE(bufoff, gbase, voff) do { _Pragma("unroll") for (int _i = 0; _i < 2; ++_i) \
        __builtin_amdgcn_global_load_lds((const unsigned*)((const char*)(gbase) + (voff)[_i]), (PG8_LAS unsigned*)(lds + (bufoff) + ldsw + _i * 8192), 16, 0, 0); } while (0)
#define PG8_LDA(dst, b, h) do { _Pragma("unroll") for (int m = 0; m < 4; ++m) _Pragma("unroll") for (int k = 0; k < 2; ++k) dst[m][k] = *(const PG8_LAS bf16x8*)(lds + PG8_SA(b, h) + aoff + m * 2048 + k * 1024); } while (0)
#define PG8_LDB(dst, b, h) do { _Pragma("unroll") for (int n = 0; n < 2; ++n) _Pragma("unroll") for (int k = 0; k < 2; ++k) dst[n][k] = *(const PG8_LAS bf16x8*)(lds + PG8_SB(b, h) + boff + n * 2048 + k * 1024); } while (0)
#define PG8_MMA(ai, bj, At, Bt) do { __builtin_amdgcn_s_setprio(1); _Pragma("unroll") for (int m = 0; m < 4; ++m) _Pragma("unroll") for (int n = 0; n < 2; ++n) _Pragma("unroll") for (int k = 0; k < 2; ++k) \
        acc[ai][bj][m][n] = __builtin_amdgcn_mfma_f32_16x16x32_bf16(Bt[n][k], At[m][k], acc[ai][bj][m][n], 0, 0, 0); __builtin_amdgcn_s_setprio(0); } while (0)
#define PG8_WAIT_V(n) asm volatile("s_waitcnt vmcnt(" #n ")" ::: "memory")
#define PG8_WAIT_L(n) asm volatile("s_waitcnt lgkmcnt(" #n ")" ::: "memory")
#define PG8_BAR __builtin_amdgcn_s_barrier()
#define PG8_SCHED __builtin_amdgcn_sched_barrier(0)
    Unit cur, nxt; int ui = 0;
    if (!S.next(0, cur)) return;
    f32x4 acc[2][2][4][2];
#pragma unroll
    for (int a = 0; a < 2; ++a)
#pragma unroll
        for (int b = 0; b < 2; ++b)
#pragma unroll
            for (int m = 0; m < 4; ++m)
#pragma unroll
                for (int n = 0; n < 2; ++n) acc[a][b][m][n] = (f32x4){0.f, 0.f, 0.f, 0.f};
    bf16x8 At[4][2], B0[2][2], B1[2][2];
    const char* cA = (const char*)g.A + (size_t)cur.pm * tstep + (size_t)cur.kt0 * kstep; const char* cB = (const char*)g.Bt + (size_t)cur.pn * tstep + (size_t)cur.kt0 * kstep;
    int ntc = cur.nkt > 0 ? cur.nkt : nt;
    S.a_ready(cur);
    PG8_STAGE(PG8_SB(0, 0), cB, voffB); PG8_STAGE(PG8_SA(0, 0), cA, voffA); PG8_STAGE(PG8_SB(0, 1), cB + hstep, voffB); PG8_STAGE(PG8_SA(0, 1), cA + hstep, voffA);
    if (wr == 1) PG8_BAR;
    PG8_WAIT_V(4); PG8_BAR;
    PG8_STAGE(PG8_SB(1, 0), cB + kstep, voffB); PG8_STAGE(PG8_SA(1, 0), cA + kstep, voffA); PG8_STAGE(PG8_SB(1, 1), cB + hstep + kstep, voffB);
    PG8_WAIT_V(6); PG8_BAR;
    PG8_STAMP();
    for (;;) {
        const bool has_next = S.next(ui + 1, nxt);
        const char* nA = has_next ? (const char*)g.A + (size_t)nxt.pm * tstep + (size_t)nxt.kt0 * kstep : cA; const char* nB = has_next ? (const char*)g.Bt + (size_t)nxt.pn * tstep + (size_t)nxt.kt0 * kstep : cB;
        for (int t = 0; t < ntc; t += 2) {
            const bool last = (t == ntc - 2);
            const char* a1 = cA + (size_t)(t + 1) * kstep;
            const char* a2 = last ? nA : cA + (size_t)(t + 2) * kstep; const char* b2 = last ? nB : cB + (size_t)(t + 2) * kstep;
            const char* a3 = a2 + kstep; const char* b3 = b2 + kstep;
            if (last && has_next) S.a_ready(nxt);
            PG8_LDB(B0, 0, 0); PG8_SCHED; PG8_LDA(At, 0, 0); PG8_STAGE(PG8_SA(1, 1), a1 + hstep, voffA);
            PG8_WAIT_L(8); PG8_BAR; PG8_WAIT_L(0); PG8_MMA(0, 0, At, B0); PG8_BAR; PG8_SCHED;
            PG8_LDB(B1, 0, 1); PG8_STAGE(PG8_SB(0, 0), b2, voffB);
            PG8_BAR; PG8_WAIT_L(0); PG8_MMA(0, 1, At, B1); PG8_BAR;
            PG8_LDA(At, 0, 1); PG8_STAGE(PG8_SA(0, 0), a2, voffA);
            PG8_BAR; PG8_WAIT_L(0); PG8_MMA(1, 0, At, B0); PG8_BAR; PG8_SCHED;
            PG8_STAGE(PG8_SB(0, 1), b2 + hstep, voffB);
            PG8_WAIT_V(6); PG8_BAR; PG8_MMA(1, 1, At, B1); PG8_BAR;
            PG8_LDB(B0, 1, 0); PG8_SCHED; PG8_LDA(At, 1, 0); PG8_STAGE(PG8_SA(0, 1), a2 + hstep, voffA);
            PG8_WAIT_L(8); PG8_BAR; PG8_WAIT_L(0); PG8_MMA(0, 0, At, B0); PG8_BAR; PG8_SCHED;
            PG8_LDB(B1, 1, 1); PG8_STAGE(PG8_SB(1, 0), b3, voffB);
            PG8_BAR; PG8_WAIT_L(0); PG8_MMA(0, 1, At, B1); PG8_BAR;
            PG8_LDA(At, 1, 1); PG8_STAGE(PG8_SA(1, 0), a3, voffA);
            PG8_BAR; PG8_WAIT_L(0); PG8_MMA(1, 0, At, B0); PG8_BAR; PG8_SCHED;
            PG8_STAGE(PG8_SB(1, 1), b3 + hstep, voffB);
            PG8_WAIT_V(6); PG8_BAR; PG8_MMA(1, 1, At, B1); PG8_BAR;
        }
        PG8_STAMP();
        if constexpr (!Epi::AFTER_DRAIN) { E(acc, cur, wr, wc, fr, fq); S.done(cur); }
        PG8_STAMP();
        if (!has_next) break;
#pragma unroll
        for (int a = 0; a < 2; ++a)
#pragma unroll
            for (int b = 0; b < 2; ++b)
#pragma unroll
                for (int m = 0; m < 4; ++m)
#pragma unroll
                    for (int n = 0; n < 2; ++n) acc[a][b][m][n] = (f32x4){0.f, 0.f, 0.f, 0.f};
        cur = nxt; cA = nA; cB = nB; ++ui; ntc = cur.nkt > 0 ? cur.nkt : nt;
    }
    PG8_WAIT_V(0);
    if (wr == 0) PG8_BAR;
    PG8_BAR;
    if constexpr (Epi::AFTER_DRAIN) { E.fused(acc, cur, wr, wc, fr, fq, lds, wid, lane); S.done(cur); }
    PG8_STAMP();
#undef PG8_STAMP
#undef PG8_SA
#undef PG8_SB
#undef PG8_STAGE
#undef PG8_LDA
#undef PG8_LDB
#undef PG8_MMA
#undef PG8_WAIT_V
#undef PG8_WAIT_L
#undef PG8_BAR
#undef PG8_SCHED
}
}
#define LAS __attribute__((address_space(3)))
#define XB_TMO      128
#define XB_XCNT(j)  (256  + 64 * (j))
#define XB_XSUB(j)  (1280 + 64 * (j))
#define XB_XGEN(j)  (2304 + 64 * (j))
#define XB_TOP      3328
#define XB_TOPGEN   3392
#define XCD_BAR_WORDS 3456
#define XB_SPIN_CAP (1u << 18)

__device__ __forceinline__ unsigned xb_ld(unsigned* p)              { return __hip_atomic_load(p, __ATOMIC_RELAXED, __HIP_MEMORY_SCOPE_AGENT); }
__device__ __forceinline__ unsigned xb_add(unsigned* p, unsigned v) { return __hip_atomic_fetch_add(p, v, __ATOMIC_RELAXED, __HIP_MEMORY_SCOPE_AGENT); }
__device__ __forceinline__ unsigned xb_xcc_id() { return (unsigned)__builtin_amdgcn_s_getreg((3 << 11) | 20) & 0xFu; }
#define XB_SPIN(cond, bar) do { unsigned _sp = 0; while (cond) { __builtin_amdgcn_s_sleep(1); \
    if ((++_sp & 255u) == 0u) { if (xb_ld(&(bar)[XB_TMO])) break; if (_sp > XB_SPIN_CAP) { atomicAdd(&(bar)[XB_TMO], 1u); break; } } } } while (0)

struct XcdBarrier {
    unsigned* bar; unsigned x;
    volatile LAS unsigned* st;
};

__device__ __forceinline__ XcdBarrier xcd_barrier_post(unsigned* bar, volatile LAS unsigned* st) {
    XcdBarrier b; b.bar = bar; b.x = xb_xcc_id(); b.st = st;
    if (threadIdx.x == 0) (void)xb_add(&bar[XB_XCNT(b.x)], 1u);
    return b;
}
__device__ __forceinline__ void xcd_barrier_complete(unsigned* bar, unsigned x, unsigned& nloc, unsigned& nx) {
    const unsigned G = gridDim.x * gridDim.y * gridDim.z;
    unsigned sum, cnt, mine, sp = 0u;
    for (;;) {
        sum = 0u; cnt = 0u; mine = 0u;
#pragma unroll
        for (unsigned j = 0; j < 16; ++j) { const unsigned c = xb_ld(&bar[XB_XCNT(j)]); sum += c; cnt += (c > 0u) ? 1u : 0u; mine = (j == x) ? c : mine; }
        if (sum == G) break;
        __builtin_amdgcn_s_sleep(1);
        if ((++sp & 255u) == 0u) { if (xb_ld(&bar[XB_TMO])) break; if (sp > XB_SPIN_CAP) { atomicAdd(&bar[XB_TMO], 1u); break; } }
    }
    nloc = mine > 0u ? mine : 1u; nx = cnt > 0u ? cnt : 1u;
}

__device__ __forceinline__ void xcd_barrier(const XcdBarrier& b) {
    asm volatile("s_waitcnt vmcnt(0)" ::: "memory");
    __syncthreads();
    if (threadIdx.x == 0) {
        unsigned* bar = b.bar;
        __builtin_amdgcn_s_waitcnt(0);
        unsigned nloc = b.st[0], nx = b.st[1];
        if (nloc == 0u) { xcd_barrier_complete(bar, b.x, nloc, nx); b.st[0] = nloc; b.st[1] = nx; }
        const unsigned old = xb_add(&bar[XB_XSUB(b.x)], 1u);
        const unsigned gen = old / nloc;
        if (old + 1u == (gen + 1u) * nloc) {
            __builtin_amdgcn_fence(__ATOMIC_RELEASE, "agent");
            asm volatile("s_waitcnt vmcnt(0)" ::: "memory");
            const unsigned og = xb_add(&bar[XB_TOP], 1u);
            const unsigned tg = og / nx;
            if (og + 1u == (tg + 1u) * nx) xb_add(&bar[XB_TOPGEN], 1u);
            else XB_SPIN(xb_ld(&bar[XB_TOPGEN]) == tg, bar);
            __builtin_amdgcn_fence(__ATOMIC_ACQUIRE, "agent");
            xb_add(&bar[XB_XGEN(b.x)], 1u);
            asm volatile("s_waitcnt vmcnt(0)" ::: "memory");
        } else {
            XB_SPIN(xb_ld(&bar[XB_XGEN(b.x)]) == gen, bar);
            __builtin_amdgcn_fence(__ATOMIC_ACQUIRE, "agent");
            asm volatile("s_waitcnt vmcnt(0)" ::: "memory");
        }
    }
    __syncthreads();
}

using pg8::bf16_t; using pg8::f32x4; using pg8::u32x4; using pg8::cvt_pk_bf16;
typedef unsigned u32x2 __attribute__((ext_vector_type(2)));


constexpr int D = 1024, NB = 2, SEQ = 8192, DEPTH = 4, CTX = 256, DFF = 2816;
constexpr int TL = NB * SEQ, TC = NB * CTX, T = TL + TC;
constexpr int NMOD = 9 * D;
constexpr int HYC = 256, RWW = 384, NAW = 384, INW = 3456, INWP = 3584;
constexpr int HY_IN = 768, RW_IN = 1536, NA_IN = 1152;
constexpr int NFFT = 16384;
constexpr int NTHR = 512, NWAVE = 8;
constexpr int LDS_MAIN = 131072, LDS_EXTRA = 8192, LDS_BYTES = LDS_MAIN + LDS_EXTRA;
constexpr float NORM_EPS = 1e-6f;

constexpr size_t al256(size_t x) { return (x + 255) & ~(size_t)255; }
constexpr size_t WS_MODV = 0;
constexpr size_t WS_WGU1 = al256(WS_MODV + (size_t)DEPTH * 3 * NMOD * 4);
constexpr size_t WS_WDN1 = WS_WGU1 + (size_t)2 * DFF * D * 2;
constexpr size_t WS_WGU2 = WS_WDN1 + (size_t)D * DFF * 2;
constexpr size_t WS_WDN2 = WS_WGU2 + (size_t)2 * DFF * D * 2;
constexpr size_t WS_WIN = WS_WDN2 + (size_t)D * DFF * 2;
constexpr size_t WS_WOUT = WS_WIN + (size_t)INWP * D * 2;
constexpr size_t WS_WLORA = WS_WOUT + (size_t)D * D * 2;
constexpr size_t WS_H = WS_WLORA + (size_t)2048 * 384 * 2;
constexpr size_t WS_U = WS_H + (size_t)T * D * 4;
constexpr size_t WS_S = WS_U + (size_t)T * D * 2;
constexpr size_t WS_Y = WS_S;
constexpr size_t WS_ACT = WS_Y + (size_t)T * D * 4;
constexpr size_t WS_FFN_END = WS_ACT + (size_t)T * DFF * 2;
constexpr size_t WS_PHY = WS_S;
constexpr size_t WS_PRW = WS_PHY + (size_t)T * HY_IN * 2;
constexpr size_t WS_YDIR = WS_PRW;
constexpr size_t WS_PNA = WS_PRW + (size_t)T * RW_IN * 2;
constexpr size_t WS_ALORA = WS_PNA + (size_t)T * NA_IN * 2;
constexpr size_t WS_DECAY = WS_ALORA + (size_t)T * 384 * 2;
constexpr size_t WS_LORAO = WS_DECAY + (size_t)2 * T * 384 * 4;
constexpr size_t WS_E = WS_LORAO;
constexpr size_t WS_ZP = WS_E + (size_t)24 * SEQ * 64 * 2;
constexpr size_t WS_GATE = WS_LORAO + (size_t)T * 1536 * 2;
static_assert(WS_ZP + (size_t)24 * 33 * 2 * 4096 * 4 <= WS_GATE, "E + ZP must fit in the LORAO region");
constexpr size_t WS_RS = WS_GATE + (size_t)T * 384 * 2;
constexpr size_t WS_KKS = WS_RS + (size_t)T * 384 * 2;
constexpr size_t WS_VS = WS_KKS + (size_t)T * 384 * 2;
constexpr size_t WS_KS = WS_VS + (size_t)T * 384 * 2;
constexpr size_t WS_BS = WS_KS + (size_t)2 * T * 384 * 2;
constexpr size_t WS_BONUS = WS_BS + (size_t)2 * T * 384 * 2;
constexpr size_t WS_FILT = al256(WS_BONUS + (size_t)T * 6 * 4);
constexpr size_t WS_FILTC = WS_FILT + (size_t)1024 * SEQ * 2;
constexpr size_t WS_SPEC = WS_FILTC + (size_t)1024 * CTX * 2;
constexpr size_t WS_Z1 = WS_SPEC + (size_t)512 * NFFT * 8;
constexpr size_t WS_VTL = WS_Z1 + (size_t)HYC * NB * SEQ * 4;
constexpr size_t WS_VTC = WS_VTL + (size_t)NB * 6 * 64 * SEQ * 2;
constexpr size_t WS_MIX_END = WS_VTC + (size_t)NB * 6 * 64 * CTX * 2;
constexpr size_t WS_BAR = al256(WS_MIX_END > WS_FFN_END ? WS_MIX_END : WS_FFN_END);
constexpr size_t WS_ROPE = al256(WS_BAR + (size_t)XCD_BAR_WORDS * 4);
constexpr size_t WS_YC = WS_FFN_END + (size_t)(8 << 20);
static_assert(WS_YC + (size_t)11 * TC * D * 4 <= WS_FILT, "YC partials must stay below the filter tables");
constexpr size_t WS_END = WS_ROPE + (size_t)128 * 16 * 8;
static_assert(WS_END <= (size_t)4 * DEPTH * D * NMOD * 4, "workspace map exceeds 4x the largest input tensor");

struct Params { const float* in[34]; float* out; unsigned char* ws; };
enum { I_X = 0, I_C, I_CTX, I_CCTX, I_MODW, I_MODB, I_NORMG, I_F1GU, I_F1DN, I_F2GU, I_F2DN, I_WIN, I_WOUT, I_HCW, I_HCB, I_HW1, I_HB1, I_HW2, I_HB2, I_HW3, I_HFREQ, I_HBIAS,
       I_MU, I_W0, I_W2, I_A0, I_A2, I_G2, I_KK, I_KA, I_RK, I_LNW, I_LNB, I_RPB };

typedef LAS float* ldsfp;
__device__ __forceinline__ ldsfp vlds(const void* p) { ldsfp q = (ldsfp)p; asm volatile("" : "+v"(q)); return q; }
__device__ __forceinline__ float bf2f(bf16_t b) { return __uint_as_float(((unsigned)b) << 16); }
__device__ __forceinline__ bf16_t f2bf(float f) { unsigned u = __float_as_uint(f); u += 0x7FFFu + ((u >> 16) & 1u); return (bf16_t)(u >> 16); }
__device__ __forceinline__ float lo_bf(unsigned w) { return __uint_as_float(w << 16); }
__device__ __forceinline__ float hi_bf(unsigned w) { return __uint_as_float(w & 0xffff0000u); }
__device__ __forceinline__ float wsum(float v) {
#pragma unroll
    for (int o = 32; o > 0; o >>= 1) v += __shfl_xor(v, o);
    return v;
}
__device__ __forceinline__ float sigmoidf_(float x) { return __builtin_amdgcn_rcpf(1.0f + __expf(-x)); }
__device__ __forceinline__ void unpack8(const u32x4 w, float (&f)[8]) {
    f[0] = lo_bf(w.x); f[1] = hi_bf(w.x); f[2] = lo_bf(w.y); f[3] = hi_bf(w.y); f[4] = lo_bf(w.z); f[5] = hi_bf(w.z); f[6] = lo_bf(w.w); f[7] = hi_bf(w.w);
}
__device__ __forceinline__ void row_nbrs(int row, bool& hasp, bool& hasn) {
    if (row < TL) { const int t = row & (SEQ - 1); hasp = t > 0; hasn = t < SEQ - 1; }
    else { const int t = (row - TL) & (CTX - 1); hasp = t > 0; hasn = t < CTX - 1; }
}

__device__ __forceinline__ void ph_modv(const Params& P, float* lds) {
    const int tid = otid();
    float* sv = lds;
    float* red = lds + 3072;
    for (int i = tid; i < 3072; i += NTHR) { const int s = i >> 10, k = i & 1023; const float c = s < 2 ? P.in[I_C][s * 1024 + k] : P.in[I_CCTX][k]; sv[i] = c / (1.0f + expf(-c)); }
    __syncthreads();
    if (blockIdx.x < 4) { const int e = blockIdx.x * NTHR + tid, pos = e >> 4, f = e & 15; float sn, cs; sincosf((float)pos * expf(-(float)f * (9.210340371976184f / 16.0f)), &sn, &cs); ((float2*)(P.ws + WS_ROPE))[e] = make_float2(cs, sn); }
    float* modv = (float*)(P.ws + WS_MODV);
    const int kc = tid >> 6, cl = tid & 63;
    for (int item = blockIdx.x; item < DEPTH * 144; item += gridDim.x) {
        const int l = item / 144, cb = item % 144, col = cb * 64 + cl;
        const float* w = P.in[I_MODW] + ((size_t)l * 1024 + kc * 128) * NMOD + col;
        float a0 = 0.f, a1 = 0.f, a2 = 0.f;
#pragma unroll 8
        for (int k = 0; k < 128; ++k) { const float wv = w[(size_t)k * NMOD]; a0 += sv[kc * 128 + k] * wv; a1 += sv[1024 + kc * 128 + k] * wv; a2 += sv[2048 + kc * 128 + k] * wv; }
        red[(0 * 8 + kc) * 64 + cl] = a0; red[(1 * 8 + kc) * 64 + cl] = a1; red[(2 * 8 + kc) * 64 + cl] = a2;
        __syncthreads();
        if (tid < 192) { const int s = tid >> 6, c = tid & 63; float r = P.in[I_MODB][l * NMOD + cb * 64 + c];
#pragma unroll
            for (int q = 0; q < 8; ++q) r += red[(s * 8 + q) * 64 + c];
            modv[((size_t)l * 3 + s) * NMOD + cb * 64 + c] = r; }
        __syncthreads();
    }
}

__device__ __forceinline__ float hy_delta(int c);
__device__ __forceinline__ int rowmap_gu(int n) { const int up = n >= DFF ? 1 : 0; const int j = n - up * DFF; return (j >> 7) * 256 + up * 128 + (j & 127); }
__device__ __forceinline__ void conv_tile(const float* __restrict__ src, int K, int N, bf16_t* __restrict__ dst, int tk, int tn, bool gu, float* tile) {
    const int tid = otid(); const int k0 = tk * 64, n0 = tn * 64;
#pragma unroll
    for (int rr = 0; rr < 2; ++rr) { const int kk = (tid >> 4) + rr * 32, n4 = (tid & 15) * 4; const float4 v = *(const float4*)(src + (size_t)(k0 + kk) * N + n0 + n4);
        tile[kk * 65 + n4 + 0] = v.x; tile[kk * 65 + n4 + 1] = v.y; tile[kk * 65 + n4 + 2] = v.z; tile[kk * 65 + n4 + 3] = v.w; }
    __syncthreads();
    { const int nn = tid >> 3, ks = (tid & 7) * 8; const int n = n0 + nn; const int row = gu ? rowmap_gu(n) : n;
      u32x4 w; w.x = cvt_pk_bf16(tile[(ks + 0) * 65 + nn], tile[(ks + 1) * 65 + nn]); w.y = cvt_pk_bf16(tile[(ks + 2) * 65 + nn], tile[(ks + 3) * 65 + nn]);
      w.z = cvt_pk_bf16(tile[(ks + 4) * 65 + nn], tile[(ks + 5) * 65 + nn]); w.w = cvt_pk_bf16(tile[(ks + 6) * 65 + nn], tile[(ks + 7) * 65 + nn]);
      *(u32x4*)(dst + (size_t)row * K + k0 + ks) = w; }
    __syncthreads();
}
__device__ __forceinline__ void ph_prep(const Params& P, int l, float* lds) {
    const int tid = otid();
    unsigned char* ws = P.ws;
    constexpr int N0 = 16 * 88, N1 = 44 * 16, N4 = 16 * 54, N5 = 16 * 16;
    constexpr int C0 = N0, C1 = C0 + N1, C2 = C1 + N0, C3 = C2 + N1, C4 = C3 + N4, C5 = C4 + N5;
    for (int it = blockIdx.x; it < C5; it += gridDim.x) {
        if (it < C0) { conv_tile(P.in[I_F1GU] + (size_t)l * D * 2 * DFF, D, 2 * DFF, (bf16_t*)(ws + WS_WGU1), it / 88, it % 88, true, lds); }
        else if (it < C1) { const int j = it - C0; conv_tile(P.in[I_F1DN] + (size_t)l * DFF * D, DFF, D, (bf16_t*)(ws + WS_WDN1), j / 16, j % 16, false, lds); }
        else if (it < C2) { const int j = it - C1; conv_tile(P.in[I_F2GU] + (size_t)l * D * 2 * DFF, D, 2 * DFF, (bf16_t*)(ws + WS_WGU2), j / 88, j % 88, true, lds); }
        else if (it < C3) { const int j = it - C2; conv_tile(P.in[I_F2DN] + (size_t)l * DFF * D, DFF, D, (bf16_t*)(ws + WS_WDN2), j / 16, j % 16, false, lds); }
        else if (it < C4) { const int j = it - C3; conv_tile(P.in[I_WIN] + (size_t)l * D * INW, D, INW, (bf16_t*)(ws + WS_WIN), j / 54, j % 54, false, lds); }
        else { const int j = it - C4; conv_tile(P.in[I_WOUT] + (size_t)l * D * D, D, D, (bf16_t*)(ws + WS_WOUT), j / 16, j % 16, false, lds); }
    }
    const int gtid = blockIdx.x * NTHR + tid, gn = gridDim.x * NTHR;
    { unsigned* z = (unsigned*)(ws + WS_WIN + (size_t)INW * D * 2); for (int i = gtid; i < (INWP - INW) * D / 2; i += gn) z[i] = 0u; }
    { bf16_t* wl = (bf16_t*)(ws + WS_WLORA);
      const float* w2 = P.in[I_W2] + (size_t)l * 2 * 64 * RWW; const float* a2 = P.in[I_A2] + (size_t)l * 2 * 64 * RWW; const float* g2 = P.in[I_G2] + (size_t)l * 128 * RWW;
      for (int i = gtid; i < 2048 * 48; i += gn) { const int kb = (i / 2048) * 8, j = i % 2048; float v[8];
#pragma unroll
          for (int q = 0; q < 8; ++q) v[q] = 0.f;
          if (j < 1920) { const int grp = j / 384, c = j % 384;
              const bool act = grp < 4 ? (kb >> 6) == grp : kb >= 256;
              if (act) { const float* src = (grp < 2 ? w2 + (size_t)kb * RWW : (grp < 4 ? a2 + (size_t)(kb - 128) * RWW : g2 + (size_t)(kb - 256) * RWW)) + c;
#pragma unroll
                  for (int q = 0; q < 8; ++q) v[q] = src[(size_t)q * RWW]; } }
          u32x4 w; w.x = cvt_pk_bf16(v[0], v[1]); w.y = cvt_pk_bf16(v[2], v[3]); w.z = cvt_pk_bf16(v[4], v[5]); w.w = cvt_pk_bf16(v[6], v[7]);
          *(u32x4*)(wl + (size_t)j * 384 + kb) = w; } }
    { const float* w1_ = P.in[I_HW1] + (size_t)l * 33 * 64; const float* b1 = P.in[I_HB1] + l * 64; const float* w2f_ = P.in[I_HW2] + (size_t)l * 64 * 64; const float* b2 = P.in[I_HB2] + l * 64;
      const float* fqv = P.in[I_HFREQ] + l * 64; const float* w3 = P.in[I_HW3] + (size_t)l * 64 * 1024;
      const int lane = tid & 63, wv = tid >> 6;
      const float fq = fqv[lane], bb1 = b1[lane], bb2 = b2[lane];
      const ldsfp hl = vlds(lds);
      for (int task = blockIdx.x; task < 256; task += gridDim.x) {
          const int n0 = task * 32;
          __syncthreads();
#pragma unroll 1
          for (int p = wv; p < 33; p += NWAVE) { const int L = p < 32 ? SEQ : CTX, pos = p < 32 ? n0 + p : task;
              const float* w1 = w1_; const float* w2f = w2f_; asm volatile("" : "+s"(w1), "+s"(w2f));
              const float tt = (float)pos / (float)(L - 1);
              const float ang = 6.283185307179586f * (float)pos / (float)L;
              float z = 0.f;
              if (lane == 0) z = tt;
              else if (lane <= 16) { const float fr = 1e-4f + (float)(lane - 1) * ((15.0f - 1e-4f) / 15.0f); z = cosf(fr * ang); }
              else if (lane <= 32) { const float fr = 1e-4f + (float)(lane - 17) * ((15.0f - 1e-4f) / 15.0f); z = -sinf(fr * ang); }
              float a = bb1;
#pragma unroll
              for (int e = 0; e < 33; ++e) a += __shfl(z, e) * w1[e * 64 + lane];
              const float h1 = sinf(fq * a);
              float c = bb2;
#pragma unroll
              for (int i = 0; i < 64; ++i) c += __shfl(h1, i) * w2f[i * 64 + lane];
              hl[lane * 36 + p] = sinf(fq * c); }
          __syncthreads();
          float acc0[33], acc1[33];
#pragma unroll
          for (int p = 0; p < 33; ++p) { acc0[p] = 0.f; acc1[p] = 0.f; }
#pragma unroll 2
          for (int i = 0; i < 64; ++i) { const float wa = w3[(size_t)i * 1024 + tid], wb = w3[(size_t)i * 1024 + 512 + tid];
#pragma unroll
              for (int p4 = 0; p4 < 8; ++p4) { const f32x4 hv = *(const LAS f32x4*)(hl + i * 36 + p4 * 4);
                  acc0[p4 * 4 + 0] += hv.x * wa; acc0[p4 * 4 + 1] += hv.y * wa; acc0[p4 * 4 + 2] += hv.z * wa; acc0[p4 * 4 + 3] += hv.w * wa;
                  acc1[p4 * 4 + 0] += hv.x * wb; acc1[p4 * 4 + 1] += hv.y * wb; acc1[p4 * 4 + 2] += hv.z * wb; acc1[p4 * 4 + 3] += hv.w * wb; }
              const float hc = hl[i * 36 + 32]; acc0[32] += hc * wa; acc1[32] += hc * wb; }
          const float dl = hy_delta(tid & 255), sc = 1.0f / NFFT, invL = 1.0f / (float)(SEQ - 1);
          bf16_t* dst = (bf16_t*)(ws + WS_FILT) + (size_t)tid * SEQ + n0;
          const size_t cstep = (size_t)512 * SEQ;
#pragma unroll
          for (int p8 = 0; p8 < 4; ++p8) { float d[8];
#pragma unroll
              for (int k = 0; k < 8; ++k) d[k] = __expf(-((float)(n0 + p8 * 8 + k) * invL) * dl) * sc;
              u32x4 w; w.x = cvt_pk_bf16(acc0[p8 * 8 + 0] * d[0], acc0[p8 * 8 + 1] * d[1]); w.y = cvt_pk_bf16(acc0[p8 * 8 + 2] * d[2], acc0[p8 * 8 + 3] * d[3]);
              w.z = cvt_pk_bf16(acc0[p8 * 8 + 4] * d[4], acc0[p8 * 8 + 5] * d[5]); w.w = cvt_pk_bf16(acc0[p8 * 8 + 6] * d[6], acc0[p8 * 8 + 7] * d[7]);
              *(u32x4*)(dst + p8 * 8) = w;
              w.x = cvt_pk_bf16(acc1[p8 * 8 + 0] * d[0], acc1[p8 * 8 + 1] * d[1]); w.y = cvt_pk_bf16(acc1[p8 * 8 + 2] * d[2], acc1[p8 * 8 + 3] * d[3]);
              w.z = cvt_pk_bf16(acc1[p8 * 8 + 4] * d[4], acc1[p8 * 8 + 5] * d[5]); w.w = cvt_pk_bf16(acc1[p8 * 8 + 6] * d[6], acc1[p8 * 8 + 7] * d[7]);
              *(u32x4*)(dst + cstep + p8 * 8) = w; }
          { const float dc = __expf(-((float)task * (1.0f / (float)(CTX - 1))) * dl); bf16_t* fc = (bf16_t*)(ws + WS_FILTC) + (size_t)tid * CTX + task;
            fc[0] = f2bf(acc0[32] * dc); fc[(size_t)512 * CTX] = f2bf(acc1[32] * dc); }
      }
      __syncthreads(); }
}

__device__ __forceinline__ void ph_rowpass(const Params& P, int mode, int lpost, int gate_i, int gpost_i, float ps, int lpre, int gpre_i, int shift_i, int scale_i, int nsplit) {
    const int tid = otid(), lane = tid & 63, gw = blockIdx.x * NWAVE + (tid >> 6), nw = gridDim.x * NWAVE;
    const float* modv = (const float*)(P.ws + WS_MODV);
    float* H = (float*)(P.ws + WS_H); const bf16_t* Y = (const bf16_t*)(P.ws + WS_Y); bf16_t* U = (bf16_t*)(P.ws + WS_U);
    int cur_s = -1;
    float4 A[4], Bv[4], Cv[4];
#pragma unroll
    for (int j = 0; j < 4; ++j) { A[j] = make_float4(0.f, 0.f, 0.f, 0.f); Bv[j] = A[j]; Cv[j] = A[j]; }
    for (int row = gw; row < T; row += nw) {
        const int s = row < SEQ ? 0 : (row < TL ? 1 : 2);
        if (s != cur_s) { cur_s = s;
#pragma unroll
            for (int j = 0; j < 4; ++j) { const int e = lane * 4 + 256 * j;
                if (mode != 0) { const float4 g = *(const float4*)(modv + ((size_t)lpost * 3 + s) * NMOD + gate_i * D + e); const float4 gp = *(const float4*)(P.in[I_NORMG] + ((size_t)lpost * 6 + gpost_i) * D + e);
                    A[j] = make_float4(ps * g.x * gp.x, ps * g.y * gp.y, ps * g.z * gp.z, ps * g.w * gp.w); }
                if (mode != 2) { const float4 sc = *(const float4*)(modv + ((size_t)lpre * 3 + s) * NMOD + scale_i * D + e); const float4 gq = *(const float4*)(P.in[I_NORMG] + ((size_t)lpre * 6 + gpre_i) * D + e);
                    Bv[j] = make_float4(gq.x * (1.f + sc.x), gq.y * (1.f + sc.y), gq.z * (1.f + sc.z), gq.w * (1.f + sc.w));
                    Cv[j] = *(const float4*)(modv + ((size_t)lpre * 3 + s) * NMOD + shift_i * D + e); } } }
        float4 h[4];
        if (mode == 0) { const float* src = row < TL ? P.in[I_X] + (size_t)row * D : P.in[I_CTX] + (size_t)(row - TL) * D;
#pragma unroll
            for (int j = 0; j < 4; ++j) h[j] = *(const float4*)(src + lane * 4 + 256 * j);
        } else {
            float4 y[4]; float ss = 0.f;
#pragma unroll
            for (int j = 0; j < 4; ++j) { h[j] = *(const float4*)(H + (size_t)row * D + lane * 4 + 256 * j); if (row < TL) { const u32x2 yw = *(const u32x2*)(Y + (size_t)row * D + lane * 4 + 256 * j); y[j] = make_float4(lo_bf(yw.x), hi_bf(yw.x), lo_bf(yw.y), hi_bf(yw.y)); } else { const float* yp = (const float*)(P.ws + WS_YC) + (size_t)(row - TL) * D + lane * 4 + 256 * j; float4 a = *(const float4*)yp;
                    for (int q = 1; q < nsplit; ++q) { const float4 b4 = *(const float4*)(yp + (size_t)q * TC * D); a.x += b4.x; a.y += b4.y; a.z += b4.z; a.w += b4.w; } y[j] = a; }
                ss += y[j].x * y[j].x + y[j].y * y[j].y + y[j].z * y[j].z + y[j].w * y[j].w; }
            ss = wsum(ss); const float r = rsqrtf(ss * (1.0f / D) + NORM_EPS);
#pragma unroll
            for (int j = 0; j < 4; ++j) { h[j].x += A[j].x * (y[j].x * r); h[j].y += A[j].y * (y[j].y * r); h[j].z += A[j].z * (y[j].z * r); h[j].w += A[j].w * (y[j].w * r); }
        }
        if (mode == 2) { if (row < TL) {
#pragma unroll
                for (int j = 0; j < 4; ++j) *(float4*)(P.out + (size_t)row * D + lane * 4 + 256 * j) = h[j]; }
            continue; }
        float s2 = 0.f;
#pragma unroll
        for (int j = 0; j < 4; ++j) { *(float4*)(H + (size_t)row * D + lane * 4 + 256 * j) = h[j]; s2 += h[j].x * h[j].x + h[j].y * h[j].y + h[j].z * h[j].z + h[j].w * h[j].w; }
        s2 = wsum(s2); const float r2 = rsqrtf(s2 * (1.0f / D) + NORM_EPS);
#pragma unroll
        for (int j = 0; j < 4; ++j) { u32x2 w; w.x = cvt_pk_bf16(h[j].x * r2 * Bv[j].x + Cv[j].x, h[j].y * r2 * Bv[j].y + Cv[j].y); w.y = cvt_pk_bf16(h[j].z * r2 * Bv[j].z + Cv[j].z, h[j].w * r2 * Bv[j].w + Cv[j].w);
            *(u32x2*)(U + (size_t)row * D + lane * 4 + 256 * j) = w; }
    }
}

struct EpiGU {
    static constexpr bool PERM = true, AFTER_DRAIN = false;
    bf16_t* O;
    __device__ __forceinline__ void operator()(const f32x4 (&acc)[2][2][4][2], const pg8::Unit& u, int wr, int wc, int fr, int fq) const {
        const int row0 = u.pm * 256 + wr * 64 + fr, col0 = u.pn * 128 + wc * 32 + 8 * fq;
#pragma unroll
        for (int ai = 0; ai < 2; ++ai)
#pragma unroll
            for (int m = 0; m < 4; ++m) { float o[8];
#pragma unroll
                for (int n = 0; n < 2; ++n)
#pragma unroll
                    for (int j = 0; j < 4; ++j) { const float g = acc[ai][0][m][n][j], up = acc[ai][1][m][n][j]; o[n * 4 + j] = g * __builtin_amdgcn_rcpf(1.0f + __expf(-g)) * up; }
                u32x4 w; w.x = cvt_pk_bf16(o[0], o[1]); w.y = cvt_pk_bf16(o[2], o[3]); w.z = cvt_pk_bf16(o[4], o[5]); w.w = cvt_pk_bf16(o[6], o[7]);
                *(u32x4*)(O + (size_t)(row0 + ai * 128 + m * 16) * DFF + col0) = w; }
    }
};

struct TailOrder {
    int nsplit, kp, G, c;
    __device__ void init(int K, int KP, int G_, int c_) { kp = KP; nsplit = (K / 64) / KP; G = G_; c = c_; }
    __device__ bool next(int i, pg8::Unit& u) const {
        const long L = (long)i * G + c;
        if (L < 256) { int wgid = (int)L; { const int q = 256 / 8, xcd = wgid % 8, off = wgid / 8; wgid = xcd * q + off; }
            const int nig = 8 * 4, gid = wgid / nig, fm = gid * 8; u.pm = fm + ((wgid % nig) % 8); u.pn = (wgid % nig) / 8; u.kt0 = 0; u.nkt = 0; return true; }
        const int L2 = (int)(L - 256); if (L2 >= 8 * nsplit) return false;
        const int tile = L2 / nsplit, ks = L2 % nsplit; u.pm = 64 + (tile >> 2); u.pn = tile & 3; u.kt0 = ks * kp; u.nkt = kp; return true;
    }
    __device__ __forceinline__ void a_ready(const pg8::Unit&) const {}
    __device__ __forceinline__ void done(const pg8::Unit&) const {}
};
struct EpiF32 {
    static constexpr bool PERM = true, AFTER_DRAIN = false;
    bf16_t* C; float* YC;
    __device__ __forceinline__ void operator()(const f32x4 (&acc)[2][2][4][2], const pg8::Unit& u, int wr, int wc, int fr, int fq) const {
        const int row0 = u.pm * 256 + wr * 64 + fr, col0 = u.pn * 256 + wc * 32 + 8 * fq;
        if (u.pm < 64) {
#pragma unroll
            for (int ai = 0; ai < 2; ++ai)
#pragma unroll
                for (int m = 0; m < 4; ++m) { bf16_t* rowp = C + (size_t)(row0 + ai * 128 + m * 16) * D + col0;
#pragma unroll
                    for (int bj = 0; bj < 2; ++bj) { const f32x4 v0 = acc[ai][bj][m][0], v1 = acc[ai][bj][m][1];
                        u32x4 w; w.x = cvt_pk_bf16(v0[0], v0[1]); w.y = cvt_pk_bf16(v0[2], v0[3]); w.z = cvt_pk_bf16(v1[0], v1[1]); w.w = cvt_pk_bf16(v1[2], v1[3]);
                        *(u32x4*)(rowp + bj * 128) = w; } }
        } else { float* base = YC + (size_t)(u.kt0 >> 2) * TC * D;
#pragma unroll
            for (int ai = 0; ai < 2; ++ai)
#pragma unroll
                for (int m = 0; m < 4; ++m) { float* rowp = base + (size_t)(row0 - TL + ai * 128 + m * 16) * D + col0;
#pragma unroll
                    for (int bj = 0; bj < 2; ++bj)
#pragma unroll
                        for (int n = 0; n < 2; ++n) *(f32x4*)(rowp + bj * 128 + n * 4) = acc[ai][bj][m][n]; }
        }
    }
};
template <class Epi> __device__ __forceinline__ void run_gemm_tail(LAS unsigned char* lds, const bf16_t* A, const bf16_t* Bt, int K, const Epi& E) {
    asm volatile("" : "+s"(K));
    pg8::Gemm g{A, Bt, T, D, K}; TailOrder S; S.init(K, 4, (int)gridDim.x, (int)blockIdx.x);
    pg8::gemm_phase<Epi, TailOrder>(lds, g, S, E);
    __syncthreads();
}
__device__ __forceinline__ void zero_yc(const Params& P) { float4* z = (float4*)(P.ws + WS_YC); for (int i = blockIdx.x * NTHR + otid(); i < TC * D / 4; i += gridDim.x * NTHR) z[i] = make_float4(0.f, 0.f, 0.f, 0.f); }
struct EpiWin {
    static constexpr bool PERM = true, AFTER_DRAIN = false;
    bf16_t* PHYT; bf16_t* PRW; bf16_t* PNA;
    __device__ __forceinline__ void operator()(const f32x4 (&acc)[2][2][4][2], const pg8::Unit& u, int wr, int wc, int fr, int fq) const {
        const int row0 = u.pm * 256 + wr * 64 + fr;
        if (u.pn < 3) {
#pragma unroll
            for (int bj = 0; bj < 2; ++bj) { bf16_t* cp = PHYT + (size_t)(u.pn * 256 + bj * 128 + wc * 32 + 8 * fq) * T + row0;
#pragma unroll
                for (int ai = 0; ai < 2; ++ai)
#pragma unroll
                    for (int m = 0; m < 4; ++m) { const f32x4 v0 = acc[ai][bj][m][0], v1 = acc[ai][bj][m][1]; bf16_t* rp = cp + ai * 128 + m * 16;
                        const unsigned w0 = cvt_pk_bf16(v0[0], v0[1]), w1 = cvt_pk_bf16(v0[2], v0[3]), w2 = cvt_pk_bf16(v1[0], v1[1]), w3 = cvt_pk_bf16(v1[2], v1[3]);
                        rp[0] = (bf16_t)w0; rp[(size_t)T] = (bf16_t)(w0 >> 16); rp[(size_t)2 * T] = (bf16_t)w1; rp[(size_t)3 * T] = (bf16_t)(w1 >> 16);
                        rp[(size_t)4 * T] = (bf16_t)w2; rp[(size_t)5 * T] = (bf16_t)(w2 >> 16); rp[(size_t)6 * T] = (bf16_t)w3; rp[(size_t)7 * T] = (bf16_t)(w3 >> 16); } }
            return; }
        bf16_t* base; int ld, cbase;
        if (u.pn < 9) { base = PRW; ld = RW_IN; cbase = u.pn * 256 - HY_IN; }
        else { base = PNA; ld = NA_IN; cbase = u.pn * 256 - HY_IN - RW_IN; }
        const int nbj = (u.pn == 13) ? 1 : 2;
#pragma unroll
        for (int ai = 0; ai < 2; ++ai)
#pragma unroll
            for (int m = 0; m < 4; ++m)
#pragma unroll
                for (int bj = 0; bj < 2; ++bj) { if (bj < nbj) { const f32x4 v0 = acc[ai][bj][m][0], v1 = acc[ai][bj][m][1];
                    u32x4 w; w.x = cvt_pk_bf16(v0[0], v0[1]); w.y = cvt_pk_bf16(v0[2], v0[3]); w.z = cvt_pk_bf16(v1[0], v1[1]); w.w = cvt_pk_bf16(v1[2], v1[3]);
                    *(u32x4*)(base + (size_t)(row0 + ai * 128 + m * 16) * ld + cbase + bj * 128 + wc * 32 + 8 * fq) = w; } }
    }
};
struct EpiLora {
    static constexpr bool PERM = true, AFTER_DRAIN = false;
    bf16_t* LO; bf16_t* GATE;
    __device__ __forceinline__ void operator()(const f32x4 (&acc)[2][2][4][2], const pg8::Unit& u, int wr, int wc, int fr, int fq) const {
        const int row0 = u.pm * 256 + wr * 64 + fr;
        bf16_t* base; int ld, cbase;
        if (u.pn < 6) { base = LO; ld = 1536; cbase = u.pn * 256; } else { base = GATE; ld = 384; cbase = u.pn * 256 - 1536; }
        const int nbj = (u.pn == 7) ? 1 : 2;
#pragma unroll
        for (int ai = 0; ai < 2; ++ai)
#pragma unroll
            for (int m = 0; m < 4; ++m)
#pragma unroll
                for (int bj = 0; bj < 2; ++bj) { if (bj < nbj) { const f32x4 v0 = acc[ai][bj][m][0], v1 = acc[ai][bj][m][1];
                    u32x4 w; w.x = cvt_pk_bf16(v0[0], v0[1]); w.y = cvt_pk_bf16(v0[2], v0[3]); w.z = cvt_pk_bf16(v1[0], v1[1]); w.w = cvt_pk_bf16(v1[2], v1[3]);
                    *(u32x4*)(base + (size_t)(row0 + ai * 128 + m * 16) * ld + cbase + bj * 128 + wc * 32 + 8 * fq) = w; } }
    }
};
template <class Epi> __device__ __forceinline__ void run_gemm(LAS unsigned char* lds, const bf16_t* A, const bf16_t* Bt, int M, int N, int K, const Epi& E) {
    asm volatile("" : "+s"(K));
    pg8::Gemm g{A, Bt, M, N, K}; pg8::StaticOrder S; S.init(M, N, (int)gridDim.x, (int)blockIdx.x);
    pg8::gemm_phase<Epi, pg8::StaticOrder>(lds, g, S, E);
    __syncthreads();
}

__device__ __forceinline__ void ph_loraprep(const Params& P, int l) {
    const bf16_t* PRW = (const bf16_t*)(P.ws + WS_PRW); bf16_t* AL = (bf16_t*)(P.ws + WS_ALORA);
    const float* mu = P.in[I_MU] + (size_t)l * 2 * RW_IN;
    const int gtid = blockIdx.x * NTHR + otid(), gn = gridDim.x * NTHR;
    for (int it = gtid; it < T * 48; it += gn) {
        const int row = it / 48, j8 = it % 48, col = 1152 + j8 * 8;
        bool hp, hn; row_nbrs(row, hp, hn);
        float p[8], pp[8], pn[8];
        unpack8(*(const u32x4*)(PRW + (size_t)row * RW_IN + col), p);
        if (hp) unpack8(*(const u32x4*)(PRW + (size_t)(row - 1) * RW_IN + col), pp); else {
#pragma unroll
            for (int i = 0; i < 8; ++i) pp[i] = 0.f; }
        if (hn) unpack8(*(const u32x4*)(PRW + (size_t)(row + 1) * RW_IN + col), pn); else {
#pragma unroll
            for (int i = 0; i < 8; ++i) pn[i] = 0.f; }
        float o[8];
#pragma unroll
        for (int i = 0; i < 8; ++i) { const float xs = p[i] + mu[col + i] * (pp[i] - p[i]) + mu[RW_IN + col + i] * (pn[i] - p[i]);
            o[i] = j8 < 16 ? tanhf(xs) : (j8 < 32 ? xs : sigmoidf_(xs)); }
        u32x4 w; w.x = cvt_pk_bf16(o[0], o[1]); w.y = cvt_pk_bf16(o[2], o[3]); w.z = cvt_pk_bf16(o[4], o[5]); w.w = cvt_pk_bf16(o[6], o[7]);
        *(u32x4*)(AL + (size_t)row * 384 + j8 * 8) = w;
    }
}

__device__ __forceinline__ void ph_rwkvprep(const Params& P, int l) {
    const int tid = otid(), lane = tid & 63, gw = blockIdx.x * NWAVE + (tid >> 6), nw = gridDim.x * NWAVE;
    const int nrw = nw / 6, h = gw % 6, rw0 = gw / 6;
    if (rw0 >= nrw) return;
    const int q = lane & 31, half = lane >> 5, c = h * 64 + 2 * q;
    const bf16_t* PRW = (const bf16_t*)(P.ws + WS_PRW); const bf16_t* LO = (const bf16_t*)(P.ws + WS_LORAO);
    bf16_t* RS = (bf16_t*)(P.ws + WS_RS); bf16_t* KKS = (bf16_t*)(P.ws + WS_KKS); bf16_t* VS = (bf16_t*)(P.ws + WS_VS); bf16_t* KS = (bf16_t*)(P.ws + WS_KS); bf16_t* BS = (bf16_t*)(P.ws + WS_BS);
    float* BON = (float*)(P.ws + WS_BONUS); float* DEC = (float*)(P.ws + WS_DECAY);
    const float* RT = (const float*)(P.ws + WS_ROPE);
    const float* mu = P.in[I_MU] + (size_t)l * 2 * RW_IN;
    float mp[3][2], mn[3][2], ckk[2], cka[2], crk[2], ca0[2], ca1[2], cw0[2], cw1[2];
#pragma unroll
    for (int e = 0; e < 2; ++e) {
#pragma unroll
        for (int t3 = 0; t3 < 3; ++t3) { mp[t3][e] = mu[t3 * 384 + c + e]; mn[t3][e] = mu[RW_IN + t3 * 384 + c + e]; }
        ckk[e] = P.in[I_KK][l * RWW + c + e]; cka[e] = P.in[I_KA][l * RWW + c + e]; crk[e] = P.in[I_RK][l * RWW + c + e];
        ca0[e] = P.in[I_A0][(size_t)l * 2 * RWW + c + e]; ca1[e] = P.in[I_A0][(size_t)l * 2 * RWW + RWW + c + e]; cw0[e] = P.in[I_W0][(size_t)l * 2 * RWW + c + e]; cw1[e] = P.in[I_W0][(size_t)l * 2 * RWW + RWW + c + e]; }
    const float sg = (q & 8) ? 1.f : -1.f;
    const int f0 = (2 * q) & 15;
#define LD2(ptr, lo_, hi_) do { const unsigned w_ = *(const unsigned*)(ptr); lo_ = lo_bf(w_); hi_ = hi_bf(w_); } while (0)
#define SUM32(x) do { x += __shfl_xor(x, 1); x += __shfl_xor(x, 2); x += __shfl_xor(x, 4); x += __shfl_xor(x, 8); x += __shfl_xor(x, 16); } while (0)
#pragma unroll 2
    for (int pi = rw0; pi < T / 2; pi += nrw) { const int row = 2 * pi + half;
        bool hp, hn; row_nbrs(row, hp, hn);
        const bf16_t* pr = PRW + (size_t)row * RW_IN + c; const int om = hp ? -RW_IN : 0, op = hn ? RW_IN : 0; const float fm = hp ? 1.f : 0.f, fp = hn ? 1.f : 0.f;
        float x[3][2];
#pragma unroll
        for (int t3 = 0; t3 < 3; ++t3) { float c0, c1, m0, m1, p0, p1; LD2(pr + t3 * 384, c0, c1); LD2(pr + t3 * 384 + om, m0, m1); LD2(pr + t3 * 384 + op, p0, p1);
            x[t3][0] = c0 + mp[t3][0] * (fm * m0 - c0) + mn[t3][0] * (fp * p0 - c0); x[t3][1] = c1 + mp[t3][1] * (fm * m1 - c1) + mn[t3][1] * (fp * p1 - c1); }
        const bf16_t* lo = LO + (size_t)row * 1536 + c;
        float la0[2], la1[2], lw0[2], lw1[2]; LD2(lo + 768, la0[0], la0[1]); LD2(lo + 1152, la1[0], la1[1]); LD2(lo, lw0[0], lw0[1]); LD2(lo + 384, lw1[0], lw1[1]);
        float a0[2], a1[2], kkr[2];
#pragma unroll
        for (int e = 0; e < 2; ++e) { a0[e] = sigmoidf_(la0[e] + ca0[e]); a1[e] = sigmoidf_(la1[e] + ca1[e]); kkr[e] = x[1][e] * ckk[e]; }
        float n2 = kkr[0] * kkr[0] + kkr[1] * kkr[1]; SUM32(n2);
        const float rn = 1.0f / fmaxf(sqrtf(n2), 1e-12f);
        float rs[2], kks[2], kd0[2], kd1[2], b0[2], b1[2]; float bon = 0.f;
#pragma unroll
        for (int e = 0; e < 2; ++e) { const float k = x[1][e]; kks[e] = kkr[e] * rn; rs[e] = x[0][e];
            kd0[e] = k * (1.f + (a0[e] - 1.f) * cka[e]); kd1[e] = k * (1.f + (a1[e] - 1.f) * cka[e]); b0[e] = kks[e] * a0[e]; b1[e] = kks[e] * a1[e];
            bon += rs[e] * (kd0[e] + kd1[e]) * crk[e]; }
        SUM32(bon);
        if (row < TL) {
            const int t = row & (SEQ - 1); const int pos = (q < 16) ? (t >> 6) : (t & 63);
            const float4 cs4 = *(const float4*)(RT + (size_t)(pos * 16 + f0) * 2);
            const float cs[2] = {cs4.x, cs4.z}, sn[2] = {cs4.y, cs4.w};
#pragma unroll
            for (int e = 0; e < 2; ++e) {
                const float r2 = __shfl_xor(rs[e], 8), k2 = __shfl_xor(kks[e], 8), d0 = __shfl_xor(kd0[e], 8), d1 = __shfl_xor(kd1[e], 8), e0 = __shfl_xor(b0[e], 8), e1 = __shfl_xor(b1[e], 8);
                rs[e] = rs[e] * cs[e] + sg * r2 * sn[e]; kks[e] = kks[e] * cs[e] + sg * k2 * sn[e]; kd0[e] = kd0[e] * cs[e] + sg * d0 * sn[e]; kd1[e] = kd1[e] * cs[e] + sg * d1 * sn[e];
                b0[e] = b0[e] * cs[e] + sg * e0 * sn[e]; b1[e] = b1[e] * cs[e] + sg * e1 * sn[e]; }
        }
        const size_t o = (size_t)row * 384 + c;
        *(float2*)(DEC + o) = make_float2(__expf(-0.6065306597f * sigmoidf_(lw0[0] + cw0[0])), __expf(-0.6065306597f * sigmoidf_(lw0[1] + cw0[1])));
        *(float2*)(DEC + (size_t)T * 384 + o) = make_float2(__expf(-0.6065306597f * sigmoidf_(lw1[0] + cw1[0])), __expf(-0.6065306597f * sigmoidf_(lw1[1] + cw1[1])));
        if (q == 0) BON[(size_t)row * 6 + h] = bon;
        *(unsigned*)(RS + o) = cvt_pk_bf16(rs[0], rs[1]); *(unsigned*)(KKS + o) = cvt_pk_bf16(-kks[0], -kks[1]); *(unsigned*)(VS + o) = cvt_pk_bf16(x[2][0], x[2][1]);
        *(unsigned*)(KS + o) = cvt_pk_bf16(kd0[0], kd0[1]); *(unsigned*)(KS + (size_t)T * 384 + o) = cvt_pk_bf16(kd1[0], kd1[1]);
        *(unsigned*)(BS + o) = cvt_pk_bf16(b0[0], b0[1]); *(unsigned*)(BS + (size_t)T * 384 + o) = cvt_pk_bf16(b1[0], b1[1]);
    }
#undef LD2
#undef SUM32
}

__device__ __forceinline__ int scan_row(int b, int d, int step) {
    if (step < CTX) { const int tc = d ? (CTX - 1 - step) : step; return TL + b * CTX + tc; }
    const int tl = d ? (SEQ - 1 - (step - CTX)) : (step - CTX); return b * SEQ + tl;
}
__device__ __forceinline__ void scan_task_v1(const Params& P, int task, float* sv) {
    const int lane = otid() & 63;
    const int d = task & 1, h = (task >> 1) % 6, b = task / 12;
    const float* DEC = (const float*)(P.ws + WS_DECAY) + (size_t)d * T * 384; const bf16_t* KKS = (const bf16_t*)(P.ws + WS_KKS); const bf16_t* RS = (const bf16_t*)(P.ws + WS_RS);
    const bf16_t* VS = (const bf16_t*)(P.ws + WS_VS); const bf16_t* KS = (const bf16_t*)(P.ws + WS_KS) + (size_t)d * T * 384; const bf16_t* BS = (const bf16_t*)(P.ws + WS_BS) + (size_t)d * T * 384;
    float* YD = (float*)(P.ws + WS_YDIR) + (size_t)d * T * 384;
    float S[64];
#pragma unroll
    for (int j = 0; j < 64; ++j) S[j] = 0.f;
    size_t o = (size_t)scan_row(b, d, 0) * 384 + h * 64 + lane;
    float nw_ = DEC[o], na = bf2f(KKS[o]), nb = bf2f(BS[o]), nk = bf2f(KS[o]), nr = bf2f(RS[o]), nv = bf2f(VS[o]);
    for (int step = 0; step < CTX + SEQ; ++step) {
        const float v = nv; const size_t oc = o;
        asm volatile("s_waitcnt lgkmcnt(0)" ::: "memory");
        sv[lane] = nw_; sv[64 + lane] = na; sv[128 + lane] = nb; sv[192 + lane] = nk; sv[256 + lane] = nr;
        asm volatile("s_waitcnt lgkmcnt(0)" ::: "memory");
        if (step + 1 < CTX + SEQ) { o = (size_t)scan_row(b, d, step + 1) * 384 + h * 64 + lane;
            nw_ = DEC[o]; na = bf2f(KKS[o]); nb = bf2f(BS[o]); nk = bf2f(KS[o]); nr = bf2f(RS[o]); nv = bf2f(VS[o]); }
        float sa0 = 0.f, sa1 = 0.f, sa2 = 0.f, sa3 = 0.f;
#pragma unroll
        for (int j = 0; j < 64; j += 4) { const float4 a4 = *(const float4*)(sv + 64 + j);
            sa0 += S[j + 0] * a4.x; sa1 += S[j + 1] * a4.y; sa2 += S[j + 2] * a4.z; sa3 += S[j + 3] * a4.w; }
        const float sa = (sa0 + sa1) + (sa2 + sa3);
        float y0 = 0.f, y1 = 0.f, y2 = 0.f, y3 = 0.f;
#pragma unroll
        for (int j = 0; j < 64; j += 4) {
            const float4 w4 = *(const float4*)(sv + j), b4 = *(const float4*)(sv + 128 + j), k4 = *(const float4*)(sv + 192 + j), r4 = *(const float4*)(sv + 256 + j);
            S[j + 0] = S[j + 0] * w4.x + sa * b4.x + v * k4.x; y0 += S[j + 0] * r4.x;
            S[j + 1] = S[j + 1] * w4.y + sa * b4.y + v * k4.y; y1 += S[j + 1] * r4.y;
            S[j + 2] = S[j + 2] * w4.z + sa * b4.z + v * k4.z; y2 += S[j + 2] * r4.z;
            S[j + 3] = S[j + 3] * w4.w + sa * b4.w + v * k4.w; y3 += S[j + 3] * r4.w; }
        YD[oc] = (y0 + y1) + (y2 + y3);
    }
}

__device__ __forceinline__ void natt_key(const bf16_t* PNA, size_t krow, int hoff, const float (&q)[16], float bias, float& m, float& lsum, float (&o)[16]) {
    const bf16_t* kp = PNA + krow * NA_IN + 384 + hoff; const bf16_t* vp = PNA + krow * NA_IN + 768 + hoff;
    float s = 0.f;
#pragma unroll
    for (int j8 = 0; j8 < 2; ++j8) { float kf[8]; unpack8(*(const u32x4*)(kp + j8 * 8), kf);
#pragma unroll
        for (int i = 0; i < 8; ++i) s += q[j8 * 8 + i] * kf[i]; }
    s += __shfl_xor(s, 1); s += __shfl_xor(s, 2); s += bias;
    const float mn = fmaxf(m, s), corr = __expf(m - mn), p = __expf(s - mn);
    m = mn; lsum = lsum * corr + p;
#pragma unroll
    for (int j8 = 0; j8 < 2; ++j8) { float vf[8]; unpack8(*(const u32x4*)(vp + j8 * 8), vf);
#pragma unroll
        for (int i = 0; i < 8; ++i) o[j8 * 8 + i] = o[j8 * 8 + i] * corr + p * vf[i]; }
}
__device__ __forceinline__ void natten_items_v1(const Params& P, int l, int wid0, int nworkers) {
    const bf16_t* PNA = (const bf16_t*)(P.ws + WS_PNA); bf16_t* MIX = (bf16_t*)(P.ws + WS_U);
    const float* rpb = P.in[I_RPB] + (size_t)l * 6 * 15 * 31;
    const int sub = wid0 & 3;
    for (int it = wid0 >> 2; it < T * 6; it += nworkers >> 2) {
        const int row = it % T, h = it / T, hoff = h * 64 + sub * 16;
        float q[16], o[16];
#pragma unroll
        for (int j8 = 0; j8 < 2; ++j8) { float qf[8]; unpack8(*(const u32x4*)(PNA + (size_t)row * NA_IN + hoff + j8 * 8), qf);
#pragma unroll
            for (int i = 0; i < 8; ++i) { q[j8 * 8 + i] = qf[i] * 0.125f; o[j8 * 8 + i] = 0.f; } }
        float m = -3.0e38f, lsum = 0.f;
        int b;
        if (row < TL) { b = row >> 13; const int t = row & (SEQ - 1), i = t >> 6, col = t & 63;
            const int start = min(max(i - 4, 0), 120), win0 = min(max(col - 8, 0), 48);
            for (int r = 0; r < 8; ++r) for (int kc = win0; kc < win0 + 16; ++kc) {
                const float bias = rpb[(h * 15 + (start + r - i + 7)) * 31 + (kc - col + 15)];
                natt_key(PNA, (size_t)b * SEQ + (start + r) * 64 + kc, hoff, q, bias, m, lsum, o); }
        } else b = (row - TL) >> 8;
        for (int c = 0; c < CTX; ++c) natt_key(PNA, (size_t)TL + b * CTX + c, hoff, q, 0.f, m, lsum, o);
        const float il = 1.0f / lsum;
#pragma unroll
        for (int j8 = 0; j8 < 2; ++j8) { u32x4 w; w.x = cvt_pk_bf16(o[j8 * 8 + 0] * il, o[j8 * 8 + 1] * il); w.y = cvt_pk_bf16(o[j8 * 8 + 2] * il, o[j8 * 8 + 3] * il);
            w.z = cvt_pk_bf16(o[j8 * 8 + 4] * il, o[j8 * 8 + 5] * il); w.w = cvt_pk_bf16(o[j8 * 8 + 6] * il, o[j8 * 8 + 7] * il);
            *(u32x4*)(MIX + (size_t)row * D + 640 + hoff + j8 * 8) = w; }
    }
}

__device__ __forceinline__ void vt_tile(const Params& P, int tile, unsigned short* tl  ) {
    const int tid = otid();
    const bf16_t* PNA = (const bf16_t*)(P.ws + WS_PNA);
    int h, tok0; bf16_t* dst; int ldt;
    if (tile < NB * 128 * 6) { h = tile % 6; const int sb = tile / 6; const int b = sb >> 7, blk = sb & 127; tok0 = b * SEQ + blk * 64; dst = (bf16_t*)(P.ws + WS_VTL) + ((size_t)(b * 6 + h) * 64) * SEQ + blk * 64; ldt = SEQ; }
    else { const int tt = tile - NB * 128 * 6; h = tt % 6; const int sb = tt / 6; const int b = sb >> 2, blk = sb & 3; tok0 = TL + b * CTX + blk * 64; dst = (bf16_t*)(P.ws + WS_VTC) + ((size_t)(b * 6 + h) * 64) * CTX + blk * 64; ldt = CTX; }
    { const int tok = tid >> 3, seg = tid & 7; const u32x4 v = *(const u32x4*)(PNA + (size_t)(tok0 + tok) * NA_IN + 768 + h * 64 + seg * 8);
      unsigned* w = (unsigned*)(tl + tok * 72 + seg * 8); w[0] = v.x; w[1] = v.y; w[2] = v.z; w[3] = v.w; }
    __syncthreads();
    { const int hd = tid >> 3, ts = tid & 7; unsigned short e[8];
#pragma unroll
      for (int k = 0; k < 8; ++k) e[k] = tl[(ts * 8 + k) * 72 + hd];
      u32x4 w; w.x = (unsigned)e[0] | ((unsigned)e[1] << 16); w.y = (unsigned)e[2] | ((unsigned)e[3] << 16); w.z = (unsigned)e[4] | ((unsigned)e[5] << 16); w.w = (unsigned)e[6] | ((unsigned)e[7] << 16);
      *(u32x4*)(dst + (size_t)hd * ldt + ts * 8) = w; }
    __syncthreads();
}
constexpr int NAT_LAT_TASKS = NB * 128 * 4 * 6, NAT_CTX_TASKS = NB * 16 * 6, NAT_TASKS = NAT_LAT_TASKS + NAT_CTX_TASKS;
__device__ __forceinline__ void natten_task(const Params& P, int l, int task) {
    using pg8::bf16x8;
    const int lane = otid() & 63, fr = lane & 15, fq = lane >> 4;
    const bf16_t* PNA = (const bf16_t*)(P.ws + WS_PNA); bf16_t* MIX = (bf16_t*)(P.ws + WS_U);
    const bool lat = task < NAT_LAT_TASKS;
    int b, h, i = 0, n = 0, qtok0;
    if (lat) { h = task % 6; const int r = task / 6; n = r & 3; i = (r >> 2) & 127; b = r >> 9; qtok0 = b * SEQ + i * 64 + 16 * n; }
    else { const int tt = task - NAT_LAT_TASKS; h = tt % 6; const int qb = (tt / 6) & 15; b = tt / 96; qtok0 = TL + b * CTX + 16 * qb; }
    const int start = min(max(i - 4, 0), 120), band0 = min(max(16 * n - 8, 0), 32);
    const int col = 16 * n + fr, win0 = min(max(col - 8, 0), 48);
    bf16x8 bq[2];
#pragma unroll
    for (int kh = 0; kh < 2; ++kh) bq[kh] = *(const bf16x8*)(PNA + (size_t)(qtok0 + fr) * NA_IN + h * 64 + kh * 32 + fq * 8);
    f32x4 sc[32];
    if (lat) {
#pragma unroll
        for (int t = 0; t < 16; ++t) { const int tok0 = b * SEQ + (start + (t >> 1)) * 64 + band0 + 16 * (t & 1);
            const bf16_t* kp = PNA + (size_t)(tok0 + fr) * NA_IN + 384 + h * 64 + fq * 8;
            const bf16x8 k0 = *(const bf16x8*)kp, k1 = *(const bf16x8*)(kp + 32);
            f32x4 a = (f32x4){0.f, 0.f, 0.f, 0.f};
            a = __builtin_amdgcn_mfma_f32_16x16x32_bf16(k0, bq[0], a, 0, 0, 0); a = __builtin_amdgcn_mfma_f32_16x16x32_bf16(k1, bq[1], a, 0, 0, 0);
            sc[t] = a; if ((t & 3) == 3) asm volatile("" ::: "memory"); }
    } else {
#pragma unroll
        for (int t = 0; t < 16; ++t) sc[t] = (f32x4){-3.0e38f, -3.0e38f, -3.0e38f, -3.0e38f};
    }
#pragma unroll
    for (int t = 16; t < 32; ++t) { const int tok0 = TL + b * CTX + 16 * (t - 16);
        const bf16_t* kp = PNA + (size_t)(tok0 + fr) * NA_IN + 384 + h * 64 + fq * 8;
        const bf16x8 k0 = *(const bf16x8*)kp, k1 = *(const bf16x8*)(kp + 32);
        f32x4 a = (f32x4){0.f, 0.f, 0.f, 0.f};
        a = __builtin_amdgcn_mfma_f32_16x16x32_bf16(k0, bq[0], a, 0, 0, 0); a = __builtin_amdgcn_mfma_f32_16x16x32_bf16(k1, bq[1], a, 0, 0, 0);
        sc[t] = a * 0.125f; if ((t & 3) == 3) asm volatile("" ::: "memory"); }
    if (lat) { const float* rpb = P.in[I_RPB] + ((size_t)l * 6 + h) * 15 * 31;
#pragma unroll
        for (int t = 0; t < 16; ++t) { const int ro = start + (t >> 1) - i + 7; const int kc0 = band0 + 16 * (t & 1) + fq * 4;
#pragma unroll
            for (int j = 0; j < 4; ++j) { const int kc = kc0 + j; const bool ok = kc >= win0 && kc < win0 + 16; const int co = min(max(kc - col + 15, 0), 30);
                const float bias = rpb[ro * 31 + co]; sc[t][j] = ok ? sc[t][j] * 0.125f + bias : -3.0e38f; } } }
    float mx = -3.0e38f;
#pragma unroll
    for (int t = 0; t < 32; ++t) mx = fmaxf(mx, fmaxf(fmaxf(sc[t][0], sc[t][1]), fmaxf(sc[t][2], sc[t][3])));
    mx = fmaxf(mx, __shfl_xor(mx, 16)); mx = fmaxf(mx, __shfl_xor(mx, 32));
    float sum = 0.f;
#pragma unroll
    for (int t = 0; t < 32; ++t) {
#pragma unroll
        for (int j = 0; j < 4; ++j) { const float p = __expf(sc[t][j] - mx); sc[t][j] = p; sum += p; } }
    sum += __shfl_xor(sum, 16); sum += __shfl_xor(sum, 32);
    const float inv = 1.0f / sum;
    f32x4 ot[4];
#pragma unroll
    for (int q = 0; q < 4; ++q) ot[q] = (f32x4){0.f, 0.f, 0.f, 0.f};
    const bf16_t* VTL = (const bf16_t*)(P.ws + WS_VTL) + ((size_t)(b * 6 + h) * 64) * SEQ; const bf16_t* VTC = (const bf16_t*)(P.ws + WS_VTC) + ((size_t)(b * 6 + h) * 64) * CTX;
    if (lat) {
#pragma unroll
        for (int m = 0; m < 8; ++m) { const int tk = (start + m) * 64 + band0 + fq * 4;
            u32x4 pw; pw.x = cvt_pk_bf16(sc[2 * m][0], sc[2 * m][1]); pw.y = cvt_pk_bf16(sc[2 * m][2], sc[2 * m][3]); pw.z = cvt_pk_bf16(sc[2 * m + 1][0], sc[2 * m + 1][1]); pw.w = cvt_pk_bf16(sc[2 * m + 1][2], sc[2 * m + 1][3]);
            const bf16x8 pb = __builtin_bit_cast(bf16x8, pw);
#pragma unroll
            for (int q = 0; q < 4; ++q) { const bf16_t* vp = VTL + (size_t)(q * 16 + fr) * SEQ + tk; const u32x2 v0 = *(const u32x2*)vp, v1 = *(const u32x2*)(vp + 16);
                u32x4 vw; vw.x = v0.x; vw.y = v0.y; vw.z = v1.x; vw.w = v1.y;
                ot[q] = __builtin_amdgcn_mfma_f32_16x16x32_bf16(__builtin_bit_cast(bf16x8, vw), pb, ot[q], 0, 0, 0); }
            if (m & 1) asm volatile("" ::: "memory"); }
    }
#pragma unroll
    for (int m = 0; m < 8; ++m) { const int tk = 32 * m + fq * 4;
        u32x4 pw; pw.x = cvt_pk_bf16(sc[16 + 2 * m][0], sc[16 + 2 * m][1]); pw.y = cvt_pk_bf16(sc[16 + 2 * m][2], sc[16 + 2 * m][3]); pw.z = cvt_pk_bf16(sc[17 + 2 * m][0], sc[17 + 2 * m][1]); pw.w = cvt_pk_bf16(sc[17 + 2 * m][2], sc[17 + 2 * m][3]);
        const bf16x8 pb = __builtin_bit_cast(bf16x8, pw);
#pragma unroll
        for (int q = 0; q < 4; ++q) { const bf16_t* vp = VTC + (size_t)(q * 16 + fr) * CTX + tk; const u32x2 v0 = *(const u32x2*)vp, v1 = *(const u32x2*)(vp + 16);
            u32x4 vw; vw.x = v0.x; vw.y = v0.y; vw.z = v1.x; vw.w = v1.y;
            ot[q] = __builtin_amdgcn_mfma_f32_16x16x32_bf16(__builtin_bit_cast(bf16x8, vw), pb, ot[q], 0, 0, 0); }
        if (m & 1) asm volatile("" ::: "memory"); }
#pragma unroll
    for (int q = 0; q < 4; ++q) { u32x2 w; w.x = cvt_pk_bf16(ot[q][0] * inv, ot[q][1] * inv); w.y = cvt_pk_bf16(ot[q][2] * inv, ot[q][3] * inv);
        *(u32x2*)(MIX + (size_t)(qtok0 + fr) * D + 640 + h * 64 + q * 16 + fq * 4) = w; }
}

__device__ __forceinline__ void fft_fwd(float2* X) {
#pragma unroll 1
    for (int lq = 12; lq >= 0; lq -= 2) { const int q = 1 << lq; const float rq = 1.0f / (float)(4 * q);
        for (int j = otid(); j < NFFT / 4; j += NTHR) { const int lo = j & (q - 1), base = ((j >> lq) << (lq + 2)) | lo;
            const float2 x0 = X[base], x1 = X[base + q], x2 = X[base + 2 * q], x3 = X[base + 3 * q];
            const float fr = (float)lo * rq; const float c = __builtin_amdgcn_cosf(fr), s = __builtin_amdgcn_sinf(fr), c2 = c * c - s * s, s2 = 2.f * c * s;
            const float a0x = x0.x + x2.x, a0y = x0.y + x2.y, dx = x0.x - x2.x, dy = x0.y - x2.y;
            const float a2x = dx * c + dy * s, a2y = dy * c - dx * s;
            const float a1x = x1.x + x3.x, a1y = x1.y + x3.y, ex = x1.x - x3.x, ey = x1.y - x3.y;
            const float mx = ex * c + ey * s, my = ey * c - ex * s;
            const float a3x = my, a3y = -mx;
            const float fx = a0x - a1x, fy = a0y - a1y, gx = a2x - a3x, gy = a2y - a3y;
            X[base] = make_float2(a0x + a1x, a0y + a1y); X[base + q] = make_float2(fx * c2 + fy * s2, fy * c2 - fx * s2);
            X[base + 2 * q] = make_float2(a2x + a3x, a2y + a3y); X[base + 3 * q] = make_float2(gx * c2 + gy * s2, gy * c2 - gx * s2); }
        __syncthreads(); }
}
__device__ __forceinline__ void fft_inv(float2* X) {
#pragma unroll 1
    for (int lq = 0; lq <= 12; lq += 2) { const int q = 1 << lq; const float rq = 1.0f / (float)(4 * q);
        for (int j = otid(); j < NFFT / 4; j += NTHR) { const int lo = j & (q - 1), base = ((j >> lq) << (lq + 2)) | lo;
            const float2 y0 = X[base], y1 = X[base + q], y2 = X[base + 2 * q], y3 = X[base + 3 * q];
            const float fr = (float)lo * rq; const float c = __builtin_amdgcn_cosf(fr), s = __builtin_amdgcn_sinf(fr), c2 = c * c - s * s, s2 = 2.f * c * s;
            const float tx = y1.x * c2 - y1.y * s2, ty = y1.x * s2 + y1.y * c2;
            const float a0x = y0.x + tx, a0y = y0.y + ty, a1x = y0.x - tx, a1y = y0.y - ty;
            const float ux = y3.x * c2 - y3.y * s2, uy = y3.x * s2 + y3.y * c2;
            const float a2x = y2.x + ux, a2y = y2.y + uy, a3x = y2.x - ux, a3y = y2.y - uy;
            const float vx = a2x * c - a2y * s, vy = a2x * s + a2y * c;
            const float mx = a3x * c - a3y * s, my = a3x * s + a3y * c;
            const float wx = -my, wy = mx;
            X[base] = make_float2(a0x + vx, a0y + vy); X[base + 2 * q] = make_float2(a0x - vx, a0y - vy);
            X[base + q] = make_float2(a1x + wx, a1y + wy); X[base + 3 * q] = make_float2(a1x - wx, a1y - wy); }
        __syncthreads(); }
}
__device__ __forceinline__ float hy_delta(int c) { const float lo = -4.605170185988091f / 1.5f, hi = -4.605170185988091f / 0.3f; return fabsf(lo + (float)c * ((hi - lo) / 255.0f)); }
__device__ __forceinline__ float hy_short(const bf16_t* PHYT, const float* cw, const float* cb, int row, int col) {
    bool hp, hn; row_nbrs(row, hp, hn);
    const bf16_t* p = PHYT + (size_t)col * T + row;
    float v = cb[col] + cw[HY_IN + col] * bf2f(p[0]);
    if (hp) v += cw[col] * bf2f(p[-1]);
    if (hn) v += cw[2 * HY_IN + col] * bf2f(p[1]);
    return v;
}
struct HyTap { float w0, w1, w2, b; };
__device__ __forceinline__ HyTap hy_tap(const float* cw, const float* cb, int col) { HyTap t; t.w0 = cw[col]; t.w1 = cw[HY_IN + col]; t.w2 = cw[2 * HY_IN + col]; t.b = cb[col]; return t; }
__device__ __forceinline__ float hy_lat(const bf16_t* colp, int b, int n, const HyTap t) {
    const bf16_t* p = colp + b * SEQ + n;
    const float xm = bf2f(p[n > 0 ? -1 : 0]), x0 = bf2f(p[0]), xp = bf2f(p[n < SEQ - 1 ? 1 : 0]);
    return t.b + t.w1 * x0 + (n > 0 ? t.w0 * xm : 0.f) + (n < SEQ - 1 ? t.w2 * xp : 0.f);
}
__device__ __forceinline__ void hy_spec_task(const Params& P, int l, int c, float2* X) {
    const int tid = otid();
    const bf16_t* f0 = (const bf16_t*)(P.ws + WS_FILT) + (size_t)c * SEQ; const bf16_t* b0 = f0 + (size_t)256 * SEQ; const bf16_t* f1 = f0 + (size_t)512 * SEQ; const bf16_t* b1 = f0 + (size_t)768 * SEQ;
    for (int n = tid; n < SEQ; n += NTHR) {
        X[n] = make_float2(bf2f(f0[n]), bf2f(f1[n]));
        if (n > 0) X[NFFT - n] = make_float2(bf2f(b0[n]), bf2f(b1[n])); else X[SEQ] = make_float2(0.f, 0.f); }
    __syncthreads();
    fft_fwd(X);
    float2* spec = (float2*)(P.ws + WS_SPEC) + (size_t)c * NFFT;
    for (int i = tid; i < NFFT; i += NTHR) spec[i] = X[i];
    __syncthreads();
}
__device__ __forceinline__ void hy_conv_core(const Params& P, int o, int c, float2* X) {
    fft_fwd(X);
    const float2* spec = (const float2*)(P.ws + WS_SPEC) + (size_t)c * NFFT;
    for (int i = otid(); i < NFFT; i += NTHR) {
        const unsigned f = __brev((unsigned)i) >> 18;
        const unsigned ip = __brev(((unsigned)NFFT - f) & (unsigned)(NFFT - 1)) >> 18;
        const float2 a = X[i], w = spec[i], w2 = spec[ip];
        const float kx = o == 0 ? 0.5f * (w.x + w2.x) : 0.5f * (w.y + w2.y), ky = o == 0 ? 0.5f * (w.y - w2.y) : -0.5f * (w.x - w2.x);
        X[i] = make_float2(a.x * kx - a.y * ky, a.x * ky + a.y * kx); }
    __syncthreads();
    fft_inv(X);
}
__device__ __forceinline__ void hy_task1(const Params& P, int l, int c, float2* X, float* ex) {
    const int tid = otid();
    const bf16_t* PHY = (const bf16_t*)(P.ws + WS_PHY); const float* cw = P.in[I_HCW] + (size_t)l * 3 * HY_IN; const float* cb = P.in[I_HCB] + (size_t)l * HY_IN;
    const float bias0 = P.in[I_HBIAS][(size_t)l * 2 * HYC + c], bias1 = P.in[I_HBIAS][(size_t)l * 2 * HYC + HYC + c];
    const HyTap tv = hy_tap(cw, cb, c), tg1 = hy_tap(cw, cb, HYC + c); const bf16_t* colv = PHY + (size_t)c * T; const bf16_t* colg1 = PHY + (size_t)(HYC + c) * T;
#pragma unroll 4
    for (int n = tid; n < SEQ; n += NTHR) { X[n] = make_float2(hy_lat(colv, 0, n, tv), hy_lat(colv, 1, n, tv)); X[SEQ + n] = make_float2(0.f, 0.f); }
    __syncthreads();
    hy_conv_core(P, 0, c, X);
    float* Z1 = (float*)(P.ws + WS_Z1) + (size_t)c * NB * SEQ;
#pragma unroll 4
    for (int n = tid; n < SEQ; n += NTHR) { const float2 y = X[n];
        const float v0 = hy_lat(colv, 0, n, tv), v1 = hy_lat(colv, 1, n, tv), g0 = hy_lat(colg1, 0, n, tg1), g1 = hy_lat(colg1, 1, n, tg1);
        Z1[n] = g0 * (y.x + bias0 * v0); Z1[SEQ + n] = g1 * (y.y + bias0 * v1); }
    __syncthreads();
    float* f = (float*)X;
    float* vv = f, *x1 = f + 512, *x2 = f + 1024, *hf = f + 1536  , *z1 = f + 2560;
    const bf16_t* fc = (const bf16_t*)(P.ws + WS_FILTC);
    { const int b = tid >> 8, t = tid & 255, row = TL + b * CTX + t;
      vv[tid] = hy_short(PHY, cw, cb, row, c); x1[tid] = hy_short(PHY, cw, cb, row, HYC + c); x2[tid] = hy_short(PHY, cw, cb, row, 2 * HYC + c);
      for (int q = tid; q < 1024; q += NTHR) { const int od = q >> 8, n = q & 255; hf[q] = bf2f(fc[(size_t)(od * 256 + c) * CTX + n]); } }
    __syncthreads();
    { const int b = tid >> 8, t = tid & 255; float y = bias0 * vv[tid];
      for (int s = 0; s <= t; ++s) y += hf[t - s] * vv[b * 256 + s];
      for (int s = t + 1; s < CTX; ++s) y += hf[256 + s - t] * vv[b * 256 + s];
      z1[tid] = x1[tid] * y; }
    __syncthreads();
    { const int b = tid >> 8, t = tid & 255; float y = bias1 * z1[tid];
      for (int s = 0; s <= t; ++s) y += hf[512 + t - s] * z1[b * 256 + s];
      for (int s = t + 1; s < CTX; ++s) y += hf[768 + s - t] * z1[b * 256 + s];
      bf16_t* MIX = (bf16_t*)(P.ws + WS_U); MIX[(size_t)(TL + b * CTX + t) * D + c] = f2bf(x2[tid] * y); }
    __syncthreads();
}
__device__ __forceinline__ void hy_task2(const Params& P, int l, int c, float2* X) {
    const int tid = otid();
    const bf16_t* PHY = (const bf16_t*)(P.ws + WS_PHY); const float* cw = P.in[I_HCW] + (size_t)l * 3 * HY_IN; const float* cb = P.in[I_HCB] + (size_t)l * HY_IN;
    const float bias1 = P.in[I_HBIAS][(size_t)l * 2 * HYC + HYC + c];
    const float* Z1 = (const float*)(P.ws + WS_Z1) + (size_t)c * NB * SEQ; float* Z1w = (float*)(P.ws + WS_Z1) + (size_t)c * NB * SEQ;
    for (int n = tid; n < SEQ; n += NTHR) { X[n] = make_float2(Z1[n], Z1[SEQ + n]); X[SEQ + n] = make_float2(0.f, 0.f); }
    __syncthreads();
    hy_conv_core(P, 1, c, X);
    bf16_t* MIX = (bf16_t*)(P.ws + WS_U);
    const HyTap tg2 = hy_tap(cw, cb, 2 * HYC + c); const bf16_t* colg2 = PHY + (size_t)(2 * HYC + c) * T;
#pragma unroll 4
    for (int n = tid; n < SEQ; n += NTHR) { const float2 y = X[n];
        const float g0 = hy_lat(colg2, 0, n, tg2), g1 = hy_lat(colg2, 1, n, tg2);
        Z1w[n] = g0 * (y.x + bias1 * Z1[n]); Z1w[SEQ + n] = g1 * (y.y + bias1 * Z1[SEQ + n]); }
    __syncthreads();
}

constexpr int SEGC = 256, NSEG = 33, SCH = 4;
typedef float f32x2v __attribute__((ext_vector_type(2)));
template <bool IDENT>
__device__ __forceinline__ void scan_seg(const Params& P, int chain, int g, float* ring_  ) {
    const ldsfp ring = vlds(ring_);
    const int lane = otid() & 63;
    const int d = chain & 1, h = (chain >> 1) % 6, b = chain / 12;
    const float* DEC = (const float*)(P.ws + WS_DECAY) + (size_t)d * T * 384; const bf16_t* KKS = (const bf16_t*)(P.ws + WS_KKS); const bf16_t* RS = (const bf16_t*)(P.ws + WS_RS);
    const bf16_t* VS = (const bf16_t*)(P.ws + WS_VS); const bf16_t* KS = (const bf16_t*)(P.ws + WS_KS) + (size_t)d * T * 384; const bf16_t* BS = (const bf16_t*)(P.ws + WS_BS) + (size_t)d * T * 384;
    float* YD = (float*)(P.ws + WS_YDIR) + (size_t)d * T * 384;
    bf16_t* E = (bf16_t*)(P.ws + WS_E) + (size_t)chain * SEQ * 64;
    const int step0 = g == 0 ? 0 : CTX + (g - 1) * SEGC;
    f32x2v S0[32], S1[32];
#pragma unroll
    for (int j = 0; j < 32; ++j) { S0[j] = (f32x2v){0.f, 0.f}; S1[j] = (f32x2v){(2 * j == lane) ? 1.f : 0.f, (2 * j + 1 == lane) ? 1.f : 0.f}; }
    float pw[SCH], pa[SCH], pb[SCH], pk[SCH], pr[SCH], pv[SCH]; int po[SCH];
#pragma unroll
    for (int s = 0; s < SCH; ++s) { const int o = scan_row(b, d, step0 + s) * 384 + h * 64 + lane; po[s] = o;
        pw[s] = DEC[o]; pa[s] = bf2f(KKS[o]); pb[s] = bf2f(BS[o]); pk[s] = bf2f(KS[o]); pr[s] = bf2f(RS[o]); pv[s] = bf2f(VS[o]); }
    for (int c = 0; c < SEGC / SCH; ++c) {
        float cv[SCH]; int co[SCH];
        asm volatile("s_waitcnt lgkmcnt(0)" ::: "memory");
#pragma unroll
        for (int s = 0; s < SCH; ++s) { const ldsfp sv = ring + s * 320; sv[lane] = pw[s]; sv[64 + lane] = pa[s]; sv[128 + lane] = pb[s]; sv[192 + lane] = pk[s]; sv[256 + lane] = pr[s]; cv[s] = pv[s]; co[s] = po[s]; }
        asm volatile("s_waitcnt lgkmcnt(0)" ::: "memory");
        if (c + 1 < SEGC / SCH) {
#pragma unroll
            for (int s = 0; s < SCH; ++s) { const int o = scan_row(b, d, step0 + (c + 1) * SCH + s) * 384 + h * 64 + lane; po[s] = o;
                pw[s] = DEC[o]; pa[s] = bf2f(KKS[o]); pb[s] = bf2f(BS[o]); pk[s] = bf2f(KS[o]); pr[s] = bf2f(RS[o]); pv[s] = bf2f(VS[o]); } }
#pragma unroll
        for (int s = 0; s < SCH; ++s) { const ldsfp sv = ring + s * 320;
            f32x2v sa2 = (f32x2v){0.f, 0.f}, sb2 = (f32x2v){0.f, 0.f}, sa3 = sa2, sb3 = sa2;
#pragma unroll
            for (int hb = 0; hb < 2; ++hb) { f32x4 A[8];
#pragma unroll
                for (int i = 0; i < 8; ++i) A[i] = *(const LAS f32x4*)(sv + 64 + hb * 32 + 4 * i);
                __builtin_amdgcn_sched_barrier(0);
#pragma unroll
                for (int i = 0; i < 8; ++i) { const int jj = hb * 16 + 2 * i; const f32x2v alo = (f32x2v){A[i].x, A[i].y}, ahi = (f32x2v){A[i].z, A[i].w};
                    sa2 += S0[jj] * alo; sa3 += S0[jj + 1] * ahi;
                    if (IDENT) { sb2 += S1[jj] * alo; sb3 += S1[jj + 1] * ahi; } }
                __builtin_amdgcn_sched_barrier(0); }
            const float sa = (sa2.x + sa2.y) + (sa3.x + sa3.y), sb = (sb2.x + sb2.y) + (sb3.x + sb3.y);
            const f32x2v saa = (f32x2v){sa, sa}, sbb = (f32x2v){sb, sb}, vv = (f32x2v){cv[s], cv[s]};
            f32x2v y2 = (f32x2v){0.f, 0.f}, y3 = y2, e2 = y2, e3 = y2;
#pragma unroll
            for (int ch = 0; ch < 8; ++ch) { f32x4 W[2], Bq[2], K[2], R[2];
#pragma unroll
                for (int i = 0; i < 2; ++i) { const int j = ch * 8 + 4 * i; W[i] = *(const LAS f32x4*)(sv + j); Bq[i] = *(const LAS f32x4*)(sv + 128 + j); K[i] = *(const LAS f32x4*)(sv + 192 + j); R[i] = *(const LAS f32x4*)(sv + 256 + j); }
                __builtin_amdgcn_sched_barrier(0);
#pragma unroll
                for (int i = 0; i < 2; ++i) { const int jj = ch * 4 + 2 * i;
                    const f32x2v wlo = (f32x2v){W[i].x, W[i].y}, whi = (f32x2v){W[i].z, W[i].w}, blo = (f32x2v){Bq[i].x, Bq[i].y}, bhi = (f32x2v){Bq[i].z, Bq[i].w};
                    const f32x2v klo = (f32x2v){K[i].x, K[i].y}, khi = (f32x2v){K[i].z, K[i].w}, rlo = (f32x2v){R[i].x, R[i].y}, rhi = (f32x2v){R[i].z, R[i].w};
                    S0[jj] = S0[jj] * wlo + saa * blo + vv * klo; y2 += S0[jj] * rlo;
                    S0[jj + 1] = S0[jj + 1] * whi + saa * bhi + vv * khi; y3 += S0[jj + 1] * rhi;
                    if (IDENT) { S1[jj] = S1[jj] * wlo + sbb * blo; e2 += S1[jj] * rlo; S1[jj + 1] = S1[jj + 1] * whi + sbb * bhi; e3 += S1[jj + 1] * rhi; } }
                __builtin_amdgcn_sched_barrier(0); }
            YD[co[s]] = (y2.x + y2.y) + (y3.x + y3.y);
            if (IDENT) { const int tl = d ? (SEQ - 1 - (step0 - CTX + c * SCH + s)) : (step0 - CTX + c * SCH + s); E[(size_t)tl * 64 + lane] = f2bf((e2.x + e2.y) + (e3.x + e3.y)); }
        }
    }
    float* ZP = (float*)(P.ws + WS_ZP) + ((size_t)chain * NSEG + g) * 2 * 4096;
#pragma unroll
    for (int j = 0; j < 32; j += 2) { *(float4*)(ZP + lane * 64 + 2 * j) = make_float4(S0[j].x, S0[j].y, S0[j + 1].x, S0[j + 1].y);
        if (IDENT) *(float4*)(ZP + 4096 + lane * 64 + 2 * j) = make_float4(S1[j].x, S1[j].y, S1[j + 1].x, S1[j + 1].y); }
}
typedef float f32x16 __attribute__((ext_vector_type(16)));
__device__ __forceinline__ void scan_combine(const Params& P, int chain, float* lds) {
    const int tid = otid(), lane = tid & 63, wv = tid >> 6, li = lane & 31, lh = lane >> 5;
    const ldsfp Sl = vlds(lds);
    const ldsfp Pl = Sl + 64 * 65;
    float* ZPc = (float*)(P.ws + WS_ZP) + (size_t)chain * NSEG * 2 * 4096;
    const int ti = (wv >> 1) & 1, tj = wv & 1;
    float pn[8];
#pragma unroll
    for (int q = 0; q < 8; ++q) { pn[q] = ZPc[(size_t)2 * 4096 + 4096 + tid * 8 + q]; Sl[(tid >> 3) * 65 + (tid & 7) * 8 + q] = ZPc[tid * 8 + q]; }
    f32x16 acc, zn;
#pragma unroll
    for (int r = 0; r < 16; ++r) { zn[r] = 0.f; acc[r] = 0.f; }
    if (wv < 4) {
#pragma unroll
        for (int r = 0; r < 16; ++r) zn[r] = ZPc[(size_t)2 * 4096 + (32 * ti + (r & 3) + 8 * (r >> 2) + 4 * lh) * 64 + 32 * tj + li]; }
    for (int g = 1; g < NSEG - 1; ++g) {
        __syncthreads();
        if (g > 1 && wv < 4) {
#pragma unroll
            for (int r = 0; r < 16; ++r) Sl[(32 * ti + (r & 3) + 8 * (r >> 2) + 4 * lh) * 65 + 32 * tj + li] = acc[r]; }
#pragma unroll
        for (int q = 0; q < 8; ++q) Pl[tid * 8 + q] = pn[q];
        acc = zn;
        if (g + 1 < NSEG - 1) { const float* nx = ZPc + (size_t)(g + 1) * 2 * 4096;
#pragma unroll
            for (int q = 0; q < 8; ++q) pn[q] = nx[4096 + tid * 8 + q];
            if (wv < 4) {
#pragma unroll
                for (int r = 0; r < 16; ++r) zn[r] = nx[(32 * ti + (r & 3) + 8 * (r >> 2) + 4 * lh) * 64 + 32 * tj + li]; } }
        __syncthreads();
        if (wv < 4) {
#pragma unroll 8
            for (int k0 = 0; k0 < 64; k0 += 2) { const float av = Sl[(32 * ti + li) * 65 + k0 + lh], bv = Pl[(k0 + lh) * 64 + 32 * tj + li];
                acc = __builtin_amdgcn_mfma_f32_32x32x2f32(av, bv, acc, 0, 0, 0); }
            float* Zg = ZPc + (size_t)g * 2 * 4096;
#pragma unroll
            for (int r = 0; r < 16; ++r) Zg[(32 * ti + (r & 3) + 8 * (r >> 2) + 4 * lh) * 64 + 32 * tj + li] = acc[r]; }
    }
    __syncthreads();
}

__device__ __forceinline__ void rwkv_out_fin(const Params& P, int row, int c, float y, float lnw, float lnb, float bon, float vs, float gt) {
    bf16_t* MIX = (bf16_t*)(P.ws + WS_U);
    const float mean = wsum(y) * (1.0f / 64.0f); const float dv = y - mean; const float var = wsum(dv * dv) * (1.0f / 64.0f);
    const float yn = dv * rsqrtf(var + 64e-5f) * lnw + lnb;
    MIX[(size_t)row * D + 256 + c] = f2bf((yn + bon * vs) * gt);
}
__device__ __forceinline__ void ph_rwkvout(const Params& P, int l, float* ldsf) {
    using pg8::bf16x8;
    const int tid = otid(), lane = tid & 63, fr = lane & 15, fq = lane >> 4, wv = tid >> 6, gw = blockIdx.x * NWAVE + wv, nw = gridDim.x * NWAVE;
    const float* YD = (const float*)(P.ws + WS_YDIR); const bf16_t* VS = (const bf16_t*)(P.ws + WS_VS); const bf16_t* GT = (const bf16_t*)(P.ws + WS_GATE); const float* BON = (const float*)(P.ws + WS_BONUS);
    bf16_t* MIX = (bf16_t*)(P.ws + WS_U);
    for (int it = gw; it < NB * 6 * 32 * 4; it += nw) {
        const int sub = it & 3, q = (it >> 2) & 31, h = (it >> 7) % 6, b = it / (128 * 6);
        const int t0 = q * 256 + sub * 64;
        f32x4 acc[4][4];
#pragma unroll
        for (int mt = 0; mt < 4; ++mt)
#pragma unroll
            for (int nt = 0; nt < 4; ++nt) acc[mt][nt] = (f32x4){0.f, 0.f, 0.f, 0.f};
#pragma unroll
        for (int dir = 0; dir < 2; ++dir) { const int ch = b * 12 + h * 2 + dir, slot = dir ? (31 - q) : q;
            const float* Sp = (const float*)(P.ws + WS_ZP) + ((size_t)ch * NSEG + slot) * 2 * 4096;
            const bf16_t* Ep = (const bf16_t*)(P.ws + WS_E) + ((size_t)ch * SEQ + t0) * 64;
#pragma unroll
            for (int ks = 0; ks < 2; ++ks) { bf16x8 bop[4];
#pragma unroll
                for (int nt = 0; nt < 4; ++nt) { const float* sp = Sp + (nt * 16 + fr) * 64 + ks * 32 + fq * 8; const float4 s0 = *(const float4*)sp, s1 = *(const float4*)(sp + 4);
                    u32x4 w; w.x = cvt_pk_bf16(s0.x, s0.y); w.y = cvt_pk_bf16(s0.z, s0.w); w.z = cvt_pk_bf16(s1.x, s1.y); w.w = cvt_pk_bf16(s1.z, s1.w); bop[nt] = __builtin_bit_cast(bf16x8, w); }
#pragma unroll
                for (int mt = 0; mt < 4; ++mt) { const bf16x8 a = *(const bf16x8*)(Ep + (size_t)(mt * 16 + fr) * 64 + ks * 32 + fq * 8);
#pragma unroll
                    for (int nt = 0; nt < 4; ++nt) acc[mt][nt] = __builtin_amdgcn_mfma_f32_16x16x32_bf16(bop[nt], a, acc[mt][nt], 0, 0, 0); } } }
        f32x4 lnw[4], lnb[4];
#pragma unroll
        for (int nt = 0; nt < 4; ++nt) { lnw[nt] = *(const f32x4*)(P.in[I_LNW] + l * RWW + h * 64 + nt * 16 + fq * 4); lnb[nt] = *(const f32x4*)(P.in[I_LNB] + l * RWW + h * 64 + nt * 16 + fq * 4); }
#pragma unroll
        for (int mt = 0; mt < 4; ++mt) { const int row = b * SEQ + t0 + mt * 16 + fr; const size_t o = (size_t)row * 384 + h * 64 + fq * 4;
            f32x4 y[4]; u32x2 vsw[4], gtw[4]; const float bon = BON[(size_t)row * 6 + h];
#pragma unroll
            for (int nt = 0; nt < 4; ++nt) { y[nt] = *(const f32x4*)(YD + o + nt * 16) + *(const f32x4*)(YD + (size_t)T * 384 + o + nt * 16) + acc[mt][nt];
                vsw[nt] = *(const u32x2*)(VS + o + nt * 16); gtw[nt] = *(const u32x2*)(GT + o + nt * 16); }
            float sm = 0.f;
#pragma unroll
            for (int nt = 0; nt < 4; ++nt) sm += (y[nt][0] + y[nt][1]) + (y[nt][2] + y[nt][3]);
            sm += __shfl_xor(sm, 16); sm += __shfl_xor(sm, 32);
            const float mean = sm * (1.0f / 64.0f);
            float vr = 0.f;
#pragma unroll
            for (int nt = 0; nt < 4; ++nt) { y[nt] = y[nt] - mean; vr += (y[nt][0] * y[nt][0] + y[nt][1] * y[nt][1]) + (y[nt][2] * y[nt][2] + y[nt][3] * y[nt][3]); }
            vr += __shfl_xor(vr, 16); vr += __shfl_xor(vr, 32);
            const float rstd = rsqrtf(vr * (1.0f / 64.0f) + 64e-5f);
#pragma unroll
            for (int nt = 0; nt < 4; ++nt) { const f32x4 yn = y[nt] * rstd * lnw[nt] + lnb[nt];
                const float o0 = (yn[0] + bon * lo_bf(vsw[nt].x)) * lo_bf(gtw[nt].x), o1 = (yn[1] + bon * hi_bf(vsw[nt].x)) * hi_bf(gtw[nt].x);
                const float o2 = (yn[2] + bon * lo_bf(vsw[nt].y)) * lo_bf(gtw[nt].y), o3 = (yn[3] + bon * hi_bf(vsw[nt].y)) * hi_bf(gtw[nt].y);
                u32x2 w; w.x = cvt_pk_bf16(o0, o1); w.y = cvt_pk_bf16(o2, o3);
                *(u32x2*)(MIX + (size_t)row * D + 256 + h * 64 + nt * 16 + fq * 4) = w; }
            asm volatile("" ::: "memory"); }
    }
    for (int it = gw; it < TC * 6; it += nw) { const int row = TL + it / 6, h = it % 6, c = h * 64 + lane; const size_t o = (size_t)row * 384 + c;
        rwkv_out_fin(P, row, c, YD[o] + YD[(size_t)T * 384 + o], P.in[I_LNW][l * RWW + c], P.in[I_LNB][l * RWW + c], BON[(size_t)row * 6 + h], bf2f(VS[o]), bf2f(GT[o])); }
}

__device__ __forceinline__ void zt_tile(const Params& P, int tile, float* tl  ) {
    const int tid = otid(); const int c0 = (tile & 3) * 64, t0 = (tile >> 2) * 64;
    const float* Z = (const float*)(P.ws + WS_Z1); bf16_t* MIX = (bf16_t*)(P.ws + WS_U);
    { const int cc = tid >> 3, sg = (tid & 7) * 8; const float* src = Z + (size_t)(c0 + cc) * TL + t0 + sg; const float4 a = *(const float4*)src, b = *(const float4*)(src + 4);
      tl[cc * 65 + sg + 0] = a.x; tl[cc * 65 + sg + 1] = a.y; tl[cc * 65 + sg + 2] = a.z; tl[cc * 65 + sg + 3] = a.w; tl[cc * 65 + sg + 4] = b.x; tl[cc * 65 + sg + 5] = b.y; tl[cc * 65 + sg + 6] = b.z; tl[cc * 65 + sg + 7] = b.w; }
    __syncthreads();
    { const int tk = tid >> 3, cs = (tid & 7) * 8;
      u32x4 w; w.x = cvt_pk_bf16(tl[(cs + 0) * 65 + tk], tl[(cs + 1) * 65 + tk]); w.y = cvt_pk_bf16(tl[(cs + 2) * 65 + tk], tl[(cs + 3) * 65 + tk]);
      w.z = cvt_pk_bf16(tl[(cs + 4) * 65 + tk], tl[(cs + 5) * 65 + tk]); w.w = cvt_pk_bf16(tl[(cs + 6) * 65 + tk], tl[(cs + 7) * 65 + tk]);
      *(u32x4*)(MIX + (size_t)(t0 + tk) * D + c0 + cs) = w; }
    __syncthreads();
}
typedef const __attribute__((address_space(4))) Params* KParamsPtr;
__device__ __forceinline__ const Params* fresh_params() { KParamsPtr q = (KParamsPtr)__builtin_amdgcn_kernarg_segment_ptr(); asm volatile("" : "+s"(q)); return (const Params*)q; }
__global__ void __launch_bounds__(NTHR, 2) fwd_megakernel(Params P_unused, int ph_lo, int ph_hi) {
    extern __shared__ __attribute__((aligned(16))) unsigned char smem[];
    cg::grid_group grid = cg::this_grid();
    LAS unsigned char* lds3 = (LAS unsigned char*)smem;
    float* ldsf = (float*)smem; float2* X = (float2*)smem; float* ex = (float*)(smem + LDS_MAIN);
    { volatile LAS unsigned* st = (volatile LAS unsigned*)(lds3 + LDS_MAIN + 4096); if (threadIdx.x == 0) { st[0] = 0u; st[1] = 0u; } }
    __syncthreads();
    XcdBarrier xbar = xcd_barrier_post((unsigned*)(((const Params*)fresh_params())->ws + WS_BAR), (volatile LAS unsigned*)(lds3 + LDS_MAIN + 4096));
    int ph = 0;
#ifndef REP_GEMM
#define REP_GEMM 1
#endif
#ifndef REP_SCAN
#define REP_SCAN 1
#endif
#ifndef REP_MISC
#define REP_MISC 1
#endif
#ifndef REP_HY
#define REP_HY 1
#endif
#define PHASE_BEGIN if (ph >= ph_lo && ph < ph_hi) { const Params& P = *fresh_params(); unsigned char* ws = P.ws; (void)ws;
#ifndef REP_SYNC
#define REP_SYNC 1
#endif
#define PHASE_END   if (ph + 1 < ph_hi) { for (int rs_ = 0; rs_ < REP_SYNC; ++rs_) { if (ph == 0) grid.sync(); else xcd_barrier(xbar); } } } ++ph;
    PHASE_BEGIN ph_modv(P, ldsf); PHASE_END
    for (int l = 0; l < DEPTH; ++l) {
        PHASE_BEGIN
            for (int rep_ = 0; rep_ < REP_MISC; ++rep_) ph_prep(P, l, ldsf);
            if (l == 0) ph_rowpass(P, 0, 0, 0, 0, 0.f, 0, 0, 0, 1, 1);
            else ph_rowpass(P, 1, l - 1, 8, 5, 0.5f, l, 0, 0, 1, 11);
        PHASE_END
        PHASE_BEGIN { EpiGU E{(bf16_t*)(ws + WS_ACT)}; for (int rep_ = 0; rep_ < REP_GEMM; ++rep_) run_gemm(lds3, (const bf16_t*)(ws + WS_U), (const bf16_t*)(ws + WS_WGU1), T, 2 * DFF, D, E); } PHASE_END
        PHASE_BEGIN { EpiF32 E{(bf16_t*)(ws + WS_Y), (float*)(ws + WS_YC)}; run_gemm_tail(lds3, (const bf16_t*)(ws + WS_ACT), (const bf16_t*)(ws + WS_WDN1), DFF, E); } PHASE_END
        PHASE_BEGIN ph_rowpass(P, 1, l, 2, 1, 0.5f, l, 2, 3, 4, 11); PHASE_END
        PHASE_BEGIN { EpiWin E{(bf16_t*)(ws + WS_PHY), (bf16_t*)(ws + WS_PRW), (bf16_t*)(ws + WS_PNA)}; for (int rep_ = 0; rep_ < REP_GEMM; ++rep_) run_gemm(lds3, (const bf16_t*)(ws + WS_U), (const bf16_t*)(ws + WS_WIN), T, INWP, D, E); } PHASE_END
        PHASE_BEGIN
            for (int rep_ = 0; rep_ < REP_MISC; ++rep_) { ph_loraprep(P, l);
            for (int it = blockIdx.x; it < NB * 128 * 6 + NB * 4 * 6; it += gridDim.x) vt_tile(P, it, (unsigned short*)smem); }
            for (int rep_ = 0; rep_ < REP_HY; ++rep_) for (int it = blockIdx.x; it < 256; it += gridDim.x) hy_spec_task(P, l, it, X);
        PHASE_END
        PHASE_BEGIN { EpiLora E{(bf16_t*)(ws + WS_LORAO), (bf16_t*)(ws + WS_GATE)};
            for (int rep_ = 0; rep_ < REP_GEMM; ++rep_) run_gemm(lds3, (const bf16_t*)(ws + WS_ALORA), (const bf16_t*)(ws + WS_WLORA), T, 2048, 384, E); } PHASE_END
        PHASE_BEGIN
            for (int rep_ = 0; rep_ < REP_MISC; ++rep_) ph_rwkvprep(P, l);
            for (int rep_ = 0; rep_ < REP_HY; ++rep_) for (int c = blockIdx.x; c < HYC; c += gridDim.x) hy_task1(P, l, c, X, ex);
        PHASE_END
        PHASE_BEGIN {
            const int wv = __builtin_amdgcn_readfirstlane(otid() >> 6);
            if (wv < 4) { const int k = wv * (int)gridDim.x + (int)blockIdx.x;
                if (k < 24 * NSEG) { const int chain = k / NSEG, g = k % NSEG; float* ring = ldsf + wv * (SCH * 320);
                    __builtin_amdgcn_s_setprio(3);
                    for (int rep_ = 0; rep_ < REP_SCAN; ++rep_) { if (g == 0) scan_seg<false>(P, chain, g, ring); else scan_seg<true>(P, chain, g, ring); }
                    __builtin_amdgcn_s_setprio(0); } }
            else for (int it = (wv - 4) * (int)gridDim.x + (int)blockIdx.x; it < NAT_TASKS; it += 4 * (int)gridDim.x) natten_task(P, l, it);
        } PHASE_END
        PHASE_BEGIN
            for (int rep_ = 0; rep_ < REP_HY; ++rep_) for (int c = blockIdx.x; c < HYC; c += gridDim.x) hy_task2(P, l, c, X);
            if (blockIdx.x >= gridDim.x - 24) scan_combine(P, (int)(gridDim.x - 1 - blockIdx.x), ldsf);
        PHASE_END
        PHASE_BEGIN for (int rep_ = 0; rep_ < REP_MISC; ++rep_) ph_rwkvout(P, l, ldsf);
            __syncthreads();
            for (int it = blockIdx.x; it < 4 * (TL / 64); it += gridDim.x) zt_tile(P, it, ldsf);
        PHASE_END
        PHASE_BEGIN { EpiF32 E{(bf16_t*)(ws + WS_Y), (float*)(ws + WS_YC)}; run_gemm_tail(lds3, (const bf16_t*)(ws + WS_U), (const bf16_t*)(ws + WS_WOUT), D, E); } PHASE_END
        PHASE_BEGIN ph_rowpass(P, 1, l, 5, 3, 1.0f, l, 4, 6, 7, 4); PHASE_END
        PHASE_BEGIN { EpiGU E{(bf16_t*)(ws + WS_ACT)}; for (int rep_ = 0; rep_ < REP_GEMM; ++rep_) run_gemm(lds3, (const bf16_t*)(ws + WS_U), (const bf16_t*)(ws + WS_WGU2), T, 2 * DFF, D, E); } PHASE_END
        PHASE_BEGIN { EpiF32 E{(bf16_t*)(ws + WS_Y), (float*)(ws + WS_YC)}; run_gemm_tail(lds3, (const bf16_t*)(ws + WS_ACT), (const bf16_t*)(ws + WS_WDN2), DFF, E); } PHASE_END
    }
    PHASE_BEGIN ph_rowpass(P, 2, DEPTH - 1, 8, 5, 0.5f, 0, 0, 0, 0, 11); PHASE_END
#undef PHASE_BEGIN
#undef PHASE_END
}
constexpr int N_PHASES = 1 + DEPTH * 15 + 1;

extern "C" void kernel_launch(void* const* d_in, const int* in_sizes, int n_in, void* d_out, int out_size, void* d_ws, size_t ws_size, hipStream_t stream) {
    static int grid = 0;
    if (grid == 0) {
        if (n_in != 34 || ws_size < WS_END) { fprintf(stderr, "kernel_launch: need 34 inputs and %zu bytes of workspace; got %d, %zu\n", (size_t)WS_END, n_in, ws_size); grid = -1; return; }
        int dev = 0, cus = 0, per_cu = 0;
        hipGetDevice(&dev); hipDeviceGetAttribute(&cus, hipDeviceAttributeMultiprocessorCount, dev);
        if (hipFuncSetAttribute((const void*)fwd_megakernel, hipFuncAttributeMaxDynamicSharedMemorySize, LDS_BYTES) != hipSuccess) { fprintf(stderr, "kernel_launch: hipFuncSetAttribute failed\n"); grid = -1; return; }
        if (hipOccupancyMaxActiveBlocksPerMultiprocessor(&per_cu, (const void*)fwd_megakernel, NTHR, LDS_BYTES) != hipSuccess || per_cu < 1) { fprintf(stderr, "kernel_launch: occupancy query says %d\n", per_cu); per_cu = 1; }
        (void)hipGetLastError();
        grid = cus;
    }
    if (grid < 0) return;
    if (hipMemsetAsync((char*)d_ws + WS_BAR, 0, (size_t)XCD_BAR_WORDS * 4, stream) != hipSuccess) { fprintf(stderr, "kernel_launch: memset of the barrier words failed\n"); return; }
    Params p{};
    for (int i = 0; i < 34; ++i) p.in[i] = (const float*)d_in[i];
    p.out = (float*)d_out; p.ws = (unsigned char*)d_ws;
#if MK_SPLIT
    for (int ph = 0; ph < N_PHASES; ++ph) { int lo = ph, hi = ph + 1; hipLaunchKernelGGL(fwd_megakernel, dim3(grid), dim3(NTHR), LDS_BYTES, stream, p, lo, hi); }
#else
    int lo = 0, hi = N_PHASES;
    void* args[] = {&p, &lo, &hi};
    hipError_t e = hipLaunchCooperativeKernel((const void*)fwd_megakernel, dim3(grid), dim3(NTHR), args, LDS_BYTES, stream);
    if (e != hipSuccess) fprintf(stderr, "cooperative launch failed: %s (grid %d)\n", hipGetErrorString(e), grid);
#endif
}
```

```cpp
#include <hip/hip_runtime.h>
#include <hip/hip_cooperative_groups.h>
#include <cstdio>
namespace cg = cooperative_groups;
__device__ __forceinline__ int otid() { int t = threadIdx.x; asm volatile("" : "+v"(t)); return t; }
namespace pg8 {
#define PG8_LAS __attribute__((address_space(3)))
typedef unsigned short bf16_t;
typedef short bf16x8 __attribute__((ext_vector_type(8)));
typedef float f32x4 __attribute__((ext_vector_type(4)));
typedef unsigned u32x4 __attribute__((ext_vector_type(4)));
constexpr int BM = 256, BK = 64, HALF = 128, HTB = HALF * BK * 2  , STAGE_BYTES = 8 * HTB, NXCD = 8, WGM = 8;

__host__ __device__ __forceinline__ int lds_byte(int r, int c) { const int st = (r >> 4) * 2 + (c >> 5), rr = r & 15, cc = c & 31, ob = rr * 64 + cc * 2; return st * 1024 + (ob ^ (((ob >> 9) & 1) << 5)); }
__host__ __device__ __forceinline__ void stage_rc(int b, int& R, int& C) { const int st = b / 1024, sb = b % 1024, swz = sb ^ (((sb >> 9) & 1) << 5); R = (st >> 1) * 16 + swz / 64; C = (st & 1) * 32 + (swz % 64) / 2; }
__host__ __device__ __forceinline__ int perm32(int rho) { const int n = rho >> 4, i = rho & 15; return 8 * (i >> 2) + 4 * n + (i & 3); }

struct Unit { int pm, pn, kt0, nkt; };
struct Gemm { const bf16_t* A; const bf16_t* Bt; int M, N, K; };
struct StaticOrder {
    int nM, nN, nwg, G, c;
    __host__ __device__ void init(int M, int N, int G_, int c_) { nM = M / BM; nN = N / BM; nwg = nM * nN; G = G_; c = c_; }
    __host__ __device__ bool next(int i, Unit& u) const {
        const long L = (long)i * G + c; if (L >= nwg) return false;
        int wgid = (int)L; { const int q = nwg / NXCD, r = nwg % NXCD, xcd = wgid % NXCD, off = wgid / NXCD; wgid = (xcd < r ? xcd * (q + 1) : r * (q + 1) + (xcd - r) * q) + off; }
        const int nig = WGM * nN, gid = wgid / nig, fm = gid * WGM, gsz = (nM - fm) < WGM ? (nM - fm) : WGM;
        u.pm = fm + ((wgid % nig) % gsz); u.pn = (wgid % nig) / gsz; u.kt0 = 0; u.nkt = 0; return true;
    }
    __device__ __forceinline__ void a_ready(const Unit&) const {}
    __device__ __forceinline__ void done(const Unit&) const {}
};
__device__ __forceinline__ unsigned cvt_pk_bf16(float lo, float hi) { unsigned r; asm volatile("v_cvt_pk_bf16_f32 %0, %1, %2" : "=v"(r) : "v"(lo), "v"(hi)); return r; }
template <class Epi, class Sched>
__device__ __forceinline__ void gemm_phase(PG8_LAS unsigned char* lds, const Gemm g, const Sched& S, const Epi& E) {
    const int tid = otid(), wid = __builtin_amdgcn_readfirstlane(tid >> 6), lane = tid & 63, wr = wid >> 2, wc = wid & 3, fr = lane & 15, fq = lane >> 4;
    const int K = g.K, nt = K / BK;
#define PG8_STAMP() do {} while (0)
    unsigned voffA[2], voffB[2];
#pragma unroll
    for (int i = 0; i < 2; ++i) { int R, C; stage_rc(tid * 16 + i * 8192, R, C); const int Rb = Epi::PERM ? ((R & ~31) + perm32(R & 31)) : R;
        voffA[i] = (unsigned)(R * K + C) * 2u; voffB[i] = (unsigned)(Rb * K + C) * 2u; }
    const size_t kstep = (size_t)(BK * 2);
    const size_t hstep = (size_t)HALF * K * 2;
    const size_t tstep = 2 * hstep;
    const unsigned ldsw = (unsigned)wid * 1024u;
    const int aoff = lds_byte(wr * 64 + fr, fq * 8), boff = lds_byte(wc * 32 + fr, fq * 8);
#define PG8_SA(b, h) (((b) * 2 + (h)) * HTB)
#define PG8_SB(b, h) ((4 + (b) * 2 + (h)) * HTB)
#define PG8_STAGE(bufoff, gbase, voff) do { _Pragma("unroll") for (int _i = 0; _i < 2; ++_i) \
        __builtin_amdgcn_global_load_lds((const unsigned*)((const char*)(gbase) + (voff)[_i]), (PG8_LAS unsigned*)(lds + (bufoff) + ldsw + _i * 8192), 16, 0, 0); } while (0)
#define PG8_LDA(dst, b, h) do { _Pragma("unroll") for (int m = 0; m < 4; ++m) _Pragma("unroll") for (int k = 0; k < 2; ++k) dst[m][k] = *(const PG8_LAS bf16x8*)(lds + PG8_SA(b, h) + aoff + m * 2048 + k * 1024); } while (0)
#define PG8_LDB(dst, b, h) do { _Pragma("unroll") for (int n = 0; n < 2; ++n) _Pragma("unroll") for (int k = 0; k < 2; ++k) dst[n][k] = *(const PG8_LAS bf16x8*)(lds + PG8_SB(b, h) + boff + n * 2048 + k * 1024); } while (0)
#define PG8_MMA(ai, bj, At, Bt) do { __builtin_amdgcn_s_setprio(1); _Pragma("unroll") for (int m = 0; m < 4; ++m) _Pragma("unroll") for (int n = 0; n < 2; ++n) _Pragma("unroll") for (int k = 0; k < 2; ++k) \
        acc[ai][bj][m][n] = __builtin_amdgcn_mfma_f32_16x16x32_bf16(Bt[n][k], At[m][k], acc[ai][bj][m][n], 0, 0, 0); __builtin_amdgcn_s_setprio(0); } while (0)
#define PG8_WAIT_V(n) asm volatile("s_waitcnt vmcnt(" #n ")" ::: "memory")
#define PG8_WAIT_L(n) asm volatile("s_waitcnt lgkmcnt(" #n ")" ::: "memory")
#define PG8_BAR __builtin_amdgcn_s_barrier()
#define PG8_SCHED __builtin_amdgcn_sched_barrier(0)
    Unit cur, nxt; int ui = 0;
    if (!S.next(0, cur)) return;
    f32x4 acc[2][2][4][2];
#pragma unroll
    for (int a = 0; a < 2; ++a)
#pragma unroll
        for (int b = 0; b < 2; ++b)
#pragma unroll
            for (int m = 0; m < 4; ++m)
#pragma unroll
                for (int n = 0; n < 2; ++n) acc[a][b][m][n] = (f32x4){0.f, 0.f, 0.f, 0.f};
    bf16x8 At[4][2], B0[2][2], B1[2][2];
    const char* cA = (const char*)g.A + (size_t)cur.pm * tstep + (size_t)cur.kt0 * kstep; const char* cB = (const char*)g.Bt + (size_t)cur.pn * tstep + (size_t)cur.kt0 * kstep;
    int ntc = cur.nkt > 0 ? cur.nkt : nt;
    S.a_ready(cur);
    PG8_STAGE(PG8_SB(0, 0), cB, voffB); PG8_STAGE(PG8_SA(0, 0), cA, voffA); PG8_STAGE(PG8_SB(0, 1), cB + hstep, voffB); PG8_STAGE(PG8_SA(0, 1), cA + hstep, voffA);
    if (wr == 1) PG8_BAR;
    PG8_WAIT_V(4); PG8_BAR;
    PG8_STAGE(PG8_SB(1, 0), cB + kstep, voffB); PG8_STAGE(PG8_SA(1, 0), cA + kstep, voffA); PG8_STAGE(PG8_SB(1, 1), cB + hstep + kstep, voffB);
    PG8_WAIT_V(6); PG8_BAR;
    PG8_STAMP();
    for (;;) {
        const bool has_next = S.next(ui + 1, nxt);
        const char* nA = has_next ? (const char*)g.A + (size_t)nxt.pm * tstep + (size_t)nxt.kt0 * kstep : cA; const char* nB = has_next ? (const char*)g.Bt + (size_t)nxt.pn * tstep + (size_t)nxt.kt0 * kstep : cB;
        for (int t = 0; t < ntc; t += 2) {
            const bool last = (t == ntc - 2);
            const char* a1 = cA + (size_t)(t + 1) * kstep;
            const char* a2 = last ? nA : cA + (size_t)(t + 2) * kstep; const char* b2 = last ? nB : cB + (size_t)(t + 2) * kstep;
            const char* a3 = a2 + kstep; const char* b3 = b2 + kstep;
            if (last && has_next) S.a_ready(nxt);
            PG8_LDB(B0, 0, 0); PG8_SCHED; PG8_LDA(At, 0, 0); PG8_STAGE(PG8_SA(1, 1), a1 + hstep, voffA);
            PG8_WAIT_L(8); PG8_BAR; PG8_WAIT_L(0); PG8_MMA(0, 0, At, B0); PG8_BAR; PG8_SCHED;
            PG8_LDB(B1, 0, 1); PG8_STAGE(PG8_SB(0, 0), b2, voffB);
            PG8_BAR; PG8_WAIT_L(0); PG8_MMA(0, 1, At, B1); PG8_BAR;
            PG8_LDA(At, 0, 1); PG8_STAGE(PG8_SA(0, 0), a2, voffA);
            PG8_BAR; PG8_WAIT_L(0); PG8_MMA(1, 0, At, B0); PG8_BAR; PG8_SCHED;
            PG8_STAGE(PG8_SB(0, 1), b2 + hstep, voffB);
            PG8_WAIT_V(6); PG8_BAR; PG8_MMA(1, 1, At, B1); PG8_BAR;
            PG8_LDB(B0, 1, 0); PG8_SCHED; PG8_LDA(At, 1, 0); PG8_STAGE(PG8_SA(0, 1), a2 + hstep, voffA);
            PG8_WAIT_L(8); PG8_BAR; PG8_WAIT_L(0); PG8_MMA(0, 0, At, B0); PG8_BAR; PG8_SCHED;
            PG8_LDB(B1, 1, 1); PG8_STAGE(PG8_SB(1, 0), b3, voffB);
            PG8_BAR; PG8_WAIT_L(0); PG8_MMA(0, 1, At, B1); PG8_BAR;
            PG8_LDA(At, 1, 1); PG8_STAGE(PG8_SA(1, 0), a3, voffA);
            PG8_BAR; PG8_WAIT_L(0); PG8_MMA(1, 0, At, B0); PG8_BAR; PG8_SCHED;
            PG8_STAGE(PG8_SB(1, 1), b3 + hstep, voffB);
            PG8_WAIT_V(6); PG8_BAR; PG8_MMA(1, 1, At, B1); PG8_BAR;
        }
        PG8_STAMP();
        if constexpr (!Epi::AFTER_DRAIN) { E(acc, cur, wr, wc, fr, fq); S.done(cur); }
        PG8_STAMP();
        if (!has_next) break;
#pragma unroll
        for (int a = 0; a < 2; ++a)
#pragma unroll
            for (int b = 0; b < 2; ++b)
#pragma unroll
                for (int m = 0; m < 4; ++m)
#pragma unroll
                    for (int n = 0; n < 2; ++n) acc[a][b][m][n] = (f32x4){0.f, 0.f, 0.f, 0.f};
        cur = nxt; cA = nA; cB = nB; ++ui; ntc = cur.nkt > 0 ? cur.nkt : nt;
    }
    PG8_WAIT_V(0);
    if (wr == 0) PG8_BAR;
    PG8_BAR;
    if constexpr (Epi::AFTER_DRAIN) { E.fused(acc, cur, wr, wc, fr, fq, lds, wid, lane); S.done(cur); }
    PG8_STAMP();
#undef PG8_STAMP
#undef PG8_SA
#undef PG8_SB
#undef PG8_STAGE
#undef PG8_LDA
#undef PG8_LDB
#undef PG8_MMA
#undef PG8_WAIT_V
#undef PG8_WAIT_L
#undef PG8_BAR
#undef PG8_SCHED
}
}
#define LAS __attribute__((address_space(3)))
#define XB_TMO      128
#define XB_XCNT(j)  (256  + 64 * (j))
#define XB_XSUB(j)  (1280 + 64 * (j))
#define XB_XGEN(j)  (2304 + 64 * (j))
#define XB_TOP      3328
#define XB_TOPGEN   3392
#define XCD_BAR_WORDS 3456
#define XB_SPIN_CAP (1u << 18)

__device__ __forceinline__ unsigned xb_ld(unsigned* p)              { return __hip_atomic_load(p, __ATOMIC_RELAXED, __HIP_MEMORY_SCOPE_AGENT); }
__device__ __forceinline__ unsigned xb_add(unsigned* p, unsigned v) { return __hip_atomic_fetch_add(p, v, __ATOMIC_RELAXED, __HIP_MEMORY_SCOPE_AGENT); }
__device__ __forceinline__ unsigned xb_xcc_id() { return (unsigned)__builtin_amdgcn_s_getreg((3 << 11) | 20) & 0xFu; }
#define XB_SPIN(cond, bar) do { unsigned _sp = 0; while (cond) { __builtin_amdgcn_s_sleep(1); \
    if ((++_sp & 255u) == 0u) { if (xb_ld(&(bar)[XB_TMO])) break; if (_sp > XB_SPIN_CAP) { atomicAdd(&(bar)[XB_TMO], 1u); break; } } } } while (0)

struct XcdBarrier {
    unsigned* bar; unsigned x;
    volatile LAS unsigned* st;
};

__device__ __forceinline__ XcdBarrier xcd_barrier_post(unsigned* bar, volatile LAS unsigned* st) {
    XcdBarrier b; b.bar = bar; b.x = xb_xcc_id(); b.st = st;
    if (threadIdx.x == 0) (void)xb_add(&bar[XB_XCNT(b.x)], 1u);
    return b;
}
__device__ __forceinline__ void xcd_barrier_complete(unsigned* bar, unsigned x, unsigned& nloc, unsigned& nx) {
    const unsigned G = gridDim.x * gridDim.y * gridDim.z;
    unsigned sum, cnt, mine, sp = 0u;
    for (;;) {
        sum = 0u; cnt = 0u; mine = 0u;
#pragma unroll
        for (unsigned j = 0; j < 16; ++j) { const unsigned c = xb_ld(&bar[XB_XCNT(j)]); sum += c; cnt += (c > 0u) ? 1u : 0u; mine = (j == x) ? c : mine; }
        if (sum == G) break;
        __builtin_amdgcn_s_sleep(1);
        if ((++sp & 255u) == 0u) { if (xb_ld(&bar[XB_TMO])) break; if (sp > XB_SPIN_CAP) { atomicAdd(&bar[XB_TMO], 1u); break; } }
    }
    nloc = mine > 0u ? mine : 1u; nx = cnt > 0u ? cnt : 1u;
}

__device__ __forceinline__ void xcd_barrier(const XcdBarrier& b) {
    asm volatile("s_waitcnt vmcnt(0)" ::: "memory");
    __syncthreads();
    if (threadIdx.x == 0) {
        unsigned* bar = b.bar;
        __builtin_amdgcn_s_waitcnt(0);
        unsigned nloc = b.st[0], nx = b.st[1];
        if (nloc == 0u) { xcd_barrier_complete(bar, b.x, nloc, nx); b.st[0] = nloc; b.st[1] = nx; }
        const unsigned old = xb_add(&bar[XB_XSUB(b.x)], 1u);
        const unsigned gen = old / nloc;
        if (old + 1u == (gen + 1u) * nloc) {
            __builtin_amdgcn_fence(__ATOMIC_RELEASE, "agent");
            asm volatile("s_waitcnt vmcnt(0)" ::: "memory");
            const unsigned og = xb_add(&bar[XB_TOP], 1u);
            const unsigned tg = og / nx;
            if (og + 1u == (tg + 1u) * nx) xb_add(&bar[XB_TOPGEN], 1u);
            else XB_SPIN(xb_ld(&bar[XB_TOPGEN]) == tg, bar);
            __builtin_amdgcn_fence(__ATOMIC_ACQUIRE, "agent");
            xb_add(&bar[XB_XGEN(b.x)], 1u);
            asm volatile("s_waitcnt vmcnt(0)" ::: "memory");
        } else {
            XB_SPIN(xb_ld(&bar[XB_XGEN(b.x)]) == gen, bar);
            __builtin_amdgcn_fence(__ATOMIC_ACQUIRE, "agent");
            asm volatile("s_waitcnt vmcnt(0)" ::: "memory");
        }
    }
    __syncthreads();
}

using pg8::bf16_t; using pg8::f32x4; using pg8::u32x4; using pg8::cvt_pk_bf16;
typedef unsigned u32x2 __attribute__((ext_vector_type(2)));


constexpr int D = 1024, NB = 2, SEQ = 8192, DEPTH = 4, CTX = 256, DFF = 2816;
constexpr int TL = NB * SEQ, TC = NB * CTX, T = TL + TC;
constexpr int NMOD = 9 * D;
constexpr int HYC = 256, RWW = 384, NAW = 384, INW = 3456, INWP = 3584;
constexpr int HY_IN = 768, RW_IN = 1536, NA_IN = 1152;
constexpr int NFFT = 16384;
constexpr int NTHR = 512, NWAVE = 8;
constexpr int LDS_MAIN = 131072, LDS_EXTRA = 8192, LDS_BYTES = LDS_MAIN + LDS_EXTRA;
constexpr float NORM_EPS = 1e-6f;

constexpr size_t al256(size_t x) { return (x + 255) & ~(size_t)255; }
constexpr size_t WS_MODV = 0;
constexpr size_t WS_WGU1 = al256(WS_MODV + (size_t)DEPTH * 3 * NMOD * 4);
constexpr size_t WS_WDN1 = WS_WGU1 + (size_t)2 * DFF * D * 2;
constexpr size_t WS_WGU2 = WS_WDN1 + (size_t)D * DFF * 2;
constexpr size_t WS_WDN2 = WS_WGU2 + (size_t)2 * DFF * D * 2;
constexpr size_t WS_WIN = WS_WDN2 + (size_t)D * DFF * 2;
constexpr size_t WS_WOUT = WS_WIN + (size_t)INWP * D * 2;
constexpr size_t WS_WLORA = WS_WOUT + (size_t)D * D * 2;
constexpr size_t WS_H = WS_WLORA + (size_t)2048 * 384 * 2;
constexpr size_t WS_U = WS_H + (size_t)T * D * 4;
constexpr size_t WS_S = WS_U + (size_t)T * D * 2;
constexpr size_t WS_Y = WS_S;
constexpr size_t WS_ACT = WS_Y + (size_t)T * D * 4;
constexpr size_t WS_FFN_END = WS_ACT + (size_t)T * DFF * 2;
constexpr size_t WS_PHY = WS_S;
constexpr size_t WS_PRW = WS_PHY + (size_t)T * HY_IN * 2;
constexpr size_t WS_YDIR = WS_PRW;
constexpr size_t WS_PNA = WS_PRW + (size_t)T * RW_IN * 2;
constexpr size_t WS_ALORA = WS_PNA + (size_t)T * NA_IN * 2;
constexpr size_t WS_DECAY = WS_ALORA + (size_t)T * 384 * 2;
constexpr size_t WS_LORAO = WS_DECAY + (size_t)2 * T * 384 * 4;
constexpr size_t WS_E = WS_LORAO;
constexpr size_t WS_ZP = WS_E + (size_t)24 * SEQ * 64 * 2;
constexpr size_t WS_GATE = WS_LORAO + (size_t)T * 1536 * 2;
static_assert(WS_ZP + (size_t)24 * 33 * 2 * 4096 * 4 <= WS_GATE, "E + ZP must fit in the LORAO region");
constexpr size_t WS_RS = WS_GATE + (size_t)T * 384 * 2;
constexpr size_t WS_KKS = WS_RS + (size_t)T * 384 * 2;
constexpr size_t WS_VS = WS_KKS + (size_t)T * 384 * 2;
constexpr size_t WS_KS = WS_VS + (size_t)T * 384 * 2;
constexpr size_t WS_BS = WS_KS + (size_t)2 * T * 384 * 2;
constexpr size_t WS_BONUS = WS_BS + (size_t)2 * T * 384 * 2;
constexpr size_t WS_FILT = al256(WS_BONUS + (size_t)T * 6 * 4);
constexpr size_t WS_FILTC = WS_FILT + (size_t)1024 * SEQ * 2;
constexpr size_t WS_SPEC = WS_FILTC + (size_t)1024 * CTX * 2;
constexpr size_t WS_Z1 = WS_SPEC + (size_t)512 * NFFT * 8;
constexpr size_t WS_VTL = WS_Z1 + (size_t)HYC * NB * SEQ * 4;
constexpr size_t WS_VTC = WS_VTL + (size_t)NB * 6 * 64 * SEQ * 2;
constexpr size_t WS_MIX_END = WS_VTC + (size_t)NB * 6 * 64 * CTX * 2;
constexpr size_t WS_BAR = al256(WS_MIX_END > WS_FFN_END ? WS_MIX_END : WS_FFN_END);
constexpr size_t WS_ROPE = al256(WS_BAR + (size_t)XCD_BAR_WORDS * 4);
constexpr size_t WS_YC = WS_FFN_END + (size_t)(8 << 20);
static_assert(WS_YC + (size_t)11 * TC * D * 4 <= WS_FILT, "YC partials must stay below the filter tables");
constexpr size_t WS_END = WS_ROPE + (size_t)128 * 16 * 8;
static_assert(WS_END <= (size_t)4 * DEPTH * D * NMOD * 4, "workspace map exceeds 4x the largest input tensor");

struct Params { const float* in[34]; float* out; unsigned char* ws; };
enum { I_X = 0, I_C, I_CTX, I_CCTX, I_MODW, I_MODB, I_NORMG, I_F1GU, I_F1DN, I_F2GU, I_F2DN, I_WIN, I_WOUT, I_HCW, I_HCB, I_HW1, I_HB1, I_HW2, I_HB2, I_HW3, I_HFREQ, I_HBIAS,
       I_MU, I_W0, I_W2, I_A0, I_A2, I_G2, I_KK, I_KA, I_RK, I_LNW, I_LNB, I_RPB };

typedef LAS float* ldsfp;
__device__ __forceinline__ ldsfp vlds(const void* p) { ldsfp q = (ldsfp)p; asm volatile("" : "+v"(q)); return q; }
__device__ __forceinline__ float bf2f(bf16_t b) { return __uint_as_float(((unsigned)b) << 16); }
__device__ __forceinline__ bf16_t f2bf(float f) { unsigned u = __float_as_uint(f); u += 0x7FFFu + ((u >> 16) & 1u); return (bf16_t)(u >> 16); }
__device__ __forceinline__ float lo_bf(unsigned w) { return __uint_as_float(w << 16); }
__device__ __forceinline__ float hi_bf(unsigned w) { return __uint_as_float(w & 0xffff0000u); }
__device__ __forceinline__ float wsum(float v) {
#pragma unroll
    for (int o = 32; o > 0; o >>= 1) v += __shfl_xor(v, o);
    return v;
}
__device__ __forceinline__ float sigmoidf_(float x) { return __builtin_amdgcn_rcpf(1.0f + __expf(-x)); }
__device__ __forceinline__ void unpack8(const u32x4 w, float (&f)[8]) {
    f[0] = lo_bf(w.x); f[1] = hi_bf(w.x); f[2] = lo_bf(w.y); f[3] = hi_bf(w.y); f[4] = lo_bf(w.z); f[5] = hi_bf(w.z); f[6] = lo_bf(w.w); f[7] = hi_bf(w.w);
}
__device__ __forceinline__ void row_nbrs(int row, bool& hasp, bool& hasn) {
    if (row < TL) { const int t = row & (SEQ - 1); hasp = t > 0; hasn = t < SEQ - 1; }
    else { const int t = (row - TL) & (CTX - 1); hasp = t > 0; hasn = t < CTX - 1; }
}

__device__ __forceinline__ void ph_modv(const Params& P, float* lds) {
    const int tid = otid();
    float* sv = lds;
    float* red = lds + 3072;
    for (int i = tid; i < 3072; i += NTHR) { const int s = i >> 10, k = i & 1023; const float c = s < 2 ? P.in[I_C][s * 1024 + k] : P.in[I_CCTX][k]; sv[i] = c / (1.0f + expf(-c)); }
    __syncthreads();
    if (blockIdx.x < 4) { const int e = blockIdx.x * NTHR + tid, pos = e >> 4, f = e & 15; float sn, cs; sincosf((float)pos * expf(-(float)f * (9.210340371976184f / 16.0f)), &sn, &cs); ((float2*)(P.ws + WS_ROPE))[e] = make_float2(cs, sn); }
    float* modv = (float*)(P.ws + WS_MODV);
    const int kc = tid >> 6, cl = tid & 63;
    for (int item = blockIdx.x; item < DEPTH * 144; item += gridDim.x) {
        const int l = item / 144, cb = item % 144, col = cb * 64 + cl;
        const float* w = P.in[I_MODW] + ((size_t)l * 1024 + kc * 128) * NMOD + col;
        float a0 = 0.f, a1 = 0.f, a2 = 0.f;
#pragma unroll 8
        for (int k = 0; k < 128; ++k) { const float wv = w[(size_t)k * NMOD]; a0 += sv[kc * 128 + k] * wv; a1 += sv[1024 + kc * 128 + k] * wv; a2 += sv[2048 + kc * 128 + k] * wv; }
        red[(0 * 8 + kc) * 64 + cl] = a0; red[(1 * 8 + kc) * 64 + cl] = a1; red[(2 * 8 + kc) * 64 + cl] = a2;
        __syncthreads();
        if (tid < 192) { const int s = tid >> 6, c = tid & 63; float r = P.in[I_MODB][l * NMOD + cb * 64 + c];
#pragma unroll
            for (int q = 0; q < 8; ++q) r += red[(s * 8 + q) * 64 + c];
            modv[((size_t)l * 3 + s) * NMOD + cb * 64 + c] = r; }
        __syncthreads();
    }
}

__device__ __forceinline__ float hy_delta(int c);
__device__ __forceinline__ int rowmap_gu(int n) { const int up = n >= DFF ? 1 : 0; const int j = n - up * DFF; return (j >> 7) * 256 + up * 128 + (j & 127); }
__device__ __forceinline__ void conv_tile(const float* __restrict__ src, int K, int N, bf16_t* __restrict__ dst, int tk, int tn, bool gu, float* tile) {
    const int tid = otid(); const int k0 = tk * 64, n0 = tn * 64;
#pragma unroll
    for (int rr = 0; rr < 2; ++rr) { const int kk = (tid >> 4) + rr * 32, n4 = (tid & 15) * 4; const float4 v = *(const float4*)(src + (size_t)(k0 + kk) * N + n0 + n4);
        tile[kk * 65 + n4 + 0] = v.x; tile[kk * 65 + n4 + 1] = v.y; tile[kk * 65 + n4 + 2] = v.z; tile[kk * 65 + n4 + 3] = v.w; }
    __syncthreads();
    { const int nn = tid >> 3, ks = (tid & 7) * 8; const int n = n0 + nn; const int row = gu ? rowmap_gu(n) : n;
      u32x4 w; w.x = cvt_pk_bf16(tile[(ks + 0) * 65 + nn], tile[(ks + 1) * 65 + nn]); w.y = cvt_pk_bf16(tile[(ks + 2) * 65 + nn], tile[(ks + 3) * 65 + nn]);
      w.z = cvt_pk_bf16(tile[(ks + 4) * 65 + nn], tile[(ks + 5) * 65 + nn]); w.w = cvt_pk_bf16(tile[(ks + 6) * 65 + nn], tile[(ks + 7) * 65 + nn]);
      *(u32x4*)(dst + (size_t)row * K + k0 + ks) = w; }
    __syncthreads();
}
__device__ __forceinline__ void ph_prep(const Params& P, int l, float* lds) {
    const int tid = otid();
    unsigned char* ws = P.ws;
    constexpr int N0 = 16 * 88, N1 = 44 * 16, N4 = 16 * 54, N5 = 16 * 16;
    constexpr int C0 = N0, C1 = C0 + N1, C2 = C1 + N0, C3 = C2 + N1, C4 = C3 + N4, C5 = C4 + N5;
    for (int it = blockIdx.x; it < C5; it += gridDim.x) {
        if (it < C0) { conv_tile(P.in[I_F1GU] + (size_t)l * D * 2 * DFF, D, 2 * DFF, (bf16_t*)(ws + WS_WGU1), it / 88, it % 88, true, lds); }
        else if (it < C1) { const int j = it - C0; conv_tile(P.in[I_F1DN] + (size_t)l * DFF * D, DFF, D, (bf16_t*)(ws + WS_WDN1), j / 16, j % 16, false, lds); }
        else if (it < C2) { const int j = it - C1; conv_tile(P.in[I_F2GU] + (size_t)l * D * 2 * DFF, D, 2 * DFF, (bf16_t*)(ws + WS_WGU2), j / 88, j % 88, true, lds); }
        else if (it < C3) { const int j = it - C2; conv_tile(P.in[I_F2DN] + (size_t)l * DFF * D, DFF, D, (bf16_t*)(ws + WS_WDN2), j / 16, j % 16, false, lds); }
        else if (it < C4) { const int j = it - C3; conv_tile(P.in[I_WIN] + (size_t)l * D * INW, D, INW, (bf16_t*)(ws + WS_WIN), j / 54, j % 54, false, lds); }
        else { const int j = it - C4; conv_tile(P.in[I_WOUT] + (size_t)l * D * D, D, D, (bf16_t*)(ws + WS_WOUT), j / 16, j % 16, false, lds); }
    }
    const int gtid = blockIdx.x * NTHR + tid, gn = gridDim.x * NTHR;
    { unsigned* z = (unsigned*)(ws + WS_WIN + (size_t)INW * D * 2); for (int i = gtid; i < (INWP - INW) * D / 2; i += gn) z[i] = 0u; }
    { bf16_t* wl = (bf16_t*)(ws + WS_WLORA);
      const float* w2 = P.in[I_W2] + (size_t)l * 2 * 64 * RWW; const float* a2 = P.in[I_A2] + (size_t)l * 2 * 64 * RWW; const float* g2 = P.in[I_G2] + (size_t)l * 128 * RWW;
      for (int i = gtid; i < 2048 * 48; i += gn) { const int kb = (i / 2048) * 8, j = i % 2048; float v[8];
#pragma unroll
          for (int q = 0; q < 8; ++q) v[q] = 0.f;
          if (j < 1920) { const int grp = j / 384, c = j % 384;
              const bool act = grp < 4 ? (kb >> 6) == grp : kb >= 256;
              if (act) { const float* src = (grp < 2 ? w2 + (size_t)kb * RWW : (grp < 4 ? a2 + (size_t)(kb - 128) * RWW : g2 + (size_t)(kb - 256) * RWW)) + c;
#pragma unroll
                  for (int q = 0; q < 8; ++q) v[q] = src[(size_t)q * RWW]; } }
          u32x4 w; w.x = cvt_pk_bf16(v[0], v[1]); w.y = cvt_pk_bf16(v[2], v[3]); w.z = cvt_pk_bf16(v[4], v[5]); w.w = cvt_pk_bf16(v[6], v[7]);
          *(u32x4*)(wl + (size_t)j * 384 + kb) = w; } }
    { const float* w1_ = P.in[I_HW1] + (size_t)l * 33 * 64; const float* b1 = P.in[I_HB1] + l * 64; const float* w2f_ = P.in[I_HW2] + (size_t)l * 64 * 64; const float* b2 = P.in[I_HB2] + l * 64;
      const float* fqv = P.in[I_HFREQ] + l * 64; const float* w3 = P.in[I_HW3] + (size_t)l * 64 * 1024;
      const int lane = tid & 63, wv = tid >> 6;
      const float fq = fqv[lane], bb1 = b1[lane], bb2 = b2[lane];
      const ldsfp hl = vlds(lds);
      for (int task = blockIdx.x; task < 256; task += gridDim.x) {
          const int n0 = task * 32;
          __syncthreads();
#pragma unroll 1
          for (int p = wv; p < 33; p += NWAVE) { const int L = p < 32 ? SEQ : CTX, pos = p < 32 ? n0 + p : task;
              const float* w1 = w1_; const float* w2f = w2f_; asm volatile("" : "+s"(w1), "+s"(w2f));
              const float tt = (float)pos / (float)(L - 1);
              const float ang = 6.283185307179586f * (float)pos / (float)L;
              float z = 0.f;
              if (lane == 0) z = tt;
              else if (lane <= 16) { const float fr = 1e-4f + (float)(lane - 1) * ((15.0f - 1e-4f) / 15.0f); z = cosf(fr * ang); }
              else if (lane <= 32) { const float fr = 1e-4f + (float)(lane - 17) * ((15.0f - 1e-4f) / 15.0f); z = -sinf(fr * ang); }
              float a = bb1;
#pragma unroll
              for (int e = 0; e < 33; ++e) a += __shfl(z, e) * w1[e * 64 + lane];
              const float h1 = sinf(fq * a);
              float c = bb2;
#pragma unroll
              for (int i = 0; i < 64; ++i) c += __shfl(h1, i) * w2f[i * 64 + lane];
              hl[lane * 36 + p] = sinf(fq * c); }
          __syncthreads();
          float acc0[33], acc1[33];
#pragma unroll
          for (int p = 0; p < 33; ++p) { acc0[p] = 0.f; acc1[p] = 0.f; }
#pragma unroll 2
          for (int i = 0; i < 64; ++i) { const float wa = w3[(size_t)i * 1024 + tid], wb = w3[(size_t)i * 1024 + 512 + tid];
#pragma unroll
              for (int p4 = 0; p4 < 8; ++p4) { const f32x4 hv = *(const LAS f32x4*)(hl + i * 36 + p4 * 4);
                  acc0[p4 * 4 + 0] += hv.x * wa; acc0[p4 * 4 + 1] += hv.y * wa; acc0[p4 * 4 + 2] += hv.z * wa; acc0[p4 * 4 + 3] += hv.w * wa;
                  acc1[p4 * 4 + 0] += hv.x * wb; acc1[p4 * 4 + 1] += hv.y * wb; acc1[p4 * 4 + 2] += hv.z * wb; acc1[p4 * 4 + 3] += hv.w * wb; }
              const float hc = hl[i * 36 + 32]; acc0[32] += hc * wa; acc1[32] += hc * wb; }
          const float dl = hy_delta(tid & 255), sc = 1.0f / NFFT, invL = 1.0f / (float)(SEQ - 1);
          bf16_t* dst = (bf16_t*)(ws + WS_FILT) + (size_t)tid * SEQ + n0;
          const size_t cstep = (size_t)512 * SEQ;
#pragma unroll
          for (int p8 = 0; p8 < 4; ++p8) { float d[8];
#pragma unroll
              for (int k = 0; k < 8; ++k) d[k] = __expf(-((float)(n0 + p8 * 8 + k) * invL) * dl) * sc;
              u32x4 w; w.x = cvt_pk_bf16(acc0[p8 * 8 + 0] * d[0], acc0[p8 * 8 + 1] * d[1]); w.y = cvt_pk_bf16(acc0[p8 * 8 + 2] * d[2], acc0[p8 * 8 + 3] * d[3]);
              w.z = cvt_pk_bf16(acc0[p8 * 8 + 4] * d[4], acc0[p8 * 8 + 5] * d[5]); w.w = cvt_pk_bf16(acc0[p8 * 8 + 6] * d[6], acc0[p8 * 8 + 7] * d[7]);
              *(u32x4*)(dst + p8 * 8) = w;
              w.x = cvt_pk_bf16(acc1[p8 * 8 + 0] * d[0], acc1[p8 * 8 + 1] * d[1]); w.y = cvt_pk_bf16(acc1[p8 * 8 + 2] * d[2], acc1[p8 * 8 + 3] * d[3]);
              w.z = cvt_pk_bf16(acc1[p8 * 8 + 4] * d[4], acc1[p8 * 8 + 5] * d[5]); w.w = cvt_pk_bf16(acc1[p8 * 8 + 6] * d[6], acc1[p8 * 8 + 7] * d[7]);
              *(u32x4*)(dst + cstep + p8 * 8) = w; }
          { const float dc = __expf(-((float)task * (1.0f / (float)(CTX - 1))) * dl); bf16_t* fc = (bf16_t*)(ws + WS_FILTC) + (size_t)tid * CTX + task;
            fc[0] = f2bf(acc0[32] * dc); fc[(size_t)512 * CTX] = f2bf(acc1[32] * dc); }
      }
      __syncthreads(); }
}

__device__ __forceinline__ void ph_rowpass(const Params& P, int mode, int lpost, int gate_i, int gpost_i, float ps, int lpre, int gpre_i, int shift_i, int scale_i, int nsplit) {
    const int tid = otid(), lane = tid & 63, gw = blockIdx.x * NWAVE + (tid >> 6), nw = gridDim.x * NWAVE;
    const float* modv = (const float*)(P.ws + WS_MODV);
    float* H = (float*)(P.ws + WS_H); const bf16_t* Y = (const bf16_t*)(P.ws + WS_Y); bf16_t* U = (bf16_t*)(P.ws + WS_U);
    int cur_s = -1;
    float4 A[4], Bv[4], Cv[4];
#pragma unroll
    for (int j = 0; j < 4; ++j) { A[j] = make_float4(0.f, 0.f, 0.f, 0.f); Bv[j] = A[j]; Cv[j] = A[j]; }
    for (int row = gw; row < T; row += nw) {
        const int s = row < SEQ ? 0 : (row < TL ? 1 : 2);
        if (s != cur_s) { cur_s = s;
#pragma unroll
            for (int j = 0; j < 4; ++j) { const int e = lane * 4 + 256 * j;
                if (mode != 0) { const float4 g = *(const float4*)(modv + ((size_t)lpost * 3 + s) * NMOD + gate_i * D + e); const float4 gp = *(const float4*)(P.in[I_NORMG] + ((size_t)lpost * 6 + gpost_i) * D + e);
                    A[j] = make_float4(ps * g.x * gp.x, ps * g.y * gp.y, ps * g.z * gp.z, ps * g.w * gp.w); }
                if (mode != 2) { const float4 sc = *(const float4*)(modv + ((size_t)lpre * 3 + s) * NMOD + scale_i * D + e); const float4 gq = *(const float4*)(P.in[I_NORMG] + ((size_t)lpre * 6 + gpre_i) * D + e);
                    Bv[j] = make_float4(gq.x * (1.f + sc.x), gq.y * (1.f + sc.y), gq.z * (1.f + sc.z), gq.w * (1.f + sc.w));
                    Cv[j] = *(const float4*)(modv + ((size_t)lpre * 3 + s) * NMOD + shift_i * D + e); } } }
        float4 h[4];
        if (mode == 0) { const float* src = row < TL ? P.in[I_X] + (size_t)row * D : P.in[I_CTX] + (size_t)(row - TL) * D;
#pragma unroll
            for (int j = 0; j < 4; ++j) h[j] = *(const float4*)(src + lane * 4 + 256 * j);
        } else {
            float4 y[4]; float ss = 0.f;
#pragma unroll
            for (int j = 0; j < 4; ++j) { h[j] = *(const float4*)(H + (size_t)row * D + lane * 4 + 256 * j); if (row < TL) { const u32x2 yw = *(const u32x2*)(Y + (size_t)row * D + lane * 4 + 256 * j); y[j] = make_float4(lo_bf(yw.x), hi_bf(yw.x), lo_bf(yw.y), hi_bf(yw.y)); } else { const float* yp = (const float*)(P.ws + WS_YC) + (size_t)(row - TL) * D + lane * 4 + 256 * j; float4 a = *(const float4*)yp;
                    for (int q = 1; q < nsplit; ++q) { const float4 b4 = *(const float4*)(yp + (size_t)q * TC * D); a.x += b4.x; a.y += b4.y; a.z += b4.z; a.w += b4.w; } y[j] = a; }
                ss += y[j].x * y[j].x + y[j].y * y[j].y + y[j].z * y[j].z + y[j].w * y[j].w; }
            ss = wsum(ss); const float r = rsqrtf(ss * (1.0f / D) + NORM_EPS);
#pragma unroll
            for (int j = 0; j < 4; ++j) { h[j].x += A[j].x * (y[j].x * r); h[j].y += A[j].y * (y[j].y * r); h[j].z += A[j].z * (y[j].z * r); h[j].w += A[j].w * (y[j].w * r); }
        }
        if (mode == 2) { if (row < TL) {
#pragma unroll
                for (int j = 0; j < 4; ++j) *(float4*)(P.out + (size_t)row * D + lane * 4 + 256 * j) = h[j]; }
            continue; }
        float s2 = 0.f;
#pragma unroll
        for (int j = 0; j < 4; ++j) { *(float4*)(H + (size_t)row * D + lane * 4 + 256 * j) = h[j]; s2 += h[j].x * h[j].x + h[j].y * h[j].y + h[j].z * h[j].z + h[j].w * h[j].w; }
        s2 = wsum(s2); const float r2 = rsqrtf(s2 * (1.0f / D) + NORM_EPS);
#pragma unroll
        for (int j = 0; j < 4; ++j) { u32x2 w; w.x = cvt_pk_bf16(h[j].x * r2 * Bv[j].x + Cv[j].x, h[j].y * r2 * Bv[j].y + Cv[j].y); w.y = cvt_pk_bf16(h[j].z * r2 * Bv[j].z + Cv[j].z, h[j].w * r2 * Bv[j].w + Cv[j].w);
            *(u32x2*)(U + (size_t)row * D + lane * 4 + 256 * j) = w; }
    }
}

struct EpiGU {
    static constexpr bool PERM = true, AFTER_DRAIN = false;
    bf16_t* O;
    __device__ __forceinline__ void operator()(const f32x4 (&acc)[2][2][4][2], const pg8::Unit& u, int wr, int wc, int fr, int fq) const {
        const int row0 = u.pm * 256 + wr * 64 + fr, col0 = u.pn * 128 + wc * 32 + 8 * fq;
#pragma unroll
        for (int ai = 0; ai < 2; ++ai)
#pragma unroll
            for (int m = 0; m < 4; ++m) { float o[8];
#pragma unroll
                for (int n = 0; n < 2; ++n)
#pragma unroll
                    for (int j = 0; j < 4; ++j) { const float g = acc[ai][0][m][n][j], up = acc[ai][1][m][n][j]; o[n * 4 + j] = g * __builtin_amdgcn_rcpf(1.0f + __expf(-g)) * up; }
                u32x4 w; w.x = cvt_pk_bf16(o[0], o[1]); w.y = cvt_pk_bf16(o[2], o[3]); w.z = cvt_pk_bf16(o[4], o[5]); w.w = cvt_pk_bf16(o[6], o[7]);
                *(u32x4*)(O + (size_t)(row0 + ai * 128 + m * 16) * DFF + col0) = w; }
    }
};

struct TailOrder {
    int nsplit, kp, G, c;
    __device__ void init(int K, int KP, int G_, int c_) { kp = KP; nsplit = (K / 64) / KP; G = G_; c = c_; }
    __device__ bool next(int i, pg8::Unit& u) const {
        const long L = (long)i * G + c;
        if (L < 256) { int wgid = (int)L; { const int q = 256 / 8, xcd = wgid % 8, off = wgid / 8; wgid = xcd * q + off; }
            const int nig = 8 * 4, gid = wgid / nig, fm = gid * 8; u.pm = fm + ((wgid % nig) % 8); u.pn = (wgid % nig) / 8; u.kt0 = 0; u.nkt = 0; return true; }
        const int L2 = (int)(L - 256); if (L2 >= 8 * nsplit) return false;
        const int tile = L2 / nsplit, ks = L2 % nsplit; u.pm = 64 + (tile >> 2); u.pn = tile & 3; u.kt0 = ks * kp; u.nkt = kp; return true;
    }
    __device__ __forceinline__ void a_ready(const pg8::Unit&) const {}
    __device__ __forceinline__ void done(const pg8::Unit&) const {}
};
struct EpiF32 {
    static constexpr bool PERM = true, AFTER_DRAIN = false;
    bf16_t* C; float* YC;
    __device__ __forceinline__ void operator()(const f32x4 (&acc)[2][2][4][2], const pg8::Unit& u, int wr, int wc, int fr, int fq) const {
        const int row0 = u.pm * 256 + wr * 64 + fr, col0 = u.pn * 256 + wc * 32 + 8 * fq;
        if (u.pm < 64) {
#pragma unroll
            for (int ai = 0; ai < 2; ++ai)
#pragma unroll
                for (int m = 0; m < 4; ++m) { bf16_t* rowp = C + (size_t)(row0 + ai * 128 + m * 16) * D + col0;
#pragma unroll
                    for (int bj = 0; bj < 2; ++bj) { const f32x4 v0 = acc[ai][bj][m][0], v1 = acc[ai][bj][m][1];
                        u32x4 w; w.x = cvt_pk_bf16(v0[0], v0[1]); w.y = cvt_pk_bf16(v0[2], v0[3]); w.z = cvt_pk_bf16(v1[0], v1[1]); w.w = cvt_pk_bf16(v1[2], v1[3]);
                        *(u32x4*)(rowp + bj * 128) = w; } }
        } else { float* base = YC + (size_t)(u.kt0 >> 2) * TC * D;
#pragma unroll
            for (int ai = 0; ai < 2; ++ai)
#pragma unroll
                for (int m = 0; m < 4; ++m) { float* rowp = base + (size_t)(row0 - TL + ai * 128 + m * 16) * D + col0;
#pragma unroll
                    for (int bj = 0; bj < 2; ++bj)
#pragma unroll
                        for (int n = 0; n < 2; ++n) *(f32x4*)(rowp + bj * 128 + n * 4) = acc[ai][bj][m][n]; }
        }
    }
};
template <class Epi> __device__ __forceinline__ void run_gemm_tail(LAS unsigned char* lds, const bf16_t* A, const bf16_t* Bt, int K, const Epi& E) {
    asm volatile("" : "+s"(K));
    pg8::Gemm g{A, Bt, T, D, K}; TailOrder S; S.init(K, 4, (int)gridDim.x, (int)blockIdx.x);
    pg8::gemm_phase<Epi, TailOrder>(lds, g, S, E);
    __syncthreads();
}
__device__ __forceinline__ void zero_yc(const Params& P) { float4* z = (float4*)(P.ws + WS_YC); for (int i = blockIdx.x * NTHR + otid(); i < TC * D / 4; i += gridDim.x * NTHR) z[i] = make_float4(0.f, 0.f, 0.f, 0.f); }
struct EpiWin {
    static constexpr bool PERM = true, AFTER_DRAIN = false;
    bf16_t* PHYT; bf16_t* PRW; bf16_t* PNA;
    __device__ __forceinline__ void operator()(const f32x4 (&acc)[2][2][4][2], const pg8::Unit& u, int wr, int wc, int fr, int fq) const {
        const int row0 = u.pm * 256 + wr * 64 + fr;
        if (u.pn < 3) {
#pragma unroll
            for (int bj = 0; bj < 2; ++bj) { bf16_t* cp = PHYT + (size_t)(u.pn * 256 + bj * 128 + wc * 32 + 8 * fq) * T + row0;
#pragma unroll
                for (int ai = 0; ai < 2; ++ai)
#pragma unroll
                    for (int m = 0; m < 4; ++m) { const f32x4 v0 = acc[ai][bj][m][0], v1 = acc[ai][bj][m][1]; bf16_t* rp = cp + ai * 128 + m * 16;
                        const unsigned w0 = cvt_pk_bf16(v0[0], v0[1]), w1 = cvt_pk_bf16(v0[2], v0[3]), w2 = cvt_pk_bf16(v1[0], v1[1]), w3 = cvt_pk_bf16(v1[2], v1[3]);
                        rp[0] = (bf16_t)w0; rp[(size_t)T] = (bf16_t)(w0 >> 16); rp[(size_t)2 * T] = (bf16_t)w1; rp[(size_t)3 * T] = (bf16_t)(w1 >> 16);
                        rp[(size_t)4 * T] = (bf16_t)w2; rp[(size_t)5 * T] = (bf16_t)(w2 >> 16); rp[(size_t)6 * T] = (bf16_t)w3; rp[(size_t)7 * T] = (bf16_t)(w3 >> 16); } }
            return; }
        bf16_t* base; int ld, cbase;
        if (u.pn < 9) { base = PRW; ld = RW_IN; cbase = u.pn * 256 - HY_IN; }
        else { base = PNA; ld = NA_IN; cbase = u.pn * 256 - HY_IN - RW_IN; }
        const int nbj = (u.pn == 13) ? 1 : 2;
#pragma unroll
        for (int ai = 0; ai < 2; ++ai)
#pragma unroll
            for (int m = 0; m < 4; ++m)
#pragma unroll
                for (int bj = 0; bj < 2; ++bj) { if (bj < nbj) { const f32x4 v0 = acc[ai][bj][m][0], v1 = acc[ai][bj][m][1];
                    u32x4 w; w.x = cvt_pk_bf16(v0[0], v0[1]); w.y = cvt_pk_bf16(v0[2], v0[3]); w.z = cvt_pk_bf16(v1[0], v1[1]); w.w = cvt_pk_bf16(v1[2], v1[3]);
                    *(u32x4*)(base + (size_t)(row0 + ai * 128 + m * 16) * ld + cbase + bj * 128 + wc * 32 + 8 * fq) = w; } }
    }
};
struct EpiLora {
    static constexpr bool PERM = true, AFTER_DRAIN = false;
    bf16_t* LO; bf16_t* GATE;
    __device__ __forceinline__ void operator()(const f32x4 (&acc)[2][2][4][2], const pg8::Unit& u, int wr, int wc, int fr, int fq) const {
        const int row0 = u.pm * 256 + wr * 64 + fr;
        bf16_t* base; int ld, cbase;
        if (u.pn < 6) { base = LO; ld = 1536; cbase = u.pn * 256; } else { base = GATE; ld = 384; cbase = u.pn * 256 - 1536; }
        const int nbj = (u.pn == 7) ? 1 : 2;
#pragma unroll
        for (int ai = 0; ai < 2; ++ai)
#pragma unroll
            for (int m = 0; m < 4; ++m)
#pragma unroll
                for (int bj = 0; bj < 2; ++bj) { if (bj < nbj) { const f32x4 v0 = acc[ai][bj][m][0], v1 = acc[ai][bj][m][1];
                    u32x4 w; w.x = cvt_pk_bf16(v0[0], v0[1]); w.y = cvt_pk_bf16(v0[2], v0[3]); w.z = cvt_pk_bf16(v1[0], v1[1]); w.w = cvt_pk_bf16(v1[2], v1[3]);
                    *(u32x4*)(base + (size_t)(row0 + ai * 128 + m * 16) * ld + cbase + bj * 128 + wc * 32 + 8 * fq) = w; } }
    }
};
template <class Epi> __device__ __forceinline__ void run_gemm(LAS unsigned char* lds, const bf16_t* A, const bf16_t* Bt, int M, int N, int K, const Epi& E) {
    asm volatile("" : "+s"(K));
    pg8::Gemm g{A, Bt, M, N, K}; pg8::StaticOrder S; S.init(M, N, (int)gridDim.x, (int)blockIdx.x);
    pg8::gemm_phase<Epi, pg8::StaticOrder>(lds, g, S, E);
    __syncthreads();
}

__device__ __forceinline__ void ph_loraprep(const Params& P, int l) {
    const bf16_t* PRW = (const bf16_t*)(P.ws + WS_PRW); bf16_t* AL = (bf16_t*)(P.ws + WS_ALORA);
    const float* mu = P.in[I_MU] + (size_t)l * 2 * RW_IN;
    const int gtid = blockIdx.x * NTHR + otid(), gn = gridDim.x * NTHR;
    for (int it = gtid; it < T * 48; it += gn) {
        const int row = it / 48, j8 = it % 48, col = 1152 + j8 * 8;
        bool hp, hn; row_nbrs(row, hp, hn);
        float p[8], pp[8], pn[8];
        unpack8(*(const u32x4*)(PRW + (size_t)row * RW_IN + col), p);
        if (hp) unpack8(*(const u32x4*)(PRW + (size_t)(row - 1) * RW_IN + col), pp); else {
#pragma unroll
            for (int i = 0; i < 8; ++i) pp[i] = 0.f; }
        if (hn) unpack8(*(const u32x4*)(PRW + (size_t)(row + 1) * RW_IN + col), pn); else {
#pragma unroll
            for (int i = 0; i < 8; ++i) pn[i] = 0.f; }
        float o[8];
#pragma unroll
        for (int i = 0; i < 8; ++i) { const float xs = p[i] + mu[col + i] * (pp[i] - p[i]) + mu[RW_IN + col + i] * (pn[i] - p[i]);
            o[i] = j8 < 16 ? tanhf(xs) : (j8 < 32 ? xs : sigmoidf_(xs)); }
        u32x4 w; w.x = cvt_pk_bf16(o[0], o[1]); w.y = cvt_pk_bf16(o[2], o[3]); w.z = cvt_pk_bf16(o[4], o[5]); w.w = cvt_pk_bf16(o[6], o[7]);
        *(u32x4*)(AL + (size_t)row * 384 + j8 * 8) = w;
    }
}

__device__ __forceinline__ void ph_rwkvprep(const Params& P, int l) {
    const int tid = otid(), lane = tid & 63, gw = blockIdx.x * NWAVE + (tid >> 6), nw = gridDim.x * NWAVE;
    const int nrw = nw / 6, h = gw % 6, rw0 = gw / 6;
    if (rw0 >= nrw) return;
    const int q = lane & 15, qt = lane >> 4, c = h * 64 + 4 * q;
    const bf16_t* PRW = (const bf16_t*)(P.ws + WS_PRW); const bf16_t* LO = (const bf16_t*)(P.ws + WS_LORAO);
    bf16_t* RS = (bf16_t*)(P.ws + WS_RS); bf16_t* KKS = (bf16_t*)(P.ws + WS_KKS); bf16_t* VS = (bf16_t*)(P.ws + WS_VS); bf16_t* KS = (bf16_t*)(P.ws + WS_KS); bf16_t* BS = (bf16_t*)(P.ws + WS_BS);
    float* BON = (float*)(P.ws + WS_BONUS); float* DEC = (float*)(P.ws + WS_DECAY);
    const float* RT = (const float*)(P.ws + WS_ROPE);
    const float* mu = P.in[I_MU] + (size_t)l * 2 * RW_IN;
    float mp[3][4], mn[3][4], ckk[4], cka[4], crk[4], ca0[4], ca1[4], cw0[4], cw1[4];
#pragma unroll
    for (int e = 0; e < 4; ++e) {
#pragma unroll
        for (int t3 = 0; t3 < 3; ++t3) { mp[t3][e] = mu[t3 * 384 + c + e]; mn[t3][e] = mu[RW_IN + t3 * 384 + c + e]; }
        ckk[e] = P.in[I_KK][l * RWW + c + e]; cka[e] = P.in[I_KA][l * RWW + c + e]; crk[e] = P.in[I_RK][l * RWW + c + e];
        ca0[e] = P.in[I_A0][(size_t)l * 2 * RWW + c + e]; ca1[e] = P.in[I_A0][(size_t)l * 2 * RWW + RWW + c + e]; cw0[e] = P.in[I_W0][(size_t)l * 2 * RWW + c + e]; cw1[e] = P.in[I_W0][(size_t)l * 2 * RWW + RWW + c + e]; }
    const float sg = (q & 4) ? 1.f : -1.f;
    const int f0 = (4 * q) & 15;
#define LD4(ptr, dst) do { const u32x2 w_ = *(const u32x2*)(ptr); dst[0] = lo_bf(w_.x); dst[1] = hi_bf(w_.x); dst[2] = lo_bf(w_.y); dst[3] = hi_bf(w_.y); } while (0)
#define ST4(ptr, v0, v1, v2, v3) do { u32x2 w_; w_.x = cvt_pk_bf16(v0, v1); w_.y = cvt_pk_bf16(v2, v3); *(u32x2*)(ptr) = w_; } while (0)
#define SUM16(x) do { x += __shfl_xor(x, 1); x += __shfl_xor(x, 2); x += __shfl_xor(x, 4); x += __shfl_xor(x, 8); } while (0)
#pragma unroll 2
    for (int pi = rw0; pi < T / 4; pi += nrw) { const int row = 4 * pi + qt;
        bool hp, hn; row_nbrs(row, hp, hn);
        const bf16_t* pr = PRW + (size_t)row * RW_IN + c; const int om = hp ? -RW_IN : 0, op = hn ? RW_IN : 0; const float fm = hp ? 1.f : 0.f, fp = hn ? 1.f : 0.f;
        float x[3][4];
#pragma unroll
        for (int t3 = 0; t3 < 3; ++t3) { float cc[4], mm[4], pp[4]; LD4(pr + t3 * 384, cc); LD4(pr + t3 * 384 + om, mm); LD4(pr + t3 * 384 + op, pp);
#pragma unroll
            for (int e = 0; e < 4; ++e) x[t3][e] = cc[e] + mp[t3][e] * (fm * mm[e] - cc[e]) + mn[t3][e] * (fp * pp[e] - cc[e]); }
        const bf16_t* lo = LO + (size_t)row * 1536 + c;
        float la0[4], la1[4], lw0[4], lw1[4]; LD4(lo + 768, la0); LD4(lo + 1152, la1); LD4(lo, lw0); LD4(lo + 384, lw1);
        float a0[4], a1[4], kkr[4]; float n2 = 0.f;
#pragma unroll
        for (int e = 0; e < 4; ++e) { a0[e] = sigmoidf_(la0[e] + ca0[e]); a1[e] = sigmoidf_(la1[e] + ca1[e]); kkr[e] = x[1][e] * ckk[e]; n2 += kkr[e] * kkr[e]; }
        SUM16(n2);
        const float rn = 1.0f / fmaxf(sqrtf(n2), 1e-12f);
        float rs[4], kks[4], kd0[4], kd1[4], b0[4], b1[4]; float bon = 0.f;
#pragma unroll
        for (int e = 0; e < 4; ++e) { const float k = x[1][e]; kks[e] = kkr[e] * rn; rs[e] = x[0][e];
            kd0[e] = k * (1.f + (a0[e] - 1.f) * cka[e]); kd1[e] = k * (1.f + (a1[e] - 1.f) * cka[e]); b0[e] = kks[e] * a0[e]; b1[e] = kks[e] * a1[e];
            bon += rs[e] * (kd0[e] + kd1[e]) * crk[e]; }
        SUM16(bon);
        if (row < TL) {
            const int t = row & (SEQ - 1); const int pos = (q < 8) ? (t >> 6) : (t & 63);
            const float4 csa = *(const float4*)(RT + (size_t)(pos * 16 + f0) * 2), csb = *(const float4*)(RT + (size_t)(pos * 16 + f0) * 2 + 4);
            const float cs[4] = {csa.x, csa.z, csb.x, csb.z}, sn[4] = {csa.y, csa.w, csb.y, csb.w};
#pragma unroll
            for (int e = 0; e < 4; ++e) {
                const float r2 = __shfl_xor(rs[e], 4), k2 = __shfl_xor(kks[e], 4), d0 = __shfl_xor(kd0[e], 4), d1 = __shfl_xor(kd1[e], 4), e0 = __shfl_xor(b0[e], 4), e1 = __shfl_xor(b1[e], 4);
                rs[e] = rs[e] * cs[e] + sg * r2 * sn[e]; kks[e] = kks[e] * cs[e] + sg * k2 * sn[e]; kd0[e] = kd0[e] * cs[e] + sg * d0 * sn[e]; kd1[e] = kd1[e] * cs[e] + sg * d1 * sn[e];
                b0[e] = b0[e] * cs[e] + sg * e0 * sn[e]; b1[e] = b1[e] * cs[e] + sg * e1 * sn[e]; }
        }
        const size_t o = (size_t)row * 384 + c;
        { float d0v[4], d1v[4];
#pragma unroll
          for (int e = 0; e < 4; ++e) { d0v[e] = __expf(-0.6065306597f * sigmoidf_(lw0[e] + cw0[e])); d1v[e] = __expf(-0.6065306597f * sigmoidf_(lw1[e] + cw1[e])); }
          *(float4*)(DEC + o) = make_float4(d0v[0], d0v[1], d0v[2], d0v[3]); *(float4*)(DEC + (size_t)T * 384 + o) = make_float4(d1v[0], d1v[1], d1v[2], d1v[3]); }
        if (q == 0) BON[(size_t)row * 6 + h] = bon;
        ST4(RS + o, rs[0], rs[1], rs[2], rs[3]); ST4(KKS + o, -kks[0], -kks[1], -kks[2], -kks[3]); ST4(VS + o, x[2][0], x[2][1], x[2][2], x[2][3]);
        ST4(KS + o, kd0[0], kd0[1], kd0[2], kd0[3]); ST4(KS + (size_t)T * 384 + o, kd1[0], kd1[1], kd1[2], kd1[3]);
        ST4(BS + o, b0[0], b0[1], b0[2], b0[3]); ST4(BS + (size_t)T * 384 + o, b1[0], b1[1], b1[2], b1[3]);
    }
#undef LD4
#undef ST4
#undef SUM16
}

__device__ __forceinline__ int scan_row(int b, int d, int step) {
    if (step < CTX) { const int tc = d ? (CTX - 1 - step) : step; return TL + b * CTX + tc; }
    const int tl = d ? (SEQ - 1 - (step - CTX)) : (step - CTX); return b * SEQ + tl;
}
__device__ __forceinline__ void scan_task_v1(const Params& P, int task, float* sv) {
    const int lane = otid() & 63;
    const int d = task & 1, h = (task >> 1) % 6, b = task / 12;
    const float* DEC = (const float*)(P.ws + WS_DECAY) + (size_t)d * T * 384; const bf16_t* KKS = (const bf16_t*)(P.ws + WS_KKS); const bf16_t* RS = (const bf16_t*)(P.ws + WS_RS);
    const bf16_t* VS = (const bf16_t*)(P.ws + WS_VS); const bf16_t* KS = (const bf16_t*)(P.ws + WS_KS) + (size_t)d * T * 384; const bf16_t* BS = (const bf16_t*)(P.ws + WS_BS) + (size_t)d * T * 384;
    float* YD = (float*)(P.ws + WS_YDIR) + (size_t)d * T * 384;
    float S[64];
#pragma unroll
    for (int j = 0; j < 64; ++j) S[j] = 0.f;
    size_t o = (size_t)scan_row(b, d, 0) * 384 + h * 64 + lane;
    float nw_ = DEC[o], na = bf2f(KKS[o]), nb = bf2f(BS[o]), nk = bf2f(KS[o]), nr = bf2f(RS[o]), nv = bf2f(VS[o]);
    for (int step = 0; step < CTX + SEQ; ++step) {
        const float v = nv; const size_t oc = o;
        asm volatile("s_waitcnt lgkmcnt(0)" ::: "memory");
        sv[lane] = nw_; sv[64 + lane] = na; sv[128 + lane] = nb; sv[192 + lane] = nk; sv[256 + lane] = nr;
        asm volatile("s_waitcnt lgkmcnt(0)" ::: "memory");
        if (step + 1 < CTX + SEQ) { o = (size_t)scan_row(b, d, step + 1) * 384 + h * 64 + lane;
            nw_ = DEC[o]; na = bf2f(KKS[o]); nb = bf2f(BS[o]); nk = bf2f(KS[o]); nr = bf2f(RS[o]); nv = bf2f(VS[o]); }
        float sa0 = 0.f, sa1 = 0.f, sa2 = 0.f, sa3 = 0.f;
#pragma unroll
        for (int j = 0; j < 64; j += 4) { const float4 a4 = *(const float4*)(sv + 64 + j);
            sa0 += S[j + 0] * a4.x; sa1 += S[j + 1] * a4.y; sa2 += S[j + 2] * a4.z; sa3 += S[j + 3] * a4.w; }
        const float sa = (sa0 + sa1) + (sa2 + sa3);
        float y0 = 0.f, y1 = 0.f, y2 = 0.f, y3 = 0.f;
#pragma unroll
        for (int j = 0; j < 64; j += 4) {
            const float4 w4 = *(const float4*)(sv + j), b4 = *(const float4*)(sv + 128 + j), k4 = *(const float4*)(sv + 192 + j), r4 = *(const float4*)(sv + 256 + j);
            S[j + 0] = S[j + 0] * w4.x + sa * b4.x + v * k4.x; y0 += S[j + 0] * r4.x;
            S[j + 1] = S[j + 1] * w4.y + sa * b4.y + v * k4.y; y1 += S[j + 1] * r4.y;
            S[j + 2] = S[j + 2] * w4.z + sa * b4.z + v * k4.z; y2 += S[j + 2] * r4.z;
            S[j + 3] = S[j + 3] * w4.w + sa * b4.w + v * k4.w; y3 += S[j + 3] * r4.w; }
        YD[oc] = (y0 + y1) + (y2 + y3);
    }
}

__device__ __forceinline__ void natt_key(const bf16_t* PNA, size_t krow, int hoff, const float (&q)[16], float bias, float& m, float& lsum, float (&o)[16]) {
    const bf16_t* kp = PNA + krow * NA_IN + 384 + hoff; const bf16_t* vp = PNA + krow * NA_IN + 768 + hoff;
    float s = 0.f;
#pragma unroll
    for (int j8 = 0; j8 < 2; ++j8) { float kf[8]; unpack8(*(const u32x4*)(kp + j8 * 8), kf);
#pragma unroll
        for (int i = 0; i < 8; ++i) s += q[j8 * 8 + i] * kf[i]; }
    s += __shfl_xor(s, 1); s += __shfl_xor(s, 2); s += bias;
    const float mn = fmaxf(m, s), corr = __expf(m - mn), p = __expf(s - mn);
    m = mn; lsum = lsum * corr + p;
#pragma unroll
    for (int j8 = 0; j8 < 2; ++j8) { float vf[8]; unpack8(*(const u32x4*)(vp + j8 * 8), vf);
#pragma unroll
        for (int i = 0; i < 8; ++i) o[j8 * 8 + i] = o[j8 * 8 + i] * corr + p * vf[i]; }
}
__device__ __forceinline__ void natten_items_v1(const Params& P, int l, int wid0, int nworkers) {
    const bf16_t* PNA = (const bf16_t*)(P.ws + WS_PNA); bf16_t* MIX = (bf16_t*)(P.ws + WS_U);
    const float* rpb = P.in[I_RPB] + (size_t)l * 6 * 15 * 31;
    const int sub = wid0 & 3;
    for (int it = wid0 >> 2; it < T * 6; it += nworkers >> 2) {
        const int row = it % T, h = it / T, hoff = h * 64 + sub * 16;
        float q[16], o[16];
#pragma unroll
        for (int j8 = 0; j8 < 2; ++j8) { float qf[8]; unpack8(*(const u32x4*)(PNA + (size_t)row * NA_IN + hoff + j8 * 8), qf);
#pragma unroll
            for (int i = 0; i < 8; ++i) { q[j8 * 8 + i] = qf[i] * 0.125f; o[j8 * 8 + i] = 0.f; } }
        float m = -3.0e38f, lsum = 0.f;
        int b;
        if (row < TL) { b = row >> 13; const int t = row & (SEQ - 1), i = t >> 6, col = t & 63;
            const int start = min(max(i - 4, 0), 120), win0 = min(max(col - 8, 0), 48);
            for (int r = 0; r < 8; ++r) for (int kc = win0; kc < win0 + 16; ++kc) {
                const float bias = rpb[(h * 15 + (start + r - i + 7)) * 31 + (kc - col + 15)];
                natt_key(PNA, (size_t)b * SEQ + (start + r) * 64 + kc, hoff, q, bias, m, lsum, o); }
        } else b = (row - TL) >> 8;
        for (int c = 0; c < CTX; ++c) natt_key(PNA, (size_t)TL + b * CTX + c, hoff, q, 0.f, m, lsum, o);
        const float il = 1.0f / lsum;
#pragma unroll
        for (int j8 = 0; j8 < 2; ++j8) { u32x4 w; w.x = cvt_pk_bf16(o[j8 * 8 + 0] * il, o[j8 * 8 + 1] * il); w.y = cvt_pk_bf16(o[j8 * 8 + 2] * il, o[j8 * 8 + 3] * il);
            w.z = cvt_pk_bf16(o[j8 * 8 + 4] * il, o[j8 * 8 + 5] * il); w.w = cvt_pk_bf16(o[j8 * 8 + 6] * il, o[j8 * 8 + 7] * il);
            *(u32x4*)(MIX + (size_t)row * D + 640 + hoff + j8 * 8) = w; }
    }
}

__device__ __forceinline__ void vt_tile(const Params& P, int tile, unsigned short* tl  ) {
    const int tid = otid();
    const bf16_t* PNA = (const bf16_t*)(P.ws + WS_PNA);
    int h, tok0; bf16_t* dst; int ldt;
    if (tile < NB * 128 * 6) { h = tile % 6; const int sb = tile / 6; const int b = sb >> 7, blk = sb & 127; tok0 = b * SEQ + blk * 64; dst = (bf16_t*)(P.ws + WS_VTL) + ((size_t)(b * 6 + h) * 64) * SEQ + blk * 64; ldt = SEQ; }
    else { const int tt = tile - NB * 128 * 6; h = tt % 6; const int sb = tt / 6; const int b = sb >> 2, blk = sb & 3; tok0 = TL + b * CTX + blk * 64; dst = (bf16_t*)(P.ws + WS_VTC) + ((size_t)(b * 6 + h) * 64) * CTX + blk * 64; ldt = CTX; }
    { const int tok = tid >> 3, seg = tid & 7; const u32x4 v = *(const u32x4*)(PNA + (size_t)(tok0 + tok) * NA_IN + 768 + h * 64 + seg * 8);
      unsigned* w = (unsigned*)(tl + tok * 72 + seg * 8); w[0] = v.x; w[1] = v.y; w[2] = v.z; w[3] = v.w; }
    __syncthreads();
    { const int hd = tid >> 3, ts = tid & 7; unsigned short e[8];
#pragma unroll
      for (int k = 0; k < 8; ++k) e[k] = tl[(ts * 8 + k) * 72 + hd];
      u32x4 w; w.x = (unsigned)e[0] | ((unsigned)e[1] << 16); w.y = (unsigned)e[2] | ((unsigned)e[3] << 16); w.z = (unsigned)e[4] | ((unsigned)e[5] << 16); w.w = (unsigned)e[6] | ((unsigned)e[7] << 16);
      *(u32x4*)(dst + (size_t)hd * ldt + ts * 8) = w; }
    __syncthreads();
}
constexpr int NAT_LAT_TASKS = NB * 128 * 4 * 6, NAT_CTX_TASKS = NB * 16 * 6, NAT_TASKS = NAT_LAT_TASKS + NAT_CTX_TASKS;
__device__ __forceinline__ void natten_task(const Params& P, int l, int task) {
    using pg8::bf16x8;
    const int lane = otid() & 63, fr = lane & 15, fq = lane >> 4;
    const bf16_t* PNA = (const bf16_t*)(P.ws + WS_PNA); bf16_t* MIX = (bf16_t*)(P.ws + WS_U);
    const bool lat = task < NAT_LAT_TASKS;
    int b, h, i = 0, n = 0, qtok0;
    if (lat) { h = task % 6; const int r = task / 6; n = r & 3; i = (r >> 2) & 127; b = r >> 9; qtok0 = b * SEQ + i * 64 + 16 * n; }
    else { const int tt = task - NAT_LAT_TASKS; h = tt % 6; const int qb = (tt / 6) & 15; b = tt / 96; qtok0 = TL + b * CTX + 16 * qb; }
    const int start = min(max(i - 4, 0), 120), band0 = min(max(16 * n - 8, 0), 32);
    const int col = 16 * n + fr, win0 = min(max(col - 8, 0), 48);
    bf16x8 bq[2];
#pragma unroll
    for (int kh = 0; kh < 2; ++kh) bq[kh] = *(const bf16x8*)(PNA + (size_t)(qtok0 + fr) * NA_IN + h * 64 + kh * 32 + fq * 8);
    f32x4 sc[32];
    if (lat) {
#pragma unroll
        for (int t = 0; t < 16; ++t) { const int tok0 = b * SEQ + (start + (t >> 1)) * 64 + band0 + 16 * (t & 1);
            const bf16_t* kp = PNA + (size_t)(tok0 + fr) * NA_IN + 384 + h * 64 + fq * 8;
            const bf16x8 k0 = *(const bf16x8*)kp, k1 = *(const bf16x8*)(kp + 32);
            f32x4 a = (f32x4){0.f, 0.f, 0.f, 0.f};
            a = __builtin_amdgcn_mfma_f32_16x16x32_bf16(k0, bq[0], a, 0, 0, 0); a = __builtin_amdgcn_mfma_f32_16x16x32_bf16(k1, bq[1], a, 0, 0, 0);
            sc[t] = a; if ((t & 3) == 3) asm volatile("" ::: "memory"); }
    } else {
#pragma unroll
        for (int t = 0; t < 16; ++t) sc[t] = (f32x4){-3.0e38f, -3.0e38f, -3.0e38f, -3.0e38f};
    }
#pragma unroll
    for (int t = 16; t < 32; ++t) { const int tok0 = TL + b * CTX + 16 * (t - 16);
        const bf16_t* kp = PNA + (size_t)(tok0 + fr) * NA_IN + 384 + h * 64 + fq * 8;
        const bf16x8 k0 = *(const bf16x8*)kp, k1 = *(const bf16x8*)(kp + 32);
        f32x4 a = (f32x4){0.f, 0.f, 0.f, 0.f};
        a = __builtin_amdgcn_mfma_f32_16x16x32_bf16(k0, bq[0], a, 0, 0, 0); a = __builtin_amdgcn_mfma_f32_16x16x32_bf16(k1, bq[1], a, 0, 0, 0);
        sc[t] = a * 0.125f; if ((t & 3) == 3) asm volatile("" ::: "memory"); }
    if (lat) { const float* rpb = P.in[I_RPB] + ((size_t)l * 6 + h) * 15 * 31;
#pragma unroll
        for (int t = 0; t < 16; ++t) { const int ro = start + (t >> 1) - i + 7; const int kc0 = band0 + 16 * (t & 1) + fq * 4;
#pragma unroll
            for (int j = 0; j < 4; ++j) { const int kc = kc0 + j; const bool ok = kc >= win0 && kc < win0 + 16; const int co = min(max(kc - col + 15, 0), 30);
                const float bias = rpb[ro * 31 + co]; sc[t][j] = ok ? sc[t][j] * 0.125f + bias : -3.0e38f; } } }
    float mx = -3.0e38f;
#pragma unroll
    for (int t = 0; t < 32; ++t) mx = fmaxf(mx, fmaxf(fmaxf(sc[t][0], sc[t][1]), fmaxf(sc[t][2], sc[t][3])));
    mx = fmaxf(mx, __shfl_xor(mx, 16)); mx = fmaxf(mx, __shfl_xor(mx, 32));
    float sum = 0.f;
#pragma unroll
    for (int t = 0; t < 32; ++t) {
#pragma unroll
        for (int j = 0; j < 4; ++j) { const float p = __expf(sc[t][j] - mx); sc[t][j] = p; sum += p; } }
    sum += __shfl_xor(sum, 16); sum += __shfl_xor(sum, 32);
    const float inv = 1.0f / sum;
    f32x4 ot[4];
#pragma unroll
    for (int q = 0; q < 4; ++q) ot[q] = (f32x4){0.f, 0.f, 0.f, 0.f};
    const bf16_t* VTL = (const bf16_t*)(P.ws + WS_VTL) + ((size_t)(b * 6 + h) * 64) * SEQ; const bf16_t* VTC = (const bf16_t*)(P.ws + WS_VTC) + ((size_t)(b * 6 + h) * 64) * CTX;
    if (lat) {
#pragma unroll
        for (int m = 0; m < 8; ++m) { const int tk = (start + m) * 64 + band0 + fq * 4;
            u32x4 pw; pw.x = cvt_pk_bf16(sc[2 * m][0], sc[2 * m][1]); pw.y = cvt_pk_bf16(sc[2 * m][2], sc[2 * m][3]); pw.z = cvt_pk_bf16(sc[2 * m + 1][0], sc[2 * m + 1][1]); pw.w = cvt_pk_bf16(sc[2 * m + 1][2], sc[2 * m + 1][3]);
            const bf16x8 pb = __builtin_bit_cast(bf16x8, pw);
#pragma unroll
            for (int q = 0; q < 4; ++q) { const bf16_t* vp = VTL + (size_t)(q * 16 + fr) * SEQ + tk; const u32x2 v0 = *(const u32x2*)vp, v1 = *(const u32x2*)(vp + 16);
                u32x4 vw; vw.x = v0.x; vw.y = v0.y; vw.z = v1.x; vw.w = v1.y;
                ot[q] = __builtin_amdgcn_mfma_f32_16x16x32_bf16(__builtin_bit_cast(bf16x8, vw), pb, ot[q], 0, 0, 0); }
            if (m & 1) asm volatile("" ::: "memory"); }
    }
#pragma unroll
    for (int m = 0; m < 8; ++m) { const int tk = 32 * m + fq * 4;
        u32x4 pw; pw.x = cvt_pk_bf16(sc[16 + 2 * m][0], sc[16 + 2 * m][1]); pw.y = cvt_pk_bf16(sc[16 + 2 * m][2], sc[16 + 2 * m][3]); pw.z = cvt_pk_bf16(sc[17 + 2 * m][0], sc[17 + 2 * m][1]); pw.w = cvt_pk_bf16(sc[17 + 2 * m][2], sc[17 + 2 * m][3]);
        const bf16x8 pb = __builtin_bit_cast(bf16x8, pw);
#pragma unroll
        for (int q = 0; q < 4; ++q) { const bf16_t* vp = VTC + (size_t)(q * 16 + fr) * CTX + tk; const u32x2 v0 = *(const u32x2*)vp, v1 = *(const u32x2*)(vp + 16);
            u32x4 vw; vw.x = v0.x; vw.y = v0.y; vw.z = v1.x; vw.w = v1.y;
            ot[q] = __builtin_amdgcn_mfma_f32_16x16x32_bf16(__builtin_bit_cast(bf16x8, vw), pb, ot[q], 0, 0, 0); }
        if (m & 1) asm volatile("" ::: "memory"); }
#pragma unroll
    for (int q = 0; q < 4; ++q) { u32x2 w; w.x = cvt_pk_bf16(ot[q][0] * inv, ot[q][1] * inv); w.y = cvt_pk_bf16(ot[q][2] * inv, ot[q][3] * inv);
        *(u32x2*)(MIX + (size_t)(qtok0 + fr) * D + 640 + h * 64 + q * 16 + fq * 4) = w; }
}

__device__ __forceinline__ void fft_fwd(float2* X) {
#pragma unroll 1
    for (int lq = 12; lq >= 0; lq -= 2) { const int q = 1 << lq; const float rq = 1.0f / (float)(4 * q);
        for (int j = otid(); j < NFFT / 4; j += NTHR) { const int lo = j & (q - 1), base = ((j >> lq) << (lq + 2)) | lo;
            const float2 x0 = X[base], x1 = X[base + q], x2 = X[base + 2 * q], x3 = X[base + 3 * q];
            const float fr = (float)lo * rq; const float c = __builtin_amdgcn_cosf(fr), s = __builtin_amdgcn_sinf(fr), c2 = c * c - s * s, s2 = 2.f * c * s;
            const float a0x = x0.x + x2.x, a0y = x0.y + x2.y, dx = x0.x - x2.x, dy = x0.y - x2.y;
            const float a2x = dx * c + dy * s, a2y = dy * c - dx * s;
            const float a1x = x1.x + x3.x, a1y = x1.y + x3.y, ex = x1.x - x3.x, ey = x1.y - x3.y;
            const float mx = ex * c + ey * s, my = ey * c - ex * s;
            const float a3x = my, a3y = -mx;
            const float fx = a0x - a1x, fy = a0y - a1y, gx = a2x - a3x, gy = a2y - a3y;
            X[base] = make_float2(a0x + a1x, a0y + a1y); X[base + q] = make_float2(fx * c2 + fy * s2, fy * c2 - fx * s2);
            X[base + 2 * q] = make_float2(a2x + a3x, a2y + a3y); X[base + 3 * q] = make_float2(gx * c2 + gy * s2, gy * c2 - gx * s2); }
        __syncthreads(); }
}
__device__ __forceinline__ void fft_inv(float2* X) {
#pragma unroll 1
    for (int lq = 0; lq <= 12; lq += 2) { const int q = 1 << lq; const float rq = 1.0f / (float)(4 * q);
        for (int j = otid(); j < NFFT / 4; j += NTHR) { const int lo = j & (q - 1), base = ((j >> lq) << (lq + 2)) | lo;
            const float2 y0 = X[base], y1 = X[base + q], y2 = X[base + 2 * q], y3 = X[base + 3 * q];
            const float fr = (float)lo * rq; const float c = __builtin_amdgcn_cosf(fr), s = __builtin_amdgcn_sinf(fr), c2 = c * c - s * s, s2 = 2.f * c * s;
            const float tx = y1.x * c2 - y1.y * s2, ty = y1.x * s2 + y1.y * c2;
            const float a0x = y0.x + tx, a0y = y0.y + ty, a1x = y0.x - tx, a1y = y0.y - ty;
            const float ux = y3.x * c2 - y3.y * s2, uy = y3.x * s2 + y3.y * c2;
            const float a2x = y2.x + ux, a2y = y2.y + uy, a3x = y2.x - ux, a3y = y2.y - uy;
            const float vx = a2x * c - a2y * s, vy = a2x * s + a2y * c;
            const float mx = a3x * c - a3y * s, my = a3x * s + a3y * c;
            const float wx = -my, wy = mx;
            X[base] = make_float2(a0x + vx, a0y + vy); X[base + 2 * q] = make_float2(a0x - vx, a0y - vy);
            X[base + q] = make_float2(a1x + wx, a1y + wy); X[base + 3 * q] = make_float2(a1x - wx, a1y - wy); }
        __syncthreads(); }
}
__device__ __forceinline__ float hy_delta(int c) { const float lo = -4.605170185988091f / 1.5f, hi = -4.605170185988091f / 0.3f; return fabsf(lo + (float)c * ((hi - lo) / 255.0f)); }
__device__ __forceinline__ float hy_short(const bf16_t* PHYT, const float* cw, const float* cb, int row, int col) {
    bool hp, hn; row_nbrs(row, hp, hn);
    const bf16_t* p = PHYT + (size_t)col * T + row;
    float v = cb[col] + cw[HY_IN + col] * bf2f(p[0]);
    if (hp) v += cw[col] * bf2f(p[-1]);
    if (hn) v += cw[2 * HY_IN + col] * bf2f(p[1]);
    return v;
}
struct HyTap { float w0, w1, w2, b; };
__device__ __forceinline__ HyTap hy_tap(const float* cw, const float* cb, int col) { HyTap t; t.w0 = cw[col]; t.w1 = cw[HY_IN + col]; t.w2 = cw[2 * HY_IN + col]; t.b = cb[col]; return t; }
__device__ __forceinline__ float hy_lat(const bf16_t* colp, int b, int n, const HyTap t) {
    const bf16_t* p = colp + b * SEQ + n;
    const float xm = bf2f(p[n > 0 ? -1 : 0]), x0 = bf2f(p[0]), xp = bf2f(p[n < SEQ - 1 ? 1 : 0]);
    return t.b + t.w1 * x0 + (n > 0 ? t.w0 * xm : 0.f) + (n < SEQ - 1 ? t.w2 * xp : 0.f);
}
__device__ __forceinline__ void hy_spec_task(const Params& P, int l, int c, float2* X) {
    const int tid = otid();
    const bf16_t* f0 = (const bf16_t*)(P.ws + WS_FILT) + (size_t)c * SEQ; const bf16_t* b0 = f0 + (size_t)256 * SEQ; const bf16_t* f1 = f0 + (size_t)512 * SEQ; const bf16_t* b1 = f0 + (size_t)768 * SEQ;
    for (int n = tid; n < SEQ; n += NTHR) {
        X[n] = make_float2(bf2f(f0[n]), bf2f(f1[n]));
        if (n > 0) X[NFFT - n] = make_float2(bf2f(b0[n]), bf2f(b1[n])); else X[SEQ] = make_float2(0.f, 0.f); }
    __syncthreads();
    fft_fwd(X);
    float2* spec = (float2*)(P.ws + WS_SPEC) + (size_t)c * NFFT;
    for (int i = tid; i < NFFT; i += NTHR) spec[i] = X[i];
    __syncthreads();
}
__device__ __forceinline__ void hy_conv_core(const Params& P, int o, int c, float2* X) {
    fft_fwd(X);
    const float2* spec = (const float2*)(P.ws + WS_SPEC) + (size_t)c * NFFT;
    for (int i = otid(); i < NFFT; i += NTHR) {
        const unsigned f = __brev((unsigned)i) >> 18;
        const unsigned ip = __brev(((unsigned)NFFT - f) & (unsigned)(NFFT - 1)) >> 18;
        const float2 a = X[i], w = spec[i], w2 = spec[ip];
        const float kx = o == 0 ? 0.5f * (w.x + w2.x) : 0.5f * (w.y + w2.y), ky = o == 0 ? 0.5f * (w.y - w2.y) : -0.5f * (w.x - w2.x);
        X[i] = make_float2(a.x * kx - a.y * ky, a.x * ky + a.y * kx); }
    __syncthreads();
    fft_inv(X);
}
__device__ __forceinline__ void hy_task1(const Params& P, int l, int c, float2* X, float* ex) {
    const int tid = otid();
    const bf16_t* PHY = (const bf16_t*)(P.ws + WS_PHY); const float* cw = P.in[I_HCW] + (size_t)l * 3 * HY_IN; const float* cb = P.in[I_HCB] + (size_t)l * HY_IN;
    const float bias0 = P.in[I_HBIAS][(size_t)l * 2 * HYC + c], bias1 = P.in[I_HBIAS][(size_t)l * 2 * HYC + HYC + c];
    const HyTap tv = hy_tap(cw, cb, c), tg1 = hy_tap(cw, cb, HYC + c); const bf16_t* colv = PHY + (size_t)c * T; const bf16_t* colg1 = PHY + (size_t)(HYC + c) * T;
#pragma unroll 4
    for (int n = tid; n < SEQ; n += NTHR) { X[n] = make_float2(hy_lat(colv, 0, n, tv), hy_lat(colv, 1, n, tv)); X[SEQ + n] = make_float2(0.f, 0.f); }
    __syncthreads();
    hy_conv_core(P, 0, c, X);
    float* Z1 = (float*)(P.ws + WS_Z1) + (size_t)c * NB * SEQ;
#pragma unroll 4
    for (int n = tid; n < SEQ; n += NTHR) { const float2 y = X[n];
        const float v0 = hy_lat(colv, 0, n, tv), v1 = hy_lat(colv, 1, n, tv), g0 = hy_lat(colg1, 0, n, tg1), g1 = hy_lat(colg1, 1, n, tg1);
        Z1[n] = g0 * (y.x + bias0 * v0); Z1[SEQ + n] = g1 * (y.y + bias0 * v1); }
    __syncthreads();
    float* f = (float*)X;
    float* vv = f, *x1 = f + 512, *x2 = f + 1024, *hf = f + 1536  , *z1 = f + 2560;
    const bf16_t* fc = (const bf16_t*)(P.ws + WS_FILTC);
    { const int b = tid >> 8, t = tid & 255, row = TL + b * CTX + t;
      vv[tid] = hy_short(PHY, cw, cb, row, c); x1[tid] = hy_short(PHY, cw, cb, row, HYC + c); x2[tid] = hy_short(PHY, cw, cb, row, 2 * HYC + c);
      for (int q = tid; q < 1024; q += NTHR) { const int od = q >> 8, n = q & 255; hf[q] = bf2f(fc[(size_t)(od * 256 + c) * CTX + n]); } }
    __syncthreads();
    { const int b = tid >> 8, t = tid & 255; float y = bias0 * vv[tid];
      for (int s = 0; s <= t; ++s) y += hf[t - s] * vv[b * 256 + s];
      for (int s = t + 1; s < CTX; ++s) y += hf[256 + s - t] * vv[b * 256 + s];
      z1[tid] = x1[tid] * y; }
    __syncthreads();
    { const int b = tid >> 8, t = tid & 255; float y = bias1 * z1[tid];
      for (int s = 0; s <= t; ++s) y += hf[512 + t - s] * z1[b * 256 + s];
      for (int s = t + 1; s < CTX; ++s) y += hf[768 + s - t] * z1[b * 256 + s];
      bf16_t* MIX = (bf16_t*)(P.ws + WS_U); MIX[(size_t)(TL + b * CTX + t) * D + c] = f2bf(x2[tid] * y); }
    __syncthreads();
}
__device__ __forceinline__ void hy_task2(const Params& P, int l, int c, float2* X) {
    const int tid = otid();
    const bf16_t* PHY = (const bf16_t*)(P.ws + WS_PHY); const float* cw = P.in[I_HCW] + (size_t)l * 3 * HY_IN; const float* cb = P.in[I_HCB] + (size_t)l * HY_IN;
    const float bias1 = P.in[I_HBIAS][(size_t)l * 2 * HYC + HYC + c];
    const float* Z1 = (const float*)(P.ws + WS_Z1) + (size_t)c * NB * SEQ; float* Z1w = (float*)(P.ws + WS_Z1) + (size_t)c * NB * SEQ;
    for (int n = tid; n < SEQ; n += NTHR) { X[n] = make_float2(Z1[n], Z1[SEQ + n]); X[SEQ + n] = make_float2(0.f, 0.f); }
    __syncthreads();
    hy_conv_core(P, 1, c, X);
    bf16_t* MIX = (bf16_t*)(P.ws + WS_U);
    const HyTap tg2 = hy_tap(cw, cb, 2 * HYC + c); const bf16_t* colg2 = PHY + (size_t)(2 * HYC + c) * T;
#pragma unroll 4
    for (int n = tid; n < SEQ; n += NTHR) { const float2 y = X[n];
        const float g0 = hy_lat(colg2, 0, n, tg2), g1 = hy_lat(colg2, 1, n, tg2);
        Z1w[n] = g0 * (y.x + bias1 * Z1[n]); Z1w[SEQ + n] = g1 * (y.y + bias1 * Z1[SEQ + n]); }
    __syncthreads();
}

constexpr int SEGC = 256, NSEG = 33, SCH = 4;
typedef float f32x2v __attribute__((ext_vector_type(2)));
template <bool IDENT>
__device__ __forceinline__ void scan_seg(const Params& P, int chain, int g, float* ring_  ) {
    const ldsfp ring = vlds(ring_);
    const int lane = otid() & 63;
    const int d = chain & 1, h = (chain >> 1) % 6, b = chain / 12;
    const float* DEC = (const float*)(P.ws + WS_DECAY) + (size_t)d * T * 384; const bf16_t* KKS = (const bf16_t*)(P.ws + WS_KKS); const bf16_t* RS = (const bf16_t*)(P.ws + WS_RS);
    const bf16_t* VS = (const bf16_t*)(P.ws + WS_VS); const bf16_t* KS = (const bf16_t*)(P.ws + WS_KS) + (size_t)d * T * 384; const bf16_t* BS = (const bf16_t*)(P.ws + WS_BS) + (size_t)d * T * 384;
    float* YD = (float*)(P.ws + WS_YDIR) + (size_t)d * T * 384;
    bf16_t* E = (bf16_t*)(P.ws + WS_E) + (size_t)chain * SEQ * 64;
    const int step0 = g == 0 ? 0 : CTX + (g - 1) * SEGC;
    f32x2v S0[32], S1[32];
#pragma unroll
    for (int j = 0; j < 32; ++j) { S0[j] = (f32x2v){0.f, 0.f}; S1[j] = (f32x2v){(2 * j == lane) ? 1.f : 0.f, (2 * j + 1 == lane) ? 1.f : 0.f}; }
    float pw[SCH], pa[SCH], pb[SCH], pk[SCH], pr[SCH], pv[SCH]; int po[SCH];
#pragma unroll
    for (int s = 0; s < SCH; ++s) { const int o = scan_row(b, d, step0 + s) * 384 + h * 64 + lane; po[s] = o;
        pw[s] = DEC[o]; pa[s] = bf2f(KKS[o]); pb[s] = bf2f(BS[o]); pk[s] = bf2f(KS[o]); pr[s] = bf2f(RS[o]); pv[s] = bf2f(VS[o]); }
    for (int c = 0; c < SEGC / SCH; ++c) {
        float cv[SCH]; int co[SCH];
        asm volatile("s_waitcnt lgkmcnt(0)" ::: "memory");
#pragma unroll
        for (int s = 0; s < SCH; ++s) { const ldsfp sv = ring + s * 320; sv[lane] = pw[s]; sv[64 + lane] = pa[s]; sv[128 + lane] = pb[s]; sv[192 + lane] = pk[s]; sv[256 + lane] = pr[s]; cv[s] = pv[s]; co[s] = po[s]; }
        asm volatile("s_waitcnt lgkmcnt(0)" ::: "memory");
        if (c + 1 < SEGC / SCH) {
#pragma unroll
            for (int s = 0; s < SCH; ++s) { const int o = scan_row(b, d, step0 + (c + 1) * SCH + s) * 384 + h * 64 + lane; po[s] = o;
                pw[s] = DEC[o]; pa[s] = bf2f(KKS[o]); pb[s] = bf2f(BS[o]); pk[s] = bf2f(KS[o]); pr[s] = bf2f(RS[o]); pv[s] = bf2f(VS[o]); } }
#pragma unroll
        for (int s = 0; s < SCH; ++s) { const ldsfp sv = ring + s * 320;
            f32x2v sa2 = (f32x2v){0.f, 0.f}, sb2 = (f32x2v){0.f, 0.f}, sa3 = sa2, sb3 = sa2;
#pragma unroll
            for (int hb = 0; hb < 2; ++hb) { f32x4 A[8];
#pragma unroll
                for (int i = 0; i < 8; ++i) A[i] = *(const LAS f32x4*)(sv + 64 + hb * 32 + 4 * i);
                __builtin_amdgcn_sched_barrier(0);
#pragma unroll
                for (int i = 0; i < 8; ++i) { const int jj = hb * 16 + 2 * i; const f32x2v alo = (f32x2v){A[i].x, A[i].y}, ahi = (f32x2v){A[i].z, A[i].w};
                    sa2 += S0[jj] * alo; sa3 += S0[jj + 1] * ahi;
                    if (IDENT) { sb2 += S1[jj] * alo; sb3 += S1[jj + 1] * ahi; } }
                __builtin_amdgcn_sched_barrier(0); }
            const float sa = (sa2.x + sa2.y) + (sa3.x + sa3.y), sb = (sb2.x + sb2.y) + (sb3.x + sb3.y);
            const f32x2v saa = (f32x2v){sa, sa}, sbb = (f32x2v){sb, sb}, vv = (f32x2v){cv[s], cv[s]};
            f32x2v y2 = (f32x2v){0.f, 0.f}, y3 = y2, e2 = y2, e3 = y2;
#pragma unroll
            for (int ch = 0; ch < 8; ++ch) { f32x4 W[2], Bq[2], K[2], R[2];
#pragma unroll
                for (int i = 0; i < 2; ++i) { const int j = ch * 8 + 4 * i; W[i] = *(const LAS f32x4*)(sv + j); Bq[i] = *(const LAS f32x4*)(sv + 128 + j); K[i] = *(const LAS f32x4*)(sv + 192 + j); R[i] = *(const LAS f32x4*)(sv + 256 + j); }
                __builtin_amdgcn_sched_barrier(0);
#pragma unroll
                for (int i = 0; i < 2; ++i) { const int jj = ch * 4 + 2 * i;
                    const f32x2v wlo = (f32x2v){W[i].x, W[i].y}, whi = (f32x2v){W[i].z, W[i].w}, blo = (f32x2v){Bq[i].x, Bq[i].y}, bhi = (f32x2v){Bq[i].z, Bq[i].w};
                    const f32x2v klo = (f32x2v){K[i].x, K[i].y}, khi = (f32x2v){K[i].z, K[i].w}, rlo = (f32x2v){R[i].x, R[i].y}, rhi = (f32x2v){R[i].z, R[i].w};
                    S0[jj] = S0[jj] * wlo + saa * blo + vv * klo; y2 += S0[jj] * rlo;
                    S0[jj + 1] = S0[jj + 1] * whi + saa * bhi + vv * khi; y3 += S0[jj + 1] * rhi;
                    if (IDENT) { S1[jj] = S1[jj] * wlo + sbb * blo; e2 += S1[jj] * rlo; S1[jj + 1] = S1[jj + 1] * whi + sbb * bhi; e3 += S1[jj + 1] * rhi; } }
                __builtin_amdgcn_sched_barrier(0); }
            YD[co[s]] = (y2.x + y2.y) + (y3.x + y3.y);
            if (IDENT) { const int tl = d ? (SEQ - 1 - (step0 - CTX + c * SCH + s)) : (step0 - CTX + c * SCH + s); E[(size_t)tl * 64 + lane] = f2bf((e2.x + e2.y) + (e3.x + e3.y)); }
        }
    }
    float* ZP = (float*)(P.ws + WS_ZP) + ((size_t)chain * NSEG + g) * 2 * 4096;
#pragma unroll
    for (int j = 0; j < 32; j += 2) { *(float4*)(ZP + lane * 64 + 2 * j) = make_float4(S0[j].x, S0[j].y, S0[j + 1].x, S0[j + 1].y);
        if (IDENT) *(float4*)(ZP + 4096 + lane * 64 + 2 * j) = make_float4(S1[j].x, S1[j].y, S1[j + 1].x, S1[j + 1].y); }
}
typedef float f32x16 __attribute__((ext_vector_type(16)));
__device__ __forceinline__ void scan_combine(const Params& P, int chain, float* lds) {
    const int tid = otid(), lane = tid & 63, wv = tid >> 6, li = lane & 31, lh = lane >> 5;
    const ldsfp Sl = vlds(lds);
    const ldsfp Pl = Sl + 64 * 65;
    float* ZPc = (float*)(P.ws + WS_ZP) + (size_t)chain * NSEG * 2 * 4096;
    const int ti = (wv >> 1) & 1, tj = wv & 1;
    float pn[8];
#pragma unroll
    for (int q = 0; q < 8; ++q) { pn[q] = ZPc[(size_t)2 * 4096 + 4096 + tid * 8 + q]; Sl[(tid >> 3) * 65 + (tid & 7) * 8 + q] = ZPc[tid * 8 + q]; }
    f32x16 acc, zn;
#pragma unroll
    for (int r = 0; r < 16; ++r) { zn[r] = 0.f; acc[r] = 0.f; }
    if (wv < 4) {
#pragma unroll
        for (int r = 0; r < 16; ++r) zn[r] = ZPc[(size_t)2 * 4096 + (32 * ti + (r & 3) + 8 * (r >> 2) + 4 * lh) * 64 + 32 * tj + li]; }
    for (int g = 1; g < NSEG - 1; ++g) {
        __syncthreads();
        if (g > 1 && wv < 4) {
#pragma unroll
            for (int r = 0; r < 16; ++r) Sl[(32 * ti + (r & 3) + 8 * (r >> 2) + 4 * lh) * 65 + 32 * tj + li] = acc[r]; }
#pragma unroll
        for (int q = 0; q < 8; ++q) Pl[tid * 8 + q] = pn[q];
        acc = zn;
        if (g + 1 < NSEG - 1) { const float* nx = ZPc + (size_t)(g + 1) * 2 * 4096;
#pragma unroll
            for (int q = 0; q < 8; ++q) pn[q] = nx[4096 + tid * 8 + q];
            if (wv < 4) {
#pragma unroll
                for (int r = 0; r < 16; ++r) zn[r] = nx[(32 * ti + (r & 3) + 8 * (r >> 2) + 4 * lh) * 64 + 32 * tj + li]; } }
        __syncthreads();
        if (wv < 4) {
#pragma unroll 8
            for (int k0 = 0; k0 < 64; k0 += 2) { const float av = Sl[(32 * ti + li) * 65 + k0 + lh], bv = Pl[(k0 + lh) * 64 + 32 * tj + li];
                acc = __builtin_amdgcn_mfma_f32_32x32x2f32(av, bv, acc, 0, 0, 0); }
            float* Zg = ZPc + (size_t)g * 2 * 4096;
#pragma unroll
            for (int r = 0; r < 16; ++r) Zg[(32 * ti + (r & 3) + 8 * (r >> 2) + 4 * lh) * 64 + 32 * tj + li] = acc[r]; }
    }
    __syncthreads();
}

__device__ __forceinline__ void rwkv_out_fin(const Params& P, int row, int c, float y, float lnw, float lnb, float bon, float vs, float gt) {
    bf16_t* MIX = (bf16_t*)(P.ws + WS_U);
    const float mean = wsum(y) * (1.0f / 64.0f); const float dv = y - mean; const float var = wsum(dv * dv) * (1.0f / 64.0f);
    const float yn = dv * rsqrtf(var + 64e-5f) * lnw + lnb;
    MIX[(size_t)row * D + 256 + c] = f2bf((yn + bon * vs) * gt);
}
__device__ __forceinline__ void ph_rwkvout(const Params& P, int l, float* ldsf) {
    using pg8::bf16x8;
    const int tid = otid(), lane = tid & 63, fr = lane & 15, fq = lane >> 4, wv = tid >> 6, gw = blockIdx.x * NWAVE + wv, nw = gridDim.x * NWAVE;
    const float* YD = (const float*)(P.ws + WS_YDIR); const bf16_t* VS = (const bf16_t*)(P.ws + WS_VS); const bf16_t* GT = (const bf16_t*)(P.ws + WS_GATE); const float* BON = (const float*)(P.ws + WS_BONUS);
    bf16_t* MIX = (bf16_t*)(P.ws + WS_U);
    for (int it = gw; it < NB * 6 * 32 * 4; it += nw) {
        const int sub = it & 3, q = (it >> 2) & 31, h = (it >> 7) % 6, b = it / (128 * 6);
        const int t0 = q * 256 + sub * 64;
        f32x4 acc[4][4];
#pragma unroll
        for (int mt = 0; mt < 4; ++mt)
#pragma unroll
            for (int nt = 0; nt < 4; ++nt) acc[mt][nt] = (f32x4){0.f, 0.f, 0.f, 0.f};
#pragma unroll
        for (int dir = 0; dir < 2; ++dir) { const int ch = b * 12 + h * 2 + dir, slot = dir ? (31 - q) : q;
            const float* Sp = (const float*)(P.ws + WS_ZP) + ((size_t)ch * NSEG + slot) * 2 * 4096;
            const bf16_t* Ep = (const bf16_t*)(P.ws + WS_E) + ((size_t)ch * SEQ + t0) * 64;
#pragma unroll
            for (int ks = 0; ks < 2; ++ks) { bf16x8 bop[4];
#pragma unroll
                for (int nt = 0; nt < 4; ++nt) { const float* sp = Sp + (nt * 16 + fr) * 64 + ks * 32 + fq * 8; const float4 s0 = *(const float4*)sp, s1 = *(const float4*)(sp + 4);
                    u32x4 w; w.x = cvt_pk_bf16(s0.x, s0.y); w.y = cvt_pk_bf16(s0.z, s0.w); w.z = cvt_pk_bf16(s1.x, s1.y); w.w = cvt_pk_bf16(s1.z, s1.w); bop[nt] = __builtin_bit_cast(bf16x8, w); }
#pragma unroll
                for (int mt = 0; mt < 4; ++mt) { const bf16x8 a = *(const bf16x8*)(Ep + (size_t)(mt * 16 + fr) * 64 + ks * 32 + fq * 8);
#pragma unroll
                    for (int nt = 0; nt < 4; ++nt) acc[mt][nt] = __builtin_amdgcn_mfma_f32_16x16x32_bf16(bop[nt], a, acc[mt][nt], 0, 0, 0); } } }
        f32x4 lnw[4], lnb[4];
#pragma unroll
        for (int nt = 0; nt < 4; ++nt) { lnw[nt] = *(const f32x4*)(P.in[I_LNW] + l * RWW + h * 64 + nt * 16 + fq * 4); lnb[nt] = *(const f32x4*)(P.in[I_LNB] + l * RWW + h * 64 + nt * 16 + fq * 4); }
#pragma unroll
        for (int mt = 0; mt < 4; ++mt) { const int row = b * SEQ + t0 + mt * 16 + fr; const size_t o = (size_t)row * 384 + h * 64 + fq * 4;
            f32x4 y[4]; u32x2 vsw[4], gtw[4]; const float bon = BON[(size_t)row * 6 + h];
#pragma unroll
            for (int nt = 0; nt < 4; ++nt) { y[nt] = *(const f32x4*)(YD + o + nt * 16) + *(const f32x4*)(YD + (size_t)T * 384 + o + nt * 16) + acc[mt][nt];
                vsw[nt] = *(const u32x2*)(VS + o + nt * 16); gtw[nt] = *(const u32x2*)(GT + o + nt * 16); }
            float sm = 0.f;
#pragma unroll
            for (int nt = 0; nt < 4; ++nt) sm += (y[nt][0] + y[nt][1]) + (y[nt][2] + y[nt][3]);
            sm += __shfl_xor(sm, 16); sm += __shfl_xor(sm, 32);
            const float mean = sm * (1.0f / 64.0f);
            float vr = 0.f;
#pragma unroll
            for (int nt = 0; nt < 4; ++nt) { y[nt] = y[nt] - mean; vr += (y[nt][0] * y[nt][0] + y[nt][1] * y[nt][1]) + (y[nt][2] * y[nt][2] + y[nt][3] * y[nt][3]); }
            vr += __shfl_xor(vr, 16); vr += __shfl_xor(vr, 32);
            const float rstd = rsqrtf(vr * (1.0f / 64.0f) + 64e-5f);
#pragma unroll
            for (int nt = 0; nt < 4; ++nt) { const f32x4 yn = y[nt] * rstd * lnw[nt] + lnb[nt];
                const float o0 = (yn[0] + bon * lo_bf(vsw[nt].x)) * lo_bf(gtw[nt].x), o1 = (yn[1] + bon * hi_bf(vsw[nt].x)) * hi_bf(gtw[nt].x);
                const float o2 = (yn[2] + bon * lo_bf(vsw[nt].y)) * lo_bf(gtw[nt].y), o3 = (yn[3] + bon * hi_bf(vsw[nt].y)) * hi_bf(gtw[nt].y);
                u32x2 w; w.x = cvt_pk_bf16(o0, o1); w.y = cvt_pk_bf16(o2, o3);
                *(u32x2*)(MIX + (size_t)row * D + 256 + h * 64 + nt * 16 + fq * 4) = w; }
            asm volatile("" ::: "memory"); }
    }
    for (int it = gw; it < TC * 6; it += nw) { const int row = TL + it / 6, h = it % 6, c = h * 64 + lane; const size_t o = (size_t)row * 384 + c;
        rwkv_out_fin(P, row, c, YD[o] + YD[(size_t)T * 384 + o], P.in[I_LNW][l * RWW + c], P.in[I_LNB][l * RWW + c], BON[(size_t)row * 6 + h], bf2f(VS[o]), bf2f(GT[o])); }
}

__device__ __forceinline__ void zt_tile(const Params& P, int tile, float* tl  ) {
    const int tid = otid(); const int c0 = (tile & 3) * 64, t0 = (tile >> 2) * 64;
    const float* Z = (const float*)(P.ws + WS_Z1); bf16_t* MIX = (bf16_t*)(P.ws + WS_U);
    { const int cc = tid >> 3, sg = (tid & 7) * 8; const float* src = Z + (size_t)(c0 + cc) * TL + t0 + sg; const float4 a = *(const float4*)src, b = *(const float4*)(src + 4);
      tl[cc * 65 + sg + 0] = a.x; tl[cc * 65 + sg + 1] = a.y; tl[cc * 65 + sg + 2] = a.z; tl[cc * 65 + sg + 3] = a.w; tl[cc * 65 + sg + 4] = b.x; tl[cc * 65 + sg + 5] = b.y; tl[cc * 65 + sg + 6] = b.z; tl[cc * 65 + sg + 7] = b.w; }
    __syncthreads();
    { const int tk = tid >> 3, cs = (tid & 7) * 8;
      u32x4 w; w.x = cvt_pk_bf16(tl[(cs + 0) * 65 + tk], tl[(cs + 1) * 65 + tk]); w.y = cvt_pk_bf16(tl[(cs + 2) * 65 + tk], tl[(cs + 3) * 65 + tk]);
      w.z = cvt_pk_bf16(tl[(cs + 4) * 65 + tk], tl[(cs + 5) * 65 + tk]); w.w = cvt_pk_bf16(tl[(cs + 6) * 65 + tk], tl[(cs + 7) * 65 + tk]);
      *(u32x4*)(MIX + (size_t)(t0 + tk) * D + c0 + cs) = w; }
    __syncthreads();
}
typedef const __attribute__((address_space(4))) Params* KParamsPtr;
__device__ __forceinline__ const Params* fresh_params() { KParamsPtr q = (KParamsPtr)__builtin_amdgcn_kernarg_segment_ptr(); asm volatile("" : "+s"(q)); return (const Params*)q; }
__global__ void __launch_bounds__(NTHR, 2) fwd_megakernel(Params P_unused, int ph_lo, int ph_hi) {
    extern __shared__ __attribute__((aligned(16))) unsigned char smem[];
    cg::grid_group grid = cg::this_grid();
    LAS unsigned char* lds3 = (LAS unsigned char*)smem;
    float* ldsf = (float*)smem; float2* X = (float2*)smem; float* ex = (float*)(smem + LDS_MAIN);
    { volatile LAS unsigned* st = (volatile LAS unsigned*)(lds3 + LDS_MAIN + 4096); if (threadIdx.x == 0) { st[0] = 0u; st[1] = 0u; } }
    __syncthreads();
    XcdBarrier xbar = xcd_barrier_post((unsigned*)(((const Params*)fresh_params())->ws + WS_BAR), (volatile LAS unsigned*)(lds3 + LDS_MAIN + 4096));
    int ph = 0;
#ifndef REP_GEMM
#define REP_GEMM 1
#endif
#ifndef REP_SCAN
#define REP_SCAN 1
#endif
#ifndef REP_MISC
#define REP_MISC 1
#endif
#ifndef REP_HY
#define REP_HY 1
#endif
#define PHASE_BEGIN if (ph >= ph_lo && ph < ph_hi) { const Params& P = *fresh_params(); unsigned char* ws = P.ws; (void)ws;
#ifndef REP_SYNC
#define REP_SYNC 1
#endif
#define PHASE_END   if (ph + 1 < ph_hi) { for (int rs_ = 0; rs_ < REP_SYNC; ++rs_) { if (ph == 0) grid.sync(); else xcd_barrier(xbar); } } } ++ph;
    PHASE_BEGIN ph_modv(P, ldsf); PHASE_END
    for (int l = 0; l < DEPTH; ++l) {
        PHASE_BEGIN
            for (int rep_ = 0; rep_ < REP_MISC; ++rep_) ph_prep(P, l, ldsf);
            if (l == 0) ph_rowpass(P, 0, 0, 0, 0, 0.f, 0, 0, 0, 1, 1);
            else ph_rowpass(P, 1, l - 1, 8, 5, 0.5f, l, 0, 0, 1, 11);
        PHASE_END
        PHASE_BEGIN { EpiGU E{(bf16_t*)(ws + WS_ACT)}; for (int rep_ = 0; rep_ < REP_GEMM; ++rep_) run_gemm(lds3, (const bf16_t*)(ws + WS_U), (const bf16_t*)(ws + WS_WGU1), T, 2 * DFF, D, E); } PHASE_END
        PHASE_BEGIN { EpiF32 E{(bf16_t*)(ws + WS_Y), (float*)(ws + WS_YC)}; run_gemm_tail(lds3, (const bf16_t*)(ws + WS_ACT), (const bf16_t*)(ws + WS_WDN1), DFF, E); } PHASE_END
        PHASE_BEGIN ph_rowpass(P, 1, l, 2, 1, 0.5f, l, 2, 3, 4, 11); PHASE_END
        PHASE_BEGIN { EpiWin E{(bf16_t*)(ws + WS_PHY), (bf16_t*)(ws + WS_PRW), (bf16_t*)(ws + WS_PNA)}; for (int rep_ = 0; rep_ < REP_GEMM; ++rep_) run_gemm(lds3, (const bf16_t*)(ws + WS_U), (const bf16_t*)(ws + WS_WIN), T, INWP, D, E); } PHASE_END
        PHASE_BEGIN
            for (int rep_ = 0; rep_ < REP_MISC; ++rep_) { ph_loraprep(P, l);
            for (int it = blockIdx.x; it < NB * 128 * 6 + NB * 4 * 6; it += gridDim.x) vt_tile(P, it, (unsigned short*)smem); }
            for (int rep_ = 0; rep_ < REP_HY; ++rep_) for (int it = blockIdx.x; it < 256; it += gridDim.x) hy_spec_task(P, l, it, X);
        PHASE_END
        PHASE_BEGIN { EpiLora E{(bf16_t*)(ws + WS_LORAO), (bf16_t*)(ws + WS_GATE)};
            for (int rep_ = 0; rep_ < REP_GEMM; ++rep_) run_gemm(lds3, (const bf16_t*)(ws + WS_ALORA), (const bf16_t*)(ws + WS_WLORA), T, 2048, 384, E); } PHASE_END
        PHASE_BEGIN
            for (int rep_ = 0; rep_ < REP_MISC; ++rep_) ph_rwkvprep(P, l);
            for (int rep_ = 0; rep_ < REP_HY; ++rep_) for (int c = blockIdx.x; c < HYC; c += gridDim.x) hy_task1(P, l, c, X, ex);
        PHASE_END
        PHASE_BEGIN {
            const int wv = __builtin_amdgcn_readfirstlane(otid() >> 6);
            if (wv < 4) { const int k = wv * (int)gridDim.x + (int)blockIdx.x;
                if (k < 24 * NSEG) { const int chain = k / NSEG, g = k % NSEG; float* ring = ldsf + wv * (SCH * 320);
                    __builtin_amdgcn_s_setprio(3);
                    for (int rep_ = 0; rep_ < REP_SCAN; ++rep_) { if (g == 0) scan_seg<false>(P, chain, g, ring); else scan_seg<true>(P, chain, g, ring); }
                    __builtin_amdgcn_s_setprio(0); } }
            else for (int it = (wv - 4) * (int)gridDim.x + (int)blockIdx.x; it < NAT_TASKS; it += 4 * (int)gridDim.x) natten_task(P, l, it);
        } PHASE_END
        PHASE_BEGIN
            for (int rep_ = 0; rep_ < REP_HY; ++rep_) for (int c = blockIdx.x; c < HYC; c += gridDim.x) hy_task2(P, l, c, X);
            if (blockIdx.x >= gridDim.x - 24) scan_combine(P, (int)(gridDim.x - 1 - blockIdx.x), ldsf);
        PHASE_END
        PHASE_BEGIN for (int rep_ = 0; rep_ < REP_MISC; ++rep_) ph_rwkvout(P, l, ldsf);
            __syncthreads();
            for (int it = blockIdx.x; it < 4 * (TL / 64); it += gridDim.x) zt_tile(P, it, ldsf);
        PHASE_END
        PHASE_BEGIN { EpiF32 E{(bf16_t*)(ws + WS_Y), (float*)(ws + WS_YC)}; run_gemm_tail(lds3, (const bf16_t*)(ws + WS_U), (const bf16_t*)(ws + WS_WOUT), D, E); } PHASE_END
        PHASE_BEGIN ph_rowpass(P, 1, l, 5, 3, 1.0f, l, 4, 6, 7, 4); PHASE_END
        PHASE_BEGIN { EpiGU E{(bf16_t*)(ws + WS_ACT)}; for (int rep_ = 0; rep_ < REP_GEMM; ++rep_) run_gemm(lds3, (const bf16_t*)(ws + WS_U), (const bf16_t*)(ws + WS_WGU2), T, 2 * DFF, D, E); } PHASE_END
        PHASE_BEGIN { EpiF32 E{(bf16_t*)(ws + WS_Y), (float*)(ws + WS_YC)}; run_gemm_tail(lds3, (const bf16_t*)(ws + WS_ACT), (const bf16_t*)(ws + WS_WDN2), DFF, E); } PHASE_END
    }
    PHASE_BEGIN ph_rowpass(P, 2, DEPTH - 1, 8, 5, 0.5f, 0, 0, 0, 0, 11); PHASE_END
#undef PHASE_BEGIN
#undef PHASE_END
}
constexpr int N_PHASES = 1 + DEPTH * 15 + 1;

extern "C" void kernel_launch(void* const* d_in, const int* in_sizes, int n_in, void* d_out, int out_size, void* d_ws, size_t ws_size, hipStream_t stream) {
    static int grid = 0;
    if (grid == 0) {
        if (n_in != 34 || ws_size < WS_END) { fprintf(stderr, "kernel_launch: need 34 inputs and %zu bytes of workspace; got %d, %zu\n", (size_t)WS_END, n_in, ws_size); grid = -1; return; }
        int dev = 0, cus = 0, per_cu = 0;
        hipGetDevice(&dev); hipDeviceGetAttribute(&cus, hipDeviceAttributeMultiprocessorCount, dev);
        if (hipFuncSetAttribute((const void*)fwd_megakernel, hipFuncAttributeMaxDynamicSharedMemorySize, LDS_BYTES) != hipSuccess) { fprintf(stderr, "kernel_launch: hipFuncSetAttribute failed\n"); grid = -1; return; }
        if (hipOccupancyMaxActiveBlocksPerMultiprocessor(&per_cu, (const void*)fwd_megakernel, NTHR, LDS_BYTES) != hipSuccess || per_cu < 1) { fprintf(stderr, "kernel_launch: occupancy query says %d\n", per_cu); per_cu = 1; }
        (void)hipGetLastError();
        grid = cus;
    }
    if (grid < 0) return;
    if (hipMemsetAsync((char*)d_ws + WS_BAR, 0, (size_t)XCD_BAR_WORDS * 4, stream) != hipSuccess) { fprintf(stderr, "kernel_launch: memset of the barrier words failed\n"); return; }
    Params p{};
    for (int i = 0; i < 34; ++i) p.in[i] = (const float*)d_in[i];
    p.out = (float*)d_out; p.ws = (unsigned char*)d_ws;
#if MK_SPLIT
    for (int ph = 0; ph < N_PHASES; ++ph) { int lo = ph, hi = ph + 1; hipLaunchKernelGGL(fwd_megakernel, dim3(grid), dim3(NTHR), LDS_BYTES, stream, p, lo, hi); }
#else
    int lo = 0, hi = N_PHASES;
    void* args[] = {&p, &lo, &hi};
    hipError_t e = hipLaunchCooperativeKernel((const void*)fwd_megakernel, dim3(grid), dim3(NTHR), args, LDS_BYTES, stream);
    if (e != hipSuccess) fprintf(stderr, "cooperative launch failed: %s (grid %d)\n", hipGetErrorString(e), grid);
#endif
}
```

```cpp
#include <hip/hip_runtime.h>
#include <hip/hip_cooperative_groups.h>
#include <cstdio>
namespace cg = cooperative_groups;
__device__ __forceinline__ int otid() { int t = threadIdx.x; asm volatile("" : "+v"(t)); return t; }
namespace pg8 {
#define PG8_LAS __attribute__((address_space(3)))
typedef unsigned short bf16_t;
typedef short bf16x8 __attribute__((ext_vector_type(8)));
typedef float f32x4 __attribute__((ext_vector_type(4)));
typedef unsigned u32x4 __attribute__((ext_vector_type(4)));
constexpr int BM = 256, BK = 64, HALF = 128, HTB = HALF * BK * 2  , STAGE_BYTES = 8 * HTB, NXCD = 8, WGM = 8;

__host__ __device__ __forceinline__ int lds_byte(int r, int c) { const int st = (r >> 4) * 2 + (c >> 5), rr = r & 15, cc = c & 31, ob = rr * 64 + cc * 2; return st * 1024 + (ob ^ (((ob >> 9) & 1) << 5)); }
__host__ __device__ __forceinline__ void stage_rc(int b, int& R, int& C) { const int st = b / 1024, sb = b % 1024, swz = sb ^ (((sb >> 9) & 1) << 5); R = (st >> 1) * 16 + swz / 64; C = (st & 1) * 32 + (swz % 64) / 2; }
__host__ __device__ __forceinline__ int perm32(int rho) { const int n = rho >> 4, i = rho & 15; return 8 * (i >> 2) + 4 * n + (i & 3); }

struct Unit { int pm, pn, kt0, nkt; };
struct Gemm { const bf16_t* A; const bf16_t* Bt; int M, N, K; };
struct StaticOrder {
    int nM, nN, nwg, G, c;
    __host__ __device__ void init(int M, int N, int G_, int c_) { nM = M / BM; nN = N / BM; nwg = nM * nN; G = G_; c = c_; }
    __host__ __device__ bool next(int i, Unit& u) const {
        const long L = (long)i * G + c; if (L >= nwg) return false;
        int wgid = (int)L; { const int q = nwg / NXCD, r = nwg % NXCD, xcd = wgid % NXCD, off = wgid / NXCD; wgid = (xcd < r ? xcd * (q + 1) : r * (q + 1) + (xcd - r) * q) + off; }
        const int nig = WGM * nN, gid = wgid / nig, fm = gid * WGM, gsz = (nM - fm) < WGM ? (nM - fm) : WGM;
        u.pm = fm + ((wgid % nig) % gsz); u.pn = (wgid % nig) / gsz; u.kt0 = 0; u.nkt = 0; return true;
    }
    __device__ __forceinline__ void a_ready(const Unit&) const {}
    __device__ __forceinline__ void done(const Unit&) const {}
};
__device__ __forceinline__ unsigned cvt_pk_bf16(float lo, float hi) { unsigned r; asm volatile("v_cvt_pk_bf16_f32 %0, %1, %2" : "=v"(r) : "v"(lo), "v"(hi)); return r; }
template <class Epi, class Sched>
__device__ __forceinline__ void gemm_phase(PG8_LAS unsigned char* lds, const Gemm g, const Sched& S, const Epi& E) {
    const int tid = otid(), wid = __builtin_amdgcn_readfirstlane(tid >> 6), lane = tid & 63, wr = wid >> 2, wc = wid & 3, fr = lane & 15, fq = lane >> 4;
    const int K = g.K, nt = K / BK;
#define PG8_STAMP() do {} while (0)
    unsigned voffA[2], voffB[2];
#pragma unroll
    for (int i = 0; i < 2; ++i) { int R, C; stage_rc(tid * 16 + i * 8192, R, C); const int Rb = Epi::PERM ? ((R & ~31) + perm32(R & 31)) : R;
        voffA[i] = (unsigned)(R * K + C) * 2u; voffB[i] = (unsigned)(Rb * K + C) * 2u; }
    const size_t kstep = (size_t)(BK * 2);
    const size_t hstep = (size_t)HALF * K * 2;
    const size_t tstep = 2 * hstep;
    const unsigned ldsw = (unsigned)wid * 1024u;
    const int aoff = lds_byte(wr * 64 + fr, fq * 8), boff = lds_byte(wc * 32 + fr, fq * 8);
#define PG8_SA(b, h) (((b) * 2 + (h)) * HTB)
#define PG8_SB(b, h) ((4 + (b) * 2 + (h)) * HTB)
#define PG8_STAGE(bufoff, gbase, voff) do { _Pragma("unroll") for (int _i = 0; _i < 2; ++_i) \
        __builtin_amdgcn_global_load_lds((const unsigned*)((const char*)(gbase) + (voff)[_i]), (PG8_LAS unsigned*)(lds + (bufoff) + ldsw + _i * 8192), 16, 0, 0); } while (0)
#define PG8_LDA(dst, b, h) do { _Pragma("unroll") for (int m = 0; m < 4; ++m) _Pragma("unroll") for (int k = 0; k < 2; ++k) dst[m][k] = *(const PG8_LAS bf16x8*)(lds + PG8_SA(b, h) + aoff + m * 2048 + k * 1024); } while (0)
#define PG8_LDB(dst, b, h) do { _Pragma("unroll") for (int n = 0; n < 2; ++n) _Pragma("unroll") for (int k = 0; k < 2; ++k) dst[n][k] = *(const PG8_LAS bf16x8*)(lds + PG8_SB(b, h) + boff + n * 2048 + k * 1024); } while (0)
#define PG8_MMA(ai, bj, At, Bt) do { __builtin_amdgcn_s_setprio(1); _Pragma("unroll") for (int m = 0; m < 4; ++m) _Pragma("unroll") for (int n = 0; n < 2; ++n) _Pragma("unroll") for (int k = 0; k < 2; ++k) \
        acc[ai][bj][m][n] = __builtin_amdgcn_mfma_f32_16x16x32_bf16(Bt[n][k], At[m][k], acc[ai][bj][m][n], 0, 0, 0); __builtin_amdgcn_s_setprio(0); } while (0)
#define PG8_WAIT_V(n) asm volatile("s_waitcnt vmcnt(" #n ")" ::: "memory")
#define PG8_WAIT_L(n) asm volatile("s_waitcnt lgkmcnt(" #n ")" ::: "memory")
#define PG8_BAR __builtin_amdgcn_s_barrier()
#define PG8_SCHED __builtin_amdgcn_sched_barrier(0)
    Unit cur, nxt; int ui = 0;
    if (!S.next(0, cur)) return;
    f32x4 acc[2][2][4][2];
#pragma unroll
    for (int a = 0; a < 2; ++a)
#pragma unroll
        for (int b = 0; b < 2; ++b)
#pragma unroll
            for (int m = 0; m < 4; ++m)
#pragma unroll
                for (int n = 0; n < 2; ++n) acc[a][b][m][n] = (f32x4){0.f, 0.f, 0.f, 0.f};
    bf16x8 At[4][2], B0[2][2], B1[2][2];
    const char* cA = (const char*)g.A + (size_t)cur.pm * tstep + (size_t)cur.kt0 * kstep; const char* cB = (const char*)g.Bt + (size_t)cur.pn * tstep + (size_t)cur.kt0 * kstep;
    int ntc = cur.nkt > 0 ? cur.nkt : nt;
    S.a_ready(cur);
    PG8_STAGE(PG8_SB(0, 0), cB, voffB); PG8_STAGE(PG8_SA(0, 0), cA, voffA); PG8_STAGE(PG8_SB(0, 1), cB + hstep, voffB); PG8_STAGE(PG8_SA(0, 1), cA + hstep, voffA);
    if (wr == 1) PG8_BAR;
    PG8_WAIT_V(4); PG8_BAR;
    PG8_STAGE(PG8_SB(1, 0), cB + kstep, voffB); PG8_STAGE(PG8_SA(1, 0), cA + kstep, voffA); PG8_STAGE(PG8_SB(1, 1), cB + hstep + kstep, voffB);
    PG8_WAIT_V(6); PG8_BAR;
    PG8_STAMP();
    for (;;) {
        const bool has_next = S.next(ui + 1, nxt);
        const char* nA = has_next ? (const char*)g.A + (size_t)nxt.pm * tstep + (size_t)nxt.kt0 * kstep : cA; const char* nB = has_next ? (const char*)g.Bt + (size_t)nxt.pn * tstep + (size_t)nxt.kt0 * kstep : cB;
        for (int t = 0; t < ntc; t += 2) {
            const bool last = (t == ntc - 2);
            const char* a1 = cA + (size_t)(t + 1) * kstep;
            const char* a2 = last ? nA : cA + (size_t)(t + 2) * kstep; const char* b2 = last ? nB : cB + (size_t)(t + 2) * kstep;
            const char* a3 = a2 + kstep; const char* b3 = b2 + kstep;
            if (last && has_next) S.a_ready(nxt);
            PG8_LDB(B0, 0, 0); PG8_SCHED; PG8_LDA(At, 0, 0); PG8_STAGE(PG8_SA(1, 1), a1 + hstep, voffA);
            PG8_WAIT_L(8); PG8_BAR; PG8_WAIT_L(0); PG8_MMA(0, 0, At, B0); PG8_BAR; PG8_SCHED;
            PG8_LDB(B1, 0, 1); PG8_STAGE(PG8_SB(0, 0), b2, voffB);
            PG8_BAR; PG8_WAIT_L(0); PG8_MMA(0, 1, At, B1); PG8_BAR;
            PG8_LDA(At, 0, 1); PG8_STAGE(PG8_SA(0, 0), a2, voffA);
            PG8_BAR; PG8_WAIT_L(0); PG8_MMA(1, 0, At, B0); PG8_BAR; PG8_SCHED;
            PG8_STAGE(PG8_SB(0, 1), b2 + hstep, voffB);
            PG8_WAIT_V(6); PG8_BAR; PG8_MMA(1, 1, At, B1); PG8_BAR;
            PG8_LDB(B0, 1, 0); PG8_SCHED; PG8_LDA(At, 1, 0); PG8_STAGE(PG8_SA(0, 1), a2 + hstep, voffA);
            PG8_WAIT_L(8); PG8_BAR; PG8_WAIT_L(0); PG8_MMA(0, 0, At, B0); PG8_BAR; PG8_SCHED;
            PG8_LDB(B1, 1, 1); PG8_STAGE(PG8_SB(1, 0), b3, voffB);
            PG8_BAR; PG8_WAIT_L(0); PG8_MMA(0, 1, At, B1); PG8_BAR;
            PG8_LDA(At, 1, 1); PG8_STAGE(PG8_SA(1, 0), a3, voffA);
            PG8_BAR; PG8_WAIT_L(0); PG8_MMA(1, 0, At, B0); PG8_BAR; PG8_SCHED;
            PG8_STAGE(PG8_SB(1, 1), b3 + hstep, voffB);
            PG8_WAIT_V(6); PG8_BAR; PG8_MMA(1, 1, At, B1); PG8_BAR;
        }
        PG8_STAMP();
        if constexpr (!Epi::AFTER_DRAIN) { E(acc, cur, wr, wc, fr, fq); S.done(cur); }
        PG8_STAMP();
        if (!has_next) break;
#pragma unroll
        for (int a = 0; a < 2; ++a)
#pragma unroll
            for (int b = 0; b < 2; ++b)
#pragma unroll
                for (int m = 0; m < 4; ++m)
#pragma unroll
                    for (int n = 0; n < 2; ++n) acc[a][b][m][n] = (f32x4){0.f, 0.f, 0.f, 0.f};
        cur = nxt; cA = nA; cB = nB; ++ui; ntc = cur.nkt > 0 ? cur.nkt : nt;
    }
    PG8_WAIT_V(0);
    if (wr == 0) PG8_BAR;
    PG8_BAR;
    if constexpr (Epi::AFTER_DRAIN) { E.fused(acc, cur, wr, wc, fr, fq, lds, wid, lane); S.done(cur); }
    PG8_STAMP();
#undef PG8_STAMP
#undef PG8_SA
#undef PG8_SB
#undef PG8_STAGE
#undef PG8_LDA
#undef PG8_LDB
#undef PG8_MMA
#undef PG8_WAIT_V
#undef PG8_WAIT_L
#undef PG8_BAR
#undef PG8_SCHED
}
}
#define LAS __attribute__((address_space(3)))
#define XB_TMO      128
#define XB_XCNT(j)  (256  + 64 * (j))
#define XB_XSUB(j)  (1280 + 64 * (j))
#define XB_XGEN(j)  (2304 + 64 * (j))
#define XB_TOP      3328
#define XB_TOPGEN   3392
#define XCD_BAR_WORDS 3456
#define XB_SPIN_CAP (1u << 18)

__device__ __forceinline__ unsigned xb_ld(unsigned* p)              { return __hip_atomic_load(p, __ATOMIC_RELAXED, __HIP_MEMORY_SCOPE_AGENT); }
__device__ __forceinline__ unsigned xb_add(unsigned* p, unsigned v) { return __hip_atomic_fetch_add(p, v, __ATOMIC_RELAXED, __HIP_MEMORY_SCOPE_AGENT); }
__device__ __forceinline__ unsigned xb_xcc_id() { return (unsigned)__builtin_amdgcn_s_getreg((3 << 11) | 20) & 0xFu; }
#define XB_SPIN(cond, bar) do { unsigned _sp = 0; while (cond) { __builtin_amdgcn_s_sleep(1); \
    if ((++_sp & 255u) == 0u) { if (xb_ld(&(bar)[XB_TMO])) break; if (_sp > XB_SPIN_CAP) { atomicAdd(&(bar)[XB_TMO], 1u); break; } } } } while (0)

struct XcdBarrier {
    unsigned* bar; unsigned x;
    volatile LAS unsigned* st;
};

__device__ __forceinline__ XcdBarrier xcd_barrier_post(unsigned* bar, volatile LAS unsigned* st) {
    XcdBarrier b; b.bar = bar; b.x = xb_xcc_id(); b.st = st;
    if (threadIdx.x == 0) (void)xb_add(&bar[XB_XCNT(b.x)], 1u);
    return b;
}
__device__ __forceinline__ void xcd_barrier_complete(unsigned* bar, unsigned x, unsigned& nloc, unsigned& nx) {
    const unsigned G = gridDim.x * gridDim.y * gridDim.z;
    unsigned sum, cnt, mine, sp = 0u;
    for (;;) {
        sum = 0u; cnt = 0u; mine = 0u;
#pragma unroll
        for (unsigned j = 0; j < 16; ++j) { const unsigned c = xb_ld(&bar[XB_XCNT(j)]); sum += c; cnt += (c > 0u) ? 1u : 0u; mine = (j == x) ? c : mine; }
        if (sum == G) break;
        __builtin_amdgcn_s_sleep(1);
        if ((++sp & 255u) == 0u) { if (xb_ld(&bar[XB_TMO])) break; if (sp > XB_SPIN_CAP) { atomicAdd(&bar[XB_TMO], 1u); break; } }
    }
    nloc = mine > 0u ? mine : 1u; nx = cnt > 0u ? cnt : 1u;
}

__device__ __forceinline__ void xcd_barrier(const XcdBarrier& b) {
    asm volatile("s_waitcnt vmcnt(0)" ::: "memory");
    __syncthreads();
    if (threadIdx.x == 0) {
        unsigned* bar = b.bar;
        __builtin_amdgcn_s_waitcnt(0);
        unsigned nloc = b.st[0], nx = b.st[1];
        if (nloc == 0u) { xcd_barrier_complete(bar, b.x, nloc, nx); b.st[0] = nloc; b.st[1] = nx; }
        const unsigned old = xb_add(&bar[XB_XSUB(b.x)], 1u);
        const unsigned gen = old / nloc;
        if (old + 1u == (gen + 1u) * nloc) {
            __builtin_amdgcn_fence(__ATOMIC_RELEASE, "agent");
            asm volatile("s_waitcnt vmcnt(0)" ::: "memory");
            const unsigned og = xb_add(&bar[XB_TOP], 1u);
            const unsigned tg = og / nx;
            if (og + 1u == (tg + 1u) * nx) xb_add(&bar[XB_TOPGEN], 1u);
            else XB_SPIN(xb_ld(&bar[XB_TOPGEN]) == tg, bar);
            __builtin_amdgcn_fence(__ATOMIC_ACQUIRE, "agent");
            xb_add(&bar[XB_XGEN(b.x)], 1u);
            asm volatile("s_waitcnt vmcnt(0)" ::: "memory");
        } else {
            XB_SPIN(xb_ld(&bar[XB_XGEN(b.x)]) == gen, bar);
            __builtin_amdgcn_fence(__ATOMIC_ACQUIRE, "agent");
            asm volatile("s_waitcnt vmcnt(0)" ::: "memory");
        }
    }
    __syncthreads();
}

using pg8::bf16_t; using pg8::f32x4; using pg8::u32x4; using pg8::cvt_pk_bf16;
typedef unsigned u32x2 __attribute__((ext_vector_type(2)));


constexpr int D = 1024, NB = 2, SEQ = 8192, DEPTH = 4, CTX = 256, DFF = 2816;
constexpr int TL = NB * SEQ, TC = NB * CTX, T = TL + TC;
constexpr int NMOD = 9 * D;
constexpr int HYC = 256, RWW = 384, NAW = 384, INW = 3456, INWP = 3584;
constexpr int HY_IN = 768, RW_IN = 1536, NA_IN = 1152;
constexpr int NFFT = 16384;
constexpr int NTHR = 512, NWAVE = 8;
constexpr int LDS_MAIN = 131072, LDS_EXTRA = 8192, LDS_BYTES = LDS_MAIN + LDS_EXTRA;
constexpr float NORM_EPS = 1e-6f;

constexpr size_t al256(size_t x) { return (x + 255) & ~(size_t)255; }
constexpr size_t WS_MODV = 0;
constexpr size_t WS_WGU1 = al256(WS_MODV + (size_t)DEPTH * 3 * NMOD * 4);
constexpr size_t WS_WDN1 = WS_WGU1 + (size_t)2 * DFF * D * 2;
constexpr size_t WS_WGU2 = WS_WDN1 + (size_t)D * DFF * 2;
constexpr size_t WS_WDN2 = WS_WGU2 + (size_t)2 * DFF * D * 2;
constexpr size_t WS_WIN = WS_WDN2 + (size_t)D * DFF * 2;
constexpr size_t WS_WOUT = WS_WIN + (size_t)INWP * D * 2;
constexpr size_t WS_WLORA = WS_WOUT + (size_t)D * D * 2;
constexpr size_t WS_H = WS_WLORA + (size_t)2048 * 384 * 2;
constexpr size_t WS_U = WS_H + (size_t)T * D * 4;
constexpr size_t WS_S = WS_U + (size_t)T * D * 2;
constexpr size_t WS_Y = WS_S;
constexpr size_t WS_ACT = WS_Y + (size_t)T * D * 4;
constexpr size_t WS_FFN_END = WS_ACT + (size_t)T * DFF * 2;
constexpr size_t WS_PHY = WS_S;
constexpr size_t WS_PRW = WS_PHY + (size_t)T * HY_IN * 2;
constexpr size_t WS_YDIR = WS_PRW;
constexpr size_t WS_PNA = WS_PRW + (size_t)T * RW_IN * 2;
constexpr size_t WS_ALORA = WS_PNA + (size_t)T * NA_IN * 2;
constexpr size_t WS_DECAY = WS_ALORA + (size_t)T * 384 * 2;
constexpr size_t WS_LORAO = WS_DECAY + (size_t)2 * T * 384 * 4;
constexpr size_t WS_E = WS_LORAO;
constexpr size_t WS_ZP = WS_E + (size_t)24 * SEQ * 64 * 2;
constexpr size_t WS_GATE = WS_LORAO + (size_t)T * 1536 * 2;
static_assert(WS_ZP + (size_t)24 * 33 * 2 * 4096 * 4 <= WS_GATE, "E + ZP must fit in the LORAO region");
constexpr size_t WS_RS = WS_GATE + (size_t)T * 384 * 2;
constexpr size_t WS_KKS = WS_RS + (size_t)T * 384 * 2;
constexpr size_t WS_VS = WS_KKS + (size_t)T * 384 * 2;
constexpr size_t WS_KS = WS_VS + (size_t)T * 384 * 2;
constexpr size_t WS_BS = WS_KS + (size_t)2 * T * 384 * 2;
constexpr size_t WS_BONUS = WS_BS + (size_t)2 * T * 384 * 2;
constexpr size_t WS_FILT = al256(WS_BONUS + (size_t)T * 6 * 4);
constexpr size_t WS_FILTC = WS_FILT + (size_t)1024 * SEQ * 2;
constexpr size_t WS_SPEC = WS_FILTC + (size_t)1024 * CTX * 2;
constexpr size_t WS_Z1 = WS_SPEC + (size_t)512 * NFFT * 8;
constexpr size_t WS_VTL = WS_Z1 + (size_t)HYC * NB * SEQ * 4;
constexpr size_t WS_VTC = WS_VTL + (size_t)NB * 6 * 64 * SEQ * 2;
constexpr size_t WS_MIX_END = WS_VTC + (size_t)NB * 6 * 64 * CTX * 2;
constexpr size_t WS_BAR = al256(WS_MIX_END > WS_FFN_END ? WS_MIX_END : WS_FFN_END);
constexpr size_t WS_ROPE = al256(WS_BAR + (size_t)XCD_BAR_WORDS * 4);
constexpr size_t WS_YC = WS_FFN_END + (size_t)(8 << 20);
static_assert(WS_YC + (size_t)11 * TC * D * 4 <= WS_FILT, "YC partials must stay below the filter tables");
constexpr size_t WS_END = WS_ROPE + (size_t)128 * 16 * 8;
static_assert(WS_END <= (size_t)4 * DEPTH * D * NMOD * 4, "workspace map exceeds 4x the largest input tensor");

struct Params { const float* in[34]; float* out; unsigned char* ws; };
enum { I_X = 0, I_C, I_CTX, I_CCTX, I_MODW, I_MODB, I_NORMG, I_F1GU, I_F1DN, I_F2GU, I_F2DN, I_WIN, I_WOUT, I_HCW, I_HCB, I_HW1, I_HB1, I_HW2, I_HB2, I_HW3, I_HFREQ, I_HBIAS,
       I_MU, I_W0, I_W2, I_A0, I_A2, I_G2, I_KK, I_KA, I_RK, I_LNW, I_LNB, I_RPB };

typedef LAS float* ldsfp;
__device__ __forceinline__ ldsfp vlds(const void* p) { ldsfp q = (ldsfp)p; asm volatile("" : "+v"(q)); return q; }
__device__ __forceinline__ float bf2f(bf16_t b) { return __uint_as_float(((unsigned)b) << 16); }
__device__ __forceinline__ bf16_t f2bf(float f) { unsigned u = __float_as_uint(f); u += 0x7FFFu + ((u >> 16) & 1u); return (bf16_t)(u >> 16); }
__device__ __forceinline__ float lo_bf(unsigned w) { return __uint_as_float(w << 16); }
__device__ __forceinline__ float hi_bf(unsigned w) { return __uint_as_float(w & 0xffff0000u); }
__device__ __forceinline__ float wsum(float v) {
#pragma unroll
    for (int o = 32; o > 0; o >>= 1) v += __shfl_xor(v, o);
    return v;
}
__device__ __forceinline__ float sigmoidf_(float x) { return __builtin_amdgcn_rcpf(1.0f + __expf(-x)); }
__device__ __forceinline__ void unpack8(const u32x4 w, float (&f)[8]) {
    f[0] = lo_bf(w.x); f[1] = hi_bf(w.x); f[2] = lo_bf(w.y); f[3] = hi_bf(w.y); f[4] = lo_bf(w.z); f[5] = hi_bf(w.z); f[6] = lo_bf(w.w); f[7] = hi_bf(w.w);
}
__device__ __forceinline__ void row_nbrs(int row, bool& hasp, bool& hasn) {
    if (row < TL) { const int t = row & (SEQ - 1); hasp = t > 0; hasn = t < SEQ - 1; }
    else { const int t = (row - TL) & (CTX - 1); hasp = t > 0; hasn = t < CTX - 1; }
}

__device__ __forceinline__ void ph_modv(const Params& P, float* lds) {
    const int tid = otid();
    float* sv = lds;
    float* red = lds + 3072;
    for (int i = tid; i < 3072; i += NTHR) { const int s = i >> 10, k = i & 1023; const float c = s < 2 ? P.in[I_C][s * 1024 + k] : P.in[I_CCTX][k]; sv[i] = c / (1.0f + expf(-c)); }
    __syncthreads();
    if (blockIdx.x < 4) { const int e = blockIdx.x * NTHR + tid, pos = e >> 4, f = e & 15; float sn, cs; sincosf((float)pos * expf(-(float)f * (9.210340371976184f / 16.0f)), &sn, &cs); ((float2*)(P.ws + WS_ROPE))[e] = make_float2(cs, sn); }
    float* modv = (float*)(P.ws + WS_MODV);
    const int kc = tid >> 6, cl = tid & 63;
    for (int item = blockIdx.x; item < DEPTH * 144; item += gridDim.x) {
        const int l = item / 144, cb = item % 144, col = cb * 64 + cl;
        const float* w = P.in[I_MODW] + ((size_t)l * 1024 + kc * 128) * NMOD + col;
        float a0 = 0.f, a1 = 0.f, a2 = 0.f;
#pragma unroll 8
        for (int k = 0; k < 128; ++k) { const float wv = __builtin_nontemporal_load(w + (size_t)k * NMOD); a0 += sv[kc * 128 + k] * wv; a1 += sv[1024 + kc * 128 + k] * wv; a2 += sv[2048 + kc * 128 + k] * wv; }
        red[(0 * 8 + kc) * 64 + cl] = a0; red[(1 * 8 + kc) * 64 + cl] = a1; red[(2 * 8 + kc) * 64 + cl] = a2;
        __syncthreads();
        if (tid < 192) { const int s = tid >> 6, c = tid & 63; float r = P.in[I_MODB][l * NMOD + cb * 64 + c];
#pragma unroll
            for (int q = 0; q < 8; ++q) r += red[(s * 8 + q) * 64 + c];
            modv[((size_t)l * 3 + s) * NMOD + cb * 64 + c] = r; }
        __syncthreads();
    }
}

__device__ __forceinline__ float hy_delta(int c);
__device__ __forceinline__ int rowmap_gu(int n) { const int up = n >= DFF ? 1 : 0; const int j = n - up * DFF; return (j >> 7) * 256 + up * 128 + (j & 127); }
__device__ __forceinline__ void conv_tile(const float* __restrict__ src, int K, int N, bf16_t* __restrict__ dst, int tk, int tn, bool gu, float* tile) {
    const int tid = otid(); const int k0 = tk * 64, n0 = tn * 64;
#pragma unroll
    for (int rr = 0; rr < 2; ++rr) { const int kk = (tid >> 4) + rr * 32, n4 = (tid & 15) * 4; const f32x4 vv_ = __builtin_nontemporal_load((const f32x4*)(src + (size_t)(k0 + kk) * N + n0 + n4)); const float4 v = make_float4(vv_[0], vv_[1], vv_[2], vv_[3]);
        tile[kk * 65 + n4 + 0] = v.x; tile[kk * 65 + n4 + 1] = v.y; tile[kk * 65 + n4 + 2] = v.z; tile[kk * 65 + n4 + 3] = v.w; }
    __syncthreads();
    { const int nn = tid >> 3, ks = (tid & 7) * 8; const int n = n0 + nn; const int row = gu ? rowmap_gu(n) : n;
      u32x4 w; w.x = cvt_pk_bf16(tile[(ks + 0) * 65 + nn], tile[(ks + 1) * 65 + nn]); w.y = cvt_pk_bf16(tile[(ks + 2) * 65 + nn], tile[(ks + 3) * 65 + nn]);
      w.z = cvt_pk_bf16(tile[(ks + 4) * 65 + nn], tile[(ks + 5) * 65 + nn]); w.w = cvt_pk_bf16(tile[(ks + 6) * 65 + nn], tile[(ks + 7) * 65 + nn]);
      *(u32x4*)(dst + (size_t)row * K + k0 + ks) = w; }
    __syncthreads();
}
__device__ __forceinline__ void ph_prep(const Params& P, int l, float* lds) {
    const int tid = otid();
    unsigned char* ws = P.ws;
    constexpr int N0 = 16 * 88, N1 = 44 * 16, N4 = 16 * 54, N5 = 16 * 16;
    constexpr int C0 = N0, C1 = C0 + N1, C2 = C1 + N0, C3 = C2 + N1, C4 = C3 + N4, C5 = C4 + N5;
    for (int it = blockIdx.x; it < C5; it += gridDim.x) {
        if (it < C0) { conv_tile(P.in[I_F1GU] + (size_t)l * D * 2 * DFF, D, 2 * DFF, (bf16_t*)(ws + WS_WGU1), it / 88, it % 88, true, lds); }
        else if (it < C1) { const int j = it - C0; conv_tile(P.in[I_F1DN] + (size_t)l * DFF * D, DFF, D, (bf16_t*)(ws + WS_WDN1), j / 16, j % 16, false, lds); }
        else if (it < C2) { const int j = it - C1; conv_tile(P.in[I_F2GU] + (size_t)l * D * 2 * DFF, D, 2 * DFF, (bf16_t*)(ws + WS_WGU2), j / 88, j % 88, true, lds); }
        else if (it < C3) { const int j = it - C2; conv_tile(P.in[I_F2DN] + (size_t)l * DFF * D, DFF, D, (bf16_t*)(ws + WS_WDN2), j / 16, j % 16, false, lds); }
        else if (it < C4) { const int j = it - C3; conv_tile(P.in[I_WIN] + (size_t)l * D * INW, D, INW, (bf16_t*)(ws + WS_WIN), j / 54, j % 54, false, lds); }
        else { const int j = it - C4; conv_tile(P.in[I_WOUT] + (size_t)l * D * D, D, D, (bf16_t*)(ws + WS_WOUT), j / 16, j % 16, false, lds); }
    }
    const int gtid = blockIdx.x * NTHR + tid, gn = gridDim.x * NTHR;
    { unsigned* z = (unsigned*)(ws + WS_WIN + (size_t)INW * D * 2); for (int i = gtid; i < (INWP - INW) * D / 2; i += gn) z[i] = 0u; }
    { bf16_t* wl = (bf16_t*)(ws + WS_WLORA);
      const float* w2 = P.in[I_W2] + (size_t)l * 2 * 64 * RWW; const float* a2 = P.in[I_A2] + (size_t)l * 2 * 64 * RWW; const float* g2 = P.in[I_G2] + (size_t)l * 128 * RWW;
      for (int i = gtid; i < 2048 * 48; i += gn) { const int kb = (i / 2048) * 8, j = i % 2048; float v[8];
#pragma unroll
          for (int q = 0; q < 8; ++q) v[q] = 0.f;
          if (j < 1920) { const int grp = j / 384, c = j % 384;
              const bool act = grp < 4 ? (kb >> 6) == grp : kb >= 256;
              if (act) { const float* src = (grp < 2 ? w2 + (size_t)kb * RWW : (grp < 4 ? a2 + (size_t)(kb - 128) * RWW : g2 + (size_t)(kb - 256) * RWW)) + c;
#pragma unroll
                  for (int q = 0; q < 8; ++q) v[q] = src[(size_t)q * RWW]; } }
          u32x4 w; w.x = cvt_pk_bf16(v[0], v[1]); w.y = cvt_pk_bf16(v[2], v[3]); w.z = cvt_pk_bf16(v[4], v[5]); w.w = cvt_pk_bf16(v[6], v[7]);
          *(u32x4*)(wl + (size_t)j * 384 + kb) = w; } }
    { const float* w1_ = P.in[I_HW1] + (size_t)l * 33 * 64; const float* b1 = P.in[I_HB1] + l * 64; const float* w2f_ = P.in[I_HW2] + (size_t)l * 64 * 64; const float* b2 = P.in[I_HB2] + l * 64;
      const float* fqv = P.in[I_HFREQ] + l * 64; const float* w3 = P.in[I_HW3] + (size_t)l * 64 * 1024;
      const int lane = tid & 63, wv = tid >> 6;
      const float fq = fqv[lane], bb1 = b1[lane], bb2 = b2[lane];
      const ldsfp hl = vlds(lds);
      for (int task = blockIdx.x; task < 256; task += gridDim.x) {
          const int n0 = task * 32;
          __syncthreads();
#pragma unroll 1
          for (int p = wv; p < 33; p += NWAVE) { const int L = p < 32 ? SEQ : CTX, pos = p < 32 ? n0 + p : task;
              const float* w1 = w1_; const float* w2f = w2f_; asm volatile("" : "+s"(w1), "+s"(w2f));
              const float tt = (float)pos / (float)(L - 1);
              const float ang = 6.283185307179586f * (float)pos / (float)L;
              float z = 0.f;
              if (lane == 0) z = tt;
              else if (lane <= 16) { const float fr = 1e-4f + (float)(lane - 1) * ((15.0f - 1e-4f) / 15.0f); z = cosf(fr * ang); }
              else if (lane <= 32) { const float fr = 1e-4f + (float)(lane - 17) * ((15.0f - 1e-4f) / 15.0f); z = -sinf(fr * ang); }
              float a = bb1;
#pragma unroll
              for (int e = 0; e < 33; ++e) a += __shfl(z, e) * w1[e * 64 + lane];
              const float h1 = sinf(fq * a);
              float c = bb2;
#pragma unroll
              for (int i = 0; i < 64; ++i) c += __shfl(h1, i) * w2f[i * 64 + lane];
              hl[lane * 36 + p] = sinf(fq * c); }
          __syncthreads();
          float acc0[33], acc1[33];
#pragma unroll
          for (int p = 0; p < 33; ++p) { acc0[p] = 0.f; acc1[p] = 0.f; }
#pragma unroll 2
          for (int i = 0; i < 64; ++i) { const float wa = w3[(size_t)i * 1024 + tid], wb = w3[(size_t)i * 1024 + 512 + tid];
#pragma unroll
              for (int p4 = 0; p4 < 8; ++p4) { const f32x4 hv = *(const LAS f32x4*)(hl + i * 36 + p4 * 4);
                  acc0[p4 * 4 + 0] += hv.x * wa; acc0[p4 * 4 + 1] += hv.y * wa; acc0[p4 * 4 + 2] += hv.z * wa; acc0[p4 * 4 + 3] += hv.w * wa;
                  acc1[p4 * 4 + 0] += hv.x * wb; acc1[p4 * 4 + 1] += hv.y * wb; acc1[p4 * 4 + 2] += hv.z * wb; acc1[p4 * 4 + 3] += hv.w * wb; }
              const float hc = hl[i * 36 + 32]; acc0[32] += hc * wa; acc1[32] += hc * wb; }
          const float dl = hy_delta(tid & 255), sc = 1.0f / NFFT, invL = 1.0f / (float)(SEQ - 1);
          bf16_t* dst = (bf16_t*)(ws + WS_FILT) + (size_t)tid * SEQ + n0;
          const size_t cstep = (size_t)512 * SEQ;
#pragma unroll
          for (int p8 = 0; p8 < 4; ++p8) { float d[8];
#pragma unroll
              for (int k = 0; k < 8; ++k) d[k] = __expf(-((float)(n0 + p8 * 8 + k) * invL) * dl) * sc;
              u32x4 w; w.x = cvt_pk_bf16(acc0[p8 * 8 + 0] * d[0], acc0[p8 * 8 + 1] * d[1]); w.y = cvt_pk_bf16(acc0[p8 * 8 + 2] * d[2], acc0[p8 * 8 + 3] * d[3]);
              w.z = cvt_pk_bf16(acc0[p8 * 8 + 4] * d[4], acc0[p8 * 8 + 5] * d[5]); w.w = cvt_pk_bf16(acc0[p8 * 8 + 6] * d[6], acc0[p8 * 8 + 7] * d[7]);
              *(u32x4*)(dst + p8 * 8) = w;
              w.x = cvt_pk_bf16(acc1[p8 * 8 + 0] * d[0], acc1[p8 * 8 + 1] * d[1]); w.y = cvt_pk_bf16(acc1[p8 * 8 + 2] * d[2], acc1[p8 * 8 + 3] * d[3]);
              w.z = cvt_pk_bf16(acc1[p8 * 8 + 4] * d[4], acc1[p8 * 8 + 5] * d[5]); w.w = cvt_pk_bf16(acc1[p8 * 8 + 6] * d[6], acc1[p8 * 8 + 7] * d[7]);
              *(u32x4*)(dst + cstep + p8 * 8) = w; }
          { const float dc = __expf(-((float)task * (1.0f / (float)(CTX - 1))) * dl); bf16_t* fc = (bf16_t*)(ws + WS_FILTC) + (size_t)tid * CTX + task;
            fc[0] = f2bf(acc0[32] * dc); fc[(size_t)512 * CTX] = f2bf(acc1[32] * dc); }
      }
      __syncthreads(); }
}

__device__ __forceinline__ void ph_rowpass(const Params& P, int mode, int lpost, int gate_i, int gpost_i, float ps, int lpre, int gpre_i, int shift_i, int scale_i, int nsplit) {
    const int tid = otid(), lane = tid & 63, gw = blockIdx.x * NWAVE + (tid >> 6), nw = gridDim.x * NWAVE;
    const float* modv = (const float*)(P.ws + WS_MODV);
    float* H = (float*)(P.ws + WS_H); const bf16_t* Y = (const bf16_t*)(P.ws + WS_Y); bf16_t* U = (bf16_t*)(P.ws + WS_U);
    int cur_s = -1;
    float4 A[4], Bv[4], Cv[4];
#pragma unroll
    for (int j = 0; j < 4; ++j) { A[j] = make_float4(0.f, 0.f, 0.f, 0.f); Bv[j] = A[j]; Cv[j] = A[j]; }
    for (int row = gw; row < T; row += nw) {
        const int s = row < SEQ ? 0 : (row < TL ? 1 : 2);
        if (s != cur_s) { cur_s = s;
#pragma unroll
            for (int j = 0; j < 4; ++j) { const int e = lane * 4 + 256 * j;
                if (mode != 0) { const float4 g = *(const float4*)(modv + ((size_t)lpost * 3 + s) * NMOD + gate_i * D + e); const float4 gp = *(const float4*)(P.in[I_NORMG] + ((size_t)lpost * 6 + gpost_i) * D + e);
                    A[j] = make_float4(ps * g.x * gp.x, ps * g.y * gp.y, ps * g.z * gp.z, ps * g.w * gp.w); }
                if (mode != 2) { const float4 sc = *(const float4*)(modv + ((size_t)lpre * 3 + s) * NMOD + scale_i * D + e); const float4 gq = *(const float4*)(P.in[I_NORMG] + ((size_t)lpre * 6 + gpre_i) * D + e);
                    Bv[j] = make_float4(gq.x * (1.f + sc.x), gq.y * (1.f + sc.y), gq.z * (1.f + sc.z), gq.w * (1.f + sc.w));
                    Cv[j] = *(const float4*)(modv + ((size_t)lpre * 3 + s) * NMOD + shift_i * D + e); } } }
        float4 h[4];
        if (mode == 0) { const float* src = row < TL ? P.in[I_X] + (size_t)row * D : P.in[I_CTX] + (size_t)(row - TL) * D;
#pragma unroll
            for (int j = 0; j < 4; ++j) h[j] = *(const float4*)(src + lane * 4 + 256 * j);
        } else {
            float4 y[4]; float ss = 0.f;
#pragma unroll
            for (int j = 0; j < 4; ++j) { h[j] = *(const float4*)(H + (size_t)row * D + lane * 4 + 256 * j); if (row < TL) { const u32x2 yw = *(const u32x2*)(Y + (size_t)row * D + lane * 4 + 256 * j); y[j] = make_float4(lo_bf(yw.x), hi_bf(yw.x), lo_bf(yw.y), hi_bf(yw.y)); } else { const float* yp = (const float*)(P.ws + WS_YC) + (size_t)(row - TL) * D + lane * 4 + 256 * j; float4 a = *(const float4*)yp;
                    for (int q = 1; q < nsplit; ++q) { const float4 b4 = *(const float4*)(yp + (size_t)q * TC * D); a.x += b4.x; a.y += b4.y; a.z += b4.z; a.w += b4.w; } y[j] = a; }
                ss += y[j].x * y[j].x + y[j].y * y[j].y + y[j].z * y[j].z + y[j].w * y[j].w; }
            ss = wsum(ss); const float r = rsqrtf(ss * (1.0f / D) + NORM_EPS);
#pragma unroll
            for (int j = 0; j < 4; ++j) { h[j].x += A[j].x * (y[j].x * r); h[j].y += A[j].y * (y[j].y * r); h[j].z += A[j].z * (y[j].z * r); h[j].w += A[j].w * (y[j].w * r); }
        }
        if (mode == 2) { if (row < TL) {
#pragma unroll
                for (int j = 0; j < 4; ++j) *(float4*)(P.out + (size_t)row * D + lane * 4 + 256 * j) = h[j]; }
            continue; }
        float s2 = 0.f;
#pragma unroll
        for (int j = 0; j < 4; ++j) { *(float4*)(H + (size_t)row * D + lane * 4 + 256 * j) = h[j]; s2 += h[j].x * h[j].x + h[j].y * h[j].y + h[j].z * h[j].z + h[j].w * h[j].w; }
        s2 = wsum(s2); const float r2 = rsqrtf(s2 * (1.0f / D) + NORM_EPS);
#pragma unroll
        for (int j = 0; j < 4; ++j) { u32x2 w; w.x = cvt_pk_bf16(h[j].x * r2 * Bv[j].x + Cv[j].x, h[j].y * r2 * Bv[j].y + Cv[j].y); w.y = cvt_pk_bf16(h[j].z * r2 * Bv[j].z + Cv[j].z, h[j].w * r2 * Bv[j].w + Cv[j].w);
            *(u32x2*)(U + (size_t)row * D + lane * 4 + 256 * j) = w; }
    }
}

struct EpiGU {
    static constexpr bool PERM = true, AFTER_DRAIN = false;
    bf16_t* O;
    __device__ __forceinline__ void operator()(const f32x4 (&acc)[2][2][4][2], const pg8::Unit& u, int wr, int wc, int fr, int fq) const {
        const int row0 = u.pm * 256 + wr * 64 + fr, col0 = u.pn * 128 + wc * 32 + 8 * fq;
#pragma unroll
        for (int ai = 0; ai < 2; ++ai)
#pragma unroll
            for (int m = 0; m < 4; ++m) { float o[8];
#pragma unroll
                for (int n = 0; n < 2; ++n)
#pragma unroll
                    for (int j = 0; j < 4; ++j) { const float g = acc[ai][0][m][n][j], up = acc[ai][1][m][n][j]; o[n * 4 + j] = g * __builtin_amdgcn_rcpf(1.0f + __expf(-g)) * up; }
                u32x4 w; w.x = cvt_pk_bf16(o[0], o[1]); w.y = cvt_pk_bf16(o[2], o[3]); w.z = cvt_pk_bf16(o[4], o[5]); w.w = cvt_pk_bf16(o[6], o[7]);
                *(u32x4*)(O + (size_t)(row0 + ai * 128 + m * 16) * DFF + col0) = w; }
    }
};

struct TailOrder {
    int nsplit, kp, G, c;
    __device__ void init(int K, int KP, int G_, int c_) { kp = KP; nsplit = (K / 64) / KP; G = G_; c = c_; }
    __device__ bool next(int i, pg8::Unit& u) const {
        const long L = (long)i * G + c;
        if (L < 256) { int wgid = (int)L; { const int q = 256 / 8, xcd = wgid % 8, off = wgid / 8; wgid = xcd * q + off; }
            const int nig = 8 * 4, gid = wgid / nig, fm = gid * 8; u.pm = fm + ((wgid % nig) % 8); u.pn = (wgid % nig) / 8; u.kt0 = 0; u.nkt = 0; return true; }
        const int L2 = (int)(L - 256); if (L2 >= 8 * nsplit) return false;
        const int tile = L2 / nsplit, ks = L2 % nsplit; u.pm = 64 + (tile >> 2); u.pn = tile & 3; u.kt0 = ks * kp; u.nkt = kp; return true;
    }
    __device__ __forceinline__ void a_ready(const pg8::Unit&) const {}
    __device__ __forceinline__ void done(const pg8::Unit&) const {}
};
struct EpiF32 {
    static constexpr bool PERM = true, AFTER_DRAIN = false;
    bf16_t* C; float* YC;
    __device__ __forceinline__ void operator()(const f32x4 (&acc)[2][2][4][2], const pg8::Unit& u, int wr, int wc, int fr, int fq) const {
        const int row0 = u.pm * 256 + wr * 64 + fr, col0 = u.pn * 256 + wc * 32 + 8 * fq;
        if (u.pm < 64) {
#pragma unroll
            for (int ai = 0; ai < 2; ++ai)
#pragma unroll
                for (int m = 0; m < 4; ++m) { bf16_t* rowp = C + (size_t)(row0 + ai * 128 + m * 16) * D + col0;
#pragma unroll
                    for (int bj = 0; bj < 2; ++bj) { const f32x4 v0 = acc[ai][bj][m][0], v1 = acc[ai][bj][m][1];
                        u32x4 w; w.x = cvt_pk_bf16(v0[0], v0[1]); w.y = cvt_pk_bf16(v0[2], v0[3]); w.z = cvt_pk_bf16(v1[0], v1[1]); w.w = cvt_pk_bf16(v1[2], v1[3]);
                        *(u32x4*)(rowp + bj * 128) = w; } }
        } else { float* base = YC + (size_t)(u.kt0 >> 2) * TC * D;
#pragma unroll
            for (int ai = 0; ai < 2; ++ai)
#pragma unroll
                for (int m = 0; m < 4; ++m) { float* rowp = base + (size_t)(row0 - TL + ai * 128 + m * 16) * D + col0;
#pragma unroll
                    for (int bj = 0; bj < 2; ++bj)
#pragma unroll
                        for (int n = 0; n < 2; ++n) *(f32x4*)(rowp + bj * 128 + n * 4) = acc[ai][bj][m][n]; }
        }
    }
};
template <class Epi> __device__ __forceinline__ void run_gemm_tail(LAS unsigned char* lds, const bf16_t* A, const bf16_t* Bt, int K, const Epi& E) {
    asm volatile("" : "+s"(K));
    pg8::Gemm g{A, Bt, T, D, K}; TailOrder S; S.init(K, 4, (int)gridDim.x, (int)blockIdx.x);
    pg8::gemm_phase<Epi, TailOrder>(lds, g, S, E);
    __syncthreads();
}
__device__ __forceinline__ void zero_yc(const Params& P) { float4* z = (float4*)(P.ws + WS_YC); for (int i = blockIdx.x * NTHR + otid(); i < TC * D / 4; i += gridDim.x * NTHR) z[i] = make_float4(0.f, 0.f, 0.f, 0.f); }
struct EpiWin {
    static constexpr bool PERM = true, AFTER_DRAIN = false;
    bf16_t* PHYT; bf16_t* PRW; bf16_t* PNA;
    __device__ __forceinline__ void operator()(const f32x4 (&acc)[2][2][4][2], const pg8::Unit& u, int wr, int wc, int fr, int fq) const {
        const int row0 = u.pm * 256 + wr * 64 + fr;
        if (u.pn < 3) {
#pragma unroll
            for (int bj = 0; bj < 2; ++bj) { bf16_t* cp = PHYT + (size_t)(u.pn * 256 + bj * 128 + wc * 32 + 8 * fq) * T + row0;
#pragma unroll
                for (int ai = 0; ai < 2; ++ai)
#pragma unroll
                    for (int m = 0; m < 4; ++m) { const f32x4 v0 = acc[ai][bj][m][0], v1 = acc[ai][bj][m][1]; bf16_t* rp = cp + ai * 128 + m * 16;
                        const unsigned w0 = cvt_pk_bf16(v0[0], v0[1]), w1 = cvt_pk_bf16(v0[2], v0[3]), w2 = cvt_pk_bf16(v1[0], v1[1]), w3 = cvt_pk_bf16(v1[2], v1[3]);
                        rp[0] = (bf16_t)w0; rp[(size_t)T] = (bf16_t)(w0 >> 16); rp[(size_t)2 * T] = (bf16_t)w1; rp[(size_t)3 * T] = (bf16_t)(w1 >> 16);
                        rp[(size_t)4 * T] = (bf16_t)w2; rp[(size_t)5 * T] = (bf16_t)(w2 >> 16); rp[(size_t)6 * T] = (bf16_t)w3; rp[(size_t)7 * T] = (bf16_t)(w3 >> 16); } }
            return; }
        bf16_t* base; int ld, cbase;
        if (u.pn < 9) { base = PRW; ld = RW_IN; cbase = u.pn * 256 - HY_IN; }
        else { base = PNA; ld = NA_IN; cbase = u.pn * 256 - HY_IN - RW_IN; }
        const int nbj = (u.pn == 13) ? 1 : 2;
#pragma unroll
        for (int ai = 0; ai < 2; ++ai)
#pragma unroll
            for (int m = 0; m < 4; ++m)
#pragma unroll
                for (int bj = 0; bj < 2; ++bj) { if (bj < nbj) { const f32x4 v0 = acc[ai][bj][m][0], v1 = acc[ai][bj][m][1];
                    u32x4 w; w.x = cvt_pk_bf16(v0[0], v0[1]); w.y = cvt_pk_bf16(v0[2], v0[3]); w.z = cvt_pk_bf16(v1[0], v1[1]); w.w = cvt_pk_bf16(v1[2], v1[3]);
                    *(u32x4*)(base + (size_t)(row0 + ai * 128 + m * 16) * ld + cbase + bj * 128 + wc * 32 + 8 * fq) = w; } }
    }
};
struct EpiLora {
    static constexpr bool PERM = true, AFTER_DRAIN = false;
    bf16_t* LO; bf16_t* GATE;
    __device__ __forceinline__ void operator()(const f32x4 (&acc)[2][2][4][2], const pg8::Unit& u, int wr, int wc, int fr, int fq) const {
        const int row0 = u.pm * 256 + wr * 64 + fr;
        bf16_t* base; int ld, cbase;
        if (u.pn < 6) { base = LO; ld = 1536; cbase = u.pn * 256; } else { base = GATE; ld = 384; cbase = u.pn * 256 - 1536; }
        const int nbj = (u.pn == 7) ? 1 : 2;
#pragma unroll
        for (int ai = 0; ai < 2; ++ai)
#pragma unroll
            for (int m = 0; m < 4; ++m)
#pragma unroll
                for (int bj = 0; bj < 2; ++bj) { if (bj < nbj) { const f32x4 v0 = acc[ai][bj][m][0], v1 = acc[ai][bj][m][1];
                    u32x4 w; w.x = cvt_pk_bf16(v0[0], v0[1]); w.y = cvt_pk_bf16(v0[2], v0[3]); w.z = cvt_pk_bf16(v1[0], v1[1]); w.w = cvt_pk_bf16(v1[2], v1[3]);
                    *(u32x4*)(base + (size_t)(row0 + ai * 128 + m * 16) * ld + cbase + bj * 128 + wc * 32 + 8 * fq) = w; } }
    }
};
template <class Epi> __device__ __forceinline__ void run_gemm(LAS unsigned char* lds, const bf16_t* A, const bf16_t* Bt, int M, int N, int K, const Epi& E) {
    asm volatile("" : "+s"(K));
    pg8::Gemm g{A, Bt, M, N, K}; pg8::StaticOrder S; S.init(M, N, (int)gridDim.x, (int)blockIdx.x);
    pg8::gemm_phase<Epi, pg8::StaticOrder>(lds, g, S, E);
    __syncthreads();
}

__device__ __forceinline__ void ph_loraprep(const Params& P, int l) {
    const bf16_t* PRW = (const bf16_t*)(P.ws + WS_PRW); bf16_t* AL = (bf16_t*)(P.ws + WS_ALORA);
    const float* mu = P.in[I_MU] + (size_t)l * 2 * RW_IN;
    const int gtid = blockIdx.x * NTHR + otid(), gn = gridDim.x * NTHR;
    for (int it = gtid; it < T * 48; it += gn) {
        const int row = it / 48, j8 = it % 48, col = 1152 + j8 * 8;
        bool hp, hn; row_nbrs(row, hp, hn);
        float p[8], pp[8], pn[8];
        unpack8(*(const u32x4*)(PRW + (size_t)row * RW_IN + col), p);
        if (hp) unpack8(*(const u32x4*)(PRW + (size_t)(row - 1) * RW_IN + col), pp); else {
#pragma unroll
            for (int i = 0; i < 8; ++i) pp[i] = 0.f; }
        if (hn) unpack8(*(const u32x4*)(PRW + (size_t)(row + 1) * RW_IN + col), pn); else {
#pragma unroll
            for (int i = 0; i < 8; ++i) pn[i] = 0.f; }
        float o[8];
#pragma unroll
        for (int i = 0; i < 8; ++i) { const float xs = p[i] + mu[col + i] * (pp[i] - p[i]) + mu[RW_IN + col + i] * (pn[i] - p[i]);
            o[i] = j8 < 16 ? tanhf(xs) : (j8 < 32 ? xs : sigmoidf_(xs)); }
        u32x4 w; w.x = cvt_pk_bf16(o[0], o[1]); w.y = cvt_pk_bf16(o[2], o[3]); w.z = cvt_pk_bf16(o[4], o[5]); w.w = cvt_pk_bf16(o[6], o[7]);
        *(u32x4*)(AL + (size_t)row * 384 + j8 * 8) = w;
    }
}

__device__ __forceinline__ void ph_rwkvprep(const Params& P, int l) {
    const int tid = otid(), lane = tid & 63, gw = blockIdx.x * NWAVE + (tid >> 6), nw = gridDim.x * NWAVE;
    const int nrw = nw / 6, h = gw % 6, rw0 = gw / 6;
    if (rw0 >= nrw) return;
    const int q = lane & 15, qt = lane >> 4, c = h * 64 + 4 * q;
    const bf16_t* PRW = (const bf16_t*)(P.ws + WS_PRW); const bf16_t* LO = (const bf16_t*)(P.ws + WS_LORAO);
    bf16_t* RS = (bf16_t*)(P.ws + WS_RS); bf16_t* KKS = (bf16_t*)(P.ws + WS_KKS); bf16_t* VS = (bf16_t*)(P.ws + WS_VS); bf16_t* KS = (bf16_t*)(P.ws + WS_KS); bf16_t* BS = (bf16_t*)(P.ws + WS_BS);
    float* BON = (float*)(P.ws + WS_BONUS); float* DEC = (float*)(P.ws + WS_DECAY);
    const float* RT = (const float*)(P.ws + WS_ROPE);
    const float* mu = P.in[I_MU] + (size_t)l * 2 * RW_IN;
    float mp[3][4], mn[3][4], ckk[4], cka[4], crk[4], ca0[4], ca1[4], cw0[4], cw1[4];
#pragma unroll
    for (int e = 0; e < 4; ++e) {
#pragma unroll
        for (int t3 = 0; t3 < 3; ++t3) { mp[t3][e] = mu[t3 * 384 + c + e]; mn[t3][e] = mu[RW_IN + t3 * 384 + c + e]; }
        ckk[e] = P.in[I_KK][l * RWW + c + e]; cka[e] = P.in[I_KA][l * RWW + c + e]; crk[e] = P.in[I_RK][l * RWW + c + e];
        ca0[e] = P.in[I_A0][(size_t)l * 2 * RWW + c + e]; ca1[e] = P.in[I_A0][(size_t)l * 2 * RWW + RWW + c + e]; cw0[e] = P.in[I_W0][(size_t)l * 2 * RWW + c + e]; cw1[e] = P.in[I_W0][(size_t)l * 2 * RWW + RWW + c + e]; }
    const float sg = (q & 4) ? 1.f : -1.f;
    const int f0 = (4 * q) & 15;
#define LD4(ptr, dst) do { const u32x2 w_ = *(const u32x2*)(ptr); dst[0] = lo_bf(w_.x); dst[1] = hi_bf(w_.x); dst[2] = lo_bf(w_.y); dst[3] = hi_bf(w_.y); } while (0)
#define ST4(ptr, v0, v1, v2, v3) do { u32x2 w_; w_.x = cvt_pk_bf16(v0, v1); w_.y = cvt_pk_bf16(v2, v3); *(u32x2*)(ptr) = w_; } while (0)
#define SUM16(x) do { x += __shfl_xor(x, 1); x += __shfl_xor(x, 2); x += __shfl_xor(x, 4); x += __shfl_xor(x, 8); } while (0)
#pragma unroll 2
    for (int pi = rw0; pi < T / 4; pi += nrw) { const int row = 4 * pi + qt;
        bool hp, hn; row_nbrs(row, hp, hn);
        const bf16_t* pr = PRW + (size_t)row * RW_IN + c; const int om = hp ? -RW_IN : 0, op = hn ? RW_IN : 0; const float fm = hp ? 1.f : 0.f, fp = hn ? 1.f : 0.f;
        float x[3][4];
#pragma unroll
        for (int t3 = 0; t3 < 3; ++t3) { float cc[4], mm[4], pp[4]; LD4(pr + t3 * 384, cc); LD4(pr + t3 * 384 + om, mm); LD4(pr + t3 * 384 + op, pp);
#pragma unroll
            for (int e = 0; e < 4; ++e) x[t3][e] = cc[e] + mp[t3][e] * (fm * mm[e] - cc[e]) + mn[t3][e] * (fp * pp[e] - cc[e]); }
        const bf16_t* lo = LO + (size_t)row * 1536 + c;
        float la0[4], la1[4], lw0[4], lw1[4]; LD4(lo + 768, la0); LD4(lo + 1152, la1); LD4(lo, lw0); LD4(lo + 384, lw1);
        float a0[4], a1[4], kkr[4]; float n2 = 0.f;
#pragma unroll
        for (int e = 0; e < 4; ++e) { a0[e] = sigmoidf_(la0[e] + ca0[e]); a1[e] = sigmoidf_(la1[e] + ca1[e]); kkr[e] = x[1][e] * ckk[e]; n2 += kkr[e] * kkr[e]; }
        SUM16(n2);
        const float rn = 1.0f / fmaxf(sqrtf(n2), 1e-12f);
        float rs[4], kks[4], kd0[4], kd1[4], b0[4], b1[4]; float bon = 0.f;
#pragma unroll
        for (int e = 0; e < 4; ++e) { const float k = x[1][e]; kks[e] = kkr[e] * rn; rs[e] = x[0][e];
            kd0[e] = k * (1.f + (a0[e] - 1.f) * cka[e]); kd1[e] = k * (1.f + (a1[e] - 1.f) * cka[e]); b0[e] = kks[e] * a0[e]; b1[e] = kks[e] * a1[e];
            bon += rs[e] * (kd0[e] + kd1[e]) * crk[e]; }
        SUM16(bon);
        if (row < TL) {
            const int t = row & (SEQ - 1); const int pos = (q < 8) ? (t >> 6) : (t & 63);
            const float4 csa = *(const float4*)(RT + (size_t)(pos * 16 + f0) * 2), csb = *(const float4*)(RT + (size_t)(pos * 16 + f0) * 2 + 4);
            const float cs[4] = {csa.x, csa.z, csb.x, csb.z}, sn[4] = {csa.y, csa.w, csb.y, csb.w};
#pragma unroll
            for (int e = 0; e < 4; ++e) {
                const float r2 = __shfl_xor(rs[e], 4), k2 = __shfl_xor(kks[e], 4), d0 = __shfl_xor(kd0[e], 4), d1 = __shfl_xor(kd1[e], 4), e0 = __shfl_xor(b0[e], 4), e1 = __shfl_xor(b1[e], 4);
                rs[e] = rs[e] * cs[e] + sg * r2 * sn[e]; kks[e] = kks[e] * cs[e] + sg * k2 * sn[e]; kd0[e] = kd0[e] * cs[e] + sg * d0 * sn[e]; kd1[e] = kd1[e] * cs[e] + sg * d1 * sn[e];
                b0[e] = b0[e] * cs[e] + sg * e0 * sn[e]; b1[e] = b1[e] * cs[e] + sg * e1 * sn[e]; }
        }
        const size_t o = (size_t)row * 384 + c;
        { float d0v[4], d1v[4];
#pragma unroll
          for (int e = 0; e < 4; ++e) { d0v[e] = __expf(-0.6065306597f * sigmoidf_(lw0[e] + cw0[e])); d1v[e] = __expf(-0.6065306597f * sigmoidf_(lw1[e] + cw1[e])); }
          *(float4*)(DEC + o) = make_float4(d0v[0], d0v[1], d0v[2], d0v[3]); *(float4*)(DEC + (size_t)T * 384 + o) = make_float4(d1v[0], d1v[1], d1v[2], d1v[3]); }
        if (q == 0) BON[(size_t)row * 6 + h] = bon;
        ST4(RS + o, rs[0], rs[1], rs[2], rs[3]); ST4(KKS + o, -kks[0], -kks[1], -kks[2], -kks[3]); ST4(VS + o, x[2][0], x[2][1], x[2][2], x[2][3]);
        ST4(KS + o, kd0[0], kd0[1], kd0[2], kd0[3]); ST4(KS + (size_t)T * 384 + o, kd1[0], kd1[1], kd1[2], kd1[3]);
        ST4(BS + o, b0[0], b0[1], b0[2], b0[3]); ST4(BS + (size_t)T * 384 + o, b1[0], b1[1], b1[2], b1[3]);
    }
#undef LD4
#undef ST4
#undef SUM16
}

__device__ __forceinline__ int scan_row(int b, int d, int step) {
    if (step < CTX) { const int tc = d ? (CTX - 1 - step) : step; return TL + b * CTX + tc; }
    const int tl = d ? (SEQ - 1 - (step - CTX)) : (step - CTX); return b * SEQ + tl;
}
__device__ __forceinline__ void scan_task_v1(const Params& P, int task, float* sv) {
    const int lane = otid() & 63;
    const int d = task & 1, h = (task >> 1) % 6, b = task / 12;
    const float* DEC = (const float*)(P.ws + WS_DECAY) + (size_t)d * T * 384; const bf16_t* KKS = (const bf16_t*)(P.ws + WS_KKS); const bf16_t* RS = (const bf16_t*)(P.ws + WS_RS);
    const bf16_t* VS = (const bf16_t*)(P.ws + WS_VS); const bf16_t* KS = (const bf16_t*)(P.ws + WS_KS) + (size_t)d * T * 384; const bf16_t* BS = (const bf16_t*)(P.ws + WS_BS) + (size_t)d * T * 384;
    float* YD = (float*)(P.ws + WS_YDIR) + (size_t)d * T * 384;
    float S[64];
#pragma unroll
    for (int j = 0; j < 64; ++j) S[j] = 0.f;
    size_t o = (size_t)scan_row(b, d, 0) * 384 + h * 64 + lane;
    float nw_ = DEC[o], na = bf2f(KKS[o]), nb = bf2f(BS[o]), nk = bf2f(KS[o]), nr = bf2f(RS[o]), nv = bf2f(VS[o]);
    for (int step = 0; step < CTX + SEQ; ++step) {
        const float v = nv; const size_t oc = o;
        asm volatile("s_waitcnt lgkmcnt(0)" ::: "memory");
        sv[lane] = nw_; sv[64 + lane] = na; sv[128 + lane] = nb; sv[192 + lane] = nk; sv[256 + lane] = nr;
        asm volatile("s_waitcnt lgkmcnt(0)" ::: "memory");
        if (step + 1 < CTX + SEQ) { o = (size_t)scan_row(b, d, step + 1) * 384 + h * 64 + lane;
            nw_ = DEC[o]; na = bf2f(KKS[o]); nb = bf2f(BS[o]); nk = bf2f(KS[o]); nr = bf2f(RS[o]); nv = bf2f(VS[o]); }
        float sa0 = 0.f, sa1 = 0.f, sa2 = 0.f, sa3 = 0.f;
#pragma unroll
        for (int j = 0; j < 64; j += 4) { const float4 a4 = *(const float4*)(sv + 64 + j);
            sa0 += S[j + 0] * a4.x; sa1 += S[j + 1] * a4.y; sa2 += S[j + 2] * a4.z; sa3 += S[j + 3] * a4.w; }
        const float sa = (sa0 + sa1) + (sa2 + sa3);
        float y0 = 0.f, y1 = 0.f, y2 = 0.f, y3 = 0.f;
#pragma unroll
        for (int j = 0; j < 64; j += 4) {
            const float4 w4 = *(const float4*)(sv + j), b4 = *(const float4*)(sv + 128 + j), k4 = *(const float4*)(sv + 192 + j), r4 = *(const float4*)(sv + 256 + j);
            S[j + 0] = S[j + 0] * w4.x + sa * b4.x + v * k4.x; y0 += S[j + 0] * r4.x;
            S[j + 1] = S[j + 1] * w4.y + sa * b4.y + v * k4.y; y1 += S[j + 1] * r4.y;
            S[j + 2] = S[j + 2] * w4.z + sa * b4.z + v * k4.z; y2 += S[j + 2] * r4.z;
            S[j + 3] = S[j + 3] * w4.w + sa * b4.w + v * k4.w; y3 += S[j + 3] * r4.w; }
        YD[oc] = (y0 + y1) + (y2 + y3);
    }
}

__device__ __forceinline__ void natt_key(const bf16_t* PNA, size_t krow, int hoff, const float (&q)[16], float bias, float& m, float& lsum, float (&o)[16]) {
    const bf16_t* kp = PNA + krow * NA_IN + 384 + hoff; const bf16_t* vp = PNA + krow * NA_IN + 768 + hoff;
    float s = 0.f;
#pragma unroll
    for (int j8 = 0; j8 < 2; ++j8) { float kf[8]; unpack8(*(const u32x4*)(kp + j8 * 8), kf);
#pragma unroll
        for (int i = 0; i < 8; ++i) s += q[j8 * 8 + i] * kf[i]; }
    s += __shfl_xor(s, 1); s += __shfl_xor(s, 2); s += bias;
    const float mn = fmaxf(m, s), corr = __expf(m - mn), p = __expf(s - mn);
    m = mn; lsum = lsum * corr + p;
#pragma unroll
    for (int j8 = 0; j8 < 2; ++j8) { float vf[8]; unpack8(*(const u32x4*)(vp + j8 * 8), vf);
#pragma unroll
        for (int i = 0; i < 8; ++i) o[j8 * 8 + i] = o[j8 * 8 + i] * corr + p * vf[i]; }
}
__device__ __forceinline__ void natten_items_v1(const Params& P, int l, int wid0, int nworkers) {
    const bf16_t* PNA = (const bf16_t*)(P.ws + WS_PNA); bf16_t* MIX = (bf16_t*)(P.ws + WS_U);
    const float* rpb = P.in[I_RPB] + (size_t)l * 6 * 15 * 31;
    const int sub = wid0 & 3;
    for (int it = wid0 >> 2; it < T * 6; it += nworkers >> 2) {
        const int row = it % T, h = it / T, hoff = h * 64 + sub * 16;
        float q[16], o[16];
#pragma unroll
        for (int j8 = 0; j8 < 2; ++j8) { float qf[8]; unpack8(*(const u32x4*)(PNA + (size_t)row * NA_IN + hoff + j8 * 8), qf);
#pragma unroll
            for (int i = 0; i < 8; ++i) { q[j8 * 8 + i] = qf[i] * 0.125f; o[j8 * 8 + i] = 0.f; } }
        float m = -3.0e38f, lsum = 0.f;
        int b;
        if (row < TL) { b = row >> 13; const int t = row & (SEQ - 1), i = t >> 6, col = t & 63;
            const int start = min(max(i - 4, 0), 120), win0 = min(max(col - 8, 0), 48);
            for (int r = 0; r < 8; ++r) for (int kc = win0; kc < win0 + 16; ++kc) {
                const float bias = rpb[(h * 15 + (start + r - i + 7)) * 31 + (kc - col + 15)];
                natt_key(PNA, (size_t)b * SEQ + (start + r) * 64 + kc, hoff, q, bias, m, lsum, o); }
        } else b = (row - TL) >> 8;
        for (int c = 0; c < CTX; ++c) natt_key(PNA, (size_t)TL + b * CTX + c, hoff, q, 0.f, m, lsum, o);
        const float il = 1.0f / lsum;
#pragma unroll
        for (int j8 = 0; j8 < 2; ++j8) { u32x4 w; w.x = cvt_pk_bf16(o[j8 * 8 + 0] * il, o[j8 * 8 + 1] * il); w.y = cvt_pk_bf16(o[j8 * 8 + 2] * il, o[j8 * 8 + 3] * il);
            w.z = cvt_pk_bf16(o[j8 * 8 + 4] * il, o[j8 * 8 + 5] * il); w.w = cvt_pk_bf16(o[j8 * 8 + 6] * il, o[j8 * 8 + 7] * il);
            *(u32x4*)(MIX + (size_t)row * D + 640 + hoff + j8 * 8) = w; }
    }
}

__device__ __forceinline__ void vt_tile(const Params& P, int tile, unsigned short* tl  ) {
    const int tid = otid();
    const bf16_t* PNA = (const bf16_t*)(P.ws + WS_PNA);
    int h, tok0; bf16_t* dst; int ldt;
    if (tile < NB * 128 * 6) { h = tile % 6; const int sb = tile / 6; const int b = sb >> 7, blk = sb & 127; tok0 = b * SEQ + blk * 64; dst = (bf16_t*)(P.ws + WS_VTL) + ((size_t)(b * 6 + h) * 64) * SEQ + blk * 64; ldt = SEQ; }
    else { const int tt = tile - NB * 128 * 6; h = tt % 6; const int sb = tt / 6; const int b = sb >> 2, blk = sb & 3; tok0 = TL + b * CTX + blk * 64; dst = (bf16_t*)(P.ws + WS_VTC) + ((size_t)(b * 6 + h) * 64) * CTX + blk * 64; ldt = CTX; }
    { const int tok = tid >> 3, seg = tid & 7; const u32x4 v = *(const u32x4*)(PNA + (size_t)(tok0 + tok) * NA_IN + 768 + h * 64 + seg * 8);
      unsigned* w = (unsigned*)(tl + tok * 72 + seg * 8); w[0] = v.x; w[1] = v.y; w[2] = v.z; w[3] = v.w; }
    __syncthreads();
    { const int hd = tid >> 3, ts = tid & 7; unsigned short e[8];
#pragma unroll
      for (int k = 0; k < 8; ++k) e[k] = tl[(ts * 8 + k) * 72 + hd];
      u32x4 w; w.x = (unsigned)e[0] | ((unsigned)e[1] << 16); w.y = (unsigned)e[2] | ((unsigned)e[3] << 16); w.z = (unsigned)e[4] | ((unsigned)e[5] << 16); w.w = (unsigned)e[6] | ((unsigned)e[7] << 16);
      *(u32x4*)(dst + (size_t)hd * ldt + ts * 8) = w; }
    __syncthreads();
}
constexpr int NAT_LAT_TASKS = NB * 128 * 4 * 6, NAT_CTX_TASKS = NB * 16 * 6, NAT_TASKS = NAT_LAT_TASKS + NAT_CTX_TASKS;
__device__ __forceinline__ void natten_task(const Params& P, int l, int task) {
    using pg8::bf16x8;
    const int lane = otid() & 63, fr = lane & 15, fq = lane >> 4;
    const bf16_t* PNA = (const bf16_t*)(P.ws + WS_PNA); bf16_t* MIX = (bf16_t*)(P.ws + WS_U);
    const bool lat = task < NAT_LAT_TASKS;
    int b, h, i = 0, n = 0, qtok0;
    if (lat) { h = task % 6; const int r = task / 6; n = r & 3; i = (r >> 2) & 127; b = r >> 9; qtok0 = b * SEQ + i * 64 + 16 * n; }
    else { const int tt = task - NAT_LAT_TASKS; h = tt % 6; const int qb = (tt / 6) & 15; b = tt / 96; qtok0 = TL + b * CTX + 16 * qb; }
    const int start = min(max(i - 4, 0), 120), band0 = min(max(16 * n - 8, 0), 32);
    const int col = 16 * n + fr, win0 = min(max(col - 8, 0), 48);
    bf16x8 bq[2];
#pragma unroll
    for (int kh = 0; kh < 2; ++kh) bq[kh] = *(const bf16x8*)(PNA + (size_t)(qtok0 + fr) * NA_IN + h * 64 + kh * 32 + fq * 8);
    f32x4 sc[32];
    if (lat) {
#pragma unroll
        for (int t = 0; t < 16; ++t) { const int tok0 = b * SEQ + (start + (t >> 1)) * 64 + band0 + 16 * (t & 1);
            const bf16_t* kp = PNA + (size_t)(tok0 + fr) * NA_IN + 384 + h * 64 + fq * 8;
            const bf16x8 k0 = *(const bf16x8*)kp, k1 = *(const bf16x8*)(kp + 32);
            f32x4 a = (f32x4){0.f, 0.f, 0.f, 0.f};
            a = __builtin_amdgcn_mfma_f32_16x16x32_bf16(k0, bq[0], a, 0, 0, 0); a = __builtin_amdgcn_mfma_f32_16x16x32_bf16(k1, bq[1], a, 0, 0, 0);
            sc[t] = a; if ((t & 3) == 3) asm volatile("" ::: "memory"); }
    } else {
#pragma unroll
        for (int t = 0; t < 16; ++t) sc[t] = (f32x4){-3.0e38f, -3.0e38f, -3.0e38f, -3.0e38f};
    }
#pragma unroll
    for (int t = 16; t < 32; ++t) { const int tok0 = TL + b * CTX + 16 * (t - 16);
        const bf16_t* kp = PNA + (size_t)(tok0 + fr) * NA_IN + 384 + h * 64 + fq * 8;
        const bf16x8 k0 = *(const bf16x8*)kp, k1 = *(const bf16x8*)(kp + 32);
        f32x4 a = (f32x4){0.f, 0.f, 0.f, 0.f};
        a = __builtin_amdgcn_mfma_f32_16x16x32_bf16(k0, bq[0], a, 0, 0, 0); a = __builtin_amdgcn_mfma_f32_16x16x32_bf16(k1, bq[1], a, 0, 0, 0);
        sc[t] = a * 0.125f; if ((t & 3) == 3) asm volatile("" ::: "memory"); }
    if (lat) { const float* rpb = P.in[I_RPB] + ((size_t)l * 6 + h) * 15 * 31;
#pragma unroll
        for (int t = 0; t < 16; ++t) { const int ro = start + (t >> 1) - i + 7; const int kc0 = band0 + 16 * (t & 1) + fq * 4;
#pragma unroll
            for (int j = 0; j < 4; ++j) { const int kc = kc0 + j; const bool ok = kc >= win0 && kc < win0 + 16; const int co = min(max(kc - col + 15, 0), 30);
                const float bias = rpb[ro * 31 + co]; sc[t][j] = ok ? sc[t][j] * 0.125f + bias : -3.0e38f; } } }
    float mx = -3.0e38f;
#pragma unroll
    for (int t = 0; t < 32; ++t) mx = fmaxf(mx, fmaxf(fmaxf(sc[t][0], sc[t][1]), fmaxf(sc[t][2], sc[t][3])));
    mx = fmaxf(mx, __shfl_xor(mx, 16)); mx = fmaxf(mx, __shfl_xor(mx, 32));
    float sum = 0.f;
#pragma unroll
    for (int t = 0; t < 32; ++t) {
#pragma unroll
        for (int j = 0; j < 4; ++j) { const float p = __expf(sc[t][j] - mx); sc[t][j] = p; sum += p; } }
    sum += __shfl_xor(sum, 16); sum += __shfl_xor(sum, 32);
    const float inv = 1.0f / sum;
    f32x4 ot[4];
#pragma unroll
    for (int q = 0; q < 4; ++q) ot[q] = (f32x4){0.f, 0.f, 0.f, 0.f};
    const bf16_t* VTL = (const bf16_t*)(P.ws + WS_VTL) + ((size_t)(b * 6 + h) * 64) * SEQ; const bf16_t* VTC = (const bf16_t*)(P.ws + WS_VTC) + ((size_t)(b * 6 + h) * 64) * CTX;
    if (lat) {
#pragma unroll
        for (int m = 0; m < 8; ++m) { const int tk = (start + m) * 64 + band0 + fq * 4;
            u32x4 pw; pw.x = cvt_pk_bf16(sc[2 * m][0], sc[2 * m][1]); pw.y = cvt_pk_bf16(sc[2 * m][2], sc[2 * m][3]); pw.z = cvt_pk_bf16(sc[2 * m + 1][0], sc[2 * m + 1][1]); pw.w = cvt_pk_bf16(sc[2 * m + 1][2], sc[2 * m + 1][3]);
            const bf16x8 pb = __builtin_bit_cast(bf16x8, pw);
#pragma unroll
            for (int q = 0; q < 4; ++q) { const bf16_t* vp = VTL + (size_t)(q * 16 + fr) * SEQ + tk; const u32x2 v0 = *(const u32x2*)vp, v1 = *(const u32x2*)(vp + 16);
                u32x4 vw; vw.x = v0.x; vw.y = v0.y; vw.z = v1.x; vw.w = v1.y;
                ot[q] = __builtin_amdgcn_mfma_f32_16x16x32_bf16(__builtin_bit_cast(bf16x8, vw), pb, ot[q], 0, 0, 0); }
            if (m & 1) asm volatile("" ::: "memory"); }
    }
#pragma unroll
    for (int m = 0; m < 8; ++m) { const int tk = 32 * m + fq * 4;
        u32x4 pw; pw.x = cvt_pk_bf16(sc[16 + 2 * m][0], sc[16 + 2 * m][1]); pw.y = cvt_pk_bf16(sc[16 + 2 * m][2], sc[16 + 2 * m][3]); pw.z = cvt_pk_bf16(sc[17 + 2 * m][0], sc[17 + 2 * m][1]); pw.w = cvt_pk_bf16(sc[17 + 2 * m][2], sc[17 + 2 * m][3]);
        const bf16x8 pb = __builtin_bit_cast(bf16x8, pw);
#pragma unroll
        for (int q = 0; q < 4; ++q) { const bf16_t* vp = VTC + (size_t)(q * 16 + fr) * CTX + tk; const u32x2 v0 = *(const u32x2*)vp, v1 = *(const u32x2*)(vp + 16);
            u32x4 vw; vw.x = v0.x; vw.y = v0.y; vw.z = v1.x; vw.w = v1.y;
            ot[q] = __builtin_amdgcn_mfma_f32_16x16x32_bf16(__builtin_bit_cast(bf16x8, vw), pb, ot[q], 0, 0, 0); }
        if (m & 1) asm volatile("" ::: "memory"); }
#pragma unroll
    for (int q = 0; q < 4; ++q) { u32x2 w; w.x = cvt_pk_bf16(ot[q][0] * inv, ot[q][1] * inv); w.y = cvt_pk_bf16(ot[q][2] * inv, ot[q][3] * inv);
        *(u32x2*)(MIX + (size_t)(qtok0 + fr) * D + 640 + h * 64 + q * 16 + fq * 4) = w; }
}

__device__ __forceinline__ void fft_fwd(float2* X) {
#pragma unroll 1
    for (int lq = 12; lq >= 0; lq -= 2) { const int q = 1 << lq; const float rq = 1.0f / (float)(4 * q);
        for (int j = otid(); j < NFFT / 4; j += NTHR) { const int lo = j & (q - 1), base = ((j >> lq) << (lq + 2)) | lo;
            const float2 x0 = X[base], x1 = X[base + q], x2 = X[base + 2 * q], x3 = X[base + 3 * q];
            const float fr = (float)lo * rq; const float c = __builtin_amdgcn_cosf(fr), s = __builtin_amdgcn_sinf(fr), c2 = c * c - s * s, s2 = 2.f * c * s;
            const float a0x = x0.x + x2.x, a0y = x0.y + x2.y, dx = x0.x - x2.x, dy = x0.y - x2.y;
            const float a2x = dx * c + dy * s, a2y = dy * c - dx * s;
            const float a1x = x1.x + x3.x, a1y = x1.y + x3.y, ex = x1.x - x3.x, ey = x1.y - x3.y;
            const float mx = ex * c + ey * s, my = ey * c - ex * s;
            const float a3x = my, a3y = -mx;
            const float fx = a0x - a1x, fy = a0y - a1y, gx = a2x - a3x, gy = a2y - a3y;
            X[base] = make_float2(a0x + a1x, a0y + a1y); X[base + q] = make_float2(fx * c2 + fy * s2, fy * c2 - fx * s2);
            X[base + 2 * q] = make_float2(a2x + a3x, a2y + a3y); X[base + 3 * q] = make_float2(gx * c2 + gy * s2, gy * c2 - gx * s2); }
        __syncthreads(); }
}
__device__ __forceinline__ void fft_inv(float2* X) {
#pragma unroll 1
    for (int lq = 0; lq <= 12; lq += 2) { const int q = 1 << lq; const float rq = 1.0f / (float)(4 * q);
        for (int j = otid(); j < NFFT / 4; j += NTHR) { const int lo = j & (q - 1), base = ((j >> lq) << (lq + 2)) | lo;
            const float2 y0 = X[base], y1 = X[base + q], y2 = X[base + 2 * q], y3 = X[base + 3 * q];
            const float fr = (float)lo * rq; const float c = __builtin_amdgcn_cosf(fr), s = __builtin_amdgcn_sinf(fr), c2 = c * c - s * s, s2 = 2.f * c * s;
            const float tx = y1.x * c2 - y1.y * s2, ty = y1.x * s2 + y1.y * c2;
            const float a0x = y0.x + tx, a0y = y0.y + ty, a1x = y0.x - tx, a1y = y0.y - ty;
            const float ux = y3.x * c2 - y3.y * s2, uy = y3.x * s2 + y3.y * c2;
            const float a2x = y2.x + ux, a2y = y2.y + uy, a3x = y2.x - ux, a3y = y2.y - uy;
            const float vx = a2x * c - a2y * s, vy = a2x * s + a2y * c;
            const float mx = a3x * c - a3y * s, my = a3x * s + a3y * c;
            const float wx = -my, wy = mx;
            X[base] = make_float2(a0x + vx, a0y + vy); X[base + 2 * q] = make_float2(a0x - vx, a0y - vy);
            X[base + q] = make_float2(a1x + wx, a1y + wy); X[base + 3 * q] = make_float2(a1x - wx, a1y - wy); }
        __syncthreads(); }
}
__device__ __forceinline__ float hy_delta(int c) { const float lo = -4.605170185988091f / 1.5f, hi = -4.605170185988091f / 0.3f; return fabsf(lo + (float)c * ((hi - lo) / 255.0f)); }
__device__ __forceinline__ float hy_short(const bf16_t* PHYT, const float* cw, const float* cb, int row, int col) {
    bool hp, hn; row_nbrs(row, hp, hn);
    const bf16_t* p = PHYT + (size_t)col * T + row;
    float v = cb[col] + cw[HY_IN + col] * bf2f(p[0]);
    if (hp) v += cw[col] * bf2f(p[-1]);
    if (hn) v += cw[2 * HY_IN + col] * bf2f(p[1]);
    return v;
}
struct HyTap { float w0, w1, w2, b; };
__device__ __forceinline__ HyTap hy_tap(const float* cw, const float* cb, int col) { HyTap t; t.w0 = cw[col]; t.w1 = cw[HY_IN + col]; t.w2 = cw[2 * HY_IN + col]; t.b = cb[col]; return t; }
__device__ __forceinline__ float hy_lat(const bf16_t* colp, int b, int n, const HyTap t) {
    const bf16_t* p = colp + b * SEQ + n;
    const float xm = bf2f(p[n > 0 ? -1 : 0]), x0 = bf2f(p[0]), xp = bf2f(p[n < SEQ - 1 ? 1 : 0]);
    return t.b + t.w1 * x0 + (n > 0 ? t.w0 * xm : 0.f) + (n < SEQ - 1 ? t.w2 * xp : 0.f);
}
__device__ __forceinline__ void hy_spec_task(const Params& P, int l, int c, float2* X) {
    const int tid = otid();
    const bf16_t* f0 = (const bf16_t*)(P.ws + WS_FILT) + (size_t)c * SEQ; const bf16_t* b0 = f0 + (size_t)256 * SEQ; const bf16_t* f1 = f0 + (size_t)512 * SEQ; const bf16_t* b1 = f0 + (size_t)768 * SEQ;
    for (int n = tid; n < SEQ; n += NTHR) {
        X[n] = make_float2(bf2f(f0[n]), bf2f(f1[n]));
        if (n > 0) X[NFFT - n] = make_float2(bf2f(b0[n]), bf2f(b1[n])); else X[SEQ] = make_float2(0.f, 0.f); }
    __syncthreads();
    fft_fwd(X);
    float2* spec = (float2*)(P.ws + WS_SPEC) + (size_t)c * NFFT;
    for (int i = tid; i < NFFT; i += NTHR) spec[i] = X[i];
    __syncthreads();
}
__device__ __forceinline__ void hy_conv_core(const Params& P, int o, int c, float2* X) {
    fft_fwd(X);
    const float2* spec = (const float2*)(P.ws + WS_SPEC) + (size_t)c * NFFT;
    for (int i = otid(); i < NFFT; i += NTHR) {
        const unsigned f = __brev((unsigned)i) >> 18;
        const unsigned ip = __brev(((unsigned)NFFT - f) & (unsigned)(NFFT - 1)) >> 18;
        const float2 a = X[i], w = spec[i], w2 = spec[ip];
        const float kx = o == 0 ? 0.5f * (w.x + w2.x) : 0.5f * (w.y + w2.y), ky = o == 0 ? 0.5f * (w.y - w2.y) : -0.5f * (w.x - w2.x);
        X[i] = make_float2(a.x * kx - a.y * ky, a.x * ky + a.y * kx); }
    __syncthreads();
    fft_inv(X);
}
__device__ __forceinline__ void hy_task1(const Params& P, int l, int c, float2* X, float* ex) {
    const int tid = otid();
    const bf16_t* PHY = (const bf16_t*)(P.ws + WS_PHY); const float* cw = P.in[I_HCW] + (size_t)l * 3 * HY_IN; const float* cb = P.in[I_HCB] + (size_t)l * HY_IN;
    const float bias0 = P.in[I_HBIAS][(size_t)l * 2 * HYC + c], bias1 = P.in[I_HBIAS][(size_t)l * 2 * HYC + HYC + c];
    const HyTap tv = hy_tap(cw, cb, c), tg1 = hy_tap(cw, cb, HYC + c); const bf16_t* colv = PHY + (size_t)c * T; const bf16_t* colg1 = PHY + (size_t)(HYC + c) * T;
#pragma unroll 4
    for (int n = tid; n < SEQ; n += NTHR) { X[n] = make_float2(hy_lat(colv, 0, n, tv), hy_lat(colv, 1, n, tv)); X[SEQ + n] = make_float2(0.f, 0.f); }
    __syncthreads();
    hy_conv_core(P, 0, c, X);
    float* Z1 = (float*)(P.ws + WS_Z1) + (size_t)c * NB * SEQ;
#pragma unroll 4
    for (int n = tid; n < SEQ; n += NTHR) { const float2 y = X[n];
        const float v0 = hy_lat(colv, 0, n, tv), v1 = hy_lat(colv, 1, n, tv), g0 = hy_lat(colg1, 0, n, tg1), g1 = hy_lat(colg1, 1, n, tg1);
        Z1[n] = g0 * (y.x + bias0 * v0); Z1[SEQ + n] = g1 * (y.y + bias0 * v1); }
    __syncthreads();
    float* f = (float*)X;
    float* vv = f, *x1 = f + 512, *x2 = f + 1024, *hf = f + 1536  , *z1 = f + 2560;
    const bf16_t* fc = (const bf16_t*)(P.ws + WS_FILTC);
    { const int b = tid >> 8, t = tid & 255, row = TL + b * CTX + t;
      vv[tid] = hy_short(PHY, cw, cb, row, c); x1[tid] = hy_short(PHY, cw, cb, row, HYC + c); x2[tid] = hy_short(PHY, cw, cb, row, 2 * HYC + c);
      for (int q = tid; q < 1024; q += NTHR) { const int od = q >> 8, n = q & 255; hf[q] = bf2f(fc[(size_t)(od * 256 + c) * CTX + n]); } }
    __syncthreads();
    { const int b = tid >> 8, t = tid & 255; float y = bias0 * vv[tid];
      for (int s = 0; s <= t; ++s) y += hf[t - s] * vv[b * 256 + s];
      for (int s = t + 1; s < CTX; ++s) y += hf[256 + s - t] * vv[b * 256 + s];
      z1[tid] = x1[tid] * y; }
    __syncthreads();
    { const int b = tid >> 8, t = tid & 255; float y = bias1 * z1[tid];
      for (int s = 0; s <= t; ++s) y += hf[512 + t - s] * z1[b * 256 + s];
      for (int s = t + 1; s < CTX; ++s) y += hf[768 + s - t] * z1[b * 256 + s];
      bf16_t* MIX = (bf16_t*)(P.ws + WS_U); MIX[(size_t)(TL + b * CTX + t) * D + c] = f2bf(x2[tid] * y); }
    __syncthreads();
}
__device__ __forceinline__ void hy_task2(const Params& P, int l, int c, float2* X) {
    const int tid = otid();
    const bf16_t* PHY = (const bf16_t*)(P.ws + WS_PHY); const float* cw = P.in[I_HCW] + (size_t)l * 3 * HY_IN; const float* cb = P.in[I_HCB] + (size_t)l * HY_IN;
    const float bias1 = P.in[I_HBIAS][(size_t)l * 2 * HYC + HYC + c];
    const float* Z1 = (const float*)(P.ws + WS_Z1) + (size_t)c * NB * SEQ; float* Z1w = (float*)(P.ws + WS_Z1) + (size_t)c * NB * SEQ;
    for (int n = tid; n < SEQ; n += NTHR) { X[n] = make_float2(Z1[n], Z1[SEQ + n]); X[SEQ + n] = make_float2(0.f, 0.f); }
    __syncthreads();
    hy_conv_core(P, 1, c, X);
    bf16_t* MIX = (bf16_t*)(P.ws + WS_U);
    const HyTap tg2 = hy_tap(cw, cb, 2 * HYC + c); const bf16_t* colg2 = PHY + (size_t)(2 * HYC + c) * T;
#pragma unroll 4
    for (int n = tid; n < SEQ; n += NTHR) { const float2 y = X[n];
        const float g0 = hy_lat(colg2, 0, n, tg2), g1 = hy_lat(colg2, 1, n, tg2);
        Z1w[n] = g0 * (y.x + bias1 * Z1[n]); Z1w[SEQ + n] = g1 * (y.y + bias1 * Z1[SEQ + n]); }
    __syncthreads();
}

constexpr int SEGC = 256, NSEG = 33, SCH = 4;
typedef float f32x2v __attribute__((ext_vector_type(2)));
template <bool IDENT>
__device__ __forceinline__ void scan_seg(const Params& P, int chain, int g, float* ring_  ) {
    const ldsfp ring = vlds(ring_);
    const int lane = otid() & 63;
    const int d = chain & 1, h = (chain >> 1) % 6, b = chain / 12;
    const float* DEC = (const float*)(P.ws + WS_DECAY) + (size_t)d * T * 384; const bf16_t* KKS = (const bf16_t*)(P.ws + WS_KKS); const bf16_t* RS = (const bf16_t*)(P.ws + WS_RS);
    const bf16_t* VS = (const bf16_t*)(P.ws + WS_VS); const bf16_t* KS = (const bf16_t*)(P.ws + WS_KS) + (size_t)d * T * 384; const bf16_t* BS = (const bf16_t*)(P.ws + WS_BS) + (size_t)d * T * 384;
    float* YD = (float*)(P.ws + WS_YDIR) + (size_t)d * T * 384;
    bf16_t* E = (bf16_t*)(P.ws + WS_E) + (size_t)chain * SEQ * 64;
    const int step0 = g == 0 ? 0 : CTX + (g - 1) * SEGC;
    f32x2v S0[32], S1[32];
#pragma unroll
    for (int j = 0; j < 32; ++j) { S0[j] = (f32x2v){0.f, 0.f}; S1[j] = (f32x2v){(2 * j == lane) ? 1.f : 0.f, (2 * j + 1 == lane) ? 1.f : 0.f}; }
    float pw[SCH], pa[SCH], pb[SCH], pk[SCH], pr[SCH], pv[SCH]; int po[SCH];
#pragma unroll
    for (int s = 0; s < SCH; ++s) { const int o = scan_row(b, d, step0 + s) * 384 + h * 64 + lane; po[s] = o;
        pw[s] = DEC[o]; pa[s] = bf2f(KKS[o]); pb[s] = bf2f(BS[o]); pk[s] = bf2f(KS[o]); pr[s] = bf2f(RS[o]); pv[s] = bf2f(VS[o]); }
    for (int c = 0; c < SEGC / SCH; ++c) {
        float cv[SCH]; int co[SCH];
        asm volatile("s_waitcnt lgkmcnt(0)" ::: "memory");
#pragma unroll
        for (int s = 0; s < SCH; ++s) { const ldsfp sv = ring + s * 320; sv[lane] = pw[s]; sv[64 + lane] = pa[s]; sv[128 + lane] = pb[s]; sv[192 + lane] = pk[s]; sv[256 + lane] = pr[s]; cv[s] = pv[s]; co[s] = po[s]; }
        asm volatile("s_waitcnt lgkmcnt(0)" ::: "memory");
        if (c + 1 < SEGC / SCH) {
#pragma unroll
            for (int s = 0; s < SCH; ++s) { const int o = scan_row(b, d, step0 + (c + 1) * SCH + s) * 384 + h * 64 + lane; po[s] = o;
                pw[s] = DEC[o]; pa[s] = bf2f(KKS[o]); pb[s] = bf2f(BS[o]); pk[s] = bf2f(KS[o]); pr[s] = bf2f(RS[o]); pv[s] = bf2f(VS[o]); } }
#pragma unroll
        for (int s = 0; s < SCH; ++s) { const ldsfp sv = ring + s * 320;
            f32x2v sa2 = (f32x2v){0.f, 0.f}, sb2 = (f32x2v){0.f, 0.f}, sa3 = sa2, sb3 = sa2;
#pragma unroll
            for (int hb = 0; hb < 2; ++hb) { f32x4 A[8];
#pragma unroll
                for (int i = 0; i < 8; ++i) A[i] = *(const LAS f32x4*)(sv + 64 + hb * 32 + 4 * i);
                __builtin_amdgcn_sched_barrier(0);
#pragma unroll
                for (int i = 0; i < 8; ++i) { const int jj = hb * 16 + 2 * i; const f32x2v alo = (f32x2v){A[i].x, A[i].y}, ahi = (f32x2v){A[i].z, A[i].w};
                    sa2 += S0[jj] * alo; sa3 += S0[jj + 1] * ahi;
                    if (IDENT) { sb2 += S1[jj] * alo; sb3 += S1[jj + 1] * ahi; } }
                __builtin_amdgcn_sched_barrier(0); }
            const float sa = (sa2.x + sa2.y) + (sa3.x + sa3.y), sb = (sb2.x + sb2.y) + (sb3.x + sb3.y);
            const f32x2v saa = (f32x2v){sa, sa}, sbb = (f32x2v){sb, sb}, vv = (f32x2v){cv[s], cv[s]};
            f32x2v y2 = (f32x2v){0.f, 0.f}, y3 = y2, e2 = y2, e3 = y2;
#pragma unroll
            for (int ch = 0; ch < 8; ++ch) { f32x4 W[2], Bq[2], K[2], R[2];
#pragma unroll
                for (int i = 0; i < 2; ++i) { const int j = ch * 8 + 4 * i; W[i] = *(const LAS f32x4*)(sv + j); Bq[i] = *(const LAS f32x4*)(sv + 128 + j); K[i] = *(const LAS f32x4*)(sv + 192 + j); R[i] = *(const LAS f32x4*)(sv + 256 + j); }
                __builtin_amdgcn_sched_barrier(0);
#pragma unroll
                for (int i = 0; i < 2; ++i) { const int jj = ch * 4 + 2 * i;
                    const f32x2v wlo = (f32x2v){W[i].x, W[i].y}, whi = (f32x2v){W[i].z, W[i].w}, blo = (f32x2v){Bq[i].x, Bq[i].y}, bhi = (f32x2v){Bq[i].z, Bq[i].w};
                    const f32x2v klo = (f32x2v){K[i].x, K[i].y}, khi = (f32x2v){K[i].z, K[i].w}, rlo = (f32x2v){R[i].x, R[i].y}, rhi = (f32x2v){R[i].z, R[i].w};
                    S0[jj] = S0[jj] * wlo + saa * blo + vv * klo; y2 += S0[jj] * rlo;
                    S0[jj + 1] = S0[jj + 1] * whi + saa * bhi + vv * khi; y3 += S0[jj + 1] * rhi;
                    if (IDENT) { S1[jj] = S1[jj] * wlo + sbb * blo; e2 += S1[jj] * rlo; S1[jj + 1] = S1[jj + 1] * whi + sbb * bhi; e3 += S1[jj + 1] * rhi; } }
                __builtin_amdgcn_sched_barrier(0); }
            YD[co[s]] = (y2.x + y2.y) + (y3.x + y3.y);
            if (IDENT) { const int tl = d ? (SEQ - 1 - (step0 - CTX + c * SCH + s)) : (step0 - CTX + c * SCH + s); E[(size_t)tl * 64 + lane] = f2bf((e2.x + e2.y) + (e3.x + e3.y)); }
        }
    }
    float* ZP = (float*)(P.ws + WS_ZP) + ((size_t)chain * NSEG + g) * 2 * 4096;
#pragma unroll
    for (int j = 0; j < 32; j += 2) { *(float4*)(ZP + lane * 64 + 2 * j) = make_float4(S0[j].x, S0[j].y, S0[j + 1].x, S0[j + 1].y);
        if (IDENT) *(float4*)(ZP + 4096 + lane * 64 + 2 * j) = make_float4(S1[j].x, S1[j].y, S1[j + 1].x, S1[j + 1].y); }
}
typedef float f32x16 __attribute__((ext_vector_type(16)));
__device__ __forceinline__ void scan_combine(const Params& P, int chain, float* lds) {
    const int tid = otid(), lane = tid & 63, wv = tid >> 6, li = lane & 31, lh = lane >> 5;
    const ldsfp Sl = vlds(lds);
    const ldsfp Pl = Sl + 64 * 65;
    float* ZPc = (float*)(P.ws + WS_ZP) + (size_t)chain * NSEG * 2 * 4096;
    const int ti = (wv >> 1) & 1, tj = wv & 1;
    float pn[8];
#pragma unroll
    for (int q = 0; q < 8; ++q) { pn[q] = ZPc[(size_t)2 * 4096 + 4096 + tid * 8 + q]; Sl[(tid >> 3) * 65 + (tid & 7) * 8 + q] = ZPc[tid * 8 + q]; }
    f32x16 acc, zn;
#pragma unroll
    for (int r = 0; r < 16; ++r) { zn[r] = 0.f; acc[r] = 0.f; }
    if (wv < 4) {
#pragma unroll
        for (int r = 0; r < 16; ++r) zn[r] = ZPc[(size_t)2 * 4096 + (32 * ti + (r & 3) + 8 * (r >> 2) + 4 * lh) * 64 + 32 * tj + li]; }
    for (int g = 1; g < NSEG - 1; ++g) {
        __syncthreads();
        if (g > 1 && wv < 4) {
#pragma unroll
            for (int r = 0; r < 16; ++r) Sl[(32 * ti + (r & 3) + 8 * (r >> 2) + 4 * lh) * 65 + 32 * tj + li] = acc[r]; }
#pragma unroll
        for (int q = 0; q < 8; ++q) Pl[tid * 8 + q] = pn[q];
        acc = zn;
        if (g + 1 < NSEG - 1) { const float* nx = ZPc + (size_t)(g + 1) * 2 * 4096;
#pragma unroll
            for (int q = 0; q < 8; ++q) pn[q] = nx[4096 + tid * 8 + q];
            if (wv < 4) {
#pragma unroll
                for (int r = 0; r < 16; ++r) zn[r] = nx[(32 * ti + (r & 3) + 8 * (r >> 2) + 4 * lh) * 64 + 32 * tj + li]; } }
        __syncthreads();
        if (wv < 4) {
#pragma unroll 8
            for (int k0 = 0; k0 < 64; k0 += 2) { const float av = Sl[(32 * ti + li) * 65 + k0 + lh], bv = Pl[(k0 + lh) * 64 + 32 * tj + li];
                acc = __builtin_amdgcn_mfma_f32_32x32x2f32(av, bv, acc, 0, 0, 0); }
            float* Zg = ZPc + (size_t)g * 2 * 4096;
#pragma unroll
            for (int r = 0; r < 16; ++r) Zg[(32 * ti + (r & 3) + 8 * (r >> 2) + 4 * lh) * 64 + 32 * tj + li] = acc[r]; }
    }
    __syncthreads();
}

__device__ __forceinline__ void rwkv_out_fin(const Params& P, int row, int c, float y, float lnw, float lnb, float bon, float vs, float gt) {
    bf16_t* MIX = (bf16_t*)(P.ws + WS_U);
    const float mean = wsum(y) * (1.0f / 64.0f); const float dv = y - mean; const float var = wsum(dv * dv) * (1.0f / 64.0f);
    const float yn = dv * rsqrtf(var + 64e-5f) * lnw + lnb;
    MIX[(size_t)row * D + 256 + c] = f2bf((yn + bon * vs) * gt);
}
__device__ __forceinline__ void ph_rwkvout(const Params& P, int l, float* ldsf) {
    using pg8::bf16x8;
    const int tid = otid(), lane = tid & 63, fr = lane & 15, fq = lane >> 4, wv = tid >> 6, gw = blockIdx.x * NWAVE + wv, nw = gridDim.x * NWAVE;
    const float* YD = (const float*)(P.ws + WS_YDIR); const bf16_t* VS = (const bf16_t*)(P.ws + WS_VS); const bf16_t* GT = (const bf16_t*)(P.ws + WS_GATE); const float* BON = (const float*)(P.ws + WS_BONUS);
    bf16_t* MIX = (bf16_t*)(P.ws + WS_U);
    for (int it = gw; it < NB * 6 * 32 * 4; it += nw) {
        const int sub = it & 3, q = (it >> 2) & 31, h = (it >> 7) % 6, b = it / (128 * 6);
        const int t0 = q * 256 + sub * 64;
        f32x4 acc[4][4];
#pragma unroll
        for (int mt = 0; mt < 4; ++mt)
#pragma unroll
            for (int nt = 0; nt < 4; ++nt) acc[mt][nt] = (f32x4){0.f, 0.f, 0.f, 0.f};
#pragma unroll
        for (int dir = 0; dir < 2; ++dir) { const int ch = b * 12 + h * 2 + dir, slot = dir ? (31 - q) : q;
            const float* Sp = (const float*)(P.ws + WS_ZP) + ((size_t)ch * NSEG + slot) * 2 * 4096;
            const bf16_t* Ep = (const bf16_t*)(P.ws + WS_E) + ((size_t)ch * SEQ + t0) * 64;
#pragma unroll
            for (int ks = 0; ks < 2; ++ks) { bf16x8 bop[4];
#pragma unroll
                for (int nt = 0; nt < 4; ++nt) { const float* sp = Sp + (nt * 16 + fr) * 64 + ks * 32 + fq * 8; const float4 s0 = *(const float4*)sp, s1 = *(const float4*)(sp + 4);
                    u32x4 w; w.x = cvt_pk_bf16(s0.x, s0.y); w.y = cvt_pk_bf16(s0.z, s0.w); w.z = cvt_pk_bf16(s1.x, s1.y); w.w = cvt_pk_bf16(s1.z, s1.w); bop[nt] = __builtin_bit_cast(bf16x8, w); }
#pragma unroll
                for (int mt = 0; mt < 4; ++mt) { const bf16x8 a = *(const bf16x8*)(Ep + (size_t)(mt * 16 + fr) * 64 + ks * 32 + fq * 8);
#pragma unroll
                    for (int nt = 0; nt < 4; ++nt) acc[mt][nt] = __builtin_amdgcn_mfma_f32_16x16x32_bf16(bop[nt], a, acc[mt][nt], 0, 0, 0); } } }
        f32x4 lnw[4], lnb[4];
#pragma unroll
        for (int nt = 0; nt < 4; ++nt) { lnw[nt] = *(const f32x4*)(P.in[I_LNW] + l * RWW + h * 64 + nt * 16 + fq * 4); lnb[nt] = *(const f32x4*)(P.in[I_LNB] + l * RWW + h * 64 + nt * 16 + fq * 4); }
#pragma unroll
        for (int mt = 0; mt < 4; ++mt) { const int row = b * SEQ + t0 + mt * 16 + fr; const size_t o = (size_t)row * 384 + h * 64 + fq * 4;
            f32x4 y[4]; u32x2 vsw[4], gtw[4]; const float bon = BON[(size_t)row * 6 + h];
#pragma unroll
            for (int nt = 0; nt < 4; ++nt) { y[nt] = *(const f32x4*)(YD + o + nt * 16) + *(const f32x4*)(YD + (size_t)T * 384 + o + nt * 16) + acc[mt][nt];
                vsw[nt] = *(const u32x2*)(VS + o + nt * 16); gtw[nt] = *(const u32x2*)(GT + o + nt * 16); }
            float sm = 0.f;
#pragma unroll
            for (int nt = 0; nt < 4; ++nt) sm += (y[nt][0] + y[nt][1]) + (y[nt][2] + y[nt][3]);
            sm += __shfl_xor(sm, 16); sm += __shfl_xor(sm, 32);
            const float mean = sm * (1.0f / 64.0f);
            float vr = 0.f;
#pragma unroll
            for (int nt = 0; nt < 4; ++nt) { y[nt] = y[nt] - mean; vr += (y[nt][0] * y[nt][0] + y[nt][1] * y[nt][1]) + (y[nt][2] * y[nt][2] + y[nt][3] * y[nt][3]); }
            vr += __shfl_xor(vr, 16); vr += __shfl_xor(vr, 32);
            const float rstd = rsqrtf(vr * (1.0f / 64.0f) + 64e-5f);
#pragma unroll
            for (int nt = 0; nt < 4; ++nt) { const f32x4 yn = y[nt] * rstd * lnw[nt] + lnb[nt];
                const float o0 = (yn[0] + bon * lo_bf(vsw[nt].x)) * lo_bf(gtw[nt].x), o1 = (yn[1] + bon * hi_bf(vsw[nt].x)) * hi_bf(gtw[nt].x);
                const float o2 = (yn[2] + bon * lo_bf(vsw[nt].y)) * lo_bf(gtw[nt].y), o3 = (yn[3] + bon * hi_bf(vsw[nt].y)) * hi_bf(gtw[nt].y);
                u32x2 w; w.x = cvt_pk_bf16(o0, o1); w.y = cvt_pk_bf16(o2, o3);
                *(u32x2*)(MIX + (size_t)row * D + 256 + h * 64 + nt * 16 + fq * 4) = w; }
            asm volatile("" ::: "memory"); }
    }
    for (int it = gw; it < TC * 6; it += nw) { const int row = TL + it / 6, h = it % 6, c = h * 64 + lane; const size_t o = (size_t)row * 384 + c;
        rwkv_out_fin(P, row, c, YD[o] + YD[(size_t)T * 384 + o], P.in[I_LNW][l * RWW + c], P.in[I_LNB][l * RWW + c], BON[(size_t)row * 6 + h], bf2f(VS[o]), bf2f(GT[o])); }
}

__device__ __forceinline__ void zt_tile(const Params& P, int tile, float* tl  ) {
    const int tid = otid(); const int c0 = (tile & 3) * 64, t0 = (tile >> 2) * 64;
    const float* Z = (const float*)(P.ws + WS_Z1); bf16_t* MIX = (bf16_t*)(P.ws + WS_U);
    { const int cc = tid >> 3, sg = (tid & 7) * 8; const float* src = Z + (size_t)(c0 + cc) * TL + t0 + sg; const float4 a = *(const float4*)src, b = *(const float4*)(src + 4);
      tl[cc * 65 + sg + 0] = a.x; tl[cc * 65 + sg + 1] = a.y; tl[cc * 65 + sg + 2] = a.z; tl[cc * 65 + sg + 3] = a.w; tl[cc * 65 + sg + 4] = b.x; tl[cc * 65 + sg + 5] = b.y; tl[cc * 65 + sg + 6] = b.z; tl[cc * 65 + sg + 7] = b.w; }
    __syncthreads();
    { const int tk = tid >> 3, cs = (tid & 7) * 8;
      u32x4 w; w.x = cvt_pk_bf16(tl[(cs + 0) * 65 + tk], tl[(cs + 1) * 65 + tk]); w.y = cvt_pk_bf16(tl[(cs + 2) * 65 + tk], tl[(cs + 3) * 65 + tk]);
      w.z = cvt_pk_bf16(tl[(cs + 4) * 65 + tk], tl[(cs + 5) * 65 + tk]); w.w = cvt_pk_bf16(tl[(cs + 6) * 65 + tk], tl[(cs + 7) * 65 + tk]);
      *(u32x4*)(MIX + (size_t)(t0 + tk) * D + c0 + cs) = w; }
    __syncthreads();
}
typedef const __attribute__((address_space(4))) Params* KParamsPtr;
__device__ __forceinline__ const Params* fresh_params() { KParamsPtr q = (KParamsPtr)__builtin_amdgcn_kernarg_segment_ptr(); asm volatile("" : "+s"(q)); return (const Params*)q; }
__global__ void __launch_bounds__(NTHR, 2) fwd_megakernel(Params P_unused, int ph_lo, int ph_hi) {
    extern __shared__ __attribute__((aligned(16))) unsigned char smem[];
    cg::grid_group grid = cg::this_grid();
    LAS unsigned char* lds3 = (LAS unsigned char*)smem;
    float* ldsf = (float*)smem; float2* X = (float2*)smem; float* ex = (float*)(smem + LDS_MAIN);
    { volatile LAS unsigned* st = (volatile LAS unsigned*)(lds3 + LDS_MAIN + 4096); if (threadIdx.x == 0) { st[0] = 0u; st[1] = 0u; } }
    __syncthreads();
    XcdBarrier xbar = xcd_barrier_post((unsigned*)(((const Params*)fresh_params())->ws + WS_BAR), (volatile LAS unsigned*)(lds3 + LDS_MAIN + 4096));
    int ph = 0;
#ifndef REP_GEMM
#define REP_GEMM 1
#endif
#ifndef REP_SCAN
#define REP_SCAN 1
#endif
#ifndef REP_MISC
#define REP_MISC 1
#endif
#ifndef REP_HY
#define REP_HY 1
#endif
#define PHASE_BEGIN if (ph >= ph_lo && ph < ph_hi) { const Params& P = *fresh_params(); unsigned char* ws = P.ws; (void)ws;
#ifndef REP_SYNC
#define REP_SYNC 1
#endif
#define PHASE_END   if (ph + 1 < ph_hi) { for (int rs_ = 0; rs_ < REP_SYNC; ++rs_) { if (ph == 0) grid.sync(); else xcd_barrier(xbar); } } } ++ph;
    PHASE_BEGIN ph_modv(P, ldsf); PHASE_END
    for (int l = 0; l < DEPTH; ++l) {
        PHASE_BEGIN
            for (int rep_ = 0; rep_ < REP_MISC; ++rep_) ph_prep(P, l, ldsf);
            if (l == 0) ph_rowpass(P, 0, 0, 0, 0, 0.f, 0, 0, 0, 1, 1);
            else ph_rowpass(P, 1, l - 1, 8, 5, 0.5f, l, 0, 0, 1, 11);
        PHASE_END
        PHASE_BEGIN { EpiGU E{(bf16_t*)(ws + WS_ACT)}; for (int rep_ = 0; rep_ < REP_GEMM; ++rep_) run_gemm(lds3, (const bf16_t*)(ws + WS_U), (const bf16_t*)(ws + WS_WGU1), T, 2 * DFF, D, E); } PHASE_END
        PHASE_BEGIN { EpiF32 E{(bf16_t*)(ws + WS_Y), (float*)(ws + WS_YC)}; run_gemm_tail(lds3, (const bf16_t*)(ws + WS_ACT), (const bf16_t*)(ws + WS_WDN1), DFF, E); } PHASE_END
        PHASE_BEGIN ph_rowpass(P, 1, l, 2, 1, 0.5f, l, 2, 3, 4, 11); PHASE_END
        PHASE_BEGIN { EpiWin E{(bf16_t*)(ws + WS_PHY), (bf16_t*)(ws + WS_PRW), (bf16_t*)(ws + WS_PNA)}; for (int rep_ = 0; rep_ < REP_GEMM; ++rep_) run_gemm(lds3, (const bf16_t*)(ws + WS_U), (const bf16_t*)(ws + WS_WIN), T, INWP, D, E); } PHASE_END
        PHASE_BEGIN
            for (int rep_ = 0; rep_ < REP_MISC; ++rep_) { ph_loraprep(P, l);
            for (int it = blockIdx.x; it < NB * 128 * 6 + NB * 4 * 6; it += gridDim.x) vt_tile(P, it, (unsigned short*)smem); }
            for (int rep_ = 0; rep_ < REP_HY; ++rep_) for (int it = blockIdx.x; it < 256; it += gridDim.x) hy_spec_task(P, l, it, X);
        PHASE_END
        PHASE_BEGIN { EpiLora E{(bf16_t*)(ws + WS_LORAO), (bf16_t*)(ws + WS_GATE)};
            for (int rep_ = 0; rep_ < REP_GEMM; ++rep_) run_gemm(lds3, (const bf16_t*)(ws + WS_ALORA), (const bf16_t*)(ws + WS_WLORA), T, 2048, 384, E); } PHASE_END
        PHASE_BEGIN
            for (int rep_ = 0; rep_ < REP_MISC; ++rep_) ph_rwkvprep(P, l);
            for (int rep_ = 0; rep_ < REP_HY; ++rep_) for (int c = blockIdx.x; c < HYC; c += gridDim.x) hy_task1(P, l, c, X, ex);
        PHASE_END
        PHASE_BEGIN {
            const int wv = __builtin_amdgcn_readfirstlane(otid() >> 6);
            if (wv < 4) { const int k = wv * (int)gridDim.x + (int)blockIdx.x;
                if (k < 24 * NSEG) { const int chain = k / NSEG, g = k % NSEG; float* ring = ldsf + wv * (SCH * 320);
                    __builtin_amdgcn_s_setprio(3);
                    for (int rep_ = 0; rep_ < REP_SCAN; ++rep_) { if (g == 0) scan_seg<false>(P, chain, g, ring); else scan_seg<true>(P, chain, g, ring); }
                    __builtin_amdgcn_s_setprio(0); } }
            else for (int it = (wv - 4) * (int)gridDim.x + (int)blockIdx.x; it < NAT_TASKS; it += 4 * (int)gridDim.x) natten_task(P, l, it);
        } PHASE_END
        PHASE_BEGIN
            for (int rep_ = 0; rep_ < REP_HY; ++rep_) for (int c = blockIdx.x; c < HYC; c += gridDim.x) hy_task2(P, l, c, X);
            if (blockIdx.x >= gridDim.x - 24) scan_combine(P, (int)(gridDim.x - 1 - blockIdx.x), ldsf);
        PHASE_END
        PHASE_BEGIN for (int rep_ = 0; rep_ < REP_MISC; ++rep_) ph_rwkvout(P, l, ldsf);
            __syncthreads();
            for (int it = blockIdx.x; it < 4 * (TL / 64); it += gridDim.x) zt_tile(P, it, ldsf);
        PHASE_END
        PHASE_BEGIN { EpiF32 E{(bf16_t*)(ws + WS_Y), (float*)(ws + WS_YC)}; run_gemm_tail(lds3, (const bf16_t*)(ws + WS_U), (const bf16_t*)(ws + WS_WOUT), D, E); } PHASE_END
        PHASE_BEGIN ph_rowpass(P, 1, l, 5, 3, 1.0f, l, 4, 6, 7, 4); PHASE_END
        PHASE_BEGIN { EpiGU E{(bf16_t*)(ws + WS_ACT)}; for (int rep_ = 0; rep_ < REP_GEMM; ++rep_) run_gemm(lds3, (const bf16_t*)(ws + WS_U), (const bf16_t*)(ws + WS_WGU2), T, 2 * DFF, D, E); } PHASE_END
        PHASE_BEGIN { EpiF32 E{(bf16_t*)(ws + WS_Y), (float*)(ws + WS_YC)}; run_gemm_tail(lds3, (const bf16_t*)(ws + WS_ACT), (const bf16_t*)(ws + WS_WDN2), DFF, E); } PHASE_END
    }
    PHASE_BEGIN ph_rowpass(P, 2, DEPTH - 1, 8, 5, 0.5f, 0, 0, 0, 0, 11); PHASE_END
#undef PHASE_BEGIN
#undef PHASE_END
}
constexpr int N_PHASES = 1 + DEPTH * 15 + 1;

extern "C" void kernel_launch(void* const* d_in, const int* in_sizes, int n_in, void* d_out, int out_size, void* d_ws, size_t ws_size, hipStream_t stream) {
    static int grid = 0;
    if (grid == 0) {
        if (n_in != 34 || ws_size < WS_END) { fprintf(stderr, "kernel_launch: need 34 inputs and %zu bytes of workspace; got %d, %zu\n", (size_t)WS_END, n_in, ws_size); grid = -1; return; }
        int dev = 0, cus = 0, per_cu = 0;
        hipGetDevice(&dev); hipDeviceGetAttribute(&cus, hipDeviceAttributeMultiprocessorCount, dev);
        if (hipFuncSetAttribute((const void*)fwd_megakernel, hipFuncAttributeMaxDynamicSharedMemorySize, LDS_BYTES) != hipSuccess) { fprintf(stderr, "kernel_launch: hipFuncSetAttribute failed\n"); grid = -1; return; }
        if (hipOccupancyMaxActiveBlocksPerMultiprocessor(&per_cu, (const void*)fwd_megakernel, NTHR, LDS_BYTES) != hipSuccess || per_cu < 1) { fprintf(stderr, "kernel_launch: occupancy query says %d\n", per_cu); per_cu = 1; }
        (void)hipGetLastError();
        grid = cus;
    }
    if (grid < 0) return;
    if (hipMemsetAsync((char*)d_ws + WS_BAR, 0, (size_t)XCD_BAR_WORDS * 4, stream) != hipSuccess) { fprintf(stderr, "kernel_launch: memset of the barrier words failed\n"); return; }
    Params p{};
    for (int i = 0; i < 34; ++i) p.in[i] = (const float*)d_in[i];
    p.out = (float*)d_out; p.ws = (unsigned char*)d_ws;
#if MK_SPLIT
    for (int ph = 0; ph < N_PHASES; ++ph) { int lo = ph, hi = ph + 1; hipLaunchKernelGGL(fwd_megakernel, dim3(grid), dim3(NTHR), LDS_BYTES, stream, p, lo, hi); }
#else
    int lo = 0, hi = N_PHASES;
    void* args[] = {&p, &lo, &hi};
    hipError_t e = hipLaunchCooperativeKernel((const void*)fwd_megakernel, dim3(grid), dim3(NTHR), args, LDS_BYTES, stream);
    if (e != hipSuccess) fprintf(stderr, "cooperative launch failed: %s (grid %d)\n", hipGetErrorString(e), grid);
#endif
}
```
